# Optimizing an MI355X kernel written in HIP

```python
import math
import jax, jax.numpy as jnp
from jax import lax
import numpy as np

D_MODEL = 2048
BATCH = 2
SEQ = 4096
DEPTH = 2
DEC_BATCH = 32
DEC_SEQ = 1
PAST_LEN = 16384
PAGE_SIZE = 128

N_META = 16
ATTN_WIDTH = D_MODEL // 2
HEAD_DIM = 128
N_HEADS = ATTN_WIDTH // HEAD_DIM
N_KV_HEADS = N_HEADS // 4
GQA_GROUP = N_HEADS // N_KV_HEADS
KV_WIDTH = N_KV_HEADS * HEAD_DIM
WINDOW = 128
BLOCK = 128
ROT_DIM = HEAD_DIM // 4
ROPE_THETA = 500000.0
SSM_WIDTH = D_MODEL // 4
SSM_GROUP_SIZE = 16
SSM_GROUPS = SSM_WIDTH // SSM_GROUP_SIZE
SSM_STATE = 64
POOL_WIDTH = D_MODEL // 4
POOL_WINDOWS = (2, 4, 8, 16)
POOL_GROUP = POOL_WIDTH // len(POOL_WINDOWS)
POOL_BUF = max(POOL_WINDOWS) - 1
MIX_WIDTH = ATTN_WIDTH + SSM_WIDTH + POOL_WIDTH
IN_WIDTH = ATTN_WIDTH + 2 * KV_WIDTH + SSM_WIDTH + POOL_WIDTH
D_FF = 4 * D_MODEL
EPS = 1e-6

kernel_name = "hymba_swa_s5_pool_decoder_step"


def rms_norm(x, g):
    xf = x.astype(jnp.float32)
    y = xf * lax.rsqrt(jnp.mean(xf * xf, axis=-1, keepdims=True) + EPS)
    return (y * g.astype(jnp.float32)).astype(x.dtype)


def rope(x, pos):
    half = ROT_DIM // 2
    inv = ROPE_THETA ** (-jnp.arange(0, ROT_DIM, 2, dtype=jnp.float32) / ROT_DIM)
    ang = pos.astype(jnp.float32)[:, None] * inv
    cos = jnp.cos(ang)[:, None, :]
    sin = jnp.sin(ang)[:, None, :]
    xf = x.astype(jnp.float32)
    x1, x2 = xf[..., :half], xf[..., half:ROT_DIM]
    out = jnp.concatenate([x1 * cos - x2 * sin, x2 * cos + x1 * sin, xf[..., ROT_DIM:]], axis=-1)
    return out.astype(x.dtype)


def sink_attend(q, k, v, mask, sink):
    s = jnp.einsum('...qkgd,...skd->...kgqs', q, k).astype(jnp.float32) * (HEAD_DIM ** -0.5)
    s = jnp.where(mask[..., None, None, :, :], s, -jnp.inf)
    sk = sink.astype(jnp.float32)[:, :, None, None]
    m = jnp.maximum(jnp.max(s, axis=-1, keepdims=True), sk)
    p = jnp.exp(s - m)
    denom = jnp.sum(p, axis=-1, keepdims=True) + jnp.exp(sk - m)
    return jnp.einsum('...kgqs,...skd->...qkgd', (p / denom).astype(v.dtype), v)


def attn_prompt(q, k, v, sink):
    bsz, L = q.shape[0], q.shape[1]
    front = (-N_META) % BLOCK
    back = (-(front + L)) % BLOCK
    pad = lambda t: jnp.pad(t, ((0, 0), (front, back), (0, 0), (0, 0)))
    qp, kp, vp = pad(q), pad(k), pad(v)
    Lp = front + L + back
    nb = Lp // BLOCK
    qb = qp.reshape(bsz, nb, BLOCK, N_KV_HEADS, GQA_GROUP, HEAD_DIM)
    kb = kp.reshape(bsz, nb, BLOCK, N_KV_HEADS, HEAD_DIM)
    vb = vp.reshape(bsz, nb, BLOCK, N_KV_HEADS, HEAD_DIM)

    def band(t):
        prev = jnp.pad(t, ((0, 0), (1, 0), (0, 0), (0, 0), (0, 0)))[:, :-1]
        return jnp.concatenate([prev, t], axis=2)

    qpos = (jnp.arange(Lp) - front).reshape(nb, BLOCK)
    kpos = qpos[:, :1] - BLOCK + jnp.arange(2 * BLOCK)[None, :]
    diff = qpos[:, :, None] - kpos[:, None, :]
    mask = (diff >= 0) & (diff <= WINDOW) & (kpos[:, None, :] >= 0)
    o = sink_attend(qb, band(kb), band(vb), mask[None], sink)
    return o.reshape(bsz, Lp, ATTN_WIDTH)[:, front:front + L]


def attn_sample(q, k, v, k_buf, v_buf, sink):
    bsz, T = q.shape[0], q.shape[1]
    wb = k_buf.shape[1]
    kk = jnp.concatenate([k_buf.astype(k.dtype), k], axis=1)
    vv = jnp.concatenate([v_buf.astype(v.dtype), v], axis=1)
    qpos = PAST_LEN + jnp.arange(T)
    kpos = PAST_LEN - wb + jnp.arange(wb + T)
    diff = qpos[:, None] - kpos[None, :]
    mask = (diff >= 0) & (diff <= WINDOW)
    o = sink_attend(q.reshape(bsz, T, N_KV_HEADS, GQA_GROUP, HEAD_DIM), kk, vv, mask[None], sink)
    return o.reshape(bsz, T, ATTN_WIDTH), kk[:, -wb:], vv[:, -wb:]


def _complex_combine(e1, e2):
    a1r, a1i, b1r, b1i = e1
    a2r, a2i, b2r, b2i = e2
    return (a2r * a1r - a2i * a1i, a2r * a1i + a2i * a1r,
            a2r * b1r - a2i * b1i + b2r, a2r * b1i + a2i * b1r + b2i)


def ssm_mix(u, A_re, A_im, log_dt, B_re, B_im, C_re, C_im, D_skip, w_glu, b_glu, h0=None):
    bsz, T = u.shape[0], u.shape[1]
    uf = u.astype(jnp.float32)
    ug = uf.reshape(bsz, T, SSM_GROUPS, SSM_GROUP_SIZE)
    dt = jnp.exp(log_dt.astype(jnp.float32))[:, None]
    ar, ai = A_re.astype(jnp.float32), A_im.astype(jnp.float32)
    mag = jnp.exp(dt * ar)
    abr, abi = mag * jnp.cos(dt * ai), mag * jnp.sin(dt * ai)
    den = ar * ar + ai * ai
    fr = ((abr - 1.0) * ar + abi * ai) / den
    fi = (abi * ar - (abr - 1.0) * ai) / den
    br, bi = B_re.astype(jnp.float32), B_im.astype(jnp.float32)
    bbr = fr[..., None] * br - fi[..., None] * bi
    bbi = fr[..., None] * bi + fi[..., None] * br
    xr = jnp.einsum('btgc,gnc->btgn', ug, bbr)
    xi = jnp.einsum('btgc,gnc->btgn', ug, bbi)
    car, cai, hr, hi = lax.associative_scan(
        _complex_combine,
        (jnp.broadcast_to(abr, xr.shape), jnp.broadcast_to(abi, xr.shape), xr, xi), axis=1)
    if h0 is not None:
        h0r = h0[0].astype(jnp.float32)[:, None]
        h0i = h0[1].astype(jnp.float32)[:, None]
        hr, hi = hr + car * h0r - cai * h0i, hi + car * h0i + cai * h0r
    y = (jnp.einsum('gcn,btgn->btgc', C_re.astype(jnp.float32), hr)
         - jnp.einsum('gcn,btgn->btgc', C_im.astype(jnp.float32), hi))
    y = y.reshape(bsz, T, SSM_WIDTH) + D_skip.astype(jnp.float32) * uf
    z = jax.nn.gelu(y)
    out = z * jax.nn.sigmoid(z @ w_glu.astype(jnp.float32) + b_glu.astype(jnp.float32))
    return out.astype(u.dtype), hr[:, -1], hi[:, -1]


def pool_mix(xp, w_pool, pool_scale, prev=None):
    T = xp.shape[1]
    ext = xp if prev is None else jnp.concatenate([prev.astype(xp.dtype), xp], axis=1)
    n_prev = ext.shape[1] - T
    cs = jnp.pad(jnp.cumsum(ext.astype(jnp.float32), axis=1), ((0, 0), (1, 0), (0, 0)))
    hi = n_prev + jnp.arange(T) + 1
    outs = []
    for g, w in enumerate(POOL_WINDOWS):
        lo = jnp.maximum(hi - w, 0)
        sl = slice(g * POOL_GROUP, (g + 1) * POOL_GROUP)
        csg = cs[..., sl]
        mean = (csg[:, hi] - csg[:, lo]) / (hi - lo).astype(jnp.float32)[:, None]
        outs.append(jnp.einsum('btc,cd->btd', mean - xp[..., sl].astype(jnp.float32),
                               w_pool[g].astype(jnp.float32)))
    y = jnp.concatenate(outs, axis=-1) * pool_scale.astype(jnp.float32)
    return y.astype(xp.dtype), ext[:, -POOL_BUF:]


def trunk_layer(x, pos, lp, past):
    bsz, T = x.shape[0], x.shape[1]
    h = rms_norm(x, lp['g_mix'])
    proj = h @ lp['w_in']
    o1 = ATTN_WIDTH
    o2 = o1 + KV_WIDTH
    o3 = o2 + KV_WIDTH
    o4 = o3 + SSM_WIDTH
    q = proj[..., :o1].reshape(bsz, T, N_HEADS, HEAD_DIM)
    k = proj[..., o1:o2].reshape(bsz, T, N_KV_HEADS, HEAD_DIM)
    v = proj[..., o2:o3].reshape(bsz, T, N_KV_HEADS, HEAD_DIM)
    u = proj[..., o3:o4]
    xpool = proj[..., o4:]
    q = rope(rms_norm(q, lp['g_q']), pos)
    k = rope(rms_norm(k, lp['g_k']), pos)
    sink = lp['sinks'].reshape(N_KV_HEADS, GQA_GROUP)
    ssm_args = (lp['A_re'], lp['A_im'], lp['log_dt'], lp['B_re'], lp['B_im'], lp['C_re'],
                lp['C_im'], lp['D_skip'], lp['w_glu'], lp['b_glu'])
    if past is None:
        a = attn_prompt(q, k, v, sink)
        nw = min(WINDOW, T)
        new_k, new_v = k[:, -nw:], v[:, -nw:]
        s, hr, hi = ssm_mix(u, *ssm_args)
        pl, pbuf = pool_mix(xpool, lp['w_pool'], lp['pool_scale'])
    else:
        k_buf, v_buf, h_re, h_im, p_buf = past
        a, new_k, new_v = attn_sample(q, k, v, k_buf, v_buf, sink)
        s, hr, hi = ssm_mix(u, *ssm_args, h0=(h_re, h_im))
        pl, pbuf = pool_mix(xpool, lp['w_pool'], lp['pool_scale'], p_buf)
    mix = jnp.concatenate([rms_norm(a, lp['g_out_attn']), rms_norm(s, lp['g_out_ssm']),
                           rms_norm(pl, lp['g_out_pool'])], axis=-1)
    x = x + mix @ lp['w_out']
    h2 = rms_norm(x, lp['g_ffn'])
    x = x + jnp.square(jax.nn.relu(h2 @ lp['w_ff1'])) @ lp['w_ff2']
    return x, (new_k, new_v, hr, hi, pbuf)


def setup_inputs(seed: int = 0) -> dict:
    key = jax.random.key(seed)
    ks = jax.random.split(key, 40)
    nrm = lambda i, shape: jax.random.normal(ks[i], shape, jnp.float32)
    win_buf = min(WINDOW, PAST_LEN)
    return {
        'x_prompt': nrm(0, (BATCH, SEQ, D_MODEL)),
        'x_sample': nrm(1, (DEC_BATCH, DEC_SEQ, D_MODEL)),
        'cache_k': nrm(2, (DEPTH, DEC_BATCH, win_buf, N_KV_HEADS, HEAD_DIM)),
        'cache_v': nrm(3, (DEPTH, DEC_BATCH, win_buf, N_KV_HEADS, HEAD_DIM)),
        'state_ssm_re': 0.1 * nrm(4, (DEPTH, DEC_BATCH, SSM_GROUPS, SSM_STATE)),
        'state_ssm_im': 0.1 * nrm(5, (DEPTH, DEC_BATCH, SSM_GROUPS, SSM_STATE)),
        'state_pool': nrm(6, (DEPTH, DEC_BATCH, POOL_BUF, POOL_WIDTH)),
        'meta_tokens': nrm(7, (N_META, D_MODEL)),
        'g_mix': 1.0 + 0.01 * nrm(8, (DEPTH, D_MODEL)),
        'w_in': nrm(9, (DEPTH, D_MODEL, IN_WIDTH)) * D_MODEL ** -0.5,
        'g_q': 1.0 + 0.01 * nrm(10, (DEPTH, HEAD_DIM)),
        'g_k': 1.0 + 0.01 * nrm(11, (DEPTH, HEAD_DIM)),
        'sinks': nrm(12, (DEPTH, N_HEADS)),
        'A_re': -0.5 + 0.01 * nrm(13, (DEPTH, SSM_GROUPS, SSM_STATE)),
        'A_im': jnp.pi * jnp.arange(SSM_STATE, dtype=jnp.float32) + 0.01 * nrm(14, (DEPTH, SSM_GROUPS, SSM_STATE)),
        'log_dt': jax.random.uniform(ks[15], (DEPTH, SSM_GROUPS), jnp.float32, math.log(1e-3), math.log(1e-1)),
        'B_re': nrm(16, (DEPTH, SSM_GROUPS, SSM_STATE, SSM_GROUP_SIZE)) * (2 * SSM_GROUP_SIZE) ** -0.5,
        'B_im': nrm(17, (DEPTH, SSM_GROUPS, SSM_STATE, SSM_GROUP_SIZE)) * (2 * SSM_GROUP_SIZE) ** -0.5,
        'C_re': nrm(18, (DEPTH, SSM_GROUPS, SSM_GROUP_SIZE, SSM_STATE)) * (2 * SSM_STATE) ** -0.5,
        'C_im': nrm(19, (DEPTH, SSM_GROUPS, SSM_GROUP_SIZE, SSM_STATE)) * (2 * SSM_STATE) ** -0.5,
        'D_skip': nrm(20, (DEPTH, SSM_WIDTH)),
        'w_glu': nrm(21, (DEPTH, SSM_WIDTH, SSM_WIDTH)) * SSM_WIDTH ** -0.5,
        'b_glu': 0.01 * nrm(22, (DEPTH, SSM_WIDTH)),
        'w_pool': nrm(23, (DEPTH, len(POOL_WINDOWS), POOL_GROUP, POOL_GROUP)) * POOL_GROUP ** -0.5,
        'pool_scale': 1.0 + 0.1 * nrm(24, (DEPTH, POOL_WIDTH)),
        'g_out_attn': 1.0 + 0.01 * nrm(25, (DEPTH, ATTN_WIDTH)),
        'g_out_ssm': 1.0 + 0.01 * nrm(26, (DEPTH, SSM_WIDTH)),
        'g_out_pool': 1.0 + 0.01 * nrm(27, (DEPTH, POOL_WIDTH)),
        'w_out': nrm(28, (DEPTH, MIX_WIDTH, D_MODEL)) * MIX_WIDTH ** -0.5,
        'g_ffn': 1.0 + 0.01 * nrm(29, (DEPTH, D_MODEL)),
        'w_ff1': nrm(30, (DEPTH, D_MODEL, D_FF)) * D_MODEL ** -0.5,
        'w_ff2': nrm(31, (DEPTH, D_FF, D_MODEL)) * D_FF ** -0.5,
    }


def reference(x_prompt, x_sample, cache_k, cache_v, state_ssm_re, state_ssm_im, state_pool,
              meta_tokens, g_mix, w_in, g_q, g_k, sinks, A_re, A_im, log_dt, B_re, B_im,
              C_re, C_im, D_skip, w_glu, b_glu, w_pool, pool_scale, g_out_attn, g_out_ssm,
              g_out_pool, w_out, g_ffn, w_ff1, w_ff2):
    meta = jnp.broadcast_to(meta_tokens.astype(x_prompt.dtype)[None],
                            (x_prompt.shape[0], N_META, D_MODEL))
    xp = jnp.concatenate([meta, x_prompt], axis=1)
    xs = x_sample
    pos_p = jnp.arange(xp.shape[1])
    pos_s = PAST_LEN + jnp.arange(xs.shape[1])
    states_p, states_s = [], []
    for l in range(DEPTH):
        lp = dict(g_mix=g_mix[l], w_in=w_in[l], g_q=g_q[l], g_k=g_k[l], sinks=sinks[l],
                  A_re=A_re[l], A_im=A_im[l], log_dt=log_dt[l], B_re=B_re[l], B_im=B_im[l],
                  C_re=C_re[l], C_im=C_im[l], D_skip=D_skip[l], w_glu=w_glu[l], b_glu=b_glu[l],
                  w_pool=w_pool[l], pool_scale=pool_scale[l], g_out_attn=g_out_attn[l],
                  g_out_ssm=g_out_ssm[l], g_out_pool=g_out_pool[l], w_out=w_out[l],
                  g_ffn=g_ffn[l], w_ff1=w_ff1[l], w_ff2=w_ff2[l])
        xp, st_p = trunk_layer(xp, pos_p, lp, None)
        xs, st_s = trunk_layer(xs, pos_s, lp, (cache_k[l], cache_v[l], state_ssm_re[l],
                                               state_ssm_im[l], state_pool[l]))
        states_p.append(st_p)
        states_s.append(st_s)
    np_ = [jnp.stack(s) for s in zip(*states_p)]
    ns_ = [jnp.stack(s) for s in zip(*states_s)]
    y_prompt = xp[:, N_META:]
    return (y_prompt, xs, np_[0], np_[1], np_[2], np_[3], np_[4],
            ns_[0], ns_[1], ns_[2], ns_[3], ns_[4])
```

```cpp
#include <hip/hip_runtime.h>
#include <cstdio>
#include <cstdint>

#ifndef MK_N_LAUNCHES
#define MK_N_LAUNCHES 11
#endif

constexpr int DM = 2048, TT = 4112  , NSEQ = 4096, NMETA = 16, NBATCH = 2, NSAMP = 32;
constexpr int MR = NBATCH * TT + NSAMP;
constexpr int MP = 8448;
constexpr int SROW0 = NBATCH * TT;
constexpr int INW = 2560, DFF = 8192, NLAYER = 2;
constexpr int TPV = 4128;
constexpr int ROPE_SAMPLE_IDX = TT;
constexpr float EPS = 1e-6f;
constexpr float LOG2E = 1.4426950408889634f;
constexpr float QSCALE = 0.08838834764831845f * LOG2E;
constexpr int NCHUNK = MR / 64;
constexpr int NQB = (TT + 31) / 32;

constexpr size_t O_YP = 0, O_YS = O_YP + (size_t)NBATCH * NSEQ * DM, O_PK = O_YS + (size_t)NSAMP * DM, O_PV = O_PK + (size_t)NLAYER * NBATCH * 128 * 256,
                 O_PSR = O_PV + (size_t)NLAYER * NBATCH * 128 * 256, O_PSI = O_PSR + (size_t)NLAYER * NBATCH * 2048, O_PP = O_PSI + (size_t)NLAYER * NBATCH * 2048,
                 O_SK = O_PP + (size_t)NLAYER * NBATCH * 15 * 512, O_SV = O_SK + (size_t)NLAYER * NSAMP * 128 * 256, O_SSR = O_SV + (size_t)NLAYER * NSAMP * 128 * 256,
                 O_SSI = O_SSR + (size_t)NLAYER * NSAMP * 2048, O_SP = O_SSI + (size_t)NLAYER * NSAMP * 2048, O_END = O_SP + (size_t)NLAYER * NSAMP * 15 * 512;

constexpr size_t MiB = 1u << 20;
constexpr size_t WS_CTL = 0, CTL_ZERO_BYTES = 1 * MiB;
constexpr size_t WS_WIN = 1 * MiB, WS_WOUT = 21 * MiB, WS_W1 = 37 * MiB, WS_W2 = 101 * MiB, WS_WGLU = 165 * MiB, WS_WPOOL = 166 * MiB, WS_TAB = 167 * MiB;
constexpr size_t WS_X = 170 * MiB, WS_XB = 236 * MiB, WS_Q = 269 * MiB, WS_K = 286 * MiB, WS_VT = 291 * MiB, WS_U = 296 * MiB, WS_XP = 313 * MiB, WS_MIX = 330 * MiB,
                 WS_H = 363 * MiB, WS_SSQ = 495 * MiB, WS_SST = 497 * MiB, WS_KSN = 502 * MiB, WS_END = 503 * MiB;
static_assert(WS_WIN + (size_t)NLAYER * INW * DM * 2 <= WS_WOUT && WS_WOUT + (size_t)NLAYER * DM * DM * 2 <= WS_W1 && WS_W1 + (size_t)NLAYER * DFF * DM * 2 <= WS_W2 && WS_W2 + (size_t)NLAYER * DFF * DM * 2 <= WS_WGLU, "ws map 1");
static_assert(WS_X + (size_t)MP * DM * 4 <= WS_XB && WS_XB + (size_t)MP * DM * 2 <= WS_Q && WS_Q + (size_t)MP * 1024 * 2 <= WS_K && WS_K + (size_t)MP * 256 * 2 <= WS_VT && WS_VT + (size_t)4 * 128 * TPV * 2 <= WS_U, "ws map 2");
static_assert(WS_U + (size_t)MP * 512 * 4 <= WS_XP && WS_XP + (size_t)MP * 512 * 4 <= WS_MIX && WS_MIX + (size_t)MP * DM * 2 <= WS_H && WS_H + (size_t)MP * DFF * 2 <= WS_SSQ && WS_SSQ + (size_t)MP * 32 * 4 <= WS_SST, "ws map 3");
static_assert(WS_SST + (size_t)NLAYER * NCHUNK * 32 * 64 * 8 <= WS_KSN, "ws map 4");
constexpr size_t TB_ABR = 0, TB_ABI = 8192, TB_ALR = 16384, TB_ALI = 24576, TB_A16R = 32768, TB_A16I = 40960, TB_A32R = 49152, TB_A32I = 57344,
                 TB_BBR = 65536, TB_BBI = TB_BBR + 131072, TB_PM = TB_BBI + 131072, TB_CMT = TB_PM + 524288, TB_LAYER = 1 * MiB;
static_assert(TB_CMT + 131072 <= TB_LAYER, "table map");
constexpr size_t WS_ROPE = WS_TAB + 2 * MiB;
constexpr size_t ROPE_N = (size_t)(TT + 1) * 16;
constexpr int CW_TMO = 0, CW_CODE = 1, CW_BAR = 4096, CW_SSMF = 16384  ;
static_assert((CW_SSMF + NLAYER * NCHUNK * 8 * 16) * 4 <= (int)CTL_ZERO_BYTES, "ctl map");

constexpr int RING_BYTES = 131072, ESC_OFF = RING_BYTES  , LDSCTL_OFF = ESC_OFF + 12288, MISC_OFF = LDSCTL_OFF + 320, LDS_BYTES = 147456;
static_assert(MISC_OFF + 128 <= LDS_BYTES, "LDS map");

#define GAS __attribute__((address_space(1)))
#define LAS __attribute__((address_space(3)))
typedef unsigned short bf16;
typedef unsigned v4u __attribute__((ext_vector_type(4)));
typedef unsigned v2u __attribute__((ext_vector_type(2)));
typedef float f32x2 __attribute__((ext_vector_type(2)));
typedef float f32x16 __attribute__((ext_vector_type(16)));
typedef __bf16 bf16x2_t __attribute__((ext_vector_type(2)));
typedef GAS unsigned gu32;
typedef GAS unsigned long long gu64;
#define RLX_AGENT __ATOMIC_RELAXED, __HIP_MEMORY_SCOPE_AGENT
#define LDS_WAIT() asm volatile("s_waitcnt lgkmcnt(0)" ::: "memory")
#define VM_WAIT() asm volatile("s_waitcnt vmcnt(0)" ::: "memory")
#define WG_BAR() do { asm volatile("s_waitcnt lgkmcnt(0)" ::: "memory"); __builtin_amdgcn_s_barrier(); asm volatile("" ::: "memory"); } while (0)
__device__ __forceinline__ unsigned pk2(float lo, float hi) { f32x2 v = {lo, hi}; bf16x2_t b = __builtin_convertvector(v, bf16x2_t); return __builtin_bit_cast(unsigned, b); }
__device__ __forceinline__ float bf2f(unsigned short h) { return __builtin_bit_cast(float, (unsigned)h << 16); }
__device__ __forceinline__ float wave_sum(float v) {
#pragma unroll
    for (int o = 1; o < 64; o <<= 1) v += __shfl_xor(v, o);
    return v;
}
__device__ __forceinline__ float wave_max(float v) {
#pragma unroll
    for (int o = 1; o < 64; o <<= 1) v = fmaxf(v, __shfl_xor(v, o));
    return v;
}
__host__ __device__ __forceinline__ int perm16(int o) { return 8 * ((o >> 2) & 1) + 4 * (o >> 3) + (o & 3); }

namespace pg8 {
#define PG8_LAS __attribute__((address_space(3)))
typedef unsigned short bf16_t;
typedef short bf16x8 __attribute__((ext_vector_type(8)));
typedef float f32x4 __attribute__((ext_vector_type(4)));
typedef unsigned u32x4 __attribute__((ext_vector_type(4)));
constexpr int BM = 256, BK = 64, HALF = 128, HTB = HALF * BK * 2  , STAGE_BYTES = 8 * HTB, NXCD = 8, WGM = 8;

__host__ __device__ __forceinline__ int lds_byte(int r, int c) { const int st = (r >> 4) * 2 + (c >> 5), rr = r & 15, cc = c & 31, ob = rr * 64 + cc * 2; return st * 1024 + (ob ^ (((ob >> 9) & 1) << 5)); }
__host__ __device__ __forceinline__ void stage_rc(int b, int& R, int& C) { const int st = b / 1024, sb = b % 1024, swz = sb ^ (((sb >> 9) & 1) << 5); R = (st >> 1) * 16 + swz / 64; C = (st & 1) * 32 + (swz % 64) / 2; }
__host__ __device__ __forceinline__ int perm32(int rho) { const int n = rho >> 4, i = rho & 15; return 8 * (i >> 2) + 4 * n + (i & 3); }

struct Unit { int pm, pn; };
struct Gemm { const bf16_t* A; const bf16_t* Bt; int M, N, K; };

struct StaticOrder {
    int nM, nN, nwg, G, c;
    __host__ __device__ void init(int M, int N, int G_, int c_) { nM = M / BM; nN = N / BM; nwg = nM * nN; G = G_; c = c_; }
    __host__ __device__ bool next(int i, Unit& u) const {
        const long L = (long)i * G + c; if (L >= nwg) return false;
        int wgid = (int)L; { const int q = nwg / NXCD, r = nwg % NXCD, xcd = wgid % NXCD, off = wgid / NXCD; wgid = (xcd < r ? xcd * (q + 1) : r * (q + 1) + (xcd - r) * q) + off; }
        const int nig = WGM * nN, gid = wgid / nig, fm = gid * WGM, gsz = (nM - fm) < WGM ? (nM - fm) : WGM;
        u.pm = fm + ((wgid % nig) % gsz); u.pn = (wgid % nig) / gsz; return true;
    }
    __device__ __forceinline__ void a_ready(const Unit&) const {}
    __device__ __forceinline__ void done(const Unit&) const {}
};


template <class Epi, class Sched, bool ALIGN_EPI = false, bool SP2 = false>
__device__ __forceinline__ void gemm_phase(PG8_LAS unsigned char* lds, PG8_LAS unsigned char* esc, const Gemm g, const Sched& S, const Epi& E) {
    int tid_ = threadIdx.x; asm volatile("" : "+v"(tid_));
    const int tid = tid_, wid = __builtin_amdgcn_readfirstlane(tid >> 6), lane = tid & 63, wr = wid >> 2, wc = wid & 3, fr = lane & 15, fq = lane >> 4;
    const int K = g.K, nt = K / BK;
    unsigned voffA[2], voffB[2];
#pragma unroll
    for (int i = 0; i < 2; ++i) { int R, C; stage_rc(tid * 16 + i * 8192, R, C); const int Rb = Epi::PERM ? ((R & ~31) + perm32(R & 31)) : R;
        voffA[i] = (unsigned)(R * K + C) * 2u; voffB[i] = (unsigned)(Rb * K + C) * 2u; }
    const size_t kstep = (size_t)(BK * 2);
    const size_t hstep = (size_t)HALF * K * 2;
    const size_t tstep = 2 * hstep;
    const unsigned ldsw = (unsigned)wid * 1024u;
    const int aoff = lds_byte(wr * 64 + fr, fq * 8), boff = lds_byte(wc * 32 + fr, fq * 8);
#define PG8_SA(b, h) (((b) * 2 + (h)) * HTB)
#define PG8_SB(b, h) ((4 + (b) * 2 + (h)) * HTB)
#define PG8_STAGE(bufoff, gbase, voff) do { _Pragma("unroll") for (int _i = 0; _i < 2; ++_i) \
        __builtin_amdgcn_global_load_lds((const unsigned*)((const char*)(gbase) + (voff)[_i]), (PG8_LAS unsigned*)(lds + (bufoff) + ldsw + _i * 8192), 16, 0, 0); } while (0)
#define PG8_LDA(dst, b, h) do { _Pragma("unroll") for (int m = 0; m < 4; ++m) _Pragma("unroll") for (int k = 0; k < 2; ++k) dst[m][k] = *(const PG8_LAS bf16x8*)(lds + PG8_SA(b, h) + aoff + m * 2048 + k * 1024); } while (0)
#define PG8_LDB(dst, b, h) do { _Pragma("unroll") for (int n = 0; n < 2; ++n) _Pragma("unroll") for (int k = 0; k < 2; ++k) dst[n][k] = *(const PG8_LAS bf16x8*)(lds + PG8_SB(b, h) + boff + n * 2048 + k * 1024); } while (0)
#define PG8_MMA(ai, bj, At, Bt) do { __builtin_amdgcn_s_setprio(1); _Pragma("unroll") for (int m = 0; m < 4; ++m) _Pragma("unroll") for (int n = 0; n < 2; ++n) _Pragma("unroll") for (int k = 0; k < 2; ++k) \
        acc[ai][bj][m][n] = __builtin_amdgcn_mfma_f32_16x16x32_bf16(Bt[n][k], At[m][k], acc[ai][bj][m][n], 0, 0, 0); __builtin_amdgcn_s_setprio(0); } while (0)
#define PG8_WAIT_V(n) asm volatile("s_waitcnt vmcnt(" #n ")" ::: "memory")
#define PG8_WAIT_L(n) asm volatile("s_waitcnt lgkmcnt(" #n ")" ::: "memory")
#define PG8_BAR __builtin_amdgcn_s_barrier()
#define PG8_SCHED __builtin_amdgcn_sched_barrier(0)
    Unit cur, nxt; int ui = 0;
    if (!S.next(0, cur)) return;
    f32x4 acc[2][2][4][2];
#pragma unroll
    for (int a = 0; a < 2; ++a)
#pragma unroll
        for (int b = 0; b < 2; ++b)
#pragma unroll
            for (int m = 0; m < 4; ++m)
#pragma unroll
                for (int n = 0; n < 2; ++n) acc[a][b][m][n] = (f32x4){0.f, 0.f, 0.f, 0.f};
    bf16x8 At[4][2], B0[2][2], B1[2][2];
    const char* cA = (const char*)g.A + (size_t)cur.pm * tstep; const char* cB = (const char*)g.Bt + (size_t)cur.pn * tstep;
    S.a_ready(cur);
    if constexpr (SP2) {
        PG8_STAGE(PG8_SB(0, 0), cB, voffB); PG8_STAGE(PG8_SB(0, 1), cB + hstep, voffB); PG8_STAGE(PG8_SA(0, 0), cA, voffA); PG8_STAGE(PG8_SA(0, 1), cA + hstep, voffA);
        if (wr == 1) PG8_BAR;
        PG8_WAIT_V(2); PG8_BAR;
        PG8_STAGE(PG8_SB(1, 0), cB + kstep, voffB); PG8_STAGE(PG8_SA(1, 0), cA + kstep, voffA); PG8_STAGE(PG8_SB(1, 1), cB + hstep + kstep, voffB);
        PG8_WAIT_V(6); PG8_BAR;
    } else {
        PG8_STAGE(PG8_SB(0, 0), cB, voffB); PG8_STAGE(PG8_SA(0, 0), cA, voffA); PG8_STAGE(PG8_SB(0, 1), cB + hstep, voffB); PG8_STAGE(PG8_SA(0, 1), cA + hstep, voffA);
        if (wr == 1) PG8_BAR;
        PG8_WAIT_V(4); PG8_BAR;
        PG8_STAGE(PG8_SB(1, 0), cB + kstep, voffB); PG8_STAGE(PG8_SA(1, 0), cA + kstep, voffA); PG8_STAGE(PG8_SB(1, 1), cB + hstep + kstep, voffB);
        PG8_WAIT_V(6); PG8_BAR;
    }
    for (;;) {
        const bool has_next = S.next(ui + 1, nxt);
        const char* nA = has_next ? (const char*)g.A + (size_t)nxt.pm * tstep : cA; const char* nB = has_next ? (const char*)g.Bt + (size_t)nxt.pn * tstep : cB;
        for (int t = 0; t < nt; t += 2) {
            const bool last = (t == nt - 2);
            const char* a1 = cA + (size_t)(t + 1) * kstep;
            const char* a2 = last ? nA : cA + (size_t)(t + 2) * kstep; const char* b2 = last ? nB : cB + (size_t)(t + 2) * kstep;
            const char* a3 = a2 + kstep; const char* b3 = b2 + kstep;
            if (last && has_next) S.a_ready(nxt);
            if constexpr (SP2) {
            PG8_LDB(B0, 0, 0); PG8_LDB(B1, 0, 1); PG8_SCHED; PG8_LDA(At, 0, 0); PG8_STAGE(PG8_SA(1, 1), a1 + hstep, voffA);
            PG8_WAIT_V(8); PG8_WAIT_L(0); PG8_BAR; PG8_MMA(0, 0, At, B0); PG8_MMA(0, 1, At, B1); PG8_BAR; PG8_SCHED;
            PG8_LDA(At, 0, 1); PG8_STAGE(PG8_SB(0, 0), b2, voffB); PG8_STAGE(PG8_SB(0, 1), b2 + hstep, voffB); PG8_STAGE(PG8_SA(0, 0), a2, voffA);
            PG8_WAIT_V(8); PG8_WAIT_L(0); PG8_BAR; PG8_MMA(1, 0, At, B0); PG8_MMA(1, 1, At, B1); PG8_BAR; PG8_SCHED;
            PG8_LDB(B0, 1, 0); PG8_LDB(B1, 1, 1); PG8_SCHED; PG8_LDA(At, 1, 0); PG8_STAGE(PG8_SA(0, 1), a2 + hstep, voffA);
            PG8_WAIT_V(8); PG8_WAIT_L(0); PG8_BAR; PG8_MMA(0, 0, At, B0); PG8_MMA(0, 1, At, B1); PG8_BAR; PG8_SCHED;
            PG8_LDA(At, 1, 1); PG8_STAGE(PG8_SB(1, 0), b3, voffB); PG8_STAGE(PG8_SB(1, 1), b3 + hstep, voffB); PG8_STAGE(PG8_SA(1, 0), a3, voffA);
            PG8_WAIT_V(8); PG8_WAIT_L(0); PG8_BAR; PG8_MMA(1, 0, At, B0); PG8_MMA(1, 1, At, B1); PG8_BAR; PG8_SCHED;
            } else {
            PG8_LDB(B0, 0, 0); PG8_SCHED; PG8_LDA(At, 0, 0); PG8_STAGE(PG8_SA(1, 1), a1 + hstep, voffA);
            PG8_WAIT_L(8); PG8_BAR; PG8_WAIT_L(0); PG8_MMA(0, 0, At, B0); PG8_BAR; PG8_SCHED;
            PG8_LDB(B1, 0, 1); PG8_STAGE(PG8_SB(0, 0), b2, voffB);
            PG8_BAR; PG8_WAIT_L(0); PG8_MMA(0, 1, At, B1); PG8_BAR;
            PG8_LDA(At, 0, 1); PG8_STAGE(PG8_SA(0, 0), a2, voffA);
            PG8_BAR; PG8_WAIT_L(0); PG8_MMA(1, 0, At, B0); PG8_BAR; PG8_SCHED;
            PG8_STAGE(PG8_SB(0, 1), b2 + hstep, voffB);
            PG8_WAIT_V(6); PG8_BAR; PG8_MMA(1, 1, At, B1); PG8_BAR;
            PG8_LDB(B0, 1, 0); PG8_SCHED; PG8_LDA(At, 1, 0); PG8_STAGE(PG8_SA(0, 1), a2 + hstep, voffA);
            PG8_WAIT_L(8); PG8_BAR; PG8_WAIT_L(0); PG8_MMA(0, 0, At, B0); PG8_BAR; PG8_SCHED;
            PG8_LDB(B1, 1, 1); PG8_STAGE(PG8_SB(1, 0), b3, voffB);
            PG8_BAR; PG8_WAIT_L(0); PG8_MMA(0, 1, At, B1); PG8_BAR;
            PG8_LDA(At, 1, 1); PG8_STAGE(PG8_SA(1, 0), a3, voffA);
            PG8_BAR; PG8_WAIT_L(0); PG8_MMA(1, 0, At, B0); PG8_BAR; PG8_SCHED;
            PG8_STAGE(PG8_SB(1, 1), b3 + hstep, voffB);
            PG8_WAIT_V(6); PG8_BAR; PG8_MMA(1, 1, At, B1); PG8_BAR;
            }
        }
        if constexpr (ALIGN_EPI) { if (wr == 0) PG8_BAR; }
        { E(acc, cur, wr, wc, fr, fq, esc, tid); S.done(cur); }
        if (!has_next) break;
#pragma unroll
        for (int a = 0; a < 2; ++a)
#pragma unroll
            for (int b = 0; b < 2; ++b)
#pragma unroll
                for (int m = 0; m < 4; ++m)
#pragma unroll
                    for (int n = 0; n < 2; ++n) acc[a][b][m][n] = (f32x4){0.f, 0.f, 0.f, 0.f};
        cur = nxt; cA = nA; cB = nB; ++ui;
        if constexpr (ALIGN_EPI) { if (wr == 1) PG8_BAR; }
    }
    PG8_WAIT_V(0);
    if constexpr (!ALIGN_EPI) { if (wr == 0) PG8_BAR; }
    PG8_BAR;
#undef PG8_SA
#undef PG8_SB
#undef PG8_STAGE
#undef PG8_LDA
#undef PG8_LDB
#undef PG8_MMA
#undef PG8_WAIT_V
#undef PG8_WAIT_L
#undef PG8_BAR
#undef PG8_SCHED
}
}

typedef float f32x4 __attribute__((ext_vector_type(4)));
typedef short bf16x8 __attribute__((ext_vector_type(8)));


__device__ __forceinline__ void build_rs(const float* ssq, int pm, LAS unsigned char* esc, int tid) {
    LAS float* rsT = (LAS float*)esc;
    WG_BAR();
    if (tid < 256) {
        const f32x4* p = (const f32x4*)(ssq + (size_t)(pm * 256 + tid) * 32); float s = 0.f;
#pragma unroll
        for (int j = 0; j < 8; ++j) { const f32x4 v = p[j]; s += (v[0] + v[1]) + (v[2] + v[3]); }
        rsT[tid] = rsqrtf(s * (1.0f / DM) + EPS);
    }
    WG_BAR();
}

struct EpiProj {
    static constexpr bool PERM = false, AFTER_DRAIN = false;
    unsigned char* ws_; float* out_; const float* gq; const float* gk; int l;
    __device__ __forceinline__ void operator()(f32x4 (&acc)[2][2][4][2], const pg8::Unit& u, int wr, int wc, int fr, int fq, LAS unsigned char* esc, int tid) const {
        asm volatile("" : "+v"(fr), "+v"(fq), "+v"(tid));
        unsigned char* ws = ws_; asm volatile("" : "+s"(ws));
        const float* ssq = (const float*)(ws + WS_SSQ); const float* ropec = (const float*)(ws + WS_ROPE); const float* ropes = ropec + ROPE_N;
        bf16* Q = (bf16*)(ws + WS_Q); bf16* K = (bf16*)(ws + WS_K); bf16* VT = (bf16*)(ws + WS_VT); float* U = (float*)(ws + WS_U); float* XP = (float*)(ws + WS_XP);
        float* ksn = (float*)(ws + WS_KSN); float* vsn = ksn + NSAMP * 256;
        float* out_pk = out_ + O_PK + (size_t)l * NBATCH * 128 * 256; float* out_pv = out_ + O_PV + (size_t)l * NBATCH * 128 * 256;
        build_rs(ssq, u.pm, esc, tid);
        const LAS float* rsT = (const LAS float*)esc;
        LAS float* hss = (LAS float*)(esc + 1024);
        const int pn = u.pn;
#pragma unroll
        for (int ai = 0; ai < 2; ++ai)
#pragma unroll
            for (int m = 0; m < 4; ++m) { const float rsv = rsT[ai * 128 + wr * 64 + m * 16 + fr];
#pragma unroll
                for (int bj = 0; bj < 2; ++bj)
#pragma unroll
                    for (int n = 0; n < 2; ++n) acc[ai][bj][m][n] *= rsv; }
        if (pn <= 4) {
#pragma unroll
            for (int ai = 0; ai < 2; ++ai)
#pragma unroll
                for (int m = 0; m < 4; ++m)
#pragma unroll
                    for (int bj = 0; bj < 2; ++bj) { const f32x4 a = acc[ai][bj][m][0], b = acc[ai][bj][m][1];
                        float s = (a[0] * a[0] + a[1] * a[1]) + (a[2] * a[2] + a[3] * a[3]) + (b[0] * b[0] + b[1] * b[1]) + (b[2] * b[2] + b[3] * b[3]);
                        s += __shfl_xor(s, 16); s += __shfl_xor(s, 32);
                        if (fq == 0) hss[(bj * 256 + ai * 128 + wr * 64 + m * 16 + fr) * 4 + wc] = s; }
            WG_BAR();
            const float* g = (pn < 4) ? gq : gk; const float osc = (pn < 4) ? QSCALE : 1.0f;
            f32x4 gv[2];
#pragma unroll
            for (int n = 0; n < 2; ++n) gv[n] = *(const f32x4*)(g + wc * 32 + n * 16 + 4 * fq);
#pragma unroll
            for (int ai = 0; ai < 2; ++ai)
#pragma unroll
                for (int m = 0; m < 4; ++m) {
                    const int rl = ai * 128 + wr * 64 + m * 16 + fr, r = u.pm * 256 + rl;
                    const bool samp = r >= SROW0, pad = r >= MR;
                    const int b = (r >= TT && !samp) ? 1 : 0, t = r - b * TT;
                    const int pidx = samp ? ROPE_SAMPLE_IDX : t;
                    f32x4 cs = {1.f, 1.f, 1.f, 1.f}, sn = {0.f, 0.f, 0.f, 0.f};
                    if (wc == 0 && !pad) { cs = *(const f32x4*)(ropec + (size_t)pidx * 16 + 4 * fq); sn = *(const f32x4*)(ropes + (size_t)pidx * 16 + 4 * fq); }
#pragma unroll
                    for (int bj = 0; bj < 2; ++bj) {
                        const f32x4 hv = *(const LAS f32x4*)(hss + (bj * 256 + rl) * 4);
                        const float hn = rsqrtf(((hv[0] + hv[1]) + (hv[2] + hv[3])) * (1.0f / 128.0f) + EPS);
                        f32x4 x1 = acc[ai][bj][m][0] * hn * gv[0], x2 = acc[ai][bj][m][1] * hn * gv[1];
                        if (wc == 0) { const f32x4 o1 = x1 * cs - x2 * sn, o2 = x2 * cs + x1 * sn; x1 = o1; x2 = o2; }
                        x1 = x1 * osc; x2 = x2 * osc;
                        const int cl = bj * 128 + wc * 32 + 4 * fq;
                        if (pn < 4) { bf16* qp = Q + (size_t)r * 1024 + pn * 256 + cl;
                            *(v2u*)qp = (v2u){pk2(x1[0], x1[1]), pk2(x1[2], x1[3])}; *(v2u*)(qp + 16) = (v2u){pk2(x2[0], x2[1]), pk2(x2[2], x2[3])}; }
                        else { bf16* kp = K + (size_t)r * 256 + cl;
                            *(v2u*)kp = (v2u){pk2(x1[0], x1[1]), pk2(x1[2], x1[3])}; *(v2u*)(kp + 16) = (v2u){pk2(x2[0], x2[1]), pk2(x2[2], x2[3])};
                            if (samp && !pad) { float* o = ksn + (size_t)(r - SROW0) * 256 + cl; *(f32x4*)o = x1; *(f32x4*)(o + 16) = x2; }
                            else if (!samp && t >= TT - 128) { float* o = out_pk + ((size_t)(b * 128 + (t - (TT - 128))) * 256) + cl; *(f32x4*)o = x1; *(f32x4*)(o + 16) = x2; } }
                    }
                }
        } else if (pn == 5) {
#pragma unroll
            for (int ai = 0; ai < 2; ++ai)
#pragma unroll
                for (int m = 0; m < 4; ++m) {
                    const int rl = ai * 128 + wr * 64 + m * 16 + fr, r = u.pm * 256 + rl;
                    const bool samp = r >= SROW0, pad = r >= MR;
                    const int b = (r >= TT && !samp) ? 1 : 0, t = r - b * TT;
                    const int tpos = (t & ~15) + perm16(t & 15);
#pragma unroll
                    for (int bj = 0; bj < 2; ++bj)
#pragma unroll
                        for (int n = 0; n < 2; ++n) { const f32x4 x = acc[ai][bj][m][n]; const int d = wc * 32 + n * 16 + 4 * fq;
                            if (!samp) { bf16* vp = VT + ((size_t)((b * 2 + bj) * 128 + d)) * TPV + tpos;
#pragma unroll
                                for (int j = 0; j < 4; ++j) vp[(size_t)j * TPV] = (bf16)(pk2(x[j], 0.f) & 0xffffu);
                                if (t >= TT - 128) *(f32x4*)(out_pv + ((size_t)(b * 128 + (t - (TT - 128))) * 256) + bj * 128 + d) = x; }
                            else if (!pad) *(f32x4*)(vsn + (size_t)(r - SROW0) * 256 + bj * 128 + d) = x; }
                }
        } else {
            float* dst = (pn < 8) ? U + (pn - 6) * 256 : XP + (pn - 8) * 256;
#pragma unroll
            for (int ai = 0; ai < 2; ++ai)
#pragma unroll
                for (int m = 0; m < 4; ++m) { float* rp = dst + (size_t)(u.pm * 256 + ai * 128 + wr * 64 + m * 16 + fr) * 512 + wc * 32 + 4 * fq;
#pragma unroll
                    for (int bj = 0; bj < 2; ++bj)
#pragma unroll
                        for (int n = 0; n < 2; ++n) *(f32x4*)(rp + bj * 128 + n * 16) = acc[ai][bj][m][n]; }
        }
    }
};

struct EpiRes {
    static constexpr bool PERM = false, AFTER_DRAIN = false;
    float* X; bf16* XB; float* ssq; float* out; int last;
    __device__ __forceinline__ void operator()(f32x4 (&acc)[2][2][4][2], const pg8::Unit& u, int wr, int wc, int fr, int fq, LAS unsigned char* esc, int tid) const {
        asm volatile("" : "+v"(fr), "+v"(fq), "+v"(tid));
#pragma unroll
        for (int ai = 0; ai < 2; ++ai)
#pragma unroll
            for (int m = 0; m < 4; ++m) {
                const int r = u.pm * 256 + ai * 128 + wr * 64 + m * 16 + fr; const int c0 = u.pn * 256 + wc * 32 + 4 * fq;
                float* xp = X + (size_t)r * DM + c0; float s = 0.f;
                f32x4 v[2][2];
#pragma unroll
                for (int bj = 0; bj < 2; ++bj)
#pragma unroll
                    for (int n = 0; n < 2; ++n) { v[bj][n] = *(const f32x4*)(xp + bj * 128 + n * 16) + acc[ai][bj][m][n]; const f32x4 q = v[bj][n] * v[bj][n]; s += (q[0] + q[1]) + (q[2] + q[3]); }
                if (!last) {
                    bf16* bp = XB + (size_t)r * DM + c0;
#pragma unroll
                    for (int bj = 0; bj < 2; ++bj)
#pragma unroll
                        for (int n = 0; n < 2; ++n) { *(f32x4*)(xp + bj * 128 + n * 16) = v[bj][n]; *(v2u*)(bp + bj * 128 + n * 16) = (v2u){pk2(v[bj][n][0], v[bj][n][1]), pk2(v[bj][n][2], v[bj][n][3])}; }
                    s += __shfl_xor(s, 16); s += __shfl_xor(s, 32);
                    if (fq == 0) ssq[(size_t)r * 32 + u.pn * 4 + wc] = s;
                } else {
                    const bool samp = r >= SROW0, pad = r >= MR; const int b = (r >= TT && !samp) ? 1 : 0, t = r - b * TT;
                    float* op = nullptr;
                    if (samp) { if (!pad) op = out + O_YS + (size_t)(r - SROW0) * DM + c0; } else if (t >= NMETA) op = out + O_YP + ((size_t)b * NSEQ + (t - NMETA)) * DM + c0;
                    if (op) {
#pragma unroll
                        for (int bj = 0; bj < 2; ++bj)
#pragma unroll
                            for (int n = 0; n < 2; ++n) *(f32x4*)(op + bj * 128 + n * 16) = v[bj][n]; }
                }
                if (m & 1) asm volatile("" ::: "memory");
            }
    }
};

struct EpiFfn1 {
    static constexpr bool PERM = true, AFTER_DRAIN = false;
    const float* ssq; bf16* H;
    __device__ __forceinline__ void operator()(f32x4 (&acc)[2][2][4][2], const pg8::Unit& u, int wr, int wc, int fr, int fq, LAS unsigned char* esc, int tid) const {
        asm volatile("" : "+v"(fr), "+v"(fq), "+v"(tid));
        build_rs(ssq, u.pm, esc, tid);
        const LAS float* rsT = (const LAS float*)esc;
#pragma unroll
        for (int ai = 0; ai < 2; ++ai)
#pragma unroll
            for (int m = 0; m < 4; ++m) { const int rl = ai * 128 + wr * 64 + m * 16 + fr; const float rsv = rsT[rl];
                bf16* rowp = H + (size_t)(u.pm * 256 + rl) * DFF + u.pn * 256 + wc * 32 + 8 * fq;
#pragma unroll
                for (int bj = 0; bj < 2; ++bj) { f32x4 v0 = acc[ai][bj][m][0] * rsv, v1 = acc[ai][bj][m][1] * rsv;
#pragma unroll
                    for (int j = 0; j < 4; ++j) { const float a = fmaxf(v0[j], 0.f), b = fmaxf(v1[j], 0.f); v0[j] = a * a; v1[j] = b * b; }
                    *(v4u*)(rowp + bj * 128) = (v4u){pk2(v0[0], v0[1]), pk2(v0[2], v0[3]), pk2(v1[0], v1[1]), pk2(v1[2], v1[3])}; } }
    }
};

#define XB_TMO      128
#define XB_XCNT(j)  (256  + 64 * (j))
#define XB_XSUB(j)  (1280 + 64 * (j))
#define XB_XGEN(j)  (2304 + 64 * (j))
#define XB_TOP      3328
#define XB_TOPGEN   3392
#define XCD_BAR_WORDS 3456
#define XB_SPIN_CAP (1u << 18)
__device__ __forceinline__ unsigned xb_ld(unsigned* p)              { return __hip_atomic_load(p, __ATOMIC_RELAXED, __HIP_MEMORY_SCOPE_AGENT); }
__device__ __forceinline__ unsigned xb_add(unsigned* p, unsigned v) { return __hip_atomic_fetch_add(p, v, __ATOMIC_RELAXED, __HIP_MEMORY_SCOPE_AGENT); }
__device__ __forceinline__ unsigned xb_xcc_id() { return (unsigned)__builtin_amdgcn_s_getreg((3 << 11) | 20) & 0xFu; }
#define XB_SPIN(cond, bar) do { unsigned _sp = 0; while (cond) { __builtin_amdgcn_s_sleep(1); \
    if ((++_sp & 255u) == 0u) { if (xb_ld(&(bar)[XB_TMO])) break; if (_sp > XB_SPIN_CAP) { atomicAdd(&(bar)[XB_TMO], 1u); break; } } } } while (0)

struct XcdBarrier {
    unsigned* bar; unsigned x;
    volatile LAS unsigned* st;
};

__device__ __forceinline__ XcdBarrier xcd_barrier_post(unsigned* bar, volatile LAS unsigned* st) {
    XcdBarrier b; b.bar = bar; b.x = xb_xcc_id(); b.st = st;
    if (threadIdx.x == 0) (void)xb_add(&bar[XB_XCNT(b.x)], 1u);
    return b;
}
__device__ __forceinline__ void xcd_barrier_complete(unsigned* bar, unsigned x, unsigned& nloc, unsigned& nx) {
    const unsigned G = gridDim.x * gridDim.y * gridDim.z;
    unsigned sum, cnt, mine, sp = 0u;
    for (;;) {
        sum = 0u; cnt = 0u; mine = 0u;
#pragma unroll
        for (unsigned j = 0; j < 16; ++j) { const unsigned c = xb_ld(&bar[XB_XCNT(j)]); sum += c; cnt += (c > 0u) ? 1u : 0u; mine = (j == x) ? c : mine; }
        if (sum == G) break;
        __builtin_amdgcn_s_sleep(1);
        if ((++sp & 255u) == 0u) { if (xb_ld(&bar[XB_TMO])) break; if (sp > XB_SPIN_CAP) { atomicAdd(&bar[XB_TMO], 1u); break; } }
    }
    nloc = mine > 0u ? mine : 1u; nx = cnt > 0u ? cnt : 1u;
}

__device__ __forceinline__ void xcd_barrier(const XcdBarrier& b) {
    asm volatile("s_waitcnt vmcnt(0)" ::: "memory");
    __syncthreads();
    if (threadIdx.x == 0) {
        unsigned* bar = b.bar;
        __builtin_amdgcn_s_waitcnt(0);
        unsigned nloc = b.st[0], nx = b.st[1];
        if (nloc == 0u) { xcd_barrier_complete(bar, b.x, nloc, nx); b.st[0] = nloc; b.st[1] = nx; }
        const unsigned old = xb_add(&bar[XB_XSUB(b.x)], 1u);
        const unsigned gen = old / nloc;
        if (old + 1u == (gen + 1u) * nloc) {
            __builtin_amdgcn_fence(__ATOMIC_RELEASE, "agent");
            asm volatile("s_waitcnt vmcnt(0)" ::: "memory");
            const unsigned og = xb_add(&bar[XB_TOP], 1u);
            const unsigned tg = og / nx;
            if (og + 1u == (tg + 1u) * nx) xb_add(&bar[XB_TOPGEN], 1u);
            else XB_SPIN(xb_ld(&bar[XB_TOPGEN]) == tg, bar);
            __builtin_amdgcn_fence(__ATOMIC_ACQUIRE, "agent");
            xb_add(&bar[XB_XGEN(b.x)], 1u);
            asm volatile("s_waitcnt vmcnt(0)" ::: "memory");
        } else {
            XB_SPIN(xb_ld(&bar[XB_XGEN(b.x)]) == gen, bar);
            __builtin_amdgcn_fence(__ATOMIC_ACQUIRE, "agent");
            asm volatile("s_waitcnt vmcnt(0)" ::: "memory");
        }
    }
    __syncthreads();
}

struct Frame {
    LAS unsigned char* lds;
    volatile LAS unsigned* MISC;
    gu32* ctl;
    int tid, lane, wave, vcu, G;
    float* out; unsigned char* ws;
};
#define IN_XPROMPT 0
#define IN_XSAMPLE 1
#define IN_CACHEK 2
#define IN_CACHEV 3
#define IN_SSMRE 4
#define IN_SSMIM 5
#define IN_SPOOL 6
#define IN_META 7
#define IN_GMIX 8
#define IN_WIN 9
#define IN_GQ 10
#define IN_GK 11
#define IN_SINKS 12
#define IN_ARE 13
#define IN_AIM 14
#define IN_LOGDT 15
#define IN_BRE 16
#define IN_BIM 17
#define IN_CRE 18
#define IN_CIM 19
#define IN_DSKIP 20
#define IN_WGLU 21
#define IN_BGLU 22
#define IN_WPOOL 23
#define IN_PSCALE 24
#define IN_GOA 25
#define IN_GOS 26
#define IN_GOP 27
#define IN_WOUT 28
#define IN_GFFN 29
#define IN_WFF1 30
#define IN_WFF2 31
struct Args { const float* in[32]; float* out; unsigned char* ws; int ph_lo, ph_hi; };
static_assert(sizeof(Args) == 32 * 8 + 8 + 8 + 8, "Args has no padding");

__device__ __forceinline__ void p0_transpose_item(const float* W, int K, int N, bf16* WT, const float* gain, LAS float* scr, int item, int lane) {
    const int nblk = N / 32, kb = item / nblk, nb = item % nblk, k0 = 64 * kb, n0 = 32 * nb;
#pragma unroll 8
    for (int i = 0; i < 32; ++i) { const int kk = 2 * i + (lane >> 5); float v = W[(size_t)(k0 + kk) * N + n0 + (lane & 31)]; if (gain) v *= gain[k0 + kk]; scr[kk * 33 + (lane & 31)] = v; }
    LDS_WAIT(); asm volatile("" ::: "memory");
    const int c = lane & 7;
#pragma unroll
    for (int j = 0; j < 4; ++j) { const int n = (lane >> 3) + 8 * j; const LAS float* s = scr + (8 * c) * 33 + n;
        v4u o; o.x = pk2(s[0 * 33], s[1 * 33]); o.y = pk2(s[2 * 33], s[3 * 33]); o.z = pk2(s[4 * 33], s[5 * 33]); o.w = pk2(s[6 * 33], s[7 * 33]);
        *(GAS v4u*)(WT + (size_t)(n0 + n) * K + k0 + 8 * c) = o; }
    LDS_WAIT(); asm volatile("" ::: "memory");
}
__device__ __forceinline__ void sincos_d(double x, double& s, double& c) {
    const double TWO_PI = 6.283185307179586476925286766559;
    const double k = rint(x * (1.0 / TWO_PI)); const double r = fma(-k, TWO_PI, x), r2 = r * r;
    const double fs[14] = {0.16666666666666666, 0.05, 0.023809523809523808, 0.013888888888888888, 0.00909090909090909, 0.00641025641025641, 0.004761904761904762, 0.003676470588235294,
                           0.0029239766081871343, 0.002380952380952381, 0.001976284584980237, 0.0016666666666666668, 0.0014245014245014246, 0.0012315270935960591};
    const double fc[14] = {0.5, 0.08333333333333333, 0.03333333333333333, 0.017857142857142856, 0.011111111111111112, 0.007575757575757576, 0.005494505494505495, 0.004166666666666667,
                           0.0032679738562091504, 0.002631578947368421, 0.0021645021645021645, 0.0018115942028985507, 0.0015384615384615385, 0.0013227513227513227};
    double ts = r, tc = 1.0; s = r; c = 1.0;
#pragma unroll
    for (int i = 0; i < 14; ++i) { ts *= -r2 * fs[i]; s += ts; tc *= -r2 * fc[i]; c += tc; }
}
__device__ __forceinline__ double exp_small(double x) {
    double t = 1.0, e = 1.0;
#pragma unroll
    for (int i = 1; i <= 14; ++i) { t *= x * (1.0 / i); e += t; }
    return e;
}
__device__ __forceinline__ void p0_prologue(const Args& AR, Frame& F) {
    LAS float* scr = (LAS float*)(F.lds + F.wave * 16384);
    const int gw = F.vcu * 8 + F.wave, NGW = F.G * 8, lane = F.lane;
    unsigned char* ws = F.ws;
    constexpr int I_IN = (DM / 64) * (INW / 32), I_OUT = (DM / 64) * (DM / 32), I_1 = (DM / 64) * (DFF / 32), I_2 = (DFF / 64) * (DM / 32), I_GLU = (512 / 64) * (512 / 32), I_POOL = 4 * 2 * 4;
    constexpr int I_LAYER = I_IN + I_OUT + I_1 + I_2 + I_GLU + I_POOL;
    for (int it = gw; it < NLAYER * I_LAYER; it += NGW) {
        const int l = it / I_LAYER; int r = it % I_LAYER;
        if (r < I_IN) { p0_transpose_item(AR.in[IN_WIN] + (size_t)l * DM * INW, DM, INW, (bf16*)(ws + WS_WIN) + (size_t)l * INW * DM, AR.in[IN_GMIX] + l * DM, scr, r, lane); continue; } r -= I_IN;
        if (r < I_OUT) { const int k0 = 64 * (r / (DM / 32));
            const float* g = (k0 < 1024) ? AR.in[IN_GOA] + l * 1024 : (k0 < 1536) ? AR.in[IN_GOS] + l * 512 - 1024 : AR.in[IN_GOP] + l * 512 - 1536;
            p0_transpose_item(AR.in[IN_WOUT] + (size_t)l * DM * DM, DM, DM, (bf16*)(ws + WS_WOUT) + (size_t)l * DM * DM, g, scr, r, lane); continue; } r -= I_OUT;
        if (r < I_1) { p0_transpose_item(AR.in[IN_WFF1] + (size_t)l * DM * DFF, DM, DFF, (bf16*)(ws + WS_W1) + (size_t)l * DFF * DM, AR.in[IN_GFFN] + l * DM, scr, r, lane); continue; } r -= I_1;
        if (r < I_2) { p0_transpose_item(AR.in[IN_WFF2] + (size_t)l * DFF * DM, DFF, DM, (bf16*)(ws + WS_W2) + (size_t)l * DM * DFF, nullptr, scr, r, lane); continue; } r -= I_2;
        if (r < I_GLU) { p0_transpose_item(AR.in[IN_WGLU] + (size_t)l * 512 * 512, 512, 512, (bf16*)(ws + WS_WGLU) + (size_t)l * 512 * 512, nullptr, scr, r, lane); continue; } r -= I_GLU;
        { const int g = r / 8; p0_transpose_item(AR.in[IN_WPOOL] + ((size_t)l * 4 + g) * 128 * 128, 128, 128, (bf16*)(ws + WS_WPOOL) + ((size_t)l * 4 + g) * 128 * 128, nullptr, scr, r % 8, lane); }
    }
    float* X = (float*)(ws + WS_X); bf16* XB = (bf16*)(ws + WS_XB); float* SSQ = (float*)(ws + WS_SSQ);
    for (int m = gw; m < MP; m += NGW) {
        const float* src = nullptr;
        if (m < SROW0) { const int b = m >= TT ? 1 : 0, t = m - b * TT; src = (t < NMETA) ? AR.in[IN_META] + (size_t)t * DM : AR.in[IN_XPROMPT] + ((size_t)b * NSEQ + (t - NMETA)) * DM; }
        else if (m < MR) src = AR.in[IN_XSAMPLE] + (size_t)(m - SROW0) * DM;
        float s = 0.f;
#pragma unroll
        for (int j = 0; j < 8; ++j) { f32x4 v = {0.f, 0.f, 0.f, 0.f}; if (src) v = *(const f32x4*)(src + j * 256 + lane * 4);
            s += (v[0] * v[0] + v[1] * v[1]) + (v[2] * v[2] + v[3] * v[3]);
            *(f32x4*)(X + (size_t)m * DM + j * 256 + lane * 4) = v; *(v2u*)(XB + (size_t)m * DM + j * 256 + lane * 4) = (v2u){pk2(v[0], v[1]), pk2(v[2], v[3])}; }
        s = wave_sum(s);
        if (lane < 32) SSQ[(size_t)m * 32 + lane] = (lane == 0) ? s : 0.f;
    }
    const int gt = gw * 64 + lane, NGT = NGW * 64;
    for (int id = gt; id < NLAYER * 32 * 64; id += NGT) {
        const int l = id >> 11, g = (id >> 6) & 31, n = id & 63;
        unsigned char* tb = ws + WS_TAB + (size_t)l * TB_LAYER;
        const double dt = (double)expf(AR.in[IN_LOGDT][l * 32 + g]);
        const double ar = (double)AR.in[IN_ARE][id], ai = (double)AR.in[IN_AIM][id];
        const double mag = exp_small(dt * ar); double sn, cs; sincos_d(dt * ai, sn, cs);
        const double abr = mag * cs, abi = mag * sn, den = ar * ar + ai * ai;
        const double fr = ((abr - 1.0) * ar + abi * ai) / den, fi = (abi * ar - (abr - 1.0) * ai) / den;
        ((float*)(tb + TB_ABR))[g * 64 + n] = (float)abr; ((float*)(tb + TB_ABI))[g * 64 + n] = (float)abi;
        const float* Br = AR.in[IN_BRE] + (size_t)id * 16; const float* Bi = AR.in[IN_BIM] + (size_t)id * 16;
        float* bbr = (float*)(tb + TB_BBR) + (size_t)(g * 64 + n) * 16; float* bbi = (float*)(tb + TB_BBI) + (size_t)(g * 64 + n) * 16;
#pragma unroll
        for (int c = 0; c < 16; ++c) { const double br = Br[c], bi = Bi[c]; bbr[c] = (float)(fr * br - fi * bi); bbi[c] = (float)(fr * bi + fi * br); }
        bf16* Pm = (bf16*)(tb + TB_PM) + (size_t)g * 64 * 128;
        double pr = abr, pi = abi;
        for (int t = 0; t < 64; ++t) {
            Pm[t * 128 + n] = (bf16)(pk2((float)pr, 0.f) & 0xffffu); Pm[t * 128 + 64 + n] = (bf16)(pk2((float)pi, 0.f) & 0xffffu);
            if (t == 15) { ((float*)(tb + TB_A16R))[g * 64 + n] = (float)pr; ((float*)(tb + TB_A16I))[g * 64 + n] = (float)pi; }
            if (t == 31) { ((float*)(tb + TB_A32R))[g * 64 + n] = (float)pr; ((float*)(tb + TB_A32I))[g * 64 + n] = (float)pi; }
            if (t == 63) { ((float*)(tb + TB_ALR))[g * 64 + n] = (float)pr; ((float*)(tb + TB_ALI))[g * 64 + n] = (float)pi; }
            const double nr = pr * abr - pi * abi, ni = pr * abi + pi * abr; pr = nr; pi = ni;
        }
        bf16* CmT = (bf16*)(tb + TB_CMT) + (size_t)g * 16 * 128;
        const float* Cr = AR.in[IN_CRE] + ((size_t)(l * 32 + g) * 16) * 64 + n; const float* Ci = AR.in[IN_CIM] + ((size_t)(l * 32 + g) * 16) * 64 + n;
#pragma unroll
        for (int c = 0; c < 16; ++c) { CmT[c * 128 + n] = (bf16)(pk2(Cr[c * 64], 0.f) & 0xffffu); CmT[c * 128 + 64 + n] = (bf16)(pk2(-Ci[c * 64], 0.f) & 0xffffu); }
    }
    float* rc = (float*)(ws + WS_ROPE); float* rs_ = rc + ROPE_N;
    for (int id = gt; id < (int)ROPE_N; id += NGT) {
        const int p = id >> 4, i = id & 15; const double pos = (p == ROPE_SAMPLE_IDX) ? 16384.0 : (double)p;
        double inv = 1.0;
        for (int k = 0; k < i; ++k) inv *= 0.44036660267178046;
        double sn, cs; sincos_d(pos * inv, sn, cs);
        rc[id] = (float)cs; rs_[id] = (float)sn;
    }
}

__device__ __forceinline__ void attn_unit(const Args& AR, Frame& F, int l, int b, int i) {
    int lane_ = F.lane; asm volatile("" : "+v"(lane_));
    unsigned char* ws = F.ws; asm volatile("" : "+s"(ws));
    const int lane = lane_, h = F.wave, c = lane & 31, hh = lane >> 5, kvh = h >> 2;
    const int t0 = 32 * i; const size_t rb = (size_t)b * TT;
    const bf16* Q = (const bf16*)(ws + WS_Q); const bf16* K = (const bf16*)(ws + WS_K); const bf16* VT = (const bf16*)(ws + WS_VT);
    bf16* MIX = (bf16*)(ws + WS_MIX);
    LAS float* ex = (LAS float*)(F.lds + ESC_OFF);
    bf16x8 qf[8];
    { const bf16* qp = Q + (rb + t0 + c) * 1024 + 128 * h + 8 * hh;
#pragma unroll
      for (int ks = 0; ks < 8; ++ks) qf[ks] = *(const bf16x8*)(qp + 16 * ks); }
    const int kt0 = (t0 >= 128) ? 0 : (4 - i);
    f32x16 S[5];
#pragma unroll
    for (int kt = 0; kt < 5; ++kt) {
#pragma unroll
        for (int r = 0; r < 16; ++r) S[kt][r] = -INFINITY;
        if (kt >= kt0) {
            const int tk0 = t0 - 128 + 32 * kt;
            const bf16* kp = K + (rb + tk0 + c) * 256 + 128 * kvh + 8 * hh;
            bf16x8 kf[8];
#pragma unroll
            for (int ks = 0; ks < 8; ++ks) kf[ks] = *(const bf16x8*)(kp + 16 * ks);
            f32x16 a = {0.f, 0.f, 0.f, 0.f, 0.f, 0.f, 0.f, 0.f, 0.f, 0.f, 0.f, 0.f, 0.f, 0.f, 0.f, 0.f};
#pragma unroll
            for (int ks = 0; ks < 8; ++ks) a = __builtin_amdgcn_mfma_f32_32x32x16_bf16(kf[ks], qf[ks], a, 0, 0, 0);
#pragma unroll
            for (int r = 0; r < 16; ++r) { const int kr = (r & 3) + 8 * (r >> 2) + 4 * hh; bool ok = true;
                if (kt == 0) ok = kr >= c;
                if (kt == 4) ok = kr <= c;
                S[kt][r] = ok ? a[r] : -INFINITY; }
        }
    }
    const float sink2 = AR.in[IN_SINKS][l * 8 + h] * LOG2E;
    float mx = sink2;
#pragma unroll
    for (int kt = 0; kt < 5; ++kt)
#pragma unroll
        for (int r = 0; r < 16; ++r) mx = fmaxf(mx, S[kt][r]);
    mx = fmaxf(mx, __shfl_xor(mx, 32));
    float sum = 0.f;
#pragma unroll
    for (int kt = 0; kt < 5; ++kt)
#pragma unroll
        for (int r = 0; r < 16; ++r) { const float p = __builtin_amdgcn_exp2f(S[kt][r] - mx); S[kt][r] = p; sum += p; }
    sum += __shfl_xor(sum, 32);
    const float inv = 1.0f / (sum + __builtin_amdgcn_exp2f(sink2 - mx));
    f32x16 O[4];
#pragma unroll
    for (int db = 0; db < 4; ++db)
#pragma unroll
        for (int r = 0; r < 16; ++r) O[db][r] = 0.f;
#pragma unroll
    for (int kt = 0; kt < 5; ++kt) {
        if (kt >= kt0) {
            const int tk0 = t0 - 128 + 32 * kt;
#pragma unroll
            for (int s = 0; s < 2; ++s) {
                v4u pw; pw.x = pk2(S[kt][8 * s + 0], S[kt][8 * s + 1]); pw.y = pk2(S[kt][8 * s + 2], S[kt][8 * s + 3]); pw.z = pk2(S[kt][8 * s + 4], S[kt][8 * s + 5]); pw.w = pk2(S[kt][8 * s + 6], S[kt][8 * s + 7]);
                const bf16x8 pf = __builtin_bit_cast(bf16x8, pw);
#pragma unroll
                for (int db = 0; db < 4; ++db) {
                    const bf16x8 vf = *(const bf16x8*)(VT + ((size_t)((b * 2 + kvh) * 128 + 32 * db + c)) * TPV + tk0 + 16 * s + 8 * hh);
                    O[db] = __builtin_amdgcn_mfma_f32_32x32x16_bf16(vf, pf, O[db], 0, 0, 0);
                }
            }
        }
    }
    float ss = 0.f;
#pragma unroll
    for (int db = 0; db < 4; ++db)
#pragma unroll
        for (int r = 0; r < 16; ++r) { O[db][r] *= inv; ss += O[db][r] * O[db][r]; }
    ss += __shfl_xor(ss, 32);
    if (hh == 0) ex[h * 32 + c] = ss;
    WG_BAR();
    float tot = 0.f;
#pragma unroll
    for (int j = 0; j < 8; ++j) tot += ex[j * 32 + c];
    const float rsa = rsqrtf(tot * (1.0f / 1024.0f) + EPS);
    if (t0 + c < TT) {
        bf16* mp = MIX + (rb + t0 + c) * DM + 128 * h + 4 * hh;
#pragma unroll
        for (int db = 0; db < 4; ++db)
#pragma unroll
            for (int g4 = 0; g4 < 4; ++g4)
                *(v2u*)(mp + 32 * db + 8 * g4) = (v2u){pk2(O[db][4 * g4 + 0] * rsa, O[db][4 * g4 + 1] * rsa), pk2(O[db][4 * g4 + 2] * rsa, O[db][4 * g4 + 3] * rsa)};
    }
    WG_BAR();
}

__device__ __forceinline__ void sattn_unit(const Args& AR, Frame& F, int l, int s) {
    int tid_ = F.tid; asm volatile("" : "+v"(tid_));
    const int tid = tid_, lane = tid & 63, wave = F.wave;
    LAS float* qs = (LAS float*)F.lds;
    LAS float* sc = qs + 1024;
    LAS float* part = sc + 8 * 132;
    LAS float* red = part + 4096;
    const size_t row = SROW0 + s;
    const bf16* Q = (const bf16*)(F.ws + WS_Q) + row * 1024;
    const float* ksn = (const float*)(F.ws + WS_KSN) + (size_t)s * 256; const float* vsn = ksn + NSAMP * 256;
    const float* ck = AR.in[IN_CACHEK] + ((size_t)(l * NSAMP + s)) * 128 * 256; const float* cv = AR.in[IN_CACHEV] + ((size_t)(l * NSAMP + s)) * 128 * 256;
    for (int j = tid; j < 1024; j += 512) qs[j] = bf2f(Q[j]);
    WG_BAR();
    { const int key = tid >> 2, pt = tid & 3;
#pragma unroll
      for (int kvh = 0; kvh < 2; ++kvh) {
          const float* kp = ck + (size_t)key * 256 + kvh * 128 + 32 * pt; float d[4] = {0.f, 0.f, 0.f, 0.f};
#pragma unroll
          for (int j = 0; j < 8; ++j) { const f32x4 kv = *(const f32x4*)(kp + 4 * j);
#pragma unroll
              for (int g = 0; g < 4; ++g) { const f32x4 qv = *(const LAS f32x4*)(qs + (4 * kvh + g) * 128 + 32 * pt + 4 * j); d[g] += (kv[0] * qv[0] + kv[1] * qv[1]) + (kv[2] * qv[2] + kv[3] * qv[3]); } }
#pragma unroll
          for (int g = 0; g < 4; ++g) { d[g] += __shfl_xor(d[g], 1); d[g] += __shfl_xor(d[g], 2); if (pt == 0) sc[(4 * kvh + g) * 132 + key] = d[g]; }
      } }
    {
      const int h = wave, kvh = h >> 2; float d = ksn[kvh * 128 + lane] * qs[h * 128 + lane] + ksn[kvh * 128 + 64 + lane] * qs[h * 128 + 64 + lane];
      d = wave_sum(d); if (lane == 0) sc[h * 132 + 128] = d; }
    WG_BAR();
    { const int h = wave; const float sink2 = AR.in[IN_SINKS][l * 8 + h] * LOG2E;
      const float v0 = sc[h * 132 + lane], v1 = sc[h * 132 + 64 + lane], v2 = (lane == 0) ? sc[h * 132 + 128] : -INFINITY;
      const float mx = fmaxf(wave_max(fmaxf(fmaxf(v0, v1), v2)), sink2);
      const float p0 = __builtin_amdgcn_exp2f(v0 - mx), p1 = __builtin_amdgcn_exp2f(v1 - mx), p2 = __builtin_amdgcn_exp2f(v2 - mx);
      const float inv = 1.0f / (wave_sum(p0 + p1 + p2) + __builtin_amdgcn_exp2f(sink2 - mx));
      sc[h * 132 + lane] = p0 * inv; sc[h * 132 + 64 + lane] = p1 * inv; if (lane == 0) sc[h * 132 + 128] = p2 * inv; }
    WG_BAR();
    { const int d = tid & 127, kq = tid >> 7;
#pragma unroll
      for (int kvh = 0; kvh < 2; ++kvh) { float a[4] = {0.f, 0.f, 0.f, 0.f};
          for (int k = 0; k < 32; ++k) { const int key = 32 * kq + k; const float v = cv[(size_t)key * 256 + kvh * 128 + d];
#pragma unroll
              for (int g = 0; g < 4; ++g) a[g] += sc[(4 * kvh + g) * 132 + key] * v; }
#pragma unroll
          for (int g = 0; g < 4; ++g) part[kq * 1024 + (4 * kvh + g) * 128 + d] = a[g]; } }
    WG_BAR();
    float o[2]; float ss = 0.f;
#pragma unroll
    for (int e = 0; e < 2; ++e) { const int j = tid + 512 * e, h = j >> 7, d = j & 127, kvh = h >> 2;
        o[e] = (part[j] + part[1024 + j]) + (part[2048 + j] + part[3072 + j]) + sc[h * 132 + 128] * vsn[kvh * 128 + d]; ss += o[e] * o[e]; }
    ss = wave_sum(ss); if (lane == 0) red[wave] = ss;
    WG_BAR();
    { float tot = 0.f;
#pragma unroll
      for (int j = 0; j < 8; ++j) tot += red[j];
      const float rsa = rsqrtf(tot * (1.0f / 1024.0f) + EPS);
      bf16* mp = (bf16*)(F.ws + WS_MIX) + row * DM;
#pragma unroll
      for (int e = 0; e < 2; ++e) mp[tid + 512 * e] = (bf16)(pk2(o[e] * rsa, 0.f) & 0xffffu); }
    { float* ok = F.out + O_SK + ((size_t)(l * NSAMP + s)) * 128 * 256; float* ov = F.out + O_SV + ((size_t)(l * NSAMP + s)) * 128 * 256;
      for (int j = tid; j < 127 * 64; j += 512) { *(f32x4*)(ok + 4 * j) = *(const f32x4*)(ck + 256 + 4 * j); *(f32x4*)(ov + 4 * j) = *(const f32x4*)(cv + 256 + 4 * j); }
      if (tid < 64) *(f32x4*)(ok + 127 * 256 + 4 * tid) = *(const f32x4*)(ksn + 4 * tid);
      else if (tid < 128) *(f32x4*)(ov + 127 * 256 + 4 * (tid - 64)) = *(const f32x4*)(vsn + 4 * (tid - 64)); }
    WG_BAR();
}

__device__ __forceinline__ float gelu_tanh(float y) {
    const float inner = 0.7978845608028654f * (y + 0.044715f * y * y * y);
    return y / (1.0f + __builtin_amdgcn_exp2f(-2.0f * LOG2E * inner));
}
__device__ __forceinline__ float sigmoidf_(float x) { return 1.0f / (1.0f + __builtin_amdgcn_exp2f(-LOG2E * x)); }
#define SWZ(r, ch, PITCH) ((r) * (PITCH) + ((((ch)) ^ ((r) & 15)) << 4))

__device__ __forceinline__ void ssm_unit(const Args& AR, Frame& F, int l, int c) {
    int lane_ = F.lane; asm volatile("" : "+v"(lane_));
    const int lane = lane_, w = F.wave, n = lane, t16 = lane & 15, cq = lane >> 4;
    const int row0 = 64 * c;
    unsigned char* ws = F.ws; asm volatile("" : "+s"(ws));
    const unsigned char* tb = ws + WS_TAB + (size_t)l * TB_LAYER;
    const float* U = (const float*)(ws + WS_U);
    float* SST = (float*)(ws + WS_SST) + ((size_t)l * NCHUNK) * 32 * 128;
    gu32* flags = F.ctl + CW_SSMF + (size_t)(l * NCHUNK) * 8 * 16;
    LAS unsigned char* myl = F.lds + w * 12288;
    LAS unsigned char* Hm = myl; LAS unsigned char* CHt = myl + 8192;
    const int rr = (c == 64) ? 16 : (c == 128) ? 32 : 64;
    f32x4 Y[4][4];
    float eR[4], eI[4];
#pragma unroll
    for (int gi = 0; gi < 4; ++gi) { eR[gi] = 0.f; eI[gi] = 0.f;
#pragma unroll
        for (int mt = 0; mt < 4; ++mt) Y[gi][mt] = (f32x4){0.f, 0.f, 0.f, 0.f}; }
#ifndef NO_P1
#pragma unroll
    for (int gi = 0; gi < 4; ++gi) {
        asm volatile("" ::: "memory");
        const int g = 4 * w + gi;
        const float abr = ((const float*)(tb + TB_ABR))[g * 64 + n], abi = ((const float*)(tb + TB_ABI))[g * 64 + n];
        float bbr[16], bbi[16];
        { const f32x4* pr = (const f32x4*)((const float*)(tb + TB_BBR) + (size_t)(g * 64 + n) * 16); const f32x4* pi = (const f32x4*)((const float*)(tb + TB_BBI) + (size_t)(g * 64 + n) * 16);
#pragma unroll
          for (int j = 0; j < 4; ++j) { const f32x4 a = pr[j], b2 = pi[j];
#pragma unroll
              for (int e = 0; e < 4; ++e) { bbr[4 * j + e] = a[e]; bbi[4 * j + e] = b2[e]; } } }
        float uu[16];
        { const f32x4* pu = (const f32x4*)(U + (size_t)(row0 + lane) * 512 + 16 * g);
#pragma unroll
          for (int j = 0; j < 4; ++j) { const f32x4 a = pu[j];
#pragma unroll
              for (int e = 0; e < 4; ++e) uu[4 * j + e] = a[e]; } }
        bf16x8 cmf[4];
        { const bf16* cm = (const bf16*)(tb + TB_CMT) + (size_t)g * 16 * 128 + t16 * 128 + 8 * cq;
#pragma unroll
          for (int ks = 0; ks < 4; ++ks) cmf[ks] = *(const bf16x8*)(cm + 32 * ks); }
        float hr = 0.f, hi = 0.f;
#pragma unroll
        for (int half = 0; half < 2; ++half) {
#pragma unroll 1
            for (int r = 32 * half; r < 32 * half + 32; ++r) {
                if (c == 64 && r == 16) { hr = 0.f; hi = 0.f; }
                if (c == 128 && r >= 32) { const size_t o = ((size_t)(l * NSAMP + (r - 32)) * 32 + g) * 64 + n; hr = AR.in[IN_SSMRE][o]; hi = AR.in[IN_SSMIM][o]; }
                float xr = 0.f, xi = 0.f;
#pragma unroll
                for (int cc = 0; cc < 16; ++cc) { const float uv = __builtin_bit_cast(float, __builtin_amdgcn_readlane(__builtin_bit_cast(int, uu[cc]), r)); xr += bbr[cc] * uv; xi += bbi[cc] * uv; }
                const float nr = abr * hr - abi * hi + xr, ni = abr * hi + abi * hr + xi; hr = nr; hi = ni;
                const int rl = r & 31;
                *(LAS bf16*)(Hm + SWZ(rl, n >> 3, 256) + (n & 7) * 2) = (bf16)(pk2(hr, 0.f) & 0xffffu);
                *(LAS bf16*)(Hm + SWZ(rl, 8 + (n >> 3), 256) + (n & 7) * 2) = (bf16)(pk2(hi, 0.f) & 0xffffu);
                if ((c == 64 && r == 15) || (c == 128 && r == 31)) { eR[gi] = hr; eI[gi] = hi; }
                if (c == 128 && r >= 32) { const size_t o = ((size_t)(l * NSAMP + (r - 32)) * 32 + g) * 64 + n; F.out[O_SSR + o] = hr; F.out[O_SSI + o] = hi; }
            }
            LDS_WAIT();
#pragma unroll
            for (int mt = 0; mt < 2; ++mt)
#pragma unroll
                for (int ks = 0; ks < 4; ++ks) { const bf16x8 hf = *(const LAS bf16x8*)(Hm + SWZ(16 * mt + t16, 4 * ks + cq, 256));
                    Y[gi][2 * half + mt] = __builtin_amdgcn_mfma_f32_16x16x32_bf16(cmf[ks], hf, Y[gi][2 * half + mt], 0, 0, 0); }
            LDS_WAIT();
        }
        __hip_atomic_store((gu64*)(SST + ((size_t)c * 32 + g) * 128 + 2 * n), ((unsigned long long)__builtin_bit_cast(unsigned, hi) << 32) | __builtin_bit_cast(unsigned, hr), RLX_AGENT);
    }
#endif
    VM_WAIT();
    if (lane == 0) __hip_atomic_store(flags + ((size_t)c * 8 + w) * 16, 1u, RLX_AGENT);
    const int cs0 = (c <= 64) ? 0 : 64, npred = c - cs0;
#ifndef NO_P2
    if (npred > 0) {
        { unsigned sp = 0; bool ok = false;
          for (;;) { ok = (lane >= npred) || (__hip_atomic_load(flags + ((size_t)(cs0 + lane) * 8 + w) * 16, RLX_AGENT) != 0u);
              if (__all(ok)) break;
              __builtin_amdgcn_s_sleep(2);
              if (++sp > (1u << 20)) { if (lane == 0) __hip_atomic_store(F.ctl + CW_TMO, 0x55u, RLX_AGENT); break; } } }
        __builtin_amdgcn_fence(__ATOMIC_ACQUIRE, "agent");
        VM_WAIT();
#pragma unroll
        for (int gi = 0; gi < 4; ++gi) {
            asm volatile("" ::: "memory");
            const int g = 4 * w + gi;
            const float aLr = ((const float*)(tb + TB_ALR))[g * 64 + n], aLi = ((const float*)(tb + TB_ALI))[g * 64 + n];
            float Hr = 0.f, Hi = 0.f;
#pragma unroll 2
            for (int cp = cs0; cp < c; ++cp) {
                const unsigned long long sv = __hip_atomic_load((gu64*)(SST + ((size_t)cp * 32 + g) * 128 + 2 * n), RLX_AGENT);
                const float sr = __builtin_bit_cast(float, (unsigned)sv), si = __builtin_bit_cast(float, (unsigned)(sv >> 32));
                const float nr = aLr * Hr - aLi * Hi + sr, ni = aLr * Hi + aLi * Hr + si; Hr = nr; Hi = ni;
            }
            if (c == 64 || c == 128) {
                const float pr = ((const float*)(tb + (c == 64 ? TB_A16R : TB_A32R)))[g * 64 + n], pi = ((const float*)(tb + (c == 64 ? TB_A16I : TB_A32I)))[g * 64 + n];
                const size_t o = ((size_t)(l * NBATCH + (c == 64 ? 0 : 1)) * 32 + g) * 64 + n;
                F.out[O_PSR + o] = eR[gi] + pr * Hr - pi * Hi; F.out[O_PSI + o] = eI[gi] + pr * Hi + pi * Hr;
            }
            { const float* Cr = AR.in[IN_CRE] + ((size_t)(l * 32 + g) * 16) * 64 + n; const float* Ci = AR.in[IN_CIM] + ((size_t)(l * 32 + g) * 16) * 64 + n;
#pragma unroll
              for (int ch = 0; ch < 16; ++ch) { const float cr = Cr[ch * 64], ci = Ci[ch * 64];
                  *(LAS bf16*)(CHt + SWZ(ch, n >> 3, 256) + (n & 7) * 2) = (bf16)(pk2(cr * Hr - ci * Hi, 0.f) & 0xffffu);
                  *(LAS bf16*)(CHt + SWZ(ch, 8 + (n >> 3), 256) + (n & 7) * 2) = (bf16)(pk2(-(cr * Hi + ci * Hr), 0.f) & 0xffffu); } }
            LDS_WAIT();
            bf16x8 chf[4];
#pragma unroll
            for (int ks = 0; ks < 4; ++ks) chf[ks] = *(const LAS bf16x8*)(CHt + SWZ(t16, 4 * ks + cq, 256));
            const bf16* Pm = (const bf16*)(tb + TB_PM) + (size_t)g * 64 * 128 + t16 * 128 + 8 * cq;
#pragma unroll
            for (int mt = 0; mt < 4; ++mt) {
                if (16 * mt < rr) {
#pragma unroll
                    for (int ks = 0; ks < 4; ++ks) { const bf16x8 pf = *(const bf16x8*)(Pm + (size_t)mt * 16 * 128 + 32 * ks);
                        Y[gi][mt] = __builtin_amdgcn_mfma_f32_16x16x32_bf16(chf[ks], pf, Y[gi][mt], 0, 0, 0); }
                }
            }
            LDS_WAIT();
        }
    }
#endif
    LAS unsigned char* Zs = F.lds;
    LAS float* red = (LAS float*)(F.lds + ESC_OFF);
    WG_BAR();
#pragma unroll
    for (int gi = 0; gi < 4; ++gi) {
        const int col = 64 * w + 16 * gi + 4 * cq;
        const f32x4 dsk = *(const f32x4*)(AR.in[IN_DSKIP] + l * 512 + col);
#pragma unroll
        for (int mt = 0; mt < 4; ++mt) { const int rl = 16 * mt + t16;
            const f32x4 uv = *(const f32x4*)(U + (size_t)(row0 + rl) * 512 + col);
            f32x4 z;
#pragma unroll
            for (int e = 0; e < 4; ++e) z[e] = gelu_tanh(Y[gi][mt][e] + dsk[e] * uv[e]);
            Y[gi][mt] = z;
            *(LAS v2u*)(Zs + SWZ(rl, col >> 3, 1024) + (col & 7) * 2) = (v2u){pk2(z[0], z[1]), pk2(z[2], z[3])}; }
    }
    WG_BAR();
#ifndef NO_GLU
    f32x4 G[4][4];
#pragma unroll
    for (int mt = 0; mt < 4; ++mt)
#pragma unroll
        for (int nt = 0; nt < 4; ++nt) G[mt][nt] = (f32x4){0.f, 0.f, 0.f, 0.f};
    { const bf16* Wg = (const bf16*)(ws + WS_WGLU) + (size_t)l * 512 * 512 + (size_t)(64 * w + t16) * 512 + 8 * cq;
#pragma unroll 1
      for (int ks = 0; ks < 16; ++ks) {
          bf16x8 wf[4], zf[4];
#pragma unroll
          for (int nt = 0; nt < 4; ++nt) wf[nt] = *(const bf16x8*)(Wg + (size_t)nt * 16 * 512 + 32 * ks);
#pragma unroll
          for (int mt = 0; mt < 4; ++mt) zf[mt] = *(const LAS bf16x8*)(Zs + SWZ(16 * mt + t16, 4 * ks + cq, 1024));
#pragma unroll
          for (int mt = 0; mt < 4; ++mt)
#pragma unroll
              for (int nt = 0; nt < 4; ++nt) G[mt][nt] = __builtin_amdgcn_mfma_f32_16x16x32_bf16(wf[nt], zf[mt], G[mt][nt], 0, 0, 0);
      } }
#pragma unroll
    for (int mt = 0; mt < 4; ++mt) { float ss = 0.f;
#pragma unroll
        for (int nt = 0; nt < 4; ++nt) { const f32x4 bg = *(const f32x4*)(AR.in[IN_BGLU] + l * 512 + 64 * w + 16 * nt + 4 * cq);
#pragma unroll
            for (int e = 0; e < 4; ++e) { const float o = Y[nt][mt][e] * sigmoidf_(G[mt][nt][e] + bg[e]); G[mt][nt][e] = o; ss += o * o; } }
        ss += __shfl_xor(ss, 16); ss += __shfl_xor(ss, 32);
        if (cq == 0) red[(16 * mt + t16) * 8 + w] = ss; }
    WG_BAR();
    { bf16* MIX = (bf16*)(ws + WS_MIX);
#pragma unroll
      for (int mt = 0; mt < 4; ++mt) { const int rl = 16 * mt + t16; const LAS f32x4* rp = (const LAS f32x4*)(red + rl * 8); const f32x4 a = rp[0], b2 = rp[1];
          const float rsn = rsqrtf(((a[0] + a[1]) + (a[2] + a[3]) + (b2[0] + b2[1]) + (b2[2] + b2[3])) * (1.0f / 512.0f) + EPS);
          bf16* mp = MIX + (size_t)(row0 + rl) * DM + 1024 + 64 * w + 4 * cq;
#pragma unroll
          for (int nt = 0; nt < 4; ++nt) *(v2u*)(mp + 16 * nt) = (v2u){pk2(G[mt][nt][0] * rsn, G[mt][nt][1] * rsn), pk2(G[mt][nt][2] * rsn, G[mt][nt][3] * rsn)}; } }
#endif
    WG_BAR();
}

__device__ __forceinline__ void pool_unit(const Args& AR, Frame& F, int l, int c) {
    int tid_ = F.tid; asm volatile("" : "+v"(tid_));
    const int tid = tid_, lane = tid & 63, w = F.wave, t16 = lane & 15, cq = lane >> 4;
    const int row0 = 64 * c;
    unsigned char* ws = F.ws; asm volatile("" : "+s"(ws));
    const float* XP = (const float*)(ws + WS_XP);
    LAS unsigned char* Ds = F.lds;
    LAS float* red = (LAS float*)(F.lds + ESC_OFF);
    { const int ch = tid, wlen = 2 << (ch >> 7);
      const float* sp = AR.in[IN_SPOOL] + (size_t)l * NSAMP * 15 * 512 + ch;
      int seg = (row0 >= TT) ? TT : 0;
      float sum = 0.f;
      for (int j = wlen; j >= 1; --j) { const int ra = row0 - j; if (ra >= seg) sum += XP[(size_t)ra * 512 + ch]; }
      for (int r = 0; r < 64; ++r) {
          const int ra = row0 + r; const float x = XP[(size_t)ra * 512 + ch]; float dm;
          if (ra < SROW0) {
              if (ra == TT) { seg = TT; sum = 0.f; }
              sum += x;
              if (ra - wlen >= seg) sum -= XP[(size_t)(ra - wlen) * 512 + ch];
              const int cnt = (ra - seg + 1 < wlen) ? (ra - seg + 1) : wlen;
              dm = sum / (float)cnt - x;
              if (ra >= TT - 15 && ra < TT) F.out[O_PP + ((size_t)(l * NBATCH + 0) * 15 + (ra - (TT - 15))) * 512 + ch] = x;
              if (ra >= SROW0 - 15) F.out[O_PP + ((size_t)(l * NBATCH + 1) * 15 + (ra - (SROW0 - 15))) * 512 + ch] = x;
          } else {
              const int s = ra - SROW0; const float* pp = sp + (size_t)s * 15 * 512; float a = x;
              for (int j = 16 - wlen; j < 15; ++j) a += pp[(size_t)j * 512];
              dm = a / (float)wlen - x;
              float* op = F.out + O_SP + ((size_t)(l * NSAMP + s) * 15) * 512 + ch;
              for (int j = 0; j < 14; ++j) op[(size_t)j * 512] = pp[(size_t)(j + 1) * 512];
              op[(size_t)14 * 512] = x;
          }
          *(LAS bf16*)(Ds + SWZ(r, ch >> 3, 1024) + (ch & 7) * 2) = (bf16)(pk2(dm, 0.f) & 0xffffu);
      } }
    WG_BAR();
    const int gp = w & 3, rh = w >> 2;
    f32x4 A[2][8];
#pragma unroll
    for (int mt = 0; mt < 2; ++mt)
#pragma unroll
        for (int nt = 0; nt < 8; ++nt) A[mt][nt] = (f32x4){0.f, 0.f, 0.f, 0.f};
    { const bf16* Wp = (const bf16*)(ws + WS_WPOOL) + ((size_t)(l * 4 + gp) * 128 + t16) * 128 + 8 * cq;
#pragma unroll
      for (int ks = 0; ks < 4; ++ks) {
          bf16x8 df[2];
#pragma unroll
          for (int mt = 0; mt < 2; ++mt) df[mt] = *(const LAS bf16x8*)(Ds + SWZ(32 * rh + 16 * mt + t16, 16 * gp + 4 * ks + cq, 1024));
#pragma unroll
          for (int nt = 0; nt < 8; ++nt) { const bf16x8 wf = *(const bf16x8*)(Wp + (size_t)nt * 16 * 128 + 32 * ks);
#pragma unroll
              for (int mt = 0; mt < 2; ++mt) A[mt][nt] = __builtin_amdgcn_mfma_f32_16x16x32_bf16(wf, df[mt], A[mt][nt], 0, 0, 0); }
      } }
#pragma unroll
    for (int mt = 0; mt < 2; ++mt) { float ss = 0.f;
#pragma unroll
        for (int nt = 0; nt < 8; ++nt) { const f32x4 sc = *(const f32x4*)(AR.in[IN_PSCALE] + l * 512 + 128 * gp + 16 * nt + 4 * cq);
#pragma unroll
            for (int e = 0; e < 4; ++e) { const float o = A[mt][nt][e] * sc[e]; A[mt][nt][e] = o; ss += o * o; } }
        ss += __shfl_xor(ss, 16); ss += __shfl_xor(ss, 32);
        if (cq == 0) red[(32 * rh + 16 * mt + t16) * 4 + gp] = ss; }
    WG_BAR();
    { bf16* MIX = (bf16*)(ws + WS_MIX);
#pragma unroll
      for (int mt = 0; mt < 2; ++mt) { const int rl = 32 * rh + 16 * mt + t16; const f32x4 a = *(const LAS f32x4*)(red + rl * 4);
          const float rsn = rsqrtf(((a[0] + a[1]) + (a[2] + a[3])) * (1.0f / 512.0f) + EPS);
          bf16* mp = MIX + (size_t)(row0 + rl) * DM + 1536 + 128 * gp + 4 * cq;
#pragma unroll
          for (int nt = 0; nt < 8; ++nt) *(v2u*)(mp + 16 * nt) = (v2u){pk2(A[mt][nt][0] * rsn, A[mt][nt][1] * rsn), pk2(A[mt][nt][2] * rsn, A[mt][nt][3] * rsn)}; } }
    WG_BAR();
}

constexpr int N_PHASES = 1 + 5 * NLAYER;
constexpr int NU_SSM = NCHUNK, NU_ATT = NBATCH * NQB, NU_SATT = NSAMP, NU_POOL = NCHUNK, NU_B = NU_SSM + NU_ATT + NU_SATT + NU_POOL;

__global__ void __launch_bounds__(512, 2) hymba_fwd(Args args) {
    extern __shared__ __attribute__((aligned(16))) unsigned char lds[];
    Frame F;
    F.lds = (LAS unsigned char*)lds;
    F.MISC = (volatile LAS unsigned*)(F.lds + MISC_OFF);
    F.tid = threadIdx.x; F.lane = F.tid & 63; F.wave = __builtin_amdgcn_readfirstlane(F.tid >> 6);
    F.G = gridDim.x; { const int bx = blockIdx.x; F.vcu = (F.G % 8 == 0) ? (bx % 8) * (F.G / 8) + bx / 8 : bx; }
    F.ws = args.ws; F.out = args.out; F.ctl = (gu32*)(args.ws + WS_CTL);
    for (int u = F.tid; u < (LDS_BYTES - LDSCTL_OFF) / 4; u += 512) ((LAS unsigned*)(F.lds + LDSCTL_OFF))[u] = 0u;
    __syncthreads();
    XcdBarrier bar; bar.bar = (unsigned*)(F.ctl + CW_BAR); bar.x = 0; bar.st = nullptr;
    if (MK_N_LAUNCHES == 1) bar = xcd_barrier_post((unsigned*)(F.ctl + CW_BAR), F.MISC + 8);
    const int lo = args.ph_lo, hi = args.ph_hi;
#ifndef PH_MASK
#define PH_MASK 0x1ff
#endif
#define PHM(j) (((PH_MASK) >> (j)) & 1)
#define IN_PH(k) (lo <= (k) && (k) < hi)
#define SEAM(k) do { if (IN_PH(k) && IN_PH((k) + 1)) xcd_barrier(bar); } while (0)
    LAS unsigned char* ring = F.lds; LAS unsigned char* esc = F.lds + ESC_OFF;

    if (PHM(0) && IN_PH(0)) { p0_prologue(args, F); }
    SEAM(0);
    for (int l = 0; l < NLAYER; ++l) {
        const int pb = 1 + 5 * l;
        if (PHM(1) && IN_PH(pb)) {
            unsigned char* ws = args.ws; asm volatile("" : "+s"(ws)); const bf16* XB = (const bf16*)(ws + WS_XB); int Gs = F.G, bid = (int)blockIdx.x; asm volatile("" : "+s"(Gs), "+s"(bid));
            pg8::Gemm g{XB, (const bf16*)(ws + WS_WIN) + (size_t)l * INW * DM, MP, INW, DM}; pg8::StaticOrder S; S.init(MP, INW, Gs, bid);
            EpiProj E{ws, F.out, args.in[IN_GQ] + l * 128, args.in[IN_GK] + l * 128, l};
            pg8::gemm_phase<EpiProj, pg8::StaticOrder, true, true>(ring, esc, g, S, E);
        }
        SEAM(pb);
        if (IN_PH(pb + 1)) {
            for (int ui = F.vcu; ui < NU_B; ui += F.G) {
                int r = ui;
                if (r < NU_SSM) { if (PHM(2)) ssm_unit(args, F, l, r); continue; } r -= NU_SSM;
                if (r < NU_ATT) { if (PHM(3)) attn_unit(args, F, l, r / NQB, r % NQB); continue; } r -= NU_ATT;
                if (r < NU_SATT) { if (PHM(4)) sattn_unit(args, F, l, r); continue; } r -= NU_SATT;
                if (PHM(5)) pool_unit(args, F, l, r);
            }
        }
        SEAM(pb + 1);
        if (PHM(6) && IN_PH(pb + 2)) {
            unsigned char* ws = args.ws; asm volatile("" : "+s"(ws)); const bf16* XB = (const bf16*)(ws + WS_XB); int Gs = F.G, bid = (int)blockIdx.x; asm volatile("" : "+s"(Gs), "+s"(bid));
            pg8::Gemm g{(const bf16*)(ws + WS_MIX), (const bf16*)(ws + WS_WOUT) + (size_t)l * DM * DM, MP, DM, DM}; pg8::StaticOrder S; S.init(MP, DM, Gs, bid);
            EpiRes E{(float*)(ws + WS_X), (bf16*)(ws + WS_XB), (float*)(ws + WS_SSQ), F.out, 0};
            pg8::gemm_phase<EpiRes, pg8::StaticOrder, true, true>(ring, esc, g, S, E);
        }
        SEAM(pb + 2);
        if (PHM(7) && IN_PH(pb + 3)) {
            unsigned char* ws = args.ws; asm volatile("" : "+s"(ws)); const bf16* XB = (const bf16*)(ws + WS_XB); int Gs = F.G, bid = (int)blockIdx.x; asm volatile("" : "+s"(Gs), "+s"(bid));
            pg8::Gemm g{XB, (const bf16*)(ws + WS_W1) + (size_t)l * DFF * DM, MP, DFF, DM}; pg8::StaticOrder S; S.init(MP, DFF, Gs, bid);
            EpiFfn1 E{(const float*)(ws + WS_SSQ), (bf16*)(ws + WS_H)};
            pg8::gemm_phase<EpiFfn1, pg8::StaticOrder, true, true>(ring, esc, g, S, E);
        }
        SEAM(pb + 3);
        if (PHM(8) && IN_PH(pb + 4)) {
            unsigned char* ws = args.ws; asm volatile("" : "+s"(ws)); const bf16* XB = (const bf16*)(ws + WS_XB); int Gs = F.G, bid = (int)blockIdx.x; asm volatile("" : "+s"(Gs), "+s"(bid));
            pg8::Gemm g{(const bf16*)(ws + WS_H), (const bf16*)(ws + WS_W2) + (size_t)l * DM * DFF, MP, DM, DFF}; pg8::StaticOrder S; S.init(MP, DM, Gs, bid);
            EpiRes E{(float*)(ws + WS_X), (bf16*)(ws + WS_XB), (float*)(ws + WS_SSQ), F.out, (l == NLAYER - 1) ? 1 : 0};
            pg8::gemm_phase<EpiRes, pg8::StaticOrder, true, true>(ring, esc, g, S, E);
        }
        SEAM(pb + 4);
    }
#undef IN_PH
#undef SEAM
}

extern "C" void kernel_launch(void* const* d_in, const int* in_sizes, int n_in, void* d_out, int out_size, void* d_ws, size_t ws_size, hipStream_t stream) {
    static int grid = 0;
    if (grid == 0) {
        if (n_in != 32 || (size_t)out_size != O_END || ws_size < WS_END) { fprintf(stderr, "kernel_launch: unexpected shapes: n_in %d out %d (want %zu) ws %zu (want >= %zu)\n", n_in, out_size, (size_t)O_END, ws_size, (size_t)WS_END); grid = -1; return; }
        int dev = 0, cus = 0, per_cu = 0;
        if (hipGetDevice(&dev) != hipSuccess || hipDeviceGetAttribute(&cus, hipDeviceAttributeMultiprocessorCount, dev) != hipSuccess) { fprintf(stderr, "kernel_launch: device query failed\n"); grid = -1; return; }
        if (hipFuncSetAttribute((const void*)hymba_fwd, hipFuncAttributeMaxDynamicSharedMemorySize, LDS_BYTES) != hipSuccess) { fprintf(stderr, "kernel_launch: hipFuncSetAttribute failed\n"); grid = -1; return; }
        if (hipOccupancyMaxActiveBlocksPerMultiprocessor(&per_cu, (const void*)hymba_fwd, 512, LDS_BYTES) != hipSuccess || per_cu < 1) { fprintf(stderr, "kernel_launch: occupancy query says %d blocks per CU\n", per_cu); per_cu = 1; }
        (void)hipGetLastError();
        grid = cus;
        if (grid % 8 != 0) grid -= grid % 8;
    }
    if (grid < 0) return;
    (void)hipMemsetAsync((char*)d_ws + WS_CTL, 0, CTL_ZERO_BYTES, stream);
    Args a{};
    for (int i = 0; i < 32; ++i) a.in[i] = (const float*)d_in[i];
    a.out = (float*)d_out; a.ws = (unsigned char*)d_ws;
    if (MK_N_LAUNCHES == 1) {
        a.ph_lo = 0; a.ph_hi = N_PHASES;
        hipLaunchKernelGGL(hymba_fwd, dim3(grid), dim3(512), LDS_BYTES, stream, a);
    } else {
        for (int p = 0; p < N_PHASES; ++p) { a.ph_lo = p; a.ph_hi = p + 1; hipLaunchKernelGGL(hymba_fwd, dim3(grid), dim3(512), LDS_BYTES, stream, a); }
    }
    const hipError_t le = hipPeekAtLastError();
    if (le != hipSuccess) fprintf(stderr, "kernel_launch: launch failed: %s\n", hipGetErrorName(le));
}
```

```cpp
#include <hip/hip_runtime.h>
#include <cstdio>
#include <cstdint>

#ifndef MK_N_LAUNCHES
#define MK_N_LAUNCHES 1
#endif

constexpr int DM = 2048, TT = 4112  , NSEQ = 4096, NMETA = 16, NBATCH = 2, NSAMP = 32;
constexpr int MR = NBATCH * TT + NSAMP;
constexpr int MP = 8448;
constexpr int SROW0 = NBATCH * TT;
constexpr int INW = 2560, DFF = 8192, NLAYER = 2;
constexpr int TPV = 4128;
constexpr int ROPE_SAMPLE_IDX = TT;
constexpr float EPS = 1e-6f;
constexpr float LOG2E = 1.4426950408889634f;
constexpr float QSCALE = 0.08838834764831845f * LOG2E;
constexpr int NCHUNK = MR / 64;
constexpr int NQB = (TT + 31) / 32;

constexpr size_t O_YP = 0, O_YS = O_YP + (size_t)NBATCH * NSEQ * DM, O_PK = O_YS + (size_t)NSAMP * DM, O_PV = O_PK + (size_t)NLAYER * NBATCH * 128 * 256,
                 O_PSR = O_PV + (size_t)NLAYER * NBATCH * 128 * 256, O_PSI = O_PSR + (size_t)NLAYER * NBATCH * 2048, O_PP = O_PSI + (size_t)NLAYER * NBATCH * 2048,
                 O_SK = O_PP + (size_t)NLAYER * NBATCH * 15 * 512, O_SV = O_SK + (size_t)NLAYER * NSAMP * 128 * 256, O_SSR = O_SV + (size_t)NLAYER * NSAMP * 128 * 256,
                 O_SSI = O_SSR + (size_t)NLAYER * NSAMP * 2048, O_SP = O_SSI + (size_t)NLAYER * NSAMP * 2048, O_END = O_SP + (size_t)NLAYER * NSAMP * 15 * 512;

constexpr size_t MiB = 1u << 20;
constexpr size_t WS_CTL = 0, CTL_ZERO_BYTES = 1 * MiB;
constexpr size_t WS_WIN = 1 * MiB, WS_WOUT = 21 * MiB, WS_W1 = 37 * MiB, WS_W2 = 101 * MiB, WS_WGLU = 165 * MiB, WS_WPOOL = 166 * MiB, WS_TAB = 167 * MiB;
constexpr size_t WS_X = 170 * MiB, WS_XB = 236 * MiB, WS_Q = 269 * MiB, WS_K = 286 * MiB, WS_VT = 291 * MiB, WS_U = 296 * MiB, WS_XP = 313 * MiB, WS_MIX = 330 * MiB,
                 WS_H = 363 * MiB, WS_SSQ = 495 * MiB, WS_SST = 497 * MiB, WS_KSN = 502 * MiB, WS_END = 503 * MiB;
static_assert(WS_WIN + (size_t)NLAYER * INW * DM * 2 <= WS_WOUT && WS_WOUT + (size_t)NLAYER * DM * DM * 2 <= WS_W1 && WS_W1 + (size_t)NLAYER * DFF * DM * 2 <= WS_W2 && WS_W2 + (size_t)NLAYER * DFF * DM * 2 <= WS_WGLU, "ws map 1");
static_assert(WS_X + (size_t)MP * DM * 4 <= WS_XB && WS_XB + (size_t)MP * DM * 2 <= WS_Q && WS_Q + (size_t)MP * 1024 * 2 <= WS_K && WS_K + (size_t)MP * 256 * 2 <= WS_VT && WS_VT + (size_t)4 * 128 * TPV * 2 <= WS_U, "ws map 2");
static_assert(WS_U + (size_t)MP * 512 * 4 <= WS_XP && WS_XP + (size_t)MP * 512 * 4 <= WS_MIX && WS_MIX + (size_t)MP * DM * 2 <= WS_H && WS_H + (size_t)MP * DFF * 2 <= WS_SSQ && WS_SSQ + (size_t)MP * 32 * 4 <= WS_SST, "ws map 3");
static_assert(WS_SST + (size_t)NLAYER * NCHUNK * 32 * 64 * 8 <= WS_KSN, "ws map 4");
constexpr size_t TB_ABR = 0, TB_ABI = 8192, TB_ALR = 16384, TB_ALI = 24576, TB_A16R = 32768, TB_A16I = 40960, TB_A32R = 49152, TB_A32I = 57344,
                 TB_BBR = 65536, TB_BBI = TB_BBR + 131072, TB_PM = TB_BBI + 131072, TB_CMT = TB_PM + 524288, TB_LAYER = 1 * MiB;
static_assert(TB_CMT + 131072 <= TB_LAYER, "table map");
constexpr size_t WS_ROPE = WS_TAB + 2 * MiB;
constexpr size_t ROPE_N = (size_t)(TT + 1) * 16;
constexpr int CW_TMO = 0, CW_CODE = 1, CW_BAR = 4096, CW_SSMF = 16384  ;
static_assert((CW_SSMF + NLAYER * NCHUNK * 8 * 16) * 4 <= (int)CTL_ZERO_BYTES, "ctl map");

constexpr int RING_BYTES = 131072, ESC_OFF = RING_BYTES  , LDSCTL_OFF = ESC_OFF + 12288, MISC_OFF = LDSCTL_OFF + 320, LDS_BYTES = 147456;
static_assert(MISC_OFF + 128 <= LDS_BYTES, "LDS map");

#define GAS __attribute__((address_space(1)))
#define LAS __attribute__((address_space(3)))
typedef unsigned short bf16;
typedef unsigned v4u __attribute__((ext_vector_type(4)));
typedef unsigned v2u __attribute__((ext_vector_type(2)));
typedef float f32x2 __attribute__((ext_vector_type(2)));
typedef float f32x16 __attribute__((ext_vector_type(16)));
typedef __bf16 bf16x2_t __attribute__((ext_vector_type(2)));
typedef GAS unsigned gu32;
typedef GAS unsigned long long gu64;
#define RLX_AGENT __ATOMIC_RELAXED, __HIP_MEMORY_SCOPE_AGENT
#define LDS_WAIT() asm volatile("s_waitcnt lgkmcnt(0)" ::: "memory")
#define VM_WAIT() asm volatile("s_waitcnt vmcnt(0)" ::: "memory")
#define WG_BAR() do { asm volatile("s_waitcnt lgkmcnt(0)" ::: "memory"); __builtin_amdgcn_s_barrier(); asm volatile("" ::: "memory"); } while (0)
__device__ __forceinline__ unsigned pk2(float lo, float hi) { f32x2 v = {lo, hi}; bf16x2_t b = __builtin_convertvector(v, bf16x2_t); return __builtin_bit_cast(unsigned, b); }
__device__ __forceinline__ float bf2f(unsigned short h) { return __builtin_bit_cast(float, (unsigned)h << 16); }
__device__ __forceinline__ float wave_sum(float v) {
#pragma unroll
    for (int o = 1; o < 64; o <<= 1) v += __shfl_xor(v, o);
    return v;
}
__device__ __forceinline__ float wave_max(float v) {
#pragma unroll
    for (int o = 1; o < 64; o <<= 1) v = fmaxf(v, __shfl_xor(v, o));
    return v;
}
__host__ __device__ __forceinline__ int perm16(int o) { return 8 * ((o >> 2) & 1) + 4 * (o >> 3) + (o & 3); }

namespace pg8 {
#define PG8_LAS __attribute__((address_space(3)))
typedef unsigned short bf16_t;
typedef short bf16x8 __attribute__((ext_vector_type(8)));
typedef float f32x4 __attribute__((ext_vector_type(4)));
typedef unsigned u32x4 __attribute__((ext_vector_type(4)));
constexpr int BM = 256, BK = 64, HALF = 128, HTB = HALF * BK * 2  , STAGE_BYTES = 8 * HTB, NXCD = 8, WGM = 8;

__host__ __device__ __forceinline__ int lds_byte(int r, int c) { const int st = (r >> 4) * 2 + (c >> 5), rr = r & 15, cc = c & 31, ob = rr * 64 + cc * 2; return st * 1024 + (ob ^ (((ob >> 9) & 1) << 5)); }
__host__ __device__ __forceinline__ void stage_rc(int b, int& R, int& C) { const int st = b / 1024, sb = b % 1024, swz = sb ^ (((sb >> 9) & 1) << 5); R = (st >> 1) * 16 + swz / 64; C = (st & 1) * 32 + (swz % 64) / 2; }
__host__ __device__ __forceinline__ int perm32(int rho) { const int n = rho >> 4, i = rho & 15; return 8 * (i >> 2) + 4 * n + (i & 3); }

struct Unit { int pm, pn; };
struct Gemm { const bf16_t* A; const bf16_t* Bt; int M, N, K; };

struct StaticOrder {
    int nM, nN, nwg, G, c;
    __host__ __device__ void init(int M, int N, int G_, int c_) { nM = M / BM; nN = N / BM; nwg = nM * nN; G = G_; c = c_; }
    __host__ __device__ bool next(int i, Unit& u) const {
        const long L = (long)i * G + c; if (L >= nwg) return false;
        int wgid = (int)L; { const int q = nwg / NXCD, r = nwg % NXCD, xcd = wgid % NXCD, off = wgid / NXCD; wgid = (xcd < r ? xcd * (q + 1) : r * (q + 1) + (xcd - r) * q) + off; }
        const int nig = WGM * nN, gid = wgid / nig, fm = gid * WGM, gsz = (nM - fm) < WGM ? (nM - fm) : WGM;
        u.pm = fm + ((wgid % nig) % gsz); u.pn = (wgid % nig) / gsz; return true;
    }
    __device__ __forceinline__ void a_ready(const Unit&) const {}
    __device__ __forceinline__ void done(const Unit&) const {}
};


template <class Epi, class Sched, bool ALIGN_EPI = false, bool SP2 = false>
__device__ __forceinline__ void gemm_phase(PG8_LAS unsigned char* lds, PG8_LAS unsigned char* esc, const Gemm g, const Sched& S, const Epi& E) {
    int tid_ = threadIdx.x; asm volatile("" : "+v"(tid_));
    const int tid = tid_, wid = __builtin_amdgcn_readfirstlane(tid >> 6), lane = tid & 63, wr = wid >> 2, wc = wid & 3, fr = lane & 15, fq = lane >> 4;
    const int K = g.K, nt = K / BK;
    unsigned voffA[2], voffB[2];
#pragma unroll
    for (int i = 0; i < 2; ++i) { int R, C; stage_rc(tid * 16 + i * 8192, R, C); const int Rb = Epi::PERM ? ((R & ~31) + perm32(R & 31)) : R;
        voffA[i] = (unsigned)(R * K + C) * 2u; voffB[i] = (unsigned)(Rb * K + C) * 2u; }
    const size_t kstep = (size_t)(BK * 2);
    const size_t hstep = (size_t)HALF * K * 2;
    const size_t tstep = 2 * hstep;
    const unsigned ldsw = (unsigned)wid * 1024u;
    const int aoff = lds_byte(wr * 64 + fr, fq * 8), boff = lds_byte(wc * 32 + fr, fq * 8);
#define PG8_SA(b, h) (((b) * 2 + (h)) * HTB)
#define PG8_SB(b, h) ((4 + (b) * 2 + (h)) * HTB)
#define PG8_STAGE(bufoff, gbase, voff) do { _Pragma("unroll") for (int _i = 0; _i < 2; ++_i) \
        __builtin_amdgcn_global_load_lds((const unsigned*)((const char*)(gbase) + (voff)[_i]), (PG8_LAS unsigned*)(lds + (bufoff) + ldsw + _i * 8192), 16, 0, 0); } while (0)
#define PG8_LDA(dst, b, h) do { _Pragma("unroll") for (int m = 0; m < 4; ++m) _Pragma("unroll") for (int k = 0; k < 2; ++k) dst[m][k] = *(const PG8_LAS bf16x8*)(lds + PG8_SA(b, h) + aoff + m * 2048 + k * 1024); } while (0)
#define PG8_LDB(dst, b, h) do { _Pragma("unroll") for (int n = 0; n < 2; ++n) _Pragma("unroll") for (int k = 0; k < 2; ++k) dst[n][k] = *(const PG8_LAS bf16x8*)(lds + PG8_SB(b, h) + boff + n * 2048 + k * 1024); } while (0)
#define PG8_MMA(ai, bj, At, Bt) do { __builtin_amdgcn_s_setprio(1); _Pragma("unroll") for (int m = 0; m < 4; ++m) _Pragma("unroll") for (int n = 0; n < 2; ++n) _Pragma("unroll") for (int k = 0; k < 2; ++k) \
        acc[ai][bj][m][n] = __builtin_amdgcn_mfma_f32_16x16x32_bf16(Bt[n][k], At[m][k], acc[ai][bj][m][n], 0, 0, 0); __builtin_amdgcn_s_setprio(0); } while (0)
#define PG8_WAIT_V(n) asm volatile("s_waitcnt vmcnt(" #n ")" ::: "memory")
#define PG8_WAIT_L(n) asm volatile("s_waitcnt lgkmcnt(" #n ")" ::: "memory")
#define PG8_BAR __builtin_amdgcn_s_barrier()
#define PG8_SCHED __builtin_amdgcn_sched_barrier(0)
    Unit cur, nxt; int ui = 0;
    if (!S.next(0, cur)) return;
    f32x4 acc[2][2][4][2];
#pragma unroll
    for (int a = 0; a < 2; ++a)
#pragma unroll
        for (int b = 0; b < 2; ++b)
#pragma unroll
            for (int m = 0; m < 4; ++m)
#pragma unroll
                for (int n = 0; n < 2; ++n) acc[a][b][m][n] = (f32x4){0.f, 0.f, 0.f, 0.f};
    bf16x8 At[4][2], B0[2][2], B1[2][2];
    const char* cA = (const char*)g.A + (size_t)cur.pm * tstep; const char* cB = (const char*)g.Bt + (size_t)cur.pn * tstep;
    S.a_ready(cur);
    if constexpr (SP2) {
        PG8_STAGE(PG8_SB(0, 0), cB, voffB); PG8_STAGE(PG8_SB(0, 1), cB + hstep, voffB); PG8_STAGE(PG8_SA(0, 0), cA, voffA); PG8_STAGE(PG8_SA(0, 1), cA + hstep, voffA);
        if (wr == 1) PG8_BAR;
        PG8_WAIT_V(2); PG8_BAR;
        PG8_STAGE(PG8_SB(1, 0), cB + kstep, voffB); PG8_STAGE(PG8_SA(1, 0), cA + kstep, voffA); PG8_STAGE(PG8_SB(1, 1), cB + hstep + kstep, voffB);
        PG8_WAIT_V(6); PG8_BAR;
    } else {
        PG8_STAGE(PG8_SB(0, 0), cB, voffB); PG8_STAGE(PG8_SA(0, 0), cA, voffA); PG8_STAGE(PG8_SB(0, 1), cB + hstep, voffB); PG8_STAGE(PG8_SA(0, 1), cA + hstep, voffA);
        if (wr == 1) PG8_BAR;
        PG8_WAIT_V(4); PG8_BAR;
        PG8_STAGE(PG8_SB(1, 0), cB + kstep, voffB); PG8_STAGE(PG8_SA(1, 0), cA + kstep, voffA); PG8_STAGE(PG8_SB(1, 1), cB + hstep + kstep, voffB);
        PG8_WAIT_V(6); PG8_BAR;
    }
    for (;;) {
        const bool has_next = S.next(ui + 1, nxt);
        const char* nA = has_next ? (const char*)g.A + (size_t)nxt.pm * tstep : cA; const char* nB = has_next ? (const char*)g.Bt + (size_t)nxt.pn * tstep : cB;
        for (int t = 0; t < nt; t += 2) {
            const bool last = (t == nt - 2);
            const char* a1 = cA + (size_t)(t + 1) * kstep;
            const char* a2 = last ? nA : cA + (size_t)(t + 2) * kstep; const char* b2 = last ? nB : cB + (size_t)(t + 2) * kstep;
            const char* a3 = a2 + kstep; const char* b3 = b2 + kstep;
            if (last && has_next) S.a_ready(nxt);
            if constexpr (SP2) {
            PG8_LDB(B0, 0, 0); PG8_LDB(B1, 0, 1); PG8_SCHED; PG8_LDA(At, 0, 0); PG8_STAGE(PG8_SA(1, 1), a1 + hstep, voffA);
            PG8_WAIT_V(8); PG8_WAIT_L(0); PG8_BAR; PG8_MMA(0, 0, At, B0); PG8_MMA(0, 1, At, B1); PG8_BAR; PG8_SCHED;
            PG8_LDA(At, 0, 1); PG8_STAGE(PG8_SB(0, 0), b2, voffB); PG8_STAGE(PG8_SB(0, 1), b2 + hstep, voffB); PG8_STAGE(PG8_SA(0, 0), a2, voffA);
            PG8_WAIT_V(8); PG8_WAIT_L(0); PG8_BAR; PG8_MMA(1, 0, At, B0); PG8_MMA(1, 1, At, B1); PG8_BAR; PG8_SCHED;
            PG8_LDB(B0, 1, 0); PG8_LDB(B1, 1, 1); PG8_SCHED; PG8_LDA(At, 1, 0); PG8_STAGE(PG8_SA(0, 1), a2 + hstep, voffA);
            PG8_WAIT_V(8); PG8_WAIT_L(0); PG8_BAR; PG8_MMA(0, 0, At, B0); PG8_MMA(0, 1, At, B1); PG8_BAR; PG8_SCHED;
            PG8_LDA(At, 1, 1); PG8_STAGE(PG8_SB(1, 0), b3, voffB); PG8_STAGE(PG8_SB(1, 1), b3 + hstep, voffB); PG8_STAGE(PG8_SA(1, 0), a3, voffA);
            PG8_WAIT_V(8); PG8_WAIT_L(0); PG8_BAR; PG8_MMA(1, 0, At, B0); PG8_MMA(1, 1, At, B1); PG8_BAR; PG8_SCHED;
            } else {
            PG8_LDB(B0, 0, 0); PG8_SCHED; PG8_LDA(At, 0, 0); PG8_STAGE(PG8_SA(1, 1), a1 + hstep, voffA);
            PG8_WAIT_L(8); PG8_BAR; PG8_WAIT_L(0); PG8_MMA(0, 0, At, B0); PG8_BAR; PG8_SCHED;
            PG8_LDB(B1, 0, 1); PG8_STAGE(PG8_SB(0, 0), b2, voffB);
            PG8_BAR; PG8_WAIT_L(0); PG8_MMA(0, 1, At, B1); PG8_BAR;
            PG8_LDA(At, 0, 1); PG8_STAGE(PG8_SA(0, 0), a2, voffA);
            PG8_BAR; PG8_WAIT_L(0); PG8_MMA(1, 0, At, B0); PG8_BAR; PG8_SCHED;
            PG8_STAGE(PG8_SB(0, 1), b2 + hstep, voffB);
            PG8_WAIT_V(6); PG8_BAR; PG8_MMA(1, 1, At, B1); PG8_BAR;
            PG8_LDB(B0, 1, 0); PG8_SCHED; PG8_LDA(At, 1, 0); PG8_STAGE(PG8_SA(0, 1), a2 + hstep, voffA);
            PG8_WAIT_L(8); PG8_BAR; PG8_WAIT_L(0); PG8_MMA(0, 0, At, B0); PG8_BAR; PG8_SCHED;
            PG8_LDB(B1, 1, 1); PG8_STAGE(PG8_SB(1, 0), b3, voffB);
            PG8_BAR; PG8_WAIT_L(0); PG8_MMA(0, 1, At, B1); PG8_BAR;
            PG8_LDA(At, 1, 1); PG8_STAGE(PG8_SA(1, 0), a3, voffA);
            PG8_BAR; PG8_WAIT_L(0); PG8_MMA(1, 0, At, B0); PG8_BAR; PG8_SCHED;
            PG8_STAGE(PG8_SB(1, 1), b3 + hstep, voffB);
            PG8_WAIT_V(6); PG8_BAR; PG8_MMA(1, 1, At, B1); PG8_BAR;
            }
        }
        if constexpr (ALIGN_EPI) { if (wr == 0) PG8_BAR; }
        { E(acc, cur, wr, wc, fr, fq, esc, tid); S.done(cur); }
        if (!has_next) break;
#pragma unroll
        for (int a = 0; a < 2; ++a)
#pragma unroll
            for (int b = 0; b < 2; ++b)
#pragma unroll
                for (int m = 0; m < 4; ++m)
#pragma unroll
                    for (int n = 0; n < 2; ++n) acc[a][b][m][n] = (f32x4){0.f, 0.f, 0.f, 0.f};
        cur = nxt; cA = nA; cB = nB; ++ui;
        if constexpr (ALIGN_EPI) { if (wr == 1) PG8_BAR; }
    }
    PG8_WAIT_V(0);
    if constexpr (!ALIGN_EPI) { if (wr == 0) PG8_BAR; }
    PG8_BAR;
#undef PG8_SA
#undef PG8_SB
#undef PG8_STAGE
#undef PG8_LDA
#undef PG8_LDB
#undef PG8_MMA
#undef PG8_WAIT_V
#undef PG8_WAIT_L
#undef PG8_BAR
#undef PG8_SCHED
}
}

typedef float f32x4 __attribute__((ext_vector_type(4)));
typedef short bf16x8 __attribute__((ext_vector_type(8)));


__device__ __forceinline__ void build_rs(const float* ssq, int pm, LAS unsigned char* esc, int tid) {
    LAS float* rsT = (LAS float*)esc;
    WG_BAR();
    if (tid < 256) {
        const f32x4* p = (const f32x4*)(ssq + (size_t)(pm * 256 + tid) * 32); float s = 0.f;
#pragma unroll
        for (int j = 0; j < 8; ++j) { const f32x4 v = p[j]; s += (v[0] + v[1]) + (v[2] + v[3]); }
        rsT[tid] = rsqrtf(s * (1.0f / DM) + EPS);
    }
    WG_BAR();
}

struct EpiProj {
    static constexpr bool PERM = false, AFTER_DRAIN = false;
    unsigned char* ws_; float* out_; const float* gq; const float* gk; int l;
    __device__ __forceinline__ void operator()(f32x4 (&acc)[2][2][4][2], const pg8::Unit& u, int wr, int wc, int fr, int fq, LAS unsigned char* esc, int tid) const {
        asm volatile("" : "+v"(fr), "+v"(fq), "+v"(tid));
        unsigned char* ws = ws_; asm volatile("" : "+s"(ws));
        const float* ssq = (const float*)(ws + WS_SSQ); const float* ropec = (const float*)(ws + WS_ROPE); const float* ropes = ropec + ROPE_N;
        bf16* Q = (bf16*)(ws + WS_Q); bf16* K = (bf16*)(ws + WS_K); bf16* VT = (bf16*)(ws + WS_VT); float* U = (float*)(ws + WS_U); float* XP = (float*)(ws + WS_XP);
        float* ksn = (float*)(ws + WS_KSN); float* vsn = ksn + NSAMP * 256;
        float* out_pk = out_ + O_PK + (size_t)l * NBATCH * 128 * 256; float* out_pv = out_ + O_PV + (size_t)l * NBATCH * 128 * 256;
        build_rs(ssq, u.pm, esc, tid);
        const LAS float* rsT = (const LAS float*)esc;
        LAS float* hss = (LAS float*)(esc + 1024);
        const int pn = u.pn;
#pragma unroll
        for (int ai = 0; ai < 2; ++ai)
#pragma unroll
            for (int m = 0; m < 4; ++m) { const float rsv = rsT[ai * 128 + wr * 64 + m * 16 + fr];
#pragma unroll
                for (int bj = 0; bj < 2; ++bj)
#pragma unroll
                    for (int n = 0; n < 2; ++n) acc[ai][bj][m][n] *= rsv; }
        if (pn <= 4) {
#pragma unroll
            for (int ai = 0; ai < 2; ++ai)
#pragma unroll
                for (int m = 0; m < 4; ++m)
#pragma unroll
                    for (int bj = 0; bj < 2; ++bj) { const f32x4 a = acc[ai][bj][m][0], b = acc[ai][bj][m][1];
                        float s = (a[0] * a[0] + a[1] * a[1]) + (a[2] * a[2] + a[3] * a[3]) + (b[0] * b[0] + b[1] * b[1]) + (b[2] * b[2] + b[3] * b[3]);
                        s += __shfl_xor(s, 16); s += __shfl_xor(s, 32);
                        if (fq == 0) hss[(bj * 256 + ai * 128 + wr * 64 + m * 16 + fr) * 4 + wc] = s; }
            WG_BAR();
            const float* g = (pn < 4) ? gq : gk; const float osc = (pn < 4) ? QSCALE : 1.0f;
            f32x4 gv[2];
#pragma unroll
            for (int n = 0; n < 2; ++n) gv[n] = *(const f32x4*)(g + wc * 32 + n * 16 + 4 * fq);
#pragma unroll
            for (int ai = 0; ai < 2; ++ai)
#pragma unroll
                for (int m = 0; m < 4; ++m) {
                    const int rl = ai * 128 + wr * 64 + m * 16 + fr, r = u.pm * 256 + rl;
                    const bool samp = r >= SROW0, pad = r >= MR;
                    const int b = (r >= TT && !samp) ? 1 : 0, t = r - b * TT;
                    const int pidx = samp ? ROPE_SAMPLE_IDX : t;
                    f32x4 cs = {1.f, 1.f, 1.f, 1.f}, sn = {0.f, 0.f, 0.f, 0.f};
                    if (wc == 0 && !pad) { cs = *(const f32x4*)(ropec + (size_t)pidx * 16 + 4 * fq); sn = *(const f32x4*)(ropes + (size_t)pidx * 16 + 4 * fq); }
#pragma unroll
                    for (int bj = 0; bj < 2; ++bj) {
                        const f32x4 hv = *(const LAS f32x4*)(hss + (bj * 256 + rl) * 4);
                        const float hn = rsqrtf(((hv[0] + hv[1]) + (hv[2] + hv[3])) * (1.0f / 128.0f) + EPS);
                        f32x4 x1 = acc[ai][bj][m][0] * hn * gv[0], x2 = acc[ai][bj][m][1] * hn * gv[1];
                        if (wc == 0) { const f32x4 o1 = x1 * cs - x2 * sn, o2 = x2 * cs + x1 * sn; x1 = o1; x2 = o2; }
                        x1 = x1 * osc; x2 = x2 * osc;
                        const int cl = bj * 128 + wc * 32 + 4 * fq;
                        if (pn < 4) { bf16* qp = Q + (size_t)r * 1024 + pn * 256 + cl;
                            *(v2u*)qp = (v2u){pk2(x1[0], x1[1]), pk2(x1[2], x1[3])}; *(v2u*)(qp + 16) = (v2u){pk2(x2[0], x2[1]), pk2(x2[2], x2[3])}; }
                        else { bf16* kp = K + (size_t)r * 256 + cl;
                            *(v2u*)kp = (v2u){pk2(x1[0], x1[1]), pk2(x1[2], x1[3])}; *(v2u*)(kp + 16) = (v2u){pk2(x2[0], x2[1]), pk2(x2[2], x2[3])};
                            if (samp && !pad) { float* o = ksn + (size_t)(r - SROW0) * 256 + cl; *(f32x4*)o = x1; *(f32x4*)(o + 16) = x2; }
                            else if (!samp && t >= TT - 128) { float* o = out_pk + ((size_t)(b * 128 + (t - (TT - 128))) * 256) + cl; *(f32x4*)o = x1; *(f32x4*)(o + 16) = x2; } }
                    }
                }
        } else if (pn == 5) {
#pragma unroll
            for (int ai = 0; ai < 2; ++ai)
#pragma unroll
                for (int m = 0; m < 4; ++m) {
                    const int rl = ai * 128 + wr * 64 + m * 16 + fr, r = u.pm * 256 + rl;
                    const bool samp = r >= SROW0, pad = r >= MR;
                    const int b = (r >= TT && !samp) ? 1 : 0, t = r - b * TT;
                    const int tpos = (t & ~15) + perm16(t & 15);
#pragma unroll
                    for (int bj = 0; bj < 2; ++bj)
#pragma unroll
                        for (int n = 0; n < 2; ++n) { const f32x4 x = acc[ai][bj][m][n]; const int d = wc * 32 + n * 16 + 4 * fq;
                            if (!samp) { bf16* vp = VT + ((size_t)((b * 2 + bj) * 128 + d)) * TPV + tpos;
#pragma unroll
                                for (int j = 0; j < 4; ++j) vp[(size_t)j * TPV] = (bf16)(pk2(x[j], 0.f) & 0xffffu);
                                if (t >= TT - 128) *(f32x4*)(out_pv + ((size_t)(b * 128 + (t - (TT - 128))) * 256) + bj * 128 + d) = x; }
                            else if (!pad) *(f32x4*)(vsn + (size_t)(r - SROW0) * 256 + bj * 128 + d) = x; }
                }
        } else {
            float* dst = (pn < 8) ? U + (pn - 6) * 256 : XP + (pn - 8) * 256;
#pragma unroll
            for (int ai = 0; ai < 2; ++ai)
#pragma unroll
                for (int m = 0; m < 4; ++m) { float* rp = dst + (size_t)(u.pm * 256 + ai * 128 + wr * 64 + m * 16 + fr) * 512 + wc * 32 + 4 * fq;
#pragma unroll
                    for (int bj = 0; bj < 2; ++bj)
#pragma unroll
                        for (int n = 0; n < 2; ++n) *(f32x4*)(rp + bj * 128 + n * 16) = acc[ai][bj][m][n]; }
        }
    }
};

struct EpiRes {
    static constexpr bool PERM = false, AFTER_DRAIN = false;
    float* X; bf16* XB; float* ssq; float* out; int last;
    __device__ __forceinline__ void operator()(f32x4 (&acc)[2][2][4][2], const pg8::Unit& u, int wr, int wc, int fr, int fq, LAS unsigned char* esc, int tid) const {
        asm volatile("" : "+v"(fr), "+v"(fq), "+v"(tid));
#pragma unroll
        for (int ai = 0; ai < 2; ++ai)
#pragma unroll
            for (int m = 0; m < 4; ++m) {
                const int r = u.pm * 256 + ai * 128 + wr * 64 + m * 16 + fr; const int c0 = u.pn * 256 + wc * 32 + 4 * fq;
                float* xp = X + (size_t)r * DM + c0; float s = 0.f;
                f32x4 v[2][2];
#pragma unroll
                for (int bj = 0; bj < 2; ++bj)
#pragma unroll
                    for (int n = 0; n < 2; ++n) { v[bj][n] = *(const f32x4*)(xp + bj * 128 + n * 16) + acc[ai][bj][m][n]; const f32x4 q = v[bj][n] * v[bj][n]; s += (q[0] + q[1]) + (q[2] + q[3]); }
                if (!last) {
                    bf16* bp = XB + (size_t)r * DM + c0;
#pragma unroll
                    for (int bj = 0; bj < 2; ++bj)
#pragma unroll
                        for (int n = 0; n < 2; ++n) { *(f32x4*)(xp + bj * 128 + n * 16) = v[bj][n]; *(v2u*)(bp + bj * 128 + n * 16) = (v2u){pk2(v[bj][n][0], v[bj][n][1]), pk2(v[bj][n][2], v[bj][n][3])}; }
                    s += __shfl_xor(s, 16); s += __shfl_xor(s, 32);
                    if (fq == 0) ssq[(size_t)r * 32 + u.pn * 4 + wc] = s;
                } else {
                    const bool samp = r >= SROW0, pad = r >= MR; const int b = (r >= TT && !samp) ? 1 : 0, t = r - b * TT;
                    float* op = nullptr;
                    if (samp) { if (!pad) op = out + O_YS + (size_t)(r - SROW0) * DM + c0; } else if (t >= NMETA) op = out + O_YP + ((size_t)b * NSEQ + (t - NMETA)) * DM + c0;
                    if (op) {
#pragma unroll
                        for (int bj = 0; bj < 2; ++bj)
#pragma unroll
                            for (int n = 0; n < 2; ++n) *(f32x4*)(op + bj * 128 + n * 16) = v[bj][n]; }
                }
                if (m & 1) asm volatile("" ::: "memory");
            }
    }
};

struct EpiFfn1 {
    static constexpr bool PERM = true, AFTER_DRAIN = false;
    const float* ssq; bf16* H;
    __device__ __forceinline__ void operator()(f32x4 (&acc)[2][2][4][2], const pg8::Unit& u, int wr, int wc, int fr, int fq, LAS unsigned char* esc, int tid) const {
        asm volatile("" : "+v"(fr), "+v"(fq), "+v"(tid));
        build_rs(ssq, u.pm, esc, tid);
        const LAS float* rsT = (const LAS float*)esc;
#pragma unroll
        for (int ai = 0; ai < 2; ++ai)
#pragma unroll
            for (int m = 0; m < 4; ++m) { const int rl = ai * 128 + wr * 64 + m * 16 + fr; const float rsv = rsT[rl];
                bf16* rowp = H + (size_t)(u.pm * 256 + rl) * DFF + u.pn * 256 + wc * 32 + 8 * fq;
#pragma unroll
                for (int bj = 0; bj < 2; ++bj) { f32x4 v0 = acc[ai][bj][m][0] * rsv, v1 = acc[ai][bj][m][1] * rsv;
#pragma unroll
                    for (int j = 0; j < 4; ++j) { const float a = fmaxf(v0[j], 0.f), b = fmaxf(v1[j], 0.f); v0[j] = a * a; v1[j] = b * b; }
                    *(v4u*)(rowp + bj * 128) = (v4u){pk2(v0[0], v0[1]), pk2(v0[2], v0[3]), pk2(v1[0], v1[1]), pk2(v1[2], v1[3])}; } }
    }
};

#define XB_TMO      128
#define XB_XCNT(j)  (256  + 64 * (j))
#define XB_XSUB(j)  (1280 + 64 * (j))
#define XB_XGEN(j)  (2304 + 64 * (j))
#define XB_TOP      3328
#define XB_TOPGEN   3392
#define XCD_BAR_WORDS 3456
#define XB_SPIN_CAP (1u << 18)
__device__ __forceinline__ unsigned xb_ld(unsigned* p)              { return __hip_atomic_load(p, __ATOMIC_RELAXED, __HIP_MEMORY_SCOPE_AGENT); }
__device__ __forceinline__ unsigned xb_add(unsigned* p, unsigned v) { return __hip_atomic_fetch_add(p, v, __ATOMIC_RELAXED, __HIP_MEMORY_SCOPE_AGENT); }
__device__ __forceinline__ unsigned xb_xcc_id() { return (unsigned)__builtin_amdgcn_s_getreg((3 << 11) | 20) & 0xFu; }
#define XB_SPIN(cond, bar) do { unsigned _sp = 0; while (cond) { __builtin_amdgcn_s_sleep(1); \
    if ((++_sp & 255u) == 0u) { if (xb_ld(&(bar)[XB_TMO])) break; if (_sp > XB_SPIN_CAP) { atomicAdd(&(bar)[XB_TMO], 1u); break; } } } } while (0)

struct XcdBarrier {
    unsigned* bar; unsigned x;
    volatile LAS unsigned* st;
};

__device__ __forceinline__ XcdBarrier xcd_barrier_post(unsigned* bar, volatile LAS unsigned* st) {
    XcdBarrier b; b.bar = bar; b.x = xb_xcc_id(); b.st = st;
    if (threadIdx.x == 0) (void)xb_add(&bar[XB_XCNT(b.x)], 1u);
    return b;
}
__device__ __forceinline__ void xcd_barrier_complete(unsigned* bar, unsigned x, unsigned& nloc, unsigned& nx) {
    const unsigned G = gridDim.x * gridDim.y * gridDim.z;
    unsigned sum, cnt, mine, sp = 0u;
    for (;;) {
        sum = 0u; cnt = 0u; mine = 0u;
#pragma unroll
        for (unsigned j = 0; j < 16; ++j) { const unsigned c = xb_ld(&bar[XB_XCNT(j)]); sum += c; cnt += (c > 0u) ? 1u : 0u; mine = (j == x) ? c : mine; }
        if (sum == G) break;
        __builtin_amdgcn_s_sleep(1);
        if ((++sp & 255u) == 0u) { if (xb_ld(&bar[XB_TMO])) break; if (sp > XB_SPIN_CAP) { atomicAdd(&bar[XB_TMO], 1u); break; } }
    }
    nloc = mine > 0u ? mine : 1u; nx = cnt > 0u ? cnt : 1u;
}

__device__ __forceinline__ void xcd_barrier(const XcdBarrier& b) {
    asm volatile("s_waitcnt vmcnt(0)" ::: "memory");
    __syncthreads();
    if (threadIdx.x == 0) {
        unsigned* bar = b.bar;
        __builtin_amdgcn_s_waitcnt(0);
        unsigned nloc = b.st[0], nx = b.st[1];
        if (nloc == 0u) { xcd_barrier_complete(bar, b.x, nloc, nx); b.st[0] = nloc; b.st[1] = nx; }
        const unsigned old = xb_add(&bar[XB_XSUB(b.x)], 1u);
        const unsigned gen = old / nloc;
        if (old + 1u == (gen + 1u) * nloc) {
            __builtin_amdgcn_fence(__ATOMIC_RELEASE, "agent");
            asm volatile("s_waitcnt vmcnt(0)" ::: "memory");
            const unsigned og = xb_add(&bar[XB_TOP], 1u);
            const unsigned tg = og / nx;
            if (og + 1u == (tg + 1u) * nx) xb_add(&bar[XB_TOPGEN], 1u);
            else XB_SPIN(xb_ld(&bar[XB_TOPGEN]) == tg, bar);
            __builtin_amdgcn_fence(__ATOMIC_ACQUIRE, "agent");
            xb_add(&bar[XB_XGEN(b.x)], 1u);
            asm volatile("s_waitcnt vmcnt(0)" ::: "memory");
        } else {
            XB_SPIN(xb_ld(&bar[XB_XGEN(b.x)]) == gen, bar);
            __builtin_amdgcn_fence(__ATOMIC_ACQUIRE, "agent");
            asm volatile("s_waitcnt vmcnt(0)" ::: "memory");
        }
    }
    __syncthreads();
}

struct Frame {
    LAS unsigned char* lds;
    volatile LAS unsigned* MISC;
    gu32* ctl;
    int tid, lane, wave, vcu, G;
    float* out; unsigned char* ws;
};
#define IN_XPROMPT 0
#define IN_XSAMPLE 1
#define IN_CACHEK 2
#define IN_CACHEV 3
#define IN_SSMRE 4
#define IN_SSMIM 5
#define IN_SPOOL 6
#define IN_META 7
#define IN_GMIX 8
#define IN_WIN 9
#define IN_GQ 10
#define IN_GK 11
#define IN_SINKS 12
#define IN_ARE 13
#define IN_AIM 14
#define IN_LOGDT 15
#define IN_BRE 16
#define IN_BIM 17
#define IN_CRE 18
#define IN_CIM 19
#define IN_DSKIP 20
#define IN_WGLU 21
#define IN_BGLU 22
#define IN_WPOOL 23
#define IN_PSCALE 24
#define IN_GOA 25
#define IN_GOS 26
#define IN_GOP 27
#define IN_WOUT 28
#define IN_GFFN 29
#define IN_WFF1 30
#define IN_WFF2 31
struct Args { const float* in[32]; float* out; unsigned char* ws; int ph_lo, ph_hi; };
static_assert(sizeof(Args) == 32 * 8 + 8 + 8 + 8, "Args has no padding");

__device__ __forceinline__ void p0_transpose_item(const float* W, int K, int N, bf16* WT, const float* gain, LAS float* scr, int item, int lane) {
    const int nblk = N / 32, kb = item / nblk, nb = item % nblk, k0 = 64 * kb, n0 = 32 * nb;
#pragma unroll 8
    for (int i = 0; i < 32; ++i) { const int kk = 2 * i + (lane >> 5); float v = W[(size_t)(k0 + kk) * N + n0 + (lane & 31)]; if (gain) v *= gain[k0 + kk]; scr[kk * 33 + (lane & 31)] = v; }
    LDS_WAIT(); asm volatile("" ::: "memory");
    const int c = lane & 7;
#pragma unroll
    for (int j = 0; j < 4; ++j) { const int n = (lane >> 3) + 8 * j; const LAS float* s = scr + (8 * c) * 33 + n;
        v4u o; o.x = pk2(s[0 * 33], s[1 * 33]); o.y = pk2(s[2 * 33], s[3 * 33]); o.z = pk2(s[4 * 33], s[5 * 33]); o.w = pk2(s[6 * 33], s[7 * 33]);
        *(GAS v4u*)(WT + (size_t)(n0 + n) * K + k0 + 8 * c) = o; }
    LDS_WAIT(); asm volatile("" ::: "memory");
}
__device__ __forceinline__ void sincos_d(double x, double& s, double& c) {
    const double TWO_PI = 6.283185307179586476925286766559;
    const double k = rint(x * (1.0 / TWO_PI)); const double r = fma(-k, TWO_PI, x), r2 = r * r;
    const double fs[14] = {0.16666666666666666, 0.05, 0.023809523809523808, 0.013888888888888888, 0.00909090909090909, 0.00641025641025641, 0.004761904761904762, 0.003676470588235294,
                           0.0029239766081871343, 0.002380952380952381, 0.001976284584980237, 0.0016666666666666668, 0.0014245014245014246, 0.0012315270935960591};
    const double fc[14] = {0.5, 0.08333333333333333, 0.03333333333333333, 0.017857142857142856, 0.011111111111111112, 0.007575757575757576, 0.005494505494505495, 0.004166666666666667,
                           0.0032679738562091504, 0.002631578947368421, 0.0021645021645021645, 0.0018115942028985507, 0.0015384615384615385, 0.0013227513227513227};
    double ts = r, tc = 1.0; s = r; c = 1.0;
#pragma unroll
    for (int i = 0; i < 14; ++i) { ts *= -r2 * fs[i]; s += ts; tc *= -r2 * fc[i]; c += tc; }
}
__device__ __forceinline__ double exp_small(double x) {
    double t = 1.0, e = 1.0;
#pragma unroll
    for (int i = 1; i <= 14; ++i) { t *= x * (1.0 / i); e += t; }
    return e;
}
__device__ __forceinline__ void p0_prologue(const Args& AR, Frame& F) {
    LAS float* scr = (LAS float*)(F.lds + F.wave * 16384);
    const int gw = F.vcu * 8 + F.wave, NGW = F.G * 8, lane = F.lane;
    unsigned char* ws = F.ws;
    constexpr int I_IN = (DM / 64) * (INW / 32), I_OUT = (DM / 64) * (DM / 32), I_1 = (DM / 64) * (DFF / 32), I_2 = (DFF / 64) * (DM / 32), I_GLU = (512 / 64) * (512 / 32), I_POOL = 4 * 2 * 4;
    constexpr int I_LAYER = I_IN + I_OUT + I_1 + I_2 + I_GLU + I_POOL;
    for (int it = gw; it < NLAYER * I_LAYER; it += NGW) {
        const int l = it / I_LAYER; int r = it % I_LAYER;
        if (r < I_IN) { p0_transpose_item(AR.in[IN_WIN] + (size_t)l * DM * INW, DM, INW, (bf16*)(ws + WS_WIN) + (size_t)l * INW * DM, AR.in[IN_GMIX] + l * DM, scr, r, lane); continue; } r -= I_IN;
        if (r < I_OUT) { const int k0 = 64 * (r / (DM / 32));
            const float* g = (k0 < 1024) ? AR.in[IN_GOA] + l * 1024 : (k0 < 1536) ? AR.in[IN_GOS] + l * 512 - 1024 : AR.in[IN_GOP] + l * 512 - 1536;
            p0_transpose_item(AR.in[IN_WOUT] + (size_t)l * DM * DM, DM, DM, (bf16*)(ws + WS_WOUT) + (size_t)l * DM * DM, g, scr, r, lane); continue; } r -= I_OUT;
        if (r < I_1) { p0_transpose_item(AR.in[IN_WFF1] + (size_t)l * DM * DFF, DM, DFF, (bf16*)(ws + WS_W1) + (size_t)l * DFF * DM, AR.in[IN_GFFN] + l * DM, scr, r, lane); continue; } r -= I_1;
        if (r < I_2) { p0_transpose_item(AR.in[IN_WFF2] + (size_t)l * DFF * DM, DFF, DM, (bf16*)(ws + WS_W2) + (size_t)l * DM * DFF, nullptr, scr, r, lane); continue; } r -= I_2;
        if (r < I_GLU) { p0_transpose_item(AR.in[IN_WGLU] + (size_t)l * 512 * 512, 512, 512, (bf16*)(ws + WS_WGLU) + (size_t)l * 512 * 512, nullptr, scr, r, lane); continue; } r -= I_GLU;
        { const int g = r / 8; p0_transpose_item(AR.in[IN_WPOOL] + ((size_t)l * 4 + g) * 128 * 128, 128, 128, (bf16*)(ws + WS_WPOOL) + ((size_t)l * 4 + g) * 128 * 128, nullptr, scr, r % 8, lane); }
    }
    float* X = (float*)(ws + WS_X); bf16* XB = (bf16*)(ws + WS_XB); float* SSQ = (float*)(ws + WS_SSQ);
    for (int m = gw; m < MP; m += NGW) {
        const float* src = nullptr;
        if (m < SROW0) { const int b = m >= TT ? 1 : 0, t = m - b * TT; src = (t < NMETA) ? AR.in[IN_META] + (size_t)t * DM : AR.in[IN_XPROMPT] + ((size_t)b * NSEQ + (t - NMETA)) * DM; }
        else if (m < MR) src = AR.in[IN_XSAMPLE] + (size_t)(m - SROW0) * DM;
        float s = 0.f;
#pragma unroll
        for (int j = 0; j < 8; ++j) { f32x4 v = {0.f, 0.f, 0.f, 0.f}; if (src) v = *(const f32x4*)(src + j * 256 + lane * 4);
            s += (v[0] * v[0] + v[1] * v[1]) + (v[2] * v[2] + v[3] * v[3]);
            *(f32x4*)(X + (size_t)m * DM + j * 256 + lane * 4) = v; *(v2u*)(XB + (size_t)m * DM + j * 256 + lane * 4) = (v2u){pk2(v[0], v[1]), pk2(v[2], v[3])}; }
        s = wave_sum(s);
        if (lane < 32) SSQ[(size_t)m * 32 + lane] = (lane == 0) ? s : 0.f;
    }
    const int gt = gw * 64 + lane, NGT = NGW * 64;
    for (int id = gt; id < NLAYER * 32 * 64; id += NGT) {
        const int l = id >> 11, g = (id >> 6) & 31, n = id & 63;
        unsigned char* tb = ws + WS_TAB + (size_t)l * TB_LAYER;
        const double dt = (double)expf(AR.in[IN_LOGDT][l * 32 + g]);
        const double ar = (double)AR.in[IN_ARE][id], ai = (double)AR.in[IN_AIM][id];
        const double mag = exp_small(dt * ar); double sn, cs; sincos_d(dt * ai, sn, cs);
        const double abr = mag * cs, abi = mag * sn, den = ar * ar + ai * ai;
        const double fr = ((abr - 1.0) * ar + abi * ai) / den, fi = (abi * ar - (abr - 1.0) * ai) / den;
        ((float*)(tb + TB_ABR))[g * 64 + n] = (float)abr; ((float*)(tb + TB_ABI))[g * 64 + n] = (float)abi;
        const float* Br = AR.in[IN_BRE] + (size_t)id * 16; const float* Bi = AR.in[IN_BIM] + (size_t)id * 16;
        float* bbr = (float*)(tb + TB_BBR) + (size_t)(g * 64 + n) * 16; float* bbi = (float*)(tb + TB_BBI) + (size_t)(g * 64 + n) * 16;
#pragma unroll
        for (int c = 0; c < 16; ++c) { const double br = Br[c], bi = Bi[c]; bbr[c] = (float)(fr * br - fi * bi); bbi[c] = (float)(fr * bi + fi * br); }
        bf16* Pm = (bf16*)(tb + TB_PM) + (size_t)g * 64 * 128;
        double pr = abr, pi = abi;
        for (int t = 0; t < 64; ++t) {
            Pm[t * 128 + n] = (bf16)(pk2((float)pr, 0.f) & 0xffffu); Pm[t * 128 + 64 + n] = (bf16)(pk2((float)pi, 0.f) & 0xffffu);
            if (t == 15) { ((float*)(tb + TB_A16R))[g * 64 + n] = (float)pr; ((float*)(tb + TB_A16I))[g * 64 + n] = (float)pi; }
            if (t == 31) { ((float*)(tb + TB_A32R))[g * 64 + n] = (float)pr; ((float*)(tb + TB_A32I))[g * 64 + n] = (float)pi; }
            if (t == 63) { ((float*)(tb + TB_ALR))[g * 64 + n] = (float)pr; ((float*)(tb + TB_ALI))[g * 64 + n] = (float)pi; }
            const double nr = pr * abr - pi * abi, ni = pr * abi + pi * abr; pr = nr; pi = ni;
        }
        bf16* CmT = (bf16*)(tb + TB_CMT) + (size_t)g * 16 * 128;
        const float* Cr = AR.in[IN_CRE] + ((size_t)(l * 32 + g) * 16) * 64 + n; const float* Ci = AR.in[IN_CIM] + ((size_t)(l * 32 + g) * 16) * 64 + n;
#pragma unroll
        for (int c = 0; c < 16; ++c) { CmT[c * 128 + n] = (bf16)(pk2(Cr[c * 64], 0.f) & 0xffffu); CmT[c * 128 + 64 + n] = (bf16)(pk2(-Ci[c * 64], 0.f) & 0xffffu); }
    }
    float* rc = (float*)(ws + WS_ROPE); float* rs_ = rc + ROPE_N;
    for (int id = gt; id < (int)ROPE_N; id += NGT) {
        const int p = id >> 4, i = id & 15; const double pos = (p == ROPE_SAMPLE_IDX) ? 16384.0 : (double)p;
        double inv = 1.0;
        for (int k = 0; k < i; ++k) inv *= 0.44036660267178046;
        double sn, cs; sincos_d(pos * inv, sn, cs);
        rc[id] = (float)cs; rs_[id] = (float)sn;
    }
}

__device__ __forceinline__ void attn_unit(const Args& AR, Frame& F, int l, int b, int i) {
    int lane_ = F.lane; asm volatile("" : "+v"(lane_));
    unsigned char* ws = F.ws; asm volatile("" : "+s"(ws));
    const int lane = lane_, h = F.wave, c = lane & 31, hh = lane >> 5, kvh = h >> 2;
    const int t0 = 32 * i; const size_t rb = (size_t)b * TT;
    const bf16* Q = (const bf16*)(ws + WS_Q); const bf16* K = (const bf16*)(ws + WS_K); const bf16* VT = (const bf16*)(ws + WS_VT);
    bf16* MIX = (bf16*)(ws + WS_MIX);
    LAS float* ex = (LAS float*)(F.lds + ESC_OFF);
    bf16x8 qf[8];
    { const bf16* qp = Q + (rb + t0 + c) * 1024 + 128 * h + 8 * hh;
#pragma unroll
      for (int ks = 0; ks < 8; ++ks) qf[ks] = *(const bf16x8*)(qp + 16 * ks); }
    const int kt0 = (t0 >= 128) ? 0 : (4 - i);
    f32x16 S[5];
#pragma unroll
    for (int kt = 0; kt < 5; ++kt) {
#pragma unroll
        for (int r = 0; r < 16; ++r) S[kt][r] = -INFINITY;
        if (kt >= kt0) {
            const int tk0 = t0 - 128 + 32 * kt;
            const bf16* kp = K + (rb + tk0 + c) * 256 + 128 * kvh + 8 * hh;
            bf16x8 kf[8];
#pragma unroll
            for (int ks = 0; ks < 8; ++ks) kf[ks] = *(const bf16x8*)(kp + 16 * ks);
            f32x16 a = {0.f, 0.f, 0.f, 0.f, 0.f, 0.f, 0.f, 0.f, 0.f, 0.f, 0.f, 0.f, 0.f, 0.f, 0.f, 0.f};
#pragma unroll
            for (int ks = 0; ks < 8; ++ks) a = __builtin_amdgcn_mfma_f32_32x32x16_bf16(kf[ks], qf[ks], a, 0, 0, 0);
#pragma unroll
            for (int r = 0; r < 16; ++r) { const int kr = (r & 3) + 8 * (r >> 2) + 4 * hh; bool ok = true;
                if (kt == 0) ok = kr >= c;
                if (kt == 4) ok = kr <= c;
                S[kt][r] = ok ? a[r] : -INFINITY; }
        }
    }
    const float sink2 = AR.in[IN_SINKS][l * 8 + h] * LOG2E;
    float mx = sink2;
#pragma unroll
    for (int kt = 0; kt < 5; ++kt)
#pragma unroll
        for (int r = 0; r < 16; ++r) mx = fmaxf(mx, S[kt][r]);
    mx = fmaxf(mx, __shfl_xor(mx, 32));
    float sum = 0.f;
#pragma unroll
    for (int kt = 0; kt < 5; ++kt)
#pragma unroll
        for (int r = 0; r < 16; ++r) { const float p = __builtin_amdgcn_exp2f(S[kt][r] - mx); S[kt][r] = p; sum += p; }
    sum += __shfl_xor(sum, 32);
    const float inv = 1.0f / (sum + __builtin_amdgcn_exp2f(sink2 - mx));
    f32x16 O[4];
#pragma unroll
    for (int db = 0; db < 4; ++db)
#pragma unroll
        for (int r = 0; r < 16; ++r) O[db][r] = 0.f;
#pragma unroll
    for (int kt = 0; kt < 5; ++kt) {
        if (kt >= kt0) {
            const int tk0 = t0 - 128 + 32 * kt;
#pragma unroll
            for (int s = 0; s < 2; ++s) {
                v4u pw; pw.x = pk2(S[kt][8 * s + 0], S[kt][8 * s + 1]); pw.y = pk2(S[kt][8 * s + 2], S[kt][8 * s + 3]); pw.z = pk2(S[kt][8 * s + 4], S[kt][8 * s + 5]); pw.w = pk2(S[kt][8 * s + 6], S[kt][8 * s + 7]);
                const bf16x8 pf = __builtin_bit_cast(bf16x8, pw);
#pragma unroll
                for (int db = 0; db < 4; ++db) {
                    const bf16x8 vf = *(const bf16x8*)(VT + ((size_t)((b * 2 + kvh) * 128 + 32 * db + c)) * TPV + tk0 + 16 * s + 8 * hh);
                    O[db] = __builtin_amdgcn_mfma_f32_32x32x16_bf16(vf, pf, O[db], 0, 0, 0);
                }
            }
        }
    }
    float ss = 0.f;
#pragma unroll
    for (int db = 0; db < 4; ++db)
#pragma unroll
        for (int r = 0; r < 16; ++r) { O[db][r] *= inv; ss += O[db][r] * O[db][r]; }
    ss += __shfl_xor(ss, 32);
    if (hh == 0) ex[h * 32 + c] = ss;
    WG_BAR();
    float tot = 0.f;
#pragma unroll
    for (int j = 0; j < 8; ++j) tot += ex[j * 32 + c];
    const float rsa = rsqrtf(tot * (1.0f / 1024.0f) + EPS);
    if (t0 + c < TT) {
        bf16* mp = MIX + (rb + t0 + c) * DM + 128 * h + 4 * hh;
#pragma unroll
        for (int db = 0; db < 4; ++db)
#pragma unroll
            for (int g4 = 0; g4 < 4; ++g4)
                *(v2u*)(mp + 32 * db + 8 * g4) = (v2u){pk2(O[db][4 * g4 + 0] * rsa, O[db][4 * g4 + 1] * rsa), pk2(O[db][4 * g4 + 2] * rsa, O[db][4 * g4 + 3] * rsa)};
    }
    WG_BAR();
}

__device__ __forceinline__ void sattn_unit(const Args& AR, Frame& F, int l, int s) {
    int tid_ = F.tid; asm volatile("" : "+v"(tid_));
    const int tid = tid_, lane = tid & 63, wave = F.wave;
    LAS float* qs = (LAS float*)F.lds;
    LAS float* sc = qs + 1024;
    LAS float* part = sc + 8 * 132;
    LAS float* red = part + 4096;
    const size_t row = SROW0 + s;
    const bf16* Q = (const bf16*)(F.ws + WS_Q) + row * 1024;
    const float* ksn = (const float*)(F.ws + WS_KSN) + (size_t)s * 256; const float* vsn = ksn + NSAMP * 256;
    const float* ck = AR.in[IN_CACHEK] + ((size_t)(l * NSAMP + s)) * 128 * 256; const float* cv = AR.in[IN_CACHEV] + ((size_t)(l * NSAMP + s)) * 128 * 256;
    for (int j = tid; j < 1024; j += 512) qs[j] = bf2f(Q[j]);
    WG_BAR();
    { const int key = tid >> 2, pt = tid & 3;
#pragma unroll
      for (int kvh = 0; kvh < 2; ++kvh) {
          const float* kp = ck + (size_t)key * 256 + kvh * 128 + 32 * pt; float d[4] = {0.f, 0.f, 0.f, 0.f};
#pragma unroll
          for (int j = 0; j < 8; ++j) { const f32x4 kv = *(const f32x4*)(kp + 4 * j);
#pragma unroll
              for (int g = 0; g < 4; ++g) { const f32x4 qv = *(const LAS f32x4*)(qs + (4 * kvh + g) * 128 + 32 * pt + 4 * j); d[g] += (kv[0] * qv[0] + kv[1] * qv[1]) + (kv[2] * qv[2] + kv[3] * qv[3]); } }
#pragma unroll
          for (int g = 0; g < 4; ++g) { d[g] += __shfl_xor(d[g], 1); d[g] += __shfl_xor(d[g], 2); if (pt == 0) sc[(4 * kvh + g) * 132 + key] = d[g]; }
      } }
    {
      const int h = wave, kvh = h >> 2; float d = ksn[kvh * 128 + lane] * qs[h * 128 + lane] + ksn[kvh * 128 + 64 + lane] * qs[h * 128 + 64 + lane];
      d = wave_sum(d); if (lane == 0) sc[h * 132 + 128] = d; }
    WG_BAR();
    { const int h = wave; const float sink2 = AR.in[IN_SINKS][l * 8 + h] * LOG2E;
      const float v0 = sc[h * 132 + lane], v1 = sc[h * 132 + 64 + lane], v2 = (lane == 0) ? sc[h * 132 + 128] : -INFINITY;
      const float mx = fmaxf(wave_max(fmaxf(fmaxf(v0, v1), v2)), sink2);
      const float p0 = __builtin_amdgcn_exp2f(v0 - mx), p1 = __builtin_amdgcn_exp2f(v1 - mx), p2 = __builtin_amdgcn_exp2f(v2 - mx);
      const float inv = 1.0f / (wave_sum(p0 + p1 + p2) + __builtin_amdgcn_exp2f(sink2 - mx));
      sc[h * 132 + lane] = p0 * inv; sc[h * 132 + 64 + lane] = p1 * inv; if (lane == 0) sc[h * 132 + 128] = p2 * inv; }
    WG_BAR();
    { const int d = tid & 127, kq = tid >> 7;
#pragma unroll
      for (int kvh = 0; kvh < 2; ++kvh) { float a[4] = {0.f, 0.f, 0.f, 0.f};
          for (int k = 0; k < 32; ++k) { const int key = 32 * kq + k; const float v = cv[(size_t)key * 256 + kvh * 128 + d];
#pragma unroll
              for (int g = 0; g < 4; ++g) a[g] += sc[(4 * kvh + g) * 132 + key] * v; }
#pragma unroll
          for (int g = 0; g < 4; ++g) part[kq * 1024 + (4 * kvh + g) * 128 + d] = a[g]; } }
    WG_BAR();
    float o[2]; float ss = 0.f;
#pragma unroll
    for (int e = 0; e < 2; ++e) { const int j = tid + 512 * e, h = j >> 7, d = j & 127, kvh = h >> 2;
        o[e] = (part[j] + part[1024 + j]) + (part[2048 + j] + part[3072 + j]) + sc[h * 132 + 128] * vsn[kvh * 128 + d]; ss += o[e] * o[e]; }
    ss = wave_sum(ss); if (lane == 0) red[wave] = ss;
    WG_BAR();
    { float tot = 0.f;
#pragma unroll
      for (int j = 0; j < 8; ++j) tot += red[j];
      const float rsa = rsqrtf(tot * (1.0f / 1024.0f) + EPS);
      bf16* mp = (bf16*)(F.ws + WS_MIX) + row * DM;
#pragma unroll
      for (int e = 0; e < 2; ++e) mp[tid + 512 * e] = (bf16)(pk2(o[e] * rsa, 0.f) & 0xffffu); }
    { float* ok = F.out + O_SK + ((size_t)(l * NSAMP + s)) * 128 * 256; float* ov = F.out + O_SV + ((size_t)(l * NSAMP + s)) * 128 * 256;
      for (int j = tid; j < 127 * 64; j += 512) { *(f32x4*)(ok + 4 * j) = *(const f32x4*)(ck + 256 + 4 * j); *(f32x4*)(ov + 4 * j) = *(const f32x4*)(cv + 256 + 4 * j); }
      if (tid < 64) *(f32x4*)(ok + 127 * 256 + 4 * tid) = *(const f32x4*)(ksn + 4 * tid);
      else if (tid < 128) *(f32x4*)(ov + 127 * 256 + 4 * (tid - 64)) = *(const f32x4*)(vsn + 4 * (tid - 64)); }
    WG_BAR();
}

__device__ __forceinline__ float gelu_tanh(float y) {
    const float inner = 0.7978845608028654f * (y + 0.044715f * y * y * y);
    return y / (1.0f + __builtin_amdgcn_exp2f(-2.0f * LOG2E * inner));
}
__device__ __forceinline__ float sigmoidf_(float x) { return 1.0f / (1.0f + __builtin_amdgcn_exp2f(-LOG2E * x)); }
#define SWZ(r, ch, PITCH) ((r) * (PITCH) + ((((ch)) ^ ((r) & 15)) << 4))

__device__ __forceinline__ void ssm_unit(const Args& AR, Frame& F, int l, int c) {
    int lane_ = F.lane; asm volatile("" : "+v"(lane_));
    const int lane = lane_, w = F.wave, n = lane, t16 = lane & 15, cq = lane >> 4;
    const int row0 = 64 * c;
    unsigned char* ws = F.ws; asm volatile("" : "+s"(ws));
    const unsigned char* tb = ws + WS_TAB + (size_t)l * TB_LAYER;
    const float* U = (const float*)(ws + WS_U);
    float* SST = (float*)(ws + WS_SST) + ((size_t)l * NCHUNK) * 32 * 128;
    gu32* flags = F.ctl + CW_SSMF + (size_t)(l * NCHUNK) * 8 * 16;
    LAS unsigned char* myl = F.lds + w * 12288;
    LAS unsigned char* Hm = myl; LAS unsigned char* CHt = myl + 8192;
    const int rr = (c == 64) ? 16 : (c == 128) ? 32 : 64;
    f32x4 Y[4][4];
    float eR[4], eI[4];
#pragma unroll
    for (int gi = 0; gi < 4; ++gi) { eR[gi] = 0.f; eI[gi] = 0.f;
#pragma unroll
        for (int mt = 0; mt < 4; ++mt) Y[gi][mt] = (f32x4){0.f, 0.f, 0.f, 0.f}; }
#ifndef NO_P1
#pragma unroll
    for (int gi = 0; gi < 4; ++gi) {
        asm volatile("" ::: "memory");
        const int g = 4 * w + gi;
        const float abr = ((const float*)(tb + TB_ABR))[g * 64 + n], abi = ((const float*)(tb + TB_ABI))[g * 64 + n];
        float bbr[16], bbi[16];
        { const f32x4* pr = (const f32x4*)((const float*)(tb + TB_BBR) + (size_t)(g * 64 + n) * 16); const f32x4* pi = (const f32x4*)((const float*)(tb + TB_BBI) + (size_t)(g * 64 + n) * 16);
#pragma unroll
          for (int j = 0; j < 4; ++j) { const f32x4 a = pr[j], b2 = pi[j];
#pragma unroll
              for (int e = 0; e < 4; ++e) { bbr[4 * j + e] = a[e]; bbi[4 * j + e] = b2[e]; } } }
        float uu[16];
        { const f32x4* pu = (const f32x4*)(U + (size_t)(row0 + lane) * 512 + 16 * g);
#pragma unroll
          for (int j = 0; j < 4; ++j) { const f32x4 a = pu[j];
#pragma unroll
              for (int e = 0; e < 4; ++e) uu[4 * j + e] = a[e]; } }
        bf16x8 cmf[4];
        { const bf16* cm = (const bf16*)(tb + TB_CMT) + (size_t)g * 16 * 128 + t16 * 128 + 8 * cq;
#pragma unroll
          for (int ks = 0; ks < 4; ++ks) cmf[ks] = *(const bf16x8*)(cm + 32 * ks); }
        float hr = 0.f, hi = 0.f;
#pragma unroll
        for (int half = 0; half < 2; ++half) {
#pragma unroll 1
            for (int r = 32 * half; r < 32 * half + 32; ++r) {
                if (c == 64 && r == 16) { hr = 0.f; hi = 0.f; }
                if (c == 128 && r >= 32) { const size_t o = ((size_t)(l * NSAMP + (r - 32)) * 32 + g) * 64 + n; hr = AR.in[IN_SSMRE][o]; hi = AR.in[IN_SSMIM][o]; }
                float xr = 0.f, xi = 0.f;
#pragma unroll
                for (int cc = 0; cc < 16; ++cc) { const float uv = __builtin_bit_cast(float, __builtin_amdgcn_readlane(__builtin_bit_cast(int, uu[cc]), r)); xr += bbr[cc] * uv; xi += bbi[cc] * uv; }
                const float nr = abr * hr - abi * hi + xr, ni = abr * hi + abi * hr + xi; hr = nr; hi = ni;
                const int rl = r & 31;
                *(LAS bf16*)(Hm + SWZ(rl, n >> 3, 256) + (n & 7) * 2) = (bf16)(pk2(hr, 0.f) & 0xffffu);
                *(LAS bf16*)(Hm + SWZ(rl, 8 + (n >> 3), 256) + (n & 7) * 2) = (bf16)(pk2(hi, 0.f) & 0xffffu);
                if ((c == 64 && r == 15) || (c == 128 && r == 31)) { eR[gi] = hr; eI[gi] = hi; }
                if (c == 128 && r >= 32) { const size_t o = ((size_t)(l * NSAMP + (r - 32)) * 32 + g) * 64 + n; F.out[O_SSR + o] = hr; F.out[O_SSI + o] = hi; }
            }
            LDS_WAIT();
#pragma unroll
            for (int mt = 0; mt < 2; ++mt)
#pragma unroll
                for (int ks = 0; ks < 4; ++ks) { const bf16x8 hf = *(const LAS bf16x8*)(Hm + SWZ(16 * mt + t16, 4 * ks + cq, 256));
                    Y[gi][2 * half + mt] = __builtin_amdgcn_mfma_f32_16x16x32_bf16(cmf[ks], hf, Y[gi][2 * half + mt], 0, 0, 0); }
            LDS_WAIT();
        }
        __hip_atomic_store((gu64*)(SST + ((size_t)c * 32 + g) * 128 + 2 * n), ((unsigned long long)__builtin_bit_cast(unsigned, hi) << 32) | __builtin_bit_cast(unsigned, hr), RLX_AGENT);
    }
#endif
    VM_WAIT();
    if (lane == 0) __hip_atomic_store(flags + ((size_t)c * 8 + w) * 16, 1u, RLX_AGENT);
    const int cs0 = (c <= 64) ? 0 : 64, npred = c - cs0;
#ifndef NO_P2
    if (npred > 0) {
        { unsigned sp = 0; bool ok = false;
          for (;;) { ok = (lane >= npred) || (__hip_atomic_load(flags + ((size_t)(cs0 + lane) * 8 + w) * 16, RLX_AGENT) != 0u);
              if (__all(ok)) break;
              __builtin_amdgcn_s_sleep(2);
              if (++sp > (1u << 20)) { if (lane == 0) __hip_atomic_store(F.ctl + CW_TMO, 0x55u, RLX_AGENT); break; } } }
        __builtin_amdgcn_fence(__ATOMIC_ACQUIRE, "agent");
        VM_WAIT();
#pragma unroll
        for (int gi = 0; gi < 4; ++gi) {
            asm volatile("" ::: "memory");
            const int g = 4 * w + gi;
            const float aLr = ((const float*)(tb + TB_ALR))[g * 64 + n], aLi = ((const float*)(tb + TB_ALI))[g * 64 + n];
            float Hr = 0.f, Hi = 0.f;
#pragma unroll 2
            for (int cp = cs0; cp < c; ++cp) {
                const unsigned long long sv = __hip_atomic_load((gu64*)(SST + ((size_t)cp * 32 + g) * 128 + 2 * n), RLX_AGENT);
                const float sr = __builtin_bit_cast(float, (unsigned)sv), si = __builtin_bit_cast(float, (unsigned)(sv >> 32));
                const float nr = aLr * Hr - aLi * Hi + sr, ni = aLr * Hi + aLi * Hr + si; Hr = nr; Hi = ni;
            }
            if (c == 64 || c == 128) {
                const float pr = ((const float*)(tb + (c == 64 ? TB_A16R : TB_A32R)))[g * 64 + n], pi = ((const float*)(tb + (c == 64 ? TB_A16I : TB_A32I)))[g * 64 + n];
                const size_t o = ((size_t)(l * NBATCH + (c == 64 ? 0 : 1)) * 32 + g) * 64 + n;
                F.out[O_PSR + o] = eR[gi] + pr * Hr - pi * Hi; F.out[O_PSI + o] = eI[gi] + pr * Hi + pi * Hr;
            }
            { const float* Cr = AR.in[IN_CRE] + ((size_t)(l * 32 + g) * 16) * 64 + n; const float* Ci = AR.in[IN_CIM] + ((size_t)(l * 32 + g) * 16) * 64 + n;
#pragma unroll
              for (int ch = 0; ch < 16; ++ch) { const float cr = Cr[ch * 64], ci = Ci[ch * 64];
                  *(LAS bf16*)(CHt + SWZ(ch, n >> 3, 256) + (n & 7) * 2) = (bf16)(pk2(cr * Hr - ci * Hi, 0.f) & 0xffffu);
                  *(LAS bf16*)(CHt + SWZ(ch, 8 + (n >> 3), 256) + (n & 7) * 2) = (bf16)(pk2(-(cr * Hi + ci * Hr), 0.f) & 0xffffu); } }
            LDS_WAIT();
            bf16x8 chf[4];
#pragma unroll
            for (int ks = 0; ks < 4; ++ks) chf[ks] = *(const LAS bf16x8*)(CHt + SWZ(t16, 4 * ks + cq, 256));
            const bf16* Pm = (const bf16*)(tb + TB_PM) + (size_t)g * 64 * 128 + t16 * 128 + 8 * cq;
#pragma unroll
            for (int mt = 0; mt < 4; ++mt) {
                if (16 * mt < rr) {
#pragma unroll
                    for (int ks = 0; ks < 4; ++ks) { const bf16x8 pf = *(const bf16x8*)(Pm + (size_t)mt * 16 * 128 + 32 * ks);
                        Y[gi][mt] = __builtin_amdgcn_mfma_f32_16x16x32_bf16(chf[ks], pf, Y[gi][mt], 0, 0, 0); }
                }
            }
            LDS_WAIT();
        }
    }
#endif
    LAS unsigned char* Zs = F.lds;
    LAS float* red = (LAS float*)(F.lds + ESC_OFF);
    WG_BAR();
#pragma unroll
    for (int gi = 0; gi < 4; ++gi) {
        const int col = 64 * w + 16 * gi + 4 * cq;
        const f32x4 dsk = *(const f32x4*)(AR.in[IN_DSKIP] + l * 512 + col);
#pragma unroll
        for (int mt = 0; mt < 4; ++mt) { const int rl = 16 * mt + t16;
            const f32x4 uv = *(const f32x4*)(U + (size_t)(row0 + rl) * 512 + col);
            f32x4 z;
#pragma unroll
            for (int e = 0; e < 4; ++e) z[e] = gelu_tanh(Y[gi][mt][e] + dsk[e] * uv[e]);
            Y[gi][mt] = z;
            *(LAS v2u*)(Zs + SWZ(rl, col >> 3, 1024) + (col & 7) * 2) = (v2u){pk2(z[0], z[1]), pk2(z[2], z[3])}; }
    }
    WG_BAR();
#ifndef NO_GLU
    f32x4 G[4][4];
#pragma unroll
    for (int mt = 0; mt < 4; ++mt)
#pragma unroll
        for (int nt = 0; nt < 4; ++nt) G[mt][nt] = (f32x4){0.f, 0.f, 0.f, 0.f};
    { const bf16* Wg = (const bf16*)(ws + WS_WGLU) + (size_t)l * 512 * 512 + (size_t)(64 * w + t16) * 512 + 8 * cq;
#pragma unroll 1
      for (int ks = 0; ks < 16; ++ks) {
          bf16x8 wf[4], zf[4];
#pragma unroll
          for (int nt = 0; nt < 4; ++nt) wf[nt] = *(const bf16x8*)(Wg + (size_t)nt * 16 * 512 + 32 * ks);
#pragma unroll
          for (int mt = 0; mt < 4; ++mt) zf[mt] = *(const LAS bf16x8*)(Zs + SWZ(16 * mt + t16, 4 * ks + cq, 1024));
#pragma unroll
          for (int mt = 0; mt < 4; ++mt)
#pragma unroll
              for (int nt = 0; nt < 4; ++nt) G[mt][nt] = __builtin_amdgcn_mfma_f32_16x16x32_bf16(wf[nt], zf[mt], G[mt][nt], 0, 0, 0);
      } }
#pragma unroll
    for (int mt = 0; mt < 4; ++mt) { float ss = 0.f;
#pragma unroll
        for (int nt = 0; nt < 4; ++nt) { const f32x4 bg = *(const f32x4*)(AR.in[IN_BGLU] + l * 512 + 64 * w + 16 * nt + 4 * cq);
#pragma unroll
            for (int e = 0; e < 4; ++e) { const float o = Y[nt][mt][e] * sigmoidf_(G[mt][nt][e] + bg[e]); G[mt][nt][e] = o; ss += o * o; } }
        ss += __shfl_xor(ss, 16); ss += __shfl_xor(ss, 32);
        if (cq == 0) red[(16 * mt + t16) * 8 + w] = ss; }
    WG_BAR();
    { bf16* MIX = (bf16*)(ws + WS_MIX);
#pragma unroll
      for (int mt = 0; mt < 4; ++mt) { const int rl = 16 * mt + t16; const LAS f32x4* rp = (const LAS f32x4*)(red + rl * 8); const f32x4 a = rp[0], b2 = rp[1];
          const float rsn = rsqrtf(((a[0] + a[1]) + (a[2] + a[3]) + (b2[0] + b2[1]) + (b2[2] + b2[3])) * (1.0f / 512.0f) + EPS);
          bf16* mp = MIX + (size_t)(row0 + rl) * DM + 1024 + 64 * w + 4 * cq;
#pragma unroll
          for (int nt = 0; nt < 4; ++nt) *(v2u*)(mp + 16 * nt) = (v2u){pk2(G[mt][nt][0] * rsn, G[mt][nt][1] * rsn), pk2(G[mt][nt][2] * rsn, G[mt][nt][3] * rsn)}; } }
#endif
    WG_BAR();
}

__device__ __forceinline__ void pool_unit(const Args& AR, Frame& F, int l, int c) {
    int tid_ = F.tid; asm volatile("" : "+v"(tid_));
    const int tid = tid_, lane = tid & 63, w = F.wave, t16 = lane & 15, cq = lane >> 4;
    const int row0 = 64 * c;
    unsigned char* ws = F.ws; asm volatile("" : "+s"(ws));
    const float* XP = (const float*)(ws + WS_XP);
    LAS unsigned char* Ds = F.lds;
    LAS float* red = (LAS float*)(F.lds + ESC_OFF);
    { const int ch = tid, wlen = 2 << (ch >> 7);
      const float* sp = AR.in[IN_SPOOL] + (size_t)l * NSAMP * 15 * 512 + ch;
      int seg = (row0 >= TT) ? TT : 0;
      float sum = 0.f;
      for (int j = wlen; j >= 1; --j) { const int ra = row0 - j; if (ra >= seg) sum += XP[(size_t)ra * 512 + ch]; }
      for (int r = 0; r < 64; ++r) {
          const int ra = row0 + r; const float x = XP[(size_t)ra * 512 + ch]; float dm;
          if (ra < SROW0) {
              if (ra == TT) { seg = TT; sum = 0.f; }
              sum += x;
              if (ra - wlen >= seg) sum -= XP[(size_t)(ra - wlen) * 512 + ch];
              const int cnt = (ra - seg + 1 < wlen) ? (ra - seg + 1) : wlen;
              dm = sum / (float)cnt - x;
              if (ra >= TT - 15 && ra < TT) F.out[O_PP + ((size_t)(l * NBATCH + 0) * 15 + (ra - (TT - 15))) * 512 + ch] = x;
              if (ra >= SROW0 - 15) F.out[O_PP + ((size_t)(l * NBATCH + 1) * 15 + (ra - (SROW0 - 15))) * 512 + ch] = x;
          } else {
              const int s = ra - SROW0; const float* pp = sp + (size_t)s * 15 * 512; float a = x;
              for (int j = 16 - wlen; j < 15; ++j) a += pp[(size_t)j * 512];
              dm = a / (float)wlen - x;
              float* op = F.out + O_SP + ((size_t)(l * NSAMP + s) * 15) * 512 + ch;
              for (int j = 0; j < 14; ++j) op[(size_t)j * 512] = pp[(size_t)(j + 1) * 512];
              op[(size_t)14 * 512] = x;
          }
          *(LAS bf16*)(Ds + SWZ(r, ch >> 3, 1024) + (ch & 7) * 2) = (bf16)(pk2(dm, 0.f) & 0xffffu);
      } }
    WG_BAR();
    const int gp = w & 3, rh = w >> 2;
    f32x4 A[2][8];
#pragma unroll
    for (int mt = 0; mt < 2; ++mt)
#pragma unroll
        for (int nt = 0; nt < 8; ++nt) A[mt][nt] = (f32x4){0.f, 0.f, 0.f, 0.f};
    { const bf16* Wp = (const bf16*)(ws + WS_WPOOL) + ((size_t)(l * 4 + gp) * 128 + t16) * 128 + 8 * cq;
#pragma unroll
      for (int ks = 0; ks < 4; ++ks) {
          bf16x8 df[2];
#pragma unroll
          for (int mt = 0; mt < 2; ++mt) df[mt] = *(const LAS bf16x8*)(Ds + SWZ(32 * rh + 16 * mt + t16, 16 * gp + 4 * ks + cq, 1024));
#pragma unroll
          for (int nt = 0; nt < 8; ++nt) { const bf16x8 wf = *(const bf16x8*)(Wp + (size_t)nt * 16 * 128 + 32 * ks);
#pragma unroll
              for (int mt = 0; mt < 2; ++mt) A[mt][nt] = __builtin_amdgcn_mfma_f32_16x16x32_bf16(wf, df[mt], A[mt][nt], 0, 0, 0); }
      } }
#pragma unroll
    for (int mt = 0; mt < 2; ++mt) { float ss = 0.f;
#pragma unroll
        for (int nt = 0; nt < 8; ++nt) { const f32x4 sc = *(const f32x4*)(AR.in[IN_PSCALE] + l * 512 + 128 * gp + 16 * nt + 4 * cq);
#pragma unroll
            for (int e = 0; e < 4; ++e) { const float o = A[mt][nt][e] * sc[e]; A[mt][nt][e] = o; ss += o * o; } }
        ss += __shfl_xor(ss, 16); ss += __shfl_xor(ss, 32);
        if (cq == 0) red[(32 * rh + 16 * mt + t16) * 4 + gp] = ss; }
    WG_BAR();
    { bf16* MIX = (bf16*)(ws + WS_MIX);
#pragma unroll
      for (int mt = 0; mt < 2; ++mt) { const int rl = 32 * rh + 16 * mt + t16; const f32x4 a = *(const LAS f32x4*)(red + rl * 4);
          const float rsn = rsqrtf(((a[0] + a[1]) + (a[2] + a[3])) * (1.0f / 512.0f) + EPS);
          bf16* mp = MIX + (size_t)(row0 + rl) * DM + 1536 + 128 * gp + 4 * cq;
#pragma unroll
          for (int nt = 0; nt < 8; ++nt) *(v2u*)(mp + 16 * nt) = (v2u){pk2(A[mt][nt][0] * rsn, A[mt][nt][1] * rsn), pk2(A[mt][nt][2] * rsn, A[mt][nt][3] * rsn)}; } }
    WG_BAR();
}

constexpr int N_PHASES = 1 + 5 * NLAYER;
constexpr int NU_SSM = NCHUNK, NU_ATT = NBATCH * NQB, NU_SATT = NSAMP, NU_POOL = NCHUNK, NU_B = NU_SSM + NU_ATT + NU_SATT + NU_POOL;

__global__ void __launch_bounds__(512, 2) hymba_fwd(Args args) {
    extern __shared__ __attribute__((aligned(16))) unsigned char lds[];
    Frame F;
    F.lds = (LAS unsigned char*)lds;
    F.MISC = (volatile LAS unsigned*)(F.lds + MISC_OFF);
    F.tid = threadIdx.x; F.lane = F.tid & 63; F.wave = __builtin_amdgcn_readfirstlane(F.tid >> 6);
    F.G = gridDim.x; { const int bx = blockIdx.x; F.vcu = (F.G % 8 == 0) ? (bx % 8) * (F.G / 8) + bx / 8 : bx; }
    F.ws = args.ws; F.out = args.out; F.ctl = (gu32*)(args.ws + WS_CTL);
    for (int u = F.tid; u < (LDS_BYTES - LDSCTL_OFF) / 4; u += 512) ((LAS unsigned*)(F.lds + LDSCTL_OFF))[u] = 0u;
    __syncthreads();
    XcdBarrier bar; bar.bar = (unsigned*)(F.ctl + CW_BAR); bar.x = 0; bar.st = nullptr;
    if (MK_N_LAUNCHES == 1) bar = xcd_barrier_post((unsigned*)(F.ctl + CW_BAR), F.MISC + 8);
    const int lo = args.ph_lo, hi = args.ph_hi;
#ifndef PH_MASK
#define PH_MASK 0x1ff
#endif
#define PHM(j) (((PH_MASK) >> (j)) & 1)
#define IN_PH(k) (lo <= (k) && (k) < hi)
#define SEAM(k) do { if (IN_PH(k) && IN_PH((k) + 1)) xcd_barrier(bar); } while (0)
    LAS unsigned char* ring = F.lds; LAS unsigned char* esc = F.lds + ESC_OFF;

    if (PHM(0) && IN_PH(0)) { p0_prologue(args, F); }
    SEAM(0);
    for (int l = 0; l < NLAYER; ++l) {
        const int pb = 1 + 5 * l;
        if (PHM(1) && IN_PH(pb)) {
            unsigned char* ws = args.ws; asm volatile("" : "+s"(ws)); const bf16* XB = (const bf16*)(ws + WS_XB); int Gs = F.G, bid = (int)blockIdx.x; asm volatile("" : "+s"(Gs), "+s"(bid));
            pg8::Gemm g{XB, (const bf16*)(ws + WS_WIN) + (size_t)l * INW * DM, MP, INW, DM}; pg8::StaticOrder S; S.init(MP, INW, Gs, bid);
            EpiProj E{ws, F.out, args.in[IN_GQ] + l * 128, args.in[IN_GK] + l * 128, l};
            pg8::gemm_phase<EpiProj, pg8::StaticOrder, true, true>(ring, esc, g, S, E);
        }
        SEAM(pb);
        if (IN_PH(pb + 1)) {
            for (int ui = F.vcu; ui < NU_B; ui += F.G) {
                int r = ui;
                if (r < NU_SSM) { if (PHM(2)) ssm_unit(args, F, l, r); continue; } r -= NU_SSM;
                if (r < NU_ATT) { if (PHM(3)) attn_unit(args, F, l, r / NQB, r % NQB); continue; } r -= NU_ATT;
                if (r < NU_SATT) { if (PHM(4)) sattn_unit(args, F, l, r); continue; } r -= NU_SATT;
                if (PHM(5)) pool_unit(args, F, l, r);
            }
        }
        SEAM(pb + 1);
        if (PHM(6) && IN_PH(pb + 2)) {
            unsigned char* ws = args.ws; asm volatile("" : "+s"(ws)); const bf16* XB = (const bf16*)(ws + WS_XB); int Gs = F.G, bid = (int)blockIdx.x; asm volatile("" : "+s"(Gs), "+s"(bid));
            pg8::Gemm g{(const bf16*)(ws + WS_MIX), (const bf16*)(ws + WS_WOUT) + (size_t)l * DM * DM, MP, DM, DM}; pg8::StaticOrder S; S.init(MP, DM, Gs, bid);
            EpiRes E{(float*)(ws + WS_X), (bf16*)(ws + WS_XB), (float*)(ws + WS_SSQ), F.out, 0};
            pg8::gemm_phase<EpiRes, pg8::StaticOrder, true, true>(ring, esc, g, S, E);
        }
        SEAM(pb + 2);
        if (PHM(7) && IN_PH(pb + 3)) {
            unsigned char* ws = args.ws; asm volatile("" : "+s"(ws)); const bf16* XB = (const bf16*)(ws + WS_XB); int Gs = F.G, bid = (int)blockIdx.x; asm volatile("" : "+s"(Gs), "+s"(bid));
            pg8::Gemm g{XB, (const bf16*)(ws + WS_W1) + (size_t)l * DFF * DM, MP, DFF, DM}; pg8::StaticOrder S; S.init(MP, DFF, Gs, bid);
            EpiFfn1 E{(const float*)(ws + WS_SSQ), (bf16*)(ws + WS_H)};
            pg8::gemm_phase<EpiFfn1, pg8::StaticOrder, true, true>(ring, esc, g, S, E);
        }
        SEAM(pb + 3);
        if (PHM(8) && IN_PH(pb + 4)) {
            unsigned char* ws = args.ws; asm volatile("" : "+s"(ws)); const bf16* XB = (const bf16*)(ws + WS_XB); int Gs = F.G, bid = (int)blockIdx.x; asm volatile("" : "+s"(Gs), "+s"(bid));
            pg8::Gemm g{(const bf16*)(ws + WS_H), (const bf16*)(ws + WS_W2) + (size_t)l * DM * DFF, MP, DM, DFF}; pg8::StaticOrder S; S.init(MP, DM, Gs, bid);
            EpiRes E{(float*)(ws + WS_X), (bf16*)(ws + WS_XB), (float*)(ws + WS_SSQ), F.out, (l == NLAYER - 1) ? 1 : 0};
            pg8::gemm_phase<EpiRes, pg8::StaticOrder, true, true>(ring, esc, g, S, E);
        }
        SEAM(pb + 4);
    }
#undef IN_PH
#undef SEAM
}

extern "C" void kernel_launch(void* const* d_in, const int* in_sizes, int n_in, void* d_out, int out_size, void* d_ws, size_t ws_size, hipStream_t stream) {
    static int grid = 0;
    if (grid == 0) {
        if (n_in != 32 || (size_t)out_size != O_END || ws_size < WS_END) { fprintf(stderr, "kernel_launch: unexpected shapes: n_in %d out %d (want %zu) ws %zu (want >= %zu)\n", n_in, out_size, (size_t)O_END, ws_size, (size_t)WS_END); grid = -1; return; }
        int dev = 0, cus = 0, per_cu = 0;
        if (hipGetDevice(&dev) != hipSuccess || hipDeviceGetAttribute(&cus, hipDeviceAttributeMultiprocessorCount, dev) != hipSuccess) { fprintf(stderr, "kernel_launch: device query failed\n"); grid = -1; return; }
        if (hipFuncSetAttribute((const void*)hymba_fwd, hipFuncAttributeMaxDynamicSharedMemorySize, LDS_BYTES) != hipSuccess) { fprintf(stderr, "kernel_launch: hipFuncSetAttribute failed\n"); grid = -1; return; }
        if (hipOccupancyMaxActiveBlocksPerMultiprocessor(&per_cu, (const void*)hymba_fwd, 512, LDS_BYTES) != hipSuccess || per_cu < 1) { fprintf(stderr, "kernel_launch: occupancy query says %d blocks per CU\n", per_cu); per_cu = 1; }
        (void)hipGetLastError();
        grid = cus;
        if (grid % 8 != 0) grid -= grid % 8;
    }
    if (grid < 0) return;
    (void)hipMemsetAsync((char*)d_ws + WS_CTL, 0, CTL_ZERO_BYTES, stream);
    Args a{};
    for (int i = 0; i < 32; ++i) a.in[i] = (const float*)d_in[i];
    a.out = (float*)d_out; a.ws = (unsigned char*)d_ws;
    if (MK_N_LAUNCHES == 1) {
        a.ph_lo = 0; a.ph_hi = N_PHASES;
        hipLaunchKernelGGL(hymba_fwd, dim3(grid), dim3(512), LDS_BYTES, stream, a);
    } else {
        for (int p = 0; p < N_PHASES; ++p) { a.ph_lo = p; a.ph_hi = p + 1; hipLaunchKernelGGL(hymba_fwd, dim3(grid), dim3(512), LDS_BYTES, stream, a); }
    }
    const hipError_t le = hipPeekAtLastError();
    if (le != hipSuccess) fprintf(stderr, "kernel_launch: launch failed: %s\n", hipGetErrorName(le));
}
```

```cpp
#include <hip/hip_runtime.h>
#include <cstdio>
#include <cstdint>

#ifndef MK_N_LAUNCHES
#define MK_N_LAUNCHES 1
#endif

#ifndef DUP_PB
#define DUP_PB 1
#endif
#ifndef DUP_P0
#define DUP_P0 1
#endif

constexpr int DM = 2048, TT = 4112  , NSEQ = 4096, NMETA = 16, NBATCH = 2, NSAMP = 32;
constexpr int MR = NBATCH * TT + NSAMP;
constexpr int MP = 8448;
constexpr int SROW0 = NBATCH * TT;
constexpr int INW = 2560, DFF = 8192, NLAYER = 2;
constexpr int TPV = 4128;
constexpr int ROPE_SAMPLE_IDX = TT;
constexpr float EPS = 1e-6f;
constexpr float LOG2E = 1.4426950408889634f;
constexpr float QSCALE = 0.08838834764831845f * LOG2E;
constexpr int NCHUNK = MR / 64;
constexpr int NQB = (TT + 31) / 32;

constexpr size_t O_YP = 0, O_YS = O_YP + (size_t)NBATCH * NSEQ * DM, O_PK = O_YS + (size_t)NSAMP * DM, O_PV = O_PK + (size_t)NLAYER * NBATCH * 128 * 256,
                 O_PSR = O_PV + (size_t)NLAYER * NBATCH * 128 * 256, O_PSI = O_PSR + (size_t)NLAYER * NBATCH * 2048, O_PP = O_PSI + (size_t)NLAYER * NBATCH * 2048,
                 O_SK = O_PP + (size_t)NLAYER * NBATCH * 15 * 512, O_SV = O_SK + (size_t)NLAYER * NSAMP * 128 * 256, O_SSR = O_SV + (size_t)NLAYER * NSAMP * 128 * 256,
                 O_SSI = O_SSR + (size_t)NLAYER * NSAMP * 2048, O_SP = O_SSI + (size_t)NLAYER * NSAMP * 2048, O_END = O_SP + (size_t)NLAYER * NSAMP * 15 * 512;

constexpr size_t MiB = 1u << 20;
constexpr size_t WS_CTL = 0, CTL_ZERO_BYTES = 1 * MiB;
constexpr size_t WS_WIN = 1 * MiB, WS_WOUT = 21 * MiB, WS_W1 = 37 * MiB, WS_W2 = 101 * MiB, WS_WGLU = 165 * MiB, WS_WPOOL = 166 * MiB, WS_TAB = 167 * MiB;
constexpr size_t WS_X = 170 * MiB, WS_XB = 236 * MiB, WS_Q = 269 * MiB, WS_K = 286 * MiB, WS_VT = 291 * MiB, WS_U = 296 * MiB, WS_XP = 313 * MiB, WS_MIX = 330 * MiB,
                 WS_H = 363 * MiB, WS_SSQ = 495 * MiB, WS_SST = 497 * MiB, WS_KSN = 502 * MiB, WS_END = 503 * MiB;
static_assert(WS_WIN + (size_t)NLAYER * INW * DM * 2 <= WS_WOUT && WS_WOUT + (size_t)NLAYER * DM * DM * 2 <= WS_W1 && WS_W1 + (size_t)NLAYER * DFF * DM * 2 <= WS_W2 && WS_W2 + (size_t)NLAYER * DFF * DM * 2 <= WS_WGLU, "ws map 1");
static_assert(WS_X + (size_t)MP * DM * 4 <= WS_XB && WS_XB + (size_t)MP * DM * 2 <= WS_Q && WS_Q + (size_t)MP * 1024 * 2 <= WS_K && WS_K + (size_t)MP * 256 * 2 <= WS_VT && WS_VT + (size_t)4 * 128 * TPV * 2 <= WS_U, "ws map 2");
static_assert(WS_U + (size_t)MP * 512 * 4 <= WS_XP && WS_XP + (size_t)MP * 512 * 4 <= WS_MIX && WS_MIX + (size_t)MP * DM * 2 <= WS_H && WS_H + (size_t)MP * DFF * 2 <= WS_SSQ && WS_SSQ + (size_t)MP * 32 * 4 <= WS_SST, "ws map 3");
static_assert(WS_SST + (size_t)NLAYER * NCHUNK * 32 * 64 * 8 <= WS_KSN, "ws map 4");
constexpr size_t TB_ABR = 0, TB_ABI = 8192, TB_ALR = 16384, TB_ALI = 24576, TB_A16R = 32768, TB_A16I = 40960, TB_A32R = 49152, TB_A32I = 57344,
                 TB_BBR = 65536, TB_BBI = TB_BBR + 131072, TB_PM = TB_BBI + 131072, TB_CMT = TB_PM + 524288, TB_LAYER = 1 * MiB;
static_assert(TB_CMT + 131072 <= TB_LAYER, "table map");
constexpr size_t WS_ROPE = WS_TAB + 2 * MiB;
constexpr size_t ROPE_N = (size_t)(TT + 1) * 16;
constexpr int CW_TMO = 0, CW_CODE = 1, CW_BAR = 4096, CW_SSMF = 16384  ;
static_assert((CW_SSMF + NLAYER * NCHUNK * 8 * 16) * 4 <= (int)CTL_ZERO_BYTES, "ctl map");

constexpr int RING_BYTES = 131072, ESC_OFF = RING_BYTES  , LDSCTL_OFF = ESC_OFF + 12288, MISC_OFF = LDSCTL_OFF + 320, LDS_BYTES = 147456;
static_assert(MISC_OFF + 128 <= LDS_BYTES, "LDS map");

#define GAS __attribute__((address_space(1)))
#define LAS __attribute__((address_space(3)))
typedef unsigned short bf16;
typedef unsigned v4u __attribute__((ext_vector_type(4)));
typedef unsigned v2u __attribute__((ext_vector_type(2)));
typedef float f32x2 __attribute__((ext_vector_type(2)));
typedef float f32x16 __attribute__((ext_vector_type(16)));
typedef __bf16 bf16x2_t __attribute__((ext_vector_type(2)));
typedef GAS unsigned gu32;
typedef GAS unsigned long long gu64;
#define RLX_AGENT __ATOMIC_RELAXED, __HIP_MEMORY_SCOPE_AGENT
#define LDS_WAIT() asm volatile("s_waitcnt lgkmcnt(0)" ::: "memory")
#define VM_WAIT() asm volatile("s_waitcnt vmcnt(0)" ::: "memory")
#define WG_BAR() do { asm volatile("s_waitcnt lgkmcnt(0)" ::: "memory"); __builtin_amdgcn_s_barrier(); asm volatile("" ::: "memory"); } while (0)
__device__ __forceinline__ unsigned pk2(float lo, float hi) { f32x2 v = {lo, hi}; bf16x2_t b = __builtin_convertvector(v, bf16x2_t); return __builtin_bit_cast(unsigned, b); }
__device__ __forceinline__ float bf2f(unsigned short h) { return __builtin_bit_cast(float, (unsigned)h << 16); }
__device__ __forceinline__ float wave_sum(float v) {
#pragma unroll
    for (int o = 1; o < 64; o <<= 1) v += __shfl_xor(v, o);
    return v;
}
__device__ __forceinline__ float wave_max(float v) {
#pragma unroll
    for (int o = 1; o < 64; o <<= 1) v = fmaxf(v, __shfl_xor(v, o));
    return v;
}
__host__ __device__ __forceinline__ int perm16(int o) { return 8 * ((o >> 2) & 1) + 4 * (o >> 3) + (o & 3); }

namespace pg8 {
#define PG8_LAS __attribute__((address_space(3)))
typedef unsigned short bf16_t;
typedef short bf16x8 __attribute__((ext_vector_type(8)));
typedef float f32x4 __attribute__((ext_vector_type(4)));
typedef unsigned u32x4 __attribute__((ext_vector_type(4)));
constexpr int BM = 256, BK = 64, HALF = 128, HTB = HALF * BK * 2  , STAGE_BYTES = 8 * HTB, NXCD = 8, WGM = 8;

__host__ __device__ __forceinline__ int lds_byte(int r, int c) { const int st = (r >> 4) * 2 + (c >> 5), rr = r & 15, cc = c & 31, ob = rr * 64 + cc * 2; return st * 1024 + (ob ^ (((ob >> 9) & 1) << 5)); }
__host__ __device__ __forceinline__ void stage_rc(int b, int& R, int& C) { const int st = b / 1024, sb = b % 1024, swz = sb ^ (((sb >> 9) & 1) << 5); R = (st >> 1) * 16 + swz / 64; C = (st & 1) * 32 + (swz % 64) / 2; }
__host__ __device__ __forceinline__ int perm32(int rho) { const int n = rho >> 4, i = rho & 15; return 8 * (i >> 2) + 4 * n + (i & 3); }

struct Unit { int pm, pn; };
struct Gemm { const bf16_t* A; const bf16_t* Bt; int M, N, K; };

struct StaticOrder {
    int nM, nN, nwg, G, c;
    __host__ __device__ void init(int M, int N, int G_, int c_) { nM = M / BM; nN = N / BM; nwg = nM * nN; G = G_; c = c_; }
    __host__ __device__ bool next(int i, Unit& u) const {
        const long L = (long)i * G + c; if (L >= nwg) return false;
        int wgid = (int)L; { const int q = nwg / NXCD, r = nwg % NXCD, xcd = wgid % NXCD, off = wgid / NXCD; wgid = (xcd < r ? xcd * (q + 1) : r * (q + 1) + (xcd - r) * q) + off; }
        const int nig = WGM * nN, gid = wgid / nig, fm = gid * WGM, gsz = (nM - fm) < WGM ? (nM - fm) : WGM;
        u.pm = fm + ((wgid % nig) % gsz); u.pn = (wgid % nig) / gsz; return true;
    }
    __device__ __forceinline__ void a_ready(const Unit&) const {}
    __device__ __forceinline__ void done(const Unit&) const {}
};


template <class Epi, class Sched, bool ALIGN_EPI = false, bool SP2 = false>
__device__ __forceinline__ void gemm_phase(PG8_LAS unsigned char* lds, PG8_LAS unsigned char* esc, const Gemm g, const Sched& S, const Epi& E) {
    int tid_ = threadIdx.x; asm volatile("" : "+v"(tid_));
    const int tid = tid_, wid = __builtin_amdgcn_readfirstlane(tid >> 6), lane = tid & 63, wr = wid >> 2, wc = wid & 3, fr = lane & 15, fq = lane >> 4;
    const int K = g.K, nt = K / BK;
    unsigned voffA[2], voffB[2];
#pragma unroll
    for (int i = 0; i < 2; ++i) { int R, C; stage_rc(tid * 16 + i * 8192, R, C); const int Rb = Epi::PERM ? ((R & ~31) + perm32(R & 31)) : R;
        voffA[i] = (unsigned)(R * K + C) * 2u; voffB[i] = (unsigned)(Rb * K + C) * 2u; }
    const size_t kstep = (size_t)(BK * 2);
    const size_t hstep = (size_t)HALF * K * 2;
    const size_t tstep = 2 * hstep;
    const unsigned ldsw = (unsigned)wid * 1024u;
    const int aoff = lds_byte(wr * 64 + fr, fq * 8), boff = lds_byte(wc * 32 + fr, fq * 8);
#define PG8_SA(b, h) (((b) * 2 + (h)) * HTB)
#define PG8_SB(b, h) ((4 + (b) * 2 + (h)) * HTB)
#define PG8_STAGE(bufoff, gbase, voff) do { _Pragma("unroll") for (int _i = 0; _i < 2; ++_i) \
        __builtin_amdgcn_global_load_lds((const unsigned*)((const char*)(gbase) + (voff)[_i]), (PG8_LAS unsigned*)(lds + (bufoff) + ldsw + _i * 8192), 16, 0, 0); } while (0)
#define PG8_LDA(dst, b, h) do { _Pragma("unroll") for (int m = 0; m < 4; ++m) _Pragma("unroll") for (int k = 0; k < 2; ++k) dst[m][k] = *(const PG8_LAS bf16x8*)(lds + PG8_SA(b, h) + aoff + m * 2048 + k * 1024); } while (0)
#define PG8_LDB(dst, b, h) do { _Pragma("unroll") for (int n = 0; n < 2; ++n) _Pragma("unroll") for (int k = 0; k < 2; ++k) dst[n][k] = *(const PG8_LAS bf16x8*)(lds + PG8_SB(b, h) + boff + n * 2048 + k * 1024); } while (0)
#define PG8_MMA(ai, bj, At, Bt) do { __builtin_amdgcn_s_setprio(1); _Pragma("unroll") for (int m = 0; m < 4; ++m) _Pragma("unroll") for (int n = 0; n < 2; ++n) _Pragma("unroll") for (int k = 0; k < 2; ++k) \
        acc[ai][bj][m][n] = __builtin_amdgcn_mfma_f32_16x16x32_bf16(Bt[n][k], At[m][k], acc[ai][bj][m][n], 0, 0, 0); __builtin_amdgcn_s_setprio(0); } while (0)
#define PG8_WAIT_V(n) asm volatile("s_waitcnt vmcnt(" #n ")" ::: "memory")
#define PG8_WAIT_L(n) asm volatile("s_waitcnt lgkmcnt(" #n ")" ::: "memory")
#define PG8_BAR __builtin_amdgcn_s_barrier()
#define PG8_SCHED __builtin_amdgcn_sched_barrier(0)
    Unit cur, nxt; int ui = 0;
    if (!S.next(0, cur)) return;
    f32x4 acc[2][2][4][2];
#pragma unroll
    for (int a = 0; a < 2; ++a)
#pragma unroll
        for (int b = 0; b < 2; ++b)
#pragma unroll
            for (int m = 0; m < 4; ++m)
#pragma unroll
                for (int n = 0; n < 2; ++n) acc[a][b][m][n] = (f32x4){0.f, 0.f, 0.f, 0.f};
    bf16x8 At[4][2], B0[2][2], B1[2][2];
    const char* cA = (const char*)g.A + (size_t)cur.pm * tstep; const char* cB = (const char*)g.Bt + (size_t)cur.pn * tstep;
    S.a_ready(cur);
    if constexpr (SP2) {
        PG8_STAGE(PG8_SB(0, 0), cB, voffB); PG8_STAGE(PG8_SB(0, 1), cB + hstep, voffB); PG8_STAGE(PG8_SA(0, 0), cA, voffA); PG8_STAGE(PG8_SA(0, 1), cA + hstep, voffA);
        if (wr == 1) PG8_BAR;
        PG8_WAIT_V(2); PG8_BAR;
        PG8_STAGE(PG8_SB(1, 0), cB + kstep, voffB); PG8_STAGE(PG8_SA(1, 0), cA + kstep, voffA); PG8_STAGE(PG8_SB(1, 1), cB + hstep + kstep, voffB);
        PG8_WAIT_V(6); PG8_BAR;
    } else {
        PG8_STAGE(PG8_SB(0, 0), cB, voffB); PG8_STAGE(PG8_SA(0, 0), cA, voffA); PG8_STAGE(PG8_SB(0, 1), cB + hstep, voffB); PG8_STAGE(PG8_SA(0, 1), cA + hstep, voffA);
        if (wr == 1) PG8_BAR;
        PG8_WAIT_V(4); PG8_BAR;
        PG8_STAGE(PG8_SB(1, 0), cB + kstep, voffB); PG8_STAGE(PG8_SA(1, 0), cA + kstep, voffA); PG8_STAGE(PG8_SB(1, 1), cB + hstep + kstep, voffB);
        PG8_WAIT_V(6); PG8_BAR;
    }
    for (;;) {
        const bool has_next = S.next(ui + 1, nxt);
        const char* nA = has_next ? (const char*)g.A + (size_t)nxt.pm * tstep : cA; const char* nB = has_next ? (const char*)g.Bt + (size_t)nxt.pn * tstep : cB;
        for (int t = 0; t < nt; t += 2) {
            const bool last = (t == nt - 2);
            const char* a1 = cA + (size_t)(t + 1) * kstep;
            const char* a2 = last ? nA : cA + (size_t)(t + 2) * kstep; const char* b2 = last ? nB : cB + (size_t)(t + 2) * kstep;
            const char* a3 = a2 + kstep; const char* b3 = b2 + kstep;
            if (last && has_next) S.a_ready(nxt);
            if constexpr (SP2) {
            PG8_LDB(B0, 0, 0); PG8_LDB(B1, 0, 1); PG8_SCHED; PG8_LDA(At, 0, 0); PG8_STAGE(PG8_SA(1, 1), a1 + hstep, voffA);
            PG8_WAIT_V(8); PG8_WAIT_L(0); PG8_BAR; PG8_MMA(0, 0, At, B0); PG8_MMA(0, 1, At, B1); PG8_BAR; PG8_SCHED;
            PG8_LDA(At, 0, 1); PG8_STAGE(PG8_SB(0, 0), b2, voffB); PG8_STAGE(PG8_SB(0, 1), b2 + hstep, voffB); PG8_STAGE(PG8_SA(0, 0), a2, voffA);
            PG8_WAIT_V(8); PG8_WAIT_L(0); PG8_BAR; PG8_MMA(1, 0, At, B0); PG8_MMA(1, 1, At, B1); PG8_BAR; PG8_SCHED;
            PG8_LDB(B0, 1, 0); PG8_LDB(B1, 1, 1); PG8_SCHED; PG8_LDA(At, 1, 0); PG8_STAGE(PG8_SA(0, 1), a2 + hstep, voffA);
            PG8_WAIT_V(8); PG8_WAIT_L(0); PG8_BAR; PG8_MMA(0, 0, At, B0); PG8_MMA(0, 1, At, B1); PG8_BAR; PG8_SCHED;
            PG8_LDA(At, 1, 1); PG8_STAGE(PG8_SB(1, 0), b3, voffB); PG8_STAGE(PG8_SB(1, 1), b3 + hstep, voffB); PG8_STAGE(PG8_SA(1, 0), a3, voffA);
            PG8_WAIT_V(8); PG8_WAIT_L(0); PG8_BAR; PG8_MMA(1, 0, At, B0); PG8_MMA(1, 1, At, B1); PG8_BAR; PG8_SCHED;
            } else {
            PG8_LDB(B0, 0, 0); PG8_SCHED; PG8_LDA(At, 0, 0); PG8_STAGE(PG8_SA(1, 1), a1 + hstep, voffA);
            PG8_WAIT_L(8); PG8_BAR; PG8_WAIT_L(0); PG8_MMA(0, 0, At, B0); PG8_BAR; PG8_SCHED;
            PG8_LDB(B1, 0, 1); PG8_STAGE(PG8_SB(0, 0), b2, voffB);
            PG8_BAR; PG8_WAIT_L(0); PG8_MMA(0, 1, At, B1); PG8_BAR;
            PG8_LDA(At, 0, 1); PG8_STAGE(PG8_SA(0, 0), a2, voffA);
            PG8_BAR; PG8_WAIT_L(0); PG8_MMA(1, 0, At, B0); PG8_BAR; PG8_SCHED;
            PG8_STAGE(PG8_SB(0, 1), b2 + hstep, voffB);
            PG8_WAIT_V(6); PG8_BAR; PG8_MMA(1, 1, At, B1); PG8_BAR;
            PG8_LDB(B0, 1, 0); PG8_SCHED; PG8_LDA(At, 1, 0); PG8_STAGE(PG8_SA(0, 1), a2 + hstep, voffA);
            PG8_WAIT_L(8); PG8_BAR; PG8_WAIT_L(0); PG8_MMA(0, 0, At, B0); PG8_BAR; PG8_SCHED;
            PG8_LDB(B1, 1, 1); PG8_STAGE(PG8_SB(1, 0), b3, voffB);
            PG8_BAR; PG8_WAIT_L(0); PG8_MMA(0, 1, At, B1); PG8_BAR;
            PG8_LDA(At, 1, 1); PG8_STAGE(PG8_SA(1, 0), a3, voffA);
            PG8_BAR; PG8_WAIT_L(0); PG8_MMA(1, 0, At, B0); PG8_BAR; PG8_SCHED;
            PG8_STAGE(PG8_SB(1, 1), b3 + hstep, voffB);
            PG8_WAIT_V(6); PG8_BAR; PG8_MMA(1, 1, At, B1); PG8_BAR;
            }
        }
        if constexpr (ALIGN_EPI) { if (wr == 0) PG8_BAR; }
        { E(acc, cur, wr, wc, fr, fq, esc, tid); S.done(cur); }
        if (!has_next) break;
#pragma unroll
        for (int a = 0; a < 2; ++a)
#pragma unroll
            for (int b = 0; b < 2; ++b)
#pragma unroll
                for (int m = 0; m < 4; ++m)
#pragma unroll
                    for (int n = 0; n < 2; ++n) acc[a][b][m][n] = (f32x4){0.f, 0.f, 0.f, 0.f};
        cur = nxt; cA = nA; cB = nB; ++ui;
        if constexpr (ALIGN_EPI) { if (wr == 1) PG8_BAR; }
    }
    PG8_WAIT_V(0);
    if constexpr (!ALIGN_EPI) { if (wr == 0) PG8_BAR; }
    PG8_BAR;
#undef PG8_SA
#undef PG8_SB
#undef PG8_STAGE
#undef PG8_LDA
#undef PG8_LDB
#undef PG8_MMA
#undef PG8_WAIT_V
#undef PG8_WAIT_L
#undef PG8_BAR
#undef PG8_SCHED
}
}

typedef float f32x4 __attribute__((ext_vector_type(4)));
typedef short bf16x8 __attribute__((ext_vector_type(8)));


__device__ __forceinline__ void build_rs(const float* ssq, int pm, LAS unsigned char* esc, int tid) {
    LAS float* rsT = (LAS float*)esc;
    WG_BAR();
    if (tid < 256) {
        const f32x4* p = (const f32x4*)(ssq + (size_t)(pm * 256 + tid) * 32); float s = 0.f;
#pragma unroll
        for (int j = 0; j < 8; ++j) { const f32x4 v = p[j]; s += (v[0] + v[1]) + (v[2] + v[3]); }
        rsT[tid] = rsqrtf(s * (1.0f / DM) + EPS);
    }
    WG_BAR();
}

struct EpiProj {
    static constexpr bool PERM = false, AFTER_DRAIN = false;
    unsigned char* ws_; float* out_; const float* gq; const float* gk; int l;
    __device__ __forceinline__ void operator()(f32x4 (&acc)[2][2][4][2], const pg8::Unit& u, int wr, int wc, int fr, int fq, LAS unsigned char* esc, int tid) const {
        asm volatile("" : "+v"(fr), "+v"(fq), "+v"(tid));
        unsigned char* ws = ws_; asm volatile("" : "+s"(ws));
        const float* ssq = (const float*)(ws + WS_SSQ); const float* ropec = (const float*)(ws + WS_ROPE); const float* ropes = ropec + ROPE_N;
        bf16* Q = (bf16*)(ws + WS_Q); bf16* K = (bf16*)(ws + WS_K); bf16* VT = (bf16*)(ws + WS_VT); float* U = (float*)(ws + WS_U); float* XP = (float*)(ws + WS_XP);
        float* ksn = (float*)(ws + WS_KSN); float* vsn = ksn + NSAMP * 256;
        float* out_pk = out_ + O_PK + (size_t)l * NBATCH * 128 * 256; float* out_pv = out_ + O_PV + (size_t)l * NBATCH * 128 * 256;
        build_rs(ssq, u.pm, esc, tid);
        const LAS float* rsT = (const LAS float*)esc;
        LAS float* hss = (LAS float*)(esc + 1024);
        const int pn = u.pn;
#pragma unroll
        for (int ai = 0; ai < 2; ++ai)
#pragma unroll
            for (int m = 0; m < 4; ++m) { const float rsv = rsT[ai * 128 + wr * 64 + m * 16 + fr];
#pragma unroll
                for (int bj = 0; bj < 2; ++bj)
#pragma unroll
                    for (int n = 0; n < 2; ++n) acc[ai][bj][m][n] *= rsv; }
        if (pn <= 4) {
#pragma unroll
            for (int ai = 0; ai < 2; ++ai)
#pragma unroll
                for (int m = 0; m < 4; ++m)
#pragma unroll
                    for (int bj = 0; bj < 2; ++bj) { const f32x4 a = acc[ai][bj][m][0], b = acc[ai][bj][m][1];
                        float s = (a[0] * a[0] + a[1] * a[1]) + (a[2] * a[2] + a[3] * a[3]) + (b[0] * b[0] + b[1] * b[1]) + (b[2] * b[2] + b[3] * b[3]);
                        s += __shfl_xor(s, 16); s += __shfl_xor(s, 32);
                        if (fq == 0) hss[(bj * 256 + ai * 128 + wr * 64 + m * 16 + fr) * 4 + wc] = s; }
            WG_BAR();
            const float* g = (pn < 4) ? gq : gk; const float osc = (pn < 4) ? QSCALE : 1.0f;
            f32x4 gv[2];
#pragma unroll
            for (int n = 0; n < 2; ++n) gv[n] = *(const f32x4*)(g + wc * 32 + n * 16 + 4 * fq);
#pragma unroll
            for (int ai = 0; ai < 2; ++ai)
#pragma unroll
                for (int m = 0; m < 4; ++m) {
                    const int rl = ai * 128 + wr * 64 + m * 16 + fr, r = u.pm * 256 + rl;
                    const bool samp = r >= SROW0, pad = r >= MR;
                    const int b = (r >= TT && !samp) ? 1 : 0, t = r - b * TT;
                    const int pidx = samp ? ROPE_SAMPLE_IDX : t;
                    f32x4 cs = {1.f, 1.f, 1.f, 1.f}, sn = {0.f, 0.f, 0.f, 0.f};
                    if (wc == 0 && !pad) { cs = *(const f32x4*)(ropec + (size_t)pidx * 16 + 4 * fq); sn = *(const f32x4*)(ropes + (size_t)pidx * 16 + 4 * fq); }
#pragma unroll
                    for (int bj = 0; bj < 2; ++bj) {
                        const f32x4 hv = *(const LAS f32x4*)(hss + (bj * 256 + rl) * 4);
                        const float hn = rsqrtf(((hv[0] + hv[1]) + (hv[2] + hv[3])) * (1.0f / 128.0f) + EPS);
                        f32x4 x1 = acc[ai][bj][m][0] * hn * gv[0], x2 = acc[ai][bj][m][1] * hn * gv[1];
                        if (wc == 0) { const f32x4 o1 = x1 * cs - x2 * sn, o2 = x2 * cs + x1 * sn; x1 = o1; x2 = o2; }
                        x1 = x1 * osc; x2 = x2 * osc;
                        const int cl = bj * 128 + wc * 32 + 4 * fq;
                        if (pn < 4) { bf16* qp = Q + (size_t)r * 1024 + pn * 256 + cl;
                            *(v2u*)qp = (v2u){pk2(x1[0], x1[1]), pk2(x1[2], x1[3])}; *(v2u*)(qp + 16) = (v2u){pk2(x2[0], x2[1]), pk2(x2[2], x2[3])}; }
                        else { bf16* kp = K + (size_t)r * 256 + cl;
                            *(v2u*)kp = (v2u){pk2(x1[0], x1[1]), pk2(x1[2], x1[3])}; *(v2u*)(kp + 16) = (v2u){pk2(x2[0], x2[1]), pk2(x2[2], x2[3])};
                            if (samp && !pad) { float* o = ksn + (size_t)(r - SROW0) * 256 + cl; *(f32x4*)o = x1; *(f32x4*)(o + 16) = x2; }
                            else if (!samp && t >= TT - 128) { float* o = out_pk + ((size_t)(b * 128 + (t - (TT - 128))) * 256) + cl; *(f32x4*)o = x1; *(f32x4*)(o + 16) = x2; } }
                    }
                }
        } else if (pn == 5) {
#pragma unroll
            for (int ai = 0; ai < 2; ++ai)
#pragma unroll
                for (int m = 0; m < 4; ++m) {
                    const int rl = ai * 128 + wr * 64 + m * 16 + fr, r = u.pm * 256 + rl;
                    const bool samp = r >= SROW0, pad = r >= MR;
                    const int b = (r >= TT && !samp) ? 1 : 0, t = r - b * TT;
                    const int tpos = (t & ~15) + perm16(t & 15);
#pragma unroll
                    for (int bj = 0; bj < 2; ++bj)
#pragma unroll
                        for (int n = 0; n < 2; ++n) { const f32x4 x = acc[ai][bj][m][n]; const int d = wc * 32 + n * 16 + 4 * fq;
                            if (!samp) { bf16* vp = VT + ((size_t)((b * 2 + bj) * 128 + d)) * TPV + tpos;
#pragma unroll
                                for (int j = 0; j < 4; ++j) vp[(size_t)j * TPV] = (bf16)(pk2(x[j], 0.f) & 0xffffu);
                                if (t >= TT - 128) *(f32x4*)(out_pv + ((size_t)(b * 128 + (t - (TT - 128))) * 256) + bj * 128 + d) = x; }
                            else if (!pad) *(f32x4*)(vsn + (size_t)(r - SROW0) * 256 + bj * 128 + d) = x; }
                }
        } else {
            float* dst = (pn < 8) ? U + (pn - 6) * 256 : XP + (pn - 8) * 256;
#pragma unroll
            for (int ai = 0; ai < 2; ++ai)
#pragma unroll
                for (int m = 0; m < 4; ++m) { float* rp = dst + (size_t)(u.pm * 256 + ai * 128 + wr * 64 + m * 16 + fr) * 512 + wc * 32 + 4 * fq;
#pragma unroll
                    for (int bj = 0; bj < 2; ++bj)
#pragma unroll
                        for (int n = 0; n < 2; ++n) *(f32x4*)(rp + bj * 128 + n * 16) = acc[ai][bj][m][n]; }
        }
    }
};

struct EpiRes {
    static constexpr bool PERM = false, AFTER_DRAIN = false;
    float* X; bf16* XB; float* ssq; float* out; int last;
    __device__ __forceinline__ void operator()(f32x4 (&acc)[2][2][4][2], const pg8::Unit& u, int wr, int wc, int fr, int fq, LAS unsigned char* esc, int tid) const {
        asm volatile("" : "+v"(fr), "+v"(fq), "+v"(tid));
#pragma unroll
        for (int ai = 0; ai < 2; ++ai)
#pragma unroll
            for (int m = 0; m < 4; ++m) {
                const int r = u.pm * 256 + ai * 128 + wr * 64 + m * 16 + fr; const int c0 = u.pn * 256 + wc * 32 + 4 * fq;
                float* xp = X + (size_t)r * DM + c0; float s = 0.f;
                f32x4 v[2][2];
#pragma unroll
                for (int bj = 0; bj < 2; ++bj)
#pragma unroll
                    for (int n = 0; n < 2; ++n) { v[bj][n] = *(const f32x4*)(xp + bj * 128 + n * 16) + acc[ai][bj][m][n]; const f32x4 q = v[bj][n] * v[bj][n]; s += (q[0] + q[1]) + (q[2] + q[3]); }
                if (!last) {
                    bf16* bp = XB + (size_t)r * DM + c0;
#pragma unroll
                    for (int bj = 0; bj < 2; ++bj)
#pragma unroll
                        for (int n = 0; n < 2; ++n) { *(f32x4*)(xp + bj * 128 + n * 16) = v[bj][n]; *(v2u*)(bp + bj * 128 + n * 16) = (v2u){pk2(v[bj][n][0], v[bj][n][1]), pk2(v[bj][n][2], v[bj][n][3])}; }
                    s += __shfl_xor(s, 16); s += __shfl_xor(s, 32);
                    if (fq == 0) ssq[(size_t)r * 32 + u.pn * 4 + wc] = s;
                } else {
                    const bool samp = r >= SROW0, pad = r >= MR; const int b = (r >= TT && !samp) ? 1 : 0, t = r - b * TT;
                    float* op = nullptr;
                    if (samp) { if (!pad) op = out + O_YS + (size_t)(r - SROW0) * DM + c0; } else if (t >= NMETA) op = out + O_YP + ((size_t)b * NSEQ + (t - NMETA)) * DM + c0;
                    if (op) {
#pragma unroll
                        for (int bj = 0; bj < 2; ++bj)
#pragma unroll
                            for (int n = 0; n < 2; ++n) *(f32x4*)(op + bj * 128 + n * 16) = v[bj][n]; }
                }
                if (m & 1) asm volatile("" ::: "memory");
            }
    }
};

struct EpiFfn1 {
    static constexpr bool PERM = true, AFTER_DRAIN = false;
    const float* ssq; bf16* H;
    __device__ __forceinline__ void operator()(f32x4 (&acc)[2][2][4][2], const pg8::Unit& u, int wr, int wc, int fr, int fq, LAS unsigned char* esc, int tid) const {
        asm volatile("" : "+v"(fr), "+v"(fq), "+v"(tid));
        build_rs(ssq, u.pm, esc, tid);
        const LAS float* rsT = (const LAS float*)esc;
#pragma unroll
        for (int ai = 0; ai < 2; ++ai)
#pragma unroll
            for (int m = 0; m < 4; ++m) { const int rl = ai * 128 + wr * 64 + m * 16 + fr; const float rsv = rsT[rl];
                bf16* rowp = H + (size_t)(u.pm * 256 + rl) * DFF + u.pn * 256 + wc * 32 + 8 * fq;
#pragma unroll
                for (int bj = 0; bj < 2; ++bj) { f32x4 v0 = acc[ai][bj][m][0] * rsv, v1 = acc[ai][bj][m][1] * rsv;
#pragma unroll
                    for (int j = 0; j < 4; ++j) { const float a = fmaxf(v0[j], 0.f), b = fmaxf(v1[j], 0.f); v0[j] = a * a; v1[j] = b * b; }
                    *(v4u*)(rowp + bj * 128) = (v4u){pk2(v0[0], v0[1]), pk2(v0[2], v0[3]), pk2(v1[0], v1[1]), pk2(v1[2], v1[3])}; } }
    }
};

#define XB_TMO      128
#define XB_XCNT(j)  (256  + 64 * (j))
#define XB_XSUB(j)  (1280 + 64 * (j))
#define XB_XGEN(j)  (2304 + 64 * (j))
#define XB_TOP      3328
#define XB_TOPGEN   3392
#define XCD_BAR_WORDS 3456
#define XB_SPIN_CAP (1u << 18)
__device__ __forceinline__ unsigned xb_ld(unsigned* p)              { return __hip_atomic_load(p, __ATOMIC_RELAXED, __HIP_MEMORY_SCOPE_AGENT); }
__device__ __forceinline__ unsigned xb_add(unsigned* p, unsigned v) { return __hip_atomic_fetch_add(p, v, __ATOMIC_RELAXED, __HIP_MEMORY_SCOPE_AGENT); }
__device__ __forceinline__ unsigned xb_xcc_id() { return (unsigned)__builtin_amdgcn_s_getreg((3 << 11) | 20) & 0xFu; }
#define XB_SPIN(cond, bar) do { unsigned _sp = 0; while (cond) { __builtin_amdgcn_s_sleep(1); \
    if ((++_sp & 255u) == 0u) { if (xb_ld(&(bar)[XB_TMO])) break; if (_sp > XB_SPIN_CAP) { atomicAdd(&(bar)[XB_TMO], 1u); break; } } } } while (0)

struct XcdBarrier {
    unsigned* bar; unsigned x;
    volatile LAS unsigned* st;
};

__device__ __forceinline__ XcdBarrier xcd_barrier_post(unsigned* bar, volatile LAS unsigned* st) {
    XcdBarrier b; b.bar = bar; b.x = xb_xcc_id(); b.st = st;
    if (threadIdx.x == 0) (void)xb_add(&bar[XB_XCNT(b.x)], 1u);
    return b;
}
__device__ __forceinline__ void xcd_barrier_complete(unsigned* bar, unsigned x, unsigned& nloc, unsigned& nx) {
    const unsigned G = gridDim.x * gridDim.y * gridDim.z;
    unsigned sum, cnt, mine, sp = 0u;
    for (;;) {
        sum = 0u; cnt = 0u; mine = 0u;
#pragma unroll
        for (unsigned j = 0; j < 16; ++j) { const unsigned c = xb_ld(&bar[XB_XCNT(j)]); sum += c; cnt += (c > 0u) ? 1u : 0u; mine = (j == x) ? c : mine; }
        if (sum == G) break;
        __builtin_amdgcn_s_sleep(1);
        if ((++sp & 255u) == 0u) { if (xb_ld(&bar[XB_TMO])) break; if (sp > XB_SPIN_CAP) { atomicAdd(&bar[XB_TMO], 1u); break; } }
    }
    nloc = mine > 0u ? mine : 1u; nx = cnt > 0u ? cnt : 1u;
}

__device__ __forceinline__ void xcd_barrier(const XcdBarrier& b) {
    asm volatile("s_waitcnt vmcnt(0)" ::: "memory");
    __syncthreads();
    if (threadIdx.x == 0) {
        unsigned* bar = b.bar;
        __builtin_amdgcn_s_waitcnt(0);
        unsigned nloc = b.st[0], nx = b.st[1];
        if (nloc == 0u) { xcd_barrier_complete(bar, b.x, nloc, nx); b.st[0] = nloc; b.st[1] = nx; }
        const unsigned old = xb_add(&bar[XB_XSUB(b.x)], 1u);
        const unsigned gen = old / nloc;
        if (old + 1u == (gen + 1u) * nloc) {
            __builtin_amdgcn_fence(__ATOMIC_RELEASE, "agent");
            asm volatile("s_waitcnt vmcnt(0)" ::: "memory");
            const unsigned og = xb_add(&bar[XB_TOP], 1u);
            const unsigned tg = og / nx;
            if (og + 1u == (tg + 1u) * nx) xb_add(&bar[XB_TOPGEN], 1u);
            else XB_SPIN(xb_ld(&bar[XB_TOPGEN]) == tg, bar);
            __builtin_amdgcn_fence(__ATOMIC_ACQUIRE, "agent");
            xb_add(&bar[XB_XGEN(b.x)], 1u);
            asm volatile("s_waitcnt vmcnt(0)" ::: "memory");
        } else {
            XB_SPIN(xb_ld(&bar[XB_XGEN(b.x)]) == gen, bar);
            __builtin_amdgcn_fence(__ATOMIC_ACQUIRE, "agent");
            asm volatile("s_waitcnt vmcnt(0)" ::: "memory");
        }
    }
    __syncthreads();
}

struct Frame {
    LAS unsigned char* lds;
    volatile LAS unsigned* MISC;
    gu32* ctl;
    int tid, lane, wave, vcu, G;
    float* out; unsigned char* ws;
};
#define IN_XPROMPT 0
#define IN_XSAMPLE 1
#define IN_CACHEK 2
#define IN_CACHEV 3
#define IN_SSMRE 4
#define IN_SSMIM 5
#define IN_SPOOL 6
#define IN_META 7
#define IN_GMIX 8
#define IN_WIN 9
#define IN_GQ 10
#define IN_GK 11
#define IN_SINKS 12
#define IN_ARE 13
#define IN_AIM 14
#define IN_LOGDT 15
#define IN_BRE 16
#define IN_BIM 17
#define IN_CRE 18
#define IN_CIM 19
#define IN_DSKIP 20
#define IN_WGLU 21
#define IN_BGLU 22
#define IN_WPOOL 23
#define IN_PSCALE 24
#define IN_GOA 25
#define IN_GOS 26
#define IN_GOP 27
#define IN_WOUT 28
#define IN_GFFN 29
#define IN_WFF1 30
#define IN_WFF2 31
struct Args { const float* in[32]; float* out; unsigned char* ws; int ph_lo, ph_hi; };
static_assert(sizeof(Args) == 32 * 8 + 8 + 8 + 8, "Args has no padding");

__device__ __forceinline__ void p0_transpose_item(const float* W, int K, int N, bf16* WT, const float* gain, LAS float* scr, int item, int lane) {
    const int nblk = N / 32, kb = item / nblk, nb = item % nblk, k0 = 64 * kb, n0 = 32 * nb;
#pragma unroll 8
    for (int i = 0; i < 32; ++i) { const int kk = 2 * i + (lane >> 5); float v = W[(size_t)(k0 + kk) * N + n0 + (lane & 31)]; if (gain) v *= gain[k0 + kk]; scr[kk * 33 + (lane & 31)] = v; }
    LDS_WAIT(); asm volatile("" ::: "memory");
    const int c = lane & 7;
#pragma unroll
    for (int j = 0; j < 4; ++j) { const int n = (lane >> 3) + 8 * j; const LAS float* s = scr + (8 * c) * 33 + n;
        v4u o; o.x = pk2(s[0 * 33], s[1 * 33]); o.y = pk2(s[2 * 33], s[3 * 33]); o.z = pk2(s[4 * 33], s[5 * 33]); o.w = pk2(s[6 * 33], s[7 * 33]);
        *(GAS v4u*)(WT + (size_t)(n0 + n) * K + k0 + 8 * c) = o; }
    LDS_WAIT(); asm volatile("" ::: "memory");
}
__device__ __forceinline__ void sincos_d(double x, double& s, double& c) {
    const double TWO_PI = 6.283185307179586476925286766559;
    const double k = rint(x * (1.0 / TWO_PI)); const double r = fma(-k, TWO_PI, x), r2 = r * r;
    const double fs[14] = {0.16666666666666666, 0.05, 0.023809523809523808, 0.013888888888888888, 0.00909090909090909, 0.00641025641025641, 0.004761904761904762, 0.003676470588235294,
                           0.0029239766081871343, 0.002380952380952381, 0.001976284584980237, 0.0016666666666666668, 0.0014245014245014246, 0.0012315270935960591};
    const double fc[14] = {0.5, 0.08333333333333333, 0.03333333333333333, 0.017857142857142856, 0.011111111111111112, 0.007575757575757576, 0.005494505494505495, 0.004166666666666667,
                           0.0032679738562091504, 0.002631578947368421, 0.0021645021645021645, 0.0018115942028985507, 0.0015384615384615385, 0.0013227513227513227};
    double ts = r, tc = 1.0; s = r; c = 1.0;
#pragma unroll
    for (int i = 0; i < 14; ++i) { ts *= -r2 * fs[i]; s += ts; tc *= -r2 * fc[i]; c += tc; }
}
__device__ __forceinline__ double exp_small(double x) {
    double t = 1.0, e = 1.0;
#pragma unroll
    for (int i = 1; i <= 14; ++i) { t *= x * (1.0 / i); e += t; }
    return e;
}
__device__ __forceinline__ void p0_prologue(const Args& AR, Frame& F) {
    LAS float* scr = (LAS float*)(F.lds + F.wave * 16384);
    const int gw = F.vcu * 8 + F.wave, NGW = F.G * 8, lane = F.lane;
    unsigned char* ws = F.ws;
    constexpr int I_IN = (DM / 64) * (INW / 32), I_OUT = (DM / 64) * (DM / 32), I_1 = (DM / 64) * (DFF / 32), I_2 = (DFF / 64) * (DM / 32), I_GLU = (512 / 64) * (512 / 32), I_POOL = 4 * 2 * 4;
    constexpr int I_LAYER = I_IN + I_OUT + I_1 + I_2 + I_GLU + I_POOL;
    for (int it = gw; it < NLAYER * I_LAYER; it += NGW) {
        const int l = it / I_LAYER; int r = it % I_LAYER;
        if (r < I_IN) { p0_transpose_item(AR.in[IN_WIN] + (size_t)l * DM * INW, DM, INW, (bf16*)(ws + WS_WIN) + (size_t)l * INW * DM, AR.in[IN_GMIX] + l * DM, scr, r, lane); continue; } r -= I_IN;
        if (r < I_OUT) { const int k0 = 64 * (r / (DM / 32));
            const float* g = (k0 < 1024) ? AR.in[IN_GOA] + l * 1024 : (k0 < 1536) ? AR.in[IN_GOS] + l * 512 - 1024 : AR.in[IN_GOP] + l * 512 - 1536;
            p0_transpose_item(AR.in[IN_WOUT] + (size_t)l * DM * DM, DM, DM, (bf16*)(ws + WS_WOUT) + (size_t)l * DM * DM, g, scr, r, lane); continue; } r -= I_OUT;
        if (r < I_1) { p0_transpose_item(AR.in[IN_WFF1] + (size_t)l * DM * DFF, DM, DFF, (bf16*)(ws + WS_W1) + (size_t)l * DFF * DM, AR.in[IN_GFFN] + l * DM, scr, r, lane); continue; } r -= I_1;
        if (r < I_2) { p0_transpose_item(AR.in[IN_WFF2] + (size_t)l * DFF * DM, DFF, DM, (bf16*)(ws + WS_W2) + (size_t)l * DM * DFF, nullptr, scr, r, lane); continue; } r -= I_2;
        if (r < I_GLU) { p0_transpose_item(AR.in[IN_WGLU] + (size_t)l * 512 * 512, 512, 512, (bf16*)(ws + WS_WGLU) + (size_t)l * 512 * 512, nullptr, scr, r, lane); continue; } r -= I_GLU;
        { const int g = r / 8; p0_transpose_item(AR.in[IN_WPOOL] + ((size_t)l * 4 + g) * 128 * 128, 128, 128, (bf16*)(ws + WS_WPOOL) + ((size_t)l * 4 + g) * 128 * 128, nullptr, scr, r % 8, lane); }
    }
    float* X = (float*)(ws + WS_X); bf16* XB = (bf16*)(ws + WS_XB); float* SSQ = (float*)(ws + WS_SSQ);
    for (int m = gw; m < MP; m += NGW) {
        const float* src = nullptr;
        if (m < SROW0) { const int b = m >= TT ? 1 : 0, t = m - b * TT; src = (t < NMETA) ? AR.in[IN_META] + (size_t)t * DM : AR.in[IN_XPROMPT] + ((size_t)b * NSEQ + (t - NMETA)) * DM; }
        else if (m < MR) src = AR.in[IN_XSAMPLE] + (size_t)(m - SROW0) * DM;
        float s = 0.f;
#pragma unroll
        for (int j = 0; j < 8; ++j) { f32x4 v = {0.f, 0.f, 0.f, 0.f}; if (src) v = *(const f32x4*)(src + j * 256 + lane * 4);
            s += (v[0] * v[0] + v[1] * v[1]) + (v[2] * v[2] + v[3] * v[3]);
            *(f32x4*)(X + (size_t)m * DM + j * 256 + lane * 4) = v; *(v2u*)(XB + (size_t)m * DM + j * 256 + lane * 4) = (v2u){pk2(v[0], v[1]), pk2(v[2], v[3])}; }
        s = wave_sum(s);
        if (lane < 32) SSQ[(size_t)m * 32 + lane] = (lane == 0) ? s : 0.f;
    }
    const int gt = gw * 64 + lane, NGT = NGW * 64;
    for (int id = gt; id < NLAYER * 32 * 64; id += NGT) {
        const int l = id >> 11, g = (id >> 6) & 31, n = id & 63;
        unsigned char* tb = ws + WS_TAB + (size_t)l * TB_LAYER;
        const double dt = (double)expf(AR.in[IN_LOGDT][l * 32 + g]);
        const double ar = (double)AR.in[IN_ARE][id], ai = (double)AR.in[IN_AIM][id];
        const double mag = exp_small(dt * ar); double sn, cs; sincos_d(dt * ai, sn, cs);
        const double abr = mag * cs, abi = mag * sn, den = ar * ar + ai * ai;
        const double fr = ((abr - 1.0) * ar + abi * ai) / den, fi = (abi * ar - (abr - 1.0) * ai) / den;
        ((float*)(tb + TB_ABR))[g * 64 + n] = (float)abr; ((float*)(tb + TB_ABI))[g * 64 + n] = (float)abi;
        const float* Br = AR.in[IN_BRE] + (size_t)id * 16; const float* Bi = AR.in[IN_BIM] + (size_t)id * 16;
        float* bbr = (float*)(tb + TB_BBR) + (size_t)(g * 64 + n) * 16; float* bbi = (float*)(tb + TB_BBI) + (size_t)(g * 64 + n) * 16;
#pragma unroll
        for (int c = 0; c < 16; ++c) { const double br = Br[c], bi = Bi[c]; bbr[c] = (float)(fr * br - fi * bi); bbi[c] = (float)(fr * bi + fi * br); }
        bf16* Pm = (bf16*)(tb + TB_PM) + (size_t)g * 64 * 128;
        double pr = abr, pi = abi;
        for (int t = 0; t < 64; ++t) {
            Pm[t * 128 + n] = (bf16)(pk2((float)pr, 0.f) & 0xffffu); Pm[t * 128 + 64 + n] = (bf16)(pk2((float)pi, 0.f) & 0xffffu);
            if (t == 15) { ((float*)(tb + TB_A16R))[g * 64 + n] = (float)pr; ((float*)(tb + TB_A16I))[g * 64 + n] = (float)pi; }
            if (t == 31) { ((float*)(tb + TB_A32R))[g * 64 + n] = (float)pr; ((float*)(tb + TB_A32I))[g * 64 + n] = (float)pi; }
            if (t == 63) { ((float*)(tb + TB_ALR))[g * 64 + n] = (float)pr; ((float*)(tb + TB_ALI))[g * 64 + n] = (float)pi; }
            const double nr = pr * abr - pi * abi, ni = pr * abi + pi * abr; pr = nr; pi = ni;
        }
        bf16* CmT = (bf16*)(tb + TB_CMT) + (size_t)g * 16 * 128;
        const float* Cr = AR.in[IN_CRE] + ((size_t)(l * 32 + g) * 16) * 64 + n; const float* Ci = AR.in[IN_CIM] + ((size_t)(l * 32 + g) * 16) * 64 + n;
#pragma unroll
        for (int c = 0; c < 16; ++c) { CmT[c * 128 + n] = (bf16)(pk2(Cr[c * 64], 0.f) & 0xffffu); CmT[c * 128 + 64 + n] = (bf16)(pk2(-Ci[c * 64], 0.f) & 0xffffu); }
    }
    float* rc = (float*)(ws + WS_ROPE); float* rs_ = rc + ROPE_N;
    for (int id = gt; id < (int)ROPE_N; id += NGT) {
        const int p = id >> 4, i = id & 15; const double pos = (p == ROPE_SAMPLE_IDX) ? 16384.0 : (double)p;
        double inv = 1.0;
        for (int k = 0; k < i; ++k) inv *= 0.44036660267178046;
        double sn, cs; sincos_d(pos * inv, sn, cs);
        rc[id] = (float)cs; rs_[id] = (float)sn;
    }
}

__device__ __forceinline__ void attn_unit(const Args& AR, Frame& F, int l, int b, int i) {
    int lane_ = F.lane; asm volatile("" : "+v"(lane_));
    unsigned char* ws = F.ws; asm volatile("" : "+s"(ws));
    const int lane = lane_, h = F.wave, c = lane & 31, hh = lane >> 5, kvh = h >> 2;
    const int t0 = 32 * i; const size_t rb = (size_t)b * TT;
    const bf16* Q = (const bf16*)(ws + WS_Q); const bf16* K = (const bf16*)(ws + WS_K); const bf16* VT = (const bf16*)(ws + WS_VT);
    bf16* MIX = (bf16*)(ws + WS_MIX);
    LAS float* ex = (LAS float*)(F.lds + ESC_OFF);
    bf16x8 qf[8];
    { const bf16* qp = Q + (rb + t0 + c) * 1024 + 128 * h + 8 * hh;
#pragma unroll
      for (int ks = 0; ks < 8; ++ks) qf[ks] = *(const bf16x8*)(qp + 16 * ks); }
    const int kt0 = (t0 >= 128) ? 0 : (4 - i);
    f32x16 S[5];
#pragma unroll
    for (int kt = 0; kt < 5; ++kt) {
#pragma unroll
        for (int r = 0; r < 16; ++r) S[kt][r] = -INFINITY;
        if (kt >= kt0) {
            const int tk0 = t0 - 128 + 32 * kt;
            const bf16* kp = K + (rb + tk0 + c) * 256 + 128 * kvh + 8 * hh;
            bf16x8 kf[8];
#pragma unroll
            for (int ks = 0; ks < 8; ++ks) kf[ks] = *(const bf16x8*)(kp + 16 * ks);
            f32x16 a = {0.f, 0.f, 0.f, 0.f, 0.f, 0.f, 0.f, 0.f, 0.f, 0.f, 0.f, 0.f, 0.f, 0.f, 0.f, 0.f};
#pragma unroll
            for (int ks = 0; ks < 8; ++ks) a = __builtin_amdgcn_mfma_f32_32x32x16_bf16(kf[ks], qf[ks], a, 0, 0, 0);
#pragma unroll
            for (int r = 0; r < 16; ++r) { const int kr = (r & 3) + 8 * (r >> 2) + 4 * hh; bool ok = true;
                if (kt == 0) ok = kr >= c;
                if (kt == 4) ok = kr <= c;
                S[kt][r] = ok ? a[r] : -INFINITY; }
        }
    }
    const float sink2 = AR.in[IN_SINKS][l * 8 + h] * LOG2E;
    float mx = sink2;
#pragma unroll
    for (int kt = 0; kt < 5; ++kt)
#pragma unroll
        for (int r = 0; r < 16; ++r) mx = fmaxf(mx, S[kt][r]);
    mx = fmaxf(mx, __shfl_xor(mx, 32));
    float sum = 0.f;
#pragma unroll
    for (int kt = 0; kt < 5; ++kt)
#pragma unroll
        for (int r = 0; r < 16; ++r) { const float p = __builtin_amdgcn_exp2f(S[kt][r] - mx); S[kt][r] = p; sum += p; }
    sum += __shfl_xor(sum, 32);
    const float inv = 1.0f / (sum + __builtin_amdgcn_exp2f(sink2 - mx));
    f32x16 O[4];
#pragma unroll
    for (int db = 0; db < 4; ++db)
#pragma unroll
        for (int r = 0; r < 16; ++r) O[db][r] = 0.f;
#pragma unroll
    for (int kt = 0; kt < 5; ++kt) {
        if (kt >= kt0) {
            const int tk0 = t0 - 128 + 32 * kt;
#pragma unroll
            for (int s = 0; s < 2; ++s) {
                v4u pw; pw.x = pk2(S[kt][8 * s + 0], S[kt][8 * s + 1]); pw.y = pk2(S[kt][8 * s + 2], S[kt][8 * s + 3]); pw.z = pk2(S[kt][8 * s + 4], S[kt][8 * s + 5]); pw.w = pk2(S[kt][8 * s + 6], S[kt][8 * s + 7]);
                const bf16x8 pf = __builtin_bit_cast(bf16x8, pw);
#pragma unroll
                for (int db = 0; db < 4; ++db) {
                    const bf16x8 vf = *(const bf16x8*)(VT + ((size_t)((b * 2 + kvh) * 128 + 32 * db + c)) * TPV + tk0 + 16 * s + 8 * hh);
                    O[db] = __builtin_amdgcn_mfma_f32_32x32x16_bf16(vf, pf, O[db], 0, 0, 0);
                }
            }
        }
    }
    float ss = 0.f;
#pragma unroll
    for (int db = 0; db < 4; ++db)
#pragma unroll
        for (int r = 0; r < 16; ++r) { O[db][r] *= inv; ss += O[db][r] * O[db][r]; }
    ss += __shfl_xor(ss, 32);
    if (hh == 0) ex[h * 32 + c] = ss;
    WG_BAR();
    float tot = 0.f;
#pragma unroll
    for (int j = 0; j < 8; ++j) tot += ex[j * 32 + c];
    const float rsa = rsqrtf(tot * (1.0f / 1024.0f) + EPS);
    if (t0 + c < TT) {
        bf16* mp = MIX + (rb + t0 + c) * DM + 128 * h + 4 * hh;
#pragma unroll
        for (int db = 0; db < 4; ++db)
#pragma unroll
            for (int g4 = 0; g4 < 4; ++g4)
                *(v2u*)(mp + 32 * db + 8 * g4) = (v2u){pk2(O[db][4 * g4 + 0] * rsa, O[db][4 * g4 + 1] * rsa), pk2(O[db][4 * g4 + 2] * rsa, O[db][4 * g4 + 3] * rsa)};
    }
    WG_BAR();
}

__device__ __forceinline__ void sattn_unit(const Args& AR, Frame& F, int l, int s) {
    int tid_ = F.tid; asm volatile("" : "+v"(tid_));
    const int tid = tid_, lane = tid & 63, wave = F.wave;
    LAS float* qs = (LAS float*)F.lds;
    LAS float* sc = qs + 1024;
    LAS float* part = sc + 8 * 132;
    LAS float* red = part + 4096;
    const size_t row = SROW0 + s;
    const bf16* Q = (const bf16*)(F.ws + WS_Q) + row * 1024;
    const float* ksn = (const float*)(F.ws + WS_KSN) + (size_t)s * 256; const float* vsn = ksn + NSAMP * 256;
    const float* ck = AR.in[IN_CACHEK] + ((size_t)(l * NSAMP + s)) * 128 * 256; const float* cv = AR.in[IN_CACHEV] + ((size_t)(l * NSAMP + s)) * 128 * 256;
    for (int j = tid; j < 1024; j += 512) qs[j] = bf2f(Q[j]);
    WG_BAR();
    { const int key = tid >> 2, pt = tid & 3;
#pragma unroll
      for (int kvh = 0; kvh < 2; ++kvh) {
          const float* kp = ck + (size_t)key * 256 + kvh * 128 + 32 * pt; float d[4] = {0.f, 0.f, 0.f, 0.f};
#pragma unroll
          for (int j = 0; j < 8; ++j) { const f32x4 kv = *(const f32x4*)(kp + 4 * j);
#pragma unroll
              for (int g = 0; g < 4; ++g) { const f32x4 qv = *(const LAS f32x4*)(qs + (4 * kvh + g) * 128 + 32 * pt + 4 * j); d[g] += (kv[0] * qv[0] + kv[1] * qv[1]) + (kv[2] * qv[2] + kv[3] * qv[3]); } }
#pragma unroll
          for (int g = 0; g < 4; ++g) { d[g] += __shfl_xor(d[g], 1); d[g] += __shfl_xor(d[g], 2); if (pt == 0) sc[(4 * kvh + g) * 132 + key] = d[g]; }
      } }
    {
      const int h = wave, kvh = h >> 2; float d = ksn[kvh * 128 + lane] * qs[h * 128 + lane] + ksn[kvh * 128 + 64 + lane] * qs[h * 128 + 64 + lane];
      d = wave_sum(d); if (lane == 0) sc[h * 132 + 128] = d; }
    WG_BAR();
    { const int h = wave; const float sink2 = AR.in[IN_SINKS][l * 8 + h] * LOG2E;
      const float v0 = sc[h * 132 + lane], v1 = sc[h * 132 + 64 + lane], v2 = (lane == 0) ? sc[h * 132 + 128] : -INFINITY;
      const float mx = fmaxf(wave_max(fmaxf(fmaxf(v0, v1), v2)), sink2);
      const float p0 = __builtin_amdgcn_exp2f(v0 - mx), p1 = __builtin_amdgcn_exp2f(v1 - mx), p2 = __builtin_amdgcn_exp2f(v2 - mx);
      const float inv = 1.0f / (wave_sum(p0 + p1 + p2) + __builtin_amdgcn_exp2f(sink2 - mx));
      sc[h * 132 + lane] = p0 * inv; sc[h * 132 + 64 + lane] = p1 * inv; if (lane == 0) sc[h * 132 + 128] = p2 * inv; }
    WG_BAR();
    { const int d = tid & 127, kq = tid >> 7;
#pragma unroll
      for (int kvh = 0; kvh < 2; ++kvh) { float a[4] = {0.f, 0.f, 0.f, 0.f};
#pragma unroll 8
          for (int k = 0; k < 32; ++k) { const int key = 32 * kq + k; const float v = cv[(size_t)key * 256 + kvh * 128 + d];
#pragma unroll
              for (int g = 0; g < 4; ++g) a[g] += sc[(4 * kvh + g) * 132 + key] * v; }
#pragma unroll
          for (int g = 0; g < 4; ++g) part[kq * 1024 + (4 * kvh + g) * 128 + d] = a[g]; } }
    WG_BAR();
    float o[2]; float ss = 0.f;
#pragma unroll
    for (int e = 0; e < 2; ++e) { const int j = tid + 512 * e, h = j >> 7, d = j & 127, kvh = h >> 2;
        o[e] = (part[j] + part[1024 + j]) + (part[2048 + j] + part[3072 + j]) + sc[h * 132 + 128] * vsn[kvh * 128 + d]; ss += o[e] * o[e]; }
    ss = wave_sum(ss); if (lane == 0) red[wave] = ss;
    WG_BAR();
    { float tot = 0.f;
#pragma unroll
      for (int j = 0; j < 8; ++j) tot += red[j];
      const float rsa = rsqrtf(tot * (1.0f / 1024.0f) + EPS);
      bf16* mp = (bf16*)(F.ws + WS_MIX) + row * DM;
#pragma unroll
      for (int e = 0; e < 2; ++e) mp[tid + 512 * e] = (bf16)(pk2(o[e] * rsa, 0.f) & 0xffffu); }
    { float* ok = F.out + O_SK + ((size_t)(l * NSAMP + s)) * 128 * 256; float* ov = F.out + O_SV + ((size_t)(l * NSAMP + s)) * 128 * 256;
      for (int j = tid; j < 127 * 64; j += 512) { *(f32x4*)(ok + 4 * j) = *(const f32x4*)(ck + 256 + 4 * j); *(f32x4*)(ov + 4 * j) = *(const f32x4*)(cv + 256 + 4 * j); }
      if (tid < 64) *(f32x4*)(ok + 127 * 256 + 4 * tid) = *(const f32x4*)(ksn + 4 * tid);
      else if (tid < 128) *(f32x4*)(ov + 127 * 256 + 4 * (tid - 64)) = *(const f32x4*)(vsn + 4 * (tid - 64)); }
    WG_BAR();
}

__device__ __forceinline__ float gelu_tanh(float y) {
    const float inner = 0.7978845608028654f * (y + 0.044715f * y * y * y);
    return y / (1.0f + __builtin_amdgcn_exp2f(-2.0f * LOG2E * inner));
}
__device__ __forceinline__ float sigmoidf_(float x) { return 1.0f / (1.0f + __builtin_amdgcn_exp2f(-LOG2E * x)); }
#define SWZ(r, ch, PITCH) ((r) * (PITCH) + ((((ch)) ^ ((r) & 15)) << 4))

#define SSM_ROWS4(BODY_PRE, BODY_POST) \
    _Pragma("unroll") for (int r4 = 0; r4 < 4; ++r4) { const int r = rbase + r4; BODY_PRE \
        f32x2 xx = {0.f, 0.f}; \
        _Pragma("unroll") for (int cc = 0; cc < 16; ++cc) { const float uv = __builtin_bit_cast(float, __builtin_amdgcn_readlane(__builtin_bit_cast(int, uu[cc]), r)); xx += bb[cc] * (f32x2){uv, uv}; } \
        const float nr = abr * hr - abi * hi + xx[0], ni = abr * hi + abi * hr + xx[1]; hr = nr; hi = ni; BODY_POST }
__device__ __forceinline__ void ssm_unit(const Args& AR, Frame& F, int l, int c) {
    int lane_ = F.lane; asm volatile("" : "+v"(lane_));
    const int lane = lane_, w = F.wave, n = lane, t16 = lane & 15, cq = lane >> 4;
    const int row0 = 64 * c;
    unsigned char* ws = F.ws; asm volatile("" : "+s"(ws));
    const unsigned char* tb = ws + WS_TAB + (size_t)l * TB_LAYER;
    const float* U = (const float*)(ws + WS_U);
    float* SST = (float*)(ws + WS_SST) + ((size_t)l * NCHUNK) * 32 * 128;
    gu32* flags = F.ctl + CW_SSMF + (size_t)(l * NCHUNK) * 8 * 16;
    LAS unsigned char* Zs = F.lds;
    LAS unsigned char* Hm = F.lds + 65536 + w * 8192;
    LAS float* red = (LAS float*)(F.lds + ESC_OFF);
    if (c != NCHUNK - 1) {
#pragma unroll 1
        for (int gi = 0; gi < 4; ++gi) {
            const int g = 4 * w + gi;
            const float abr = ((const float*)(tb + TB_ABR))[g * 64 + n], abi = ((const float*)(tb + TB_ABI))[g * 64 + n];
            f32x2 bb[16];
            { const f32x4* pr = (const f32x4*)((const float*)(tb + TB_BBR) + (size_t)(g * 64 + n) * 16); const f32x4* pi = (const f32x4*)((const float*)(tb + TB_BBI) + (size_t)(g * 64 + n) * 16);
#pragma unroll
              for (int j = 0; j < 4; ++j) { const f32x4 a = pr[j], b2 = pi[j];
#pragma unroll
                  for (int e = 0; e < 4; ++e) bb[4 * j + e] = (f32x2){a[e], b2[e]}; } }
            float uu[16];
            { const f32x4* pu = (const f32x4*)(U + (size_t)(row0 + lane) * 512 + 16 * g);
#pragma unroll
              for (int j = 0; j < 4; ++j) { const f32x4 a = pu[j];
#pragma unroll
                  for (int e = 0; e < 4; ++e) uu[4 * j + e] = a[e]; } }
            float hr = 0.f, hi = 0.f;
#pragma unroll 1
            for (int rbase = (c == 64) ? 16 : 0; rbase < 64; rbase += 4) { SSM_ROWS4(, ) }
            __hip_atomic_store((gu64*)(SST + ((size_t)c * 32 + g) * 128 + 2 * n), ((unsigned long long)__builtin_bit_cast(unsigned, hi) << 32) | __builtin_bit_cast(unsigned, hr), RLX_AGENT);
        }
        VM_WAIT();
        if (lane == 0) __hip_atomic_store(flags + ((size_t)c * 8 + w) * 16, 1u, RLX_AGENT);
    }
    const int cs0 = (c <= 64) ? 0 : 64, npred = c - cs0;
    if (npred > 0) {
        unsigned sp = 0; bool ok = false;
        for (;;) { ok = (lane >= npred) || (__hip_atomic_load(flags + ((size_t)(cs0 + lane) * 8 + w) * 16, RLX_AGENT) != 0u);
            if (__all(ok)) break;
            __builtin_amdgcn_s_sleep(2);
            if (++sp > (1u << 20)) { if (lane == 0) __hip_atomic_store(F.ctl + CW_TMO, 0x55u, RLX_AGENT); break; } }
        __builtin_amdgcn_fence(__ATOMIC_ACQUIRE, "agent");
        VM_WAIT();
    }
#pragma unroll 1
    for (int gi = 0; gi < 4; ++gi) {
        const int g = 4 * w + gi;
        const float abr = ((const float*)(tb + TB_ABR))[g * 64 + n], abi = ((const float*)(tb + TB_ABI))[g * 64 + n];
        float hr = 0.f, hi = 0.f;
        if (npred > 0) {
            const float aLr = ((const float*)(tb + TB_ALR))[g * 64 + n], aLi = ((const float*)(tb + TB_ALI))[g * 64 + n];
            for (int cp = cs0; cp < c; cp += 8) {
                f32x2 sv[8];
#pragma unroll
                for (int j = 0; j < 8; ++j) { const int cj = (cp + j < c) ? cp + j : c - 1; sv[j] = *(const f32x2*)(SST + ((size_t)cj * 32 + g) * 128 + 2 * n); }
#pragma unroll
                for (int j = 0; j < 8; ++j) if (cp + j < c) { const float nr = aLr * hr - aLi * hi + sv[j][0], ni = aLr * hi + aLi * hr + sv[j][1]; hr = nr; hi = ni; }
            }
        }
        f32x2 bb[16];
        { const f32x4* pr = (const f32x4*)((const float*)(tb + TB_BBR) + (size_t)(g * 64 + n) * 16); const f32x4* pi = (const f32x4*)((const float*)(tb + TB_BBI) + (size_t)(g * 64 + n) * 16);
#pragma unroll
          for (int j = 0; j < 4; ++j) { const f32x4 a = pr[j], b2 = pi[j];
#pragma unroll
              for (int e = 0; e < 4; ++e) bb[4 * j + e] = (f32x2){a[e], b2[e]}; } }
        float uu[16];
        { const f32x4* pu = (const f32x4*)(U + (size_t)(row0 + lane) * 512 + 16 * g);
#pragma unroll
          for (int j = 0; j < 4; ++j) { const f32x4 a = pu[j];
#pragma unroll
              for (int e = 0; e < 4; ++e) uu[4 * j + e] = a[e]; } }
        bf16x8 cmf[4];
        { const bf16* cm = (const bf16*)(tb + TB_CMT) + (size_t)g * 16 * 128 + t16 * 128 + 8 * cq;
#pragma unroll
          for (int ks = 0; ks < 4; ++ks) cmf[ks] = *(const bf16x8*)(cm + 32 * ks); }
        const int col = 64 * w + 16 * gi + 4 * cq;
        const f32x4 dsk = *(const f32x4*)(AR.in[IN_DSKIP] + l * 512 + col);
#pragma unroll 1
        for (int half = 0; half < 2; ++half) {
            const bool samp = (c == NCHUNK - 1) && (half == 1);
#pragma unroll 1
            for (int rbase = 32 * half; rbase < 32 * half + 32; rbase += 4) {
                float h0r[4], h0i[4];
#pragma unroll
                for (int r4 = 0; r4 < 4; ++r4) { h0r[r4] = 0.f; h0i[r4] = 0.f; }
                if (samp) {
#pragma unroll
                    for (int r4 = 0; r4 < 4; ++r4) { const size_t o = ((size_t)(l * NSAMP + (rbase - 32 + r4)) * 32 + g) * 64 + n; h0r[r4] = AR.in[IN_SSMRE][o]; h0i[r4] = AR.in[IN_SSMIM][o]; }
                }
                SSM_ROWS4(
                    if (c == 64 && r == 16) { hr = 0.f; hi = 0.f; }
                    if (samp) { hr = h0r[r4]; hi = h0i[r4]; } ,
                    { const int rl = r & 31;
                      *(LAS bf16*)(Hm + SWZ(rl, n >> 3, 256) + (n & 7) * 2) = (bf16)(pk2(hr, 0.f) & 0xffffu);
                      *(LAS bf16*)(Hm + SWZ(rl, 8 + (n >> 3), 256) + (n & 7) * 2) = (bf16)(pk2(hi, 0.f) & 0xffffu);
                      if ((c == 64 && r == 15) || (c == NCHUNK - 1 && r == 31)) { const size_t o = ((size_t)(l * NBATCH + (c == 64 ? 0 : 1)) * 32 + g) * 64 + n; F.out[O_PSR + o] = hr; F.out[O_PSI + o] = hi; }
                      if (samp) { const size_t o = ((size_t)(l * NSAMP + (r - 32)) * 32 + g) * 64 + n; F.out[O_SSR + o] = hr; F.out[O_SSI + o] = hi; } } )
            }
            LDS_WAIT();
#pragma unroll
            for (int mt = 0; mt < 2; ++mt) {
                f32x4 y = {0.f, 0.f, 0.f, 0.f};
#pragma unroll
                for (int ks = 0; ks < 4; ++ks) { const bf16x8 hf = *(const LAS bf16x8*)(Hm + SWZ(16 * mt + t16, 4 * ks + cq, 256));
                    y = __builtin_amdgcn_mfma_f32_16x16x32_bf16(cmf[ks], hf, y, 0, 0, 0); }
                const int rl = 32 * half + 16 * mt + t16;
                const f32x4 uv = *(const f32x4*)(U + (size_t)(row0 + rl) * 512 + col);
                f32x4 z;
#pragma unroll
                for (int e = 0; e < 4; ++e) z[e] = gelu_tanh(y[e] + dsk[e] * uv[e]);
                *(LAS v2u*)(Zs + SWZ(rl, col >> 3, 1024) + (col & 7) * 2) = (v2u){pk2(z[0], z[1]), pk2(z[2], z[3])};
            }
            LDS_WAIT();
        }
    }
    WG_BAR();
    f32x4 G[4][4];
#pragma unroll
    for (int mt = 0; mt < 4; ++mt)
#pragma unroll
        for (int nt = 0; nt < 4; ++nt) G[mt][nt] = (f32x4){0.f, 0.f, 0.f, 0.f};
    { const bf16* Wg = (const bf16*)(ws + WS_WGLU) + (size_t)l * 512 * 512 + (size_t)(64 * w + t16) * 512 + 8 * cq;
#pragma unroll 2
      for (int ks = 0; ks < 16; ++ks) {
          bf16x8 wf[4], zf[4];
#pragma unroll
          for (int nt = 0; nt < 4; ++nt) wf[nt] = *(const bf16x8*)(Wg + (size_t)nt * 16 * 512 + 32 * ks);
#pragma unroll
          for (int mt = 0; mt < 4; ++mt) zf[mt] = *(const LAS bf16x8*)(Zs + SWZ(16 * mt + t16, 4 * ks + cq, 1024));
#pragma unroll
          for (int mt = 0; mt < 4; ++mt)
#pragma unroll
              for (int nt = 0; nt < 4; ++nt) G[mt][nt] = __builtin_amdgcn_mfma_f32_16x16x32_bf16(wf[nt], zf[mt], G[mt][nt], 0, 0, 0);
      } }
#pragma unroll
    for (int mt = 0; mt < 4; ++mt) { float ss = 0.f; const int rl = 16 * mt + t16;
#pragma unroll
        for (int nt = 0; nt < 4; ++nt) { const int col = 64 * w + 16 * nt + 4 * cq; const f32x4 bg = *(const f32x4*)(AR.in[IN_BGLU] + l * 512 + col);
            const v2u zz = *(const LAS v2u*)(Zs + SWZ(rl, col >> 3, 1024) + (col & 7) * 2);
            const float zv[4] = {bf2f((unsigned short)(zz.x & 0xffffu)), bf2f((unsigned short)(zz.x >> 16)), bf2f((unsigned short)(zz.y & 0xffffu)), bf2f((unsigned short)(zz.y >> 16))};
#pragma unroll
            for (int e = 0; e < 4; ++e) { const float o = zv[e] * sigmoidf_(G[mt][nt][e] + bg[e]); G[mt][nt][e] = o; ss += o * o; } }
        ss += __shfl_xor(ss, 16); ss += __shfl_xor(ss, 32);
        if (cq == 0) red[rl * 8 + w] = ss; }
    WG_BAR();
    { bf16* MIX = (bf16*)(ws + WS_MIX);
#pragma unroll
      for (int mt = 0; mt < 4; ++mt) { const int rl = 16 * mt + t16; const LAS f32x4* rp = (const LAS f32x4*)(red + rl * 8); const f32x4 a = rp[0], b2 = rp[1];
          const float rsn = rsqrtf(((a[0] + a[1]) + (a[2] + a[3]) + (b2[0] + b2[1]) + (b2[2] + b2[3])) * (1.0f / 512.0f) + EPS);
          bf16* mp = MIX + (size_t)(row0 + rl) * DM + 1024 + 64 * w + 4 * cq;
#pragma unroll
          for (int nt = 0; nt < 4; ++nt) *(v2u*)(mp + 16 * nt) = (v2u){pk2(G[mt][nt][0] * rsn, G[mt][nt][1] * rsn), pk2(G[mt][nt][2] * rsn, G[mt][nt][3] * rsn)}; } }
    WG_BAR();
}
#undef SSM_ROWS4

template <int WLEN>
__device__ __forceinline__ void pool_half(const float* XP, float* out, int l, int ch, int rfirst, int rl0, LAS unsigned char* Ds) {
    float xv[48];
#pragma unroll
    for (int i = 0; i < 48; ++i) { const int ra = rfirst + i - 16; xv[i] = (ra >= 0) ? XP[(size_t)ra * 512 + ch] : 0.f; }
    int seg = (rfirst >= TT) ? TT : 0;
    float sum = 0.f;
#pragma unroll
    for (int j = 1; j <= WLEN; ++j) if (rfirst - j >= seg) sum += xv[16 - j];
#pragma unroll
    for (int i = 0; i < 32; ++i) {
        const int ra = rfirst + i; const float x = xv[16 + i];
        if (ra == TT) { seg = TT; sum = 0.f; }
        sum += x;
        if (ra - WLEN >= seg) sum -= xv[16 + i - WLEN];
        const int cnt = (ra - seg + 1 < WLEN) ? (ra - seg + 1) : WLEN;
        const float dm = sum * __builtin_amdgcn_rcpf((float)cnt) - x;
        if (ra >= TT - 15 && ra < TT) out[O_PP + ((size_t)(l * NBATCH + 0) * 15 + (ra - (TT - 15))) * 512 + ch] = x;
        if (ra >= SROW0 - 15) out[O_PP + ((size_t)(l * NBATCH + 1) * 15 + (ra - (SROW0 - 15))) * 512 + ch] = x;
        const int r = rl0 + i;
        *(LAS bf16*)(Ds + SWZ(r, ch >> 3, 1024) + (ch & 7) * 2) = (bf16)(pk2(dm, 0.f) & 0xffffu);
    }
}
template <int WLEN>
__device__ __forceinline__ void pool_sample_rows(const float* XP, const float* sp, float* out, int l, int ch, LAS unsigned char* Ds) {
#pragma unroll 2
    for (int s = 0; s < NSAMP; ++s) {
        const float* pp = sp + (size_t)s * 15 * 512; float pv[15];
#pragma unroll
        for (int j = 0; j < 15; ++j) pv[j] = pp[(size_t)j * 512];
        const float x = XP[(size_t)(SROW0 + s) * 512 + ch]; float a = x;
#pragma unroll
        for (int j = 16 - WLEN; j < 15; ++j) a += pv[j];
        const float dm = a * (1.0f / WLEN) - x;
        float* op = out + O_SP + ((size_t)(l * NSAMP + s) * 15) * 512 + ch;
#pragma unroll
        for (int j = 0; j < 14; ++j) op[(size_t)j * 512] = pv[j + 1];
        op[(size_t)14 * 512] = x;
        *(LAS bf16*)(Ds + SWZ(32 + s, ch >> 3, 1024) + (ch & 7) * 2) = (bf16)(pk2(dm, 0.f) & 0xffffu);
    }
}
__device__ __forceinline__ void pool_unit(const Args& AR, Frame& F, int l, int c) {
    int tid_ = F.tid; asm volatile("" : "+v"(tid_));
    const int tid = tid_, lane = tid & 63, w = F.wave, t16 = lane & 15, cq = lane >> 4;
    const int row0 = 64 * c;
    unsigned char* ws = F.ws; asm volatile("" : "+s"(ws));
    const float* XP = (const float*)(ws + WS_XP);
    LAS unsigned char* Ds = F.lds;
    LAS float* red = (LAS float*)(F.lds + ESC_OFF);
    { const int ch = tid, wsel = w >> 1;
      const float* sp = AR.in[IN_SPOOL] + (size_t)l * NSAMP * 15 * 512 + ch;
#pragma unroll 1
      for (int half = 0; half < 2; ++half) {
          if (c == NCHUNK - 1 && half == 1) {
              if (wsel == 0) pool_sample_rows<2>(XP, sp, F.out, l, ch, Ds); else if (wsel == 1) pool_sample_rows<4>(XP, sp, F.out, l, ch, Ds);
              else if (wsel == 2) pool_sample_rows<8>(XP, sp, F.out, l, ch, Ds); else pool_sample_rows<16>(XP, sp, F.out, l, ch, Ds);
          } else {
              const int rfirst = row0 + 32 * half;
              if (wsel == 0) pool_half<2>(XP, F.out, l, ch, rfirst, 32 * half, Ds); else if (wsel == 1) pool_half<4>(XP, F.out, l, ch, rfirst, 32 * half, Ds);
              else if (wsel == 2) pool_half<8>(XP, F.out, l, ch, rfirst, 32 * half, Ds); else pool_half<16>(XP, F.out, l, ch, rfirst, 32 * half, Ds);
          }
      } }
    WG_BAR();
    const int gp = w & 3, rh = w >> 2;
    f32x4 A[2][8];
#pragma unroll
    for (int mt = 0; mt < 2; ++mt)
#pragma unroll
        for (int nt = 0; nt < 8; ++nt) A[mt][nt] = (f32x4){0.f, 0.f, 0.f, 0.f};
    { const bf16* Wp = (const bf16*)(ws + WS_WPOOL) + ((size_t)(l * 4 + gp) * 128 + t16) * 128 + 8 * cq;
#pragma unroll
      for (int ks = 0; ks < 4; ++ks) {
          bf16x8 df[2];
#pragma unroll
          for (int mt = 0; mt < 2; ++mt) df[mt] = *(const LAS bf16x8*)(Ds + SWZ(32 * rh + 16 * mt + t16, 16 * gp + 4 * ks + cq, 1024));
#pragma unroll
          for (int nt = 0; nt < 8; ++nt) { const bf16x8 wf = *(const bf16x8*)(Wp + (size_t)nt * 16 * 128 + 32 * ks);
#pragma unroll
              for (int mt = 0; mt < 2; ++mt) A[mt][nt] = __builtin_amdgcn_mfma_f32_16x16x32_bf16(wf, df[mt], A[mt][nt], 0, 0, 0); }
      } }
#pragma unroll
    for (int mt = 0; mt < 2; ++mt) { float ss = 0.f;
#pragma unroll
        for (int nt = 0; nt < 8; ++nt) { const f32x4 sc = *(const f32x4*)(AR.in[IN_PSCALE] + l * 512 + 128 * gp + 16 * nt + 4 * cq);
#pragma unroll
            for (int e = 0; e < 4; ++e) { const float o = A[mt][nt][e] * sc[e]; A[mt][nt][e] = o; ss += o * o; } }
        ss += __shfl_xor(ss, 16); ss += __shfl_xor(ss, 32);
        if (cq == 0) red[(32 * rh + 16 * mt + t16) * 4 + gp] = ss; }
    WG_BAR();
    { bf16* MIX = (bf16*)(ws + WS_MIX);
#pragma unroll
      for (int mt = 0; mt < 2; ++mt) { const int rl = 32 * rh + 16 * mt + t16; const f32x4 a = *(const LAS f32x4*)(red + rl * 4);
          const float rsn = rsqrtf(((a[0] + a[1]) + (a[2] + a[3])) * (1.0f / 512.0f) + EPS);
          bf16* mp = MIX + (size_t)(row0 + rl) * DM + 1536 + 128 * gp + 4 * cq;
#pragma unroll
          for (int nt = 0; nt < 8; ++nt) *(v2u*)(mp + 16 * nt) = (v2u){pk2(A[mt][nt][0] * rsn, A[mt][nt][1] * rsn), pk2(A[mt][nt][2] * rsn, A[mt][nt][3] * rsn)}; } }
    WG_BAR();
}

constexpr int N_PHASES = 1 + 5 * NLAYER;
constexpr int NU_SSM = NCHUNK, NU_ATT = NBATCH * NQB, NU_SATT = NSAMP, NU_POOL = NCHUNK, NU_B = NU_SSM + NU_ATT + NU_SATT + NU_POOL;

__global__ void __launch_bounds__(512, 2) hymba_fwd(Args args) {
    extern __shared__ __attribute__((aligned(16))) unsigned char lds[];
    Frame F;
    F.lds = (LAS unsigned char*)lds;
    F.MISC = (volatile LAS unsigned*)(F.lds + MISC_OFF);
    F.tid = threadIdx.x; F.lane = F.tid & 63; F.wave = __builtin_amdgcn_readfirstlane(F.tid >> 6);
    F.G = gridDim.x; { const int bx = blockIdx.x; F.vcu = (F.G % 8 == 0) ? (bx % 8) * (F.G / 8) + bx / 8 : bx; }
    F.ws = args.ws; F.out = args.out; F.ctl = (gu32*)(args.ws + WS_CTL);
    for (int u = F.tid; u < (LDS_BYTES - LDSCTL_OFF) / 4; u += 512) ((LAS unsigned*)(F.lds + LDSCTL_OFF))[u] = 0u;
    __syncthreads();
    XcdBarrier bar; bar.bar = (unsigned*)(F.ctl + CW_BAR); bar.x = 0; bar.st = nullptr;
    if (MK_N_LAUNCHES == 1) bar = xcd_barrier_post((unsigned*)(F.ctl + CW_BAR), F.MISC + 8);
    const int lo = args.ph_lo, hi = args.ph_hi;
#ifndef PH_MASK
#define PH_MASK 0x1ff
#endif
#define PHM(j) (((PH_MASK) >> (j)) & 1)
#define IN_PH(k) (lo <= (k) && (k) < hi)
#define SEAM(k) do { if (IN_PH(k) && IN_PH((k) + 1)) xcd_barrier(bar); } while (0)
    LAS unsigned char* ring = F.lds; LAS unsigned char* esc = F.lds + ESC_OFF;

    if (PHM(0) && IN_PH(0)) { for (int rep = 0; rep < DUP_P0; ++rep) p0_prologue(args, F); }
    SEAM(0);
    for (int l = 0; l < NLAYER; ++l) {
        const int pb = 1 + 5 * l;
        if (PHM(1) && IN_PH(pb)) {
            unsigned char* ws = args.ws; asm volatile("" : "+s"(ws)); const bf16* XB = (const bf16*)(ws + WS_XB); int Gs = F.G, bid = (int)blockIdx.x; asm volatile("" : "+s"(Gs), "+s"(bid));
            pg8::Gemm g{XB, (const bf16*)(ws + WS_WIN) + (size_t)l * INW * DM, MP, INW, DM}; pg8::StaticOrder S; S.init(MP, INW, Gs, bid);
            EpiProj E{ws, F.out, args.in[IN_GQ] + l * 128, args.in[IN_GK] + l * 128, l};
            pg8::gemm_phase<EpiProj, pg8::StaticOrder, true, true>(ring, esc, g, S, E);
        }
        SEAM(pb);
        if (IN_PH(pb + 1)) {
          for (int rep = 0; rep < DUP_PB; ++rep)
            for (int ui = F.vcu; ui < NU_B; ui += F.G) {
                int r = ui;
                if (r < NU_SSM) { if (PHM(2)) ssm_unit(args, F, l, r); continue; } r -= NU_SSM;
                if (r < NU_ATT) { if (PHM(3)) attn_unit(args, F, l, r / NQB, r % NQB); continue; } r -= NU_ATT;
                if (r < NU_SATT) { if (PHM(4)) sattn_unit(args, F, l, r); continue; } r -= NU_SATT;
                if (PHM(5)) pool_unit(args, F, l, r);
            }
        }
        SEAM(pb + 1);
        if (PHM(6) && IN_PH(pb + 2)) {
            unsigned char* ws = args.ws; asm volatile("" : "+s"(ws)); const bf16* XB = (const bf16*)(ws + WS_XB); int Gs = F.G, bid = (int)blockIdx.x; asm volatile("" : "+s"(Gs), "+s"(bid));
            pg8::Gemm g{(const bf16*)(ws + WS_MIX), (const bf16*)(ws + WS_WOUT) + (size_t)l * DM * DM, MP, DM, DM}; pg8::StaticOrder S; S.init(MP, DM, Gs, bid);
            EpiRes E{(float*)(ws + WS_X), (bf16*)(ws + WS_XB), (float*)(ws + WS_SSQ), F.out, 0};
            pg8::gemm_phase<EpiRes, pg8::StaticOrder, true, true>(ring, esc, g, S, E);
        }
        SEAM(pb + 2);
        if (PHM(7) && IN_PH(pb + 3)) {
            unsigned char* ws = args.ws; asm volatile("" : "+s"(ws)); const bf16* XB = (const bf16*)(ws + WS_XB); int Gs = F.G, bid = (int)blockIdx.x; asm volatile("" : "+s"(Gs), "+s"(bid));
            pg8::Gemm g{XB, (const bf16*)(ws + WS_W1) + (size_t)l * DFF * DM, MP, DFF, DM}; pg8::StaticOrder S; S.init(MP, DFF, Gs, bid);
            EpiFfn1 E{(const float*)(ws + WS_SSQ), (bf16*)(ws + WS_H)};
            pg8::gemm_phase<EpiFfn1, pg8::StaticOrder, true, true>(ring, esc, g, S, E);
        }
        SEAM(pb + 3);
        if (PHM(8) && IN_PH(pb + 4)) {
            unsigned char* ws = args.ws; asm volatile("" : "+s"(ws)); const bf16* XB = (const bf16*)(ws + WS_XB); int Gs = F.G, bid = (int)blockIdx.x; asm volatile("" : "+s"(Gs), "+s"(bid));
            pg8::Gemm g{(const bf16*)(ws + WS_H), (const bf16*)(ws + WS_W2) + (size_t)l * DM * DFF, MP, DM, DFF}; pg8::StaticOrder S; S.init(MP, DM, Gs, bid);
            EpiRes E{(float*)(ws + WS_X), (bf16*)(ws + WS_XB), (float*)(ws + WS_SSQ), F.out, (l == NLAYER - 1) ? 1 : 0};
            pg8::gemm_phase<EpiRes, pg8::StaticOrder, true, true>(ring, esc, g, S, E);
        }
        SEAM(pb + 4);
    }
#undef IN_PH
#undef SEAM
}

extern "C" void kernel_launch(void* const* d_in, const int* in_sizes, int n_in, void* d_out, int out_size, void* d_ws, size_t ws_size, hipStream_t stream) {
    static int grid = 0;
    if (grid == 0) {
        if (n_in != 32 || (size_t)out_size != O_END || ws_size < WS_END) { fprintf(stderr, "kernel_launch: unexpected shapes: n_in %d out %d (want %zu) ws %zu (want >= %zu)\n", n_in, out_size, (size_t)O_END, ws_size, (size_t)WS_END); grid = -1; return; }
        int dev = 0, cus = 0, per_cu = 0;
        if (hipGetDevice(&dev) != hipSuccess || hipDeviceGetAttribute(&cus, hipDeviceAttributeMultiprocessorCount, dev) != hipSuccess) { fprintf(stderr, "kernel_launch: device query failed\n"); grid = -1; return; }
        if (hipFuncSetAttribute((const void*)hymba_fwd, hipFuncAttributeMaxDynamicSharedMemorySize, LDS_BYTES) != hipSuccess) { fprintf(stderr, "kernel_launch: hipFuncSetAttribute failed\n"); grid = -1; return; }
        if (hipOccupancyMaxActiveBlocksPerMultiprocessor(&per_cu, (const void*)hymba_fwd, 512, LDS_BYTES) != hipSuccess || per_cu < 1) { fprintf(stderr, "kernel_launch: occupancy query says %d blocks per CU\n", per_cu); per_cu = 1; }
        (void)hipGetLastError();
        grid = cus;
        if (grid % 8 != 0) grid -= grid % 8;
    }
    if (grid < 0) return;
    (void)hipMemsetAsync((char*)d_ws + WS_CTL, 0, CTL_ZERO_BYTES, stream);
    Args a{};
    for (int i = 0; i < 32; ++i) a.in[i] = (const float*)d_in[i];
    a.out = (float*)d_out; a.ws = (unsigned char*)d_ws;
    if (MK_N_LAUNCHES == 1) {
        a.ph_lo = 0; a.ph_hi = N_PHASES;
        hipLaunchKernelGGL(hymba_fwd, dim3(grid), dim3(512), LDS_BYTES, stream, a);
    } else {
        for (int p = 0; p < N_PHASES; ++p) { a.ph_lo = p; a.ph_hi = p + 1; hipLaunchKernelGGL(hymba_fwd, dim3(grid), dim3(512), LDS_BYTES, stream, a); }
    }
    const hipError_t le = hipPeekAtLastError();
    if (le != hipSuccess) fprintf(stderr, "kernel_launch: launch failed: %s\n", hipGetErrorName(le));
}
```

```cpp
#include <hip/hip_runtime.h>
#include <cstdio>
#include <cstdint>

#ifndef MK_N_LAUNCHES
#define MK_N_LAUNCHES 1
#endif

#ifndef SEC_BARRIER
#define SEC_BARRIER 0
#endif
#ifndef STREAM_SAME_SECTION
#define STREAM_SAME_SECTION 1
#endif
#ifndef SEC_MASK
#define SEC_MASK 0x10
#endif
#ifndef DUP_PB
#define DUP_PB 1
#endif
#ifndef DUP_P0
#define DUP_P0 1
#endif

constexpr int DM = 2048, TT = 4112  , NSEQ = 4096, NMETA = 16, NBATCH = 2, NSAMP = 32;
constexpr int MR = NBATCH * TT + NSAMP;
constexpr int MP = 8448;
constexpr int SROW0 = NBATCH * TT;
constexpr int INW = 2560, DFF = 8192, NLAYER = 2;
constexpr int TPV = 4128;
constexpr int ROPE_SAMPLE_IDX = TT;
constexpr float EPS = 1e-6f;
constexpr float LOG2E = 1.4426950408889634f;
constexpr float QSCALE = 0.08838834764831845f * LOG2E;
constexpr int NCHUNK = MR / 64;
constexpr int NQB = (TT + 31) / 32;

constexpr size_t O_YP = 0, O_YS = O_YP + (size_t)NBATCH * NSEQ * DM, O_PK = O_YS + (size_t)NSAMP * DM, O_PV = O_PK + (size_t)NLAYER * NBATCH * 128 * 256,
                 O_PSR = O_PV + (size_t)NLAYER * NBATCH * 128 * 256, O_PSI = O_PSR + (size_t)NLAYER * NBATCH * 2048, O_PP = O_PSI + (size_t)NLAYER * NBATCH * 2048,
                 O_SK = O_PP + (size_t)NLAYER * NBATCH * 15 * 512, O_SV = O_SK + (size_t)NLAYER * NSAMP * 128 * 256, O_SSR = O_SV + (size_t)NLAYER * NSAMP * 128 * 256,
                 O_SSI = O_SSR + (size_t)NLAYER * NSAMP * 2048, O_SP = O_SSI + (size_t)NLAYER * NSAMP * 2048, O_END = O_SP + (size_t)NLAYER * NSAMP * 15 * 512;

constexpr size_t MiB = 1u << 20;
constexpr size_t WS_CTL = 0, CTL_ZERO_BYTES = 1 * MiB;
constexpr size_t WS_WIN = 1 * MiB, WS_WOUT = 21 * MiB, WS_W1 = 37 * MiB, WS_W2 = 101 * MiB, WS_WGLU = 165 * MiB, WS_WPOOL = 166 * MiB, WS_TAB = 167 * MiB;
constexpr size_t WS_X = 170 * MiB, WS_XB = 236 * MiB, WS_Q = 269 * MiB, WS_K = 286 * MiB, WS_VT = 291 * MiB, WS_U = 296 * MiB, WS_XP = 313 * MiB, WS_MIX = 330 * MiB,
                 WS_H = 363 * MiB, WS_SSQ = 495 * MiB, WS_SST = 497 * MiB, WS_KSN = 502 * MiB, WS_QUEUE = 503 * MiB, WS_END = 504 * MiB;
static_assert(WS_WIN + (size_t)NLAYER * INW * DM * 2 <= WS_WOUT && WS_WOUT + (size_t)NLAYER * DM * DM * 2 <= WS_W1 && WS_W1 + (size_t)NLAYER * DFF * DM * 2 <= WS_W2 && WS_W2 + (size_t)NLAYER * DFF * DM * 2 <= WS_WGLU, "ws map 1");
static_assert(WS_X + (size_t)MP * DM * 4 <= WS_XB && WS_XB + (size_t)MP * DM * 2 <= WS_Q && WS_Q + (size_t)MP * 1024 * 2 <= WS_K && WS_K + (size_t)MP * 256 * 2 <= WS_VT && WS_VT + (size_t)4 * 128 * TPV * 2 <= WS_U, "ws map 2");
static_assert(WS_U + (size_t)MP * 512 * 4 <= WS_XP && WS_XP + (size_t)MP * 512 * 4 <= WS_MIX && WS_MIX + (size_t)MP * DM * 2 <= WS_H && WS_H + (size_t)MP * DFF * 2 <= WS_SSQ && WS_SSQ + (size_t)MP * 32 * 4 <= WS_SST, "ws map 3");
static_assert(WS_SST + (size_t)NLAYER * NCHUNK * 32 * 64 * 8 <= WS_KSN, "ws map 4");
constexpr size_t TB_ABR = 0, TB_ABI = 8192, TB_ALR = 16384, TB_ALI = 24576, TB_A16R = 32768, TB_A16I = 40960, TB_A32R = 49152, TB_A32I = 57344,
                 TB_BBR = 65536, TB_BBI = TB_BBR + 131072, TB_PM = TB_BBI + 131072, TB_CMT = TB_PM + 524288, TB_LAYER = 1 * MiB;
static_assert(TB_CMT + 131072 <= TB_LAYER, "table map");
constexpr size_t WS_ROPE = WS_TAB + 2 * MiB;
constexpr size_t ROPE_N = (size_t)(TT + 1) * 16;
constexpr int CW_TMO = 0, CW_CODE = 1, CW_BAR = 4096, CW_QHEAD = 8192  , CW_CNT = 9216  , CW_SSMF = 16384  ;
static_assert(CW_CNT + NLAYER * 5 * 40 * 16 <= CW_SSMF, "ctl map: counters");
static_assert((CW_SSMF + NLAYER * NCHUNK * 8 * 16) * 4 <= (int)CTL_ZERO_BYTES, "ctl map");

constexpr int RING_BYTES = 131072, ESC_OFF = RING_BYTES  , QTAB_OFF = ESC_OFF + 12288  , LDSCTL_OFF = QTAB_OFF + 4096, MISC_OFF = LDSCTL_OFF + 320, LDS_BYTES = 148480;
static_assert(MISC_OFF + 128 <= LDS_BYTES, "LDS map");

#define GAS __attribute__((address_space(1)))
#define LAS __attribute__((address_space(3)))
typedef unsigned short bf16;
typedef unsigned v4u __attribute__((ext_vector_type(4)));
typedef unsigned v2u __attribute__((ext_vector_type(2)));
typedef float f32x2 __attribute__((ext_vector_type(2)));
typedef float f32x16 __attribute__((ext_vector_type(16)));
typedef __bf16 bf16x2_t __attribute__((ext_vector_type(2)));
typedef GAS unsigned gu32;
typedef GAS unsigned long long gu64;
#define RLX_AGENT __ATOMIC_RELAXED, __HIP_MEMORY_SCOPE_AGENT
#define LDS_WAIT() asm volatile("s_waitcnt lgkmcnt(0)" ::: "memory")
#define VM_WAIT() asm volatile("s_waitcnt vmcnt(0)" ::: "memory")
#define WG_BAR() do { asm volatile("s_waitcnt lgkmcnt(0)" ::: "memory"); __builtin_amdgcn_s_barrier(); asm volatile("" ::: "memory"); } while (0)
__device__ __forceinline__ unsigned pk2(float lo, float hi) { f32x2 v = {lo, hi}; bf16x2_t b = __builtin_convertvector(v, bf16x2_t); return __builtin_bit_cast(unsigned, b); }
__device__ __forceinline__ float bf2f(unsigned short h) { return __builtin_bit_cast(float, (unsigned)h << 16); }
__device__ __forceinline__ float wave_sum(float v) {
#pragma unroll
    for (int o = 1; o < 64; o <<= 1) v += __shfl_xor(v, o);
    return v;
}
__device__ __forceinline__ float wave_max(float v) {
#pragma unroll
    for (int o = 1; o < 64; o <<= 1) v = fmaxf(v, __shfl_xor(v, o));
    return v;
}
__host__ __device__ __forceinline__ int perm16(int o) { return 8 * ((o >> 2) & 1) + 4 * (o >> 3) + (o & 3); }

namespace pg8 {
#define PG8_LAS __attribute__((address_space(3)))
typedef unsigned short bf16_t;
typedef short bf16x8 __attribute__((ext_vector_type(8)));
typedef float f32x4 __attribute__((ext_vector_type(4)));
typedef unsigned u32x4 __attribute__((ext_vector_type(4)));
constexpr int BM = 256, BK = 64, HALF = 128, HTB = HALF * BK * 2  , STAGE_BYTES = 8 * HTB, NXCD = 8, WGM = 8;

__host__ __device__ __forceinline__ int lds_byte(int r, int c) { const int st = (r >> 4) * 2 + (c >> 5), rr = r & 15, cc = c & 31, ob = rr * 64 + cc * 2; return st * 1024 + (ob ^ (((ob >> 9) & 1) << 5)); }
__host__ __device__ __forceinline__ void stage_rc(int b, int& R, int& C) { const int st = b / 1024, sb = b % 1024, swz = sb ^ (((sb >> 9) & 1) << 5); R = (st >> 1) * 16 + swz / 64; C = (st & 1) * 32 + (swz % 64) / 2; }
__host__ __device__ __forceinline__ int perm32(int rho) { const int n = rho >> 4, i = rho & 15; return 8 * (i >> 2) + 4 * n + (i & 3); }

struct Unit { int pm, pn; };
struct Gemm { const bf16_t* A; const bf16_t* Bt; int M, N, K; };

struct StaticOrder {
    int nM, nN, nwg, G, c;
    __host__ __device__ void init(int M, int N, int G_, int c_) { nM = M / BM; nN = N / BM; nwg = nM * nN; G = G_; c = c_; }
    __host__ __device__ bool next(int i, Unit& u) const {
        const long L = (long)i * G + c; if (L >= nwg) return false;
        int wgid = (int)L; { const int q = nwg / NXCD, r = nwg % NXCD, xcd = wgid % NXCD, off = wgid / NXCD; wgid = (xcd < r ? xcd * (q + 1) : r * (q + 1) + (xcd - r) * q) + off; }
        const int nig = WGM * nN, gid = wgid / nig, fm = gid * WGM, gsz = (nM - fm) < WGM ? (nM - fm) : WGM;
        u.pm = fm + ((wgid % nig) % gsz); u.pn = (wgid % nig) / gsz; return true;
    }
    __device__ __forceinline__ void a_ready(const Unit&) const {}
    __device__ __forceinline__ void done(const Unit&) const {}
};


template <class Epi, class Sched, bool ALIGN_EPI = false, bool SP2 = false>
__device__ __forceinline__ void gemm_phase(PG8_LAS unsigned char* lds, PG8_LAS unsigned char* esc, const Gemm g, const Sched& S, const Epi& E) {
    int tid_ = threadIdx.x; asm volatile("" : "+v"(tid_));
    const int tid = tid_, wid = __builtin_amdgcn_readfirstlane(tid >> 6), lane = tid & 63, wr = wid >> 2, wc = wid & 3, fr = lane & 15, fq = lane >> 4;
    const int K = g.K, nt = K / BK;
    unsigned voffA[2], voffB[2];
#pragma unroll
    for (int i = 0; i < 2; ++i) { int R, C; stage_rc(tid * 16 + i * 8192, R, C); const int Rb = Epi::PERM ? ((R & ~31) + perm32(R & 31)) : R;
        voffA[i] = (unsigned)(R * K + C) * 2u; voffB[i] = (unsigned)(Rb * K + C) * 2u; }
    const size_t kstep = (size_t)(BK * 2);
    const size_t hstep = (size_t)HALF * K * 2;
    const size_t tstep = 2 * hstep;
    const unsigned ldsw = (unsigned)wid * 1024u;
    const int aoff = lds_byte(wr * 64 + fr, fq * 8), boff = lds_byte(wc * 32 + fr, fq * 8);
#define PG8_SA(b, h) (((b) * 2 + (h)) * HTB)
#define PG8_SB(b, h) ((4 + (b) * 2 + (h)) * HTB)
#define PG8_STAGE(bufoff, gbase, voff) do { _Pragma("unroll") for (int _i = 0; _i < 2; ++_i) \
        __builtin_amdgcn_global_load_lds((const unsigned*)((const char*)(gbase) + (voff)[_i]), (PG8_LAS unsigned*)(lds + (bufoff) + ldsw + _i * 8192), 16, 0, 0); } while (0)
#define PG8_LDA(dst, b, h) do { _Pragma("unroll") for (int m = 0; m < 4; ++m) _Pragma("unroll") for (int k = 0; k < 2; ++k) dst[m][k] = *(const PG8_LAS bf16x8*)(lds + PG8_SA(b, h) + aoff + m * 2048 + k * 1024); } while (0)
#define PG8_LDB(dst, b, h) do { _Pragma("unroll") for (int n = 0; n < 2; ++n) _Pragma("unroll") for (int k = 0; k < 2; ++k) dst[n][k] = *(const PG8_LAS bf16x8*)(lds + PG8_SB(b, h) + boff + n * 2048 + k * 1024); } while (0)
#define PG8_MMA(ai, bj, At, Bt) do { __builtin_amdgcn_s_setprio(1); _Pragma("unroll") for (int m = 0; m < 4; ++m) _Pragma("unroll") for (int n = 0; n < 2; ++n) _Pragma("unroll") for (int k = 0; k < 2; ++k) \
        acc[ai][bj][m][n] = __builtin_amdgcn_mfma_f32_16x16x32_bf16(Bt[n][k], At[m][k], acc[ai][bj][m][n], 0, 0, 0); __builtin_amdgcn_s_setprio(0); } while (0)
#define PG8_WAIT_V(n) asm volatile("s_waitcnt vmcnt(" #n ")" ::: "memory")
#define PG8_WAIT_L(n) asm volatile("s_waitcnt lgkmcnt(" #n ")" ::: "memory")
#define PG8_BAR __builtin_amdgcn_s_barrier()
#define PG8_SCHED __builtin_amdgcn_sched_barrier(0)
    Unit cur, nxt; int ui = 0;
    if (!S.next(0, cur)) return;
    f32x4 acc[2][2][4][2];
#pragma unroll
    for (int a = 0; a < 2; ++a)
#pragma unroll
        for (int b = 0; b < 2; ++b)
#pragma unroll
            for (int m = 0; m < 4; ++m)
#pragma unroll
                for (int n = 0; n < 2; ++n) acc[a][b][m][n] = (f32x4){0.f, 0.f, 0.f, 0.f};
    bf16x8 At[4][2], B0[2][2], B1[2][2];
    const char* cA = (const char*)g.A + (size_t)cur.pm * tstep; const char* cB = (const char*)g.Bt + (size_t)cur.pn * tstep;
    S.a_ready(cur);
    if constexpr (SP2) {
        PG8_STAGE(PG8_SB(0, 0), cB, voffB); PG8_STAGE(PG8_SB(0, 1), cB + hstep, voffB); PG8_STAGE(PG8_SA(0, 0), cA, voffA); PG8_STAGE(PG8_SA(0, 1), cA + hstep, voffA);
        if (wr == 1) PG8_BAR;
        PG8_WAIT_V(2); PG8_BAR;
        PG8_STAGE(PG8_SB(1, 0), cB + kstep, voffB); PG8_STAGE(PG8_SA(1, 0), cA + kstep, voffA); PG8_STAGE(PG8_SB(1, 1), cB + hstep + kstep, voffB);
        PG8_WAIT_V(6); PG8_BAR;
    } else {
        PG8_STAGE(PG8_SB(0, 0), cB, voffB); PG8_STAGE(PG8_SA(0, 0), cA, voffA); PG8_STAGE(PG8_SB(0, 1), cB + hstep, voffB); PG8_STAGE(PG8_SA(0, 1), cA + hstep, voffA);
        if (wr == 1) PG8_BAR;
        PG8_WAIT_V(4); PG8_BAR;
        PG8_STAGE(PG8_SB(1, 0), cB + kstep, voffB); PG8_STAGE(PG8_SA(1, 0), cA + kstep, voffA); PG8_STAGE(PG8_SB(1, 1), cB + hstep + kstep, voffB);
        PG8_WAIT_V(6); PG8_BAR;
    }
    for (;;) {
        const bool has_next = S.next(ui + 1, nxt);
        const char* nA = has_next ? (const char*)g.A + (size_t)nxt.pm * tstep : cA; const char* nB = has_next ? (const char*)g.Bt + (size_t)nxt.pn * tstep : cB;
        for (int t = 0; t < nt; t += 2) {
            const bool last = (t == nt - 2);
            const char* a1 = cA + (size_t)(t + 1) * kstep;
            const char* a2 = last ? nA : cA + (size_t)(t + 2) * kstep; const char* b2 = last ? nB : cB + (size_t)(t + 2) * kstep;
            const char* a3 = a2 + kstep; const char* b3 = b2 + kstep;
            if (last && has_next) S.a_ready(nxt);
            if constexpr (SP2) {
            PG8_LDB(B0, 0, 0); PG8_LDB(B1, 0, 1); PG8_SCHED; PG8_LDA(At, 0, 0); PG8_STAGE(PG8_SA(1, 1), a1 + hstep, voffA);
            PG8_WAIT_V(8); PG8_WAIT_L(0); PG8_BAR; PG8_MMA(0, 0, At, B0); PG8_MMA(0, 1, At, B1); PG8_BAR; PG8_SCHED;
            PG8_LDA(At, 0, 1); PG8_STAGE(PG8_SB(0, 0), b2, voffB); PG8_STAGE(PG8_SB(0, 1), b2 + hstep, voffB); PG8_STAGE(PG8_SA(0, 0), a2, voffA);
            PG8_WAIT_V(8); PG8_WAIT_L(0); PG8_BAR; PG8_MMA(1, 0, At, B0); PG8_MMA(1, 1, At, B1); PG8_BAR; PG8_SCHED;
            PG8_LDB(B0, 1, 0); PG8_LDB(B1, 1, 1); PG8_SCHED; PG8_LDA(At, 1, 0); PG8_STAGE(PG8_SA(0, 1), a2 + hstep, voffA);
            PG8_WAIT_V(8); PG8_WAIT_L(0); PG8_BAR; PG8_MMA(0, 0, At, B0); PG8_MMA(0, 1, At, B1); PG8_BAR; PG8_SCHED;
            PG8_LDA(At, 1, 1); PG8_STAGE(PG8_SB(1, 0), b3, voffB); PG8_STAGE(PG8_SB(1, 1), b3 + hstep, voffB); PG8_STAGE(PG8_SA(1, 0), a3, voffA);
            PG8_WAIT_V(8); PG8_WAIT_L(0); PG8_BAR; PG8_MMA(1, 0, At, B0); PG8_MMA(1, 1, At, B1); PG8_BAR; PG8_SCHED;
            } else {
            PG8_LDB(B0, 0, 0); PG8_SCHED; PG8_LDA(At, 0, 0); PG8_STAGE(PG8_SA(1, 1), a1 + hstep, voffA);
            PG8_WAIT_L(8); PG8_BAR; PG8_WAIT_L(0); PG8_MMA(0, 0, At, B0); PG8_BAR; PG8_SCHED;
            PG8_LDB(B1, 0, 1); PG8_STAGE(PG8_SB(0, 0), b2, voffB);
            PG8_BAR; PG8_WAIT_L(0); PG8_MMA(0, 1, At, B1); PG8_BAR;
            PG8_LDA(At, 0, 1); PG8_STAGE(PG8_SA(0, 0), a2, voffA);
            PG8_BAR; PG8_WAIT_L(0); PG8_MMA(1, 0, At, B0); PG8_BAR; PG8_SCHED;
            PG8_STAGE(PG8_SB(0, 1), b2 + hstep, voffB);
            PG8_WAIT_V(6); PG8_BAR; PG8_MMA(1, 1, At, B1); PG8_BAR;
            PG8_LDB(B0, 1, 0); PG8_SCHED; PG8_LDA(At, 1, 0); PG8_STAGE(PG8_SA(0, 1), a2 + hstep, voffA);
            PG8_WAIT_L(8); PG8_BAR; PG8_WAIT_L(0); PG8_MMA(0, 0, At, B0); PG8_BAR; PG8_SCHED;
            PG8_LDB(B1, 1, 1); PG8_STAGE(PG8_SB(1, 0), b3, voffB);
            PG8_BAR; PG8_WAIT_L(0); PG8_MMA(0, 1, At, B1); PG8_BAR;
            PG8_LDA(At, 1, 1); PG8_STAGE(PG8_SA(1, 0), a3, voffA);
            PG8_BAR; PG8_WAIT_L(0); PG8_MMA(1, 0, At, B0); PG8_BAR; PG8_SCHED;
            PG8_STAGE(PG8_SB(1, 1), b3 + hstep, voffB);
            PG8_WAIT_V(6); PG8_BAR; PG8_MMA(1, 1, At, B1); PG8_BAR;
            }
        }
        if constexpr (ALIGN_EPI) { if (wr == 0) PG8_BAR; }
        { E(acc, cur, wr, wc, fr, fq, esc, tid); S.done(cur); }
        if (!has_next) break;
#pragma unroll
        for (int a = 0; a < 2; ++a)
#pragma unroll
            for (int b = 0; b < 2; ++b)
#pragma unroll
                for (int m = 0; m < 4; ++m)
#pragma unroll
                    for (int n = 0; n < 2; ++n) acc[a][b][m][n] = (f32x4){0.f, 0.f, 0.f, 0.f};
        cur = nxt; cA = nA; cB = nB; ++ui;
        if constexpr (ALIGN_EPI) { if (wr == 1) PG8_BAR; }
    }
    PG8_WAIT_V(0);
    if constexpr (!ALIGN_EPI) { if (wr == 0) PG8_BAR; }
    PG8_BAR;
#undef PG8_SA
#undef PG8_SB
#undef PG8_STAGE
#undef PG8_LDA
#undef PG8_LDB
#undef PG8_MMA
#undef PG8_WAIT_V
#undef PG8_WAIT_L
#undef PG8_BAR
#undef PG8_SCHED
}
}

typedef float f32x4 __attribute__((ext_vector_type(4)));
typedef short bf16x8 __attribute__((ext_vector_type(8)));


__device__ __forceinline__ void build_rs(const float* ssq, int pm, LAS unsigned char* esc, int tid) {
    LAS float* rsT = (LAS float*)esc;
    WG_BAR();
    if (tid < 256) {
        float s = 0.f;
#pragma unroll
        for (int j = 0; j < 8; ++j) { const gu64* p = (const gu64*)(ssq + ((size_t)j * MP + pm * 256 + tid) * 4);
#pragma unroll
            for (int h = 0; h < 2; ++h) { const unsigned long long v = __hip_atomic_load(p + h, RLX_AGENT); s += __builtin_bit_cast(float, (unsigned)v) + __builtin_bit_cast(float, (unsigned)(v >> 32)); } }
        rsT[tid] = rsqrtf(s * (1.0f / DM) + EPS);
    }
    WG_BAR();
}

struct EpiProj {
    static constexpr bool PERM = false, AFTER_DRAIN = false;
    unsigned char* ws_; float* out_; const float* gq; const float* gk; int l;
    __device__ __forceinline__ void operator()(f32x4 (&acc)[2][2][4][2], const pg8::Unit& u, int wr, int wc, int fr, int fq, LAS unsigned char* esc, int tid) const {
        asm volatile("" : "+v"(fr), "+v"(fq), "+v"(tid));
        unsigned char* ws = ws_; asm volatile("" : "+s"(ws));
        const float* ssq = (const float*)(ws + WS_SSQ); const float* ropec = (const float*)(ws + WS_ROPE); const float* ropes = ropec + ROPE_N;
        bf16* Q = (bf16*)(ws + WS_Q); bf16* K = (bf16*)(ws + WS_K); bf16* VT = (bf16*)(ws + WS_VT); float* U = (float*)(ws + WS_U); float* XP = (float*)(ws + WS_XP);
        float* ksn = (float*)(ws + WS_KSN); float* vsn = ksn + NSAMP * 256;
        float* out_pk = out_ + O_PK + (size_t)l * NBATCH * 128 * 256; float* out_pv = out_ + O_PV + (size_t)l * NBATCH * 128 * 256;
        build_rs(ssq, u.pm, esc, tid);
        const LAS float* rsT = (const LAS float*)esc;
        LAS float* hss = (LAS float*)(esc + 1024);
        const int pn = u.pn;
#pragma unroll
        for (int ai = 0; ai < 2; ++ai)
#pragma unroll
            for (int m = 0; m < 4; ++m) { const float rsv = rsT[ai * 128 + wr * 64 + m * 16 + fr];
#pragma unroll
                for (int bj = 0; bj < 2; ++bj)
#pragma unroll
                    for (int n = 0; n < 2; ++n) acc[ai][bj][m][n] *= rsv; }
        if (pn <= 4) {
#pragma unroll
            for (int ai = 0; ai < 2; ++ai)
#pragma unroll
                for (int m = 0; m < 4; ++m)
#pragma unroll
                    for (int bj = 0; bj < 2; ++bj) { const f32x4 a = acc[ai][bj][m][0], b = acc[ai][bj][m][1];
                        float s = (a[0] * a[0] + a[1] * a[1]) + (a[2] * a[2] + a[3] * a[3]) + (b[0] * b[0] + b[1] * b[1]) + (b[2] * b[2] + b[3] * b[3]);
                        s += __shfl_xor(s, 16); s += __shfl_xor(s, 32);
                        if (fq == 0) hss[(bj * 256 + ai * 128 + wr * 64 + m * 16 + fr) * 4 + wc] = s; }
            WG_BAR();
            const float* g = (pn < 4) ? gq : gk; const float osc = (pn < 4) ? QSCALE : 1.0f;
            f32x4 gv[2];
#pragma unroll
            for (int n = 0; n < 2; ++n) gv[n] = *(const f32x4*)(g + wc * 32 + n * 16 + 4 * fq);
#pragma unroll
            for (int ai = 0; ai < 2; ++ai)
#pragma unroll
                for (int m = 0; m < 4; ++m) {
                    const int rl = ai * 128 + wr * 64 + m * 16 + fr, r = u.pm * 256 + rl;
                    const bool samp = r >= SROW0, pad = r >= MR;
                    const int b = (r >= TT && !samp) ? 1 : 0, t = r - b * TT;
                    const int pidx = samp ? ROPE_SAMPLE_IDX : t;
                    f32x4 cs = {1.f, 1.f, 1.f, 1.f}, sn = {0.f, 0.f, 0.f, 0.f};
                    if (wc == 0 && !pad) { cs = *(const f32x4*)(ropec + (size_t)pidx * 16 + 4 * fq); sn = *(const f32x4*)(ropes + (size_t)pidx * 16 + 4 * fq); }
#pragma unroll
                    for (int bj = 0; bj < 2; ++bj) {
                        const f32x4 hv = *(const LAS f32x4*)(hss + (bj * 256 + rl) * 4);
                        const float hn = rsqrtf(((hv[0] + hv[1]) + (hv[2] + hv[3])) * (1.0f / 128.0f) + EPS);
                        f32x4 x1 = acc[ai][bj][m][0] * hn * gv[0], x2 = acc[ai][bj][m][1] * hn * gv[1];
                        if (wc == 0) { const f32x4 o1 = x1 * cs - x2 * sn, o2 = x2 * cs + x1 * sn; x1 = o1; x2 = o2; }
                        x1 = x1 * osc; x2 = x2 * osc;
                        const int cl = bj * 128 + wc * 32 + 4 * fq;
                        if (pn < 4) { bf16* qp = Q + (size_t)r * 1024 + pn * 256 + cl;
                            *(v2u*)qp = (v2u){pk2(x1[0], x1[1]), pk2(x1[2], x1[3])}; *(v2u*)(qp + 16) = (v2u){pk2(x2[0], x2[1]), pk2(x2[2], x2[3])}; }
                        else { bf16* kp = K + (size_t)r * 256 + cl;
                            *(v2u*)kp = (v2u){pk2(x1[0], x1[1]), pk2(x1[2], x1[3])}; *(v2u*)(kp + 16) = (v2u){pk2(x2[0], x2[1]), pk2(x2[2], x2[3])};
                            if (samp && !pad) { float* o = ksn + (size_t)(r - SROW0) * 256 + cl; *(f32x4*)o = x1; *(f32x4*)(o + 16) = x2; }
                            else if (!samp && t >= TT - 128) { float* o = out_pk + ((size_t)(b * 128 + (t - (TT - 128))) * 256) + cl; *(f32x4*)o = x1; *(f32x4*)(o + 16) = x2; } }
                    }
                }
        } else if (pn == 5) {
#pragma unroll
            for (int ai = 0; ai < 2; ++ai)
#pragma unroll
                for (int m = 0; m < 4; ++m) {
                    const int rl = ai * 128 + wr * 64 + m * 16 + fr, r = u.pm * 256 + rl;
                    const bool samp = r >= SROW0, pad = r >= MR;
                    const int b = (r >= TT && !samp) ? 1 : 0, t = r - b * TT;
                    const int tpos = (t & ~15) + perm16(t & 15);
#pragma unroll
                    for (int bj = 0; bj < 2; ++bj)
#pragma unroll
                        for (int n = 0; n < 2; ++n) { const f32x4 x = acc[ai][bj][m][n]; const int d = wc * 32 + n * 16 + 4 * fq;
                            if (!samp) { bf16* vp = VT + ((size_t)((b * 2 + bj) * 128 + d)) * TPV + tpos;
#pragma unroll
                                for (int j = 0; j < 4; ++j) vp[(size_t)j * TPV] = (bf16)(pk2(x[j], 0.f) & 0xffffu);
                                if (t >= TT - 128) *(f32x4*)(out_pv + ((size_t)(b * 128 + (t - (TT - 128))) * 256) + bj * 128 + d) = x; }
                            else if (!pad) *(f32x4*)(vsn + (size_t)(r - SROW0) * 256 + bj * 128 + d) = x; }
                }
        } else {
            float* dst = (pn < 8) ? U + (pn - 6) * 256 : XP + (pn - 8) * 256;
#pragma unroll
            for (int ai = 0; ai < 2; ++ai)
#pragma unroll
                for (int m = 0; m < 4; ++m) { float* rp = dst + (size_t)(u.pm * 256 + ai * 128 + wr * 64 + m * 16 + fr) * 512 + wc * 32 + 4 * fq;
#pragma unroll
                    for (int bj = 0; bj < 2; ++bj)
#pragma unroll
                        for (int n = 0; n < 2; ++n) *(f32x4*)(rp + bj * 128 + n * 16) = acc[ai][bj][m][n]; }
        }
    }
};

struct EpiRes {
    static constexpr bool PERM = false, AFTER_DRAIN = false;
    float* X; bf16* XB; float* ssq; float* out; int last;
    __device__ __forceinline__ void operator()(f32x4 (&acc)[2][2][4][2], const pg8::Unit& u, int wr, int wc, int fr, int fq, LAS unsigned char* esc, int tid) const {
        asm volatile("" : "+v"(fr), "+v"(fq), "+v"(tid));
#pragma unroll
        for (int ai = 0; ai < 2; ++ai)
#pragma unroll
            for (int m = 0; m < 4; ++m) {
                const int r = u.pm * 256 + ai * 128 + wr * 64 + m * 16 + fr; const int c0 = u.pn * 256 + wc * 32 + 4 * fq;
                float* xp = X + (size_t)r * DM + c0; float s = 0.f;
                f32x4 v[2][2];
#pragma unroll
                for (int bj = 0; bj < 2; ++bj)
#pragma unroll
                    for (int n = 0; n < 2; ++n) { v[bj][n] = *(const f32x4*)(xp + bj * 128 + n * 16) + acc[ai][bj][m][n]; const f32x4 q = v[bj][n] * v[bj][n]; s += (q[0] + q[1]) + (q[2] + q[3]); }
                if (!last) {
                    bf16* bp = XB + (size_t)r * DM + c0;
#pragma unroll
                    for (int bj = 0; bj < 2; ++bj)
#pragma unroll
                        for (int n = 0; n < 2; ++n) { *(f32x4*)(xp + bj * 128 + n * 16) = v[bj][n]; *(v2u*)(bp + bj * 128 + n * 16) = (v2u){pk2(v[bj][n][0], v[bj][n][1]), pk2(v[bj][n][2], v[bj][n][3])}; }
                    s += __shfl_xor(s, 16); s += __shfl_xor(s, 32);
                    if (fq == 0) ssq[((size_t)u.pn * MP + r) * 4 + wc] = s;
                } else {
                    const bool samp = r >= SROW0, pad = r >= MR; const int b = (r >= TT && !samp) ? 1 : 0, t = r - b * TT;
                    float* op = nullptr;
                    if (samp) { if (!pad) op = out + O_YS + (size_t)(r - SROW0) * DM + c0; } else if (t >= NMETA) op = out + O_YP + ((size_t)b * NSEQ + (t - NMETA)) * DM + c0;
                    if (op) {
#pragma unroll
                        for (int bj = 0; bj < 2; ++bj)
#pragma unroll
                            for (int n = 0; n < 2; ++n) *(f32x4*)(op + bj * 128 + n * 16) = v[bj][n]; }
                }
                if (m & 1) asm volatile("" ::: "memory");
            }
    }
};

struct EpiFfn1 {
    static constexpr bool PERM = true, AFTER_DRAIN = false;
    const float* ssq; bf16* H;
    __device__ __forceinline__ void operator()(f32x4 (&acc)[2][2][4][2], const pg8::Unit& u, int wr, int wc, int fr, int fq, LAS unsigned char* esc, int tid) const {
        asm volatile("" : "+v"(fr), "+v"(fq), "+v"(tid));
        build_rs(ssq, u.pm, esc, tid);
        const LAS float* rsT = (const LAS float*)esc;
#pragma unroll
        for (int ai = 0; ai < 2; ++ai)
#pragma unroll
            for (int m = 0; m < 4; ++m) { const int rl = ai * 128 + wr * 64 + m * 16 + fr; const float rsv = rsT[rl];
                bf16* rowp = H + (size_t)(u.pm * 256 + rl) * DFF + u.pn * 256 + wc * 32 + 8 * fq;
#pragma unroll
                for (int bj = 0; bj < 2; ++bj) { f32x4 v0 = acc[ai][bj][m][0] * rsv, v1 = acc[ai][bj][m][1] * rsv;
#pragma unroll
                    for (int j = 0; j < 4; ++j) { const float a = fmaxf(v0[j], 0.f), b = fmaxf(v1[j], 0.f); v0[j] = a * a; v1[j] = b * b; }
                    *(v4u*)(rowp + bj * 128) = (v4u){pk2(v0[0], v0[1]), pk2(v0[2], v0[3]), pk2(v1[0], v1[1]), pk2(v1[2], v1[3])}; } }
    }
};

#define XB_TMO      128
#define XB_XCNT(j)  (256  + 64 * (j))
#define XB_XSUB(j)  (1280 + 64 * (j))
#define XB_XGEN(j)  (2304 + 64 * (j))
#define XB_TOP      3328
#define XB_TOPGEN   3392
#define XCD_BAR_WORDS 3456
#define XB_SPIN_CAP (1u << 18)
__device__ __forceinline__ unsigned xb_ld(unsigned* p)              { return __hip_atomic_load(p, __ATOMIC_RELAXED, __HIP_MEMORY_SCOPE_AGENT); }
__device__ __forceinline__ unsigned xb_add(unsigned* p, unsigned v) { return __hip_atomic_fetch_add(p, v, __ATOMIC_RELAXED, __HIP_MEMORY_SCOPE_AGENT); }
__device__ __forceinline__ unsigned xb_xcc_id() { return (unsigned)__builtin_amdgcn_s_getreg((3 << 11) | 20) & 0xFu; }
#define XB_SPIN(cond, bar) do { unsigned _sp = 0; while (cond) { __builtin_amdgcn_s_sleep(1); \
    if ((++_sp & 255u) == 0u) { if (xb_ld(&(bar)[XB_TMO])) break; if (_sp > XB_SPIN_CAP) { atomicAdd(&(bar)[XB_TMO], 1u); break; } } } } while (0)

struct XcdBarrier {
    unsigned* bar; unsigned x;
    volatile LAS unsigned* st;
};

__device__ __forceinline__ XcdBarrier xcd_barrier_post(unsigned* bar, volatile LAS unsigned* st) {
    XcdBarrier b; b.bar = bar; b.x = xb_xcc_id(); b.st = st;
    if (threadIdx.x == 0) (void)xb_add(&bar[XB_XCNT(b.x)], 1u);
    return b;
}
__device__ __forceinline__ void xcd_barrier_complete(unsigned* bar, unsigned x, unsigned& nloc, unsigned& nx) {
    const unsigned G = gridDim.x * gridDim.y * gridDim.z;
    unsigned sum, cnt, mine, sp = 0u;
    for (;;) {
        sum = 0u; cnt = 0u; mine = 0u;
#pragma unroll
        for (unsigned j = 0; j < 16; ++j) { const unsigned c = xb_ld(&bar[XB_XCNT(j)]); sum += c; cnt += (c > 0u) ? 1u : 0u; mine = (j == x) ? c : mine; }
        if (sum == G) break;
        __builtin_amdgcn_s_sleep(1);
        if ((++sp & 255u) == 0u) { if (xb_ld(&bar[XB_TMO])) break; if (sp > XB_SPIN_CAP) { atomicAdd(&bar[XB_TMO], 1u); break; } }
    }
    nloc = mine > 0u ? mine : 1u; nx = cnt > 0u ? cnt : 1u;
}

__device__ __forceinline__ void xcd_barrier(const XcdBarrier& b) {
    asm volatile("s_waitcnt vmcnt(0)" ::: "memory");
    __syncthreads();
    if (threadIdx.x == 0) {
        unsigned* bar = b.bar;
        __builtin_amdgcn_s_waitcnt(0);
        unsigned nloc = b.st[0], nx = b.st[1];
        if (nloc == 0u) { xcd_barrier_complete(bar, b.x, nloc, nx); b.st[0] = nloc; b.st[1] = nx; }
        const unsigned old = xb_add(&bar[XB_XSUB(b.x)], 1u);
        const unsigned gen = old / nloc;
        if (old + 1u == (gen + 1u) * nloc) {
            __builtin_amdgcn_fence(__ATOMIC_RELEASE, "agent");
            asm volatile("s_waitcnt vmcnt(0)" ::: "memory");
            const unsigned og = xb_add(&bar[XB_TOP], 1u);
            const unsigned tg = og / nx;
            if (og + 1u == (tg + 1u) * nx) xb_add(&bar[XB_TOPGEN], 1u);
            else XB_SPIN(xb_ld(&bar[XB_TOPGEN]) == tg, bar);
            __builtin_amdgcn_fence(__ATOMIC_ACQUIRE, "agent");
            xb_add(&bar[XB_XGEN(b.x)], 1u);
            asm volatile("s_waitcnt vmcnt(0)" ::: "memory");
        } else {
            XB_SPIN(xb_ld(&bar[XB_XGEN(b.x)]) == gen, bar);
            __builtin_amdgcn_fence(__ATOMIC_ACQUIRE, "agent");
            asm volatile("s_waitcnt vmcnt(0)" ::: "memory");
        }
    }
    __syncthreads();
}

struct Frame {
    LAS unsigned char* lds;
    volatile LAS unsigned* MISC;
    gu32* ctl;
    int tid, lane, wave, vcu, G;
    float* out; unsigned char* ws;
};
#define IN_XPROMPT 0
#define IN_XSAMPLE 1
#define IN_CACHEK 2
#define IN_CACHEV 3
#define IN_SSMRE 4
#define IN_SSMIM 5
#define IN_SPOOL 6
#define IN_META 7
#define IN_GMIX 8
#define IN_WIN 9
#define IN_GQ 10
#define IN_GK 11
#define IN_SINKS 12
#define IN_ARE 13
#define IN_AIM 14
#define IN_LOGDT 15
#define IN_BRE 16
#define IN_BIM 17
#define IN_CRE 18
#define IN_CIM 19
#define IN_DSKIP 20
#define IN_WGLU 21
#define IN_BGLU 22
#define IN_WPOOL 23
#define IN_PSCALE 24
#define IN_GOA 25
#define IN_GOS 26
#define IN_GOP 27
#define IN_WOUT 28
#define IN_GFFN 29
#define IN_WFF1 30
#define IN_WFF2 31
struct Args { const float* in[32]; float* out; unsigned char* ws; int ph_lo, ph_hi; };
static_assert(sizeof(Args) == 32 * 8 + 8 + 8 + 8, "Args has no padding");

__device__ __forceinline__ void p0_transpose_item(const float* W, int K, int N, bf16* WT, const float* gain, LAS float* scr, int item, int lane) {
    const int nblk = N / 32, kb = item / nblk, nb = item % nblk, k0 = 64 * kb, n0 = 32 * nb;
#pragma unroll 8
    for (int i = 0; i < 32; ++i) { const int kk = 2 * i + (lane >> 5); float v = W[(size_t)(k0 + kk) * N + n0 + (lane & 31)]; if (gain) v *= gain[k0 + kk]; scr[kk * 33 + (lane & 31)] = v; }
    LDS_WAIT(); asm volatile("" ::: "memory");
    const int c = lane & 7;
#pragma unroll
    for (int j = 0; j < 4; ++j) { const int n = (lane >> 3) + 8 * j; const LAS float* s = scr + (8 * c) * 33 + n;
        v4u o; o.x = pk2(s[0 * 33], s[1 * 33]); o.y = pk2(s[2 * 33], s[3 * 33]); o.z = pk2(s[4 * 33], s[5 * 33]); o.w = pk2(s[6 * 33], s[7 * 33]);
        *(GAS v4u*)(WT + (size_t)(n0 + n) * K + k0 + 8 * c) = o; }
    LDS_WAIT(); asm volatile("" ::: "memory");
}
__device__ __forceinline__ void sincos_d(double x, double& s, double& c) {
    const double TWO_PI = 6.283185307179586476925286766559;
    const double k = rint(x * (1.0 / TWO_PI)); const double r = fma(-k, TWO_PI, x), r2 = r * r;
    const double fs[14] = {0.16666666666666666, 0.05, 0.023809523809523808, 0.013888888888888888, 0.00909090909090909, 0.00641025641025641, 0.004761904761904762, 0.003676470588235294,
                           0.0029239766081871343, 0.002380952380952381, 0.001976284584980237, 0.0016666666666666668, 0.0014245014245014246, 0.0012315270935960591};
    const double fc[14] = {0.5, 0.08333333333333333, 0.03333333333333333, 0.017857142857142856, 0.011111111111111112, 0.007575757575757576, 0.005494505494505495, 0.004166666666666667,
                           0.0032679738562091504, 0.002631578947368421, 0.0021645021645021645, 0.0018115942028985507, 0.0015384615384615385, 0.0013227513227513227};
    double ts = r, tc = 1.0; s = r; c = 1.0;
#pragma unroll
    for (int i = 0; i < 14; ++i) { ts *= -r2 * fs[i]; s += ts; tc *= -r2 * fc[i]; c += tc; }
}
__device__ __forceinline__ double exp_small(double x) {
    double t = 1.0, e = 1.0;
#pragma unroll
    for (int i = 1; i <= 14; ++i) { t *= x * (1.0 / i); e += t; }
    return e;
}
__device__ __forceinline__ void p0_prologue(const Args& AR, Frame& F) {
    LAS float* scr = (LAS float*)(F.lds + F.wave * 16384);
    const int gw = F.vcu * 8 + F.wave, NGW = F.G * 8, lane = F.lane;
    unsigned char* ws = F.ws;
    constexpr int I_IN = (DM / 64) * (INW / 32), I_OUT = (DM / 64) * (DM / 32), I_1 = (DM / 64) * (DFF / 32), I_2 = (DFF / 64) * (DM / 32), I_GLU = (512 / 64) * (512 / 32), I_POOL = 4 * 2 * 4;
    constexpr int I_LAYER = I_IN + I_OUT + I_1 + I_2 + I_GLU + I_POOL;
    for (int it = gw; it < NLAYER * I_LAYER; it += NGW) {
        const int l = it / I_LAYER; int r = it % I_LAYER;
        if (r < I_IN) { p0_transpose_item(AR.in[IN_WIN] + (size_t)l * DM * INW, DM, INW, (bf16*)(ws + WS_WIN) + (size_t)l * INW * DM, AR.in[IN_GMIX] + l * DM, scr, r, lane); continue; } r -= I_IN;
        if (r < I_OUT) { const int k0 = 64 * (r / (DM / 32));
            const float* g = (k0 < 1024) ? AR.in[IN_GOA] + l * 1024 : (k0 < 1536) ? AR.in[IN_GOS] + l * 512 - 1024 : AR.in[IN_GOP] + l * 512 - 1536;
            p0_transpose_item(AR.in[IN_WOUT] + (size_t)l * DM * DM, DM, DM, (bf16*)(ws + WS_WOUT) + (size_t)l * DM * DM, g, scr, r, lane); continue; } r -= I_OUT;
        if (r < I_1) { p0_transpose_item(AR.in[IN_WFF1] + (size_t)l * DM * DFF, DM, DFF, (bf16*)(ws + WS_W1) + (size_t)l * DFF * DM, AR.in[IN_GFFN] + l * DM, scr, r, lane); continue; } r -= I_1;
        if (r < I_2) { p0_transpose_item(AR.in[IN_WFF2] + (size_t)l * DFF * DM, DFF, DM, (bf16*)(ws + WS_W2) + (size_t)l * DM * DFF, nullptr, scr, r, lane); continue; } r -= I_2;
        if (r < I_GLU) { p0_transpose_item(AR.in[IN_WGLU] + (size_t)l * 512 * 512, 512, 512, (bf16*)(ws + WS_WGLU) + (size_t)l * 512 * 512, nullptr, scr, r, lane); continue; } r -= I_GLU;
        { const int g = r / 8; p0_transpose_item(AR.in[IN_WPOOL] + ((size_t)l * 4 + g) * 128 * 128, 128, 128, (bf16*)(ws + WS_WPOOL) + ((size_t)l * 4 + g) * 128 * 128, nullptr, scr, r % 8, lane); }
    }
    float* X = (float*)(ws + WS_X); bf16* XB = (bf16*)(ws + WS_XB); float* SSQ = (float*)(ws + WS_SSQ);
    for (int m = gw; m < MP; m += NGW) {
        const float* src = nullptr;
        if (m < SROW0) { const int b = m >= TT ? 1 : 0, t = m - b * TT; src = (t < NMETA) ? AR.in[IN_META] + (size_t)t * DM : AR.in[IN_XPROMPT] + ((size_t)b * NSEQ + (t - NMETA)) * DM; }
        else if (m < MR) src = AR.in[IN_XSAMPLE] + (size_t)(m - SROW0) * DM;
        float s = 0.f;
#pragma unroll
        for (int j = 0; j < 8; ++j) { f32x4 v = {0.f, 0.f, 0.f, 0.f}; if (src) v = *(const f32x4*)(src + j * 256 + lane * 4);
            s += (v[0] * v[0] + v[1] * v[1]) + (v[2] * v[2] + v[3] * v[3]);
            *(f32x4*)(X + (size_t)m * DM + j * 256 + lane * 4) = v; *(v2u*)(XB + (size_t)m * DM + j * 256 + lane * 4) = (v2u){pk2(v[0], v[1]), pk2(v[2], v[3])}; }
        s = wave_sum(s);
        if (lane < 32) SSQ[((size_t)(lane >> 2) * MP + m) * 4 + (lane & 3)] = (lane == 0) ? s : 0.f;
    }
    const int gt = gw * 64 + lane, NGT = NGW * 64;
    for (int id = gt; id < NLAYER * 32 * 64; id += NGT) {
        const int l = id >> 11, g = (id >> 6) & 31, n = id & 63;
        unsigned char* tb = ws + WS_TAB + (size_t)l * TB_LAYER;
        const double dt = (double)expf(AR.in[IN_LOGDT][l * 32 + g]);
        const double ar = (double)AR.in[IN_ARE][id], ai = (double)AR.in[IN_AIM][id];
        const double mag = exp_small(dt * ar); double sn, cs; sincos_d(dt * ai, sn, cs);
        const double abr = mag * cs, abi = mag * sn, den = ar * ar + ai * ai;
        const double fr = ((abr - 1.0) * ar + abi * ai) / den, fi = (abi * ar - (abr - 1.0) * ai) / den;
        ((float*)(tb + TB_ABR))[g * 64 + n] = (float)abr; ((float*)(tb + TB_ABI))[g * 64 + n] = (float)abi;
        const float* Br = AR.in[IN_BRE] + (size_t)id * 16; const float* Bi = AR.in[IN_BIM] + (size_t)id * 16;
        float* bbr = (float*)(tb + TB_BBR) + (size_t)(g * 64 + n) * 16; float* bbi = (float*)(tb + TB_BBI) + (size_t)(g * 64 + n) * 16;
#pragma unroll
        for (int c = 0; c < 16; ++c) { const double br = Br[c], bi = Bi[c]; bbr[c] = (float)(fr * br - fi * bi); bbi[c] = (float)(fr * bi + fi * br); }
        bf16* Pm = (bf16*)(tb + TB_PM) + (size_t)g * 64 * 128;
        double pr = abr, pi = abi;
        for (int t = 0; t < 64; ++t) {
            Pm[t * 128 + n] = (bf16)(pk2((float)pr, 0.f) & 0xffffu); Pm[t * 128 + 64 + n] = (bf16)(pk2((float)pi, 0.f) & 0xffffu);
            if (t == 15) { ((float*)(tb + TB_A16R))[g * 64 + n] = (float)pr; ((float*)(tb + TB_A16I))[g * 64 + n] = (float)pi; }
            if (t == 31) { ((float*)(tb + TB_A32R))[g * 64 + n] = (float)pr; ((float*)(tb + TB_A32I))[g * 64 + n] = (float)pi; }
            if (t == 63) { ((float*)(tb + TB_ALR))[g * 64 + n] = (float)pr; ((float*)(tb + TB_ALI))[g * 64 + n] = (float)pi; }
            const double nr = pr * abr - pi * abi, ni = pr * abi + pi * abr; pr = nr; pi = ni;
        }
        bf16* CmT = (bf16*)(tb + TB_CMT) + (size_t)g * 16 * 128;
        const float* Cr = AR.in[IN_CRE] + ((size_t)(l * 32 + g) * 16) * 64 + n; const float* Ci = AR.in[IN_CIM] + ((size_t)(l * 32 + g) * 16) * 64 + n;
#pragma unroll
        for (int c = 0; c < 16; ++c) { CmT[c * 128 + n] = (bf16)(pk2(Cr[c * 64], 0.f) & 0xffffu); CmT[c * 128 + 64 + n] = (bf16)(pk2(-Ci[c * 64], 0.f) & 0xffffu); }
    }
    float* rc = (float*)(ws + WS_ROPE); float* rs_ = rc + ROPE_N;
    for (int id = gt; id < (int)ROPE_N; id += NGT) {
        const int p = id >> 4, i = id & 15; const double pos = (p == ROPE_SAMPLE_IDX) ? 16384.0 : (double)p;
        double inv = 1.0;
        for (int k = 0; k < i; ++k) inv *= 0.44036660267178046;
        double sn, cs; sincos_d(pos * inv, sn, cs);
        rc[id] = (float)cs; rs_[id] = (float)sn;
    }
}

__device__ __forceinline__ void attn_unit(const Args& AR, Frame& F, int l, int b, int i) {
    int lane_ = F.lane; asm volatile("" : "+v"(lane_));
    unsigned char* ws = F.ws; asm volatile("" : "+s"(ws));
    const int lane = lane_, h = F.wave, c = lane & 31, hh = lane >> 5, kvh = h >> 2;
    const int t0 = 32 * i; const size_t rb = (size_t)b * TT;
    const bf16* Q = (const bf16*)(ws + WS_Q); const bf16* K = (const bf16*)(ws + WS_K); const bf16* VT = (const bf16*)(ws + WS_VT);
    bf16* MIX = (bf16*)(ws + WS_MIX);
    LAS float* ex = (LAS float*)(F.lds + ESC_OFF);
    bf16x8 qf[8];
    { const bf16* qp = Q + (rb + t0 + c) * 1024 + 128 * h + 8 * hh;
#pragma unroll
      for (int ks = 0; ks < 8; ++ks) qf[ks] = *(const bf16x8*)(qp + 16 * ks); }
    const int kt0 = (t0 >= 128) ? 0 : (4 - i);
    f32x16 S[5];
#pragma unroll
    for (int kt = 0; kt < 5; ++kt) {
#pragma unroll
        for (int r = 0; r < 16; ++r) S[kt][r] = -INFINITY;
        if (kt >= kt0) {
            const int tk0 = t0 - 128 + 32 * kt;
            const bf16* kp = K + (rb + tk0 + c) * 256 + 128 * kvh + 8 * hh;
            bf16x8 kf[8];
#pragma unroll
            for (int ks = 0; ks < 8; ++ks) kf[ks] = *(const bf16x8*)(kp + 16 * ks);
            f32x16 a = {0.f, 0.f, 0.f, 0.f, 0.f, 0.f, 0.f, 0.f, 0.f, 0.f, 0.f, 0.f, 0.f, 0.f, 0.f, 0.f};
#pragma unroll
            for (int ks = 0; ks < 8; ++ks) a = __builtin_amdgcn_mfma_f32_32x32x16_bf16(kf[ks], qf[ks], a, 0, 0, 0);
#pragma unroll
            for (int r = 0; r < 16; ++r) { const int kr = (r & 3) + 8 * (r >> 2) + 4 * hh; bool ok = true;
                if (kt == 0) ok = kr >= c;
                if (kt == 4) ok = kr <= c;
                S[kt][r] = ok ? a[r] : -INFINITY; }
        }
    }
    const float sink2 = AR.in[IN_SINKS][l * 8 + h] * LOG2E;
    float mx = sink2;
#pragma unroll
    for (int kt = 0; kt < 5; ++kt)
#pragma unroll
        for (int r = 0; r < 16; ++r) mx = fmaxf(mx, S[kt][r]);
    mx = fmaxf(mx, __shfl_xor(mx, 32));
    float sum = 0.f;
#pragma unroll
    for (int kt = 0; kt < 5; ++kt)
#pragma unroll
        for (int r = 0; r < 16; ++r) { const float p = __builtin_amdgcn_exp2f(S[kt][r] - mx); S[kt][r] = p; sum += p; }
    sum += __shfl_xor(sum, 32);
    const float inv = 1.0f / (sum + __builtin_amdgcn_exp2f(sink2 - mx));
    f32x16 O[4];
#pragma unroll
    for (int db = 0; db < 4; ++db)
#pragma unroll
        for (int r = 0; r < 16; ++r) O[db][r] = 0.f;
#pragma unroll
    for (int kt = 0; kt < 5; ++kt) {
        if (kt >= kt0) {
            const int tk0 = t0 - 128 + 32 * kt;
#pragma unroll
            for (int s = 0; s < 2; ++s) {
                v4u pw; pw.x = pk2(S[kt][8 * s + 0], S[kt][8 * s + 1]); pw.y = pk2(S[kt][8 * s + 2], S[kt][8 * s + 3]); pw.z = pk2(S[kt][8 * s + 4], S[kt][8 * s + 5]); pw.w = pk2(S[kt][8 * s + 6], S[kt][8 * s + 7]);
                const bf16x8 pf = __builtin_bit_cast(bf16x8, pw);
#pragma unroll
                for (int db = 0; db < 4; ++db) {
                    const bf16x8 vf = *(const bf16x8*)(VT + ((size_t)((b * 2 + kvh) * 128 + 32 * db + c)) * TPV + tk0 + 16 * s + 8 * hh);
                    O[db] = __builtin_amdgcn_mfma_f32_32x32x16_bf16(vf, pf, O[db], 0, 0, 0);
                }
            }
        }
    }
    float ss = 0.f;
#pragma unroll
    for (int db = 0; db < 4; ++db)
#pragma unroll
        for (int r = 0; r < 16; ++r) { O[db][r] *= inv; ss += O[db][r] * O[db][r]; }
    ss += __shfl_xor(ss, 32);
    if (hh == 0) ex[h * 32 + c] = ss;
    WG_BAR();
    float tot = 0.f;
#pragma unroll
    for (int j = 0; j < 8; ++j) tot += ex[j * 32 + c];
    const float rsa = rsqrtf(tot * (1.0f / 1024.0f) + EPS);
    if (t0 + c < TT) {
        bf16* mp = MIX + (rb + t0 + c) * DM + 128 * h + 4 * hh;
#pragma unroll
        for (int db = 0; db < 4; ++db)
#pragma unroll
            for (int g4 = 0; g4 < 4; ++g4)
                *(v2u*)(mp + 32 * db + 8 * g4) = (v2u){pk2(O[db][4 * g4 + 0] * rsa, O[db][4 * g4 + 1] * rsa), pk2(O[db][4 * g4 + 2] * rsa, O[db][4 * g4 + 3] * rsa)};
    }
    WG_BAR();
}

__device__ __forceinline__ void sattn_unit(const Args& AR, Frame& F, int l, int s) {
    int tid_ = F.tid; asm volatile("" : "+v"(tid_));
    const int tid = tid_, lane = tid & 63, wave = F.wave;
    LAS float* qs = (LAS float*)F.lds;
    LAS float* sc = qs + 1024;
    LAS float* part = sc + 8 * 132;
    LAS float* red = part + 4096;
    const size_t row = SROW0 + s;
    const bf16* Q = (const bf16*)(F.ws + WS_Q) + row * 1024;
    const float* ksn = (const float*)(F.ws + WS_KSN) + (size_t)s * 256; const float* vsn = ksn + NSAMP * 256;
    const float* ck = AR.in[IN_CACHEK] + ((size_t)(l * NSAMP + s)) * 128 * 256; const float* cv = AR.in[IN_CACHEV] + ((size_t)(l * NSAMP + s)) * 128 * 256;
    for (int j = tid; j < 1024; j += 512) qs[j] = bf2f(Q[j]);
    WG_BAR();
    { const int key = tid >> 2, pt = tid & 3;
#pragma unroll
      for (int kvh = 0; kvh < 2; ++kvh) {
          const float* kp = ck + (size_t)key * 256 + kvh * 128 + 32 * pt; float d[4] = {0.f, 0.f, 0.f, 0.f};
#pragma unroll
          for (int j = 0; j < 8; ++j) { const f32x4 kv = *(const f32x4*)(kp + 4 * j);
#pragma unroll
              for (int g = 0; g < 4; ++g) { const f32x4 qv = *(const LAS f32x4*)(qs + (4 * kvh + g) * 128 + 32 * pt + 4 * j); d[g] += (kv[0] * qv[0] + kv[1] * qv[1]) + (kv[2] * qv[2] + kv[3] * qv[3]); } }
#pragma unroll
          for (int g = 0; g < 4; ++g) { d[g] += __shfl_xor(d[g], 1); d[g] += __shfl_xor(d[g], 2); if (pt == 0) sc[(4 * kvh + g) * 132 + key] = d[g]; }
      } }
    {
      const int h = wave, kvh = h >> 2; float d = ksn[kvh * 128 + lane] * qs[h * 128 + lane] + ksn[kvh * 128 + 64 + lane] * qs[h * 128 + 64 + lane];
      d = wave_sum(d); if (lane == 0) sc[h * 132 + 128] = d; }
    WG_BAR();
    { const int h = wave; const float sink2 = AR.in[IN_SINKS][l * 8 + h] * LOG2E;
      const float v0 = sc[h * 132 + lane], v1 = sc[h * 132 + 64 + lane], v2 = (lane == 0) ? sc[h * 132 + 128] : -INFINITY;
      const float mx = fmaxf(wave_max(fmaxf(fmaxf(v0, v1), v2)), sink2);
      const float p0 = __builtin_amdgcn_exp2f(v0 - mx), p1 = __builtin_amdgcn_exp2f(v1 - mx), p2 = __builtin_amdgcn_exp2f(v2 - mx);
      const float inv = 1.0f / (wave_sum(p0 + p1 + p2) + __builtin_amdgcn_exp2f(sink2 - mx));
      sc[h * 132 + lane] = p0 * inv; sc[h * 132 + 64 + lane] = p1 * inv; if (lane == 0) sc[h * 132 + 128] = p2 * inv; }
    WG_BAR();
    { const int d = tid & 127, kq = tid >> 7;
#pragma unroll
      for (int kvh = 0; kvh < 2; ++kvh) { float a[4] = {0.f, 0.f, 0.f, 0.f};
#pragma unroll 8
          for (int k = 0; k < 32; ++k) { const int key = 32 * kq + k; const float v = cv[(size_t)key * 256 + kvh * 128 + d];
#pragma unroll
              for (int g = 0; g < 4; ++g) a[g] += sc[(4 * kvh + g) * 132 + key] * v; }
#pragma unroll
          for (int g = 0; g < 4; ++g) part[kq * 1024 + (4 * kvh + g) * 128 + d] = a[g]; } }
    WG_BAR();
    float o[2]; float ss = 0.f;
#pragma unroll
    for (int e = 0; e < 2; ++e) { const int j = tid + 512 * e, h = j >> 7, d = j & 127, kvh = h >> 2;
        o[e] = (part[j] + part[1024 + j]) + (part[2048 + j] + part[3072 + j]) + sc[h * 132 + 128] * vsn[kvh * 128 + d]; ss += o[e] * o[e]; }
    ss = wave_sum(ss); if (lane == 0) red[wave] = ss;
    WG_BAR();
    { float tot = 0.f;
#pragma unroll
      for (int j = 0; j < 8; ++j) tot += red[j];
      const float rsa = rsqrtf(tot * (1.0f / 1024.0f) + EPS);
      bf16* mp = (bf16*)(F.ws + WS_MIX) + row * DM;
#pragma unroll
      for (int e = 0; e < 2; ++e) mp[tid + 512 * e] = (bf16)(pk2(o[e] * rsa, 0.f) & 0xffffu); }
    { float* ok = F.out + O_SK + ((size_t)(l * NSAMP + s)) * 128 * 256; float* ov = F.out + O_SV + ((size_t)(l * NSAMP + s)) * 128 * 256;
      for (int j = tid; j < 127 * 64; j += 512) { *(f32x4*)(ok + 4 * j) = *(const f32x4*)(ck + 256 + 4 * j); *(f32x4*)(ov + 4 * j) = *(const f32x4*)(cv + 256 + 4 * j); }
      if (tid < 64) *(f32x4*)(ok + 127 * 256 + 4 * tid) = *(const f32x4*)(ksn + 4 * tid);
      else if (tid < 128) *(f32x4*)(ov + 127 * 256 + 4 * (tid - 64)) = *(const f32x4*)(vsn + 4 * (tid - 64)); }
    WG_BAR();
}

__device__ __forceinline__ float gelu_tanh(float y) {
    const float inner = 0.7978845608028654f * (y + 0.044715f * y * y * y);
    return y / (1.0f + __builtin_amdgcn_exp2f(-2.0f * LOG2E * inner));
}
__device__ __forceinline__ float sigmoidf_(float x) { return 1.0f / (1.0f + __builtin_amdgcn_exp2f(-LOG2E * x)); }
#define SWZ(r, ch, PITCH) ((r) * (PITCH) + ((((ch)) ^ ((r) & 15)) << 4))

#define SSM_ROWS4(BODY_PRE, BODY_POST) \
    _Pragma("unroll") for (int r4 = 0; r4 < 4; ++r4) { const int r = rbase + r4; BODY_PRE \
        f32x2 xx = {0.f, 0.f}; \
        _Pragma("unroll") for (int cc = 0; cc < 16; ++cc) { const float uv = __builtin_bit_cast(float, __builtin_amdgcn_readlane(__builtin_bit_cast(int, uu[cc]), r)); xx += bb[cc] * (f32x2){uv, uv}; } \
        const float nr = abr * hr - abi * hi + xx[0], ni = abr * hi + abi * hr + xx[1]; hr = nr; hi = ni; BODY_POST }
__device__ __forceinline__ void ssm_unit(const Args& AR, Frame& F, int l, int c) {
    int lane_ = F.lane; asm volatile("" : "+v"(lane_));
    const int lane = lane_, w = F.wave, n = lane, t16 = lane & 15, cq = lane >> 4;
    const int row0 = 64 * c;
    unsigned char* ws = F.ws; asm volatile("" : "+s"(ws));
    const unsigned char* tb = ws + WS_TAB + (size_t)l * TB_LAYER;
    const float* U = (const float*)(ws + WS_U);
    float* SST = (float*)(ws + WS_SST) + ((size_t)l * NCHUNK) * 32 * 128;
    gu32* flags = F.ctl + CW_SSMF + (size_t)(l * NCHUNK) * 8 * 16;
    LAS unsigned char* Zs = F.lds;
    LAS unsigned char* Hm = F.lds + 65536 + w * 8192;
    LAS float* red = (LAS float*)(F.lds + ESC_OFF);
    if (c != NCHUNK - 1) {
#pragma unroll 1
        for (int gi = 0; gi < 4; ++gi) {
            const int g = 4 * w + gi;
            const float abr = ((const float*)(tb + TB_ABR))[g * 64 + n], abi = ((const float*)(tb + TB_ABI))[g * 64 + n];
            f32x2 bb[16];
            { const f32x4* pr = (const f32x4*)((const float*)(tb + TB_BBR) + (size_t)(g * 64 + n) * 16); const f32x4* pi = (const f32x4*)((const float*)(tb + TB_BBI) + (size_t)(g * 64 + n) * 16);
#pragma unroll
              for (int j = 0; j < 4; ++j) { const f32x4 a = pr[j], b2 = pi[j];
#pragma unroll
                  for (int e = 0; e < 4; ++e) bb[4 * j + e] = (f32x2){a[e], b2[e]}; } }
            float uu[16];
            { const f32x4* pu = (const f32x4*)(U + (size_t)(row0 + lane) * 512 + 16 * g);
#pragma unroll
              for (int j = 0; j < 4; ++j) { const f32x4 a = pu[j];
#pragma unroll
                  for (int e = 0; e < 4; ++e) uu[4 * j + e] = a[e]; } }
            float hr = 0.f, hi = 0.f;
#pragma unroll 1
            for (int rbase = (c == 64) ? 16 : 0; rbase < 64; rbase += 4) { SSM_ROWS4(, ) }
            __hip_atomic_store((gu64*)(SST + ((size_t)c * 32 + g) * 128 + 2 * n), ((unsigned long long)__builtin_bit_cast(unsigned, hi) << 32) | __builtin_bit_cast(unsigned, hr), RLX_AGENT);
        }
        VM_WAIT();
        if (lane == 0) __hip_atomic_store(flags + ((size_t)c * 8 + w) * 16, 1u, RLX_AGENT);
    }
    const int cs0 = (c <= 64) ? 0 : 64, npred = c - cs0;
    if (npred > 0) {
        unsigned sp = 0; bool ok = false;
        for (;;) { ok = (lane >= npred) || (__hip_atomic_load(flags + ((size_t)(cs0 + lane) * 8 + w) * 16, RLX_AGENT) != 0u);
            if (__all(ok)) break;
            __builtin_amdgcn_s_sleep(2);
            if (++sp > (1u << 20)) { if (lane == 0) __hip_atomic_store(F.ctl + CW_TMO, 0x55u, RLX_AGENT); break; } }
        __builtin_amdgcn_fence(__ATOMIC_ACQUIRE, "agent");
        VM_WAIT();
    }
#pragma unroll 1
    for (int gi = 0; gi < 4; ++gi) {
        const int g = 4 * w + gi;
        const float abr = ((const float*)(tb + TB_ABR))[g * 64 + n], abi = ((const float*)(tb + TB_ABI))[g * 64 + n];
        float hr = 0.f, hi = 0.f;
        if (npred > 0) {
            const float aLr = ((const float*)(tb + TB_ALR))[g * 64 + n], aLi = ((const float*)(tb + TB_ALI))[g * 64 + n];
            for (int cp = cs0; cp < c; cp += 8) {
                f32x2 sv[8];
#pragma unroll
                for (int j = 0; j < 8; ++j) { const int cj = (cp + j < c) ? cp + j : c - 1; sv[j] = *(const f32x2*)(SST + ((size_t)cj * 32 + g) * 128 + 2 * n); }
#pragma unroll
                for (int j = 0; j < 8; ++j) if (cp + j < c) { const float nr = aLr * hr - aLi * hi + sv[j][0], ni = aLr * hi + aLi * hr + sv[j][1]; hr = nr; hi = ni; }
            }
        }
        f32x2 bb[16];
        { const f32x4* pr = (const f32x4*)((const float*)(tb + TB_BBR) + (size_t)(g * 64 + n) * 16); const f32x4* pi = (const f32x4*)((const float*)(tb + TB_BBI) + (size_t)(g * 64 + n) * 16);
#pragma unroll
          for (int j = 0; j < 4; ++j) { const f32x4 a = pr[j], b2 = pi[j];
#pragma unroll
              for (int e = 0; e < 4; ++e) bb[4 * j + e] = (f32x2){a[e], b2[e]}; } }
        float uu[16];
        { const f32x4* pu = (const f32x4*)(U + (size_t)(row0 + lane) * 512 + 16 * g);
#pragma unroll
          for (int j = 0; j < 4; ++j) { const f32x4 a = pu[j];
#pragma unroll
              for (int e = 0; e < 4; ++e) uu[4 * j + e] = a[e]; } }
        bf16x8 cmf[4];
        { const bf16* cm = (const bf16*)(tb + TB_CMT) + (size_t)g * 16 * 128 + t16 * 128 + 8 * cq;
#pragma unroll
          for (int ks = 0; ks < 4; ++ks) cmf[ks] = *(const bf16x8*)(cm + 32 * ks); }
        const int col = 64 * w + 16 * gi + 4 * cq;
        const f32x4 dsk = *(const f32x4*)(AR.in[IN_DSKIP] + l * 512 + col);
#pragma unroll 1
        for (int half = 0; half < 2; ++half) {
            const bool samp = (c == NCHUNK - 1) && (half == 1);
#pragma unroll 1
            for (int rbase = 32 * half; rbase < 32 * half + 32; rbase += 4) {
                float h0r[4], h0i[4];
#pragma unroll
                for (int r4 = 0; r4 < 4; ++r4) { h0r[r4] = 0.f; h0i[r4] = 0.f; }
                if (samp) {
#pragma unroll
                    for (int r4 = 0; r4 < 4; ++r4) { const size_t o = ((size_t)(l * NSAMP + (rbase - 32 + r4)) * 32 + g) * 64 + n; h0r[r4] = AR.in[IN_SSMRE][o]; h0i[r4] = AR.in[IN_SSMIM][o]; }
                }
                SSM_ROWS4(
                    if (c == 64 && r == 16) { hr = 0.f; hi = 0.f; }
                    if (samp) { hr = h0r[r4]; hi = h0i[r4]; } ,
                    { const int rl = r & 31;
                      *(LAS bf16*)(Hm + SWZ(rl, n >> 3, 256) + (n & 7) * 2) = (bf16)(pk2(hr, 0.f) & 0xffffu);
                      *(LAS bf16*)(Hm + SWZ(rl, 8 + (n >> 3), 256) + (n & 7) * 2) = (bf16)(pk2(hi, 0.f) & 0xffffu);
                      if ((c == 64 && r == 15) || (c == NCHUNK - 1 && r == 31)) { const size_t o = ((size_t)(l * NBATCH + (c == 64 ? 0 : 1)) * 32 + g) * 64 + n; F.out[O_PSR + o] = hr; F.out[O_PSI + o] = hi; }
                      if (samp) { const size_t o = ((size_t)(l * NSAMP + (r - 32)) * 32 + g) * 64 + n; F.out[O_SSR + o] = hr; F.out[O_SSI + o] = hi; } } )
            }
            LDS_WAIT();
#pragma unroll
            for (int mt = 0; mt < 2; ++mt) {
                f32x4 y = {0.f, 0.f, 0.f, 0.f};
#pragma unroll
                for (int ks = 0; ks < 4; ++ks) { const bf16x8 hf = *(const LAS bf16x8*)(Hm + SWZ(16 * mt + t16, 4 * ks + cq, 256));
                    y = __builtin_amdgcn_mfma_f32_16x16x32_bf16(cmf[ks], hf, y, 0, 0, 0); }
                const int rl = 32 * half + 16 * mt + t16;
                const f32x4 uv = *(const f32x4*)(U + (size_t)(row0 + rl) * 512 + col);
                f32x4 z;
#pragma unroll
                for (int e = 0; e < 4; ++e) z[e] = gelu_tanh(y[e] + dsk[e] * uv[e]);
                *(LAS v2u*)(Zs + SWZ(rl, col >> 3, 1024) + (col & 7) * 2) = (v2u){pk2(z[0], z[1]), pk2(z[2], z[3])};
            }
            LDS_WAIT();
        }
    }
    WG_BAR();
    f32x4 G[4][4];
#pragma unroll
    for (int mt = 0; mt < 4; ++mt)
#pragma unroll
        for (int nt = 0; nt < 4; ++nt) G[mt][nt] = (f32x4){0.f, 0.f, 0.f, 0.f};
    { const bf16* Wg = (const bf16*)(ws + WS_WGLU) + (size_t)l * 512 * 512 + (size_t)(64 * w + t16) * 512 + 8 * cq;
#pragma unroll 2
      for (int ks = 0; ks < 16; ++ks) {
          bf16x8 wf[4], zf[4];
#pragma unroll
          for (int nt = 0; nt < 4; ++nt) wf[nt] = *(const bf16x8*)(Wg + (size_t)nt * 16 * 512 + 32 * ks);
#pragma unroll
          for (int mt = 0; mt < 4; ++mt) zf[mt] = *(const LAS bf16x8*)(Zs + SWZ(16 * mt + t16, 4 * ks + cq, 1024));
#pragma unroll
          for (int mt = 0; mt < 4; ++mt)
#pragma unroll
              for (int nt = 0; nt < 4; ++nt) G[mt][nt] = __builtin_amdgcn_mfma_f32_16x16x32_bf16(wf[nt], zf[mt], G[mt][nt], 0, 0, 0);
      } }
#pragma unroll
    for (int mt = 0; mt < 4; ++mt) { float ss = 0.f; const int rl = 16 * mt + t16;
#pragma unroll
        for (int nt = 0; nt < 4; ++nt) { const int col = 64 * w + 16 * nt + 4 * cq; const f32x4 bg = *(const f32x4*)(AR.in[IN_BGLU] + l * 512 + col);
            const v2u zz = *(const LAS v2u*)(Zs + SWZ(rl, col >> 3, 1024) + (col & 7) * 2);
            const float zv[4] = {bf2f((unsigned short)(zz.x & 0xffffu)), bf2f((unsigned short)(zz.x >> 16)), bf2f((unsigned short)(zz.y & 0xffffu)), bf2f((unsigned short)(zz.y >> 16))};
#pragma unroll
            for (int e = 0; e < 4; ++e) { const float o = zv[e] * sigmoidf_(G[mt][nt][e] + bg[e]); G[mt][nt][e] = o; ss += o * o; } }
        ss += __shfl_xor(ss, 16); ss += __shfl_xor(ss, 32);
        if (cq == 0) red[rl * 8 + w] = ss; }
    WG_BAR();
    { bf16* MIX = (bf16*)(ws + WS_MIX);
#pragma unroll
      for (int mt = 0; mt < 4; ++mt) { const int rl = 16 * mt + t16; const LAS f32x4* rp = (const LAS f32x4*)(red + rl * 8); const f32x4 a = rp[0], b2 = rp[1];
          const float rsn = rsqrtf(((a[0] + a[1]) + (a[2] + a[3]) + (b2[0] + b2[1]) + (b2[2] + b2[3])) * (1.0f / 512.0f) + EPS);
          bf16* mp = MIX + (size_t)(row0 + rl) * DM + 1024 + 64 * w + 4 * cq;
#pragma unroll
          for (int nt = 0; nt < 4; ++nt) *(v2u*)(mp + 16 * nt) = (v2u){pk2(G[mt][nt][0] * rsn, G[mt][nt][1] * rsn), pk2(G[mt][nt][2] * rsn, G[mt][nt][3] * rsn)}; } }
    WG_BAR();
}
#undef SSM_ROWS4

template <int WLEN>
__device__ __forceinline__ void pool_half(const float* XP, float* out, int l, int ch, int rfirst, int rl0, LAS unsigned char* Ds) {
    float xv[48];
#pragma unroll
    for (int i = 0; i < 48; ++i) { const int ra = rfirst + i - 16; xv[i] = (ra >= 0) ? XP[(size_t)ra * 512 + ch] : 0.f; }
    int seg = (rfirst >= TT) ? TT : 0;
    float sum = 0.f;
#pragma unroll
    for (int j = 1; j <= WLEN; ++j) if (rfirst - j >= seg) sum += xv[16 - j];
#pragma unroll
    for (int i = 0; i < 32; ++i) {
        const int ra = rfirst + i; const float x = xv[16 + i];
        if (ra == TT) { seg = TT; sum = 0.f; }
        sum += x;
        if (ra - WLEN >= seg) sum -= xv[16 + i - WLEN];
        const int cnt = (ra - seg + 1 < WLEN) ? (ra - seg + 1) : WLEN;
        const float dm = sum * __builtin_amdgcn_rcpf((float)cnt) - x;
        if (ra >= TT - 15 && ra < TT) out[O_PP + ((size_t)(l * NBATCH + 0) * 15 + (ra - (TT - 15))) * 512 + ch] = x;
        if (ra >= SROW0 - 15) out[O_PP + ((size_t)(l * NBATCH + 1) * 15 + (ra - (SROW0 - 15))) * 512 + ch] = x;
        const int r = rl0 + i;
        *(LAS bf16*)(Ds + SWZ(r, ch >> 3, 1024) + (ch & 7) * 2) = (bf16)(pk2(dm, 0.f) & 0xffffu);
    }
}
template <int WLEN>
__device__ __forceinline__ void pool_sample_rows(const float* XP, const float* sp, float* out, int l, int ch, LAS unsigned char* Ds) {
#pragma unroll 2
    for (int s = 0; s < NSAMP; ++s) {
        const float* pp = sp + (size_t)s * 15 * 512; float pv[15];
#pragma unroll
        for (int j = 0; j < 15; ++j) pv[j] = pp[(size_t)j * 512];
        const float x = XP[(size_t)(SROW0 + s) * 512 + ch]; float a = x;
#pragma unroll
        for (int j = 16 - WLEN; j < 15; ++j) a += pv[j];
        const float dm = a * (1.0f / WLEN) - x;
        float* op = out + O_SP + ((size_t)(l * NSAMP + s) * 15) * 512 + ch;
#pragma unroll
        for (int j = 0; j < 14; ++j) op[(size_t)j * 512] = pv[j + 1];
        op[(size_t)14 * 512] = x;
        *(LAS bf16*)(Ds + SWZ(32 + s, ch >> 3, 1024) + (ch & 7) * 2) = (bf16)(pk2(dm, 0.f) & 0xffffu);
    }
}
__device__ __forceinline__ void pool_unit(const Args& AR, Frame& F, int l, int c) {
    int tid_ = F.tid; asm volatile("" : "+v"(tid_));
    const int tid = tid_, lane = tid & 63, w = F.wave, t16 = lane & 15, cq = lane >> 4;
    const int row0 = 64 * c;
    unsigned char* ws = F.ws; asm volatile("" : "+s"(ws));
    const float* XP = (const float*)(ws + WS_XP);
    LAS unsigned char* Ds = F.lds;
    LAS float* red = (LAS float*)(F.lds + ESC_OFF);
    { const int ch = tid, wsel = w >> 1;
      const float* sp = AR.in[IN_SPOOL] + (size_t)l * NSAMP * 15 * 512 + ch;
#pragma unroll 1
      for (int half = 0; half < 2; ++half) {
          if (c == NCHUNK - 1 && half == 1) {
              if (wsel == 0) pool_sample_rows<2>(XP, sp, F.out, l, ch, Ds); else if (wsel == 1) pool_sample_rows<4>(XP, sp, F.out, l, ch, Ds);
              else if (wsel == 2) pool_sample_rows<8>(XP, sp, F.out, l, ch, Ds); else pool_sample_rows<16>(XP, sp, F.out, l, ch, Ds);
          } else {
              const int rfirst = row0 + 32 * half;
              if (wsel == 0) pool_half<2>(XP, F.out, l, ch, rfirst, 32 * half, Ds); else if (wsel == 1) pool_half<4>(XP, F.out, l, ch, rfirst, 32 * half, Ds);
              else if (wsel == 2) pool_half<8>(XP, F.out, l, ch, rfirst, 32 * half, Ds); else pool_half<16>(XP, F.out, l, ch, rfirst, 32 * half, Ds);
          }
      } }
    WG_BAR();
    const int gp = w & 3, rh = w >> 2;
    f32x4 A[2][8];
#pragma unroll
    for (int mt = 0; mt < 2; ++mt)
#pragma unroll
        for (int nt = 0; nt < 8; ++nt) A[mt][nt] = (f32x4){0.f, 0.f, 0.f, 0.f};
    { const bf16* Wp = (const bf16*)(ws + WS_WPOOL) + ((size_t)(l * 4 + gp) * 128 + t16) * 128 + 8 * cq;
#pragma unroll
      for (int ks = 0; ks < 4; ++ks) {
          bf16x8 df[2];
#pragma unroll
          for (int mt = 0; mt < 2; ++mt) df[mt] = *(const LAS bf16x8*)(Ds + SWZ(32 * rh + 16 * mt + t16, 16 * gp + 4 * ks + cq, 1024));
#pragma unroll
          for (int nt = 0; nt < 8; ++nt) { const bf16x8 wf = *(const bf16x8*)(Wp + (size_t)nt * 16 * 128 + 32 * ks);
#pragma unroll
              for (int mt = 0; mt < 2; ++mt) A[mt][nt] = __builtin_amdgcn_mfma_f32_16x16x32_bf16(wf, df[mt], A[mt][nt], 0, 0, 0); }
      } }
#pragma unroll
    for (int mt = 0; mt < 2; ++mt) { float ss = 0.f;
#pragma unroll
        for (int nt = 0; nt < 8; ++nt) { const f32x4 sc = *(const f32x4*)(AR.in[IN_PSCALE] + l * 512 + 128 * gp + 16 * nt + 4 * cq);
#pragma unroll
            for (int e = 0; e < 4; ++e) { const float o = A[mt][nt][e] * sc[e]; A[mt][nt][e] = o; ss += o * o; } }
        ss += __shfl_xor(ss, 16); ss += __shfl_xor(ss, 32);
        if (cq == 0) red[(32 * rh + 16 * mt + t16) * 4 + gp] = ss; }
    WG_BAR();
    { bf16* MIX = (bf16*)(ws + WS_MIX);
#pragma unroll
      for (int mt = 0; mt < 2; ++mt) { const int rl = 32 * rh + 16 * mt + t16; const f32x4 a = *(const LAS f32x4*)(red + rl * 4);
          const float rsn = rsqrtf(((a[0] + a[1]) + (a[2] + a[3])) * (1.0f / 512.0f) + EPS);
          bf16* mp = MIX + (size_t)(row0 + rl) * DM + 1536 + 128 * gp + 4 * cq;
#pragma unroll
          for (int nt = 0; nt < 8; ++nt) *(v2u*)(mp + 16 * nt) = (v2u){pk2(A[mt][nt][0] * rsn, A[mt][nt][1] * rsn), pk2(A[mt][nt][2] * rsn, A[mt][nt][3] * rsn)}; } }
    WG_BAR();
}

#ifndef ACQ_SCOPE
#define ACQ_SCOPE "agent"
#endif
enum { U_END = 0, U_PA = 1, U_PC = 2, U_PD = 3, U_PE = 4, U_SSM = 5, U_ATT = 6, U_SATT = 7, U_POOL = 8 };
constexpr int NPANEL = MP / 256;
constexpr int QCAP = 1024;
__host__ __device__ constexpr unsigned mkd(int type, int l, int a, int b) { return ((unsigned)type << 24) | ((unsigned)l << 20) | ((unsigned)a << 10) | (unsigned)b; }
__device__ __forceinline__ gu32* cnt_word(gu32* ctl, int l, int kind, int pm) { return ctl + CW_CNT + ((l * 5 + kind) * 40 + pm) * 16; }
__host__ __device__ constexpr unsigned mix_target(int pm) { return 3u * (unsigned)((MR - 256 * pm) < 256 ? (MR - 256 * pm) : 256); }

__device__ __forceinline__ void build_queue(unsigned* qt, int q) {
    int n = 1;
    for (int l = 0; l < NLAYER; ++l) {
        for (int pm = 0; pm < NPANEL; ++pm) { qt[n++] = mkd(U_PA, l, pm, q); if ((pm & 7) == q) { qt[n++] = mkd(U_PA, l, pm, 8); qt[n++] = mkd(U_PA, l, pm, 9); } }
        for (int c = q; c < NCHUNK; c += 8) qt[n++] = mkd(U_SSM, l, c, 0);
        for (int i = q; i < NBATCH * NQB; i += 8) qt[n++] = mkd(U_ATT, l, i, 0);
        for (int s = q; s < NSAMP; s += 8) qt[n++] = mkd(U_SATT, l, s, 0);
        for (int c = q; c < NCHUNK; c += 8) qt[n++] = mkd(U_POOL, l, c, 0);
        for (int pm = 0; pm < NPANEL; ++pm) qt[n++] = mkd(U_PC, l, pm, q);
        for (int pm = 0; pm < NPANEL; ++pm) for (int j = 0; j < 4; ++j) qt[n++] = mkd(U_PD, l, pm, 4 * q + j);
        for (int pm = 0; pm < NPANEL; ++pm) qt[n++] = mkd(U_PE, l, pm, q);
    }
    qt[0] = (unsigned)(n - 1);
}

struct Sched {
    gu32* ctl; const unsigned* qglob; LAS unsigned* qlds; volatile LAS unsigned* slot; int myq; unsigned nclaim;
    __device__ __forceinline__ unsigned claim_lane() {
        { const unsigned idx = __hip_atomic_fetch_add(ctl + CW_QHEAD + myq * 64, 1u, RLX_AGENT); if (idx < qlds[0]) return qlds[1 + idx]; }
        for (int k = 1; k < 8; ++k) { const int q = (myq + k) & 7; const unsigned* qg = qglob + (size_t)q * QCAP;
            if (__hip_atomic_load((gu32*)(ctl + CW_QHEAD + q * 64), RLX_AGENT) >= qg[0]) continue;
            const unsigned idx = __hip_atomic_fetch_add(ctl + CW_QHEAD + q * 64, 1u, RLX_AGENT); if (idx < qg[0]) return qg[1 + idx]; }
        return 0u;
    }
    __device__ __forceinline__ unsigned claim_wg(int tid) {
        const unsigned k = nclaim++ & 1u;
        if (tid == 0) slot[k] = claim_lane();
        WG_BAR();
        return slot[k];
    }
    __device__ __forceinline__ void poll(gu32* w, unsigned want) {
        unsigned sp = 0;
        while (__hip_atomic_load(w, RLX_AGENT) < want) { __builtin_amdgcn_s_sleep(2);
            if ((++sp & 1023u) == 0u) { if (__hip_atomic_load(ctl + CW_TMO, RLX_AGENT) != 0u) break; if (sp > (1u << 17)) { __hip_atomic_store(ctl + CW_TMO, 0x66u, RLX_AGENT); break; } } }
    }
    __device__ __forceinline__ void wait_deps(unsigned d, int tid) {
        if (tid == 0) {
            const int type = d >> 24, l = (d >> 20) & 15, a = (d >> 10) & 1023;
            if (type == U_PA) { if (l > 0) { poll(cnt_word(ctl, l - 1, 4, a), 8u); const int p2 = (a + 1 < NPANEL) ? a + 1 : NPANEL - 1; poll(cnt_word(ctl, l - 1, 1, p2), mix_target(p2)); } }
            else if (type == U_PC) poll(cnt_word(ctl, l, 1, a), mix_target(a));
            else if (type == U_PD) poll(cnt_word(ctl, l, 2, a), 8u);
            else if (type == U_PE) poll(cnt_word(ctl, l, 3, a), 32u);
            else if (type == U_SSM) poll(cnt_word(ctl, l, 0, a >> 2), 10u);
            else if (type == U_POOL) { poll(cnt_word(ctl, l, 0, a >> 2), 10u); const int r0 = 64 * a - 16; if (r0 >= 0) poll(cnt_word(ctl, l, 0, r0 >> 8), 10u); }
            else if (type == U_SATT) poll(cnt_word(ctl, l, 0, NPANEL - 1), 10u);
            else if (type == U_ATT) { const int b = a / NQB, i = a % NQB, t0 = 32 * i; const int rlo = b * TT + (t0 >= 128 ? t0 - 128 : 0), rhi = b * TT + ((t0 + 31 < TT) ? t0 + 31 : TT - 1);
                poll(cnt_word(ctl, l, 0, rlo >> 8), 10u); if ((rhi >> 8) != (rlo >> 8)) poll(cnt_word(ctl, l, 0, rhi >> 8), 10u); }
            __builtin_amdgcn_fence(__ATOMIC_ACQUIRE, ACQ_SCOPE);
            asm volatile("s_waitcnt vmcnt(0)" ::: "memory");
        }
        asm volatile("" ::: "memory"); __builtin_amdgcn_s_barrier(); asm volatile("" ::: "memory");
    }
    __device__ __forceinline__ void publish(unsigned d, int tid) {
        asm volatile("s_waitcnt vmcnt(0)" ::: "memory");
        WG_BAR();
        if (tid == 0) {
            const int type = d >> 24, l = (d >> 20) & 15, a = (d >> 10) & 1023;
            __builtin_amdgcn_fence(__ATOMIC_RELEASE, "agent");
            asm volatile("s_waitcnt vmcnt(0)" ::: "memory");
            if (type == U_PA) __hip_atomic_fetch_add(cnt_word(ctl, l, 0, a), 1u, RLX_AGENT);
            else if (type == U_PC) __hip_atomic_fetch_add(cnt_word(ctl, l, 2, a), 1u, RLX_AGENT);
            else if (type == U_PD) __hip_atomic_fetch_add(cnt_word(ctl, l, 3, a), 1u, RLX_AGENT);
            else if (type == U_PE) __hip_atomic_fetch_add(cnt_word(ctl, l, 4, a), 1u, RLX_AGENT);
            else if (type == U_SSM || type == U_POOL) __hip_atomic_fetch_add(cnt_word(ctl, l, 1, a >> 2), 64u, RLX_AGENT);
            else if (type == U_SATT) __hip_atomic_fetch_add(cnt_word(ctl, l, 1, NPANEL - 1), 1u, RLX_AGENT);
            else if (type == U_ATT) { const int b = a / NQB, i = a % NQB, t0 = 32 * i; const int r0 = b * TT + t0, r1 = b * TT + ((t0 + 31 < TT) ? t0 + 31 : TT - 1);
                const int p0 = r0 >> 8, p1 = r1 >> 8;
                if (p0 == p1) __hip_atomic_fetch_add(cnt_word(ctl, l, 1, p0), (unsigned)(r1 - r0 + 1), RLX_AGENT);
                else { __hip_atomic_fetch_add(cnt_word(ctl, l, 1, p0), (unsigned)(256 * p1 - r0), RLX_AGENT); __hip_atomic_fetch_add(cnt_word(ctl, l, 1, p1), (unsigned)(r1 - 256 * p1 + 1), RLX_AGENT); } }
        }
    }
};

#ifndef A_AUX
#define A_AUX 0
#endif
struct GU { const char* A; const char* B; unsigned voffA[2], voffB[2]; size_t hstep; int nt; unsigned d; pg8::Unit u; };

struct StreamCtx { unsigned char* ws; float* out; const float* gq; const float* gk; int R[2], C[2], Rp[2]; };
__device__ __forceinline__ void gu_fill(GU& g, unsigned d, const StreamCtx& X) {
    const int type = d >> 24, l = (d >> 20) & 15, pm = (d >> 10) & 1023, pn = d & 1023;
    unsigned char* ws = X.ws;
    const bf16* A; const bf16* B; int K = DM; bool perm = false;
    if (type == U_PA) { A = (const bf16*)(ws + WS_XB); B = (const bf16*)(ws + WS_WIN) + (size_t)l * INW * DM; }
    else if (type == U_PC) { A = (const bf16*)(ws + WS_MIX); B = (const bf16*)(ws + WS_WOUT) + (size_t)l * DM * DM; }
    else if (type == U_PD) { A = (const bf16*)(ws + WS_XB); B = (const bf16*)(ws + WS_W1) + (size_t)l * DFF * DM; perm = true; }
    else { A = (const bf16*)(ws + WS_H); B = (const bf16*)(ws + WS_W2) + (size_t)l * DM * DFF; K = DFF; }
    g.d = d; g.u.pm = pm; g.u.pn = pn; g.nt = K / 64; g.hstep = (size_t)128 * K * 2;
    g.A = (const char*)A + (size_t)pm * 256 * K * 2; g.B = (const char*)B + (size_t)pn * 256 * K * 2;
#pragma unroll
    for (int i = 0; i < 2; ++i) { g.voffA[i] = (unsigned)(X.R[i] * K + X.C[i]) * 2u; g.voffB[i] = (unsigned)((perm ? X.Rp[i] : X.R[i]) * K + X.C[i]) * 2u; }
}

__device__ __forceinline__ unsigned gemm_stream(const Args& AR, Frame& F, Sched& Q, unsigned d0) {
    int tid_ = threadIdx.x; asm volatile("" : "+v"(tid_));
    const int tid = tid_, wid = __builtin_amdgcn_readfirstlane(tid >> 6), lane = tid & 63, wr = wid >> 2, wc = wid & 3, fr = lane & 15, fq = lane >> 4;
    LAS unsigned char* lds = F.lds; LAS unsigned char* esc = F.lds + ESC_OFF;
    StreamCtx X; X.ws = F.ws; X.out = F.out;
#pragma unroll
    for (int i = 0; i < 2; ++i) { int R, C; pg8::stage_rc(tid * 16 + i * 8192, R, C); X.R[i] = R; X.C[i] = C; X.Rp[i] = (R & ~31) + pg8::perm32(R & 31); }
    const size_t kstep = (size_t)(pg8::BK * 2);
    const unsigned ldsw = (unsigned)wid * 1024u;
    const int aoff = pg8::lds_byte(wr * 64 + fr, fq * 8), boff = pg8::lds_byte(wc * 32 + fr, fq * 8);
#define PG8_SA(b, h) (((b) * 2 + (h)) * pg8::HTB)
#define PG8_SB(b, h) ((4 + (b) * 2 + (h)) * pg8::HTB)
#define PG8_STAGE(bufoff, gbase, voff) do { _Pragma("unroll") for (int _i = 0; _i < 2; ++_i) \
        __builtin_amdgcn_global_load_lds((const unsigned*)((const char*)(gbase) + (voff)[_i]), (LAS unsigned*)(lds + (bufoff) + ldsw + _i * 8192), 16, 0, 0); } while (0)
#define PG8_STAGE_A(bufoff, gbase, voff) do { _Pragma("unroll") for (int _i = 0; _i < 2; ++_i) \
        __builtin_amdgcn_global_load_lds((const unsigned*)((const char*)(gbase) + (voff)[_i]), (LAS unsigned*)(lds + (bufoff) + ldsw + _i * 8192), 16, 0, A_AUX); } while (0)
#define PG8_LDA(dst, b, h) do { _Pragma("unroll") for (int m = 0; m < 4; ++m) _Pragma("unroll") for (int k = 0; k < 2; ++k) dst[m][k] = *(const LAS bf16x8*)(lds + PG8_SA(b, h) + aoff + m * 2048 + k * 1024); } while (0)
#define PG8_LDB(dst, b, h) do { _Pragma("unroll") for (int n = 0; n < 2; ++n) _Pragma("unroll") for (int k = 0; k < 2; ++k) dst[n][k] = *(const LAS bf16x8*)(lds + PG8_SB(b, h) + boff + n * 2048 + k * 1024); } while (0)
#define PG8_MMA(ai, bj, At, Bt) do { __builtin_amdgcn_s_setprio(1); _Pragma("unroll") for (int m = 0; m < 4; ++m) _Pragma("unroll") for (int n = 0; n < 2; ++n) _Pragma("unroll") for (int k = 0; k < 2; ++k) \
        acc[ai][bj][m][n] = __builtin_amdgcn_mfma_f32_16x16x32_bf16(Bt[n][k], At[m][k], acc[ai][bj][m][n], 0, 0, 0); __builtin_amdgcn_s_setprio(0); } while (0)
#define PG8_WAIT_V(n) asm volatile("s_waitcnt vmcnt(" #n ")" ::: "memory")
#define PG8_WAIT_L(n) asm volatile("s_waitcnt lgkmcnt(" #n ")" ::: "memory")
#define PG8_BAR __builtin_amdgcn_s_barrier()
#define PG8_SCHED __builtin_amdgcn_sched_barrier(0)
    GU cur, nxt;
    gu_fill(cur, d0, X);
    f32x4 acc[2][2][4][2];
#pragma unroll
    for (int a = 0; a < 2; ++a)
#pragma unroll
        for (int b = 0; b < 2; ++b)
#pragma unroll
            for (int m = 0; m < 4; ++m)
#pragma unroll
                for (int n = 0; n < 2; ++n) acc[a][b][m][n] = (f32x4){0.f, 0.f, 0.f, 0.f};
    bf16x8 At[4][2], B0[2][2], B1[2][2];
    Q.wait_deps(cur.d, tid);
    PG8_STAGE(PG8_SB(0, 0), cur.B, cur.voffB); PG8_STAGE(PG8_SB(0, 1), cur.B + cur.hstep, cur.voffB); PG8_STAGE_A(PG8_SA(0, 0), cur.A, cur.voffA); PG8_STAGE_A(PG8_SA(0, 1), cur.A + cur.hstep, cur.voffA);
    if (wr == 1) PG8_BAR;
    PG8_WAIT_V(2); PG8_BAR;
    PG8_STAGE(PG8_SB(1, 0), cur.B + kstep, cur.voffB); PG8_STAGE_A(PG8_SA(1, 0), cur.A + kstep, cur.voffA); PG8_STAGE(PG8_SB(1, 1), cur.B + cur.hstep + kstep, cur.voffB);
    PG8_WAIT_V(6); PG8_BAR;
    unsigned carry = 0u; unsigned ui = 0u;
    for (;;) {
        { const unsigned k = 2u + (ui & 1u);
          if (tid == 0) Q.slot[k] = Q.claim_lane();
          asm volatile("s_waitcnt lgkmcnt(0)" ::: "memory"); PG8_BAR; asm volatile("" ::: "memory");
          carry = Q.slot[k]; }
        const bool has_next = (carry >> 24) >= U_PA && (carry >> 24) <= U_PE && (!STREAM_SAME_SECTION || ((carry >> 20) == (cur.d >> 20)));
        if (has_next) gu_fill(nxt, carry, X); else nxt = cur;
        const char* cA = cur.A; const char* cB = cur.B; const size_t hstep = cur.hstep; const int nt = cur.nt;
        for (int t = 0; t < nt; t += 2) {
            const bool last = (t == nt - 2);
            const char* a1 = cA + (size_t)(t + 1) * kstep;
            const char* a2 = last ? nxt.A : cA + (size_t)(t + 2) * kstep; const char* b2 = last ? nxt.B : cB + (size_t)(t + 2) * kstep;
            const char* a3 = a2 + kstep; const char* b3 = b2 + kstep;
            const size_t h2 = last ? nxt.hstep : hstep;
            unsigned vA2[2], vB2[2];
#pragma unroll
            for (int i = 0; i < 2; ++i) { vA2[i] = last ? nxt.voffA[i] : cur.voffA[i]; vB2[i] = last ? nxt.voffB[i] : cur.voffB[i]; }
            if (last && has_next) Q.wait_deps(nxt.d, tid);
            PG8_LDB(B0, 0, 0); PG8_LDB(B1, 0, 1); PG8_SCHED; PG8_LDA(At, 0, 0); PG8_STAGE_A(PG8_SA(1, 1), a1 + hstep, cur.voffA);
            PG8_WAIT_V(8); PG8_WAIT_L(0); PG8_BAR; PG8_MMA(0, 0, At, B0); PG8_MMA(0, 1, At, B1); PG8_BAR; PG8_SCHED;
            PG8_LDA(At, 0, 1); PG8_STAGE(PG8_SB(0, 0), b2, vB2); PG8_STAGE(PG8_SB(0, 1), b2 + h2, vB2); PG8_STAGE_A(PG8_SA(0, 0), a2, vA2);
            PG8_WAIT_V(8); PG8_WAIT_L(0); PG8_BAR; PG8_MMA(1, 0, At, B0); PG8_MMA(1, 1, At, B1); PG8_BAR; PG8_SCHED;
            PG8_LDB(B0, 1, 0); PG8_LDB(B1, 1, 1); PG8_SCHED; PG8_LDA(At, 1, 0); PG8_STAGE_A(PG8_SA(0, 1), a2 + h2, vA2);
            PG8_WAIT_V(8); PG8_WAIT_L(0); PG8_BAR; PG8_MMA(0, 0, At, B0); PG8_MMA(0, 1, At, B1); PG8_BAR; PG8_SCHED;
            PG8_LDA(At, 1, 1); PG8_STAGE(PG8_SB(1, 0), b3, vB2); PG8_STAGE(PG8_SB(1, 1), b3 + h2, vB2); PG8_STAGE_A(PG8_SA(1, 0), a3, vA2);
            PG8_WAIT_V(8); PG8_WAIT_L(0); PG8_BAR; PG8_MMA(1, 0, At, B0); PG8_MMA(1, 1, At, B1); PG8_BAR; PG8_SCHED;
        }
        if (wr == 0) PG8_BAR;
        { const int type = cur.d >> 24, l = (cur.d >> 20) & 15;
          if (type == U_PA) { EpiProj E{X.ws, X.out, AR.in[IN_GQ] + l * 128, AR.in[IN_GK] + l * 128, l}; E(acc, cur.u, wr, wc, fr, fq, esc, tid); }
          else if (type == U_PD) { EpiFfn1 E{(const float*)(X.ws + WS_SSQ), (bf16*)(X.ws + WS_H)}; E(acc, cur.u, wr, wc, fr, fq, esc, tid); }
          else { EpiRes E{(float*)(X.ws + WS_X), (bf16*)(X.ws + WS_XB), (float*)(X.ws + WS_SSQ), X.out, (type == U_PE && l == NLAYER - 1) ? 1 : 0}; E(acc, cur.u, wr, wc, fr, fq, esc, tid); }
          Q.publish(cur.d, tid); }
        if (!has_next) break;
#pragma unroll
        for (int a = 0; a < 2; ++a)
#pragma unroll
            for (int b = 0; b < 2; ++b)
#pragma unroll
                for (int m = 0; m < 4; ++m)
#pragma unroll
                    for (int n = 0; n < 2; ++n) acc[a][b][m][n] = (f32x4){0.f, 0.f, 0.f, 0.f};
        cur = nxt; ++ui;
        if (wr == 1) PG8_BAR;
    }
    PG8_WAIT_V(0);
    PG8_BAR;
#undef PG8_SA
#undef PG8_SB
#undef PG8_STAGE
#undef PG8_STAGE_A
#undef PG8_LDA
#undef PG8_LDB
#undef PG8_MMA
#undef PG8_WAIT_V
#undef PG8_WAIT_L
#undef PG8_BAR
#undef PG8_SCHED
    return carry;
}

__global__ void __launch_bounds__(512, 2) hymba_fwd(Args args) {
    extern __shared__ __attribute__((aligned(16))) unsigned char lds[];
    Frame F;
    F.lds = (LAS unsigned char*)lds;
    F.MISC = (volatile LAS unsigned*)(F.lds + MISC_OFF);
    F.tid = threadIdx.x; F.lane = F.tid & 63; F.wave = __builtin_amdgcn_readfirstlane(F.tid >> 6);
    F.G = gridDim.x; { const int bx = blockIdx.x; F.vcu = (F.G % 8 == 0) ? (bx % 8) * (F.G / 8) + bx / 8 : bx; }
    F.ws = args.ws; F.out = args.out; F.ctl = (gu32*)(args.ws + WS_CTL);
    for (int u = F.tid; u < (LDS_BYTES - LDSCTL_OFF) / 4; u += 512) ((LAS unsigned*)(F.lds + LDSCTL_OFF))[u] = 0u;
    __syncthreads();
    XcdBarrier bar = xcd_barrier_post((unsigned*)(F.ctl + CW_BAR), F.MISC + 8);
    for (int rep = 0; rep < DUP_P0; ++rep) p0_prologue(args, F);
    if (blockIdx.x < 8 && F.tid == 0) build_queue((unsigned*)(args.ws + WS_QUEUE) + (size_t)blockIdx.x * QCAP, (int)blockIdx.x);
    xcd_barrier(bar);
    Sched Q; Q.ctl = F.ctl; Q.qglob = (const unsigned*)(args.ws + WS_QUEUE); Q.qlds = (LAS unsigned*)(F.lds + QTAB_OFF); Q.slot = F.MISC; Q.myq = (int)(bar.x & 7u); Q.nclaim = 0u;
    { const unsigned* qg = Q.qglob + (size_t)Q.myq * QCAP; for (int i = F.tid; i < QCAP; i += 512) Q.qlds[i] = qg[i]; }
    WG_BAR();
    unsigned d = Q.claim_wg(F.tid);
#if SEC_BARRIER
    int cursec = 0;
#endif
    for (;;) {
        const int type = d >> 24;
#if SEC_BARRIER
        { const int sec = (type == U_END) ? 5 * NLAYER : ((d >> 20) & 15) * 5 + ((type >= U_SSM) ? 1 : (type == U_PA ? 0 : type));
          while (cursec < sec) { if ((SEC_MASK >> cursec) & 1) xcd_barrier(bar); ++cursec; } }
#endif
        if (type == U_END) break;
        if (type <= U_PE) { d = gemm_stream(args, F, Q, d); continue; }
        const int l = (d >> 20) & 15, a = (d >> 10) & 1023;
        Q.wait_deps(d, F.tid);
        if (type == U_SSM) ssm_unit(args, F, l, a);
        else if (type == U_ATT) attn_unit(args, F, l, a / NQB, a % NQB);
        else if (type == U_SATT) sattn_unit(args, F, l, a);
        else pool_unit(args, F, l, a);
        Q.publish(d, F.tid);
        d = Q.claim_wg(F.tid);
    }
}

extern "C" void kernel_launch(void* const* d_in, const int* in_sizes, int n_in, void* d_out, int out_size, void* d_ws, size_t ws_size, hipStream_t stream) {
    static int grid = 0;
    if (grid == 0) {
        if (n_in != 32 || (size_t)out_size != O_END || ws_size < WS_END) { fprintf(stderr, "kernel_launch: unexpected shapes: n_in %d out %d (want %zu) ws %zu (want >= %zu)\n", n_in, out_size, (size_t)O_END, ws_size, (size_t)WS_END); grid = -1; return; }
        int dev = 0, cus = 0, per_cu = 0;
        if (hipGetDevice(&dev) != hipSuccess || hipDeviceGetAttribute(&cus, hipDeviceAttributeMultiprocessorCount, dev) != hipSuccess) { fprintf(stderr, "kernel_launch: device query failed\n"); grid = -1; return; }
        if (hipFuncSetAttribute((const void*)hymba_fwd, hipFuncAttributeMaxDynamicSharedMemorySize, LDS_BYTES) != hipSuccess) { fprintf(stderr, "kernel_launch: hipFuncSetAttribute failed\n"); grid = -1; return; }
        if (hipOccupancyMaxActiveBlocksPerMultiprocessor(&per_cu, (const void*)hymba_fwd, 512, LDS_BYTES) != hipSuccess || per_cu < 1) { fprintf(stderr, "kernel_launch: occupancy query says %d blocks per CU\n", per_cu); per_cu = 1; }
        (void)hipGetLastError();
        grid = cus;
        if (grid % 8 != 0) grid -= grid % 8;
    }
    if (grid < 0) return;
    (void)hipMemsetAsync((char*)d_ws + WS_CTL, 0, CTL_ZERO_BYTES, stream);
    Args a{};
    for (int i = 0; i < 32; ++i) a.in[i] = (const float*)d_in[i];
    a.out = (float*)d_out; a.ws = (unsigned char*)d_ws; a.ph_lo = 0; a.ph_hi = 0;
    hipLaunchKernelGGL(hymba_fwd, dim3(grid), dim3(512), LDS_BYTES, stream, a);
    const hipError_t le = hipPeekAtLastError();
    if (le != hipSuccess) fprintf(stderr, "kernel_launch: launch failed: %s\n", hipGetErrorName(le));
}
```

```cpp
#include <hip/hip_runtime.h>
#include <cstdio>
#include <cstdint>

#ifndef MK_N_LAUNCHES
#define MK_N_LAUNCHES 1
#endif

#ifndef SEC_BARRIER
#define SEC_BARRIER 0
#endif
#ifndef STREAM_SAME_SECTION
#define STREAM_SAME_SECTION 1
#endif
#ifndef SEC_MASK
#define SEC_MASK 0x10
#endif
#ifndef DUP_PB
#define DUP_PB 1
#endif
#ifndef DUP_P0
#define DUP_P0 1
#endif

constexpr int DM = 2048, TT = 4112  , NSEQ = 4096, NMETA = 16, NBATCH = 2, NSAMP = 32;
constexpr int MR = NBATCH * TT + NSAMP;
constexpr int MP = 8448;
constexpr int SROW0 = NBATCH * TT;
constexpr int INW = 2560, DFF = 8192, NLAYER = 2;
constexpr int TPV = 4128;
constexpr int ROPE_SAMPLE_IDX = TT;
constexpr float EPS = 1e-6f;
constexpr float LOG2E = 1.4426950408889634f;
constexpr float QSCALE = 0.08838834764831845f * LOG2E;
constexpr int NCHUNK = MR / 64;
constexpr int NQB = (TT + 31) / 32;

constexpr size_t O_YP = 0, O_YS = O_YP + (size_t)NBATCH * NSEQ * DM, O_PK = O_YS + (size_t)NSAMP * DM, O_PV = O_PK + (size_t)NLAYER * NBATCH * 128 * 256,
                 O_PSR = O_PV + (size_t)NLAYER * NBATCH * 128 * 256, O_PSI = O_PSR + (size_t)NLAYER * NBATCH * 2048, O_PP = O_PSI + (size_t)NLAYER * NBATCH * 2048,
                 O_SK = O_PP + (size_t)NLAYER * NBATCH * 15 * 512, O_SV = O_SK + (size_t)NLAYER * NSAMP * 128 * 256, O_SSR = O_SV + (size_t)NLAYER * NSAMP * 128 * 256,
                 O_SSI = O_SSR + (size_t)NLAYER * NSAMP * 2048, O_SP = O_SSI + (size_t)NLAYER * NSAMP * 2048, O_END = O_SP + (size_t)NLAYER * NSAMP * 15 * 512;

constexpr size_t MiB = 1u << 20;
constexpr size_t WS_CTL = 0, CTL_ZERO_BYTES = 1 * MiB;
constexpr size_t WS_WIN = 1 * MiB, WS_WOUT = 21 * MiB, WS_W1 = 37 * MiB, WS_W2 = 101 * MiB, WS_WGLU = 165 * MiB, WS_WPOOL = 166 * MiB, WS_TAB = 167 * MiB;
constexpr size_t WS_X = 170 * MiB, WS_XB = 236 * MiB, WS_Q = 269 * MiB, WS_K = 286 * MiB, WS_VT = 291 * MiB, WS_U = 296 * MiB, WS_XP = 313 * MiB, WS_MIX = 330 * MiB,
                 WS_H = 363 * MiB, WS_SSQ = 495 * MiB, WS_SST = 497 * MiB, WS_KSN = 502 * MiB, WS_QUEUE = 503 * MiB, WS_END = 504 * MiB;
static_assert(WS_WIN + (size_t)NLAYER * INW * DM * 2 <= WS_WOUT && WS_WOUT + (size_t)NLAYER * DM * DM * 2 <= WS_W1 && WS_W1 + (size_t)NLAYER * DFF * DM * 2 <= WS_W2 && WS_W2 + (size_t)NLAYER * DFF * DM * 2 <= WS_WGLU, "ws map 1");
static_assert(WS_X + (size_t)MP * DM * 4 <= WS_XB && WS_XB + (size_t)MP * DM * 2 <= WS_Q && WS_Q + (size_t)MP * 1024 * 2 <= WS_K && WS_K + (size_t)MP * 256 * 2 <= WS_VT && WS_VT + (size_t)4 * 128 * TPV * 2 <= WS_U, "ws map 2");
static_assert(WS_U + (size_t)MP * 512 * 4 <= WS_XP && WS_XP + (size_t)MP * 512 * 4 <= WS_MIX && WS_MIX + (size_t)MP * DM * 2 <= WS_H && WS_H + (size_t)MP * DFF * 2 <= WS_SSQ && WS_SSQ + (size_t)MP * 32 * 4 <= WS_SST, "ws map 3");
static_assert(WS_SST + (size_t)NLAYER * NCHUNK * 32 * 64 * 8 <= WS_KSN, "ws map 4");
constexpr size_t TB_ABR = 0, TB_ABI = 8192, TB_ALR = 16384, TB_ALI = 24576, TB_A16R = 32768, TB_A16I = 40960, TB_A32R = 49152, TB_A32I = 57344,
                 TB_BBR = 65536, TB_BBI = TB_BBR + 131072, TB_PM = TB_BBI + 131072, TB_CMT = TB_PM + 524288, TB_LAYER = 1 * MiB;
static_assert(TB_CMT + 131072 <= TB_LAYER, "table map");
constexpr size_t WS_ROPE = WS_TAB + 2 * MiB;
constexpr size_t ROPE_N = (size_t)(TT + 1) * 16;
constexpr int CW_TMO = 0, CW_CODE = 1, CW_BAR = 4096, CW_QHEAD = 8192  , CW_CNT = 9216  , CW_SSMF = 16384  ;
static_assert(CW_CNT + NLAYER * 5 * 40 * 16 <= CW_SSMF, "ctl map: counters");
static_assert((CW_SSMF + NLAYER * NCHUNK * 8 * 16) * 4 <= (int)CTL_ZERO_BYTES, "ctl map");

constexpr int RING_BYTES = 131072, ESC_OFF = RING_BYTES  , QTAB_OFF = ESC_OFF + 12288  , LDSCTL_OFF = QTAB_OFF + 4096, MISC_OFF = LDSCTL_OFF + 320, LDS_BYTES = 148480;
static_assert(MISC_OFF + 128 <= LDS_BYTES, "LDS map");

#define GAS __attribute__((address_space(1)))
#define LAS __attribute__((address_space(3)))
typedef unsigned short bf16;
typedef unsigned v4u __attribute__((ext_vector_type(4)));
typedef unsigned v2u __attribute__((ext_vector_type(2)));
typedef float f32x2 __attribute__((ext_vector_type(2)));
typedef float f32x16 __attribute__((ext_vector_type(16)));
typedef __bf16 bf16x2_t __attribute__((ext_vector_type(2)));
typedef GAS unsigned gu32;
typedef GAS unsigned long long gu64;
#define RLX_AGENT __ATOMIC_RELAXED, __HIP_MEMORY_SCOPE_AGENT
#define LDS_WAIT() asm volatile("s_waitcnt lgkmcnt(0)" ::: "memory")
#define VM_WAIT() asm volatile("s_waitcnt vmcnt(0)" ::: "memory")
#define WG_BAR() do { asm volatile("s_waitcnt lgkmcnt(0)" ::: "memory"); __builtin_amdgcn_s_barrier(); asm volatile("" ::: "memory"); } while (0)
__device__ __forceinline__ unsigned pk2(float lo, float hi) { f32x2 v = {lo, hi}; bf16x2_t b = __builtin_convertvector(v, bf16x2_t); return __builtin_bit_cast(unsigned, b); }
__device__ __forceinline__ float bf2f(unsigned short h) { return __builtin_bit_cast(float, (unsigned)h << 16); }
__device__ __forceinline__ float wave_sum(float v) {
#pragma unroll
    for (int o = 1; o < 64; o <<= 1) v += __shfl_xor(v, o);
    return v;
}
__device__ __forceinline__ float wave_max(float v) {
#pragma unroll
    for (int o = 1; o < 64; o <<= 1) v = fmaxf(v, __shfl_xor(v, o));
    return v;
}
__host__ __device__ __forceinline__ int perm16(int o) { return 8 * ((o >> 2) & 1) + 4 * (o >> 3) + (o & 3); }

namespace pg8 {
#define PG8_LAS __attribute__((address_space(3)))
typedef unsigned short bf16_t;
typedef short bf16x8 __attribute__((ext_vector_type(8)));
typedef float f32x4 __attribute__((ext_vector_type(4)));
typedef unsigned u32x4 __attribute__((ext_vector_type(4)));
constexpr int BM = 256, BK = 64, HALF = 128, HTB = HALF * BK * 2  , STAGE_BYTES = 8 * HTB, NXCD = 8, WGM = 8;

__host__ __device__ __forceinline__ int lds_byte(int r, int c) { const int st = (r >> 4) * 2 + (c >> 5), rr = r & 15, cc = c & 31, ob = rr * 64 + cc * 2; return st * 1024 + (ob ^ (((ob >> 9) & 1) << 5)); }
__host__ __device__ __forceinline__ void stage_rc(int b, int& R, int& C) { const int st = b / 1024, sb = b % 1024, swz = sb ^ (((sb >> 9) & 1) << 5); R = (st >> 1) * 16 + swz / 64; C = (st & 1) * 32 + (swz % 64) / 2; }
__host__ __device__ __forceinline__ int perm32(int rho) { const int n = rho >> 4, i = rho & 15; return 8 * (i >> 2) + 4 * n + (i & 3); }

struct Unit { int pm, pn; };
struct Gemm { const bf16_t* A; const bf16_t* Bt; int M, N, K; };

struct StaticOrder {
    int nM, nN, nwg, G, c;
    __host__ __device__ void init(int M, int N, int G_, int c_) { nM = M / BM; nN = N / BM; nwg = nM * nN; G = G_; c = c_; }
    __host__ __device__ bool next(int i, Unit& u) const {
        const long L = (long)i * G + c; if (L >= nwg) return false;
        int wgid = (int)L; { const int q = nwg / NXCD, r = nwg % NXCD, xcd = wgid % NXCD, off = wgid / NXCD; wgid = (xcd < r ? xcd * (q + 1) : r * (q + 1) + (xcd - r) * q) + off; }
        const int nig = WGM * nN, gid = wgid / nig, fm = gid * WGM, gsz = (nM - fm) < WGM ? (nM - fm) : WGM;
        u.pm = fm + ((wgid % nig) % gsz); u.pn = (wgid % nig) / gsz; return true;
    }
    __device__ __forceinline__ void a_ready(const Unit&) const {}
    __device__ __forceinline__ void done(const Unit&) const {}
};


template <class Epi, class Sched, bool ALIGN_EPI = false, bool SP2 = false>
__device__ __forceinline__ void gemm_phase(PG8_LAS unsigned char* lds, PG8_LAS unsigned char* esc, const Gemm g, const Sched& S, const Epi& E) {
    int tid_ = threadIdx.x; asm volatile("" : "+v"(tid_));
    const int tid = tid_, wid = __builtin_amdgcn_readfirstlane(tid >> 6), lane = tid & 63, wr = wid >> 2, wc = wid & 3, fr = lane & 15, fq = lane >> 4;
    const int K = g.K, nt = K / BK;
    unsigned voffA[2], voffB[2];
#pragma unroll
    for (int i = 0; i < 2; ++i) { int R, C; stage_rc(tid * 16 + i * 8192, R, C); const int Rb = Epi::PERM ? ((R & ~31) + perm32(R & 31)) : R;
        voffA[i] = (unsigned)(R * K + C) * 2u; voffB[i] = (unsigned)(Rb * K + C) * 2u; }
    const size_t kstep = (size_t)(BK * 2);
    const size_t hstep = (size_t)HALF * K * 2;
    const size_t tstep = 2 * hstep;
    const unsigned ldsw = (unsigned)wid * 1024u;
    const int aoff = lds_byte(wr * 64 + fr, fq * 8), boff = lds_byte(wc * 32 + fr, fq * 8);
#define PG8_SA(b, h) (((b) * 2 + (h)) * HTB)
#define PG8_SB(b, h) ((4 + (b) * 2 + (h)) * HTB)
#define PG8_STAGE(bufoff, gbase, voff) do { _Pragma("unroll") for (int _i = 0; _i < 2; ++_i) \
        __builtin_amdgcn_global_load_lds((const unsigned*)((const char*)(gbase) + (voff)[_i]), (PG8_LAS unsigned*)(lds + (bufoff) + ldsw + _i * 8192), 16, 0, 0); } while (0)
#define PG8_LDA(dst, b, h) do { _Pragma("unroll") for (int m = 0; m < 4; ++m) _Pragma("unroll") for (int k = 0; k < 2; ++k) dst[m][k] = *(const PG8_LAS bf16x8*)(lds + PG8_SA(b, h) + aoff + m * 2048 + k * 1024); } while (0)
#define PG8_LDB(dst, b, h) do { _Pragma("unroll") for (int n = 0; n < 2; ++n) _Pragma("unroll") for (int k = 0; k < 2; ++k) dst[n][k] = *(const PG8_LAS bf16x8*)(lds + PG8_SB(b, h) + boff + n * 2048 + k * 1024); } while (0)
#define PG8_MMA(ai, bj, At, Bt) do { __builtin_amdgcn_s_setprio(1); _Pragma("unroll") for (int m = 0; m < 4; ++m) _Pragma("unroll") for (int n = 0; n < 2; ++n) _Pragma("unroll") for (int k = 0; k < 2; ++k) \
        acc[ai][bj][m][n] = __builtin_amdgcn_mfma_f32_16x16x32_bf16(Bt[n][k], At[m][k], acc[ai][bj][m][n], 0, 0, 0); __builtin_amdgcn_s_setprio(0); } while (0)
#define PG8_WAIT_V(n) asm volatile("s_waitcnt vmcnt(" #n ")" ::: "memory")
#define PG8_WAIT_L(n) asm volatile("s_waitcnt lgkmcnt(" #n ")" ::: "memory")
#define PG8_BAR __builtin_amdgcn_s_barrier()
#define PG8_SCHED __builtin_amdgcn_sched_barrier(0)
    Unit cur, nxt; int ui = 0;
    if (!S.next(0, cur)) return;
    f32x4 acc[2][2][4][2];
#pragma unroll
    for (int a = 0; a < 2; ++a)
#pragma unroll
        for (int b = 0; b < 2; ++b)
#pragma unroll
            for (int m = 0; m < 4; ++m)
#pragma unroll
                for (int n = 0; n < 2; ++n) acc[a][b][m][n] = (f32x4){0.f, 0.f, 0.f, 0.f};
    bf16x8 At[4][2], B0[2][2], B1[2][2];
    const char* cA = (const char*)g.A + (size_t)cur.pm * tstep; const char* cB = (const char*)g.Bt + (size_t)cur.pn * tstep;
    S.a_ready(cur);
    if constexpr (SP2) {
        PG8_STAGE(PG8_SB(0, 0), cB, voffB); PG8_STAGE(PG8_SB(0, 1), cB + hstep, voffB); PG8_STAGE(PG8_SA(0, 0), cA, voffA); PG8_STAGE(PG8_SA(0, 1), cA + hstep, voffA);
        if (wr == 1) PG8_BAR;
        PG8_WAIT_V(2); PG8_BAR;
        PG8_STAGE(PG8_SB(1, 0), cB + kstep, voffB); PG8_STAGE(PG8_SA(1, 0), cA + kstep, voffA); PG8_STAGE(PG8_SB(1, 1), cB + hstep + kstep, voffB);
        PG8_WAIT_V(6); PG8_BAR;
    } else {
        PG8_STAGE(PG8_SB(0, 0), cB, voffB); PG8_STAGE(PG8_SA(0, 0), cA, voffA); PG8_STAGE(PG8_SB(0, 1), cB + hstep, voffB); PG8_STAGE(PG8_SA(0, 1), cA + hstep, voffA);
        if (wr == 1) PG8_BAR;
        PG8_WAIT_V(4); PG8_BAR;
        PG8_STAGE(PG8_SB(1, 0), cB + kstep, voffB); PG8_STAGE(PG8_SA(1, 0), cA + kstep, voffA); PG8_STAGE(PG8_SB(1, 1), cB + hstep + kstep, voffB);
        PG8_WAIT_V(6); PG8_BAR;
    }
    for (;;) {
        const bool has_next = S.next(ui + 1, nxt);
        const char* nA = has_next ? (const char*)g.A + (size_t)nxt.pm * tstep : cA; const char* nB = has_next ? (const char*)g.Bt + (size_t)nxt.pn * tstep : cB;
        for (int t = 0; t < nt; t += 2) {
            const bool last = (t == nt - 2);
            const char* a1 = cA + (size_t)(t + 1) * kstep;
            const char* a2 = last ? nA : cA + (size_t)(t + 2) * kstep; const char* b2 = last ? nB : cB + (size_t)(t + 2) * kstep;
            const char* a3 = a2 + kstep; const char* b3 = b2 + kstep;
            if (last && has_next) S.a_ready(nxt);
            if constexpr (SP2) {
            PG8_LDB(B0, 0, 0); PG8_LDB(B1, 0, 1); PG8_SCHED; PG8_LDA(At, 0, 0); PG8_STAGE(PG8_SA(1, 1), a1 + hstep, voffA);
            PG8_WAIT_V(8); PG8_WAIT_L(0); PG8_BAR; PG8_MMA(0, 0, At, B0); PG8_MMA(0, 1, At, B1); PG8_BAR; PG8_SCHED;
            PG8_LDA(At, 0, 1); PG8_STAGE(PG8_SB(0, 0), b2, voffB); PG8_STAGE(PG8_SB(0, 1), b2 + hstep, voffB); PG8_STAGE(PG8_SA(0, 0), a2, voffA);
            PG8_WAIT_V(8); PG8_WAIT_L(0); PG8_BAR; PG8_MMA(1, 0, At, B0); PG8_MMA(1, 1, At, B1); PG8_BAR; PG8_SCHED;
            PG8_LDB(B0, 1, 0); PG8_LDB(B1, 1, 1); PG8_SCHED; PG8_LDA(At, 1, 0); PG8_STAGE(PG8_SA(0, 1), a2 + hstep, voffA);
            PG8_WAIT_V(8); PG8_WAIT_L(0); PG8_BAR; PG8_MMA(0, 0, At, B0); PG8_MMA(0, 1, At, B1); PG8_BAR; PG8_SCHED;
            PG8_LDA(At, 1, 1); PG8_STAGE(PG8_SB(1, 0), b3, voffB); PG8_STAGE(PG8_SB(1, 1), b3 + hstep, voffB); PG8_STAGE(PG8_SA(1, 0), a3, voffA);
            PG8_WAIT_V(8); PG8_WAIT_L(0); PG8_BAR; PG8_MMA(1, 0, At, B0); PG8_MMA(1, 1, At, B1); PG8_BAR; PG8_SCHED;
            } else {
            PG8_LDB(B0, 0, 0); PG8_SCHED; PG8_LDA(At, 0, 0); PG8_STAGE(PG8_SA(1, 1), a1 + hstep, voffA);
            PG8_WAIT_L(8); PG8_BAR; PG8_WAIT_L(0); PG8_MMA(0, 0, At, B0); PG8_BAR; PG8_SCHED;
            PG8_LDB(B1, 0, 1); PG8_STAGE(PG8_SB(0, 0), b2, voffB);
            PG8_BAR; PG8_WAIT_L(0); PG8_MMA(0, 1, At, B1); PG8_BAR;
            PG8_LDA(At, 0, 1); PG8_STAGE(PG8_SA(0, 0), a2, voffA);
            PG8_BAR; PG8_WAIT_L(0); PG8_MMA(1, 0, At, B0); PG8_BAR; PG8_SCHED;
            PG8_STAGE(PG8_SB(0, 1), b2 + hstep, voffB);
            PG8_WAIT_V(6); PG8_BAR; PG8_MMA(1, 1, At, B1); PG8_BAR;
            PG8_LDB(B0, 1, 0); PG8_SCHED; PG8_LDA(At, 1, 0); PG8_STAGE(PG8_SA(0, 1), a2 + hstep, voffA);
            PG8_WAIT_L(8); PG8_BAR; PG8_WAIT_L(0); PG8_MMA(0, 0, At, B0); PG8_BAR; PG8_SCHED;
            PG8_LDB(B1, 1, 1); PG8_STAGE(PG8_SB(1, 0), b3, voffB);
            PG8_BAR; PG8_WAIT_L(0); PG8_MMA(0, 1, At, B1); PG8_BAR;
            PG8_LDA(At, 1, 1); PG8_STAGE(PG8_SA(1, 0), a3, voffA);
            PG8_BAR; PG8_WAIT_L(0); PG8_MMA(1, 0, At, B0); PG8_BAR; PG8_SCHED;
            PG8_STAGE(PG8_SB(1, 1), b3 + hstep, voffB);
            PG8_WAIT_V(6); PG8_BAR; PG8_MMA(1, 1, At, B1); PG8_BAR;
            }
        }
        if constexpr (ALIGN_EPI) { if (wr == 0) PG8_BAR; }
        { E(acc, cur, wr, wc, fr, fq, esc, tid); S.done(cur); }
        if (!has_next) break;
#pragma unroll
        for (int a = 0; a < 2; ++a)
#pragma unroll
            for (int b = 0; b < 2; ++b)
#pragma unroll
                for (int m = 0; m < 4; ++m)
#pragma unroll
                    for (int n = 0; n < 2; ++n) acc[a][b][m][n] = (f32x4){0.f, 0.f, 0.f, 0.f};
        cur = nxt; cA = nA; cB = nB; ++ui;
        if constexpr (ALIGN_EPI) { if (wr == 1) PG8_BAR; }
    }
    PG8_WAIT_V(0);
    if constexpr (!ALIGN_EPI) { if (wr == 0) PG8_BAR; }
    PG8_BAR;
#undef PG8_SA
#undef PG8_SB
#undef PG8_STAGE
#undef PG8_LDA
#undef PG8_LDB
#undef PG8_MMA
#undef PG8_WAIT_V
#undef PG8_WAIT_L
#undef PG8_BAR
#undef PG8_SCHED
}
}

typedef float f32x4 __attribute__((ext_vector_type(4)));
typedef short bf16x8 __attribute__((ext_vector_type(8)));


__device__ __forceinline__ void build_rs(const float* ssq, int pm, LAS unsigned char* esc, int tid) {
    LAS float* rsT = (LAS float*)esc;
    WG_BAR();
    if (tid < 256) {
        float s = 0.f;
#pragma unroll
        for (int j = 0; j < 8; ++j) { const gu64* p = (const gu64*)(ssq + ((size_t)j * MP + pm * 256 + tid) * 4);
#pragma unroll
            for (int h = 0; h < 2; ++h) { const unsigned long long v = __hip_atomic_load(p + h, RLX_AGENT); s += __builtin_bit_cast(float, (unsigned)v) + __builtin_bit_cast(float, (unsigned)(v >> 32)); } }
        rsT[tid] = rsqrtf(s * (1.0f / DM) + EPS);
    }
    WG_BAR();
}

struct EpiProj {
    static constexpr bool PERM = false, AFTER_DRAIN = false;
    unsigned char* ws_; float* out_; const float* gq; const float* gk; int l;
    __device__ __forceinline__ void operator()(f32x4 (&acc)[2][2][4][2], const pg8::Unit& u, int wr, int wc, int fr, int fq, LAS unsigned char* esc, int tid) const {
        asm volatile("" : "+v"(fr), "+v"(fq), "+v"(tid));
        unsigned char* ws = ws_; asm volatile("" : "+s"(ws));
        const float* ssq = (const float*)(ws + WS_SSQ); const float* ropec = (const float*)(ws + WS_ROPE); const float* ropes = ropec + ROPE_N;
        bf16* Q = (bf16*)(ws + WS_Q); bf16* K = (bf16*)(ws + WS_K); bf16* VT = (bf16*)(ws + WS_VT); float* U = (float*)(ws + WS_U); float* XP = (float*)(ws + WS_XP);
        float* ksn = (float*)(ws + WS_KSN); float* vsn = ksn + NSAMP * 256;
        float* out_pk = out_ + O_PK + (size_t)l * NBATCH * 128 * 256; float* out_pv = out_ + O_PV + (size_t)l * NBATCH * 128 * 256;
        build_rs(ssq, u.pm, esc, tid);
        const LAS float* rsT = (const LAS float*)esc;
        LAS float* hss = (LAS float*)(esc + 1024);
        const int pn = u.pn;
#pragma unroll
        for (int ai = 0; ai < 2; ++ai)
#pragma unroll
            for (int m = 0; m < 4; ++m) { const float rsv = rsT[ai * 128 + wr * 64 + m * 16 + fr];
#pragma unroll
                for (int bj = 0; bj < 2; ++bj)
#pragma unroll
                    for (int n = 0; n < 2; ++n) acc[ai][bj][m][n] *= rsv; }
        if (pn <= 4) {
#pragma unroll
            for (int ai = 0; ai < 2; ++ai)
#pragma unroll
                for (int m = 0; m < 4; ++m)
#pragma unroll
                    for (int bj = 0; bj < 2; ++bj) { const f32x4 a = acc[ai][bj][m][0], b = acc[ai][bj][m][1];
                        float s = (a[0] * a[0] + a[1] * a[1]) + (a[2] * a[2] + a[3] * a[3]) + (b[0] * b[0] + b[1] * b[1]) + (b[2] * b[2] + b[3] * b[3]);
                        s += __shfl_xor(s, 16); s += __shfl_xor(s, 32);
                        if (fq == 0) hss[(bj * 256 + ai * 128 + wr * 64 + m * 16 + fr) * 4 + wc] = s; }
            WG_BAR();
            const float* g = (pn < 4) ? gq : gk; const float osc = (pn < 4) ? QSCALE : 1.0f;
            f32x4 gv[2];
#pragma unroll
            for (int n = 0; n < 2; ++n) gv[n] = *(const f32x4*)(g + wc * 32 + n * 16 + 4 * fq);
#pragma unroll
            for (int ai = 0; ai < 2; ++ai)
#pragma unroll
                for (int m = 0; m < 4; ++m) {
                    const int rl = ai * 128 + wr * 64 + m * 16 + fr, r = u.pm * 256 + rl;
                    const bool samp = r >= SROW0, pad = r >= MR;
                    const int b = (r >= TT && !samp) ? 1 : 0, t = r - b * TT;
                    const int pidx = samp ? ROPE_SAMPLE_IDX : t;
                    f32x4 cs = {1.f, 1.f, 1.f, 1.f}, sn = {0.f, 0.f, 0.f, 0.f};
                    if (wc == 0 && !pad) { cs = *(const f32x4*)(ropec + (size_t)pidx * 16 + 4 * fq); sn = *(const f32x4*)(ropes + (size_t)pidx * 16 + 4 * fq); }
#pragma unroll
                    for (int bj = 0; bj < 2; ++bj) {
                        const f32x4 hv = *(const LAS f32x4*)(hss + (bj * 256 + rl) * 4);
                        const float hn = rsqrtf(((hv[0] + hv[1]) + (hv[2] + hv[3])) * (1.0f / 128.0f) + EPS);
                        f32x4 x1 = acc[ai][bj][m][0] * hn * gv[0], x2 = acc[ai][bj][m][1] * hn * gv[1];
                        if (wc == 0) { const f32x4 o1 = x1 * cs - x2 * sn, o2 = x2 * cs + x1 * sn; x1 = o1; x2 = o2; }
                        x1 = x1 * osc; x2 = x2 * osc;
                        const int cl = bj * 128 + wc * 32 + 4 * fq;
                        if (pn < 4) { bf16* qp = Q + (size_t)r * 1024 + pn * 256 + cl;
                            *(v2u*)qp = (v2u){pk2(x1[0], x1[1]), pk2(x1[2], x1[3])}; *(v2u*)(qp + 16) = (v2u){pk2(x2[0], x2[1]), pk2(x2[2], x2[3])}; }
                        else { bf16* kp = K + (size_t)r * 256 + cl;
                            *(v2u*)kp = (v2u){pk2(x1[0], x1[1]), pk2(x1[2], x1[3])}; *(v2u*)(kp + 16) = (v2u){pk2(x2[0], x2[1]), pk2(x2[2], x2[3])};
                            if (samp && !pad) { float* o = ksn + (size_t)(r - SROW0) * 256 + cl; *(f32x4*)o = x1; *(f32x4*)(o + 16) = x2; }
                            else if (!samp && t >= TT - 128) { float* o = out_pk + ((size_t)(b * 128 + (t - (TT - 128))) * 256) + cl; *(f32x4*)o = x1; *(f32x4*)(o + 16) = x2; } }
                    }
                }
        } else if (pn == 5) {
#pragma unroll
            for (int ai = 0; ai < 2; ++ai)
#pragma unroll
                for (int m = 0; m < 4; ++m) {
                    const int rl = ai * 128 + wr * 64 + m * 16 + fr, r = u.pm * 256 + rl;
                    const bool samp = r >= SROW0, pad = r >= MR;
                    const int b = (r >= TT && !samp) ? 1 : 0, t = r - b * TT;
                    const int tpos = (t & ~15) + perm16(t & 15);
#pragma unroll
                    for (int bj = 0; bj < 2; ++bj)
#pragma unroll
                        for (int n = 0; n < 2; ++n) { const f32x4 x = acc[ai][bj][m][n]; const int d = wc * 32 + n * 16 + 4 * fq;
                            if (!samp) { bf16* vp = VT + ((size_t)((b * 2 + bj) * 128 + d)) * TPV + tpos;
#pragma unroll
                                for (int j = 0; j < 4; ++j) vp[(size_t)j * TPV] = (bf16)(pk2(x[j], 0.f) & 0xffffu);
                                if (t >= TT - 128) *(f32x4*)(out_pv + ((size_t)(b * 128 + (t - (TT - 128))) * 256) + bj * 128 + d) = x; }
                            else if (!pad) *(f32x4*)(vsn + (size_t)(r - SROW0) * 256 + bj * 128 + d) = x; }
                }
        } else {
            float* dst = (pn < 8) ? U + (pn - 6) * 256 : XP + (pn - 8) * 256;
#pragma unroll
            for (int ai = 0; ai < 2; ++ai)
#pragma unroll
                for (int m = 0; m < 4; ++m) { float* rp = dst + (size_t)(u.pm * 256 + ai * 128 + wr * 64 + m * 16 + fr) * 512 + wc * 32 + 4 * fq;
#pragma unroll
                    for (int bj = 0; bj < 2; ++bj)
#pragma unroll
                        for (int n = 0; n < 2; ++n) *(f32x4*)(rp + bj * 128 + n * 16) = acc[ai][bj][m][n]; }
        }
    }
};

struct EpiRes {
    static constexpr bool PERM = false, AFTER_DRAIN = false;
    float* X; bf16* XB; float* ssq; float* out; int last;
    __device__ __forceinline__ void operator()(f32x4 (&acc)[2][2][4][2], const pg8::Unit& u, int wr, int wc, int fr, int fq, LAS unsigned char* esc, int tid) const {
        asm volatile("" : "+v"(fr), "+v"(fq), "+v"(tid));
#pragma unroll
        for (int ai = 0; ai < 2; ++ai)
#pragma unroll
            for (int m = 0; m < 4; ++m) {
                const int r = u.pm * 256 + ai * 128 + wr * 64 + m * 16 + fr; const int c0 = u.pn * 256 + wc * 32 + 4 * fq;
                float* xp = X + (size_t)r * DM + c0; float s = 0.f;
                f32x4 v[2][2];
#pragma unroll
                for (int bj = 0; bj < 2; ++bj)
#pragma unroll
                    for (int n = 0; n < 2; ++n) { v[bj][n] = *(const f32x4*)(xp + bj * 128 + n * 16) + acc[ai][bj][m][n]; const f32x4 q = v[bj][n] * v[bj][n]; s += (q[0] + q[1]) + (q[2] + q[3]); }
                if (!last) {
                    bf16* bp = XB + (size_t)r * DM + c0;
#pragma unroll
                    for (int bj = 0; bj < 2; ++bj)
#pragma unroll
                        for (int n = 0; n < 2; ++n) { *(f32x4*)(xp + bj * 128 + n * 16) = v[bj][n]; *(v2u*)(bp + bj * 128 + n * 16) = (v2u){pk2(v[bj][n][0], v[bj][n][1]), pk2(v[bj][n][2], v[bj][n][3])}; }
                    s += __shfl_xor(s, 16); s += __shfl_xor(s, 32);
                    if (fq == 0) ssq[((size_t)u.pn * MP + r) * 4 + wc] = s;
                } else {
                    const bool samp = r >= SROW0, pad = r >= MR; const int b = (r >= TT && !samp) ? 1 : 0, t = r - b * TT;
                    float* op = nullptr;
                    if (samp) { if (!pad) op = out + O_YS + (size_t)(r - SROW0) * DM + c0; } else if (t >= NMETA) op = out + O_YP + ((size_t)b * NSEQ + (t - NMETA)) * DM + c0;
                    if (op) {
#pragma unroll
                        for (int bj = 0; bj < 2; ++bj)
#pragma unroll
                            for (int n = 0; n < 2; ++n) *(f32x4*)(op + bj * 128 + n * 16) = v[bj][n]; }
                }
                if (m & 1) asm volatile("" ::: "memory");
            }
    }
};

struct EpiFfn1 {
    static constexpr bool PERM = true, AFTER_DRAIN = false;
    const float* ssq; bf16* H;
    __device__ __forceinline__ void operator()(f32x4 (&acc)[2][2][4][2], const pg8::Unit& u, int wr, int wc, int fr, int fq, LAS unsigned char* esc, int tid) const {
        asm volatile("" : "+v"(fr), "+v"(fq), "+v"(tid));
        build_rs(ssq, u.pm, esc, tid);
        const LAS float* rsT = (const LAS float*)esc;
#pragma unroll
        for (int ai = 0; ai < 2; ++ai)
#pragma unroll
            for (int m = 0; m < 4; ++m) { const int rl = ai * 128 + wr * 64 + m * 16 + fr; const float rsv = rsT[rl];
                bf16* rowp = H + (size_t)(u.pm * 256 + rl) * DFF + u.pn * 256 + wc * 32 + 8 * fq;
#pragma unroll
                for (int bj = 0; bj < 2; ++bj) { f32x4 v0 = acc[ai][bj][m][0] * rsv, v1 = acc[ai][bj][m][1] * rsv;
#pragma unroll
                    for (int j = 0; j < 4; ++j) { const float a = fmaxf(v0[j], 0.f), b = fmaxf(v1[j], 0.f); v0[j] = a * a; v1[j] = b * b; }
                    *(v4u*)(rowp + bj * 128) = (v4u){pk2(v0[0], v0[1]), pk2(v0[2], v0[3]), pk2(v1[0], v1[1]), pk2(v1[2], v1[3])}; } }
    }
};

#define XB_TMO      128
#define XB_XCNT(j)  (256  + 64 * (j))
#define XB_XSUB(j)  (1280 + 64 * (j))
#define XB_XGEN(j)  (2304 + 64 * (j))
#define XB_TOP      3328
#define XB_TOPGEN   3392
#define XCD_BAR_WORDS 3456
#define XB_SPIN_CAP (1u << 18)
__device__ __forceinline__ unsigned xb_ld(unsigned* p)              { return __hip_atomic_load(p, __ATOMIC_RELAXED, __HIP_MEMORY_SCOPE_AGENT); }
__device__ __forceinline__ unsigned xb_add(unsigned* p, unsigned v) { return __hip_atomic_fetch_add(p, v, __ATOMIC_RELAXED, __HIP_MEMORY_SCOPE_AGENT); }
__device__ __forceinline__ unsigned xb_xcc_id() { return (unsigned)__builtin_amdgcn_s_getreg((3 << 11) | 20) & 0xFu; }
#define XB_SPIN(cond, bar) do { unsigned _sp = 0; while (cond) { __builtin_amdgcn_s_sleep(1); \
    if ((++_sp & 255u) == 0u) { if (xb_ld(&(bar)[XB_TMO])) break; if (_sp > XB_SPIN_CAP) { atomicAdd(&(bar)[XB_TMO], 1u); break; } } } } while (0)

struct XcdBarrier {
    unsigned* bar; unsigned x;
    volatile LAS unsigned* st;
};

__device__ __forceinline__ XcdBarrier xcd_barrier_post(unsigned* bar, volatile LAS unsigned* st) {
    XcdBarrier b; b.bar = bar; b.x = xb_xcc_id(); b.st = st;
    if (threadIdx.x == 0) (void)xb_add(&bar[XB_XCNT(b.x)], 1u);
    return b;
}
__device__ __forceinline__ void xcd_barrier_complete(unsigned* bar, unsigned x, unsigned& nloc, unsigned& nx) {
    const unsigned G = gridDim.x * gridDim.y * gridDim.z;
    unsigned sum, cnt, mine, sp = 0u;
    for (;;) {
        sum = 0u; cnt = 0u; mine = 0u;
#pragma unroll
        for (unsigned j = 0; j < 16; ++j) { const unsigned c = xb_ld(&bar[XB_XCNT(j)]); sum += c; cnt += (c > 0u) ? 1u : 0u; mine = (j == x) ? c : mine; }
        if (sum == G) break;
        __builtin_amdgcn_s_sleep(1);
        if ((++sp & 255u) == 0u) { if (xb_ld(&bar[XB_TMO])) break; if (sp > XB_SPIN_CAP) { atomicAdd(&bar[XB_TMO], 1u); break; } }
    }
    nloc = mine > 0u ? mine : 1u; nx = cnt > 0u ? cnt : 1u;
}

__device__ __forceinline__ void xcd_barrier(const XcdBarrier& b) {
    asm volatile("s_waitcnt vmcnt(0)" ::: "memory");
    __syncthreads();
    if (threadIdx.x == 0) {
        unsigned* bar = b.bar;
        __builtin_amdgcn_s_waitcnt(0);
        unsigned nloc = b.st[0], nx = b.st[1];
        if (nloc == 0u) { xcd_barrier_complete(bar, b.x, nloc, nx); b.st[0] = nloc; b.st[1] = nx; }
        const unsigned old = xb_add(&bar[XB_XSUB(b.x)], 1u);
        const unsigned gen = old / nloc;
        if (old + 1u == (gen + 1u) * nloc) {
            __builtin_amdgcn_fence(__ATOMIC_RELEASE, "agent");
            asm volatile("s_waitcnt vmcnt(0)" ::: "memory");
            const unsigned og = xb_add(&bar[XB_TOP], 1u);
            const unsigned tg = og / nx;
            if (og + 1u == (tg + 1u) * nx) xb_add(&bar[XB_TOPGEN], 1u);
            else XB_SPIN(xb_ld(&bar[XB_TOPGEN]) == tg, bar);
            __builtin_amdgcn_fence(__ATOMIC_ACQUIRE, "agent");
            xb_add(&bar[XB_XGEN(b.x)], 1u);
            asm volatile("s_waitcnt vmcnt(0)" ::: "memory");
        } else {
            XB_SPIN(xb_ld(&bar[XB_XGEN(b.x)]) == gen, bar);
            __builtin_amdgcn_fence(__ATOMIC_ACQUIRE, "agent");
            asm volatile("s_waitcnt vmcnt(0)" ::: "memory");
        }
    }
    __syncthreads();
}

struct Frame {
    LAS unsigned char* lds;
    volatile LAS unsigned* MISC;
    gu32* ctl;
    int tid, lane, wave, vcu, G;
    float* out; unsigned char* ws;
};
#define IN_XPROMPT 0
#define IN_XSAMPLE 1
#define IN_CACHEK 2
#define IN_CACHEV 3
#define IN_SSMRE 4
#define IN_SSMIM 5
#define IN_SPOOL 6
#define IN_META 7
#define IN_GMIX 8
#define IN_WIN 9
#define IN_GQ 10
#define IN_GK 11
#define IN_SINKS 12
#define IN_ARE 13
#define IN_AIM 14
#define IN_LOGDT 15
#define IN_BRE 16
#define IN_BIM 17
#define IN_CRE 18
#define IN_CIM 19
#define IN_DSKIP 20
#define IN_WGLU 21
#define IN_BGLU 22
#define IN_WPOOL 23
#define IN_PSCALE 24
#define IN_GOA 25
#define IN_GOS 26
#define IN_GOP 27
#define IN_WOUT 28
#define IN_GFFN 29
#define IN_WFF1 30
#define IN_WFF2 31
struct Args { const float* in[32]; float* out; unsigned char* ws; int ph_lo, ph_hi; };
static_assert(sizeof(Args) == 32 * 8 + 8 + 8 + 8, "Args has no padding");

__device__ __forceinline__ void p0_transpose_item(const float* W, int K, int N, bf16* WT, const float* gain, LAS float* scr, int item, int lane) {
    const int nblk = N / 32, kb = item / nblk, nb = item % nblk, k0 = 64 * kb, n0 = 32 * nb;
    float wv[32];
#pragma unroll
    for (int i = 0; i < 32; ++i) wv[i] = W[(size_t)(k0 + 2 * i + (lane >> 5)) * N + n0 + (lane & 31)];
    if (gain) {
#pragma unroll
        for (int i = 0; i < 32; ++i) wv[i] *= gain[k0 + 2 * i + (lane >> 5)];
    }
#pragma unroll
    for (int i = 0; i < 32; ++i) scr[(2 * i + (lane >> 5)) * 33 + (lane & 31)] = wv[i];
    LDS_WAIT(); asm volatile("" ::: "memory");
    const int c = lane & 7;
#pragma unroll
    for (int j = 0; j < 4; ++j) { const int n = (lane >> 3) + 8 * j; const LAS float* s = scr + (8 * c) * 33 + n;
        v4u o; o.x = pk2(s[0 * 33], s[1 * 33]); o.y = pk2(s[2 * 33], s[3 * 33]); o.z = pk2(s[4 * 33], s[5 * 33]); o.w = pk2(s[6 * 33], s[7 * 33]);
        *(GAS v4u*)(WT + (size_t)(n0 + n) * K + k0 + 8 * c) = o; }
    LDS_WAIT(); asm volatile("" ::: "memory");
}
__device__ __forceinline__ void sincos_d(double x, double& s, double& c) {
    const double TWO_PI = 6.283185307179586476925286766559;
    const double k = rint(x * (1.0 / TWO_PI)); const double r = fma(-k, TWO_PI, x), r2 = r * r;
    const double fs[14] = {0.16666666666666666, 0.05, 0.023809523809523808, 0.013888888888888888, 0.00909090909090909, 0.00641025641025641, 0.004761904761904762, 0.003676470588235294,
                           0.0029239766081871343, 0.002380952380952381, 0.001976284584980237, 0.0016666666666666668, 0.0014245014245014246, 0.0012315270935960591};
    const double fc[14] = {0.5, 0.08333333333333333, 0.03333333333333333, 0.017857142857142856, 0.011111111111111112, 0.007575757575757576, 0.005494505494505495, 0.004166666666666667,
                           0.0032679738562091504, 0.002631578947368421, 0.0021645021645021645, 0.0018115942028985507, 0.0015384615384615385, 0.0013227513227513227};
    double ts = r, tc = 1.0; s = r; c = 1.0;
#pragma unroll
    for (int i = 0; i < 14; ++i) { ts *= -r2 * fs[i]; s += ts; tc *= -r2 * fc[i]; c += tc; }
}
__device__ __forceinline__ double exp_small(double x) {
    double t = 1.0, e = 1.0;
#pragma unroll
    for (int i = 1; i <= 14; ++i) { t *= x * (1.0 / i); e += t; }
    return e;
}
__device__ __forceinline__ void p0_prologue(const Args& AR, Frame& F) {
    LAS float* scr = (LAS float*)(F.lds + F.wave * 16384);
    const int gw = F.vcu * 8 + F.wave, NGW = F.G * 8, lane = F.lane;
    unsigned char* ws = F.ws;
    constexpr int I_IN = (DM / 64) * (INW / 32), I_OUT = (DM / 64) * (DM / 32), I_1 = (DM / 64) * (DFF / 32), I_2 = (DFF / 64) * (DM / 32), I_GLU = (512 / 64) * (512 / 32), I_POOL = 4 * 2 * 4;
    constexpr int I_LAYER = I_IN + I_OUT + I_1 + I_2 + I_GLU + I_POOL;
    for (int it = gw; it < NLAYER * I_LAYER; it += NGW) {
        const int l = it / I_LAYER; int r = it % I_LAYER;
        if (r < I_IN) { p0_transpose_item(AR.in[IN_WIN] + (size_t)l * DM * INW, DM, INW, (bf16*)(ws + WS_WIN) + (size_t)l * INW * DM, AR.in[IN_GMIX] + l * DM, scr, r, lane); continue; } r -= I_IN;
        if (r < I_OUT) { const int k0 = 64 * (r / (DM / 32));
            const float* g = (k0 < 1024) ? AR.in[IN_GOA] + l * 1024 : (k0 < 1536) ? AR.in[IN_GOS] + l * 512 - 1024 : AR.in[IN_GOP] + l * 512 - 1536;
            p0_transpose_item(AR.in[IN_WOUT] + (size_t)l * DM * DM, DM, DM, (bf16*)(ws + WS_WOUT) + (size_t)l * DM * DM, g, scr, r, lane); continue; } r -= I_OUT;
        if (r < I_1) { p0_transpose_item(AR.in[IN_WFF1] + (size_t)l * DM * DFF, DM, DFF, (bf16*)(ws + WS_W1) + (size_t)l * DFF * DM, AR.in[IN_GFFN] + l * DM, scr, r, lane); continue; } r -= I_1;
        if (r < I_2) { p0_transpose_item(AR.in[IN_WFF2] + (size_t)l * DFF * DM, DFF, DM, (bf16*)(ws + WS_W2) + (size_t)l * DM * DFF, nullptr, scr, r, lane); continue; } r -= I_2;
        if (r < I_GLU) { p0_transpose_item(AR.in[IN_WGLU] + (size_t)l * 512 * 512, 512, 512, (bf16*)(ws + WS_WGLU) + (size_t)l * 512 * 512, nullptr, scr, r, lane); continue; } r -= I_GLU;
        { const int g = r / 8; p0_transpose_item(AR.in[IN_WPOOL] + ((size_t)l * 4 + g) * 128 * 128, 128, 128, (bf16*)(ws + WS_WPOOL) + ((size_t)l * 4 + g) * 128 * 128, nullptr, scr, r % 8, lane); }
    }
    float* X = (float*)(ws + WS_X); bf16* XB = (bf16*)(ws + WS_XB); float* SSQ = (float*)(ws + WS_SSQ);
    for (int m = gw; m < MP; m += NGW) {
        const float* src = nullptr;
        if (m < SROW0) { const int b = m >= TT ? 1 : 0, t = m - b * TT; src = (t < NMETA) ? AR.in[IN_META] + (size_t)t * DM : AR.in[IN_XPROMPT] + ((size_t)b * NSEQ + (t - NMETA)) * DM; }
        else if (m < MR) src = AR.in[IN_XSAMPLE] + (size_t)(m - SROW0) * DM;
        float s = 0.f;
#pragma unroll
        for (int j = 0; j < 8; ++j) { f32x4 v = {0.f, 0.f, 0.f, 0.f}; if (src) v = *(const f32x4*)(src + j * 256 + lane * 4);
            s += (v[0] * v[0] + v[1] * v[1]) + (v[2] * v[2] + v[3] * v[3]);
            *(f32x4*)(X + (size_t)m * DM + j * 256 + lane * 4) = v; *(v2u*)(XB + (size_t)m * DM + j * 256 + lane * 4) = (v2u){pk2(v[0], v[1]), pk2(v[2], v[3])}; }
        s = wave_sum(s);
        if (lane < 32) SSQ[((size_t)(lane >> 2) * MP + m) * 4 + (lane & 3)] = (lane == 0) ? s : 0.f;
    }
    const int gt = gw * 64 + lane, NGT = NGW * 64;
    for (int id = gt; id < NLAYER * 32 * 64; id += NGT) {
        const int l = id >> 11, g = (id >> 6) & 31, n = id & 63;
        unsigned char* tb = ws + WS_TAB + (size_t)l * TB_LAYER;
        const double dt = (double)expf(AR.in[IN_LOGDT][l * 32 + g]);
        const double ar = (double)AR.in[IN_ARE][id], ai = (double)AR.in[IN_AIM][id];
        const double mag = exp_small(dt * ar); double sn, cs; sincos_d(dt * ai, sn, cs);
        const double abr = mag * cs, abi = mag * sn, den = ar * ar + ai * ai;
        const double fr = ((abr - 1.0) * ar + abi * ai) / den, fi = (abi * ar - (abr - 1.0) * ai) / den;
        ((float*)(tb + TB_ABR))[g * 64 + n] = (float)abr; ((float*)(tb + TB_ABI))[g * 64 + n] = (float)abi;
        const float* Br = AR.in[IN_BRE] + (size_t)id * 16; const float* Bi = AR.in[IN_BIM] + (size_t)id * 16;
        float* bbr = (float*)(tb + TB_BBR) + (size_t)(g * 64 + n) * 16; float* bbi = (float*)(tb + TB_BBI) + (size_t)(g * 64 + n) * 16;
#pragma unroll
        for (int c = 0; c < 16; ++c) { const double br = Br[c], bi = Bi[c]; bbr[c] = (float)(fr * br - fi * bi); bbi[c] = (float)(fr * bi + fi * br); }
        bf16* Pm = (bf16*)(tb + TB_PM) + (size_t)g * 64 * 128;
        double pr = abr, pi = abi;
        for (int t = 0; t < 64; ++t) {
            Pm[t * 128 + n] = (bf16)(pk2((float)pr, 0.f) & 0xffffu); Pm[t * 128 + 64 + n] = (bf16)(pk2((float)pi, 0.f) & 0xffffu);
            if (t == 15) { ((float*)(tb + TB_A16R))[g * 64 + n] = (float)pr; ((float*)(tb + TB_A16I))[g * 64 + n] = (float)pi; }
            if (t == 31) { ((float*)(tb + TB_A32R))[g * 64 + n] = (float)pr; ((float*)(tb + TB_A32I))[g * 64 + n] = (float)pi; }
            if (t == 63) { ((float*)(tb + TB_ALR))[g * 64 + n] = (float)pr; ((float*)(tb + TB_ALI))[g * 64 + n] = (float)pi; }
            const double nr = pr * abr - pi * abi, ni = pr * abi + pi * abr; pr = nr; pi = ni;
        }
        bf16* CmT = (bf16*)(tb + TB_CMT) + (size_t)g * 16 * 128;
        const float* Cr = AR.in[IN_CRE] + ((size_t)(l * 32 + g) * 16) * 64 + n; const float* Ci = AR.in[IN_CIM] + ((size_t)(l * 32 + g) * 16) * 64 + n;
#pragma unroll
        for (int c = 0; c < 16; ++c) { CmT[c * 128 + n] = (bf16)(pk2(Cr[c * 64], 0.f) & 0xffffu); CmT[c * 128 + 64 + n] = (bf16)(pk2(-Ci[c * 64], 0.f) & 0xffffu); }
    }
    float* rc = (float*)(ws + WS_ROPE); float* rs_ = rc + ROPE_N;
    for (int id = gt; id < (int)ROPE_N; id += NGT) {
        const int p = id >> 4, i = id & 15; const double pos = (p == ROPE_SAMPLE_IDX) ? 16384.0 : (double)p;
        double inv = 1.0;
        for (int k = 0; k < i; ++k) inv *= 0.44036660267178046;
        double sn, cs; sincos_d(pos * inv, sn, cs);
        rc[id] = (float)cs; rs_[id] = (float)sn;
    }
}

__device__ __forceinline__ void attn_unit(const Args& AR, Frame& F, int l, int b, int i) {
    int lane_ = F.lane; asm volatile("" : "+v"(lane_));
    unsigned char* ws = F.ws; asm volatile("" : "+s"(ws));
    const int lane = lane_, h = F.wave, c = lane & 31, hh = lane >> 5, kvh = h >> 2;
    const int t0 = 32 * i; const size_t rb = (size_t)b * TT;
    const bf16* Q = (const bf16*)(ws + WS_Q); const bf16* K = (const bf16*)(ws + WS_K); const bf16* VT = (const bf16*)(ws + WS_VT);
    bf16* MIX = (bf16*)(ws + WS_MIX);
    LAS float* ex = (LAS float*)(F.lds + ESC_OFF);
    bf16x8 qf[8];
    { const bf16* qp = Q + (rb + t0 + c) * 1024 + 128 * h + 8 * hh;
#pragma unroll
      for (int ks = 0; ks < 8; ++ks) qf[ks] = *(const bf16x8*)(qp + 16 * ks); }
    const int kt0 = (t0 >= 128) ? 0 : (4 - i);
    f32x16 S[5];
#pragma unroll
    for (int kt = 0; kt < 5; ++kt) {
#pragma unroll
        for (int r = 0; r < 16; ++r) S[kt][r] = -INFINITY;
        if (kt >= kt0) {
            const int tk0 = t0 - 128 + 32 * kt;
            const bf16* kp = K + (rb + tk0 + c) * 256 + 128 * kvh + 8 * hh;
            bf16x8 kf[8];
#pragma unroll
            for (int ks = 0; ks < 8; ++ks) kf[ks] = *(const bf16x8*)(kp + 16 * ks);
            f32x16 a = {0.f, 0.f, 0.f, 0.f, 0.f, 0.f, 0.f, 0.f, 0.f, 0.f, 0.f, 0.f, 0.f, 0.f, 0.f, 0.f};
#pragma unroll
            for (int ks = 0; ks < 8; ++ks) a = __builtin_amdgcn_mfma_f32_32x32x16_bf16(kf[ks], qf[ks], a, 0, 0, 0);
#pragma unroll
            for (int r = 0; r < 16; ++r) { const int kr = (r & 3) + 8 * (r >> 2) + 4 * hh; bool ok = true;
                if (kt == 0) ok = kr >= c;
                if (kt == 4) ok = kr <= c;
                S[kt][r] = ok ? a[r] : -INFINITY; }
        }
    }
    const float sink2 = AR.in[IN_SINKS][l * 8 + h] * LOG2E;
    float mx = sink2;
#pragma unroll
    for (int kt = 0; kt < 5; ++kt)
#pragma unroll
        for (int r = 0; r < 16; ++r) mx = fmaxf(mx, S[kt][r]);
    mx = fmaxf(mx, __shfl_xor(mx, 32));
    float sum = 0.f;
#pragma unroll
    for (int kt = 0; kt < 5; ++kt)
#pragma unroll
        for (int r = 0; r < 16; ++r) { const float p = __builtin_amdgcn_exp2f(S[kt][r] - mx); S[kt][r] = p; sum += p; }
    sum += __shfl_xor(sum, 32);
    const float inv = 1.0f / (sum + __builtin_amdgcn_exp2f(sink2 - mx));
    f32x16 O[4];
#pragma unroll
    for (int db = 0; db < 4; ++db)
#pragma unroll
        for (int r = 0; r < 16; ++r) O[db][r] = 0.f;
#pragma unroll
    for (int kt = 0; kt < 5; ++kt) {
        if (kt >= kt0) {
            const int tk0 = t0 - 128 + 32 * kt;
#pragma unroll
            for (int s = 0; s < 2; ++s) {
                v4u pw; pw.x = pk2(S[kt][8 * s + 0], S[kt][8 * s + 1]); pw.y = pk2(S[kt][8 * s + 2], S[kt][8 * s + 3]); pw.z = pk2(S[kt][8 * s + 4], S[kt][8 * s + 5]); pw.w = pk2(S[kt][8 * s + 6], S[kt][8 * s + 7]);
                const bf16x8 pf = __builtin_bit_cast(bf16x8, pw);
#pragma unroll
                for (int db = 0; db < 4; ++db) {
                    const bf16x8 vf = *(const bf16x8*)(VT + ((size_t)((b * 2 + kvh) * 128 + 32 * db + c)) * TPV + tk0 + 16 * s + 8 * hh);
                    O[db] = __builtin_amdgcn_mfma_f32_32x32x16_bf16(vf, pf, O[db], 0, 0, 0);
                }
            }
        }
    }
    float ss = 0.f;
#pragma unroll
    for (int db = 0; db < 4; ++db)
#pragma unroll
        for (int r = 0; r < 16; ++r) { O[db][r] *= inv; ss += O[db][r] * O[db][r]; }
    ss += __shfl_xor(ss, 32);
    if (hh == 0) ex[h * 32 + c] = ss;
    WG_BAR();
    float tot = 0.f;
#pragma unroll
    for (int j = 0; j < 8; ++j) tot += ex[j * 32 + c];
    const float rsa = rsqrtf(tot * (1.0f / 1024.0f) + EPS);
    if (t0 + c < TT) {
        bf16* mp = MIX + (rb + t0 + c) * DM + 128 * h + 4 * hh;
#pragma unroll
        for (int db = 0; db < 4; ++db)
#pragma unroll
            for (int g4 = 0; g4 < 4; ++g4)
                *(v2u*)(mp + 32 * db + 8 * g4) = (v2u){pk2(O[db][4 * g4 + 0] * rsa, O[db][4 * g4 + 1] * rsa), pk2(O[db][4 * g4 + 2] * rsa, O[db][4 * g4 + 3] * rsa)};
    }
    WG_BAR();
}

__device__ __forceinline__ void sattn_unit(const Args& AR, Frame& F, int l, int s) {
    int tid_ = F.tid; asm volatile("" : "+v"(tid_));
    const int tid = tid_, lane = tid & 63, wave = F.wave;
    LAS float* qs = (LAS float*)F.lds;
    LAS float* sc = qs + 1024;
    LAS float* part = sc + 8 * 132;
    LAS float* red = part + 4096;
    const size_t row = SROW0 + s;
    const bf16* Q = (const bf16*)(F.ws + WS_Q) + row * 1024;
    const float* ksn = (const float*)(F.ws + WS_KSN) + (size_t)s * 256; const float* vsn = ksn + NSAMP * 256;
    const float* ck = AR.in[IN_CACHEK] + ((size_t)(l * NSAMP + s)) * 128 * 256; const float* cv = AR.in[IN_CACHEV] + ((size_t)(l * NSAMP + s)) * 128 * 256;
    for (int j = tid; j < 1024; j += 512) qs[j] = bf2f(Q[j]);
    WG_BAR();
    { const int key = tid >> 2, pt = tid & 3;
#pragma unroll
      for (int kvh = 0; kvh < 2; ++kvh) {
          const float* kp = ck + (size_t)key * 256 + kvh * 128 + 32 * pt; float d[4] = {0.f, 0.f, 0.f, 0.f};
#pragma unroll
          for (int j = 0; j < 8; ++j) { const f32x4 kv = *(const f32x4*)(kp + 4 * j);
#pragma unroll
              for (int g = 0; g < 4; ++g) { const f32x4 qv = *(const LAS f32x4*)(qs + (4 * kvh + g) * 128 + 32 * pt + 4 * j); d[g] += (kv[0] * qv[0] + kv[1] * qv[1]) + (kv[2] * qv[2] + kv[3] * qv[3]); } }
#pragma unroll
          for (int g = 0; g < 4; ++g) { d[g] += __shfl_xor(d[g], 1); d[g] += __shfl_xor(d[g], 2); if (pt == 0) sc[(4 * kvh + g) * 132 + key] = d[g]; }
      } }
    {
      const int h = wave, kvh = h >> 2; float d = ksn[kvh * 128 + lane] * qs[h * 128 + lane] + ksn[kvh * 128 + 64 + lane] * qs[h * 128 + 64 + lane];
      d = wave_sum(d); if (lane == 0) sc[h * 132 + 128] = d; }
    WG_BAR();
    { const int h = wave; const float sink2 = AR.in[IN_SINKS][l * 8 + h] * LOG2E;
      const float v0 = sc[h * 132 + lane], v1 = sc[h * 132 + 64 + lane], v2 = (lane == 0) ? sc[h * 132 + 128] : -INFINITY;
      const float mx = fmaxf(wave_max(fmaxf(fmaxf(v0, v1), v2)), sink2);
      const float p0 = __builtin_amdgcn_exp2f(v0 - mx), p1 = __builtin_amdgcn_exp2f(v1 - mx), p2 = __builtin_amdgcn_exp2f(v2 - mx);
      const float inv = 1.0f / (wave_sum(p0 + p1 + p2) + __builtin_amdgcn_exp2f(sink2 - mx));
      sc[h * 132 + lane] = p0 * inv; sc[h * 132 + 64 + lane] = p1 * inv; if (lane == 0) sc[h * 132 + 128] = p2 * inv; }
    WG_BAR();
    { const int d = tid & 127, kq = tid >> 7;
#pragma unroll
      for (int kvh = 0; kvh < 2; ++kvh) { float a[4] = {0.f, 0.f, 0.f, 0.f};
#pragma unroll 8
          for (int k = 0; k < 32; ++k) { const int key = 32 * kq + k; const float v = cv[(size_t)key * 256 + kvh * 128 + d];
#pragma unroll
              for (int g = 0; g < 4; ++g) a[g] += sc[(4 * kvh + g) * 132 + key] * v; }
#pragma unroll
          for (int g = 0; g < 4; ++g) part[kq * 1024 + (4 * kvh + g) * 128 + d] = a[g]; } }
    WG_BAR();
    float o[2]; float ss = 0.f;
#pragma unroll
    for (int e = 0; e < 2; ++e) { const int j = tid + 512 * e, h = j >> 7, d = j & 127, kvh = h >> 2;
        o[e] = (part[j] + part[1024 + j]) + (part[2048 + j] + part[3072 + j]) + sc[h * 132 + 128] * vsn[kvh * 128 + d]; ss += o[e] * o[e]; }
    ss = wave_sum(ss); if (lane == 0) red[wave] = ss;
    WG_BAR();
    { float tot = 0.f;
#pragma unroll
      for (int j = 0; j < 8; ++j) tot += red[j];
      const float rsa = rsqrtf(tot * (1.0f / 1024.0f) + EPS);
      bf16* mp = (bf16*)(F.ws + WS_MIX) + row * DM;
#pragma unroll
      for (int e = 0; e < 2; ++e) mp[tid + 512 * e] = (bf16)(pk2(o[e] * rsa, 0.f) & 0xffffu); }
    { float* ok = F.out + O_SK + ((size_t)(l * NSAMP + s)) * 128 * 256; float* ov = F.out + O_SV + ((size_t)(l * NSAMP + s)) * 128 * 256;
      for (int j = tid; j < 127 * 64; j += 512) { *(f32x4*)(ok + 4 * j) = *(const f32x4*)(ck + 256 + 4 * j); *(f32x4*)(ov + 4 * j) = *(const f32x4*)(cv + 256 + 4 * j); }
      if (tid < 64) *(f32x4*)(ok + 127 * 256 + 4 * tid) = *(const f32x4*)(ksn + 4 * tid);
      else if (tid < 128) *(f32x4*)(ov + 127 * 256 + 4 * (tid - 64)) = *(const f32x4*)(vsn + 4 * (tid - 64)); }
    WG_BAR();
}

__device__ __forceinline__ float gelu_tanh(float y) {
    const float inner = 0.7978845608028654f * (y + 0.044715f * y * y * y);
    return y / (1.0f + __builtin_amdgcn_exp2f(-2.0f * LOG2E * inner));
}
__device__ __forceinline__ float sigmoidf_(float x) { return 1.0f / (1.0f + __builtin_amdgcn_exp2f(-LOG2E * x)); }
#define SWZ(r, ch, PITCH) ((r) * (PITCH) + ((((ch)) ^ ((r) & 15)) << 4))

#define SSM_ROWS4(BODY_PRE, BODY_POST) \
    _Pragma("unroll") for (int r4 = 0; r4 < 4; ++r4) { const int r = rbase + r4; BODY_PRE \
        f32x2 xx = {0.f, 0.f}; \
        _Pragma("unroll") for (int cc = 0; cc < 16; ++cc) { const float uv = __builtin_bit_cast(float, __builtin_amdgcn_readlane(__builtin_bit_cast(int, uu[cc]), r)); xx += bb[cc] * (f32x2){uv, uv}; } \
        const float nr = abr * hr - abi * hi + xx[0], ni = abr * hi + abi * hr + xx[1]; hr = nr; hi = ni; BODY_POST }
__device__ __forceinline__ void ssm_unit(const Args& AR, Frame& F, int l, int c) {
    int lane_ = F.lane; asm volatile("" : "+v"(lane_));
    const int lane = lane_, w = F.wave, n = lane, t16 = lane & 15, cq = lane >> 4;
    const int row0 = 64 * c;
    unsigned char* ws = F.ws; asm volatile("" : "+s"(ws));
    const unsigned char* tb = ws + WS_TAB + (size_t)l * TB_LAYER;
    const float* U = (const float*)(ws + WS_U);
    float* SST = (float*)(ws + WS_SST) + ((size_t)l * NCHUNK) * 32 * 128;
    gu32* flags = F.ctl + CW_SSMF + (size_t)(l * NCHUNK) * 8 * 16;
    LAS unsigned char* Zs = F.lds;
    LAS unsigned char* Hm = F.lds + 65536 + w * 8192;
    LAS float* red = (LAS float*)(F.lds + ESC_OFF);
    if (c != NCHUNK - 1) {
#pragma unroll 1
        for (int gi = 0; gi < 4; ++gi) {
            const int g = 4 * w + gi;
            const float abr = ((const float*)(tb + TB_ABR))[g * 64 + n], abi = ((const float*)(tb + TB_ABI))[g * 64 + n];
            f32x2 bb[16];
            { const f32x4* pr = (const f32x4*)((const float*)(tb + TB_BBR) + (size_t)(g * 64 + n) * 16); const f32x4* pi = (const f32x4*)((const float*)(tb + TB_BBI) + (size_t)(g * 64 + n) * 16);
#pragma unroll
              for (int j = 0; j < 4; ++j) { const f32x4 a = pr[j], b2 = pi[j];
#pragma unroll
                  for (int e = 0; e < 4; ++e) bb[4 * j + e] = (f32x2){a[e], b2[e]}; } }
            float uu[16];
            { const f32x4* pu = (const f32x4*)(U + (size_t)(row0 + lane) * 512 + 16 * g);
#pragma unroll
              for (int j = 0; j < 4; ++j) { const f32x4 a = pu[j];
#pragma unroll
                  for (int e = 0; e < 4; ++e) uu[4 * j + e] = a[e]; } }
            float hr = 0.f, hi = 0.f;
#pragma unroll 1
            for (int rbase = (c == 64) ? 16 : 0; rbase < 64; rbase += 4) { SSM_ROWS4(, ) }
            __hip_atomic_store((gu64*)(SST + ((size_t)c * 32 + g) * 128 + 2 * n), ((unsigned long long)__builtin_bit_cast(unsigned, hi) << 32) | __builtin_bit_cast(unsigned, hr), RLX_AGENT);
        }
        VM_WAIT();
        if (lane == 0) __hip_atomic_store(flags + ((size_t)c * 8 + w) * 16, 1u, RLX_AGENT);
    }
    const int cs0 = (c <= 64) ? 0 : 64, npred = c - cs0;
    if (npred > 0) {
        unsigned sp = 0; bool ok = false;
        for (;;) { ok = (lane >= npred) || (__hip_atomic_load(flags + ((size_t)(cs0 + lane) * 8 + w) * 16, RLX_AGENT) != 0u);
            if (__all(ok)) break;
            __builtin_amdgcn_s_sleep(2);
            if (++sp > (1u << 20)) { if (lane == 0) __hip_atomic_store(F.ctl + CW_TMO, 0x55u, RLX_AGENT); break; } }
        __builtin_amdgcn_fence(__ATOMIC_ACQUIRE, "agent");
        VM_WAIT();
    }
#pragma unroll 1
    for (int gi = 0; gi < 4; ++gi) {
        const int g = 4 * w + gi;
        const float abr = ((const float*)(tb + TB_ABR))[g * 64 + n], abi = ((const float*)(tb + TB_ABI))[g * 64 + n];
        float hr = 0.f, hi = 0.f;
        if (npred > 0) {
            const float aLr = ((const float*)(tb + TB_ALR))[g * 64 + n], aLi = ((const float*)(tb + TB_ALI))[g * 64 + n];
            for (int cp = cs0; cp < c; cp += 8) {
                f32x2 sv[8];
#pragma unroll
                for (int j = 0; j < 8; ++j) { const int cj = (cp + j < c) ? cp + j : c - 1; sv[j] = *(const f32x2*)(SST + ((size_t)cj * 32 + g) * 128 + 2 * n); }
#pragma unroll
                for (int j = 0; j < 8; ++j) if (cp + j < c) { const float nr = aLr * hr - aLi * hi + sv[j][0], ni = aLr * hi + aLi * hr + sv[j][1]; hr = nr; hi = ni; }
            }
        }
        f32x2 bb[16];
        { const f32x4* pr = (const f32x4*)((const float*)(tb + TB_BBR) + (size_t)(g * 64 + n) * 16); const f32x4* pi = (const f32x4*)((const float*)(tb + TB_BBI) + (size_t)(g * 64 + n) * 16);
#pragma unroll
          for (int j = 0; j < 4; ++j) { const f32x4 a = pr[j], b2 = pi[j];
#pragma unroll
              for (int e = 0; e < 4; ++e) bb[4 * j + e] = (f32x2){a[e], b2[e]}; } }
        float uu[16];
        { const f32x4* pu = (const f32x4*)(U + (size_t)(row0 + lane) * 512 + 16 * g);
#pragma unroll
          for (int j = 0; j < 4; ++j) { const f32x4 a = pu[j];
#pragma unroll
              for (int e = 0; e < 4; ++e) uu[4 * j + e] = a[e]; } }
        bf16x8 cmf[4];
        { const bf16* cm = (const bf16*)(tb + TB_CMT) + (size_t)g * 16 * 128 + t16 * 128 + 8 * cq;
#pragma unroll
          for (int ks = 0; ks < 4; ++ks) cmf[ks] = *(const bf16x8*)(cm + 32 * ks); }
        const int col = 64 * w + 16 * gi + 4 * cq;
        const f32x4 dsk = *(const f32x4*)(AR.in[IN_DSKIP] + l * 512 + col);
#pragma unroll 1
        for (int half = 0; half < 2; ++half) {
            const bool samp = (c == NCHUNK - 1) && (half == 1);
#pragma unroll 1
            for (int rbase = 32 * half; rbase < 32 * half + 32; rbase += 4) {
                float h0r[4], h0i[4];
#pragma unroll
                for (int r4 = 0; r4 < 4; ++r4) { h0r[r4] = 0.f; h0i[r4] = 0.f; }
                if (samp) {
#pragma unroll
                    for (int r4 = 0; r4 < 4; ++r4) { const size_t o = ((size_t)(l * NSAMP + (rbase - 32 + r4)) * 32 + g) * 64 + n; h0r[r4] = AR.in[IN_SSMRE][o]; h0i[r4] = AR.in[IN_SSMIM][o]; }
                }
                SSM_ROWS4(
                    if (c == 64 && r == 16) { hr = 0.f; hi = 0.f; }
                    if (samp) { hr = h0r[r4]; hi = h0i[r4]; } ,
                    { const int rl = r & 31;
                      *(LAS bf16*)(Hm + SWZ(rl, n >> 3, 256) + (n & 7) * 2) = (bf16)(pk2(hr, 0.f) & 0xffffu);
                      *(LAS bf16*)(Hm + SWZ(rl, 8 + (n >> 3), 256) + (n & 7) * 2) = (bf16)(pk2(hi, 0.f) & 0xffffu);
                      if ((c == 64 && r == 15) || (c == NCHUNK - 1 && r == 31)) { const size_t o = ((size_t)(l * NBATCH + (c == 64 ? 0 : 1)) * 32 + g) * 64 + n; F.out[O_PSR + o] = hr; F.out[O_PSI + o] = hi; }
                      if (samp) { const size_t o = ((size_t)(l * NSAMP + (r - 32)) * 32 + g) * 64 + n; F.out[O_SSR + o] = hr; F.out[O_SSI + o] = hi; } } )
            }
            LDS_WAIT();
#pragma unroll
            for (int mt = 0; mt < 2; ++mt) {
                f32x4 y = {0.f, 0.f, 0.f, 0.f};
#pragma unroll
                for (int ks = 0; ks < 4; ++ks) { const bf16x8 hf = *(const LAS bf16x8*)(Hm + SWZ(16 * mt + t16, 4 * ks + cq, 256));
                    y = __builtin_amdgcn_mfma_f32_16x16x32_bf16(cmf[ks], hf, y, 0, 0, 0); }
                const int rl = 32 * half + 16 * mt + t16;
                const f32x4 uv = *(const f32x4*)(U + (size_t)(row0 + rl) * 512 + col);
                f32x4 z;
#pragma unroll
                for (int e = 0; e < 4; ++e) z[e] = gelu_tanh(y[e] + dsk[e] * uv[e]);
                *(LAS v2u*)(Zs + SWZ(rl, col >> 3, 1024) + (col & 7) * 2) = (v2u){pk2(z[0], z[1]), pk2(z[2], z[3])};
            }
            LDS_WAIT();
        }
    }
    WG_BAR();
    f32x4 G[4][4];
#pragma unroll
    for (int mt = 0; mt < 4; ++mt)
#pragma unroll
        for (int nt = 0; nt < 4; ++nt) G[mt][nt] = (f32x4){0.f, 0.f, 0.f, 0.f};
    { const bf16* Wg = (const bf16*)(ws + WS_WGLU) + (size_t)l * 512 * 512 + (size_t)(64 * w + t16) * 512 + 8 * cq;
#pragma unroll 2
      for (int ks = 0; ks < 16; ++ks) {
          bf16x8 wf[4], zf[4];
#pragma unroll
          for (int nt = 0; nt < 4; ++nt) wf[nt] = *(const bf16x8*)(Wg + (size_t)nt * 16 * 512 + 32 * ks);
#pragma unroll
          for (int mt = 0; mt < 4; ++mt) zf[mt] = *(const LAS bf16x8*)(Zs + SWZ(16 * mt + t16, 4 * ks + cq, 1024));
#pragma unroll
          for (int mt = 0; mt < 4; ++mt)
#pragma unroll
              for (int nt = 0; nt < 4; ++nt) G[mt][nt] = __builtin_amdgcn_mfma_f32_16x16x32_bf16(wf[nt], zf[mt], G[mt][nt], 0, 0, 0);
      } }
#pragma unroll
    for (int mt = 0; mt < 4; ++mt) { float ss = 0.f; const int rl = 16 * mt + t16;
#pragma unroll
        for (int nt = 0; nt < 4; ++nt) { const int col = 64 * w + 16 * nt + 4 * cq; const f32x4 bg = *(const f32x4*)(AR.in[IN_BGLU] + l * 512 + col);
            const v2u zz = *(const LAS v2u*)(Zs + SWZ(rl, col >> 3, 1024) + (col & 7) * 2);
            const float zv[4] = {bf2f((unsigned short)(zz.x & 0xffffu)), bf2f((unsigned short)(zz.x >> 16)), bf2f((unsigned short)(zz.y & 0xffffu)), bf2f((unsigned short)(zz.y >> 16))};
#pragma unroll
            for (int e = 0; e < 4; ++e) { const float o = zv[e] * sigmoidf_(G[mt][nt][e] + bg[e]); G[mt][nt][e] = o; ss += o * o; } }
        ss += __shfl_xor(ss, 16); ss += __shfl_xor(ss, 32);
        if (cq == 0) red[rl * 8 + w] = ss; }
    WG_BAR();
    { bf16* MIX = (bf16*)(ws + WS_MIX);
#pragma unroll
      for (int mt = 0; mt < 4; ++mt) { const int rl = 16 * mt + t16; const LAS f32x4* rp = (const LAS f32x4*)(red + rl * 8); const f32x4 a = rp[0], b2 = rp[1];
          const float rsn = rsqrtf(((a[0] + a[1]) + (a[2] + a[3]) + (b2[0] + b2[1]) + (b2[2] + b2[3])) * (1.0f / 512.0f) + EPS);
          bf16* mp = MIX + (size_t)(row0 + rl) * DM + 1024 + 64 * w + 4 * cq;
#pragma unroll
          for (int nt = 0; nt < 4; ++nt) *(v2u*)(mp + 16 * nt) = (v2u){pk2(G[mt][nt][0] * rsn, G[mt][nt][1] * rsn), pk2(G[mt][nt][2] * rsn, G[mt][nt][3] * rsn)}; } }
    WG_BAR();
}
#undef SSM_ROWS4

template <int WLEN>
__device__ __forceinline__ void pool_half(const float* XP, float* out, int l, int ch, int rfirst, int rl0, LAS unsigned char* Ds) {
    float xv[48];
#pragma unroll
    for (int i = 0; i < 48; ++i) { const int ra = rfirst + i - 16; xv[i] = (ra >= 0) ? XP[(size_t)ra * 512 + ch] : 0.f; }
    int seg = (rfirst >= TT) ? TT : 0;
    float sum = 0.f;
#pragma unroll
    for (int j = 1; j <= WLEN; ++j) if (rfirst - j >= seg) sum += xv[16 - j];
#pragma unroll
    for (int i = 0; i < 32; ++i) {
        const int ra = rfirst + i; const float x = xv[16 + i];
        if (ra == TT) { seg = TT; sum = 0.f; }
        sum += x;
        if (ra - WLEN >= seg) sum -= xv[16 + i - WLEN];
        const int cnt = (ra - seg + 1 < WLEN) ? (ra - seg + 1) : WLEN;
        const float dm = sum * __builtin_amdgcn_rcpf((float)cnt) - x;
        if (ra >= TT - 15 && ra < TT) out[O_PP + ((size_t)(l * NBATCH + 0) * 15 + (ra - (TT - 15))) * 512 + ch] = x;
        if (ra >= SROW0 - 15) out[O_PP + ((size_t)(l * NBATCH + 1) * 15 + (ra - (SROW0 - 15))) * 512 + ch] = x;
        const int r = rl0 + i;
        *(LAS bf16*)(Ds + SWZ(r, ch >> 3, 1024) + (ch & 7) * 2) = (bf16)(pk2(dm, 0.f) & 0xffffu);
    }
}
template <int WLEN>
__device__ __forceinline__ void pool_sample_rows(const float* XP, const float* sp, float* out, int l, int ch, LAS unsigned char* Ds) {
#pragma unroll 2
    for (int s = 0; s < NSAMP; ++s) {
        const float* pp = sp + (size_t)s * 15 * 512; float pv[15];
#pragma unroll
        for (int j = 0; j < 15; ++j) pv[j] = pp[(size_t)j * 512];
        const float x = XP[(size_t)(SROW0 + s) * 512 + ch]; float a = x;
#pragma unroll
        for (int j = 16 - WLEN; j < 15; ++j) a += pv[j];
        const float dm = a * (1.0f / WLEN) - x;
        float* op = out + O_SP + ((size_t)(l * NSAMP + s) * 15) * 512 + ch;
#pragma unroll
        for (int j = 0; j < 14; ++j) op[(size_t)j * 512] = pv[j + 1];
        op[(size_t)14 * 512] = x;
        *(LAS bf16*)(Ds + SWZ(32 + s, ch >> 3, 1024) + (ch & 7) * 2) = (bf16)(pk2(dm, 0.f) & 0xffffu);
    }
}
__device__ __forceinline__ void pool_unit(const Args& AR, Frame& F, int l, int c) {
    int tid_ = F.tid; asm volatile("" : "+v"(tid_));
    const int tid = tid_, lane = tid & 63, w = F.wave, t16 = lane & 15, cq = lane >> 4;
    const int row0 = 64 * c;
    unsigned char* ws = F.ws; asm volatile("" : "+s"(ws));
    const float* XP = (const float*)(ws + WS_XP);
    LAS unsigned char* Ds = F.lds;
    LAS float* red = (LAS float*)(F.lds + ESC_OFF);
    { const int ch = tid, wsel = w >> 1;
      const float* sp = AR.in[IN_SPOOL] + (size_t)l * NSAMP * 15 * 512 + ch;
#pragma unroll 1
      for (int half = 0; half < 2; ++half) {
          if (c == NCHUNK - 1 && half == 1) {
              if (wsel == 0) pool_sample_rows<2>(XP, sp, F.out, l, ch, Ds); else if (wsel == 1) pool_sample_rows<4>(XP, sp, F.out, l, ch, Ds);
              else if (wsel == 2) pool_sample_rows<8>(XP, sp, F.out, l, ch, Ds); else pool_sample_rows<16>(XP, sp, F.out, l, ch, Ds);
          } else {
              const int rfirst = row0 + 32 * half;
              if (wsel == 0) pool_half<2>(XP, F.out, l, ch, rfirst, 32 * half, Ds); else if (wsel == 1) pool_half<4>(XP, F.out, l, ch, rfirst, 32 * half, Ds);
              else if (wsel == 2) pool_half<8>(XP, F.out, l, ch, rfirst, 32 * half, Ds); else pool_half<16>(XP, F.out, l, ch, rfirst, 32 * half, Ds);
          }
      } }
    WG_BAR();
    const int gp = w & 3, rh = w >> 2;
    f32x4 A[2][8];
#pragma unroll
    for (int mt = 0; mt < 2; ++mt)
#pragma unroll
        for (int nt = 0; nt < 8; ++nt) A[mt][nt] = (f32x4){0.f, 0.f, 0.f, 0.f};
    { const bf16* Wp = (const bf16*)(ws + WS_WPOOL) + ((size_t)(l * 4 + gp) * 128 + t16) * 128 + 8 * cq;
#pragma unroll
      for (int ks = 0; ks < 4; ++ks) {
          bf16x8 df[2];
#pragma unroll
          for (int mt = 0; mt < 2; ++mt) df[mt] = *(const LAS bf16x8*)(Ds + SWZ(32 * rh + 16 * mt + t16, 16 * gp + 4 * ks + cq, 1024));
#pragma unroll
          for (int nt = 0; nt < 8; ++nt) { const bf16x8 wf = *(const bf16x8*)(Wp + (size_t)nt * 16 * 128 + 32 * ks);
#pragma unroll
              for (int mt = 0; mt < 2; ++mt) A[mt][nt] = __builtin_amdgcn_mfma_f32_16x16x32_bf16(wf, df[mt], A[mt][nt], 0, 0, 0); }
      } }
#pragma unroll
    for (int mt = 0; mt < 2; ++mt) { float ss = 0.f;
#pragma unroll
        for (int nt = 0; nt < 8; ++nt) { const f32x4 sc = *(const f32x4*)(AR.in[IN_PSCALE] + l * 512 + 128 * gp + 16 * nt + 4 * cq);
#pragma unroll
            for (int e = 0; e < 4; ++e) { const float o = A[mt][nt][e] * sc[e]; A[mt][nt][e] = o; ss += o * o; } }
        ss += __shfl_xor(ss, 16); ss += __shfl_xor(ss, 32);
        if (cq == 0) red[(32 * rh + 16 * mt + t16) * 4 + gp] = ss; }
    WG_BAR();
    { bf16* MIX = (bf16*)(ws + WS_MIX);
#pragma unroll
      for (int mt = 0; mt < 2; ++mt) { const int rl = 32 * rh + 16 * mt + t16; const f32x4 a = *(const LAS f32x4*)(red + rl * 4);
          const float rsn = rsqrtf(((a[0] + a[1]) + (a[2] + a[3])) * (1.0f / 512.0f) + EPS);
          bf16* mp = MIX + (size_t)(row0 + rl) * DM + 1536 + 128 * gp + 4 * cq;
#pragma unroll
          for (int nt = 0; nt < 8; ++nt) *(v2u*)(mp + 16 * nt) = (v2u){pk2(A[mt][nt][0] * rsn, A[mt][nt][1] * rsn), pk2(A[mt][nt][2] * rsn, A[mt][nt][3] * rsn)}; } }
    WG_BAR();
}

#ifndef ACQ_SCOPE
#define ACQ_SCOPE "agent"
#endif
enum { U_END = 0, U_PA = 1, U_PC = 2, U_PD = 3, U_PE = 4, U_SSM = 5, U_ATT = 6, U_SATT = 7, U_POOL = 8 };
constexpr int NPANEL = MP / 256;
constexpr int QCAP = 1024;
__host__ __device__ constexpr unsigned mkd(int type, int l, int a, int b) { return ((unsigned)type << 24) | ((unsigned)l << 20) | ((unsigned)a << 10) | (unsigned)b; }
__device__ __forceinline__ gu32* cnt_word(gu32* ctl, int l, int kind, int pm) { return ctl + CW_CNT + ((l * 5 + kind) * 40 + pm) * 16; }
__host__ __device__ constexpr unsigned mix_target(int pm) { return 3u * (unsigned)((MR - 256 * pm) < 256 ? (MR - 256 * pm) : 256); }

__device__ __forceinline__ void build_queue(unsigned* qt, int q) {
    int n = 1;
    for (int l = 0; l < NLAYER; ++l) {
        for (int pm = 0; pm < NPANEL; ++pm) { qt[n++] = mkd(U_PA, l, pm, q); if ((pm & 7) == q) { qt[n++] = mkd(U_PA, l, pm, 8); qt[n++] = mkd(U_PA, l, pm, 9); } }
        for (int c = q; c < NCHUNK; c += 8) qt[n++] = mkd(U_SSM, l, c, 0);
        for (int i = q; i < NBATCH * NQB; i += 8) qt[n++] = mkd(U_ATT, l, i, 0);
        for (int s = q; s < NSAMP; s += 8) qt[n++] = mkd(U_SATT, l, s, 0);
        for (int c = q; c < NCHUNK; c += 8) qt[n++] = mkd(U_POOL, l, c, 0);
        for (int pm = 0; pm < NPANEL; ++pm) qt[n++] = mkd(U_PC, l, pm, q);
        for (int pm = 0; pm < NPANEL; ++pm) for (int j = 0; j < 4; ++j) qt[n++] = mkd(U_PD, l, pm, 4 * q + j);
        for (int pm = 0; pm < NPANEL; ++pm) qt[n++] = mkd(U_PE, l, pm, q);
    }
    qt[0] = (unsigned)(n - 1);
}

struct Sched {
    gu32* ctl; const unsigned* qglob; LAS unsigned* qlds; volatile LAS unsigned* slot; int myq; unsigned nclaim;
    __device__ __forceinline__ unsigned claim_lane() {
        { const unsigned idx = __hip_atomic_fetch_add(ctl + CW_QHEAD + myq * 64, 1u, RLX_AGENT); if (idx < qlds[0]) return qlds[1 + idx]; }
        for (int k = 1; k < 8; ++k) { const int q = (myq + k) & 7; const unsigned* qg = qglob + (size_t)q * QCAP;
            if (__hip_atomic_load((gu32*)(ctl + CW_QHEAD + q * 64), RLX_AGENT) >= qg[0]) continue;
            const unsigned idx = __hip_atomic_fetch_add(ctl + CW_QHEAD + q * 64, 1u, RLX_AGENT); if (idx < qg[0]) return qg[1 + idx]; }
        return 0u;
    }
    __device__ __forceinline__ unsigned claim_wg(int tid) {
        const unsigned k = nclaim++ & 1u;
        if (tid == 0) slot[k] = claim_lane();
        WG_BAR();
        return slot[k];
    }
    __device__ __forceinline__ void poll(gu32* w, unsigned want) {
        unsigned sp = 0;
        while (__hip_atomic_load(w, RLX_AGENT) < want) { __builtin_amdgcn_s_sleep(2);
            if ((++sp & 1023u) == 0u) { if (__hip_atomic_load(ctl + CW_TMO, RLX_AGENT) != 0u) break; if (sp > (1u << 17)) { __hip_atomic_store(ctl + CW_TMO, 0x66u, RLX_AGENT); break; } } }
    }
    __device__ __forceinline__ void wait_deps(unsigned d, int tid) {
        if (tid == 0) {
            const int type = d >> 24, l = (d >> 20) & 15, a = (d >> 10) & 1023;
            if (type == U_PA) { if (l > 0) { poll(cnt_word(ctl, l - 1, 4, a), 8u); const int p2 = (a + 1 < NPANEL) ? a + 1 : NPANEL - 1; poll(cnt_word(ctl, l - 1, 1, p2), mix_target(p2)); } }
            else if (type == U_PC) poll(cnt_word(ctl, l, 1, a), mix_target(a));
            else if (type == U_PD) poll(cnt_word(ctl, l, 2, a), 8u);
            else if (type == U_PE) poll(cnt_word(ctl, l, 3, a), 32u);
            else if (type == U_SSM) poll(cnt_word(ctl, l, 0, a >> 2), 10u);
            else if (type == U_POOL) { poll(cnt_word(ctl, l, 0, a >> 2), 10u); const int r0 = 64 * a - 16; if (r0 >= 0) poll(cnt_word(ctl, l, 0, r0 >> 8), 10u); }
            else if (type == U_SATT) poll(cnt_word(ctl, l, 0, NPANEL - 1), 10u);
            else if (type == U_ATT) { const int b = a / NQB, i = a % NQB, t0 = 32 * i; const int rlo = b * TT + (t0 >= 128 ? t0 - 128 : 0), rhi = b * TT + ((t0 + 31 < TT) ? t0 + 31 : TT - 1);
                poll(cnt_word(ctl, l, 0, rlo >> 8), 10u); if ((rhi >> 8) != (rlo >> 8)) poll(cnt_word(ctl, l, 0, rhi >> 8), 10u); }
            __builtin_amdgcn_fence(__ATOMIC_ACQUIRE, ACQ_SCOPE);
            asm volatile("s_waitcnt vmcnt(0)" ::: "memory");
        }
        asm volatile("" ::: "memory"); __builtin_amdgcn_s_barrier(); asm volatile("" ::: "memory");
    }
    __device__ __forceinline__ void publish(unsigned d, int tid) {
        asm volatile("s_waitcnt vmcnt(0)" ::: "memory");
        WG_BAR();
        if (tid == 0) {
            const int type = d >> 24, l = (d >> 20) & 15, a = (d >> 10) & 1023;
            __builtin_amdgcn_fence(__ATOMIC_RELEASE, "agent");
            asm volatile("s_waitcnt vmcnt(0)" ::: "memory");
            if (type == U_PA) __hip_atomic_fetch_add(cnt_word(ctl, l, 0, a), 1u, RLX_AGENT);
            else if (type == U_PC) __hip_atomic_fetch_add(cnt_word(ctl, l, 2, a), 1u, RLX_AGENT);
            else if (type == U_PD) __hip_atomic_fetch_add(cnt_word(ctl, l, 3, a), 1u, RLX_AGENT);
            else if (type == U_PE) __hip_atomic_fetch_add(cnt_word(ctl, l, 4, a), 1u, RLX_AGENT);
            else if (type == U_SSM || type == U_POOL) __hip_atomic_fetch_add(cnt_word(ctl, l, 1, a >> 2), 64u, RLX_AGENT);
            else if (type == U_SATT) __hip_atomic_fetch_add(cnt_word(ctl, l, 1, NPANEL - 1), 1u, RLX_AGENT);
            else if (type == U_ATT) { const int b = a / NQB, i = a % NQB, t0 = 32 * i; const int r0 = b * TT + t0, r1 = b * TT + ((t0 + 31 < TT) ? t0 + 31 : TT - 1);
                const int p0 = r0 >> 8, p1 = r1 >> 8;
                if (p0 == p1) __hip_atomic_fetch_add(cnt_word(ctl, l, 1, p0), (unsigned)(r1 - r0 + 1), RLX_AGENT);
                else { __hip_atomic_fetch_add(cnt_word(ctl, l, 1, p0), (unsigned)(256 * p1 - r0), RLX_AGENT); __hip_atomic_fetch_add(cnt_word(ctl, l, 1, p1), (unsigned)(r1 - 256 * p1 + 1), RLX_AGENT); } }
        }
    }
};

#ifndef A_AUX
#define A_AUX 0
#endif
struct GU { const char* A; const char* B; unsigned voffA[2], voffB[2]; size_t hstep; int nt; unsigned d; pg8::Unit u; };

struct StreamCtx { unsigned char* ws; float* out; const float* gq; const float* gk; int R[2], C[2], Rp[2]; };
__device__ __forceinline__ void gu_fill(GU& g, unsigned d, const StreamCtx& X) {
    const int type = d >> 24, l = (d >> 20) & 15, pm = (d >> 10) & 1023, pn = d & 1023;
    unsigned char* ws = X.ws;
    const bf16* A; const bf16* B; int K = DM; bool perm = false;
    if (type == U_PA) { A = (const bf16*)(ws + WS_XB); B = (const bf16*)(ws + WS_WIN) + (size_t)l * INW * DM; }
    else if (type == U_PC) { A = (const bf16*)(ws + WS_MIX); B = (const bf16*)(ws + WS_WOUT) + (size_t)l * DM * DM; }
    else if (type == U_PD) { A = (const bf16*)(ws + WS_XB); B = (const bf16*)(ws + WS_W1) + (size_t)l * DFF * DM; perm = true; }
    else { A = (const bf16*)(ws + WS_H); B = (const bf16*)(ws + WS_W2) + (size_t)l * DM * DFF; K = DFF; }
    g.d = d; g.u.pm = pm; g.u.pn = pn; g.nt = K / 64; g.hstep = (size_t)128 * K * 2;
    g.A = (const char*)A + (size_t)pm * 256 * K * 2; g.B = (const char*)B + (size_t)pn * 256 * K * 2;
#pragma unroll
    for (int i = 0; i < 2; ++i) { g.voffA[i] = (unsigned)(X.R[i] * K + X.C[i]) * 2u; g.voffB[i] = (unsigned)((perm ? X.Rp[i] : X.R[i]) * K + X.C[i]) * 2u; }
}

__device__ __forceinline__ unsigned gemm_stream(const Args& AR, Frame& F, Sched& Q, unsigned d0) {
    int tid_ = threadIdx.x; asm volatile("" : "+v"(tid_));
    const int tid = tid_, wid = __builtin_amdgcn_readfirstlane(tid >> 6), lane = tid & 63, wr = wid >> 2, wc = wid & 3, fr = lane & 15, fq = lane >> 4;
    LAS unsigned char* lds = F.lds; LAS unsigned char* esc = F.lds + ESC_OFF;
    StreamCtx X; X.ws = F.ws; X.out = F.out;
#pragma unroll
    for (int i = 0; i < 2; ++i) { int R, C; pg8::stage_rc(tid * 16 + i * 8192, R, C); X.R[i] = R; X.C[i] = C; X.Rp[i] = (R & ~31) + pg8::perm32(R & 31); }
    const size_t kstep = (size_t)(pg8::BK * 2);
    const unsigned ldsw = (unsigned)wid * 1024u;
    const int aoff = pg8::lds_byte(wr * 64 + fr, fq * 8), boff = pg8::lds_byte(wc * 32 + fr, fq * 8);
#define PG8_SA(b, h) (((b) * 2 + (h)) * pg8::HTB)
#define PG8_SB(b, h) ((4 + (b) * 2 + (h)) * pg8::HTB)
#define PG8_STAGE(bufoff, gbase, voff) do { _Pragma("unroll") for (int _i = 0; _i < 2; ++_i) \
        __builtin_amdgcn_global_load_lds((const unsigned*)((const char*)(gbase) + (voff)[_i]), (LAS unsigned*)(lds + (bufoff) + ldsw + _i * 8192), 16, 0, 0); } while (0)
#define PG8_STAGE_A(bufoff, gbase, voff) do { _Pragma("unroll") for (int _i = 0; _i < 2; ++_i) \
        __builtin_amdgcn_global_load_lds((const unsigned*)((const char*)(gbase) + (voff)[_i]), (LAS unsigned*)(lds + (bufoff) + ldsw + _i * 8192), 16, 0, A_AUX); } while (0)
#define PG8_LDA(dst, b, h) do { _Pragma("unroll") for (int m = 0; m < 4; ++m) _Pragma("unroll") for (int k = 0; k < 2; ++k) dst[m][k] = *(const LAS bf16x8*)(lds + PG8_SA(b, h) + aoff + m * 2048 + k * 1024); } while (0)
#define PG8_LDB(dst, b, h) do { _Pragma("unroll") for (int n = 0; n < 2; ++n) _Pragma("unroll") for (int k = 0; k < 2; ++k) dst[n][k] = *(const LAS bf16x8*)(lds + PG8_SB(b, h) + boff + n * 2048 + k * 1024); } while (0)
#define PG8_MMA(ai, bj, At, Bt) do { __builtin_amdgcn_s_setprio(1); _Pragma("unroll") for (int m = 0; m < 4; ++m) _Pragma("unroll") for (int n = 0; n < 2; ++n) _Pragma("unroll") for (int k = 0; k < 2; ++k) \
        acc[ai][bj][m][n] = __builtin_amdgcn_mfma_f32_16x16x32_bf16(Bt[n][k], At[m][k], acc[ai][bj][m][n], 0, 0, 0); __builtin_amdgcn_s_setprio(0); } while (0)
#define PG8_WAIT_V(n) asm volatile("s_waitcnt vmcnt(" #n ")" ::: "memory")
#define PG8_WAIT_L(n) asm volatile("s_waitcnt lgkmcnt(" #n ")" ::: "memory")
#define PG8_BAR __builtin_amdgcn_s_barrier()
#define PG8_SCHED __builtin_amdgcn_sched_barrier(0)
    GU cur, nxt;
    gu_fill(cur, d0, X);
    f32x4 acc[2][2][4][2];
#pragma unroll
    for (int a = 0; a < 2; ++a)
#pragma unroll
        for (int b = 0; b < 2; ++b)
#pragma unroll
            for (int m = 0; m < 4; ++m)
#pragma unroll
                for (int n = 0; n < 2; ++n) acc[a][b][m][n] = (f32x4){0.f, 0.f, 0.f, 0.f};
    bf16x8 At[4][2], B0[2][2], B1[2][2];
    Q.wait_deps(cur.d, tid);
    PG8_STAGE(PG8_SB(0, 0), cur.B, cur.voffB); PG8_STAGE(PG8_SB(0, 1), cur.B + cur.hstep, cur.voffB); PG8_STAGE_A(PG8_SA(0, 0), cur.A, cur.voffA); PG8_STAGE_A(PG8_SA(0, 1), cur.A + cur.hstep, cur.voffA);
    if (wr == 1) PG8_BAR;
    PG8_WAIT_V(2); PG8_BAR;
    PG8_STAGE(PG8_SB(1, 0), cur.B + kstep, cur.voffB); PG8_STAGE_A(PG8_SA(1, 0), cur.A + kstep, cur.voffA); PG8_STAGE(PG8_SB(1, 1), cur.B + cur.hstep + kstep, cur.voffB);
    PG8_WAIT_V(6); PG8_BAR;
    unsigned carry = 0u; unsigned ui = 0u;
    for (;;) {
        { const unsigned k = 2u + (ui & 1u);
          if (tid == 0) Q.slot[k] = Q.claim_lane();
          asm volatile("s_waitcnt lgkmcnt(0)" ::: "memory"); PG8_BAR; asm volatile("" ::: "memory");
          carry = Q.slot[k]; }
        const bool has_next = (carry >> 24) >= U_PA && (carry >> 24) <= U_PE && (!STREAM_SAME_SECTION || ((carry >> 20) == (cur.d >> 20)));
        if (has_next) gu_fill(nxt, carry, X); else nxt = cur;
        const char* cA = cur.A; const char* cB = cur.B; const size_t hstep = cur.hstep; const int nt = cur.nt;
        for (int t = 0; t < nt; t += 2) {
            const bool last = (t == nt - 2);
            const char* a1 = cA + (size_t)(t + 1) * kstep;
            const char* a2 = last ? nxt.A : cA + (size_t)(t + 2) * kstep; const char* b2 = last ? nxt.B : cB + (size_t)(t + 2) * kstep;
            const char* a3 = a2 + kstep; const char* b3 = b2 + kstep;
            const size_t h2 = last ? nxt.hstep : hstep;
            unsigned vA2[2], vB2[2];
#pragma unroll
            for (int i = 0; i < 2; ++i) { vA2[i] = last ? nxt.voffA[i] : cur.voffA[i]; vB2[i] = last ? nxt.voffB[i] : cur.voffB[i]; }
            if (last && has_next) Q.wait_deps(nxt.d, tid);
            PG8_LDB(B0, 0, 0); PG8_LDB(B1, 0, 1); PG8_SCHED; PG8_LDA(At, 0, 0); PG8_STAGE_A(PG8_SA(1, 1), a1 + hstep, cur.voffA);
            PG8_WAIT_V(8); PG8_WAIT_L(0); PG8_BAR; PG8_MMA(0, 0, At, B0); PG8_MMA(0, 1, At, B1); PG8_BAR; PG8_SCHED;
            PG8_LDA(At, 0, 1); PG8_STAGE(PG8_SB(0, 0), b2, vB2); PG8_STAGE(PG8_SB(0, 1), b2 + h2, vB2); PG8_STAGE_A(PG8_SA(0, 0), a2, vA2);
            PG8_WAIT_V(8); PG8_WAIT_L(0); PG8_BAR; PG8_MMA(1, 0, At, B0); PG8_MMA(1, 1, At, B1); PG8_BAR; PG8_SCHED;
            PG8_LDB(B0, 1, 0); PG8_LDB(B1, 1, 1); PG8_SCHED; PG8_LDA(At, 1, 0); PG8_STAGE_A(PG8_SA(0, 1), a2 + h2, vA2);
            PG8_WAIT_V(8); PG8_WAIT_L(0); PG8_BAR; PG8_MMA(0, 0, At, B0); PG8_MMA(0, 1, At, B1); PG8_BAR; PG8_SCHED;
            PG8_LDA(At, 1, 1); PG8_STAGE(PG8_SB(1, 0), b3, vB2); PG8_STAGE(PG8_SB(1, 1), b3 + h2, vB2); PG8_STAGE_A(PG8_SA(1, 0), a3, vA2);
            PG8_WAIT_V(8); PG8_WAIT_L(0); PG8_BAR; PG8_MMA(1, 0, At, B0); PG8_MMA(1, 1, At, B1); PG8_BAR; PG8_SCHED;
        }
        if (wr == 0) PG8_BAR;
        { const int type = cur.d >> 24, l = (cur.d >> 20) & 15;
          if (type == U_PA) { EpiProj E{X.ws, X.out, AR.in[IN_GQ] + l * 128, AR.in[IN_GK] + l * 128, l}; E(acc, cur.u, wr, wc, fr, fq, esc, tid); }
          else if (type == U_PD) { EpiFfn1 E{(const float*)(X.ws + WS_SSQ), (bf16*)(X.ws + WS_H)}; E(acc, cur.u, wr, wc, fr, fq, esc, tid); }
          else { EpiRes E{(float*)(X.ws + WS_X), (bf16*)(X.ws + WS_XB), (float*)(X.ws + WS_SSQ), X.out, (type == U_PE && l == NLAYER - 1) ? 1 : 0}; E(acc, cur.u, wr, wc, fr, fq, esc, tid); }
          Q.publish(cur.d, tid); }
        if (!has_next) break;
#pragma unroll
        for (int a = 0; a < 2; ++a)
#pragma unroll
            for (int b = 0; b < 2; ++b)
#pragma unroll
                for (int m = 0; m < 4; ++m)
#pragma unroll
                    for (int n = 0; n < 2; ++n) acc[a][b][m][n] = (f32x4){0.f, 0.f, 0.f, 0.f};
        cur = nxt; ++ui;
        if (wr == 1) PG8_BAR;
    }
    PG8_WAIT_V(0);
    PG8_BAR;
#undef PG8_SA
#undef PG8_SB
#undef PG8_STAGE
#undef PG8_STAGE_A
#undef PG8_LDA
#undef PG8_LDB
#undef PG8_MMA
#undef PG8_WAIT_V
#undef PG8_WAIT_L
#undef PG8_BAR
#undef PG8_SCHED
    return carry;
}

__global__ void __launch_bounds__(512, 2) hymba_fwd(Args args) {
    extern __shared__ __attribute__((aligned(16))) unsigned char lds[];
    Frame F;
    F.lds = (LAS unsigned char*)lds;
    F.MISC = (volatile LAS unsigned*)(F.lds + MISC_OFF);
    F.tid = threadIdx.x; F.lane = F.tid & 63; F.wave = __builtin_amdgcn_readfirstlane(F.tid >> 6);
    F.G = gridDim.x; { const int bx = blockIdx.x; F.vcu = (F.G % 8 == 0) ? (bx % 8) * (F.G / 8) + bx / 8 : bx; }
    F.ws = args.ws; F.out = args.out; F.ctl = (gu32*)(args.ws + WS_CTL);
    for (int u = F.tid; u < (LDS_BYTES - LDSCTL_OFF) / 4; u += 512) ((LAS unsigned*)(F.lds + LDSCTL_OFF))[u] = 0u;
    __syncthreads();
    XcdBarrier bar = xcd_barrier_post((unsigned*)(F.ctl + CW_BAR), F.MISC + 8);
    for (int rep = 0; rep < DUP_P0; ++rep) p0_prologue(args, F);
    if (blockIdx.x < 8 && F.tid == 0) build_queue((unsigned*)(args.ws + WS_QUEUE) + (size_t)blockIdx.x * QCAP, (int)blockIdx.x);
    xcd_barrier(bar);
    Sched Q; Q.ctl = F.ctl; Q.qglob = (const unsigned*)(args.ws + WS_QUEUE); Q.qlds = (LAS unsigned*)(F.lds + QTAB_OFF); Q.slot = F.MISC; Q.myq = (int)(bar.x & 7u); Q.nclaim = 0u;
    { const unsigned* qg = Q.qglob + (size_t)Q.myq * QCAP; for (int i = F.tid; i < QCAP; i += 512) Q.qlds[i] = qg[i]; }
    WG_BAR();
    unsigned d = Q.claim_wg(F.tid);
#if SEC_BARRIER
    int cursec = 0;
#endif
    for (;;) {
        const int type = d >> 24;
#if SEC_BARRIER
        { const int sec = (type == U_END) ? 5 * NLAYER : ((d >> 20) & 15) * 5 + ((type >= U_SSM) ? 1 : (type == U_PA ? 0 : type));
          while (cursec < sec) { if ((SEC_MASK >> cursec) & 1) xcd_barrier(bar); ++cursec; } }
#endif
        if (type == U_END) break;
        if (type <= U_PE) { d = gemm_stream(args, F, Q, d); continue; }
        const int l = (d >> 20) & 15, a = (d >> 10) & 1023;
        Q.wait_deps(d, F.tid);
        if (type == U_SSM) ssm_unit(args, F, l, a);
        else if (type == U_ATT) attn_unit(args, F, l, a / NQB, a % NQB);
        else if (type == U_SATT) sattn_unit(args, F, l, a);
        else pool_unit(args, F, l, a);
        Q.publish(d, F.tid);
        d = Q.claim_wg(F.tid);
    }
}

extern "C" void kernel_launch(void* const* d_in, const int* in_sizes, int n_in, void* d_out, int out_size, void* d_ws, size_t ws_size, hipStream_t stream) {
    static int grid = 0;
    if (grid == 0) {
        if (n_in != 32 || (size_t)out_size != O_END || ws_size < WS_END) { fprintf(stderr, "kernel_launch: unexpected shapes: n_in %d out %d (want %zu) ws %zu (want >= %zu)\n", n_in, out_size, (size_t)O_END, ws_size, (size_t)WS_END); grid = -1; return; }
        int dev = 0, cus = 0, per_cu = 0;
        if (hipGetDevice(&dev) != hipSuccess || hipDeviceGetAttribute(&cus, hipDeviceAttributeMultiprocessorCount, dev) != hipSuccess) { fprintf(stderr, "kernel_launch: device query failed\n"); grid = -1; return; }
        if (hipFuncSetAttribute((const void*)hymba_fwd, hipFuncAttributeMaxDynamicSharedMemorySize, LDS_BYTES) != hipSuccess) { fprintf(stderr, "kernel_launch: hipFuncSetAttribute failed\n"); grid = -1; return; }
        if (hipOccupancyMaxActiveBlocksPerMultiprocessor(&per_cu, (const void*)hymba_fwd, 512, LDS_BYTES) != hipSuccess || per_cu < 1) { fprintf(stderr, "kernel_launch: occupancy query says %d blocks per CU\n", per_cu); per_cu = 1; }
        (void)hipGetLastError();
        grid = cus;
        if (grid % 8 != 0) grid -= grid % 8;
    }
    if (grid < 0) return;
    (void)hipMemsetAsync((char*)d_ws + WS_CTL, 0, CTL_ZERO_BYTES, stream);
    Args a{};
    for (int i = 0; i < 32; ++i) a.in[i] = (const float*)d_in[i];
    a.out = (float*)d_out; a.ws = (unsigned char*)d_ws; a.ph_lo = 0; a.ph_hi = 0;
    hipLaunchKernelGGL(hymba_fwd, dim3(grid), dim3(512), LDS_BYTES, stream, a);
    const hipError_t le = hipPeekAtLastError();
    if (le != hipSuccess) fprintf(stderr, "kernel_launch: launch failed: %s\n", hipGetErrorName(le));
}
```

```cpp
#include <hip/hip_runtime.h>
#include <cstdio>
#include <cstdint>

#ifndef MK_N_LAUNCHES
#define MK_N_LAUNCHES 1
#endif

#ifndef SEC_BARRIER
#define SEC_BARRIER 0
#endif
#ifndef STREAM_SAME_SECTION
#define STREAM_SAME_SECTION 1
#endif
#ifndef SEC_MASK
#define SEC_MASK 0x10
#endif
#ifndef DUP_PB
#define DUP_PB 1
#endif
#ifndef DUP_P0
#define DUP_P0 1
#endif

constexpr int DM = 2048, TT = 4112  , NSEQ = 4096, NMETA = 16, NBATCH = 2, NSAMP = 32;
constexpr int MR = NBATCH * TT + NSAMP;
constexpr int MP = 8448;
constexpr int SROW0 = NBATCH * TT;
constexpr int INW = 2560, DFF = 8192, NLAYER = 2;
constexpr int TPV = 4128;
constexpr int ROPE_SAMPLE_IDX = TT;
constexpr float EPS = 1e-6f;
constexpr float LOG2E = 1.4426950408889634f;
constexpr float QSCALE = 0.08838834764831845f * LOG2E;
constexpr int NCHUNK = MR / 64;
constexpr int NQB = (TT + 31) / 32;

constexpr size_t O_YP = 0, O_YS = O_YP + (size_t)NBATCH * NSEQ * DM, O_PK = O_YS + (size_t)NSAMP * DM, O_PV = O_PK + (size_t)NLAYER * NBATCH * 128 * 256,
                 O_PSR = O_PV + (size_t)NLAYER * NBATCH * 128 * 256, O_PSI = O_PSR + (size_t)NLAYER * NBATCH * 2048, O_PP = O_PSI + (size_t)NLAYER * NBATCH * 2048,
                 O_SK = O_PP + (size_t)NLAYER * NBATCH * 15 * 512, O_SV = O_SK + (size_t)NLAYER * NSAMP * 128 * 256, O_SSR = O_SV + (size_t)NLAYER * NSAMP * 128 * 256,
                 O_SSI = O_SSR + (size_t)NLAYER * NSAMP * 2048, O_SP = O_SSI + (size_t)NLAYER * NSAMP * 2048, O_END = O_SP + (size_t)NLAYER * NSAMP * 15 * 512;

constexpr size_t MiB = 1u << 20;
constexpr size_t WS_CTL = 0, CTL_ZERO_BYTES = 1 * MiB;
constexpr size_t WS_WIN = 1 * MiB, WS_WOUT = 21 * MiB, WS_W1 = 37 * MiB, WS_W2 = 101 * MiB, WS_WGLU = 165 * MiB, WS_WPOOL = 166 * MiB, WS_TAB = 167 * MiB;
constexpr size_t WS_X = 170 * MiB, WS_XB = 236 * MiB, WS_Q = 269 * MiB, WS_K = 286 * MiB, WS_VT = 291 * MiB, WS_U = 296 * MiB, WS_XP = 313 * MiB, WS_MIX = 330 * MiB,
                 WS_H = 363 * MiB, WS_SSQ = 495 * MiB, WS_SST = 497 * MiB, WS_KSN = 502 * MiB, WS_QUEUE = 503 * MiB, WS_END = 504 * MiB;
static_assert(WS_WIN + (size_t)NLAYER * INW * DM * 2 <= WS_WOUT && WS_WOUT + (size_t)NLAYER * DM * DM * 2 <= WS_W1 && WS_W1 + (size_t)NLAYER * DFF * DM * 2 <= WS_W2 && WS_W2 + (size_t)NLAYER * DFF * DM * 2 <= WS_WGLU, "ws map 1");
static_assert(WS_X + (size_t)MP * DM * 4 <= WS_XB && WS_XB + (size_t)MP * DM * 2 <= WS_Q && WS_Q + (size_t)MP * 1024 * 2 <= WS_K && WS_K + (size_t)MP * 256 * 2 <= WS_VT && WS_VT + (size_t)4 * 128 * TPV * 2 <= WS_U, "ws map 2");
static_assert(WS_U + (size_t)MP * 512 * 4 <= WS_XP && WS_XP + (size_t)MP * 512 * 4 <= WS_MIX && WS_MIX + (size_t)MP * DM * 2 <= WS_H && WS_H + (size_t)MP * DFF * 2 <= WS_SSQ && WS_SSQ + (size_t)MP * 32 * 4 <= WS_SST, "ws map 3");
static_assert(WS_SST + (size_t)NLAYER * NCHUNK * 32 * 64 * 8 <= WS_KSN, "ws map 4");
constexpr size_t TB_ABR = 0, TB_ABI = 8192, TB_ALR = 16384, TB_ALI = 24576, TB_A16R = 32768, TB_A16I = 40960, TB_A32R = 49152, TB_A32I = 57344,
                 TB_BBR = 65536, TB_BBI = TB_BBR + 131072, TB_PM = TB_BBI + 131072, TB_CMT = TB_PM + 524288, TB_LAYER = 1 * MiB;
static_assert(TB_CMT + 131072 <= TB_LAYER, "table map");
constexpr size_t WS_ROPE = WS_TAB + 2 * MiB;
constexpr size_t ROPE_N = (size_t)(TT + 1) * 16;
constexpr int CW_TMO = 0, CW_CODE = 1, CW_BAR = 4096, CW_QHEAD = 8192  , CW_CNT = 9216  , CW_SSMF = 16384  ;
static_assert(CW_CNT + NLAYER * 5 * 40 * 16 <= CW_SSMF, "ctl map: counters");
static_assert((CW_SSMF + NLAYER * NCHUNK * 8 * 16) * 4 <= (int)CTL_ZERO_BYTES, "ctl map");

constexpr int RING_BYTES = 131072, ESC_OFF = RING_BYTES  , QTAB_OFF = ESC_OFF + 12288  , LDSCTL_OFF = QTAB_OFF + 4096, MISC_OFF = LDSCTL_OFF + 320, LDS_BYTES = 148480;
static_assert(MISC_OFF + 128 <= LDS_BYTES, "LDS map");

#define GAS __attribute__((address_space(1)))
#define LAS __attribute__((address_space(3)))
typedef unsigned short bf16;
typedef unsigned v4u __attribute__((ext_vector_type(4)));
typedef unsigned v2u __attribute__((ext_vector_type(2)));
typedef float f32x2 __attribute__((ext_vector_type(2)));
typedef float f32x16 __attribute__((ext_vector_type(16)));
typedef __bf16 bf16x2_t __attribute__((ext_vector_type(2)));
typedef GAS unsigned gu32;
typedef GAS unsigned long long gu64;
#define RLX_AGENT __ATOMIC_RELAXED, __HIP_MEMORY_SCOPE_AGENT
#define LDS_WAIT() asm volatile("s_waitcnt lgkmcnt(0)" ::: "memory")
#define VM_WAIT() asm volatile("s_waitcnt vmcnt(0)" ::: "memory")
#define WG_BAR() do { asm volatile("s_waitcnt lgkmcnt(0)" ::: "memory"); __builtin_amdgcn_s_barrier(); asm volatile("" ::: "memory"); } while (0)
__device__ __forceinline__ unsigned pk2(float lo, float hi) { f32x2 v = {lo, hi}; bf16x2_t b = __builtin_convertvector(v, bf16x2_t); return __builtin_bit_cast(unsigned, b); }
__device__ __forceinline__ float bf2f(unsigned short h) { return __builtin_bit_cast(float, (unsigned)h << 16); }
__device__ __forceinline__ float wave_sum(float v) {
#pragma unroll
    for (int o = 1; o < 64; o <<= 1) v += __shfl_xor(v, o);
    return v;
}
__device__ __forceinline__ float wave_max(float v) {
#pragma unroll
    for (int o = 1; o < 64; o <<= 1) v = fmaxf(v, __shfl_xor(v, o));
    return v;
}

typedef __amdgpu_buffer_rsrc_t rsrc_t;
__device__ __forceinline__ rsrc_t ws_rsrc(unsigned char* ws) { return __builtin_amdgcn_make_buffer_rsrc(ws, 0, (int)WS_END, 0x00020000); }
#define ST16(r, off, v) __builtin_amdgcn_raw_buffer_store_b128(__builtin_bit_cast(v4u, (v)), (r), (unsigned)(off), 0, 16)
#define ST8(r, off, v)  __builtin_amdgcn_raw_buffer_store_b64((v), (r), (unsigned)(off), 0, 16)
#define ST4(r, off, v)  __builtin_amdgcn_raw_buffer_store_b32(__builtin_bit_cast(unsigned, (v)), (r), (unsigned)(off), 0, 16)
#define ST2(r, off, v)  __builtin_amdgcn_raw_buffer_store_b16((unsigned short)(v), (r), (unsigned)(off), 0, 16)
__host__ __device__ __forceinline__ int perm16(int o) { return 8 * ((o >> 2) & 1) + 4 * (o >> 3) + (o & 3); }

namespace pg8 {
#define PG8_LAS __attribute__((address_space(3)))
typedef unsigned short bf16_t;
typedef short bf16x8 __attribute__((ext_vector_type(8)));
typedef float f32x4 __attribute__((ext_vector_type(4)));
typedef unsigned u32x4 __attribute__((ext_vector_type(4)));
constexpr int BM = 256, BK = 64, HALF = 128, HTB = HALF * BK * 2  , STAGE_BYTES = 8 * HTB, NXCD = 8, WGM = 8;

__host__ __device__ __forceinline__ int lds_byte(int r, int c) { const int st = (r >> 4) * 2 + (c >> 5), rr = r & 15, cc = c & 31, ob = rr * 64 + cc * 2; return st * 1024 + (ob ^ (((ob >> 9) & 1) << 5)); }
__host__ __device__ __forceinline__ void stage_rc(int b, int& R, int& C) { const int st = b / 1024, sb = b % 1024, swz = sb ^ (((sb >> 9) & 1) << 5); R = (st >> 1) * 16 + swz / 64; C = (st & 1) * 32 + (swz % 64) / 2; }
__host__ __device__ __forceinline__ int perm32(int rho) { const int n = rho >> 4, i = rho & 15; return 8 * (i >> 2) + 4 * n + (i & 3); }

struct Unit { int pm, pn; };
struct Gemm { const bf16_t* A; const bf16_t* Bt; int M, N, K; };

struct StaticOrder {
    int nM, nN, nwg, G, c;
    __host__ __device__ void init(int M, int N, int G_, int c_) { nM = M / BM; nN = N / BM; nwg = nM * nN; G = G_; c = c_; }
    __host__ __device__ bool next(int i, Unit& u) const {
        const long L = (long)i * G + c; if (L >= nwg) return false;
        int wgid = (int)L; { const int q = nwg / NXCD, r = nwg % NXCD, xcd = wgid % NXCD, off = wgid / NXCD; wgid = (xcd < r ? xcd * (q + 1) : r * (q + 1) + (xcd - r) * q) + off; }
        const int nig = WGM * nN, gid = wgid / nig, fm = gid * WGM, gsz = (nM - fm) < WGM ? (nM - fm) : WGM;
        u.pm = fm + ((wgid % nig) % gsz); u.pn = (wgid % nig) / gsz; return true;
    }
    __device__ __forceinline__ void a_ready(const Unit&) const {}
    __device__ __forceinline__ void done(const Unit&) const {}
};


template <class Epi, class Sched, bool ALIGN_EPI = false, bool SP2 = false>
__device__ __forceinline__ void gemm_phase(PG8_LAS unsigned char* lds, PG8_LAS unsigned char* esc, const Gemm g, const Sched& S, const Epi& E) {
    int tid_ = threadIdx.x; asm volatile("" : "+v"(tid_));
    const int tid = tid_, wid = __builtin_amdgcn_readfirstlane(tid >> 6), lane = tid & 63, wr = wid >> 2, wc = wid & 3, fr = lane & 15, fq = lane >> 4;
    const int K = g.K, nt = K / BK;
    unsigned voffA[2], voffB[2];
#pragma unroll
    for (int i = 0; i < 2; ++i) { int R, C; stage_rc(tid * 16 + i * 8192, R, C); const int Rb = Epi::PERM ? ((R & ~31) + perm32(R & 31)) : R;
        voffA[i] = (unsigned)(R * K + C) * 2u; voffB[i] = (unsigned)(Rb * K + C) * 2u; }
    const size_t kstep = (size_t)(BK * 2);
    const size_t hstep = (size_t)HALF * K * 2;
    const size_t tstep = 2 * hstep;
    const unsigned ldsw = (unsigned)wid * 1024u;
    const int aoff = lds_byte(wr * 64 + fr, fq * 8), boff = lds_byte(wc * 32 + fr, fq * 8);
#define PG8_SA(b, h) (((b) * 2 + (h)) * HTB)
#define PG8_SB(b, h) ((4 + (b) * 2 + (h)) * HTB)
#define PG8_STAGE(bufoff, gbase, voff) do { _Pragma("unroll") for (int _i = 0; _i < 2; ++_i) \
        __builtin_amdgcn_global_load_lds((const unsigned*)((const char*)(gbase) + (voff)[_i]), (PG8_LAS unsigned*)(lds + (bufoff) + ldsw + _i * 8192), 16, 0, 0); } while (0)
#define PG8_LDA(dst, b, h) do { _Pragma("unroll") for (int m = 0; m < 4; ++m) _Pragma("unroll") for (int k = 0; k < 2; ++k) dst[m][k] = *(const PG8_LAS bf16x8*)(lds + PG8_SA(b, h) + aoff + m * 2048 + k * 1024); } while (0)
#define PG8_LDB(dst, b, h) do { _Pragma("unroll") for (int n = 0; n < 2; ++n) _Pragma("unroll") for (int k = 0; k < 2; ++k) dst[n][k] = *(const PG8_LAS bf16x8*)(lds + PG8_SB(b, h) + boff + n * 2048 + k * 1024); } while (0)
#define PG8_MMA(ai, bj, At, Bt) do { __builtin_amdgcn_s_setprio(1); _Pragma("unroll") for (int m = 0; m < 4; ++m) _Pragma("unroll") for (int n = 0; n < 2; ++n) _Pragma("unroll") for (int k = 0; k < 2; ++k) \
        acc[ai][bj][m][n] = __builtin_amdgcn_mfma_f32_16x16x32_bf16(Bt[n][k], At[m][k], acc[ai][bj][m][n], 0, 0, 0); __builtin_amdgcn_s_setprio(0); } while (0)
#define PG8_WAIT_V(n) asm volatile("s_waitcnt vmcnt(" #n ")" ::: "memory")
#define PG8_WAIT_L(n) asm volatile("s_waitcnt lgkmcnt(" #n ")" ::: "memory")
#define PG8_BAR __builtin_amdgcn_s_barrier()
#define PG8_SCHED __builtin_amdgcn_sched_barrier(0)
    Unit cur, nxt; int ui = 0;
    if (!S.next(0, cur)) return;
    f32x4 acc[2][2][4][2];
#pragma unroll
    for (int a = 0; a < 2; ++a)
#pragma unroll
        for (int b = 0; b < 2; ++b)
#pragma unroll
            for (int m = 0; m < 4; ++m)
#pragma unroll
                for (int n = 0; n < 2; ++n) acc[a][b][m][n] = (f32x4){0.f, 0.f, 0.f, 0.f};
    bf16x8 At[4][2], B0[2][2], B1[2][2];
    const char* cA = (const char*)g.A + (size_t)cur.pm * tstep; const char* cB = (const char*)g.Bt + (size_t)cur.pn * tstep;
    S.a_ready(cur);
    if constexpr (SP2) {
        PG8_STAGE(PG8_SB(0, 0), cB, voffB); PG8_STAGE(PG8_SB(0, 1), cB + hstep, voffB); PG8_STAGE(PG8_SA(0, 0), cA, voffA); PG8_STAGE(PG8_SA(0, 1), cA + hstep, voffA);
        if (wr == 1) PG8_BAR;
        PG8_WAIT_V(2); PG8_BAR;
        PG8_STAGE(PG8_SB(1, 0), cB + kstep, voffB); PG8_STAGE(PG8_SA(1, 0), cA + kstep, voffA); PG8_STAGE(PG8_SB(1, 1), cB + hstep + kstep, voffB);
        PG8_WAIT_V(6); PG8_BAR;
    } else {
        PG8_STAGE(PG8_SB(0, 0), cB, voffB); PG8_STAGE(PG8_SA(0, 0), cA, voffA); PG8_STAGE(PG8_SB(0, 1), cB + hstep, voffB); PG8_STAGE(PG8_SA(0, 1), cA + hstep, voffA);
        if (wr == 1) PG8_BAR;
        PG8_WAIT_V(4); PG8_BAR;
        PG8_STAGE(PG8_SB(1, 0), cB + kstep, voffB); PG8_STAGE(PG8_SA(1, 0), cA + kstep, voffA); PG8_STAGE(PG8_SB(1, 1), cB + hstep + kstep, voffB);
        PG8_WAIT_V(6); PG8_BAR;
    }
    for (;;) {
        const bool has_next = S.next(ui + 1, nxt);
        const char* nA = has_next ? (const char*)g.A + (size_t)nxt.pm * tstep : cA; const char* nB = has_next ? (const char*)g.Bt + (size_t)nxt.pn * tstep : cB;
        for (int t = 0; t < nt; t += 2) {
            const bool last = (t == nt - 2);
            const char* a1 = cA + (size_t)(t + 1) * kstep;
            const char* a2 = last ? nA : cA + (size_t)(t + 2) * kstep; const char* b2 = last ? nB : cB + (size_t)(t + 2) * kstep;
            const char* a3 = a2 + kstep; const char* b3 = b2 + kstep;
            if (last && has_next) S.a_ready(nxt);
            if constexpr (SP2) {
            PG8_LDB(B0, 0, 0); PG8_LDB(B1, 0, 1); PG8_SCHED; PG8_LDA(At, 0, 0); PG8_STAGE(PG8_SA(1, 1), a1 + hstep, voffA);
            PG8_WAIT_V(8); PG8_WAIT_L(0); PG8_BAR; PG8_MMA(0, 0, At, B0); PG8_MMA(0, 1, At, B1); PG8_BAR; PG8_SCHED;
            PG8_LDA(At, 0, 1); PG8_STAGE(PG8_SB(0, 0), b2, voffB); PG8_STAGE(PG8_SB(0, 1), b2 + hstep, voffB); PG8_STAGE(PG8_SA(0, 0), a2, voffA);
            PG8_WAIT_V(8); PG8_WAIT_L(0); PG8_BAR; PG8_MMA(1, 0, At, B0); PG8_MMA(1, 1, At, B1); PG8_BAR; PG8_SCHED;
            PG8_LDB(B0, 1, 0); PG8_LDB(B1, 1, 1); PG8_SCHED; PG8_LDA(At, 1, 0); PG8_STAGE(PG8_SA(0, 1), a2 + hstep, voffA);
            PG8_WAIT_V(8); PG8_WAIT_L(0); PG8_BAR; PG8_MMA(0, 0, At, B0); PG8_MMA(0, 1, At, B1); PG8_BAR; PG8_SCHED;
            PG8_LDA(At, 1, 1); PG8_STAGE(PG8_SB(1, 0), b3, voffB); PG8_STAGE(PG8_SB(1, 1), b3 + hstep, voffB); PG8_STAGE(PG8_SA(1, 0), a3, voffA);
            PG8_WAIT_V(8); PG8_WAIT_L(0); PG8_BAR; PG8_MMA(1, 0, At, B0); PG8_MMA(1, 1, At, B1); PG8_BAR; PG8_SCHED;
            } else {
            PG8_LDB(B0, 0, 0); PG8_SCHED; PG8_LDA(At, 0, 0); PG8_STAGE(PG8_SA(1, 1), a1 + hstep, voffA);
            PG8_WAIT_L(8); PG8_BAR; PG8_WAIT_L(0); PG8_MMA(0, 0, At, B0); PG8_BAR; PG8_SCHED;
            PG8_LDB(B1, 0, 1); PG8_STAGE(PG8_SB(0, 0), b2, voffB);
            PG8_BAR; PG8_WAIT_L(0); PG8_MMA(0, 1, At, B1); PG8_BAR;
            PG8_LDA(At, 0, 1); PG8_STAGE(PG8_SA(0, 0), a2, voffA);
            PG8_BAR; PG8_WAIT_L(0); PG8_MMA(1, 0, At, B0); PG8_BAR; PG8_SCHED;
            PG8_STAGE(PG8_SB(0, 1), b2 + hstep, voffB);
            PG8_WAIT_V(6); PG8_BAR; PG8_MMA(1, 1, At, B1); PG8_BAR;
            PG8_LDB(B0, 1, 0); PG8_SCHED; PG8_LDA(At, 1, 0); PG8_STAGE(PG8_SA(0, 1), a2 + hstep, voffA);
            PG8_WAIT_L(8); PG8_BAR; PG8_WAIT_L(0); PG8_MMA(0, 0, At, B0); PG8_BAR; PG8_SCHED;
            PG8_LDB(B1, 1, 1); PG8_STAGE(PG8_SB(1, 0), b3, voffB);
            PG8_BAR; PG8_WAIT_L(0); PG8_MMA(0, 1, At, B1); PG8_BAR;
            PG8_LDA(At, 1, 1); PG8_STAGE(PG8_SA(1, 0), a3, voffA);
            PG8_BAR; PG8_WAIT_L(0); PG8_MMA(1, 0, At, B0); PG8_BAR; PG8_SCHED;
            PG8_STAGE(PG8_SB(1, 1), b3 + hstep, voffB);
            PG8_WAIT_V(6); PG8_BAR; PG8_MMA(1, 1, At, B1); PG8_BAR;
            }
        }
        if constexpr (ALIGN_EPI) { if (wr == 0) PG8_BAR; }
        { E(acc, cur, wr, wc, fr, fq, esc, tid); S.done(cur); }
        if (!has_next) break;
#pragma unroll
        for (int a = 0; a < 2; ++a)
#pragma unroll
            for (int b = 0; b < 2; ++b)
#pragma unroll
                for (int m = 0; m < 4; ++m)
#pragma unroll
                    for (int n = 0; n < 2; ++n) acc[a][b][m][n] = (f32x4){0.f, 0.f, 0.f, 0.f};
        cur = nxt; cA = nA; cB = nB; ++ui;
        if constexpr (ALIGN_EPI) { if (wr == 1) PG8_BAR; }
    }
    PG8_WAIT_V(0);
    if constexpr (!ALIGN_EPI) { if (wr == 0) PG8_BAR; }
    PG8_BAR;
#undef PG8_SA
#undef PG8_SB
#undef PG8_STAGE
#undef PG8_LDA
#undef PG8_LDB
#undef PG8_MMA
#undef PG8_WAIT_V
#undef PG8_WAIT_L
#undef PG8_BAR
#undef PG8_SCHED
}
}

typedef float f32x4 __attribute__((ext_vector_type(4)));
typedef short bf16x8 __attribute__((ext_vector_type(8)));


__device__ __forceinline__ void build_rs(const float* ssq, int pm, LAS unsigned char* esc, int tid) {
    LAS float* rsT = (LAS float*)esc;
    WG_BAR();
    if (tid < 256) {
        float s = 0.f;
#pragma unroll
        for (int j = 0; j < 8; ++j) { const gu64* p = (const gu64*)(ssq + ((size_t)j * MP + pm * 256 + tid) * 4);
#pragma unroll
            for (int h = 0; h < 2; ++h) { const unsigned long long v = __hip_atomic_load(p + h, RLX_AGENT); s += __builtin_bit_cast(float, (unsigned)v) + __builtin_bit_cast(float, (unsigned)(v >> 32)); } }
        rsT[tid] = rsqrtf(s * (1.0f / DM) + EPS);
    }
    WG_BAR();
}

struct EpiProj {
    static constexpr bool PERM = false, AFTER_DRAIN = false;
    unsigned char* ws_; float* out_; const float* gq; const float* gk; int l;
    __device__ __forceinline__ void operator()(f32x4 (&acc)[2][2][4][2], const pg8::Unit& u, int wr, int wc, int fr, int fq, LAS unsigned char* esc, int tid) const {
        asm volatile("" : "+v"(fr), "+v"(fq), "+v"(tid));
        unsigned char* ws = ws_; asm volatile("" : "+s"(ws));
        const float* ssq = (const float*)(ws + WS_SSQ); const float* ropec = (const float*)(ws + WS_ROPE); const float* ropes = ropec + ROPE_N;
        bf16* Q = (bf16*)(ws + WS_Q); bf16* K = (bf16*)(ws + WS_K); bf16* VT = (bf16*)(ws + WS_VT); float* U = (float*)(ws + WS_U); float* XP = (float*)(ws + WS_XP);
        float* ksn = (float*)(ws + WS_KSN); float* vsn = ksn + NSAMP * 256;
        float* out_pk = out_ + O_PK + (size_t)l * NBATCH * 128 * 256; float* out_pv = out_ + O_PV + (size_t)l * NBATCH * 128 * 256;
        const rsrc_t rs_ = ws_rsrc(ws);
        build_rs(ssq, u.pm, esc, tid);
        const LAS float* rsT = (const LAS float*)esc;
        LAS float* hss = (LAS float*)(esc + 1024);
        const int pn = u.pn;
#pragma unroll
        for (int ai = 0; ai < 2; ++ai)
#pragma unroll
            for (int m = 0; m < 4; ++m) { const float rsv = rsT[ai * 128 + wr * 64 + m * 16 + fr];
#pragma unroll
                for (int bj = 0; bj < 2; ++bj)
#pragma unroll
                    for (int n = 0; n < 2; ++n) acc[ai][bj][m][n] *= rsv; }
        if (pn <= 4) {
#pragma unroll
            for (int ai = 0; ai < 2; ++ai)
#pragma unroll
                for (int m = 0; m < 4; ++m)
#pragma unroll
                    for (int bj = 0; bj < 2; ++bj) { const f32x4 a = acc[ai][bj][m][0], b = acc[ai][bj][m][1];
                        float s = (a[0] * a[0] + a[1] * a[1]) + (a[2] * a[2] + a[3] * a[3]) + (b[0] * b[0] + b[1] * b[1]) + (b[2] * b[2] + b[3] * b[3]);
                        s += __shfl_xor(s, 16); s += __shfl_xor(s, 32);
                        if (fq == 0) hss[(bj * 256 + ai * 128 + wr * 64 + m * 16 + fr) * 4 + wc] = s; }
            WG_BAR();
            const float* g = (pn < 4) ? gq : gk; const float osc = (pn < 4) ? QSCALE : 1.0f;
            f32x4 gv[2];
#pragma unroll
            for (int n = 0; n < 2; ++n) gv[n] = *(const f32x4*)(g + wc * 32 + n * 16 + 4 * fq);
#pragma unroll
            for (int ai = 0; ai < 2; ++ai)
#pragma unroll
                for (int m = 0; m < 4; ++m) {
                    const int rl = ai * 128 + wr * 64 + m * 16 + fr, r = u.pm * 256 + rl;
                    const bool samp = r >= SROW0, pad = r >= MR;
                    const int b = (r >= TT && !samp) ? 1 : 0, t = r - b * TT;
                    const int pidx = samp ? ROPE_SAMPLE_IDX : t;
                    f32x4 cs = {1.f, 1.f, 1.f, 1.f}, sn = {0.f, 0.f, 0.f, 0.f};
                    if (wc == 0 && !pad) { cs = *(const f32x4*)(ropec + (size_t)pidx * 16 + 4 * fq); sn = *(const f32x4*)(ropes + (size_t)pidx * 16 + 4 * fq); }
#pragma unroll
                    for (int bj = 0; bj < 2; ++bj) {
                        const f32x4 hv = *(const LAS f32x4*)(hss + (bj * 256 + rl) * 4);
                        const float hn = rsqrtf(((hv[0] + hv[1]) + (hv[2] + hv[3])) * (1.0f / 128.0f) + EPS);
                        f32x4 x1 = acc[ai][bj][m][0] * hn * gv[0], x2 = acc[ai][bj][m][1] * hn * gv[1];
                        if (wc == 0) { const f32x4 o1 = x1 * cs - x2 * sn, o2 = x2 * cs + x1 * sn; x1 = o1; x2 = o2; }
                        x1 = x1 * osc; x2 = x2 * osc;
                        const int cl = bj * 128 + wc * 32 + 4 * fq;
                        if (pn < 4) { const size_t qo = WS_Q + ((size_t)r * 1024 + pn * 256 + cl) * 2;
                            ST8(rs_, qo, ((v2u){pk2(x1[0], x1[1]), pk2(x1[2], x1[3])})); ST8(rs_, qo + 32, ((v2u){pk2(x2[0], x2[1]), pk2(x2[2], x2[3])})); }
                        else { const size_t ko = WS_K + ((size_t)r * 256 + cl) * 2;
                            ST8(rs_, ko, ((v2u){pk2(x1[0], x1[1]), pk2(x1[2], x1[3])})); ST8(rs_, ko + 32, ((v2u){pk2(x2[0], x2[1]), pk2(x2[2], x2[3])}));
                            if (samp && !pad) { const size_t o = WS_KSN + ((size_t)(r - SROW0) * 256 + cl) * 4; ST16(rs_, o, x1); ST16(rs_, o + 64, x2); }
                            else if (!samp && t >= TT - 128) { float* o = out_pk + ((size_t)(b * 128 + (t - (TT - 128))) * 256) + cl; *(f32x4*)o = x1; *(f32x4*)(o + 16) = x2; } }
                    }
                }
        } else if (pn == 5) {
#pragma unroll
            for (int ai = 0; ai < 2; ++ai)
#pragma unroll
                for (int m = 0; m < 4; ++m) {
                    const int rl = ai * 128 + wr * 64 + m * 16 + fr, r = u.pm * 256 + rl;
                    const bool samp = r >= SROW0, pad = r >= MR;
                    const int b = (r >= TT && !samp) ? 1 : 0, t = r - b * TT;
                    const int tpos = (t & ~15) + perm16(t & 15);
#pragma unroll
                    for (int bj = 0; bj < 2; ++bj)
#pragma unroll
                        for (int n = 0; n < 2; ++n) { const f32x4 x = acc[ai][bj][m][n]; const int d = wc * 32 + n * 16 + 4 * fq;
                            if (!samp) { const size_t vo = WS_VT + (((size_t)((b * 2 + bj) * 128 + d)) * TPV + tpos) * 2;
#pragma unroll
                                for (int j = 0; j < 4; ++j) ST2(rs_, vo + (size_t)j * TPV * 2, pk2(x[j], 0.f) & 0xffffu);
                                if (t >= TT - 128) *(f32x4*)(out_pv + ((size_t)(b * 128 + (t - (TT - 128))) * 256) + bj * 128 + d) = x; }
                            else if (!pad) ST16(rs_, WS_KSN + ((size_t)NSAMP * 256 + (size_t)(r - SROW0) * 256 + bj * 128 + d) * 4, x); }
                }
        } else {
            const size_t dsto = (pn < 8) ? WS_U + (size_t)(pn - 6) * 256 * 4 : WS_XP + (size_t)(pn - 8) * 256 * 4;
#pragma unroll
            for (int ai = 0; ai < 2; ++ai)
#pragma unroll
                for (int m = 0; m < 4; ++m) { const size_t ro = dsto + ((size_t)(u.pm * 256 + ai * 128 + wr * 64 + m * 16 + fr) * 512 + wc * 32 + 4 * fq) * 4;
#pragma unroll
                    for (int bj = 0; bj < 2; ++bj)
#pragma unroll
                        for (int n = 0; n < 2; ++n) ST16(rs_, ro + (size_t)(bj * 128 + n * 16) * 4, acc[ai][bj][m][n]); }
        }
    }
};

struct EpiRes {
    static constexpr bool PERM = false, AFTER_DRAIN = false;
    unsigned char* ws_; float* out; int last;
    __device__ __forceinline__ void operator()(f32x4 (&acc)[2][2][4][2], const pg8::Unit& u, int wr, int wc, int fr, int fq, LAS unsigned char* esc, int tid) const {
        asm volatile("" : "+v"(fr), "+v"(fq), "+v"(tid));
        unsigned char* ws = ws_; asm volatile("" : "+s"(ws));
        const float* X = (const float*)(ws + WS_X); const rsrc_t rs_ = ws_rsrc(ws);
#pragma unroll
        for (int ai = 0; ai < 2; ++ai)
#pragma unroll
            for (int m = 0; m < 4; ++m) {
                const int r = u.pm * 256 + ai * 128 + wr * 64 + m * 16 + fr; const int c0 = u.pn * 256 + wc * 32 + 4 * fq;
                const float* xp = X + (size_t)r * DM + c0; float s = 0.f; const size_t eo = (size_t)r * DM + c0;
                f32x4 v[2][2];
#pragma unroll
                for (int bj = 0; bj < 2; ++bj)
#pragma unroll
                    for (int n = 0; n < 2; ++n) { v[bj][n] = *(const f32x4*)(xp + bj * 128 + n * 16) + acc[ai][bj][m][n]; const f32x4 q = v[bj][n] * v[bj][n]; s += (q[0] + q[1]) + (q[2] + q[3]); }
                if (!last) {
#pragma unroll
                    for (int bj = 0; bj < 2; ++bj)
#pragma unroll
                        for (int n = 0; n < 2; ++n) { ST16(rs_, WS_X + (eo + bj * 128 + n * 16) * 4, v[bj][n]); ST8(rs_, WS_XB + (eo + bj * 128 + n * 16) * 2, ((v2u){pk2(v[bj][n][0], v[bj][n][1]), pk2(v[bj][n][2], v[bj][n][3])})); }
                    s += __shfl_xor(s, 16); s += __shfl_xor(s, 32);
                    if (fq == 0) ST4(rs_, WS_SSQ + (((size_t)u.pn * MP + r) * 4 + wc) * 4, s);
                } else {
                    const bool samp = r >= SROW0, pad = r >= MR; const int b = (r >= TT && !samp) ? 1 : 0, t = r - b * TT;
                    float* op = nullptr;
                    if (samp) { if (!pad) op = out + O_YS + (size_t)(r - SROW0) * DM + c0; } else if (t >= NMETA) op = out + O_YP + ((size_t)b * NSEQ + (t - NMETA)) * DM + c0;
                    if (op) {
#pragma unroll
                        for (int bj = 0; bj < 2; ++bj)
#pragma unroll
                            for (int n = 0; n < 2; ++n) *(f32x4*)(op + bj * 128 + n * 16) = v[bj][n]; }
                }
                if (m & 1) asm volatile("" ::: "memory");
            }
    }
};

struct EpiFfn1 {
    static constexpr bool PERM = true, AFTER_DRAIN = false;
    unsigned char* ws_;
    __device__ __forceinline__ void operator()(f32x4 (&acc)[2][2][4][2], const pg8::Unit& u, int wr, int wc, int fr, int fq, LAS unsigned char* esc, int tid) const {
        asm volatile("" : "+v"(fr), "+v"(fq), "+v"(tid));
        unsigned char* ws = ws_; asm volatile("" : "+s"(ws));
        const rsrc_t rs_ = ws_rsrc(ws);
        build_rs((const float*)(ws + WS_SSQ), u.pm, esc, tid);
        const LAS float* rsT = (const LAS float*)esc;
#pragma unroll
        for (int ai = 0; ai < 2; ++ai)
#pragma unroll
            for (int m = 0; m < 4; ++m) { const int rl = ai * 128 + wr * 64 + m * 16 + fr; const float rsv = rsT[rl];
                const size_t ho = WS_H + ((size_t)(u.pm * 256 + rl) * DFF + u.pn * 256 + wc * 32 + 8 * fq) * 2;
#pragma unroll
                for (int bj = 0; bj < 2; ++bj) { f32x4 v0 = acc[ai][bj][m][0] * rsv, v1 = acc[ai][bj][m][1] * rsv;
#pragma unroll
                    for (int j = 0; j < 4; ++j) { const float a = fmaxf(v0[j], 0.f), b = fmaxf(v1[j], 0.f); v0[j] = a * a; v1[j] = b * b; }
                    ST16(rs_, ho + bj * 256, ((v4u){pk2(v0[0], v0[1]), pk2(v0[2], v0[3]), pk2(v1[0], v1[1]), pk2(v1[2], v1[3])})); } }
    }
};

#define XB_TMO      128
#define XB_XCNT(j)  (256  + 64 * (j))
#define XB_XSUB(j)  (1280 + 64 * (j))
#define XB_XGEN(j)  (2304 + 64 * (j))
#define XB_TOP      3328
#define XB_TOPGEN   3392
#define XCD_BAR_WORDS 3456
#define XB_SPIN_CAP (1u << 18)
__device__ __forceinline__ unsigned xb_ld(unsigned* p)              { return __hip_atomic_load(p, __ATOMIC_RELAXED, __HIP_MEMORY_SCOPE_AGENT); }
__device__ __forceinline__ unsigned xb_add(unsigned* p, unsigned v) { return __hip_atomic_fetch_add(p, v, __ATOMIC_RELAXED, __HIP_MEMORY_SCOPE_AGENT); }
__device__ __forceinline__ unsigned xb_xcc_id() { return (unsigned)__builtin_amdgcn_s_getreg((3 << 11) | 20) & 0xFu; }
#define XB_SPIN(cond, bar) do { unsigned _sp = 0; while (cond) { __builtin_amdgcn_s_sleep(1); \
    if ((++_sp & 255u) == 0u) { if (xb_ld(&(bar)[XB_TMO])) break; if (_sp > XB_SPIN_CAP) { atomicAdd(&(bar)[XB_TMO], 1u); break; } } } } while (0)

struct XcdBarrier {
    unsigned* bar; unsigned x;
    volatile LAS unsigned* st;
};

__device__ __forceinline__ XcdBarrier xcd_barrier_post(unsigned* bar, volatile LAS unsigned* st) {
    XcdBarrier b; b.bar = bar; b.x = xb_xcc_id(); b.st = st;
    if (threadIdx.x == 0) (void)xb_add(&bar[XB_XCNT(b.x)], 1u);
    return b;
}
__device__ __forceinline__ void xcd_barrier_complete(unsigned* bar, unsigned x, unsigned& nloc, unsigned& nx) {
    const unsigned G = gridDim.x * gridDim.y * gridDim.z;
    unsigned sum, cnt, mine, sp = 0u;
    for (;;) {
        sum = 0u; cnt = 0u; mine = 0u;
#pragma unroll
        for (unsigned j = 0; j < 16; ++j) { const unsigned c = xb_ld(&bar[XB_XCNT(j)]); sum += c; cnt += (c > 0u) ? 1u : 0u; mine = (j == x) ? c : mine; }
        if (sum == G) break;
        __builtin_amdgcn_s_sleep(1);
        if ((++sp & 255u) == 0u) { if (xb_ld(&bar[XB_TMO])) break; if (sp > XB_SPIN_CAP) { atomicAdd(&bar[XB_TMO], 1u); break; } }
    }
    nloc = mine > 0u ? mine : 1u; nx = cnt > 0u ? cnt : 1u;
}

__device__ __forceinline__ void xcd_barrier(const XcdBarrier& b) {
    asm volatile("s_waitcnt vmcnt(0)" ::: "memory");
    __syncthreads();
    if (threadIdx.x == 0) {
        unsigned* bar = b.bar;
        __builtin_amdgcn_s_waitcnt(0);
        unsigned nloc = b.st[0], nx = b.st[1];
        if (nloc == 0u) { xcd_barrier_complete(bar, b.x, nloc, nx); b.st[0] = nloc; b.st[1] = nx; }
        const unsigned old = xb_add(&bar[XB_XSUB(b.x)], 1u);
        const unsigned gen = old / nloc;
        if (old + 1u == (gen + 1u) * nloc) {
            __builtin_amdgcn_fence(__ATOMIC_RELEASE, "agent");
            asm volatile("s_waitcnt vmcnt(0)" ::: "memory");
            const unsigned og = xb_add(&bar[XB_TOP], 1u);
            const unsigned tg = og / nx;
            if (og + 1u == (tg + 1u) * nx) xb_add(&bar[XB_TOPGEN], 1u);
            else XB_SPIN(xb_ld(&bar[XB_TOPGEN]) == tg, bar);
            __builtin_amdgcn_fence(__ATOMIC_ACQUIRE, "agent");
            xb_add(&bar[XB_XGEN(b.x)], 1u);
            asm volatile("s_waitcnt vmcnt(0)" ::: "memory");
        } else {
            XB_SPIN(xb_ld(&bar[XB_XGEN(b.x)]) == gen, bar);
            __builtin_amdgcn_fence(__ATOMIC_ACQUIRE, "agent");
            asm volatile("s_waitcnt vmcnt(0)" ::: "memory");
        }
    }
    __syncthreads();
}

struct Frame {
    LAS unsigned char* lds;
    volatile LAS unsigned* MISC;
    gu32* ctl;
    int tid, lane, wave, vcu, G;
    float* out; unsigned char* ws;
};
#define IN_XPROMPT 0
#define IN_XSAMPLE 1
#define IN_CACHEK 2
#define IN_CACHEV 3
#define IN_SSMRE 4
#define IN_SSMIM 5
#define IN_SPOOL 6
#define IN_META 7
#define IN_GMIX 8
#define IN_WIN 9
#define IN_GQ 10
#define IN_GK 11
#define IN_SINKS 12
#define IN_ARE 13
#define IN_AIM 14
#define IN_LOGDT 15
#define IN_BRE 16
#define IN_BIM 17
#define IN_CRE 18
#define IN_CIM 19
#define IN_DSKIP 20
#define IN_WGLU 21
#define IN_BGLU 22
#define IN_WPOOL 23
#define IN_PSCALE 24
#define IN_GOA 25
#define IN_GOS 26
#define IN_GOP 27
#define IN_WOUT 28
#define IN_GFFN 29
#define IN_WFF1 30
#define IN_WFF2 31
struct Args { const float* in[32]; float* out; unsigned char* ws; int ph_lo, ph_hi; };
static_assert(sizeof(Args) == 32 * 8 + 8 + 8 + 8, "Args has no padding");

__device__ __forceinline__ void p0_transpose_item(const float* W, int K, int N, bf16* WT, const float* gain, LAS float* scr, int item, int lane) {
    const int nblk = N / 32, kb = item / nblk, nb = item % nblk, k0 = 64 * kb, n0 = 32 * nb;
    float wv[32];
#pragma unroll
    for (int i = 0; i < 32; ++i) wv[i] = W[(size_t)(k0 + 2 * i + (lane >> 5)) * N + n0 + (lane & 31)];
    if (gain) {
#pragma unroll
        for (int i = 0; i < 32; ++i) wv[i] *= gain[k0 + 2 * i + (lane >> 5)];
    }
#pragma unroll
    for (int i = 0; i < 32; ++i) scr[(2 * i + (lane >> 5)) * 33 + (lane & 31)] = wv[i];
    LDS_WAIT(); asm volatile("" ::: "memory");
    const int c = lane & 7;
#pragma unroll
    for (int j = 0; j < 4; ++j) { const int n = (lane >> 3) + 8 * j; const LAS float* s = scr + (8 * c) * 33 + n;
        v4u o; o.x = pk2(s[0 * 33], s[1 * 33]); o.y = pk2(s[2 * 33], s[3 * 33]); o.z = pk2(s[4 * 33], s[5 * 33]); o.w = pk2(s[6 * 33], s[7 * 33]);
        *(GAS v4u*)(WT + (size_t)(n0 + n) * K + k0 + 8 * c) = o; }
    LDS_WAIT(); asm volatile("" ::: "memory");
}
__device__ __forceinline__ void sincos_d(double x, double& s, double& c) {
    const double TWO_PI = 6.283185307179586476925286766559;
    const double k = rint(x * (1.0 / TWO_PI)); const double r = fma(-k, TWO_PI, x), r2 = r * r;
    const double fs[14] = {0.16666666666666666, 0.05, 0.023809523809523808, 0.013888888888888888, 0.00909090909090909, 0.00641025641025641, 0.004761904761904762, 0.003676470588235294,
                           0.0029239766081871343, 0.002380952380952381, 0.001976284584980237, 0.0016666666666666668, 0.0014245014245014246, 0.0012315270935960591};
    const double fc[14] = {0.5, 0.08333333333333333, 0.03333333333333333, 0.017857142857142856, 0.011111111111111112, 0.007575757575757576, 0.005494505494505495, 0.004166666666666667,
                           0.0032679738562091504, 0.002631578947368421, 0.0021645021645021645, 0.0018115942028985507, 0.0015384615384615385, 0.0013227513227513227};
    double ts = r, tc = 1.0; s = r; c = 1.0;
#pragma unroll
    for (int i = 0; i < 14; ++i) { ts *= -r2 * fs[i]; s += ts; tc *= -r2 * fc[i]; c += tc; }
}
__device__ __forceinline__ double exp_small(double x) {
    double t = 1.0, e = 1.0;
#pragma unroll
    for (int i = 1; i <= 14; ++i) { t *= x * (1.0 / i); e += t; }
    return e;
}
__device__ __forceinline__ void p0_prologue(const Args& AR, Frame& F) {
    LAS float* scr = (LAS float*)(F.lds + F.wave * 16384);
    const int gw = F.vcu * 8 + F.wave, NGW = F.G * 8, lane = F.lane;
    unsigned char* ws = F.ws;
    constexpr int I_IN = (DM / 64) * (INW / 32), I_OUT = (DM / 64) * (DM / 32), I_1 = (DM / 64) * (DFF / 32), I_2 = (DFF / 64) * (DM / 32), I_GLU = (512 / 64) * (512 / 32), I_POOL = 4 * 2 * 4;
    constexpr int I_LAYER = I_IN + I_OUT + I_1 + I_2 + I_GLU + I_POOL;
    for (int it = gw; it < NLAYER * I_LAYER; it += NGW) {
        const int l = it / I_LAYER; int r = it % I_LAYER;
        if (r < I_IN) { p0_transpose_item(AR.in[IN_WIN] + (size_t)l * DM * INW, DM, INW, (bf16*)(ws + WS_WIN) + (size_t)l * INW * DM, AR.in[IN_GMIX] + l * DM, scr, r, lane); continue; } r -= I_IN;
        if (r < I_OUT) { const int k0 = 64 * (r / (DM / 32));
            const float* g = (k0 < 1024) ? AR.in[IN_GOA] + l * 1024 : (k0 < 1536) ? AR.in[IN_GOS] + l * 512 - 1024 : AR.in[IN_GOP] + l * 512 - 1536;
            p0_transpose_item(AR.in[IN_WOUT] + (size_t)l * DM * DM, DM, DM, (bf16*)(ws + WS_WOUT) + (size_t)l * DM * DM, g, scr, r, lane); continue; } r -= I_OUT;
        if (r < I_1) { p0_transpose_item(AR.in[IN_WFF1] + (size_t)l * DM * DFF, DM, DFF, (bf16*)(ws + WS_W1) + (size_t)l * DFF * DM, AR.in[IN_GFFN] + l * DM, scr, r, lane); continue; } r -= I_1;
        if (r < I_2) { p0_transpose_item(AR.in[IN_WFF2] + (size_t)l * DFF * DM, DFF, DM, (bf16*)(ws + WS_W2) + (size_t)l * DM * DFF, nullptr, scr, r, lane); continue; } r -= I_2;
        if (r < I_GLU) { p0_transpose_item(AR.in[IN_WGLU] + (size_t)l * 512 * 512, 512, 512, (bf16*)(ws + WS_WGLU) + (size_t)l * 512 * 512, nullptr, scr, r, lane); continue; } r -= I_GLU;
        { const int g = r / 8; p0_transpose_item(AR.in[IN_WPOOL] + ((size_t)l * 4 + g) * 128 * 128, 128, 128, (bf16*)(ws + WS_WPOOL) + ((size_t)l * 4 + g) * 128 * 128, nullptr, scr, r % 8, lane); }
    }
    float* X = (float*)(ws + WS_X); bf16* XB = (bf16*)(ws + WS_XB); float* SSQ = (float*)(ws + WS_SSQ);
    for (int m = gw; m < MP; m += NGW) {
        const float* src = nullptr;
        if (m < SROW0) { const int b = m >= TT ? 1 : 0, t = m - b * TT; src = (t < NMETA) ? AR.in[IN_META] + (size_t)t * DM : AR.in[IN_XPROMPT] + ((size_t)b * NSEQ + (t - NMETA)) * DM; }
        else if (m < MR) src = AR.in[IN_XSAMPLE] + (size_t)(m - SROW0) * DM;
        float s = 0.f;
#pragma unroll
        for (int j = 0; j < 8; ++j) { f32x4 v = {0.f, 0.f, 0.f, 0.f}; if (src) v = *(const f32x4*)(src + j * 256 + lane * 4);
            s += (v[0] * v[0] + v[1] * v[1]) + (v[2] * v[2] + v[3] * v[3]);
            *(f32x4*)(X + (size_t)m * DM + j * 256 + lane * 4) = v; *(v2u*)(XB + (size_t)m * DM + j * 256 + lane * 4) = (v2u){pk2(v[0], v[1]), pk2(v[2], v[3])}; }
        s = wave_sum(s);
        if (lane < 32) SSQ[((size_t)(lane >> 2) * MP + m) * 4 + (lane & 3)] = (lane == 0) ? s : 0.f;
    }
    const int gt = gw * 64 + lane, NGT = NGW * 64;
    for (int id = gt; id < NLAYER * 32 * 64; id += NGT) {
        const int l = id >> 11, g = (id >> 6) & 31, n = id & 63;
        unsigned char* tb = ws + WS_TAB + (size_t)l * TB_LAYER;
        const double dt = (double)expf(AR.in[IN_LOGDT][l * 32 + g]);
        const double ar = (double)AR.in[IN_ARE][id], ai = (double)AR.in[IN_AIM][id];
        const double mag = exp_small(dt * ar); double sn, cs; sincos_d(dt * ai, sn, cs);
        const double abr = mag * cs, abi = mag * sn, den = ar * ar + ai * ai;
        const double fr = ((abr - 1.0) * ar + abi * ai) / den, fi = (abi * ar - (abr - 1.0) * ai) / den;
        ((float*)(tb + TB_ABR))[g * 64 + n] = (float)abr; ((float*)(tb + TB_ABI))[g * 64 + n] = (float)abi;
        const float* Br = AR.in[IN_BRE] + (size_t)id * 16; const float* Bi = AR.in[IN_BIM] + (size_t)id * 16;
        float* bbr = (float*)(tb + TB_BBR) + (size_t)(g * 64 + n) * 16; float* bbi = (float*)(tb + TB_BBI) + (size_t)(g * 64 + n) * 16;
#pragma unroll
        for (int c = 0; c < 16; ++c) { const double br = Br[c], bi = Bi[c]; bbr[c] = (float)(fr * br - fi * bi); bbi[c] = (float)(fr * bi + fi * br); }
        bf16* Pm = (bf16*)(tb + TB_PM) + (size_t)g * 64 * 128;
        double pr = abr, pi = abi;
        for (int t = 0; t < 64; ++t) {
            Pm[t * 128 + n] = (bf16)(pk2((float)pr, 0.f) & 0xffffu); Pm[t * 128 + 64 + n] = (bf16)(pk2((float)pi, 0.f) & 0xffffu);
            if (t == 15) { ((float*)(tb + TB_A16R))[g * 64 + n] = (float)pr; ((float*)(tb + TB_A16I))[g * 64 + n] = (float)pi; }
            if (t == 31) { ((float*)(tb + TB_A32R))[g * 64 + n] = (float)pr; ((float*)(tb + TB_A32I))[g * 64 + n] = (float)pi; }
            if (t == 63) { ((float*)(tb + TB_ALR))[g * 64 + n] = (float)pr; ((float*)(tb + TB_ALI))[g * 64 + n] = (float)pi; }
            const double nr = pr * abr - pi * abi, ni = pr * abi + pi * abr; pr = nr; pi = ni;
        }
        bf16* CmT = (bf16*)(tb + TB_CMT) + (size_t)g * 16 * 128;
        const float* Cr = AR.in[IN_CRE] + ((size_t)(l * 32 + g) * 16) * 64 + n; const float* Ci = AR.in[IN_CIM] + ((size_t)(l * 32 + g) * 16) * 64 + n;
#pragma unroll
        for (int c = 0; c < 16; ++c) { CmT[c * 128 + n] = (bf16)(pk2(Cr[c * 64], 0.f) & 0xffffu); CmT[c * 128 + 64 + n] = (bf16)(pk2(-Ci[c * 64], 0.f) & 0xffffu); }
    }
    float* rc = (float*)(ws + WS_ROPE); float* rs_ = rc + ROPE_N;
    for (int id = gt; id < (int)ROPE_N; id += NGT) {
        const int p = id >> 4, i = id & 15; const double pos = (p == ROPE_SAMPLE_IDX) ? 16384.0 : (double)p;
        double inv = 1.0;
        for (int k = 0; k < i; ++k) inv *= 0.44036660267178046;
        double sn, cs; sincos_d(pos * inv, sn, cs);
        rc[id] = (float)cs; rs_[id] = (float)sn;
    }
}

__device__ __forceinline__ void attn_unit(const Args& AR, Frame& F, int l, int b, int i) {
    int lane_ = F.lane; asm volatile("" : "+v"(lane_));
    unsigned char* ws = F.ws; asm volatile("" : "+s"(ws));
    const int lane = lane_, h = F.wave, c = lane & 31, hh = lane >> 5, kvh = h >> 2;
    const int t0 = 32 * i; const size_t rb = (size_t)b * TT;
    const bf16* Q = (const bf16*)(ws + WS_Q); const bf16* K = (const bf16*)(ws + WS_K); const bf16* VT = (const bf16*)(ws + WS_VT);
    LAS float* ex = (LAS float*)(F.lds + ESC_OFF);
    bf16x8 qf[8];
    { const bf16* qp = Q + (rb + t0 + c) * 1024 + 128 * h + 8 * hh;
#pragma unroll
      for (int ks = 0; ks < 8; ++ks) qf[ks] = *(const bf16x8*)(qp + 16 * ks); }
    const int kt0 = (t0 >= 128) ? 0 : (4 - i);
    f32x16 S[5];
#pragma unroll
    for (int kt = 0; kt < 5; ++kt) {
#pragma unroll
        for (int r = 0; r < 16; ++r) S[kt][r] = -INFINITY;
        if (kt >= kt0) {
            const int tk0 = t0 - 128 + 32 * kt;
            const bf16* kp = K + (rb + tk0 + c) * 256 + 128 * kvh + 8 * hh;
            bf16x8 kf[8];
#pragma unroll
            for (int ks = 0; ks < 8; ++ks) kf[ks] = *(const bf16x8*)(kp + 16 * ks);
            f32x16 a = {0.f, 0.f, 0.f, 0.f, 0.f, 0.f, 0.f, 0.f, 0.f, 0.f, 0.f, 0.f, 0.f, 0.f, 0.f, 0.f};
#pragma unroll
            for (int ks = 0; ks < 8; ++ks) a = __builtin_amdgcn_mfma_f32_32x32x16_bf16(kf[ks], qf[ks], a, 0, 0, 0);
#pragma unroll
            for (int r = 0; r < 16; ++r) { const int kr = (r & 3) + 8 * (r >> 2) + 4 * hh; bool ok = true;
                if (kt == 0) ok = kr >= c;
                if (kt == 4) ok = kr <= c;
                S[kt][r] = ok ? a[r] : -INFINITY; }
        }
    }
    const float sink2 = AR.in[IN_SINKS][l * 8 + h] * LOG2E;
    float mx = sink2;
#pragma unroll
    for (int kt = 0; kt < 5; ++kt)
#pragma unroll
        for (int r = 0; r < 16; ++r) mx = fmaxf(mx, S[kt][r]);
    mx = fmaxf(mx, __shfl_xor(mx, 32));
    float sum = 0.f;
#pragma unroll
    for (int kt = 0; kt < 5; ++kt)
#pragma unroll
        for (int r = 0; r < 16; ++r) { const float p = __builtin_amdgcn_exp2f(S[kt][r] - mx); S[kt][r] = p; sum += p; }
    sum += __shfl_xor(sum, 32);
    const float inv = 1.0f / (sum + __builtin_amdgcn_exp2f(sink2 - mx));
    f32x16 O[4];
#pragma unroll
    for (int db = 0; db < 4; ++db)
#pragma unroll
        for (int r = 0; r < 16; ++r) O[db][r] = 0.f;
#pragma unroll
    for (int kt = 0; kt < 5; ++kt) {
        if (kt >= kt0) {
            const int tk0 = t0 - 128 + 32 * kt;
#pragma unroll
            for (int s = 0; s < 2; ++s) {
                v4u pw; pw.x = pk2(S[kt][8 * s + 0], S[kt][8 * s + 1]); pw.y = pk2(S[kt][8 * s + 2], S[kt][8 * s + 3]); pw.z = pk2(S[kt][8 * s + 4], S[kt][8 * s + 5]); pw.w = pk2(S[kt][8 * s + 6], S[kt][8 * s + 7]);
                const bf16x8 pf = __builtin_bit_cast(bf16x8, pw);
#pragma unroll
                for (int db = 0; db < 4; ++db) {
                    const bf16x8 vf = *(const bf16x8*)(VT + ((size_t)((b * 2 + kvh) * 128 + 32 * db + c)) * TPV + tk0 + 16 * s + 8 * hh);
                    O[db] = __builtin_amdgcn_mfma_f32_32x32x16_bf16(vf, pf, O[db], 0, 0, 0);
                }
            }
        }
    }
    float ss = 0.f;
#pragma unroll
    for (int db = 0; db < 4; ++db)
#pragma unroll
        for (int r = 0; r < 16; ++r) { O[db][r] *= inv; ss += O[db][r] * O[db][r]; }
    ss += __shfl_xor(ss, 32);
    if (hh == 0) ex[h * 32 + c] = ss;
    WG_BAR();
    float tot = 0.f;
#pragma unroll
    for (int j = 0; j < 8; ++j) tot += ex[j * 32 + c];
    const float rsa = rsqrtf(tot * (1.0f / 1024.0f) + EPS);
    if (t0 + c < TT) {
        const rsrc_t rs_ = ws_rsrc(ws); const size_t mo = WS_MIX + ((rb + t0 + c) * DM + 128 * h + 4 * hh) * 2;
#pragma unroll
        for (int db = 0; db < 4; ++db)
#pragma unroll
            for (int g4 = 0; g4 < 4; ++g4)
                ST8(rs_, mo + (32 * db + 8 * g4) * 2, ((v2u){pk2(O[db][4 * g4 + 0] * rsa, O[db][4 * g4 + 1] * rsa), pk2(O[db][4 * g4 + 2] * rsa, O[db][4 * g4 + 3] * rsa)}));
    }
    WG_BAR();
}

__device__ __forceinline__ void sattn_unit(const Args& AR, Frame& F, int l, int s) {
    int tid_ = F.tid; asm volatile("" : "+v"(tid_));
    const int tid = tid_, lane = tid & 63, wave = F.wave;
    LAS float* qs = (LAS float*)F.lds;
    LAS float* sc = qs + 1024;
    LAS float* part = sc + 8 * 132;
    LAS float* red = part + 4096;
    const size_t row = SROW0 + s;
    const bf16* Q = (const bf16*)(F.ws + WS_Q) + row * 1024;
    const float* ksn = (const float*)(F.ws + WS_KSN) + (size_t)s * 256; const float* vsn = ksn + NSAMP * 256;
    const float* ck = AR.in[IN_CACHEK] + ((size_t)(l * NSAMP + s)) * 128 * 256; const float* cv = AR.in[IN_CACHEV] + ((size_t)(l * NSAMP + s)) * 128 * 256;
    for (int j = tid; j < 1024; j += 512) qs[j] = bf2f(Q[j]);
    WG_BAR();
    { const int key = tid >> 2, pt = tid & 3;
#pragma unroll
      for (int kvh = 0; kvh < 2; ++kvh) {
          const float* kp = ck + (size_t)key * 256 + kvh * 128 + 32 * pt; float d[4] = {0.f, 0.f, 0.f, 0.f};
#pragma unroll
          for (int j = 0; j < 8; ++j) { const f32x4 kv = *(const f32x4*)(kp + 4 * j);
#pragma unroll
              for (int g = 0; g < 4; ++g) { const f32x4 qv = *(const LAS f32x4*)(qs + (4 * kvh + g) * 128 + 32 * pt + 4 * j); d[g] += (kv[0] * qv[0] + kv[1] * qv[1]) + (kv[2] * qv[2] + kv[3] * qv[3]); } }
#pragma unroll
          for (int g = 0; g < 4; ++g) { d[g] += __shfl_xor(d[g], 1); d[g] += __shfl_xor(d[g], 2); if (pt == 0) sc[(4 * kvh + g) * 132 + key] = d[g]; }
      } }
    {
      const int h = wave, kvh = h >> 2; float d = ksn[kvh * 128 + lane] * qs[h * 128 + lane] + ksn[kvh * 128 + 64 + lane] * qs[h * 128 + 64 + lane];
      d = wave_sum(d); if (lane == 0) sc[h * 132 + 128] = d; }
    WG_BAR();
    { const int h = wave; const float sink2 = AR.in[IN_SINKS][l * 8 + h] * LOG2E;
      const float v0 = sc[h * 132 + lane], v1 = sc[h * 132 + 64 + lane], v2 = (lane == 0) ? sc[h * 132 + 128] : -INFINITY;
      const float mx = fmaxf(wave_max(fmaxf(fmaxf(v0, v1), v2)), sink2);
      const float p0 = __builtin_amdgcn_exp2f(v0 - mx), p1 = __builtin_amdgcn_exp2f(v1 - mx), p2 = __builtin_amdgcn_exp2f(v2 - mx);
      const float inv = 1.0f / (wave_sum(p0 + p1 + p2) + __builtin_amdgcn_exp2f(sink2 - mx));
      sc[h * 132 + lane] = p0 * inv; sc[h * 132 + 64 + lane] = p1 * inv; if (lane == 0) sc[h * 132 + 128] = p2 * inv; }
    WG_BAR();
    { const int d = tid & 127, kq = tid >> 7;
#pragma unroll
      for (int kvh = 0; kvh < 2; ++kvh) { float a[4] = {0.f, 0.f, 0.f, 0.f};
#pragma unroll 8
          for (int k = 0; k < 32; ++k) { const int key = 32 * kq + k; const float v = cv[(size_t)key * 256 + kvh * 128 + d];
#pragma unroll
              for (int g = 0; g < 4; ++g) a[g] += sc[(4 * kvh + g) * 132 + key] * v; }
#pragma unroll
          for (int g = 0; g < 4; ++g) part[kq * 1024 + (4 * kvh + g) * 128 + d] = a[g]; } }
    WG_BAR();
    float o[2]; float ss = 0.f;
#pragma unroll
    for (int e = 0; e < 2; ++e) { const int j = tid + 512 * e, h = j >> 7, d = j & 127, kvh = h >> 2;
        o[e] = (part[j] + part[1024 + j]) + (part[2048 + j] + part[3072 + j]) + sc[h * 132 + 128] * vsn[kvh * 128 + d]; ss += o[e] * o[e]; }
    ss = wave_sum(ss); if (lane == 0) red[wave] = ss;
    WG_BAR();
    { float tot = 0.f;
#pragma unroll
      for (int j = 0; j < 8; ++j) tot += red[j];
      const float rsa = rsqrtf(tot * (1.0f / 1024.0f) + EPS);
      const rsrc_t rs_ = ws_rsrc(F.ws);
#pragma unroll
      for (int e = 0; e < 2; ++e) ST2(rs_, WS_MIX + (row * DM + tid + 512 * e) * 2, pk2(o[e] * rsa, 0.f) & 0xffffu); }
    { float* ok = F.out + O_SK + ((size_t)(l * NSAMP + s)) * 128 * 256; float* ov = F.out + O_SV + ((size_t)(l * NSAMP + s)) * 128 * 256;
      for (int j = tid; j < 127 * 64; j += 512) { *(f32x4*)(ok + 4 * j) = *(const f32x4*)(ck + 256 + 4 * j); *(f32x4*)(ov + 4 * j) = *(const f32x4*)(cv + 256 + 4 * j); }
      if (tid < 64) *(f32x4*)(ok + 127 * 256 + 4 * tid) = *(const f32x4*)(ksn + 4 * tid);
      else if (tid < 128) *(f32x4*)(ov + 127 * 256 + 4 * (tid - 64)) = *(const f32x4*)(vsn + 4 * (tid - 64)); }
    WG_BAR();
}

__device__ __forceinline__ float gelu_tanh(float y) {
    const float inner = 0.7978845608028654f * (y + 0.044715f * y * y * y);
    return y / (1.0f + __builtin_amdgcn_exp2f(-2.0f * LOG2E * inner));
}
__device__ __forceinline__ float sigmoidf_(float x) { return 1.0f / (1.0f + __builtin_amdgcn_exp2f(-LOG2E * x)); }
#define SWZ(r, ch, PITCH) ((r) * (PITCH) + ((((ch)) ^ ((r) & 15)) << 4))

#define SSM_ROWS4(BODY_PRE, BODY_POST) \
    _Pragma("unroll") for (int r4 = 0; r4 < 4; ++r4) { const int r = rbase + r4; BODY_PRE \
        f32x2 xx = {0.f, 0.f}; \
        _Pragma("unroll") for (int cc = 0; cc < 16; ++cc) { const float uv = __builtin_bit_cast(float, __builtin_amdgcn_readlane(__builtin_bit_cast(int, uu[cc]), r)); xx += bb[cc] * (f32x2){uv, uv}; } \
        const float nr = abr * hr - abi * hi + xx[0], ni = abr * hi + abi * hr + xx[1]; hr = nr; hi = ni; BODY_POST }
__device__ __forceinline__ void ssm_unit(const Args& AR, Frame& F, int l, int c) {
    int lane_ = F.lane; asm volatile("" : "+v"(lane_));
    const int lane = lane_, w = F.wave, n = lane, t16 = lane & 15, cq = lane >> 4;
    const int row0 = 64 * c;
    unsigned char* ws = F.ws; asm volatile("" : "+s"(ws));
    const unsigned char* tb = ws + WS_TAB + (size_t)l * TB_LAYER;
    const float* U = (const float*)(ws + WS_U);
    float* SST = (float*)(ws + WS_SST) + ((size_t)l * NCHUNK) * 32 * 128;
    gu32* flags = F.ctl + CW_SSMF + (size_t)(l * NCHUNK) * 8 * 16;
    LAS unsigned char* Zs = F.lds;
    LAS unsigned char* Hm = F.lds + 65536 + w * 8192;
    LAS float* red = (LAS float*)(F.lds + ESC_OFF);
    if (c != NCHUNK - 1) {
#pragma unroll 1
        for (int gi = 0; gi < 4; ++gi) {
            const int g = 4 * w + gi;
            const float abr = ((const float*)(tb + TB_ABR))[g * 64 + n], abi = ((const float*)(tb + TB_ABI))[g * 64 + n];
            f32x2 bb[16];
            { const f32x4* pr = (const f32x4*)((const float*)(tb + TB_BBR) + (size_t)(g * 64 + n) * 16); const f32x4* pi = (const f32x4*)((const float*)(tb + TB_BBI) + (size_t)(g * 64 + n) * 16);
#pragma unroll
              for (int j = 0; j < 4; ++j) { const f32x4 a = pr[j], b2 = pi[j];
#pragma unroll
                  for (int e = 0; e < 4; ++e) bb[4 * j + e] = (f32x2){a[e], b2[e]}; } }
            float uu[16];
            { const f32x4* pu = (const f32x4*)(U + (size_t)(row0 + lane) * 512 + 16 * g);
#pragma unroll
              for (int j = 0; j < 4; ++j) { const f32x4 a = pu[j];
#pragma unroll
                  for (int e = 0; e < 4; ++e) uu[4 * j + e] = a[e]; } }
            float hr = 0.f, hi = 0.f;
#pragma unroll 1
            for (int rbase = (c == 64) ? 16 : 0; rbase < 64; rbase += 4) { SSM_ROWS4(, ) }
            __hip_atomic_store((gu64*)(SST + ((size_t)c * 32 + g) * 128 + 2 * n), ((unsigned long long)__builtin_bit_cast(unsigned, hi) << 32) | __builtin_bit_cast(unsigned, hr), RLX_AGENT);
        }
        VM_WAIT();
        if (lane == 0) __hip_atomic_store(flags + ((size_t)c * 8 + w) * 16, 1u, RLX_AGENT);
    }
    const int cs0 = (c <= 64) ? 0 : 64, npred = c - cs0;
    if (npred > 0) {
        unsigned sp = 0; bool ok = false;
        for (;;) { ok = (lane >= npred) || (__hip_atomic_load(flags + ((size_t)(cs0 + lane) * 8 + w) * 16, RLX_AGENT) != 0u);
            if (__all(ok)) break;
            __builtin_amdgcn_s_sleep(2);
            if (++sp > (1u << 20)) { if (lane == 0) __hip_atomic_store(F.ctl + CW_TMO, 0x55u, RLX_AGENT); break; } }
        __builtin_amdgcn_fence(__ATOMIC_ACQUIRE, "agent");
        VM_WAIT();
    }
#pragma unroll 1
    for (int gi = 0; gi < 4; ++gi) {
        const int g = 4 * w + gi;
        const float abr = ((const float*)(tb + TB_ABR))[g * 64 + n], abi = ((const float*)(tb + TB_ABI))[g * 64 + n];
        float hr = 0.f, hi = 0.f;
        if (npred > 0) {
            const float aLr = ((const float*)(tb + TB_ALR))[g * 64 + n], aLi = ((const float*)(tb + TB_ALI))[g * 64 + n];
            for (int cp = cs0; cp < c; cp += 8) {
                f32x2 sv[8];
#pragma unroll
                for (int j = 0; j < 8; ++j) { const int cj = (cp + j < c) ? cp + j : c - 1; sv[j] = *(const f32x2*)(SST + ((size_t)cj * 32 + g) * 128 + 2 * n); }
#pragma unroll
                for (int j = 0; j < 8; ++j) if (cp + j < c) { const float nr = aLr * hr - aLi * hi + sv[j][0], ni = aLr * hi + aLi * hr + sv[j][1]; hr = nr; hi = ni; }
            }
        }
        f32x2 bb[16];
        { const f32x4* pr = (const f32x4*)((const float*)(tb + TB_BBR) + (size_t)(g * 64 + n) * 16); const f32x4* pi = (const f32x4*)((const float*)(tb + TB_BBI) + (size_t)(g * 64 + n) * 16);
#pragma unroll
          for (int j = 0; j < 4; ++j) { const f32x4 a = pr[j], b2 = pi[j];
#pragma unroll
              for (int e = 0; e < 4; ++e) bb[4 * j + e] = (f32x2){a[e], b2[e]}; } }
        float uu[16];
        { const f32x4* pu = (const f32x4*)(U + (size_t)(row0 + lane) * 512 + 16 * g);
#pragma unroll
          for (int j = 0; j < 4; ++j) { const f32x4 a = pu[j];
#pragma unroll
              for (int e = 0; e < 4; ++e) uu[4 * j + e] = a[e]; } }
        bf16x8 cmf[4];
        { const bf16* cm = (const bf16*)(tb + TB_CMT) + (size_t)g * 16 * 128 + t16 * 128 + 8 * cq;
#pragma unroll
          for (int ks = 0; ks < 4; ++ks) cmf[ks] = *(const bf16x8*)(cm + 32 * ks); }
        const int col = 64 * w + 16 * gi + 4 * cq;
        const f32x4 dsk = *(const f32x4*)(AR.in[IN_DSKIP] + l * 512 + col);
#pragma unroll 1
        for (int half = 0; half < 2; ++half) {
            const bool samp = (c == NCHUNK - 1) && (half == 1);
#pragma unroll 1
            for (int rbase = 32 * half; rbase < 32 * half + 32; rbase += 4) {
                float h0r[4], h0i[4];
#pragma unroll
                for (int r4 = 0; r4 < 4; ++r4) { h0r[r4] = 0.f; h0i[r4] = 0.f; }
                if (samp) {
#pragma unroll
                    for (int r4 = 0; r4 < 4; ++r4) { const size_t o = ((size_t)(l * NSAMP + (rbase - 32 + r4)) * 32 + g) * 64 + n; h0r[r4] = AR.in[IN_SSMRE][o]; h0i[r4] = AR.in[IN_SSMIM][o]; }
                }
                SSM_ROWS4(
                    if (c == 64 && r == 16) { hr = 0.f; hi = 0.f; }
                    if (samp) { hr = h0r[r4]; hi = h0i[r4]; } ,
                    { const int rl = r & 31;
                      *(LAS bf16*)(Hm + SWZ(rl, n >> 3, 256) + (n & 7) * 2) = (bf16)(pk2(hr, 0.f) & 0xffffu);
                      *(LAS bf16*)(Hm + SWZ(rl, 8 + (n >> 3), 256) + (n & 7) * 2) = (bf16)(pk2(hi, 0.f) & 0xffffu);
                      if ((c == 64 && r == 15) || (c == NCHUNK - 1 && r == 31)) { const size_t o = ((size_t)(l * NBATCH + (c == 64 ? 0 : 1)) * 32 + g) * 64 + n; F.out[O_PSR + o] = hr; F.out[O_PSI + o] = hi; }
                      if (samp) { const size_t o = ((size_t)(l * NSAMP + (r - 32)) * 32 + g) * 64 + n; F.out[O_SSR + o] = hr; F.out[O_SSI + o] = hi; } } )
            }
            LDS_WAIT();
#pragma unroll
            for (int mt = 0; mt < 2; ++mt) {
                f32x4 y = {0.f, 0.f, 0.f, 0.f};
#pragma unroll
                for (int ks = 0; ks < 4; ++ks) { const bf16x8 hf = *(const LAS bf16x8*)(Hm + SWZ(16 * mt + t16, 4 * ks + cq, 256));
                    y = __builtin_amdgcn_mfma_f32_16x16x32_bf16(cmf[ks], hf, y, 0, 0, 0); }
                const int rl = 32 * half + 16 * mt + t16;
                const f32x4 uv = *(const f32x4*)(U + (size_t)(row0 + rl) * 512 + col);
                f32x4 z;
#pragma unroll
                for (int e = 0; e < 4; ++e) z[e] = gelu_tanh(y[e] + dsk[e] * uv[e]);
                *(LAS v2u*)(Zs + SWZ(rl, col >> 3, 1024) + (col & 7) * 2) = (v2u){pk2(z[0], z[1]), pk2(z[2], z[3])};
            }
            LDS_WAIT();
        }
    }
    WG_BAR();
    f32x4 G[4][4];
#pragma unroll
    for (int mt = 0; mt < 4; ++mt)
#pragma unroll
        for (int nt = 0; nt < 4; ++nt) G[mt][nt] = (f32x4){0.f, 0.f, 0.f, 0.f};
    { const bf16* Wg = (const bf16*)(ws + WS_WGLU) + (size_t)l * 512 * 512 + (size_t)(64 * w + t16) * 512 + 8 * cq;
#pragma unroll 2
      for (int ks = 0; ks < 16; ++ks) {
          bf16x8 wf[4], zf[4];
#pragma unroll
          for (int nt = 0; nt < 4; ++nt) wf[nt] = *(const bf16x8*)(Wg + (size_t)nt * 16 * 512 + 32 * ks);
#pragma unroll
          for (int mt = 0; mt < 4; ++mt) zf[mt] = *(const LAS bf16x8*)(Zs + SWZ(16 * mt + t16, 4 * ks + cq, 1024));
#pragma unroll
          for (int mt = 0; mt < 4; ++mt)
#pragma unroll
              for (int nt = 0; nt < 4; ++nt) G[mt][nt] = __builtin_amdgcn_mfma_f32_16x16x32_bf16(wf[nt], zf[mt], G[mt][nt], 0, 0, 0);
      } }
#pragma unroll
    for (int mt = 0; mt < 4; ++mt) { float ss = 0.f; const int rl = 16 * mt + t16;
#pragma unroll
        for (int nt = 0; nt < 4; ++nt) { const int col = 64 * w + 16 * nt + 4 * cq; const f32x4 bg = *(const f32x4*)(AR.in[IN_BGLU] + l * 512 + col);
            const v2u zz = *(const LAS v2u*)(Zs + SWZ(rl, col >> 3, 1024) + (col & 7) * 2);
            const float zv[4] = {bf2f((unsigned short)(zz.x & 0xffffu)), bf2f((unsigned short)(zz.x >> 16)), bf2f((unsigned short)(zz.y & 0xffffu)), bf2f((unsigned short)(zz.y >> 16))};
#pragma unroll
            for (int e = 0; e < 4; ++e) { const float o = zv[e] * sigmoidf_(G[mt][nt][e] + bg[e]); G[mt][nt][e] = o; ss += o * o; } }
        ss += __shfl_xor(ss, 16); ss += __shfl_xor(ss, 32);
        if (cq == 0) red[rl * 8 + w] = ss; }
    WG_BAR();
    { const rsrc_t rs_ = ws_rsrc(ws);
#pragma unroll
      for (int mt = 0; mt < 4; ++mt) { const int rl = 16 * mt + t16; const LAS f32x4* rp = (const LAS f32x4*)(red + rl * 8); const f32x4 a = rp[0], b2 = rp[1];
          const float rsn = rsqrtf(((a[0] + a[1]) + (a[2] + a[3]) + (b2[0] + b2[1]) + (b2[2] + b2[3])) * (1.0f / 512.0f) + EPS);
          const size_t mo = WS_MIX + ((size_t)(row0 + rl) * DM + 1024 + 64 * w + 4 * cq) * 2;
#pragma unroll
          for (int nt = 0; nt < 4; ++nt) ST8(rs_, mo + 32 * nt, ((v2u){pk2(G[mt][nt][0] * rsn, G[mt][nt][1] * rsn), pk2(G[mt][nt][2] * rsn, G[mt][nt][3] * rsn)})); } }
    WG_BAR();
}
#undef SSM_ROWS4

template <int WLEN>
__device__ __forceinline__ void pool_half(const float* XP, float* out, int l, int ch, int rfirst, int rl0, LAS unsigned char* Ds) {
    float xv[48];
#pragma unroll
    for (int i = 0; i < 48; ++i) { const int ra = rfirst + i - 16; xv[i] = (ra >= 0) ? XP[(size_t)ra * 512 + ch] : 0.f; }
    int seg = (rfirst >= TT) ? TT : 0;
    float sum = 0.f;
#pragma unroll
    for (int j = 1; j <= WLEN; ++j) if (rfirst - j >= seg) sum += xv[16 - j];
#pragma unroll
    for (int i = 0; i < 32; ++i) {
        const int ra = rfirst + i; const float x = xv[16 + i];
        if (ra == TT) { seg = TT; sum = 0.f; }
        sum += x;
        if (ra - WLEN >= seg) sum -= xv[16 + i - WLEN];
        const int cnt = (ra - seg + 1 < WLEN) ? (ra - seg + 1) : WLEN;
        const float dm = sum * __builtin_amdgcn_rcpf((float)cnt) - x;
        if (ra >= TT - 15 && ra < TT) out[O_PP + ((size_t)(l * NBATCH + 0) * 15 + (ra - (TT - 15))) * 512 + ch] = x;
        if (ra >= SROW0 - 15) out[O_PP + ((size_t)(l * NBATCH + 1) * 15 + (ra - (SROW0 - 15))) * 512 + ch] = x;
        const int r = rl0 + i;
        *(LAS bf16*)(Ds + SWZ(r, ch >> 3, 1024) + (ch & 7) * 2) = (bf16)(pk2(dm, 0.f) & 0xffffu);
    }
}
template <int WLEN>
__device__ __forceinline__ void pool_sample_rows(const float* XP, const float* sp, float* out, int l, int ch, LAS unsigned char* Ds) {
#pragma unroll 2
    for (int s = 0; s < NSAMP; ++s) {
        const float* pp = sp + (size_t)s * 15 * 512; float pv[15];
#pragma unroll
        for (int j = 0; j < 15; ++j) pv[j] = pp[(size_t)j * 512];
        const float x = XP[(size_t)(SROW0 + s) * 512 + ch]; float a = x;
#pragma unroll
        for (int j = 16 - WLEN; j < 15; ++j) a += pv[j];
        const float dm = a * (1.0f / WLEN) - x;
        float* op = out + O_SP + ((size_t)(l * NSAMP + s) * 15) * 512 + ch;
#pragma unroll
        for (int j = 0; j < 14; ++j) op[(size_t)j * 512] = pv[j + 1];
        op[(size_t)14 * 512] = x;
        *(LAS bf16*)(Ds + SWZ(32 + s, ch >> 3, 1024) + (ch & 7) * 2) = (bf16)(pk2(dm, 0.f) & 0xffffu);
    }
}
__device__ __forceinline__ void pool_unit(const Args& AR, Frame& F, int l, int c) {
    int tid_ = F.tid; asm volatile("" : "+v"(tid_));
    const int tid = tid_, lane = tid & 63, w = F.wave, t16 = lane & 15, cq = lane >> 4;
    const int row0 = 64 * c;
    unsigned char* ws = F.ws; asm volatile("" : "+s"(ws));
    const float* XP = (const float*)(ws + WS_XP);
    LAS unsigned char* Ds = F.lds;
    LAS float* red = (LAS float*)(F.lds + ESC_OFF);
    { const int ch = tid, wsel = w >> 1;
      const float* sp = AR.in[IN_SPOOL] + (size_t)l * NSAMP * 15 * 512 + ch;
#pragma unroll 1
      for (int half = 0; half < 2; ++half) {
          if (c == NCHUNK - 1 && half == 1) {
              if (wsel == 0) pool_sample_rows<2>(XP, sp, F.out, l, ch, Ds); else if (wsel == 1) pool_sample_rows<4>(XP, sp, F.out, l, ch, Ds);
              else if (wsel == 2) pool_sample_rows<8>(XP, sp, F.out, l, ch, Ds); else pool_sample_rows<16>(XP, sp, F.out, l, ch, Ds);
          } else {
              const int rfirst = row0 + 32 * half;
              if (wsel == 0) pool_half<2>(XP, F.out, l, ch, rfirst, 32 * half, Ds); else if (wsel == 1) pool_half<4>(XP, F.out, l, ch, rfirst, 32 * half, Ds);
              else if (wsel == 2) pool_half<8>(XP, F.out, l, ch, rfirst, 32 * half, Ds); else pool_half<16>(XP, F.out, l, ch, rfirst, 32 * half, Ds);
          }
      } }
    WG_BAR();
    const int gp = w & 3, rh = w >> 2;
    f32x4 A[2][8];
#pragma unroll
    for (int mt = 0; mt < 2; ++mt)
#pragma unroll
        for (int nt = 0; nt < 8; ++nt) A[mt][nt] = (f32x4){0.f, 0.f, 0.f, 0.f};
    { const bf16* Wp = (const bf16*)(ws + WS_WPOOL) + ((size_t)(l * 4 + gp) * 128 + t16) * 128 + 8 * cq;
#pragma unroll
      for (int ks = 0; ks < 4; ++ks) {
          bf16x8 df[2];
#pragma unroll
          for (int mt = 0; mt < 2; ++mt) df[mt] = *(const LAS bf16x8*)(Ds + SWZ(32 * rh + 16 * mt + t16, 16 * gp + 4 * ks + cq, 1024));
#pragma unroll
          for (int nt = 0; nt < 8; ++nt) { const bf16x8 wf = *(const bf16x8*)(Wp + (size_t)nt * 16 * 128 + 32 * ks);
#pragma unroll
              for (int mt = 0; mt < 2; ++mt) A[mt][nt] = __builtin_amdgcn_mfma_f32_16x16x32_bf16(wf, df[mt], A[mt][nt], 0, 0, 0); }
      } }
#pragma unroll
    for (int mt = 0; mt < 2; ++mt) { float ss = 0.f;
#pragma unroll
        for (int nt = 0; nt < 8; ++nt) { const f32x4 sc = *(const f32x4*)(AR.in[IN_PSCALE] + l * 512 + 128 * gp + 16 * nt + 4 * cq);
#pragma unroll
            for (int e = 0; e < 4; ++e) { const float o = A[mt][nt][e] * sc[e]; A[mt][nt][e] = o; ss += o * o; } }
        ss += __shfl_xor(ss, 16); ss += __shfl_xor(ss, 32);
        if (cq == 0) red[(32 * rh + 16 * mt + t16) * 4 + gp] = ss; }
    WG_BAR();
    { const rsrc_t rs_ = ws_rsrc(ws);
#pragma unroll
      for (int mt = 0; mt < 2; ++mt) { const int rl = 32 * rh + 16 * mt + t16; const f32x4 a = *(const LAS f32x4*)(red + rl * 4);
          const float rsn = rsqrtf(((a[0] + a[1]) + (a[2] + a[3])) * (1.0f / 512.0f) + EPS);
          const size_t mo = WS_MIX + ((size_t)(row0 + rl) * DM + 1536 + 128 * gp + 4 * cq) * 2;
#pragma unroll
          for (int nt = 0; nt < 8; ++nt) ST8(rs_, mo + 32 * nt, ((v2u){pk2(A[mt][nt][0] * rsn, A[mt][nt][1] * rsn), pk2(A[mt][nt][2] * rsn, A[mt][nt][3] * rsn)})); } }
    WG_BAR();
}

#ifndef ACQ_SCOPE
#define ACQ_SCOPE "agent"
#endif
#ifndef PUBLISH_FENCE
#define PUBLISH_FENCE 0
#endif
enum { U_END = 0, U_PA = 1, U_PC = 2, U_PD = 3, U_PE = 4, U_SSM = 5, U_ATT = 6, U_SATT = 7, U_POOL = 8 };
constexpr int NPANEL = MP / 256;
constexpr int QCAP = 1024;
__host__ __device__ constexpr unsigned mkd(int type, int l, int a, int b) { return ((unsigned)type << 24) | ((unsigned)l << 20) | ((unsigned)a << 10) | (unsigned)b; }
__device__ __forceinline__ gu32* cnt_word(gu32* ctl, int l, int kind, int pm) { return ctl + CW_CNT + ((l * 5 + kind) * 40 + pm) * 16; }
__host__ __device__ constexpr unsigned mix_target(int pm) { return 3u * (unsigned)((MR - 256 * pm) < 256 ? (MR - 256 * pm) : 256); }

__device__ __forceinline__ void build_queue(unsigned* qt, int q) {
    int n = 1;
    for (int l = 0; l < NLAYER; ++l) {
        for (int pm = 0; pm < NPANEL; ++pm) { qt[n++] = mkd(U_PA, l, pm, q); if ((pm & 7) == q) { qt[n++] = mkd(U_PA, l, pm, 8); qt[n++] = mkd(U_PA, l, pm, 9); } }
        for (int c = q; c < NCHUNK; c += 8) qt[n++] = mkd(U_SSM, l, c, 0);
        for (int i = q; i < NBATCH * NQB; i += 8) qt[n++] = mkd(U_ATT, l, i, 0);
        for (int s = q; s < NSAMP; s += 8) qt[n++] = mkd(U_SATT, l, s, 0);
        for (int c = q; c < NCHUNK; c += 8) qt[n++] = mkd(U_POOL, l, c, 0);
        for (int pm = 0; pm < NPANEL; ++pm) qt[n++] = mkd(U_PC, l, pm, q);
        for (int pm = 0; pm < NPANEL; ++pm) for (int j = 0; j < 4; ++j) qt[n++] = mkd(U_PD, l, pm, 4 * q + j);
        for (int pm = 0; pm < NPANEL; ++pm) qt[n++] = mkd(U_PE, l, pm, q);
    }
    qt[0] = (unsigned)(n - 1);
}

struct Sched {
    gu32* ctl; const unsigned* qglob; LAS unsigned* qlds; volatile LAS unsigned* slot; int myq; unsigned nclaim;
    __device__ __forceinline__ unsigned claim_lane() {
        { const unsigned idx = __hip_atomic_fetch_add(ctl + CW_QHEAD + myq * 64, 1u, RLX_AGENT); if (idx < qlds[0]) return qlds[1 + idx]; }
        for (int k = 1; k < 8; ++k) { const int q = (myq + k) & 7; const unsigned* qg = qglob + (size_t)q * QCAP;
            if (__hip_atomic_load((gu32*)(ctl + CW_QHEAD + q * 64), RLX_AGENT) >= qg[0]) continue;
            const unsigned idx = __hip_atomic_fetch_add(ctl + CW_QHEAD + q * 64, 1u, RLX_AGENT); if (idx < qg[0]) return qg[1 + idx]; }
        return 0u;
    }
    __device__ __forceinline__ unsigned claim_wg(int tid) {
        const unsigned k = nclaim++ & 1u;
        if (tid == 0) slot[k] = claim_lane();
        WG_BAR();
        return slot[k];
    }
    __device__ __forceinline__ void poll(gu32* w, unsigned want) {
        unsigned sp = 0;
        while (__hip_atomic_load(w, RLX_AGENT) < want) { __builtin_amdgcn_s_sleep(2);
            if ((++sp & 1023u) == 0u) { if (__hip_atomic_load(ctl + CW_TMO, RLX_AGENT) != 0u) break; if (sp > (1u << 17)) { __hip_atomic_store(ctl + CW_TMO, 0x66u, RLX_AGENT); break; } } }
    }
    __device__ __forceinline__ void wait_deps(unsigned d, int tid) {
        if (tid == 0) {
            const int type = d >> 24, l = (d >> 20) & 15, a = (d >> 10) & 1023;
            if (type == U_PA) { if (l > 0) { poll(cnt_word(ctl, l - 1, 4, a), 8u); const int p2 = (a + 1 < NPANEL) ? a + 1 : NPANEL - 1; poll(cnt_word(ctl, l - 1, 1, p2), mix_target(p2)); } }
            else if (type == U_PC) poll(cnt_word(ctl, l, 1, a), mix_target(a));
            else if (type == U_PD) poll(cnt_word(ctl, l, 2, a), 8u);
            else if (type == U_PE) poll(cnt_word(ctl, l, 3, a), 32u);
            else if (type == U_SSM) poll(cnt_word(ctl, l, 0, a >> 2), 10u);
            else if (type == U_POOL) { poll(cnt_word(ctl, l, 0, a >> 2), 10u); const int r0 = 64 * a - 16; if (r0 >= 0) poll(cnt_word(ctl, l, 0, r0 >> 8), 10u); }
            else if (type == U_SATT) poll(cnt_word(ctl, l, 0, NPANEL - 1), 10u);
            else if (type == U_ATT) { const int b = a / NQB, i = a % NQB, t0 = 32 * i; const int rlo = b * TT + (t0 >= 128 ? t0 - 128 : 0), rhi = b * TT + ((t0 + 31 < TT) ? t0 + 31 : TT - 1);
                poll(cnt_word(ctl, l, 0, rlo >> 8), 10u); if ((rhi >> 8) != (rlo >> 8)) poll(cnt_word(ctl, l, 0, rhi >> 8), 10u); }
            __builtin_amdgcn_fence(__ATOMIC_ACQUIRE, ACQ_SCOPE);
            asm volatile("s_waitcnt vmcnt(0)" ::: "memory");
        }
        asm volatile("" ::: "memory"); __builtin_amdgcn_s_barrier(); asm volatile("" ::: "memory");
    }
    __device__ __forceinline__ void publish(unsigned d, int tid) {
        asm volatile("s_waitcnt vmcnt(0)" ::: "memory");
        WG_BAR();
        if (tid == 0) {
            const int type = d >> 24, l = (d >> 20) & 15, a = (d >> 10) & 1023;
#if PUBLISH_FENCE
            __builtin_amdgcn_fence(__ATOMIC_RELEASE, "agent");
            asm volatile("s_waitcnt vmcnt(0)" ::: "memory");
#endif
            if (type == U_PA) __hip_atomic_fetch_add(cnt_word(ctl, l, 0, a), 1u, RLX_AGENT);
            else if (type == U_PC) __hip_atomic_fetch_add(cnt_word(ctl, l, 2, a), 1u, RLX_AGENT);
            else if (type == U_PD) __hip_atomic_fetch_add(cnt_word(ctl, l, 3, a), 1u, RLX_AGENT);
            else if (type == U_PE) __hip_atomic_fetch_add(cnt_word(ctl, l, 4, a), 1u, RLX_AGENT);
            else if (type == U_SSM || type == U_POOL) __hip_atomic_fetch_add(cnt_word(ctl, l, 1, a >> 2), 64u, RLX_AGENT);
            else if (type == U_SATT) __hip_atomic_fetch_add(cnt_word(ctl, l, 1, NPANEL - 1), 1u, RLX_AGENT);
            else if (type == U_ATT) { const int b = a / NQB, i = a % NQB, t0 = 32 * i; const int r0 = b * TT + t0, r1 = b * TT + ((t0 + 31 < TT) ? t0 + 31 : TT - 1);
                const int p0 = r0 >> 8, p1 = r1 >> 8;
                if (p0 == p1) __hip_atomic_fetch_add(cnt_word(ctl, l, 1, p0), (unsigned)(r1 - r0 + 1), RLX_AGENT);
                else { __hip_atomic_fetch_add(cnt_word(ctl, l, 1, p0), (unsigned)(256 * p1 - r0), RLX_AGENT); __hip_atomic_fetch_add(cnt_word(ctl, l, 1, p1), (unsigned)(r1 - 256 * p1 + 1), RLX_AGENT); } }
        }
    }
};

#ifndef A_AUX
#define A_AUX 0
#endif
struct GU { const char* A; const char* B; unsigned voffA[2], voffB[2]; size_t hstep; int nt; unsigned d; pg8::Unit u; };

struct StreamCtx { unsigned char* ws; float* out; const float* gq; const float* gk; int R[2], C[2], Rp[2]; };
__device__ __forceinline__ void gu_fill(GU& g, unsigned d, const StreamCtx& X) {
    const int type = d >> 24, l = (d >> 20) & 15, pm = (d >> 10) & 1023, pn = d & 1023;
    unsigned char* ws = X.ws;
    const bf16* A; const bf16* B; int K = DM; bool perm = false;
    if (type == U_PA) { A = (const bf16*)(ws + WS_XB); B = (const bf16*)(ws + WS_WIN) + (size_t)l * INW * DM; }
    else if (type == U_PC) { A = (const bf16*)(ws + WS_MIX); B = (const bf16*)(ws + WS_WOUT) + (size_t)l * DM * DM; }
    else if (type == U_PD) { A = (const bf16*)(ws + WS_XB); B = (const bf16*)(ws + WS_W1) + (size_t)l * DFF * DM; perm = true; }
    else { A = (const bf16*)(ws + WS_H); B = (const bf16*)(ws + WS_W2) + (size_t)l * DM * DFF; K = DFF; }
    g.d = d; g.u.pm = pm; g.u.pn = pn; g.nt = K / 64; g.hstep = (size_t)128 * K * 2;
    g.A = (const char*)A + (size_t)pm * 256 * K * 2; g.B = (const char*)B + (size_t)pn * 256 * K * 2;
#pragma unroll
    for (int i = 0; i < 2; ++i) { g.voffA[i] = (unsigned)(X.R[i] * K + X.C[i]) * 2u; g.voffB[i] = (unsigned)((perm ? X.Rp[i] : X.R[i]) * K + X.C[i]) * 2u; }
}

__device__ __forceinline__ unsigned gemm_stream(const Args& AR, Frame& F, Sched& Q, unsigned d0) {
    int tid_ = threadIdx.x; asm volatile("" : "+v"(tid_));
    const int tid = tid_, wid = __builtin_amdgcn_readfirstlane(tid >> 6), lane = tid & 63, wr = wid >> 2, wc = wid & 3, fr = lane & 15, fq = lane >> 4;
    LAS unsigned char* lds = F.lds; LAS unsigned char* esc = F.lds + ESC_OFF;
    StreamCtx X; X.ws = F.ws; X.out = F.out;
#pragma unroll
    for (int i = 0; i < 2; ++i) { int R, C; pg8::stage_rc(tid * 16 + i * 8192, R, C); X.R[i] = R; X.C[i] = C; X.Rp[i] = (R & ~31) + pg8::perm32(R & 31); }
    const size_t kstep = (size_t)(pg8::BK * 2);
    const unsigned ldsw = (unsigned)wid * 1024u;
    const int aoff = pg8::lds_byte(wr * 64 + fr, fq * 8), boff = pg8::lds_byte(wc * 32 + fr, fq * 8);
#define PG8_SA(b, h) (((b) * 2 + (h)) * pg8::HTB)
#define PG8_SB(b, h) ((4 + (b) * 2 + (h)) * pg8::HTB)
#define PG8_STAGE(bufoff, gbase, voff) do { _Pragma("unroll") for (int _i = 0; _i < 2; ++_i) \
        __builtin_amdgcn_global_load_lds((const unsigned*)((const char*)(gbase) + (voff)[_i]), (LAS unsigned*)(lds + (bufoff) + ldsw + _i * 8192), 16, 0, 0); } while (0)
#define PG8_STAGE_A(bufoff, gbase, voff) do { _Pragma("unroll") for (int _i = 0; _i < 2; ++_i) \
        __builtin_amdgcn_global_load_lds((const unsigned*)((const char*)(gbase) + (voff)[_i]), (LAS unsigned*)(lds + (bufoff) + ldsw + _i * 8192), 16, 0, A_AUX); } while (0)
#define PG8_LDA(dst, b, h) do { _Pragma("unroll") for (int m = 0; m < 4; ++m) _Pragma("unroll") for (int k = 0; k < 2; ++k) dst[m][k] = *(const LAS bf16x8*)(lds + PG8_SA(b, h) + aoff + m * 2048 + k * 1024); } while (0)
#define PG8_LDB(dst, b, h) do { _Pragma("unroll") for (int n = 0; n < 2; ++n) _Pragma("unroll") for (int k = 0; k < 2; ++k) dst[n][k] = *(const LAS bf16x8*)(lds + PG8_SB(b, h) + boff + n * 2048 + k * 1024); } while (0)
#define PG8_MMA(ai, bj, At, Bt) do { __builtin_amdgcn_s_setprio(1); _Pragma("unroll") for (int m = 0; m < 4; ++m) _Pragma("unroll") for (int n = 0; n < 2; ++n) _Pragma("unroll") for (int k = 0; k < 2; ++k) \
        acc[ai][bj][m][n] = __builtin_amdgcn_mfma_f32_16x16x32_bf16(Bt[n][k], At[m][k], acc[ai][bj][m][n], 0, 0, 0); __builtin_amdgcn_s_setprio(0); } while (0)
#define PG8_WAIT_V(n) asm volatile("s_waitcnt vmcnt(" #n ")" ::: "memory")
#define PG8_WAIT_L(n) asm volatile("s_waitcnt lgkmcnt(" #n ")" ::: "memory")
#define PG8_BAR __builtin_amdgcn_s_barrier()
#define PG8_SCHED __builtin_amdgcn_sched_barrier(0)
    GU cur, nxt;
    gu_fill(cur, d0, X);
    f32x4 acc[2][2][4][2];
#pragma unroll
    for (int a = 0; a < 2; ++a)
#pragma unroll
        for (int b = 0; b < 2; ++b)
#pragma unroll
            for (int m = 0; m < 4; ++m)
#pragma unroll
                for (int n = 0; n < 2; ++n) acc[a][b][m][n] = (f32x4){0.f, 0.f, 0.f, 0.f};
    bf16x8 At[4][2], B0[2][2], B1[2][2];
    Q.wait_deps(cur.d, tid);
    PG8_STAGE(PG8_SB(0, 0), cur.B, cur.voffB); PG8_STAGE(PG8_SB(0, 1), cur.B + cur.hstep, cur.voffB); PG8_STAGE_A(PG8_SA(0, 0), cur.A, cur.voffA); PG8_STAGE_A(PG8_SA(0, 1), cur.A + cur.hstep, cur.voffA);
    if (wr == 1) PG8_BAR;
    PG8_WAIT_V(2); PG8_BAR;
    PG8_STAGE(PG8_SB(1, 0), cur.B + kstep, cur.voffB); PG8_STAGE_A(PG8_SA(1, 0), cur.A + kstep, cur.voffA); PG8_STAGE(PG8_SB(1, 1), cur.B + cur.hstep + kstep, cur.voffB);
    PG8_WAIT_V(6); PG8_BAR;
    unsigned carry = 0u; unsigned ui = 0u;
    for (;;) {
        { const unsigned k = 2u + (ui & 1u);
          if (tid == 0) Q.slot[k] = Q.claim_lane();
          asm volatile("s_waitcnt lgkmcnt(0)" ::: "memory"); PG8_BAR; asm volatile("" ::: "memory");
          carry = Q.slot[k]; }
        const bool has_next = (carry >> 24) >= U_PA && (carry >> 24) <= U_PE && (!STREAM_SAME_SECTION || ((carry >> 20) == (cur.d >> 20)));
        if (has_next) gu_fill(nxt, carry, X); else nxt = cur;
        const char* cA = cur.A; const char* cB = cur.B; const size_t hstep = cur.hstep; const int nt = cur.nt;
        for (int t = 0; t < nt; t += 2) {
            const bool last = (t == nt - 2);
            const char* a1 = cA + (size_t)(t + 1) * kstep;
            const char* a2 = last ? nxt.A : cA + (size_t)(t + 2) * kstep; const char* b2 = last ? nxt.B : cB + (size_t)(t + 2) * kstep;
            const char* a3 = a2 + kstep; const char* b3 = b2 + kstep;
            const size_t h2 = last ? nxt.hstep : hstep;
            unsigned vA2[2], vB2[2];
#pragma unroll
            for (int i = 0; i < 2; ++i) { vA2[i] = last ? nxt.voffA[i] : cur.voffA[i]; vB2[i] = last ? nxt.voffB[i] : cur.voffB[i]; }
            if (last && has_next) Q.wait_deps(nxt.d, tid);
            PG8_LDB(B0, 0, 0); PG8_LDB(B1, 0, 1); PG8_SCHED; PG8_LDA(At, 0, 0); PG8_STAGE_A(PG8_SA(1, 1), a1 + hstep, cur.voffA);
            PG8_WAIT_V(8); PG8_WAIT_L(0); PG8_BAR; PG8_MMA(0, 0, At, B0); PG8_MMA(0, 1, At, B1); PG8_BAR; PG8_SCHED;
            PG8_LDA(At, 0, 1); PG8_STAGE(PG8_SB(0, 0), b2, vB2); PG8_STAGE(PG8_SB(0, 1), b2 + h2, vB2); PG8_STAGE_A(PG8_SA(0, 0), a2, vA2);
            PG8_WAIT_V(8); PG8_WAIT_L(0); PG8_BAR; PG8_MMA(1, 0, At, B0); PG8_MMA(1, 1, At, B1); PG8_BAR; PG8_SCHED;
            PG8_LDB(B0, 1, 0); PG8_LDB(B1, 1, 1); PG8_SCHED; PG8_LDA(At, 1, 0); PG8_STAGE_A(PG8_SA(0, 1), a2 + h2, vA2);
            PG8_WAIT_V(8); PG8_WAIT_L(0); PG8_BAR; PG8_MMA(0, 0, At, B0); PG8_MMA(0, 1, At, B1); PG8_BAR; PG8_SCHED;
            PG8_LDA(At, 1, 1); PG8_STAGE(PG8_SB(1, 0), b3, vB2); PG8_STAGE(PG8_SB(1, 1), b3 + h2, vB2); PG8_STAGE_A(PG8_SA(1, 0), a3, vA2);
            PG8_WAIT_V(8); PG8_WAIT_L(0); PG8_BAR; PG8_MMA(1, 0, At, B0); PG8_MMA(1, 1, At, B1); PG8_BAR; PG8_SCHED;
        }
        if (wr == 0) PG8_BAR;
        { const int type = cur.d >> 24, l = (cur.d >> 20) & 15;
          if (type == U_PA) { EpiProj E{X.ws, X.out, AR.in[IN_GQ] + l * 128, AR.in[IN_GK] + l * 128, l}; E(acc, cur.u, wr, wc, fr, fq, esc, tid); }
          else if (type == U_PD) { EpiFfn1 E{X.ws}; E(acc, cur.u, wr, wc, fr, fq, esc, tid); }
          else { EpiRes E{X.ws, X.out, (type == U_PE && l == NLAYER - 1) ? 1 : 0}; E(acc, cur.u, wr, wc, fr, fq, esc, tid); }
          Q.publish(cur.d, tid); }
        if (!has_next) break;
#pragma unroll
        for (int a = 0; a < 2; ++a)
#pragma unroll
            for (int b = 0; b < 2; ++b)
#pragma unroll
                for (int m = 0; m < 4; ++m)
#pragma unroll
                    for (int n = 0; n < 2; ++n) acc[a][b][m][n] = (f32x4){0.f, 0.f, 0.f, 0.f};
        cur = nxt; ++ui;
        if (wr == 1) PG8_BAR;
    }
    PG8_WAIT_V(0);
    PG8_BAR;
#undef PG8_SA
#undef PG8_SB
#undef PG8_STAGE
#undef PG8_STAGE_A
#undef PG8_LDA
#undef PG8_LDB
#undef PG8_MMA
#undef PG8_WAIT_V
#undef PG8_WAIT_L
#undef PG8_BAR
#undef PG8_SCHED
    return carry;
}

__global__ void __launch_bounds__(512, 2) hymba_fwd(Args args) {
    extern __shared__ __attribute__((aligned(16))) unsigned char lds[];
    Frame F;
    F.lds = (LAS unsigned char*)lds;
    F.MISC = (volatile LAS unsigned*)(F.lds + MISC_OFF);
    F.tid = threadIdx.x; F.lane = F.tid & 63; F.wave = __builtin_amdgcn_readfirstlane(F.tid >> 6);
    F.G = gridDim.x; { const int bx = blockIdx.x; F.vcu = (F.G % 8 == 0) ? (bx % 8) * (F.G / 8) + bx / 8 : bx; }
    F.ws = args.ws; F.out = args.out; F.ctl = (gu32*)(args.ws + WS_CTL);
    for (int u = F.tid; u < (LDS_BYTES - LDSCTL_OFF) / 4; u += 512) ((LAS unsigned*)(F.lds + LDSCTL_OFF))[u] = 0u;
    __syncthreads();
    XcdBarrier bar = xcd_barrier_post((unsigned*)(F.ctl + CW_BAR), F.MISC + 8);
    for (int rep = 0; rep < DUP_P0; ++rep) p0_prologue(args, F);
    if (blockIdx.x < 8 && F.tid == 0) build_queue((unsigned*)(args.ws + WS_QUEUE) + (size_t)blockIdx.x * QCAP, (int)blockIdx.x);
    xcd_barrier(bar);
    Sched Q; Q.ctl = F.ctl; Q.qglob = (const unsigned*)(args.ws + WS_QUEUE); Q.qlds = (LAS unsigned*)(F.lds + QTAB_OFF); Q.slot = F.MISC; Q.myq = (int)(bar.x & 7u); Q.nclaim = 0u;
    { const unsigned* qg = Q.qglob + (size_t)Q.myq * QCAP; for (int i = F.tid; i < QCAP; i += 512) Q.qlds[i] = qg[i]; }
    WG_BAR();
    unsigned d = Q.claim_wg(F.tid);
#if SEC_BARRIER
    int cursec = 0;
#endif
    for (;;) {
        const int type = d >> 24;
#if SEC_BARRIER
        { const int sec = (type == U_END) ? 5 * NLAYER : ((d >> 20) & 15) * 5 + ((type >= U_SSM) ? 1 : (type == U_PA ? 0 : type));
          while (cursec < sec) { if ((SEC_MASK >> cursec) & 1) xcd_barrier(bar); ++cursec; } }
#endif
        if (type == U_END) break;
        if (type <= U_PE) { d = gemm_stream(args, F, Q, d); continue; }
        const int l = (d >> 20) & 15, a = (d >> 10) & 1023;
        Q.wait_deps(d, F.tid);
        if (type == U_SSM) ssm_unit(args, F, l, a);
        else if (type == U_ATT) attn_unit(args, F, l, a / NQB, a % NQB);
        else if (type == U_SATT) sattn_unit(args, F, l, a);
        else pool_unit(args, F, l, a);
        Q.publish(d, F.tid);
        d = Q.claim_wg(F.tid);
    }
}

extern "C" void kernel_launch(void* const* d_in, const int* in_sizes, int n_in, void* d_out, int out_size, void* d_ws, size_t ws_size, hipStream_t stream) {
    static int grid = 0;
    if (grid == 0) {
        if (n_in != 32 || (size_t)out_size != O_END || ws_size < WS_END) { fprintf(stderr, "kernel_launch: unexpected shapes: n_in %d out %d (want %zu) ws %zu (want >= %zu)\n", n_in, out_size, (size_t)O_END, ws_size, (size_t)WS_END); grid = -1; return; }
        int dev = 0, cus = 0, per_cu = 0;
        if (hipGetDevice(&dev) != hipSuccess || hipDeviceGetAttribute(&cus, hipDeviceAttributeMultiprocessorCount, dev) != hipSuccess) { fprintf(stderr, "kernel_launch: device query failed\n"); grid = -1; return; }
        if (hipFuncSetAttribute((const void*)hymba_fwd, hipFuncAttributeMaxDynamicSharedMemorySize, LDS_BYTES) != hipSuccess) { fprintf(stderr, "kernel_launch: hipFuncSetAttribute failed\n"); grid = -1; return; }
        if (hipOccupancyMaxActiveBlocksPerMultiprocessor(&per_cu, (const void*)hymba_fwd, 512, LDS_BYTES) != hipSuccess || per_cu < 1) { fprintf(stderr, "kernel_launch: occupancy query says %d blocks per CU\n", per_cu); per_cu = 1; }
        (void)hipGetLastError();
        grid = cus;
        if (grid % 8 != 0) grid -= grid % 8;
    }
    if (grid < 0) return;
    (void)hipMemsetAsync((char*)d_ws + WS_CTL, 0, CTL_ZERO_BYTES, stream);
    Args a{};
    for (int i = 0; i < 32; ++i) a.in[i] = (const float*)d_in[i];
    a.out = (float*)d_out; a.ws = (unsigned char*)d_ws; a.ph_lo = 0; a.ph_hi = 0;
    hipLaunchKernelGGL(hymba_fwd, dim3(grid), dim3(512), LDS_BYTES, stream, a);
    const hipError_t le = hipPeekAtLastError();
    if (le != hipSuccess) fprintf(stderr, "kernel_launch: launch failed: %s\n", hipGetErrorName(le));
}
```

```cpp
#include <hip/hip_runtime.h>
#include <cstdio>
#include <cstdint>

#ifndef MK_N_LAUNCHES
#define MK_N_LAUNCHES 1
#endif

#ifndef SEC_BARRIER
#define SEC_BARRIER 0
#endif
#ifndef STREAM_SAME_SECTION
#define STREAM_SAME_SECTION 1
#endif
#ifndef SEC_MASK
#define SEC_MASK 0x10
#endif
#ifndef DUP_PB
#define DUP_PB 1
#endif
#ifndef DUP_P0
#define DUP_P0 1
#endif

constexpr int DM = 2048, TT = 4112  , NSEQ = 4096, NMETA = 16, NBATCH = 2, NSAMP = 32;
constexpr int MR = NBATCH * TT + NSAMP;
constexpr int MP = 8448;
constexpr int SROW0 = NBATCH * TT;
constexpr int INW = 2560, DFF = 8192, NLAYER = 2;
constexpr int TPV = 4128;
constexpr int ROPE_SAMPLE_IDX = TT;
constexpr float EPS = 1e-6f;
constexpr float LOG2E = 1.4426950408889634f;
constexpr float QSCALE = 0.08838834764831845f * LOG2E;
constexpr int NCHUNK = MR / 64;
constexpr int NQB = (TT + 31) / 32;

constexpr size_t O_YP = 0, O_YS = O_YP + (size_t)NBATCH * NSEQ * DM, O_PK = O_YS + (size_t)NSAMP * DM, O_PV = O_PK + (size_t)NLAYER * NBATCH * 128 * 256,
                 O_PSR = O_PV + (size_t)NLAYER * NBATCH * 128 * 256, O_PSI = O_PSR + (size_t)NLAYER * NBATCH * 2048, O_PP = O_PSI + (size_t)NLAYER * NBATCH * 2048,
                 O_SK = O_PP + (size_t)NLAYER * NBATCH * 15 * 512, O_SV = O_SK + (size_t)NLAYER * NSAMP * 128 * 256, O_SSR = O_SV + (size_t)NLAYER * NSAMP * 128 * 256,
                 O_SSI = O_SSR + (size_t)NLAYER * NSAMP * 2048, O_SP = O_SSI + (size_t)NLAYER * NSAMP * 2048, O_END = O_SP + (size_t)NLAYER * NSAMP * 15 * 512;

constexpr size_t MiB = 1u << 20;
constexpr size_t WS_CTL = 0, CTL_ZERO_BYTES = 1 * MiB;
constexpr size_t WS_WIN = 1 * MiB, WS_WOUT = 21 * MiB, WS_W1 = 37 * MiB, WS_W2 = 101 * MiB, WS_WGLU = 165 * MiB, WS_WPOOL = 166 * MiB, WS_TAB = 167 * MiB;
constexpr size_t WS_X = 170 * MiB, WS_XB = 236 * MiB, WS_Q = 269 * MiB, WS_K = 286 * MiB, WS_VT = 291 * MiB, WS_U = 296 * MiB, WS_XP = 313 * MiB, WS_MIX = 330 * MiB,
                 WS_H = 363 * MiB, WS_SSQ = 495 * MiB, WS_SST = 497 * MiB, WS_KSN = 502 * MiB, WS_QUEUE = 503 * MiB, WS_END = 504 * MiB;
static_assert(WS_WIN + (size_t)NLAYER * INW * DM * 2 <= WS_WOUT && WS_WOUT + (size_t)NLAYER * DM * DM * 2 <= WS_W1 && WS_W1 + (size_t)NLAYER * DFF * DM * 2 <= WS_W2 && WS_W2 + (size_t)NLAYER * DFF * DM * 2 <= WS_WGLU, "ws map 1");
static_assert(WS_X + (size_t)MP * DM * 4 <= WS_XB && WS_XB + (size_t)MP * DM * 2 <= WS_Q && WS_Q + (size_t)MP * 1024 * 2 <= WS_K && WS_K + (size_t)MP * 256 * 2 <= WS_VT && WS_VT + (size_t)4 * 128 * TPV * 2 <= WS_U, "ws map 2");
static_assert(WS_U + (size_t)MP * 512 * 4 <= WS_XP && WS_XP + (size_t)MP * 512 * 4 <= WS_MIX && WS_MIX + (size_t)MP * DM * 2 <= WS_H && WS_H + (size_t)MP * DFF * 2 <= WS_SSQ && WS_SSQ + (size_t)MP * 32 * 4 <= WS_SST, "ws map 3");
static_assert(WS_SST + (size_t)NLAYER * NCHUNK * 32 * 64 * 8 <= WS_KSN, "ws map 4");
constexpr size_t TB_ABR = 0, TB_ABI = 8192, TB_ALR = 16384, TB_ALI = 24576, TB_A16R = 32768, TB_A16I = 40960, TB_A32R = 49152, TB_A32I = 57344,
                 TB_BBR = 65536, TB_BBI = TB_BBR + 131072, TB_PM = TB_BBI + 131072, TB_CMT = TB_PM + 524288, TB_LAYER = 1 * MiB;
static_assert(TB_CMT + 131072 <= TB_LAYER, "table map");
constexpr size_t WS_ROPE = WS_TAB + 2 * MiB;
constexpr size_t ROPE_N = (size_t)(TT + 1) * 16;
constexpr int CW_TMO = 0, CW_CODE = 1, CW_BAR = 4096, CW_QHEAD = 8192  , CW_CNT = 9216  , CW_SSMF = 16384  ;
static_assert(CW_CNT + NLAYER * 5 * 40 * 16 <= CW_SSMF, "ctl map: counters");
static_assert((CW_SSMF + NLAYER * NCHUNK * 8 * 16) * 4 <= (int)CTL_ZERO_BYTES, "ctl map");

constexpr int RING_BYTES = 131072, ESC_OFF = RING_BYTES  , QTAB_OFF = ESC_OFF + 12288  , LDSCTL_OFF = QTAB_OFF + 4096, MISC_OFF = LDSCTL_OFF + 320, LDS_BYTES = 148480;
static_assert(MISC_OFF + 128 <= LDS_BYTES, "LDS map");

#define GAS __attribute__((address_space(1)))
#define LAS __attribute__((address_space(3)))
typedef unsigned short bf16;
typedef unsigned v4u __attribute__((ext_vector_type(4)));
typedef unsigned v2u __attribute__((ext_vector_type(2)));
typedef float f32x2 __attribute__((ext_vector_type(2)));
typedef float f32x16 __attribute__((ext_vector_type(16)));
typedef __bf16 bf16x2_t __attribute__((ext_vector_type(2)));
typedef GAS unsigned gu32;
typedef GAS unsigned long long gu64;
#define RLX_AGENT __ATOMIC_RELAXED, __HIP_MEMORY_SCOPE_AGENT
#define LDS_WAIT() asm volatile("s_waitcnt lgkmcnt(0)" ::: "memory")
#define VM_WAIT() asm volatile("s_waitcnt vmcnt(0)" ::: "memory")
#define WG_BAR() do { asm volatile("s_waitcnt lgkmcnt(0)" ::: "memory"); __builtin_amdgcn_s_barrier(); asm volatile("" ::: "memory"); } while (0)
__device__ __forceinline__ unsigned pk2(float lo, float hi) { f32x2 v = {lo, hi}; bf16x2_t b = __builtin_convertvector(v, bf16x2_t); return __builtin_bit_cast(unsigned, b); }
__device__ __forceinline__ float bf2f(unsigned short h) { return __builtin_bit_cast(float, (unsigned)h << 16); }
__device__ __forceinline__ float wave_sum(float v) {
#pragma unroll
    for (int o = 1; o < 64; o <<= 1) v += __shfl_xor(v, o);
    return v;
}
__device__ __forceinline__ float wave_max(float v) {
#pragma unroll
    for (int o = 1; o < 64; o <<= 1) v = fmaxf(v, __shfl_xor(v, o));
    return v;
}

typedef __amdgpu_buffer_rsrc_t rsrc_t;
__device__ __forceinline__ rsrc_t ws_rsrc(unsigned char* ws) { return __builtin_amdgcn_make_buffer_rsrc(ws, 0, (int)WS_END, 0x00020000); }
#define ST16(r, off, v) __builtin_amdgcn_raw_buffer_store_b128(__builtin_bit_cast(v4u, (v)), (r), (unsigned)(off), 0, 16)
#define ST8(r, off, v)  __builtin_amdgcn_raw_buffer_store_b64((v), (r), (unsigned)(off), 0, 16)
#define ST4(r, off, v)  __builtin_amdgcn_raw_buffer_store_b32(__builtin_bit_cast(unsigned, (v)), (r), (unsigned)(off), 0, 16)
#define ST2(r, off, v)  __builtin_amdgcn_raw_buffer_store_b16((unsigned short)(v), (r), (unsigned)(off), 0, 16)
__host__ __device__ __forceinline__ int perm16(int o) { return 8 * ((o >> 2) & 1) + 4 * (o >> 3) + (o & 3); }

namespace pg8 {
#define PG8_LAS __attribute__((address_space(3)))
typedef unsigned short bf16_t;
typedef short bf16x8 __attribute__((ext_vector_type(8)));
typedef float f32x4 __attribute__((ext_vector_type(4)));
typedef unsigned u32x4 __attribute__((ext_vector_type(4)));
constexpr int BM = 256, BK = 64, HALF = 128, HTB = HALF * BK * 2  , STAGE_BYTES = 8 * HTB, NXCD = 8, WGM = 8;

__host__ __device__ __forceinline__ int lds_byte(int r, int c) { const int st = (r >> 4) * 2 + (c >> 5), rr = r & 15, cc = c & 31, ob = rr * 64 + cc * 2; return st * 1024 + (ob ^ (((ob >> 9) & 1) << 5)); }
__host__ __device__ __forceinline__ void stage_rc(int b, int& R, int& C) { const int st = b / 1024, sb = b % 1024, swz = sb ^ (((sb >> 9) & 1) << 5); R = (st >> 1) * 16 + swz / 64; C = (st & 1) * 32 + (swz % 64) / 2; }
__host__ __device__ __forceinline__ int perm32(int rho) { const int n = rho >> 4, i = rho & 15; return 8 * (i >> 2) + 4 * n + (i & 3); }

struct Unit { int pm, pn; };
struct Gemm { const bf16_t* A; const bf16_t* Bt; int M, N, K; };

struct StaticOrder {
    int nM, nN, nwg, G, c;
    __host__ __device__ void init(int M, int N, int G_, int c_) { nM = M / BM; nN = N / BM; nwg = nM * nN; G = G_; c = c_; }
    __host__ __device__ bool next(int i, Unit& u) const {
        const long L = (long)i * G + c; if (L >= nwg) return false;
        int wgid = (int)L; { const int q = nwg / NXCD, r = nwg % NXCD, xcd = wgid % NXCD, off = wgid / NXCD; wgid = (xcd < r ? xcd * (q + 1) : r * (q + 1) + (xcd - r) * q) + off; }
        const int nig = WGM * nN, gid = wgid / nig, fm = gid * WGM, gsz = (nM - fm) < WGM ? (nM - fm) : WGM;
        u.pm = fm + ((wgid % nig) % gsz); u.pn = (wgid % nig) / gsz; return true;
    }
    __device__ __forceinline__ void a_ready(const Unit&) const {}
    __device__ __forceinline__ void done(const Unit&) const {}
};


template <class Epi, class Sched, bool ALIGN_EPI = false, bool SP2 = false>
__device__ __forceinline__ void gemm_phase(PG8_LAS unsigned char* lds, PG8_LAS unsigned char* esc, const Gemm g, const Sched& S, const Epi& E) {
    int tid_ = threadIdx.x; asm volatile("" : "+v"(tid_));
    const int tid = tid_, wid = __builtin_amdgcn_readfirstlane(tid >> 6), lane = tid & 63, wr = wid >> 2, wc = wid & 3, fr = lane & 15, fq = lane >> 4;
    const int K = g.K, nt = K / BK;
    unsigned voffA[2], voffB[2];
#pragma unroll
    for (int i = 0; i < 2; ++i) { int R, C; stage_rc(tid * 16 + i * 8192, R, C); const int Rb = Epi::PERM ? ((R & ~31) + perm32(R & 31)) : R;
        voffA[i] = (unsigned)(R * K + C) * 2u; voffB[i] = (unsigned)(Rb * K + C) * 2u; }
    const size_t kstep = (size_t)(BK * 2);
    const size_t hstep = (size_t)HALF * K * 2;
    const size_t tstep = 2 * hstep;
    const unsigned ldsw = (unsigned)wid * 1024u;
    const int aoff = lds_byte(wr * 64 + fr, fq * 8), boff = lds_byte(wc * 32 + fr, fq * 8);
#define PG8_SA(b, h) (((b) * 2 + (h)) * HTB)
#define PG8_SB(b, h) ((4 + (b) * 2 + (h)) * HTB)
#define PG8_STAGE(bufoff, gbase, voff) do { _Pragma("unroll") for (int _i = 0; _i < 2; ++_i) \
        __builtin_amdgcn_global_load_lds((const unsigned*)((const char*)(gbase) + (voff)[_i]), (PG8_LAS unsigned*)(lds + (bufoff) + ldsw + _i * 8192), 16, 0, 0); } while (0)
#define PG8_LDA(dst, b, h) do { _Pragma("unroll") for (int m = 0; m < 4; ++m) _Pragma("unroll") for (int k = 0; k < 2; ++k) dst[m][k] = *(const PG8_LAS bf16x8*)(lds + PG8_SA(b, h) + aoff + m * 2048 + k * 1024); } while (0)
#define PG8_LDB(dst, b, h) do { _Pragma("unroll") for (int n = 0; n < 2; ++n) _Pragma("unroll") for (int k = 0; k < 2; ++k) dst[n][k] = *(const PG8_LAS bf16x8*)(lds + PG8_SB(b, h) + boff + n * 2048 + k * 1024); } while (0)
#define PG8_MMA(ai, bj, At, Bt) do { __builtin_amdgcn_s_setprio(1); _Pragma("unroll") for (int m = 0; m < 4; ++m) _Pragma("unroll") for (int n = 0; n < 2; ++n) _Pragma("unroll") for (int k = 0; k < 2; ++k) \
        acc[ai][bj][m][n] = __builtin_amdgcn_mfma_f32_16x16x32_bf16(Bt[n][k], At[m][k], acc[ai][bj][m][n], 0, 0, 0); __builtin_amdgcn_s_setprio(0); } while (0)
#define PG8_WAIT_V(n) asm volatile("s_waitcnt vmcnt(" #n ")" ::: "memory")
#define PG8_WAIT_L(n) asm volatile("s_waitcnt lgkmcnt(" #n ")" ::: "memory")
#define PG8_BAR __builtin_amdgcn_s_barrier()
#define PG8_SCHED __builtin_amdgcn_sched_barrier(0)
    Unit cur, nxt; int ui = 0;
    if (!S.next(0, cur)) return;
    f32x4 acc[2][2][4][2];
#pragma unroll
    for (int a = 0; a < 2; ++a)
#pragma unroll
        for (int b = 0; b < 2; ++b)
#pragma unroll
            for (int m = 0; m < 4; ++m)
#pragma unroll
                for (int n = 0; n < 2; ++n) acc[a][b][m][n] = (f32x4){0.f, 0.f, 0.f, 0.f};
    bf16x8 At[4][2], B0[2][2], B1[2][2];
    const char* cA = (const char*)g.A + (size_t)cur.pm * tstep; const char* cB = (const char*)g.Bt + (size_t)cur.pn * tstep;
    S.a_ready(cur);
    if constexpr (SP2) {
        PG8_STAGE(PG8_SB(0, 0), cB, voffB); PG8_STAGE(PG8_SB(0, 1), cB + hstep, voffB); PG8_STAGE(PG8_SA(0, 0), cA, voffA); PG8_STAGE(PG8_SA(0, 1), cA + hstep, voffA);
        if (wr == 1) PG8_BAR;
        PG8_WAIT_V(2); PG8_BAR;
        PG8_STAGE(PG8_SB(1, 0), cB + kstep, voffB); PG8_STAGE(PG8_SA(1, 0), cA + kstep, voffA); PG8_STAGE(PG8_SB(1, 1), cB + hstep + kstep, voffB);
        PG8_WAIT_V(6); PG8_BAR;
    } else {
        PG8_STAGE(PG8_SB(0, 0), cB, voffB); PG8_STAGE(PG8_SA(0, 0), cA, voffA); PG8_STAGE(PG8_SB(0, 1), cB + hstep, voffB); PG8_STAGE(PG8_SA(0, 1), cA + hstep, voffA);
        if (wr == 1) PG8_BAR;
        PG8_WAIT_V(4); PG8_BAR;
        PG8_STAGE(PG8_SB(1, 0), cB + kstep, voffB); PG8_STAGE(PG8_SA(1, 0), cA + kstep, voffA); PG8_STAGE(PG8_SB(1, 1), cB + hstep + kstep, voffB);
        PG8_WAIT_V(6); PG8_BAR;
    }
    for (;;) {
        const bool has_next = S.next(ui + 1, nxt);
        const char* nA = has_next ? (const char*)g.A + (size_t)nxt.pm * tstep : cA; const char* nB = has_next ? (const char*)g.Bt + (size_t)nxt.pn * tstep : cB;
        for (int t = 0; t < nt; t += 2) {
            const bool last = (t == nt - 2);
            const char* a1 = cA + (size_t)(t + 1) * kstep;
            const char* a2 = last ? nA : cA + (size_t)(t + 2) * kstep; const char* b2 = last ? nB : cB + (size_t)(t + 2) * kstep;
            const char* a3 = a2 + kstep; const char* b3 = b2 + kstep;
            if (last && has_next) S.a_ready(nxt);
            if constexpr (SP2) {
            PG8_LDB(B0, 0, 0); PG8_LDB(B1, 0, 1); PG8_SCHED; PG8_LDA(At, 0, 0); PG8_STAGE(PG8_SA(1, 1), a1 + hstep, voffA);
            PG8_WAIT_V(8); PG8_WAIT_L(0); PG8_BAR; PG8_MMA(0, 0, At, B0); PG8_MMA(0, 1, At, B1); PG8_BAR; PG8_SCHED;
            PG8_LDA(At, 0, 1); PG8_STAGE(PG8_SB(0, 0), b2, voffB); PG8_STAGE(PG8_SB(0, 1), b2 + hstep, voffB); PG8_STAGE(PG8_SA(0, 0), a2, voffA);
            PG8_WAIT_V(8); PG8_WAIT_L(0); PG8_BAR; PG8_MMA(1, 0, At, B0); PG8_MMA(1, 1, At, B1); PG8_BAR; PG8_SCHED;
            PG8_LDB(B0, 1, 0); PG8_LDB(B1, 1, 1); PG8_SCHED; PG8_LDA(At, 1, 0); PG8_STAGE(PG8_SA(0, 1), a2 + hstep, voffA);
            PG8_WAIT_V(8); PG8_WAIT_L(0); PG8_BAR; PG8_MMA(0, 0, At, B0); PG8_MMA(0, 1, At, B1); PG8_BAR; PG8_SCHED;
            PG8_LDA(At, 1, 1); PG8_STAGE(PG8_SB(1, 0), b3, voffB); PG8_STAGE(PG8_SB(1, 1), b3 + hstep, voffB); PG8_STAGE(PG8_SA(1, 0), a3, voffA);
            PG8_WAIT_V(8); PG8_WAIT_L(0); PG8_BAR; PG8_MMA(1, 0, At, B0); PG8_MMA(1, 1, At, B1); PG8_BAR; PG8_SCHED;
            } else {
            PG8_LDB(B0, 0, 0); PG8_SCHED; PG8_LDA(At, 0, 0); PG8_STAGE(PG8_SA(1, 1), a1 + hstep, voffA);
            PG8_WAIT_L(8); PG8_BAR; PG8_WAIT_L(0); PG8_MMA(0, 0, At, B0); PG8_BAR; PG8_SCHED;
            PG8_LDB(B1, 0, 1); PG8_STAGE(PG8_SB(0, 0), b2, voffB);
            PG8_BAR; PG8_WAIT_L(0); PG8_MMA(0, 1, At, B1); PG8_BAR;
            PG8_LDA(At, 0, 1); PG8_STAGE(PG8_SA(0, 0), a2, voffA);
            PG8_BAR; PG8_WAIT_L(0); PG8_MMA(1, 0, At, B0); PG8_BAR; PG8_SCHED;
            PG8_STAGE(PG8_SB(0, 1), b2 + hstep, voffB);
            PG8_WAIT_V(6); PG8_BAR; PG8_MMA(1, 1, At, B1); PG8_BAR;
            PG8_LDB(B0, 1, 0); PG8_SCHED; PG8_LDA(At, 1, 0); PG8_STAGE(PG8_SA(0, 1), a2 + hstep, voffA);
            PG8_WAIT_L(8); PG8_BAR; PG8_WAIT_L(0); PG8_MMA(0, 0, At, B0); PG8_BAR; PG8_SCHED;
            PG8_LDB(B1, 1, 1); PG8_STAGE(PG8_SB(1, 0), b3, voffB);
            PG8_BAR; PG8_WAIT_L(0); PG8_MMA(0, 1, At, B1); PG8_BAR;
            PG8_LDA(At, 1, 1); PG8_STAGE(PG8_SA(1, 0), a3, voffA);
            PG8_BAR; PG8_WAIT_L(0); PG8_MMA(1, 0, At, B0); PG8_BAR; PG8_SCHED;
            PG8_STAGE(PG8_SB(1, 1), b3 + hstep, voffB);
            PG8_WAIT_V(6); PG8_BAR; PG8_MMA(1, 1, At, B1); PG8_BAR;
            }
        }
        if constexpr (ALIGN_EPI) { if (wr == 0) PG8_BAR; }
        { E(acc, cur, wr, wc, fr, fq, esc, tid); S.done(cur); }
        if (!has_next) break;
#pragma unroll
        for (int a = 0; a < 2; ++a)
#pragma unroll
            for (int b = 0; b < 2; ++b)
#pragma unroll
                for (int m = 0; m < 4; ++m)
#pragma unroll
                    for (int n = 0; n < 2; ++n) acc[a][b][m][n] = (f32x4){0.f, 0.f, 0.f, 0.f};
        cur = nxt; cA = nA; cB = nB; ++ui;
        if constexpr (ALIGN_EPI) { if (wr == 1) PG8_BAR; }
    }
    PG8_WAIT_V(0);
    if constexpr (!ALIGN_EPI) { if (wr == 0) PG8_BAR; }
    PG8_BAR;
#undef PG8_SA
#undef PG8_SB
#undef PG8_STAGE
#undef PG8_LDA
#undef PG8_LDB
#undef PG8_MMA
#undef PG8_WAIT_V
#undef PG8_WAIT_L
#undef PG8_BAR
#undef PG8_SCHED
}
}

typedef float f32x4 __attribute__((ext_vector_type(4)));
typedef short bf16x8 __attribute__((ext_vector_type(8)));


__device__ __forceinline__ void build_rs(const float* ssq, int pm, LAS unsigned char* esc, int tid) {
    LAS float* rsT = (LAS float*)esc;
    WG_BAR();
    if (tid < 256) {
        float s = 0.f;
#pragma unroll
        for (int j = 0; j < 8; ++j) { const gu64* p = (const gu64*)(ssq + ((size_t)j * MP + pm * 256 + tid) * 4);
#pragma unroll
            for (int h = 0; h < 2; ++h) { const unsigned long long v = __hip_atomic_load(p + h, RLX_AGENT); s += __builtin_bit_cast(float, (unsigned)v) + __builtin_bit_cast(float, (unsigned)(v >> 32)); } }
        rsT[tid] = rsqrtf(s * (1.0f / DM) + EPS);
    }
    WG_BAR();
}

struct EpiProj {
    static constexpr bool PERM = false, AFTER_DRAIN = false;
    unsigned char* ws_; float* out_; const float* gq; const float* gk; int l;
    __device__ __forceinline__ void operator()(f32x4 (&acc)[2][2][4][2], const pg8::Unit& u, int wr, int wc, int fr, int fq, LAS unsigned char* esc, int tid) const {
        asm volatile("" : "+v"(fr), "+v"(fq), "+v"(tid));
        unsigned char* ws = ws_; asm volatile("" : "+s"(ws));
        const float* ssq = (const float*)(ws + WS_SSQ); const float* ropec = (const float*)(ws + WS_ROPE); const float* ropes = ropec + ROPE_N;
        bf16* Q = (bf16*)(ws + WS_Q); bf16* K = (bf16*)(ws + WS_K); bf16* VT = (bf16*)(ws + WS_VT); float* U = (float*)(ws + WS_U); float* XP = (float*)(ws + WS_XP);
        float* ksn = (float*)(ws + WS_KSN); float* vsn = ksn + NSAMP * 256;
        float* out_pk = out_ + O_PK + (size_t)l * NBATCH * 128 * 256; float* out_pv = out_ + O_PV + (size_t)l * NBATCH * 128 * 256;
        const rsrc_t rs_ = ws_rsrc(ws);
        build_rs(ssq, u.pm, esc, tid);
        const LAS float* rsT = (const LAS float*)esc;
        LAS float* hss = (LAS float*)(esc + 1024);
        const int pn = u.pn;
#pragma unroll
        for (int ai = 0; ai < 2; ++ai)
#pragma unroll
            for (int m = 0; m < 4; ++m) { const float rsv = rsT[ai * 128 + wr * 64 + m * 16 + fr];
#pragma unroll
                for (int bj = 0; bj < 2; ++bj)
#pragma unroll
                    for (int n = 0; n < 2; ++n) acc[ai][bj][m][n] *= rsv; }
        if (pn <= 4) {
#pragma unroll
            for (int ai = 0; ai < 2; ++ai)
#pragma unroll
                for (int m = 0; m < 4; ++m)
#pragma unroll
                    for (int bj = 0; bj < 2; ++bj) { const f32x4 a = acc[ai][bj][m][0], b = acc[ai][bj][m][1];
                        float s = (a[0] * a[0] + a[1] * a[1]) + (a[2] * a[2] + a[3] * a[3]) + (b[0] * b[0] + b[1] * b[1]) + (b[2] * b[2] + b[3] * b[3]);
                        s += __shfl_xor(s, 16); s += __shfl_xor(s, 32);
                        if (fq == 0) hss[(bj * 256 + ai * 128 + wr * 64 + m * 16 + fr) * 4 + wc] = s; }
            WG_BAR();
            const float* g = (pn < 4) ? gq : gk; const float osc = (pn < 4) ? QSCALE : 1.0f;
            f32x4 gv[2];
#pragma unroll
            for (int n = 0; n < 2; ++n) gv[n] = *(const f32x4*)(g + wc * 32 + n * 16 + 4 * fq);
#pragma unroll
            for (int ai = 0; ai < 2; ++ai)
#pragma unroll
                for (int m = 0; m < 4; ++m) {
                    const int rl = ai * 128 + wr * 64 + m * 16 + fr, r = u.pm * 256 + rl;
                    const bool samp = r >= SROW0, pad = r >= MR;
                    const int b = (r >= TT && !samp) ? 1 : 0, t = r - b * TT;
                    const int pidx = samp ? ROPE_SAMPLE_IDX : t;
                    f32x4 cs = {1.f, 1.f, 1.f, 1.f}, sn = {0.f, 0.f, 0.f, 0.f};
                    if (wc == 0 && !pad) { cs = *(const f32x4*)(ropec + (size_t)pidx * 16 + 4 * fq); sn = *(const f32x4*)(ropes + (size_t)pidx * 16 + 4 * fq); }
#pragma unroll
                    for (int bj = 0; bj < 2; ++bj) {
                        const f32x4 hv = *(const LAS f32x4*)(hss + (bj * 256 + rl) * 4);
                        const float hn = rsqrtf(((hv[0] + hv[1]) + (hv[2] + hv[3])) * (1.0f / 128.0f) + EPS);
                        f32x4 x1 = acc[ai][bj][m][0] * hn * gv[0], x2 = acc[ai][bj][m][1] * hn * gv[1];
                        if (wc == 0) { const f32x4 o1 = x1 * cs - x2 * sn, o2 = x2 * cs + x1 * sn; x1 = o1; x2 = o2; }
                        x1 = x1 * osc; x2 = x2 * osc;
                        const int cl = bj * 128 + wc * 32 + 4 * fq;
                        if (pn < 4) { const size_t qo = WS_Q + ((size_t)r * 1024 + pn * 256 + cl) * 2;
                            ST8(rs_, qo, ((v2u){pk2(x1[0], x1[1]), pk2(x1[2], x1[3])})); ST8(rs_, qo + 32, ((v2u){pk2(x2[0], x2[1]), pk2(x2[2], x2[3])})); }
                        else { const size_t ko = WS_K + ((size_t)r * 256 + cl) * 2;
                            ST8(rs_, ko, ((v2u){pk2(x1[0], x1[1]), pk2(x1[2], x1[3])})); ST8(rs_, ko + 32, ((v2u){pk2(x2[0], x2[1]), pk2(x2[2], x2[3])}));
                            if (samp && !pad) { const size_t o = WS_KSN + ((size_t)(r - SROW0) * 256 + cl) * 4; ST16(rs_, o, x1); ST16(rs_, o + 64, x2); }
                            else if (!samp && t >= TT - 128) { float* o = out_pk + ((size_t)(b * 128 + (t - (TT - 128))) * 256) + cl; *(f32x4*)o = x1; *(f32x4*)(o + 16) = x2; } }
                    }
                }
        } else if (pn == 5) {
#pragma unroll
            for (int ai = 0; ai < 2; ++ai)
#pragma unroll
                for (int m = 0; m < 4; ++m) {
                    const int rl = ai * 128 + wr * 64 + m * 16 + fr, r = u.pm * 256 + rl;
                    const bool samp = r >= SROW0, pad = r >= MR;
                    const int b = (r >= TT && !samp) ? 1 : 0, t = r - b * TT;
                    const int tpos = (t & ~15) + perm16(t & 15);
#pragma unroll
                    for (int bj = 0; bj < 2; ++bj)
#pragma unroll
                        for (int n = 0; n < 2; ++n) { const f32x4 x = acc[ai][bj][m][n]; const int d = wc * 32 + n * 16 + 4 * fq;
                            if (!samp) { const size_t vo = WS_VT + (((size_t)((b * 2 + bj) * 128 + d)) * TPV + tpos) * 2;
#pragma unroll
                                for (int j = 0; j < 4; ++j) ST2(rs_, vo + (size_t)j * TPV * 2, pk2(x[j], 0.f) & 0xffffu);
                                if (t >= TT - 128) *(f32x4*)(out_pv + ((size_t)(b * 128 + (t - (TT - 128))) * 256) + bj * 128 + d) = x; }
                            else if (!pad) ST16(rs_, WS_KSN + ((size_t)NSAMP * 256 + (size_t)(r - SROW0) * 256 + bj * 128 + d) * 4, x); }
                }
        } else {
            const size_t dsto = (pn < 8) ? WS_U + (size_t)(pn - 6) * 256 * 4 : WS_XP + (size_t)(pn - 8) * 256 * 4;
#pragma unroll
            for (int ai = 0; ai < 2; ++ai)
#pragma unroll
                for (int m = 0; m < 4; ++m) { const size_t ro = dsto + ((size_t)(u.pm * 256 + ai * 128 + wr * 64 + m * 16 + fr) * 512 + wc * 32 + 4 * fq) * 4;
#pragma unroll
                    for (int bj = 0; bj < 2; ++bj)
#pragma unroll
                        for (int n = 0; n < 2; ++n) ST16(rs_, ro + (size_t)(bj * 128 + n * 16) * 4, acc[ai][bj][m][n]); }
        }
    }
};

struct EpiRes {
    static constexpr bool PERM = false, AFTER_DRAIN = false;
    unsigned char* ws_; float* out; int last;
    __device__ __forceinline__ void operator()(f32x4 (&acc)[2][2][4][2], const pg8::Unit& u, int wr, int wc, int fr, int fq, LAS unsigned char* esc, int tid) const {
        asm volatile("" : "+v"(fr), "+v"(fq), "+v"(tid));
        unsigned char* ws = ws_; asm volatile("" : "+s"(ws));
        const float* X = (const float*)(ws + WS_X); const rsrc_t rs_ = ws_rsrc(ws);
#pragma unroll
        for (int ai = 0; ai < 2; ++ai)
#pragma unroll
            for (int m = 0; m < 4; ++m) {
                const int r = u.pm * 256 + ai * 128 + wr * 64 + m * 16 + fr; const int c0 = u.pn * 256 + wc * 32 + 4 * fq;
                const float* xp = X + (size_t)r * DM + c0; float s = 0.f; const size_t eo = (size_t)r * DM + c0;
                f32x4 v[2][2];
#pragma unroll
                for (int bj = 0; bj < 2; ++bj)
#pragma unroll
                    for (int n = 0; n < 2; ++n) { v[bj][n] = *(const f32x4*)(xp + bj * 128 + n * 16) + acc[ai][bj][m][n]; const f32x4 q = v[bj][n] * v[bj][n]; s += (q[0] + q[1]) + (q[2] + q[3]); }
                if (!last) {
#pragma unroll
                    for (int bj = 0; bj < 2; ++bj)
#pragma unroll
                        for (int n = 0; n < 2; ++n) { ST16(rs_, WS_X + (eo + bj * 128 + n * 16) * 4, v[bj][n]); ST8(rs_, WS_XB + (eo + bj * 128 + n * 16) * 2, ((v2u){pk2(v[bj][n][0], v[bj][n][1]), pk2(v[bj][n][2], v[bj][n][3])})); }
                    s += __shfl_xor(s, 16); s += __shfl_xor(s, 32);
                    if (fq == 0) ST4(rs_, WS_SSQ + (((size_t)u.pn * MP + r) * 4 + wc) * 4, s);
                } else {
                    const bool samp = r >= SROW0, pad = r >= MR; const int b = (r >= TT && !samp) ? 1 : 0, t = r - b * TT;
                    float* op = nullptr;
                    if (samp) { if (!pad) op = out + O_YS + (size_t)(r - SROW0) * DM + c0; } else if (t >= NMETA) op = out + O_YP + ((size_t)b * NSEQ + (t - NMETA)) * DM + c0;
                    if (op) {
#pragma unroll
                        for (int bj = 0; bj < 2; ++bj)
#pragma unroll
                            for (int n = 0; n < 2; ++n) *(f32x4*)(op + bj * 128 + n * 16) = v[bj][n]; }
                }
                if (m & 1) asm volatile("" ::: "memory");
            }
    }
};

struct EpiFfn1 {
    static constexpr bool PERM = true, AFTER_DRAIN = false;
    unsigned char* ws_;
    __device__ __forceinline__ void operator()(f32x4 (&acc)[2][2][4][2], const pg8::Unit& u, int wr, int wc, int fr, int fq, LAS unsigned char* esc, int tid) const {
        asm volatile("" : "+v"(fr), "+v"(fq), "+v"(tid));
        unsigned char* ws = ws_; asm volatile("" : "+s"(ws));
        const rsrc_t rs_ = ws_rsrc(ws);
        build_rs((const float*)(ws + WS_SSQ), u.pm, esc, tid);
        const LAS float* rsT = (const LAS float*)esc;
#pragma unroll
        for (int ai = 0; ai < 2; ++ai)
#pragma unroll
            for (int m = 0; m < 4; ++m) { const int rl = ai * 128 + wr * 64 + m * 16 + fr; const float rsv = rsT[rl];
                const size_t ho = WS_H + ((size_t)(u.pm * 256 + rl) * DFF + u.pn * 256 + wc * 32 + 8 * fq) * 2;
#pragma unroll
                for (int bj = 0; bj < 2; ++bj) { f32x4 v0 = acc[ai][bj][m][0] * rsv, v1 = acc[ai][bj][m][1] * rsv;
#pragma unroll
                    for (int j = 0; j < 4; ++j) { const float a = fmaxf(v0[j], 0.f), b = fmaxf(v1[j], 0.f); v0[j] = a * a; v1[j] = b * b; }
                    ST16(rs_, ho + bj * 256, ((v4u){pk2(v0[0], v0[1]), pk2(v0[2], v0[3]), pk2(v1[0], v1[1]), pk2(v1[2], v1[3])})); } }
    }
};

#define XB_TMO      128
#define XB_XCNT(j)  (256  + 64 * (j))
#define XB_XSUB(j)  (1280 + 64 * (j))
#define XB_XGEN(j)  (2304 + 64 * (j))
#define XB_TOP      3328
#define XB_TOPGEN   3392
#define XCD_BAR_WORDS 3456
#define XB_SPIN_CAP (1u << 18)
__device__ __forceinline__ unsigned xb_ld(unsigned* p)              { return __hip_atomic_load(p, __ATOMIC_RELAXED, __HIP_MEMORY_SCOPE_AGENT); }
__device__ __forceinline__ unsigned xb_add(unsigned* p, unsigned v) { return __hip_atomic_fetch_add(p, v, __ATOMIC_RELAXED, __HIP_MEMORY_SCOPE_AGENT); }
__device__ __forceinline__ unsigned xb_xcc_id() { return (unsigned)__builtin_amdgcn_s_getreg((3 << 11) | 20) & 0xFu; }
#define XB_SPIN(cond, bar) do { unsigned _sp = 0; while (cond) { __builtin_amdgcn_s_sleep(1); \
    if ((++_sp & 255u) == 0u) { if (xb_ld(&(bar)[XB_TMO])) break; if (_sp > XB_SPIN_CAP) { atomicAdd(&(bar)[XB_TMO], 1u); break; } } } } while (0)

struct XcdBarrier {
    unsigned* bar; unsigned x;
    volatile LAS unsigned* st;
};

__device__ __forceinline__ XcdBarrier xcd_barrier_post(unsigned* bar, volatile LAS unsigned* st) {
    XcdBarrier b; b.bar = bar; b.x = xb_xcc_id(); b.st = st;
    if (threadIdx.x == 0) (void)xb_add(&bar[XB_XCNT(b.x)], 1u);
    return b;
}
__device__ __forceinline__ void xcd_barrier_complete(unsigned* bar, unsigned x, unsigned& nloc, unsigned& nx) {
    const unsigned G = gridDim.x * gridDim.y * gridDim.z;
    unsigned sum, cnt, mine, sp = 0u;
    for (;;) {
        sum = 0u; cnt = 0u; mine = 0u;
#pragma unroll
        for (unsigned j = 0; j < 16; ++j) { const unsigned c = xb_ld(&bar[XB_XCNT(j)]); sum += c; cnt += (c > 0u) ? 1u : 0u; mine = (j == x) ? c : mine; }
        if (sum == G) break;
        __builtin_amdgcn_s_sleep(1);
        if ((++sp & 255u) == 0u) { if (xb_ld(&bar[XB_TMO])) break; if (sp > XB_SPIN_CAP) { atomicAdd(&bar[XB_TMO], 1u); break; } }
    }
    nloc = mine > 0u ? mine : 1u; nx = cnt > 0u ? cnt : 1u;
}

__device__ __forceinline__ void xcd_barrier(const XcdBarrier& b) {
    asm volatile("s_waitcnt vmcnt(0)" ::: "memory");
    __syncthreads();
    if (threadIdx.x == 0) {
        unsigned* bar = b.bar;
        __builtin_amdgcn_s_waitcnt(0);
        unsigned nloc = b.st[0], nx = b.st[1];
        if (nloc == 0u) { xcd_barrier_complete(bar, b.x, nloc, nx); b.st[0] = nloc; b.st[1] = nx; }
        const unsigned old = xb_add(&bar[XB_XSUB(b.x)], 1u);
        const unsigned gen = old / nloc;
        if (old + 1u == (gen + 1u) * nloc) {
            __builtin_amdgcn_fence(__ATOMIC_RELEASE, "agent");
            asm volatile("s_waitcnt vmcnt(0)" ::: "memory");
            const unsigned og = xb_add(&bar[XB_TOP], 1u);
            const unsigned tg = og / nx;
            if (og + 1u == (tg + 1u) * nx) xb_add(&bar[XB_TOPGEN], 1u);
            else XB_SPIN(xb_ld(&bar[XB_TOPGEN]) == tg, bar);
            __builtin_amdgcn_fence(__ATOMIC_ACQUIRE, "agent");
            xb_add(&bar[XB_XGEN(b.x)], 1u);
            asm volatile("s_waitcnt vmcnt(0)" ::: "memory");
        } else {
            XB_SPIN(xb_ld(&bar[XB_XGEN(b.x)]) == gen, bar);
            __builtin_amdgcn_fence(__ATOMIC_ACQUIRE, "agent");
            asm volatile("s_waitcnt vmcnt(0)" ::: "memory");
        }
    }
    __syncthreads();
}

struct Frame {
    LAS unsigned char* lds;
    volatile LAS unsigned* MISC;
    gu32* ctl;
    int tid, lane, wave, vcu, G;
    float* out; unsigned char* ws;
};
#define IN_XPROMPT 0
#define IN_XSAMPLE 1
#define IN_CACHEK 2
#define IN_CACHEV 3
#define IN_SSMRE 4
#define IN_SSMIM 5
#define IN_SPOOL 6
#define IN_META 7
#define IN_GMIX 8
#define IN_WIN 9
#define IN_GQ 10
#define IN_GK 11
#define IN_SINKS 12
#define IN_ARE 13
#define IN_AIM 14
#define IN_LOGDT 15
#define IN_BRE 16
#define IN_BIM 17
#define IN_CRE 18
#define IN_CIM 19
#define IN_DSKIP 20
#define IN_WGLU 21
#define IN_BGLU 22
#define IN_WPOOL 23
#define IN_PSCALE 24
#define IN_GOA 25
#define IN_GOS 26
#define IN_GOP 27
#define IN_WOUT 28
#define IN_GFFN 29
#define IN_WFF1 30
#define IN_WFF2 31
struct Args { const float* in[32]; float* out; unsigned char* ws; int ph_lo, ph_hi; };
static_assert(sizeof(Args) == 32 * 8 + 8 + 8 + 8, "Args has no padding");

__device__ __forceinline__ void p0_transpose_item(const float* W, int K, int N, bf16* WT, const float* gain, LAS float* scr, int item, int lane) {
    const int nblk = N / 32, kb = item / nblk, nb = item % nblk, k0 = 64 * kb, n0 = 32 * nb;
    float wv[32];
#pragma unroll
    for (int i = 0; i < 32; ++i) wv[i] = W[(size_t)(k0 + 2 * i + (lane >> 5)) * N + n0 + (lane & 31)];
    if (gain) {
#pragma unroll
        for (int i = 0; i < 32; ++i) wv[i] *= gain[k0 + 2 * i + (lane >> 5)];
    }
#pragma unroll
    for (int i = 0; i < 32; ++i) scr[(2 * i + (lane >> 5)) * 33 + (lane & 31)] = wv[i];
    LDS_WAIT(); asm volatile("" ::: "memory");
    const int c = lane & 7;
#pragma unroll
    for (int j = 0; j < 4; ++j) { const int n = (lane >> 3) + 8 * j; const LAS float* s = scr + (8 * c) * 33 + n;
        v4u o; o.x = pk2(s[0 * 33], s[1 * 33]); o.y = pk2(s[2 * 33], s[3 * 33]); o.z = pk2(s[4 * 33], s[5 * 33]); o.w = pk2(s[6 * 33], s[7 * 33]);
        *(GAS v4u*)(WT + (size_t)(n0 + n) * K + k0 + 8 * c) = o; }
    LDS_WAIT(); asm volatile("" ::: "memory");
}
__device__ __forceinline__ void sincos_d(double x, double& s, double& c) {
    const double TWO_PI = 6.283185307179586476925286766559;
    const double k = rint(x * (1.0 / TWO_PI)); const double r = fma(-k, TWO_PI, x), r2 = r * r;
    const double fs[14] = {0.16666666666666666, 0.05, 0.023809523809523808, 0.013888888888888888, 0.00909090909090909, 0.00641025641025641, 0.004761904761904762, 0.003676470588235294,
                           0.0029239766081871343, 0.002380952380952381, 0.001976284584980237, 0.0016666666666666668, 0.0014245014245014246, 0.0012315270935960591};
    const double fc[14] = {0.5, 0.08333333333333333, 0.03333333333333333, 0.017857142857142856, 0.011111111111111112, 0.007575757575757576, 0.005494505494505495, 0.004166666666666667,
                           0.0032679738562091504, 0.002631578947368421, 0.0021645021645021645, 0.0018115942028985507, 0.0015384615384615385, 0.0013227513227513227};
    double ts = r, tc = 1.0; s = r; c = 1.0;
#pragma unroll
    for (int i = 0; i < 14; ++i) { ts *= -r2 * fs[i]; s += ts; tc *= -r2 * fc[i]; c += tc; }
}
__device__ __forceinline__ double exp_small(double x) {
    double t = 1.0, e = 1.0;
#pragma unroll
    for (int i = 1; i <= 14; ++i) { t *= x * (1.0 / i); e += t; }
    return e;
}
__device__ __forceinline__ void p0_prologue(const Args& AR, Frame& F) {
    LAS float* scr = (LAS float*)(F.lds + F.wave * 16384);
    const int gw = F.vcu * 8 + F.wave, NGW = F.G * 8, lane = F.lane;
    unsigned char* ws = F.ws;
    constexpr int I_IN = (DM / 64) * (INW / 32), I_OUT = (DM / 64) * (DM / 32), I_1 = (DM / 64) * (DFF / 32), I_2 = (DFF / 64) * (DM / 32), I_GLU = (512 / 64) * (512 / 32), I_POOL = 4 * 2 * 4;
    constexpr int I_LAYER = I_IN + I_OUT + I_1 + I_2 + I_GLU + I_POOL;
    for (int it = gw; it < NLAYER * I_LAYER; it += NGW) {
        const int l = it / I_LAYER; int r = it % I_LAYER;
        if (r < I_IN) { p0_transpose_item(AR.in[IN_WIN] + (size_t)l * DM * INW, DM, INW, (bf16*)(ws + WS_WIN) + (size_t)l * INW * DM, AR.in[IN_GMIX] + l * DM, scr, r, lane); continue; } r -= I_IN;
        if (r < I_OUT) { const int k0 = 64 * (r / (DM / 32));
            const float* g = (k0 < 1024) ? AR.in[IN_GOA] + l * 1024 : (k0 < 1536) ? AR.in[IN_GOS] + l * 512 - 1024 : AR.in[IN_GOP] + l * 512 - 1536;
            p0_transpose_item(AR.in[IN_WOUT] + (size_t)l * DM * DM, DM, DM, (bf16*)(ws + WS_WOUT) + (size_t)l * DM * DM, g, scr, r, lane); continue; } r -= I_OUT;
        if (r < I_1) { p0_transpose_item(AR.in[IN_WFF1] + (size_t)l * DM * DFF, DM, DFF, (bf16*)(ws + WS_W1) + (size_t)l * DFF * DM, AR.in[IN_GFFN] + l * DM, scr, r, lane); continue; } r -= I_1;
        if (r < I_2) { p0_transpose_item(AR.in[IN_WFF2] + (size_t)l * DFF * DM, DFF, DM, (bf16*)(ws + WS_W2) + (size_t)l * DM * DFF, nullptr, scr, r, lane); continue; } r -= I_2;
        if (r < I_GLU) { p0_transpose_item(AR.in[IN_WGLU] + (size_t)l * 512 * 512, 512, 512, (bf16*)(ws + WS_WGLU) + (size_t)l * 512 * 512, nullptr, scr, r, lane); continue; } r -= I_GLU;
        { const int g = r / 8; p0_transpose_item(AR.in[IN_WPOOL] + ((size_t)l * 4 + g) * 128 * 128, 128, 128, (bf16*)(ws + WS_WPOOL) + ((size_t)l * 4 + g) * 128 * 128, nullptr, scr, r % 8, lane); }
    }
    float* X = (float*)(ws + WS_X); bf16* XB = (bf16*)(ws + WS_XB); float* SSQ = (float*)(ws + WS_SSQ);
    for (int m = gw; m < MP; m += NGW) {
        const float* src = nullptr;
        if (m < SROW0) { const int b = m >= TT ? 1 : 0, t = m - b * TT; src = (t < NMETA) ? AR.in[IN_META] + (size_t)t * DM : AR.in[IN_XPROMPT] + ((size_t)b * NSEQ + (t - NMETA)) * DM; }
        else if (m < MR) src = AR.in[IN_XSAMPLE] + (size_t)(m - SROW0) * DM;
        float s = 0.f;
#pragma unroll
        for (int j = 0; j < 8; ++j) { f32x4 v = {0.f, 0.f, 0.f, 0.f}; if (src) v = *(const f32x4*)(src + j * 256 + lane * 4);
            s += (v[0] * v[0] + v[1] * v[1]) + (v[2] * v[2] + v[3] * v[3]);
            *(f32x4*)(X + (size_t)m * DM + j * 256 + lane * 4) = v; *(v2u*)(XB + (size_t)m * DM + j * 256 + lane * 4) = (v2u){pk2(v[0], v[1]), pk2(v[2], v[3])}; }
        s = wave_sum(s);
        if (lane < 32) SSQ[((size_t)(lane >> 2) * MP + m) * 4 + (lane & 3)] = (lane == 0) ? s : 0.f;
    }
    const int gt = gw * 64 + lane, NGT = NGW * 64;
    for (int id = gt; id < NLAYER * 32 * 64; id += NGT) {
        const int l = id >> 11, g = (id >> 6) & 31, n = id & 63;
        unsigned char* tb = ws + WS_TAB + (size_t)l * TB_LAYER;
        const double dt = (double)expf(AR.in[IN_LOGDT][l * 32 + g]);
        const double ar = (double)AR.in[IN_ARE][id], ai = (double)AR.in[IN_AIM][id];
        const double mag = exp_small(dt * ar); double sn, cs; sincos_d(dt * ai, sn, cs);
        const double abr = mag * cs, abi = mag * sn, den = ar * ar + ai * ai;
        const double fr = ((abr - 1.0) * ar + abi * ai) / den, fi = (abi * ar - (abr - 1.0) * ai) / den;
        ((float*)(tb + TB_ABR))[g * 64 + n] = (float)abr; ((float*)(tb + TB_ABI))[g * 64 + n] = (float)abi;
        const float* Br = AR.in[IN_BRE] + (size_t)id * 16; const float* Bi = AR.in[IN_BIM] + (size_t)id * 16;
        float* bbr = (float*)(tb + TB_BBR) + (size_t)(g * 64 + n) * 16; float* bbi = (float*)(tb + TB_BBI) + (size_t)(g * 64 + n) * 16;
#pragma unroll
        for (int c = 0; c < 16; ++c) { const double br = Br[c], bi = Bi[c]; bbr[c] = (float)(fr * br - fi * bi); bbi[c] = (float)(fr * bi + fi * br); }
        bf16* Pm = (bf16*)(tb + TB_PM) + (size_t)g * 64 * 128;
        double pr = abr, pi = abi;
        for (int t = 0; t < 64; ++t) {
            Pm[t * 128 + n] = (bf16)(pk2((float)pr, 0.f) & 0xffffu); Pm[t * 128 + 64 + n] = (bf16)(pk2((float)pi, 0.f) & 0xffffu);
            if (t == 15) { ((float*)(tb + TB_A16R))[g * 64 + n] = (float)pr; ((float*)(tb + TB_A16I))[g * 64 + n] = (float)pi; }
            if (t == 31) { ((float*)(tb + TB_A32R))[g * 64 + n] = (float)pr; ((float*)(tb + TB_A32I))[g * 64 + n] = (float)pi; }
            if (t == 63) { ((float*)(tb + TB_ALR))[g * 64 + n] = (float)pr; ((float*)(tb + TB_ALI))[g * 64 + n] = (float)pi; }
            const double nr = pr * abr - pi * abi, ni = pr * abi + pi * abr; pr = nr; pi = ni;
        }
        bf16* CmT = (bf16*)(tb + TB_CMT) + (size_t)g * 16 * 128;
        const float* Cr = AR.in[IN_CRE] + ((size_t)(l * 32 + g) * 16) * 64 + n; const float* Ci = AR.in[IN_CIM] + ((size_t)(l * 32 + g) * 16) * 64 + n;
#pragma unroll
        for (int c = 0; c < 16; ++c) { CmT[c * 128 + n] = (bf16)(pk2(Cr[c * 64], 0.f) & 0xffffu); CmT[c * 128 + 64 + n] = (bf16)(pk2(-Ci[c * 64], 0.f) & 0xffffu); }
    }
    float* rc = (float*)(ws + WS_ROPE); float* rs_ = rc + ROPE_N;
    for (int id = gt; id < (int)ROPE_N; id += NGT) {
        const int p = id >> 4, i = id & 15; const double pos = (p == ROPE_SAMPLE_IDX) ? 16384.0 : (double)p;
        double inv = 1.0;
        for (int k = 0; k < i; ++k) inv *= 0.44036660267178046;
        double sn, cs; sincos_d(pos * inv, sn, cs);
        rc[id] = (float)cs; rs_[id] = (float)sn;
    }
}

__device__ __forceinline__ void attn_unit(const Args& AR, Frame& F, int l, int b, int i) {
    int lane_ = F.lane; asm volatile("" : "+v"(lane_));
    unsigned char* ws = F.ws; asm volatile("" : "+s"(ws));
    const int lane = lane_, h = F.wave, c = lane & 31, hh = lane >> 5, kvh = h >> 2;
    const int t0 = 32 * i; const size_t rb = (size_t)b * TT;
    const bf16* Q = (const bf16*)(ws + WS_Q); const bf16* K = (const bf16*)(ws + WS_K); const bf16* VT = (const bf16*)(ws + WS_VT);
    LAS float* ex = (LAS float*)(F.lds + ESC_OFF);
    bf16x8 qf[8];
    { const bf16* qp = Q + (rb + t0 + c) * 1024 + 128 * h + 8 * hh;
#pragma unroll
      for (int ks = 0; ks < 8; ++ks) qf[ks] = *(const bf16x8*)(qp + 16 * ks); }
    const int kt0 = (t0 >= 128) ? 0 : (4 - i);
    f32x16 S[5];
#pragma unroll
    for (int kt = 0; kt < 5; ++kt) {
#pragma unroll
        for (int r = 0; r < 16; ++r) S[kt][r] = -INFINITY;
        if (kt >= kt0) {
            const int tk0 = t0 - 128 + 32 * kt;
            const bf16* kp = K + (rb + tk0 + c) * 256 + 128 * kvh + 8 * hh;
            bf16x8 kf[8];
#pragma unroll
            for (int ks = 0; ks < 8; ++ks) kf[ks] = *(const bf16x8*)(kp + 16 * ks);
            f32x16 a = {0.f, 0.f, 0.f, 0.f, 0.f, 0.f, 0.f, 0.f, 0.f, 0.f, 0.f, 0.f, 0.f, 0.f, 0.f, 0.f};
#pragma unroll
            for (int ks = 0; ks < 8; ++ks) a = __builtin_amdgcn_mfma_f32_32x32x16_bf16(kf[ks], qf[ks], a, 0, 0, 0);
#pragma unroll
            for (int r = 0; r < 16; ++r) { const int kr = (r & 3) + 8 * (r >> 2) + 4 * hh; bool ok = true;
                if (kt == 0) ok = kr >= c;
                if (kt == 4) ok = kr <= c;
                S[kt][r] = ok ? a[r] : -INFINITY; }
        }
    }
    const float sink2 = AR.in[IN_SINKS][l * 8 + h] * LOG2E;
    float mx = sink2;
#pragma unroll
    for (int kt = 0; kt < 5; ++kt)
#pragma unroll
        for (int r = 0; r < 16; ++r) mx = fmaxf(mx, S[kt][r]);
    mx = fmaxf(mx, __shfl_xor(mx, 32));
    float sum = 0.f;
#pragma unroll
    for (int kt = 0; kt < 5; ++kt)
#pragma unroll
        for (int r = 0; r < 16; ++r) { const float p = __builtin_amdgcn_exp2f(S[kt][r] - mx); S[kt][r] = p; sum += p; }
    sum += __shfl_xor(sum, 32);
    const float inv = 1.0f / (sum + __builtin_amdgcn_exp2f(sink2 - mx));
    f32x16 O[4];
#pragma unroll
    for (int db = 0; db < 4; ++db)
#pragma unroll
        for (int r = 0; r < 16; ++r) O[db][r] = 0.f;
#pragma unroll
    for (int kt = 0; kt < 5; ++kt) {
        if (kt >= kt0) {
            const int tk0 = t0 - 128 + 32 * kt;
#pragma unroll
            for (int s = 0; s < 2; ++s) {
                v4u pw; pw.x = pk2(S[kt][8 * s + 0], S[kt][8 * s + 1]); pw.y = pk2(S[kt][8 * s + 2], S[kt][8 * s + 3]); pw.z = pk2(S[kt][8 * s + 4], S[kt][8 * s + 5]); pw.w = pk2(S[kt][8 * s + 6], S[kt][8 * s + 7]);
                const bf16x8 pf = __builtin_bit_cast(bf16x8, pw);
#pragma unroll
                for (int db = 0; db < 4; ++db) {
                    const bf16x8 vf = *(const bf16x8*)(VT + ((size_t)((b * 2 + kvh) * 128 + 32 * db + c)) * TPV + tk0 + 16 * s + 8 * hh);
                    O[db] = __builtin_amdgcn_mfma_f32_32x32x16_bf16(vf, pf, O[db], 0, 0, 0);
                }
            }
        }
    }
    float ss = 0.f;
#pragma unroll
    for (int db = 0; db < 4; ++db)
#pragma unroll
        for (int r = 0; r < 16; ++r) { O[db][r] *= inv; ss += O[db][r] * O[db][r]; }
    ss += __shfl_xor(ss, 32);
    if (hh == 0) ex[h * 32 + c] = ss;
    WG_BAR();
    float tot = 0.f;
#pragma unroll
    for (int j = 0; j < 8; ++j) tot += ex[j * 32 + c];
    const float rsa = rsqrtf(tot * (1.0f / 1024.0f) + EPS);
    if (t0 + c < TT) {
        const rsrc_t rs_ = ws_rsrc(ws); const size_t mo = WS_MIX + ((rb + t0 + c) * DM + 128 * h + 4 * hh) * 2;
#pragma unroll
        for (int db = 0; db < 4; ++db)
#pragma unroll
            for (int g4 = 0; g4 < 4; ++g4)
                ST8(rs_, mo + (32 * db + 8 * g4) * 2, ((v2u){pk2(O[db][4 * g4 + 0] * rsa, O[db][4 * g4 + 1] * rsa), pk2(O[db][4 * g4 + 2] * rsa, O[db][4 * g4 + 3] * rsa)}));
    }
    WG_BAR();
}

__device__ __forceinline__ void sattn_unit(const Args& AR, Frame& F, int l, int s) {
    int tid_ = F.tid; asm volatile("" : "+v"(tid_));
    const int tid = tid_, lane = tid & 63, wave = F.wave;
    LAS float* qs = (LAS float*)F.lds;
    LAS float* sc = qs + 1024;
    LAS float* part = sc + 8 * 132;
    LAS float* red = part + 4096;
    const size_t row = SROW0 + s;
    const bf16* Q = (const bf16*)(F.ws + WS_Q) + row * 1024;
    const float* ksn = (const float*)(F.ws + WS_KSN) + (size_t)s * 256; const float* vsn = ksn + NSAMP * 256;
    const float* ck = AR.in[IN_CACHEK] + ((size_t)(l * NSAMP + s)) * 128 * 256; const float* cv = AR.in[IN_CACHEV] + ((size_t)(l * NSAMP + s)) * 128 * 256;
    for (int j = tid; j < 1024; j += 512) qs[j] = bf2f(Q[j]);
    WG_BAR();
    { const int key = tid >> 2, pt = tid & 3;
#pragma unroll
      for (int kvh = 0; kvh < 2; ++kvh) {
          const float* kp = ck + (size_t)key * 256 + kvh * 128 + 32 * pt; float d[4] = {0.f, 0.f, 0.f, 0.f};
#pragma unroll
          for (int j = 0; j < 8; ++j) { const f32x4 kv = *(const f32x4*)(kp + 4 * j);
#pragma unroll
              for (int g = 0; g < 4; ++g) { const f32x4 qv = *(const LAS f32x4*)(qs + (4 * kvh + g) * 128 + 32 * pt + 4 * j); d[g] += (kv[0] * qv[0] + kv[1] * qv[1]) + (kv[2] * qv[2] + kv[3] * qv[3]); } }
#pragma unroll
          for (int g = 0; g < 4; ++g) { d[g] += __shfl_xor(d[g], 1); d[g] += __shfl_xor(d[g], 2); if (pt == 0) sc[(4 * kvh + g) * 132 + key] = d[g]; }
      } }
    {
      const int h = wave, kvh = h >> 2; float d = ksn[kvh * 128 + lane] * qs[h * 128 + lane] + ksn[kvh * 128 + 64 + lane] * qs[h * 128 + 64 + lane];
      d = wave_sum(d); if (lane == 0) sc[h * 132 + 128] = d; }
    WG_BAR();
    { const int h = wave; const float sink2 = AR.in[IN_SINKS][l * 8 + h] * LOG2E;
      const float v0 = sc[h * 132 + lane], v1 = sc[h * 132 + 64 + lane], v2 = (lane == 0) ? sc[h * 132 + 128] : -INFINITY;
      const float mx = fmaxf(wave_max(fmaxf(fmaxf(v0, v1), v2)), sink2);
      const float p0 = __builtin_amdgcn_exp2f(v0 - mx), p1 = __builtin_amdgcn_exp2f(v1 - mx), p2 = __builtin_amdgcn_exp2f(v2 - mx);
      const float inv = 1.0f / (wave_sum(p0 + p1 + p2) + __builtin_amdgcn_exp2f(sink2 - mx));
      sc[h * 132 + lane] = p0 * inv; sc[h * 132 + 64 + lane] = p1 * inv; if (lane == 0) sc[h * 132 + 128] = p2 * inv; }
    WG_BAR();
    { const int d = tid & 127, kq = tid >> 7;
#pragma unroll
      for (int kvh = 0; kvh < 2; ++kvh) { float a[4] = {0.f, 0.f, 0.f, 0.f};
#pragma unroll 8
          for (int k = 0; k < 32; ++k) { const int key = 32 * kq + k; const float v = cv[(size_t)key * 256 + kvh * 128 + d];
#pragma unroll
              for (int g = 0; g < 4; ++g) a[g] += sc[(4 * kvh + g) * 132 + key] * v; }
#pragma unroll
          for (int g = 0; g < 4; ++g) part[kq * 1024 + (4 * kvh + g) * 128 + d] = a[g]; } }
    WG_BAR();
    float o[2]; float ss = 0.f;
#pragma unroll
    for (int e = 0; e < 2; ++e) { const int j = tid + 512 * e, h = j >> 7, d = j & 127, kvh = h >> 2;
        o[e] = (part[j] + part[1024 + j]) + (part[2048 + j] + part[3072 + j]) + sc[h * 132 + 128] * vsn[kvh * 128 + d]; ss += o[e] * o[e]; }
    ss = wave_sum(ss); if (lane == 0) red[wave] = ss;
    WG_BAR();
    { float tot = 0.f;
#pragma unroll
      for (int j = 0; j < 8; ++j) tot += red[j];
      const float rsa = rsqrtf(tot * (1.0f / 1024.0f) + EPS);
      const rsrc_t rs_ = ws_rsrc(F.ws);
#pragma unroll
      for (int e = 0; e < 2; ++e) ST2(rs_, WS_MIX + (row * DM + tid + 512 * e) * 2, pk2(o[e] * rsa, 0.f) & 0xffffu); }
    { float* ok = F.out + O_SK + ((size_t)(l * NSAMP + s)) * 128 * 256; float* ov = F.out + O_SV + ((size_t)(l * NSAMP + s)) * 128 * 256;
      for (int j = tid; j < 127 * 64; j += 512) { *(f32x4*)(ok + 4 * j) = *(const f32x4*)(ck + 256 + 4 * j); *(f32x4*)(ov + 4 * j) = *(const f32x4*)(cv + 256 + 4 * j); }
      if (tid < 64) *(f32x4*)(ok + 127 * 256 + 4 * tid) = *(const f32x4*)(ksn + 4 * tid);
      else if (tid < 128) *(f32x4*)(ov + 127 * 256 + 4 * (tid - 64)) = *(const f32x4*)(vsn + 4 * (tid - 64)); }
    WG_BAR();
}

__device__ __forceinline__ float gelu_tanh(float y) {
    const float inner = 0.7978845608028654f * (y + 0.044715f * y * y * y);
    return y / (1.0f + __builtin_amdgcn_exp2f(-2.0f * LOG2E * inner));
}
__device__ __forceinline__ float sigmoidf_(float x) { return 1.0f / (1.0f + __builtin_amdgcn_exp2f(-LOG2E * x)); }
#define SWZ(r, ch, PITCH) ((r) * (PITCH) + ((((ch)) ^ ((r) & 15)) << 4))

#define SSM_ROWS4(BODY_PRE, BODY_POST) \
    _Pragma("unroll") for (int r4 = 0; r4 < 4; ++r4) { const int r = rbase + r4; BODY_PRE \
        f32x2 xx = {0.f, 0.f}; \
        _Pragma("unroll") for (int cc = 0; cc < 16; ++cc) { const float uv = __builtin_bit_cast(float, __builtin_amdgcn_readlane(__builtin_bit_cast(int, uu[cc]), r)); xx += bb[cc] * (f32x2){uv, uv}; } \
        const float nr = abr * hr - abi * hi + xx[0], ni = abr * hi + abi * hr + xx[1]; hr = nr; hi = ni; BODY_POST }
__device__ __forceinline__ void ssm_unit(const Args& AR, Frame& F, int l, int c) {
    int lane_ = F.lane; asm volatile("" : "+v"(lane_));
    const int lane = lane_, w = F.wave, n = lane, t16 = lane & 15, cq = lane >> 4;
    const int row0 = 64 * c;
    unsigned char* ws = F.ws; asm volatile("" : "+s"(ws));
    const unsigned char* tb = ws + WS_TAB + (size_t)l * TB_LAYER;
    const float* U = (const float*)(ws + WS_U);
    float* SST = (float*)(ws + WS_SST) + ((size_t)l * NCHUNK) * 32 * 128;
    gu32* flags = F.ctl + CW_SSMF + (size_t)(l * NCHUNK) * 8 * 16;
    LAS unsigned char* Zs = F.lds;
    LAS unsigned char* Hm = F.lds + 65536 + w * 8192;
    LAS float* red = (LAS float*)(F.lds + ESC_OFF);
    if (c != NCHUNK - 1) {
#pragma unroll 1
        for (int gi = 0; gi < 4; ++gi) {
            const int g = 4 * w + gi;
            const float abr = ((const float*)(tb + TB_ABR))[g * 64 + n], abi = ((const float*)(tb + TB_ABI))[g * 64 + n];
            f32x2 bb[16];
            { const f32x4* pr = (const f32x4*)((const float*)(tb + TB_BBR) + (size_t)(g * 64 + n) * 16); const f32x4* pi = (const f32x4*)((const float*)(tb + TB_BBI) + (size_t)(g * 64 + n) * 16);
#pragma unroll
              for (int j = 0; j < 4; ++j) { const f32x4 a = pr[j], b2 = pi[j];
#pragma unroll
                  for (int e = 0; e < 4; ++e) bb[4 * j + e] = (f32x2){a[e], b2[e]}; } }
            float uu[16];
            { const f32x4* pu = (const f32x4*)(U + (size_t)(row0 + lane) * 512 + 16 * g);
#pragma unroll
              for (int j = 0; j < 4; ++j) { const f32x4 a = pu[j];
#pragma unroll
                  for (int e = 0; e < 4; ++e) uu[4 * j + e] = a[e]; } }
            float hr = 0.f, hi = 0.f;
#pragma unroll 1
            for (int rbase = (c == 64) ? 16 : 0; rbase < 64; rbase += 4) { SSM_ROWS4(, ) }
            __hip_atomic_store((gu64*)(SST + ((size_t)c * 32 + g) * 128 + 2 * n), ((unsigned long long)__builtin_bit_cast(unsigned, hi) << 32) | __builtin_bit_cast(unsigned, hr), RLX_AGENT);
        }
        VM_WAIT();
        if (lane == 0) __hip_atomic_store(flags + ((size_t)c * 8 + w) * 16, 1u, RLX_AGENT);
    }
    const int cs0 = (c <= 64) ? 0 : 64, npred = c - cs0;
    if (npred > 0) {
        unsigned sp = 0; bool ok = false;
        for (;;) { ok = (lane >= npred) || (__hip_atomic_load(flags + ((size_t)(cs0 + lane) * 8 + w) * 16, RLX_AGENT) != 0u);
            if (__all(ok)) break;
            __builtin_amdgcn_s_sleep(2);
            if (++sp > (1u << 20)) { if (lane == 0) __hip_atomic_store(F.ctl + CW_TMO, 0x55u, RLX_AGENT); break; } }
        __builtin_amdgcn_fence(__ATOMIC_ACQUIRE, "agent");
        VM_WAIT();
    }
#pragma unroll 1
    for (int gi = 0; gi < 4; ++gi) {
        const int g = 4 * w + gi;
        const float abr = ((const float*)(tb + TB_ABR))[g * 64 + n], abi = ((const float*)(tb + TB_ABI))[g * 64 + n];
        float hr = 0.f, hi = 0.f;
        if (npred > 0) {
            const float aLr = ((const float*)(tb + TB_ALR))[g * 64 + n], aLi = ((const float*)(tb + TB_ALI))[g * 64 + n];
            for (int cp = cs0; cp < c; cp += 8) {
                f32x2 sv[8];
#pragma unroll
                for (int j = 0; j < 8; ++j) { const int cj = (cp + j < c) ? cp + j : c - 1; sv[j] = *(const f32x2*)(SST + ((size_t)cj * 32 + g) * 128 + 2 * n); }
#pragma unroll
                for (int j = 0; j < 8; ++j) if (cp + j < c) { const float nr = aLr * hr - aLi * hi + sv[j][0], ni = aLr * hi + aLi * hr + sv[j][1]; hr = nr; hi = ni; }
            }
        }
        f32x2 bb[16];
        { const f32x4* pr = (const f32x4*)((const float*)(tb + TB_BBR) + (size_t)(g * 64 + n) * 16); const f32x4* pi = (const f32x4*)((const float*)(tb + TB_BBI) + (size_t)(g * 64 + n) * 16);
#pragma unroll
          for (int j = 0; j < 4; ++j) { const f32x4 a = pr[j], b2 = pi[j];
#pragma unroll
              for (int e = 0; e < 4; ++e) bb[4 * j + e] = (f32x2){a[e], b2[e]}; } }
        float uu[16];
        { const f32x4* pu = (const f32x4*)(U + (size_t)(row0 + lane) * 512 + 16 * g);
#pragma unroll
          for (int j = 0; j < 4; ++j) { const f32x4 a = pu[j];
#pragma unroll
              for (int e = 0; e < 4; ++e) uu[4 * j + e] = a[e]; } }
        bf16x8 cmf[4];
        { const bf16* cm = (const bf16*)(tb + TB_CMT) + (size_t)g * 16 * 128 + t16 * 128 + 8 * cq;
#pragma unroll
          for (int ks = 0; ks < 4; ++ks) cmf[ks] = *(const bf16x8*)(cm + 32 * ks); }
        const int col = 64 * w + 16 * gi + 4 * cq;
        const f32x4 dsk = *(const f32x4*)(AR.in[IN_DSKIP] + l * 512 + col);
#pragma unroll 1
        for (int half = 0; half < 2; ++half) {
            const bool samp = (c == NCHUNK - 1) && (half == 1);
#pragma unroll 1
            for (int rbase = 32 * half; rbase < 32 * half + 32; rbase += 4) {
                float h0r[4], h0i[4];
#pragma unroll
                for (int r4 = 0; r4 < 4; ++r4) { h0r[r4] = 0.f; h0i[r4] = 0.f; }
                if (samp) {
#pragma unroll
                    for (int r4 = 0; r4 < 4; ++r4) { const size_t o = ((size_t)(l * NSAMP + (rbase - 32 + r4)) * 32 + g) * 64 + n; h0r[r4] = AR.in[IN_SSMRE][o]; h0i[r4] = AR.in[IN_SSMIM][o]; }
                }
                SSM_ROWS4(
                    if (c == 64 && r == 16) { hr = 0.f; hi = 0.f; }
                    if (samp) { hr = h0r[r4]; hi = h0i[r4]; } ,
                    { const int rl = r & 31;
                      *(LAS bf16*)(Hm + SWZ(rl, n >> 3, 256) + (n & 7) * 2) = (bf16)(pk2(hr, 0.f) & 0xffffu);
                      *(LAS bf16*)(Hm + SWZ(rl, 8 + (n >> 3), 256) + (n & 7) * 2) = (bf16)(pk2(hi, 0.f) & 0xffffu);
                      if ((c == 64 && r == 15) || (c == NCHUNK - 1 && r == 31)) { const size_t o = ((size_t)(l * NBATCH + (c == 64 ? 0 : 1)) * 32 + g) * 64 + n; F.out[O_PSR + o] = hr; F.out[O_PSI + o] = hi; }
                      if (samp) { const size_t o = ((size_t)(l * NSAMP + (r - 32)) * 32 + g) * 64 + n; F.out[O_SSR + o] = hr; F.out[O_SSI + o] = hi; } } )
            }
            LDS_WAIT();
#pragma unroll
            for (int mt = 0; mt < 2; ++mt) {
                f32x4 y = {0.f, 0.f, 0.f, 0.f};
#pragma unroll
                for (int ks = 0; ks < 4; ++ks) { const bf16x8 hf = *(const LAS bf16x8*)(Hm + SWZ(16 * mt + t16, 4 * ks + cq, 256));
                    y = __builtin_amdgcn_mfma_f32_16x16x32_bf16(cmf[ks], hf, y, 0, 0, 0); }
                const int rl = 32 * half + 16 * mt + t16;
                const f32x4 uv = *(const f32x4*)(U + (size_t)(row0 + rl) * 512 + col);
                f32x4 z;
#pragma unroll
                for (int e = 0; e < 4; ++e) z[e] = gelu_tanh(y[e] + dsk[e] * uv[e]);
                *(LAS v2u*)(Zs + SWZ(rl, col >> 3, 1024) + (col & 7) * 2) = (v2u){pk2(z[0], z[1]), pk2(z[2], z[3])};
            }
            LDS_WAIT();
        }
    }
    WG_BAR();
    f32x4 G[4][4];
#pragma unroll
    for (int mt = 0; mt < 4; ++mt)
#pragma unroll
        for (int nt = 0; nt < 4; ++nt) G[mt][nt] = (f32x4){0.f, 0.f, 0.f, 0.f};
    { const bf16* Wg = (const bf16*)(ws + WS_WGLU) + (size_t)l * 512 * 512 + (size_t)(64 * w + t16) * 512 + 8 * cq;
#pragma unroll 2
      for (int ks = 0; ks < 16; ++ks) {
          bf16x8 wf[4], zf[4];
#pragma unroll
          for (int nt = 0; nt < 4; ++nt) wf[nt] = *(const bf16x8*)(Wg + (size_t)nt * 16 * 512 + 32 * ks);
#pragma unroll
          for (int mt = 0; mt < 4; ++mt) zf[mt] = *(const LAS bf16x8*)(Zs + SWZ(16 * mt + t16, 4 * ks + cq, 1024));
#pragma unroll
          for (int mt = 0; mt < 4; ++mt)
#pragma unroll
              for (int nt = 0; nt < 4; ++nt) G[mt][nt] = __builtin_amdgcn_mfma_f32_16x16x32_bf16(wf[nt], zf[mt], G[mt][nt], 0, 0, 0);
      } }
#pragma unroll
    for (int mt = 0; mt < 4; ++mt) { float ss = 0.f; const int rl = 16 * mt + t16;
#pragma unroll
        for (int nt = 0; nt < 4; ++nt) { const int col = 64 * w + 16 * nt + 4 * cq; const f32x4 bg = *(const f32x4*)(AR.in[IN_BGLU] + l * 512 + col);
            const v2u zz = *(const LAS v2u*)(Zs + SWZ(rl, col >> 3, 1024) + (col & 7) * 2);
            const float zv[4] = {bf2f((unsigned short)(zz.x & 0xffffu)), bf2f((unsigned short)(zz.x >> 16)), bf2f((unsigned short)(zz.y & 0xffffu)), bf2f((unsigned short)(zz.y >> 16))};
#pragma unroll
            for (int e = 0; e < 4; ++e) { const float o = zv[e] * sigmoidf_(G[mt][nt][e] + bg[e]); G[mt][nt][e] = o; ss += o * o; } }
        ss += __shfl_xor(ss, 16); ss += __shfl_xor(ss, 32);
        if (cq == 0) red[rl * 8 + w] = ss; }
    WG_BAR();
    { const rsrc_t rs_ = ws_rsrc(ws);
#pragma unroll
      for (int mt = 0; mt < 4; ++mt) { const int rl = 16 * mt + t16; const LAS f32x4* rp = (const LAS f32x4*)(red + rl * 8); const f32x4 a = rp[0], b2 = rp[1];
          const float rsn = rsqrtf(((a[0] + a[1]) + (a[2] + a[3]) + (b2[0] + b2[1]) + (b2[2] + b2[3])) * (1.0f / 512.0f) + EPS);
          const size_t mo = WS_MIX + ((size_t)(row0 + rl) * DM + 1024 + 64 * w + 4 * cq) * 2;
#pragma unroll
          for (int nt = 0; nt < 4; ++nt) ST8(rs_, mo + 32 * nt, ((v2u){pk2(G[mt][nt][0] * rsn, G[mt][nt][1] * rsn), pk2(G[mt][nt][2] * rsn, G[mt][nt][3] * rsn)})); } }
    WG_BAR();
}
#undef SSM_ROWS4

template <int WLEN>
__device__ __forceinline__ void pool_half(const float* XP, float* out, int l, int ch, int rfirst, int rl0, LAS unsigned char* Ds) {
    float xv[48];
#pragma unroll
    for (int i = 0; i < 48; ++i) { const int ra = rfirst + i - 16; xv[i] = (ra >= 0) ? XP[(size_t)ra * 512 + ch] : 0.f; }
    int seg = (rfirst >= TT) ? TT : 0;
    float sum = 0.f;
#pragma unroll
    for (int j = 1; j <= WLEN; ++j) if (rfirst - j >= seg) sum += xv[16 - j];
#pragma unroll
    for (int i = 0; i < 32; ++i) {
        const int ra = rfirst + i; const float x = xv[16 + i];
        if (ra == TT) { seg = TT; sum = 0.f; }
        sum += x;
        if (ra - WLEN >= seg) sum -= xv[16 + i - WLEN];
        const int cnt = (ra - seg + 1 < WLEN) ? (ra - seg + 1) : WLEN;
        const float dm = sum * __builtin_amdgcn_rcpf((float)cnt) - x;
        if (ra >= TT - 15 && ra < TT) out[O_PP + ((size_t)(l * NBATCH + 0) * 15 + (ra - (TT - 15))) * 512 + ch] = x;
        if (ra >= SROW0 - 15) out[O_PP + ((size_t)(l * NBATCH + 1) * 15 + (ra - (SROW0 - 15))) * 512 + ch] = x;
        const int r = rl0 + i;
        *(LAS bf16*)(Ds + SWZ(r, ch >> 3, 1024) + (ch & 7) * 2) = (bf16)(pk2(dm, 0.f) & 0xffffu);
    }
}
template <int WLEN>
__device__ __forceinline__ void pool_sample_rows(const float* XP, const float* sp, float* out, int l, int ch, LAS unsigned char* Ds) {
#pragma unroll 2
    for (int s = 0; s < NSAMP; ++s) {
        const float* pp = sp + (size_t)s * 15 * 512; float pv[15];
#pragma unroll
        for (int j = 0; j < 15; ++j) pv[j] = pp[(size_t)j * 512];
        const float x = XP[(size_t)(SROW0 + s) * 512 + ch]; float a = x;
#pragma unroll
        for (int j = 16 - WLEN; j < 15; ++j) a += pv[j];
        const float dm = a * (1.0f / WLEN) - x;
        float* op = out + O_SP + ((size_t)(l * NSAMP + s) * 15) * 512 + ch;
#pragma unroll
        for (int j = 0; j < 14; ++j) op[(size_t)j * 512] = pv[j + 1];
        op[(size_t)14 * 512] = x;
        *(LAS bf16*)(Ds + SWZ(32 + s, ch >> 3, 1024) + (ch & 7) * 2) = (bf16)(pk2(dm, 0.f) & 0xffffu);
    }
}
__device__ __forceinline__ void pool_unit(const Args& AR, Frame& F, int l, int c) {
    int tid_ = F.tid; asm volatile("" : "+v"(tid_));
    const int tid = tid_, lane = tid & 63, w = F.wave, t16 = lane & 15, cq = lane >> 4;
    const int row0 = 64 * c;
    unsigned char* ws = F.ws; asm volatile("" : "+s"(ws));
    const float* XP = (const float*)(ws + WS_XP);
    LAS unsigned char* Ds = F.lds;
    LAS float* red = (LAS float*)(F.lds + ESC_OFF);
    { const int ch = tid, wsel = w >> 1;
      const float* sp = AR.in[IN_SPOOL] + (size_t)l * NSAMP * 15 * 512 + ch;
#pragma unroll 1
      for (int half = 0; half < 2; ++half) {
          if (c == NCHUNK - 1 && half == 1) {
              if (wsel == 0) pool_sample_rows<2>(XP, sp, F.out, l, ch, Ds); else if (wsel == 1) pool_sample_rows<4>(XP, sp, F.out, l, ch, Ds);
              else if (wsel == 2) pool_sample_rows<8>(XP, sp, F.out, l, ch, Ds); else pool_sample_rows<16>(XP, sp, F.out, l, ch, Ds);
          } else {
              const int rfirst = row0 + 32 * half;
              if (wsel == 0) pool_half<2>(XP, F.out, l, ch, rfirst, 32 * half, Ds); else if (wsel == 1) pool_half<4>(XP, F.out, l, ch, rfirst, 32 * half, Ds);
              else if (wsel == 2) pool_half<8>(XP, F.out, l, ch, rfirst, 32 * half, Ds); else pool_half<16>(XP, F.out, l, ch, rfirst, 32 * half, Ds);
          }
      } }
    WG_BAR();
    const int gp = w & 3, rh = w >> 2;
    f32x4 A[2][8];
#pragma unroll
    for (int mt = 0; mt < 2; ++mt)
#pragma unroll
        for (int nt = 0; nt < 8; ++nt) A[mt][nt] = (f32x4){0.f, 0.f, 0.f, 0.f};
    { const bf16* Wp = (const bf16*)(ws + WS_WPOOL) + ((size_t)(l * 4 + gp) * 128 + t16) * 128 + 8 * cq;
#pragma unroll
      for (int ks = 0; ks < 4; ++ks) {
          bf16x8 df[2];
#pragma unroll
          for (int mt = 0; mt < 2; ++mt) df[mt] = *(const LAS bf16x8*)(Ds + SWZ(32 * rh + 16 * mt + t16, 16 * gp + 4 * ks + cq, 1024));
#pragma unroll
          for (int nt = 0; nt < 8; ++nt) { const bf16x8 wf = *(const bf16x8*)(Wp + (size_t)nt * 16 * 128 + 32 * ks);
#pragma unroll
              for (int mt = 0; mt < 2; ++mt) A[mt][nt] = __builtin_amdgcn_mfma_f32_16x16x32_bf16(wf, df[mt], A[mt][nt], 0, 0, 0); }
      } }
#pragma unroll
    for (int mt = 0; mt < 2; ++mt) { float ss = 0.f;
#pragma unroll
        for (int nt = 0; nt < 8; ++nt) { const f32x4 sc = *(const f32x4*)(AR.in[IN_PSCALE] + l * 512 + 128 * gp + 16 * nt + 4 * cq);
#pragma unroll
            for (int e = 0; e < 4; ++e) { const float o = A[mt][nt][e] * sc[e]; A[mt][nt][e] = o; ss += o * o; } }
        ss += __shfl_xor(ss, 16); ss += __shfl_xor(ss, 32);
        if (cq == 0) red[(32 * rh + 16 * mt + t16) * 4 + gp] = ss; }
    WG_BAR();
    { const rsrc_t rs_ = ws_rsrc(ws);
#pragma unroll
      for (int mt = 0; mt < 2; ++mt) { const int rl = 32 * rh + 16 * mt + t16; const f32x4 a = *(const LAS f32x4*)(red + rl * 4);
          const float rsn = rsqrtf(((a[0] + a[1]) + (a[2] + a[3])) * (1.0f / 512.0f) + EPS);
          const size_t mo = WS_MIX + ((size_t)(row0 + rl) * DM + 1536 + 128 * gp + 4 * cq) * 2;
#pragma unroll
          for (int nt = 0; nt < 8; ++nt) ST8(rs_, mo + 32 * nt, ((v2u){pk2(A[mt][nt][0] * rsn, A[mt][nt][1] * rsn), pk2(A[mt][nt][2] * rsn, A[mt][nt][3] * rsn)})); } }
    WG_BAR();
}

#ifndef ACQ_SCOPE
#define ACQ_SCOPE "agent"
#endif
#ifndef PUBLISH_FENCE
#define PUBLISH_FENCE 0
#endif
enum { U_END = 0, U_PA = 1, U_PC = 2, U_PD = 3, U_PE = 4, U_SSM = 5, U_ATT = 6, U_SATT = 7, U_POOL = 8 };
constexpr int NPANEL = MP / 256;
constexpr int QCAP = 1024;
__host__ __device__ constexpr unsigned mkd(int type, int l, int a, int b) { return ((unsigned)type << 24) | ((unsigned)l << 20) | ((unsigned)a << 10) | (unsigned)b; }
__device__ __forceinline__ gu32* cnt_word(gu32* ctl, int l, int kind, int pm) { return ctl + CW_CNT + ((l * 5 + kind) * 40 + pm) * 16; }
__host__ __device__ constexpr unsigned mix_target(int pm) { return 3u * (unsigned)((MR - 256 * pm) < 256 ? (MR - 256 * pm) : 256); }

__device__ __forceinline__ void build_queue(unsigned* qt, int q) {
    int n = 1;
    for (int l = 0; l < NLAYER; ++l) {
        for (int pm = 0; pm < NPANEL; ++pm) { qt[n++] = mkd(U_PA, l, pm, q); if ((pm & 7) == q) { qt[n++] = mkd(U_PA, l, pm, 8); qt[n++] = mkd(U_PA, l, pm, 9); } }
        for (int c = q; c < NCHUNK; c += 8) qt[n++] = mkd(U_SSM, l, c, 0);
        for (int i = q; i < NBATCH * NQB; i += 8) qt[n++] = mkd(U_ATT, l, i, 0);
        for (int s = q; s < NSAMP; s += 8) qt[n++] = mkd(U_SATT, l, s, 0);
        for (int c = q; c < NCHUNK; c += 8) qt[n++] = mkd(U_POOL, l, c, 0);
        for (int pm = 0; pm < NPANEL; ++pm) qt[n++] = mkd(U_PC, l, pm, q);
        for (int pm = 0; pm < NPANEL; ++pm) for (int j = 0; j < 4; ++j) qt[n++] = mkd(U_PD, l, pm, 4 * q + j);
        for (int pm = 0; pm < NPANEL; ++pm) qt[n++] = mkd(U_PE, l, pm, q);
    }
    qt[0] = (unsigned)(n - 1);
}

struct Sched {
    gu32* ctl; const unsigned* qglob; LAS unsigned* qlds; volatile LAS unsigned* slot; int myq; unsigned nclaim;
    __device__ __forceinline__ unsigned claim_lane() {
        { const unsigned idx = __hip_atomic_fetch_add(ctl + CW_QHEAD + myq * 64, 1u, RLX_AGENT); if (idx < qlds[0]) return qlds[1 + idx]; }
        for (int k = 1; k < 8; ++k) { const int q = (myq + k) & 7; const unsigned* qg = qglob + (size_t)q * QCAP;
            if (__hip_atomic_load((gu32*)(ctl + CW_QHEAD + q * 64), RLX_AGENT) >= qg[0]) continue;
            const unsigned idx = __hip_atomic_fetch_add(ctl + CW_QHEAD + q * 64, 1u, RLX_AGENT); if (idx < qg[0]) return qg[1 + idx]; }
        return 0u;
    }
    __device__ __forceinline__ unsigned claim_wg(int tid) {
        const unsigned k = nclaim++ & 1u;
        if (tid == 0) slot[k] = claim_lane();
        WG_BAR();
        return slot[k];
    }
    __device__ __forceinline__ void poll(gu32* w, unsigned want) {
        unsigned sp = 0;
        while (__hip_atomic_load(w, RLX_AGENT) < want) { __builtin_amdgcn_s_sleep(2);
            if ((++sp & 1023u) == 0u) { if (__hip_atomic_load(ctl + CW_TMO, RLX_AGENT) != 0u) break; if (sp > (1u << 17)) { __hip_atomic_store(ctl + CW_TMO, 0x66u, RLX_AGENT); break; } } }
    }
    __device__ __forceinline__ bool ready_now(gu32* w, unsigned want) { return __hip_atomic_load(w, RLX_AGENT) >= want; }
    __device__ __forceinline__ bool deps_ready_now(unsigned d) {
        const int type = d >> 24, l = (d >> 20) & 15, a = (d >> 10) & 1023; bool ok = true;
        if (type == U_PA) { if (l > 0) { const int p2 = (a + 1 < NPANEL) ? a + 1 : NPANEL - 1; ok = ready_now(cnt_word(ctl, l - 1, 4, a), 8u) && ready_now(cnt_word(ctl, l - 1, 1, p2), mix_target(p2)); } }
        else if (type == U_PC) ok = ready_now(cnt_word(ctl, l, 1, a), mix_target(a));
        else if (type == U_PD) ok = ready_now(cnt_word(ctl, l, 2, a), 8u);
        else ok = ready_now(cnt_word(ctl, l, 3, a), 32u);
        if (ok) { __builtin_amdgcn_fence(__ATOMIC_ACQUIRE, ACQ_SCOPE); asm volatile("s_waitcnt vmcnt(0)" ::: "memory"); }
        return ok;
    }
    __device__ __forceinline__ void wait_deps(unsigned d, int tid) {
        if (tid == 0) {
            const int type = d >> 24, l = (d >> 20) & 15, a = (d >> 10) & 1023;
            if (type == U_PA) { if (l > 0) { poll(cnt_word(ctl, l - 1, 4, a), 8u); const int p2 = (a + 1 < NPANEL) ? a + 1 : NPANEL - 1; poll(cnt_word(ctl, l - 1, 1, p2), mix_target(p2)); } }
            else if (type == U_PC) poll(cnt_word(ctl, l, 1, a), mix_target(a));
            else if (type == U_PD) poll(cnt_word(ctl, l, 2, a), 8u);
            else if (type == U_PE) poll(cnt_word(ctl, l, 3, a), 32u);
            else if (type == U_SSM) poll(cnt_word(ctl, l, 0, a >> 2), 10u);
            else if (type == U_POOL) { poll(cnt_word(ctl, l, 0, a >> 2), 10u); const int r0 = 64 * a - 16; if (r0 >= 0) poll(cnt_word(ctl, l, 0, r0 >> 8), 10u); }
            else if (type == U_SATT) poll(cnt_word(ctl, l, 0, NPANEL - 1), 10u);
            else if (type == U_ATT) { const int b = a / NQB, i = a % NQB, t0 = 32 * i; const int rlo = b * TT + (t0 >= 128 ? t0 - 128 : 0), rhi = b * TT + ((t0 + 31 < TT) ? t0 + 31 : TT - 1);
                poll(cnt_word(ctl, l, 0, rlo >> 8), 10u); if ((rhi >> 8) != (rlo >> 8)) poll(cnt_word(ctl, l, 0, rhi >> 8), 10u); }
            __builtin_amdgcn_fence(__ATOMIC_ACQUIRE, ACQ_SCOPE);
            asm volatile("s_waitcnt vmcnt(0)" ::: "memory");
        }
        asm volatile("" ::: "memory"); __builtin_amdgcn_s_barrier(); asm volatile("" ::: "memory");
    }
    __device__ __forceinline__ void publish(unsigned d, int tid) {
        asm volatile("s_waitcnt vmcnt(0)" ::: "memory");
        WG_BAR();
        if (tid == 0) {
            const int type = d >> 24, l = (d >> 20) & 15, a = (d >> 10) & 1023;
#if PUBLISH_FENCE
            __builtin_amdgcn_fence(__ATOMIC_RELEASE, "agent");
            asm volatile("s_waitcnt vmcnt(0)" ::: "memory");
#endif
            if (type == U_PA) __hip_atomic_fetch_add(cnt_word(ctl, l, 0, a), 1u, RLX_AGENT);
            else if (type == U_PC) __hip_atomic_fetch_add(cnt_word(ctl, l, 2, a), 1u, RLX_AGENT);
            else if (type == U_PD) __hip_atomic_fetch_add(cnt_word(ctl, l, 3, a), 1u, RLX_AGENT);
            else if (type == U_PE) __hip_atomic_fetch_add(cnt_word(ctl, l, 4, a), 1u, RLX_AGENT);
            else if (type == U_SSM || type == U_POOL) __hip_atomic_fetch_add(cnt_word(ctl, l, 1, a >> 2), 64u, RLX_AGENT);
            else if (type == U_SATT) __hip_atomic_fetch_add(cnt_word(ctl, l, 1, NPANEL - 1), 1u, RLX_AGENT);
            else if (type == U_ATT) { const int b = a / NQB, i = a % NQB, t0 = 32 * i; const int r0 = b * TT + t0, r1 = b * TT + ((t0 + 31 < TT) ? t0 + 31 : TT - 1);
                const int p0 = r0 >> 8, p1 = r1 >> 8;
                if (p0 == p1) __hip_atomic_fetch_add(cnt_word(ctl, l, 1, p0), (unsigned)(r1 - r0 + 1), RLX_AGENT);
                else { __hip_atomic_fetch_add(cnt_word(ctl, l, 1, p0), (unsigned)(256 * p1 - r0), RLX_AGENT); __hip_atomic_fetch_add(cnt_word(ctl, l, 1, p1), (unsigned)(r1 - 256 * p1 + 1), RLX_AGENT); } }
        }
    }
};

#ifndef A_AUX
#define A_AUX 0
#endif
struct GU { const char* A; const char* B; unsigned voffA[2], voffB[2]; size_t hstep; int nt; unsigned d; pg8::Unit u; };

struct StreamCtx { unsigned char* ws; float* out; const float* gq; const float* gk; int R[2], C[2], Rp[2]; };
__device__ __forceinline__ void gu_fill(GU& g, unsigned d, const StreamCtx& X) {
    const int type = d >> 24, l = (d >> 20) & 15, pm = (d >> 10) & 1023, pn = d & 1023;
    unsigned char* ws = X.ws;
    const bf16* A; const bf16* B; int K = DM; bool perm = false;
    if (type == U_PA) { A = (const bf16*)(ws + WS_XB); B = (const bf16*)(ws + WS_WIN) + (size_t)l * INW * DM; }
    else if (type == U_PC) { A = (const bf16*)(ws + WS_MIX); B = (const bf16*)(ws + WS_WOUT) + (size_t)l * DM * DM; }
    else if (type == U_PD) { A = (const bf16*)(ws + WS_XB); B = (const bf16*)(ws + WS_W1) + (size_t)l * DFF * DM; perm = true; }
    else { A = (const bf16*)(ws + WS_H); B = (const bf16*)(ws + WS_W2) + (size_t)l * DM * DFF; K = DFF; }
    g.d = d; g.u.pm = pm; g.u.pn = pn; g.nt = K / 64; g.hstep = (size_t)128 * K * 2;
    g.A = (const char*)A + (size_t)pm * 256 * K * 2; g.B = (const char*)B + (size_t)pn * 256 * K * 2;
#pragma unroll
    for (int i = 0; i < 2; ++i) { g.voffA[i] = (unsigned)(X.R[i] * K + X.C[i]) * 2u; g.voffB[i] = (unsigned)((perm ? X.Rp[i] : X.R[i]) * K + X.C[i]) * 2u; }
}

__device__ __forceinline__ unsigned gemm_stream(const Args& AR, Frame& F, Sched& Q, unsigned d0) {
    int tid_ = threadIdx.x; asm volatile("" : "+v"(tid_));
    const int tid = tid_, wid = __builtin_amdgcn_readfirstlane(tid >> 6), lane = tid & 63, wr = wid >> 2, wc = wid & 3, fr = lane & 15, fq = lane >> 4;
    LAS unsigned char* lds = F.lds; LAS unsigned char* esc = F.lds + ESC_OFF;
    StreamCtx X; X.ws = F.ws; X.out = F.out;
#pragma unroll
    for (int i = 0; i < 2; ++i) { int R, C; pg8::stage_rc(tid * 16 + i * 8192, R, C); X.R[i] = R; X.C[i] = C; X.Rp[i] = (R & ~31) + pg8::perm32(R & 31); }
    const size_t kstep = (size_t)(pg8::BK * 2);
    const unsigned ldsw = (unsigned)wid * 1024u;
    const int aoff = pg8::lds_byte(wr * 64 + fr, fq * 8), boff = pg8::lds_byte(wc * 32 + fr, fq * 8);
#define PG8_SA(b, h) (((b) * 2 + (h)) * pg8::HTB)
#define PG8_SB(b, h) ((4 + (b) * 2 + (h)) * pg8::HTB)
#define PG8_STAGE(bufoff, gbase, voff) do { _Pragma("unroll") for (int _i = 0; _i < 2; ++_i) \
        __builtin_amdgcn_global_load_lds((const unsigned*)((const char*)(gbase) + (voff)[_i]), (LAS unsigned*)(lds + (bufoff) + ldsw + _i * 8192), 16, 0, 0); } while (0)
#define PG8_STAGE_A(bufoff, gbase, voff) do { _Pragma("unroll") for (int _i = 0; _i < 2; ++_i) \
        __builtin_amdgcn_global_load_lds((const unsigned*)((const char*)(gbase) + (voff)[_i]), (LAS unsigned*)(lds + (bufoff) + ldsw + _i * 8192), 16, 0, A_AUX); } while (0)
#define PG8_LDA(dst, b, h) do { _Pragma("unroll") for (int m = 0; m < 4; ++m) _Pragma("unroll") for (int k = 0; k < 2; ++k) dst[m][k] = *(const LAS bf16x8*)(lds + PG8_SA(b, h) + aoff + m * 2048 + k * 1024); } while (0)
#define PG8_LDB(dst, b, h) do { _Pragma("unroll") for (int n = 0; n < 2; ++n) _Pragma("unroll") for (int k = 0; k < 2; ++k) dst[n][k] = *(const LAS bf16x8*)(lds + PG8_SB(b, h) + boff + n * 2048 + k * 1024); } while (0)
#define PG8_MMA(ai, bj, At, Bt) do { if (mm[ai]) { __builtin_amdgcn_s_setprio(1); _Pragma("unroll") for (int m = 0; m < 4; ++m) _Pragma("unroll") for (int n = 0; n < 2; ++n) _Pragma("unroll") for (int k = 0; k < 2; ++k) \
        acc[ai][bj][m][n] = __builtin_amdgcn_mfma_f32_16x16x32_bf16(Bt[n][k], At[m][k], acc[ai][bj][m][n], 0, 0, 0); __builtin_amdgcn_s_setprio(0); } } while (0)
#define PG8_WAIT_V(n) asm volatile("s_waitcnt vmcnt(" #n ")" ::: "memory")
#define PG8_WAIT_L(n) asm volatile("s_waitcnt lgkmcnt(" #n ")" ::: "memory")
#define PG8_BAR __builtin_amdgcn_s_barrier()
#define PG8_SCHED __builtin_amdgcn_sched_barrier(0)
    GU cur;
    gu_fill(cur, d0, X);
    f32x4 acc[2][2][4][2];
#pragma unroll
    for (int a = 0; a < 2; ++a)
#pragma unroll
        for (int b = 0; b < 2; ++b)
#pragma unroll
            for (int m = 0; m < 4; ++m)
#pragma unroll
                for (int n = 0; n < 2; ++n) acc[a][b][m][n] = (f32x4){0.f, 0.f, 0.f, 0.f};
    bf16x8 At[4][2], B0[2][2], B1[2][2];
    Q.wait_deps(cur.d, tid);
    PG8_STAGE(PG8_SB(0, 0), cur.B, cur.voffB); PG8_STAGE(PG8_SB(0, 1), cur.B + cur.hstep, cur.voffB); PG8_STAGE_A(PG8_SA(0, 0), cur.A, cur.voffA); PG8_STAGE_A(PG8_SA(0, 1), cur.A + cur.hstep, cur.voffA);
    if (wr == 1) PG8_BAR;
    PG8_WAIT_V(2); PG8_BAR;
    PG8_STAGE(PG8_SB(1, 0), cur.B + kstep, cur.voffB); PG8_STAGE_A(PG8_SA(1, 0), cur.A + kstep, cur.voffA); PG8_STAGE(PG8_SB(1, 1), cur.B + cur.hstep + kstep, cur.voffB);
    PG8_WAIT_V(6); PG8_BAR;
    unsigned carry = 0u; unsigned ui = 0u;
    for (;;) {
        bool go = false;
        const char* cA = cur.A; const char* cB = cur.B; const size_t hstep = cur.hstep; const int nt = cur.nt;
        const bool fullp = cur.u.pm != NPANEL - 1; const bool mm[2] = {fullp || wr == 0, fullp};
        for (int t = 0; t < nt; t += 2) {
            const bool last = (t == nt - 2);
            const char* a1 = cA + (size_t)(t + 1) * kstep;
            const char* a2_ = cA + (size_t)(last ? 0 : t + 2) * kstep; const char* b2_ = cB + (size_t)(last ? 0 : t + 2) * kstep;
            const char* a2 = a2_; const char* b2 = b2_; size_t h2 = hstep;
            unsigned vA2[2], vB2[2];
#pragma unroll
            for (int i = 0; i < 2; ++i) { vA2[i] = cur.voffA[i]; vB2[i] = cur.voffB[i]; }
            if (last) {
                const unsigned k = 2u + (ui & 1u);
                if (tid == 0) { const unsigned dn = Q.claim_lane(); Q.slot[k] = dn;
                    Q.slot[2u + k] = ((dn >> 24) >= U_PA && (dn >> 24) <= U_PE && (!STREAM_SAME_SECTION || ((dn >> 20) == (cur.d >> 20))) && Q.deps_ready_now(dn)) ? 1u : 0u; }
                asm volatile("s_waitcnt lgkmcnt(0)" ::: "memory"); PG8_BAR; asm volatile("" ::: "memory");
                carry = Q.slot[k]; go = Q.slot[2u + k] != 0u;
                if (go) { GU n2; gu_fill(n2, carry, X); a2 = n2.A; b2 = n2.B; h2 = n2.hstep;
#pragma unroll
                    for (int i = 0; i < 2; ++i) { vA2[i] = n2.voffA[i]; vB2[i] = n2.voffB[i]; } }
            }
            const char* a3 = a2 + kstep; const char* b3 = b2 + kstep;
            PG8_LDB(B0, 0, 0); PG8_LDB(B1, 0, 1); PG8_SCHED; PG8_LDA(At, 0, 0); PG8_STAGE_A(PG8_SA(1, 1), a1 + hstep, cur.voffA);
            PG8_WAIT_V(8); PG8_WAIT_L(0); PG8_BAR; PG8_MMA(0, 0, At, B0); PG8_MMA(0, 1, At, B1); PG8_BAR; PG8_SCHED;
            PG8_LDA(At, 0, 1); PG8_STAGE(PG8_SB(0, 0), b2, vB2); PG8_STAGE(PG8_SB(0, 1), b2 + h2, vB2); PG8_STAGE_A(PG8_SA(0, 0), a2, vA2);
            PG8_WAIT_V(8); PG8_WAIT_L(0); PG8_BAR; PG8_MMA(1, 0, At, B0); PG8_MMA(1, 1, At, B1); PG8_BAR; PG8_SCHED;
            PG8_LDB(B0, 1, 0); PG8_LDB(B1, 1, 1); PG8_SCHED; PG8_LDA(At, 1, 0); PG8_STAGE_A(PG8_SA(0, 1), a2 + h2, vA2);
            PG8_WAIT_V(8); PG8_WAIT_L(0); PG8_BAR; PG8_MMA(0, 0, At, B0); PG8_MMA(0, 1, At, B1); PG8_BAR; PG8_SCHED;
            PG8_LDA(At, 1, 1); PG8_STAGE(PG8_SB(1, 0), b3, vB2); PG8_STAGE(PG8_SB(1, 1), b3 + h2, vB2); PG8_STAGE_A(PG8_SA(1, 0), a3, vA2);
            PG8_WAIT_V(8); PG8_WAIT_L(0); PG8_BAR; PG8_MMA(1, 0, At, B0); PG8_MMA(1, 1, At, B1); PG8_BAR; PG8_SCHED;
        }
        if (wr == 0) PG8_BAR;
        { const int type = cur.d >> 24, l = (cur.d >> 20) & 15;
          if (type == U_PA) { EpiProj E{X.ws, X.out, AR.in[IN_GQ] + l * 128, AR.in[IN_GK] + l * 128, l}; E(acc, cur.u, wr, wc, fr, fq, esc, tid); }
          else if (type == U_PD) { EpiFfn1 E{X.ws}; E(acc, cur.u, wr, wc, fr, fq, esc, tid); }
          else { EpiRes E{X.ws, X.out, (type == U_PE && l == NLAYER - 1) ? 1 : 0}; E(acc, cur.u, wr, wc, fr, fq, esc, tid); }
          Q.publish(cur.d, tid); }
        if (!go) break;
#pragma unroll
        for (int a = 0; a < 2; ++a)
#pragma unroll
            for (int b = 0; b < 2; ++b)
#pragma unroll
                for (int m = 0; m < 4; ++m)
#pragma unroll
                    for (int n = 0; n < 2; ++n) acc[a][b][m][n] = (f32x4){0.f, 0.f, 0.f, 0.f};
        gu_fill(cur, carry, X); ++ui;
        if (wr == 1) PG8_BAR;
    }
    PG8_WAIT_V(0);
    PG8_BAR;
#undef PG8_SA
#undef PG8_SB
#undef PG8_STAGE
#undef PG8_STAGE_A
#undef PG8_LDA
#undef PG8_LDB
#undef PG8_MMA
#undef PG8_WAIT_V
#undef PG8_WAIT_L
#undef PG8_BAR
#undef PG8_SCHED
    return carry;
}

__global__ void __launch_bounds__(512, 2) hymba_fwd(Args args) {
    extern __shared__ __attribute__((aligned(16))) unsigned char lds[];
    Frame F;
    F.lds = (LAS unsigned char*)lds;
    F.MISC = (volatile LAS unsigned*)(F.lds + MISC_OFF);
    F.tid = threadIdx.x; F.lane = F.tid & 63; F.wave = __builtin_amdgcn_readfirstlane(F.tid >> 6);
    F.G = gridDim.x; { const int bx = blockIdx.x; F.vcu = (F.G % 8 == 0) ? (bx % 8) * (F.G / 8) + bx / 8 : bx; }
    F.ws = args.ws; F.out = args.out; F.ctl = (gu32*)(args.ws + WS_CTL);
    for (int u = F.tid; u < (LDS_BYTES - LDSCTL_OFF) / 4; u += 512) ((LAS unsigned*)(F.lds + LDSCTL_OFF))[u] = 0u;
    __syncthreads();
    XcdBarrier bar = xcd_barrier_post((unsigned*)(F.ctl + CW_BAR), F.MISC + 8);
    for (int rep = 0; rep < DUP_P0; ++rep) p0_prologue(args, F);
    if (blockIdx.x < 8 && F.tid == 0) build_queue((unsigned*)(args.ws + WS_QUEUE) + (size_t)blockIdx.x * QCAP, (int)blockIdx.x);
    xcd_barrier(bar);
    Sched Q; Q.ctl = F.ctl; Q.qglob = (const unsigned*)(args.ws + WS_QUEUE); Q.qlds = (LAS unsigned*)(F.lds + QTAB_OFF); Q.slot = F.MISC; Q.myq = (int)(bar.x & 7u); Q.nclaim = 0u;
    { const unsigned* qg = Q.qglob + (size_t)Q.myq * QCAP; for (int i = F.tid; i < QCAP; i += 512) Q.qlds[i] = qg[i]; }
    WG_BAR();
    unsigned d = Q.claim_wg(F.tid);
#if SEC_BARRIER
    int cursec = 0;
#endif
    for (;;) {
        const int type = d >> 24;
#if SEC_BARRIER
        { const int sec = (type == U_END) ? 5 * NLAYER : ((d >> 20) & 15) * 5 + ((type >= U_SSM) ? 1 : (type == U_PA ? 0 : type));
          while (cursec < sec) { if ((SEC_MASK >> cursec) & 1) xcd_barrier(bar); ++cursec; } }
#endif
        if (type == U_END) break;
        if (type <= U_PE) { d = gemm_stream(args, F, Q, d); continue; }
        const int l = (d >> 20) & 15, a = (d >> 10) & 1023;
        Q.wait_deps(d, F.tid);
        if (type == U_SSM) ssm_unit(args, F, l, a);
        else if (type == U_ATT) attn_unit(args, F, l, a / NQB, a % NQB);
        else if (type == U_SATT) sattn_unit(args, F, l, a);
        else pool_unit(args, F, l, a);
        Q.publish(d, F.tid);
        d = Q.claim_wg(F.tid);
    }
}

extern "C" void kernel_launch(void* const* d_in, const int* in_sizes, int n_in, void* d_out, int out_size, void* d_ws, size_t ws_size, hipStream_t stream) {
    static int grid = 0;
    if (grid == 0) {
        if (n_in != 32 || (size_t)out_size != O_END || ws_size < WS_END) { fprintf(stderr, "kernel_launch: unexpected shapes: n_in %d out %d (want %zu) ws %zu (want >= %zu)\n", n_in, out_size, (size_t)O_END, ws_size, (size_t)WS_END); grid = -1; return; }
        int dev = 0, cus = 0, per_cu = 0;
        if (hipGetDevice(&dev) != hipSuccess || hipDeviceGetAttribute(&cus, hipDeviceAttributeMultiprocessorCount, dev) != hipSuccess) { fprintf(stderr, "kernel_launch: device query failed\n"); grid = -1; return; }
        if (hipFuncSetAttribute((const void*)hymba_fwd, hipFuncAttributeMaxDynamicSharedMemorySize, LDS_BYTES) != hipSuccess) { fprintf(stderr, "kernel_launch: hipFuncSetAttribute failed\n"); grid = -1; return; }
        if (hipOccupancyMaxActiveBlocksPerMultiprocessor(&per_cu, (const void*)hymba_fwd, 512, LDS_BYTES) != hipSuccess || per_cu < 1) { fprintf(stderr, "kernel_launch: occupancy query says %d blocks per CU\n", per_cu); per_cu = 1; }
        (void)hipGetLastError();
        grid = cus;
        if (grid % 8 != 0) grid -= grid % 8;
    }
    if (grid < 0) return;
    (void)hipMemsetAsync((char*)d_ws + WS_CTL, 0, CTL_ZERO_BYTES, stream);
    Args a{};
    for (int i = 0; i < 32; ++i) a.in[i] = (const float*)d_in[i];
    a.out = (float*)d_out; a.ws = (unsigned char*)d_ws; a.ph_lo = 0; a.ph_hi = 0;
    hipLaunchKernelGGL(hymba_fwd, dim3(grid), dim3(512), LDS_BYTES, stream, a);
    const hipError_t le = hipPeekAtLastError();
    if (le != hipSuccess) fprintf(stderr, "kernel_launch: launch failed: %s\n", hipGetErrorName(le));
}
```

```cpp
#include <hip/hip_runtime.h>
#include <cstdio>
#include <cstdint>

#ifndef MK_N_LAUNCHES
#define MK_N_LAUNCHES 1
#endif

#ifndef SEC_BARRIER
#define SEC_BARRIER 0
#endif
#ifndef STREAM_SAME_SECTION
#define STREAM_SAME_SECTION 1
#endif
#ifndef SEC_MASK
#define SEC_MASK 0x10
#endif
#ifndef DUP_PB
#define DUP_PB 1
#endif
#ifndef DUP_P0
#define DUP_P0 1
#endif

constexpr int DM = 2048, TT = 4112  , NSEQ = 4096, NMETA = 16, NBATCH = 2, NSAMP = 32;
constexpr int MR = NBATCH * TT + NSAMP;
constexpr int MP = 8448;
constexpr int SROW0 = NBATCH * TT;
constexpr int INW = 2560, DFF = 8192, NLAYER = 2;
constexpr int TPV = 4128;
constexpr int ROPE_SAMPLE_IDX = TT;
constexpr float EPS = 1e-6f;
constexpr float LOG2E = 1.4426950408889634f;
constexpr float QSCALE = 0.08838834764831845f * LOG2E;
constexpr int NCHUNK = MR / 64;
constexpr int NQB = (TT + 31) / 32;

constexpr size_t O_YP = 0, O_YS = O_YP + (size_t)NBATCH * NSEQ * DM, O_PK = O_YS + (size_t)NSAMP * DM, O_PV = O_PK + (size_t)NLAYER * NBATCH * 128 * 256,
                 O_PSR = O_PV + (size_t)NLAYER * NBATCH * 128 * 256, O_PSI = O_PSR + (size_t)NLAYER * NBATCH * 2048, O_PP = O_PSI + (size_t)NLAYER * NBATCH * 2048,
                 O_SK = O_PP + (size_t)NLAYER * NBATCH * 15 * 512, O_SV = O_SK + (size_t)NLAYER * NSAMP * 128 * 256, O_SSR = O_SV + (size_t)NLAYER * NSAMP * 128 * 256,
                 O_SSI = O_SSR + (size_t)NLAYER * NSAMP * 2048, O_SP = O_SSI + (size_t)NLAYER * NSAMP * 2048, O_END = O_SP + (size_t)NLAYER * NSAMP * 15 * 512;

constexpr size_t MiB = 1u << 20;
constexpr size_t WS_CTL = 0, CTL_ZERO_BYTES = 1 * MiB;
constexpr size_t WS_WIN = 1 * MiB, WS_WOUT = 21 * MiB, WS_W1 = 37 * MiB, WS_W2 = 101 * MiB, WS_WGLU = 165 * MiB, WS_WPOOL = 166 * MiB, WS_TAB = 167 * MiB;
constexpr size_t WS_X = 170 * MiB, WS_XB = 236 * MiB, WS_Q = 269 * MiB, WS_K = 286 * MiB, WS_VT = 291 * MiB, WS_U = 296 * MiB, WS_XP = 313 * MiB, WS_MIX = 330 * MiB,
                 WS_H = 363 * MiB, WS_SSQ = 495 * MiB, WS_SST = 497 * MiB, WS_KSN = 502 * MiB, WS_QUEUE = 503 * MiB, WS_END = 504 * MiB;
static_assert(WS_WIN + (size_t)NLAYER * INW * DM * 2 <= WS_WOUT && WS_WOUT + (size_t)NLAYER * DM * DM * 2 <= WS_W1 && WS_W1 + (size_t)NLAYER * DFF * DM * 2 <= WS_W2 && WS_W2 + (size_t)NLAYER * DFF * DM * 2 <= WS_WGLU, "ws map 1");
static_assert(WS_X + (size_t)MP * DM * 4 <= WS_XB && WS_XB + (size_t)MP * DM * 2 <= WS_Q && WS_Q + (size_t)MP * 1024 * 2 <= WS_K && WS_K + (size_t)MP * 256 * 2 <= WS_VT && WS_VT + (size_t)4 * 128 * TPV * 2 <= WS_U, "ws map 2");
static_assert(WS_U + (size_t)MP * 512 * 4 <= WS_XP && WS_XP + (size_t)MP * 512 * 4 <= WS_MIX && WS_MIX + (size_t)MP * DM * 2 <= WS_H && WS_H + (size_t)MP * DFF * 2 <= WS_SSQ && WS_SSQ + (size_t)MP * 32 * 4 <= WS_SST, "ws map 3");
static_assert(WS_SST + (size_t)NLAYER * NCHUNK * 32 * 64 * 8 <= WS_KSN, "ws map 4");
constexpr size_t TB_ABR = 0, TB_ABI = 8192, TB_ALR = 16384, TB_ALI = 24576, TB_A16R = 32768, TB_A16I = 40960, TB_A32R = 49152, TB_A32I = 57344,
                 TB_BBR = 65536, TB_BBI = TB_BBR + 131072, TB_PM = TB_BBI + 131072, TB_CMT = TB_PM + 524288, TB_LAYER = 1 * MiB;
static_assert(TB_CMT + 131072 <= TB_LAYER, "table map");
constexpr size_t WS_ROPE = WS_TAB + 2 * MiB;
constexpr size_t ROPE_N = (size_t)(TT + 1) * 16;
constexpr int CW_TMO = 0, CW_CODE = 1, CW_BAR = 4096, CW_QHEAD = 8192  , CW_CNT = 9216  , CW_SSMF = 16384  ;
static_assert(CW_CNT + NLAYER * 5 * 40 * 16 <= CW_SSMF, "ctl map: counters");
static_assert((CW_SSMF + NLAYER * NCHUNK * 8 * 16) * 4 <= (int)CTL_ZERO_BYTES, "ctl map");

constexpr int RING_BYTES = 131072, ESC_OFF = RING_BYTES  , QTAB_OFF = ESC_OFF + 12288  , LDSCTL_OFF = QTAB_OFF + 4096, MISC_OFF = LDSCTL_OFF + 320, LDS_BYTES = 148480;
static_assert(MISC_OFF + 128 <= LDS_BYTES, "LDS map");

#define GAS __attribute__((address_space(1)))
#define LAS __attribute__((address_space(3)))
typedef unsigned short bf16;
typedef unsigned v4u __attribute__((ext_vector_type(4)));
typedef unsigned v2u __attribute__((ext_vector_type(2)));
typedef float f32x2 __attribute__((ext_vector_type(2)));
typedef float f32x16 __attribute__((ext_vector_type(16)));
typedef __bf16 bf16x2_t __attribute__((ext_vector_type(2)));
typedef GAS unsigned gu32;
typedef GAS unsigned long long gu64;
#define RLX_AGENT __ATOMIC_RELAXED, __HIP_MEMORY_SCOPE_AGENT
#define LDS_WAIT() asm volatile("s_waitcnt lgkmcnt(0)" ::: "memory")
#define VM_WAIT() asm volatile("s_waitcnt vmcnt(0)" ::: "memory")
#define WG_BAR() do { asm volatile("s_waitcnt lgkmcnt(0)" ::: "memory"); __builtin_amdgcn_s_barrier(); asm volatile("" ::: "memory"); } while (0)
__device__ __forceinline__ unsigned pk2(float lo, float hi) { f32x2 v = {lo, hi}; bf16x2_t b = __builtin_convertvector(v, bf16x2_t); return __builtin_bit_cast(unsigned, b); }
__device__ __forceinline__ float bf2f(unsigned short h) { return __builtin_bit_cast(float, (unsigned)h << 16); }
__device__ __forceinline__ float wave_sum(float v) {
#pragma unroll
    for (int o = 1; o < 64; o <<= 1) v += __shfl_xor(v, o);
    return v;
}
__device__ __forceinline__ float wave_max(float v) {
#pragma unroll
    for (int o = 1; o < 64; o <<= 1) v = fmaxf(v, __shfl_xor(v, o));
    return v;
}

typedef __amdgpu_buffer_rsrc_t rsrc_t;
__device__ __forceinline__ rsrc_t ws_rsrc(unsigned char* ws) { return __builtin_amdgcn_make_buffer_rsrc(ws, 0, (int)WS_END, 0x00020000); }
#define ST16(r, off, v) __builtin_amdgcn_raw_buffer_store_b128(__builtin_bit_cast(v4u, (v)), (r), (unsigned)(off), 0, 16)
#define ST8(r, off, v)  __builtin_amdgcn_raw_buffer_store_b64((v), (r), (unsigned)(off), 0, 16)
#define ST4(r, off, v)  __builtin_amdgcn_raw_buffer_store_b32(__builtin_bit_cast(unsigned, (v)), (r), (unsigned)(off), 0, 16)
#define ST2(r, off, v)  __builtin_amdgcn_raw_buffer_store_b16((unsigned short)(v), (r), (unsigned)(off), 0, 16)
__host__ __device__ __forceinline__ int perm16(int o) { return 8 * ((o >> 2) & 1) + 4 * (o >> 3) + (o & 3); }

namespace pg8 {
#define PG8_LAS __attribute__((address_space(3)))
typedef unsigned short bf16_t;
typedef short bf16x8 __attribute__((ext_vector_type(8)));
typedef float f32x4 __attribute__((ext_vector_type(4)));
typedef unsigned u32x4 __attribute__((ext_vector_type(4)));
constexpr int BM = 256, BK = 64, HALF = 128, HTB = HALF * BK * 2  , STAGE_BYTES = 8 * HTB, NXCD = 8, WGM = 8;

__host__ __device__ __forceinline__ int lds_byte(int r, int c) { const int st = (r >> 4) * 2 + (c >> 5), rr = r & 15, cc = c & 31, ob = rr * 64 + cc * 2; return st * 1024 + (ob ^ (((ob >> 9) & 1) << 5)); }
__host__ __device__ __forceinline__ void stage_rc(int b, int& R, int& C) { const int st = b / 1024, sb = b % 1024, swz = sb ^ (((sb >> 9) & 1) << 5); R = (st >> 1) * 16 + swz / 64; C = (st & 1) * 32 + (swz % 64) / 2; }
__host__ __device__ __forceinline__ int perm32(int rho) { const int n = rho >> 4, i = rho & 15; return 8 * (i >> 2) + 4 * n + (i & 3); }

struct Unit { int pm, pn; };
struct Gemm { const bf16_t* A; const bf16_t* Bt; int M, N, K; };

struct StaticOrder {
    int nM, nN, nwg, G, c;
    __host__ __device__ void init(int M, int N, int G_, int c_) { nM = M / BM; nN = N / BM; nwg = nM * nN; G = G_; c = c_; }
    __host__ __device__ bool next(int i, Unit& u) const {
        const long L = (long)i * G + c; if (L >= nwg) return false;
        int wgid = (int)L; { const int q = nwg / NXCD, r = nwg % NXCD, xcd = wgid % NXCD, off = wgid / NXCD; wgid = (xcd < r ? xcd * (q + 1) : r * (q + 1) + (xcd - r) * q) + off; }
        const int nig = WGM * nN, gid = wgid / nig, fm = gid * WGM, gsz = (nM - fm) < WGM ? (nM - fm) : WGM;
        u.pm = fm + ((wgid % nig) % gsz); u.pn = (wgid % nig) / gsz; return true;
    }
    __device__ __forceinline__ void a_ready(const Unit&) const {}
    __device__ __forceinline__ void done(const Unit&) const {}
};


template <class Epi, class Sched, bool ALIGN_EPI = false, bool SP2 = false>
__device__ __forceinline__ void gemm_phase(PG8_LAS unsigned char* lds, PG8_LAS unsigned char* esc, const Gemm g, const Sched& S, const Epi& E) {
    int tid_ = threadIdx.x; asm volatile("" : "+v"(tid_));
    const int tid = tid_, wid = __builtin_amdgcn_readfirstlane(tid >> 6), lane = tid & 63, wr = wid >> 2, wc = wid & 3, fr = lane & 15, fq = lane >> 4;
    const int K = g.K, nt = K / BK;
    unsigned voffA[2], voffB[2];
#pragma unroll
    for (int i = 0; i < 2; ++i) { int R, C; stage_rc(tid * 16 + i * 8192, R, C); const int Rb = Epi::PERM ? ((R & ~31) + perm32(R & 31)) : R;
        voffA[i] = (unsigned)(R * K + C) * 2u; voffB[i] = (unsigned)(Rb * K + C) * 2u; }
    const size_t kstep = (size_t)(BK * 2);
    const size_t hstep = (size_t)HALF * K * 2;
    const size_t tstep = 2 * hstep;
    const unsigned ldsw = (unsigned)wid * 1024u;
    const int aoff = lds_byte(wr * 64 + fr, fq * 8), boff = lds_byte(wc * 32 + fr, fq * 8);
#define PG8_SA(b, h) (((b) * 2 + (h)) * HTB)
#define PG8_SB(b, h) ((4 + (b) * 2 + (h)) * HTB)
#define PG8_STAGE(bufoff, gbase, voff) do { _Pragma("unroll") for (int _i = 0; _i < 2; ++_i) \
        __builtin_amdgcn_global_load_lds((const unsigned*)((const char*)(gbase) + (voff)[_i]), (PG8_LAS unsigned*)(lds + (bufoff) + ldsw + _i * 8192), 16, 0, 0); } while (0)
#define PG8_LDA(dst, b, h) do { _Pragma("unroll") for (int m = 0; m < 4; ++m) _Pragma("unroll") for (int k = 0; k < 2; ++k) dst[m][k] = *(const PG8_LAS bf16x8*)(lds + PG8_SA(b, h) + aoff + m * 2048 + k * 1024); } while (0)
#define PG8_LDB(dst, b, h) do { _Pragma("unroll") for (int n = 0; n < 2; ++n) _Pragma("unroll") for (int k = 0; k < 2; ++k) dst[n][k] = *(const PG8_LAS bf16x8*)(lds + PG8_SB(b, h) + boff + n * 2048 + k * 1024); } while (0)
#define PG8_MMA(ai, bj, At, Bt) do { __builtin_amdgcn_s_setprio(1); _Pragma("unroll") for (int m = 0; m < 4; ++m) _Pragma("unroll") for (int n = 0; n < 2; ++n) _Pragma("unroll") for (int k = 0; k < 2; ++k) \
        acc[ai][bj][m][n] = __builtin_amdgcn_mfma_f32_16x16x32_bf16(Bt[n][k], At[m][k], acc[ai][bj][m][n], 0, 0, 0); __builtin_amdgcn_s_setprio(0); } while (0)
#define PG8_WAIT_V(n) asm volatile("s_waitcnt vmcnt(" #n ")" ::: "memory")
#define PG8_WAIT_L(n) asm volatile("s_waitcnt lgkmcnt(" #n ")" ::: "memory")
#define PG8_BAR __builtin_amdgcn_s_barrier()
#define PG8_SCHED __builtin_amdgcn_sched_barrier(0)
    Unit cur, nxt; int ui = 0;
    if (!S.next(0, cur)) return;
    f32x4 acc[2][2][4][2];
#pragma unroll
    for (int a = 0; a < 2; ++a)
#pragma unroll
        for (int b = 0; b < 2; ++b)
#pragma unroll
            for (int m = 0; m < 4; ++m)
#pragma unroll
                for (int n = 0; n < 2; ++n) acc[a][b][m][n] = (f32x4){0.f, 0.f, 0.f, 0.f};
    bf16x8 At[4][2], B0[2][2], B1[2][2];
    const char* cA = (const char*)g.A + (size_t)cur.pm * tstep; const char* cB = (const char*)g.Bt + (size_t)cur.pn * tstep;
    S.a_ready(cur);
    if constexpr (SP2) {
        PG8_STAGE(PG8_SB(0, 0), cB, voffB); PG8_STAGE(PG8_SB(0, 1), cB + hstep, voffB); PG8_STAGE(PG8_SA(0, 0), cA, voffA); PG8_STAGE(PG8_SA(0, 1), cA + hstep, voffA);
        if (wr == 1) PG8_BAR;
        PG8_WAIT_V(2); PG8_BAR;
        PG8_STAGE(PG8_SB(1, 0), cB + kstep, voffB); PG8_STAGE(PG8_SA(1, 0), cA + kstep, voffA); PG8_STAGE(PG8_SB(1, 1), cB + hstep + kstep, voffB);
        PG8_WAIT_V(6); PG8_BAR;
    } else {
        PG8_STAGE(PG8_SB(0, 0), cB, voffB); PG8_STAGE(PG8_SA(0, 0), cA, voffA); PG8_STAGE(PG8_SB(0, 1), cB + hstep, voffB); PG8_STAGE(PG8_SA(0, 1), cA + hstep, voffA);
        if (wr == 1) PG8_BAR;
        PG8_WAIT_V(4); PG8_BAR;
        PG8_STAGE(PG8_SB(1, 0), cB + kstep, voffB); PG8_STAGE(PG8_SA(1, 0), cA + kstep, voffA); PG8_STAGE(PG8_SB(1, 1), cB + hstep + kstep, voffB);
        PG8_WAIT_V(6); PG8_BAR;
    }
    for (;;) {
        const bool has_next = S.next(ui + 1, nxt);
        const char* nA = has_next ? (const char*)g.A + (size_t)nxt.pm * tstep : cA; const char* nB = has_next ? (const char*)g.Bt + (size_t)nxt.pn * tstep : cB;
        for (int t = 0; t < nt; t += 2) {
            const bool last = (t == nt - 2);
            const char* a1 = cA + (size_t)(t + 1) * kstep;
            const char* a2 = last ? nA : cA + (size_t)(t + 2) * kstep; const char* b2 = last ? nB : cB + (size_t)(t + 2) * kstep;
            const char* a3 = a2 + kstep; const char* b3 = b2 + kstep;
            if (last && has_next) S.a_ready(nxt);
            if constexpr (SP2) {
            PG8_LDB(B0, 0, 0); PG8_LDB(B1, 0, 1); PG8_SCHED; PG8_LDA(At, 0, 0); PG8_STAGE(PG8_SA(1, 1), a1 + hstep, voffA);
            PG8_WAIT_V(8); PG8_WAIT_L(0); PG8_BAR; PG8_MMA(0, 0, At, B0); PG8_MMA(0, 1, At, B1); PG8_BAR; PG8_SCHED;
            PG8_LDA(At, 0, 1); PG8_STAGE(PG8_SB(0, 0), b2, voffB); PG8_STAGE(PG8_SB(0, 1), b2 + hstep, voffB); PG8_STAGE(PG8_SA(0, 0), a2, voffA);
            PG8_WAIT_V(8); PG8_WAIT_L(0); PG8_BAR; PG8_MMA(1, 0, At, B0); PG8_MMA(1, 1, At, B1); PG8_BAR; PG8_SCHED;
            PG8_LDB(B0, 1, 0); PG8_LDB(B1, 1, 1); PG8_SCHED; PG8_LDA(At, 1, 0); PG8_STAGE(PG8_SA(0, 1), a2 + hstep, voffA);
            PG8_WAIT_V(8); PG8_WAIT_L(0); PG8_BAR; PG8_MMA(0, 0, At, B0); PG8_MMA(0, 1, At, B1); PG8_BAR; PG8_SCHED;
            PG8_LDA(At, 1, 1); PG8_STAGE(PG8_SB(1, 0), b3, voffB); PG8_STAGE(PG8_SB(1, 1), b3 + hstep, voffB); PG8_STAGE(PG8_SA(1, 0), a3, voffA);
            PG8_WAIT_V(8); PG8_WAIT_L(0); PG8_BAR; PG8_MMA(1, 0, At, B0); PG8_MMA(1, 1, At, B1); PG8_BAR; PG8_SCHED;
            } else {
            PG8_LDB(B0, 0, 0); PG8_SCHED; PG8_LDA(At, 0, 0); PG8_STAGE(PG8_SA(1, 1), a1 + hstep, voffA);
            PG8_WAIT_L(8); PG8_BAR; PG8_WAIT_L(0); PG8_MMA(0, 0, At, B0); PG8_BAR; PG8_SCHED;
            PG8_LDB(B1, 0, 1); PG8_STAGE(PG8_SB(0, 0), b2, voffB);
            PG8_BAR; PG8_WAIT_L(0); PG8_MMA(0, 1, At, B1); PG8_BAR;
            PG8_LDA(At, 0, 1); PG8_STAGE(PG8_SA(0, 0), a2, voffA);
            PG8_BAR; PG8_WAIT_L(0); PG8_MMA(1, 0, At, B0); PG8_BAR; PG8_SCHED;
            PG8_STAGE(PG8_SB(0, 1), b2 + hstep, voffB);
            PG8_WAIT_V(6); PG8_BAR; PG8_MMA(1, 1, At, B1); PG8_BAR;
            PG8_LDB(B0, 1, 0); PG8_SCHED; PG8_LDA(At, 1, 0); PG8_STAGE(PG8_SA(0, 1), a2 + hstep, voffA);
            PG8_WAIT_L(8); PG8_BAR; PG8_WAIT_L(0); PG8_MMA(0, 0, At, B0); PG8_BAR; PG8_SCHED;
            PG8_LDB(B1, 1, 1); PG8_STAGE(PG8_SB(1, 0), b3, voffB);
            PG8_BAR; PG8_WAIT_L(0); PG8_MMA(0, 1, At, B1); PG8_BAR;
            PG8_LDA(At, 1, 1); PG8_STAGE(PG8_SA(1, 0), a3, voffA);
            PG8_BAR; PG8_WAIT_L(0); PG8_MMA(1, 0, At, B0); PG8_BAR; PG8_SCHED;
            PG8_STAGE(PG8_SB(1, 1), b3 + hstep, voffB);
            PG8_WAIT_V(6); PG8_BAR; PG8_MMA(1, 1, At, B1); PG8_BAR;
            }
        }
        if constexpr (ALIGN_EPI) { if (wr == 0) PG8_BAR; }
        { E(acc, cur, wr, wc, fr, fq, esc, tid); S.done(cur); }
        if (!has_next) break;
#pragma unroll
        for (int a = 0; a < 2; ++a)
#pragma unroll
            for (int b = 0; b < 2; ++b)
#pragma unroll
                for (int m = 0; m < 4; ++m)
#pragma unroll
                    for (int n = 0; n < 2; ++n) acc[a][b][m][n] = (f32x4){0.f, 0.f, 0.f, 0.f};
        cur = nxt; cA = nA; cB = nB; ++ui;
        if constexpr (ALIGN_EPI) { if (wr == 1) PG8_BAR; }
    }
    PG8_WAIT_V(0);
    if constexpr (!ALIGN_EPI) { if (wr == 0) PG8_BAR; }
    PG8_BAR;
#undef PG8_SA
#undef PG8_SB
#undef PG8_STAGE
#undef PG8_LDA
#undef PG8_LDB
#undef PG8_MMA
#undef PG8_WAIT_V
#undef PG8_WAIT_L
#undef PG8_BAR
#undef PG8_SCHED
}
}

typedef float f32x4 __attribute__((ext_vector_type(4)));
typedef short bf16x8 __attribute__((ext_vector_type(8)));


__device__ __forceinline__ void build_rs(const float* ssq, int pm, LAS unsigned char* esc, int tid) {
    LAS float* rsT = (LAS float*)esc;
    WG_BAR();
    if (tid < 256) {
        float s = 0.f;
#pragma unroll
        for (int j = 0; j < 8; ++j) { const gu64* p = (const gu64*)(ssq + ((size_t)j * MP + pm * 256 + tid) * 4);
#pragma unroll
            for (int h = 0; h < 2; ++h) { const unsigned long long v = __hip_atomic_load(p + h, RLX_AGENT); s += __builtin_bit_cast(float, (unsigned)v) + __builtin_bit_cast(float, (unsigned)(v >> 32)); } }
        rsT[tid] = rsqrtf(s * (1.0f / DM) + EPS);
    }
    WG_BAR();
}

struct EpiProj {
    static constexpr bool PERM = false, AFTER_DRAIN = false;
    unsigned char* ws_; float* out_; const float* gq; const float* gk; int l;
    __device__ __forceinline__ void operator()(f32x4 (&acc)[2][2][4][2], const pg8::Unit& u, int wr, int wc, int fr, int fq, LAS unsigned char* esc, int tid) const {
        asm volatile("" : "+v"(fr), "+v"(fq), "+v"(tid));
        unsigned char* ws = ws_; asm volatile("" : "+s"(ws));
        const float* ssq = (const float*)(ws + WS_SSQ); const float* ropec = (const float*)(ws + WS_ROPE); const float* ropes = ropec + ROPE_N;
        bf16* Q = (bf16*)(ws + WS_Q); bf16* K = (bf16*)(ws + WS_K); bf16* VT = (bf16*)(ws + WS_VT); float* U = (float*)(ws + WS_U); float* XP = (float*)(ws + WS_XP);
        float* ksn = (float*)(ws + WS_KSN); float* vsn = ksn + NSAMP * 256;
        float* out_pk = out_ + O_PK + (size_t)l * NBATCH * 128 * 256; float* out_pv = out_ + O_PV + (size_t)l * NBATCH * 128 * 256;
        const rsrc_t rs_ = ws_rsrc(ws);
        build_rs(ssq, u.pm, esc, tid);
        const LAS float* rsT = (const LAS float*)esc;
        LAS float* hss = (LAS float*)(esc + 1024);
        const int pn = u.pn;
#pragma unroll
        for (int ai = 0; ai < 2; ++ai)
#pragma unroll
            for (int m = 0; m < 4; ++m) { const float rsv = rsT[ai * 128 + wr * 64 + m * 16 + fr];
#pragma unroll
                for (int bj = 0; bj < 2; ++bj)
#pragma unroll
                    for (int n = 0; n < 2; ++n) acc[ai][bj][m][n] *= rsv; }
        if (pn <= 4) {
#pragma unroll
            for (int ai = 0; ai < 2; ++ai)
#pragma unroll
                for (int m = 0; m < 4; ++m)
#pragma unroll
                    for (int bj = 0; bj < 2; ++bj) { const f32x4 a = acc[ai][bj][m][0], b = acc[ai][bj][m][1];
                        float s = (a[0] * a[0] + a[1] * a[1]) + (a[2] * a[2] + a[3] * a[3]) + (b[0] * b[0] + b[1] * b[1]) + (b[2] * b[2] + b[3] * b[3]);
                        s += __shfl_xor(s, 16); s += __shfl_xor(s, 32);
                        if (fq == 0) hss[(bj * 256 + ai * 128 + wr * 64 + m * 16 + fr) * 4 + wc] = s; }
            WG_BAR();
            const float* g = (pn < 4) ? gq : gk; const float osc = (pn < 4) ? QSCALE : 1.0f;
            f32x4 gv[2];
#pragma unroll
            for (int n = 0; n < 2; ++n) gv[n] = *(const f32x4*)(g + wc * 32 + n * 16 + 4 * fq);
#pragma unroll
            for (int ai = 0; ai < 2; ++ai)
#pragma unroll
                for (int m = 0; m < 4; ++m) {
                    const int rl = ai * 128 + wr * 64 + m * 16 + fr, r = u.pm * 256 + rl;
                    const bool samp = r >= SROW0, pad = r >= MR;
                    const int b = (r >= TT && !samp) ? 1 : 0, t = r - b * TT;
                    const int pidx = samp ? ROPE_SAMPLE_IDX : t;
                    f32x4 cs = {1.f, 1.f, 1.f, 1.f}, sn = {0.f, 0.f, 0.f, 0.f};
                    if (wc == 0 && !pad) { cs = *(const f32x4*)(ropec + (size_t)pidx * 16 + 4 * fq); sn = *(const f32x4*)(ropes + (size_t)pidx * 16 + 4 * fq); }
#pragma unroll
                    for (int bj = 0; bj < 2; ++bj) {
                        const f32x4 hv = *(const LAS f32x4*)(hss + (bj * 256 + rl) * 4);
                        const float hn = rsqrtf(((hv[0] + hv[1]) + (hv[2] + hv[3])) * (1.0f / 128.0f) + EPS);
                        f32x4 x1 = acc[ai][bj][m][0] * hn * gv[0], x2 = acc[ai][bj][m][1] * hn * gv[1];
                        if (wc == 0) { const f32x4 o1 = x1 * cs - x2 * sn, o2 = x2 * cs + x1 * sn; x1 = o1; x2 = o2; }
                        x1 = x1 * osc; x2 = x2 * osc;
                        const int cl = bj * 128 + wc * 32 + 4 * fq;
                        if (pn < 4) { const size_t qo = WS_Q + ((size_t)r * 1024 + pn * 256 + cl) * 2;
                            ST8(rs_, qo, ((v2u){pk2(x1[0], x1[1]), pk2(x1[2], x1[3])})); ST8(rs_, qo + 32, ((v2u){pk2(x2[0], x2[1]), pk2(x2[2], x2[3])})); }
                        else { const size_t ko = WS_K + ((size_t)r * 256 + cl) * 2;
                            ST8(rs_, ko, ((v2u){pk2(x1[0], x1[1]), pk2(x1[2], x1[3])})); ST8(rs_, ko + 32, ((v2u){pk2(x2[0], x2[1]), pk2(x2[2], x2[3])}));
                            if (samp && !pad) { const size_t o = WS_KSN + ((size_t)(r - SROW0) * 256 + cl) * 4; ST16(rs_, o, x1); ST16(rs_, o + 64, x2); }
                            else if (!samp && t >= TT - 128) { float* o = out_pk + ((size_t)(b * 128 + (t - (TT - 128))) * 256) + cl; *(f32x4*)o = x1; *(f32x4*)(o + 16) = x2; } }
                    }
                }
        } else if (pn == 5) {
#pragma unroll
            for (int ai = 0; ai < 2; ++ai)
#pragma unroll
                for (int m = 0; m < 4; ++m) {
                    const int rl = ai * 128 + wr * 64 + m * 16 + fr, r = u.pm * 256 + rl;
                    const bool samp = r >= SROW0, pad = r >= MR;
                    const int b = (r >= TT && !samp) ? 1 : 0, t = r - b * TT;
                    const int tpos = (t & ~15) + perm16(t & 15);
#pragma unroll
                    for (int bj = 0; bj < 2; ++bj)
#pragma unroll
                        for (int n = 0; n < 2; ++n) { const f32x4 x = acc[ai][bj][m][n]; const int d = wc * 32 + n * 16 + 4 * fq;
                            if (!samp) { const size_t vo = WS_VT + (((size_t)((b * 2 + bj) * 128 + d)) * TPV + tpos) * 2;
#pragma unroll
                                for (int j = 0; j < 4; ++j) ST2(rs_, vo + (size_t)j * TPV * 2, pk2(x[j], 0.f) & 0xffffu);
                                if (t >= TT - 128) *(f32x4*)(out_pv + ((size_t)(b * 128 + (t - (TT - 128))) * 256) + bj * 128 + d) = x; }
                            else if (!pad) ST16(rs_, WS_KSN + ((size_t)NSAMP * 256 + (size_t)(r - SROW0) * 256 + bj * 128 + d) * 4, x); }
                }
        } else {
            const size_t dsto = (pn < 8) ? WS_U + (size_t)(pn - 6) * 256 * 4 : WS_XP + (size_t)(pn - 8) * 256 * 4;
#pragma unroll
            for (int ai = 0; ai < 2; ++ai)
#pragma unroll
                for (int m = 0; m < 4; ++m) { const size_t ro = dsto + ((size_t)(u.pm * 256 + ai * 128 + wr * 64 + m * 16 + fr) * 512 + wc * 32 + 4 * fq) * 4;
#pragma unroll
                    for (int bj = 0; bj < 2; ++bj)
#pragma unroll
                        for (int n = 0; n < 2; ++n) ST16(rs_, ro + (size_t)(bj * 128 + n * 16) * 4, acc[ai][bj][m][n]); }
        }
    }
};

struct EpiRes {
    static constexpr bool PERM = false, AFTER_DRAIN = false;
    unsigned char* ws_; float* out; int last;
    __device__ __forceinline__ void operator()(f32x4 (&acc)[2][2][4][2], const pg8::Unit& u, int wr, int wc, int fr, int fq, LAS unsigned char* esc, int tid) const {
        asm volatile("" : "+v"(fr), "+v"(fq), "+v"(tid));
        unsigned char* ws = ws_; asm volatile("" : "+s"(ws));
        const float* X = (const float*)(ws + WS_X); const rsrc_t rs_ = ws_rsrc(ws);
#pragma unroll
        for (int ai = 0; ai < 2; ++ai)
#pragma unroll
            for (int m = 0; m < 4; ++m) {
                const int r = u.pm * 256 + ai * 128 + wr * 64 + m * 16 + fr; const int c0 = u.pn * 256 + wc * 32 + 4 * fq;
                const float* xp = X + (size_t)r * DM + c0; float s = 0.f; const size_t eo = (size_t)r * DM + c0;
                f32x4 v[2][2];
#pragma unroll
                for (int bj = 0; bj < 2; ++bj)
#pragma unroll
                    for (int n = 0; n < 2; ++n) { v[bj][n] = *(const f32x4*)(xp + bj * 128 + n * 16) + acc[ai][bj][m][n]; const f32x4 q = v[bj][n] * v[bj][n]; s += (q[0] + q[1]) + (q[2] + q[3]); }
                if (!last) {
#pragma unroll
                    for (int bj = 0; bj < 2; ++bj)
#pragma unroll
                        for (int n = 0; n < 2; ++n) { ST16(rs_, WS_X + (eo + bj * 128 + n * 16) * 4, v[bj][n]); ST8(rs_, WS_XB + (eo + bj * 128 + n * 16) * 2, ((v2u){pk2(v[bj][n][0], v[bj][n][1]), pk2(v[bj][n][2], v[bj][n][3])})); }
                    s += __shfl_xor(s, 16); s += __shfl_xor(s, 32);
                    if (fq == 0) ST4(rs_, WS_SSQ + (((size_t)u.pn * MP + r) * 4 + wc) * 4, s);
                } else {
                    const bool samp = r >= SROW0, pad = r >= MR; const int b = (r >= TT && !samp) ? 1 : 0, t = r - b * TT;
                    float* op = nullptr;
                    if (samp) { if (!pad) op = out + O_YS + (size_t)(r - SROW0) * DM + c0; } else if (t >= NMETA) op = out + O_YP + ((size_t)b * NSEQ + (t - NMETA)) * DM + c0;
                    if (op) {
#pragma unroll
                        for (int bj = 0; bj < 2; ++bj)
#pragma unroll
                            for (int n = 0; n < 2; ++n) *(f32x4*)(op + bj * 128 + n * 16) = v[bj][n]; }
                }
                if (m & 1) asm volatile("" ::: "memory");
            }
    }
};

struct EpiFfn1 {
    static constexpr bool PERM = true, AFTER_DRAIN = false;
    unsigned char* ws_;
    __device__ __forceinline__ void operator()(f32x4 (&acc)[2][2][4][2], const pg8::Unit& u, int wr, int wc, int fr, int fq, LAS unsigned char* esc, int tid) const {
        asm volatile("" : "+v"(fr), "+v"(fq), "+v"(tid));
        unsigned char* ws = ws_; asm volatile("" : "+s"(ws));
        const rsrc_t rs_ = ws_rsrc(ws);
        build_rs((const float*)(ws + WS_SSQ), u.pm, esc, tid);
        const LAS float* rsT = (const LAS float*)esc;
#pragma unroll
        for (int ai = 0; ai < 2; ++ai)
#pragma unroll
            for (int m = 0; m < 4; ++m) { const int rl = ai * 128 + wr * 64 + m * 16 + fr; const float rsv = rsT[rl];
                const size_t ho = WS_H + ((size_t)(u.pm * 256 + rl) * DFF + u.pn * 256 + wc * 32 + 8 * fq) * 2;
#pragma unroll
                for (int bj = 0; bj < 2; ++bj) { f32x4 v0 = acc[ai][bj][m][0] * rsv, v1 = acc[ai][bj][m][1] * rsv;
#pragma unroll
                    for (int j = 0; j < 4; ++j) { const float a = fmaxf(v0[j], 0.f), b = fmaxf(v1[j], 0.f); v0[j] = a * a; v1[j] = b * b; }
                    ST16(rs_, ho + bj * 256, ((v4u){pk2(v0[0], v0[1]), pk2(v0[2], v0[3]), pk2(v1[0], v1[1]), pk2(v1[2], v1[3])})); } }
    }
};

#define XB_TMO      128
#define XB_XCNT(j)  (256  + 64 * (j))
#define XB_XSUB(j)  (1280 + 64 * (j))
#define XB_XGEN(j)  (2304 + 64 * (j))
#define XB_TOP      3328
#define XB_TOPGEN   3392
#define XCD_BAR_WORDS 3456
#define XB_SPIN_CAP (1u << 18)
__device__ __forceinline__ unsigned xb_ld(unsigned* p)              { return __hip_atomic_load(p, __ATOMIC_RELAXED, __HIP_MEMORY_SCOPE_AGENT); }
__device__ __forceinline__ unsigned xb_add(unsigned* p, unsigned v) { return __hip_atomic_fetch_add(p, v, __ATOMIC_RELAXED, __HIP_MEMORY_SCOPE_AGENT); }
__device__ __forceinline__ unsigned xb_xcc_id() { return (unsigned)__builtin_amdgcn_s_getreg((3 << 11) | 20) & 0xFu; }
#define XB_SPIN(cond, bar) do { unsigned _sp = 0; while (cond) { __builtin_amdgcn_s_sleep(1); \
    if ((++_sp & 255u) == 0u) { if (xb_ld(&(bar)[XB_TMO])) break; if (_sp > XB_SPIN_CAP) { atomicAdd(&(bar)[XB_TMO], 1u); break; } } } } while (0)

struct XcdBarrier {
    unsigned* bar; unsigned x;
    volatile LAS unsigned* st;
};

__device__ __forceinline__ XcdBarrier xcd_barrier_post(unsigned* bar, volatile LAS unsigned* st) {
    XcdBarrier b; b.bar = bar; b.x = xb_xcc_id(); b.st = st;
    if (threadIdx.x == 0) (void)xb_add(&bar[XB_XCNT(b.x)], 1u);
    return b;
}
__device__ __forceinline__ void xcd_barrier_complete(unsigned* bar, unsigned x, unsigned& nloc, unsigned& nx) {
    const unsigned G = gridDim.x * gridDim.y * gridDim.z;
    unsigned sum, cnt, mine, sp = 0u;
    for (;;) {
        sum = 0u; cnt = 0u; mine = 0u;
#pragma unroll
        for (unsigned j = 0; j < 16; ++j) { const unsigned c = xb_ld(&bar[XB_XCNT(j)]); sum += c; cnt += (c > 0u) ? 1u : 0u; mine = (j == x) ? c : mine; }
        if (sum == G) break;
        __builtin_amdgcn_s_sleep(1);
        if ((++sp & 255u) == 0u) { if (xb_ld(&bar[XB_TMO])) break; if (sp > XB_SPIN_CAP) { atomicAdd(&bar[XB_TMO], 1u); break; } }
    }
    nloc = mine > 0u ? mine : 1u; nx = cnt > 0u ? cnt : 1u;
}

__device__ __forceinline__ void xcd_barrier(const XcdBarrier& b) {
    asm volatile("s_waitcnt vmcnt(0)" ::: "memory");
    __syncthreads();
    if (threadIdx.x == 0) {
        unsigned* bar = b.bar;
        __builtin_amdgcn_s_waitcnt(0);
        unsigned nloc = b.st[0], nx = b.st[1];
        if (nloc == 0u) { xcd_barrier_complete(bar, b.x, nloc, nx); b.st[0] = nloc; b.st[1] = nx; }
        const unsigned old = xb_add(&bar[XB_XSUB(b.x)], 1u);
        const unsigned gen = old / nloc;
        if (old + 1u == (gen + 1u) * nloc) {
            __builtin_amdgcn_fence(__ATOMIC_RELEASE, "agent");
            asm volatile("s_waitcnt vmcnt(0)" ::: "memory");
            const unsigned og = xb_add(&bar[XB_TOP], 1u);
            const unsigned tg = og / nx;
            if (og + 1u == (tg + 1u) * nx) xb_add(&bar[XB_TOPGEN], 1u);
            else XB_SPIN(xb_ld(&bar[XB_TOPGEN]) == tg, bar);
            __builtin_amdgcn_fence(__ATOMIC_ACQUIRE, "agent");
            xb_add(&bar[XB_XGEN(b.x)], 1u);
            asm volatile("s_waitcnt vmcnt(0)" ::: "memory");
        } else {
            XB_SPIN(xb_ld(&bar[XB_XGEN(b.x)]) == gen, bar);
            __builtin_amdgcn_fence(__ATOMIC_ACQUIRE, "agent");
            asm volatile("s_waitcnt vmcnt(0)" ::: "memory");
        }
    }
    __syncthreads();
}

struct Frame {
    LAS unsigned char* lds;
    volatile LAS unsigned* MISC;
    gu32* ctl;
    int wave, vcu, G;
    __device__ __forceinline__ int lane() const { int l; asm volatile("v_mbcnt_lo_u32_b32 %0, -1, 0\n\tv_mbcnt_hi_u32_b32 %0, -1, %0" : "=v"(l)); return l; }
    __device__ __forceinline__ int tid() const { return wave * 64 + lane(); }
    float* out; unsigned char* ws;
};
#define IN_XPROMPT 0
#define IN_XSAMPLE 1
#define IN_CACHEK 2
#define IN_CACHEV 3
#define IN_SSMRE 4
#define IN_SSMIM 5
#define IN_SPOOL 6
#define IN_META 7
#define IN_GMIX 8
#define IN_WIN 9
#define IN_GQ 10
#define IN_GK 11
#define IN_SINKS 12
#define IN_ARE 13
#define IN_AIM 14
#define IN_LOGDT 15
#define IN_BRE 16
#define IN_BIM 17
#define IN_CRE 18
#define IN_CIM 19
#define IN_DSKIP 20
#define IN_WGLU 21
#define IN_BGLU 22
#define IN_WPOOL 23
#define IN_PSCALE 24
#define IN_GOA 25
#define IN_GOS 26
#define IN_GOP 27
#define IN_WOUT 28
#define IN_GFFN 29
#define IN_WFF1 30
#define IN_WFF2 31
struct Args { const float* in[32]; float* out; unsigned char* ws; int ph_lo, ph_hi; };
static_assert(sizeof(Args) == 32 * 8 + 8 + 8 + 8, "Args has no padding");

__device__ __forceinline__ void p0_transpose_item(const float* W, int K, int N, bf16* WT, const float* gain, LAS float* scr, int item, int lane) {
    const int nblk = N / 32, kb = item / nblk, nb = item % nblk, k0 = 64 * kb, n0 = 32 * nb;
    float wv[32];
#pragma unroll
    for (int i = 0; i < 32; ++i) wv[i] = W[(size_t)(k0 + 2 * i + (lane >> 5)) * N + n0 + (lane & 31)];
    if (gain) {
#pragma unroll
        for (int i = 0; i < 32; ++i) wv[i] *= gain[k0 + 2 * i + (lane >> 5)];
    }
#pragma unroll
    for (int i = 0; i < 32; ++i) scr[(2 * i + (lane >> 5)) * 33 + (lane & 31)] = wv[i];
    LDS_WAIT(); asm volatile("" ::: "memory");
    const int c = lane & 7;
#pragma unroll
    for (int j = 0; j < 4; ++j) { const int n = (lane >> 3) + 8 * j; const LAS float* s = scr + (8 * c) * 33 + n;
        v4u o; o.x = pk2(s[0 * 33], s[1 * 33]); o.y = pk2(s[2 * 33], s[3 * 33]); o.z = pk2(s[4 * 33], s[5 * 33]); o.w = pk2(s[6 * 33], s[7 * 33]);
        *(GAS v4u*)(WT + (size_t)(n0 + n) * K + k0 + 8 * c) = o; }
    LDS_WAIT(); asm volatile("" ::: "memory");
}
__device__ __forceinline__ void sincos_d(double x, double& s, double& c) {
    const double TWO_PI = 6.283185307179586476925286766559;
    const double k = rint(x * (1.0 / TWO_PI)); const double r = fma(-k, TWO_PI, x), r2 = r * r;
    const double fs[14] = {0.16666666666666666, 0.05, 0.023809523809523808, 0.013888888888888888, 0.00909090909090909, 0.00641025641025641, 0.004761904761904762, 0.003676470588235294,
                           0.0029239766081871343, 0.002380952380952381, 0.001976284584980237, 0.0016666666666666668, 0.0014245014245014246, 0.0012315270935960591};
    const double fc[14] = {0.5, 0.08333333333333333, 0.03333333333333333, 0.017857142857142856, 0.011111111111111112, 0.007575757575757576, 0.005494505494505495, 0.004166666666666667,
                           0.0032679738562091504, 0.002631578947368421, 0.0021645021645021645, 0.0018115942028985507, 0.0015384615384615385, 0.0013227513227513227};
    double ts = r, tc = 1.0; s = r; c = 1.0;
#pragma unroll
    for (int i = 0; i < 14; ++i) { ts *= -r2 * fs[i]; s += ts; tc *= -r2 * fc[i]; c += tc; }
}
__device__ __forceinline__ double exp_small(double x) {
    double t = 1.0, e = 1.0;
#pragma unroll
    for (int i = 1; i <= 14; ++i) { t *= x * (1.0 / i); e += t; }
    return e;
}
__device__ __forceinline__ void p0_prologue(const Args& AR, Frame& F) {
    LAS float* scr = (LAS float*)(F.lds + F.wave * 16384);
    const int gw = F.vcu * 8 + F.wave, NGW = F.G * 8, lane = F.lane();
    unsigned char* ws = F.ws;
    constexpr int I_IN = (DM / 64) * (INW / 32), I_OUT = (DM / 64) * (DM / 32), I_1 = (DM / 64) * (DFF / 32), I_2 = (DFF / 64) * (DM / 32), I_GLU = (512 / 64) * (512 / 32), I_POOL = 4 * 2 * 4;
    constexpr int I_LAYER = I_IN + I_OUT + I_1 + I_2 + I_GLU + I_POOL;
    for (int it = gw; it < NLAYER * I_LAYER; it += NGW) {
        const int l = it / I_LAYER; int r = it % I_LAYER;
        if (r < I_IN) { p0_transpose_item(AR.in[IN_WIN] + (size_t)l * DM * INW, DM, INW, (bf16*)(ws + WS_WIN) + (size_t)l * INW * DM, AR.in[IN_GMIX] + l * DM, scr, r, lane); continue; } r -= I_IN;
        if (r < I_OUT) { const int k0 = 64 * (r / (DM / 32));
            const float* g = (k0 < 1024) ? AR.in[IN_GOA] + l * 1024 : (k0 < 1536) ? AR.in[IN_GOS] + l * 512 - 1024 : AR.in[IN_GOP] + l * 512 - 1536;
            p0_transpose_item(AR.in[IN_WOUT] + (size_t)l * DM * DM, DM, DM, (bf16*)(ws + WS_WOUT) + (size_t)l * DM * DM, g, scr, r, lane); continue; } r -= I_OUT;
        if (r < I_1) { p0_transpose_item(AR.in[IN_WFF1] + (size_t)l * DM * DFF, DM, DFF, (bf16*)(ws + WS_W1) + (size_t)l * DFF * DM, AR.in[IN_GFFN] + l * DM, scr, r, lane); continue; } r -= I_1;
        if (r < I_2) { p0_transpose_item(AR.in[IN_WFF2] + (size_t)l * DFF * DM, DFF, DM, (bf16*)(ws + WS_W2) + (size_t)l * DM * DFF, nullptr, scr, r, lane); continue; } r -= I_2;
        if (r < I_GLU) { p0_transpose_item(AR.in[IN_WGLU] + (size_t)l * 512 * 512, 512, 512, (bf16*)(ws + WS_WGLU) + (size_t)l * 512 * 512, nullptr, scr, r, lane); continue; } r -= I_GLU;
        { const int g = r / 8; p0_transpose_item(AR.in[IN_WPOOL] + ((size_t)l * 4 + g) * 128 * 128, 128, 128, (bf16*)(ws + WS_WPOOL) + ((size_t)l * 4 + g) * 128 * 128, nullptr, scr, r % 8, lane); }
    }
    float* X = (float*)(ws + WS_X); bf16* XB = (bf16*)(ws + WS_XB); float* SSQ = (float*)(ws + WS_SSQ);
    for (int m = gw; m < MP; m += NGW) {
        const float* src = nullptr;
        if (m < SROW0) { const int b = m >= TT ? 1 : 0, t = m - b * TT; src = (t < NMETA) ? AR.in[IN_META] + (size_t)t * DM : AR.in[IN_XPROMPT] + ((size_t)b * NSEQ + (t - NMETA)) * DM; }
        else if (m < MR) src = AR.in[IN_XSAMPLE] + (size_t)(m - SROW0) * DM;
        float s = 0.f;
#pragma unroll
        for (int j = 0; j < 8; ++j) { f32x4 v = {0.f, 0.f, 0.f, 0.f}; if (src) v = *(const f32x4*)(src + j * 256 + lane * 4);
            s += (v[0] * v[0] + v[1] * v[1]) + (v[2] * v[2] + v[3] * v[3]);
            *(f32x4*)(X + (size_t)m * DM + j * 256 + lane * 4) = v; *(v2u*)(XB + (size_t)m * DM + j * 256 + lane * 4) = (v2u){pk2(v[0], v[1]), pk2(v[2], v[3])}; }
        s = wave_sum(s);
        if (lane < 32) SSQ[((size_t)(lane >> 2) * MP + m) * 4 + (lane & 3)] = (lane == 0) ? s : 0.f;
    }
    const int gt = gw * 64 + lane, NGT = NGW * 64;
    for (int id = gt; id < NLAYER * 32 * 64; id += NGT) {
        const int l = id >> 11, g = (id >> 6) & 31, n = id & 63;
        unsigned char* tb = ws + WS_TAB + (size_t)l * TB_LAYER;
        const double dt = (double)expf(AR.in[IN_LOGDT][l * 32 + g]);
        const double ar = (double)AR.in[IN_ARE][id], ai = (double)AR.in[IN_AIM][id];
        const double mag = exp_small(dt * ar); double sn, cs; sincos_d(dt * ai, sn, cs);
        const double abr = mag * cs, abi = mag * sn, den = ar * ar + ai * ai;
        const double fr = ((abr - 1.0) * ar + abi * ai) / den, fi = (abi * ar - (abr - 1.0) * ai) / den;
        ((float*)(tb + TB_ABR))[g * 64 + n] = (float)abr; ((float*)(tb + TB_ABI))[g * 64 + n] = (float)abi;
        const float* Br = AR.in[IN_BRE] + (size_t)id * 16; const float* Bi = AR.in[IN_BIM] + (size_t)id * 16;
        float* bbr = (float*)(tb + TB_BBR) + (size_t)(g * 64 + n) * 16; float* bbi = (float*)(tb + TB_BBI) + (size_t)(g * 64 + n) * 16;
        bf16* bbt = (bf16*)(tb + TB_PM) + (size_t)g * 128 * 16;
#pragma unroll
        for (int c = 0; c < 16; ++c) { const double br = Br[c], bi = Bi[c]; const float vr = (float)(fr * br - fi * bi), vi = (float)(fr * bi + fi * br); bbr[c] = vr; bbi[c] = vi;
            bbt[n * 16 + c] = (bf16)(pk2(vr, 0.f) & 0xffffu); bbt[(64 + n) * 16 + c] = (bf16)(pk2(vi, 0.f) & 0xffffu); }
        double pr = abr, pi = abi;
        for (int t = 0; t < 64; ++t) {
            if (t == 15) { ((float*)(tb + TB_A16R))[g * 64 + n] = (float)pr; ((float*)(tb + TB_A16I))[g * 64 + n] = (float)pi; }
            if (t == 31) { ((float*)(tb + TB_A32R))[g * 64 + n] = (float)pr; ((float*)(tb + TB_A32I))[g * 64 + n] = (float)pi; }
            if (t == 63) { ((float*)(tb + TB_ALR))[g * 64 + n] = (float)pr; ((float*)(tb + TB_ALI))[g * 64 + n] = (float)pi; }
            const double nr = pr * abr - pi * abi, ni = pr * abi + pi * abr; pr = nr; pi = ni;
        }
        bf16* CmT = (bf16*)(tb + TB_CMT) + (size_t)g * 16 * 128;
        const float* Cr = AR.in[IN_CRE] + ((size_t)(l * 32 + g) * 16) * 64 + n; const float* Ci = AR.in[IN_CIM] + ((size_t)(l * 32 + g) * 16) * 64 + n;
#pragma unroll
        for (int c = 0; c < 16; ++c) { CmT[c * 128 + n] = (bf16)(pk2(Cr[c * 64], 0.f) & 0xffffu); CmT[c * 128 + 64 + n] = (bf16)(pk2(-Ci[c * 64], 0.f) & 0xffffu); }
    }
    float* rc = (float*)(ws + WS_ROPE); float* rs_ = rc + ROPE_N;
    for (int id = gt; id < (int)ROPE_N; id += NGT) {
        const int p = id >> 4, i = id & 15; const double pos = (p == ROPE_SAMPLE_IDX) ? 16384.0 : (double)p;
        double inv = 1.0;
        for (int k = 0; k < i; ++k) inv *= 0.44036660267178046;
        double sn, cs; sincos_d(pos * inv, sn, cs);
        rc[id] = (float)cs; rs_[id] = (float)sn;
    }
}

__device__ __forceinline__ void attn_unit(const Args& AR, Frame& F, int l, int b, int i) {
    int lane_ = F.lane(); asm volatile("" : "+v"(lane_));
    unsigned char* ws = F.ws; asm volatile("" : "+s"(ws));
    const int lane = lane_, h = F.wave, c = lane & 31, hh = lane >> 5, kvh = h >> 2;
    const int t0 = 32 * i; const size_t rb = (size_t)b * TT;
    const bf16* Q = (const bf16*)(ws + WS_Q); const bf16* K = (const bf16*)(ws + WS_K); const bf16* VT = (const bf16*)(ws + WS_VT);
    LAS float* ex = (LAS float*)(F.lds + ESC_OFF);
    bf16x8 qf[8];
    { const bf16* qp = Q + (rb + t0 + c) * 1024 + 128 * h + 8 * hh;
#pragma unroll
      for (int ks = 0; ks < 8; ++ks) qf[ks] = *(const bf16x8*)(qp + 16 * ks); }
    const int kt0 = (t0 >= 128) ? 0 : (4 - i);
    f32x16 S[5];
#pragma unroll
    for (int kt = 0; kt < 5; ++kt) {
#pragma unroll
        for (int r = 0; r < 16; ++r) S[kt][r] = -INFINITY;
        if (kt >= kt0) {
            const int tk0 = t0 - 128 + 32 * kt;
            const bf16* kp = K + (rb + tk0 + c) * 256 + 128 * kvh + 8 * hh;
            bf16x8 kf[8];
#pragma unroll
            for (int ks = 0; ks < 8; ++ks) kf[ks] = *(const bf16x8*)(kp + 16 * ks);
            f32x16 a = {0.f, 0.f, 0.f, 0.f, 0.f, 0.f, 0.f, 0.f, 0.f, 0.f, 0.f, 0.f, 0.f, 0.f, 0.f, 0.f};
#pragma unroll
            for (int ks = 0; ks < 8; ++ks) a = __builtin_amdgcn_mfma_f32_32x32x16_bf16(kf[ks], qf[ks], a, 0, 0, 0);
#pragma unroll
            for (int r = 0; r < 16; ++r) { const int kr = (r & 3) + 8 * (r >> 2) + 4 * hh; bool ok = true;
                if (kt == 0) ok = kr >= c;
                if (kt == 4) ok = kr <= c;
                S[kt][r] = ok ? a[r] : -INFINITY; }
        }
    }
    const float sink2 = AR.in[IN_SINKS][l * 8 + h] * LOG2E;
    float mx = sink2;
#pragma unroll
    for (int kt = 0; kt < 5; ++kt)
#pragma unroll
        for (int r = 0; r < 16; ++r) mx = fmaxf(mx, S[kt][r]);
    mx = fmaxf(mx, __shfl_xor(mx, 32));
    float sum = 0.f;
#pragma unroll
    for (int kt = 0; kt < 5; ++kt)
#pragma unroll
        for (int r = 0; r < 16; ++r) { const float p = __builtin_amdgcn_exp2f(S[kt][r] - mx); S[kt][r] = p; sum += p; }
    sum += __shfl_xor(sum, 32);
    const float inv = 1.0f / (sum + __builtin_amdgcn_exp2f(sink2 - mx));
    f32x16 O[4];
#pragma unroll
    for (int db = 0; db < 4; ++db)
#pragma unroll
        for (int r = 0; r < 16; ++r) O[db][r] = 0.f;
#pragma unroll
    for (int kt = 0; kt < 5; ++kt) {
        if (kt >= kt0) {
            const int tk0 = t0 - 128 + 32 * kt;
#pragma unroll
            for (int s = 0; s < 2; ++s) {
                v4u pw; pw.x = pk2(S[kt][8 * s + 0], S[kt][8 * s + 1]); pw.y = pk2(S[kt][8 * s + 2], S[kt][8 * s + 3]); pw.z = pk2(S[kt][8 * s + 4], S[kt][8 * s + 5]); pw.w = pk2(S[kt][8 * s + 6], S[kt][8 * s + 7]);
                const bf16x8 pf = __builtin_bit_cast(bf16x8, pw);
#pragma unroll
                for (int db = 0; db < 4; ++db) {
                    const bf16x8 vf = *(const bf16x8*)(VT + ((size_t)((b * 2 + kvh) * 128 + 32 * db + c)) * TPV + tk0 + 16 * s + 8 * hh);
                    O[db] = __builtin_amdgcn_mfma_f32_32x32x16_bf16(vf, pf, O[db], 0, 0, 0);
                }
            }
        }
    }
    float ss = 0.f;
#pragma unroll
    for (int db = 0; db < 4; ++db)
#pragma unroll
        for (int r = 0; r < 16; ++r) { O[db][r] *= inv; ss += O[db][r] * O[db][r]; }
    ss += __shfl_xor(ss, 32);
    if (hh == 0) ex[h * 32 + c] = ss;
    WG_BAR();
    float tot = 0.f;
#pragma unroll
    for (int j = 0; j < 8; ++j) tot += ex[j * 32 + c];
    const float rsa = rsqrtf(tot * (1.0f / 1024.0f) + EPS);
    if (t0 + c < TT) {
        const rsrc_t rs_ = ws_rsrc(ws); const size_t mo = WS_MIX + ((rb + t0 + c) * DM + 128 * h + 4 * hh) * 2;
#pragma unroll
        for (int db = 0; db < 4; ++db)
#pragma unroll
            for (int g4 = 0; g4 < 4; ++g4)
                ST8(rs_, mo + (32 * db + 8 * g4) * 2, ((v2u){pk2(O[db][4 * g4 + 0] * rsa, O[db][4 * g4 + 1] * rsa), pk2(O[db][4 * g4 + 2] * rsa, O[db][4 * g4 + 3] * rsa)}));
    }
    WG_BAR();
}

__device__ __forceinline__ void sattn_unit(const Args& AR, Frame& F, int l, int s) {
    int tid_ = F.tid(); asm volatile("" : "+v"(tid_));
    const int tid = tid_, lane = tid & 63, wave = F.wave;
    LAS float* qs = (LAS float*)F.lds;
    LAS float* sc = qs + 1024;
    LAS float* part = sc + 8 * 132;
    LAS float* red = part + 4096;
    const size_t row = SROW0 + s;
    const bf16* Q = (const bf16*)(F.ws + WS_Q) + row * 1024;
    const float* ksn = (const float*)(F.ws + WS_KSN) + (size_t)s * 256; const float* vsn = ksn + NSAMP * 256;
    const float* ck = AR.in[IN_CACHEK] + ((size_t)(l * NSAMP + s)) * 128 * 256; const float* cv = AR.in[IN_CACHEV] + ((size_t)(l * NSAMP + s)) * 128 * 256;
    for (int j = tid; j < 1024; j += 512) qs[j] = bf2f(Q[j]);
    WG_BAR();
    { const int key = tid >> 2, pt = tid & 3;
#pragma unroll
      for (int kvh = 0; kvh < 2; ++kvh) {
          const float* kp = ck + (size_t)key * 256 + kvh * 128 + 32 * pt; float d[4] = {0.f, 0.f, 0.f, 0.f};
#pragma unroll
          for (int j = 0; j < 8; ++j) { const f32x4 kv = *(const f32x4*)(kp + 4 * j);
#pragma unroll
              for (int g = 0; g < 4; ++g) { const f32x4 qv = *(const LAS f32x4*)(qs + (4 * kvh + g) * 128 + 32 * pt + 4 * j); d[g] += (kv[0] * qv[0] + kv[1] * qv[1]) + (kv[2] * qv[2] + kv[3] * qv[3]); } }
#pragma unroll
          for (int g = 0; g < 4; ++g) { d[g] += __shfl_xor(d[g], 1); d[g] += __shfl_xor(d[g], 2); if (pt == 0) sc[(4 * kvh + g) * 132 + key] = d[g]; }
      } }
    {
      const int h = wave, kvh = h >> 2; float d = ksn[kvh * 128 + lane] * qs[h * 128 + lane] + ksn[kvh * 128 + 64 + lane] * qs[h * 128 + 64 + lane];
      d = wave_sum(d); if (lane == 0) sc[h * 132 + 128] = d; }
    WG_BAR();
    { const int h = wave; const float sink2 = AR.in[IN_SINKS][l * 8 + h] * LOG2E;
      const float v0 = sc[h * 132 + lane], v1 = sc[h * 132 + 64 + lane], v2 = (lane == 0) ? sc[h * 132 + 128] : -INFINITY;
      const float mx = fmaxf(wave_max(fmaxf(fmaxf(v0, v1), v2)), sink2);
      const float p0 = __builtin_amdgcn_exp2f(v0 - mx), p1 = __builtin_amdgcn_exp2f(v1 - mx), p2 = __builtin_amdgcn_exp2f(v2 - mx);
      const float inv = 1.0f / (wave_sum(p0 + p1 + p2) + __builtin_amdgcn_exp2f(sink2 - mx));
      sc[h * 132 + lane] = p0 * inv; sc[h * 132 + 64 + lane] = p1 * inv; if (lane == 0) sc[h * 132 + 128] = p2 * inv; }
    WG_BAR();
    { const int d = tid & 127, kq = tid >> 7;
#pragma unroll
      for (int kvh = 0; kvh < 2; ++kvh) { float a[4] = {0.f, 0.f, 0.f, 0.f};
#pragma unroll 8
          for (int k = 0; k < 32; ++k) { const int key = 32 * kq + k; const float v = cv[(size_t)key * 256 + kvh * 128 + d];
#pragma unroll
              for (int g = 0; g < 4; ++g) a[g] += sc[(4 * kvh + g) * 132 + key] * v; }
#pragma unroll
          for (int g = 0; g < 4; ++g) part[kq * 1024 + (4 * kvh + g) * 128 + d] = a[g]; } }
    WG_BAR();
    float o[2]; float ss = 0.f;
#pragma unroll
    for (int e = 0; e < 2; ++e) { const int j = tid + 512 * e, h = j >> 7, d = j & 127, kvh = h >> 2;
        o[e] = (part[j] + part[1024 + j]) + (part[2048 + j] + part[3072 + j]) + sc[h * 132 + 128] * vsn[kvh * 128 + d]; ss += o[e] * o[e]; }
    ss = wave_sum(ss); if (lane == 0) red[wave] = ss;
    WG_BAR();
    { float tot = 0.f;
#pragma unroll
      for (int j = 0; j < 8; ++j) tot += red[j];
      const float rsa = rsqrtf(tot * (1.0f / 1024.0f) + EPS);
      const rsrc_t rs_ = ws_rsrc(F.ws);
#pragma unroll
      for (int e = 0; e < 2; ++e) ST2(rs_, WS_MIX + (row * DM + tid + 512 * e) * 2, pk2(o[e] * rsa, 0.f) & 0xffffu); }
    { float* ok = F.out + O_SK + ((size_t)(l * NSAMP + s)) * 128 * 256; float* ov = F.out + O_SV + ((size_t)(l * NSAMP + s)) * 128 * 256;
      for (int j = tid; j < 127 * 64; j += 512) { *(f32x4*)(ok + 4 * j) = *(const f32x4*)(ck + 256 + 4 * j); *(f32x4*)(ov + 4 * j) = *(const f32x4*)(cv + 256 + 4 * j); }
      if (tid < 64) *(f32x4*)(ok + 127 * 256 + 4 * tid) = *(const f32x4*)(ksn + 4 * tid);
      else if (tid < 128) *(f32x4*)(ov + 127 * 256 + 4 * (tid - 64)) = *(const f32x4*)(vsn + 4 * (tid - 64)); }
    WG_BAR();
}

__device__ __forceinline__ float gelu_tanh(float y) {
    const float inner = 0.7978845608028654f * (y + 0.044715f * y * y * y);
    return y / (1.0f + __builtin_amdgcn_exp2f(-2.0f * LOG2E * inner));
}
__device__ __forceinline__ float sigmoidf_(float x) { return 1.0f / (1.0f + __builtin_amdgcn_exp2f(-LOG2E * x)); }
#define SWZ(r, ch, PITCH) ((r) * (PITCH) + ((((ch)) ^ ((r) & 15)) << 4))

#ifndef SSM_P1
#define SSM_P1 1
#endif
#ifndef SSM_M2
#define SSM_M2 1
#endif
__device__ __forceinline__ int rowtok(int r) { return 16 * ((r >> 2) & 1) + 4 * (r >> 3) + (r & 3); }
struct SsmG { f32x16 X[4]; };
__device__ __forceinline__ void ssm_block(const Args& AR, SsmG& G, const float* U, int rowb, int g, const bf16x8 (&bbf)[4], const float (&ab)[4], float (&hr)[2], float (&hi)[2], int mode, int l, int s0, int lane) {
    const int c = lane & 31, hh = lane >> 5;
    bf16x8 af;
    { const float* up = U + (size_t)(rowb + rowtok(c)) * 512 + 16 * g + 8 * hh; const f32x4 u0 = *(const f32x4*)up, u1 = *(const f32x4*)(up + 4);
      v4u pw; pw.x = pk2(u0[0], u0[1]); pw.y = pk2(u0[2], u0[3]); pw.z = pk2(u1[0], u1[1]); pw.w = pk2(u1[2], u1[3]); af = __builtin_bit_cast(bf16x8, pw); }
    const f32x16 z16 = {0.f, 0.f, 0.f, 0.f, 0.f, 0.f, 0.f, 0.f, 0.f, 0.f, 0.f, 0.f, 0.f, 0.f, 0.f, 0.f};
#pragma unroll
    for (int nb = 0; nb < 4; ++nb) G.X[nb] = __builtin_amdgcn_mfma_f32_32x32x16_bf16(af, bbf[nb], z16, 0, 0, 0);
#pragma unroll
    for (int s = 0; s < 2; ++s) {
        const float ar = ab[2 * s], ai = ab[2 * s + 1];
        if (SSM_M2 && mode == 2) {
            { int cx = c; asm volatile("" : "+v"(cx)); const size_t o0 = ((size_t)(l * NSAMP + (s0 + 16 * hh)) * 32 + g) * 64 + cx + 32 * s; const float* qr = AR.in[IN_SSMRE] + o0; const float* qi = AR.in[IN_SSMIM] + o0;
#pragma unroll
              for (int j = 0; j < 16; ++j) { const float pr = *qr, pi = *qi; qr += 2048; qi += 2048; asm volatile("" : "+v"(qr), "+v"(qi));
                const float nr = ar * pr - ai * pi + G.X[s][j], ni = ar * pi + ai * pr + G.X[2 + s][j]; G.X[s][j] = nr; G.X[2 + s][j] = ni; } }
            continue;
        }
        float r = (hh == 0) ? hr[s] : 0.f, i = (hh == 0) ? hi[s] : 0.f;
#pragma unroll
        for (int j = 0; j < 16; ++j) { const float nr = ar * r - ai * i + G.X[s][j], ni = ar * i + ai * r + G.X[2 + s][j]; r = nr; i = ni; G.X[s][j] = r; G.X[2 + s][j] = i; }
        float vr = __shfl_xor(r, 32), vi = __shfl_xor(i, 32);
        if (hh == 0 || mode == 1) { vr = 0.f; vi = 0.f; }
        float pr = ar, pi = ai; asm volatile("" : "+v"(pr), "+v"(pi));
#pragma unroll
        for (int j = 0; j < 16; ++j) { G.X[s][j] += pr * vr - pi * vi; G.X[2 + s][j] += pr * vi + pi * vr; const float nr = pr * ar - pi * ai, ni = pr * ai + pi * ar; pr = nr; pi = ni; }
        const float er = G.X[s][15], ei = G.X[2 + s][15];
        const float xr = __shfl_xor(er, 32), xi = __shfl_xor(ei, 32);
        hr[s] = (hh == 1) ? er : xr; hi[s] = (hh == 1) ? ei : xi;
    }
}
__device__ __forceinline__ void ssm_unit(const Args& AR, Frame& F, int l, int c) {
    int lane_ = F.lane(); asm volatile("" : "+v"(lane_));
    const int lane = lane_, w = F.wave, t16 = lane & 15, cq = lane >> 4, c32 = lane & 31, hh = lane >> 5;
    const int row0 = 64 * c;
    unsigned char* ws = F.ws; asm volatile("" : "+s"(ws));
    const unsigned char* tb = ws + WS_TAB + (size_t)l * TB_LAYER;
    const float* U = (const float*)(ws + WS_U);
    float* SST = (float*)(ws + WS_SST) + ((size_t)l * NCHUNK) * 32 * 128;
    gu32* flags = F.ctl + CW_SSMF + (size_t)(l * NCHUNK) * 8 * 16;
    LAS unsigned char* Zs = F.lds;
    LAS unsigned char* Hm = F.lds + 65536 + w * 8704;
    LAS float* red = (LAS float*)(F.lds + 137216);
    SsmG SG;
    if (SSM_P1 && c != NCHUNK - 1) {
#pragma unroll 1
        for (int gi = 0; gi < 4; ++gi) {
            const int g = 4 * w + gi;
            int lg_ = lane; asm volatile("" : "+v"(lg_));
            const int c32 = lg_ & 31, hh = lg_ >> 5;
            float ab[4]; ab[0] = ((const float*)(tb + TB_ABR))[g * 64 + c32]; ab[1] = ((const float*)(tb + TB_ABI))[g * 64 + c32]; ab[2] = ((const float*)(tb + TB_ABR))[g * 64 + 32 + c32]; ab[3] = ((const float*)(tb + TB_ABI))[g * 64 + 32 + c32];
            bf16x8 bbf[4];
            { const bf16* bt = (const bf16*)(tb + TB_PM) + (size_t)g * 128 * 16 + c32 * 16 + 8 * hh;
#pragma unroll
              for (int nb = 0; nb < 4; ++nb) bbf[nb] = *(const bf16x8*)(bt + nb * 32 * 16); }
            float hr[2] = {0.f, 0.f}, hi[2] = {0.f, 0.f};
            ssm_block(AR, SG, U, row0, g, bbf, ab, hr, hi, (c == 64) ? 1 : 0, l, 0, lg_);
            ssm_block(AR, SG, U, row0 + 32, g, bbf, ab, hr, hi, 0, l, 0, lg_);
            if (hh == 0) {
#pragma unroll
                for (int s = 0; s < 2; ++s) __hip_atomic_store((gu64*)(SST + ((size_t)c * 32 + g) * 128 + 2 * (c32 + 32 * s)), ((unsigned long long)__builtin_bit_cast(unsigned, hi[s]) << 32) | __builtin_bit_cast(unsigned, hr[s]), RLX_AGENT);
            }
        }
        VM_WAIT();
        if (lane == 0) __hip_atomic_store(flags + ((size_t)c * 8 + w) * 16, 1u, RLX_AGENT);
    }
    const int cs0 = (c <= 64) ? 0 : 64, npred = c - cs0;
    if (npred > 0) {
        unsigned sp = 0; bool ok = false;
        for (;;) { ok = (lane >= npred) || (__hip_atomic_load(flags + ((size_t)(cs0 + lane) * 8 + w) * 16, RLX_AGENT) != 0u);
            if (__all(ok)) break;
            __builtin_amdgcn_s_sleep(2);
            if (++sp > (1u << 20)) { if (lane == 0) __hip_atomic_store(F.ctl + CW_TMO, 0x55u, RLX_AGENT); break; } }
        __builtin_amdgcn_fence(__ATOMIC_ACQUIRE, "agent");
        VM_WAIT();
    }
#pragma unroll 1
    for (int gi = 0; gi < 4; ++gi) {
        const int g = 4 * w + gi;
        int lg_ = lane; asm volatile("" : "+v"(lg_));
        const int t16 = lg_ & 15, cq = lg_ >> 4, c32 = lg_ & 31, hh = lg_ >> 5;
        float ab[4]; ab[0] = ((const float*)(tb + TB_ABR))[g * 64 + c32]; ab[1] = ((const float*)(tb + TB_ABI))[g * 64 + c32]; ab[2] = ((const float*)(tb + TB_ABR))[g * 64 + 32 + c32]; ab[3] = ((const float*)(tb + TB_ABI))[g * 64 + 32 + c32];
        float hr[2] = {0.f, 0.f}, hi[2] = {0.f, 0.f};
        if (npred > 0) {
#pragma unroll
            for (int s = 0; s < 2; ++s) {
                const int n = c32 + 32 * s;
                const float aLr = ((const float*)(tb + TB_ALR))[g * 64 + n], aLi = ((const float*)(tb + TB_ALI))[g * 64 + n];
                float Hr = 0.f, Hi = 0.f;
                for (int cp = cs0; cp < c; cp += 8) {
                    f32x2 sv[8];
#pragma unroll
                    for (int j = 0; j < 8; ++j) { const int cj = (cp + j < c) ? cp + j : c - 1; sv[j] = *(const f32x2*)(SST + ((size_t)cj * 32 + g) * 128 + 2 * n); }
#pragma unroll
                    for (int j = 0; j < 8; ++j) if (cp + j < c) { const float nr = aLr * Hr - aLi * Hi + sv[j][0], ni = aLr * Hi + aLi * Hr + sv[j][1]; Hr = nr; Hi = ni; }
                }
                hr[s] = Hr; hi[s] = Hi;
            }
        }
        bf16x8 bbf[4];
        { const bf16* bt = (const bf16*)(tb + TB_PM) + (size_t)g * 128 * 16 + c32 * 16 + 8 * hh;
#pragma unroll
          for (int nb = 0; nb < 4; ++nb) bbf[nb] = *(const bf16x8*)(bt + nb * 32 * 16); }
        bf16x8 cmf[4];
        { const bf16* cm = (const bf16*)(tb + TB_CMT) + (size_t)g * 16 * 128 + t16 * 128 + 8 * cq;
#pragma unroll
          for (int ks = 0; ks < 4; ++ks) cmf[ks] = *(const bf16x8*)(cm + 32 * ks); }
        const int col = 64 * w + 16 * gi + 4 * cq;
        const f32x4 dsk = *(const f32x4*)(AR.in[IN_DSKIP] + l * 512 + col);
#pragma unroll 1
        for (int half = 0; half < 2; ++half) {
            const bool samp = (c == NCHUNK - 1) && (half == 1);
            ssm_block(AR, SG, U, row0 + 32 * half, g, bbf, ab, hr, hi, samp ? 2 : ((c == 64 && half == 0) ? 1 : 0), l, 0, lg_);
            { LAS unsigned char* hw = Hm + hh * (16 * 272) + c32 * 2;
#pragma unroll
              for (int j = 0; j < 16; ++j)
#pragma unroll
                for (int nb = 0; nb < 4; ++nb) *(LAS bf16*)(hw + j * 272 + nb * 64) = (bf16)(pk2(SG.X[nb][j], 0.f) & 0xffffu); }
            if ((c == 64 && half == 0) || (c == NCHUNK - 1 && half == 0)) {
                int cx = c32; asm volatile("" : "+v"(cx));
                if (hh == (c == 64 ? 0 : 1)) {
#pragma unroll
                    for (int s = 0; s < 2; ++s) { const size_t o = ((size_t)(l * NBATCH + (c == 64 ? 0 : 1)) * 32 + g) * 64 + cx + 32 * s; F.out[O_PSR + o] = SG.X[s][15]; F.out[O_PSI + o] = SG.X[2 + s][15]; } } }
            if (samp) { int cx = c32; asm volatile("" : "+v"(cx)); const size_t o0 = ((size_t)(l * NSAMP + 16 * hh) * 32 + g) * 64 + cx; float* qr = F.out + O_SSR + o0; float* qi = F.out + O_SSI + o0;
#pragma unroll
                for (int j = 0; j < 16; ++j) { qr[0] = SG.X[0][j]; qr[32] = SG.X[1][j]; qi[0] = SG.X[2][j]; qi[32] = SG.X[3][j]; qr += 2048; qi += 2048; asm volatile("" : "+v"(qr), "+v"(qi)); } }
            LDS_WAIT();
#pragma unroll
            for (int mt = 0; mt < 2; ++mt) {
                f32x4 y = {0.f, 0.f, 0.f, 0.f};
#pragma unroll
                for (int ks = 0; ks < 4; ++ks) { const bf16x8 hf = *(const LAS bf16x8*)(Hm + (16 * mt + t16) * 272 + (4 * ks + cq) * 16);
                    y = __builtin_amdgcn_mfma_f32_16x16x32_bf16(cmf[ks], hf, y, 0, 0, 0); }
                const int rl = 32 * half + 16 * mt + t16;
                const f32x4 uv = *(const f32x4*)(U + (size_t)(row0 + rl) * 512 + col);
                f32x4 z;
#pragma unroll
                for (int e = 0; e < 4; ++e) z[e] = gelu_tanh(y[e] + dsk[e] * uv[e]);
                *(LAS v2u*)(Zs + SWZ(rl, col >> 3, 1024) + (col & 7) * 2) = (v2u){pk2(z[0], z[1]), pk2(z[2], z[3])};
            }
            LDS_WAIT();
        }
    }
    WG_BAR();
    f32x4 G[4][4];
#pragma unroll
    for (int mt = 0; mt < 4; ++mt)
#pragma unroll
        for (int nt = 0; nt < 4; ++nt) G[mt][nt] = (f32x4){0.f, 0.f, 0.f, 0.f};
    { const bf16* Wg = (const bf16*)(ws + WS_WGLU) + (size_t)l * 512 * 512 + (size_t)(64 * w + t16) * 512 + 8 * cq;
#pragma unroll 2
      for (int ks = 0; ks < 16; ++ks) {
          bf16x8 wf[4], zf[4];
#pragma unroll
          for (int nt = 0; nt < 4; ++nt) wf[nt] = *(const bf16x8*)(Wg + (size_t)nt * 16 * 512 + 32 * ks);
#pragma unroll
          for (int mt = 0; mt < 4; ++mt) zf[mt] = *(const LAS bf16x8*)(Zs + SWZ(16 * mt + t16, 4 * ks + cq, 1024));
#pragma unroll
          for (int mt = 0; mt < 4; ++mt)
#pragma unroll
              for (int nt = 0; nt < 4; ++nt) G[mt][nt] = __builtin_amdgcn_mfma_f32_16x16x32_bf16(wf[nt], zf[mt], G[mt][nt], 0, 0, 0);
      } }
#pragma unroll
    for (int mt = 0; mt < 4; ++mt) { float ss = 0.f; const int rl = 16 * mt + t16;
#pragma unroll
        for (int nt = 0; nt < 4; ++nt) { const int col = 64 * w + 16 * nt + 4 * cq; const f32x4 bg = *(const f32x4*)(AR.in[IN_BGLU] + l * 512 + col);
            const v2u zz = *(const LAS v2u*)(Zs + SWZ(rl, col >> 3, 1024) + (col & 7) * 2);
            const float zv[4] = {bf2f((unsigned short)(zz.x & 0xffffu)), bf2f((unsigned short)(zz.x >> 16)), bf2f((unsigned short)(zz.y & 0xffffu)), bf2f((unsigned short)(zz.y >> 16))};
#pragma unroll
            for (int e = 0; e < 4; ++e) { const float o = zv[e] * sigmoidf_(G[mt][nt][e] + bg[e]); G[mt][nt][e] = o; ss += o * o; } }
        ss += __shfl_xor(ss, 16); ss += __shfl_xor(ss, 32);
        if (cq == 0) red[rl * 8 + w] = ss; }
    WG_BAR();
    { const rsrc_t rs_ = ws_rsrc(ws);
#pragma unroll
      for (int mt = 0; mt < 4; ++mt) { const int rl = 16 * mt + t16; const LAS f32x4* rp = (const LAS f32x4*)(red + rl * 8); const f32x4 a = rp[0], b2 = rp[1];
          const float rsn = rsqrtf(((a[0] + a[1]) + (a[2] + a[3]) + (b2[0] + b2[1]) + (b2[2] + b2[3])) * (1.0f / 512.0f) + EPS);
          const size_t mo = WS_MIX + ((size_t)(row0 + rl) * DM + 1024 + 64 * w + 4 * cq) * 2;
#pragma unroll
          for (int nt = 0; nt < 4; ++nt) ST8(rs_, mo + 32 * nt, ((v2u){pk2(G[mt][nt][0] * rsn, G[mt][nt][1] * rsn), pk2(G[mt][nt][2] * rsn, G[mt][nt][3] * rsn)})); } }
    WG_BAR();
}
#undef SSM_ROWS4

template <int WLEN>
__device__ __forceinline__ void pool_half(const float* XP, float* out, int l, int ch, int rfirst, int rl0, LAS unsigned char* Ds) {
    float xv[48];
#pragma unroll
    for (int i = 0; i < 48; ++i) { const int ra = rfirst + i - 16; xv[i] = (ra >= 0) ? XP[(size_t)ra * 512 + ch] : 0.f; }
    int seg = (rfirst >= TT) ? TT : 0;
    float sum = 0.f;
#pragma unroll
    for (int j = 1; j <= WLEN; ++j) if (rfirst - j >= seg) sum += xv[16 - j];
#pragma unroll
    for (int i = 0; i < 32; ++i) {
        const int ra = rfirst + i; const float x = xv[16 + i];
        if (ra == TT) { seg = TT; sum = 0.f; }
        sum += x;
        if (ra - WLEN >= seg) sum -= xv[16 + i - WLEN];
        const int cnt = (ra - seg + 1 < WLEN) ? (ra - seg + 1) : WLEN;
        const float dm = sum * __builtin_amdgcn_rcpf((float)cnt) - x;
        if (ra >= TT - 15 && ra < TT) out[O_PP + ((size_t)(l * NBATCH + 0) * 15 + (ra - (TT - 15))) * 512 + ch] = x;
        if (ra >= SROW0 - 15) out[O_PP + ((size_t)(l * NBATCH + 1) * 15 + (ra - (SROW0 - 15))) * 512 + ch] = x;
        const int r = rl0 + i;
        *(LAS bf16*)(Ds + SWZ(r, ch >> 3, 1024) + (ch & 7) * 2) = (bf16)(pk2(dm, 0.f) & 0xffffu);
    }
}
template <int WLEN>
__device__ __forceinline__ void pool_sample_rows(const float* XP, const float* sp, float* out, int l, int ch, LAS unsigned char* Ds) {
#pragma unroll 2
    for (int s = 0; s < NSAMP; ++s) {
        const float* pp = sp + (size_t)s * 15 * 512; float pv[15];
#pragma unroll
        for (int j = 0; j < 15; ++j) pv[j] = pp[(size_t)j * 512];
        const float x = XP[(size_t)(SROW0 + s) * 512 + ch]; float a = x;
#pragma unroll
        for (int j = 16 - WLEN; j < 15; ++j) a += pv[j];
        const float dm = a * (1.0f / WLEN) - x;
        float* op = out + O_SP + ((size_t)(l * NSAMP + s) * 15) * 512 + ch;
#pragma unroll
        for (int j = 0; j < 14; ++j) op[(size_t)j * 512] = pv[j + 1];
        op[(size_t)14 * 512] = x;
        *(LAS bf16*)(Ds + SWZ(32 + s, ch >> 3, 1024) + (ch & 7) * 2) = (bf16)(pk2(dm, 0.f) & 0xffffu);
    }
}
__device__ __forceinline__ void pool_unit(const Args& AR, Frame& F, int l, int c) {
    int tid_ = F.tid(); asm volatile("" : "+v"(tid_));
    const int tid = tid_, lane = tid & 63, w = F.wave, t16 = lane & 15, cq = lane >> 4;
    const int row0 = 64 * c;
    unsigned char* ws = F.ws; asm volatile("" : "+s"(ws));
    const float* XP = (const float*)(ws + WS_XP);
    LAS unsigned char* Ds = F.lds;
    LAS float* red = (LAS float*)(F.lds + ESC_OFF);
    { const int ch = tid, wsel = w >> 1;
      const float* sp = AR.in[IN_SPOOL] + (size_t)l * NSAMP * 15 * 512 + ch;
#pragma unroll 1
      for (int half = 0; half < 2; ++half) {
          if (c == NCHUNK - 1 && half == 1) {
              if (wsel == 0) pool_sample_rows<2>(XP, sp, F.out, l, ch, Ds); else if (wsel == 1) pool_sample_rows<4>(XP, sp, F.out, l, ch, Ds);
              else if (wsel == 2) pool_sample_rows<8>(XP, sp, F.out, l, ch, Ds); else pool_sample_rows<16>(XP, sp, F.out, l, ch, Ds);
          } else {
              const int rfirst = row0 + 32 * half;
              if (wsel == 0) pool_half<2>(XP, F.out, l, ch, rfirst, 32 * half, Ds); else if (wsel == 1) pool_half<4>(XP, F.out, l, ch, rfirst, 32 * half, Ds);
              else if (wsel == 2) pool_half<8>(XP, F.out, l, ch, rfirst, 32 * half, Ds); else pool_half<16>(XP, F.out, l, ch, rfirst, 32 * half, Ds);
          }
      } }
    WG_BAR();
    const int gp = w & 3, rh = w >> 2;
    f32x4 A[2][8];
#pragma unroll
    for (int mt = 0; mt < 2; ++mt)
#pragma unroll
        for (int nt = 0; nt < 8; ++nt) A[mt][nt] = (f32x4){0.f, 0.f, 0.f, 0.f};
    { const bf16* Wp = (const bf16*)(ws + WS_WPOOL) + ((size_t)(l * 4 + gp) * 128 + t16) * 128 + 8 * cq;
#pragma unroll
      for (int ks = 0; ks < 4; ++ks) {
          bf16x8 df[2];
#pragma unroll
          for (int mt = 0; mt < 2; ++mt) df[mt] = *(const LAS bf16x8*)(Ds + SWZ(32 * rh + 16 * mt + t16, 16 * gp + 4 * ks + cq, 1024));
#pragma unroll
          for (int nt = 0; nt < 8; ++nt) { const bf16x8 wf = *(const bf16x8*)(Wp + (size_t)nt * 16 * 128 + 32 * ks);
#pragma unroll
              for (int mt = 0; mt < 2; ++mt) A[mt][nt] = __builtin_amdgcn_mfma_f32_16x16x32_bf16(wf, df[mt], A[mt][nt], 0, 0, 0); }
      } }
#pragma unroll
    for (int mt = 0; mt < 2; ++mt) { float ss = 0.f;
#pragma unroll
        for (int nt = 0; nt < 8; ++nt) { const f32x4 sc = *(const f32x4*)(AR.in[IN_PSCALE] + l * 512 + 128 * gp + 16 * nt + 4 * cq);
#pragma unroll
            for (int e = 0; e < 4; ++e) { const float o = A[mt][nt][e] * sc[e]; A[mt][nt][e] = o; ss += o * o; } }
        ss += __shfl_xor(ss, 16); ss += __shfl_xor(ss, 32);
        if (cq == 0) red[(32 * rh + 16 * mt + t16) * 4 + gp] = ss; }
    WG_BAR();
    { const rsrc_t rs_ = ws_rsrc(ws);
#pragma unroll
      for (int mt = 0; mt < 2; ++mt) { const int rl = 32 * rh + 16 * mt + t16; const f32x4 a = *(const LAS f32x4*)(red + rl * 4);
          const float rsn = rsqrtf(((a[0] + a[1]) + (a[2] + a[3])) * (1.0f / 512.0f) + EPS);
          const size_t mo = WS_MIX + ((size_t)(row0 + rl) * DM + 1536 + 128 * gp + 4 * cq) * 2;
#pragma unroll
          for (int nt = 0; nt < 8; ++nt) ST8(rs_, mo + 32 * nt, ((v2u){pk2(A[mt][nt][0] * rsn, A[mt][nt][1] * rsn), pk2(A[mt][nt][2] * rsn, A[mt][nt][3] * rsn)})); } }
    WG_BAR();
}

#ifndef ACQ_SCOPE
#define ACQ_SCOPE "agent"
#endif
#ifndef PUBLISH_FENCE
#define PUBLISH_FENCE 0
#endif
enum { U_END = 0, U_PA = 1, U_PC = 2, U_PD = 3, U_PE = 4, U_SSM = 5, U_ATT = 6, U_SATT = 7, U_POOL = 8 };
constexpr int NPANEL = MP / 256;
constexpr int QCAP = 1024;
__host__ __device__ constexpr unsigned mkd(int type, int l, int a, int b) { return ((unsigned)type << 24) | ((unsigned)l << 20) | ((unsigned)a << 10) | (unsigned)b; }
__device__ __forceinline__ gu32* cnt_word(gu32* ctl, int l, int kind, int pm) { return ctl + CW_CNT + ((l * 5 + kind) * 40 + pm) * 16; }
__host__ __device__ constexpr unsigned mix_target(int pm) { return 3u * (unsigned)((MR - 256 * pm) < 256 ? (MR - 256 * pm) : 256); }

__device__ __forceinline__ void build_queue(unsigned* qt, int q) {
    int n = 1;
    for (int l = 0; l < NLAYER; ++l) {
        for (int pm = 0; pm < NPANEL; ++pm) { qt[n++] = mkd(U_PA, l, pm, q); if ((pm & 7) == q) { qt[n++] = mkd(U_PA, l, pm, 8); qt[n++] = mkd(U_PA, l, pm, 9); } }
        for (int c = q; c < NCHUNK; c += 8) qt[n++] = mkd(U_SSM, l, c, 0);
        for (int i = q; i < NBATCH * NQB; i += 8) qt[n++] = mkd(U_ATT, l, i, 0);
        for (int s = q; s < NSAMP; s += 8) qt[n++] = mkd(U_SATT, l, s, 0);
        for (int c = q; c < NCHUNK; c += 8) qt[n++] = mkd(U_POOL, l, c, 0);
        for (int pm = 0; pm < NPANEL; ++pm) qt[n++] = mkd(U_PC, l, pm, q);
        for (int pm = 0; pm < NPANEL; ++pm) for (int j = 0; j < 4; ++j) qt[n++] = mkd(U_PD, l, pm, 4 * q + j);
        for (int pm = 0; pm < NPANEL; ++pm) qt[n++] = mkd(U_PE, l, pm, q);
    }
    qt[0] = (unsigned)(n - 1);
}

struct Sched {
    gu32* ctl; const unsigned* qglob; LAS unsigned* qlds; volatile LAS unsigned* slot; int myq; unsigned nclaim;
    __device__ __forceinline__ unsigned claim_lane() {
        { const unsigned idx = __hip_atomic_fetch_add(ctl + CW_QHEAD + myq * 64, 1u, RLX_AGENT); if (idx < qlds[0]) return qlds[1 + idx]; }
        for (int k = 1; k < 8; ++k) { const int q = (myq + k) & 7; const unsigned* qg = qglob + (size_t)q * QCAP;
            if (__hip_atomic_load((gu32*)(ctl + CW_QHEAD + q * 64), RLX_AGENT) >= qg[0]) continue;
            const unsigned idx = __hip_atomic_fetch_add(ctl + CW_QHEAD + q * 64, 1u, RLX_AGENT); if (idx < qg[0]) return qg[1 + idx]; }
        return 0u;
    }
    __device__ __forceinline__ unsigned claim_wg(int tid) {
        const unsigned k = nclaim++ & 1u;
        if (tid == 0) slot[k] = claim_lane();
        WG_BAR();
        return slot[k];
    }
    __device__ __forceinline__ void poll(gu32* w, unsigned want) {
        unsigned sp = 0;
        while (__hip_atomic_load(w, RLX_AGENT) < want) { __builtin_amdgcn_s_sleep(2);
            if ((++sp & 1023u) == 0u) { if (__hip_atomic_load(ctl + CW_TMO, RLX_AGENT) != 0u) break; if (sp > (1u << 17)) { __hip_atomic_store(ctl + CW_TMO, 0x66u, RLX_AGENT); break; } } }
    }
    __device__ __forceinline__ bool ready_now(gu32* w, unsigned want) { return __hip_atomic_load(w, RLX_AGENT) >= want; }
    __device__ __forceinline__ bool deps_ready_now(unsigned d) {
        const int type = d >> 24, l = (d >> 20) & 15, a = (d >> 10) & 1023; bool ok = true;
        if (type == U_PA) { if (l > 0) { const int p2 = (a + 1 < NPANEL) ? a + 1 : NPANEL - 1; ok = ready_now(cnt_word(ctl, l - 1, 4, a), 8u) && ready_now(cnt_word(ctl, l - 1, 1, p2), mix_target(p2)); } }
        else if (type == U_PC) ok = ready_now(cnt_word(ctl, l, 1, a), mix_target(a));
        else if (type == U_PD) ok = ready_now(cnt_word(ctl, l, 2, a), 8u);
        else ok = ready_now(cnt_word(ctl, l, 3, a), 32u);
        if (ok) { __builtin_amdgcn_fence(__ATOMIC_ACQUIRE, ACQ_SCOPE); asm volatile("s_waitcnt vmcnt(0)" ::: "memory"); }
        return ok;
    }
    __device__ __forceinline__ void wait_deps(unsigned d, int tid) {
        if (tid == 0) {
            const int type = d >> 24, l = (d >> 20) & 15, a = (d >> 10) & 1023;
            if (type == U_PA) { if (l > 0) { poll(cnt_word(ctl, l - 1, 4, a), 8u); const int p2 = (a + 1 < NPANEL) ? a + 1 : NPANEL - 1; poll(cnt_word(ctl, l - 1, 1, p2), mix_target(p2)); } }
            else if (type == U_PC) poll(cnt_word(ctl, l, 1, a), mix_target(a));
            else if (type == U_PD) poll(cnt_word(ctl, l, 2, a), 8u);
            else if (type == U_PE) poll(cnt_word(ctl, l, 3, a), 32u);
            else if (type == U_SSM) poll(cnt_word(ctl, l, 0, a >> 2), 10u);
            else if (type == U_POOL) { poll(cnt_word(ctl, l, 0, a >> 2), 10u); const int r0 = 64 * a - 16; if (r0 >= 0) poll(cnt_word(ctl, l, 0, r0 >> 8), 10u); }
            else if (type == U_SATT) poll(cnt_word(ctl, l, 0, NPANEL - 1), 10u);
            else if (type == U_ATT) { const int b = a / NQB, i = a % NQB, t0 = 32 * i; const int rlo = b * TT + (t0 >= 128 ? t0 - 128 : 0), rhi = b * TT + ((t0 + 31 < TT) ? t0 + 31 : TT - 1);
                poll(cnt_word(ctl, l, 0, rlo >> 8), 10u); if ((rhi >> 8) != (rlo >> 8)) poll(cnt_word(ctl, l, 0, rhi >> 8), 10u); }
            __builtin_amdgcn_fence(__ATOMIC_ACQUIRE, ACQ_SCOPE);
            asm volatile("s_waitcnt vmcnt(0)" ::: "memory");
        }
        asm volatile("" ::: "memory"); __builtin_amdgcn_s_barrier(); asm volatile("" ::: "memory");
    }
    __device__ __forceinline__ void publish(unsigned d, int tid) {
        asm volatile("s_waitcnt vmcnt(0)" ::: "memory");
        WG_BAR();
        if (tid == 0) {
            const int type = d >> 24, l = (d >> 20) & 15, a = (d >> 10) & 1023;
#if PUBLISH_FENCE
            __builtin_amdgcn_fence(__ATOMIC_RELEASE, "agent");
            asm volatile("s_waitcnt vmcnt(0)" ::: "memory");
#endif
            if (type == U_PA) __hip_atomic_fetch_add(cnt_word(ctl, l, 0, a), 1u, RLX_AGENT);
            else if (type == U_PC) __hip_atomic_fetch_add(cnt_word(ctl, l, 2, a), 1u, RLX_AGENT);
            else if (type == U_PD) __hip_atomic_fetch_add(cnt_word(ctl, l, 3, a), 1u, RLX_AGENT);
            else if (type == U_PE) __hip_atomic_fetch_add(cnt_word(ctl, l, 4, a), 1u, RLX_AGENT);
            else if (type == U_SSM || type == U_POOL) __hip_atomic_fetch_add(cnt_word(ctl, l, 1, a >> 2), 64u, RLX_AGENT);
            else if (type == U_SATT) __hip_atomic_fetch_add(cnt_word(ctl, l, 1, NPANEL - 1), 1u, RLX_AGENT);
            else if (type == U_ATT) { const int b = a / NQB, i = a % NQB, t0 = 32 * i; const int r0 = b * TT + t0, r1 = b * TT + ((t0 + 31 < TT) ? t0 + 31 : TT - 1);
                const int p0 = r0 >> 8, p1 = r1 >> 8;
                if (p0 == p1) __hip_atomic_fetch_add(cnt_word(ctl, l, 1, p0), (unsigned)(r1 - r0 + 1), RLX_AGENT);
                else { __hip_atomic_fetch_add(cnt_word(ctl, l, 1, p0), (unsigned)(256 * p1 - r0), RLX_AGENT); __hip_atomic_fetch_add(cnt_word(ctl, l, 1, p1), (unsigned)(r1 - 256 * p1 + 1), RLX_AGENT); } }
        }
    }
};

#ifndef A_AUX
#define A_AUX 0
#endif
struct GU { const char* A; const char* B; unsigned voffA[2], voffB[2]; size_t hstep; int nt; unsigned d; pg8::Unit u; };

struct StreamCtx { unsigned char* ws; float* out; const float* gq; const float* gk; int R[2], C[2], Rp[2]; };
__device__ __forceinline__ void gu_fill(GU& g, unsigned d, const StreamCtx& X) {
    const int type = d >> 24, l = (d >> 20) & 15, pm = (d >> 10) & 1023, pn = d & 1023;
    unsigned char* ws = X.ws;
    const bf16* A; const bf16* B; int K = DM; bool perm = false;
    if (type == U_PA) { A = (const bf16*)(ws + WS_XB); B = (const bf16*)(ws + WS_WIN) + (size_t)l * INW * DM; }
    else if (type == U_PC) { A = (const bf16*)(ws + WS_MIX); B = (const bf16*)(ws + WS_WOUT) + (size_t)l * DM * DM; }
    else if (type == U_PD) { A = (const bf16*)(ws + WS_XB); B = (const bf16*)(ws + WS_W1) + (size_t)l * DFF * DM; perm = true; }
    else { A = (const bf16*)(ws + WS_H); B = (const bf16*)(ws + WS_W2) + (size_t)l * DM * DFF; K = DFF; }
    g.d = d; g.u.pm = pm; g.u.pn = pn; g.nt = K / 64; g.hstep = (size_t)128 * K * 2;
    g.A = (const char*)A + (size_t)pm * 256 * K * 2; g.B = (const char*)B + (size_t)pn * 256 * K * 2;
#pragma unroll
    for (int i = 0; i < 2; ++i) { g.voffA[i] = (unsigned)(X.R[i] * K + X.C[i]) * 2u; g.voffB[i] = (unsigned)((perm ? X.Rp[i] : X.R[i]) * K + X.C[i]) * 2u; }
}

__device__ __forceinline__ unsigned gemm_stream(const Args& AR, Frame& F, Sched& Q, unsigned d0) {
    int tid_ = F.tid(); asm volatile("" : "+v"(tid_));
    const int tid = tid_, wid = __builtin_amdgcn_readfirstlane(tid >> 6), lane = tid & 63, wr = wid >> 2, wc = wid & 3, fr = lane & 15, fq = lane >> 4;
    LAS unsigned char* lds = F.lds; LAS unsigned char* esc = F.lds + ESC_OFF;
    StreamCtx X; X.ws = F.ws; X.out = F.out;
#pragma unroll
    for (int i = 0; i < 2; ++i) { int R, C; pg8::stage_rc(tid * 16 + i * 8192, R, C); X.R[i] = R; X.C[i] = C; X.Rp[i] = (R & ~31) + pg8::perm32(R & 31); }
    const size_t kstep = (size_t)(pg8::BK * 2);
    const unsigned ldsw = (unsigned)wid * 1024u;
    const int aoff = pg8::lds_byte(wr * 64 + fr, fq * 8), boff = pg8::lds_byte(wc * 32 + fr, fq * 8);
#define PG8_SA(b, h) (((b) * 2 + (h)) * pg8::HTB)
#define PG8_SB(b, h) ((4 + (b) * 2 + (h)) * pg8::HTB)
#define PG8_STAGE(bufoff, gbase, voff) do { _Pragma("unroll") for (int _i = 0; _i < 2; ++_i) \
        __builtin_amdgcn_global_load_lds((const unsigned*)((const char*)(gbase) + (voff)[_i]), (LAS unsigned*)(lds + (bufoff) + ldsw + _i * 8192), 16, 0, 0); } while (0)
#define PG8_STAGE_A(bufoff, gbase, voff) do { _Pragma("unroll") for (int _i = 0; _i < 2; ++_i) \
        __builtin_amdgcn_global_load_lds((const unsigned*)((const char*)(gbase) + (voff)[_i]), (LAS unsigned*)(lds + (bufoff) + ldsw + _i * 8192), 16, 0, A_AUX); } while (0)
#define PG8_LDA(dst, b, h) do { _Pragma("unroll") for (int m = 0; m < 4; ++m) _Pragma("unroll") for (int k = 0; k < 2; ++k) dst[m][k] = *(const LAS bf16x8*)(lds + PG8_SA(b, h) + aoff + m * 2048 + k * 1024); } while (0)
#define PG8_LDB(dst, b, h) do { _Pragma("unroll") for (int n = 0; n < 2; ++n) _Pragma("unroll") for (int k = 0; k < 2; ++k) dst[n][k] = *(const LAS bf16x8*)(lds + PG8_SB(b, h) + boff + n * 2048 + k * 1024); } while (0)
#define PG8_MMA(ai, bj, At, Bt) do { if (mm[ai]) { __builtin_amdgcn_s_setprio(1); _Pragma("unroll") for (int m = 0; m < 4; ++m) _Pragma("unroll") for (int n = 0; n < 2; ++n) _Pragma("unroll") for (int k = 0; k < 2; ++k) \
        acc[ai][bj][m][n] = __builtin_amdgcn_mfma_f32_16x16x32_bf16(Bt[n][k], At[m][k], acc[ai][bj][m][n], 0, 0, 0); __builtin_amdgcn_s_setprio(0); } } while (0)
#define PG8_WAIT_V(n) asm volatile("s_waitcnt vmcnt(" #n ")" ::: "memory")
#define PG8_WAIT_L(n) asm volatile("s_waitcnt lgkmcnt(" #n ")" ::: "memory")
#define PG8_BAR __builtin_amdgcn_s_barrier()
#define PG8_SCHED __builtin_amdgcn_sched_barrier(0)
    GU cur;
    gu_fill(cur, d0, X);
    f32x4 acc[2][2][4][2];
#pragma unroll
    for (int a = 0; a < 2; ++a)
#pragma unroll
        for (int b = 0; b < 2; ++b)
#pragma unroll
            for (int m = 0; m < 4; ++m)
#pragma unroll
                for (int n = 0; n < 2; ++n) acc[a][b][m][n] = (f32x4){0.f, 0.f, 0.f, 0.f};
    bf16x8 At[4][2], B0[2][2], B1[2][2];
    Q.wait_deps(cur.d, tid);
    PG8_STAGE(PG8_SB(0, 0), cur.B, cur.voffB); PG8_STAGE(PG8_SB(0, 1), cur.B + cur.hstep, cur.voffB); PG8_STAGE_A(PG8_SA(0, 0), cur.A, cur.voffA); PG8_STAGE_A(PG8_SA(0, 1), cur.A + cur.hstep, cur.voffA);
    if (wr == 1) PG8_BAR;
    PG8_WAIT_V(2); PG8_BAR;
    PG8_STAGE(PG8_SB(1, 0), cur.B + kstep, cur.voffB); PG8_STAGE_A(PG8_SA(1, 0), cur.A + kstep, cur.voffA); PG8_STAGE(PG8_SB(1, 1), cur.B + cur.hstep + kstep, cur.voffB);
    PG8_WAIT_V(6); PG8_BAR;
    unsigned carry = 0u; unsigned ui = 0u;
    for (;;) {
        bool go = false;
        const char* cA = cur.A; const char* cB = cur.B; const size_t hstep = cur.hstep; const int nt = cur.nt;
        const bool fullp = cur.u.pm != NPANEL - 1; const bool mm[2] = {fullp || wr == 0, fullp};
        for (int t = 0; t < nt; t += 2) {
            const bool last = (t == nt - 2);
            const char* a1 = cA + (size_t)(t + 1) * kstep;
            const char* a2_ = cA + (size_t)(last ? 0 : t + 2) * kstep; const char* b2_ = cB + (size_t)(last ? 0 : t + 2) * kstep;
            const char* a2 = a2_; const char* b2 = b2_; size_t h2 = hstep;
            unsigned vA2[2], vB2[2];
#pragma unroll
            for (int i = 0; i < 2; ++i) { vA2[i] = cur.voffA[i]; vB2[i] = cur.voffB[i]; }
            if (last) {
                const unsigned k = 2u + (ui & 1u);
                if (tid == 0) { const unsigned dn = Q.claim_lane(); Q.slot[k] = dn;
                    Q.slot[2u + k] = ((dn >> 24) >= U_PA && (dn >> 24) <= U_PE && (!STREAM_SAME_SECTION || ((dn >> 20) == (cur.d >> 20))) && Q.deps_ready_now(dn)) ? 1u : 0u; }
                asm volatile("s_waitcnt lgkmcnt(0)" ::: "memory"); PG8_BAR; asm volatile("" ::: "memory");
                carry = Q.slot[k]; go = Q.slot[2u + k] != 0u;
                if (go) { GU n2; gu_fill(n2, carry, X); a2 = n2.A; b2 = n2.B; h2 = n2.hstep;
#pragma unroll
                    for (int i = 0; i < 2; ++i) { vA2[i] = n2.voffA[i]; vB2[i] = n2.voffB[i]; } }
            }
            const char* a3 = a2 + kstep; const char* b3 = b2 + kstep;
            PG8_LDB(B0, 0, 0); PG8_LDB(B1, 0, 1); PG8_SCHED; PG8_LDA(At, 0, 0); PG8_STAGE_A(PG8_SA(1, 1), a1 + hstep, cur.voffA);
            PG8_WAIT_V(8); PG8_WAIT_L(0); PG8_BAR; PG8_MMA(0, 0, At, B0); PG8_MMA(0, 1, At, B1); PG8_BAR; PG8_SCHED;
            PG8_LDA(At, 0, 1); PG8_STAGE(PG8_SB(0, 0), b2, vB2); PG8_STAGE(PG8_SB(0, 1), b2 + h2, vB2); PG8_STAGE_A(PG8_SA(0, 0), a2, vA2);
            PG8_WAIT_V(8); PG8_WAIT_L(0); PG8_BAR; PG8_MMA(1, 0, At, B0); PG8_MMA(1, 1, At, B1); PG8_BAR; PG8_SCHED;
            PG8_LDB(B0, 1, 0); PG8_LDB(B1, 1, 1); PG8_SCHED; PG8_LDA(At, 1, 0); PG8_STAGE_A(PG8_SA(0, 1), a2 + h2, vA2);
            PG8_WAIT_V(8); PG8_WAIT_L(0); PG8_BAR; PG8_MMA(0, 0, At, B0); PG8_MMA(0, 1, At, B1); PG8_BAR; PG8_SCHED;
            PG8_LDA(At, 1, 1); PG8_STAGE(PG8_SB(1, 0), b3, vB2); PG8_STAGE(PG8_SB(1, 1), b3 + h2, vB2); PG8_STAGE_A(PG8_SA(1, 0), a3, vA2);
            PG8_WAIT_V(8); PG8_WAIT_L(0); PG8_BAR; PG8_MMA(1, 0, At, B0); PG8_MMA(1, 1, At, B1); PG8_BAR; PG8_SCHED;
        }
        if (wr == 0) PG8_BAR;
        { const int type = cur.d >> 24, l = (cur.d >> 20) & 15;
          if (type == U_PA) { EpiProj E{X.ws, X.out, AR.in[IN_GQ] + l * 128, AR.in[IN_GK] + l * 128, l}; E(acc, cur.u, wr, wc, fr, fq, esc, tid); }
          else if (type == U_PD) { EpiFfn1 E{X.ws}; E(acc, cur.u, wr, wc, fr, fq, esc, tid); }
          else { EpiRes E{X.ws, X.out, (type == U_PE && l == NLAYER - 1) ? 1 : 0}; E(acc, cur.u, wr, wc, fr, fq, esc, tid); }
          Q.publish(cur.d, tid); }
        if (!go) break;
#pragma unroll
        for (int a = 0; a < 2; ++a)
#pragma unroll
            for (int b = 0; b < 2; ++b)
#pragma unroll
                for (int m = 0; m < 4; ++m)
#pragma unroll
                    for (int n = 0; n < 2; ++n) acc[a][b][m][n] = (f32x4){0.f, 0.f, 0.f, 0.f};
        gu_fill(cur, carry, X); ++ui;
        if (wr == 1) PG8_BAR;
    }
    PG8_WAIT_V(0);
    PG8_BAR;
#undef PG8_SA
#undef PG8_SB
#undef PG8_STAGE
#undef PG8_STAGE_A
#undef PG8_LDA
#undef PG8_LDB
#undef PG8_MMA
#undef PG8_WAIT_V
#undef PG8_WAIT_L
#undef PG8_BAR
#undef PG8_SCHED
    return carry;
}

__global__ void __launch_bounds__(512, 2) hymba_fwd(Args args) {
    extern __shared__ __attribute__((aligned(16))) unsigned char lds[];
    Frame F;
    F.lds = (LAS unsigned char*)lds;
    F.MISC = (volatile LAS unsigned*)(F.lds + MISC_OFF);
    F.wave = __builtin_amdgcn_readfirstlane((int)(threadIdx.x >> 6));
    F.G = gridDim.x; { const int bx = blockIdx.x; F.vcu = (F.G % 8 == 0) ? (bx % 8) * (F.G / 8) + bx / 8 : bx; }
    F.ws = args.ws; F.out = args.out; F.ctl = (gu32*)(args.ws + WS_CTL);
    for (int u = F.tid(); u < (LDS_BYTES - LDSCTL_OFF) / 4; u += 512) ((LAS unsigned*)(F.lds + LDSCTL_OFF))[u] = 0u;
    __syncthreads();
    XcdBarrier bar = xcd_barrier_post((unsigned*)(F.ctl + CW_BAR), F.MISC + 8);
    for (int rep = 0; rep < DUP_P0; ++rep) p0_prologue(args, F);
    if (blockIdx.x < 8 && F.tid() == 0) build_queue((unsigned*)(args.ws + WS_QUEUE) + (size_t)blockIdx.x * QCAP, (int)blockIdx.x);
    xcd_barrier(bar);
    Sched Q; Q.ctl = F.ctl; Q.qglob = (const unsigned*)(args.ws + WS_QUEUE); Q.qlds = (LAS unsigned*)(F.lds + QTAB_OFF); Q.slot = F.MISC; Q.myq = (int)(bar.x & 7u); Q.nclaim = 0u;
    { const unsigned* qg = Q.qglob + (size_t)Q.myq * QCAP; for (int i = F.tid(); i < QCAP; i += 512) Q.qlds[i] = qg[i]; }
    WG_BAR();
    unsigned d = Q.claim_wg(F.tid());
#if SEC_BARRIER
    int cursec = 0;
#endif
    for (;;) {
        const int type = d >> 24;
#if SEC_BARRIER
        { const int sec = (type == U_END) ? 5 * NLAYER : ((d >> 20) & 15) * 5 + ((type >= U_SSM) ? 1 : (type == U_PA ? 0 : type));
          while (cursec < sec) { if ((SEC_MASK >> cursec) & 1) xcd_barrier(bar); ++cursec; } }
#endif
        if (type == U_END) break;
        if (type <= U_PE) { d = gemm_stream(args, F, Q, d); continue; }
        const int l = (d >> 20) & 15, a = (d >> 10) & 1023;
        Q.wait_deps(d, F.tid());
        if (type == U_SSM) ssm_unit(args, F, l, a);
        else if (type == U_ATT) attn_unit(args, F, l, a / NQB, a % NQB);
        else if (type == U_SATT) sattn_unit(args, F, l, a);
        else pool_unit(args, F, l, a);
        Q.publish(d, F.tid());
        d = Q.claim_wg(F.tid());
    }
}

extern "C" void kernel_launch(void* const* d_in, const int* in_sizes, int n_in, void* d_out, int out_size, void* d_ws, size_t ws_size, hipStream_t stream) {
    static int grid = 0;
    if (grid == 0) {
        if (n_in != 32 || (size_t)out_size != O_END || ws_size < WS_END) { fprintf(stderr, "kernel_launch: unexpected shapes: n_in %d out %d (want %zu) ws %zu (want >= %zu)\n", n_in, out_size, (size_t)O_END, ws_size, (size_t)WS_END); grid = -1; return; }
        int dev = 0, cus = 0, per_cu = 0;
        if (hipGetDevice(&dev) != hipSuccess || hipDeviceGetAttribute(&cus, hipDeviceAttributeMultiprocessorCount, dev) != hipSuccess) { fprintf(stderr, "kernel_launch: device query failed\n"); grid = -1; return; }
        if (hipFuncSetAttribute((const void*)hymba_fwd, hipFuncAttributeMaxDynamicSharedMemorySize, LDS_BYTES) != hipSuccess) { fprintf(stderr, "kernel_launch: hipFuncSetAttribute failed\n"); grid = -1; return; }
        if (hipOccupancyMaxActiveBlocksPerMultiprocessor(&per_cu, (const void*)hymba_fwd, 512, LDS_BYTES) != hipSuccess || per_cu < 1) { fprintf(stderr, "kernel_launch: occupancy query says %d blocks per CU\n", per_cu); per_cu = 1; }
        (void)hipGetLastError();
        grid = cus;
        if (grid % 8 != 0) grid -= grid % 8;
    }
    if (grid < 0) return;
    (void)hipMemsetAsync((char*)d_ws + WS_CTL, 0, CTL_ZERO_BYTES, stream);
    Args a{};
    for (int i = 0; i < 32; ++i) a.in[i] = (const float*)d_in[i];
    a.out = (float*)d_out; a.ws = (unsigned char*)d_ws; a.ph_lo = 0; a.ph_hi = 0;
    hipLaunchKernelGGL(hymba_fwd, dim3(grid), dim3(512), LDS_BYTES, stream, a);
    const hipError_t le = hipPeekAtLastError();
    if (le != hipSuccess) fprintf(stderr, "kernel_launch: launch failed: %s\n", hipGetErrorName(le));
}
```

```cpp
#include <hip/hip_runtime.h>
#include <cstdio>
#include <cstdint>

#ifndef MK_N_LAUNCHES
#define MK_N_LAUNCHES 1
#endif

#ifndef SEC_BARRIER
#define SEC_BARRIER 0
#endif
#ifndef STREAM_SAME_SECTION
#define STREAM_SAME_SECTION 1
#endif
#ifndef SEC_MASK
#define SEC_MASK 0x10
#endif
#ifndef PROBE
#define PROBE 0
#endif
#ifndef PROBE_KIND
#define PROBE_KIND 1
#endif
#ifndef PROBE_TYPE
#define PROBE_TYPE 0
#endif
#ifndef PROBE_Q
#define PROBE_Q 20.0f
#endif
#ifndef DUP_PB
#define DUP_PB 1
#endif
#ifndef DUP_P0
#define DUP_P0 1
#endif

constexpr int DM = 2048, TT = 4112  , NSEQ = 4096, NMETA = 16, NBATCH = 2, NSAMP = 32;
constexpr int MR = NBATCH * TT + NSAMP;
constexpr int MP = 8448;
constexpr int SROW0 = NBATCH * TT;
constexpr int INW = 2560, DFF = 8192, NLAYER = 2;
constexpr int TPV = 4128;
constexpr int ROPE_SAMPLE_IDX = TT;
constexpr float EPS = 1e-6f;
constexpr float LOG2E = 1.4426950408889634f;
constexpr float QSCALE = 0.08838834764831845f * LOG2E;
constexpr int NCHUNK = MR / 64;
constexpr int NQB = (TT + 31) / 32;

constexpr size_t O_YP = 0, O_YS = O_YP + (size_t)NBATCH * NSEQ * DM, O_PK = O_YS + (size_t)NSAMP * DM, O_PV = O_PK + (size_t)NLAYER * NBATCH * 128 * 256,
                 O_PSR = O_PV + (size_t)NLAYER * NBATCH * 128 * 256, O_PSI = O_PSR + (size_t)NLAYER * NBATCH * 2048, O_PP = O_PSI + (size_t)NLAYER * NBATCH * 2048,
                 O_SK = O_PP + (size_t)NLAYER * NBATCH * 15 * 512, O_SV = O_SK + (size_t)NLAYER * NSAMP * 128 * 256, O_SSR = O_SV + (size_t)NLAYER * NSAMP * 128 * 256,
                 O_SSI = O_SSR + (size_t)NLAYER * NSAMP * 2048, O_SP = O_SSI + (size_t)NLAYER * NSAMP * 2048, O_END = O_SP + (size_t)NLAYER * NSAMP * 15 * 512;

constexpr size_t MiB = 1u << 20;
constexpr size_t WS_CTL = 0, CTL_ZERO_BYTES = 1 * MiB;
constexpr size_t WS_WIN = 1 * MiB, WS_WOUT = 21 * MiB, WS_W1 = 37 * MiB, WS_W2 = 101 * MiB, WS_WGLU = 165 * MiB, WS_WPOOL = 166 * MiB, WS_TAB = 167 * MiB;
constexpr size_t WS_X = 170 * MiB, WS_XB = 236 * MiB, WS_Q = 269 * MiB, WS_K = 286 * MiB, WS_VT = 291 * MiB, WS_U = 296 * MiB, WS_XP = 313 * MiB, WS_MIX = 330 * MiB,
                 WS_H = 363 * MiB, WS_SSQ = 495 * MiB, WS_SST = 497 * MiB, WS_KSN = 502 * MiB, WS_QUEUE = 503 * MiB, WS_END = 504 * MiB;
static_assert(WS_WIN + (size_t)NLAYER * INW * DM * 2 <= WS_WOUT && WS_WOUT + (size_t)NLAYER * DM * DM * 2 <= WS_W1 && WS_W1 + (size_t)NLAYER * DFF * DM * 2 <= WS_W2 && WS_W2 + (size_t)NLAYER * DFF * DM * 2 <= WS_WGLU, "ws map 1");
static_assert(WS_X + (size_t)MP * DM * 4 <= WS_XB && WS_XB + (size_t)MP * DM * 2 <= WS_Q && WS_Q + (size_t)MP * 1024 * 2 <= WS_K && WS_K + (size_t)MP * 256 * 2 <= WS_VT && WS_VT + (size_t)4 * 128 * TPV * 2 <= WS_U, "ws map 2");
static_assert(WS_U + (size_t)MP * 512 * 4 <= WS_XP && WS_XP + (size_t)MP * 512 * 4 <= WS_MIX && WS_MIX + (size_t)MP * DM * 2 <= WS_H && WS_H + (size_t)MP * DFF * 2 <= WS_SSQ && WS_SSQ + (size_t)MP * 32 * 4 <= WS_SST, "ws map 3");
static_assert(WS_SST + (size_t)NLAYER * NCHUNK * 32 * 64 * 8 <= WS_KSN, "ws map 4");
constexpr size_t TB_ABR = 0, TB_ABI = 8192, TB_ALR = 16384, TB_ALI = 24576, TB_A16R = 32768, TB_A16I = 40960, TB_A32R = 49152, TB_A32I = 57344,
                 TB_BBR = 65536, TB_BBI = TB_BBR + 131072, TB_PM = TB_BBI + 131072, TB_CMT = TB_PM + 524288, TB_LAYER = 1 * MiB;
static_assert(TB_CMT + 131072 <= TB_LAYER, "table map");
constexpr size_t WS_ROPE = WS_TAB + 2 * MiB;
constexpr size_t ROPE_N = (size_t)(TT + 1) * 16;
constexpr int CW_TMO = 0, CW_CODE = 1, CW_BAR = 4096, CW_QHEAD = 8192  , CW_STAT = 8800, CW_CNT = 9216  , CW_SSMF = 16384  ;
static_assert(CW_CNT + NLAYER * 5 * 40 * 16 <= CW_SSMF, "ctl map: counters");
static_assert((CW_SSMF + NLAYER * NCHUNK * 8 * 16) * 4 <= (int)CTL_ZERO_BYTES, "ctl map");

constexpr int RING_BYTES = 131072, ESC_OFF = RING_BYTES  , QTAB_OFF = ESC_OFF + 12288  , LDSCTL_OFF = QTAB_OFF + 4096, MISC_OFF = LDSCTL_OFF + 320, LDS_BYTES = 148480;
static_assert(MISC_OFF + 128 <= LDS_BYTES, "LDS map");

#define GAS __attribute__((address_space(1)))
#define LAS __attribute__((address_space(3)))
typedef unsigned short bf16;
typedef unsigned v4u __attribute__((ext_vector_type(4)));
typedef unsigned v2u __attribute__((ext_vector_type(2)));
typedef float f32x2 __attribute__((ext_vector_type(2)));
typedef float f32x16 __attribute__((ext_vector_type(16)));
typedef __bf16 bf16x2_t __attribute__((ext_vector_type(2)));
typedef GAS unsigned gu32;
typedef GAS unsigned long long gu64;
#define RLX_AGENT __ATOMIC_RELAXED, __HIP_MEMORY_SCOPE_AGENT
#define LDS_WAIT() asm volatile("s_waitcnt lgkmcnt(0)" ::: "memory")
#define VM_WAIT() asm volatile("s_waitcnt vmcnt(0)" ::: "memory")
#define WG_BAR() do { asm volatile("s_waitcnt lgkmcnt(0)" ::: "memory"); __builtin_amdgcn_s_barrier(); asm volatile("" ::: "memory"); } while (0)
__device__ __forceinline__ unsigned pk2(float lo, float hi) { f32x2 v = {lo, hi}; bf16x2_t b = __builtin_convertvector(v, bf16x2_t); return __builtin_bit_cast(unsigned, b); }
__device__ __forceinline__ float bf2f(unsigned short h) { return __builtin_bit_cast(float, (unsigned)h << 16); }
__device__ __forceinline__ float wave_sum(float v) {
#pragma unroll
    for (int o = 1; o < 64; o <<= 1) v += __shfl_xor(v, o);
    return v;
}
__device__ __forceinline__ float wave_max(float v) {
#pragma unroll
    for (int o = 1; o < 64; o <<= 1) v = fmaxf(v, __shfl_xor(v, o));
    return v;
}

typedef __amdgpu_buffer_rsrc_t rsrc_t;
__device__ __forceinline__ rsrc_t ws_rsrc(unsigned char* ws) { return __builtin_amdgcn_make_buffer_rsrc(ws, 0, (int)WS_END, 0x00020000); }
#define ST16(r, off, v) __builtin_amdgcn_raw_buffer_store_b128(__builtin_bit_cast(v4u, (v)), (r), (unsigned)(off), 0, 16)
#define ST8(r, off, v)  __builtin_amdgcn_raw_buffer_store_b64((v), (r), (unsigned)(off), 0, 16)
#define ST4(r, off, v)  __builtin_amdgcn_raw_buffer_store_b32(__builtin_bit_cast(unsigned, (v)), (r), (unsigned)(off), 0, 16)
#define ST2(r, off, v)  __builtin_amdgcn_raw_buffer_store_b16((unsigned short)(v), (r), (unsigned)(off), 0, 16)
__host__ __device__ __forceinline__ int perm16(int o) { return 8 * ((o >> 2) & 1) + 4 * (o >> 3) + (o & 3); }

namespace pg8 {
#define PG8_LAS __attribute__((address_space(3)))
typedef unsigned short bf16_t;
typedef short bf16x8 __attribute__((ext_vector_type(8)));
typedef float f32x4 __attribute__((ext_vector_type(4)));
typedef unsigned u32x4 __attribute__((ext_vector_type(4)));
constexpr int BM = 256, BK = 64, HALF = 128, HTB = HALF * BK * 2  , STAGE_BYTES = 8 * HTB, NXCD = 8, WGM = 8;

__host__ __device__ __forceinline__ int lds_byte(int r, int c) { const int st = (r >> 4) * 2 + (c >> 5), rr = r & 15, cc = c & 31, ob = rr * 64 + cc * 2; return st * 1024 + (ob ^ (((ob >> 9) & 1) << 5)); }
__host__ __device__ __forceinline__ void stage_rc(int b, int& R, int& C) { const int st = b / 1024, sb = b % 1024, swz = sb ^ (((sb >> 9) & 1) << 5); R = (st >> 1) * 16 + swz / 64; C = (st & 1) * 32 + (swz % 64) / 2; }
__host__ __device__ __forceinline__ int perm32(int rho) { const int n = rho >> 4, i = rho & 15; return 8 * (i >> 2) + 4 * n + (i & 3); }

struct Unit { int pm, pn; };
struct Gemm { const bf16_t* A; const bf16_t* Bt; int M, N, K; };

struct StaticOrder {
    int nM, nN, nwg, G, c;
    __host__ __device__ void init(int M, int N, int G_, int c_) { nM = M / BM; nN = N / BM; nwg = nM * nN; G = G_; c = c_; }
    __host__ __device__ bool next(int i, Unit& u) const {
        const long L = (long)i * G + c; if (L >= nwg) return false;
        int wgid = (int)L; { const int q = nwg / NXCD, r = nwg % NXCD, xcd = wgid % NXCD, off = wgid / NXCD; wgid = (xcd < r ? xcd * (q + 1) : r * (q + 1) + (xcd - r) * q) + off; }
        const int nig = WGM * nN, gid = wgid / nig, fm = gid * WGM, gsz = (nM - fm) < WGM ? (nM - fm) : WGM;
        u.pm = fm + ((wgid % nig) % gsz); u.pn = (wgid % nig) / gsz; return true;
    }
    __device__ __forceinline__ void a_ready(const Unit&) const {}
    __device__ __forceinline__ void done(const Unit&) const {}
};


template <class Epi, class Sched, bool ALIGN_EPI = false, bool SP2 = false>
__device__ __forceinline__ void gemm_phase(PG8_LAS unsigned char* lds, PG8_LAS unsigned char* esc, const Gemm g, const Sched& S, const Epi& E) {
    int tid_ = threadIdx.x; asm volatile("" : "+v"(tid_));
    const int tid = tid_, wid = __builtin_amdgcn_readfirstlane(tid >> 6), lane = tid & 63, wr = wid >> 2, wc = wid & 3, fr = lane & 15, fq = lane >> 4;
    const int K = g.K, nt = K / BK;
    unsigned voffA[2], voffB[2];
#pragma unroll
    for (int i = 0; i < 2; ++i) { int R, C; stage_rc(tid * 16 + i * 8192, R, C); const int Rb = Epi::PERM ? ((R & ~31) + perm32(R & 31)) : R;
        voffA[i] = (unsigned)(R * K + C) * 2u; voffB[i] = (unsigned)(Rb * K + C) * 2u; }
    const size_t kstep = (size_t)(BK * 2);
    const size_t hstep = (size_t)HALF * K * 2;
    const size_t tstep = 2 * hstep;
    const unsigned ldsw = (unsigned)wid * 1024u;
    const int aoff = lds_byte(wr * 64 + fr, fq * 8), boff = lds_byte(wc * 32 + fr, fq * 8);
#define PG8_SA(b, h) (((b) * 2 + (h)) * HTB)
#define PG8_SB(b, h) ((4 + (b) * 2 + (h)) * HTB)
#define PG8_STAGE(bufoff, gbase, voff) do { _Pragma("unroll") for (int _i = 0; _i < 2; ++_i) \
        __builtin_amdgcn_global_load_lds((const unsigned*)((const char*)(gbase) + (voff)[_i]), (PG8_LAS unsigned*)(lds + (bufoff) + ldsw + _i * 8192), 16, 0, 0); } while (0)
#define PG8_LDA(dst, b, h) do { _Pragma("unroll") for (int m = 0; m < 4; ++m) _Pragma("unroll") for (int k = 0; k < 2; ++k) dst[m][k] = *(const PG8_LAS bf16x8*)(lds + PG8_SA(b, h) + aoff + m * 2048 + k * 1024); } while (0)
#define PG8_LDB(dst, b, h) do { _Pragma("unroll") for (int n = 0; n < 2; ++n) _Pragma("unroll") for (int k = 0; k < 2; ++k) dst[n][k] = *(const PG8_LAS bf16x8*)(lds + PG8_SB(b, h) + boff + n * 2048 + k * 1024); } while (0)
#define PG8_MMA(ai, bj, At, Bt) do { __builtin_amdgcn_s_setprio(1); _Pragma("unroll") for (int m = 0; m < 4; ++m) _Pragma("unroll") for (int n = 0; n < 2; ++n) _Pragma("unroll") for (int k = 0; k < 2; ++k) \
        acc[ai][bj][m][n] = __builtin_amdgcn_mfma_f32_16x16x32_bf16(Bt[n][k], At[m][k], acc[ai][bj][m][n], 0, 0, 0); __builtin_amdgcn_s_setprio(0); } while (0)
#define PG8_WAIT_V(n) asm volatile("s_waitcnt vmcnt(" #n ")" ::: "memory")
#define PG8_WAIT_L(n) asm volatile("s_waitcnt lgkmcnt(" #n ")" ::: "memory")
#define PG8_BAR __builtin_amdgcn_s_barrier()
#define PG8_SCHED __builtin_amdgcn_sched_barrier(0)
    Unit cur, nxt; int ui = 0;
    if (!S.next(0, cur)) return;
    f32x4 acc[2][2][4][2];
#pragma unroll
    for (int a = 0; a < 2; ++a)
#pragma unroll
        for (int b = 0; b < 2; ++b)
#pragma unroll
            for (int m = 0; m < 4; ++m)
#pragma unroll
                for (int n = 0; n < 2; ++n) acc[a][b][m][n] = (f32x4){0.f, 0.f, 0.f, 0.f};
    bf16x8 At[4][2], B0[2][2], B1[2][2];
    const char* cA = (const char*)g.A + (size_t)cur.pm * tstep; const char* cB = (const char*)g.Bt + (size_t)cur.pn * tstep;
    S.a_ready(cur);
    if constexpr (SP2) {
        PG8_STAGE(PG8_SB(0, 0), cB, voffB); PG8_STAGE(PG8_SB(0, 1), cB + hstep, voffB); PG8_STAGE(PG8_SA(0, 0), cA, voffA); PG8_STAGE(PG8_SA(0, 1), cA + hstep, voffA);
        if (wr == 1) PG8_BAR;
        PG8_WAIT_V(2); PG8_BAR;
        PG8_STAGE(PG8_SB(1, 0), cB + kstep, voffB); PG8_STAGE(PG8_SA(1, 0), cA + kstep, voffA); PG8_STAGE(PG8_SB(1, 1), cB + hstep + kstep, voffB);
        PG8_WAIT_V(6); PG8_BAR;
    } else {
        PG8_STAGE(PG8_SB(0, 0), cB, voffB); PG8_STAGE(PG8_SA(0, 0), cA, voffA); PG8_STAGE(PG8_SB(0, 1), cB + hstep, voffB); PG8_STAGE(PG8_SA(0, 1), cA + hstep, voffA);
        if (wr == 1) PG8_BAR;
        PG8_WAIT_V(4); PG8_BAR;
        PG8_STAGE(PG8_SB(1, 0), cB + kstep, voffB); PG8_STAGE(PG8_SA(1, 0), cA + kstep, voffA); PG8_STAGE(PG8_SB(1, 1), cB + hstep + kstep, voffB);
        PG8_WAIT_V(6); PG8_BAR;
    }
    for (;;) {
        const bool has_next = S.next(ui + 1, nxt);
        const char* nA = has_next ? (const char*)g.A + (size_t)nxt.pm * tstep : cA; const char* nB = has_next ? (const char*)g.Bt + (size_t)nxt.pn * tstep : cB;
        for (int t = 0; t < nt; t += 2) {
            const bool last = (t == nt - 2);
            const char* a1 = cA + (size_t)(t + 1) * kstep;
            const char* a2 = last ? nA : cA + (size_t)(t + 2) * kstep; const char* b2 = last ? nB : cB + (size_t)(t + 2) * kstep;
            const char* a3 = a2 + kstep; const char* b3 = b2 + kstep;
            if (last && has_next) S.a_ready(nxt);
            if constexpr (SP2) {
            PG8_LDB(B0, 0, 0); PG8_LDB(B1, 0, 1); PG8_SCHED; PG8_LDA(At, 0, 0); PG8_STAGE(PG8_SA(1, 1), a1 + hstep, voffA);
            PG8_WAIT_V(8); PG8_WAIT_L(0); PG8_BAR; PG8_MMA(0, 0, At, B0); PG8_MMA(0, 1, At, B1); PG8_BAR; PG8_SCHED;
            PG8_LDA(At, 0, 1); PG8_STAGE(PG8_SB(0, 0), b2, voffB); PG8_STAGE(PG8_SB(0, 1), b2 + hstep, voffB); PG8_STAGE(PG8_SA(0, 0), a2, voffA);
            PG8_WAIT_V(8); PG8_WAIT_L(0); PG8_BAR; PG8_MMA(1, 0, At, B0); PG8_MMA(1, 1, At, B1); PG8_BAR; PG8_SCHED;
            PG8_LDB(B0, 1, 0); PG8_LDB(B1, 1, 1); PG8_SCHED; PG8_LDA(At, 1, 0); PG8_STAGE(PG8_SA(0, 1), a2 + hstep, voffA);
            PG8_WAIT_V(8); PG8_WAIT_L(0); PG8_BAR; PG8_MMA(0, 0, At, B0); PG8_MMA(0, 1, At, B1); PG8_BAR; PG8_SCHED;
            PG8_LDA(At, 1, 1); PG8_STAGE(PG8_SB(1, 0), b3, voffB); PG8_STAGE(PG8_SB(1, 1), b3 + hstep, voffB); PG8_STAGE(PG8_SA(1, 0), a3, voffA);
            PG8_WAIT_V(8); PG8_WAIT_L(0); PG8_BAR; PG8_MMA(1, 0, At, B0); PG8_MMA(1, 1, At, B1); PG8_BAR; PG8_SCHED;
            } else {
            PG8_LDB(B0, 0, 0); PG8_SCHED; PG8_LDA(At, 0, 0); PG8_STAGE(PG8_SA(1, 1), a1 + hstep, voffA);
            PG8_WAIT_L(8); PG8_BAR; PG8_WAIT_L(0); PG8_MMA(0, 0, At, B0); PG8_BAR; PG8_SCHED;
            PG8_LDB(B1, 0, 1); PG8_STAGE(PG8_SB(0, 0), b2, voffB);
            PG8_BAR; PG8_WAIT_L(0); PG8_MMA(0, 1, At, B1); PG8_BAR;
            PG8_LDA(At, 0, 1); PG8_STAGE(PG8_SA(0, 0), a2, voffA);
            PG8_BAR; PG8_WAIT_L(0); PG8_MMA(1, 0, At, B0); PG8_BAR; PG8_SCHED;
            PG8_STAGE(PG8_SB(0, 1), b2 + hstep, voffB);
            PG8_WAIT_V(6); PG8_BAR; PG8_MMA(1, 1, At, B1); PG8_BAR;
            PG8_LDB(B0, 1, 0); PG8_SCHED; PG8_LDA(At, 1, 0); PG8_STAGE(PG8_SA(0, 1), a2 + hstep, voffA);
            PG8_WAIT_L(8); PG8_BAR; PG8_WAIT_L(0); PG8_MMA(0, 0, At, B0); PG8_BAR; PG8_SCHED;
            PG8_LDB(B1, 1, 1); PG8_STAGE(PG8_SB(1, 0), b3, voffB);
            PG8_BAR; PG8_WAIT_L(0); PG8_MMA(0, 1, At, B1); PG8_BAR;
            PG8_LDA(At, 1, 1); PG8_STAGE(PG8_SA(1, 0), a3, voffA);
            PG8_BAR; PG8_WAIT_L(0); PG8_MMA(1, 0, At, B0); PG8_BAR; PG8_SCHED;
            PG8_STAGE(PG8_SB(1, 1), b3 + hstep, voffB);
            PG8_WAIT_V(6); PG8_BAR; PG8_MMA(1, 1, At, B1); PG8_BAR;
            }
        }
        if constexpr (ALIGN_EPI) { if (wr == 0) PG8_BAR; }
        { E(acc, cur, wr, wc, fr, fq, esc, tid); S.done(cur); }
        if (!has_next) break;
#pragma unroll
        for (int a = 0; a < 2; ++a)
#pragma unroll
            for (int b = 0; b < 2; ++b)
#pragma unroll
                for (int m = 0; m < 4; ++m)
#pragma unroll
                    for (int n = 0; n < 2; ++n) acc[a][b][m][n] = (f32x4){0.f, 0.f, 0.f, 0.f};
        cur = nxt; cA = nA; cB = nB; ++ui;
        if constexpr (ALIGN_EPI) { if (wr == 1) PG8_BAR; }
    }
    PG8_WAIT_V(0);
    if constexpr (!ALIGN_EPI) { if (wr == 0) PG8_BAR; }
    PG8_BAR;
#undef PG8_SA
#undef PG8_SB
#undef PG8_STAGE
#undef PG8_LDA
#undef PG8_LDB
#undef PG8_MMA
#undef PG8_WAIT_V
#undef PG8_WAIT_L
#undef PG8_BAR
#undef PG8_SCHED
}
}

typedef float f32x4 __attribute__((ext_vector_type(4)));
typedef short bf16x8 __attribute__((ext_vector_type(8)));


__device__ __forceinline__ void build_rs(const float* ssq, int pm, LAS unsigned char* esc, int tid) {
    LAS float* rsT = (LAS float*)esc;
    WG_BAR();
    if (tid < 256) {
        float s = 0.f;
#pragma unroll
        for (int j = 0; j < 8; ++j) { const gu64* p = (const gu64*)(ssq + ((size_t)j * MP + pm * 256 + tid) * 4);
#pragma unroll
            for (int h = 0; h < 2; ++h) { const unsigned long long v = __hip_atomic_load(p + h, RLX_AGENT); s += __builtin_bit_cast(float, (unsigned)v) + __builtin_bit_cast(float, (unsigned)(v >> 32)); } }
        rsT[tid] = rsqrtf(s * (1.0f / DM) + EPS);
    }
    WG_BAR();
}

struct EpiProj {
    static constexpr bool PERM = false, AFTER_DRAIN = false;
    unsigned char* ws_; float* out_; const float* gq; const float* gk; int l;
    __device__ __forceinline__ void operator()(f32x4 (&acc)[2][2][4][2], const pg8::Unit& u, int wr, int wc, int fr, int fq, LAS unsigned char* esc, int tid) const {
        asm volatile("" : "+v"(fr), "+v"(fq), "+v"(tid));
        size_t z_ = 0; asm volatile("" : "+s"(z_)); unsigned char* ws = ws_ + z_;
        const float* ssq = (const float*)(ws + WS_SSQ); const float* ropec = (const float*)(ws + WS_ROPE); const float* ropes = ropec + ROPE_N;
        bf16* Q = (bf16*)(ws + WS_Q); bf16* K = (bf16*)(ws + WS_K); bf16* VT = (bf16*)(ws + WS_VT); float* U = (float*)(ws + WS_U); float* XP = (float*)(ws + WS_XP);
        float* ksn = (float*)(ws + WS_KSN); float* vsn = ksn + NSAMP * 256;
        float* out_pk = out_ + O_PK + (size_t)l * NBATCH * 128 * 256; float* out_pv = out_ + O_PV + (size_t)l * NBATCH * 128 * 256;
        const rsrc_t rs_ = ws_rsrc(ws);
        build_rs(ssq, u.pm, esc, tid);
        const LAS float* rsT = (const LAS float*)esc;
        LAS float* hss = (LAS float*)(esc + 1024);
        const int pn = u.pn;
#pragma unroll
        for (int ai = 0; ai < 2; ++ai)
#pragma unroll
            for (int m = 0; m < 4; ++m) { const float rsv = rsT[ai * 128 + wr * 64 + m * 16 + fr];
#pragma unroll
                for (int bj = 0; bj < 2; ++bj)
#pragma unroll
                    for (int n = 0; n < 2; ++n) acc[ai][bj][m][n] *= rsv; }
        if (pn <= 4) {
#pragma unroll
            for (int ai = 0; ai < 2; ++ai)
#pragma unroll
                for (int m = 0; m < 4; ++m)
#pragma unroll
                    for (int bj = 0; bj < 2; ++bj) { const f32x4 a = acc[ai][bj][m][0], b = acc[ai][bj][m][1];
                        float s = (a[0] * a[0] + a[1] * a[1]) + (a[2] * a[2] + a[3] * a[3]) + (b[0] * b[0] + b[1] * b[1]) + (b[2] * b[2] + b[3] * b[3]);
                        s += __shfl_xor(s, 16); s += __shfl_xor(s, 32);
                        if (fq == 0) hss[(bj * 256 + ai * 128 + wr * 64 + m * 16 + fr) * 4 + wc] = s; }
            WG_BAR();
            const float* g = (pn < 4) ? gq : gk; const float osc = (pn < 4) ? QSCALE : 1.0f;
            f32x4 gv[2];
#pragma unroll
            for (int n = 0; n < 2; ++n) gv[n] = *(const f32x4*)(g + wc * 32 + n * 16 + 4 * fq);
#pragma unroll
            for (int ai = 0; ai < 2; ++ai)
#pragma unroll
                for (int m = 0; m < 4; ++m) {
                    const int rl = ai * 128 + wr * 64 + m * 16 + fr, r = u.pm * 256 + rl;
                    const bool samp = r >= SROW0, pad = r >= MR;
                    const int b = (r >= TT && !samp) ? 1 : 0, t = r - b * TT;
                    const int pidx = samp ? ROPE_SAMPLE_IDX : t;
                    f32x4 cs = {1.f, 1.f, 1.f, 1.f}, sn = {0.f, 0.f, 0.f, 0.f};
                    if (wc == 0 && !pad) { cs = *(const f32x4*)(ropec + (size_t)pidx * 16 + 4 * fq); sn = *(const f32x4*)(ropes + (size_t)pidx * 16 + 4 * fq); }
#pragma unroll
                    for (int bj = 0; bj < 2; ++bj) {
                        const f32x4 hv = *(const LAS f32x4*)(hss + (bj * 256 + rl) * 4);
                        const float hn = rsqrtf(((hv[0] + hv[1]) + (hv[2] + hv[3])) * (1.0f / 128.0f) + EPS);
                        f32x4 x1 = acc[ai][bj][m][0] * hn * gv[0], x2 = acc[ai][bj][m][1] * hn * gv[1];
                        if (wc == 0) { const f32x4 o1 = x1 * cs - x2 * sn, o2 = x2 * cs + x1 * sn; x1 = o1; x2 = o2; }
                        x1 = x1 * osc; x2 = x2 * osc;
                        const int cl = bj * 128 + wc * 32 + 4 * fq;
                        if (pn < 4) { const size_t qo = WS_Q + ((size_t)r * 1024 + pn * 256 + cl) * 2;
                            ST8(rs_, qo, ((v2u){pk2(x1[0], x1[1]), pk2(x1[2], x1[3])})); ST8(rs_, qo + 32, ((v2u){pk2(x2[0], x2[1]), pk2(x2[2], x2[3])})); }
                        else { const size_t ko = WS_K + ((size_t)r * 256 + cl) * 2;
                            ST8(rs_, ko, ((v2u){pk2(x1[0], x1[1]), pk2(x1[2], x1[3])})); ST8(rs_, ko + 32, ((v2u){pk2(x2[0], x2[1]), pk2(x2[2], x2[3])}));
                            if (samp && !pad) { const size_t o = WS_KSN + ((size_t)(r - SROW0) * 256 + cl) * 4; ST16(rs_, o, x1); ST16(rs_, o + 64, x2); }
                            else if (!samp && t >= TT - 128) { float* o = out_pk + ((size_t)(b * 128 + (t - (TT - 128))) * 256) + cl; *(f32x4*)o = x1; *(f32x4*)(o + 16) = x2; } }
                    }
                }
        } else if (pn == 5) {
#pragma unroll
            for (int ai = 0; ai < 2; ++ai)
#pragma unroll
                for (int m = 0; m < 4; ++m) {
                    const int rl = ai * 128 + wr * 64 + m * 16 + fr, r = u.pm * 256 + rl;
                    const bool samp = r >= SROW0, pad = r >= MR;
                    const int b = (r >= TT && !samp) ? 1 : 0, t = r - b * TT;
                    const int tpos = (t & ~15) + perm16(t & 15);
#pragma unroll
                    for (int bj = 0; bj < 2; ++bj)
#pragma unroll
                        for (int n = 0; n < 2; ++n) { const f32x4 x = acc[ai][bj][m][n]; const int d = wc * 32 + n * 16 + 4 * fq;
                            if (!samp) { const size_t vo = WS_VT + (((size_t)((b * 2 + bj) * 128 + d)) * TPV + tpos) * 2;
#pragma unroll
                                for (int j = 0; j < 4; ++j) ST2(rs_, vo + (size_t)j * TPV * 2, pk2(x[j], 0.f) & 0xffffu);
                                if (t >= TT - 128) *(f32x4*)(out_pv + ((size_t)(b * 128 + (t - (TT - 128))) * 256) + bj * 128 + d) = x; }
                            else if (!pad) ST16(rs_, WS_KSN + ((size_t)NSAMP * 256 + (size_t)(r - SROW0) * 256 + bj * 128 + d) * 4, x); }
                }
        } else {
            const size_t dsto = (pn < 8) ? WS_U + (size_t)(pn - 6) * 256 * 4 : WS_XP + (size_t)(pn - 8) * 256 * 4;
#pragma unroll
            for (int ai = 0; ai < 2; ++ai)
#pragma unroll
                for (int m = 0; m < 4; ++m) { const size_t ro = dsto + ((size_t)(u.pm * 256 + ai * 128 + wr * 64 + m * 16 + fr) * 512 + wc * 32 + 4 * fq) * 4;
#pragma unroll
                    for (int bj = 0; bj < 2; ++bj)
#pragma unroll
                        for (int n = 0; n < 2; ++n) ST16(rs_, ro + (size_t)(bj * 128 + n * 16) * 4, acc[ai][bj][m][n]); }
        }
    }
};

struct EpiRes {
    static constexpr bool PERM = true, AFTER_DRAIN = false;
    unsigned char* ws_; float* out; int last;
    __device__ __forceinline__ void operator()(f32x4 (&acc)[2][2][4][2], const pg8::Unit& u, int wr, int wc, int fr, int fq, LAS unsigned char* esc, int tid) const {
        asm volatile("" : "+v"(fr), "+v"(fq), "+v"(tid));
        size_t z_ = 0; asm volatile("" : "+s"(z_)); unsigned char* ws = ws_ + z_;
        const bf16* XB = (const bf16*)(ws + WS_XB); const rsrc_t rs_ = ws_rsrc(ws);
        v4u xb[2][4][2];
#pragma unroll
        for (int ai = 0; ai < 2; ++ai)
#pragma unroll
            for (int m = 0; m < 4; ++m) { const bf16* xp = XB + (size_t)(u.pm * 256 + ai * 128 + wr * 64 + m * 16 + fr) * DM + u.pn * 256 + wc * 32 + 8 * fq;
#pragma unroll
                for (int bj = 0; bj < 2; ++bj) xb[ai][m][bj] = *(const v4u*)(xp + bj * 128); }
#pragma unroll
        for (int ai = 0; ai < 2; ++ai)
#pragma unroll
            for (int m = 0; m < 4; ++m) {
                const int r = u.pm * 256 + ai * 128 + wr * 64 + m * 16 + fr; const int c0 = u.pn * 256 + wc * 32 + 8 * fq;
                const size_t eo = (size_t)r * DM + c0; float s = 0.f;
                f32x4 v[2][2];
#pragma unroll
                for (int bj = 0; bj < 2; ++bj) { const v4u w = xb[ai][m][bj];
                    const f32x4 x0 = {__builtin_bit_cast(float, w.x << 16), __builtin_bit_cast(float, w.x & 0xffff0000u), __builtin_bit_cast(float, w.y << 16), __builtin_bit_cast(float, w.y & 0xffff0000u)};
                    const f32x4 x1 = {__builtin_bit_cast(float, w.z << 16), __builtin_bit_cast(float, w.z & 0xffff0000u), __builtin_bit_cast(float, w.w << 16), __builtin_bit_cast(float, w.w & 0xffff0000u)};
                    v[bj][0] = x0 + acc[ai][bj][m][0]; v[bj][1] = x1 + acc[ai][bj][m][1];
#pragma unroll
                    for (int n = 0; n < 2; ++n) { const f32x4 q = v[bj][n] * v[bj][n]; s += (q[0] + q[1]) + (q[2] + q[3]); } }
                if (!last) {
#pragma unroll
                    for (int bj = 0; bj < 2; ++bj)
                        ST16(rs_, WS_XB + (eo + bj * 128) * 2, ((v4u){pk2(v[bj][0][0], v[bj][0][1]), pk2(v[bj][0][2], v[bj][0][3]), pk2(v[bj][1][0], v[bj][1][1]), pk2(v[bj][1][2], v[bj][1][3])}));
                    s += __shfl_xor(s, 16); s += __shfl_xor(s, 32);
                    if (fq == 0) ST4(rs_, WS_SSQ + (((size_t)u.pn * MP + r) * 4 + wc) * 4, s);
                } else {
                    const bool samp = r >= SROW0, pad = r >= MR; const int b = (r >= TT && !samp) ? 1 : 0, t = r - b * TT;
                    float* op = nullptr;
                    if (samp) { if (!pad) op = out + O_YS + (size_t)(r - SROW0) * DM + c0; } else if (t >= NMETA) op = out + O_YP + ((size_t)b * NSEQ + (t - NMETA)) * DM + c0;
                    if (op) {
#pragma unroll
                        for (int bj = 0; bj < 2; ++bj)
#pragma unroll
                            for (int n = 0; n < 2; ++n) *(f32x4*)(op + bj * 128 + n * 4) = v[bj][n]; }
                }
            }
    }
};

struct EpiFfn1 {
    static constexpr bool PERM = true, AFTER_DRAIN = false;
    unsigned char* ws_;
    __device__ __forceinline__ void operator()(f32x4 (&acc)[2][2][4][2], const pg8::Unit& u, int wr, int wc, int fr, int fq, LAS unsigned char* esc, int tid) const {
        asm volatile("" : "+v"(fr), "+v"(fq), "+v"(tid));
        size_t z_ = 0; asm volatile("" : "+s"(z_)); unsigned char* ws = ws_ + z_;
        const rsrc_t rs_ = ws_rsrc(ws);
        build_rs((const float*)(ws + WS_SSQ), u.pm, esc, tid);
        const LAS float* rsT = (const LAS float*)esc;
#pragma unroll
        for (int ai = 0; ai < 2; ++ai)
#pragma unroll
            for (int m = 0; m < 4; ++m) { const int rl = ai * 128 + wr * 64 + m * 16 + fr; const float rsv = rsT[rl];
                const size_t ho = WS_H + ((size_t)(u.pm * 256 + rl) * DFF + u.pn * 256 + wc * 32 + 8 * fq) * 2;
#pragma unroll
                for (int bj = 0; bj < 2; ++bj) { f32x4 v0 = acc[ai][bj][m][0] * rsv, v1 = acc[ai][bj][m][1] * rsv;
#pragma unroll
                    for (int j = 0; j < 4; ++j) { const float a = fmaxf(v0[j], 0.f), b = fmaxf(v1[j], 0.f); v0[j] = a * a; v1[j] = b * b; }
                    ST16(rs_, ho + bj * 256, ((v4u){pk2(v0[0], v0[1]), pk2(v0[2], v0[3]), pk2(v1[0], v1[1]), pk2(v1[2], v1[3])})); } }
    }
};

#define XB_TMO      128
#define XB_XCNT(j)  (256  + 64 * (j))
#define XB_XSUB(j)  (1280 + 64 * (j))
#define XB_XGEN(j)  (2304 + 64 * (j))
#define XB_TOP      3328
#define XB_TOPGEN   3392
#define XCD_BAR_WORDS 3456
#define XB_SPIN_CAP (1u << 18)
__device__ __forceinline__ unsigned xb_ld(unsigned* p)              { return __hip_atomic_load(p, __ATOMIC_RELAXED, __HIP_MEMORY_SCOPE_AGENT); }
__device__ __forceinline__ unsigned xb_add(unsigned* p, unsigned v) { return __hip_atomic_fetch_add(p, v, __ATOMIC_RELAXED, __HIP_MEMORY_SCOPE_AGENT); }
__device__ __forceinline__ unsigned xb_xcc_id() { return (unsigned)__builtin_amdgcn_s_getreg((3 << 11) | 20) & 0xFu; }
#define XB_SPIN(cond, bar) do { unsigned _sp = 0; while (cond) { __builtin_amdgcn_s_sleep(1); \
    if ((++_sp & 255u) == 0u) { if (xb_ld(&(bar)[XB_TMO])) break; if (_sp > XB_SPIN_CAP) { atomicAdd(&(bar)[XB_TMO], 1u); break; } } } } while (0)

struct XcdBarrier {
    unsigned* bar; unsigned x;
    volatile LAS unsigned* st;
};

__device__ __forceinline__ XcdBarrier xcd_barrier_post(unsigned* bar, volatile LAS unsigned* st) {
    XcdBarrier b; b.bar = bar; b.x = xb_xcc_id(); b.st = st;
    if (threadIdx.x == 0) (void)xb_add(&bar[XB_XCNT(b.x)], 1u);
    return b;
}
__device__ __forceinline__ void xcd_barrier_complete(unsigned* bar, unsigned x, unsigned& nloc, unsigned& nx) {
    const unsigned G = gridDim.x * gridDim.y * gridDim.z;
    unsigned sum, cnt, mine, sp = 0u;
    for (;;) {
        sum = 0u; cnt = 0u; mine = 0u;
#pragma unroll
        for (unsigned j = 0; j < 16; ++j) { const unsigned c = xb_ld(&bar[XB_XCNT(j)]); sum += c; cnt += (c > 0u) ? 1u : 0u; mine = (j == x) ? c : mine; }
        if (sum == G) break;
        __builtin_amdgcn_s_sleep(1);
        if ((++sp & 255u) == 0u) { if (xb_ld(&bar[XB_TMO])) break; if (sp > XB_SPIN_CAP) { atomicAdd(&bar[XB_TMO], 1u); break; } }
    }
    nloc = mine > 0u ? mine : 1u; nx = cnt > 0u ? cnt : 1u;
}

__device__ __forceinline__ void xcd_barrier(const XcdBarrier& b) {
    asm volatile("s_waitcnt vmcnt(0)" ::: "memory");
    __syncthreads();
    if (threadIdx.x == 0) {
        unsigned* bar = b.bar;
        __builtin_amdgcn_s_waitcnt(0);
        unsigned nloc = b.st[0], nx = b.st[1];
        if (nloc == 0u) { xcd_barrier_complete(bar, b.x, nloc, nx); b.st[0] = nloc; b.st[1] = nx; }
        const unsigned old = xb_add(&bar[XB_XSUB(b.x)], 1u);
        const unsigned gen = old / nloc;
        if (old + 1u == (gen + 1u) * nloc) {
            __builtin_amdgcn_fence(__ATOMIC_RELEASE, "agent");
            asm volatile("s_waitcnt vmcnt(0)" ::: "memory");
            const unsigned og = xb_add(&bar[XB_TOP], 1u);
            const unsigned tg = og / nx;
            if (og + 1u == (tg + 1u) * nx) xb_add(&bar[XB_TOPGEN], 1u);
            else XB_SPIN(xb_ld(&bar[XB_TOPGEN]) == tg, bar);
            __builtin_amdgcn_fence(__ATOMIC_ACQUIRE, "agent");
            xb_add(&bar[XB_XGEN(b.x)], 1u);
            asm volatile("s_waitcnt vmcnt(0)" ::: "memory");
        } else {
            XB_SPIN(xb_ld(&bar[XB_XGEN(b.x)]) == gen, bar);
            __builtin_amdgcn_fence(__ATOMIC_ACQUIRE, "agent");
            asm volatile("s_waitcnt vmcnt(0)" ::: "memory");
        }
    }
    __syncthreads();
}

struct Frame {
    LAS unsigned char* lds;
    volatile LAS unsigned* MISC;
    gu32* ctl;
    int wave, vcu, G;
    __device__ __forceinline__ int lane() const { int l; asm volatile("v_mbcnt_lo_u32_b32 %0, -1, 0\n\tv_mbcnt_hi_u32_b32 %0, -1, %0" : "=v"(l)); return l; }
    __device__ __forceinline__ int tid() const { return wave * 64 + lane(); }
    float* out; unsigned char* ws;
};
#define IN_XPROMPT 0
#define IN_XSAMPLE 1
#define IN_CACHEK 2
#define IN_CACHEV 3
#define IN_SSMRE 4
#define IN_SSMIM 5
#define IN_SPOOL 6
#define IN_META 7
#define IN_GMIX 8
#define IN_WIN 9
#define IN_GQ 10
#define IN_GK 11
#define IN_SINKS 12
#define IN_ARE 13
#define IN_AIM 14
#define IN_LOGDT 15
#define IN_BRE 16
#define IN_BIM 17
#define IN_CRE 18
#define IN_CIM 19
#define IN_DSKIP 20
#define IN_WGLU 21
#define IN_BGLU 22
#define IN_WPOOL 23
#define IN_PSCALE 24
#define IN_GOA 25
#define IN_GOS 26
#define IN_GOP 27
#define IN_WOUT 28
#define IN_GFFN 29
#define IN_WFF1 30
#define IN_WFF2 31
struct Args { const float* in[32]; float* out; unsigned char* ws; int ph_lo, ph_hi; };
static_assert(sizeof(Args) == 32 * 8 + 8 + 8 + 8, "Args has no padding");

__device__ __forceinline__ void p0_transpose_item(const float* W, int K, int N, bf16* WT, const float* gain, LAS float* scr, int item, int lane) {
    const int nblk = N / 32, kb = item / nblk, nb = item % nblk, k0 = 64 * kb, n0 = 32 * nb;
    float wv[32];
#pragma unroll
    for (int i = 0; i < 32; ++i) wv[i] = W[(size_t)(k0 + 2 * i + (lane >> 5)) * N + n0 + (lane & 31)];
    if (gain) {
#pragma unroll
        for (int i = 0; i < 32; ++i) wv[i] *= gain[k0 + 2 * i + (lane >> 5)];
    }
#pragma unroll
    for (int i = 0; i < 32; ++i) scr[(2 * i + (lane >> 5)) * 33 + (lane & 31)] = wv[i];
    LDS_WAIT(); asm volatile("" ::: "memory");
    const int c = lane & 7;
#pragma unroll
    for (int j = 0; j < 4; ++j) { const int n = (lane >> 3) + 8 * j; const LAS float* s = scr + (8 * c) * 33 + n;
        v4u o; o.x = pk2(s[0 * 33], s[1 * 33]); o.y = pk2(s[2 * 33], s[3 * 33]); o.z = pk2(s[4 * 33], s[5 * 33]); o.w = pk2(s[6 * 33], s[7 * 33]);
        *(GAS v4u*)(WT + (size_t)(n0 + n) * K + k0 + 8 * c) = o; }
    LDS_WAIT(); asm volatile("" ::: "memory");
}
__device__ __forceinline__ void sincos_d(double x, double& s, double& c) {
    const double TWO_PI = 6.283185307179586476925286766559;
    const double k = rint(x * (1.0 / TWO_PI)); const double r = fma(-k, TWO_PI, x), r2 = r * r;
    const double fs[14] = {0.16666666666666666, 0.05, 0.023809523809523808, 0.013888888888888888, 0.00909090909090909, 0.00641025641025641, 0.004761904761904762, 0.003676470588235294,
                           0.0029239766081871343, 0.002380952380952381, 0.001976284584980237, 0.0016666666666666668, 0.0014245014245014246, 0.0012315270935960591};
    const double fc[14] = {0.5, 0.08333333333333333, 0.03333333333333333, 0.017857142857142856, 0.011111111111111112, 0.007575757575757576, 0.005494505494505495, 0.004166666666666667,
                           0.0032679738562091504, 0.002631578947368421, 0.0021645021645021645, 0.0018115942028985507, 0.0015384615384615385, 0.0013227513227513227};
    double ts = r, tc = 1.0; s = r; c = 1.0;
#pragma unroll
    for (int i = 0; i < 14; ++i) { ts *= -r2 * fs[i]; s += ts; tc *= -r2 * fc[i]; c += tc; }
}
__device__ __forceinline__ double exp_small(double x) {
    double t = 1.0, e = 1.0;
#pragma unroll
    for (int i = 1; i <= 14; ++i) { t *= x * (1.0 / i); e += t; }
    return e;
}
__device__ __forceinline__ void p0_prologue(const Args& AR, Frame& F) {
    LAS float* scr = (LAS float*)(F.lds + F.wave * 16384);
    const int gw = F.vcu * 8 + F.wave, NGW = F.G * 8, lane = F.lane();
    unsigned char* ws = F.ws;
    constexpr int I_IN = (DM / 64) * (INW / 32), I_OUT = (DM / 64) * (DM / 32), I_1 = (DM / 64) * (DFF / 32), I_2 = (DFF / 64) * (DM / 32), I_GLU = (512 / 64) * (512 / 32), I_POOL = 4 * 2 * 4;
    constexpr int I_LAYER = I_IN + I_OUT + I_1 + I_2 + I_GLU + I_POOL;
    for (int it = gw; it < NLAYER * I_LAYER; it += NGW) {
        const int l = it / I_LAYER; int r = it % I_LAYER;
        if (r < I_IN) { p0_transpose_item(AR.in[IN_WIN] + (size_t)l * DM * INW, DM, INW, (bf16*)(ws + WS_WIN) + (size_t)l * INW * DM, AR.in[IN_GMIX] + l * DM, scr, r, lane); continue; } r -= I_IN;
        if (r < I_OUT) { const int k0 = 64 * (r / (DM / 32));
            const float* g = (k0 < 1024) ? AR.in[IN_GOA] + l * 1024 : (k0 < 1536) ? AR.in[IN_GOS] + l * 512 - 1024 : AR.in[IN_GOP] + l * 512 - 1536;
            p0_transpose_item(AR.in[IN_WOUT] + (size_t)l * DM * DM, DM, DM, (bf16*)(ws + WS_WOUT) + (size_t)l * DM * DM, g, scr, r, lane); continue; } r -= I_OUT;
        if (r < I_1) { p0_transpose_item(AR.in[IN_WFF1] + (size_t)l * DM * DFF, DM, DFF, (bf16*)(ws + WS_W1) + (size_t)l * DFF * DM, AR.in[IN_GFFN] + l * DM, scr, r, lane); continue; } r -= I_1;
        if (r < I_2) { p0_transpose_item(AR.in[IN_WFF2] + (size_t)l * DFF * DM, DFF, DM, (bf16*)(ws + WS_W2) + (size_t)l * DM * DFF, nullptr, scr, r, lane); continue; } r -= I_2;
        if (r < I_GLU) { p0_transpose_item(AR.in[IN_WGLU] + (size_t)l * 512 * 512, 512, 512, (bf16*)(ws + WS_WGLU) + (size_t)l * 512 * 512, nullptr, scr, r, lane); continue; } r -= I_GLU;
        { const int g = r / 8; p0_transpose_item(AR.in[IN_WPOOL] + ((size_t)l * 4 + g) * 128 * 128, 128, 128, (bf16*)(ws + WS_WPOOL) + ((size_t)l * 4 + g) * 128 * 128, nullptr, scr, r % 8, lane); }
    }
    bf16* XB = (bf16*)(ws + WS_XB); float* SSQ = (float*)(ws + WS_SSQ);
    for (int m = gw; m < MP; m += NGW) {
        const float* src = nullptr;
        if (m < SROW0) { const int b = m >= TT ? 1 : 0, t = m - b * TT; src = (t < NMETA) ? AR.in[IN_META] + (size_t)t * DM : AR.in[IN_XPROMPT] + ((size_t)b * NSEQ + (t - NMETA)) * DM; }
        else if (m < MR) src = AR.in[IN_XSAMPLE] + (size_t)(m - SROW0) * DM;
        float s = 0.f;
#pragma unroll
        for (int j = 0; j < 8; ++j) { f32x4 v = {0.f, 0.f, 0.f, 0.f}; if (src) v = *(const f32x4*)(src + j * 256 + lane * 4);
            s += (v[0] * v[0] + v[1] * v[1]) + (v[2] * v[2] + v[3] * v[3]);
            *(v2u*)(XB + (size_t)m * DM + j * 256 + lane * 4) = (v2u){pk2(v[0], v[1]), pk2(v[2], v[3])}; }
        s = wave_sum(s);
        if (lane < 32) SSQ[((size_t)(lane >> 2) * MP + m) * 4 + (lane & 3)] = (lane == 0) ? s : 0.f;
    }
    const int gt = gw * 64 + lane, NGT = NGW * 64;
    for (int id = gt; id < NLAYER * 32 * 64; id += NGT) {
        const int l = id >> 11, g = (id >> 6) & 31, n = id & 63;
        unsigned char* tb = ws + WS_TAB + (size_t)l * TB_LAYER;
        const double dt = (double)expf(AR.in[IN_LOGDT][l * 32 + g]);
        const double ar = (double)AR.in[IN_ARE][id], ai = (double)AR.in[IN_AIM][id];
        const double mag = exp_small(dt * ar); double sn, cs; sincos_d(dt * ai, sn, cs);
        const double abr = mag * cs, abi = mag * sn, den = ar * ar + ai * ai;
        const double fr = ((abr - 1.0) * ar + abi * ai) / den, fi = (abi * ar - (abr - 1.0) * ai) / den;
        ((float*)(tb + TB_ABR))[g * 64 + n] = (float)abr; ((float*)(tb + TB_ABI))[g * 64 + n] = (float)abi;
        const float* Br = AR.in[IN_BRE] + (size_t)id * 16; const float* Bi = AR.in[IN_BIM] + (size_t)id * 16;
        float* bbr = (float*)(tb + TB_BBR) + (size_t)(g * 64 + n) * 16; float* bbi = (float*)(tb + TB_BBI) + (size_t)(g * 64 + n) * 16;
        bf16* bbt = (bf16*)(tb + TB_PM) + (size_t)g * 128 * 16;
#pragma unroll
        for (int c = 0; c < 16; ++c) { const double br = Br[c], bi = Bi[c]; const float vr = (float)(fr * br - fi * bi), vi = (float)(fr * bi + fi * br); bbr[c] = vr; bbi[c] = vi;
            bbt[n * 16 + c] = (bf16)(pk2(vr, 0.f) & 0xffffu); bbt[(64 + n) * 16 + c] = (bf16)(pk2(vi, 0.f) & 0xffffu); }
        double pr = abr, pi = abi;
        for (int t = 0; t < 64; ++t) {
            if (t == 15) { ((float*)(tb + TB_A16R))[g * 64 + n] = (float)pr; ((float*)(tb + TB_A16I))[g * 64 + n] = (float)pi; }
            if (t == 31) { ((float*)(tb + TB_A32R))[g * 64 + n] = (float)pr; ((float*)(tb + TB_A32I))[g * 64 + n] = (float)pi; }
            if (t == 63) { ((float*)(tb + TB_ALR))[g * 64 + n] = (float)pr; ((float*)(tb + TB_ALI))[g * 64 + n] = (float)pi; }
            const double nr = pr * abr - pi * abi, ni = pr * abi + pi * abr; pr = nr; pi = ni;
        }
        bf16* CmT = (bf16*)(tb + TB_CMT) + (size_t)g * 16 * 128;
        const float* Cr = AR.in[IN_CRE] + ((size_t)(l * 32 + g) * 16) * 64 + n; const float* Ci = AR.in[IN_CIM] + ((size_t)(l * 32 + g) * 16) * 64 + n;
#pragma unroll
        for (int c = 0; c < 16; ++c) { CmT[c * 128 + n] = (bf16)(pk2(Cr[c * 64], 0.f) & 0xffffu); CmT[c * 128 + 64 + n] = (bf16)(pk2(-Ci[c * 64], 0.f) & 0xffffu); }
    }
    float* rc = (float*)(ws + WS_ROPE); float* rs_ = rc + ROPE_N;
    for (int id = gt; id < (int)ROPE_N; id += NGT) {
        const int p = id >> 4, i = id & 15; const double pos = (p == ROPE_SAMPLE_IDX) ? 16384.0 : (double)p;
        double inv = 1.0;
        for (int k = 0; k < i; ++k) inv *= 0.44036660267178046;
        double sn, cs; sincos_d(pos * inv, sn, cs);
        rc[id] = (float)cs; rs_[id] = (float)sn;
    }
}

__device__ __forceinline__ void attn_unit(const Args& AR, Frame& F, int l, int b, int i) {
    int lane_ = F.lane(); asm volatile("" : "+v"(lane_));
    size_t z_ = 0; asm volatile("" : "+s"(z_)); unsigned char* ws = F.ws + z_;
    const int lane = lane_, h = F.wave, c = lane & 31, hh = lane >> 5, kvh = h >> 2;
    const int t0 = 32 * i; const size_t rb = (size_t)b * TT;
#if PROBE && (PROBE_KIND == 11 || PROBE_KIND == 12)
    const unsigned long long ta0 = __builtin_amdgcn_s_memrealtime();
#endif
    const bf16* Q = (const bf16*)(ws + WS_Q); const bf16* K = (const bf16*)(ws + WS_K); const bf16* VT = (const bf16*)(ws + WS_VT);
    LAS float* ex = (LAS float*)(F.lds + ESC_OFF);
    bf16x8 qf[8];
    { const bf16* qp = Q + (rb + t0 + c) * 1024 + 128 * h + 8 * hh;
#pragma unroll
      for (int ks = 0; ks < 8; ++ks) qf[ks] = *(const bf16x8*)(qp + 16 * ks); }
    const int kt0 = (t0 >= 128) ? 0 : (4 - i);
    f32x16 S[5];
    bf16x8 kf[2][8];
    { const int tk0 = t0 - 128 + 32 * kt0; const bf16* kp = K + (rb + tk0 + c) * 256 + 128 * kvh + 8 * hh;
      if (kt0 & 1) {
#pragma unroll
          for (int ks = 0; ks < 8; ++ks) kf[1][ks] = *(const bf16x8*)(kp + 16 * ks);
      } else {
#pragma unroll
          for (int ks = 0; ks < 8; ++ks) kf[0][ks] = *(const bf16x8*)(kp + 16 * ks);
      } }
#pragma unroll
    for (int kt = 0; kt < 5; ++kt) {
#pragma unroll
        for (int r = 0; r < 16; ++r) S[kt][r] = -INFINITY;
        if (kt >= kt0) {
            if (kt < 4) { const int tk1 = t0 - 128 + 32 * (kt + 1); const bf16* kp = K + (rb + tk1 + c) * 256 + 128 * kvh + 8 * hh;
#pragma unroll
                for (int ks = 0; ks < 8; ++ks) kf[(kt + 1) & 1][ks] = *(const bf16x8*)(kp + 16 * ks); }
            f32x16 a = {0.f, 0.f, 0.f, 0.f, 0.f, 0.f, 0.f, 0.f, 0.f, 0.f, 0.f, 0.f, 0.f, 0.f, 0.f, 0.f};
#pragma unroll
            for (int ks = 0; ks < 8; ++ks) a = __builtin_amdgcn_mfma_f32_32x32x16_bf16(kf[kt & 1][ks], qf[ks], a, 0, 0, 0);
#pragma unroll
            for (int r = 0; r < 16; ++r) { const int kr = (r & 3) + 8 * (r >> 2) + 4 * hh; bool ok = true;
                if (kt == 0) ok = kr >= c;
                if (kt == 4) ok = kr <= c;
                S[kt][r] = ok ? a[r] : -INFINITY; }
        }
    }
#if PROBE && PROBE_KIND == 11
    if (F.tid() == 0) F.MISC[6] += (unsigned)(__builtin_amdgcn_s_memrealtime() - ta0);
#endif
    const float sink2 = AR.in[IN_SINKS][l * 8 + h] * LOG2E;
    float mx = sink2;
#pragma unroll
    for (int kt = 0; kt < 5; ++kt)
#pragma unroll
        for (int r = 0; r < 16; ++r) mx = fmaxf(mx, S[kt][r]);
    mx = fmaxf(mx, __shfl_xor(mx, 32));
    float sum = 0.f;
#pragma unroll
    for (int kt = 0; kt < 5; ++kt)
#pragma unroll
        for (int r = 0; r < 16; ++r) { const float p = __builtin_amdgcn_exp2f(S[kt][r] - mx); S[kt][r] = p; sum += p; }
    sum += __shfl_xor(sum, 32);
    const float inv = 1.0f / (sum + __builtin_amdgcn_exp2f(sink2 - mx));
    f32x16 O[4];
#pragma unroll
    for (int db = 0; db < 4; ++db)
#pragma unroll
        for (int r = 0; r < 16; ++r) O[db][r] = 0.f;
    const bf16* vbase = VT + ((size_t)((b * 2 + kvh) * 128 + c)) * TPV + (t0 - 128) + 8 * hh;
    bf16x8 vf[2][4];
#pragma unroll
    for (int db = 0; db < 4; ++db) vf[0][db] = *(const bf16x8*)(vbase + (size_t)(32 * db) * TPV + 32 * kt0);
#pragma unroll
    for (int st = 0; st < 10; ++st) {
        const int kt = st >> 1, s = st & 1;
        if (kt >= kt0) {
            if (st < 9) {
#pragma unroll
                for (int db = 0; db < 4; ++db) vf[(st + 1) & 1][db] = *(const bf16x8*)(vbase + (size_t)(32 * db) * TPV + 16 * (st + 1)); }
            v4u pw; pw.x = pk2(S[kt][8 * s + 0], S[kt][8 * s + 1]); pw.y = pk2(S[kt][8 * s + 2], S[kt][8 * s + 3]); pw.z = pk2(S[kt][8 * s + 4], S[kt][8 * s + 5]); pw.w = pk2(S[kt][8 * s + 6], S[kt][8 * s + 7]);
            const bf16x8 pf = __builtin_bit_cast(bf16x8, pw);
#pragma unroll
            for (int db = 0; db < 4; ++db) O[db] = __builtin_amdgcn_mfma_f32_32x32x16_bf16(vf[st & 1][db], pf, O[db], 0, 0, 0);
        }
    }
    float ss = 0.f;
#pragma unroll
    for (int db = 0; db < 4; ++db)
#pragma unroll
        for (int r = 0; r < 16; ++r) { O[db][r] *= inv; ss += O[db][r] * O[db][r]; }
#if PROBE && PROBE_KIND == 12
    if (F.tid() == 0) F.MISC[6] += (unsigned)(__builtin_amdgcn_s_memrealtime() - ta0);
#endif
    ss += __shfl_xor(ss, 32);
    if (hh == 0) ex[h * 32 + c] = ss;
    WG_BAR();
    float tot = 0.f;
#pragma unroll
    for (int j = 0; j < 8; ++j) tot += ex[j * 32 + c];
    const float rsa = rsqrtf(tot * (1.0f / 1024.0f) + EPS);
    if (t0 + c < TT) {
        const rsrc_t rs_ = ws_rsrc(ws); const size_t mo = WS_MIX + ((rb + t0 + c) * DM + 128 * h + 4 * hh) * 2;
#pragma unroll
        for (int db = 0; db < 4; ++db)
#pragma unroll
            for (int g4 = 0; g4 < 4; ++g4)
                ST8(rs_, mo + (32 * db + 8 * g4) * 2, ((v2u){pk2(O[db][4 * g4 + 0] * rsa, O[db][4 * g4 + 1] * rsa), pk2(O[db][4 * g4 + 2] * rsa, O[db][4 * g4 + 3] * rsa)}));
    }
    WG_BAR();
}

__device__ __forceinline__ void sattn_unit(const Args& AR, Frame& F, int l, int s) {
    int tid_ = F.tid(); asm volatile("" : "+v"(tid_));
    const int tid = tid_, lane = tid & 63, wave = F.wave;
    LAS float* qs = (LAS float*)F.lds;
    LAS float* sc = qs + 1024;
    LAS float* part = sc + 8 * 132;
    LAS float* red = part + 4096;
    const size_t row = SROW0 + s;
    const bf16* Q = (const bf16*)(F.ws + WS_Q) + row * 1024;
    const float* ksn = (const float*)(F.ws + WS_KSN) + (size_t)s * 256; const float* vsn = ksn + NSAMP * 256;
    const float* ck = AR.in[IN_CACHEK] + ((size_t)(l * NSAMP + s)) * 128 * 256; const float* cv = AR.in[IN_CACHEV] + ((size_t)(l * NSAMP + s)) * 128 * 256;
    for (int j = tid; j < 1024; j += 512) qs[j] = bf2f(Q[j]);
    WG_BAR();
    { const int key = tid >> 2, pt = tid & 3;
#pragma unroll
      for (int kvh = 0; kvh < 2; ++kvh) {
          const float* kp = ck + (size_t)key * 256 + kvh * 128 + 32 * pt; float d[4] = {0.f, 0.f, 0.f, 0.f};
#pragma unroll
          for (int j = 0; j < 8; ++j) { const f32x4 kv = *(const f32x4*)(kp + 4 * j);
#pragma unroll
              for (int g = 0; g < 4; ++g) { const f32x4 qv = *(const LAS f32x4*)(qs + (4 * kvh + g) * 128 + 32 * pt + 4 * j); d[g] += (kv[0] * qv[0] + kv[1] * qv[1]) + (kv[2] * qv[2] + kv[3] * qv[3]); } }
#pragma unroll
          for (int g = 0; g < 4; ++g) { d[g] += __shfl_xor(d[g], 1); d[g] += __shfl_xor(d[g], 2); if (pt == 0) sc[(4 * kvh + g) * 132 + key] = d[g]; }
      } }
    {
      const int h = wave, kvh = h >> 2; float d = ksn[kvh * 128 + lane] * qs[h * 128 + lane] + ksn[kvh * 128 + 64 + lane] * qs[h * 128 + 64 + lane];
      d = wave_sum(d); if (lane == 0) sc[h * 132 + 128] = d; }
    WG_BAR();
    { const int h = wave; const float sink2 = AR.in[IN_SINKS][l * 8 + h] * LOG2E;
      const float v0 = sc[h * 132 + lane], v1 = sc[h * 132 + 64 + lane], v2 = (lane == 0) ? sc[h * 132 + 128] : -INFINITY;
      const float mx = fmaxf(wave_max(fmaxf(fmaxf(v0, v1), v2)), sink2);
      const float p0 = __builtin_amdgcn_exp2f(v0 - mx), p1 = __builtin_amdgcn_exp2f(v1 - mx), p2 = __builtin_amdgcn_exp2f(v2 - mx);
      const float inv = 1.0f / (wave_sum(p0 + p1 + p2) + __builtin_amdgcn_exp2f(sink2 - mx));
      sc[h * 132 + lane] = p0 * inv; sc[h * 132 + 64 + lane] = p1 * inv; if (lane == 0) sc[h * 132 + 128] = p2 * inv; }
    WG_BAR();
    { const int d = tid & 127, kq = tid >> 7;
#pragma unroll
      for (int kvh = 0; kvh < 2; ++kvh) { float a[4] = {0.f, 0.f, 0.f, 0.f};
#pragma unroll 8
          for (int k = 0; k < 32; ++k) { const int key = 32 * kq + k; const float v = cv[(size_t)key * 256 + kvh * 128 + d];
#pragma unroll
              for (int g = 0; g < 4; ++g) a[g] += sc[(4 * kvh + g) * 132 + key] * v; }
#pragma unroll
          for (int g = 0; g < 4; ++g) part[kq * 1024 + (4 * kvh + g) * 128 + d] = a[g]; } }
    WG_BAR();
    float o[2]; float ss = 0.f;
#pragma unroll
    for (int e = 0; e < 2; ++e) { const int j = tid + 512 * e, h = j >> 7, d = j & 127, kvh = h >> 2;
        o[e] = (part[j] + part[1024 + j]) + (part[2048 + j] + part[3072 + j]) + sc[h * 132 + 128] * vsn[kvh * 128 + d]; ss += o[e] * o[e]; }
    ss = wave_sum(ss); if (lane == 0) red[wave] = ss;
    WG_BAR();
    { float tot = 0.f;
#pragma unroll
      for (int j = 0; j < 8; ++j) tot += red[j];
      const float rsa = rsqrtf(tot * (1.0f / 1024.0f) + EPS);
      const rsrc_t rs_ = ws_rsrc(F.ws);
#pragma unroll
      for (int e = 0; e < 2; ++e) ST2(rs_, WS_MIX + (row * DM + tid + 512 * e) * 2, pk2(o[e] * rsa, 0.f) & 0xffffu); }
    { float* ok = F.out + O_SK + ((size_t)(l * NSAMP + s)) * 128 * 256; float* ov = F.out + O_SV + ((size_t)(l * NSAMP + s)) * 128 * 256;
      for (int j = tid; j < 127 * 64; j += 512) { *(f32x4*)(ok + 4 * j) = *(const f32x4*)(ck + 256 + 4 * j); *(f32x4*)(ov + 4 * j) = *(const f32x4*)(cv + 256 + 4 * j); }
      if (tid < 64) *(f32x4*)(ok + 127 * 256 + 4 * tid) = *(const f32x4*)(ksn + 4 * tid);
      else if (tid < 128) *(f32x4*)(ov + 127 * 256 + 4 * (tid - 64)) = *(const f32x4*)(vsn + 4 * (tid - 64)); }
    WG_BAR();
}

__device__ __forceinline__ float gelu_tanh(float y) {
    const float inner = 0.7978845608028654f * (y + 0.044715f * y * y * y);
    return y / (1.0f + __builtin_amdgcn_exp2f(-2.0f * LOG2E * inner));
}
__device__ __forceinline__ float sigmoidf_(float x) { return 1.0f / (1.0f + __builtin_amdgcn_exp2f(-LOG2E * x)); }
#define SWZ(r, ch, PITCH) ((r) * (PITCH) + ((((ch)) ^ ((r) & 15)) << 4))

#ifndef SSM_P1
#define SSM_P1 1
#endif
#ifndef SSM_M2
#define SSM_M2 1
#endif
__device__ __forceinline__ int rowtok(int r) { return 16 * ((r >> 2) & 1) + 4 * (r >> 3) + (r & 3); }
struct SsmG { f32x16 X[4]; };
__device__ __forceinline__ void ssm_block(const Args& AR, SsmG& G, const float* U, int rowb, int g, const bf16x8 (&bbf)[4], const float (&ab)[4], float (&hr)[2], float (&hi)[2], int mode, int l, int s0, int lane) {
    const int c = lane & 31, hh = lane >> 5;
    bf16x8 af;
    { const float* up = U + (size_t)(rowb + rowtok(c)) * 512 + 16 * g + 8 * hh; const f32x4 u0 = *(const f32x4*)up, u1 = *(const f32x4*)(up + 4);
      v4u pw; pw.x = pk2(u0[0], u0[1]); pw.y = pk2(u0[2], u0[3]); pw.z = pk2(u1[0], u1[1]); pw.w = pk2(u1[2], u1[3]); af = __builtin_bit_cast(bf16x8, pw); }
    const f32x16 z16 = {0.f, 0.f, 0.f, 0.f, 0.f, 0.f, 0.f, 0.f, 0.f, 0.f, 0.f, 0.f, 0.f, 0.f, 0.f, 0.f};
#pragma unroll
    for (int nb = 0; nb < 4; ++nb) G.X[nb] = __builtin_amdgcn_mfma_f32_32x32x16_bf16(af, bbf[nb], z16, 0, 0, 0);
#pragma unroll
    for (int s = 0; s < 2; ++s) {
        const float ar = ab[2 * s], ai = ab[2 * s + 1];
        if (SSM_M2 && mode == 2) {
            { int cx = c; asm volatile("" : "+v"(cx)); const size_t o0 = ((size_t)(l * NSAMP + (s0 + 16 * hh)) * 32 + g) * 64 + cx + 32 * s; const float* qr = AR.in[IN_SSMRE] + o0; const float* qi = AR.in[IN_SSMIM] + o0;
              size_t jo = 0;
#pragma unroll
              for (int j = 0; j < 16; ++j) { const float pr = qr[jo], pi = qi[jo]; jo += 2048; asm volatile("" : "+v"(jo));
                const float nr = ar * pr - ai * pi + G.X[s][j], ni = ar * pi + ai * pr + G.X[2 + s][j]; G.X[s][j] = nr; G.X[2 + s][j] = ni; } }
            continue;
        }
        float r = (hh == 0) ? hr[s] : 0.f, i = (hh == 0) ? hi[s] : 0.f;
#pragma unroll
        for (int j = 0; j < 16; ++j) { const float nr = ar * r - ai * i + G.X[s][j], ni = ar * i + ai * r + G.X[2 + s][j]; r = nr; i = ni; G.X[s][j] = r; G.X[2 + s][j] = i; }
        float vr = __shfl_xor(r, 32), vi = __shfl_xor(i, 32);
        if (hh == 0 || mode == 1) { vr = 0.f; vi = 0.f; }
        float pr = ar, pi = ai; asm volatile("" : "+v"(pr), "+v"(pi));
#pragma unroll
        for (int j = 0; j < 16; ++j) { G.X[s][j] += pr * vr - pi * vi; G.X[2 + s][j] += pr * vi + pi * vr; const float nr = pr * ar - pi * ai, ni = pr * ai + pi * ar; pr = nr; pi = ni; }
        const float er = G.X[s][15], ei = G.X[2 + s][15];
        const float xr = __shfl_xor(er, 32), xi = __shfl_xor(ei, 32);
        hr[s] = (hh == 1) ? er : xr; hi[s] = (hh == 1) ? ei : xi;
    }
}
__device__ __forceinline__ void ssm_unit(const Args& AR, Frame& F, int l, int c_in) {
    const int c = c_in;
    int lane_ = F.lane(); asm volatile("" : "+v"(lane_));
    const int lane = lane_, w = F.wave, t16 = lane & 15, cq = lane >> 4, c32 = lane & 31, hh = lane >> 5;
    const int row0 = 64 * c;
    size_t z_ = 0; asm volatile("" : "+s"(z_)); unsigned char* ws = F.ws + z_;
    const unsigned char* tb = ws + WS_TAB + (size_t)l * TB_LAYER;
    const float* U = (const float*)(ws + WS_U);
    float* SST = (float*)(ws + WS_SST) + ((size_t)l * NCHUNK) * 32 * 128;
    gu32* flags = F.ctl + CW_SSMF + (size_t)(l * NCHUNK) * 8 * 16;
    LAS unsigned char* Zs = F.lds;
    LAS unsigned char* Hm = F.lds + 65536 + w * 8704;
    LAS float* red = (LAS float*)(F.lds + 137216);
    SsmG SG;
    if (SSM_P1 && c != NCHUNK - 1) {
#pragma unroll 1
        for (int gi = 0; gi < 4; ++gi) {
            const int g = 4 * w + gi;
            int lg_ = lane; asm volatile("" : "+v"(lg_));
            const int c32 = lg_ & 31, hh = lg_ >> 5;
            float ab[4]; ab[0] = ((const float*)(tb + TB_ABR))[g * 64 + c32]; ab[1] = ((const float*)(tb + TB_ABI))[g * 64 + c32]; ab[2] = ((const float*)(tb + TB_ABR))[g * 64 + 32 + c32]; ab[3] = ((const float*)(tb + TB_ABI))[g * 64 + 32 + c32];
            bf16x8 bbf[4];
            { const bf16* bt = (const bf16*)(tb + TB_PM) + (size_t)g * 128 * 16 + c32 * 16 + 8 * hh;
#pragma unroll
              for (int nb = 0; nb < 4; ++nb) bbf[nb] = *(const bf16x8*)(bt + nb * 32 * 16); }
            float hr[2] = {0.f, 0.f}, hi[2] = {0.f, 0.f};
            ssm_block(AR, SG, U, row0, g, bbf, ab, hr, hi, (c == 64) ? 1 : 0, l, 0, lg_);
            ssm_block(AR, SG, U, row0 + 32, g, bbf, ab, hr, hi, 0, l, 0, lg_);
            if (hh == 0) {
#pragma unroll
                for (int s = 0; s < 2; ++s) __hip_atomic_store((gu64*)(SST + ((size_t)c * 32 + g) * 128 + 2 * (c32 + 32 * s)), ((unsigned long long)__builtin_bit_cast(unsigned, hi[s]) << 32) | __builtin_bit_cast(unsigned, hr[s]), RLX_AGENT);
            }
        }
        VM_WAIT();
        if (lane == 0) __hip_atomic_store(flags + ((size_t)c * 8 + w) * 16, 1u, RLX_AGENT);
    }
    const int cs0 = (c <= 64) ? 0 : 64, npred = c - cs0;
    if (npred > 0) {
        unsigned sp = 0; bool ok = false;
        for (;;) { ok = (lane >= npred) || (__hip_atomic_load(flags + ((size_t)(cs0 + lane) * 8 + w) * 16, RLX_AGENT) != 0u);
            if (__all(ok)) break;
            __builtin_amdgcn_s_sleep(2);
            if (++sp > (1u << 20)) { if (lane == 0) __hip_atomic_store(F.ctl + CW_TMO, 0x55u, RLX_AGENT); break; } }
        __builtin_amdgcn_fence(__ATOMIC_ACQUIRE, "agent");
        VM_WAIT();
    }
#pragma unroll 1
    for (int gi = 0; gi < 4; ++gi) {
        const int g = 4 * w + gi;
        int lg_ = lane; asm volatile("" : "+v"(lg_));
        const int t16 = lg_ & 15, cq = lg_ >> 4, c32 = lg_ & 31, hh = lg_ >> 5;
        float ab[4]; ab[0] = ((const float*)(tb + TB_ABR))[g * 64 + c32]; ab[1] = ((const float*)(tb + TB_ABI))[g * 64 + c32]; ab[2] = ((const float*)(tb + TB_ABR))[g * 64 + 32 + c32]; ab[3] = ((const float*)(tb + TB_ABI))[g * 64 + 32 + c32];
        float hr[2] = {0.f, 0.f}, hi[2] = {0.f, 0.f};
        if (npred > 0) {
#pragma unroll
            for (int s = 0; s < 2; ++s) {
                const int n = c32 + 32 * s;
                const float aLr = ((const float*)(tb + TB_ALR))[g * 64 + n], aLi = ((const float*)(tb + TB_ALI))[g * 64 + n];
                float Hr = 0.f, Hi = 0.f;
                for (int cp = cs0; cp < c; cp += 8) {
                    f32x2 sv[8];
#pragma unroll
                    for (int j = 0; j < 8; ++j) { const int cj = (cp + j < c) ? cp + j : c - 1; sv[j] = *(const f32x2*)(SST + ((size_t)cj * 32 + g) * 128 + 2 * n); }
#pragma unroll
                    for (int j = 0; j < 8; ++j) if (cp + j < c) { const float nr = aLr * Hr - aLi * Hi + sv[j][0], ni = aLr * Hi + aLi * Hr + sv[j][1]; Hr = nr; Hi = ni; }
                }
                hr[s] = Hr; hi[s] = Hi;
            }
        }
        bf16x8 bbf[4];
        { const bf16* bt = (const bf16*)(tb + TB_PM) + (size_t)g * 128 * 16 + c32 * 16 + 8 * hh;
#pragma unroll
          for (int nb = 0; nb < 4; ++nb) bbf[nb] = *(const bf16x8*)(bt + nb * 32 * 16); }
        bf16x8 cmf[4];
        { const bf16* cm = (const bf16*)(tb + TB_CMT) + (size_t)g * 16 * 128 + t16 * 128 + 8 * cq;
#pragma unroll
          for (int ks = 0; ks < 4; ++ks) cmf[ks] = *(const bf16x8*)(cm + 32 * ks); }
        const int col = 64 * w + 16 * gi + 4 * cq;
        const f32x4 dsk = *(const f32x4*)(AR.in[IN_DSKIP] + l * 512 + col);
#pragma unroll 1
        for (int half = 0; half < 2; ++half) {
            int cc_ = c_in; asm volatile("" : "+s"(cc_)); const int c = cc_;
            const bool samp = (c == NCHUNK - 1) && (half == 1);
            ssm_block(AR, SG, U, row0 + 32 * half, g, bbf, ab, hr, hi, samp ? 2 : ((c == 64 && half == 0) ? 1 : 0), l, 0, lg_);
            { LAS unsigned char* hw = Hm + hh * (16 * 272) + c32 * 2;
#pragma unroll
              for (int j = 0; j < 16; ++j)
#pragma unroll
                for (int nb = 0; nb < 4; ++nb) *(LAS bf16*)(hw + j * 272 + nb * 64) = (bf16)(pk2(SG.X[nb][j], 0.f) & 0xffffu); }
            if ((c == 64 && half == 0) || (c == NCHUNK - 1 && half == 0)) {
                int cx = c32; asm volatile("" : "+v"(cx));
                if (hh == (c == 64 ? 0 : 1)) {
#pragma unroll
                    for (int s = 0; s < 2; ++s) { const size_t o = ((size_t)(l * NBATCH + (c == 64 ? 0 : 1)) * 32 + g) * 64 + cx + 32 * s; F.out[O_PSR + o] = SG.X[s][15]; F.out[O_PSI + o] = SG.X[2 + s][15]; } } }
            if (samp) { int cx = c32; asm volatile("" : "+v"(cx)); const size_t o0 = ((size_t)(l * NSAMP + 16 * hh) * 32 + g) * 64 + cx; float* qr = F.out + O_SSR + o0; float* qi = F.out + O_SSI + o0;
#pragma unroll
                for (size_t j = 0, jo = 0; j < 16; ++j) { qr[jo] = SG.X[0][j]; qr[jo + 32] = SG.X[1][j]; qi[jo] = SG.X[2][j]; qi[jo + 32] = SG.X[3][j]; jo += 2048; asm volatile("" : "+v"(jo)); } }
            LDS_WAIT();
#pragma unroll
            for (int mt = 0; mt < 2; ++mt) {
                f32x4 y = {0.f, 0.f, 0.f, 0.f};
#pragma unroll
                for (int ks = 0; ks < 4; ++ks) { const bf16x8 hf = *(const LAS bf16x8*)(Hm + (16 * mt + t16) * 272 + (4 * ks + cq) * 16);
                    y = __builtin_amdgcn_mfma_f32_16x16x32_bf16(cmf[ks], hf, y, 0, 0, 0); }
                const int rl = 32 * half + 16 * mt + t16;
                const f32x4 uv = *(const f32x4*)(U + (size_t)(row0 + rl) * 512 + col);
                f32x4 z;
#pragma unroll
                for (int e = 0; e < 4; ++e) z[e] = gelu_tanh(y[e] + dsk[e] * uv[e]);
                *(LAS v2u*)(Zs + SWZ(rl, col >> 3, 1024) + (col & 7) * 2) = (v2u){pk2(z[0], z[1]), pk2(z[2], z[3])};
            }
            LDS_WAIT();
        }
    }
    WG_BAR();
    f32x4 G[4][4];
#pragma unroll
    for (int mt = 0; mt < 4; ++mt)
#pragma unroll
        for (int nt = 0; nt < 4; ++nt) G[mt][nt] = (f32x4){0.f, 0.f, 0.f, 0.f};
    { const bf16* Wg = (const bf16*)(ws + WS_WGLU) + (size_t)l * 512 * 512 + (size_t)(64 * w + t16) * 512 + 8 * cq;
#pragma unroll 4
      for (int ks = 0; ks < 16; ++ks) {
          bf16x8 wf[4], zf[4];
#pragma unroll
          for (int nt = 0; nt < 4; ++nt) wf[nt] = *(const bf16x8*)(Wg + (size_t)nt * 16 * 512 + 32 * ks);
#pragma unroll
          for (int mt = 0; mt < 4; ++mt) zf[mt] = *(const LAS bf16x8*)(Zs + SWZ(16 * mt + t16, 4 * ks + cq, 1024));
#pragma unroll
          for (int mt = 0; mt < 4; ++mt)
#pragma unroll
              for (int nt = 0; nt < 4; ++nt) G[mt][nt] = __builtin_amdgcn_mfma_f32_16x16x32_bf16(wf[nt], zf[mt], G[mt][nt], 0, 0, 0);
      } }
#pragma unroll
    for (int mt = 0; mt < 4; ++mt) { float ss = 0.f; const int rl = 16 * mt + t16;
#pragma unroll
        for (int nt = 0; nt < 4; ++nt) { const int col = 64 * w + 16 * nt + 4 * cq; const f32x4 bg = *(const f32x4*)(AR.in[IN_BGLU] + l * 512 + col);
            const v2u zz = *(const LAS v2u*)(Zs + SWZ(rl, col >> 3, 1024) + (col & 7) * 2);
            const float zv[4] = {bf2f((unsigned short)(zz.x & 0xffffu)), bf2f((unsigned short)(zz.x >> 16)), bf2f((unsigned short)(zz.y & 0xffffu)), bf2f((unsigned short)(zz.y >> 16))};
#pragma unroll
            for (int e = 0; e < 4; ++e) { const float o = zv[e] * sigmoidf_(G[mt][nt][e] + bg[e]); G[mt][nt][e] = o; ss += o * o; } }
        ss += __shfl_xor(ss, 16); ss += __shfl_xor(ss, 32);
        if (cq == 0) red[rl * 8 + w] = ss; }
    WG_BAR();
    { const rsrc_t rs_ = ws_rsrc(ws);
#pragma unroll
      for (int mt = 0; mt < 4; ++mt) { const int rl = 16 * mt + t16; const LAS f32x4* rp = (const LAS f32x4*)(red + rl * 8); const f32x4 a = rp[0], b2 = rp[1];
          const float rsn = rsqrtf(((a[0] + a[1]) + (a[2] + a[3]) + (b2[0] + b2[1]) + (b2[2] + b2[3])) * (1.0f / 512.0f) + EPS);
          const size_t mo = WS_MIX + ((size_t)(row0 + rl) * DM + 1024 + 64 * w + 4 * cq) * 2;
#pragma unroll
          for (int nt = 0; nt < 4; ++nt) ST8(rs_, mo + 32 * nt, ((v2u){pk2(G[mt][nt][0] * rsn, G[mt][nt][1] * rsn), pk2(G[mt][nt][2] * rsn, G[mt][nt][3] * rsn)})); } }
    WG_BAR();
}
#undef SSM_ROWS4

template <int WLEN>
__device__ __forceinline__ void pool_half(const float* XP, float* out, int l, int ch, int rfirst, int rl0, LAS unsigned char* Ds) {
    float xv[48];
#pragma unroll
    for (int i = 0; i < 48; ++i) { const int ra = rfirst + i - 16; xv[i] = (ra >= 0) ? XP[(size_t)ra * 512 + ch] : 0.f; }
    int seg = (rfirst >= TT) ? TT : 0;
    float sum = 0.f;
#pragma unroll
    for (int j = 1; j <= WLEN; ++j) if (rfirst - j >= seg) sum += xv[16 - j];
#pragma unroll
    for (int i = 0; i < 32; ++i) {
        const int ra = rfirst + i; const float x = xv[16 + i];
        if (ra == TT) { seg = TT; sum = 0.f; }
        sum += x;
        if (ra - WLEN >= seg) sum -= xv[16 + i - WLEN];
        const int cnt = (ra - seg + 1 < WLEN) ? (ra - seg + 1) : WLEN;
        const float dm = sum * __builtin_amdgcn_rcpf((float)cnt) - x;
        if (ra >= TT - 15 && ra < TT) out[O_PP + ((size_t)(l * NBATCH + 0) * 15 + (ra - (TT - 15))) * 512 + ch] = x;
        if (ra >= SROW0 - 15) out[O_PP + ((size_t)(l * NBATCH + 1) * 15 + (ra - (SROW0 - 15))) * 512 + ch] = x;
        const int r = rl0 + i;
        *(LAS bf16*)(Ds + SWZ(r, ch >> 3, 1024) + (ch & 7) * 2) = (bf16)(pk2(dm, 0.f) & 0xffffu);
    }
}
template <int WLEN>
__device__ __forceinline__ void pool_sample_rows(const float* XP, const float* sp, float* out, int l, int ch, LAS unsigned char* Ds) {
#pragma unroll 2
    for (int s = 0; s < NSAMP; ++s) {
        const float* pp = sp + (size_t)s * 15 * 512; float pv[15];
#pragma unroll
        for (int j = 0; j < 15; ++j) pv[j] = pp[(size_t)j * 512];
        const float x = XP[(size_t)(SROW0 + s) * 512 + ch]; float a = x;
#pragma unroll
        for (int j = 16 - WLEN; j < 15; ++j) a += pv[j];
        const float dm = a * (1.0f / WLEN) - x;
        float* op = out + O_SP + ((size_t)(l * NSAMP + s) * 15) * 512 + ch;
#pragma unroll
        for (int j = 0; j < 14; ++j) op[(size_t)j * 512] = pv[j + 1];
        op[(size_t)14 * 512] = x;
        *(LAS bf16*)(Ds + SWZ(32 + s, ch >> 3, 1024) + (ch & 7) * 2) = (bf16)(pk2(dm, 0.f) & 0xffffu);
    }
}
__device__ __forceinline__ void pool_unit(const Args& AR, Frame& F, int l, int c) {
    int tid_ = F.tid(); asm volatile("" : "+v"(tid_));
    const int tid = tid_, lane = tid & 63, w = F.wave, t16 = lane & 15, cq = lane >> 4;
    const int row0 = 64 * c;
    size_t z_ = 0; asm volatile("" : "+s"(z_)); unsigned char* ws = F.ws + z_;
    const float* XP = (const float*)(ws + WS_XP);
    LAS unsigned char* Ds = F.lds;
    LAS float* red = (LAS float*)(F.lds + ESC_OFF);
    { const int ch = tid, wsel = w >> 1;
      const float* sp = AR.in[IN_SPOOL] + (size_t)l * NSAMP * 15 * 512 + ch;
#pragma unroll 1
      for (int half = 0; half < 2; ++half) {
          if (c == NCHUNK - 1 && half == 1) {
              if (wsel == 0) pool_sample_rows<2>(XP, sp, F.out, l, ch, Ds); else if (wsel == 1) pool_sample_rows<4>(XP, sp, F.out, l, ch, Ds);
              else if (wsel == 2) pool_sample_rows<8>(XP, sp, F.out, l, ch, Ds); else pool_sample_rows<16>(XP, sp, F.out, l, ch, Ds);
          } else {
              const int rfirst = row0 + 32 * half;
              if (wsel == 0) pool_half<2>(XP, F.out, l, ch, rfirst, 32 * half, Ds); else if (wsel == 1) pool_half<4>(XP, F.out, l, ch, rfirst, 32 * half, Ds);
              else if (wsel == 2) pool_half<8>(XP, F.out, l, ch, rfirst, 32 * half, Ds); else pool_half<16>(XP, F.out, l, ch, rfirst, 32 * half, Ds);
          }
      } }
    WG_BAR();
    const int gp = w & 3, rh = w >> 2;
    f32x4 A[2][8];
#pragma unroll
    for (int mt = 0; mt < 2; ++mt)
#pragma unroll
        for (int nt = 0; nt < 8; ++nt) A[mt][nt] = (f32x4){0.f, 0.f, 0.f, 0.f};
    { const bf16* Wp = (const bf16*)(ws + WS_WPOOL) + ((size_t)(l * 4 + gp) * 128 + t16) * 128 + 8 * cq;
#pragma unroll
      for (int ks = 0; ks < 4; ++ks) {
          bf16x8 df[2];
#pragma unroll
          for (int mt = 0; mt < 2; ++mt) df[mt] = *(const LAS bf16x8*)(Ds + SWZ(32 * rh + 16 * mt + t16, 16 * gp + 4 * ks + cq, 1024));
#pragma unroll
          for (int nt = 0; nt < 8; ++nt) { const bf16x8 wf = *(const bf16x8*)(Wp + (size_t)nt * 16 * 128 + 32 * ks);
#pragma unroll
              for (int mt = 0; mt < 2; ++mt) A[mt][nt] = __builtin_amdgcn_mfma_f32_16x16x32_bf16(wf, df[mt], A[mt][nt], 0, 0, 0); }
      } }
#pragma unroll
    for (int mt = 0; mt < 2; ++mt) { float ss = 0.f;
#pragma unroll
        for (int nt = 0; nt < 8; ++nt) { const f32x4 sc = *(const f32x4*)(AR.in[IN_PSCALE] + l * 512 + 128 * gp + 16 * nt + 4 * cq);
#pragma unroll
            for (int e = 0; e < 4; ++e) { const float o = A[mt][nt][e] * sc[e]; A[mt][nt][e] = o; ss += o * o; } }
        ss += __shfl_xor(ss, 16); ss += __shfl_xor(ss, 32);
        if (cq == 0) red[(32 * rh + 16 * mt + t16) * 4 + gp] = ss; }
    WG_BAR();
    { const rsrc_t rs_ = ws_rsrc(ws);
#pragma unroll
      for (int mt = 0; mt < 2; ++mt) { const int rl = 32 * rh + 16 * mt + t16; const f32x4 a = *(const LAS f32x4*)(red + rl * 4);
          const float rsn = rsqrtf(((a[0] + a[1]) + (a[2] + a[3])) * (1.0f / 512.0f) + EPS);
          const size_t mo = WS_MIX + ((size_t)(row0 + rl) * DM + 1536 + 128 * gp + 4 * cq) * 2;
#pragma unroll
          for (int nt = 0; nt < 8; ++nt) ST8(rs_, mo + 32 * nt, ((v2u){pk2(A[mt][nt][0] * rsn, A[mt][nt][1] * rsn), pk2(A[mt][nt][2] * rsn, A[mt][nt][3] * rsn)})); } }
    WG_BAR();
}

#ifndef ACQ_SCOPE
#define ACQ_SCOPE "agent"
#endif
#ifndef PE_ROW_OWNED
#define PE_ROW_OWNED 0
#endif
#ifndef PUBLISH_FENCE
#define PUBLISH_FENCE 0
#endif
enum { U_END = 0, U_PA = 1, U_PC = 2, U_PD = 3, U_PE = 4, U_SSM = 5, U_ATT = 6, U_SATT = 7, U_POOL = 8 };
constexpr int NPANEL = MP / 256;
constexpr int QCAP = 1024;
__host__ __device__ constexpr unsigned mkd(int type, int l, int a, int b) { return ((unsigned)type << 24) | ((unsigned)l << 20) | ((unsigned)a << 10) | (unsigned)b; }
__device__ __forceinline__ gu32* cnt_word(gu32* ctl, int l, int kind, int pm) { return ctl + CW_CNT + ((l * 5 + kind) * 40 + pm) * 16; }
__host__ __device__ constexpr unsigned mix_target(int pm) { return 3u * (unsigned)((MR - 256 * pm) < 256 ? (MR - 256 * pm) : 256); }

__device__ __forceinline__ void build_queue(unsigned* qt, int q) {
    int n = 1;
    for (int l = 0; l < NLAYER; ++l) {
        for (int pm = 0; pm < NPANEL; ++pm) { qt[n++] = mkd(U_PA, l, pm, q); if ((pm & 7) == q) { qt[n++] = mkd(U_PA, l, pm, 8); qt[n++] = mkd(U_PA, l, pm, 9); } }
        for (int c = q; c < NCHUNK; c += 8) qt[n++] = mkd(U_SSM, l, c, 0);
        for (int i = q; i < NBATCH * NQB; i += 8) qt[n++] = mkd(U_ATT, l, i, 0);
        for (int s = q; s < NSAMP; s += 8) qt[n++] = mkd(U_SATT, l, s, 0);
        for (int c = q; c < NCHUNK; c += 8) qt[n++] = mkd(U_POOL, l, c, 0);
        for (int pm = 0; pm < NPANEL; ++pm) qt[n++] = mkd(U_PC, l, pm, q);
        for (int pm = 0; pm < NPANEL; ++pm) for (int j = 0; j < 4; ++j) qt[n++] = mkd(U_PD, l, pm, 4 * q + j);
#if PE_ROW_OWNED
        for (int pm = q; pm < NPANEL - 1; pm += 8) for (int pn = 0; pn < 8; ++pn) qt[n++] = mkd(U_PE, l, pm, pn);
        qt[n++] = mkd(U_PE, l, NPANEL - 1, q);
#else
        for (int pm = 0; pm < NPANEL; ++pm) qt[n++] = mkd(U_PE, l, pm, q);
#endif
    }
    qt[0] = (unsigned)(n - 1);
}

struct Sched {
    gu32* ctl; const unsigned* qglob; LAS unsigned* qlds; volatile LAS unsigned* slot; int myq; unsigned nclaim; int ptype;
    __device__ __forceinline__ unsigned claim_lane() {
        { unsigned ho = (unsigned)(CW_QHEAD + myq * 64); asm volatile("" : "+s"(ho));
          const unsigned idx = __hip_atomic_fetch_add(ctl + ho, 1u, RLX_AGENT); if (idx < qlds[0]) return qlds[1 + idx]; }
        for (int k = 1; k < 8; ++k) { const int q = (myq + k) & 7; const unsigned* qg = qglob + (size_t)q * QCAP;
            if (__hip_atomic_load((gu32*)(ctl + CW_QHEAD + q * 64), RLX_AGENT) >= qg[0]) continue;
            const unsigned idx = __hip_atomic_fetch_add(ctl + CW_QHEAD + q * 64, 1u, RLX_AGENT); if (idx < qg[0]) return qg[1 + idx]; }
        return 0u;
    }
    __device__ __forceinline__ unsigned claim_wg(int tid) {
        const unsigned k = nclaim++ & 1u;
        if (tid == 0) slot[k] = claim_lane();
        WG_BAR();
        return slot[k];
    }
    __device__ __forceinline__ void poll(gu32* w, unsigned want) {
        unsigned sp = 0;
#if PROBE && PROBE_KIND == 1
        if (__hip_atomic_load(w, RLX_AGENT) >= want) return;
        struct TAcc { unsigned long long t0; volatile LAS unsigned* acc; bool on; __device__ ~TAcc() { if (on) acc[6] += (unsigned)(__builtin_amdgcn_s_memrealtime() - t0); } } tacc_{__builtin_amdgcn_s_memrealtime(), slot, PROBE_TYPE == 0 || ptype == PROBE_TYPE};
#endif
        while (__hip_atomic_load(w, RLX_AGENT) < want) { __builtin_amdgcn_s_sleep(2);
            if ((++sp & 1023u) == 0u) { if (__hip_atomic_load(ctl + CW_TMO, RLX_AGENT) != 0u) break; if (sp > (1u << 17)) { __hip_atomic_store(ctl + CW_TMO, 0x66u, RLX_AGENT); break; } } }
    }
    __device__ __forceinline__ bool ready_now(gu32* w, unsigned want) { return __hip_atomic_load(w, RLX_AGENT) >= want; }
    __device__ __forceinline__ bool deps_ready_now(unsigned d) {
        const int type = d >> 24, l = (d >> 20) & 15, a = (d >> 10) & 1023; bool ok = true;
        if (type == U_PA) { if (l > 0) { const int p2 = (a + 1 < NPANEL) ? a + 1 : NPANEL - 1; ok = ready_now(cnt_word(ctl, l - 1, 4, a), 8u) && ready_now(cnt_word(ctl, l - 1, 1, p2), mix_target(p2)); } }
        else if (type == U_PC) ok = ready_now(cnt_word(ctl, l, 1, a), mix_target(a));
        else if (type == U_PD) ok = ready_now(cnt_word(ctl, l, 2, a), 8u);
        else ok = ready_now(cnt_word(ctl, l, 3, a), 32u);
        if (ok) { __builtin_amdgcn_fence(__ATOMIC_ACQUIRE, ACQ_SCOPE); asm volatile("s_waitcnt vmcnt(0)" ::: "memory"); }
        return ok;
    }
    __device__ __forceinline__ void wait_deps(unsigned d, int tid) {
        if (tid == 0) {
            const int type = d >> 24, l = (d >> 20) & 15, a = (d >> 10) & 1023; ptype = type;
            if (type == U_PA) { if (l > 0) { poll(cnt_word(ctl, l - 1, 4, a), 8u); const int p2 = (a + 1 < NPANEL) ? a + 1 : NPANEL - 1; poll(cnt_word(ctl, l - 1, 1, p2), mix_target(p2)); } }
            else if (type == U_PC) poll(cnt_word(ctl, l, 1, a), mix_target(a));
            else if (type == U_PD) poll(cnt_word(ctl, l, 2, a), 8u);
            else if (type == U_PE) poll(cnt_word(ctl, l, 3, a), 32u);
            else if (type == U_SSM) poll(cnt_word(ctl, l, 0, a >> 2), 10u);
            else if (type == U_POOL) { poll(cnt_word(ctl, l, 0, a >> 2), 10u); const int r0 = 64 * a - 16; if (r0 >= 0) poll(cnt_word(ctl, l, 0, r0 >> 8), 10u); }
            else if (type == U_SATT) poll(cnt_word(ctl, l, 0, NPANEL - 1), 10u);
            else if (type == U_ATT) { const int b = a / NQB, i = a % NQB, t0 = 32 * i; const int rlo = b * TT + (t0 >= 128 ? t0 - 128 : 0), rhi = b * TT + ((t0 + 31 < TT) ? t0 + 31 : TT - 1);
                poll(cnt_word(ctl, l, 0, rlo >> 8), 10u); if ((rhi >> 8) != (rlo >> 8)) poll(cnt_word(ctl, l, 0, rhi >> 8), 10u); }
            __builtin_amdgcn_fence(__ATOMIC_ACQUIRE, ACQ_SCOPE);
            asm volatile("s_waitcnt vmcnt(0)" ::: "memory");
        }
        asm volatile("" ::: "memory"); __builtin_amdgcn_s_barrier(); asm volatile("" ::: "memory");
    }
    __device__ __forceinline__ void publish(unsigned d, int tid) {
        asm volatile("s_waitcnt vmcnt(0)" ::: "memory");
        WG_BAR();
        if (tid == 0) {
            const int type = d >> 24, l = (d >> 20) & 15, a = (d >> 10) & 1023;
#if PUBLISH_FENCE
            __builtin_amdgcn_fence(__ATOMIC_RELEASE, "agent");
            asm volatile("s_waitcnt vmcnt(0)" ::: "memory");
#endif
            if (type == U_PA) __hip_atomic_fetch_add(cnt_word(ctl, l, 0, a), 1u, RLX_AGENT);
            else if (type == U_PC) __hip_atomic_fetch_add(cnt_word(ctl, l, 2, a), 1u, RLX_AGENT);
            else if (type == U_PD) __hip_atomic_fetch_add(cnt_word(ctl, l, 3, a), 1u, RLX_AGENT);
            else if (type == U_PE) __hip_atomic_fetch_add(cnt_word(ctl, l, 4, a), 1u, RLX_AGENT);
            else if (type == U_SSM || type == U_POOL) __hip_atomic_fetch_add(cnt_word(ctl, l, 1, a >> 2), 64u, RLX_AGENT);
            else if (type == U_SATT) __hip_atomic_fetch_add(cnt_word(ctl, l, 1, NPANEL - 1), 1u, RLX_AGENT);
            else if (type == U_ATT) { const int b = a / NQB, i = a % NQB, t0 = 32 * i; const int r0 = b * TT + t0, r1 = b * TT + ((t0 + 31 < TT) ? t0 + 31 : TT - 1);
                const int p0 = r0 >> 8, p1 = r1 >> 8;
                if (p0 == p1) __hip_atomic_fetch_add(cnt_word(ctl, l, 1, p0), (unsigned)(r1 - r0 + 1), RLX_AGENT);
                else { __hip_atomic_fetch_add(cnt_word(ctl, l, 1, p0), (unsigned)(256 * p1 - r0), RLX_AGENT); __hip_atomic_fetch_add(cnt_word(ctl, l, 1, p1), (unsigned)(r1 - 256 * p1 + 1), RLX_AGENT); } }
        }
    }
};

#ifndef A_AUX
#define A_AUX 0
#endif
struct GU { const char* A; const char* B; unsigned voffA[2], voffB[2]; size_t hstep; int nt; unsigned d; pg8::Unit u; };

struct StreamCtx { unsigned char* ws; float* out; const float* gq; const float* gk; int R[2], C[2], Rp[2]; };
__device__ __forceinline__ void gu_fill(GU& g, unsigned d, const StreamCtx& X) {
    const int type = d >> 24, l = (d >> 20) & 15, pm = (d >> 10) & 1023, pn = d & 1023;
    unsigned char* ws = X.ws;
    const bf16* A; const bf16* B; int K = DM; bool perm = false;
    if (type == U_PA) { A = (const bf16*)(ws + WS_XB); B = (const bf16*)(ws + WS_WIN) + (size_t)l * INW * DM; }
    else if (type == U_PC) { A = (const bf16*)(ws + WS_MIX); B = (const bf16*)(ws + WS_WOUT) + (size_t)l * DM * DM; perm = true; }
    else if (type == U_PD) { A = (const bf16*)(ws + WS_XB); B = (const bf16*)(ws + WS_W1) + (size_t)l * DFF * DM; perm = true; }
    else { A = (const bf16*)(ws + WS_H); B = (const bf16*)(ws + WS_W2) + (size_t)l * DM * DFF; K = DFF; perm = true; }
    g.d = d; g.u.pm = pm; g.u.pn = pn; g.nt = K / 64; g.hstep = (size_t)128 * K * 2;
    g.A = (const char*)A + (size_t)pm * 256 * K * 2; g.B = (const char*)B + (size_t)pn * 256 * K * 2;
#pragma unroll
    for (int i = 0; i < 2; ++i) { g.voffA[i] = (unsigned)(X.R[i] * K + X.C[i]) * 2u; g.voffB[i] = (unsigned)((perm ? X.Rp[i] : X.R[i]) * K + X.C[i]) * 2u; }
}

__device__ __forceinline__ unsigned gemm_stream(const Args& AR, Frame& F, Sched& Q, unsigned d0) {
    int tid_ = F.tid(); asm volatile("" : "+v"(tid_));
    const int tid = tid_, wid = __builtin_amdgcn_readfirstlane(tid >> 6), lane = tid & 63, wr = wid >> 2, wc = wid & 3, fr = lane & 15, fq = lane >> 4;
    LAS unsigned char* lds = F.lds; LAS unsigned char* esc = F.lds + ESC_OFF;
    StreamCtx X; X.ws = F.ws; X.out = F.out;
#pragma unroll
    for (int i = 0; i < 2; ++i) { int R, C; pg8::stage_rc(tid * 16 + i * 8192, R, C); X.R[i] = R; X.C[i] = C; X.Rp[i] = (R & ~31) + pg8::perm32(R & 31); }
    const size_t kstep = (size_t)(pg8::BK * 2);
    const unsigned ldsw = (unsigned)wid * 1024u;
    const int aoff = pg8::lds_byte(wr * 64 + fr, fq * 8), boff = pg8::lds_byte(wc * 32 + fr, fq * 8);
#define PG8_SA(b, h) (((b) * 2 + (h)) * pg8::HTB)
#define PG8_SB(b, h) ((4 + (b) * 2 + (h)) * pg8::HTB)
#define PG8_STAGE(bufoff, gbase, voff) do { _Pragma("unroll") for (int _i = 0; _i < 2; ++_i) \
        __builtin_amdgcn_global_load_lds((const unsigned*)((const char*)(gbase) + (voff)[_i]), (LAS unsigned*)(lds + (bufoff) + ldsw + _i * 8192), 16, 0, 0); } while (0)
#define PG8_STAGE_A(bufoff, gbase, voff) do { _Pragma("unroll") for (int _i = 0; _i < 2; ++_i) \
        __builtin_amdgcn_global_load_lds((const unsigned*)((const char*)(gbase) + (voff)[_i]), (LAS unsigned*)(lds + (bufoff) + ldsw + _i * 8192), 16, 0, A_AUX); } while (0)
#define PG8_LDA(dst, b, h) do { _Pragma("unroll") for (int m = 0; m < 4; ++m) _Pragma("unroll") for (int k = 0; k < 2; ++k) dst[m][k] = *(const LAS bf16x8*)(lds + PG8_SA(b, h) + aoff + m * 2048 + k * 1024); } while (0)
#define PG8_LDB(dst, b, h) do { _Pragma("unroll") for (int n = 0; n < 2; ++n) _Pragma("unroll") for (int k = 0; k < 2; ++k) dst[n][k] = *(const LAS bf16x8*)(lds + PG8_SB(b, h) + boff + n * 2048 + k * 1024); } while (0)
#define PG8_MMA(ai, bj, At, Bt) do { if (mm[ai]) { __builtin_amdgcn_s_setprio(1); _Pragma("unroll") for (int m = 0; m < 4; ++m) _Pragma("unroll") for (int n = 0; n < 2; ++n) _Pragma("unroll") for (int k = 0; k < 2; ++k) \
        acc[ai][bj][m][n] = __builtin_amdgcn_mfma_f32_16x16x32_bf16(Bt[n][k], At[m][k], acc[ai][bj][m][n], 0, 0, 0); __builtin_amdgcn_s_setprio(0); } } while (0)
#define PG8_WAIT_V(n) asm volatile("s_waitcnt vmcnt(" #n ")" ::: "memory")
#define PG8_WAIT_L(n) asm volatile("s_waitcnt lgkmcnt(" #n ")" ::: "memory")
#define PG8_BAR __builtin_amdgcn_s_barrier()
#define PG8_SCHED __builtin_amdgcn_sched_barrier(0)
    GU cur;
    gu_fill(cur, d0, X);
    f32x4 acc[2][2][4][2];
#pragma unroll
    for (int a = 0; a < 2; ++a)
#pragma unroll
        for (int b = 0; b < 2; ++b)
#pragma unroll
            for (int m = 0; m < 4; ++m)
#pragma unroll
                for (int n = 0; n < 2; ++n) acc[a][b][m][n] = (f32x4){0.f, 0.f, 0.f, 0.f};
    bf16x8 At[4][2], B0[2][2], B1[2][2];
    Q.wait_deps(cur.d, tid);
    PG8_STAGE(PG8_SB(0, 0), cur.B, cur.voffB); PG8_STAGE(PG8_SB(0, 1), cur.B + cur.hstep, cur.voffB); PG8_STAGE_A(PG8_SA(0, 0), cur.A, cur.voffA); PG8_STAGE_A(PG8_SA(0, 1), cur.A + cur.hstep, cur.voffA);
    if (wr == 1) PG8_BAR;
    PG8_WAIT_V(2); PG8_BAR;
    PG8_STAGE(PG8_SB(1, 0), cur.B + kstep, cur.voffB); PG8_STAGE_A(PG8_SA(1, 0), cur.A + kstep, cur.voffA); PG8_STAGE(PG8_SB(1, 1), cur.B + cur.hstep + kstep, cur.voffB);
    PG8_WAIT_V(6); PG8_BAR;
    unsigned carry = 0u; unsigned ui = 0u;
    for (;;) {
        bool go = false;
        const char* cA = cur.A; const char* cB = cur.B; const size_t hstep = cur.hstep; const int nt = cur.nt;
#if PROBE && PROBE_KIND == 3
        const unsigned long long tu0 = __builtin_amdgcn_s_memrealtime();
#endif
        const bool fullp = cur.u.pm != NPANEL - 1; const bool mm[2] = {fullp || wr == 0, fullp};
        for (int t = 0; t < nt; t += 2) {
            const bool last = (t == nt - 2);
            const char* a1 = cA + (size_t)(t + 1) * kstep;
            const char* a2_ = cA + (size_t)(last ? 0 : t + 2) * kstep; const char* b2_ = cB + (size_t)(last ? 0 : t + 2) * kstep;
            const char* a2 = a2_; const char* b2 = b2_; size_t h2 = hstep;
            unsigned vA2[2], vB2[2];
#pragma unroll
            for (int i = 0; i < 2; ++i) { vA2[i] = cur.voffA[i]; vB2[i] = cur.voffB[i]; }
            if (last) {
                const unsigned k = 2u + (ui & 1u);
#if PROBE && PROBE_KIND == 8
                const unsigned long long tc0 = __builtin_amdgcn_s_memrealtime();
#endif
                if (tid == 0) { const unsigned dn = Q.claim_lane(); Q.slot[k] = dn;
                    Q.slot[2u + k] = ((dn >> 24) >= U_PA && (dn >> 24) <= U_PE && (!STREAM_SAME_SECTION || ((dn >> 20) == (cur.d >> 20))) && Q.deps_ready_now(dn)) ? 1u : 0u; }
                asm volatile("s_waitcnt lgkmcnt(0)" ::: "memory"); PG8_BAR; asm volatile("" ::: "memory");
                carry = Q.slot[k]; go = Q.slot[2u + k] != 0u;
#if PROBE && PROBE_KIND == 8
                if (tid == 0 && (int)(cur.d >> 24) == PROBE_TYPE) { Q.slot[6] += (unsigned)(__builtin_amdgcn_s_memrealtime() - tc0); Q.slot[7] += 1u; }
#endif
                if (go) { GU n2; gu_fill(n2, carry, X); a2 = n2.A; b2 = n2.B; h2 = n2.hstep;
#pragma unroll
                    for (int i = 0; i < 2; ++i) { vA2[i] = n2.voffA[i]; vB2[i] = n2.voffB[i]; } }
            }
            const char* a3 = a2 + kstep; const char* b3 = b2 + kstep;
            PG8_LDB(B0, 0, 0); PG8_LDB(B1, 0, 1); PG8_SCHED; PG8_LDA(At, 0, 0); PG8_STAGE_A(PG8_SA(1, 1), a1 + hstep, cur.voffA);
            PG8_WAIT_V(8); PG8_WAIT_L(0); PG8_BAR; PG8_MMA(0, 0, At, B0); PG8_MMA(0, 1, At, B1); PG8_BAR; PG8_SCHED;
            PG8_LDA(At, 0, 1); PG8_STAGE(PG8_SB(0, 0), b2, vB2); PG8_STAGE(PG8_SB(0, 1), b2 + h2, vB2); PG8_STAGE_A(PG8_SA(0, 0), a2, vA2);
            PG8_WAIT_V(8); PG8_WAIT_L(0); PG8_BAR; PG8_MMA(1, 0, At, B0); PG8_MMA(1, 1, At, B1); PG8_BAR; PG8_SCHED;
            PG8_LDB(B0, 1, 0); PG8_LDB(B1, 1, 1); PG8_SCHED; PG8_LDA(At, 1, 0); PG8_STAGE_A(PG8_SA(0, 1), a2 + h2, vA2);
            PG8_WAIT_V(8); PG8_WAIT_L(0); PG8_BAR; PG8_MMA(0, 0, At, B0); PG8_MMA(0, 1, At, B1); PG8_BAR; PG8_SCHED;
            PG8_LDA(At, 1, 1); PG8_STAGE(PG8_SB(1, 0), b3, vB2); PG8_STAGE(PG8_SB(1, 1), b3 + h2, vB2); PG8_STAGE_A(PG8_SA(1, 0), a3, vA2);
            PG8_WAIT_V(8); PG8_WAIT_L(0); PG8_BAR; PG8_MMA(1, 0, At, B0); PG8_MMA(1, 1, At, B1); PG8_BAR; PG8_SCHED;
        }
#if PROBE && PROBE_KIND == 7
        const unsigned long long te0 = __builtin_amdgcn_s_memrealtime();
#endif
        if (wr == 0) PG8_BAR;
        { const int type = cur.d >> 24, l = (cur.d >> 20) & 15;
          if (type == U_PA) { EpiProj E{X.ws, X.out, AR.in[IN_GQ] + l * 128, AR.in[IN_GK] + l * 128, l}; E(acc, cur.u, wr, wc, fr, fq, esc, tid); }
          else if (type == U_PD) { EpiFfn1 E{X.ws}; E(acc, cur.u, wr, wc, fr, fq, esc, tid); }
          else { EpiRes E{X.ws, X.out, (type == U_PE && l == NLAYER - 1) ? 1 : 0}; E(acc, cur.u, wr, wc, fr, fq, esc, tid); }
          Q.publish(cur.d, tid);
#if PROBE && PROBE_KIND == 7
          if (tid == 0 && (int)(cur.d >> 24) == PROBE_TYPE && cur.u.pm != NPANEL - 1) { Q.slot[6] += (unsigned)(__builtin_amdgcn_s_memrealtime() - te0); Q.slot[7] += 1u; }
#endif
#if PROBE && PROBE_KIND == 3
          if (tid == 0 && (int)(cur.d >> 24) == PROBE_TYPE && cur.u.pm != NPANEL - 1) { Q.slot[6] += (unsigned)(__builtin_amdgcn_s_memrealtime() - tu0); Q.slot[7] += 1u; }
#endif
          }
        if (!go) break;
#pragma unroll
        for (int a = 0; a < 2; ++a)
#pragma unroll
            for (int b = 0; b < 2; ++b)
#pragma unroll
                for (int m = 0; m < 4; ++m)
#pragma unroll
                    for (int n = 0; n < 2; ++n) acc[a][b][m][n] = (f32x4){0.f, 0.f, 0.f, 0.f};
        gu_fill(cur, carry, X); ++ui;
        if (wr == 1) PG8_BAR;
    }
    PG8_WAIT_V(0);
    PG8_BAR;
#undef PG8_SA
#undef PG8_SB
#undef PG8_STAGE
#undef PG8_STAGE_A
#undef PG8_LDA
#undef PG8_LDB
#undef PG8_MMA
#undef PG8_WAIT_V
#undef PG8_WAIT_L
#undef PG8_BAR
#undef PG8_SCHED
    return carry;
}

__global__ void __launch_bounds__(512, 2) hymba_fwd(Args args) {
    extern __shared__ __attribute__((aligned(16))) unsigned char lds[];
    Frame F;
    F.lds = (LAS unsigned char*)lds;
    F.MISC = (volatile LAS unsigned*)(F.lds + MISC_OFF);
    F.wave = __builtin_amdgcn_readfirstlane((int)(threadIdx.x >> 6));
    F.G = gridDim.x; { const int bx = blockIdx.x; F.vcu = (F.G % 8 == 0) ? (bx % 8) * (F.G / 8) + bx / 8 : bx; }
    F.ws = args.ws; F.out = args.out; F.ctl = (gu32*)(args.ws + WS_CTL);
    for (int u = F.tid(); u < (LDS_BYTES - LDSCTL_OFF) / 4; u += 512) ((LAS unsigned*)(F.lds + LDSCTL_OFF))[u] = 0u;
    __syncthreads();
    XcdBarrier bar = xcd_barrier_post((unsigned*)(F.ctl + CW_BAR), F.MISC + 8);
#if PROBE
    const unsigned long long tk0 = __builtin_amdgcn_s_memrealtime();
#endif
    for (int rep = 0; rep < DUP_P0; ++rep) p0_prologue(args, F);
#if PROBE && (PROBE_KIND == 5 || PROBE_KIND == 6)
    if (F.tid() == 0) { F.MISC[6] = (unsigned)(__builtin_amdgcn_s_memrealtime() - tk0); if (PROBE_KIND == 6) __hip_atomic_fetch_max(F.ctl + CW_STAT + 48, F.MISC[6], RLX_AGENT); }
#endif
    if (blockIdx.x < 8 && F.tid() == 0) build_queue((unsigned*)(args.ws + WS_QUEUE) + (size_t)blockIdx.x * QCAP, (int)blockIdx.x);
    xcd_barrier(bar);
    Sched Q; Q.ctl = F.ctl; Q.qglob = (const unsigned*)(args.ws + WS_QUEUE); Q.qlds = (LAS unsigned*)(F.lds + QTAB_OFF); Q.slot = F.MISC; Q.myq = __builtin_amdgcn_readfirstlane((int)(bar.x & 7u)); Q.nclaim = 0u; Q.ptype = 0;
    { const unsigned* qg = Q.qglob + (size_t)Q.myq * QCAP; for (int i = F.tid(); i < QCAP; i += 512) Q.qlds[i] = qg[i]; }
    WG_BAR();
    unsigned d = Q.claim_wg(F.tid());
#if SEC_BARRIER
    int cursec = 0;
#endif
    for (;;) {
        const int type = d >> 24;
#if SEC_BARRIER
        { const int sec = (type == U_END) ? 5 * NLAYER : ((d >> 20) & 15) * 5 + ((type >= U_SSM) ? 1 : (type == U_PA ? 0 : type));
          while (cursec < sec) { if ((SEC_MASK >> cursec) & 1) xcd_barrier(bar); ++cursec; } }
#endif
        if (type == U_END) break;
        if (type <= U_PE) {
#if PROBE && PROBE_KIND == 9
            const unsigned long long ts0 = __builtin_amdgcn_s_memrealtime();
#endif
            d = gemm_stream(args, F, Q, d);
#if PROBE && PROBE_KIND == 9
            if (F.tid() == 0) { F.MISC[6] += (unsigned)(__builtin_amdgcn_s_memrealtime() - ts0); }
#endif
            continue; }
        const int l = (d >> 20) & 15, a = (d >> 10) & 1023;
        Q.wait_deps(d, F.tid());
#if PROBE && PROBE_KIND == 2
        const unsigned long long tp0 = __builtin_amdgcn_s_memrealtime();
#endif
        if (type == U_SSM) ssm_unit(args, F, l, a);
        else if (type == U_ATT) attn_unit(args, F, l, a / NQB, a % NQB);
        else if (type == U_SATT) sattn_unit(args, F, l, a);
        else pool_unit(args, F, l, a);
        Q.publish(d, F.tid());
#if PROBE && PROBE_KIND == 2
        if (F.tid() == 0 && (PROBE_TYPE == 0 || type == PROBE_TYPE)) F.MISC[6] += (unsigned)(__builtin_amdgcn_s_memrealtime() - tp0);
#endif
        d = Q.claim_wg(F.tid());
    }
#if PROBE
    if (F.tid() == 0) {
        const unsigned tend = (unsigned)(__builtin_amdgcn_s_memrealtime() - tk0);
        if (PROBE_KIND == 4) { F.MISC[6] = tend; __hip_atomic_fetch_max(F.ctl + CW_STAT + 48, tend, RLX_AGENT); }
        __hip_atomic_fetch_add(F.ctl + CW_STAT, F.MISC[6], RLX_AGENT);
        __hip_atomic_fetch_add(F.ctl + CW_STAT + 32, F.MISC[7], RLX_AGENT);
        const unsigned n = __hip_atomic_fetch_add(F.ctl + CW_STAT + 16, 1u, RLX_AGENT);
        F.MISC[7] = (n == gridDim.x - 1) ? 1u : 0u;
        if (n == gridDim.x - 1) { F.MISC[5] = __hip_atomic_load(F.ctl + CW_STAT, RLX_AGENT); F.MISC[4] = __hip_atomic_load(F.ctl + CW_STAT + 32, RLX_AGENT); F.MISC[3] = __hip_atomic_load(F.ctl + CW_STAT + 48, RLX_AGENT); }
    }
    WG_BAR();
    if (F.MISC[7]) { float v = (float)F.MISC[5] / (float)gridDim.x * 0.01f;
        if (PROBE_KIND == 3 || PROBE_KIND == 7 || PROBE_KIND == 8) v = (float)F.MISC[5] * 0.01f / (float)(F.MISC[4] ? F.MISC[4] : 1u);
        if (PROBE_KIND == 4) v = (float)F.MISC[3] * 0.01f - v;
        if (PROBE_KIND == 6) v = (float)F.MISC[3] * 0.01f;
        v = floorf((v + 0.5f * PROBE_Q) / PROBE_Q) * PROBE_Q;
        for (int i = F.tid(); i < NLAYER * NSAMP * 15 * 512; i += 512) F.out[O_SP + i] = v; }
#endif
}

extern "C" void kernel_launch(void* const* d_in, const int* in_sizes, int n_in, void* d_out, int out_size, void* d_ws, size_t ws_size, hipStream_t stream) {
    static int grid = 0;
    if (grid == 0) {
        if (n_in != 32 || (size_t)out_size != O_END || ws_size < WS_END) { fprintf(stderr, "kernel_launch: unexpected shapes: n_in %d out %d (want %zu) ws %zu (want >= %zu)\n", n_in, out_size, (size_t)O_END, ws_size, (size_t)WS_END); grid = -1; return; }
        int dev = 0, cus = 0, per_cu = 0;
        if (hipGetDevice(&dev) != hipSuccess || hipDeviceGetAttribute(&cus, hipDeviceAttributeMultiprocessorCount, dev) != hipSuccess) { fprintf(stderr, "kernel_launch: device query failed\n"); grid = -1; return; }
        if (hipFuncSetAttribute((const void*)hymba_fwd, hipFuncAttributeMaxDynamicSharedMemorySize, LDS_BYTES) != hipSuccess) { fprintf(stderr, "kernel_launch: hipFuncSetAttribute failed\n"); grid = -1; return; }
        if (hipOccupancyMaxActiveBlocksPerMultiprocessor(&per_cu, (const void*)hymba_fwd, 512, LDS_BYTES) != hipSuccess || per_cu < 1) { fprintf(stderr, "kernel_launch: occupancy query says %d blocks per CU\n", per_cu); per_cu = 1; }
        (void)hipGetLastError();
        grid = cus;
        if (grid % 8 != 0) grid -= grid % 8;
    }
    if (grid < 0) return;
    (void)hipMemsetAsync((char*)d_ws + WS_CTL, 0, CTL_ZERO_BYTES, stream);
    Args a{};
    for (int i = 0; i < 32; ++i) a.in[i] = (const float*)d_in[i];
    a.out = (float*)d_out; a.ws = (unsigned char*)d_ws; a.ph_lo = 0; a.ph_hi = 0;
    hipLaunchKernelGGL(hymba_fwd, dim3(grid), dim3(512), LDS_BYTES, stream, a);
    const hipError_t le = hipPeekAtLastError();
    if (le != hipSuccess) fprintf(stderr, "kernel_launch: launch failed: %s\n", hipGetErrorName(le));
}
```

```cpp
#include <hip/hip_runtime.h>
#include <cstdio>
#include <cstdint>

#ifndef MK_N_LAUNCHES
#define MK_N_LAUNCHES 1
#endif

#ifndef SEC_BARRIER
#define SEC_BARRIER 0
#endif
#ifndef STREAM_SAME_SECTION
#define STREAM_SAME_SECTION 1
#endif
#ifndef SEC_MASK
#define SEC_MASK 0x10
#endif
#ifndef PROBE
#define PROBE 0
#endif
#ifndef PROBE_KIND
#define PROBE_KIND 1
#endif
#ifndef PROBE_TYPE
#define PROBE_TYPE 0
#endif
#ifndef PROBE_Q
#define PROBE_Q 20.0f
#endif
#ifndef DUP_PB
#define DUP_PB 1
#endif
#ifndef DUP_P0
#define DUP_P0 1
#endif

constexpr int DM = 2048, TT = 4112  , NSEQ = 4096, NMETA = 16, NBATCH = 2, NSAMP = 32;
constexpr int MR = NBATCH * TT + NSAMP;
constexpr int MP = 8448;
constexpr int SROW0 = NBATCH * TT;
constexpr int INW = 2560, DFF = 8192, NLAYER = 2;
constexpr int TPV = 4128;
constexpr int ROPE_SAMPLE_IDX = TT;
constexpr float EPS = 1e-6f;
constexpr float LOG2E = 1.4426950408889634f;
constexpr float QSCALE = 0.08838834764831845f * LOG2E;
constexpr int NCHUNK = MR / 64;
constexpr int NQB = (TT + 31) / 32;

constexpr size_t O_YP = 0, O_YS = O_YP + (size_t)NBATCH * NSEQ * DM, O_PK = O_YS + (size_t)NSAMP * DM, O_PV = O_PK + (size_t)NLAYER * NBATCH * 128 * 256,
                 O_PSR = O_PV + (size_t)NLAYER * NBATCH * 128 * 256, O_PSI = O_PSR + (size_t)NLAYER * NBATCH * 2048, O_PP = O_PSI + (size_t)NLAYER * NBATCH * 2048,
                 O_SK = O_PP + (size_t)NLAYER * NBATCH * 15 * 512, O_SV = O_SK + (size_t)NLAYER * NSAMP * 128 * 256, O_SSR = O_SV + (size_t)NLAYER * NSAMP * 128 * 256,
                 O_SSI = O_SSR + (size_t)NLAYER * NSAMP * 2048, O_SP = O_SSI + (size_t)NLAYER * NSAMP * 2048, O_END = O_SP + (size_t)NLAYER * NSAMP * 15 * 512;

constexpr size_t MiB = 1u << 20;
constexpr size_t WS_CTL = 0, CTL_ZERO_BYTES = 1 * MiB;
constexpr size_t WS_WIN = 1 * MiB, WS_WOUT = 21 * MiB, WS_W1 = 37 * MiB, WS_W2 = 101 * MiB, WS_WGLU = 165 * MiB, WS_WPOOL = 166 * MiB, WS_TAB = 167 * MiB;
constexpr size_t WS_X = 170 * MiB, WS_XB = 236 * MiB, WS_Q = 269 * MiB, WS_K = 286 * MiB, WS_VT = 291 * MiB, WS_U = 296 * MiB, WS_XP = 313 * MiB, WS_MIX = 330 * MiB,
                 WS_H = 363 * MiB, WS_SSQ = 495 * MiB, WS_SST = 497 * MiB, WS_KSN = 502 * MiB, WS_QUEUE = 503 * MiB, WS_END = 504 * MiB;
static_assert(WS_WIN + (size_t)NLAYER * INW * DM * 2 <= WS_WOUT && WS_WOUT + (size_t)NLAYER * DM * DM * 2 <= WS_W1 && WS_W1 + (size_t)NLAYER * DFF * DM * 2 <= WS_W2 && WS_W2 + (size_t)NLAYER * DFF * DM * 2 <= WS_WGLU, "ws map 1");
static_assert(WS_X + (size_t)MP * DM * 4 <= WS_XB && WS_XB + (size_t)MP * DM * 2 <= WS_Q && WS_Q + (size_t)MP * 1024 * 2 <= WS_K && WS_K + (size_t)MP * 256 * 2 <= WS_VT && WS_VT + (size_t)4 * 128 * TPV * 2 <= WS_U, "ws map 2");
static_assert(WS_U + (size_t)MP * 512 * 4 <= WS_XP && WS_XP + (size_t)MP * 512 * 4 <= WS_MIX && WS_MIX + (size_t)MP * DM * 2 <= WS_H && WS_H + (size_t)MP * DFF * 2 <= WS_SSQ && WS_SSQ + (size_t)MP * 32 * 4 <= WS_SST, "ws map 3");
static_assert(WS_SST + (size_t)NLAYER * NCHUNK * 32 * 64 * 8 <= WS_KSN, "ws map 4");
constexpr size_t TB_ABR = 0, TB_ABI = 8192, TB_ALR = 16384, TB_ALI = 24576, TB_A16R = 32768, TB_A16I = 40960, TB_A32R = 49152, TB_A32I = 57344,
                 TB_BBR = 65536, TB_BBI = TB_BBR + 131072, TB_PM = TB_BBI + 131072, TB_CMT = TB_PM + 524288, TB_LAYER = 1 * MiB;
static_assert(TB_CMT + 131072 <= TB_LAYER, "table map");
constexpr size_t WS_ROPE = WS_TAB + 2 * MiB;
constexpr size_t ROPE_N = (size_t)(TT + 1) * 16;
constexpr int CW_TMO = 0, CW_CODE = 1, CW_BAR = 4096, CW_QHEAD = 8192  , CW_STAT = 8800, CW_CNT = 9216  , CW_SSMF = 16384  ;
static_assert(CW_CNT + NLAYER * 5 * 40 * 16 <= CW_SSMF, "ctl map: counters");
static_assert((CW_SSMF + NLAYER * NCHUNK * 8 * 16) * 4 <= (int)CTL_ZERO_BYTES, "ctl map");

constexpr int RING_BYTES = 131072, ESC_OFF = RING_BYTES  , QTAB_OFF = ESC_OFF + 12288  , LDSCTL_OFF = QTAB_OFF + 4096, MISC_OFF = LDSCTL_OFF + 320, LDS_BYTES = 148480;
static_assert(MISC_OFF + 128 <= LDS_BYTES, "LDS map");

#define GAS __attribute__((address_space(1)))
#define LAS __attribute__((address_space(3)))
typedef unsigned short bf16;
typedef unsigned v4u __attribute__((ext_vector_type(4)));
typedef unsigned v2u __attribute__((ext_vector_type(2)));
typedef float f32x2 __attribute__((ext_vector_type(2)));
typedef float f32x16 __attribute__((ext_vector_type(16)));
typedef __bf16 bf16x2_t __attribute__((ext_vector_type(2)));
typedef GAS unsigned gu32;
typedef GAS unsigned long long gu64;
#define RLX_AGENT __ATOMIC_RELAXED, __HIP_MEMORY_SCOPE_AGENT
#define LDS_WAIT() asm volatile("s_waitcnt lgkmcnt(0)" ::: "memory")
#define VM_WAIT() asm volatile("s_waitcnt vmcnt(0)" ::: "memory")
#define WG_BAR() do { asm volatile("s_waitcnt lgkmcnt(0)" ::: "memory"); __builtin_amdgcn_s_barrier(); asm volatile("" ::: "memory"); } while (0)
__device__ __forceinline__ unsigned pk2(float lo, float hi) { f32x2 v = {lo, hi}; bf16x2_t b = __builtin_convertvector(v, bf16x2_t); return __builtin_bit_cast(unsigned, b); }
__device__ __forceinline__ float bf2f(unsigned short h) { return __builtin_bit_cast(float, (unsigned)h << 16); }
__device__ __forceinline__ float wave_sum(float v) {
#pragma unroll
    for (int o = 1; o < 64; o <<= 1) v += __shfl_xor(v, o);
    return v;
}
__device__ __forceinline__ float wave_max(float v) {
#pragma unroll
    for (int o = 1; o < 64; o <<= 1) v = fmaxf(v, __shfl_xor(v, o));
    return v;
}

typedef __amdgpu_buffer_rsrc_t rsrc_t;
__device__ __forceinline__ rsrc_t ws_rsrc(unsigned char* ws) { return __builtin_amdgcn_make_buffer_rsrc(ws, 0, (int)WS_END, 0x00020000); }
#define ST16(r, off, v) __builtin_amdgcn_raw_buffer_store_b128(__builtin_bit_cast(v4u, (v)), (r), (unsigned)(off), 0, 16)
#define ST8(r, off, v)  __builtin_amdgcn_raw_buffer_store_b64((v), (r), (unsigned)(off), 0, 16)
#define ST4(r, off, v)  __builtin_amdgcn_raw_buffer_store_b32(__builtin_bit_cast(unsigned, (v)), (r), (unsigned)(off), 0, 16)
#define ST2(r, off, v)  __builtin_amdgcn_raw_buffer_store_b16((unsigned short)(v), (r), (unsigned)(off), 0, 16)
__host__ __device__ __forceinline__ int perm16(int o) { return 8 * ((o >> 2) & 1) + 4 * (o >> 3) + (o & 3); }

namespace pg8 {
#define PG8_LAS __attribute__((address_space(3)))
typedef unsigned short bf16_t;
typedef short bf16x8 __attribute__((ext_vector_type(8)));
typedef float f32x4 __attribute__((ext_vector_type(4)));
typedef unsigned u32x4 __attribute__((ext_vector_type(4)));
constexpr int BM = 256, BK = 64, HALF = 128, HTB = HALF * BK * 2  , STAGE_BYTES = 8 * HTB, NXCD = 8, WGM = 8;

__host__ __device__ __forceinline__ int lds_byte(int r, int c) { const int st = (r >> 4) * 2 + (c >> 5), rr = r & 15, cc = c & 31, ob = rr * 64 + cc * 2; return st * 1024 + (ob ^ (((ob >> 9) & 1) << 5)); }
__host__ __device__ __forceinline__ void stage_rc(int b, int& R, int& C) { const int st = b / 1024, sb = b % 1024, swz = sb ^ (((sb >> 9) & 1) << 5); R = (st >> 1) * 16 + swz / 64; C = (st & 1) * 32 + (swz % 64) / 2; }
__host__ __device__ __forceinline__ int perm32(int rho) { const int n = rho >> 4, i = rho & 15; return 8 * (i >> 2) + 4 * n + (i & 3); }

struct Unit { int pm, pn; };
struct Gemm { const bf16_t* A; const bf16_t* Bt; int M, N, K; };

struct StaticOrder {
    int nM, nN, nwg, G, c;
    __host__ __device__ void init(int M, int N, int G_, int c_) { nM = M / BM; nN = N / BM; nwg = nM * nN; G = G_; c = c_; }
    __host__ __device__ bool next(int i, Unit& u) const {
        const long L = (long)i * G + c; if (L >= nwg) return false;
        int wgid = (int)L; { const int q = nwg / NXCD, r = nwg % NXCD, xcd = wgid % NXCD, off = wgid / NXCD; wgid = (xcd < r ? xcd * (q + 1) : r * (q + 1) + (xcd - r) * q) + off; }
        const int nig = WGM * nN, gid = wgid / nig, fm = gid * WGM, gsz = (nM - fm) < WGM ? (nM - fm) : WGM;
        u.pm = fm + ((wgid % nig) % gsz); u.pn = (wgid % nig) / gsz; return true;
    }
    __device__ __forceinline__ void a_ready(const Unit&) const {}
    __device__ __forceinline__ void done(const Unit&) const {}
};


template <class Epi, class Sched, bool ALIGN_EPI = false, bool SP2 = false>
__device__ __forceinline__ void gemm_phase(PG8_LAS unsigned char* lds, PG8_LAS unsigned char* esc, const Gemm g, const Sched& S, const Epi& E) {
    int tid_ = threadIdx.x; asm volatile("" : "+v"(tid_));
    const int tid = tid_, wid = __builtin_amdgcn_readfirstlane(tid >> 6), lane = tid & 63, wr = wid >> 2, wc = wid & 3, fr = lane & 15, fq = lane >> 4;
    const int K = g.K, nt = K / BK;
    unsigned voffA[2], voffB[2];
#pragma unroll
    for (int i = 0; i < 2; ++i) { int R, C; stage_rc(tid * 16 + i * 8192, R, C); const int Rb = Epi::PERM ? ((R & ~31) + perm32(R & 31)) : R;
        voffA[i] = (unsigned)(R * K + C) * 2u; voffB[i] = (unsigned)(Rb * K + C) * 2u; }
    const size_t kstep = (size_t)(BK * 2);
    const size_t hstep = (size_t)HALF * K * 2;
    const size_t tstep = 2 * hstep;
    const unsigned ldsw = (unsigned)wid * 1024u;
    const int aoff = lds_byte(wr * 64 + fr, fq * 8), boff = lds_byte(wc * 32 + fr, fq * 8);
#define PG8_SA(b, h) (((b) * 2 + (h)) * HTB)
#define PG8_SB(b, h) ((4 + (b) * 2 + (h)) * HTB)
#define PG8_STAGE(bufoff, gbase, voff) do { _Pragma("unroll") for (int _i = 0; _i < 2; ++_i) \
        __builtin_amdgcn_global_load_lds((const unsigned*)((const char*)(gbase) + (voff)[_i]), (PG8_LAS unsigned*)(lds + (bufoff) + ldsw + _i * 8192), 16, 0, 0); } while (0)
#define PG8_LDA(dst, b, h) do { _Pragma("unroll") for (int m = 0; m < 4; ++m) _Pragma("unroll") for (int k = 0; k < 2; ++k) dst[m][k] = *(const PG8_LAS bf16x8*)(lds + PG8_SA(b, h) + aoff + m * 2048 + k * 1024); } while (0)
#define PG8_LDB(dst, b, h) do { _Pragma("unroll") for (int n = 0; n < 2; ++n) _Pragma("unroll") for (int k = 0; k < 2; ++k) dst[n][k] = *(const PG8_LAS bf16x8*)(lds + PG8_SB(b, h) + boff + n * 2048 + k * 1024); } while (0)
#define PG8_MMA(ai, bj, At, Bt) do { __builtin_amdgcn_s_setprio(1); _Pragma("unroll") for (int m = 0; m < 4; ++m) _Pragma("unroll") for (int n = 0; n < 2; ++n) _Pragma("unroll") for (int k = 0; k < 2; ++k) \
        acc[ai][bj][m][n] = __builtin_amdgcn_mfma_f32_16x16x32_bf16(Bt[n][k], At[m][k], acc[ai][bj][m][n], 0, 0, 0); __builtin_amdgcn_s_setprio(0); } while (0)
#define PG8_WAIT_V(n) asm volatile("s_waitcnt vmcnt(" #n ")" ::: "memory")
#define PG8_WAIT_L(n) asm volatile("s_waitcnt lgkmcnt(" #n ")" ::: "memory")
#define PG8_BAR __builtin_amdgcn_s_barrier()
#define PG8_SCHED __builtin_amdgcn_sched_barrier(0)
    Unit cur, nxt; int ui = 0;
    if (!S.next(0, cur)) return;
    f32x4 acc[2][2][4][2];
#pragma unroll
    for (int a = 0; a < 2; ++a)
#pragma unroll
        for (int b = 0; b < 2; ++b)
#pragma unroll
            for (int m = 0; m < 4; ++m)
#pragma unroll
                for (int n = 0; n < 2; ++n) acc[a][b][m][n] = (f32x4){0.f, 0.f, 0.f, 0.f};
    bf16x8 At[4][2], B0[2][2], B1[2][2];
    const char* cA = (const char*)g.A + (size_t)cur.pm * tstep; const char* cB = (const char*)g.Bt + (size_t)cur.pn * tstep;
    S.a_ready(cur);
    if constexpr (SP2) {
        PG8_STAGE(PG8_SB(0, 0), cB, voffB); PG8_STAGE(PG8_SB(0, 1), cB + hstep, voffB); PG8_STAGE(PG8_SA(0, 0), cA, voffA); PG8_STAGE(PG8_SA(0, 1), cA + hstep, voffA);
        if (wr == 1) PG8_BAR;
        PG8_WAIT_V(2); PG8_BAR;
        PG8_STAGE(PG8_SB(1, 0), cB + kstep, voffB); PG8_STAGE(PG8_SA(1, 0), cA + kstep, voffA); PG8_STAGE(PG8_SB(1, 1), cB + hstep + kstep, voffB);
        PG8_WAIT_V(6); PG8_BAR;
    } else {
        PG8_STAGE(PG8_SB(0, 0), cB, voffB); PG8_STAGE(PG8_SA(0, 0), cA, voffA); PG8_STAGE(PG8_SB(0, 1), cB + hstep, voffB); PG8_STAGE(PG8_SA(0, 1), cA + hstep, voffA);
        if (wr == 1) PG8_BAR;
        PG8_WAIT_V(4); PG8_BAR;
        PG8_STAGE(PG8_SB(1, 0), cB + kstep, voffB); PG8_STAGE(PG8_SA(1, 0), cA + kstep, voffA); PG8_STAGE(PG8_SB(1, 1), cB + hstep + kstep, voffB);
        PG8_WAIT_V(6); PG8_BAR;
    }
    for (;;) {
        const bool has_next = S.next(ui + 1, nxt);
        const char* nA = has_next ? (const char*)g.A + (size_t)nxt.pm * tstep : cA; const char* nB = has_next ? (const char*)g.Bt + (size_t)nxt.pn * tstep : cB;
        for (int t = 0; t < nt; t += 2) {
            const bool last = (t == nt - 2);
            const char* a1 = cA + (size_t)(t + 1) * kstep;
            const char* a2 = last ? nA : cA + (size_t)(t + 2) * kstep; const char* b2 = last ? nB : cB + (size_t)(t + 2) * kstep;
            const char* a3 = a2 + kstep; const char* b3 = b2 + kstep;
            if (last && has_next) S.a_ready(nxt);
            if constexpr (SP2) {
            PG8_LDB(B0, 0, 0); PG8_LDB(B1, 0, 1); PG8_SCHED; PG8_LDA(At, 0, 0); PG8_STAGE(PG8_SA(1, 1), a1 + hstep, voffA);
            PG8_WAIT_V(8); PG8_WAIT_L(0); PG8_BAR; PG8_MMA(0, 0, At, B0); PG8_MMA(0, 1, At, B1); PG8_BAR; PG8_SCHED;
            PG8_LDA(At, 0, 1); PG8_STAGE(PG8_SB(0, 0), b2, voffB); PG8_STAGE(PG8_SB(0, 1), b2 + hstep, voffB); PG8_STAGE(PG8_SA(0, 0), a2, voffA);
            PG8_WAIT_V(8); PG8_WAIT_L(0); PG8_BAR; PG8_MMA(1, 0, At, B0); PG8_MMA(1, 1, At, B1); PG8_BAR; PG8_SCHED;
            PG8_LDB(B0, 1, 0); PG8_LDB(B1, 1, 1); PG8_SCHED; PG8_LDA(At, 1, 0); PG8_STAGE(PG8_SA(0, 1), a2 + hstep, voffA);
            PG8_WAIT_V(8); PG8_WAIT_L(0); PG8_BAR; PG8_MMA(0, 0, At, B0); PG8_MMA(0, 1, At, B1); PG8_BAR; PG8_SCHED;
            PG8_LDA(At, 1, 1); PG8_STAGE(PG8_SB(1, 0), b3, voffB); PG8_STAGE(PG8_SB(1, 1), b3 + hstep, voffB); PG8_STAGE(PG8_SA(1, 0), a3, voffA);
            PG8_WAIT_V(8); PG8_WAIT_L(0); PG8_BAR; PG8_MMA(1, 0, At, B0); PG8_MMA(1, 1, At, B1); PG8_BAR; PG8_SCHED;
            } else {
            PG8_LDB(B0, 0, 0); PG8_SCHED; PG8_LDA(At, 0, 0); PG8_STAGE(PG8_SA(1, 1), a1 + hstep, voffA);
            PG8_WAIT_L(8); PG8_BAR; PG8_WAIT_L(0); PG8_MMA(0, 0, At, B0); PG8_BAR; PG8_SCHED;
            PG8_LDB(B1, 0, 1); PG8_STAGE(PG8_SB(0, 0), b2, voffB);
            PG8_BAR; PG8_WAIT_L(0); PG8_MMA(0, 1, At, B1); PG8_BAR;
            PG8_LDA(At, 0, 1); PG8_STAGE(PG8_SA(0, 0), a2, voffA);
            PG8_BAR; PG8_WAIT_L(0); PG8_MMA(1, 0, At, B0); PG8_BAR; PG8_SCHED;
            PG8_STAGE(PG8_SB(0, 1), b2 + hstep, voffB);
            PG8_WAIT_V(6); PG8_BAR; PG8_MMA(1, 1, At, B1); PG8_BAR;
            PG8_LDB(B0, 1, 0); PG8_SCHED; PG8_LDA(At, 1, 0); PG8_STAGE(PG8_SA(0, 1), a2 + hstep, voffA);
            PG8_WAIT_L(8); PG8_BAR; PG8_WAIT_L(0); PG8_MMA(0, 0, At, B0); PG8_BAR; PG8_SCHED;
            PG8_LDB(B1, 1, 1); PG8_STAGE(PG8_SB(1, 0), b3, voffB);
            PG8_BAR; PG8_WAIT_L(0); PG8_MMA(0, 1, At, B1); PG8_BAR;
            PG8_LDA(At, 1, 1); PG8_STAGE(PG8_SA(1, 0), a3, voffA);
            PG8_BAR; PG8_WAIT_L(0); PG8_MMA(1, 0, At, B0); PG8_BAR; PG8_SCHED;
            PG8_STAGE(PG8_SB(1, 1), b3 + hstep, voffB);
            PG8_WAIT_V(6); PG8_BAR; PG8_MMA(1, 1, At, B1); PG8_BAR;
            }
        }
        if constexpr (ALIGN_EPI) { if (wr == 0) PG8_BAR; }
        { E(acc, cur, wr, wc, fr, fq, esc, tid); S.done(cur); }
        if (!has_next) break;
#pragma unroll
        for (int a = 0; a < 2; ++a)
#pragma unroll
            for (int b = 0; b < 2; ++b)
#pragma unroll
                for (int m = 0; m < 4; ++m)
#pragma unroll
                    for (int n = 0; n < 2; ++n) acc[a][b][m][n] = (f32x4){0.f, 0.f, 0.f, 0.f};
        cur = nxt; cA = nA; cB = nB; ++ui;
        if constexpr (ALIGN_EPI) { if (wr == 1) PG8_BAR; }
    }
    PG8_WAIT_V(0);
    if constexpr (!ALIGN_EPI) { if (wr == 0) PG8_BAR; }
    PG8_BAR;
#undef PG8_SA
#undef PG8_SB
#undef PG8_STAGE
#undef PG8_LDA
#undef PG8_LDB
#undef PG8_MMA
#undef PG8_WAIT_V
#undef PG8_WAIT_L
#undef PG8_BAR
#undef PG8_SCHED
}
}

typedef float f32x4 __attribute__((ext_vector_type(4)));
typedef short bf16x8 __attribute__((ext_vector_type(8)));


__device__ __forceinline__ void build_rs(const float* ssq, int pm, LAS unsigned char* esc, int tid) {
    LAS float* rsT = (LAS float*)esc;
    WG_BAR();
    if (tid < 256) {
        float s = 0.f;
#pragma unroll
        for (int j = 0; j < 8; ++j) { const gu64* p = (const gu64*)(ssq + ((size_t)j * MP + pm * 256 + tid) * 4);
#pragma unroll
            for (int h = 0; h < 2; ++h) { const unsigned long long v = __hip_atomic_load(p + h, RLX_AGENT); s += __builtin_bit_cast(float, (unsigned)v) + __builtin_bit_cast(float, (unsigned)(v >> 32)); } }
        rsT[tid] = rsqrtf(s * (1.0f / DM) + EPS);
    }
    WG_BAR();
}

struct EpiProj {
    static constexpr bool PERM = false, AFTER_DRAIN = false;
    unsigned char* ws_; float* out_; const float* gq; const float* gk; int l;
    __device__ __forceinline__ void operator()(f32x4 (&acc)[2][2][4][2], const pg8::Unit& u, int wr, int wc, int fr, int fq, LAS unsigned char* esc, int tid) const {
        asm volatile("" : "+v"(fr), "+v"(fq), "+v"(tid));
        size_t z_ = 0; asm volatile("" : "+s"(z_)); unsigned char* ws = ws_ + z_;
        const float* ssq = (const float*)(ws + WS_SSQ); const float* ropec = (const float*)(ws + WS_ROPE); const float* ropes = ropec + ROPE_N;
        bf16* Q = (bf16*)(ws + WS_Q); bf16* K = (bf16*)(ws + WS_K); bf16* VT = (bf16*)(ws + WS_VT); float* U = (float*)(ws + WS_U); float* XP = (float*)(ws + WS_XP);
        float* ksn = (float*)(ws + WS_KSN); float* vsn = ksn + NSAMP * 256;
        float* out_pk = out_ + O_PK + (size_t)l * NBATCH * 128 * 256; float* out_pv = out_ + O_PV + (size_t)l * NBATCH * 128 * 256;
        const rsrc_t rs_ = ws_rsrc(ws);
        build_rs(ssq, u.pm, esc, tid);
        const LAS float* rsT = (const LAS float*)esc;
        LAS float* hss = (LAS float*)(esc + 1024);
        const int pn = u.pn;
#pragma unroll
        for (int ai = 0; ai < 2; ++ai)
#pragma unroll
            for (int m = 0; m < 4; ++m) { const float rsv = rsT[ai * 128 + wr * 64 + m * 16 + fr];
#pragma unroll
                for (int bj = 0; bj < 2; ++bj)
#pragma unroll
                    for (int n = 0; n < 2; ++n) acc[ai][bj][m][n] *= rsv; }
        if (pn <= 4) {
#pragma unroll
            for (int ai = 0; ai < 2; ++ai)
#pragma unroll
                for (int m = 0; m < 4; ++m)
#pragma unroll
                    for (int bj = 0; bj < 2; ++bj) { const f32x4 a = acc[ai][bj][m][0], b = acc[ai][bj][m][1];
                        float s = (a[0] * a[0] + a[1] * a[1]) + (a[2] * a[2] + a[3] * a[3]) + (b[0] * b[0] + b[1] * b[1]) + (b[2] * b[2] + b[3] * b[3]);
                        s += __shfl_xor(s, 16); s += __shfl_xor(s, 32);
                        if (fq == 0) hss[(bj * 256 + ai * 128 + wr * 64 + m * 16 + fr) * 4 + wc] = s; }
            WG_BAR();
            const float* g = (pn < 4) ? gq : gk; const float osc = (pn < 4) ? QSCALE : 1.0f;
            f32x4 gv[2];
#pragma unroll
            for (int n = 0; n < 2; ++n) gv[n] = *(const f32x4*)(g + wc * 32 + n * 16 + 4 * fq);
#pragma unroll
            for (int ai = 0; ai < 2; ++ai)
#pragma unroll
                for (int m = 0; m < 4; ++m) {
                    const int rl = ai * 128 + wr * 64 + m * 16 + fr, r = u.pm * 256 + rl;
                    const bool samp = r >= SROW0, pad = r >= MR;
                    const int b = (r >= TT && !samp) ? 1 : 0, t = r - b * TT;
                    const int pidx = samp ? ROPE_SAMPLE_IDX : t;
                    f32x4 cs = {1.f, 1.f, 1.f, 1.f}, sn = {0.f, 0.f, 0.f, 0.f};
                    if (wc == 0 && !pad) { cs = *(const f32x4*)(ropec + (size_t)pidx * 16 + 4 * fq); sn = *(const f32x4*)(ropes + (size_t)pidx * 16 + 4 * fq); }
#pragma unroll
                    for (int bj = 0; bj < 2; ++bj) {
                        const f32x4 hv = *(const LAS f32x4*)(hss + (bj * 256 + rl) * 4);
                        const float hn = rsqrtf(((hv[0] + hv[1]) + (hv[2] + hv[3])) * (1.0f / 128.0f) + EPS);
                        f32x4 x1 = acc[ai][bj][m][0] * hn * gv[0], x2 = acc[ai][bj][m][1] * hn * gv[1];
                        if (wc == 0) { const f32x4 o1 = x1 * cs - x2 * sn, o2 = x2 * cs + x1 * sn; x1 = o1; x2 = o2; }
                        x1 = x1 * osc; x2 = x2 * osc;
                        const int cl = bj * 128 + wc * 32 + 4 * fq;
                        { const int od = fq & 1; const unsigned a0 = pk2(x1[0], x1[1]), a1 = pk2(x1[2], x1[3]), b0 = pk2(x2[0], x2[1]), b1 = pk2(x2[2], x2[3]);
                          const unsigned s0 = od ? a0 : b0, s1 = od ? a1 : b1; const unsigned r0 = (unsigned)__shfl_xor((int)s0, 16), r1 = (unsigned)__shfl_xor((int)s1, 16);
                          const v4u w16 = od ? (v4u){r0, r1, b0, b1} : (v4u){a0, a1, r0, r1};
                          const int cl16 = bj * 128 + wc * 32 + 4 * (fq & ~1) + (od ? 16 : 0);
                          if (pn < 4) ST16(rs_, WS_Q + ((size_t)r * 1024 + pn * 256 + cl16) * 2, w16); else ST16(rs_, WS_K + ((size_t)r * 256 + cl16) * 2, w16); }
                        if (pn == 4) {
                            if (samp && !pad) { const size_t o = WS_KSN + ((size_t)(r - SROW0) * 256 + cl) * 4; ST16(rs_, o, x1); ST16(rs_, o + 64, x2); }
                            else if (!samp && t >= TT - 128) { float* o = out_pk + ((size_t)(b * 128 + (t - (TT - 128))) * 256) + cl; *(f32x4*)o = x1; *(f32x4*)(o + 16) = x2; } }
                    }
                }
        } else if (pn == 5) {
#pragma unroll
            for (int ai = 0; ai < 2; ++ai)
#pragma unroll
                for (int m = 0; m < 4; ++m) {
                    const int rl = ai * 128 + wr * 64 + m * 16 + fr, r = u.pm * 256 + rl;
                    const bool samp = r >= SROW0, pad = r >= MR;
                    const int b = (r >= TT && !samp) ? 1 : 0, t = r - b * TT;
                    const int tpos = (t & ~15) + perm16(t & 15);
#pragma unroll
                    for (int bj = 0; bj < 2; ++bj)
#pragma unroll
                        for (int n = 0; n < 2; ++n) { const f32x4 x = acc[ai][bj][m][n]; const int d = wc * 32 + n * 16 + 4 * fq;
                            if (!samp) { const size_t vo = WS_VT + (((size_t)((b * 2 + bj) * 128 + d)) * TPV + tpos) * 2;
#pragma unroll
                                for (int j = 0; j < 4; ++j) ST2(rs_, vo + (size_t)j * TPV * 2, pk2(x[j], 0.f) & 0xffffu);
                                if (t >= TT - 128) *(f32x4*)(out_pv + ((size_t)(b * 128 + (t - (TT - 128))) * 256) + bj * 128 + d) = x; }
                            else if (!pad) ST16(rs_, WS_KSN + ((size_t)NSAMP * 256 + (size_t)(r - SROW0) * 256 + bj * 128 + d) * 4, x); }
                }
        } else {
            const size_t dsto = (pn < 8) ? WS_U + (size_t)(pn - 6) * 256 * 4 : WS_XP + (size_t)(pn - 8) * 256 * 4;
#pragma unroll
            for (int ai = 0; ai < 2; ++ai)
#pragma unroll
                for (int m = 0; m < 4; ++m) { const size_t ro = dsto + ((size_t)(u.pm * 256 + ai * 128 + wr * 64 + m * 16 + fr) * 512 + wc * 32 + 4 * fq) * 4;
#pragma unroll
                    for (int bj = 0; bj < 2; ++bj)
#pragma unroll
                        for (int n = 0; n < 2; ++n) ST16(rs_, ro + (size_t)(bj * 128 + n * 16) * 4, acc[ai][bj][m][n]); }
        }
    }
};

struct EpiRes {
    static constexpr bool PERM = true, AFTER_DRAIN = false;
    unsigned char* ws_; float* out; int last;
    __device__ __forceinline__ void operator()(f32x4 (&acc)[2][2][4][2], const pg8::Unit& u, int wr, int wc, int fr, int fq, LAS unsigned char* esc, int tid) const {
        asm volatile("" : "+v"(fr), "+v"(fq), "+v"(tid));
        size_t z_ = 0; asm volatile("" : "+s"(z_)); unsigned char* ws = ws_ + z_;
        const bf16* XB = (const bf16*)(ws + WS_XB); const rsrc_t rs_ = ws_rsrc(ws);
        v4u xb[2][4][2];
#pragma unroll
        for (int ai = 0; ai < 2; ++ai)
#pragma unroll
            for (int m = 0; m < 4; ++m) { const bf16* xp = XB + (size_t)(u.pm * 256 + ai * 128 + wr * 64 + m * 16 + fr) * DM + u.pn * 256 + wc * 32 + 8 * fq;
#pragma unroll
                for (int bj = 0; bj < 2; ++bj) xb[ai][m][bj] = *(const v4u*)(xp + bj * 128); }
#pragma unroll
        for (int ai = 0; ai < 2; ++ai)
#pragma unroll
            for (int m = 0; m < 4; ++m) {
                const int r = u.pm * 256 + ai * 128 + wr * 64 + m * 16 + fr; const int c0 = u.pn * 256 + wc * 32 + 8 * fq;
                const size_t eo = (size_t)r * DM + c0; float s = 0.f;
                f32x4 v[2][2];
#pragma unroll
                for (int bj = 0; bj < 2; ++bj) { const v4u w = xb[ai][m][bj];
                    const f32x4 x0 = {__builtin_bit_cast(float, w.x << 16), __builtin_bit_cast(float, w.x & 0xffff0000u), __builtin_bit_cast(float, w.y << 16), __builtin_bit_cast(float, w.y & 0xffff0000u)};
                    const f32x4 x1 = {__builtin_bit_cast(float, w.z << 16), __builtin_bit_cast(float, w.z & 0xffff0000u), __builtin_bit_cast(float, w.w << 16), __builtin_bit_cast(float, w.w & 0xffff0000u)};
                    v[bj][0] = x0 + acc[ai][bj][m][0]; v[bj][1] = x1 + acc[ai][bj][m][1];
#pragma unroll
                    for (int n = 0; n < 2; ++n) { const f32x4 q = v[bj][n] * v[bj][n]; s += (q[0] + q[1]) + (q[2] + q[3]); } }
                if (!last) {
#pragma unroll
                    for (int bj = 0; bj < 2; ++bj)
                        ST16(rs_, WS_XB + (eo + bj * 128) * 2, ((v4u){pk2(v[bj][0][0], v[bj][0][1]), pk2(v[bj][0][2], v[bj][0][3]), pk2(v[bj][1][0], v[bj][1][1]), pk2(v[bj][1][2], v[bj][1][3])}));
                    s += __shfl_xor(s, 16); s += __shfl_xor(s, 32);
                    if (fq == 0) ST4(rs_, WS_SSQ + (((size_t)u.pn * MP + r) * 4 + wc) * 4, s);
                } else {
                    const bool samp = r >= SROW0, pad = r >= MR; const int b = (r >= TT && !samp) ? 1 : 0, t = r - b * TT;
                    float* op = nullptr;
                    if (samp) { if (!pad) op = out + O_YS + (size_t)(r - SROW0) * DM + c0; } else if (t >= NMETA) op = out + O_YP + ((size_t)b * NSEQ + (t - NMETA)) * DM + c0;
                    if (op) {
#pragma unroll
                        for (int bj = 0; bj < 2; ++bj)
#pragma unroll
                            for (int n = 0; n < 2; ++n) *(f32x4*)(op + bj * 128 + n * 4) = v[bj][n]; }
                }
            }
    }
};

struct EpiFfn1 {
    static constexpr bool PERM = true, AFTER_DRAIN = false;
    unsigned char* ws_;
    __device__ __forceinline__ void operator()(f32x4 (&acc)[2][2][4][2], const pg8::Unit& u, int wr, int wc, int fr, int fq, LAS unsigned char* esc, int tid) const {
        asm volatile("" : "+v"(fr), "+v"(fq), "+v"(tid));
        size_t z_ = 0; asm volatile("" : "+s"(z_)); unsigned char* ws = ws_ + z_;
        const rsrc_t rs_ = ws_rsrc(ws);
        build_rs((const float*)(ws + WS_SSQ), u.pm, esc, tid);
        const LAS float* rsT = (const LAS float*)esc;
#pragma unroll
        for (int ai = 0; ai < 2; ++ai)
#pragma unroll
            for (int m = 0; m < 4; ++m) { const int rl = ai * 128 + wr * 64 + m * 16 + fr; const float rsv = rsT[rl];
                const size_t ho = WS_H + ((size_t)(u.pm * 256 + rl) * DFF + u.pn * 256 + wc * 32 + 8 * fq) * 2;
#pragma unroll
                for (int bj = 0; bj < 2; ++bj) { f32x4 v0 = acc[ai][bj][m][0] * rsv, v1 = acc[ai][bj][m][1] * rsv;
#pragma unroll
                    for (int j = 0; j < 4; ++j) { const float a = fmaxf(v0[j], 0.f), b = fmaxf(v1[j], 0.f); v0[j] = a * a; v1[j] = b * b; }
                    ST16(rs_, ho + bj * 256, ((v4u){pk2(v0[0], v0[1]), pk2(v0[2], v0[3]), pk2(v1[0], v1[1]), pk2(v1[2], v1[3])})); } }
    }
};

#define XB_TMO      128
#define XB_XCNT(j)  (256  + 64 * (j))
#define XB_XSUB(j)  (1280 + 64 * (j))
#define XB_XGEN(j)  (2304 + 64 * (j))
#define XB_TOP      3328
#define XB_TOPGEN   3392
#define XCD_BAR_WORDS 3456
#define XB_SPIN_CAP (1u << 18)
__device__ __forceinline__ unsigned xb_ld(unsigned* p)              { return __hip_atomic_load(p, __ATOMIC_RELAXED, __HIP_MEMORY_SCOPE_AGENT); }
__device__ __forceinline__ unsigned xb_add(unsigned* p, unsigned v) { return __hip_atomic_fetch_add(p, v, __ATOMIC_RELAXED, __HIP_MEMORY_SCOPE_AGENT); }
__device__ __forceinline__ unsigned xb_xcc_id() { return (unsigned)__builtin_amdgcn_s_getreg((3 << 11) | 20) & 0xFu; }
#define XB_SPIN(cond, bar) do { unsigned _sp = 0; while (cond) { __builtin_amdgcn_s_sleep(1); \
    if ((++_sp & 255u) == 0u) { if (xb_ld(&(bar)[XB_TMO])) break; if (_sp > XB_SPIN_CAP) { atomicAdd(&(bar)[XB_TMO], 1u); break; } } } } while (0)

struct XcdBarrier {
    unsigned* bar; unsigned x;
    volatile LAS unsigned* st;
};

__device__ __forceinline__ XcdBarrier xcd_barrier_post(unsigned* bar, volatile LAS unsigned* st) {
    XcdBarrier b; b.bar = bar; b.x = xb_xcc_id(); b.st = st;
    if (threadIdx.x == 0) (void)xb_add(&bar[XB_XCNT(b.x)], 1u);
    return b;
}
__device__ __forceinline__ void xcd_barrier_complete(unsigned* bar, unsigned x, unsigned& nloc, unsigned& nx) {
    const unsigned G = gridDim.x * gridDim.y * gridDim.z;
    unsigned sum, cnt, mine, sp = 0u;
    for (;;) {
        sum = 0u; cnt = 0u; mine = 0u;
#pragma unroll
        for (unsigned j = 0; j < 16; ++j) { const unsigned c = xb_ld(&bar[XB_XCNT(j)]); sum += c; cnt += (c > 0u) ? 1u : 0u; mine = (j == x) ? c : mine; }
        if (sum == G) break;
        __builtin_amdgcn_s_sleep(1);
        if ((++sp & 255u) == 0u) { if (xb_ld(&bar[XB_TMO])) break; if (sp > XB_SPIN_CAP) { atomicAdd(&bar[XB_TMO], 1u); break; } }
    }
    nloc = mine > 0u ? mine : 1u; nx = cnt > 0u ? cnt : 1u;
}

__device__ __forceinline__ void xcd_barrier(const XcdBarrier& b) {
    asm volatile("s_waitcnt vmcnt(0)" ::: "memory");
    __syncthreads();
    if (threadIdx.x == 0) {
        unsigned* bar = b.bar;
        __builtin_amdgcn_s_waitcnt(0);
        unsigned nloc = b.st[0], nx = b.st[1];
        if (nloc == 0u) { xcd_barrier_complete(bar, b.x, nloc, nx); b.st[0] = nloc; b.st[1] = nx; }
        const unsigned old = xb_add(&bar[XB_XSUB(b.x)], 1u);
        const unsigned gen = old / nloc;
        if (old + 1u == (gen + 1u) * nloc) {
            __builtin_amdgcn_fence(__ATOMIC_RELEASE, "agent");
            asm volatile("s_waitcnt vmcnt(0)" ::: "memory");
            const unsigned og = xb_add(&bar[XB_TOP], 1u);
            const unsigned tg = og / nx;
            if (og + 1u == (tg + 1u) * nx) xb_add(&bar[XB_TOPGEN], 1u);
            else XB_SPIN(xb_ld(&bar[XB_TOPGEN]) == tg, bar);
            __builtin_amdgcn_fence(__ATOMIC_ACQUIRE, "agent");
            xb_add(&bar[XB_XGEN(b.x)], 1u);
            asm volatile("s_waitcnt vmcnt(0)" ::: "memory");
        } else {
            XB_SPIN(xb_ld(&bar[XB_XGEN(b.x)]) == gen, bar);
            __builtin_amdgcn_fence(__ATOMIC_ACQUIRE, "agent");
            asm volatile("s_waitcnt vmcnt(0)" ::: "memory");
        }
    }
    __syncthreads();
}

struct Frame {
    LAS unsigned char* lds;
    volatile LAS unsigned* MISC;
    gu32* ctl;
    int wave, vcu, G;
    __device__ __forceinline__ int lane() const { int l; asm volatile("v_mbcnt_lo_u32_b32 %0, -1, 0\n\tv_mbcnt_hi_u32_b32 %0, -1, %0" : "=v"(l)); return l; }
    __device__ __forceinline__ int tid() const { return wave * 64 + lane(); }
    float* out; unsigned char* ws;
};
#define IN_XPROMPT 0
#define IN_XSAMPLE 1
#define IN_CACHEK 2
#define IN_CACHEV 3
#define IN_SSMRE 4
#define IN_SSMIM 5
#define IN_SPOOL 6
#define IN_META 7
#define IN_GMIX 8
#define IN_WIN 9
#define IN_GQ 10
#define IN_GK 11
#define IN_SINKS 12
#define IN_ARE 13
#define IN_AIM 14
#define IN_LOGDT 15
#define IN_BRE 16
#define IN_BIM 17
#define IN_CRE 18
#define IN_CIM 19
#define IN_DSKIP 20
#define IN_WGLU 21
#define IN_BGLU 22
#define IN_WPOOL 23
#define IN_PSCALE 24
#define IN_GOA 25
#define IN_GOS 26
#define IN_GOP 27
#define IN_WOUT 28
#define IN_GFFN 29
#define IN_WFF1 30
#define IN_WFF2 31
struct Args { const float* in[32]; float* out; unsigned char* ws; int ph_lo, ph_hi; };
static_assert(sizeof(Args) == 32 * 8 + 8 + 8 + 8, "Args has no padding");

__device__ __forceinline__ void p0_transpose_item(const float* W, int K, int N, bf16* WT, const float* gain, LAS float* scr, int item, int lane) {
    const int nblk = N / 32, kb = item / nblk, nb = item % nblk, k0 = 64 * kb, n0 = 32 * nb;
    float wv[32];
#pragma unroll
    for (int i = 0; i < 32; ++i) wv[i] = W[(size_t)(k0 + 2 * i + (lane >> 5)) * N + n0 + (lane & 31)];
    if (gain) {
#pragma unroll
        for (int i = 0; i < 32; ++i) wv[i] *= gain[k0 + 2 * i + (lane >> 5)];
    }
#pragma unroll
    for (int i = 0; i < 32; ++i) scr[(2 * i + (lane >> 5)) * 33 + (lane & 31)] = wv[i];
    LDS_WAIT(); asm volatile("" ::: "memory");
    const int c = lane & 7;
#pragma unroll
    for (int j = 0; j < 4; ++j) { const int n = (lane >> 3) + 8 * j; const LAS float* s = scr + (8 * c) * 33 + n;
        v4u o; o.x = pk2(s[0 * 33], s[1 * 33]); o.y = pk2(s[2 * 33], s[3 * 33]); o.z = pk2(s[4 * 33], s[5 * 33]); o.w = pk2(s[6 * 33], s[7 * 33]);
        *(GAS v4u*)(WT + (size_t)(n0 + n) * K + k0 + 8 * c) = o; }
    LDS_WAIT(); asm volatile("" ::: "memory");
}
__device__ __forceinline__ void sincos_d(double x, double& s, double& c) {
    const double TWO_PI = 6.283185307179586476925286766559;
    const double k = rint(x * (1.0 / TWO_PI)); const double r = fma(-k, TWO_PI, x), r2 = r * r;
    const double fs[14] = {0.16666666666666666, 0.05, 0.023809523809523808, 0.013888888888888888, 0.00909090909090909, 0.00641025641025641, 0.004761904761904762, 0.003676470588235294,
                           0.0029239766081871343, 0.002380952380952381, 0.001976284584980237, 0.0016666666666666668, 0.0014245014245014246, 0.0012315270935960591};
    const double fc[14] = {0.5, 0.08333333333333333, 0.03333333333333333, 0.017857142857142856, 0.011111111111111112, 0.007575757575757576, 0.005494505494505495, 0.004166666666666667,
                           0.0032679738562091504, 0.002631578947368421, 0.0021645021645021645, 0.0018115942028985507, 0.0015384615384615385, 0.0013227513227513227};
    double ts = r, tc = 1.0; s = r; c = 1.0;
#pragma unroll
    for (int i = 0; i < 14; ++i) { ts *= -r2 * fs[i]; s += ts; tc *= -r2 * fc[i]; c += tc; }
}
__device__ __forceinline__ double exp_small(double x) {
    double t = 1.0, e = 1.0;
#pragma unroll
    for (int i = 1; i <= 14; ++i) { t *= x * (1.0 / i); e += t; }
    return e;
}
__device__ __forceinline__ void p0_prologue(const Args& AR, Frame& F) {
    LAS float* scr = (LAS float*)(F.lds + F.wave * 16384);
    const int gw = F.vcu * 8 + F.wave, NGW = F.G * 8, lane = F.lane();
    unsigned char* ws = F.ws;
    constexpr int I_IN = (DM / 64) * (INW / 32), I_OUT = (DM / 64) * (DM / 32), I_1 = (DM / 64) * (DFF / 32), I_2 = (DFF / 64) * (DM / 32), I_GLU = (512 / 64) * (512 / 32), I_POOL = 4 * 2 * 4;
    constexpr int I_LAYER = I_IN + I_OUT + I_1 + I_2 + I_GLU + I_POOL;
    for (int it = gw; it < NLAYER * I_LAYER; it += NGW) {
        const int l = it / I_LAYER; int r = it % I_LAYER;
        if (r < I_IN) { p0_transpose_item(AR.in[IN_WIN] + (size_t)l * DM * INW, DM, INW, (bf16*)(ws + WS_WIN) + (size_t)l * INW * DM, AR.in[IN_GMIX] + l * DM, scr, r, lane); continue; } r -= I_IN;
        if (r < I_OUT) { const int k0 = 64 * (r / (DM / 32));
            const float* g = (k0 < 1024) ? AR.in[IN_GOA] + l * 1024 : (k0 < 1536) ? AR.in[IN_GOS] + l * 512 - 1024 : AR.in[IN_GOP] + l * 512 - 1536;
            p0_transpose_item(AR.in[IN_WOUT] + (size_t)l * DM * DM, DM, DM, (bf16*)(ws + WS_WOUT) + (size_t)l * DM * DM, g, scr, r, lane); continue; } r -= I_OUT;
        if (r < I_1) { p0_transpose_item(AR.in[IN_WFF1] + (size_t)l * DM * DFF, DM, DFF, (bf16*)(ws + WS_W1) + (size_t)l * DFF * DM, AR.in[IN_GFFN] + l * DM, scr, r, lane); continue; } r -= I_1;
        if (r < I_2) { p0_transpose_item(AR.in[IN_WFF2] + (size_t)l * DFF * DM, DFF, DM, (bf16*)(ws + WS_W2) + (size_t)l * DM * DFF, nullptr, scr, r, lane); continue; } r -= I_2;
        if (r < I_GLU) { p0_transpose_item(AR.in[IN_WGLU] + (size_t)l * 512 * 512, 512, 512, (bf16*)(ws + WS_WGLU) + (size_t)l * 512 * 512, nullptr, scr, r, lane); continue; } r -= I_GLU;
        { const int g = r / 8; p0_transpose_item(AR.in[IN_WPOOL] + ((size_t)l * 4 + g) * 128 * 128, 128, 128, (bf16*)(ws + WS_WPOOL) + ((size_t)l * 4 + g) * 128 * 128, nullptr, scr, r % 8, lane); }
    }
    bf16* XB = (bf16*)(ws + WS_XB); float* SSQ = (float*)(ws + WS_SSQ);
    for (int m = gw; m < MP; m += NGW) {
        const float* src = nullptr;
        if (m < SROW0) { const int b = m >= TT ? 1 : 0, t = m - b * TT; src = (t < NMETA) ? AR.in[IN_META] + (size_t)t * DM : AR.in[IN_XPROMPT] + ((size_t)b * NSEQ + (t - NMETA)) * DM; }
        else if (m < MR) src = AR.in[IN_XSAMPLE] + (size_t)(m - SROW0) * DM;
        float s = 0.f;
#pragma unroll
        for (int j = 0; j < 8; ++j) { f32x4 v = {0.f, 0.f, 0.f, 0.f}; if (src) v = *(const f32x4*)(src + j * 256 + lane * 4);
            s += (v[0] * v[0] + v[1] * v[1]) + (v[2] * v[2] + v[3] * v[3]);
            *(v2u*)(XB + (size_t)m * DM + j * 256 + lane * 4) = (v2u){pk2(v[0], v[1]), pk2(v[2], v[3])}; }
        s = wave_sum(s);
        if (lane < 32) SSQ[((size_t)(lane >> 2) * MP + m) * 4 + (lane & 3)] = (lane == 0) ? s : 0.f;
    }
    const int gt = gw * 64 + lane, NGT = NGW * 64;
    for (int id = gt; id < NLAYER * 32 * 64; id += NGT) {
        const int l = id >> 11, g = (id >> 6) & 31, n = id & 63;
        unsigned char* tb = ws + WS_TAB + (size_t)l * TB_LAYER;
        const double dt = (double)expf(AR.in[IN_LOGDT][l * 32 + g]);
        const double ar = (double)AR.in[IN_ARE][id], ai = (double)AR.in[IN_AIM][id];
        const double mag = exp_small(dt * ar); double sn, cs; sincos_d(dt * ai, sn, cs);
        const double abr = mag * cs, abi = mag * sn, den = ar * ar + ai * ai;
        const double fr = ((abr - 1.0) * ar + abi * ai) / den, fi = (abi * ar - (abr - 1.0) * ai) / den;
        ((float*)(tb + TB_ABR))[g * 64 + n] = (float)abr; ((float*)(tb + TB_ABI))[g * 64 + n] = (float)abi;
        const float* Br = AR.in[IN_BRE] + (size_t)id * 16; const float* Bi = AR.in[IN_BIM] + (size_t)id * 16;
        float* bbr = (float*)(tb + TB_BBR) + (size_t)(g * 64 + n) * 16; float* bbi = (float*)(tb + TB_BBI) + (size_t)(g * 64 + n) * 16;
        bf16* bbt = (bf16*)(tb + TB_PM) + (size_t)g * 128 * 16;
#pragma unroll
        for (int c = 0; c < 16; ++c) { const double br = Br[c], bi = Bi[c]; const float vr = (float)(fr * br - fi * bi), vi = (float)(fr * bi + fi * br); bbr[c] = vr; bbi[c] = vi;
            bbt[n * 16 + c] = (bf16)(pk2(vr, 0.f) & 0xffffu); bbt[(64 + n) * 16 + c] = (bf16)(pk2(vi, 0.f) & 0xffffu); }
        double pr = abr, pi = abi;
        for (int t = 0; t < 64; ++t) {
            if (t == 15) { ((float*)(tb + TB_A16R))[g * 64 + n] = (float)pr; ((float*)(tb + TB_A16I))[g * 64 + n] = (float)pi; }
            if (t == 31) { ((float*)(tb + TB_A32R))[g * 64 + n] = (float)pr; ((float*)(tb + TB_A32I))[g * 64 + n] = (float)pi; }
            if (t == 63) { ((float*)(tb + TB_ALR))[g * 64 + n] = (float)pr; ((float*)(tb + TB_ALI))[g * 64 + n] = (float)pi; }
            const double nr = pr * abr - pi * abi, ni = pr * abi + pi * abr; pr = nr; pi = ni;
        }
        bf16* CmT = (bf16*)(tb + TB_CMT) + (size_t)g * 16 * 128;
        const float* Cr = AR.in[IN_CRE] + ((size_t)(l * 32 + g) * 16) * 64 + n; const float* Ci = AR.in[IN_CIM] + ((size_t)(l * 32 + g) * 16) * 64 + n;
#pragma unroll
        for (int c = 0; c < 16; ++c) { CmT[c * 128 + n] = (bf16)(pk2(Cr[c * 64], 0.f) & 0xffffu); CmT[c * 128 + 64 + n] = (bf16)(pk2(-Ci[c * 64], 0.f) & 0xffffu); }
    }
    float* rc = (float*)(ws + WS_ROPE); float* rs_ = rc + ROPE_N;
    for (int id = gt; id < (int)ROPE_N; id += NGT) {
        const int p = id >> 4, i = id & 15; const double pos = (p == ROPE_SAMPLE_IDX) ? 16384.0 : (double)p;
        double inv = 1.0;
        for (int k = 0; k < i; ++k) inv *= 0.44036660267178046;
        double sn, cs; sincos_d(pos * inv, sn, cs);
        rc[id] = (float)cs; rs_[id] = (float)sn;
    }
}

__device__ __forceinline__ void attn_unit(const Args& AR, Frame& F, int l, int b, int i) {
    int lane_ = F.lane(); asm volatile("" : "+v"(lane_));
    size_t z_ = 0; asm volatile("" : "+s"(z_)); unsigned char* ws = F.ws + z_;
    const int lane = lane_, h = F.wave, c = lane & 31, hh = lane >> 5, kvh = h >> 2;
    const int t0 = 32 * i; const size_t rb = (size_t)b * TT;
#if PROBE && (PROBE_KIND == 11 || PROBE_KIND == 12)
    const unsigned long long ta0 = __builtin_amdgcn_s_memrealtime();
#endif
    const bf16* Q = (const bf16*)(ws + WS_Q); const bf16* K = (const bf16*)(ws + WS_K); const bf16* VT = (const bf16*)(ws + WS_VT);
    LAS float* ex = (LAS float*)(F.lds + ESC_OFF);
    bf16x8 qf[8];
    { const bf16* qp = Q + (rb + t0 + c) * 1024 + 128 * h + 8 * hh;
#pragma unroll
      for (int ks = 0; ks < 8; ++ks) qf[ks] = *(const bf16x8*)(qp + 16 * ks); }
    const int kt0 = (t0 >= 128) ? 0 : (4 - i);
    f32x16 S[5];
    bf16x8 kf[2][8];
    { const int tk0 = t0 - 128 + 32 * kt0; const bf16* kp = K + (rb + tk0 + c) * 256 + 128 * kvh + 8 * hh;
      if (kt0 & 1) {
#pragma unroll
          for (int ks = 0; ks < 8; ++ks) kf[1][ks] = *(const bf16x8*)(kp + 16 * ks);
      } else {
#pragma unroll
          for (int ks = 0; ks < 8; ++ks) kf[0][ks] = *(const bf16x8*)(kp + 16 * ks);
      } }
#pragma unroll
    for (int kt = 0; kt < 5; ++kt) {
#pragma unroll
        for (int r = 0; r < 16; ++r) S[kt][r] = -INFINITY;
        if (kt >= kt0) {
            if (kt < 4) { const int tk1 = t0 - 128 + 32 * (kt + 1); const bf16* kp = K + (rb + tk1 + c) * 256 + 128 * kvh + 8 * hh;
#pragma unroll
                for (int ks = 0; ks < 8; ++ks) kf[(kt + 1) & 1][ks] = *(const bf16x8*)(kp + 16 * ks); }
            f32x16 a = {0.f, 0.f, 0.f, 0.f, 0.f, 0.f, 0.f, 0.f, 0.f, 0.f, 0.f, 0.f, 0.f, 0.f, 0.f, 0.f};
#pragma unroll
            for (int ks = 0; ks < 8; ++ks) a = __builtin_amdgcn_mfma_f32_32x32x16_bf16(kf[kt & 1][ks], qf[ks], a, 0, 0, 0);
#pragma unroll
            for (int r = 0; r < 16; ++r) { const int kr = (r & 3) + 8 * (r >> 2) + 4 * hh; bool ok = true;
                if (kt == 0) ok = kr >= c;
                if (kt == 4) ok = kr <= c;
                S[kt][r] = ok ? a[r] : -INFINITY; }
        }
    }
#if PROBE && PROBE_KIND == 11
    if (F.tid() == 0) F.MISC[6] += (unsigned)(__builtin_amdgcn_s_memrealtime() - ta0);
#endif
    const float sink2 = AR.in[IN_SINKS][l * 8 + h] * LOG2E;
    float mx = sink2;
#pragma unroll
    for (int kt = 0; kt < 5; ++kt)
#pragma unroll
        for (int r = 0; r < 16; ++r) mx = fmaxf(mx, S[kt][r]);
    mx = fmaxf(mx, __shfl_xor(mx, 32));
    float sum = 0.f;
#pragma unroll
    for (int kt = 0; kt < 5; ++kt)
#pragma unroll
        for (int r = 0; r < 16; ++r) { const float p = __builtin_amdgcn_exp2f(S[kt][r] - mx); S[kt][r] = p; sum += p; }
    sum += __shfl_xor(sum, 32);
    const float inv = 1.0f / (sum + __builtin_amdgcn_exp2f(sink2 - mx));
    f32x16 O[4];
#pragma unroll
    for (int db = 0; db < 4; ++db)
#pragma unroll
        for (int r = 0; r < 16; ++r) O[db][r] = 0.f;
    const bf16* vbase = VT + ((size_t)((b * 2 + kvh) * 128 + c)) * TPV + (t0 - 128) + 8 * hh;
    bf16x8 vf[2][4];
#pragma unroll
    for (int db = 0; db < 4; ++db) vf[0][db] = *(const bf16x8*)(vbase + (size_t)(32 * db) * TPV + 32 * kt0);
#pragma unroll
    for (int st = 0; st < 10; ++st) {
        const int kt = st >> 1, s = st & 1;
        if (kt >= kt0) {
            if (st < 9) {
#pragma unroll
                for (int db = 0; db < 4; ++db) vf[(st + 1) & 1][db] = *(const bf16x8*)(vbase + (size_t)(32 * db) * TPV + 16 * (st + 1)); }
            v4u pw; pw.x = pk2(S[kt][8 * s + 0], S[kt][8 * s + 1]); pw.y = pk2(S[kt][8 * s + 2], S[kt][8 * s + 3]); pw.z = pk2(S[kt][8 * s + 4], S[kt][8 * s + 5]); pw.w = pk2(S[kt][8 * s + 6], S[kt][8 * s + 7]);
            const bf16x8 pf = __builtin_bit_cast(bf16x8, pw);
#pragma unroll
            for (int db = 0; db < 4; ++db) O[db] = __builtin_amdgcn_mfma_f32_32x32x16_bf16(vf[st & 1][db], pf, O[db], 0, 0, 0);
        }
    }
    float ss = 0.f;
#pragma unroll
    for (int db = 0; db < 4; ++db)
#pragma unroll
        for (int r = 0; r < 16; ++r) { O[db][r] *= inv; ss += O[db][r] * O[db][r]; }
#if PROBE && PROBE_KIND == 12
    if (F.tid() == 0) F.MISC[6] += (unsigned)(__builtin_amdgcn_s_memrealtime() - ta0);
#endif
    ss += __shfl_xor(ss, 32);
    if (hh == 0) ex[h * 32 + c] = ss;
    WG_BAR();
    float tot = 0.f;
#pragma unroll
    for (int j = 0; j < 8; ++j) tot += ex[j * 32 + c];
    const float rsa = rsqrtf(tot * (1.0f / 1024.0f) + EPS);
    if (t0 + c < TT) {
        const rsrc_t rs_ = ws_rsrc(ws); const size_t mo16 = WS_MIX + ((rb + t0 + c) * DM + 128 * h) * 2 + 16 * hh;
#pragma unroll
        for (int db = 0; db < 4; ++db)
#pragma unroll
            for (int g4 = 0; g4 < 4; g4 += 2) {
                unsigned ax = pk2(O[db][4 * g4 + 0] * rsa, O[db][4 * g4 + 1] * rsa), ay = pk2(O[db][4 * g4 + 2] * rsa, O[db][4 * g4 + 3] * rsa);
                unsigned bx = pk2(O[db][4 * g4 + 4] * rsa, O[db][4 * g4 + 5] * rsa), by = pk2(O[db][4 * g4 + 6] * rsa, O[db][4 * g4 + 7] * rsa);
                { auto r = __builtin_amdgcn_permlane32_swap(ax, bx, false, false); ax = r[0]; bx = r[1]; }
                { auto r = __builtin_amdgcn_permlane32_swap(ay, by, false, false); ay = r[0]; by = r[1]; }
                ST16(rs_, mo16 + (32 * db + 8 * g4) * 2, ((v4u){ax, ay, bx, by}));
            }
    }
    WG_BAR();
}

__device__ __forceinline__ void sattn_unit(const Args& AR, Frame& F, int l, int s) {
    int tid_ = F.tid(); asm volatile("" : "+v"(tid_));
    const int tid = tid_, lane = tid & 63, wave = F.wave;
    LAS float* qs = (LAS float*)F.lds;
    LAS float* sc = qs + 1024;
    LAS float* part = sc + 8 * 132;
    LAS float* red = part + 4096;
    const size_t row = SROW0 + s;
    const bf16* Q = (const bf16*)(F.ws + WS_Q) + row * 1024;
    const float* ksn = (const float*)(F.ws + WS_KSN) + (size_t)s * 256; const float* vsn = ksn + NSAMP * 256;
    const float* ck = AR.in[IN_CACHEK] + ((size_t)(l * NSAMP + s)) * 128 * 256; const float* cv = AR.in[IN_CACHEV] + ((size_t)(l * NSAMP + s)) * 128 * 256;
    for (int j = tid; j < 1024; j += 512) qs[j] = bf2f(Q[j]);
    WG_BAR();
    { const int key = tid >> 2, pt = tid & 3;
#pragma unroll
      for (int kvh = 0; kvh < 2; ++kvh) {
          const float* kp = ck + (size_t)key * 256 + kvh * 128 + 32 * pt; float d[4] = {0.f, 0.f, 0.f, 0.f};
#pragma unroll
          for (int j = 0; j < 8; ++j) { const f32x4 kv = *(const f32x4*)(kp + 4 * j);
#pragma unroll
              for (int g = 0; g < 4; ++g) { const f32x4 qv = *(const LAS f32x4*)(qs + (4 * kvh + g) * 128 + 32 * pt + 4 * j); d[g] += (kv[0] * qv[0] + kv[1] * qv[1]) + (kv[2] * qv[2] + kv[3] * qv[3]); } }
#pragma unroll
          for (int g = 0; g < 4; ++g) { d[g] += __shfl_xor(d[g], 1); d[g] += __shfl_xor(d[g], 2); if (pt == 0) sc[(4 * kvh + g) * 132 + key] = d[g]; }
      } }
    {
      const int h = wave, kvh = h >> 2; float d = ksn[kvh * 128 + lane] * qs[h * 128 + lane] + ksn[kvh * 128 + 64 + lane] * qs[h * 128 + 64 + lane];
      d = wave_sum(d); if (lane == 0) sc[h * 132 + 128] = d; }
    WG_BAR();
    { const int h = wave; const float sink2 = AR.in[IN_SINKS][l * 8 + h] * LOG2E;
      const float v0 = sc[h * 132 + lane], v1 = sc[h * 132 + 64 + lane], v2 = (lane == 0) ? sc[h * 132 + 128] : -INFINITY;
      const float mx = fmaxf(wave_max(fmaxf(fmaxf(v0, v1), v2)), sink2);
      const float p0 = __builtin_amdgcn_exp2f(v0 - mx), p1 = __builtin_amdgcn_exp2f(v1 - mx), p2 = __builtin_amdgcn_exp2f(v2 - mx);
      const float inv = 1.0f / (wave_sum(p0 + p1 + p2) + __builtin_amdgcn_exp2f(sink2 - mx));
      sc[h * 132 + lane] = p0 * inv; sc[h * 132 + 64 + lane] = p1 * inv; if (lane == 0) sc[h * 132 + 128] = p2 * inv; }
    WG_BAR();
    { const int d = tid & 127, kq = tid >> 7;
#pragma unroll
      for (int kvh = 0; kvh < 2; ++kvh) { float a[4] = {0.f, 0.f, 0.f, 0.f};
#pragma unroll 8
          for (int k = 0; k < 32; ++k) { const int key = 32 * kq + k; const float v = cv[(size_t)key * 256 + kvh * 128 + d];
#pragma unroll
              for (int g = 0; g < 4; ++g) a[g] += sc[(4 * kvh + g) * 132 + key] * v; }
#pragma unroll
          for (int g = 0; g < 4; ++g) part[kq * 1024 + (4 * kvh + g) * 128 + d] = a[g]; } }
    WG_BAR();
    float o[2]; float ss = 0.f;
#pragma unroll
    for (int e = 0; e < 2; ++e) { const int j = tid + 512 * e, h = j >> 7, d = j & 127, kvh = h >> 2;
        o[e] = (part[j] + part[1024 + j]) + (part[2048 + j] + part[3072 + j]) + sc[h * 132 + 128] * vsn[kvh * 128 + d]; ss += o[e] * o[e]; }
    ss = wave_sum(ss); if (lane == 0) red[wave] = ss;
    WG_BAR();
    { float tot = 0.f;
#pragma unroll
      for (int j = 0; j < 8; ++j) tot += red[j];
      const float rsa = rsqrtf(tot * (1.0f / 1024.0f) + EPS);
      const rsrc_t rs_ = ws_rsrc(F.ws);
#pragma unroll
      for (int e = 0; e < 2; ++e) ST2(rs_, WS_MIX + (row * DM + tid + 512 * e) * 2, pk2(o[e] * rsa, 0.f) & 0xffffu); }
    { float* ok = F.out + O_SK + ((size_t)(l * NSAMP + s)) * 128 * 256; float* ov = F.out + O_SV + ((size_t)(l * NSAMP + s)) * 128 * 256;
      for (int j = tid; j < 127 * 64; j += 512) { *(f32x4*)(ok + 4 * j) = *(const f32x4*)(ck + 256 + 4 * j); *(f32x4*)(ov + 4 * j) = *(const f32x4*)(cv + 256 + 4 * j); }
      if (tid < 64) *(f32x4*)(ok + 127 * 256 + 4 * tid) = *(const f32x4*)(ksn + 4 * tid);
      else if (tid < 128) *(f32x4*)(ov + 127 * 256 + 4 * (tid - 64)) = *(const f32x4*)(vsn + 4 * (tid - 64)); }
    WG_BAR();
}

__device__ __forceinline__ float gelu_tanh(float y) {
    const float inner = 0.7978845608028654f * (y + 0.044715f * y * y * y);
    return y / (1.0f + __builtin_amdgcn_exp2f(-2.0f * LOG2E * inner));
}
__device__ __forceinline__ float sigmoidf_(float x) { return 1.0f / (1.0f + __builtin_amdgcn_exp2f(-LOG2E * x)); }
#define SWZ(r, ch, PITCH) ((r) * (PITCH) + ((((ch)) ^ ((r) & 15)) << 4))

#ifndef SSM_P1
#define SSM_P1 1
#endif
#ifndef SSM_M2
#define SSM_M2 1
#endif
__device__ __forceinline__ int rowtok(int r) { return 16 * ((r >> 2) & 1) + 4 * (r >> 3) + (r & 3); }
struct SsmG { f32x16 X[4]; };
__device__ __forceinline__ void ssm_block(const Args& AR, SsmG& G, const float* U, int rowb, int g, const bf16x8 (&bbf)[4], const float (&ab)[4], float (&hr)[2], float (&hi)[2], int mode, int l, int s0, int lane) {
    const int c = lane & 31, hh = lane >> 5;
    bf16x8 af;
    { const float* up = U + (size_t)(rowb + rowtok(c)) * 512 + 16 * g + 8 * hh; const f32x4 u0 = *(const f32x4*)up, u1 = *(const f32x4*)(up + 4);
      v4u pw; pw.x = pk2(u0[0], u0[1]); pw.y = pk2(u0[2], u0[3]); pw.z = pk2(u1[0], u1[1]); pw.w = pk2(u1[2], u1[3]); af = __builtin_bit_cast(bf16x8, pw); }
    const f32x16 z16 = {0.f, 0.f, 0.f, 0.f, 0.f, 0.f, 0.f, 0.f, 0.f, 0.f, 0.f, 0.f, 0.f, 0.f, 0.f, 0.f};
#pragma unroll
    for (int nb = 0; nb < 4; ++nb) G.X[nb] = __builtin_amdgcn_mfma_f32_32x32x16_bf16(af, bbf[nb], z16, 0, 0, 0);
#pragma unroll
    for (int s = 0; s < 2; ++s) {
        const float ar = ab[2 * s], ai = ab[2 * s + 1];
        if (SSM_M2 && mode == 2) {
            { int cx = c; asm volatile("" : "+v"(cx)); const size_t o0 = ((size_t)(l * NSAMP + (s0 + 16 * hh)) * 32 + g) * 64 + cx + 32 * s; const float* qr = AR.in[IN_SSMRE] + o0; const float* qi = AR.in[IN_SSMIM] + o0;
              size_t jo = 0;
#pragma unroll
              for (int j = 0; j < 16; ++j) { const float pr = qr[jo], pi = qi[jo]; jo += 2048; asm volatile("" : "+v"(jo));
                const float nr = ar * pr - ai * pi + G.X[s][j], ni = ar * pi + ai * pr + G.X[2 + s][j]; G.X[s][j] = nr; G.X[2 + s][j] = ni; } }
            continue;
        }
        float r = (hh == 0) ? hr[s] : 0.f, i = (hh == 0) ? hi[s] : 0.f;
#pragma unroll
        for (int j = 0; j < 16; ++j) { const float nr = ar * r - ai * i + G.X[s][j], ni = ar * i + ai * r + G.X[2 + s][j]; r = nr; i = ni; G.X[s][j] = r; G.X[2 + s][j] = i; }
        float vr = __shfl_xor(r, 32), vi = __shfl_xor(i, 32);
        if (hh == 0 || mode == 1) { vr = 0.f; vi = 0.f; }
        float pr = ar, pi = ai; asm volatile("" : "+v"(pr), "+v"(pi));
#pragma unroll
        for (int j = 0; j < 16; ++j) { G.X[s][j] += pr * vr - pi * vi; G.X[2 + s][j] += pr * vi + pi * vr; const float nr = pr * ar - pi * ai, ni = pr * ai + pi * ar; pr = nr; pi = ni; }
        const float er = G.X[s][15], ei = G.X[2 + s][15];
        const float xr = __shfl_xor(er, 32), xi = __shfl_xor(ei, 32);
        hr[s] = (hh == 1) ? er : xr; hi[s] = (hh == 1) ? ei : xi;
    }
}
__device__ __forceinline__ void ssm_unit(const Args& AR, Frame& F, int l, int c_in) {
    const int c = c_in;
    int lane_ = F.lane(); asm volatile("" : "+v"(lane_));
    const int lane = lane_, w = F.wave, t16 = lane & 15, cq = lane >> 4, c32 = lane & 31, hh = lane >> 5;
    const int row0 = 64 * c;
    size_t z_ = 0; asm volatile("" : "+s"(z_)); unsigned char* ws = F.ws + z_;
    const unsigned char* tb = ws + WS_TAB + (size_t)l * TB_LAYER;
    const float* U = (const float*)(ws + WS_U);
    float* SST = (float*)(ws + WS_SST) + ((size_t)l * NCHUNK) * 32 * 128;
    gu32* flags = F.ctl + CW_SSMF + (size_t)(l * NCHUNK) * 8 * 16;
    LAS unsigned char* Zs = F.lds;
    LAS unsigned char* Hm = F.lds + 65536 + w * 8704;
    LAS float* red = (LAS float*)(F.lds + 137216);
    SsmG SG;
    if (SSM_P1 && c != NCHUNK - 1) {
#pragma unroll 1
        for (int gi = 0; gi < 4; ++gi) {
            const int g = 4 * w + gi;
            int lg_ = lane; asm volatile("" : "+v"(lg_));
            const int c32 = lg_ & 31, hh = lg_ >> 5;
            float ab[4]; ab[0] = ((const float*)(tb + TB_ABR))[g * 64 + c32]; ab[1] = ((const float*)(tb + TB_ABI))[g * 64 + c32]; ab[2] = ((const float*)(tb + TB_ABR))[g * 64 + 32 + c32]; ab[3] = ((const float*)(tb + TB_ABI))[g * 64 + 32 + c32];
            bf16x8 bbf[4];
            { const bf16* bt = (const bf16*)(tb + TB_PM) + (size_t)g * 128 * 16 + c32 * 16 + 8 * hh;
#pragma unroll
              for (int nb = 0; nb < 4; ++nb) bbf[nb] = *(const bf16x8*)(bt + nb * 32 * 16); }
            float hr[2] = {0.f, 0.f}, hi[2] = {0.f, 0.f};
            ssm_block(AR, SG, U, row0, g, bbf, ab, hr, hi, (c == 64) ? 1 : 0, l, 0, lg_);
            ssm_block(AR, SG, U, row0 + 32, g, bbf, ab, hr, hi, 0, l, 0, lg_);
            if (hh == 0) {
#pragma unroll
                for (int s = 0; s < 2; ++s) __hip_atomic_store((gu64*)(SST + ((size_t)c * 32 + g) * 128 + 2 * (c32 + 32 * s)), ((unsigned long long)__builtin_bit_cast(unsigned, hi[s]) << 32) | __builtin_bit_cast(unsigned, hr[s]), RLX_AGENT);
            }
        }
        VM_WAIT();
        if (lane == 0) __hip_atomic_store(flags + ((size_t)c * 8 + w) * 16, 1u, RLX_AGENT);
    }
    const int cs0 = (c <= 64) ? 0 : 64, npred = c - cs0;
    if (npred > 0) {
        unsigned sp = 0; bool ok = false;
        for (;;) { ok = (lane >= npred) || (__hip_atomic_load(flags + ((size_t)(cs0 + lane) * 8 + w) * 16, RLX_AGENT) != 0u);
            if (__all(ok)) break;
            __builtin_amdgcn_s_sleep(2);
            if (++sp > (1u << 20)) { if (lane == 0) __hip_atomic_store(F.ctl + CW_TMO, 0x55u, RLX_AGENT); break; } }
        __builtin_amdgcn_fence(__ATOMIC_ACQUIRE, "agent");
        VM_WAIT();
    }
#pragma unroll 1
    for (int gi = 0; gi < 4; ++gi) {
        const int g = 4 * w + gi;
        int lg_ = lane; asm volatile("" : "+v"(lg_));
        const int t16 = lg_ & 15, cq = lg_ >> 4, c32 = lg_ & 31, hh = lg_ >> 5;
        float ab[4]; ab[0] = ((const float*)(tb + TB_ABR))[g * 64 + c32]; ab[1] = ((const float*)(tb + TB_ABI))[g * 64 + c32]; ab[2] = ((const float*)(tb + TB_ABR))[g * 64 + 32 + c32]; ab[3] = ((const float*)(tb + TB_ABI))[g * 64 + 32 + c32];
        float hr[2] = {0.f, 0.f}, hi[2] = {0.f, 0.f};
        if (npred > 0) {
#pragma unroll
            for (int s = 0; s < 2; ++s) {
                const int n = c32 + 32 * s;
                const float aLr = ((const float*)(tb + TB_ALR))[g * 64 + n], aLi = ((const float*)(tb + TB_ALI))[g * 64 + n];
                float Hr = 0.f, Hi = 0.f;
                for (int cp = cs0; cp < c; cp += 8) {
                    f32x2 sv[8];
#pragma unroll
                    for (int j = 0; j < 8; ++j) { const int cj = (cp + j < c) ? cp + j : c - 1; sv[j] = *(const f32x2*)(SST + ((size_t)cj * 32 + g) * 128 + 2 * n); }
#pragma unroll
                    for (int j = 0; j < 8; ++j) if (cp + j < c) { const float nr = aLr * Hr - aLi * Hi + sv[j][0], ni = aLr * Hi + aLi * Hr + sv[j][1]; Hr = nr; Hi = ni; }
                }
                hr[s] = Hr; hi[s] = Hi;
            }
        }
        bf16x8 bbf[4];
        { const bf16* bt = (const bf16*)(tb + TB_PM) + (size_t)g * 128 * 16 + c32 * 16 + 8 * hh;
#pragma unroll
          for (int nb = 0; nb < 4; ++nb) bbf[nb] = *(const bf16x8*)(bt + nb * 32 * 16); }
        bf16x8 cmf[4];
        { const bf16* cm = (const bf16*)(tb + TB_CMT) + (size_t)g * 16 * 128 + t16 * 128 + 8 * cq;
#pragma unroll
          for (int ks = 0; ks < 4; ++ks) cmf[ks] = *(const bf16x8*)(cm + 32 * ks); }
        const int col = 64 * w + 16 * gi + 4 * cq;
        const f32x4 dsk = *(const f32x4*)(AR.in[IN_DSKIP] + l * 512 + col);
#pragma unroll 1
        for (int half = 0; half < 2; ++half) {
            int cc_ = c_in; asm volatile("" : "+s"(cc_)); const int c = cc_;
            const bool samp = (c == NCHUNK - 1) && (half == 1);
            ssm_block(AR, SG, U, row0 + 32 * half, g, bbf, ab, hr, hi, samp ? 2 : ((c == 64 && half == 0) ? 1 : 0), l, 0, lg_);
            { LAS unsigned char* hw = Hm + hh * (16 * 272) + c32 * 2;
#pragma unroll
              for (int j = 0; j < 16; ++j)
#pragma unroll
                for (int nb = 0; nb < 4; ++nb) *(LAS bf16*)(hw + j * 272 + nb * 64) = (bf16)(pk2(SG.X[nb][j], 0.f) & 0xffffu); }
            if ((c == 64 && half == 0) || (c == NCHUNK - 1 && half == 0)) {
                int cx = c32; asm volatile("" : "+v"(cx));
                if (hh == (c == 64 ? 0 : 1)) {
#pragma unroll
                    for (int s = 0; s < 2; ++s) { const size_t o = ((size_t)(l * NBATCH + (c == 64 ? 0 : 1)) * 32 + g) * 64 + cx + 32 * s; F.out[O_PSR + o] = SG.X[s][15]; F.out[O_PSI + o] = SG.X[2 + s][15]; } } }
            if (samp) { int cx = c32; asm volatile("" : "+v"(cx)); const size_t o0 = ((size_t)(l * NSAMP + 16 * hh) * 32 + g) * 64 + cx; float* qr = F.out + O_SSR + o0; float* qi = F.out + O_SSI + o0;
#pragma unroll
                for (size_t j = 0, jo = 0; j < 16; ++j) { qr[jo] = SG.X[0][j]; qr[jo + 32] = SG.X[1][j]; qi[jo] = SG.X[2][j]; qi[jo + 32] = SG.X[3][j]; jo += 2048; asm volatile("" : "+v"(jo)); } }
            LDS_WAIT();
#pragma unroll
            for (int mt = 0; mt < 2; ++mt) {
                f32x4 y = {0.f, 0.f, 0.f, 0.f};
#pragma unroll
                for (int ks = 0; ks < 4; ++ks) { const bf16x8 hf = *(const LAS bf16x8*)(Hm + (16 * mt + t16) * 272 + (4 * ks + cq) * 16);
                    y = __builtin_amdgcn_mfma_f32_16x16x32_bf16(cmf[ks], hf, y, 0, 0, 0); }
                const int rl = 32 * half + 16 * mt + t16;
                const f32x4 uv = *(const f32x4*)(U + (size_t)(row0 + rl) * 512 + col);
                f32x4 z;
#pragma unroll
                for (int e = 0; e < 4; ++e) z[e] = gelu_tanh(y[e] + dsk[e] * uv[e]);
                *(LAS v2u*)(Zs + SWZ(rl, col >> 3, 1024) + (col & 7) * 2) = (v2u){pk2(z[0], z[1]), pk2(z[2], z[3])};
            }
            LDS_WAIT();
        }
    }
    WG_BAR();
    f32x4 G[4][4];
#pragma unroll
    for (int mt = 0; mt < 4; ++mt)
#pragma unroll
        for (int nt = 0; nt < 4; ++nt) G[mt][nt] = (f32x4){0.f, 0.f, 0.f, 0.f};
    { const bf16* Wg = (const bf16*)(ws + WS_WGLU) + (size_t)l * 512 * 512 + (size_t)(64 * w + t16) * 512 + 8 * cq;
#pragma unroll 4
      for (int ks = 0; ks < 16; ++ks) {
          bf16x8 wf[4], zf[4];
#pragma unroll
          for (int nt = 0; nt < 4; ++nt) wf[nt] = *(const bf16x8*)(Wg + (size_t)nt * 16 * 512 + 32 * ks);
#pragma unroll
          for (int mt = 0; mt < 4; ++mt) zf[mt] = *(const LAS bf16x8*)(Zs + SWZ(16 * mt + t16, 4 * ks + cq, 1024));
#pragma unroll
          for (int mt = 0; mt < 4; ++mt)
#pragma unroll
              for (int nt = 0; nt < 4; ++nt) G[mt][nt] = __builtin_amdgcn_mfma_f32_16x16x32_bf16(wf[nt], zf[mt], G[mt][nt], 0, 0, 0);
      } }
#pragma unroll
    for (int mt = 0; mt < 4; ++mt) { float ss = 0.f; const int rl = 16 * mt + t16;
#pragma unroll
        for (int nt = 0; nt < 4; ++nt) { const int col = 64 * w + 16 * nt + 4 * cq; const f32x4 bg = *(const f32x4*)(AR.in[IN_BGLU] + l * 512 + col);
            const v2u zz = *(const LAS v2u*)(Zs + SWZ(rl, col >> 3, 1024) + (col & 7) * 2);
            const float zv[4] = {bf2f((unsigned short)(zz.x & 0xffffu)), bf2f((unsigned short)(zz.x >> 16)), bf2f((unsigned short)(zz.y & 0xffffu)), bf2f((unsigned short)(zz.y >> 16))};
#pragma unroll
            for (int e = 0; e < 4; ++e) { const float o = zv[e] * sigmoidf_(G[mt][nt][e] + bg[e]); G[mt][nt][e] = o; ss += o * o; } }
        ss += __shfl_xor(ss, 16); ss += __shfl_xor(ss, 32);
        if (cq == 0) red[rl * 8 + w] = ss; }
    WG_BAR();
    { const rsrc_t rs_ = ws_rsrc(ws);
#pragma unroll
      for (int mt = 0; mt < 4; ++mt) { const int rl = 16 * mt + t16; const LAS f32x4* rp = (const LAS f32x4*)(red + rl * 8); const f32x4 a = rp[0], b2 = rp[1];
          const float rsn = rsqrtf(((a[0] + a[1]) + (a[2] + a[3]) + (b2[0] + b2[1]) + (b2[2] + b2[3])) * (1.0f / 512.0f) + EPS);
          const int od = cq & 1; const size_t mo = WS_MIX + ((size_t)(row0 + rl) * DM + 1024 + 64 * w + 4 * (cq & ~1)) * 2 + (od ? 32 : 0);
#pragma unroll
          for (int nt = 0; nt < 4; nt += 2) {
              const unsigned a0 = pk2(G[mt][nt][0] * rsn, G[mt][nt][1] * rsn), a1 = pk2(G[mt][nt][2] * rsn, G[mt][nt][3] * rsn);
              const unsigned b0 = pk2(G[mt][nt + 1][0] * rsn, G[mt][nt + 1][1] * rsn), b1 = pk2(G[mt][nt + 1][2] * rsn, G[mt][nt + 1][3] * rsn);
              const unsigned s0 = od ? a0 : b0, s1 = od ? a1 : b1;
              const unsigned r0 = (unsigned)__shfl_xor((int)s0, 16), r1 = (unsigned)__shfl_xor((int)s1, 16);
              ST16(rs_, mo + 32 * nt, (od ? (v4u){r0, r1, b0, b1} : (v4u){a0, a1, r0, r1})); } } }
    WG_BAR();
}
#undef SSM_ROWS4

template <int WLEN>
__device__ __forceinline__ void pool_half(const float* XP, float* out, int l, int ch, int rfirst, int rl0, LAS unsigned char* Ds) {
    float xv[48];
#pragma unroll
    for (int i = 0; i < 48; ++i) { const int ra = rfirst + i - 16; xv[i] = (ra >= 0) ? XP[(size_t)ra * 512 + ch] : 0.f; }
    int seg = (rfirst >= TT) ? TT : 0;
    float sum = 0.f;
#pragma unroll
    for (int j = 1; j <= WLEN; ++j) if (rfirst - j >= seg) sum += xv[16 - j];
#pragma unroll
    for (int i = 0; i < 32; ++i) {
        const int ra = rfirst + i; const float x = xv[16 + i];
        if (ra == TT) { seg = TT; sum = 0.f; }
        sum += x;
        if (ra - WLEN >= seg) sum -= xv[16 + i - WLEN];
        const int cnt = (ra - seg + 1 < WLEN) ? (ra - seg + 1) : WLEN;
        const float dm = sum * __builtin_amdgcn_rcpf((float)cnt) - x;
        if (ra >= TT - 15 && ra < TT) out[O_PP + ((size_t)(l * NBATCH + 0) * 15 + (ra - (TT - 15))) * 512 + ch] = x;
        if (ra >= SROW0 - 15) out[O_PP + ((size_t)(l * NBATCH + 1) * 15 + (ra - (SROW0 - 15))) * 512 + ch] = x;
        const int r = rl0 + i;
        *(LAS bf16*)(Ds + SWZ(r, ch >> 3, 1024) + (ch & 7) * 2) = (bf16)(pk2(dm, 0.f) & 0xffffu);
    }
}
template <int WLEN>
__device__ __forceinline__ void pool_sample_rows(const float* XP, const float* sp, float* out, int l, int ch, LAS unsigned char* Ds) {
#pragma unroll 2
    for (int s = 0; s < NSAMP; ++s) {
        const float* pp = sp + (size_t)s * 15 * 512; float pv[15];
#pragma unroll
        for (int j = 0; j < 15; ++j) pv[j] = pp[(size_t)j * 512];
        const float x = XP[(size_t)(SROW0 + s) * 512 + ch]; float a = x;
#pragma unroll
        for (int j = 16 - WLEN; j < 15; ++j) a += pv[j];
        const float dm = a * (1.0f / WLEN) - x;
        float* op = out + O_SP + ((size_t)(l * NSAMP + s) * 15) * 512 + ch;
#pragma unroll
        for (int j = 0; j < 14; ++j) op[(size_t)j * 512] = pv[j + 1];
        op[(size_t)14 * 512] = x;
        *(LAS bf16*)(Ds + SWZ(32 + s, ch >> 3, 1024) + (ch & 7) * 2) = (bf16)(pk2(dm, 0.f) & 0xffffu);
    }
}
__device__ __forceinline__ void pool_unit(const Args& AR, Frame& F, int l, int c) {
    int tid_ = F.tid(); asm volatile("" : "+v"(tid_));
    const int tid = tid_, lane = tid & 63, w = F.wave, t16 = lane & 15, cq = lane >> 4;
    const int row0 = 64 * c;
    size_t z_ = 0; asm volatile("" : "+s"(z_)); unsigned char* ws = F.ws + z_;
    const float* XP = (const float*)(ws + WS_XP);
    LAS unsigned char* Ds = F.lds;
    LAS float* red = (LAS float*)(F.lds + ESC_OFF);
    { const int ch = tid, wsel = w >> 1;
      const float* sp = AR.in[IN_SPOOL] + (size_t)l * NSAMP * 15 * 512 + ch;
#pragma unroll 1
      for (int half = 0; half < 2; ++half) {
          if (c == NCHUNK - 1 && half == 1) {
              if (wsel == 0) pool_sample_rows<2>(XP, sp, F.out, l, ch, Ds); else if (wsel == 1) pool_sample_rows<4>(XP, sp, F.out, l, ch, Ds);
              else if (wsel == 2) pool_sample_rows<8>(XP, sp, F.out, l, ch, Ds); else pool_sample_rows<16>(XP, sp, F.out, l, ch, Ds);
          } else {
              const int rfirst = row0 + 32 * half;
              if (wsel == 0) pool_half<2>(XP, F.out, l, ch, rfirst, 32 * half, Ds); else if (wsel == 1) pool_half<4>(XP, F.out, l, ch, rfirst, 32 * half, Ds);
              else if (wsel == 2) pool_half<8>(XP, F.out, l, ch, rfirst, 32 * half, Ds); else pool_half<16>(XP, F.out, l, ch, rfirst, 32 * half, Ds);
          }
      } }
    WG_BAR();
    const int gp = w & 3, rh = w >> 2;
    f32x4 A[2][8];
#pragma unroll
    for (int mt = 0; mt < 2; ++mt)
#pragma unroll
        for (int nt = 0; nt < 8; ++nt) A[mt][nt] = (f32x4){0.f, 0.f, 0.f, 0.f};
    { const bf16* Wp = (const bf16*)(ws + WS_WPOOL) + ((size_t)(l * 4 + gp) * 128 + t16) * 128 + 8 * cq;
#pragma unroll
      for (int ks = 0; ks < 4; ++ks) {
          bf16x8 df[2];
#pragma unroll
          for (int mt = 0; mt < 2; ++mt) df[mt] = *(const LAS bf16x8*)(Ds + SWZ(32 * rh + 16 * mt + t16, 16 * gp + 4 * ks + cq, 1024));
#pragma unroll
          for (int nt = 0; nt < 8; ++nt) { const bf16x8 wf = *(const bf16x8*)(Wp + (size_t)nt * 16 * 128 + 32 * ks);
#pragma unroll
              for (int mt = 0; mt < 2; ++mt) A[mt][nt] = __builtin_amdgcn_mfma_f32_16x16x32_bf16(wf, df[mt], A[mt][nt], 0, 0, 0); }
      } }
#pragma unroll
    for (int mt = 0; mt < 2; ++mt) { float ss = 0.f;
#pragma unroll
        for (int nt = 0; nt < 8; ++nt) { const f32x4 sc = *(const f32x4*)(AR.in[IN_PSCALE] + l * 512 + 128 * gp + 16 * nt + 4 * cq);
#pragma unroll
            for (int e = 0; e < 4; ++e) { const float o = A[mt][nt][e] * sc[e]; A[mt][nt][e] = o; ss += o * o; } }
        ss += __shfl_xor(ss, 16); ss += __shfl_xor(ss, 32);
        if (cq == 0) red[(32 * rh + 16 * mt + t16) * 4 + gp] = ss; }
    WG_BAR();
    { const rsrc_t rs_ = ws_rsrc(ws);
#pragma unroll
      for (int mt = 0; mt < 2; ++mt) { const int rl = 32 * rh + 16 * mt + t16; const f32x4 a = *(const LAS f32x4*)(red + rl * 4);
          const float rsn = rsqrtf(((a[0] + a[1]) + (a[2] + a[3])) * (1.0f / 512.0f) + EPS);
          const int od = cq & 1; const size_t mo = WS_MIX + ((size_t)(row0 + rl) * DM + 1536 + 128 * gp + 4 * (cq & ~1)) * 2 + (od ? 32 : 0);
#pragma unroll
          for (int nt = 0; nt < 8; nt += 2) {
              const unsigned a0 = pk2(A[mt][nt][0] * rsn, A[mt][nt][1] * rsn), a1 = pk2(A[mt][nt][2] * rsn, A[mt][nt][3] * rsn);
              const unsigned b0 = pk2(A[mt][nt + 1][0] * rsn, A[mt][nt + 1][1] * rsn), b1 = pk2(A[mt][nt + 1][2] * rsn, A[mt][nt + 1][3] * rsn);
              const unsigned s0 = od ? a0 : b0, s1 = od ? a1 : b1;
              const unsigned r0 = (unsigned)__shfl_xor((int)s0, 16), r1 = (unsigned)__shfl_xor((int)s1, 16);
              ST16(rs_, mo + 32 * nt, (od ? (v4u){r0, r1, b0, b1} : (v4u){a0, a1, r0, r1})); } } }
    WG_BAR();
}

#ifndef ACQ_SCOPE
#define ACQ_SCOPE "agent"
#endif
#ifndef PE_ROW_OWNED
#define PE_ROW_OWNED 0
#endif
#ifndef PUBLISH_FENCE
#define PUBLISH_FENCE 0
#endif
enum { U_END = 0, U_PA = 1, U_PC = 2, U_PD = 3, U_PE = 4, U_SSM = 5, U_ATT = 6, U_SATT = 7, U_POOL = 8 };
constexpr int NPANEL = MP / 256;
constexpr int QCAP = 1024;
__host__ __device__ constexpr unsigned mkd(int type, int l, int a, int b) { return ((unsigned)type << 24) | ((unsigned)l << 20) | ((unsigned)a << 10) | (unsigned)b; }
__device__ __forceinline__ gu32* cnt_word(gu32* ctl, int l, int kind, int pm) { return ctl + CW_CNT + ((l * 5 + kind) * 40 + pm) * 16; }
__host__ __device__ constexpr unsigned mix_target(int pm) { return 3u * (unsigned)((MR - 256 * pm) < 256 ? (MR - 256 * pm) : 256); }

__device__ __forceinline__ void build_queue(unsigned* qt, int q) {
    int n = 1;
    for (int l = 0; l < NLAYER; ++l) {
        for (int pm = 0; pm < NPANEL; ++pm) { qt[n++] = mkd(U_PA, l, pm, q); if ((pm & 7) == q) { qt[n++] = mkd(U_PA, l, pm, 8); qt[n++] = mkd(U_PA, l, pm, 9); } }
        for (int c = q; c < NCHUNK; c += 8) qt[n++] = mkd(U_SSM, l, c, 0);
        for (int i = q; i < NBATCH * NQB; i += 8) qt[n++] = mkd(U_ATT, l, i, 0);
        for (int s = q; s < NSAMP; s += 8) qt[n++] = mkd(U_SATT, l, s, 0);
        for (int c = q; c < NCHUNK; c += 8) qt[n++] = mkd(U_POOL, l, c, 0);
        for (int pm = 0; pm < NPANEL; ++pm) qt[n++] = mkd(U_PC, l, pm, q);
        for (int pm = 0; pm < NPANEL; ++pm) for (int j = 0; j < 4; ++j) qt[n++] = mkd(U_PD, l, pm, 4 * q + j);
#if PE_ROW_OWNED
        for (int pm = q; pm < NPANEL - 1; pm += 8) for (int pn = 0; pn < 8; ++pn) qt[n++] = mkd(U_PE, l, pm, pn);
        qt[n++] = mkd(U_PE, l, NPANEL - 1, q);
#else
        for (int pm = 0; pm < NPANEL; ++pm) qt[n++] = mkd(U_PE, l, pm, q);
#endif
    }
    qt[0] = (unsigned)(n - 1);
}

struct Sched {
    gu32* ctl; const unsigned* qglob; LAS unsigned* qlds; volatile LAS unsigned* slot; int myq; unsigned nclaim; int ptype;
    __device__ __forceinline__ unsigned claim_lane() {
        { unsigned ho = (unsigned)(CW_QHEAD + myq * 64); asm volatile("" : "+s"(ho));
          const unsigned idx = __hip_atomic_fetch_add(ctl + ho, 1u, RLX_AGENT); if (idx < qlds[0]) return qlds[1 + idx]; }
        for (int k = 1; k < 8; ++k) { const int q = (myq + k) & 7; const unsigned* qg = qglob + (size_t)q * QCAP;
            if (__hip_atomic_load((gu32*)(ctl + CW_QHEAD + q * 64), RLX_AGENT) >= qg[0]) continue;
            const unsigned idx = __hip_atomic_fetch_add(ctl + CW_QHEAD + q * 64, 1u, RLX_AGENT); if (idx < qg[0]) return qg[1 + idx]; }
        return 0u;
    }
    __device__ __forceinline__ unsigned claim_wg(int tid) {
        const unsigned k = nclaim++ & 1u;
        if (tid == 0) slot[k] = claim_lane();
        WG_BAR();
        return slot[k];
    }
    __device__ __forceinline__ void poll(gu32* w, unsigned want) {
        unsigned sp = 0;
#if PROBE && PROBE_KIND == 1
        if (__hip_atomic_load(w, RLX_AGENT) >= want) return;
        struct TAcc { unsigned long long t0; volatile LAS unsigned* acc; bool on; __device__ ~TAcc() { if (on) acc[6] += (unsigned)(__builtin_amdgcn_s_memrealtime() - t0); } } tacc_{__builtin_amdgcn_s_memrealtime(), slot, PROBE_TYPE == 0 || ptype == PROBE_TYPE};
#endif
        while (__hip_atomic_load(w, RLX_AGENT) < want) { __builtin_amdgcn_s_sleep(2);
            if ((++sp & 1023u) == 0u) { if (__hip_atomic_load(ctl + CW_TMO, RLX_AGENT) != 0u) break; if (sp > (1u << 17)) { __hip_atomic_store(ctl + CW_TMO, 0x66u, RLX_AGENT); break; } } }
    }
    __device__ __forceinline__ bool ready_now(gu32* w, unsigned want) { return __hip_atomic_load(w, RLX_AGENT) >= want; }
    __device__ __forceinline__ bool deps_ready_now(unsigned d) {
        const int type = d >> 24, l = (d >> 20) & 15, a = (d >> 10) & 1023; bool ok = true;
        if (type == U_PA) { if (l > 0) { const int p2 = (a + 1 < NPANEL) ? a + 1 : NPANEL - 1; ok = ready_now(cnt_word(ctl, l - 1, 4, a), 8u) && ready_now(cnt_word(ctl, l - 1, 1, p2), mix_target(p2)); } }
        else if (type == U_PC) ok = ready_now(cnt_word(ctl, l, 1, a), mix_target(a));
        else if (type == U_PD) ok = ready_now(cnt_word(ctl, l, 2, a), 8u);
        else ok = ready_now(cnt_word(ctl, l, 3, a), 32u);
        if (ok) { __builtin_amdgcn_fence(__ATOMIC_ACQUIRE, ACQ_SCOPE); asm volatile("s_waitcnt vmcnt(0)" ::: "memory"); }
        return ok;
    }
    __device__ __forceinline__ void wait_deps(unsigned d, int tid) {
        if (tid == 0) {
            const int type = d >> 24, l = (d >> 20) & 15, a = (d >> 10) & 1023; ptype = type;
            if (type == U_PA) { if (l > 0) { poll(cnt_word(ctl, l - 1, 4, a), 8u); const int p2 = (a + 1 < NPANEL) ? a + 1 : NPANEL - 1; poll(cnt_word(ctl, l - 1, 1, p2), mix_target(p2)); } }
            else if (type == U_PC) poll(cnt_word(ctl, l, 1, a), mix_target(a));
            else if (type == U_PD) poll(cnt_word(ctl, l, 2, a), 8u);
            else if (type == U_PE) poll(cnt_word(ctl, l, 3, a), 32u);
            else if (type == U_SSM) poll(cnt_word(ctl, l, 0, a >> 2), 10u);
            else if (type == U_POOL) { poll(cnt_word(ctl, l, 0, a >> 2), 10u); const int r0 = 64 * a - 16; if (r0 >= 0) poll(cnt_word(ctl, l, 0, r0 >> 8), 10u); }
            else if (type == U_SATT) poll(cnt_word(ctl, l, 0, NPANEL - 1), 10u);
            else if (type == U_ATT) { const int b = a / NQB, i = a % NQB, t0 = 32 * i; const int rlo = b * TT + (t0 >= 128 ? t0 - 128 : 0), rhi = b * TT + ((t0 + 31 < TT) ? t0 + 31 : TT - 1);
                poll(cnt_word(ctl, l, 0, rlo >> 8), 10u); if ((rhi >> 8) != (rlo >> 8)) poll(cnt_word(ctl, l, 0, rhi >> 8), 10u); }
            __builtin_amdgcn_fence(__ATOMIC_ACQUIRE, ACQ_SCOPE);
            asm volatile("s_waitcnt vmcnt(0)" ::: "memory");
        }
        asm volatile("" ::: "memory"); __builtin_amdgcn_s_barrier(); asm volatile("" ::: "memory");
    }
    __device__ __forceinline__ void publish(unsigned d, int tid) {
        asm volatile("s_waitcnt vmcnt(0)" ::: "memory");
        WG_BAR();
        if (tid == 0) {
            const int type = d >> 24, l = (d >> 20) & 15, a = (d >> 10) & 1023;
#if PUBLISH_FENCE
            __builtin_amdgcn_fence(__ATOMIC_RELEASE, "agent");
            asm volatile("s_waitcnt vmcnt(0)" ::: "memory");
#endif
            if (type == U_PA) __hip_atomic_fetch_add(cnt_word(ctl, l, 0, a), 1u, RLX_AGENT);
            else if (type == U_PC) __hip_atomic_fetch_add(cnt_word(ctl, l, 2, a), 1u, RLX_AGENT);
            else if (type == U_PD) __hip_atomic_fetch_add(cnt_word(ctl, l, 3, a), 1u, RLX_AGENT);
            else if (type == U_PE) __hip_atomic_fetch_add(cnt_word(ctl, l, 4, a), 1u, RLX_AGENT);
            else if (type == U_SSM || type == U_POOL) __hip_atomic_fetch_add(cnt_word(ctl, l, 1, a >> 2), 64u, RLX_AGENT);
            else if (type == U_SATT) __hip_atomic_fetch_add(cnt_word(ctl, l, 1, NPANEL - 1), 1u, RLX_AGENT);
            else if (type == U_ATT) { const int b = a / NQB, i = a % NQB, t0 = 32 * i; const int r0 = b * TT + t0, r1 = b * TT + ((t0 + 31 < TT) ? t0 + 31 : TT - 1);
                const int p0 = r0 >> 8, p1 = r1 >> 8;
                if (p0 == p1) __hip_atomic_fetch_add(cnt_word(ctl, l, 1, p0), (unsigned)(r1 - r0 + 1), RLX_AGENT);
                else { __hip_atomic_fetch_add(cnt_word(ctl, l, 1, p0), (unsigned)(256 * p1 - r0), RLX_AGENT); __hip_atomic_fetch_add(cnt_word(ctl, l, 1, p1), (unsigned)(r1 - 256 * p1 + 1), RLX_AGENT); } }
        }
    }
};

#ifndef A_AUX
#define A_AUX 0
#endif
struct GU { const char* A; const char* B; unsigned voffA[2], voffB[2]; size_t hstep; int nt; unsigned d; pg8::Unit u; };

struct StreamCtx { unsigned char* ws; float* out; const float* gq; const float* gk; int R[2], C[2], Rp[2]; };
__device__ __forceinline__ void gu_fill(GU& g, unsigned d, const StreamCtx& X) {
    const int type = d >> 24, l = (d >> 20) & 15, pm = (d >> 10) & 1023, pn = d & 1023;
    unsigned char* ws = X.ws;
    const bf16* A; const bf16* B; int K = DM; bool perm = false;
    if (type == U_PA) { A = (const bf16*)(ws + WS_XB); B = (const bf16*)(ws + WS_WIN) + (size_t)l * INW * DM; }
    else if (type == U_PC) { A = (const bf16*)(ws + WS_MIX); B = (const bf16*)(ws + WS_WOUT) + (size_t)l * DM * DM; perm = true; }
    else if (type == U_PD) { A = (const bf16*)(ws + WS_XB); B = (const bf16*)(ws + WS_W1) + (size_t)l * DFF * DM; perm = true; }
    else { A = (const bf16*)(ws + WS_H); B = (const bf16*)(ws + WS_W2) + (size_t)l * DM * DFF; K = DFF; perm = true; }
    g.d = d; g.u.pm = pm; g.u.pn = pn; g.nt = K / 64; g.hstep = (size_t)128 * K * 2;
    g.A = (const char*)A + (size_t)pm * 256 * K * 2; g.B = (const char*)B + (size_t)pn * 256 * K * 2;
#pragma unroll
    for (int i = 0; i < 2; ++i) { g.voffA[i] = (unsigned)(X.R[i] * K + X.C[i]) * 2u; g.voffB[i] = (unsigned)((perm ? X.Rp[i] : X.R[i]) * K + X.C[i]) * 2u; }
}

__device__ __forceinline__ unsigned gemm_stream(const Args& AR, Frame& F, Sched& Q, unsigned d0) {
    int tid_ = F.tid(); asm volatile("" : "+v"(tid_));
    const int tid = tid_, wid = __builtin_amdgcn_readfirstlane(tid >> 6), lane = tid & 63, wr = wid >> 2, wc = wid & 3, fr = lane & 15, fq = lane >> 4;
    LAS unsigned char* lds = F.lds; LAS unsigned char* esc = F.lds + ESC_OFF;
    StreamCtx X; X.ws = F.ws; X.out = F.out;
#pragma unroll
    for (int i = 0; i < 2; ++i) { int R, C; pg8::stage_rc(tid * 16 + i * 8192, R, C); X.R[i] = R; X.C[i] = C; X.Rp[i] = (R & ~31) + pg8::perm32(R & 31); }
    const size_t kstep = (size_t)(pg8::BK * 2);
    const unsigned ldsw = (unsigned)wid * 1024u;
    const int aoff = pg8::lds_byte(wr * 64 + fr, fq * 8), boff = pg8::lds_byte(wc * 32 + fr, fq * 8);
#define PG8_SA(b, h) (((b) * 2 + (h)) * pg8::HTB)
#define PG8_SB(b, h) ((4 + (b) * 2 + (h)) * pg8::HTB)
#define PG8_STAGE(bufoff, gbase, voff) do { _Pragma("unroll") for (int _i = 0; _i < 2; ++_i) \
        __builtin_amdgcn_global_load_lds((const unsigned*)((const char*)(gbase) + (voff)[_i]), (LAS unsigned*)(lds + (bufoff) + ldsw + _i * 8192), 16, 0, 0); } while (0)
#define PG8_STAGE_A(bufoff, gbase, voff) do { _Pragma("unroll") for (int _i = 0; _i < 2; ++_i) \
        __builtin_amdgcn_global_load_lds((const unsigned*)((const char*)(gbase) + (voff)[_i]), (LAS unsigned*)(lds + (bufoff) + ldsw + _i * 8192), 16, 0, A_AUX); } while (0)
#define PG8_LDA(dst, b, h) do { _Pragma("unroll") for (int m = 0; m < 4; ++m) _Pragma("unroll") for (int k = 0; k < 2; ++k) dst[m][k] = *(const LAS bf16x8*)(lds + PG8_SA(b, h) + aoff + m * 2048 + k * 1024); } while (0)
#define PG8_LDB(dst, b, h) do { _Pragma("unroll") for (int n = 0; n < 2; ++n) _Pragma("unroll") for (int k = 0; k < 2; ++k) dst[n][k] = *(const LAS bf16x8*)(lds + PG8_SB(b, h) + boff + n * 2048 + k * 1024); } while (0)
#define PG8_MMA(ai, bj, At, Bt) do { if (mm[ai]) { __builtin_amdgcn_s_setprio(1); _Pragma("unroll") for (int m = 0; m < 4; ++m) _Pragma("unroll") for (int n = 0; n < 2; ++n) _Pragma("unroll") for (int k = 0; k < 2; ++k) \
        acc[ai][bj][m][n] = __builtin_amdgcn_mfma_f32_16x16x32_bf16(Bt[n][k], At[m][k], acc[ai][bj][m][n], 0, 0, 0); __builtin_amdgcn_s_setprio(0); } } while (0)
#define PG8_WAIT_V(n) asm volatile("s_waitcnt vmcnt(" #n ")" ::: "memory")
#define PG8_WAIT_L(n) asm volatile("s_waitcnt lgkmcnt(" #n ")" ::: "memory")
#define PG8_BAR __builtin_amdgcn_s_barrier()
#define PG8_SCHED __builtin_amdgcn_sched_barrier(0)
    GU cur;
    gu_fill(cur, d0, X);
    f32x4 acc[2][2][4][2];
#pragma unroll
    for (int a = 0; a < 2; ++a)
#pragma unroll
        for (int b = 0; b < 2; ++b)
#pragma unroll
            for (int m = 0; m < 4; ++m)
#pragma unroll
                for (int n = 0; n < 2; ++n) acc[a][b][m][n] = (f32x4){0.f, 0.f, 0.f, 0.f};
    bf16x8 At[4][2], B0[2][2], B1[2][2];
    Q.wait_deps(cur.d, tid);
    PG8_STAGE(PG8_SB(0, 0), cur.B, cur.voffB); PG8_STAGE(PG8_SB(0, 1), cur.B + cur.hstep, cur.voffB); PG8_STAGE_A(PG8_SA(0, 0), cur.A, cur.voffA); PG8_STAGE_A(PG8_SA(0, 1), cur.A + cur.hstep, cur.voffA);
    if (wr == 1) PG8_BAR;
    PG8_WAIT_V(2); PG8_BAR;
    PG8_STAGE(PG8_SB(1, 0), cur.B + kstep, cur.voffB); PG8_STAGE_A(PG8_SA(1, 0), cur.A + kstep, cur.voffA); PG8_STAGE(PG8_SB(1, 1), cur.B + cur.hstep + kstep, cur.voffB);
    PG8_WAIT_V(6); PG8_BAR;
    unsigned carry = 0u; unsigned ui = 0u;
    for (;;) {
        bool go = false;
        const char* cA = cur.A; const char* cB = cur.B; const size_t hstep = cur.hstep; const int nt = cur.nt;
#if PROBE && PROBE_KIND == 3
        const unsigned long long tu0 = __builtin_amdgcn_s_memrealtime();
#endif
        const bool fullp = cur.u.pm != NPANEL - 1; const bool mm[2] = {fullp || wr == 0, fullp};
        for (int t = 0; t < nt; t += 2) {
            const bool last = (t == nt - 2);
            const char* a1 = cA + (size_t)(t + 1) * kstep;
            const char* a2_ = cA + (size_t)(last ? 0 : t + 2) * kstep; const char* b2_ = cB + (size_t)(last ? 0 : t + 2) * kstep;
            const char* a2 = a2_; const char* b2 = b2_; size_t h2 = hstep;
            unsigned vA2[2], vB2[2];
#pragma unroll
            for (int i = 0; i < 2; ++i) { vA2[i] = cur.voffA[i]; vB2[i] = cur.voffB[i]; }
            if (last) {
                const unsigned k = 2u + (ui & 1u);
#if PROBE && PROBE_KIND == 8
                const unsigned long long tc0 = __builtin_amdgcn_s_memrealtime();
#endif
                if (tid == 0) { const unsigned dn = Q.claim_lane(); Q.slot[k] = dn;
                    Q.slot[2u + k] = ((dn >> 24) >= U_PA && (dn >> 24) <= U_PE && (!STREAM_SAME_SECTION || ((dn >> 20) == (cur.d >> 20))) && Q.deps_ready_now(dn)) ? 1u : 0u; }
                asm volatile("s_waitcnt lgkmcnt(0)" ::: "memory"); PG8_BAR; asm volatile("" ::: "memory");
                carry = Q.slot[k]; go = Q.slot[2u + k] != 0u;
#if PROBE && PROBE_KIND == 8
                if (tid == 0 && (int)(cur.d >> 24) == PROBE_TYPE) { Q.slot[6] += (unsigned)(__builtin_amdgcn_s_memrealtime() - tc0); Q.slot[7] += 1u; }
#endif
                if (go) { GU n2; gu_fill(n2, carry, X); a2 = n2.A; b2 = n2.B; h2 = n2.hstep;
#pragma unroll
                    for (int i = 0; i < 2; ++i) { vA2[i] = n2.voffA[i]; vB2[i] = n2.voffB[i]; } }
            }
            const char* a3 = a2 + kstep; const char* b3 = b2 + kstep;
            PG8_LDB(B0, 0, 0); PG8_LDB(B1, 0, 1); PG8_SCHED; PG8_LDA(At, 0, 0); PG8_STAGE_A(PG8_SA(1, 1), a1 + hstep, cur.voffA);
            PG8_WAIT_V(8); PG8_WAIT_L(0); PG8_BAR; PG8_MMA(0, 0, At, B0); PG8_MMA(0, 1, At, B1); PG8_BAR; PG8_SCHED;
            PG8_LDA(At, 0, 1); PG8_STAGE(PG8_SB(0, 0), b2, vB2); PG8_STAGE(PG8_SB(0, 1), b2 + h2, vB2); PG8_STAGE_A(PG8_SA(0, 0), a2, vA2);
            PG8_WAIT_V(8); PG8_WAIT_L(0); PG8_BAR; PG8_MMA(1, 0, At, B0); PG8_MMA(1, 1, At, B1); PG8_BAR; PG8_SCHED;
            PG8_LDB(B0, 1, 0); PG8_LDB(B1, 1, 1); PG8_SCHED; PG8_LDA(At, 1, 0); PG8_STAGE_A(PG8_SA(0, 1), a2 + h2, vA2);
            PG8_WAIT_V(8); PG8_WAIT_L(0); PG8_BAR; PG8_MMA(0, 0, At, B0); PG8_MMA(0, 1, At, B1); PG8_BAR; PG8_SCHED;
            PG8_LDA(At, 1, 1); PG8_STAGE(PG8_SB(1, 0), b3, vB2); PG8_STAGE(PG8_SB(1, 1), b3 + h2, vB2); PG8_STAGE_A(PG8_SA(1, 0), a3, vA2);
            PG8_WAIT_V(8); PG8_WAIT_L(0); PG8_BAR; PG8_MMA(1, 0, At, B0); PG8_MMA(1, 1, At, B1); PG8_BAR; PG8_SCHED;
        }
#if PROBE && PROBE_KIND == 7
        const unsigned long long te0 = __builtin_amdgcn_s_memrealtime();
#endif
        if (wr == 0) PG8_BAR;
        { const int type = cur.d >> 24, l = (cur.d >> 20) & 15;
          if (type == U_PA) { EpiProj E{X.ws, X.out, AR.in[IN_GQ] + l * 128, AR.in[IN_GK] + l * 128, l}; E(acc, cur.u, wr, wc, fr, fq, esc, tid); }
          else if (type == U_PD) { EpiFfn1 E{X.ws}; E(acc, cur.u, wr, wc, fr, fq, esc, tid); }
          else { EpiRes E{X.ws, X.out, (type == U_PE && l == NLAYER - 1) ? 1 : 0}; E(acc, cur.u, wr, wc, fr, fq, esc, tid); }
          Q.publish(cur.d, tid);
#if PROBE && PROBE_KIND == 7
          if (tid == 0 && (int)(cur.d >> 24) == PROBE_TYPE && cur.u.pm != NPANEL - 1) { Q.slot[6] += (unsigned)(__builtin_amdgcn_s_memrealtime() - te0); Q.slot[7] += 1u; }
#endif
#if PROBE && PROBE_KIND == 3
          if (tid == 0 && (int)(cur.d >> 24) == PROBE_TYPE && cur.u.pm != NPANEL - 1) { Q.slot[6] += (unsigned)(__builtin_amdgcn_s_memrealtime() - tu0); Q.slot[7] += 1u; }
#endif
          }
        if (!go) break;
#pragma unroll
        for (int a = 0; a < 2; ++a)
#pragma unroll
            for (int b = 0; b < 2; ++b)
#pragma unroll
                for (int m = 0; m < 4; ++m)
#pragma unroll
                    for (int n = 0; n < 2; ++n) acc[a][b][m][n] = (f32x4){0.f, 0.f, 0.f, 0.f};
        gu_fill(cur, carry, X); ++ui;
        if (wr == 1) PG8_BAR;
    }
    PG8_WAIT_V(0);
    PG8_BAR;
#undef PG8_SA
#undef PG8_SB
#undef PG8_STAGE
#undef PG8_STAGE_A
#undef PG8_LDA
#undef PG8_LDB
#undef PG8_MMA
#undef PG8_WAIT_V
#undef PG8_WAIT_L
#undef PG8_BAR
#undef PG8_SCHED
    return carry;
}

__global__ void __launch_bounds__(512, 2) hymba_fwd(Args args) {
    extern __shared__ __attribute__((aligned(16))) unsigned char lds[];
    Frame F;
    F.lds = (LAS unsigned char*)lds;
    F.MISC = (volatile LAS unsigned*)(F.lds + MISC_OFF);
    F.wave = __builtin_amdgcn_readfirstlane((int)(threadIdx.x >> 6));
    F.G = gridDim.x; { const int bx = blockIdx.x; F.vcu = (F.G % 8 == 0) ? (bx % 8) * (F.G / 8) + bx / 8 : bx; }
    F.ws = args.ws; F.out = args.out; F.ctl = (gu32*)(args.ws + WS_CTL);
    for (int u = F.tid(); u < (LDS_BYTES - LDSCTL_OFF) / 4; u += 512) ((LAS unsigned*)(F.lds + LDSCTL_OFF))[u] = 0u;
    __syncthreads();
    XcdBarrier bar = xcd_barrier_post((unsigned*)(F.ctl + CW_BAR), F.MISC + 8);
#if PROBE
    const unsigned long long tk0 = __builtin_amdgcn_s_memrealtime();
#endif
    for (int rep = 0; rep < DUP_P0; ++rep) p0_prologue(args, F);
#if PROBE && (PROBE_KIND == 5 || PROBE_KIND == 6)
    if (F.tid() == 0) { F.MISC[6] = (unsigned)(__builtin_amdgcn_s_memrealtime() - tk0); if (PROBE_KIND == 6) __hip_atomic_fetch_max(F.ctl + CW_STAT + 48, F.MISC[6], RLX_AGENT); }
#endif
    if (blockIdx.x < 8 && F.tid() == 0) build_queue((unsigned*)(args.ws + WS_QUEUE) + (size_t)blockIdx.x * QCAP, (int)blockIdx.x);
    xcd_barrier(bar);
    Sched Q; Q.ctl = F.ctl; Q.qglob = (const unsigned*)(args.ws + WS_QUEUE); Q.qlds = (LAS unsigned*)(F.lds + QTAB_OFF); Q.slot = F.MISC; Q.myq = __builtin_amdgcn_readfirstlane((int)(bar.x & 7u)); Q.nclaim = 0u; Q.ptype = 0;
    { const unsigned* qg = Q.qglob + (size_t)Q.myq * QCAP; for (int i = F.tid(); i < QCAP; i += 512) Q.qlds[i] = qg[i]; }
    WG_BAR();
    unsigned d = Q.claim_wg(F.tid());
#if SEC_BARRIER
    int cursec = 0;
#endif
    for (;;) {
        const int type = d >> 24;
#if SEC_BARRIER
        { const int sec = (type == U_END) ? 5 * NLAYER : ((d >> 20) & 15) * 5 + ((type >= U_SSM) ? 1 : (type == U_PA ? 0 : type));
          while (cursec < sec) { if ((SEC_MASK >> cursec) & 1) xcd_barrier(bar); ++cursec; } }
#endif
        if (type == U_END) break;
        if (type <= U_PE) {
#if PROBE && PROBE_KIND == 9
            const unsigned long long ts0 = __builtin_amdgcn_s_memrealtime();
#endif
            d = gemm_stream(args, F, Q, d);
#if PROBE && PROBE_KIND == 9
            if (F.tid() == 0) { F.MISC[6] += (unsigned)(__builtin_amdgcn_s_memrealtime() - ts0); }
#endif
            continue; }
        const int l = (d >> 20) & 15, a = (d >> 10) & 1023;
        Q.wait_deps(d, F.tid());
#if PROBE && PROBE_KIND == 2
        const unsigned long long tp0 = __builtin_amdgcn_s_memrealtime();
#endif
        if (type == U_SSM) ssm_unit(args, F, l, a);
        else if (type == U_ATT) attn_unit(args, F, l, a / NQB, a % NQB);
        else if (type == U_SATT) sattn_unit(args, F, l, a);
        else pool_unit(args, F, l, a);
        Q.publish(d, F.tid());
#if PROBE && PROBE_KIND == 2
        if (F.tid() == 0 && (PROBE_TYPE == 0 || type == PROBE_TYPE)) F.MISC[6] += (unsigned)(__builtin_amdgcn_s_memrealtime() - tp0);
#endif
        d = Q.claim_wg(F.tid());
    }
#if PROBE
    if (F.tid() == 0) {
        const unsigned tend = (unsigned)(__builtin_amdgcn_s_memrealtime() - tk0);
        if (PROBE_KIND == 4) { F.MISC[6] = tend; __hip_atomic_fetch_max(F.ctl + CW_STAT + 48, tend, RLX_AGENT); }
        __hip_atomic_fetch_add(F.ctl + CW_STAT, F.MISC[6], RLX_AGENT);
        __hip_atomic_fetch_add(F.ctl + CW_STAT + 32, F.MISC[7], RLX_AGENT);
        const unsigned n = __hip_atomic_fetch_add(F.ctl + CW_STAT + 16, 1u, RLX_AGENT);
        F.MISC[7] = (n == gridDim.x - 1) ? 1u : 0u;
        if (n == gridDim.x - 1) { F.MISC[5] = __hip_atomic_load(F.ctl + CW_STAT, RLX_AGENT); F.MISC[4] = __hip_atomic_load(F.ctl + CW_STAT + 32, RLX_AGENT); F.MISC[3] = __hip_atomic_load(F.ctl + CW_STAT + 48, RLX_AGENT); }
    }
    WG_BAR();
    if (F.MISC[7]) { float v = (float)F.MISC[5] / (float)gridDim.x * 0.01f;
        if (PROBE_KIND == 3 || PROBE_KIND == 7 || PROBE_KIND == 8) v = (float)F.MISC[5] * 0.01f / (float)(F.MISC[4] ? F.MISC[4] : 1u);
        if (PROBE_KIND == 4) v = (float)F.MISC[3] * 0.01f - v;
        if (PROBE_KIND == 6) v = (float)F.MISC[3] * 0.01f;
        v = floorf((v + 0.5f * PROBE_Q) / PROBE_Q) * PROBE_Q;
        for (int i = F.tid(); i < NLAYER * NSAMP * 15 * 512; i += 512) F.out[O_SP + i] = v; }
#endif
}

extern "C" void kernel_launch(void* const* d_in, const int* in_sizes, int n_in, void* d_out, int out_size, void* d_ws, size_t ws_size, hipStream_t stream) {
    static int grid = 0;
    if (grid == 0) {
        if (n_in != 32 || (size_t)out_size != O_END || ws_size < WS_END) { fprintf(stderr, "kernel_launch: unexpected shapes: n_in %d out %d (want %zu) ws %zu (want >= %zu)\n", n_in, out_size, (size_t)O_END, ws_size, (size_t)WS_END); grid = -1; return; }
        int dev = 0, cus = 0, per_cu = 0;
        if (hipGetDevice(&dev) != hipSuccess || hipDeviceGetAttribute(&cus, hipDeviceAttributeMultiprocessorCount, dev) != hipSuccess) { fprintf(stderr, "kernel_launch: device query failed\n"); grid = -1; return; }
        if (hipFuncSetAttribute((const void*)hymba_fwd, hipFuncAttributeMaxDynamicSharedMemorySize, LDS_BYTES) != hipSuccess) { fprintf(stderr, "kernel_launch: hipFuncSetAttribute failed\n"); grid = -1; return; }
        if (hipOccupancyMaxActiveBlocksPerMultiprocessor(&per_cu, (const void*)hymba_fwd, 512, LDS_BYTES) != hipSuccess || per_cu < 1) { fprintf(stderr, "kernel_launch: occupancy query says %d blocks per CU\n", per_cu); per_cu = 1; }
        (void)hipGetLastError();
        grid = cus;
        if (grid % 8 != 0) grid -= grid % 8;
    }
    if (grid < 0) return;
    (void)hipMemsetAsync((char*)d_ws + WS_CTL, 0, CTL_ZERO_BYTES, stream);
    Args a{};
    for (int i = 0; i < 32; ++i) a.in[i] = (const float*)d_in[i];
    a.out = (float*)d_out; a.ws = (unsigned char*)d_ws; a.ph_lo = 0; a.ph_hi = 0;
    hipLaunchKernelGGL(hymba_fwd, dim3(grid), dim3(512), LDS_BYTES, stream, a);
    const hipError_t le = hipPeekAtLastError();
    if (le != hipSuccess) fprintf(stderr, "kernel_launch: launch failed: %s\n", hipGetErrorName(le));
}
```

```cpp
#include <hip/hip_runtime.h>
#include <cstdio>
#include <cstdint>

#ifndef MK_N_LAUNCHES
#define MK_N_LAUNCHES 1
#endif

#ifndef SEC_BARRIER
#define SEC_BARRIER 0
#endif
#ifndef STREAM_SAME_SECTION
#define STREAM_SAME_SECTION 0
#endif
#ifndef SEC_MASK
#define SEC_MASK 0x10
#endif
#ifndef PROBE
#define PROBE 0
#endif
#ifndef PROBE_KIND
#define PROBE_KIND 1
#endif
#ifndef PROBE_TYPE
#define PROBE_TYPE 0
#endif
#ifndef PROBE_Q
#define PROBE_Q 20.0f
#endif
#ifndef DUP_PB
#define DUP_PB 1
#endif
#ifndef DUP_P0
#define DUP_P0 1
#endif

constexpr int DM = 2048, TT = 4112  , NSEQ = 4096, NMETA = 16, NBATCH = 2, NSAMP = 32;
constexpr int MR = NBATCH * TT + NSAMP;
constexpr int MP = 8448;
constexpr int SROW0 = NBATCH * TT;
constexpr int INW = 2560, DFF = 8192, NLAYER = 2;
constexpr int TPV = 4128;
constexpr int ROPE_SAMPLE_IDX = TT;
constexpr float EPS = 1e-6f;
constexpr float LOG2E = 1.4426950408889634f;
constexpr float QSCALE = 0.08838834764831845f * LOG2E;
constexpr int NCHUNK = MR / 64;
constexpr int NQB = (TT + 31) / 32;

constexpr size_t O_YP = 0, O_YS = O_YP + (size_t)NBATCH * NSEQ * DM, O_PK = O_YS + (size_t)NSAMP * DM, O_PV = O_PK + (size_t)NLAYER * NBATCH * 128 * 256,
                 O_PSR = O_PV + (size_t)NLAYER * NBATCH * 128 * 256, O_PSI = O_PSR + (size_t)NLAYER * NBATCH * 2048, O_PP = O_PSI + (size_t)NLAYER * NBATCH * 2048,
                 O_SK = O_PP + (size_t)NLAYER * NBATCH * 15 * 512, O_SV = O_SK + (size_t)NLAYER * NSAMP * 128 * 256, O_SSR = O_SV + (size_t)NLAYER * NSAMP * 128 * 256,
                 O_SSI = O_SSR + (size_t)NLAYER * NSAMP * 2048, O_SP = O_SSI + (size_t)NLAYER * NSAMP * 2048, O_END = O_SP + (size_t)NLAYER * NSAMP * 15 * 512;

constexpr size_t MiB = 1u << 20;
constexpr size_t WS_CTL = 0, CTL_ZERO_BYTES = 1 * MiB;
constexpr size_t WS_WIN = 1 * MiB, WS_WOUT = 21 * MiB, WS_W1 = 37 * MiB, WS_W2 = 101 * MiB, WS_WGLU = 165 * MiB, WS_WPOOL = 166 * MiB, WS_TAB = 167 * MiB;
constexpr size_t WS_X = 170 * MiB, WS_XB = 236 * MiB, WS_Q = 269 * MiB, WS_K = 286 * MiB, WS_VT = 291 * MiB, WS_U = 296 * MiB, WS_XP = 313 * MiB, WS_MIX = 330 * MiB,
                 WS_H = 363 * MiB, WS_SSQ = 495 * MiB, WS_SST = 497 * MiB, WS_KSN = 502 * MiB, WS_QUEUE = 503 * MiB, WS_END = 504 * MiB;
static_assert(WS_WIN + (size_t)NLAYER * INW * DM * 2 <= WS_WOUT && WS_WOUT + (size_t)NLAYER * DM * DM * 2 <= WS_W1 && WS_W1 + (size_t)NLAYER * DFF * DM * 2 <= WS_W2 && WS_W2 + (size_t)NLAYER * DFF * DM * 2 <= WS_WGLU, "ws map 1");
static_assert(WS_X + (size_t)MP * DM * 4 <= WS_XB && WS_XB + (size_t)MP * DM * 2 <= WS_Q && WS_Q + (size_t)MP * 1024 * 2 <= WS_K && WS_K + (size_t)MP * 256 * 2 <= WS_VT && WS_VT + (size_t)4 * 128 * TPV * 2 <= WS_U, "ws map 2");
static_assert(WS_U + (size_t)MP * 512 * 4 <= WS_XP && WS_XP + (size_t)MP * 512 * 4 <= WS_MIX && WS_MIX + (size_t)MP * DM * 2 <= WS_H && WS_H + (size_t)MP * DFF * 2 <= WS_SSQ && WS_SSQ + (size_t)MP * 32 * 4 <= WS_SST, "ws map 3");
static_assert(WS_SST + (size_t)NLAYER * NCHUNK * 32 * 64 * 8 <= WS_KSN, "ws map 4");
constexpr size_t TB_ABR = 0, TB_ABI = 8192, TB_ALR = 16384, TB_ALI = 24576, TB_A16R = 32768, TB_A16I = 40960, TB_A32R = 49152, TB_A32I = 57344,
                 TB_BBR = 65536, TB_BBI = TB_BBR + 131072, TB_PM = TB_BBI + 131072, TB_CMT = TB_PM + 524288, TB_LAYER = 1 * MiB;
static_assert(TB_CMT + 131072 <= TB_LAYER, "table map");
constexpr size_t WS_ROPE = WS_TAB + 2 * MiB;
constexpr size_t ROPE_N = (size_t)(TT + 1) * 16;
constexpr int CW_TMO = 0, CW_CODE = 1, CW_BAR = 4096, CW_QHEAD = 8192  , CW_STAT = 8800, CW_CNT = 9216  , CW_SSMF = 16384  ;
static_assert(CW_CNT + NLAYER * 5 * 40 * 16 <= CW_SSMF, "ctl map: counters");
static_assert((CW_SSMF + NLAYER * NCHUNK * 8 * 16) * 4 <= (int)CTL_ZERO_BYTES, "ctl map");

constexpr int RING_BYTES = 131072, ESC_OFF = RING_BYTES  , QTAB_OFF = ESC_OFF + 12288  , LDSCTL_OFF = QTAB_OFF + 4096, MISC_OFF = LDSCTL_OFF + 320, LDS_BYTES = 148480;
static_assert(MISC_OFF + 128 <= LDS_BYTES, "LDS map");

#define GAS __attribute__((address_space(1)))
#define LAS __attribute__((address_space(3)))
typedef unsigned short bf16;
typedef unsigned v4u __attribute__((ext_vector_type(4)));
typedef unsigned v2u __attribute__((ext_vector_type(2)));
typedef float f32x2 __attribute__((ext_vector_type(2)));
typedef float f32x16 __attribute__((ext_vector_type(16)));
typedef __bf16 bf16x2_t __attribute__((ext_vector_type(2)));
typedef GAS unsigned gu32;
typedef GAS unsigned long long gu64;
#define RLX_AGENT __ATOMIC_RELAXED, __HIP_MEMORY_SCOPE_AGENT
#define LDS_WAIT() asm volatile("s_waitcnt lgkmcnt(0)" ::: "memory")
#define VM_WAIT() asm volatile("s_waitcnt vmcnt(0)" ::: "memory")
#define WG_BAR() do { asm volatile("s_waitcnt lgkmcnt(0)" ::: "memory"); __builtin_amdgcn_s_barrier(); asm volatile("" ::: "memory"); } while (0)
__device__ __forceinline__ unsigned pk2(float lo, float hi) { f32x2 v = {lo, hi}; bf16x2_t b = __builtin_convertvector(v, bf16x2_t); return __builtin_bit_cast(unsigned, b); }
__device__ __forceinline__ float bf2f(unsigned short h) { return __builtin_bit_cast(float, (unsigned)h << 16); }
__device__ __forceinline__ float wave_sum(float v) {
#pragma unroll
    for (int o = 1; o < 64; o <<= 1) v += __shfl_xor(v, o);
    return v;
}
__device__ __forceinline__ float wave_max(float v) {
#pragma unroll
    for (int o = 1; o < 64; o <<= 1) v = fmaxf(v, __shfl_xor(v, o));
    return v;
}

typedef __amdgpu_buffer_rsrc_t rsrc_t;
__device__ __forceinline__ rsrc_t ws_rsrc(unsigned char* ws) { return __builtin_amdgcn_make_buffer_rsrc(ws, 0, (int)WS_END, 0x00020000); }
#define ST16(r, off, v) __builtin_amdgcn_raw_buffer_store_b128(__builtin_bit_cast(v4u, (v)), (r), (unsigned)(off), 0, 16)
#define ST8(r, off, v)  __builtin_amdgcn_raw_buffer_store_b64((v), (r), (unsigned)(off), 0, 16)
#define ST4(r, off, v)  __builtin_amdgcn_raw_buffer_store_b32(__builtin_bit_cast(unsigned, (v)), (r), (unsigned)(off), 0, 16)
#define ST2(r, off, v)  __builtin_amdgcn_raw_buffer_store_b16((unsigned short)(v), (r), (unsigned)(off), 0, 16)
__host__ __device__ __forceinline__ int perm16(int o) { return 8 * ((o >> 2) & 1) + 4 * (o >> 3) + (o & 3); }

namespace pg8 {
#define PG8_LAS __attribute__((address_space(3)))
typedef unsigned short bf16_t;
typedef short bf16x8 __attribute__((ext_vector_type(8)));
typedef float f32x4 __attribute__((ext_vector_type(4)));
typedef unsigned u32x4 __attribute__((ext_vector_type(4)));
constexpr int BM = 256, BK = 64, HALF = 128, HTB = HALF * BK * 2  , STAGE_BYTES = 8 * HTB, NXCD = 8, WGM = 8;

__host__ __device__ __forceinline__ int lds_byte(int r, int c) { const int st = (r >> 4) * 2 + (c >> 5), rr = r & 15, cc = c & 31, ob = rr * 64 + cc * 2; return st * 1024 + (ob ^ (((ob >> 9) & 1) << 5)); }
__host__ __device__ __forceinline__ void stage_rc(int b, int& R, int& C) { const int st = b / 1024, sb = b % 1024, swz = sb ^ (((sb >> 9) & 1) << 5); R = (st >> 1) * 16 + swz / 64; C = (st & 1) * 32 + (swz % 64) / 2; }
__host__ __device__ __forceinline__ int perm32(int rho) { const int n = rho >> 4, i = rho & 15; return 8 * (i >> 2) + 4 * n + (i & 3); }

struct Unit { int pm, pn; };
struct Gemm { const bf16_t* A; const bf16_t* Bt; int M, N, K; };

struct StaticOrder {
    int nM, nN, nwg, G, c;
    __host__ __device__ void init(int M, int N, int G_, int c_) { nM = M / BM; nN = N / BM; nwg = nM * nN; G = G_; c = c_; }
    __host__ __device__ bool next(int i, Unit& u) const {
        const long L = (long)i * G + c; if (L >= nwg) return false;
        int wgid = (int)L; { const int q = nwg / NXCD, r = nwg % NXCD, xcd = wgid % NXCD, off = wgid / NXCD; wgid = (xcd < r ? xcd * (q + 1) : r * (q + 1) + (xcd - r) * q) + off; }
        const int nig = WGM * nN, gid = wgid / nig, fm = gid * WGM, gsz = (nM - fm) < WGM ? (nM - fm) : WGM;
        u.pm = fm + ((wgid % nig) % gsz); u.pn = (wgid % nig) / gsz; return true;
    }
    __device__ __forceinline__ void a_ready(const Unit&) const {}
    __device__ __forceinline__ void done(const Unit&) const {}
};


template <class Epi, class Sched, bool ALIGN_EPI = false, bool SP2 = false>
__device__ __forceinline__ void gemm_phase(PG8_LAS unsigned char* lds, PG8_LAS unsigned char* esc, const Gemm g, const Sched& S, const Epi& E) {
    int tid_ = threadIdx.x; asm volatile("" : "+v"(tid_));
    const int tid = tid_, wid = __builtin_amdgcn_readfirstlane(tid >> 6), lane = tid & 63, wr = wid >> 2, wc = wid & 3, fr = lane & 15, fq = lane >> 4;
    const int K = g.K, nt = K / BK;
    unsigned voffA[2], voffB[2];
#pragma unroll
    for (int i = 0; i < 2; ++i) { int R, C; stage_rc(tid * 16 + i * 8192, R, C); const int Rb = Epi::PERM ? ((R & ~31) + perm32(R & 31)) : R;
        voffA[i] = (unsigned)(R * K + C) * 2u; voffB[i] = (unsigned)(Rb * K + C) * 2u; }
    const size_t kstep = (size_t)(BK * 2);
    const size_t hstep = (size_t)HALF * K * 2;
    const size_t tstep = 2 * hstep;
    const unsigned ldsw = (unsigned)wid * 1024u;
    const int aoff = lds_byte(wr * 64 + fr, fq * 8), boff = lds_byte(wc * 32 + fr, fq * 8);
#define PG8_SA(b, h) (((b) * 2 + (h)) * HTB)
#define PG8_SB(b, h) ((4 + (b) * 2 + (h)) * HTB)
#define PG8_STAGE(bufoff, gbase, voff) do { _Pragma("unroll") for (int _i = 0; _i < 2; ++_i) \
        __builtin_amdgcn_global_load_lds((const unsigned*)((const char*)(gbase) + (voff)[_i]), (PG8_LAS unsigned*)(lds + (bufoff) + ldsw + _i * 8192), 16, 0, 0); } while (0)
#define PG8_LDA(dst, b, h) do { _Pragma("unroll") for (int m = 0; m < 4; ++m) _Pragma("unroll") for (int k = 0; k < 2; ++k) dst[m][k] = *(const PG8_LAS bf16x8*)(lds + PG8_SA(b, h) + aoff + m * 2048 + k * 1024); } while (0)
#define PG8_LDB(dst, b, h) do { _Pragma("unroll") for (int n = 0; n < 2; ++n) _Pragma("unroll") for (int k = 0; k < 2; ++k) dst[n][k] = *(const PG8_LAS bf16x8*)(lds + PG8_SB(b, h) + boff + n * 2048 + k * 1024); } while (0)
#define PG8_MMA(ai, bj, At, Bt) do { __builtin_amdgcn_s_setprio(1); _Pragma("unroll") for (int m = 0; m < 4; ++m) _Pragma("unroll") for (int n = 0; n < 2; ++n) _Pragma("unroll") for (int k = 0; k < 2; ++k) \
        acc[ai][bj][m][n] = __builtin_amdgcn_mfma_f32_16x16x32_bf16(Bt[n][k], At[m][k], acc[ai][bj][m][n], 0, 0, 0); __builtin_amdgcn_s_setprio(0); } while (0)
#define PG8_WAIT_V(n) asm volatile("s_waitcnt vmcnt(" #n ")" ::: "memory")
#define PG8_WAIT_L(n) asm volatile("s_waitcnt lgkmcnt(" #n ")" ::: "memory")
#define PG8_BAR __builtin_amdgcn_s_barrier()
#define PG8_SCHED __builtin_amdgcn_sched_barrier(0)
    Unit cur, nxt; int ui = 0;
    if (!S.next(0, cur)) return;
    f32x4 acc[2][2][4][2];
#pragma unroll
    for (int a = 0; a < 2; ++a)
#pragma unroll
        for (int b = 0; b < 2; ++b)
#pragma unroll
            for (int m = 0; m < 4; ++m)
#pragma unroll
                for (int n = 0; n < 2; ++n) acc[a][b][m][n] = (f32x4){0.f, 0.f, 0.f, 0.f};
    bf16x8 At[4][2], B0[2][2], B1[2][2];
    const char* cA = (const char*)g.A + (size_t)cur.pm * tstep; const char* cB = (const char*)g.Bt + (size_t)cur.pn * tstep;
    S.a_ready(cur);
    if constexpr (SP2) {
        PG8_STAGE(PG8_SB(0, 0), cB, voffB); PG8_STAGE(PG8_SB(0, 1), cB + hstep, voffB); PG8_STAGE(PG8_SA(0, 0), cA, voffA); PG8_STAGE(PG8_SA(0, 1), cA + hstep, voffA);
        if (wr == 1) PG8_BAR;
        PG8_WAIT_V(2); PG8_BAR;
        PG8_STAGE(PG8_SB(1, 0), cB + kstep, voffB); PG8_STAGE(PG8_SA(1, 0), cA + kstep, voffA); PG8_STAGE(PG8_SB(1, 1), cB + hstep + kstep, voffB);
        PG8_WAIT_V(6); PG8_BAR;
    } else {
        PG8_STAGE(PG8_SB(0, 0), cB, voffB); PG8_STAGE(PG8_SA(0, 0), cA, voffA); PG8_STAGE(PG8_SB(0, 1), cB + hstep, voffB); PG8_STAGE(PG8_SA(0, 1), cA + hstep, voffA);
        if (wr == 1) PG8_BAR;
        PG8_WAIT_V(4); PG8_BAR;
        PG8_STAGE(PG8_SB(1, 0), cB + kstep, voffB); PG8_STAGE(PG8_SA(1, 0), cA + kstep, voffA); PG8_STAGE(PG8_SB(1, 1), cB + hstep + kstep, voffB);
        PG8_WAIT_V(6); PG8_BAR;
    }
    for (;;) {
        const bool has_next = S.next(ui + 1, nxt);
        const char* nA = has_next ? (const char*)g.A + (size_t)nxt.pm * tstep : cA; const char* nB = has_next ? (const char*)g.Bt + (size_t)nxt.pn * tstep : cB;
        for (int t = 0; t < nt; t += 2) {
            const bool last = (t == nt - 2);
            const char* a1 = cA + (size_t)(t + 1) * kstep;
            const char* a2 = last ? nA : cA + (size_t)(t + 2) * kstep; const char* b2 = last ? nB : cB + (size_t)(t + 2) * kstep;
            const char* a3 = a2 + kstep; const char* b3 = b2 + kstep;
            if (last && has_next) S.a_ready(nxt);
            if constexpr (SP2) {
            PG8_LDB(B0, 0, 0); PG8_LDB(B1, 0, 1); PG8_SCHED; PG8_LDA(At, 0, 0); PG8_STAGE(PG8_SA(1, 1), a1 + hstep, voffA);
            PG8_WAIT_V(8); PG8_WAIT_L(0); PG8_BAR; PG8_MMA(0, 0, At, B0); PG8_MMA(0, 1, At, B1); PG8_BAR; PG8_SCHED;
            PG8_LDA(At, 0, 1); PG8_STAGE(PG8_SB(0, 0), b2, voffB); PG8_STAGE(PG8_SB(0, 1), b2 + hstep, voffB); PG8_STAGE(PG8_SA(0, 0), a2, voffA);
            PG8_WAIT_V(8); PG8_WAIT_L(0); PG8_BAR; PG8_MMA(1, 0, At, B0); PG8_MMA(1, 1, At, B1); PG8_BAR; PG8_SCHED;
            PG8_LDB(B0, 1, 0); PG8_LDB(B1, 1, 1); PG8_SCHED; PG8_LDA(At, 1, 0); PG8_STAGE(PG8_SA(0, 1), a2 + hstep, voffA);
            PG8_WAIT_V(8); PG8_WAIT_L(0); PG8_BAR; PG8_MMA(0, 0, At, B0); PG8_MMA(0, 1, At, B1); PG8_BAR; PG8_SCHED;
            PG8_LDA(At, 1, 1); PG8_STAGE(PG8_SB(1, 0), b3, voffB); PG8_STAGE(PG8_SB(1, 1), b3 + hstep, voffB); PG8_STAGE(PG8_SA(1, 0), a3, voffA);
            PG8_WAIT_V(8); PG8_WAIT_L(0); PG8_BAR; PG8_MMA(1, 0, At, B0); PG8_MMA(1, 1, At, B1); PG8_BAR; PG8_SCHED;
            } else {
            PG8_LDB(B0, 0, 0); PG8_SCHED; PG8_LDA(At, 0, 0); PG8_STAGE(PG8_SA(1, 1), a1 + hstep, voffA);
            PG8_WAIT_L(8); PG8_BAR; PG8_WAIT_L(0); PG8_MMA(0, 0, At, B0); PG8_BAR; PG8_SCHED;
            PG8_LDB(B1, 0, 1); PG8_STAGE(PG8_SB(0, 0), b2, voffB);
            PG8_BAR; PG8_WAIT_L(0); PG8_MMA(0, 1, At, B1); PG8_BAR;
            PG8_LDA(At, 0, 1); PG8_STAGE(PG8_SA(0, 0), a2, voffA);
            PG8_BAR; PG8_WAIT_L(0); PG8_MMA(1, 0, At, B0); PG8_BAR; PG8_SCHED;
            PG8_STAGE(PG8_SB(0, 1), b2 + hstep, voffB);
            PG8_WAIT_V(6); PG8_BAR; PG8_MMA(1, 1, At, B1); PG8_BAR;
            PG8_LDB(B0, 1, 0); PG8_SCHED; PG8_LDA(At, 1, 0); PG8_STAGE(PG8_SA(0, 1), a2 + hstep, voffA);
            PG8_WAIT_L(8); PG8_BAR; PG8_WAIT_L(0); PG8_MMA(0, 0, At, B0); PG8_BAR; PG8_SCHED;
            PG8_LDB(B1, 1, 1); PG8_STAGE(PG8_SB(1, 0), b3, voffB);
            PG8_BAR; PG8_WAIT_L(0); PG8_MMA(0, 1, At, B1); PG8_BAR;
            PG8_LDA(At, 1, 1); PG8_STAGE(PG8_SA(1, 0), a3, voffA);
            PG8_BAR; PG8_WAIT_L(0); PG8_MMA(1, 0, At, B0); PG8_BAR; PG8_SCHED;
            PG8_STAGE(PG8_SB(1, 1), b3 + hstep, voffB);
            PG8_WAIT_V(6); PG8_BAR; PG8_MMA(1, 1, At, B1); PG8_BAR;
            }
        }
        if constexpr (ALIGN_EPI) { if (wr == 0) PG8_BAR; }
        { E(acc, cur, wr, wc, fr, fq, esc, tid); S.done(cur); }
        if (!has_next) break;
#pragma unroll
        for (int a = 0; a < 2; ++a)
#pragma unroll
            for (int b = 0; b < 2; ++b)
#pragma unroll
                for (int m = 0; m < 4; ++m)
#pragma unroll
                    for (int n = 0; n < 2; ++n) acc[a][b][m][n] = (f32x4){0.f, 0.f, 0.f, 0.f};
        cur = nxt; cA = nA; cB = nB; ++ui;
        if constexpr (ALIGN_EPI) { if (wr == 1) PG8_BAR; }
    }
    PG8_WAIT_V(0);
    if constexpr (!ALIGN_EPI) { if (wr == 0) PG8_BAR; }
    PG8_BAR;
#undef PG8_SA
#undef PG8_SB
#undef PG8_STAGE
#undef PG8_LDA
#undef PG8_LDB
#undef PG8_MMA
#undef PG8_WAIT_V
#undef PG8_WAIT_L
#undef PG8_BAR
#undef PG8_SCHED
}
}

typedef float f32x4 __attribute__((ext_vector_type(4)));
typedef short bf16x8 __attribute__((ext_vector_type(8)));


__device__ __forceinline__ void build_rs(const float* ssq, int pm, LAS unsigned char* esc, int tid) {
    LAS float* rsT = (LAS float*)esc;
    WG_BAR();
    if (tid < 256) {
        float s = 0.f;
#pragma unroll
        for (int j = 0; j < 8; ++j) { const gu64* p = (const gu64*)(ssq + ((size_t)j * MP + pm * 256 + tid) * 4);
#pragma unroll
            for (int h = 0; h < 2; ++h) { const unsigned long long v = __hip_atomic_load(p + h, RLX_AGENT); s += __builtin_bit_cast(float, (unsigned)v) + __builtin_bit_cast(float, (unsigned)(v >> 32)); } }
        rsT[tid] = rsqrtf(s * (1.0f / DM) + EPS);
    }
    WG_BAR();
}

struct EpiProj {
    static constexpr bool PERM = false, AFTER_DRAIN = false;
    unsigned char* ws_; float* out_; const float* gq; const float* gk; int l;
    __device__ __forceinline__ void operator()(f32x4 (&acc)[2][2][4][2], const pg8::Unit& u, int wr, int wc, int fr, int fq, LAS unsigned char* esc, int tid) const {
        asm volatile("" : "+v"(fr), "+v"(fq), "+v"(tid));
        size_t z_ = 0; asm volatile("" : "+s"(z_)); unsigned char* ws = ws_ + z_;
        const float* ssq = (const float*)(ws + WS_SSQ); const float* ropec = (const float*)(ws + WS_ROPE); const float* ropes = ropec + ROPE_N;
        bf16* Q = (bf16*)(ws + WS_Q); bf16* K = (bf16*)(ws + WS_K); bf16* VT = (bf16*)(ws + WS_VT); float* U = (float*)(ws + WS_U); float* XP = (float*)(ws + WS_XP);
        float* ksn = (float*)(ws + WS_KSN); float* vsn = ksn + NSAMP * 256;
        float* out_pk = out_ + O_PK + (size_t)l * NBATCH * 128 * 256; float* out_pv = out_ + O_PV + (size_t)l * NBATCH * 128 * 256;
        const rsrc_t rs_ = ws_rsrc(ws);
        build_rs(ssq, u.pm, esc, tid);
        const LAS float* rsT = (const LAS float*)esc;
        LAS float* hss = (LAS float*)(esc + 1024);
        const int pn = u.pn;
#pragma unroll
        for (int ai = 0; ai < 2; ++ai)
#pragma unroll
            for (int m = 0; m < 4; ++m) { const float rsv = rsT[ai * 128 + wr * 64 + m * 16 + fr];
#pragma unroll
                for (int bj = 0; bj < 2; ++bj)
#pragma unroll
                    for (int n = 0; n < 2; ++n) acc[ai][bj][m][n] *= rsv; }
        if (pn <= 4) {
#pragma unroll
            for (int ai = 0; ai < 2; ++ai)
#pragma unroll
                for (int m = 0; m < 4; ++m)
#pragma unroll
                    for (int bj = 0; bj < 2; ++bj) { const f32x4 a = acc[ai][bj][m][0], b = acc[ai][bj][m][1];
                        float s = (a[0] * a[0] + a[1] * a[1]) + (a[2] * a[2] + a[3] * a[3]) + (b[0] * b[0] + b[1] * b[1]) + (b[2] * b[2] + b[3] * b[3]);
                        s += __shfl_xor(s, 16); s += __shfl_xor(s, 32);
                        if (fq == 0) hss[(bj * 256 + ai * 128 + wr * 64 + m * 16 + fr) * 4 + wc] = s; }
            WG_BAR();
            const float* g = (pn < 4) ? gq : gk; const float osc = (pn < 4) ? QSCALE : 1.0f;
            f32x4 gv[2];
#pragma unroll
            for (int n = 0; n < 2; ++n) gv[n] = *(const f32x4*)(g + wc * 32 + n * 16 + 4 * fq);
#pragma unroll
            for (int ai = 0; ai < 2; ++ai)
#pragma unroll
                for (int m = 0; m < 4; ++m) {
                    const int rl = ai * 128 + wr * 64 + m * 16 + fr, r = u.pm * 256 + rl;
                    const bool samp = r >= SROW0, pad = r >= MR;
                    const int b = (r >= TT && !samp) ? 1 : 0, t = r - b * TT;
                    const int pidx = samp ? ROPE_SAMPLE_IDX : t;
                    f32x4 cs = {1.f, 1.f, 1.f, 1.f}, sn = {0.f, 0.f, 0.f, 0.f};
                    if (wc == 0 && !pad) { cs = *(const f32x4*)(ropec + (size_t)pidx * 16 + 4 * fq); sn = *(const f32x4*)(ropes + (size_t)pidx * 16 + 4 * fq); }
#pragma unroll
                    for (int bj = 0; bj < 2; ++bj) {
                        const f32x4 hv = *(const LAS f32x4*)(hss + (bj * 256 + rl) * 4);
                        const float hn = rsqrtf(((hv[0] + hv[1]) + (hv[2] + hv[3])) * (1.0f / 128.0f) + EPS);
                        f32x4 x1 = acc[ai][bj][m][0] * hn * gv[0], x2 = acc[ai][bj][m][1] * hn * gv[1];
                        if (wc == 0) { const f32x4 o1 = x1 * cs - x2 * sn, o2 = x2 * cs + x1 * sn; x1 = o1; x2 = o2; }
                        x1 = x1 * osc; x2 = x2 * osc;
                        const int cl = bj * 128 + wc * 32 + 4 * fq;
                        { const int od = fq & 1; const unsigned a0 = pk2(x1[0], x1[1]), a1 = pk2(x1[2], x1[3]), b0 = pk2(x2[0], x2[1]), b1 = pk2(x2[2], x2[3]);
                          const unsigned s0 = od ? a0 : b0, s1 = od ? a1 : b1; const unsigned r0 = (unsigned)__shfl_xor((int)s0, 16), r1 = (unsigned)__shfl_xor((int)s1, 16);
                          const v4u w16 = od ? (v4u){r0, r1, b0, b1} : (v4u){a0, a1, r0, r1};
                          const int cl16 = bj * 128 + wc * 32 + 4 * (fq & ~1) + (od ? 16 : 0);
                          if (pn < 4) ST16(rs_, WS_Q + ((size_t)r * 1024 + pn * 256 + cl16) * 2, w16); else ST16(rs_, WS_K + ((size_t)r * 256 + cl16) * 2, w16); }
                        if (pn == 4) {
                            if (samp && !pad) { const size_t o = WS_KSN + ((size_t)(r - SROW0) * 256 + cl) * 4; ST16(rs_, o, x1); ST16(rs_, o + 64, x2); }
                            else if (!samp && t >= TT - 128) { float* o = out_pk + ((size_t)(b * 128 + (t - (TT - 128))) * 256) + cl; *(f32x4*)o = x1; *(f32x4*)(o + 16) = x2; } }
                    }
                }
        } else if (pn == 5) {
#pragma unroll
            for (int ai = 0; ai < 2; ++ai)
#pragma unroll
                for (int m = 0; m < 4; ++m) {
                    const int rl = ai * 128 + wr * 64 + m * 16 + fr, r = u.pm * 256 + rl;
                    const bool samp = r >= SROW0, pad = r >= MR;
                    const int b = (r >= TT && !samp) ? 1 : 0, t = r - b * TT;
                    const int tpos = (t & ~15) + perm16(t & 15);
#pragma unroll
                    for (int bj = 0; bj < 2; ++bj)
#pragma unroll
                        for (int n = 0; n < 2; ++n) { const f32x4 x = acc[ai][bj][m][n]; const int d = wc * 32 + n * 16 + 4 * fq;
                            if (!samp) { const size_t vo = WS_VT + (((size_t)((b * 2 + bj) * 128 + d)) * TPV + tpos) * 2;
#pragma unroll
                                for (int j = 0; j < 4; ++j) ST2(rs_, vo + (size_t)j * TPV * 2, pk2(x[j], 0.f) & 0xffffu);
                                if (t >= TT - 128) *(f32x4*)(out_pv + ((size_t)(b * 128 + (t - (TT - 128))) * 256) + bj * 128 + d) = x; }
                            else if (!pad) ST16(rs_, WS_KSN + ((size_t)NSAMP * 256 + (size_t)(r - SROW0) * 256 + bj * 128 + d) * 4, x); }
                }
        } else {
            const size_t dsto = (pn < 8) ? WS_U + (size_t)(pn - 6) * 256 * 4 : WS_XP + (size_t)(pn - 8) * 256 * 4;
#pragma unroll
            for (int ai = 0; ai < 2; ++ai)
#pragma unroll
                for (int m = 0; m < 4; ++m) { const size_t ro = dsto + ((size_t)(u.pm * 256 + ai * 128 + wr * 64 + m * 16 + fr) * 512 + wc * 32 + 4 * fq) * 4;
#pragma unroll
                    for (int bj = 0; bj < 2; ++bj)
#pragma unroll
                        for (int n = 0; n < 2; ++n) ST16(rs_, ro + (size_t)(bj * 128 + n * 16) * 4, acc[ai][bj][m][n]); }
        }
    }
};

struct EpiRes {
    static constexpr bool PERM = true, AFTER_DRAIN = false;
    unsigned char* ws_; float* out; int last;
    __device__ __forceinline__ void operator()(f32x4 (&acc)[2][2][4][2], const pg8::Unit& u, int wr, int wc, int fr, int fq, LAS unsigned char* esc, int tid) const {
        asm volatile("" : "+v"(fr), "+v"(fq), "+v"(tid));
        size_t z_ = 0; asm volatile("" : "+s"(z_)); unsigned char* ws = ws_ + z_;
        const bf16* XB = (const bf16*)(ws + WS_XB); const rsrc_t rs_ = ws_rsrc(ws);
        v4u xb[2][4][2];
#pragma unroll
        for (int ai = 0; ai < 2; ++ai)
#pragma unroll
            for (int m = 0; m < 4; ++m) { const bf16* xp = XB + (size_t)(u.pm * 256 + ai * 128 + wr * 64 + m * 16 + fr) * DM + u.pn * 256 + wc * 32 + 8 * fq;
#pragma unroll
                for (int bj = 0; bj < 2; ++bj) xb[ai][m][bj] = *(const v4u*)(xp + bj * 128); }
#pragma unroll
        for (int ai = 0; ai < 2; ++ai)
#pragma unroll
            for (int m = 0; m < 4; ++m) {
                const int r = u.pm * 256 + ai * 128 + wr * 64 + m * 16 + fr; const int c0 = u.pn * 256 + wc * 32 + 8 * fq;
                const size_t eo = (size_t)r * DM + c0; float s = 0.f;
                f32x4 v[2][2];
#pragma unroll
                for (int bj = 0; bj < 2; ++bj) { const v4u w = xb[ai][m][bj];
                    const f32x4 x0 = {__builtin_bit_cast(float, w.x << 16), __builtin_bit_cast(float, w.x & 0xffff0000u), __builtin_bit_cast(float, w.y << 16), __builtin_bit_cast(float, w.y & 0xffff0000u)};
                    const f32x4 x1 = {__builtin_bit_cast(float, w.z << 16), __builtin_bit_cast(float, w.z & 0xffff0000u), __builtin_bit_cast(float, w.w << 16), __builtin_bit_cast(float, w.w & 0xffff0000u)};
                    v[bj][0] = x0 + acc[ai][bj][m][0]; v[bj][1] = x1 + acc[ai][bj][m][1];
#pragma unroll
                    for (int n = 0; n < 2; ++n) { const f32x4 q = v[bj][n] * v[bj][n]; s += (q[0] + q[1]) + (q[2] + q[3]); } }
                if (!last) {
#pragma unroll
                    for (int bj = 0; bj < 2; ++bj)
                        ST16(rs_, WS_XB + (eo + bj * 128) * 2, ((v4u){pk2(v[bj][0][0], v[bj][0][1]), pk2(v[bj][0][2], v[bj][0][3]), pk2(v[bj][1][0], v[bj][1][1]), pk2(v[bj][1][2], v[bj][1][3])}));
                    s += __shfl_xor(s, 16); s += __shfl_xor(s, 32);
                    if (fq == 0) ST4(rs_, WS_SSQ + (((size_t)u.pn * MP + r) * 4 + wc) * 4, s);
                } else {
                    const bool samp = r >= SROW0, pad = r >= MR; const int b = (r >= TT && !samp) ? 1 : 0, t = r - b * TT;
                    float* op = nullptr;
                    if (samp) { if (!pad) op = out + O_YS + (size_t)(r - SROW0) * DM + c0; } else if (t >= NMETA) op = out + O_YP + ((size_t)b * NSEQ + (t - NMETA)) * DM + c0;
                    if (op) {
#pragma unroll
                        for (int bj = 0; bj < 2; ++bj)
#pragma unroll
                            for (int n = 0; n < 2; ++n) *(f32x4*)(op + bj * 128 + n * 4) = v[bj][n]; }
                }
            }
    }
};

struct EpiFfn1 {
    static constexpr bool PERM = true, AFTER_DRAIN = false;
    unsigned char* ws_;
    __device__ __forceinline__ void operator()(f32x4 (&acc)[2][2][4][2], const pg8::Unit& u, int wr, int wc, int fr, int fq, LAS unsigned char* esc, int tid) const {
        asm volatile("" : "+v"(fr), "+v"(fq), "+v"(tid));
        size_t z_ = 0; asm volatile("" : "+s"(z_)); unsigned char* ws = ws_ + z_;
        const rsrc_t rs_ = ws_rsrc(ws);
        build_rs((const float*)(ws + WS_SSQ), u.pm, esc, tid);
        const LAS float* rsT = (const LAS float*)esc;
#pragma unroll
        for (int ai = 0; ai < 2; ++ai)
#pragma unroll
            for (int m = 0; m < 4; ++m) { const int rl = ai * 128 + wr * 64 + m * 16 + fr; const float rsv = rsT[rl];
                const size_t ho = WS_H + ((size_t)(u.pm * 256 + rl) * DFF + u.pn * 256 + wc * 32 + 8 * fq) * 2;
#pragma unroll
                for (int bj = 0; bj < 2; ++bj) { f32x4 v0 = acc[ai][bj][m][0] * rsv, v1 = acc[ai][bj][m][1] * rsv;
#pragma unroll
                    for (int j = 0; j < 4; ++j) { const float a = fmaxf(v0[j], 0.f), b = fmaxf(v1[j], 0.f); v0[j] = a * a; v1[j] = b * b; }
                    ST16(rs_, ho + bj * 256, ((v4u){pk2(v0[0], v0[1]), pk2(v0[2], v0[3]), pk2(v1[0], v1[1]), pk2(v1[2], v1[3])})); } }
    }
};

#define XB_TMO      128
#define XB_XCNT(j)  (256  + 64 * (j))
#define XB_XSUB(j)  (1280 + 64 * (j))
#define XB_XGEN(j)  (2304 + 64 * (j))
#define XB_TOP      3328
#define XB_TOPGEN   3392
#define XCD_BAR_WORDS 3456
#define XB_SPIN_CAP (1u << 18)
__device__ __forceinline__ unsigned xb_ld(unsigned* p)              { return __hip_atomic_load(p, __ATOMIC_RELAXED, __HIP_MEMORY_SCOPE_AGENT); }
__device__ __forceinline__ unsigned xb_add(unsigned* p, unsigned v) { return __hip_atomic_fetch_add(p, v, __ATOMIC_RELAXED, __HIP_MEMORY_SCOPE_AGENT); }
__device__ __forceinline__ unsigned xb_xcc_id() { return (unsigned)__builtin_amdgcn_s_getreg((3 << 11) | 20) & 0xFu; }
#define XB_SPIN(cond, bar) do { unsigned _sp = 0; while (cond) { __builtin_amdgcn_s_sleep(1); \
    if ((++_sp & 255u) == 0u) { if (xb_ld(&(bar)[XB_TMO])) break; if (_sp > XB_SPIN_CAP) { atomicAdd(&(bar)[XB_TMO], 1u); break; } } } } while (0)

struct XcdBarrier {
    unsigned* bar; unsigned x;
    volatile LAS unsigned* st;
};

__device__ __forceinline__ XcdBarrier xcd_barrier_post(unsigned* bar, volatile LAS unsigned* st) {
    XcdBarrier b; b.bar = bar; b.x = xb_xcc_id(); b.st = st;
    if (threadIdx.x == 0) (void)xb_add(&bar[XB_XCNT(b.x)], 1u);
    return b;
}
__device__ __forceinline__ void xcd_barrier_complete(unsigned* bar, unsigned x, unsigned& nloc, unsigned& nx) {
    const unsigned G = gridDim.x * gridDim.y * gridDim.z;
    unsigned sum, cnt, mine, sp = 0u;
    for (;;) {
        sum = 0u; cnt = 0u; mine = 0u;
#pragma unroll
        for (unsigned j = 0; j < 16; ++j) { const unsigned c = xb_ld(&bar[XB_XCNT(j)]); sum += c; cnt += (c > 0u) ? 1u : 0u; mine = (j == x) ? c : mine; }
        if (sum == G) break;
        __builtin_amdgcn_s_sleep(1);
        if ((++sp & 255u) == 0u) { if (xb_ld(&bar[XB_TMO])) break; if (sp > XB_SPIN_CAP) { atomicAdd(&bar[XB_TMO], 1u); break; } }
    }
    nloc = mine > 0u ? mine : 1u; nx = cnt > 0u ? cnt : 1u;
}

__device__ __forceinline__ void xcd_barrier(const XcdBarrier& b) {
    asm volatile("s_waitcnt vmcnt(0)" ::: "memory");
    __syncthreads();
    if (threadIdx.x == 0) {
        unsigned* bar = b.bar;
        __builtin_amdgcn_s_waitcnt(0);
        unsigned nloc = b.st[0], nx = b.st[1];
        if (nloc == 0u) { xcd_barrier_complete(bar, b.x, nloc, nx); b.st[0] = nloc; b.st[1] = nx; }
        const unsigned old = xb_add(&bar[XB_XSUB(b.x)], 1u);
        const unsigned gen = old / nloc;
        if (old + 1u == (gen + 1u) * nloc) {
            __builtin_amdgcn_fence(__ATOMIC_RELEASE, "agent");
            asm volatile("s_waitcnt vmcnt(0)" ::: "memory");
            const unsigned og = xb_add(&bar[XB_TOP], 1u);
            const unsigned tg = og / nx;
            if (og + 1u == (tg + 1u) * nx) xb_add(&bar[XB_TOPGEN], 1u);
            else XB_SPIN(xb_ld(&bar[XB_TOPGEN]) == tg, bar);
            __builtin_amdgcn_fence(__ATOMIC_ACQUIRE, "agent");
            xb_add(&bar[XB_XGEN(b.x)], 1u);
            asm volatile("s_waitcnt vmcnt(0)" ::: "memory");
        } else {
            XB_SPIN(xb_ld(&bar[XB_XGEN(b.x)]) == gen, bar);
            __builtin_amdgcn_fence(__ATOMIC_ACQUIRE, "agent");
            asm volatile("s_waitcnt vmcnt(0)" ::: "memory");
        }
    }
    __syncthreads();
}

struct Frame {
    LAS unsigned char* lds;
    volatile LAS unsigned* MISC;
    gu32* ctl;
    int wave, vcu, G;
    __device__ __forceinline__ int lane() const { int l; asm volatile("v_mbcnt_lo_u32_b32 %0, -1, 0\n\tv_mbcnt_hi_u32_b32 %0, -1, %0" : "=v"(l)); return l; }
    __device__ __forceinline__ int tid() const { return wave * 64 + lane(); }
    float* out; unsigned char* ws;
};
#define IN_XPROMPT 0
#define IN_XSAMPLE 1
#define IN_CACHEK 2
#define IN_CACHEV 3
#define IN_SSMRE 4
#define IN_SSMIM 5
#define IN_SPOOL 6
#define IN_META 7
#define IN_GMIX 8
#define IN_WIN 9
#define IN_GQ 10
#define IN_GK 11
#define IN_SINKS 12
#define IN_ARE 13
#define IN_AIM 14
#define IN_LOGDT 15
#define IN_BRE 16
#define IN_BIM 17
#define IN_CRE 18
#define IN_CIM 19
#define IN_DSKIP 20
#define IN_WGLU 21
#define IN_BGLU 22
#define IN_WPOOL 23
#define IN_PSCALE 24
#define IN_GOA 25
#define IN_GOS 26
#define IN_GOP 27
#define IN_WOUT 28
#define IN_GFFN 29
#define IN_WFF1 30
#define IN_WFF2 31
struct Args { const float* in[32]; float* out; unsigned char* ws; int ph_lo, ph_hi; };
static_assert(sizeof(Args) == 32 * 8 + 8 + 8 + 8, "Args has no padding");

__device__ __forceinline__ void p0_transpose_item(const float* W, int K, int N, bf16* WT, const float* gain, LAS float* scr, int item, int lane) {
    const int nblk = N / 32, kb = item / nblk, nb = item % nblk, k0 = 64 * kb, n0 = 32 * nb;
    float wv[32];
#pragma unroll
    for (int i = 0; i < 32; ++i) wv[i] = W[(size_t)(k0 + 2 * i + (lane >> 5)) * N + n0 + (lane & 31)];
    if (gain) {
#pragma unroll
        for (int i = 0; i < 32; ++i) wv[i] *= gain[k0 + 2 * i + (lane >> 5)];
    }
#pragma unroll
    for (int i = 0; i < 32; ++i) scr[(2 * i + (lane >> 5)) * 33 + (lane & 31)] = wv[i];
    LDS_WAIT(); asm volatile("" ::: "memory");
    const int c = lane & 7;
#pragma unroll
    for (int j = 0; j < 4; ++j) { const int n = (lane >> 3) + 8 * j; const LAS float* s = scr + (8 * c) * 33 + n;
        v4u o; o.x = pk2(s[0 * 33], s[1 * 33]); o.y = pk2(s[2 * 33], s[3 * 33]); o.z = pk2(s[4 * 33], s[5 * 33]); o.w = pk2(s[6 * 33], s[7 * 33]);
        *(GAS v4u*)(WT + (size_t)(n0 + n) * K + k0 + 8 * c) = o; }
    LDS_WAIT(); asm volatile("" ::: "memory");
}
__device__ __forceinline__ void sincos_d(double x, double& s, double& c) {
    const double TWO_PI = 6.283185307179586476925286766559;
    const double k = rint(x * (1.0 / TWO_PI)); const double r = fma(-k, TWO_PI, x), r2 = r * r;
    const double fs[14] = {0.16666666666666666, 0.05, 0.023809523809523808, 0.013888888888888888, 0.00909090909090909, 0.00641025641025641, 0.004761904761904762, 0.003676470588235294,
                           0.0029239766081871343, 0.002380952380952381, 0.001976284584980237, 0.0016666666666666668, 0.0014245014245014246, 0.0012315270935960591};
    const double fc[14] = {0.5, 0.08333333333333333, 0.03333333333333333, 0.017857142857142856, 0.011111111111111112, 0.007575757575757576, 0.005494505494505495, 0.004166666666666667,
                           0.0032679738562091504, 0.002631578947368421, 0.0021645021645021645, 0.0018115942028985507, 0.0015384615384615385, 0.0013227513227513227};
    double ts = r, tc = 1.0; s = r; c = 1.0;
#pragma unroll
    for (int i = 0; i < 14; ++i) { ts *= -r2 * fs[i]; s += ts; tc *= -r2 * fc[i]; c += tc; }
}
__device__ __forceinline__ double exp_small(double x) {
    double t = 1.0, e = 1.0;
#pragma unroll
    for (int i = 1; i <= 14; ++i) { t *= x * (1.0 / i); e += t; }
    return e;
}
__device__ __forceinline__ void p0_prologue(const Args& AR, Frame& F) {
    LAS float* scr = (LAS float*)(F.lds + F.wave * 16384);
    const int gw = F.vcu * 8 + F.wave, NGW = F.G * 8, lane = F.lane();
    unsigned char* ws = F.ws;
    constexpr int I_IN = (DM / 64) * (INW / 32), I_OUT = (DM / 64) * (DM / 32), I_1 = (DM / 64) * (DFF / 32), I_2 = (DFF / 64) * (DM / 32), I_GLU = (512 / 64) * (512 / 32), I_POOL = 4 * 2 * 4;
    constexpr int I_LAYER = I_IN + I_OUT + I_1 + I_2 + I_GLU + I_POOL;
    for (int it = gw; it < NLAYER * I_LAYER; it += NGW) {
        const int l = it / I_LAYER; int r = it % I_LAYER;
        if (r < I_IN) { p0_transpose_item(AR.in[IN_WIN] + (size_t)l * DM * INW, DM, INW, (bf16*)(ws + WS_WIN) + (size_t)l * INW * DM, AR.in[IN_GMIX] + l * DM, scr, r, lane); continue; } r -= I_IN;
        if (r < I_OUT) { const int k0 = 64 * (r / (DM / 32));
            const float* g = (k0 < 1024) ? AR.in[IN_GOA] + l * 1024 : (k0 < 1536) ? AR.in[IN_GOS] + l * 512 - 1024 : AR.in[IN_GOP] + l * 512 - 1536;
            p0_transpose_item(AR.in[IN_WOUT] + (size_t)l * DM * DM, DM, DM, (bf16*)(ws + WS_WOUT) + (size_t)l * DM * DM, g, scr, r, lane); continue; } r -= I_OUT;
        if (r < I_1) { p0_transpose_item(AR.in[IN_WFF1] + (size_t)l * DM * DFF, DM, DFF, (bf16*)(ws + WS_W1) + (size_t)l * DFF * DM, AR.in[IN_GFFN] + l * DM, scr, r, lane); continue; } r -= I_1;
        if (r < I_2) { p0_transpose_item(AR.in[IN_WFF2] + (size_t)l * DFF * DM, DFF, DM, (bf16*)(ws + WS_W2) + (size_t)l * DM * DFF, nullptr, scr, r, lane); continue; } r -= I_2;
        if (r < I_GLU) { p0_transpose_item(AR.in[IN_WGLU] + (size_t)l * 512 * 512, 512, 512, (bf16*)(ws + WS_WGLU) + (size_t)l * 512 * 512, nullptr, scr, r, lane); continue; } r -= I_GLU;
        { const int g = r / 8; p0_transpose_item(AR.in[IN_WPOOL] + ((size_t)l * 4 + g) * 128 * 128, 128, 128, (bf16*)(ws + WS_WPOOL) + ((size_t)l * 4 + g) * 128 * 128, nullptr, scr, r % 8, lane); }
    }
    bf16* XB = (bf16*)(ws + WS_XB); float* SSQ = (float*)(ws + WS_SSQ);
    for (int m = gw; m < MP; m += NGW) {
        const float* src = nullptr;
        if (m < SROW0) { const int b = m >= TT ? 1 : 0, t = m - b * TT; src = (t < NMETA) ? AR.in[IN_META] + (size_t)t * DM : AR.in[IN_XPROMPT] + ((size_t)b * NSEQ + (t - NMETA)) * DM; }
        else if (m < MR) src = AR.in[IN_XSAMPLE] + (size_t)(m - SROW0) * DM;
        float s = 0.f;
#pragma unroll
        for (int j = 0; j < 8; ++j) { f32x4 v = {0.f, 0.f, 0.f, 0.f}; if (src) v = *(const f32x4*)(src + j * 256 + lane * 4);
            s += (v[0] * v[0] + v[1] * v[1]) + (v[2] * v[2] + v[3] * v[3]);
            *(v2u*)(XB + (size_t)m * DM + j * 256 + lane * 4) = (v2u){pk2(v[0], v[1]), pk2(v[2], v[3])}; }
        s = wave_sum(s);
        if (lane < 32) SSQ[((size_t)(lane >> 2) * MP + m) * 4 + (lane & 3)] = (lane == 0) ? s : 0.f;
    }
    const int gt = gw * 64 + lane, NGT = NGW * 64;
    for (int id = gt; id < NLAYER * 32 * 64; id += NGT) {
        const int l = id >> 11, g = (id >> 6) & 31, n = id & 63;
        unsigned char* tb = ws + WS_TAB + (size_t)l * TB_LAYER;
        const double dt = (double)expf(AR.in[IN_LOGDT][l * 32 + g]);
        const double ar = (double)AR.in[IN_ARE][id], ai = (double)AR.in[IN_AIM][id];
        const double mag = exp_small(dt * ar); double sn, cs; sincos_d(dt * ai, sn, cs);
        const double abr = mag * cs, abi = mag * sn, den = ar * ar + ai * ai;
        const double fr = ((abr - 1.0) * ar + abi * ai) / den, fi = (abi * ar - (abr - 1.0) * ai) / den;
        ((float*)(tb + TB_ABR))[g * 64 + n] = (float)abr; ((float*)(tb + TB_ABI))[g * 64 + n] = (float)abi;
        const float* Br = AR.in[IN_BRE] + (size_t)id * 16; const float* Bi = AR.in[IN_BIM] + (size_t)id * 16;
        float* bbr = (float*)(tb + TB_BBR) + (size_t)(g * 64 + n) * 16; float* bbi = (float*)(tb + TB_BBI) + (size_t)(g * 64 + n) * 16;
        bf16* bbt = (bf16*)(tb + TB_PM) + (size_t)g * 128 * 16;
#pragma unroll
        for (int c = 0; c < 16; ++c) { const double br = Br[c], bi = Bi[c]; const float vr = (float)(fr * br - fi * bi), vi = (float)(fr * bi + fi * br); bbr[c] = vr; bbi[c] = vi;
            bbt[n * 16 + c] = (bf16)(pk2(vr, 0.f) & 0xffffu); bbt[(64 + n) * 16 + c] = (bf16)(pk2(vi, 0.f) & 0xffffu); }
        double pr = abr, pi = abi;
        for (int t = 0; t < 64; ++t) {
            if (t == 15) { ((float*)(tb + TB_A16R))[g * 64 + n] = (float)pr; ((float*)(tb + TB_A16I))[g * 64 + n] = (float)pi; }
            if (t == 31) { ((float*)(tb + TB_A32R))[g * 64 + n] = (float)pr; ((float*)(tb + TB_A32I))[g * 64 + n] = (float)pi; }
            if (t == 63) { ((float*)(tb + TB_ALR))[g * 64 + n] = (float)pr; ((float*)(tb + TB_ALI))[g * 64 + n] = (float)pi; }
            const double nr = pr * abr - pi * abi, ni = pr * abi + pi * abr; pr = nr; pi = ni;
        }
        bf16* CmT = (bf16*)(tb + TB_CMT) + (size_t)g * 16 * 128;
        const float* Cr = AR.in[IN_CRE] + ((size_t)(l * 32 + g) * 16) * 64 + n; const float* Ci = AR.in[IN_CIM] + ((size_t)(l * 32 + g) * 16) * 64 + n;
#pragma unroll
        for (int c = 0; c < 16; ++c) { CmT[c * 128 + n] = (bf16)(pk2(Cr[c * 64], 0.f) & 0xffffu); CmT[c * 128 + 64 + n] = (bf16)(pk2(-Ci[c * 64], 0.f) & 0xffffu); }
    }
    float* rc = (float*)(ws + WS_ROPE); float* rs_ = rc + ROPE_N;
    for (int id = gt; id < (int)ROPE_N; id += NGT) {
        const int p = id >> 4, i = id & 15; const double pos = (p == ROPE_SAMPLE_IDX) ? 16384.0 : (double)p;
        double inv = 1.0;
        for (int k = 0; k < i; ++k) inv *= 0.44036660267178046;
        double sn, cs; sincos_d(pos * inv, sn, cs);
        rc[id] = (float)cs; rs_[id] = (float)sn;
    }
}

__device__ __forceinline__ void attn_unit(const Args& AR, Frame& F, int l, int b, int i) {
    int lane_ = F.lane(); asm volatile("" : "+v"(lane_));
    size_t z_ = 0; asm volatile("" : "+s"(z_)); unsigned char* ws = F.ws + z_;
    const int lane = lane_, h = F.wave, c = lane & 31, hh = lane >> 5, kvh = h >> 2;
    const int t0 = 32 * i; const size_t rb = (size_t)b * TT;
#if PROBE && (PROBE_KIND == 11 || PROBE_KIND == 12)
    const unsigned long long ta0 = __builtin_amdgcn_s_memrealtime();
#endif
    const bf16* Q = (const bf16*)(ws + WS_Q); const bf16* K = (const bf16*)(ws + WS_K); const bf16* VT = (const bf16*)(ws + WS_VT);
    LAS float* ex = (LAS float*)(F.lds + ESC_OFF);
    bf16x8 qf[8];
    { const bf16* qp = Q + (rb + t0 + c) * 1024 + 128 * h + 8 * hh;
#pragma unroll
      for (int ks = 0; ks < 8; ++ks) qf[ks] = *(const bf16x8*)(qp + 16 * ks); }
    const int kt0 = (t0 >= 128) ? 0 : (4 - i);
    f32x16 S[5];
    bf16x8 kf[2][8];
    { const int tk0 = t0 - 128 + 32 * kt0; const bf16* kp = K + (rb + tk0 + c) * 256 + 128 * kvh + 8 * hh;
      if (kt0 & 1) {
#pragma unroll
          for (int ks = 0; ks < 8; ++ks) kf[1][ks] = *(const bf16x8*)(kp + 16 * ks);
      } else {
#pragma unroll
          for (int ks = 0; ks < 8; ++ks) kf[0][ks] = *(const bf16x8*)(kp + 16 * ks);
      } }
#pragma unroll
    for (int kt = 0; kt < 5; ++kt) {
#pragma unroll
        for (int r = 0; r < 16; ++r) S[kt][r] = -INFINITY;
        if (kt >= kt0) {
            if (kt < 4) { const int tk1 = t0 - 128 + 32 * (kt + 1); const bf16* kp = K + (rb + tk1 + c) * 256 + 128 * kvh + 8 * hh;
#pragma unroll
                for (int ks = 0; ks < 8; ++ks) kf[(kt + 1) & 1][ks] = *(const bf16x8*)(kp + 16 * ks); }
            f32x16 a = {0.f, 0.f, 0.f, 0.f, 0.f, 0.f, 0.f, 0.f, 0.f, 0.f, 0.f, 0.f, 0.f, 0.f, 0.f, 0.f};
#pragma unroll
            for (int ks = 0; ks < 8; ++ks) a = __builtin_amdgcn_mfma_f32_32x32x16_bf16(kf[kt & 1][ks], qf[ks], a, 0, 0, 0);
#pragma unroll
            for (int r = 0; r < 16; ++r) { const int kr = (r & 3) + 8 * (r >> 2) + 4 * hh; bool ok = true;
                if (kt == 0) ok = kr >= c;
                if (kt == 4) ok = kr <= c;
                S[kt][r] = ok ? a[r] : -INFINITY; }
        }
    }
#if PROBE && PROBE_KIND == 11
    if (F.tid() == 0) F.MISC[6] += (unsigned)(__builtin_amdgcn_s_memrealtime() - ta0);
#endif
    const float sink2 = AR.in[IN_SINKS][l * 8 + h] * LOG2E;
    float mx = sink2;
#pragma unroll
    for (int kt = 0; kt < 5; ++kt)
#pragma unroll
        for (int r = 0; r < 16; ++r) mx = fmaxf(mx, S[kt][r]);
    mx = fmaxf(mx, __shfl_xor(mx, 32));
    float sum = 0.f;
#pragma unroll
    for (int kt = 0; kt < 5; ++kt)
#pragma unroll
        for (int r = 0; r < 16; ++r) { const float p = __builtin_amdgcn_exp2f(S[kt][r] - mx); S[kt][r] = p; sum += p; }
    sum += __shfl_xor(sum, 32);
    const float inv = 1.0f / (sum + __builtin_amdgcn_exp2f(sink2 - mx));
    f32x16 O[4];
#pragma unroll
    for (int db = 0; db < 4; ++db)
#pragma unroll
        for (int r = 0; r < 16; ++r) O[db][r] = 0.f;
    const bf16* vbase = VT + ((size_t)((b * 2 + kvh) * 128 + c)) * TPV + (t0 - 128) + 8 * hh;
    bf16x8 vf[2][4];
#pragma unroll
    for (int db = 0; db < 4; ++db) vf[0][db] = *(const bf16x8*)(vbase + (size_t)(32 * db) * TPV + 32 * kt0);
#pragma unroll
    for (int st = 0; st < 10; ++st) {
        const int kt = st >> 1, s = st & 1;
        if (kt >= kt0) {
            if (st < 9) {
#pragma unroll
                for (int db = 0; db < 4; ++db) vf[(st + 1) & 1][db] = *(const bf16x8*)(vbase + (size_t)(32 * db) * TPV + 16 * (st + 1)); }
            v4u pw; pw.x = pk2(S[kt][8 * s + 0], S[kt][8 * s + 1]); pw.y = pk2(S[kt][8 * s + 2], S[kt][8 * s + 3]); pw.z = pk2(S[kt][8 * s + 4], S[kt][8 * s + 5]); pw.w = pk2(S[kt][8 * s + 6], S[kt][8 * s + 7]);
            const bf16x8 pf = __builtin_bit_cast(bf16x8, pw);
#pragma unroll
            for (int db = 0; db < 4; ++db) O[db] = __builtin_amdgcn_mfma_f32_32x32x16_bf16(vf[st & 1][db], pf, O[db], 0, 0, 0);
        }
    }
    float ss = 0.f;
#pragma unroll
    for (int db = 0; db < 4; ++db)
#pragma unroll
        for (int r = 0; r < 16; ++r) { O[db][r] *= inv; ss += O[db][r] * O[db][r]; }
#if PROBE && PROBE_KIND == 12
    if (F.tid() == 0) F.MISC[6] += (unsigned)(__builtin_amdgcn_s_memrealtime() - ta0);
#endif
    ss += __shfl_xor(ss, 32);
    if (hh == 0) ex[h * 32 + c] = ss;
    WG_BAR();
    float tot = 0.f;
#pragma unroll
    for (int j = 0; j < 8; ++j) tot += ex[j * 32 + c];
    const float rsa = rsqrtf(tot * (1.0f / 1024.0f) + EPS);
    if (t0 + c < TT) {
        const rsrc_t rs_ = ws_rsrc(ws); const size_t mo16 = WS_MIX + ((rb + t0 + c) * DM + 128 * h) * 2 + 16 * hh;
#pragma unroll
        for (int db = 0; db < 4; ++db)
#pragma unroll
            for (int g4 = 0; g4 < 4; g4 += 2) {
                unsigned ax = pk2(O[db][4 * g4 + 0] * rsa, O[db][4 * g4 + 1] * rsa), ay = pk2(O[db][4 * g4 + 2] * rsa, O[db][4 * g4 + 3] * rsa);
                unsigned bx = pk2(O[db][4 * g4 + 4] * rsa, O[db][4 * g4 + 5] * rsa), by = pk2(O[db][4 * g4 + 6] * rsa, O[db][4 * g4 + 7] * rsa);
                { auto r = __builtin_amdgcn_permlane32_swap(ax, bx, false, false); ax = r[0]; bx = r[1]; }
                { auto r = __builtin_amdgcn_permlane32_swap(ay, by, false, false); ay = r[0]; by = r[1]; }
                ST16(rs_, mo16 + (32 * db + 8 * g4) * 2, ((v4u){ax, ay, bx, by}));
            }
    }
    WG_BAR();
}

__device__ __forceinline__ void sattn_unit(const Args& AR, Frame& F, int l, int s) {
    int tid_ = F.tid(); asm volatile("" : "+v"(tid_));
    const int tid = tid_, lane = tid & 63, wave = F.wave;
    LAS float* qs = (LAS float*)F.lds;
    LAS float* sc = qs + 1024;
    LAS float* part = sc + 8 * 132;
    LAS float* red = part + 4096;
    const size_t row = SROW0 + s;
    const bf16* Q = (const bf16*)(F.ws + WS_Q) + row * 1024;
    const float* ksn = (const float*)(F.ws + WS_KSN) + (size_t)s * 256; const float* vsn = ksn + NSAMP * 256;
    const float* ck = AR.in[IN_CACHEK] + ((size_t)(l * NSAMP + s)) * 128 * 256; const float* cv = AR.in[IN_CACHEV] + ((size_t)(l * NSAMP + s)) * 128 * 256;
    for (int j = tid; j < 1024; j += 512) qs[j] = bf2f(Q[j]);
    WG_BAR();
    { const int key = tid >> 2, pt = tid & 3;
#pragma unroll
      for (int kvh = 0; kvh < 2; ++kvh) {
          const float* kp = ck + (size_t)key * 256 + kvh * 128 + 32 * pt; float d[4] = {0.f, 0.f, 0.f, 0.f};
#pragma unroll
          for (int j = 0; j < 8; ++j) { const f32x4 kv = *(const f32x4*)(kp + 4 * j);
#pragma unroll
              for (int g = 0; g < 4; ++g) { const f32x4 qv = *(const LAS f32x4*)(qs + (4 * kvh + g) * 128 + 32 * pt + 4 * j); d[g] += (kv[0] * qv[0] + kv[1] * qv[1]) + (kv[2] * qv[2] + kv[3] * qv[3]); } }
#pragma unroll
          for (int g = 0; g < 4; ++g) { d[g] += __shfl_xor(d[g], 1); d[g] += __shfl_xor(d[g], 2); if (pt == 0) sc[(4 * kvh + g) * 132 + key] = d[g]; }
      } }
    {
      const int h = wave, kvh = h >> 2; float d = ksn[kvh * 128 + lane] * qs[h * 128 + lane] + ksn[kvh * 128 + 64 + lane] * qs[h * 128 + 64 + lane];
      d = wave_sum(d); if (lane == 0) sc[h * 132 + 128] = d; }
    WG_BAR();
    { const int h = wave; const float sink2 = AR.in[IN_SINKS][l * 8 + h] * LOG2E;
      const float v0 = sc[h * 132 + lane], v1 = sc[h * 132 + 64 + lane], v2 = (lane == 0) ? sc[h * 132 + 128] : -INFINITY;
      const float mx = fmaxf(wave_max(fmaxf(fmaxf(v0, v1), v2)), sink2);
      const float p0 = __builtin_amdgcn_exp2f(v0 - mx), p1 = __builtin_amdgcn_exp2f(v1 - mx), p2 = __builtin_amdgcn_exp2f(v2 - mx);
      const float inv = 1.0f / (wave_sum(p0 + p1 + p2) + __builtin_amdgcn_exp2f(sink2 - mx));
      sc[h * 132 + lane] = p0 * inv; sc[h * 132 + 64 + lane] = p1 * inv; if (lane == 0) sc[h * 132 + 128] = p2 * inv; }
    WG_BAR();
    { const int d = tid & 127, kq = tid >> 7;
#pragma unroll
      for (int kvh = 0; kvh < 2; ++kvh) { float a[4] = {0.f, 0.f, 0.f, 0.f};
#pragma unroll 8
          for (int k = 0; k < 32; ++k) { const int key = 32 * kq + k; const float v = cv[(size_t)key * 256 + kvh * 128 + d];
#pragma unroll
              for (int g = 0; g < 4; ++g) a[g] += sc[(4 * kvh + g) * 132 + key] * v; }
#pragma unroll
          for (int g = 0; g < 4; ++g) part[kq * 1024 + (4 * kvh + g) * 128 + d] = a[g]; } }
    WG_BAR();
    float o[2]; float ss = 0.f;
#pragma unroll
    for (int e = 0; e < 2; ++e) { const int j = tid + 512 * e, h = j >> 7, d = j & 127, kvh = h >> 2;
        o[e] = (part[j] + part[1024 + j]) + (part[2048 + j] + part[3072 + j]) + sc[h * 132 + 128] * vsn[kvh * 128 + d]; ss += o[e] * o[e]; }
    ss = wave_sum(ss); if (lane == 0) red[wave] = ss;
    WG_BAR();
    { float tot = 0.f;
#pragma unroll
      for (int j = 0; j < 8; ++j) tot += red[j];
      const float rsa = rsqrtf(tot * (1.0f / 1024.0f) + EPS);
      const rsrc_t rs_ = ws_rsrc(F.ws);
#pragma unroll
      for (int e = 0; e < 2; ++e) ST2(rs_, WS_MIX + (row * DM + tid + 512 * e) * 2, pk2(o[e] * rsa, 0.f) & 0xffffu); }
    { float* ok = F.out + O_SK + ((size_t)(l * NSAMP + s)) * 128 * 256; float* ov = F.out + O_SV + ((size_t)(l * NSAMP + s)) * 128 * 256;
      for (int j = tid; j < 127 * 64; j += 512) { *(f32x4*)(ok + 4 * j) = *(const f32x4*)(ck + 256 + 4 * j); *(f32x4*)(ov + 4 * j) = *(const f32x4*)(cv + 256 + 4 * j); }
      if (tid < 64) *(f32x4*)(ok + 127 * 256 + 4 * tid) = *(const f32x4*)(ksn + 4 * tid);
      else if (tid < 128) *(f32x4*)(ov + 127 * 256 + 4 * (tid - 64)) = *(const f32x4*)(vsn + 4 * (tid - 64)); }
    WG_BAR();
}

__device__ __forceinline__ float gelu_tanh(float y) {
    const float inner = 0.7978845608028654f * (y + 0.044715f * y * y * y);
    return y / (1.0f + __builtin_amdgcn_exp2f(-2.0f * LOG2E * inner));
}
__device__ __forceinline__ float sigmoidf_(float x) { return 1.0f / (1.0f + __builtin_amdgcn_exp2f(-LOG2E * x)); }
#define SWZ(r, ch, PITCH) ((r) * (PITCH) + ((((ch)) ^ ((r) & 15)) << 4))

#ifndef SSM_P1
#define SSM_P1 1
#endif
#ifndef SSM_M2
#define SSM_M2 1
#endif
__device__ __forceinline__ int rowtok(int r) { return 16 * ((r >> 2) & 1) + 4 * (r >> 3) + (r & 3); }
struct SsmG { f32x16 X[4]; };
struct SsmIn { f32x4 u0, u1; };
__device__ __forceinline__ SsmIn ssm_load_in(const float* U, int rowb, int g, int lane) { const float* up = U + (size_t)(rowb + rowtok(lane & 31)) * 512 + 16 * g + 8 * (lane >> 5); SsmIn r; r.u0 = *(const f32x4*)up; r.u1 = *(const f32x4*)(up + 4); return r; }
__device__ __forceinline__ void ssm_block(const Args& AR, SsmG& G, const SsmIn& in, int g, const bf16x8 (&bbf)[4], const float (&ab)[4], float (&hr)[2], float (&hi)[2], int mode, int l, int s0, int lane) {
    const int c = lane & 31, hh = lane >> 5;
    bf16x8 af;
    { const f32x4 u0 = in.u0, u1 = in.u1;
      v4u pw; pw.x = pk2(u0[0], u0[1]); pw.y = pk2(u0[2], u0[3]); pw.z = pk2(u1[0], u1[1]); pw.w = pk2(u1[2], u1[3]); af = __builtin_bit_cast(bf16x8, pw); }
    const f32x16 z16 = {0.f, 0.f, 0.f, 0.f, 0.f, 0.f, 0.f, 0.f, 0.f, 0.f, 0.f, 0.f, 0.f, 0.f, 0.f, 0.f};
#pragma unroll
    for (int nb = 0; nb < 4; ++nb) G.X[nb] = __builtin_amdgcn_mfma_f32_32x32x16_bf16(af, bbf[nb], z16, 0, 0, 0);
#pragma unroll
    for (int s = 0; s < 2; ++s) {
        const float ar = ab[2 * s], ai = ab[2 * s + 1];
        if (SSM_M2 && mode == 2) {
            { int cx = c; asm volatile("" : "+v"(cx)); const size_t o0 = ((size_t)(l * NSAMP + (s0 + 16 * hh)) * 32 + g) * 64 + cx + 32 * s; const float* qr = AR.in[IN_SSMRE] + o0; const float* qi = AR.in[IN_SSMIM] + o0;
              size_t jo = 0;
#pragma unroll
              for (int j = 0; j < 16; ++j) { const float pr = qr[jo], pi = qi[jo]; jo += 2048; asm volatile("" : "+v"(jo));
                const float nr = ar * pr - ai * pi + G.X[s][j], ni = ar * pi + ai * pr + G.X[2 + s][j]; G.X[s][j] = nr; G.X[2 + s][j] = ni; } }
            continue;
        }
        float r = (hh == 0) ? hr[s] : 0.f, i = (hh == 0) ? hi[s] : 0.f;
#pragma unroll
        for (int j = 0; j < 16; ++j) { const float nr = ar * r - ai * i + G.X[s][j], ni = ar * i + ai * r + G.X[2 + s][j]; r = nr; i = ni; G.X[s][j] = r; G.X[2 + s][j] = i; }
        float vr = __shfl_xor(r, 32), vi = __shfl_xor(i, 32);
        if (hh == 0 || mode == 1) { vr = 0.f; vi = 0.f; }
        float pr = ar, pi = ai; asm volatile("" : "+v"(pr), "+v"(pi));
#pragma unroll
        for (int j = 0; j < 16; ++j) { G.X[s][j] += pr * vr - pi * vi; G.X[2 + s][j] += pr * vi + pi * vr; const float nr = pr * ar - pi * ai, ni = pr * ai + pi * ar; pr = nr; pi = ni; }
        const float er = G.X[s][15], ei = G.X[2 + s][15];
        const float xr = __shfl_xor(er, 32), xi = __shfl_xor(ei, 32);
        hr[s] = (hh == 1) ? er : xr; hi[s] = (hh == 1) ? ei : xi;
    }
}
struct SsmTab { float ab[4]; bf16x8 bbf[4]; };
struct SsmTabC { bf16x8 cmf[4]; f32x4 dsk; };
__device__ __forceinline__ SsmTab ssm_load_tab(const unsigned char* tb, int w, int gi, int lg) {
    SsmTab T; const int g = 4 * w + gi, c32 = lg & 31, hh = lg >> 5;
    T.ab[0] = ((const float*)(tb + TB_ABR))[g * 64 + c32]; T.ab[1] = ((const float*)(tb + TB_ABI))[g * 64 + c32]; T.ab[2] = ((const float*)(tb + TB_ABR))[g * 64 + 32 + c32]; T.ab[3] = ((const float*)(tb + TB_ABI))[g * 64 + 32 + c32];
    const bf16* bt = (const bf16*)(tb + TB_PM) + (size_t)g * 128 * 16 + c32 * 16 + 8 * hh;
#pragma unroll
    for (int nb = 0; nb < 4; ++nb) T.bbf[nb] = *(const bf16x8*)(bt + nb * 32 * 16);
    return T;
}
__device__ __forceinline__ SsmTabC ssm_load_tabc(const unsigned char* tb, const float* dskip, int w, int gi, int lg) {
    SsmTabC T; const int g = 4 * w + gi, t16 = lg & 15, cq = lg >> 4;
    const bf16* cm = (const bf16*)(tb + TB_CMT) + (size_t)g * 16 * 128 + t16 * 128 + 8 * cq;
#pragma unroll
    for (int nb = 0; nb < 4; ++nb) T.cmf[nb] = *(const bf16x8*)(cm + 32 * nb);
    T.dsk = *(const f32x4*)(dskip + 64 * w + 16 * gi + 4 * cq); return T;
}
__device__ __forceinline__ void ssm_unit(const Args& AR, Frame& F, int l, int c_in) {
    const int c = c_in;
#if PROBE && PROBE_KIND == 13
    const unsigned long long tq0 = __builtin_amdgcn_s_memrealtime();
#define SSM_CP(n) do { if ((n) == PROBE_TYPE && F.tid() == 0) F.MISC[6] += (unsigned)(__builtin_amdgcn_s_memrealtime() - tq0); } while (0)
#else
#define SSM_CP(n) do { } while (0)
#endif
    int lane_ = F.lane(); asm volatile("" : "+v"(lane_));
    const int lane = lane_, w = F.wave, t16 = lane & 15, cq = lane >> 4, c32 = lane & 31, hh = lane >> 5;
    const int row0 = 64 * c;
    size_t z_ = 0; asm volatile("" : "+s"(z_)); unsigned char* ws = F.ws + z_;
    const unsigned char* tb = ws + WS_TAB + (size_t)l * TB_LAYER;
    const float* U = (const float*)(ws + WS_U);
    float* SST = (float*)(ws + WS_SST) + ((size_t)l * NCHUNK) * 32 * 128;
    gu32* flags = F.ctl + CW_SSMF + (size_t)(l * NCHUNK) * 8 * 16;
    LAS unsigned char* Zs = F.lds;
    LAS unsigned char* Hm = F.lds + 65536 + w * 8704;
    LAS float* red = (LAS float*)(F.lds + 137216);
    SsmG SG;
    float hcar[4] = {0.f, 0.f, 0.f, 0.f};
    if (SSM_P1 && c != NCHUNK - 1) {
#pragma unroll 1
        for (int gi = 0; gi < 4; ++gi) {
            const int g = 4 * w + gi;
            int lg_ = lane; asm volatile("" : "+v"(lg_));
            const int c32 = lg_ & 31, hh = lg_ >> 5;
            float ab[4]; ab[0] = ((const float*)(tb + TB_ABR))[g * 64 + c32]; ab[1] = ((const float*)(tb + TB_ABI))[g * 64 + c32]; ab[2] = ((const float*)(tb + TB_ABR))[g * 64 + 32 + c32]; ab[3] = ((const float*)(tb + TB_ABI))[g * 64 + 32 + c32];
            bf16x8 bbf[4];
            { const bf16* bt = (const bf16*)(tb + TB_PM) + (size_t)g * 128 * 16 + c32 * 16 + 8 * hh;
#pragma unroll
              for (int nb = 0; nb < 4; ++nb) bbf[nb] = *(const bf16x8*)(bt + nb * 32 * 16); }
            float hr[2] = {0.f, 0.f}, hi[2] = {0.f, 0.f};
            const SsmIn in0 = ssm_load_in(U, row0, g, lg_), in1 = ssm_load_in(U, row0 + 32, g, lg_);
            ssm_block(AR, SG, in0, g, bbf, ab, hr, hi, (c == 64) ? 1 : 0, l, 0, lg_);
            ssm_block(AR, SG, in1, g, bbf, ab, hr, hi, 0, l, 0, lg_);
            if (hh == 0) {
#pragma unroll
                for (int s = 0; s < 2; ++s) __hip_atomic_store((gu64*)(SST + ((size_t)c * 32 + g) * 128 + 2 * (c32 + 32 * s)), ((unsigned long long)__builtin_bit_cast(unsigned, hi[s]) << 32) | __builtin_bit_cast(unsigned, hr[s]), RLX_AGENT);
            }
        }
        VM_WAIT();
        if (lane == 0) __hip_atomic_store(flags + ((size_t)c * 8 + w) * 16, 1u, RLX_AGENT);
    }
    SSM_CP(1);
    const int cs0 = (c <= 64) ? 0 : 64, npred = c - cs0;
    if (npred > 0) {
        unsigned sp = 0; bool ok = false;
        for (;;) { ok = (lane >= npred) || (__hip_atomic_load(flags + ((size_t)(cs0 + lane) * 8 + w) * 16, RLX_AGENT) != 0u);
            if (__all(ok)) break;
            __builtin_amdgcn_s_sleep(2);
            if (++sp > (1u << 20)) { if (lane == 0) __hip_atomic_store(F.ctl + CW_TMO, 0x55u, RLX_AGENT); break; } }
        __builtin_amdgcn_fence(__ATOMIC_ACQUIRE, "agent");
        VM_WAIT();
    }
    SSM_CP(2);
    SSM_CP(2);
    SsmTab T = ssm_load_tab(tb, w, 0, lane);
    SsmTabC TC = ssm_load_tabc(tb, AR.in[IN_DSKIP] + l * 512, w, 0, lane);
    SsmIn inx = ssm_load_in(U, row0, 4 * w, lane);
#pragma unroll 1
    for (int step = 0; step < 8; ++step) {
        const int gi = step >> 1, half = step & 1, g = 4 * w + gi;
        int lg_ = lane; asm volatile("" : "+v"(lg_));
        const int t16 = lg_ & 15, cq = lg_ >> 4, c32 = lg_ & 31, hh = lg_ >> 5;
        int cc_ = c_in; asm volatile("" : "+s"(cc_)); const int c = cc_;
        const bool samp = (c == NCHUNK - 1) && (half == 1);
        const int col = 64 * w + 16 * gi + 4 * cq;
        const int ns = (step < 7) ? step + 1 : 7, ngi = ns >> 1, nhalf = ns & 1;
        const SsmIn in_n = ssm_load_in(U, row0 + 32 * nhalf, 4 * w + ngi, lg_);
        f32x4 uvp[2];
#pragma unroll
        for (int mt = 0; mt < 2; ++mt) uvp[mt] = *(const f32x4*)(U + (size_t)(row0 + 32 * half + 16 * mt + t16) * 512 + col);
        if (half == 0 && gi > 0) { T = ssm_load_tab(tb, w, gi, lg_); TC = ssm_load_tabc(tb, AR.in[IN_DSKIP] + l * 512, w, gi, lg_); }
        float hr[2], hi[2];
        if (half == 0) {
            hr[0] = 0.f; hr[1] = 0.f; hi[0] = 0.f; hi[1] = 0.f;
            if (npred > 0) {
                float aL[4]; aL[0] = ((const float*)(tb + TB_ALR))[g * 64 + c32]; aL[1] = ((const float*)(tb + TB_ALI))[g * 64 + c32]; aL[2] = ((const float*)(tb + TB_ALR))[g * 64 + 32 + c32]; aL[3] = ((const float*)(tb + TB_ALI))[g * 64 + 32 + c32];
                const float* sb = SST + ((size_t)g) * 128 + 2 * c32;
                for (int cp = cs0; cp < c; cp += 16) {
                    f32x2 sv[16][2];
#pragma unroll
                    for (int j = 0; j < 16; ++j) { const int cj = (cp + j < c) ? cp + j : c - 1; const float* sp_ = sb + (size_t)cj * 32 * 128; sv[j][0] = *(const f32x2*)sp_; sv[j][1] = *(const f32x2*)(sp_ + 64); }
#pragma unroll
                    for (int j = 0; j < 16; ++j) if (cp + j < c) {
#pragma unroll
                        for (int s = 0; s < 2; ++s) { const float nr = aL[2 * s] * hr[s] - aL[2 * s + 1] * hi[s] + sv[j][s][0], ni = aL[2 * s] * hi[s] + aL[2 * s + 1] * hr[s] + sv[j][s][1]; hr[s] = nr; hi[s] = ni; } }
                }
            }
        } else {
#pragma unroll
            for (int s = 0; s < 2; ++s) { hr[s] = hcar[2 * s]; hi[s] = hcar[2 * s + 1]; }
        }
        ssm_block(AR, SG, inx, g, T.bbf, T.ab, hr, hi, samp ? 2 : ((c == 64 && half == 0) ? 1 : 0), l, 0, lg_);
#pragma unroll
        for (int s = 0; s < 2; ++s) { hcar[2 * s] = hr[s]; hcar[2 * s + 1] = hi[s]; }
        { LAS unsigned char* hw = Hm + hh * (16 * 272) + c32 * 2;
#pragma unroll
          for (int j = 0; j < 16; ++j)
#pragma unroll
            for (int nb = 0; nb < 4; ++nb) *(LAS bf16*)(hw + j * 272 + nb * 64) = (bf16)(pk2(SG.X[nb][j], 0.f) & 0xffffu); }
        if ((c == 64 && half == 0) || (c == NCHUNK - 1 && half == 0)) {
            int cx = c32; asm volatile("" : "+v"(cx));
            if (hh == (c == 64 ? 0 : 1)) {
#pragma unroll
                for (int s = 0; s < 2; ++s) { const size_t o = ((size_t)(l * NBATCH + (c == 64 ? 0 : 1)) * 32 + g) * 64 + cx + 32 * s; F.out[O_PSR + o] = SG.X[s][15]; F.out[O_PSI + o] = SG.X[2 + s][15]; } } }
        if (samp) { int cx = c32; asm volatile("" : "+v"(cx)); const size_t o0 = ((size_t)(l * NSAMP + 16 * hh) * 32 + g) * 64 + cx; float* qr = F.out + O_SSR + o0; float* qi = F.out + O_SSI + o0;
#pragma unroll
            for (size_t j = 0, jo = 0; j < 16; ++j) { qr[jo] = SG.X[0][j]; qr[jo + 32] = SG.X[1][j]; qi[jo] = SG.X[2][j]; qi[jo + 32] = SG.X[3][j]; jo += 2048; asm volatile("" : "+v"(jo)); } }
        LDS_WAIT();
#pragma unroll
        for (int mt = 0; mt < 2; ++mt) {
            f32x4 y = {0.f, 0.f, 0.f, 0.f};
#pragma unroll
            for (int ks = 0; ks < 4; ++ks) { const bf16x8 hf = *(const LAS bf16x8*)(Hm + (16 * mt + t16) * 272 + (4 * ks + cq) * 16);
                y = __builtin_amdgcn_mfma_f32_16x16x32_bf16(TC.cmf[ks], hf, y, 0, 0, 0); }
            const int rl = 32 * half + 16 * mt + t16;
            const f32x4 uv = uvp[mt];
            f32x4 z;
#pragma unroll
            for (int e = 0; e < 4; ++e) z[e] = gelu_tanh(y[e] + TC.dsk[e] * uv[e]);
            *(LAS v2u*)(Zs + SWZ(rl, col >> 3, 1024) + (col & 7) * 2) = (v2u){pk2(z[0], z[1]), pk2(z[2], z[3])};
        }
        LDS_WAIT();
        inx = in_n;
    }
    WG_BAR();
    SSM_CP(3);
    f32x4 G[4][4];
#pragma unroll
    for (int mt = 0; mt < 4; ++mt)
#pragma unroll
        for (int nt = 0; nt < 4; ++nt) G[mt][nt] = (f32x4){0.f, 0.f, 0.f, 0.f};
    { const bf16* Wg = (const bf16*)(ws + WS_WGLU) + (size_t)l * 512 * 512 + (size_t)(64 * w + t16) * 512 + 8 * cq;
#pragma unroll 4
      for (int ks = 0; ks < 16; ++ks) {
          bf16x8 wf[4], zf[4];
#pragma unroll
          for (int nt = 0; nt < 4; ++nt) wf[nt] = *(const bf16x8*)(Wg + (size_t)nt * 16 * 512 + 32 * ks);
#pragma unroll
          for (int mt = 0; mt < 4; ++mt) zf[mt] = *(const LAS bf16x8*)(Zs + SWZ(16 * mt + t16, 4 * ks + cq, 1024));
#pragma unroll
          for (int mt = 0; mt < 4; ++mt)
#pragma unroll
              for (int nt = 0; nt < 4; ++nt) G[mt][nt] = __builtin_amdgcn_mfma_f32_16x16x32_bf16(wf[nt], zf[mt], G[mt][nt], 0, 0, 0);
      } }
#pragma unroll
    for (int mt = 0; mt < 4; ++mt) { float ss = 0.f; const int rl = 16 * mt + t16;
#pragma unroll
        for (int nt = 0; nt < 4; ++nt) { const int col = 64 * w + 16 * nt + 4 * cq; const f32x4 bg = *(const f32x4*)(AR.in[IN_BGLU] + l * 512 + col);
            const v2u zz = *(const LAS v2u*)(Zs + SWZ(rl, col >> 3, 1024) + (col & 7) * 2);
            const float zv[4] = {bf2f((unsigned short)(zz.x & 0xffffu)), bf2f((unsigned short)(zz.x >> 16)), bf2f((unsigned short)(zz.y & 0xffffu)), bf2f((unsigned short)(zz.y >> 16))};
#pragma unroll
            for (int e = 0; e < 4; ++e) { const float o = zv[e] * sigmoidf_(G[mt][nt][e] + bg[e]); G[mt][nt][e] = o; ss += o * o; } }
        ss += __shfl_xor(ss, 16); ss += __shfl_xor(ss, 32);
        if (cq == 0) red[rl * 8 + w] = ss; }
    SSM_CP(4);
    WG_BAR();
    { const rsrc_t rs_ = ws_rsrc(ws);
#pragma unroll
      for (int mt = 0; mt < 4; ++mt) { const int rl = 16 * mt + t16; const LAS f32x4* rp = (const LAS f32x4*)(red + rl * 8); const f32x4 a = rp[0], b2 = rp[1];
          const float rsn = rsqrtf(((a[0] + a[1]) + (a[2] + a[3]) + (b2[0] + b2[1]) + (b2[2] + b2[3])) * (1.0f / 512.0f) + EPS);
          const int od = cq & 1; const size_t mo = WS_MIX + ((size_t)(row0 + rl) * DM + 1024 + 64 * w + 4 * (cq & ~1)) * 2 + (od ? 32 : 0);
#pragma unroll
          for (int nt = 0; nt < 4; nt += 2) {
              const unsigned a0 = pk2(G[mt][nt][0] * rsn, G[mt][nt][1] * rsn), a1 = pk2(G[mt][nt][2] * rsn, G[mt][nt][3] * rsn);
              const unsigned b0 = pk2(G[mt][nt + 1][0] * rsn, G[mt][nt + 1][1] * rsn), b1 = pk2(G[mt][nt + 1][2] * rsn, G[mt][nt + 1][3] * rsn);
              const unsigned s0 = od ? a0 : b0, s1 = od ? a1 : b1;
              const unsigned r0 = (unsigned)__shfl_xor((int)s0, 16), r1 = (unsigned)__shfl_xor((int)s1, 16);
              ST16(rs_, mo + 32 * nt, (od ? (v4u){r0, r1, b0, b1} : (v4u){a0, a1, r0, r1})); } } }
    WG_BAR();
}
#undef SSM_ROWS4

template <int WLEN>
__device__ __forceinline__ void pool_half(const float* XP, float* out, int l, int ch, int rfirst, int rl0, LAS unsigned char* Ds) {
    float xv[48];
#pragma unroll
    for (int i = 0; i < 48; ++i) { const int ra = rfirst + i - 16; xv[i] = (ra >= 0) ? XP[(size_t)ra * 512 + ch] : 0.f; }
    int seg = (rfirst >= TT) ? TT : 0;
    float sum = 0.f;
#pragma unroll
    for (int j = 1; j <= WLEN; ++j) if (rfirst - j >= seg) sum += xv[16 - j];
#pragma unroll
    for (int i = 0; i < 32; ++i) {
        const int ra = rfirst + i; const float x = xv[16 + i];
        if (ra == TT) { seg = TT; sum = 0.f; }
        sum += x;
        if (ra - WLEN >= seg) sum -= xv[16 + i - WLEN];
        const int cnt = (ra - seg + 1 < WLEN) ? (ra - seg + 1) : WLEN;
        const float dm = sum * __builtin_amdgcn_rcpf((float)cnt) - x;
        if (ra >= TT - 15 && ra < TT) out[O_PP + ((size_t)(l * NBATCH + 0) * 15 + (ra - (TT - 15))) * 512 + ch] = x;
        if (ra >= SROW0 - 15) out[O_PP + ((size_t)(l * NBATCH + 1) * 15 + (ra - (SROW0 - 15))) * 512 + ch] = x;
        const int r = rl0 + i;
        *(LAS bf16*)(Ds + SWZ(r, ch >> 3, 1024) + (ch & 7) * 2) = (bf16)(pk2(dm, 0.f) & 0xffffu);
    }
}
template <int WLEN>
__device__ __forceinline__ void pool_sample_rows(const float* XP, const float* sp, float* out, int l, int ch, LAS unsigned char* Ds) {
#pragma unroll 2
    for (int s = 0; s < NSAMP; ++s) {
        const float* pp = sp + (size_t)s * 15 * 512; float pv[15];
#pragma unroll
        for (int j = 0; j < 15; ++j) pv[j] = pp[(size_t)j * 512];
        const float x = XP[(size_t)(SROW0 + s) * 512 + ch]; float a = x;
#pragma unroll
        for (int j = 16 - WLEN; j < 15; ++j) a += pv[j];
        const float dm = a * (1.0f / WLEN) - x;
        float* op = out + O_SP + ((size_t)(l * NSAMP + s) * 15) * 512 + ch;
#pragma unroll
        for (int j = 0; j < 14; ++j) op[(size_t)j * 512] = pv[j + 1];
        op[(size_t)14 * 512] = x;
        *(LAS bf16*)(Ds + SWZ(32 + s, ch >> 3, 1024) + (ch & 7) * 2) = (bf16)(pk2(dm, 0.f) & 0xffffu);
    }
}
__device__ __forceinline__ void pool_unit(const Args& AR, Frame& F, int l, int c) {
    int tid_ = F.tid(); asm volatile("" : "+v"(tid_));
    const int tid = tid_, lane = tid & 63, w = F.wave, t16 = lane & 15, cq = lane >> 4;
    const int row0 = 64 * c;
    size_t z_ = 0; asm volatile("" : "+s"(z_)); unsigned char* ws = F.ws + z_;
    const float* XP = (const float*)(ws + WS_XP);
    LAS unsigned char* Ds = F.lds;
    LAS float* red = (LAS float*)(F.lds + ESC_OFF);
    { const int ch = tid, wsel = w >> 1;
      const float* sp = AR.in[IN_SPOOL] + (size_t)l * NSAMP * 15 * 512 + ch;
#pragma unroll 1
      for (int half = 0; half < 2; ++half) {
          if (c == NCHUNK - 1 && half == 1) {
              if (wsel == 0) pool_sample_rows<2>(XP, sp, F.out, l, ch, Ds); else if (wsel == 1) pool_sample_rows<4>(XP, sp, F.out, l, ch, Ds);
              else if (wsel == 2) pool_sample_rows<8>(XP, sp, F.out, l, ch, Ds); else pool_sample_rows<16>(XP, sp, F.out, l, ch, Ds);
          } else {
              const int rfirst = row0 + 32 * half;
              if (wsel == 0) pool_half<2>(XP, F.out, l, ch, rfirst, 32 * half, Ds); else if (wsel == 1) pool_half<4>(XP, F.out, l, ch, rfirst, 32 * half, Ds);
              else if (wsel == 2) pool_half<8>(XP, F.out, l, ch, rfirst, 32 * half, Ds); else pool_half<16>(XP, F.out, l, ch, rfirst, 32 * half, Ds);
          }
      } }
    WG_BAR();
    const int gp = w & 3, rh = w >> 2;
    f32x4 A[2][8];
#pragma unroll
    for (int mt = 0; mt < 2; ++mt)
#pragma unroll
        for (int nt = 0; nt < 8; ++nt) A[mt][nt] = (f32x4){0.f, 0.f, 0.f, 0.f};
    { const bf16* Wp = (const bf16*)(ws + WS_WPOOL) + ((size_t)(l * 4 + gp) * 128 + t16) * 128 + 8 * cq;
#pragma unroll
      for (int ks = 0; ks < 4; ++ks) {
          bf16x8 df[2];
#pragma unroll
          for (int mt = 0; mt < 2; ++mt) df[mt] = *(const LAS bf16x8*)(Ds + SWZ(32 * rh + 16 * mt + t16, 16 * gp + 4 * ks + cq, 1024));
#pragma unroll
          for (int nt = 0; nt < 8; ++nt) { const bf16x8 wf = *(const bf16x8*)(Wp + (size_t)nt * 16 * 128 + 32 * ks);
#pragma unroll
              for (int mt = 0; mt < 2; ++mt) A[mt][nt] = __builtin_amdgcn_mfma_f32_16x16x32_bf16(wf, df[mt], A[mt][nt], 0, 0, 0); }
      } }
#pragma unroll
    for (int mt = 0; mt < 2; ++mt) { float ss = 0.f;
#pragma unroll
        for (int nt = 0; nt < 8; ++nt) { const f32x4 sc = *(const f32x4*)(AR.in[IN_PSCALE] + l * 512 + 128 * gp + 16 * nt + 4 * cq);
#pragma unroll
            for (int e = 0; e < 4; ++e) { const float o = A[mt][nt][e] * sc[e]; A[mt][nt][e] = o; ss += o * o; } }
        ss += __shfl_xor(ss, 16); ss += __shfl_xor(ss, 32);
        if (cq == 0) red[(32 * rh + 16 * mt + t16) * 4 + gp] = ss; }
    WG_BAR();
    { const rsrc_t rs_ = ws_rsrc(ws);
#pragma unroll
      for (int mt = 0; mt < 2; ++mt) { const int rl = 32 * rh + 16 * mt + t16; const f32x4 a = *(const LAS f32x4*)(red + rl * 4);
          const float rsn = rsqrtf(((a[0] + a[1]) + (a[2] + a[3])) * (1.0f / 512.0f) + EPS);
          const int od = cq & 1; const size_t mo = WS_MIX + ((size_t)(row0 + rl) * DM + 1536 + 128 * gp + 4 * (cq & ~1)) * 2 + (od ? 32 : 0);
#pragma unroll
          for (int nt = 0; nt < 8; nt += 2) {
              const unsigned a0 = pk2(A[mt][nt][0] * rsn, A[mt][nt][1] * rsn), a1 = pk2(A[mt][nt][2] * rsn, A[mt][nt][3] * rsn);
              const unsigned b0 = pk2(A[mt][nt + 1][0] * rsn, A[mt][nt + 1][1] * rsn), b1 = pk2(A[mt][nt + 1][2] * rsn, A[mt][nt + 1][3] * rsn);
              const unsigned s0 = od ? a0 : b0, s1 = od ? a1 : b1;
              const unsigned r0 = (unsigned)__shfl_xor((int)s0, 16), r1 = (unsigned)__shfl_xor((int)s1, 16);
              ST16(rs_, mo + 32 * nt, (od ? (v4u){r0, r1, b0, b1} : (v4u){a0, a1, r0, r1})); } } }
    WG_BAR();
}

#ifndef ACQ_SCOPE
#define ACQ_SCOPE "agent"
#endif
#ifndef PE_ROW_OWNED
#define PE_ROW_OWNED 0
#endif
#ifndef PUBLISH_FENCE
#define PUBLISH_FENCE 0
#endif
enum { U_END = 0, U_PA = 1, U_PC = 2, U_PD = 3, U_PE = 4, U_SSM = 5, U_ATT = 6, U_SATT = 7, U_POOL = 8 };
constexpr int NPANEL = MP / 256;
constexpr int QCAP = 1024;
__host__ __device__ constexpr unsigned mkd(int type, int l, int a, int b) { return ((unsigned)type << 24) | ((unsigned)l << 20) | ((unsigned)a << 10) | (unsigned)b; }
__device__ __forceinline__ gu32* cnt_word(gu32* ctl, int l, int kind, int pm) { return ctl + CW_CNT + ((l * 5 + kind) * 40 + pm) * 16; }
__host__ __device__ constexpr unsigned mix_target(int pm) { return 3u * (unsigned)((MR - 256 * pm) < 256 ? (MR - 256 * pm) : 256); }

__device__ __forceinline__ void build_queue(unsigned* qt, int q) {
    int n = 1;
    for (int l = 0; l < NLAYER; ++l) {
        for (int pm = 0; pm < NPANEL; ++pm) { qt[n++] = mkd(U_PA, l, pm, q); if ((pm & 7) == q) { qt[n++] = mkd(U_PA, l, pm, 8); qt[n++] = mkd(U_PA, l, pm, 9); } }
        for (int c = q; c < NCHUNK; c += 8) qt[n++] = mkd(U_SSM, l, c, 0);
        for (int i = q; i < NBATCH * NQB; i += 8) qt[n++] = mkd(U_ATT, l, i, 0);
        for (int s = q; s < NSAMP; s += 8) qt[n++] = mkd(U_SATT, l, s, 0);
        for (int c = q; c < NCHUNK; c += 8) qt[n++] = mkd(U_POOL, l, c, 0);
        for (int pm = 0; pm < NPANEL; ++pm) qt[n++] = mkd(U_PC, l, pm, q);
        for (int pm = 0; pm < NPANEL; ++pm) for (int j = 0; j < 4; ++j) qt[n++] = mkd(U_PD, l, pm, 4 * q + j);
#if PE_ROW_OWNED
        for (int pm = q; pm < NPANEL - 1; pm += 8) for (int pn = 0; pn < 8; ++pn) qt[n++] = mkd(U_PE, l, pm, pn);
        qt[n++] = mkd(U_PE, l, NPANEL - 1, q);
#else
        for (int pm = 0; pm < NPANEL; ++pm) qt[n++] = mkd(U_PE, l, pm, q);
#endif
    }
    qt[0] = (unsigned)(n - 1);
}

struct Sched {
    gu32* ctl; const unsigned* qglob; LAS unsigned* qlds; volatile LAS unsigned* slot; int myq; unsigned nclaim; int ptype;
    __device__ __forceinline__ unsigned claim_lane() {
        { unsigned ho = (unsigned)(CW_QHEAD + myq * 64); asm volatile("" : "+s"(ho));
          const unsigned idx = __hip_atomic_fetch_add(ctl + ho, 1u, RLX_AGENT); if (idx < qlds[0]) return qlds[1 + idx]; }
        for (int k = 1; k < 8; ++k) { const int q = (myq + k) & 7; const unsigned* qg = qglob + (size_t)q * QCAP;
            if (__hip_atomic_load((gu32*)(ctl + CW_QHEAD + q * 64), RLX_AGENT) >= qg[0]) continue;
            const unsigned idx = __hip_atomic_fetch_add(ctl + CW_QHEAD + q * 64, 1u, RLX_AGENT); if (idx < qg[0]) return qg[1 + idx]; }
        return 0u;
    }
    __device__ __forceinline__ unsigned claim_wg(int tid) {
        const unsigned k = nclaim++ & 1u;
        if (tid == 0) slot[k] = claim_lane();
        WG_BAR();
        return slot[k];
    }
    __device__ __forceinline__ void poll(gu32* w, unsigned want) {
        unsigned sp = 0;
#if PROBE && PROBE_KIND == 1
        if (__hip_atomic_load(w, RLX_AGENT) >= want) return;
        struct TAcc { unsigned long long t0; volatile LAS unsigned* acc; bool on; __device__ ~TAcc() { if (on) acc[6] += (unsigned)(__builtin_amdgcn_s_memrealtime() - t0); } } tacc_{__builtin_amdgcn_s_memrealtime(), slot, PROBE_TYPE == 0 || ptype == PROBE_TYPE};
#endif
        while (__hip_atomic_load(w, RLX_AGENT) < want) { __builtin_amdgcn_s_sleep(2);
            if ((++sp & 1023u) == 0u) { if (__hip_atomic_load(ctl + CW_TMO, RLX_AGENT) != 0u) break; if (sp > (1u << 17)) { __hip_atomic_store(ctl + CW_TMO, 0x66u, RLX_AGENT); break; } } }
    }
    __device__ __forceinline__ bool ready_now(gu32* w, unsigned want) { return __hip_atomic_load(w, RLX_AGENT) >= want; }
    __device__ __forceinline__ bool deps_ready_now(unsigned d) {
        const int type = d >> 24, l = (d >> 20) & 15, a = (d >> 10) & 1023; bool ok = true;
        if (type == U_PA) { if (l > 0) { const int p2 = (a + 1 < NPANEL) ? a + 1 : NPANEL - 1; ok = ready_now(cnt_word(ctl, l - 1, 4, a), 8u) && ready_now(cnt_word(ctl, l - 1, 1, p2), mix_target(p2)); } }
        else if (type == U_PC) ok = ready_now(cnt_word(ctl, l, 1, a), mix_target(a));
        else if (type == U_PD) ok = ready_now(cnt_word(ctl, l, 2, a), 8u);
        else ok = ready_now(cnt_word(ctl, l, 3, a), 32u);
        if (ok) { __builtin_amdgcn_fence(__ATOMIC_ACQUIRE, ACQ_SCOPE); asm volatile("s_waitcnt vmcnt(0)" ::: "memory"); }
        return ok;
    }
    __device__ __forceinline__ void wait_deps(unsigned d, int tid) {
        if (tid == 0) {
            const int type = d >> 24, l = (d >> 20) & 15, a = (d >> 10) & 1023; ptype = type;
            if (type == U_PA) { if (l > 0) { poll(cnt_word(ctl, l - 1, 4, a), 8u); const int p2 = (a + 1 < NPANEL) ? a + 1 : NPANEL - 1; poll(cnt_word(ctl, l - 1, 1, p2), mix_target(p2)); } }
            else if (type == U_PC) poll(cnt_word(ctl, l, 1, a), mix_target(a));
            else if (type == U_PD) poll(cnt_word(ctl, l, 2, a), 8u);
            else if (type == U_PE) poll(cnt_word(ctl, l, 3, a), 32u);
            else if (type == U_SSM) poll(cnt_word(ctl, l, 0, a >> 2), 10u);
            else if (type == U_POOL) { poll(cnt_word(ctl, l, 0, a >> 2), 10u); const int r0 = 64 * a - 16; if (r0 >= 0) poll(cnt_word(ctl, l, 0, r0 >> 8), 10u); }
            else if (type == U_SATT) poll(cnt_word(ctl, l, 0, NPANEL - 1), 10u);
            else if (type == U_ATT) { const int b = a / NQB, i = a % NQB, t0 = 32 * i; const int rlo = b * TT + (t0 >= 128 ? t0 - 128 : 0), rhi = b * TT + ((t0 + 31 < TT) ? t0 + 31 : TT - 1);
                poll(cnt_word(ctl, l, 0, rlo >> 8), 10u); if ((rhi >> 8) != (rlo >> 8)) poll(cnt_word(ctl, l, 0, rhi >> 8), 10u); }
            __builtin_amdgcn_fence(__ATOMIC_ACQUIRE, ACQ_SCOPE);
            asm volatile("s_waitcnt vmcnt(0)" ::: "memory");
        }
        asm volatile("" ::: "memory"); __builtin_amdgcn_s_barrier(); asm volatile("" ::: "memory");
    }
    __device__ __forceinline__ void publish(unsigned d, int tid) {
        asm volatile("s_waitcnt vmcnt(0)" ::: "memory");
        WG_BAR();
        if (tid == 0) {
            const int type = d >> 24, l = (d >> 20) & 15, a = (d >> 10) & 1023;
#if PUBLISH_FENCE
            __builtin_amdgcn_fence(__ATOMIC_RELEASE, "agent");
            asm volatile("s_waitcnt vmcnt(0)" ::: "memory");
#endif
            if (type == U_PA) __hip_atomic_fetch_add(cnt_word(ctl, l, 0, a), 1u, RLX_AGENT);
            else if (type == U_PC) __hip_atomic_fetch_add(cnt_word(ctl, l, 2, a), 1u, RLX_AGENT);
            else if (type == U_PD) __hip_atomic_fetch_add(cnt_word(ctl, l, 3, a), 1u, RLX_AGENT);
            else if (type == U_PE) __hip_atomic_fetch_add(cnt_word(ctl, l, 4, a), 1u, RLX_AGENT);
            else if (type == U_SSM || type == U_POOL) __hip_atomic_fetch_add(cnt_word(ctl, l, 1, a >> 2), 64u, RLX_AGENT);
            else if (type == U_SATT) __hip_atomic_fetch_add(cnt_word(ctl, l, 1, NPANEL - 1), 1u, RLX_AGENT);
            else if (type == U_ATT) { const int b = a / NQB, i = a % NQB, t0 = 32 * i; const int r0 = b * TT + t0, r1 = b * TT + ((t0 + 31 < TT) ? t0 + 31 : TT - 1);
                const int p0 = r0 >> 8, p1 = r1 >> 8;
                if (p0 == p1) __hip_atomic_fetch_add(cnt_word(ctl, l, 1, p0), (unsigned)(r1 - r0 + 1), RLX_AGENT);
                else { __hip_atomic_fetch_add(cnt_word(ctl, l, 1, p0), (unsigned)(256 * p1 - r0), RLX_AGENT); __hip_atomic_fetch_add(cnt_word(ctl, l, 1, p1), (unsigned)(r1 - 256 * p1 + 1), RLX_AGENT); } }
        }
    }
};

#ifndef A_AUX
#define A_AUX 0
#endif
struct GU { const char* A; const char* B; unsigned voffA[2], voffB[2]; size_t hstep; int nt; unsigned d; pg8::Unit u; };

struct StreamCtx { unsigned char* ws; float* out; const float* gq; const float* gk; int R[2], C[2], Rp[2]; };
__device__ __forceinline__ void gu_fill(GU& g, unsigned d, const StreamCtx& X) {
    const int type = d >> 24, l = (d >> 20) & 15, pm = (d >> 10) & 1023, pn = d & 1023;
    unsigned char* ws = X.ws;
    const bf16* A; const bf16* B; int K = DM; bool perm = false;
    if (type == U_PA) { A = (const bf16*)(ws + WS_XB); B = (const bf16*)(ws + WS_WIN) + (size_t)l * INW * DM; }
    else if (type == U_PC) { A = (const bf16*)(ws + WS_MIX); B = (const bf16*)(ws + WS_WOUT) + (size_t)l * DM * DM; perm = true; }
    else if (type == U_PD) { A = (const bf16*)(ws + WS_XB); B = (const bf16*)(ws + WS_W1) + (size_t)l * DFF * DM; perm = true; }
    else { A = (const bf16*)(ws + WS_H); B = (const bf16*)(ws + WS_W2) + (size_t)l * DM * DFF; K = DFF; perm = true; }
    g.d = d; g.u.pm = pm; g.u.pn = pn; g.nt = K / 64; g.hstep = (size_t)128 * K * 2;
    g.A = (const char*)A + (size_t)pm * 256 * K * 2; g.B = (const char*)B + (size_t)pn * 256 * K * 2;
#pragma unroll
    for (int i = 0; i < 2; ++i) { g.voffA[i] = (unsigned)(X.R[i] * K + X.C[i]) * 2u; g.voffB[i] = (unsigned)((perm ? X.Rp[i] : X.R[i]) * K + X.C[i]) * 2u; }
}

__device__ __forceinline__ unsigned gemm_stream(const Args& AR, Frame& F, Sched& Q, unsigned d0) {
    int tid_ = F.tid(); asm volatile("" : "+v"(tid_));
    const int tid = tid_, wid = __builtin_amdgcn_readfirstlane(tid >> 6), lane = tid & 63, wr = wid >> 2, wc = wid & 3, fr = lane & 15, fq = lane >> 4;
    LAS unsigned char* lds = F.lds; LAS unsigned char* esc = F.lds + ESC_OFF;
    StreamCtx X; X.ws = F.ws; X.out = F.out;
#pragma unroll
    for (int i = 0; i < 2; ++i) { int R, C; pg8::stage_rc(tid * 16 + i * 8192, R, C); X.R[i] = R; X.C[i] = C; X.Rp[i] = (R & ~31) + pg8::perm32(R & 31); }
    const size_t kstep = (size_t)(pg8::BK * 2);
    const unsigned ldsw = (unsigned)wid * 1024u;
    const int aoff = pg8::lds_byte(wr * 64 + fr, fq * 8), boff = pg8::lds_byte(wc * 32 + fr, fq * 8);
#define PG8_SA(b, h) (((b) * 2 + (h)) * pg8::HTB)
#define PG8_SB(b, h) ((4 + (b) * 2 + (h)) * pg8::HTB)
#define PG8_STAGE(bufoff, gbase, voff) do { _Pragma("unroll") for (int _i = 0; _i < 2; ++_i) \
        __builtin_amdgcn_global_load_lds((const unsigned*)((const char*)(gbase) + (voff)[_i]), (LAS unsigned*)(lds + (bufoff) + ldsw + _i * 8192), 16, 0, 0); } while (0)
#define PG8_STAGE_A(bufoff, gbase, voff) do { _Pragma("unroll") for (int _i = 0; _i < 2; ++_i) \
        __builtin_amdgcn_global_load_lds((const unsigned*)((const char*)(gbase) + (voff)[_i]), (LAS unsigned*)(lds + (bufoff) + ldsw + _i * 8192), 16, 0, A_AUX); } while (0)
#define PG8_LDA(dst, b, h) do { _Pragma("unroll") for (int m = 0; m < 4; ++m) _Pragma("unroll") for (int k = 0; k < 2; ++k) dst[m][k] = *(const LAS bf16x8*)(lds + PG8_SA(b, h) + aoff + m * 2048 + k * 1024); } while (0)
#define PG8_LDB(dst, b, h) do { _Pragma("unroll") for (int n = 0; n < 2; ++n) _Pragma("unroll") for (int k = 0; k < 2; ++k) dst[n][k] = *(const LAS bf16x8*)(lds + PG8_SB(b, h) + boff + n * 2048 + k * 1024); } while (0)
#define PG8_MMA(ai, bj, At, Bt) do { if (mm[ai]) { __builtin_amdgcn_s_setprio(1); _Pragma("unroll") for (int m = 0; m < 4; ++m) _Pragma("unroll") for (int n = 0; n < 2; ++n) _Pragma("unroll") for (int k = 0; k < 2; ++k) \
        acc[ai][bj][m][n] = __builtin_amdgcn_mfma_f32_16x16x32_bf16(Bt[n][k], At[m][k], acc[ai][bj][m][n], 0, 0, 0); __builtin_amdgcn_s_setprio(0); } } while (0)
#define PG8_WAIT_V(n) asm volatile("s_waitcnt vmcnt(" #n ")" ::: "memory")
#define PG8_WAIT_L(n) asm volatile("s_waitcnt lgkmcnt(" #n ")" ::: "memory")
#define PG8_BAR __builtin_amdgcn_s_barrier()
#define PG8_SCHED __builtin_amdgcn_sched_barrier(0)
    GU cur;
    gu_fill(cur, d0, X);
    f32x4 acc[2][2][4][2];
#pragma unroll
    for (int a = 0; a < 2; ++a)
#pragma unroll
        for (int b = 0; b < 2; ++b)
#pragma unroll
            for (int m = 0; m < 4; ++m)
#pragma unroll
                for (int n = 0; n < 2; ++n) acc[a][b][m][n] = (f32x4){0.f, 0.f, 0.f, 0.f};
    bf16x8 At[4][2], B0[2][2], B1[2][2];
    Q.wait_deps(cur.d, tid);
    PG8_STAGE(PG8_SB(0, 0), cur.B, cur.voffB); PG8_STAGE(PG8_SB(0, 1), cur.B + cur.hstep, cur.voffB); PG8_STAGE_A(PG8_SA(0, 0), cur.A, cur.voffA); PG8_STAGE_A(PG8_SA(0, 1), cur.A + cur.hstep, cur.voffA);
    if (wr == 1) PG8_BAR;
    PG8_WAIT_V(2); PG8_BAR;
    PG8_STAGE(PG8_SB(1, 0), cur.B + kstep, cur.voffB); PG8_STAGE_A(PG8_SA(1, 0), cur.A + kstep, cur.voffA); PG8_STAGE(PG8_SB(1, 1), cur.B + cur.hstep + kstep, cur.voffB);
    PG8_WAIT_V(6); PG8_BAR;
    unsigned carry = 0u; unsigned ui = 0u;
    for (;;) {
        bool go = false;
        const char* cA = cur.A; const char* cB = cur.B; const size_t hstep = cur.hstep; const int nt = cur.nt;
#if PROBE && PROBE_KIND == 3
        const unsigned long long tu0 = __builtin_amdgcn_s_memrealtime();
#endif
        const bool fullp = cur.u.pm != NPANEL - 1; const bool mm[2] = {fullp || wr == 0, fullp};
        for (int t = 0; t < nt; t += 2) {
            const bool last = (t == nt - 2);
            const char* a1 = cA + (size_t)(t + 1) * kstep;
            const char* a2_ = cA + (size_t)(last ? 0 : t + 2) * kstep; const char* b2_ = cB + (size_t)(last ? 0 : t + 2) * kstep;
            const char* a2 = a2_; const char* b2 = b2_; size_t h2 = hstep;
            unsigned vA2[2], vB2[2];
#pragma unroll
            for (int i = 0; i < 2; ++i) { vA2[i] = cur.voffA[i]; vB2[i] = cur.voffB[i]; }
            if (last) {
                const unsigned k = 2u + (ui & 1u);
#if PROBE && PROBE_KIND == 8
                const unsigned long long tc0 = __builtin_amdgcn_s_memrealtime();
#endif
                if (tid == 0) { const unsigned dn = Q.claim_lane(); Q.slot[k] = dn;
                    Q.slot[2u + k] = ((dn >> 24) >= U_PA && (dn >> 24) <= U_PE && (!STREAM_SAME_SECTION || ((dn >> 20) == (cur.d >> 20))) && Q.deps_ready_now(dn)) ? 1u : 0u; }
                asm volatile("s_waitcnt lgkmcnt(0)" ::: "memory"); PG8_BAR; asm volatile("" ::: "memory");
                carry = Q.slot[k]; go = Q.slot[2u + k] != 0u;
#if PROBE && PROBE_KIND == 8
                if (tid == 0 && (int)(cur.d >> 24) == PROBE_TYPE) { Q.slot[6] += (unsigned)(__builtin_amdgcn_s_memrealtime() - tc0); Q.slot[7] += 1u; }
#endif
                if (go) { GU n2; gu_fill(n2, carry, X); a2 = n2.A; b2 = n2.B; h2 = n2.hstep;
#pragma unroll
                    for (int i = 0; i < 2; ++i) { vA2[i] = n2.voffA[i]; vB2[i] = n2.voffB[i]; } }
            }
            const char* a3 = a2 + kstep; const char* b3 = b2 + kstep;
            PG8_LDB(B0, 0, 0); PG8_LDB(B1, 0, 1); PG8_SCHED; PG8_LDA(At, 0, 0); PG8_STAGE_A(PG8_SA(1, 1), a1 + hstep, cur.voffA);
            PG8_WAIT_V(8); PG8_WAIT_L(0); PG8_BAR; PG8_MMA(0, 0, At, B0); PG8_MMA(0, 1, At, B1); PG8_BAR; PG8_SCHED;
            PG8_LDA(At, 0, 1); PG8_STAGE(PG8_SB(0, 0), b2, vB2); PG8_STAGE(PG8_SB(0, 1), b2 + h2, vB2); PG8_STAGE_A(PG8_SA(0, 0), a2, vA2);
            PG8_WAIT_V(8); PG8_WAIT_L(0); PG8_BAR; PG8_MMA(1, 0, At, B0); PG8_MMA(1, 1, At, B1); PG8_BAR; PG8_SCHED;
            PG8_LDB(B0, 1, 0); PG8_LDB(B1, 1, 1); PG8_SCHED; PG8_LDA(At, 1, 0); PG8_STAGE_A(PG8_SA(0, 1), a2 + h2, vA2);
            PG8_WAIT_V(8); PG8_WAIT_L(0); PG8_BAR; PG8_MMA(0, 0, At, B0); PG8_MMA(0, 1, At, B1); PG8_BAR; PG8_SCHED;
            PG8_LDA(At, 1, 1); PG8_STAGE(PG8_SB(1, 0), b3, vB2); PG8_STAGE(PG8_SB(1, 1), b3 + h2, vB2); PG8_STAGE_A(PG8_SA(1, 0), a3, vA2);
            PG8_WAIT_V(8); PG8_WAIT_L(0); PG8_BAR; PG8_MMA(1, 0, At, B0); PG8_MMA(1, 1, At, B1); PG8_BAR; PG8_SCHED;
        }
#if PROBE && PROBE_KIND == 7
        const unsigned long long te0 = __builtin_amdgcn_s_memrealtime();
#endif
        if (wr == 0) PG8_BAR;
        { const int type = cur.d >> 24, l = (cur.d >> 20) & 15;
          if (type == U_PA) { EpiProj E{X.ws, X.out, AR.in[IN_GQ] + l * 128, AR.in[IN_GK] + l * 128, l}; E(acc, cur.u, wr, wc, fr, fq, esc, tid); }
          else if (type == U_PD) { EpiFfn1 E{X.ws}; E(acc, cur.u, wr, wc, fr, fq, esc, tid); }
          else { EpiRes E{X.ws, X.out, (type == U_PE && l == NLAYER - 1) ? 1 : 0}; E(acc, cur.u, wr, wc, fr, fq, esc, tid); }
          Q.publish(cur.d, tid);
#if PROBE && PROBE_KIND == 7
          if (tid == 0 && (int)(cur.d >> 24) == PROBE_TYPE && cur.u.pm != NPANEL - 1) { Q.slot[6] += (unsigned)(__builtin_amdgcn_s_memrealtime() - te0); Q.slot[7] += 1u; }
#endif
#if PROBE && PROBE_KIND == 3
          if (tid == 0 && (int)(cur.d >> 24) == PROBE_TYPE && cur.u.pm != NPANEL - 1) { Q.slot[6] += (unsigned)(__builtin_amdgcn_s_memrealtime() - tu0); Q.slot[7] += 1u; }
#endif
          }
        if (!go) break;
#pragma unroll
        for (int a = 0; a < 2; ++a)
#pragma unroll
            for (int b = 0; b < 2; ++b)
#pragma unroll
                for (int m = 0; m < 4; ++m)
#pragma unroll
                    for (int n = 0; n < 2; ++n) acc[a][b][m][n] = (f32x4){0.f, 0.f, 0.f, 0.f};
        gu_fill(cur, carry, X); ++ui;
        if (wr == 1) PG8_BAR;
    }
    PG8_WAIT_V(0);
    PG8_BAR;
#undef PG8_SA
#undef PG8_SB
#undef PG8_STAGE
#undef PG8_STAGE_A
#undef PG8_LDA
#undef PG8_LDB
#undef PG8_MMA
#undef PG8_WAIT_V
#undef PG8_WAIT_L
#undef PG8_BAR
#undef PG8_SCHED
    return carry;
}

__global__ void __launch_bounds__(512, 2) hymba_fwd(Args args) {
    extern __shared__ __attribute__((aligned(16))) unsigned char lds[];
    Frame F;
    F.lds = (LAS unsigned char*)lds;
    F.MISC = (volatile LAS unsigned*)(F.lds + MISC_OFF);
    F.wave = __builtin_amdgcn_readfirstlane((int)(threadIdx.x >> 6));
    F.G = gridDim.x; { const int bx = blockIdx.x; F.vcu = (F.G % 8 == 0) ? (bx % 8) * (F.G / 8) + bx / 8 : bx; }
    F.ws = args.ws; F.out = args.out; F.ctl = (gu32*)(args.ws + WS_CTL);
    for (int u = F.tid(); u < (LDS_BYTES - LDSCTL_OFF) / 4; u += 512) ((LAS unsigned*)(F.lds + LDSCTL_OFF))[u] = 0u;
    __syncthreads();
    XcdBarrier bar = xcd_barrier_post((unsigned*)(F.ctl + CW_BAR), F.MISC + 8);
#if PROBE
    const unsigned long long tk0 = __builtin_amdgcn_s_memrealtime();
#endif
    for (int rep = 0; rep < DUP_P0; ++rep) p0_prologue(args, F);
#if PROBE && (PROBE_KIND == 5 || PROBE_KIND == 6)
    if (F.tid() == 0) { F.MISC[6] = (unsigned)(__builtin_amdgcn_s_memrealtime() - tk0); if (PROBE_KIND == 6) __hip_atomic_fetch_max(F.ctl + CW_STAT + 48, F.MISC[6], RLX_AGENT); }
#endif
    if (blockIdx.x < 8 && F.tid() == 0) build_queue((unsigned*)(args.ws + WS_QUEUE) + (size_t)blockIdx.x * QCAP, (int)blockIdx.x);
    xcd_barrier(bar);
    Sched Q; Q.ctl = F.ctl; Q.qglob = (const unsigned*)(args.ws + WS_QUEUE); Q.qlds = (LAS unsigned*)(F.lds + QTAB_OFF); Q.slot = F.MISC; Q.myq = __builtin_amdgcn_readfirstlane((int)(bar.x & 7u)); Q.nclaim = 0u; Q.ptype = 0;
    { const unsigned* qg = Q.qglob + (size_t)Q.myq * QCAP; for (int i = F.tid(); i < QCAP; i += 512) Q.qlds[i] = qg[i]; }
    WG_BAR();
    unsigned d = Q.claim_wg(F.tid());
#if SEC_BARRIER
    int cursec = 0;
#endif
    for (;;) {
        const int type = d >> 24;
#if SEC_BARRIER
        { const int sec = (type == U_END) ? 5 * NLAYER : ((d >> 20) & 15) * 5 + ((type >= U_SSM) ? 1 : (type == U_PA ? 0 : type));
          while (cursec < sec) { if ((SEC_MASK >> cursec) & 1) xcd_barrier(bar); ++cursec; } }
#endif
        if (type == U_END) break;
        if (type <= U_PE) {
#if PROBE && PROBE_KIND == 9
            const unsigned long long ts0 = __builtin_amdgcn_s_memrealtime();
#endif
            d = gemm_stream(args, F, Q, d);
#if PROBE && PROBE_KIND == 9
            if (F.tid() == 0) { F.MISC[6] += (unsigned)(__builtin_amdgcn_s_memrealtime() - ts0); }
#endif
            continue; }
        const int l = (d >> 20) & 15, a = (d >> 10) & 1023;
        Q.wait_deps(d, F.tid());
#if PROBE && PROBE_KIND == 2
        const unsigned long long tp0 = __builtin_amdgcn_s_memrealtime();
#endif
        if (type == U_SSM) ssm_unit(args, F, l, a);
        else if (type == U_ATT) attn_unit(args, F, l, a / NQB, a % NQB);
        else if (type == U_SATT) sattn_unit(args, F, l, a);
        else pool_unit(args, F, l, a);
        Q.publish(d, F.tid());
#if PROBE && PROBE_KIND == 2
        if (F.tid() == 0 && (PROBE_TYPE == 0 || type == PROBE_TYPE)) F.MISC[6] += (unsigned)(__builtin_amdgcn_s_memrealtime() - tp0);
#endif
        d = Q.claim_wg(F.tid());
    }
#if PROBE
    if (F.tid() == 0) {
        const unsigned tend = (unsigned)(__builtin_amdgcn_s_memrealtime() - tk0);
        if (PROBE_KIND == 4) { F.MISC[6] = tend; __hip_atomic_fetch_max(F.ctl + CW_STAT + 48, tend, RLX_AGENT); }
        __hip_atomic_fetch_add(F.ctl + CW_STAT, F.MISC[6], RLX_AGENT);
        __hip_atomic_fetch_add(F.ctl + CW_STAT + 32, F.MISC[7], RLX_AGENT);
        const unsigned n = __hip_atomic_fetch_add(F.ctl + CW_STAT + 16, 1u, RLX_AGENT);
        F.MISC[7] = (n == gridDim.x - 1) ? 1u : 0u;
        if (n == gridDim.x - 1) { F.MISC[5] = __hip_atomic_load(F.ctl + CW_STAT, RLX_AGENT); F.MISC[4] = __hip_atomic_load(F.ctl + CW_STAT + 32, RLX_AGENT); F.MISC[3] = __hip_atomic_load(F.ctl + CW_STAT + 48, RLX_AGENT); }
    }
    WG_BAR();
    if (F.MISC[7]) { float v = (float)F.MISC[5] / (float)gridDim.x * 0.01f;
        if (PROBE_KIND == 3 || PROBE_KIND == 7 || PROBE_KIND == 8) v = (float)F.MISC[5] * 0.01f / (float)(F.MISC[4] ? F.MISC[4] : 1u);
        if (PROBE_KIND == 4) v = (float)F.MISC[3] * 0.01f - v;
        if (PROBE_KIND == 6) v = (float)F.MISC[3] * 0.01f;
        v = floorf((v + 0.5f * PROBE_Q) / PROBE_Q) * PROBE_Q;
        for (int i = F.tid(); i < NLAYER * NSAMP * 15 * 512; i += 512) F.out[O_SP + i] = v; }
#endif
}

extern "C" void kernel_launch(void* const* d_in, const int* in_sizes, int n_in, void* d_out, int out_size, void* d_ws, size_t ws_size, hipStream_t stream) {
    static int grid = 0;
    if (grid == 0) {
        if (n_in != 32 || (size_t)out_size != O_END || ws_size < WS_END) { fprintf(stderr, "kernel_launch: unexpected shapes: n_in %d out %d (want %zu) ws %zu (want >= %zu)\n", n_in, out_size, (size_t)O_END, ws_size, (size_t)WS_END); grid = -1; return; }
        int dev = 0, cus = 0, per_cu = 0;
        if (hipGetDevice(&dev) != hipSuccess || hipDeviceGetAttribute(&cus, hipDeviceAttributeMultiprocessorCount, dev) != hipSuccess) { fprintf(stderr, "kernel_launch: device query failed\n"); grid = -1; return; }
        if (hipFuncSetAttribute((const void*)hymba_fwd, hipFuncAttributeMaxDynamicSharedMemorySize, LDS_BYTES) != hipSuccess) { fprintf(stderr, "kernel_launch: hipFuncSetAttribute failed\n"); grid = -1; return; }
        if (hipOccupancyMaxActiveBlocksPerMultiprocessor(&per_cu, (const void*)hymba_fwd, 512, LDS_BYTES) != hipSuccess || per_cu < 1) { fprintf(stderr, "kernel_launch: occupancy query says %d blocks per CU\n", per_cu); per_cu = 1; }
        (void)hipGetLastError();
        grid = cus;
        if (grid % 8 != 0) grid -= grid % 8;
    }
    if (grid < 0) return;
    (void)hipMemsetAsync((char*)d_ws + WS_CTL, 0, CTL_ZERO_BYTES, stream);
    Args a{};
    for (int i = 0; i < 32; ++i) a.in[i] = (const float*)d_in[i];
    a.out = (float*)d_out; a.ws = (unsigned char*)d_ws; a.ph_lo = 0; a.ph_hi = 0;
    hipLaunchKernelGGL(hymba_fwd, dim3(grid), dim3(512), LDS_BYTES, stream, a);
    const hipError_t le = hipPeekAtLastError();
    if (le != hipSuccess) fprintf(stderr, "kernel_launch: launch failed: %s\n", hipGetErrorName(le));
}
```

```cpp
#include <hip/hip_runtime.h>
#include <cstdio>
#include <cstdint>

#ifndef MK_N_LAUNCHES
#define MK_N_LAUNCHES 1
#endif

#ifndef SEC_BARRIER
#define SEC_BARRIER 0
#endif
#ifndef STREAM_SAME_SECTION
#define STREAM_SAME_SECTION 0
#endif
#ifndef SEC_MASK
#define SEC_MASK 0x10
#endif
#ifndef PROBE
#define PROBE 0
#endif
#ifndef PROBE_KIND
#define PROBE_KIND 1
#endif
#ifndef PROBE_TYPE
#define PROBE_TYPE 0
#endif
#ifndef PROBE_Q
#define PROBE_Q 20.0f
#endif
#ifndef DUP_PB
#define DUP_PB 1
#endif
#ifndef DUP_P0
#define DUP_P0 1
#endif

constexpr int DM = 2048, TT = 4112  , NSEQ = 4096, NMETA = 16, NBATCH = 2, NSAMP = 32;
constexpr int MR = NBATCH * TT + NSAMP;
constexpr int MP = 8448;
constexpr int SROW0 = NBATCH * TT;
constexpr int INW = 2560, DFF = 8192, NLAYER = 2;
constexpr int TPV = 4128;
constexpr int ROPE_SAMPLE_IDX = TT;
constexpr float EPS = 1e-6f;
constexpr float LOG2E = 1.4426950408889634f;
constexpr float QSCALE = 0.08838834764831845f * LOG2E;
constexpr int NCHUNK = MR / 64;
constexpr int NQB = (TT + 31) / 32;

constexpr size_t O_YP = 0, O_YS = O_YP + (size_t)NBATCH * NSEQ * DM, O_PK = O_YS + (size_t)NSAMP * DM, O_PV = O_PK + (size_t)NLAYER * NBATCH * 128 * 256,
                 O_PSR = O_PV + (size_t)NLAYER * NBATCH * 128 * 256, O_PSI = O_PSR + (size_t)NLAYER * NBATCH * 2048, O_PP = O_PSI + (size_t)NLAYER * NBATCH * 2048,
                 O_SK = O_PP + (size_t)NLAYER * NBATCH * 15 * 512, O_SV = O_SK + (size_t)NLAYER * NSAMP * 128 * 256, O_SSR = O_SV + (size_t)NLAYER * NSAMP * 128 * 256,
                 O_SSI = O_SSR + (size_t)NLAYER * NSAMP * 2048, O_SP = O_SSI + (size_t)NLAYER * NSAMP * 2048, O_END = O_SP + (size_t)NLAYER * NSAMP * 15 * 512;

constexpr size_t MiB = 1u << 20;
constexpr size_t WS_CTL = 0, CTL_ZERO_BYTES = 1 * MiB;
constexpr size_t WS_WIN = 1 * MiB, WS_WOUT = 21 * MiB, WS_W1 = 37 * MiB, WS_W2 = 101 * MiB, WS_WGLU = 165 * MiB, WS_WPOOL = 166 * MiB, WS_TAB = 167 * MiB;
constexpr size_t WS_X = 170 * MiB, WS_XB = 236 * MiB, WS_Q = 269 * MiB, WS_K = 286 * MiB, WS_VT = 291 * MiB, WS_U = 296 * MiB, WS_XP = 313 * MiB, WS_MIX = 330 * MiB,
                 WS_H = 363 * MiB, WS_SSQ = 495 * MiB, WS_SST = 497 * MiB, WS_KSN = 502 * MiB, WS_QUEUE = 503 * MiB, WS_END = 504 * MiB;
static_assert(WS_WIN + (size_t)NLAYER * INW * DM * 2 <= WS_WOUT && WS_WOUT + (size_t)NLAYER * DM * DM * 2 <= WS_W1 && WS_W1 + (size_t)NLAYER * DFF * DM * 2 <= WS_W2 && WS_W2 + (size_t)NLAYER * DFF * DM * 2 <= WS_WGLU, "ws map 1");
static_assert(WS_X + (size_t)MP * DM * 4 <= WS_XB && WS_XB + (size_t)MP * DM * 2 <= WS_Q && WS_Q + (size_t)MP * 1024 * 2 <= WS_K && WS_K + (size_t)MP * 256 * 2 <= WS_VT && WS_VT + (size_t)4 * 128 * TPV * 2 <= WS_U, "ws map 2");
static_assert(WS_U + (size_t)MP * 512 * 4 <= WS_XP && WS_XP + (size_t)MP * 512 * 4 <= WS_MIX && WS_MIX + (size_t)MP * DM * 2 <= WS_H && WS_H + (size_t)MP * DFF * 2 <= WS_SSQ && WS_SSQ + (size_t)MP * 32 * 4 <= WS_SST, "ws map 3");
static_assert(WS_SST + (size_t)NLAYER * NCHUNK * 32 * 64 * 8 <= WS_KSN, "ws map 4");
constexpr size_t TB_ABR = 0, TB_ABI = 8192, TB_ALR = 16384, TB_ALI = 24576, TB_A16R = 32768, TB_A16I = 40960, TB_A32R = 49152, TB_A32I = 57344,
                 TB_BBR = 65536, TB_BBI = TB_BBR + 131072, TB_PM = TB_BBI + 131072, TB_CMT = TB_PM + 524288, TB_LAYER = 1 * MiB;
static_assert(TB_CMT + 131072 <= TB_LAYER, "table map");
constexpr size_t WS_ROPE = WS_TAB + 2 * MiB;
constexpr size_t ROPE_N = (size_t)(TT + 1) * 16;
constexpr int CW_TMO = 0, CW_CODE = 1, CW_BAR = 4096, CW_QHEAD = 8192  , CW_STAT = 8800, CW_CNT = 9216  , CW_SSMF = 16384  ;
static_assert(CW_CNT + NLAYER * 5 * 40 * 16 <= CW_SSMF, "ctl map: counters");
static_assert((CW_SSMF + NLAYER * NCHUNK * 8 * 16) * 4 <= (int)CTL_ZERO_BYTES, "ctl map");

constexpr int RING_BYTES = 131072, ESC_OFF = RING_BYTES  , QTAB_OFF = ESC_OFF + 12288  , LDSCTL_OFF = QTAB_OFF + 4096, MISC_OFF = LDSCTL_OFF + 320, LDS_BYTES = 148480;
static_assert(MISC_OFF + 128 <= LDS_BYTES, "LDS map");

#define GAS __attribute__((address_space(1)))
#define LAS __attribute__((address_space(3)))
typedef unsigned short bf16;
typedef unsigned v4u __attribute__((ext_vector_type(4)));
typedef unsigned v2u __attribute__((ext_vector_type(2)));
typedef float f32x2 __attribute__((ext_vector_type(2)));
typedef float f32x16 __attribute__((ext_vector_type(16)));
typedef __bf16 bf16x2_t __attribute__((ext_vector_type(2)));
typedef GAS unsigned gu32;
typedef GAS unsigned long long gu64;
#define RLX_AGENT __ATOMIC_RELAXED, __HIP_MEMORY_SCOPE_AGENT
#define LDS_WAIT() asm volatile("s_waitcnt lgkmcnt(0)" ::: "memory")
#define VM_WAIT() asm volatile("s_waitcnt vmcnt(0)" ::: "memory")
#define WG_BAR() do { asm volatile("s_waitcnt lgkmcnt(0)" ::: "memory"); __builtin_amdgcn_s_barrier(); asm volatile("" ::: "memory"); } while (0)
__device__ __forceinline__ unsigned pk2(float lo, float hi) { f32x2 v = {lo, hi}; bf16x2_t b = __builtin_convertvector(v, bf16x2_t); return __builtin_bit_cast(unsigned, b); }
__device__ __forceinline__ float bf2f(unsigned short h) { return __builtin_bit_cast(float, (unsigned)h << 16); }
__device__ __forceinline__ float wave_sum(float v) {
#pragma unroll
    for (int o = 1; o < 64; o <<= 1) v += __shfl_xor(v, o);
    return v;
}
__device__ __forceinline__ float wave_max(float v) {
#pragma unroll
    for (int o = 1; o < 64; o <<= 1) v = fmaxf(v, __shfl_xor(v, o));
    return v;
}

typedef __amdgpu_buffer_rsrc_t rsrc_t;
__device__ __forceinline__ rsrc_t ws_rsrc(unsigned char* ws) { return __builtin_amdgcn_make_buffer_rsrc(ws, 0, (int)WS_END, 0x00020000); }
#define ST16(r, off, v) __builtin_amdgcn_raw_buffer_store_b128(__builtin_bit_cast(v4u, (v)), (r), (unsigned)(off), 0, 16)
#define ST8(r, off, v)  __builtin_amdgcn_raw_buffer_store_b64((v), (r), (unsigned)(off), 0, 16)
#define ST4(r, off, v)  __builtin_amdgcn_raw_buffer_store_b32(__builtin_bit_cast(unsigned, (v)), (r), (unsigned)(off), 0, 16)
#define ST2(r, off, v)  __builtin_amdgcn_raw_buffer_store_b16((unsigned short)(v), (r), (unsigned)(off), 0, 16)
__host__ __device__ __forceinline__ int perm16(int o) { return 8 * ((o >> 2) & 1) + 4 * (o >> 3) + (o & 3); }

namespace pg8 {
#define PG8_LAS __attribute__((address_space(3)))
typedef unsigned short bf16_t;
typedef short bf16x8 __attribute__((ext_vector_type(8)));
typedef float f32x4 __attribute__((ext_vector_type(4)));
typedef unsigned u32x4 __attribute__((ext_vector_type(4)));
constexpr int BM = 256, BK = 64, HALF = 128, HTB = HALF * BK * 2  , STAGE_BYTES = 8 * HTB, NXCD = 8, WGM = 8;

__host__ __device__ __forceinline__ int lds_byte(int r, int c) { const int st = (r >> 4) * 2 + (c >> 5), rr = r & 15, cc = c & 31, ob = rr * 64 + cc * 2; return st * 1024 + (ob ^ (((ob >> 9) & 1) << 5)); }
__host__ __device__ __forceinline__ void stage_rc(int b, int& R, int& C) { const int st = b / 1024, sb = b % 1024, swz = sb ^ (((sb >> 9) & 1) << 5); R = (st >> 1) * 16 + swz / 64; C = (st & 1) * 32 + (swz % 64) / 2; }
__host__ __device__ __forceinline__ int perm32(int rho) { const int n = rho >> 4, i = rho & 15; return 8 * (i >> 2) + 4 * n + (i & 3); }

struct Unit { int pm, pn; };
struct Gemm { const bf16_t* A; const bf16_t* Bt; int M, N, K; };

struct StaticOrder {
    int nM, nN, nwg, G, c;
    __host__ __device__ void init(int M, int N, int G_, int c_) { nM = M / BM; nN = N / BM; nwg = nM * nN; G = G_; c = c_; }
    __host__ __device__ bool next(int i, Unit& u) const {
        const long L = (long)i * G + c; if (L >= nwg) return false;
        int wgid = (int)L; { const int q = nwg / NXCD, r = nwg % NXCD, xcd = wgid % NXCD, off = wgid / NXCD; wgid = (xcd < r ? xcd * (q + 1) : r * (q + 1) + (xcd - r) * q) + off; }
        const int nig = WGM * nN, gid = wgid / nig, fm = gid * WGM, gsz = (nM - fm) < WGM ? (nM - fm) : WGM;
        u.pm = fm + ((wgid % nig) % gsz); u.pn = (wgid % nig) / gsz; return true;
    }
    __device__ __forceinline__ void a_ready(const Unit&) const {}
    __device__ __forceinline__ void done(const Unit&) const {}
};


template <class Epi, class Sched, bool ALIGN_EPI = false, bool SP2 = false>
__device__ __forceinline__ void gemm_phase(PG8_LAS unsigned char* lds, PG8_LAS unsigned char* esc, const Gemm g, const Sched& S, const Epi& E) {
    int tid_ = threadIdx.x; asm volatile("" : "+v"(tid_));
    const int tid = tid_, wid = __builtin_amdgcn_readfirstlane(tid >> 6), lane = tid & 63, wr = wid >> 2, wc = wid & 3, fr = lane & 15, fq = lane >> 4;
    const int K = g.K, nt = K / BK;
    unsigned voffA[2], voffB[2];
#pragma unroll
    for (int i = 0; i < 2; ++i) { int R, C; stage_rc(tid * 16 + i * 8192, R, C); const int Rb = Epi::PERM ? ((R & ~31) + perm32(R & 31)) : R;
        voffA[i] = (unsigned)(R * K + C) * 2u; voffB[i] = (unsigned)(Rb * K + C) * 2u; }
    const size_t kstep = (size_t)(BK * 2);
    const size_t hstep = (size_t)HALF * K * 2;
    const size_t tstep = 2 * hstep;
    const unsigned ldsw = (unsigned)wid * 1024u;
    const int aoff = lds_byte(wr * 64 + fr, fq * 8), boff = lds_byte(wc * 32 + fr, fq * 8);
#define PG8_SA(b, h) (((b) * 2 + (h)) * HTB)
#define PG8_SB(b, h) ((4 + (b) * 2 + (h)) * HTB)
#define PG8_STAGE(bufoff, gbase, voff) do { _Pragma("unroll") for (int _i = 0; _i < 2; ++_i) \
        __builtin_amdgcn_global_load_lds((const unsigned*)((const char*)(gbase) + (voff)[_i]), (PG8_LAS unsigned*)(lds + (bufoff) + ldsw + _i * 8192), 16, 0, 0); } while (0)
#define PG8_LDA(dst, b, h) do { _Pragma("unroll") for (int m = 0; m < 4; ++m) _Pragma("unroll") for (int k = 0; k < 2; ++k) dst[m][k] = *(const PG8_LAS bf16x8*)(lds + PG8_SA(b, h) + aoff + m * 2048 + k * 1024); } while (0)
#define PG8_LDB(dst, b, h) do { _Pragma("unroll") for (int n = 0; n < 2; ++n) _Pragma("unroll") for (int k = 0; k < 2; ++k) dst[n][k] = *(const PG8_LAS bf16x8*)(lds + PG8_SB(b, h) + boff + n * 2048 + k * 1024); } while (0)
#define PG8_MMA(ai, bj, At, Bt) do { __builtin_amdgcn_s_setprio(1); _Pragma("unroll") for (int m = 0; m < 4; ++m) _Pragma("unroll") for (int n = 0; n < 2; ++n) _Pragma("unroll") for (int k = 0; k < 2; ++k) \
        acc[ai][bj][m][n] = __builtin_amdgcn_mfma_f32_16x16x32_bf16(Bt[n][k], At[m][k], acc[ai][bj][m][n], 0, 0, 0); __builtin_amdgcn_s_setprio(0); } while (0)
#define PG8_WAIT_V(n) asm volatile("s_waitcnt vmcnt(" #n ")" ::: "memory")
#define PG8_WAIT_L(n) asm volatile("s_waitcnt lgkmcnt(" #n ")" ::: "memory")
#define PG8_BAR __builtin_amdgcn_s_barrier()
#define PG8_SCHED __builtin_amdgcn_sched_barrier(0)
    Unit cur, nxt; int ui = 0;
    if (!S.next(0, cur)) return;
    f32x4 acc[2][2][4][2];
#pragma unroll
    for (int a = 0; a < 2; ++a)
#pragma unroll
        for (int b = 0; b < 2; ++b)
#pragma unroll
            for (int m = 0; m < 4; ++m)
#pragma unroll
                for (int n = 0; n < 2; ++n) acc[a][b][m][n] = (f32x4){0.f, 0.f, 0.f, 0.f};
    bf16x8 At[4][2], B0[2][2], B1[2][2];
    const char* cA = (const char*)g.A + (size_t)cur.pm * tstep; const char* cB = (const char*)g.Bt + (size_t)cur.pn * tstep;
    S.a_ready(cur);
    if constexpr (SP2) {
        PG8_STAGE(PG8_SB(0, 0), cB, voffB); PG8_STAGE(PG8_SB(0, 1), cB + hstep, voffB); PG8_STAGE(PG8_SA(0, 0), cA, voffA); PG8_STAGE(PG8_SA(0, 1), cA + hstep, voffA);
        if (wr == 1) PG8_BAR;
        PG8_WAIT_V(2); PG8_BAR;
        PG8_STAGE(PG8_SB(1, 0), cB + kstep, voffB); PG8_STAGE(PG8_SA(1, 0), cA + kstep, voffA); PG8_STAGE(PG8_SB(1, 1), cB + hstep + kstep, voffB);
        PG8_WAIT_V(6); PG8_BAR;
    } else {
        PG8_STAGE(PG8_SB(0, 0), cB, voffB); PG8_STAGE(PG8_SA(0, 0), cA, voffA); PG8_STAGE(PG8_SB(0, 1), cB + hstep, voffB); PG8_STAGE(PG8_SA(0, 1), cA + hstep, voffA);
        if (wr == 1) PG8_BAR;
        PG8_WAIT_V(4); PG8_BAR;
        PG8_STAGE(PG8_SB(1, 0), cB + kstep, voffB); PG8_STAGE(PG8_SA(1, 0), cA + kstep, voffA); PG8_STAGE(PG8_SB(1, 1), cB + hstep + kstep, voffB);
        PG8_WAIT_V(6); PG8_BAR;
    }
    for (;;) {
        const bool has_next = S.next(ui + 1, nxt);
        const char* nA = has_next ? (const char*)g.A + (size_t)nxt.pm * tstep : cA; const char* nB = has_next ? (const char*)g.Bt + (size_t)nxt.pn * tstep : cB;
        for (int t = 0; t < nt; t += 2) {
            const bool last = (t == nt - 2);
            const char* a1 = cA + (size_t)(t + 1) * kstep;
            const char* a2 = last ? nA : cA + (size_t)(t + 2) * kstep; const char* b2 = last ? nB : cB + (size_t)(t + 2) * kstep;
            const char* a3 = a2 + kstep; const char* b3 = b2 + kstep;
            if (last && has_next) S.a_ready(nxt);
            if constexpr (SP2) {
            PG8_LDB(B0, 0, 0); PG8_LDB(B1, 0, 1); PG8_SCHED; PG8_LDA(At, 0, 0); PG8_STAGE(PG8_SA(1, 1), a1 + hstep, voffA);
            PG8_WAIT_V(8); PG8_WAIT_L(0); PG8_BAR; PG8_MMA(0, 0, At, B0); PG8_MMA(0, 1, At, B1); PG8_BAR; PG8_SCHED;
            PG8_LDA(At, 0, 1); PG8_STAGE(PG8_SB(0, 0), b2, voffB); PG8_STAGE(PG8_SB(0, 1), b2 + hstep, voffB); PG8_STAGE(PG8_SA(0, 0), a2, voffA);
            PG8_WAIT_V(8); PG8_WAIT_L(0); PG8_BAR; PG8_MMA(1, 0, At, B0); PG8_MMA(1, 1, At, B1); PG8_BAR; PG8_SCHED;
            PG8_LDB(B0, 1, 0); PG8_LDB(B1, 1, 1); PG8_SCHED; PG8_LDA(At, 1, 0); PG8_STAGE(PG8_SA(0, 1), a2 + hstep, voffA);
            PG8_WAIT_V(8); PG8_WAIT_L(0); PG8_BAR; PG8_MMA(0, 0, At, B0); PG8_MMA(0, 1, At, B1); PG8_BAR; PG8_SCHED;
            PG8_LDA(At, 1, 1); PG8_STAGE(PG8_SB(1, 0), b3, voffB); PG8_STAGE(PG8_SB(1, 1), b3 + hstep, voffB); PG8_STAGE(PG8_SA(1, 0), a3, voffA);
            PG8_WAIT_V(8); PG8_WAIT_L(0); PG8_BAR; PG8_MMA(1, 0, At, B0); PG8_MMA(1, 1, At, B1); PG8_BAR; PG8_SCHED;
            } else {
            PG8_LDB(B0, 0, 0); PG8_SCHED; PG8_LDA(At, 0, 0); PG8_STAGE(PG8_SA(1, 1), a1 + hstep, voffA);
            PG8_WAIT_L(8); PG8_BAR; PG8_WAIT_L(0); PG8_MMA(0, 0, At, B0); PG8_BAR; PG8_SCHED;
            PG8_LDB(B1, 0, 1); PG8_STAGE(PG8_SB(0, 0), b2, voffB);
            PG8_BAR; PG8_WAIT_L(0); PG8_MMA(0, 1, At, B1); PG8_BAR;
            PG8_LDA(At, 0, 1); PG8_STAGE(PG8_SA(0, 0), a2, voffA);
            PG8_BAR; PG8_WAIT_L(0); PG8_MMA(1, 0, At, B0); PG8_BAR; PG8_SCHED;
            PG8_STAGE(PG8_SB(0, 1), b2 + hstep, voffB);
            PG8_WAIT_V(6); PG8_BAR; PG8_MMA(1, 1, At, B1); PG8_BAR;
            PG8_LDB(B0, 1, 0); PG8_SCHED; PG8_LDA(At, 1, 0); PG8_STAGE(PG8_SA(0, 1), a2 + hstep, voffA);
            PG8_WAIT_L(8); PG8_BAR; PG8_WAIT_L(0); PG8_MMA(0, 0, At, B0); PG8_BAR; PG8_SCHED;
            PG8_LDB(B1, 1, 1); PG8_STAGE(PG8_SB(1, 0), b3, voffB);
            PG8_BAR; PG8_WAIT_L(0); PG8_MMA(0, 1, At, B1); PG8_BAR;
            PG8_LDA(At, 1, 1); PG8_STAGE(PG8_SA(1, 0), a3, voffA);
            PG8_BAR; PG8_WAIT_L(0); PG8_MMA(1, 0, At, B0); PG8_BAR; PG8_SCHED;
            PG8_STAGE(PG8_SB(1, 1), b3 + hstep, voffB);
            PG8_WAIT_V(6); PG8_BAR; PG8_MMA(1, 1, At, B1); PG8_BAR;
            }
        }
        if constexpr (ALIGN_EPI) { if (wr == 0) PG8_BAR; }
        { E(acc, cur, wr, wc, fr, fq, esc, tid); S.done(cur); }
        if (!has_next) break;
#pragma unroll
        for (int a = 0; a < 2; ++a)
#pragma unroll
            for (int b = 0; b < 2; ++b)
#pragma unroll
                for (int m = 0; m < 4; ++m)
#pragma unroll
                    for (int n = 0; n < 2; ++n) acc[a][b][m][n] = (f32x4){0.f, 0.f, 0.f, 0.f};
        cur = nxt; cA = nA; cB = nB; ++ui;
        if constexpr (ALIGN_EPI) { if (wr == 1) PG8_BAR; }
    }
    PG8_WAIT_V(0);
    if constexpr (!ALIGN_EPI) { if (wr == 0) PG8_BAR; }
    PG8_BAR;
#undef PG8_SA
#undef PG8_SB
#undef PG8_STAGE
#undef PG8_LDA
#undef PG8_LDB
#undef PG8_MMA
#undef PG8_WAIT_V
#undef PG8_WAIT_L
#undef PG8_BAR
#undef PG8_SCHED
}
}

typedef float f32x4 __attribute__((ext_vector_type(4)));
typedef short bf16x8 __attribute__((ext_vector_type(8)));


__device__ __forceinline__ void build_rs(const float* ssq, int pm, LAS unsigned char* esc, int tid) {
    LAS float* rsT = (LAS float*)esc;
    WG_BAR();
    if (tid < 256) {
        float s = 0.f;
#pragma unroll
        for (int j = 0; j < 8; ++j) { const gu64* p = (const gu64*)(ssq + ((size_t)j * MP + pm * 256 + tid) * 4);
#pragma unroll
            for (int h = 0; h < 2; ++h) { const unsigned long long v = __hip_atomic_load(p + h, RLX_AGENT); s += __builtin_bit_cast(float, (unsigned)v) + __builtin_bit_cast(float, (unsigned)(v >> 32)); } }
        rsT[tid] = rsqrtf(s * (1.0f / DM) + EPS);
    }
    WG_BAR();
}

struct EpiProj {
    static constexpr bool PERM = false, AFTER_DRAIN = false;
    unsigned char* ws_; float* out_; const float* gq; const float* gk; int l;
    __device__ __forceinline__ void operator()(f32x4 (&acc)[2][2][4][2], const pg8::Unit& u, int wr, int wc, int fr, int fq, LAS unsigned char* esc, int tid) const {
        asm volatile("" : "+v"(fr), "+v"(fq), "+v"(tid));
        size_t z_ = 0; asm volatile("" : "+s"(z_)); unsigned char* ws = ws_ + z_;
        const float* ssq = (const float*)(ws + WS_SSQ); const float* ropec = (const float*)(ws + WS_ROPE); const float* ropes = ropec + ROPE_N;
        bf16* Q = (bf16*)(ws + WS_Q); bf16* K = (bf16*)(ws + WS_K); bf16* VT = (bf16*)(ws + WS_VT); float* U = (float*)(ws + WS_U); float* XP = (float*)(ws + WS_XP);
        float* ksn = (float*)(ws + WS_KSN); float* vsn = ksn + NSAMP * 256;
        float* out_pk = out_ + O_PK + (size_t)l * NBATCH * 128 * 256; float* out_pv = out_ + O_PV + (size_t)l * NBATCH * 128 * 256;
        const rsrc_t rs_ = ws_rsrc(ws);
        build_rs(ssq, u.pm, esc, tid);
        const LAS float* rsT = (const LAS float*)esc;
        LAS float* hss = (LAS float*)(esc + 1024);
        const int pn = u.pn;
#pragma unroll
        for (int ai = 0; ai < 2; ++ai)
#pragma unroll
            for (int m = 0; m < 4; ++m) { const float rsv = rsT[ai * 128 + wr * 64 + m * 16 + fr];
#pragma unroll
                for (int bj = 0; bj < 2; ++bj)
#pragma unroll
                    for (int n = 0; n < 2; ++n) acc[ai][bj][m][n] *= rsv; }
        if (pn <= 4) {
#pragma unroll
            for (int ai = 0; ai < 2; ++ai)
#pragma unroll
                for (int m = 0; m < 4; ++m)
#pragma unroll
                    for (int bj = 0; bj < 2; ++bj) { const f32x4 a = acc[ai][bj][m][0], b = acc[ai][bj][m][1];
                        float s = (a[0] * a[0] + a[1] * a[1]) + (a[2] * a[2] + a[3] * a[3]) + (b[0] * b[0] + b[1] * b[1]) + (b[2] * b[2] + b[3] * b[3]);
                        s += __shfl_xor(s, 16); s += __shfl_xor(s, 32);
                        if (fq == 0) hss[(bj * 256 + ai * 128 + wr * 64 + m * 16 + fr) * 4 + wc] = s; }
            WG_BAR();
            const float* g = (pn < 4) ? gq : gk; const float osc = (pn < 4) ? QSCALE : 1.0f;
            f32x4 gv[2];
#pragma unroll
            for (int n = 0; n < 2; ++n) gv[n] = *(const f32x4*)(g + wc * 32 + n * 16 + 4 * fq);
#pragma unroll
            for (int ai = 0; ai < 2; ++ai)
#pragma unroll
                for (int m = 0; m < 4; ++m) {
                    const int rl = ai * 128 + wr * 64 + m * 16 + fr, r = u.pm * 256 + rl;
                    const bool samp = r >= SROW0, pad = r >= MR;
                    const int b = (r >= TT && !samp) ? 1 : 0, t = r - b * TT;
                    const int pidx = samp ? ROPE_SAMPLE_IDX : t;
                    f32x4 cs = {1.f, 1.f, 1.f, 1.f}, sn = {0.f, 0.f, 0.f, 0.f};
                    if (wc == 0 && !pad) { cs = *(const f32x4*)(ropec + (size_t)pidx * 16 + 4 * fq); sn = *(const f32x4*)(ropes + (size_t)pidx * 16 + 4 * fq); }
#pragma unroll
                    for (int bj = 0; bj < 2; ++bj) {
                        const f32x4 hv = *(const LAS f32x4*)(hss + (bj * 256 + rl) * 4);
                        const float hn = rsqrtf(((hv[0] + hv[1]) + (hv[2] + hv[3])) * (1.0f / 128.0f) + EPS);
                        f32x4 x1 = acc[ai][bj][m][0] * hn * gv[0], x2 = acc[ai][bj][m][1] * hn * gv[1];
                        if (wc == 0) { const f32x4 o1 = x1 * cs - x2 * sn, o2 = x2 * cs + x1 * sn; x1 = o1; x2 = o2; }
                        x1 = x1 * osc; x2 = x2 * osc;
                        const int cl = bj * 128 + wc * 32 + 4 * fq;
                        { const int od = fq & 1; const unsigned a0 = pk2(x1[0], x1[1]), a1 = pk2(x1[2], x1[3]), b0 = pk2(x2[0], x2[1]), b1 = pk2(x2[2], x2[3]);
                          const unsigned s0 = od ? a0 : b0, s1 = od ? a1 : b1; const unsigned r0 = (unsigned)__shfl_xor((int)s0, 16), r1 = (unsigned)__shfl_xor((int)s1, 16);
                          const v4u w16 = od ? (v4u){r0, r1, b0, b1} : (v4u){a0, a1, r0, r1};
                          const int cl16 = bj * 128 + wc * 32 + 4 * (fq & ~1) + (od ? 16 : 0);
                          if (pn < 4) ST16(rs_, WS_Q + ((size_t)r * 1024 + pn * 256 + cl16) * 2, w16); else ST16(rs_, WS_K + ((size_t)r * 256 + cl16) * 2, w16); }
                        if (pn == 4) {
                            if (samp && !pad) { const size_t o = WS_KSN + ((size_t)(r - SROW0) * 256 + cl) * 4; ST16(rs_, o, x1); ST16(rs_, o + 64, x2); }
                            else if (!samp && t >= TT - 128) { float* o = out_pk + ((size_t)(b * 128 + (t - (TT - 128))) * 256) + cl; *(f32x4*)o = x1; *(f32x4*)(o + 16) = x2; } }
                    }
                }
        } else if (pn == 5) {
#pragma unroll
            for (int ai = 0; ai < 2; ++ai)
#pragma unroll
                for (int m = 0; m < 4; ++m) {
                    const int rl = ai * 128 + wr * 64 + m * 16 + fr, r = u.pm * 256 + rl;
                    const bool samp = r >= SROW0, pad = r >= MR;
                    const int b = (r >= TT && !samp) ? 1 : 0, t = r - b * TT;
                    const int tpos = (t & ~15) + perm16(t & 15);
#pragma unroll
                    for (int bj = 0; bj < 2; ++bj)
#pragma unroll
                        for (int n = 0; n < 2; ++n) { const f32x4 x = acc[ai][bj][m][n]; const int d = wc * 32 + n * 16 + 4 * fq;
                            if (!samp) { const size_t vo = WS_VT + (((size_t)((b * 2 + bj) * 128 + d)) * TPV + tpos) * 2;
#pragma unroll
                                for (int j = 0; j < 4; ++j) ST2(rs_, vo + (size_t)j * TPV * 2, pk2(x[j], 0.f) & 0xffffu);
                                if (t >= TT - 128) *(f32x4*)(out_pv + ((size_t)(b * 128 + (t - (TT - 128))) * 256) + bj * 128 + d) = x; }
                            else if (!pad) ST16(rs_, WS_KSN + ((size_t)NSAMP * 256 + (size_t)(r - SROW0) * 256 + bj * 128 + d) * 4, x); }
                }
        } else {
            const size_t dsto = (pn < 8) ? WS_U + (size_t)(pn - 6) * 256 * 4 : WS_XP + (size_t)(pn - 8) * 256 * 4;
#pragma unroll
            for (int ai = 0; ai < 2; ++ai)
#pragma unroll
                for (int m = 0; m < 4; ++m) { const size_t ro = dsto + ((size_t)(u.pm * 256 + ai * 128 + wr * 64 + m * 16 + fr) * 512 + wc * 32 + 4 * fq) * 4;
#pragma unroll
                    for (int bj = 0; bj < 2; ++bj)
#pragma unroll
                        for (int n = 0; n < 2; ++n) ST16(rs_, ro + (size_t)(bj * 128 + n * 16) * 4, acc[ai][bj][m][n]); }
        }
    }
};

struct EpiRes {
    static constexpr bool PERM = true, AFTER_DRAIN = false;
    unsigned char* ws_; float* out; int last; int yinit;
    __device__ __forceinline__ void operator()(f32x4 (&acc)[2][2][4][2], const pg8::Unit& u, int wr, int wc, int fr, int fq, LAS unsigned char* esc, int tid) const {
        asm volatile("" : "+v"(fr), "+v"(fq), "+v"(tid));
        size_t z_ = 0; asm volatile("" : "+s"(z_)); unsigned char* ws = ws_ + z_;
        const bf16* XB = (const bf16*)(ws + WS_XB); const rsrc_t rs_ = ws_rsrc(ws);
        v4u xb[2][4][2];
#pragma unroll
        for (int ai = 0; ai < 2; ++ai)
#pragma unroll
            for (int m = 0; m < 4; ++m) { const bf16* xp = XB + (size_t)(u.pm * 256 + ai * 128 + wr * 64 + m * 16 + fr) * DM + u.pn * 256 + wc * 32 + 8 * fq;
#pragma unroll
                for (int bj = 0; bj < 2; ++bj) xb[ai][m][bj] = *(const v4u*)(xp + bj * 128); }
#pragma unroll
        for (int ai = 0; ai < 2; ++ai)
#pragma unroll
            for (int m = 0; m < 4; ++m) {
                const int r = u.pm * 256 + ai * 128 + wr * 64 + m * 16 + fr; const int c0 = u.pn * 256 + wc * 32 + 8 * fq;
                const size_t eo = (size_t)r * DM + c0; float s = 0.f;
                f32x4 v[2][2];
#pragma unroll
                for (int bj = 0; bj < 2; ++bj) { const v4u w = xb[ai][m][bj];
                    const f32x4 x0 = {__builtin_bit_cast(float, w.x << 16), __builtin_bit_cast(float, w.x & 0xffff0000u), __builtin_bit_cast(float, w.y << 16), __builtin_bit_cast(float, w.y & 0xffff0000u)};
                    const f32x4 x1 = {__builtin_bit_cast(float, w.z << 16), __builtin_bit_cast(float, w.z & 0xffff0000u), __builtin_bit_cast(float, w.w << 16), __builtin_bit_cast(float, w.w & 0xffff0000u)};
                    v[bj][0] = x0 + acc[ai][bj][m][0]; v[bj][1] = x1 + acc[ai][bj][m][1];
#pragma unroll
                    for (int n = 0; n < 2; ++n) { const f32x4 q = v[bj][n] * v[bj][n]; s += (q[0] + q[1]) + (q[2] + q[3]); } }
                if (!last) {
#pragma unroll
                    for (int bj = 0; bj < 2; ++bj)
                        ST16(rs_, WS_XB + (eo + bj * 128) * 2, ((v4u){pk2(v[bj][0][0], v[bj][0][1]), pk2(v[bj][0][2], v[bj][0][3]), pk2(v[bj][1][0], v[bj][1][1]), pk2(v[bj][1][2], v[bj][1][3])}));
                    s += __shfl_xor(s, 16); s += __shfl_xor(s, 32);
                    if (fq == 0) ST4(rs_, WS_SSQ + (((size_t)u.pn * MP + r) * 4 + wc) * 4, s);
                    if (yinit && r < MR) { const bool samp = r >= SROW0; const size_t yo = samp ? O_YS + (size_t)(r - SROW0) * DM + c0 : O_YP + ((size_t)NSEQ + (r - TT - NMETA)) * DM + c0;
                        const rsrc_t ro_ = __builtin_amdgcn_make_buffer_rsrc(out, 0, (int)(O_END * 4), 0x00020000);
#pragma unroll
                        for (int bj = 0; bj < 2; ++bj)
#pragma unroll
                            for (int n = 0; n < 2; ++n) ST16(ro_, (yo + bj * 128 + n * 4) * 4, v[bj][n]); }
                } else {
                    const bool samp = r >= SROW0, pad = r >= MR; const int b = (r >= TT && !samp) ? 1 : 0, t = r - b * TT;
                    float* op = nullptr;
                    if (samp) { if (!pad) op = out + O_YS + (size_t)(r - SROW0) * DM + c0; } else if (t >= NMETA) op = out + O_YP + ((size_t)b * NSEQ + (t - NMETA)) * DM + c0;
                    if (op) {
#pragma unroll
                        for (int bj = 0; bj < 2; ++bj)
#pragma unroll
                            for (int n = 0; n < 2; ++n) *(f32x4*)(op + bj * 128 + n * 4) = v[bj][n]; }
                }
            }
    }
};

struct EpiAtom {
    static constexpr bool PERM = true, AFTER_DRAIN = false;
    float* out;
    __device__ __forceinline__ void operator()(f32x4 (&acc)[2][2][4][2], const pg8::Unit& u, int wr, int wc, int fr, int fq, LAS unsigned char* esc, int tid) const {
        asm volatile("" : "+v"(fr), "+v"(fq), "+v"(tid));
        if (wr != 0) return;
#pragma unroll
        for (int m = 0; m < 4; ++m) { const int r = u.pm * 256 + m * 16 + fr; const int c0 = u.pn * 256 + wc * 32 + 8 * fq;
            const bool samp = r >= SROW0; float* op = samp ? out + O_YS + (size_t)(r - SROW0) * DM + c0 : out + O_YP + ((size_t)NSEQ + (r - TT - NMETA)) * DM + c0;
            if (r < MR) {
#pragma unroll
                for (int bj = 0; bj < 2; ++bj)
#pragma unroll
                    for (int n = 0; n < 2; ++n)
#pragma unroll
                        for (int j = 0; j < 4; ++j) __hip_atomic_fetch_add(op + bj * 128 + n * 4 + j, acc[0][bj][m][n][j], RLX_AGENT); } }
    }
};

struct EpiFfn1 {
    static constexpr bool PERM = true, AFTER_DRAIN = false;
    unsigned char* ws_;
    __device__ __forceinline__ void operator()(f32x4 (&acc)[2][2][4][2], const pg8::Unit& u, int wr, int wc, int fr, int fq, LAS unsigned char* esc, int tid) const {
        asm volatile("" : "+v"(fr), "+v"(fq), "+v"(tid));
        size_t z_ = 0; asm volatile("" : "+s"(z_)); unsigned char* ws = ws_ + z_;
        const rsrc_t rs_ = ws_rsrc(ws);
        build_rs((const float*)(ws + WS_SSQ), u.pm, esc, tid);
        const LAS float* rsT = (const LAS float*)esc;
#pragma unroll
        for (int ai = 0; ai < 2; ++ai)
#pragma unroll
            for (int m = 0; m < 4; ++m) { const int rl = ai * 128 + wr * 64 + m * 16 + fr; const float rsv = rsT[rl];
                const size_t ho = WS_H + ((size_t)(u.pm * 256 + rl) * DFF + u.pn * 256 + wc * 32 + 8 * fq) * 2;
#pragma unroll
                for (int bj = 0; bj < 2; ++bj) { f32x4 v0 = acc[ai][bj][m][0] * rsv, v1 = acc[ai][bj][m][1] * rsv;
#pragma unroll
                    for (int j = 0; j < 4; ++j) { const float a = fmaxf(v0[j], 0.f), b = fmaxf(v1[j], 0.f); v0[j] = a * a; v1[j] = b * b; }
                    ST16(rs_, ho + bj * 256, ((v4u){pk2(v0[0], v0[1]), pk2(v0[2], v0[3]), pk2(v1[0], v1[1]), pk2(v1[2], v1[3])})); } }
    }
};

#define XB_TMO      128
#define XB_XCNT(j)  (256  + 64 * (j))
#define XB_XSUB(j)  (1280 + 64 * (j))
#define XB_XGEN(j)  (2304 + 64 * (j))
#define XB_TOP      3328
#define XB_TOPGEN   3392
#define XCD_BAR_WORDS 3456
#define XB_SPIN_CAP (1u << 18)
__device__ __forceinline__ unsigned xb_ld(unsigned* p)              { return __hip_atomic_load(p, __ATOMIC_RELAXED, __HIP_MEMORY_SCOPE_AGENT); }
__device__ __forceinline__ unsigned xb_add(unsigned* p, unsigned v) { return __hip_atomic_fetch_add(p, v, __ATOMIC_RELAXED, __HIP_MEMORY_SCOPE_AGENT); }
__device__ __forceinline__ unsigned xb_xcc_id() { return (unsigned)__builtin_amdgcn_s_getreg((3 << 11) | 20) & 0xFu; }
#define XB_SPIN(cond, bar) do { unsigned _sp = 0; while (cond) { __builtin_amdgcn_s_sleep(1); \
    if ((++_sp & 255u) == 0u) { if (xb_ld(&(bar)[XB_TMO])) break; if (_sp > XB_SPIN_CAP) { atomicAdd(&(bar)[XB_TMO], 1u); break; } } } } while (0)

struct XcdBarrier {
    unsigned* bar; unsigned x;
    volatile LAS unsigned* st;
};

__device__ __forceinline__ XcdBarrier xcd_barrier_post(unsigned* bar, volatile LAS unsigned* st) {
    XcdBarrier b; b.bar = bar; b.x = xb_xcc_id(); b.st = st;
    if (threadIdx.x == 0) (void)xb_add(&bar[XB_XCNT(b.x)], 1u);
    return b;
}
__device__ __forceinline__ void xcd_barrier_complete(unsigned* bar, unsigned x, unsigned& nloc, unsigned& nx) {
    const unsigned G = gridDim.x * gridDim.y * gridDim.z;
    unsigned sum, cnt, mine, sp = 0u;
    for (;;) {
        sum = 0u; cnt = 0u; mine = 0u;
#pragma unroll
        for (unsigned j = 0; j < 16; ++j) { const unsigned c = xb_ld(&bar[XB_XCNT(j)]); sum += c; cnt += (c > 0u) ? 1u : 0u; mine = (j == x) ? c : mine; }
        if (sum == G) break;
        __builtin_amdgcn_s_sleep(1);
        if ((++sp & 255u) == 0u) { if (xb_ld(&bar[XB_TMO])) break; if (sp > XB_SPIN_CAP) { atomicAdd(&bar[XB_TMO], 1u); break; } }
    }
    nloc = mine > 0u ? mine : 1u; nx = cnt > 0u ? cnt : 1u;
}

__device__ __forceinline__ void xcd_barrier(const XcdBarrier& b) {
    asm volatile("s_waitcnt vmcnt(0)" ::: "memory");
    __syncthreads();
    if (threadIdx.x == 0) {
        unsigned* bar = b.bar;
        __builtin_amdgcn_s_waitcnt(0);
        unsigned nloc = b.st[0], nx = b.st[1];
        if (nloc == 0u) { xcd_barrier_complete(bar, b.x, nloc, nx); b.st[0] = nloc; b.st[1] = nx; }
        const unsigned old = xb_add(&bar[XB_XSUB(b.x)], 1u);
        const unsigned gen = old / nloc;
        if (old + 1u == (gen + 1u) * nloc) {
            __builtin_amdgcn_fence(__ATOMIC_RELEASE, "agent");
            asm volatile("s_waitcnt vmcnt(0)" ::: "memory");
            const unsigned og = xb_add(&bar[XB_TOP], 1u);
            const unsigned tg = og / nx;
            if (og + 1u == (tg + 1u) * nx) xb_add(&bar[XB_TOPGEN], 1u);
            else XB_SPIN(xb_ld(&bar[XB_TOPGEN]) == tg, bar);
            __builtin_amdgcn_fence(__ATOMIC_ACQUIRE, "agent");
            xb_add(&bar[XB_XGEN(b.x)], 1u);
            asm volatile("s_waitcnt vmcnt(0)" ::: "memory");
        } else {
            XB_SPIN(xb_ld(&bar[XB_XGEN(b.x)]) == gen, bar);
            __builtin_amdgcn_fence(__ATOMIC_ACQUIRE, "agent");
            asm volatile("s_waitcnt vmcnt(0)" ::: "memory");
        }
    }
    __syncthreads();
}

struct Frame {
    LAS unsigned char* lds;
    volatile LAS unsigned* MISC;
    gu32* ctl;
    int wave, vcu, G;
    __device__ __forceinline__ int lane() const { int l; asm volatile("v_mbcnt_lo_u32_b32 %0, -1, 0\n\tv_mbcnt_hi_u32_b32 %0, -1, %0" : "=v"(l)); return l; }
    __device__ __forceinline__ int tid() const { return wave * 64 + lane(); }
    float* out; unsigned char* ws;
};
#define IN_XPROMPT 0
#define IN_XSAMPLE 1
#define IN_CACHEK 2
#define IN_CACHEV 3
#define IN_SSMRE 4
#define IN_SSMIM 5
#define IN_SPOOL 6
#define IN_META 7
#define IN_GMIX 8
#define IN_WIN 9
#define IN_GQ 10
#define IN_GK 11
#define IN_SINKS 12
#define IN_ARE 13
#define IN_AIM 14
#define IN_LOGDT 15
#define IN_BRE 16
#define IN_BIM 17
#define IN_CRE 18
#define IN_CIM 19
#define IN_DSKIP 20
#define IN_WGLU 21
#define IN_BGLU 22
#define IN_WPOOL 23
#define IN_PSCALE 24
#define IN_GOA 25
#define IN_GOS 26
#define IN_GOP 27
#define IN_WOUT 28
#define IN_GFFN 29
#define IN_WFF1 30
#define IN_WFF2 31
struct Args { const float* in[32]; float* out; unsigned char* ws; int ph_lo, ph_hi; };
static_assert(sizeof(Args) == 32 * 8 + 8 + 8 + 8, "Args has no padding");

__device__ __forceinline__ void p0_transpose_item(const float* W, int K, int N, bf16* WT, const float* gain, LAS float* scr, int item, int lane) {
    const int nblk = N / 32, kb = item / nblk, nb = item % nblk, k0 = 64 * kb, n0 = 32 * nb;
    float wv[32];
#pragma unroll
    for (int i = 0; i < 32; ++i) wv[i] = W[(size_t)(k0 + 2 * i + (lane >> 5)) * N + n0 + (lane & 31)];
    if (gain) {
#pragma unroll
        for (int i = 0; i < 32; ++i) wv[i] *= gain[k0 + 2 * i + (lane >> 5)];
    }
#pragma unroll
    for (int i = 0; i < 32; ++i) scr[(2 * i + (lane >> 5)) * 33 + (lane & 31)] = wv[i];
    LDS_WAIT(); asm volatile("" ::: "memory");
    const int c = lane & 7;
#pragma unroll
    for (int j = 0; j < 4; ++j) { const int n = (lane >> 3) + 8 * j; const LAS float* s = scr + (8 * c) * 33 + n;
        v4u o; o.x = pk2(s[0 * 33], s[1 * 33]); o.y = pk2(s[2 * 33], s[3 * 33]); o.z = pk2(s[4 * 33], s[5 * 33]); o.w = pk2(s[6 * 33], s[7 * 33]);
        *(GAS v4u*)(WT + (size_t)(n0 + n) * K + k0 + 8 * c) = o; }
    LDS_WAIT(); asm volatile("" ::: "memory");
}
__device__ __forceinline__ void sincos_d(double x, double& s, double& c) {
    const double TWO_PI = 6.283185307179586476925286766559;
    const double k = rint(x * (1.0 / TWO_PI)); const double r = fma(-k, TWO_PI, x), r2 = r * r;
    const double fs[14] = {0.16666666666666666, 0.05, 0.023809523809523808, 0.013888888888888888, 0.00909090909090909, 0.00641025641025641, 0.004761904761904762, 0.003676470588235294,
                           0.0029239766081871343, 0.002380952380952381, 0.001976284584980237, 0.0016666666666666668, 0.0014245014245014246, 0.0012315270935960591};
    const double fc[14] = {0.5, 0.08333333333333333, 0.03333333333333333, 0.017857142857142856, 0.011111111111111112, 0.007575757575757576, 0.005494505494505495, 0.004166666666666667,
                           0.0032679738562091504, 0.002631578947368421, 0.0021645021645021645, 0.0018115942028985507, 0.0015384615384615385, 0.0013227513227513227};
    double ts = r, tc = 1.0; s = r; c = 1.0;
#pragma unroll
    for (int i = 0; i < 14; ++i) { ts *= -r2 * fs[i]; s += ts; tc *= -r2 * fc[i]; c += tc; }
}
__device__ __forceinline__ double exp_small(double x) {
    double t = 1.0, e = 1.0;
#pragma unroll
    for (int i = 1; i <= 14; ++i) { t *= x * (1.0 / i); e += t; }
    return e;
}
__device__ __forceinline__ void p0_prologue(const Args& AR, Frame& F) {
    LAS float* scr = (LAS float*)(F.lds + F.wave * 16384);
    const int gw = F.vcu * 8 + F.wave, NGW = F.G * 8, lane = F.lane();
    unsigned char* ws = F.ws;
    constexpr int I_IN = (DM / 64) * (INW / 32), I_OUT = (DM / 64) * (DM / 32), I_1 = (DM / 64) * (DFF / 32), I_2 = (DFF / 64) * (DM / 32), I_GLU = (512 / 64) * (512 / 32), I_POOL = 4 * 2 * 4;
    constexpr int I_LAYER = I_IN + I_OUT + I_1 + I_2 + I_GLU + I_POOL;
    for (int it = gw; it < NLAYER * I_LAYER; it += NGW) {
        const int l = it / I_LAYER; int r = it % I_LAYER;
        if (r < I_IN) { p0_transpose_item(AR.in[IN_WIN] + (size_t)l * DM * INW, DM, INW, (bf16*)(ws + WS_WIN) + (size_t)l * INW * DM, AR.in[IN_GMIX] + l * DM, scr, r, lane); continue; } r -= I_IN;
        if (r < I_OUT) { const int k0 = 64 * (r / (DM / 32));
            const float* g = (k0 < 1024) ? AR.in[IN_GOA] + l * 1024 : (k0 < 1536) ? AR.in[IN_GOS] + l * 512 - 1024 : AR.in[IN_GOP] + l * 512 - 1536;
            p0_transpose_item(AR.in[IN_WOUT] + (size_t)l * DM * DM, DM, DM, (bf16*)(ws + WS_WOUT) + (size_t)l * DM * DM, g, scr, r, lane); continue; } r -= I_OUT;
        if (r < I_1) { p0_transpose_item(AR.in[IN_WFF1] + (size_t)l * DM * DFF, DM, DFF, (bf16*)(ws + WS_W1) + (size_t)l * DFF * DM, AR.in[IN_GFFN] + l * DM, scr, r, lane); continue; } r -= I_1;
        if (r < I_2) { p0_transpose_item(AR.in[IN_WFF2] + (size_t)l * DFF * DM, DFF, DM, (bf16*)(ws + WS_W2) + (size_t)l * DM * DFF, nullptr, scr, r, lane); continue; } r -= I_2;
        if (r < I_GLU) { p0_transpose_item(AR.in[IN_WGLU] + (size_t)l * 512 * 512, 512, 512, (bf16*)(ws + WS_WGLU) + (size_t)l * 512 * 512, nullptr, scr, r, lane); continue; } r -= I_GLU;
        { const int g = r / 8; p0_transpose_item(AR.in[IN_WPOOL] + ((size_t)l * 4 + g) * 128 * 128, 128, 128, (bf16*)(ws + WS_WPOOL) + ((size_t)l * 4 + g) * 128 * 128, nullptr, scr, r % 8, lane); }
    }
    bf16* XB = (bf16*)(ws + WS_XB); float* SSQ = (float*)(ws + WS_SSQ);
    for (int m = gw; m < MP; m += NGW) {
        const float* src = nullptr;
        if (m < SROW0) { const int b = m >= TT ? 1 : 0, t = m - b * TT; src = (t < NMETA) ? AR.in[IN_META] + (size_t)t * DM : AR.in[IN_XPROMPT] + ((size_t)b * NSEQ + (t - NMETA)) * DM; }
        else if (m < MR) src = AR.in[IN_XSAMPLE] + (size_t)(m - SROW0) * DM;
        float s = 0.f;
#pragma unroll
        for (int j = 0; j < 8; ++j) { f32x4 v = {0.f, 0.f, 0.f, 0.f}; if (src) v = *(const f32x4*)(src + j * 256 + lane * 4);
            s += (v[0] * v[0] + v[1] * v[1]) + (v[2] * v[2] + v[3] * v[3]);
            *(v2u*)(XB + (size_t)m * DM + j * 256 + lane * 4) = (v2u){pk2(v[0], v[1]), pk2(v[2], v[3])}; }
        s = wave_sum(s);
        if (lane < 32) SSQ[((size_t)(lane >> 2) * MP + m) * 4 + (lane & 3)] = (lane == 0) ? s : 0.f;
    }
    const int gt = gw * 64 + lane, NGT = NGW * 64;
    for (int id = gt; id < NLAYER * 32 * 64; id += NGT) {
        const int l = id >> 11, g = (id >> 6) & 31, n = id & 63;
        unsigned char* tb = ws + WS_TAB + (size_t)l * TB_LAYER;
        const double dt = (double)expf(AR.in[IN_LOGDT][l * 32 + g]);
        const double ar = (double)AR.in[IN_ARE][id], ai = (double)AR.in[IN_AIM][id];
        const double mag = exp_small(dt * ar); double sn, cs; sincos_d(dt * ai, sn, cs);
        const double abr = mag * cs, abi = mag * sn, den = ar * ar + ai * ai;
        const double fr = ((abr - 1.0) * ar + abi * ai) / den, fi = (abi * ar - (abr - 1.0) * ai) / den;
        ((float*)(tb + TB_ABR))[g * 64 + n] = (float)abr; ((float*)(tb + TB_ABI))[g * 64 + n] = (float)abi;
        const float* Br = AR.in[IN_BRE] + (size_t)id * 16; const float* Bi = AR.in[IN_BIM] + (size_t)id * 16;
        float* bbr = (float*)(tb + TB_BBR) + (size_t)(g * 64 + n) * 16; float* bbi = (float*)(tb + TB_BBI) + (size_t)(g * 64 + n) * 16;
        bf16* bbt = (bf16*)(tb + TB_PM) + (size_t)g * 128 * 16;
#pragma unroll
        for (int c = 0; c < 16; ++c) { const double br = Br[c], bi = Bi[c]; const float vr = (float)(fr * br - fi * bi), vi = (float)(fr * bi + fi * br); bbr[c] = vr; bbi[c] = vi;
            bbt[n * 16 + c] = (bf16)(pk2(vr, 0.f) & 0xffffu); bbt[(64 + n) * 16 + c] = (bf16)(pk2(vi, 0.f) & 0xffffu); }
        double pr = abr, pi = abi;
        for (int t = 0; t < 64; ++t) {
            if (t == 15) { ((float*)(tb + TB_A16R))[g * 64 + n] = (float)pr; ((float*)(tb + TB_A16I))[g * 64 + n] = (float)pi; }
            if (t == 31) { ((float*)(tb + TB_A32R))[g * 64 + n] = (float)pr; ((float*)(tb + TB_A32I))[g * 64 + n] = (float)pi; }
            if (t == 63) { ((float*)(tb + TB_ALR))[g * 64 + n] = (float)pr; ((float*)(tb + TB_ALI))[g * 64 + n] = (float)pi; }
            const double nr = pr * abr - pi * abi, ni = pr * abi + pi * abr; pr = nr; pi = ni;
        }
        bf16* CmT = (bf16*)(tb + TB_CMT) + (size_t)g * 16 * 128;
        const float* Cr = AR.in[IN_CRE] + ((size_t)(l * 32 + g) * 16) * 64 + n; const float* Ci = AR.in[IN_CIM] + ((size_t)(l * 32 + g) * 16) * 64 + n;
#pragma unroll
        for (int c = 0; c < 16; ++c) { CmT[c * 128 + n] = (bf16)(pk2(Cr[c * 64], 0.f) & 0xffffu); CmT[c * 128 + 64 + n] = (bf16)(pk2(-Ci[c * 64], 0.f) & 0xffffu); }
    }
    float* rc = (float*)(ws + WS_ROPE); float* rs_ = rc + ROPE_N;
    for (int id = gt; id < (int)ROPE_N; id += NGT) {
        const int p = id >> 4, i = id & 15; const double pos = (p == ROPE_SAMPLE_IDX) ? 16384.0 : (double)p;
        double inv = 1.0;
        for (int k = 0; k < i; ++k) inv *= 0.44036660267178046;
        double sn, cs; sincos_d(pos * inv, sn, cs);
        rc[id] = (float)cs; rs_[id] = (float)sn;
    }
}

__device__ __forceinline__ void attn_unit(const Args& AR, Frame& F, int l, int b, int i) {
    int lane_ = F.lane(); asm volatile("" : "+v"(lane_));
    size_t z_ = 0; asm volatile("" : "+s"(z_)); unsigned char* ws = F.ws + z_;
    const int lane = lane_, h = F.wave, c = lane & 31, hh = lane >> 5, kvh = h >> 2;
    const int t0 = 32 * i; const size_t rb = (size_t)b * TT;
#if PROBE && (PROBE_KIND == 11 || PROBE_KIND == 12)
    const unsigned long long ta0 = __builtin_amdgcn_s_memrealtime();
#endif
    const bf16* Q = (const bf16*)(ws + WS_Q); const bf16* K = (const bf16*)(ws + WS_K); const bf16* VT = (const bf16*)(ws + WS_VT);
    LAS float* ex = (LAS float*)(F.lds + ESC_OFF);
    bf16x8 qf[8];
    { const bf16* qp = Q + (rb + t0 + c) * 1024 + 128 * h + 8 * hh;
#pragma unroll
      for (int ks = 0; ks < 8; ++ks) qf[ks] = *(const bf16x8*)(qp + 16 * ks); }
    const int kt0 = (t0 >= 128) ? 0 : (4 - i);
    f32x16 S[5];
    bf16x8 kf[2][8];
    { const int tk0 = t0 - 128 + 32 * kt0; const bf16* kp = K + (rb + tk0 + c) * 256 + 128 * kvh + 8 * hh;
      if (kt0 & 1) {
#pragma unroll
          for (int ks = 0; ks < 8; ++ks) kf[1][ks] = *(const bf16x8*)(kp + 16 * ks);
      } else {
#pragma unroll
          for (int ks = 0; ks < 8; ++ks) kf[0][ks] = *(const bf16x8*)(kp + 16 * ks);
      } }
#pragma unroll
    for (int kt = 0; kt < 5; ++kt) {
#pragma unroll
        for (int r = 0; r < 16; ++r) S[kt][r] = -INFINITY;
        if (kt >= kt0) {
            if (kt < 4) { const int tk1 = t0 - 128 + 32 * (kt + 1); const bf16* kp = K + (rb + tk1 + c) * 256 + 128 * kvh + 8 * hh;
#pragma unroll
                for (int ks = 0; ks < 8; ++ks) kf[(kt + 1) & 1][ks] = *(const bf16x8*)(kp + 16 * ks); }
            f32x16 a = {0.f, 0.f, 0.f, 0.f, 0.f, 0.f, 0.f, 0.f, 0.f, 0.f, 0.f, 0.f, 0.f, 0.f, 0.f, 0.f};
#pragma unroll
            for (int ks = 0; ks < 8; ++ks) a = __builtin_amdgcn_mfma_f32_32x32x16_bf16(kf[kt & 1][ks], qf[ks], a, 0, 0, 0);
#pragma unroll
            for (int r = 0; r < 16; ++r) { const int kr = (r & 3) + 8 * (r >> 2) + 4 * hh; bool ok = true;
                if (kt == 0) ok = kr >= c;
                if (kt == 4) ok = kr <= c;
                S[kt][r] = ok ? a[r] : -INFINITY; }
        }
    }
#if PROBE && PROBE_KIND == 11
    if (F.tid() == 0) F.MISC[6] += (unsigned)(__builtin_amdgcn_s_memrealtime() - ta0);
#endif
    const float sink2 = AR.in[IN_SINKS][l * 8 + h] * LOG2E;
    float mx = sink2;
#pragma unroll
    for (int kt = 0; kt < 5; ++kt)
#pragma unroll
        for (int r = 0; r < 16; ++r) mx = fmaxf(mx, S[kt][r]);
    mx = fmaxf(mx, __shfl_xor(mx, 32));
    float sum = 0.f;
#pragma unroll
    for (int kt = 0; kt < 5; ++kt)
#pragma unroll
        for (int r = 0; r < 16; ++r) { const float p = __builtin_amdgcn_exp2f(S[kt][r] - mx); S[kt][r] = p; sum += p; }
    sum += __shfl_xor(sum, 32);
    const float inv = 1.0f / (sum + __builtin_amdgcn_exp2f(sink2 - mx));
    f32x16 O[4];
#pragma unroll
    for (int db = 0; db < 4; ++db)
#pragma unroll
        for (int r = 0; r < 16; ++r) O[db][r] = 0.f;
    const bf16* vbase = VT + ((size_t)((b * 2 + kvh) * 128 + c)) * TPV + (t0 - 128) + 8 * hh;
    bf16x8 vf[2][4];
#pragma unroll
    for (int db = 0; db < 4; ++db) vf[0][db] = *(const bf16x8*)(vbase + (size_t)(32 * db) * TPV + 32 * kt0);
#pragma unroll
    for (int st = 0; st < 10; ++st) {
        const int kt = st >> 1, s = st & 1;
        if (kt >= kt0) {
            if (st < 9) {
#pragma unroll
                for (int db = 0; db < 4; ++db) vf[(st + 1) & 1][db] = *(const bf16x8*)(vbase + (size_t)(32 * db) * TPV + 16 * (st + 1)); }
            v4u pw; pw.x = pk2(S[kt][8 * s + 0], S[kt][8 * s + 1]); pw.y = pk2(S[kt][8 * s + 2], S[kt][8 * s + 3]); pw.z = pk2(S[kt][8 * s + 4], S[kt][8 * s + 5]); pw.w = pk2(S[kt][8 * s + 6], S[kt][8 * s + 7]);
            const bf16x8 pf = __builtin_bit_cast(bf16x8, pw);
#pragma unroll
            for (int db = 0; db < 4; ++db) O[db] = __builtin_amdgcn_mfma_f32_32x32x16_bf16(vf[st & 1][db], pf, O[db], 0, 0, 0);
        }
    }
    float ss = 0.f;
#pragma unroll
    for (int db = 0; db < 4; ++db)
#pragma unroll
        for (int r = 0; r < 16; ++r) { O[db][r] *= inv; ss += O[db][r] * O[db][r]; }
#if PROBE && PROBE_KIND == 12
    if (F.tid() == 0) F.MISC[6] += (unsigned)(__builtin_amdgcn_s_memrealtime() - ta0);
#endif
    ss += __shfl_xor(ss, 32);
    if (hh == 0) ex[h * 32 + c] = ss;
    WG_BAR();
    float tot = 0.f;
#pragma unroll
    for (int j = 0; j < 8; ++j) tot += ex[j * 32 + c];
    const float rsa = rsqrtf(tot * (1.0f / 1024.0f) + EPS);
    if (t0 + c < TT) {
        const rsrc_t rs_ = ws_rsrc(ws); const size_t mo16 = WS_MIX + ((rb + t0 + c) * DM + 128 * h) * 2 + 16 * hh;
#pragma unroll
        for (int db = 0; db < 4; ++db)
#pragma unroll
            for (int g4 = 0; g4 < 4; g4 += 2) {
                unsigned ax = pk2(O[db][4 * g4 + 0] * rsa, O[db][4 * g4 + 1] * rsa), ay = pk2(O[db][4 * g4 + 2] * rsa, O[db][4 * g4 + 3] * rsa);
                unsigned bx = pk2(O[db][4 * g4 + 4] * rsa, O[db][4 * g4 + 5] * rsa), by = pk2(O[db][4 * g4 + 6] * rsa, O[db][4 * g4 + 7] * rsa);
                { auto r = __builtin_amdgcn_permlane32_swap(ax, bx, false, false); ax = r[0]; bx = r[1]; }
                { auto r = __builtin_amdgcn_permlane32_swap(ay, by, false, false); ay = r[0]; by = r[1]; }
                ST16(rs_, mo16 + (32 * db + 8 * g4) * 2, ((v4u){ax, ay, bx, by}));
            }
    }
    WG_BAR();
}

__device__ __forceinline__ void sattn_unit(const Args& AR, Frame& F, int l, int s) {
    int tid_ = F.tid(); asm volatile("" : "+v"(tid_));
    const int tid = tid_, lane = tid & 63, wave = F.wave;
    LAS float* qs = (LAS float*)F.lds;
    LAS float* sc = qs + 1024;
    LAS float* part = sc + 8 * 132;
    LAS float* red = part + 4096;
    const size_t row = SROW0 + s;
    const bf16* Q = (const bf16*)(F.ws + WS_Q) + row * 1024;
    const float* ksn = (const float*)(F.ws + WS_KSN) + (size_t)s * 256; const float* vsn = ksn + NSAMP * 256;
    const float* ck = AR.in[IN_CACHEK] + ((size_t)(l * NSAMP + s)) * 128 * 256; const float* cv = AR.in[IN_CACHEV] + ((size_t)(l * NSAMP + s)) * 128 * 256;
    for (int j = tid; j < 1024; j += 512) qs[j] = bf2f(Q[j]);
    WG_BAR();
    { const int key = tid >> 2, pt = tid & 3;
#pragma unroll
      for (int kvh = 0; kvh < 2; ++kvh) {
          const float* kp = ck + (size_t)key * 256 + kvh * 128 + 32 * pt; float d[4] = {0.f, 0.f, 0.f, 0.f};
#pragma unroll
          for (int j = 0; j < 8; ++j) { const f32x4 kv = *(const f32x4*)(kp + 4 * j);
#pragma unroll
              for (int g = 0; g < 4; ++g) { const f32x4 qv = *(const LAS f32x4*)(qs + (4 * kvh + g) * 128 + 32 * pt + 4 * j); d[g] += (kv[0] * qv[0] + kv[1] * qv[1]) + (kv[2] * qv[2] + kv[3] * qv[3]); } }
#pragma unroll
          for (int g = 0; g < 4; ++g) { d[g] += __shfl_xor(d[g], 1); d[g] += __shfl_xor(d[g], 2); if (pt == 0) sc[(4 * kvh + g) * 132 + key] = d[g]; }
      } }
    {
      const int h = wave, kvh = h >> 2; float d = ksn[kvh * 128 + lane] * qs[h * 128 + lane] + ksn[kvh * 128 + 64 + lane] * qs[h * 128 + 64 + lane];
      d = wave_sum(d); if (lane == 0) sc[h * 132 + 128] = d; }
    WG_BAR();
    { const int h = wave; const float sink2 = AR.in[IN_SINKS][l * 8 + h] * LOG2E;
      const float v0 = sc[h * 132 + lane], v1 = sc[h * 132 + 64 + lane], v2 = (lane == 0) ? sc[h * 132 + 128] : -INFINITY;
      const float mx = fmaxf(wave_max(fmaxf(fmaxf(v0, v1), v2)), sink2);
      const float p0 = __builtin_amdgcn_exp2f(v0 - mx), p1 = __builtin_amdgcn_exp2f(v1 - mx), p2 = __builtin_amdgcn_exp2f(v2 - mx);
      const float inv = 1.0f / (wave_sum(p0 + p1 + p2) + __builtin_amdgcn_exp2f(sink2 - mx));
      sc[h * 132 + lane] = p0 * inv; sc[h * 132 + 64 + lane] = p1 * inv; if (lane == 0) sc[h * 132 + 128] = p2 * inv; }
    WG_BAR();
    { const int d = tid & 127, kq = tid >> 7;
#pragma unroll
      for (int kvh = 0; kvh < 2; ++kvh) { float a[4] = {0.f, 0.f, 0.f, 0.f};
#pragma unroll 8
          for (int k = 0; k < 32; ++k) { const int key = 32 * kq + k; const float v = cv[(size_t)key * 256 + kvh * 128 + d];
#pragma unroll
              for (int g = 0; g < 4; ++g) a[g] += sc[(4 * kvh + g) * 132 + key] * v; }
#pragma unroll
          for (int g = 0; g < 4; ++g) part[kq * 1024 + (4 * kvh + g) * 128 + d] = a[g]; } }
    WG_BAR();
    float o[2]; float ss = 0.f;
#pragma unroll
    for (int e = 0; e < 2; ++e) { const int j = tid + 512 * e, h = j >> 7, d = j & 127, kvh = h >> 2;
        o[e] = (part[j] + part[1024 + j]) + (part[2048 + j] + part[3072 + j]) + sc[h * 132 + 128] * vsn[kvh * 128 + d]; ss += o[e] * o[e]; }
    ss = wave_sum(ss); if (lane == 0) red[wave] = ss;
    WG_BAR();
    { float tot = 0.f;
#pragma unroll
      for (int j = 0; j < 8; ++j) tot += red[j];
      const float rsa = rsqrtf(tot * (1.0f / 1024.0f) + EPS);
      const rsrc_t rs_ = ws_rsrc(F.ws);
#pragma unroll
      for (int e = 0; e < 2; ++e) ST2(rs_, WS_MIX + (row * DM + tid + 512 * e) * 2, pk2(o[e] * rsa, 0.f) & 0xffffu); }
    { float* ok = F.out + O_SK + ((size_t)(l * NSAMP + s)) * 128 * 256; float* ov = F.out + O_SV + ((size_t)(l * NSAMP + s)) * 128 * 256;
      for (int j = tid; j < 127 * 64; j += 512) { *(f32x4*)(ok + 4 * j) = *(const f32x4*)(ck + 256 + 4 * j); *(f32x4*)(ov + 4 * j) = *(const f32x4*)(cv + 256 + 4 * j); }
      if (tid < 64) *(f32x4*)(ok + 127 * 256 + 4 * tid) = *(const f32x4*)(ksn + 4 * tid);
      else if (tid < 128) *(f32x4*)(ov + 127 * 256 + 4 * (tid - 64)) = *(const f32x4*)(vsn + 4 * (tid - 64)); }
    WG_BAR();
}

__device__ __forceinline__ float gelu_tanh(float y) {
    const float inner = 0.7978845608028654f * (y + 0.044715f * y * y * y);
    return y / (1.0f + __builtin_amdgcn_exp2f(-2.0f * LOG2E * inner));
}
__device__ __forceinline__ float sigmoidf_(float x) { return 1.0f / (1.0f + __builtin_amdgcn_exp2f(-LOG2E * x)); }
#define SWZ(r, ch, PITCH) ((r) * (PITCH) + ((((ch)) ^ ((r) & 15)) << 4))

#ifndef SSM_P1
#define SSM_P1 1
#endif
#ifndef SSM_M2
#define SSM_M2 1
#endif
__device__ __forceinline__ int rowtok(int r) { return 16 * ((r >> 2) & 1) + 4 * (r >> 3) + (r & 3); }
struct SsmG { f32x16 X[4]; };
struct SsmIn { f32x4 u0, u1; };
__device__ __forceinline__ SsmIn ssm_load_in(const float* U, int rowb, int g, int lane) { const float* up = U + (size_t)(rowb + rowtok(lane & 31)) * 512 + 16 * g + 8 * (lane >> 5); SsmIn r; r.u0 = *(const f32x4*)up; r.u1 = *(const f32x4*)(up + 4); return r; }
__device__ __forceinline__ void ssm_block(const Args& AR, SsmG& G, const SsmIn& in, int g, const bf16x8 (&bbf)[4], const float (&ab)[4], float (&hr)[2], float (&hi)[2], int mode, int l, int s0, int lane) {
    const int c = lane & 31, hh = lane >> 5;
    bf16x8 af;
    { const f32x4 u0 = in.u0, u1 = in.u1;
      v4u pw; pw.x = pk2(u0[0], u0[1]); pw.y = pk2(u0[2], u0[3]); pw.z = pk2(u1[0], u1[1]); pw.w = pk2(u1[2], u1[3]); af = __builtin_bit_cast(bf16x8, pw); }
    const f32x16 z16 = {0.f, 0.f, 0.f, 0.f, 0.f, 0.f, 0.f, 0.f, 0.f, 0.f, 0.f, 0.f, 0.f, 0.f, 0.f, 0.f};
#pragma unroll
    for (int nb = 0; nb < 4; ++nb) G.X[nb] = __builtin_amdgcn_mfma_f32_32x32x16_bf16(af, bbf[nb], z16, 0, 0, 0);
#pragma unroll
    for (int s = 0; s < 2; ++s) {
        const float ar = ab[2 * s], ai = ab[2 * s + 1];
        if (SSM_M2 && mode == 2) {
            { int cx = c; asm volatile("" : "+v"(cx)); const size_t o0 = ((size_t)(l * NSAMP + (s0 + 16 * hh)) * 32 + g) * 64 + cx + 32 * s; const float* qr = AR.in[IN_SSMRE] + o0; const float* qi = AR.in[IN_SSMIM] + o0;
              size_t jo = 0;
#pragma unroll
              for (int j = 0; j < 16; ++j) { const float pr = qr[jo], pi = qi[jo]; jo += 2048; asm volatile("" : "+v"(jo));
                const float nr = ar * pr - ai * pi + G.X[s][j], ni = ar * pi + ai * pr + G.X[2 + s][j]; G.X[s][j] = nr; G.X[2 + s][j] = ni; } }
            continue;
        }
        float r = (hh == 0) ? hr[s] : 0.f, i = (hh == 0) ? hi[s] : 0.f;
#pragma unroll
        for (int j = 0; j < 16; ++j) { const float nr = ar * r - ai * i + G.X[s][j], ni = ar * i + ai * r + G.X[2 + s][j]; r = nr; i = ni; G.X[s][j] = r; G.X[2 + s][j] = i; }
        float vr = __shfl_xor(r, 32), vi = __shfl_xor(i, 32);
        if (hh == 0 || mode == 1) { vr = 0.f; vi = 0.f; }
        float pr = ar, pi = ai; asm volatile("" : "+v"(pr), "+v"(pi));
#pragma unroll
        for (int j = 0; j < 16; ++j) { G.X[s][j] += pr * vr - pi * vi; G.X[2 + s][j] += pr * vi + pi * vr; const float nr = pr * ar - pi * ai, ni = pr * ai + pi * ar; pr = nr; pi = ni; }
        const float er = G.X[s][15], ei = G.X[2 + s][15];
        const float xr = __shfl_xor(er, 32), xi = __shfl_xor(ei, 32);
        hr[s] = (hh == 1) ? er : xr; hi[s] = (hh == 1) ? ei : xi;
    }
}
struct SsmTab { float ab[4]; bf16x8 bbf[4]; };
struct SsmTabC { bf16x8 cmf[4]; f32x4 dsk; };
__device__ __forceinline__ SsmTab ssm_load_tab(const unsigned char* tb, int w, int gi, int lg) {
    SsmTab T; const int g = 4 * w + gi, c32 = lg & 31, hh = lg >> 5;
    T.ab[0] = ((const float*)(tb + TB_ABR))[g * 64 + c32]; T.ab[1] = ((const float*)(tb + TB_ABI))[g * 64 + c32]; T.ab[2] = ((const float*)(tb + TB_ABR))[g * 64 + 32 + c32]; T.ab[3] = ((const float*)(tb + TB_ABI))[g * 64 + 32 + c32];
    const bf16* bt = (const bf16*)(tb + TB_PM) + (size_t)g * 128 * 16 + c32 * 16 + 8 * hh;
#pragma unroll
    for (int nb = 0; nb < 4; ++nb) T.bbf[nb] = *(const bf16x8*)(bt + nb * 32 * 16);
    return T;
}
__device__ __forceinline__ SsmTabC ssm_load_tabc(const unsigned char* tb, const float* dskip, int w, int gi, int lg) {
    SsmTabC T; const int g = 4 * w + gi, t16 = lg & 15, cq = lg >> 4;
    const bf16* cm = (const bf16*)(tb + TB_CMT) + (size_t)g * 16 * 128 + t16 * 128 + 8 * cq;
#pragma unroll
    for (int nb = 0; nb < 4; ++nb) T.cmf[nb] = *(const bf16x8*)(cm + 32 * nb);
    T.dsk = *(const f32x4*)(dskip + 64 * w + 16 * gi + 4 * cq); return T;
}
__device__ __forceinline__ void ssm_unit(const Args& AR, Frame& F, int l, int c_in) {
    const int c = c_in;
#if PROBE && PROBE_KIND == 13
    const unsigned long long tq0 = __builtin_amdgcn_s_memrealtime();
#define SSM_CP(n) do { if ((n) == PROBE_TYPE && F.tid() == 0) F.MISC[6] += (unsigned)(__builtin_amdgcn_s_memrealtime() - tq0); } while (0)
#else
#define SSM_CP(n) do { } while (0)
#endif
    int lane_ = F.lane(); asm volatile("" : "+v"(lane_));
    const int lane = lane_, w = F.wave, t16 = lane & 15, cq = lane >> 4, c32 = lane & 31, hh = lane >> 5;
    const int row0 = 64 * c;
    size_t z_ = 0; asm volatile("" : "+s"(z_)); unsigned char* ws = F.ws + z_;
    const unsigned char* tb = ws + WS_TAB + (size_t)l * TB_LAYER;
    const float* U = (const float*)(ws + WS_U);
    float* SST = (float*)(ws + WS_SST) + ((size_t)l * NCHUNK) * 32 * 128;
    gu32* flags = F.ctl + CW_SSMF + (size_t)(l * NCHUNK) * 8 * 16;
    LAS unsigned char* Zs = F.lds;
    LAS unsigned char* Hm = F.lds + 65536 + w * 8704;
    LAS float* red = (LAS float*)(F.lds + 137216);
    SsmG SG;
    float hcar[4] = {0.f, 0.f, 0.f, 0.f};
    if (SSM_P1 && c != NCHUNK - 1) {
#pragma unroll 1
        for (int gi = 0; gi < 4; ++gi) {
            const int g = 4 * w + gi;
            int lg_ = lane; asm volatile("" : "+v"(lg_));
            const int c32 = lg_ & 31, hh = lg_ >> 5;
            float ab[4]; ab[0] = ((const float*)(tb + TB_ABR))[g * 64 + c32]; ab[1] = ((const float*)(tb + TB_ABI))[g * 64 + c32]; ab[2] = ((const float*)(tb + TB_ABR))[g * 64 + 32 + c32]; ab[3] = ((const float*)(tb + TB_ABI))[g * 64 + 32 + c32];
            bf16x8 bbf[4];
            { const bf16* bt = (const bf16*)(tb + TB_PM) + (size_t)g * 128 * 16 + c32 * 16 + 8 * hh;
#pragma unroll
              for (int nb = 0; nb < 4; ++nb) bbf[nb] = *(const bf16x8*)(bt + nb * 32 * 16); }
            float hr[2] = {0.f, 0.f}, hi[2] = {0.f, 0.f};
            const SsmIn in0 = ssm_load_in(U, row0, g, lg_), in1 = ssm_load_in(U, row0 + 32, g, lg_);
            ssm_block(AR, SG, in0, g, bbf, ab, hr, hi, (c == 64) ? 1 : 0, l, 0, lg_);
            ssm_block(AR, SG, in1, g, bbf, ab, hr, hi, 0, l, 0, lg_);
            if (hh == 0) {
#pragma unroll
                for (int s = 0; s < 2; ++s) __hip_atomic_store((gu64*)(SST + ((size_t)c * 32 + g) * 128 + 2 * (c32 + 32 * s)), ((unsigned long long)__builtin_bit_cast(unsigned, hi[s]) << 32) | __builtin_bit_cast(unsigned, hr[s]), RLX_AGENT);
            }
        }
        VM_WAIT();
        if (lane == 0) __hip_atomic_store(flags + ((size_t)c * 8 + w) * 16, 1u, RLX_AGENT);
    }
    SSM_CP(1);
    const int cs0 = (c <= 64) ? 0 : 64, npred = c - cs0;
    if (npred > 0) {
        unsigned sp = 0; bool ok = false;
        for (;;) { ok = (lane >= npred) || (__hip_atomic_load(flags + ((size_t)(cs0 + lane) * 8 + w) * 16, RLX_AGENT) != 0u);
            if (__all(ok)) break;
            __builtin_amdgcn_s_sleep(2);
            if (++sp > (1u << 20)) { if (lane == 0) __hip_atomic_store(F.ctl + CW_TMO, 0x55u, RLX_AGENT); break; } }
        __builtin_amdgcn_fence(__ATOMIC_ACQUIRE, "agent");
        VM_WAIT();
    }
    SSM_CP(2);
    SSM_CP(2);
    SsmTab T = ssm_load_tab(tb, w, 0, lane);
    SsmTabC TC = ssm_load_tabc(tb, AR.in[IN_DSKIP] + l * 512, w, 0, lane);
    SsmIn inx = ssm_load_in(U, row0, 4 * w, lane);
#pragma unroll 1
    for (int step = 0; step < 8; ++step) {
        const int gi = step >> 1, half = step & 1, g = 4 * w + gi;
        int lg_ = lane; asm volatile("" : "+v"(lg_));
        const int t16 = lg_ & 15, cq = lg_ >> 4, c32 = lg_ & 31, hh = lg_ >> 5;
        int cc_ = c_in; asm volatile("" : "+s"(cc_)); const int c = cc_;
        const bool samp = (c == NCHUNK - 1) && (half == 1);
        const int col = 64 * w + 16 * gi + 4 * cq;
        const int ns = (step < 7) ? step + 1 : 7, ngi = ns >> 1, nhalf = ns & 1;
        const SsmIn in_n = ssm_load_in(U, row0 + 32 * nhalf, 4 * w + ngi, lg_);
        f32x4 uvp[2];
#pragma unroll
        for (int mt = 0; mt < 2; ++mt) uvp[mt] = *(const f32x4*)(U + (size_t)(row0 + 32 * half + 16 * mt + t16) * 512 + col);
        if (half == 0 && gi > 0) { T = ssm_load_tab(tb, w, gi, lg_); TC = ssm_load_tabc(tb, AR.in[IN_DSKIP] + l * 512, w, gi, lg_); }
        float hr[2], hi[2];
        if (half == 0) {
            hr[0] = 0.f; hr[1] = 0.f; hi[0] = 0.f; hi[1] = 0.f;
            if (npred > 0) {
                float aL[4]; aL[0] = ((const float*)(tb + TB_ALR))[g * 64 + c32]; aL[1] = ((const float*)(tb + TB_ALI))[g * 64 + c32]; aL[2] = ((const float*)(tb + TB_ALR))[g * 64 + 32 + c32]; aL[3] = ((const float*)(tb + TB_ALI))[g * 64 + 32 + c32];
                const float* sb = SST + ((size_t)g) * 128 + 2 * c32;
                for (int cp = cs0; cp < c; cp += 16) {
                    f32x2 sv[16][2];
#pragma unroll
                    for (int j = 0; j < 16; ++j) { const int cj = (cp + j < c) ? cp + j : c - 1; const float* sp_ = sb + (size_t)cj * 32 * 128; sv[j][0] = *(const f32x2*)sp_; sv[j][1] = *(const f32x2*)(sp_ + 64); }
#pragma unroll
                    for (int j = 0; j < 16; ++j) if (cp + j < c) {
#pragma unroll
                        for (int s = 0; s < 2; ++s) { const float nr = aL[2 * s] * hr[s] - aL[2 * s + 1] * hi[s] + sv[j][s][0], ni = aL[2 * s] * hi[s] + aL[2 * s + 1] * hr[s] + sv[j][s][1]; hr[s] = nr; hi[s] = ni; } }
                }
            }
        } else {
#pragma unroll
            for (int s = 0; s < 2; ++s) { hr[s] = hcar[2 * s]; hi[s] = hcar[2 * s + 1]; }
        }
        ssm_block(AR, SG, inx, g, T.bbf, T.ab, hr, hi, samp ? 2 : ((c == 64 && half == 0) ? 1 : 0), l, 0, lg_);
#pragma unroll
        for (int s = 0; s < 2; ++s) { hcar[2 * s] = hr[s]; hcar[2 * s + 1] = hi[s]; }
        { LAS unsigned char* hw = Hm + hh * (16 * 272) + c32 * 2;
#pragma unroll
          for (int j = 0; j < 16; ++j)
#pragma unroll
            for (int nb = 0; nb < 4; ++nb) *(LAS bf16*)(hw + j * 272 + nb * 64) = (bf16)(pk2(SG.X[nb][j], 0.f) & 0xffffu); }
        if ((c == 64 && half == 0) || (c == NCHUNK - 1 && half == 0)) {
            int cx = c32; asm volatile("" : "+v"(cx));
            if (hh == (c == 64 ? 0 : 1)) {
#pragma unroll
                for (int s = 0; s < 2; ++s) { const size_t o = ((size_t)(l * NBATCH + (c == 64 ? 0 : 1)) * 32 + g) * 64 + cx + 32 * s; F.out[O_PSR + o] = SG.X[s][15]; F.out[O_PSI + o] = SG.X[2 + s][15]; } } }
        if (samp) { int cx = c32; asm volatile("" : "+v"(cx)); const size_t o0 = ((size_t)(l * NSAMP + 16 * hh) * 32 + g) * 64 + cx; float* qr = F.out + O_SSR + o0; float* qi = F.out + O_SSI + o0;
#pragma unroll
            for (size_t j = 0, jo = 0; j < 16; ++j) { qr[jo] = SG.X[0][j]; qr[jo + 32] = SG.X[1][j]; qi[jo] = SG.X[2][j]; qi[jo + 32] = SG.X[3][j]; jo += 2048; asm volatile("" : "+v"(jo)); } }
        LDS_WAIT();
#pragma unroll
        for (int mt = 0; mt < 2; ++mt) {
            f32x4 y = {0.f, 0.f, 0.f, 0.f};
#pragma unroll
            for (int ks = 0; ks < 4; ++ks) { const bf16x8 hf = *(const LAS bf16x8*)(Hm + (16 * mt + t16) * 272 + (4 * ks + cq) * 16);
                y = __builtin_amdgcn_mfma_f32_16x16x32_bf16(TC.cmf[ks], hf, y, 0, 0, 0); }
            const int rl = 32 * half + 16 * mt + t16;
            const f32x4 uv = uvp[mt];
            f32x4 z;
#pragma unroll
            for (int e = 0; e < 4; ++e) z[e] = gelu_tanh(y[e] + TC.dsk[e] * uv[e]);
            *(LAS v2u*)(Zs + SWZ(rl, col >> 3, 1024) + (col & 7) * 2) = (v2u){pk2(z[0], z[1]), pk2(z[2], z[3])};
        }
        LDS_WAIT();
        inx = in_n;
    }
    WG_BAR();
    SSM_CP(3);
    f32x4 G[4][4];
#pragma unroll
    for (int mt = 0; mt < 4; ++mt)
#pragma unroll
        for (int nt = 0; nt < 4; ++nt) G[mt][nt] = (f32x4){0.f, 0.f, 0.f, 0.f};
    { const bf16* Wg = (const bf16*)(ws + WS_WGLU) + (size_t)l * 512 * 512 + (size_t)(64 * w + t16) * 512 + 8 * cq;
#pragma unroll 4
      for (int ks = 0; ks < 16; ++ks) {
          bf16x8 wf[4], zf[4];
#pragma unroll
          for (int nt = 0; nt < 4; ++nt) wf[nt] = *(const bf16x8*)(Wg + (size_t)nt * 16 * 512 + 32 * ks);
#pragma unroll
          for (int mt = 0; mt < 4; ++mt) zf[mt] = *(const LAS bf16x8*)(Zs + SWZ(16 * mt + t16, 4 * ks + cq, 1024));
#pragma unroll
          for (int mt = 0; mt < 4; ++mt)
#pragma unroll
              for (int nt = 0; nt < 4; ++nt) G[mt][nt] = __builtin_amdgcn_mfma_f32_16x16x32_bf16(wf[nt], zf[mt], G[mt][nt], 0, 0, 0);
      } }
#pragma unroll
    for (int mt = 0; mt < 4; ++mt) { float ss = 0.f; const int rl = 16 * mt + t16;
#pragma unroll
        for (int nt = 0; nt < 4; ++nt) { const int col = 64 * w + 16 * nt + 4 * cq; const f32x4 bg = *(const f32x4*)(AR.in[IN_BGLU] + l * 512 + col);
            const v2u zz = *(const LAS v2u*)(Zs + SWZ(rl, col >> 3, 1024) + (col & 7) * 2);
            const float zv[4] = {bf2f((unsigned short)(zz.x & 0xffffu)), bf2f((unsigned short)(zz.x >> 16)), bf2f((unsigned short)(zz.y & 0xffffu)), bf2f((unsigned short)(zz.y >> 16))};
#pragma unroll
            for (int e = 0; e < 4; ++e) { const float o = zv[e] * sigmoidf_(G[mt][nt][e] + bg[e]); G[mt][nt][e] = o; ss += o * o; } }
        ss += __shfl_xor(ss, 16); ss += __shfl_xor(ss, 32);
        if (cq == 0) red[rl * 8 + w] = ss; }
    SSM_CP(4);
    WG_BAR();
    { const rsrc_t rs_ = ws_rsrc(ws);
#pragma unroll
      for (int mt = 0; mt < 4; ++mt) { const int rl = 16 * mt + t16; const LAS f32x4* rp = (const LAS f32x4*)(red + rl * 8); const f32x4 a = rp[0], b2 = rp[1];
          const float rsn = rsqrtf(((a[0] + a[1]) + (a[2] + a[3]) + (b2[0] + b2[1]) + (b2[2] + b2[3])) * (1.0f / 512.0f) + EPS);
          const int od = cq & 1; const size_t mo = WS_MIX + ((size_t)(row0 + rl) * DM + 1024 + 64 * w + 4 * (cq & ~1)) * 2 + (od ? 32 : 0);
#pragma unroll
          for (int nt = 0; nt < 4; nt += 2) {
              const unsigned a0 = pk2(G[mt][nt][0] * rsn, G[mt][nt][1] * rsn), a1 = pk2(G[mt][nt][2] * rsn, G[mt][nt][3] * rsn);
              const unsigned b0 = pk2(G[mt][nt + 1][0] * rsn, G[mt][nt + 1][1] * rsn), b1 = pk2(G[mt][nt + 1][2] * rsn, G[mt][nt + 1][3] * rsn);
              const unsigned s0 = od ? a0 : b0, s1 = od ? a1 : b1;
              const unsigned r0 = (unsigned)__shfl_xor((int)s0, 16), r1 = (unsigned)__shfl_xor((int)s1, 16);
              ST16(rs_, mo + 32 * nt, (od ? (v4u){r0, r1, b0, b1} : (v4u){a0, a1, r0, r1})); } } }
    WG_BAR();
}
#undef SSM_ROWS4

template <int WLEN>
__device__ __forceinline__ void pool_half(const float* XP, float* out, int l, int ch, int rfirst, int rl0, LAS unsigned char* Ds) {
    float xv[48];
#pragma unroll
    for (int i = 0; i < 48; ++i) { const int ra = rfirst + i - 16; xv[i] = (ra >= 0) ? XP[(size_t)ra * 512 + ch] : 0.f; }
    int seg = (rfirst >= TT) ? TT : 0;
    float sum = 0.f;
#pragma unroll
    for (int j = 1; j <= WLEN; ++j) if (rfirst - j >= seg) sum += xv[16 - j];
#pragma unroll
    for (int i = 0; i < 32; ++i) {
        const int ra = rfirst + i; const float x = xv[16 + i];
        if (ra == TT) { seg = TT; sum = 0.f; }
        sum += x;
        if (ra - WLEN >= seg) sum -= xv[16 + i - WLEN];
        const int cnt = (ra - seg + 1 < WLEN) ? (ra - seg + 1) : WLEN;
        const float dm = sum * __builtin_amdgcn_rcpf((float)cnt) - x;
        if (ra >= TT - 15 && ra < TT) out[O_PP + ((size_t)(l * NBATCH + 0) * 15 + (ra - (TT - 15))) * 512 + ch] = x;
        if (ra >= SROW0 - 15) out[O_PP + ((size_t)(l * NBATCH + 1) * 15 + (ra - (SROW0 - 15))) * 512 + ch] = x;
        const int r = rl0 + i;
        *(LAS bf16*)(Ds + SWZ(r, ch >> 3, 1024) + (ch & 7) * 2) = (bf16)(pk2(dm, 0.f) & 0xffffu);
    }
}
template <int WLEN>
__device__ __forceinline__ void pool_sample_rows(const float* XP, const float* sp, float* out, int l, int ch, LAS unsigned char* Ds) {
#pragma unroll 2
    for (int s = 0; s < NSAMP; ++s) {
        const float* pp = sp + (size_t)s * 15 * 512; float pv[15];
#pragma unroll
        for (int j = 0; j < 15; ++j) pv[j] = pp[(size_t)j * 512];
        const float x = XP[(size_t)(SROW0 + s) * 512 + ch]; float a = x;
#pragma unroll
        for (int j = 16 - WLEN; j < 15; ++j) a += pv[j];
        const float dm = a * (1.0f / WLEN) - x;
        float* op = out + O_SP + ((size_t)(l * NSAMP + s) * 15) * 512 + ch;
#pragma unroll
        for (int j = 0; j < 14; ++j) op[(size_t)j * 512] = pv[j + 1];
        op[(size_t)14 * 512] = x;
        *(LAS bf16*)(Ds + SWZ(32 + s, ch >> 3, 1024) + (ch & 7) * 2) = (bf16)(pk2(dm, 0.f) & 0xffffu);
    }
}
__device__ __forceinline__ void pool_unit(const Args& AR, Frame& F, int l, int c) {
    int tid_ = F.tid(); asm volatile("" : "+v"(tid_));
    const int tid = tid_, lane = tid & 63, w = F.wave, t16 = lane & 15, cq = lane >> 4;
    const int row0 = 64 * c;
    size_t z_ = 0; asm volatile("" : "+s"(z_)); unsigned char* ws = F.ws + z_;
    const float* XP = (const float*)(ws + WS_XP);
    LAS unsigned char* Ds = F.lds;
    LAS float* red = (LAS float*)(F.lds + ESC_OFF);
    { const int ch = tid, wsel = w >> 1;
      const float* sp = AR.in[IN_SPOOL] + (size_t)l * NSAMP * 15 * 512 + ch;
#pragma unroll 1
      for (int half = 0; half < 2; ++half) {
          if (c == NCHUNK - 1 && half == 1) {
              if (wsel == 0) pool_sample_rows<2>(XP, sp, F.out, l, ch, Ds); else if (wsel == 1) pool_sample_rows<4>(XP, sp, F.out, l, ch, Ds);
              else if (wsel == 2) pool_sample_rows<8>(XP, sp, F.out, l, ch, Ds); else pool_sample_rows<16>(XP, sp, F.out, l, ch, Ds);
          } else {
              const int rfirst = row0 + 32 * half;
              if (wsel == 0) pool_half<2>(XP, F.out, l, ch, rfirst, 32 * half, Ds); else if (wsel == 1) pool_half<4>(XP, F.out, l, ch, rfirst, 32 * half, Ds);
              else if (wsel == 2) pool_half<8>(XP, F.out, l, ch, rfirst, 32 * half, Ds); else pool_half<16>(XP, F.out, l, ch, rfirst, 32 * half, Ds);
          }
      } }
    WG_BAR();
    const int gp = w & 3, rh = w >> 2;
    f32x4 A[2][8];
#pragma unroll
    for (int mt = 0; mt < 2; ++mt)
#pragma unroll
        for (int nt = 0; nt < 8; ++nt) A[mt][nt] = (f32x4){0.f, 0.f, 0.f, 0.f};
    { const bf16* Wp = (const bf16*)(ws + WS_WPOOL) + ((size_t)(l * 4 + gp) * 128 + t16) * 128 + 8 * cq;
#pragma unroll
      for (int ks = 0; ks < 4; ++ks) {
          bf16x8 df[2];
#pragma unroll
          for (int mt = 0; mt < 2; ++mt) df[mt] = *(const LAS bf16x8*)(Ds + SWZ(32 * rh + 16 * mt + t16, 16 * gp + 4 * ks + cq, 1024));
#pragma unroll
          for (int nt = 0; nt < 8; ++nt) { const bf16x8 wf = *(const bf16x8*)(Wp + (size_t)nt * 16 * 128 + 32 * ks);
#pragma unroll
              for (int mt = 0; mt < 2; ++mt) A[mt][nt] = __builtin_amdgcn_mfma_f32_16x16x32_bf16(wf, df[mt], A[mt][nt], 0, 0, 0); }
      } }
#pragma unroll
    for (int mt = 0; mt < 2; ++mt) { float ss = 0.f;
#pragma unroll
        for (int nt = 0; nt < 8; ++nt) { const f32x4 sc = *(const f32x4*)(AR.in[IN_PSCALE] + l * 512 + 128 * gp + 16 * nt + 4 * cq);
#pragma unroll
            for (int e = 0; e < 4; ++e) { const float o = A[mt][nt][e] * sc[e]; A[mt][nt][e] = o; ss += o * o; } }
        ss += __shfl_xor(ss, 16); ss += __shfl_xor(ss, 32);
        if (cq == 0) red[(32 * rh + 16 * mt + t16) * 4 + gp] = ss; }
    WG_BAR();
    { const rsrc_t rs_ = ws_rsrc(ws);
#pragma unroll
      for (int mt = 0; mt < 2; ++mt) { const int rl = 32 * rh + 16 * mt + t16; const f32x4 a = *(const LAS f32x4*)(red + rl * 4);
          const float rsn = rsqrtf(((a[0] + a[1]) + (a[2] + a[3])) * (1.0f / 512.0f) + EPS);
          const int od = cq & 1; const size_t mo = WS_MIX + ((size_t)(row0 + rl) * DM + 1536 + 128 * gp + 4 * (cq & ~1)) * 2 + (od ? 32 : 0);
#pragma unroll
          for (int nt = 0; nt < 8; nt += 2) {
              const unsigned a0 = pk2(A[mt][nt][0] * rsn, A[mt][nt][1] * rsn), a1 = pk2(A[mt][nt][2] * rsn, A[mt][nt][3] * rsn);
              const unsigned b0 = pk2(A[mt][nt + 1][0] * rsn, A[mt][nt + 1][1] * rsn), b1 = pk2(A[mt][nt + 1][2] * rsn, A[mt][nt + 1][3] * rsn);
              const unsigned s0 = od ? a0 : b0, s1 = od ? a1 : b1;
              const unsigned r0 = (unsigned)__shfl_xor((int)s0, 16), r1 = (unsigned)__shfl_xor((int)s1, 16);
              ST16(rs_, mo + 32 * nt, (od ? (v4u){r0, r1, b0, b1} : (v4u){a0, a1, r0, r1})); } } }
    WG_BAR();
}

#ifndef ACQ_SCOPE
#define ACQ_SCOPE "agent"
#endif
#ifndef PE_ROW_OWNED
#define PE_ROW_OWNED 0
#endif
#ifndef PUBLISH_FENCE
#define PUBLISH_FENCE 0
#endif
enum { U_END = 0, U_PA = 1, U_PC = 2, U_PD = 3, U_PE = 4, U_PEQ = 5  , U_SSM = 6, U_ATT = 7, U_SATT = 8, U_POOL = 9 };
constexpr int U_GEMM_LAST = U_PEQ;
constexpr int NPANEL = MP / 256;
constexpr int QCAP = 1024;
__host__ __device__ constexpr unsigned mkd(int type, int l, int a, int b) { return ((unsigned)type << 24) | ((unsigned)l << 20) | ((unsigned)a << 10) | (unsigned)b; }
__device__ __forceinline__ gu32* cnt_word(gu32* ctl, int l, int kind, int pm) { return ctl + CW_CNT + ((l * 5 + kind) * 40 + pm) * 16; }
__host__ __device__ constexpr unsigned mix_target(int pm) { return 3u * (unsigned)((MR - 256 * pm) < 256 ? (MR - 256 * pm) : 256); }

__device__ __forceinline__ void build_queue(unsigned* qt, int q) {
    int n = 1;
    for (int l = 0; l < NLAYER; ++l) {
        for (int pm = 0; pm < NPANEL; ++pm) { qt[n++] = mkd(U_PA, l, pm, q); if ((pm & 7) == q) { qt[n++] = mkd(U_PA, l, pm, 8); qt[n++] = mkd(U_PA, l, pm, 9); } }
        for (int c = q; c < NCHUNK; c += 8) qt[n++] = mkd(U_SSM, l, c, 0);
        for (int i = q; i < NBATCH * NQB; i += 8) qt[n++] = mkd(U_ATT, l, i, 0);
        for (int s = q; s < NSAMP; s += 8) qt[n++] = mkd(U_SATT, l, s, 0);
        for (int c = q; c < NCHUNK; c += 8) qt[n++] = mkd(U_POOL, l, c, 0);
        for (int pm = 0; pm < NPANEL; ++pm) qt[n++] = mkd(U_PC, l, pm, q);
        for (int pm = 0; pm < NPANEL; ++pm) for (int j = 0; j < 4; ++j) qt[n++] = mkd(U_PD, l, pm, 4 * q + j);
#if PE_ROW_OWNED
        for (int pm = q; pm < NPANEL - 1; pm += 8) for (int pn = 0; pn < 8; ++pn) qt[n++] = mkd(U_PE, l, pm, pn);
        qt[n++] = mkd(U_PE, l, NPANEL - 1, q);
#else
        for (int pm = 0; pm < NPANEL - 1; ++pm) qt[n++] = mkd(U_PE, l, pm, q);
        if (l == NLAYER - 1) { for (int k = 0; k < 4; ++k) qt[n++] = mkd(U_PEQ, l, NPANEL - 1, 4 * q + k); } else qt[n++] = mkd(U_PE, l, NPANEL - 1, q);
#endif
    }
    qt[0] = (unsigned)(n - 1);
}

struct Sched {
    gu32* ctl; const unsigned* qglob; LAS unsigned* qlds; volatile LAS unsigned* slot; int myq; unsigned nclaim; int ptype;
    __device__ __forceinline__ unsigned claim_lane() {
        { unsigned ho = (unsigned)(CW_QHEAD + myq * 64); asm volatile("" : "+s"(ho));
          const unsigned idx = __hip_atomic_fetch_add(ctl + ho, 1u, RLX_AGENT); if (idx < qlds[0]) return qlds[1 + idx]; }
        for (int k = 1; k < 8; ++k) { const int q = (myq + k) & 7; const unsigned* qg = qglob + (size_t)q * QCAP;
            if (__hip_atomic_load((gu32*)(ctl + CW_QHEAD + q * 64), RLX_AGENT) >= qg[0]) continue;
            const unsigned idx = __hip_atomic_fetch_add(ctl + CW_QHEAD + q * 64, 1u, RLX_AGENT); if (idx < qg[0]) return qg[1 + idx]; }
        return 0u;
    }
    __device__ __forceinline__ unsigned claim_wg(int tid) {
        const unsigned k = nclaim++ & 1u;
        if (tid == 0) slot[k] = claim_lane();
        WG_BAR();
        return slot[k];
    }
    __device__ __forceinline__ void poll(gu32* w, unsigned want) {
        unsigned sp = 0;
#if PROBE && PROBE_KIND == 1
        if (__hip_atomic_load(w, RLX_AGENT) >= want) return;
        struct TAcc { unsigned long long t0; volatile LAS unsigned* acc; bool on; __device__ ~TAcc() { if (on) acc[6] += (unsigned)(__builtin_amdgcn_s_memrealtime() - t0); } } tacc_{__builtin_amdgcn_s_memrealtime(), slot, PROBE_TYPE == 0 || ptype == PROBE_TYPE};
#endif
        while (__hip_atomic_load(w, RLX_AGENT) < want) { __builtin_amdgcn_s_sleep(2);
            if ((++sp & 1023u) == 0u) { if (__hip_atomic_load(ctl + CW_TMO, RLX_AGENT) != 0u) break; if (sp > (1u << 17)) { __hip_atomic_store(ctl + CW_TMO, 0x66u, RLX_AGENT); break; } } }
    }
    __device__ __forceinline__ bool ready_now(gu32* w, unsigned want) { return __hip_atomic_load(w, RLX_AGENT) >= want; }
    __device__ __forceinline__ bool deps_ready_now(unsigned d) {
        const int type = d >> 24, l = (d >> 20) & 15, a = (d >> 10) & 1023; bool ok = true;
        if (type == U_PA) { if (l > 0) { const int p2 = (a + 1 < NPANEL) ? a + 1 : NPANEL - 1; ok = ready_now(cnt_word(ctl, l - 1, 4, a), 8u) && ready_now(cnt_word(ctl, l - 1, 1, p2), mix_target(p2)); } }
        else if (type == U_PC) ok = ready_now(cnt_word(ctl, l, 1, a), mix_target(a));
        else if (type == U_PD) ok = ready_now(cnt_word(ctl, l, 2, a), 8u);
        else ok = ready_now(cnt_word(ctl, l, 3, a), 32u);
        if (ok) { __builtin_amdgcn_fence(__ATOMIC_ACQUIRE, ACQ_SCOPE); asm volatile("s_waitcnt vmcnt(0)" ::: "memory"); }
        return ok;
    }
    __device__ __forceinline__ void wait_deps(unsigned d, int tid) {
        if (tid == 0) {
            const int type = d >> 24, l = (d >> 20) & 15, a = (d >> 10) & 1023; ptype = type;
            if (type == U_PA) { if (l > 0) { poll(cnt_word(ctl, l - 1, 4, a), 8u); const int p2 = (a + 1 < NPANEL) ? a + 1 : NPANEL - 1; poll(cnt_word(ctl, l - 1, 1, p2), mix_target(p2)); } }
            else if (type == U_PC) poll(cnt_word(ctl, l, 1, a), mix_target(a));
            else if (type == U_PD) poll(cnt_word(ctl, l, 2, a), 8u);
            else if (type == U_PE || type == U_PEQ) poll(cnt_word(ctl, l, 3, a), 32u);
            else if (type == U_SSM) poll(cnt_word(ctl, l, 0, a >> 2), 10u);
            else if (type == U_POOL) { poll(cnt_word(ctl, l, 0, a >> 2), 10u); const int r0 = 64 * a - 16; if (r0 >= 0) poll(cnt_word(ctl, l, 0, r0 >> 8), 10u); }
            else if (type == U_SATT) poll(cnt_word(ctl, l, 0, NPANEL - 1), 10u);
            else if (type == U_ATT) { const int b = a / NQB, i = a % NQB, t0 = 32 * i; const int rlo = b * TT + (t0 >= 128 ? t0 - 128 : 0), rhi = b * TT + ((t0 + 31 < TT) ? t0 + 31 : TT - 1);
                poll(cnt_word(ctl, l, 0, rlo >> 8), 10u); if ((rhi >> 8) != (rlo >> 8)) poll(cnt_word(ctl, l, 0, rhi >> 8), 10u); }
            __builtin_amdgcn_fence(__ATOMIC_ACQUIRE, ACQ_SCOPE);
            asm volatile("s_waitcnt vmcnt(0)" ::: "memory");
        }
        asm volatile("" ::: "memory"); __builtin_amdgcn_s_barrier(); asm volatile("" ::: "memory");
    }
    __device__ __forceinline__ void publish(unsigned d, int tid) {
        asm volatile("s_waitcnt vmcnt(0)" ::: "memory");
        WG_BAR();
        if (tid == 0) {
            const int type = d >> 24, l = (d >> 20) & 15, a = (d >> 10) & 1023;
#if PUBLISH_FENCE
            __builtin_amdgcn_fence(__ATOMIC_RELEASE, "agent");
            asm volatile("s_waitcnt vmcnt(0)" ::: "memory");
#endif
            if (type == U_PA) __hip_atomic_fetch_add(cnt_word(ctl, l, 0, a), 1u, RLX_AGENT);
            else if (type == U_PC) __hip_atomic_fetch_add(cnt_word(ctl, l, 2, a), 1u, RLX_AGENT);
            else if (type == U_PD) __hip_atomic_fetch_add(cnt_word(ctl, l, 3, a), 1u, RLX_AGENT);
            else if (type == U_PE) __hip_atomic_fetch_add(cnt_word(ctl, l, 4, a), 1u, RLX_AGENT);
            else if (type == U_SSM || type == U_POOL) __hip_atomic_fetch_add(cnt_word(ctl, l, 1, a >> 2), 64u, RLX_AGENT);
            else if (type == U_SATT) __hip_atomic_fetch_add(cnt_word(ctl, l, 1, NPANEL - 1), 1u, RLX_AGENT);
            else if (type == U_ATT) { const int b = a / NQB, i = a % NQB, t0 = 32 * i; const int r0 = b * TT + t0, r1 = b * TT + ((t0 + 31 < TT) ? t0 + 31 : TT - 1);
                const int p0 = r0 >> 8, p1 = r1 >> 8;
                if (p0 == p1) __hip_atomic_fetch_add(cnt_word(ctl, l, 1, p0), (unsigned)(r1 - r0 + 1), RLX_AGENT);
                else { __hip_atomic_fetch_add(cnt_word(ctl, l, 1, p0), (unsigned)(256 * p1 - r0), RLX_AGENT); __hip_atomic_fetch_add(cnt_word(ctl, l, 1, p1), (unsigned)(r1 - 256 * p1 + 1), RLX_AGENT); } }
        }
    }
};

#ifndef A_AUX
#define A_AUX 0
#endif
struct GU { const char* A; const char* B; unsigned voffA[2], voffB[2]; size_t hstep; int nt; unsigned d; pg8::Unit u; };

struct StreamCtx { unsigned char* ws; float* out; const float* gq; const float* gk; int R[2], C[2], Rp[2]; };
__device__ __forceinline__ void gu_fill(GU& g, unsigned d, const StreamCtx& X) {
    const int type = d >> 24, l = (d >> 20) & 15, pm = (d >> 10) & 1023; int pn = d & 1023;
    unsigned char* ws = X.ws;
    const bf16* A; const bf16* B; int K = DM; bool perm = false;
    if (type == U_PA) { A = (const bf16*)(ws + WS_XB); B = (const bf16*)(ws + WS_WIN) + (size_t)l * INW * DM; }
    else if (type == U_PC) { A = (const bf16*)(ws + WS_MIX); B = (const bf16*)(ws + WS_WOUT) + (size_t)l * DM * DM; perm = true; }
    else if (type == U_PD) { A = (const bf16*)(ws + WS_XB); B = (const bf16*)(ws + WS_W1) + (size_t)l * DFF * DM; perm = true; }
    else { A = (const bf16*)(ws + WS_H); B = (const bf16*)(ws + WS_W2) + (size_t)l * DM * DFF; K = DFF; perm = true; }
    int koff = 0, nt = K / 64;
    if (type == U_PEQ) { koff = (pn & 3) * (DFF / 4); nt = DFF / 4 / 64; pn >>= 2; }
    g.d = d; g.u.pm = pm; g.u.pn = pn; g.nt = nt; g.hstep = (size_t)128 * K * 2;
    g.A = (const char*)A + ((size_t)pm * 256 * K + koff) * 2; g.B = (const char*)B + ((size_t)pn * 256 * K + koff) * 2;
#pragma unroll
    for (int i = 0; i < 2; ++i) { g.voffA[i] = (unsigned)(X.R[i] * K + X.C[i]) * 2u; g.voffB[i] = (unsigned)((perm ? X.Rp[i] : X.R[i]) * K + X.C[i]) * 2u; }
}

__device__ __forceinline__ unsigned gemm_stream(const Args& AR, Frame& F, Sched& Q, unsigned d0) {
    int tid_ = F.tid(); asm volatile("" : "+v"(tid_));
    const int tid = tid_, wid = __builtin_amdgcn_readfirstlane(tid >> 6), lane = tid & 63, wr = wid >> 2, wc = wid & 3, fr = lane & 15, fq = lane >> 4;
    LAS unsigned char* lds = F.lds; LAS unsigned char* esc = F.lds + ESC_OFF;
    StreamCtx X; X.ws = F.ws; X.out = F.out;
#pragma unroll
    for (int i = 0; i < 2; ++i) { int R, C; pg8::stage_rc(tid * 16 + i * 8192, R, C); X.R[i] = R; X.C[i] = C; X.Rp[i] = (R & ~31) + pg8::perm32(R & 31); }
    const size_t kstep = (size_t)(pg8::BK * 2);
    const unsigned ldsw = (unsigned)wid * 1024u;
    const int aoff = pg8::lds_byte(wr * 64 + fr, fq * 8), boff = pg8::lds_byte(wc * 32 + fr, fq * 8);
#define PG8_SA(b, h) (((b) * 2 + (h)) * pg8::HTB)
#define PG8_SB(b, h) ((4 + (b) * 2 + (h)) * pg8::HTB)
#define PG8_STAGE(bufoff, gbase, voff) do { _Pragma("unroll") for (int _i = 0; _i < 2; ++_i) \
        __builtin_amdgcn_global_load_lds((const unsigned*)((const char*)(gbase) + (voff)[_i]), (LAS unsigned*)(lds + (bufoff) + ldsw + _i * 8192), 16, 0, 0); } while (0)
#define PG8_STAGE_A(bufoff, gbase, voff) do { _Pragma("unroll") for (int _i = 0; _i < 2; ++_i) \
        __builtin_amdgcn_global_load_lds((const unsigned*)((const char*)(gbase) + (voff)[_i]), (LAS unsigned*)(lds + (bufoff) + ldsw + _i * 8192), 16, 0, A_AUX); } while (0)
#define PG8_LDA(dst, b, h) do { _Pragma("unroll") for (int m = 0; m < 4; ++m) _Pragma("unroll") for (int k = 0; k < 2; ++k) dst[m][k] = *(const LAS bf16x8*)(lds + PG8_SA(b, h) + aoff + m * 2048 + k * 1024); } while (0)
#define PG8_LDB(dst, b, h) do { _Pragma("unroll") for (int n = 0; n < 2; ++n) _Pragma("unroll") for (int k = 0; k < 2; ++k) dst[n][k] = *(const LAS bf16x8*)(lds + PG8_SB(b, h) + boff + n * 2048 + k * 1024); } while (0)
#define PG8_MMA(ai, bj, At, Bt) do { if (mm[ai]) { __builtin_amdgcn_s_setprio(1); _Pragma("unroll") for (int m = 0; m < 4; ++m) _Pragma("unroll") for (int n = 0; n < 2; ++n) _Pragma("unroll") for (int k = 0; k < 2; ++k) \
        acc[ai][bj][m][n] = __builtin_amdgcn_mfma_f32_16x16x32_bf16(Bt[n][k], At[m][k], acc[ai][bj][m][n], 0, 0, 0); __builtin_amdgcn_s_setprio(0); } } while (0)
#define PG8_WAIT_V(n) asm volatile("s_waitcnt vmcnt(" #n ")" ::: "memory")
#define PG8_WAIT_L(n) asm volatile("s_waitcnt lgkmcnt(" #n ")" ::: "memory")
#define PG8_BAR __builtin_amdgcn_s_barrier()
#define PG8_SCHED __builtin_amdgcn_sched_barrier(0)
    GU cur;
    gu_fill(cur, d0, X);
    f32x4 acc[2][2][4][2];
#pragma unroll
    for (int a = 0; a < 2; ++a)
#pragma unroll
        for (int b = 0; b < 2; ++b)
#pragma unroll
            for (int m = 0; m < 4; ++m)
#pragma unroll
                for (int n = 0; n < 2; ++n) acc[a][b][m][n] = (f32x4){0.f, 0.f, 0.f, 0.f};
    bf16x8 At[4][2], B0[2][2], B1[2][2];
    Q.wait_deps(cur.d, tid);
    PG8_STAGE(PG8_SB(0, 0), cur.B, cur.voffB); PG8_STAGE(PG8_SB(0, 1), cur.B + cur.hstep, cur.voffB); PG8_STAGE_A(PG8_SA(0, 0), cur.A, cur.voffA); PG8_STAGE_A(PG8_SA(0, 1), cur.A + cur.hstep, cur.voffA);
    if (wr == 1) PG8_BAR;
    PG8_WAIT_V(2); PG8_BAR;
    PG8_STAGE(PG8_SB(1, 0), cur.B + kstep, cur.voffB); PG8_STAGE_A(PG8_SA(1, 0), cur.A + kstep, cur.voffA); PG8_STAGE(PG8_SB(1, 1), cur.B + cur.hstep + kstep, cur.voffB);
    PG8_WAIT_V(6); PG8_BAR;
    unsigned carry = 0u; unsigned ui = 0u;
    for (;;) {
        bool go = false;
        const char* cA = cur.A; const char* cB = cur.B; const size_t hstep = cur.hstep; const int nt = cur.nt;
#if PROBE && PROBE_KIND == 3
        const unsigned long long tu0 = __builtin_amdgcn_s_memrealtime();
#endif
        const bool fullp = cur.u.pm != NPANEL - 1; const bool mm[2] = {fullp || wr == 0, fullp};
        for (int t = 0; t < nt; t += 2) {
            const bool last = (t == nt - 2);
            const char* a1 = cA + (size_t)(t + 1) * kstep;
            const char* a2_ = cA + (size_t)(last ? 0 : t + 2) * kstep; const char* b2_ = cB + (size_t)(last ? 0 : t + 2) * kstep;
            const char* a2 = a2_; const char* b2 = b2_; size_t h2 = hstep;
            unsigned vA2[2], vB2[2];
#pragma unroll
            for (int i = 0; i < 2; ++i) { vA2[i] = cur.voffA[i]; vB2[i] = cur.voffB[i]; }
            if (last) {
                const unsigned k = 2u + (ui & 1u);
#if PROBE && PROBE_KIND == 8
                const unsigned long long tc0 = __builtin_amdgcn_s_memrealtime();
#endif
                if (tid == 0) { const unsigned dn = Q.claim_lane(); Q.slot[k] = dn;
                    Q.slot[2u + k] = ((dn >> 24) >= U_PA && (dn >> 24) <= U_GEMM_LAST && (!STREAM_SAME_SECTION || ((dn >> 20) == (cur.d >> 20))) && Q.deps_ready_now(dn)) ? 1u : 0u; }
                asm volatile("s_waitcnt lgkmcnt(0)" ::: "memory"); PG8_BAR; asm volatile("" ::: "memory");
                carry = Q.slot[k]; go = Q.slot[2u + k] != 0u;
#if PROBE && PROBE_KIND == 8
                if (tid == 0 && (int)(cur.d >> 24) == PROBE_TYPE) { Q.slot[6] += (unsigned)(__builtin_amdgcn_s_memrealtime() - tc0); Q.slot[7] += 1u; }
#endif
                if (go) { GU n2; gu_fill(n2, carry, X); a2 = n2.A; b2 = n2.B; h2 = n2.hstep;
#pragma unroll
                    for (int i = 0; i < 2; ++i) { vA2[i] = n2.voffA[i]; vB2[i] = n2.voffB[i]; } }
            }
            const char* a3 = a2 + kstep; const char* b3 = b2 + kstep;
            PG8_LDB(B0, 0, 0); PG8_LDB(B1, 0, 1); PG8_SCHED; PG8_LDA(At, 0, 0); PG8_STAGE_A(PG8_SA(1, 1), a1 + hstep, cur.voffA);
            PG8_WAIT_V(8); PG8_WAIT_L(0); PG8_BAR; PG8_MMA(0, 0, At, B0); PG8_MMA(0, 1, At, B1); PG8_BAR; PG8_SCHED;
            PG8_LDA(At, 0, 1); PG8_STAGE(PG8_SB(0, 0), b2, vB2); PG8_STAGE(PG8_SB(0, 1), b2 + h2, vB2); PG8_STAGE_A(PG8_SA(0, 0), a2, vA2);
            PG8_WAIT_V(8); PG8_WAIT_L(0); PG8_BAR; PG8_MMA(1, 0, At, B0); PG8_MMA(1, 1, At, B1); PG8_BAR; PG8_SCHED;
            PG8_LDB(B0, 1, 0); PG8_LDB(B1, 1, 1); PG8_SCHED; PG8_LDA(At, 1, 0); PG8_STAGE_A(PG8_SA(0, 1), a2 + h2, vA2);
            PG8_WAIT_V(8); PG8_WAIT_L(0); PG8_BAR; PG8_MMA(0, 0, At, B0); PG8_MMA(0, 1, At, B1); PG8_BAR; PG8_SCHED;
            PG8_LDA(At, 1, 1); PG8_STAGE(PG8_SB(1, 0), b3, vB2); PG8_STAGE(PG8_SB(1, 1), b3 + h2, vB2); PG8_STAGE_A(PG8_SA(1, 0), a3, vA2);
            PG8_WAIT_V(8); PG8_WAIT_L(0); PG8_BAR; PG8_MMA(1, 0, At, B0); PG8_MMA(1, 1, At, B1); PG8_BAR; PG8_SCHED;
        }
#if PROBE && PROBE_KIND == 7
        const unsigned long long te0 = __builtin_amdgcn_s_memrealtime();
#endif
        if (wr == 0) PG8_BAR;
        { const int type = cur.d >> 24, l = (cur.d >> 20) & 15;
          if (type == U_PA) { EpiProj E{X.ws, X.out, AR.in[IN_GQ] + l * 128, AR.in[IN_GK] + l * 128, l}; E(acc, cur.u, wr, wc, fr, fq, esc, tid); }
          else if (type == U_PD) { EpiFfn1 E{X.ws}; E(acc, cur.u, wr, wc, fr, fq, esc, tid); }
          else if (type == U_PEQ) { EpiAtom E{X.out}; E(acc, cur.u, wr, wc, fr, fq, esc, tid); }
          else { EpiRes E{X.ws, X.out, (type == U_PE && l == NLAYER - 1) ? 1 : 0, (type == U_PC && l == NLAYER - 1 && cur.u.pm == NPANEL - 1) ? 1 : 0}; E(acc, cur.u, wr, wc, fr, fq, esc, tid); }
          Q.publish(cur.d, tid);
#if PROBE && PROBE_KIND == 7
          if (tid == 0 && (int)(cur.d >> 24) == PROBE_TYPE && cur.u.pm != NPANEL - 1) { Q.slot[6] += (unsigned)(__builtin_amdgcn_s_memrealtime() - te0); Q.slot[7] += 1u; }
#endif
#if PROBE && PROBE_KIND == 3
          if (tid == 0 && (int)(cur.d >> 24) == PROBE_TYPE && cur.u.pm != NPANEL - 1) { Q.slot[6] += (unsigned)(__builtin_amdgcn_s_memrealtime() - tu0); Q.slot[7] += 1u; }
#endif
          }
        if (!go) break;
#pragma unroll
        for (int a = 0; a < 2; ++a)
#pragma unroll
            for (int b = 0; b < 2; ++b)
#pragma unroll
                for (int m = 0; m < 4; ++m)
#pragma unroll
                    for (int n = 0; n < 2; ++n) acc[a][b][m][n] = (f32x4){0.f, 0.f, 0.f, 0.f};
        gu_fill(cur, carry, X); ++ui;
        if (wr == 1) PG8_BAR;
    }
    PG8_WAIT_V(0);
    PG8_BAR;
#undef PG8_SA
#undef PG8_SB
#undef PG8_STAGE
#undef PG8_STAGE_A
#undef PG8_LDA
#undef PG8_LDB
#undef PG8_MMA
#undef PG8_WAIT_V
#undef PG8_WAIT_L
#undef PG8_BAR
#undef PG8_SCHED
    return carry;
}

__global__ void __launch_bounds__(512, 2) hymba_fwd(Args args) {
    extern __shared__ __attribute__((aligned(16))) unsigned char lds[];
    Frame F;
    F.lds = (LAS unsigned char*)lds;
    F.MISC = (volatile LAS unsigned*)(F.lds + MISC_OFF);
    F.wave = __builtin_amdgcn_readfirstlane((int)(threadIdx.x >> 6));
    F.G = gridDim.x; { const int bx = blockIdx.x; F.vcu = (F.G % 8 == 0) ? (bx % 8) * (F.G / 8) + bx / 8 : bx; }
    F.ws = args.ws; F.out = args.out; F.ctl = (gu32*)(args.ws + WS_CTL);
    for (int u = F.tid(); u < (LDS_BYTES - LDSCTL_OFF) / 4; u += 512) ((LAS unsigned*)(F.lds + LDSCTL_OFF))[u] = 0u;
    __syncthreads();
    XcdBarrier bar = xcd_barrier_post((unsigned*)(F.ctl + CW_BAR), F.MISC + 8);
#if PROBE
    const unsigned long long tk0 = __builtin_amdgcn_s_memrealtime();
#endif
    for (int rep = 0; rep < DUP_P0; ++rep) p0_prologue(args, F);
#if PROBE && (PROBE_KIND == 5 || PROBE_KIND == 6)
    if (F.tid() == 0) { F.MISC[6] = (unsigned)(__builtin_amdgcn_s_memrealtime() - tk0); if (PROBE_KIND == 6) __hip_atomic_fetch_max(F.ctl + CW_STAT + 48, F.MISC[6], RLX_AGENT); }
#endif
    if (blockIdx.x < 8 && F.tid() == 0) build_queue((unsigned*)(args.ws + WS_QUEUE) + (size_t)blockIdx.x * QCAP, (int)blockIdx.x);
    xcd_barrier(bar);
    Sched Q; Q.ctl = F.ctl; Q.qglob = (const unsigned*)(args.ws + WS_QUEUE); Q.qlds = (LAS unsigned*)(F.lds + QTAB_OFF); Q.slot = F.MISC; Q.myq = __builtin_amdgcn_readfirstlane((int)(bar.x & 7u)); Q.nclaim = 0u; Q.ptype = 0;
    { const unsigned* qg = Q.qglob + (size_t)Q.myq * QCAP; for (int i = F.tid(); i < QCAP; i += 512) Q.qlds[i] = qg[i]; }
    WG_BAR();
    unsigned d = Q.claim_wg(F.tid());
#if SEC_BARRIER
    int cursec = 0;
#endif
    for (;;) {
        const int type = d >> 24;
#if SEC_BARRIER
        { const int sec = (type == U_END) ? 5 * NLAYER : ((d >> 20) & 15) * 5 + ((type >= U_SSM) ? 1 : (type == U_PA ? 0 : type));
          while (cursec < sec) { if ((SEC_MASK >> cursec) & 1) xcd_barrier(bar); ++cursec; } }
#endif
        if (type == U_END) break;
        if (type <= U_GEMM_LAST) {
#if PROBE && PROBE_KIND == 9
            const unsigned long long ts0 = __builtin_amdgcn_s_memrealtime();
#endif
            d = gemm_stream(args, F, Q, d);
#if PROBE && PROBE_KIND == 9
            if (F.tid() == 0) { F.MISC[6] += (unsigned)(__builtin_amdgcn_s_memrealtime() - ts0); }
#endif
            continue; }
        const int l = (d >> 20) & 15, a = (d >> 10) & 1023;
        Q.wait_deps(d, F.tid());
#if PROBE && PROBE_KIND == 2
        const unsigned long long tp0 = __builtin_amdgcn_s_memrealtime();
#endif
        if (type == U_SSM) ssm_unit(args, F, l, a);
        else if (type == U_ATT) attn_unit(args, F, l, a / NQB, a % NQB);
        else if (type == U_SATT) sattn_unit(args, F, l, a);
        else pool_unit(args, F, l, a);
        Q.publish(d, F.tid());
#if PROBE && PROBE_KIND == 2
        if (F.tid() == 0 && (PROBE_TYPE == 0 || type == PROBE_TYPE)) F.MISC[6] += (unsigned)(__builtin_amdgcn_s_memrealtime() - tp0);
#endif
        d = Q.claim_wg(F.tid());
    }
#if PROBE
    if (F.tid() == 0) {
        const unsigned tend = (unsigned)(__builtin_amdgcn_s_memrealtime() - tk0);
        if (PROBE_KIND == 4) { F.MISC[6] = tend; __hip_atomic_fetch_max(F.ctl + CW_STAT + 48, tend, RLX_AGENT); }
        __hip_atomic_fetch_add(F.ctl + CW_STAT, F.MISC[6], RLX_AGENT);
        __hip_atomic_fetch_add(F.ctl + CW_STAT + 32, F.MISC[7], RLX_AGENT);
        const unsigned n = __hip_atomic_fetch_add(F.ctl + CW_STAT + 16, 1u, RLX_AGENT);
        F.MISC[7] = (n == gridDim.x - 1) ? 1u : 0u;
        if (n == gridDim.x - 1) { F.MISC[5] = __hip_atomic_load(F.ctl + CW_STAT, RLX_AGENT); F.MISC[4] = __hip_atomic_load(F.ctl + CW_STAT + 32, RLX_AGENT); F.MISC[3] = __hip_atomic_load(F.ctl + CW_STAT + 48, RLX_AGENT); }
    }
    WG_BAR();
    if (F.MISC[7]) { float v = (float)F.MISC[5] / (float)gridDim.x * 0.01f;
        if (PROBE_KIND == 3 || PROBE_KIND == 7 || PROBE_KIND == 8) v = (float)F.MISC[5] * 0.01f / (float)(F.MISC[4] ? F.MISC[4] : 1u);
        if (PROBE_KIND == 4) v = (float)F.MISC[3] * 0.01f - v;
        if (PROBE_KIND == 6) v = (float)F.MISC[3] * 0.01f;
        v = floorf((v + 0.5f * PROBE_Q) / PROBE_Q) * PROBE_Q;
        for (int i = F.tid(); i < NLAYER * NSAMP * 15 * 512; i += 512) F.out[O_SP + i] = v; }
#endif
}

extern "C" void kernel_launch(void* const* d_in, const int* in_sizes, int n_in, void* d_out, int out_size, void* d_ws, size_t ws_size, hipStream_t stream) {
    static int grid = 0;
    if (grid == 0) {
        if (n_in != 32 || (size_t)out_size != O_END || ws_size < WS_END) { fprintf(stderr, "kernel_launch: unexpected shapes: n_in %d out %d (want %zu) ws %zu (want >= %zu)\n", n_in, out_size, (size_t)O_END, ws_size, (size_t)WS_END); grid = -1; return; }
        int dev = 0, cus = 0, per_cu = 0;
        if (hipGetDevice(&dev) != hipSuccess || hipDeviceGetAttribute(&cus, hipDeviceAttributeMultiprocessorCount, dev) != hipSuccess) { fprintf(stderr, "kernel_launch: device query failed\n"); grid = -1; return; }
        if (hipFuncSetAttribute((const void*)hymba_fwd, hipFuncAttributeMaxDynamicSharedMemorySize, LDS_BYTES) != hipSuccess) { fprintf(stderr, "kernel_launch: hipFuncSetAttribute failed\n"); grid = -1; return; }
        if (hipOccupancyMaxActiveBlocksPerMultiprocessor(&per_cu, (const void*)hymba_fwd, 512, LDS_BYTES) != hipSuccess || per_cu < 1) { fprintf(stderr, "kernel_launch: occupancy query says %d blocks per CU\n", per_cu); per_cu = 1; }
        (void)hipGetLastError();
        grid = cus;
        if (grid % 8 != 0) grid -= grid % 8;
    }
    if (grid < 0) return;
    (void)hipMemsetAsync((char*)d_ws + WS_CTL, 0, CTL_ZERO_BYTES, stream);
    Args a{};
    for (int i = 0; i < 32; ++i) a.in[i] = (const float*)d_in[i];
    a.out = (float*)d_out; a.ws = (unsigned char*)d_ws; a.ph_lo = 0; a.ph_hi = 0;
    hipLaunchKernelGGL(hymba_fwd, dim3(grid), dim3(512), LDS_BYTES, stream, a);
    const hipError_t le = hipPeekAtLastError();
    if (le != hipSuccess) fprintf(stderr, "kernel_launch: launch failed: %s\n", hipGetErrorName(le));
}
```

```cpp
#include <hip/hip_runtime.h>
#include <cstdio>
#include <cstdint>

#ifndef MK_N_LAUNCHES
#define MK_N_LAUNCHES 1
#endif

#ifndef SEC_BARRIER
#define SEC_BARRIER 0
#endif
#ifndef STREAM_SAME_SECTION
#define STREAM_SAME_SECTION 0
#endif
#ifndef SEC_MASK
#define SEC_MASK 0x10
#endif
#ifndef PROBE
#define PROBE 0
#endif
#ifndef PROBE_KIND
#define PROBE_KIND 1
#endif
#ifndef PROBE_TYPE
#define PROBE_TYPE 0
#endif
#ifndef PROBE_Q
#define PROBE_Q 20.0f
#endif
#ifndef DUP_PB
#define DUP_PB 1
#endif
#ifndef DUP_P0
#define DUP_P0 1
#endif

constexpr int DM = 2048, TT = 4112  , NSEQ = 4096, NMETA = 16, NBATCH = 2, NSAMP = 32;
constexpr int MR = NBATCH * TT + NSAMP;
constexpr int MP = 8448;
constexpr int SROW0 = NBATCH * TT;
constexpr int INW = 2560, DFF = 8192, NLAYER = 2;
constexpr int TPV = 4128;
constexpr int ROPE_SAMPLE_IDX = TT;
constexpr float EPS = 1e-6f;
constexpr float LOG2E = 1.4426950408889634f;
constexpr float QSCALE = 0.08838834764831845f * LOG2E;
constexpr int NCHUNK = MR / 64;
constexpr int NQB = (TT + 31) / 32;

constexpr size_t O_YP = 0, O_YS = O_YP + (size_t)NBATCH * NSEQ * DM, O_PK = O_YS + (size_t)NSAMP * DM, O_PV = O_PK + (size_t)NLAYER * NBATCH * 128 * 256,
                 O_PSR = O_PV + (size_t)NLAYER * NBATCH * 128 * 256, O_PSI = O_PSR + (size_t)NLAYER * NBATCH * 2048, O_PP = O_PSI + (size_t)NLAYER * NBATCH * 2048,
                 O_SK = O_PP + (size_t)NLAYER * NBATCH * 15 * 512, O_SV = O_SK + (size_t)NLAYER * NSAMP * 128 * 256, O_SSR = O_SV + (size_t)NLAYER * NSAMP * 128 * 256,
                 O_SSI = O_SSR + (size_t)NLAYER * NSAMP * 2048, O_SP = O_SSI + (size_t)NLAYER * NSAMP * 2048, O_END = O_SP + (size_t)NLAYER * NSAMP * 15 * 512;

constexpr size_t MiB = 1u << 20;
constexpr size_t WS_CTL = 0, CTL_ZERO_BYTES = 1 * MiB;
constexpr size_t WS_WIN = 1 * MiB, WS_WOUT = 21 * MiB, WS_W1 = 37 * MiB, WS_W2 = 101 * MiB, WS_WGLU = 165 * MiB, WS_WPOOL = 166 * MiB, WS_TAB = 167 * MiB;
constexpr size_t WS_X = 170 * MiB, WS_XB = 236 * MiB, WS_Q = 269 * MiB, WS_K = 286 * MiB, WS_VT = 291 * MiB, WS_U = 296 * MiB, WS_XP = 313 * MiB, WS_MIX = 330 * MiB,
                 WS_H = 363 * MiB, WS_SSQ = 495 * MiB, WS_SST = 497 * MiB, WS_KSN = 502 * MiB, WS_QUEUE = 503 * MiB, WS_END = 504 * MiB;
static_assert(WS_WIN + (size_t)NLAYER * INW * DM * 2 <= WS_WOUT && WS_WOUT + (size_t)NLAYER * DM * DM * 2 <= WS_W1 && WS_W1 + (size_t)NLAYER * DFF * DM * 2 <= WS_W2 && WS_W2 + (size_t)NLAYER * DFF * DM * 2 <= WS_WGLU, "ws map 1");
static_assert(WS_X + (size_t)MP * DM * 4 <= WS_XB && WS_XB + (size_t)MP * DM * 2 <= WS_Q && WS_Q + (size_t)MP * 1024 * 2 <= WS_K && WS_K + (size_t)MP * 256 * 2 <= WS_VT && WS_VT + (size_t)4 * 128 * TPV * 2 <= WS_U, "ws map 2");
static_assert(WS_U + (size_t)MP * 512 * 4 <= WS_XP && WS_XP + (size_t)MP * 512 * 4 <= WS_MIX && WS_MIX + (size_t)MP * DM * 2 <= WS_H && WS_H + (size_t)MP * DFF * 2 <= WS_SSQ && WS_SSQ + (size_t)MP * 32 * 4 <= WS_SST, "ws map 3");
static_assert(WS_SST + (size_t)NLAYER * NCHUNK * 32 * 64 * 8 <= WS_KSN, "ws map 4");
constexpr size_t TB_ABR = 0, TB_ABI = 8192, TB_ALR = 16384, TB_ALI = 24576, TB_A16R = 32768, TB_A16I = 40960, TB_A32R = 49152, TB_A32I = 57344,
                 TB_BBR = 65536, TB_BBI = TB_BBR + 131072, TB_PM = TB_BBI + 131072, TB_CMT = TB_PM + 524288, TB_LAYER = 1 * MiB;
static_assert(TB_CMT + 131072 <= TB_LAYER, "table map");
constexpr size_t WS_ROPE = WS_TAB + 2 * MiB;
constexpr size_t ROPE_N = (size_t)(TT + 1) * 16;
constexpr int CW_TMO = 0, CW_CODE = 1, CW_BAR = 4096, CW_QHEAD = 8192  , CW_STAT = 8800, CW_CNT = 9216  , CW_SSMF = 16384  ;
static_assert(CW_CNT + NLAYER * 5 * 40 * 16 <= CW_SSMF, "ctl map: counters");
static_assert((CW_SSMF + NLAYER * NCHUNK * 8 * 16) * 4 <= (int)CTL_ZERO_BYTES, "ctl map");

constexpr int RING_BYTES = 131072, ESC_OFF = RING_BYTES  , QTAB_OFF = ESC_OFF + 12288  , LDSCTL_OFF = QTAB_OFF + 4096, MISC_OFF = LDSCTL_OFF + 320, LDS_BYTES = 148480;
static_assert(MISC_OFF + 128 <= LDS_BYTES, "LDS map");

#define GAS __attribute__((address_space(1)))
#define LAS __attribute__((address_space(3)))
typedef unsigned short bf16;
typedef unsigned v4u __attribute__((ext_vector_type(4)));
typedef unsigned v2u __attribute__((ext_vector_type(2)));
typedef float f32x2 __attribute__((ext_vector_type(2)));
typedef float f32x16 __attribute__((ext_vector_type(16)));
typedef __bf16 bf16x2_t __attribute__((ext_vector_type(2)));
typedef GAS unsigned gu32;
typedef GAS unsigned long long gu64;
#define RLX_AGENT __ATOMIC_RELAXED, __HIP_MEMORY_SCOPE_AGENT
#define LDS_WAIT() asm volatile("s_waitcnt lgkmcnt(0)" ::: "memory")
#define VM_WAIT() asm volatile("s_waitcnt vmcnt(0)" ::: "memory")
#define WG_BAR() do { asm volatile("s_waitcnt lgkmcnt(0)" ::: "memory"); __builtin_amdgcn_s_barrier(); asm volatile("" ::: "memory"); } while (0)
__device__ __forceinline__ unsigned pk2(float lo, float hi) { f32x2 v = {lo, hi}; bf16x2_t b = __builtin_convertvector(v, bf16x2_t); return __builtin_bit_cast(unsigned, b); }
__device__ __forceinline__ float bf2f(unsigned short h) { return __builtin_bit_cast(float, (unsigned)h << 16); }
__device__ __forceinline__ float wave_sum(float v) {
#pragma unroll
    for (int o = 1; o < 64; o <<= 1) v += __shfl_xor(v, o);
    return v;
}
__device__ __forceinline__ float wave_max(float v) {
#pragma unroll
    for (int o = 1; o < 64; o <<= 1) v = fmaxf(v, __shfl_xor(v, o));
    return v;
}

typedef __amdgpu_buffer_rsrc_t rsrc_t;
__device__ __forceinline__ rsrc_t ws_rsrc(unsigned char* ws) { return __builtin_amdgcn_make_buffer_rsrc(ws, 0, (int)WS_END, 0x00020000); }
#define ST16(r, off, v) __builtin_amdgcn_raw_buffer_store_b128(__builtin_bit_cast(v4u, (v)), (r), (unsigned)(off), 0, 16)
#define ST8(r, off, v)  __builtin_amdgcn_raw_buffer_store_b64((v), (r), (unsigned)(off), 0, 16)
#define ST4(r, off, v)  __builtin_amdgcn_raw_buffer_store_b32(__builtin_bit_cast(unsigned, (v)), (r), (unsigned)(off), 0, 16)
#define ST2(r, off, v)  __builtin_amdgcn_raw_buffer_store_b16((unsigned short)(v), (r), (unsigned)(off), 0, 16)
__host__ __device__ __forceinline__ int perm16(int o) { return 8 * ((o >> 2) & 1) + 4 * (o >> 3) + (o & 3); }

namespace pg8 {
#define PG8_LAS __attribute__((address_space(3)))
typedef unsigned short bf16_t;
typedef short bf16x8 __attribute__((ext_vector_type(8)));
typedef float f32x4 __attribute__((ext_vector_type(4)));
typedef unsigned u32x4 __attribute__((ext_vector_type(4)));
constexpr int BM = 256, BK = 64, HALF = 128, HTB = HALF * BK * 2  , STAGE_BYTES = 8 * HTB, NXCD = 8, WGM = 8;

__host__ __device__ __forceinline__ int lds_byte(int r, int c) { const int st = (r >> 4) * 2 + (c >> 5), rr = r & 15, cc = c & 31, ob = rr * 64 + cc * 2; return st * 1024 + (ob ^ (((ob >> 9) & 1) << 5)); }
__host__ __device__ __forceinline__ void stage_rc(int b, int& R, int& C) { const int st = b / 1024, sb = b % 1024, swz = sb ^ (((sb >> 9) & 1) << 5); R = (st >> 1) * 16 + swz / 64; C = (st & 1) * 32 + (swz % 64) / 2; }
__host__ __device__ __forceinline__ int perm32(int rho) { const int n = rho >> 4, i = rho & 15; return 8 * (i >> 2) + 4 * n + (i & 3); }

struct Unit { int pm, pn; };
struct Gemm { const bf16_t* A; const bf16_t* Bt; int M, N, K; };

struct StaticOrder {
    int nM, nN, nwg, G, c;
    __host__ __device__ void init(int M, int N, int G_, int c_) { nM = M / BM; nN = N / BM; nwg = nM * nN; G = G_; c = c_; }
    __host__ __device__ bool next(int i, Unit& u) const {
        const long L = (long)i * G + c; if (L >= nwg) return false;
        int wgid = (int)L; { const int q = nwg / NXCD, r = nwg % NXCD, xcd = wgid % NXCD, off = wgid / NXCD; wgid = (xcd < r ? xcd * (q + 1) : r * (q + 1) + (xcd - r) * q) + off; }
        const int nig = WGM * nN, gid = wgid / nig, fm = gid * WGM, gsz = (nM - fm) < WGM ? (nM - fm) : WGM;
        u.pm = fm + ((wgid % nig) % gsz); u.pn = (wgid % nig) / gsz; return true;
    }
    __device__ __forceinline__ void a_ready(const Unit&) const {}
    __device__ __forceinline__ void done(const Unit&) const {}
};


template <class Epi, class Sched, bool ALIGN_EPI = false, bool SP2 = false>
__device__ __forceinline__ void gemm_phase(PG8_LAS unsigned char* lds, PG8_LAS unsigned char* esc, const Gemm g, const Sched& S, const Epi& E) {
    int tid_ = threadIdx.x; asm volatile("" : "+v"(tid_));
    const int tid = tid_, wid = __builtin_amdgcn_readfirstlane(tid >> 6), lane = tid & 63, wr = wid >> 2, wc = wid & 3, fr = lane & 15, fq = lane >> 4;
    const int K = g.K, nt = K / BK;
    unsigned voffA[2], voffB[2];
#pragma unroll
    for (int i = 0; i < 2; ++i) { int R, C; stage_rc(tid * 16 + i * 8192, R, C); const int Rb = Epi::PERM ? ((R & ~31) + perm32(R & 31)) : R;
        voffA[i] = (unsigned)(R * K + C) * 2u; voffB[i] = (unsigned)(Rb * K + C) * 2u; }
    const size_t kstep = (size_t)(BK * 2);
    const size_t hstep = (size_t)HALF * K * 2;
    const size_t tstep = 2 * hstep;
    const unsigned ldsw = (unsigned)wid * 1024u;
    const int aoff = lds_byte(wr * 64 + fr, fq * 8), boff = lds_byte(wc * 32 + fr, fq * 8);
#define PG8_SA(b, h) (((b) * 2 + (h)) * HTB)
#define PG8_SB(b, h) ((4 + (b) * 2 + (h)) * HTB)
#define PG8_STAGE(bufoff, gbase, voff) do { _Pragma("unroll") for (int _i = 0; _i < 2; ++_i) \
        __builtin_amdgcn_global_load_lds((const unsigned*)((const char*)(gbase) + (voff)[_i]), (PG8_LAS unsigned*)(lds + (bufoff) + ldsw + _i * 8192), 16, 0, 0); } while (0)
#define PG8_LDA(dst, b, h) do { _Pragma("unroll") for (int m = 0; m < 4; ++m) _Pragma("unroll") for (int k = 0; k < 2; ++k) dst[m][k] = *(const PG8_LAS bf16x8*)(lds + PG8_SA(b, h) + aoff + m * 2048 + k * 1024); } while (0)
#define PG8_LDB(dst, b, h) do { _Pragma("unroll") for (int n = 0; n < 2; ++n) _Pragma("unroll") for (int k = 0; k < 2; ++k) dst[n][k] = *(const PG8_LAS bf16x8*)(lds + PG8_SB(b, h) + boff + n * 2048 + k * 1024); } while (0)
#define PG8_MMA(ai, bj, At, Bt) do { __builtin_amdgcn_s_setprio(1); _Pragma("unroll") for (int m = 0; m < 4; ++m) _Pragma("unroll") for (int n = 0; n < 2; ++n) _Pragma("unroll") for (int k = 0; k < 2; ++k) \
        acc[ai][bj][m][n] = __builtin_amdgcn_mfma_f32_16x16x32_bf16(Bt[n][k], At[m][k], acc[ai][bj][m][n], 0, 0, 0); __builtin_amdgcn_s_setprio(0); } while (0)
#define PG8_WAIT_V(n) asm volatile("s_waitcnt vmcnt(" #n ")" ::: "memory")
#define PG8_WAIT_L(n) asm volatile("s_waitcnt lgkmcnt(" #n ")" ::: "memory")
#define PG8_BAR __builtin_amdgcn_s_barrier()
#define PG8_SCHED __builtin_amdgcn_sched_barrier(0)
    Unit cur, nxt; int ui = 0;
    if (!S.next(0, cur)) return;
    f32x4 acc[2][2][4][2];
#pragma unroll
    for (int a = 0; a < 2; ++a)
#pragma unroll
        for (int b = 0; b < 2; ++b)
#pragma unroll
            for (int m = 0; m < 4; ++m)
#pragma unroll
                for (int n = 0; n < 2; ++n) acc[a][b][m][n] = (f32x4){0.f, 0.f, 0.f, 0.f};
    bf16x8 At[4][2], B0[2][2], B1[2][2];
    const char* cA = (const char*)g.A + (size_t)cur.pm * tstep; const char* cB = (const char*)g.Bt + (size_t)cur.pn * tstep;
    S.a_ready(cur);
    if constexpr (SP2) {
        PG8_STAGE(PG8_SB(0, 0), cB, voffB); PG8_STAGE(PG8_SB(0, 1), cB + hstep, voffB); PG8_STAGE(PG8_SA(0, 0), cA, voffA); PG8_STAGE(PG8_SA(0, 1), cA + hstep, voffA);
        if (wr == 1) PG8_BAR;
        PG8_WAIT_V(2); PG8_BAR;
        PG8_STAGE(PG8_SB(1, 0), cB + kstep, voffB); PG8_STAGE(PG8_SA(1, 0), cA + kstep, voffA); PG8_STAGE(PG8_SB(1, 1), cB + hstep + kstep, voffB);
        PG8_WAIT_V(6); PG8_BAR;
    } else {
        PG8_STAGE(PG8_SB(0, 0), cB, voffB); PG8_STAGE(PG8_SA(0, 0), cA, voffA); PG8_STAGE(PG8_SB(0, 1), cB + hstep, voffB); PG8_STAGE(PG8_SA(0, 1), cA + hstep, voffA);
        if (wr == 1) PG8_BAR;
        PG8_WAIT_V(4); PG8_BAR;
        PG8_STAGE(PG8_SB(1, 0), cB + kstep, voffB); PG8_STAGE(PG8_SA(1, 0), cA + kstep, voffA); PG8_STAGE(PG8_SB(1, 1), cB + hstep + kstep, voffB);
        PG8_WAIT_V(6); PG8_BAR;
    }
    for (;;) {
        const bool has_next = S.next(ui + 1, nxt);
        const char* nA = has_next ? (const char*)g.A + (size_t)nxt.pm * tstep : cA; const char* nB = has_next ? (const char*)g.Bt + (size_t)nxt.pn * tstep : cB;
        for (int t = 0; t < nt; t += 2) {
            const bool last = (t == nt - 2);
            const char* a1 = cA + (size_t)(t + 1) * kstep;
            const char* a2 = last ? nA : cA + (size_t)(t + 2) * kstep; const char* b2 = last ? nB : cB + (size_t)(t + 2) * kstep;
            const char* a3 = a2 + kstep; const char* b3 = b2 + kstep;
            if (last && has_next) S.a_ready(nxt);
            if constexpr (SP2) {
            PG8_LDB(B0, 0, 0); PG8_LDB(B1, 0, 1); PG8_SCHED; PG8_LDA(At, 0, 0); PG8_STAGE(PG8_SA(1, 1), a1 + hstep, voffA);
            PG8_WAIT_V(8); PG8_WAIT_L(0); PG8_BAR; PG8_MMA(0, 0, At, B0); PG8_MMA(0, 1, At, B1); PG8_BAR; PG8_SCHED;
            PG8_LDA(At, 0, 1); PG8_STAGE(PG8_SB(0, 0), b2, voffB); PG8_STAGE(PG8_SB(0, 1), b2 + hstep, voffB); PG8_STAGE(PG8_SA(0, 0), a2, voffA);
            PG8_WAIT_V(8); PG8_WAIT_L(0); PG8_BAR; PG8_MMA(1, 0, At, B0); PG8_MMA(1, 1, At, B1); PG8_BAR; PG8_SCHED;
            PG8_LDB(B0, 1, 0); PG8_LDB(B1, 1, 1); PG8_SCHED; PG8_LDA(At, 1, 0); PG8_STAGE(PG8_SA(0, 1), a2 + hstep, voffA);
            PG8_WAIT_V(8); PG8_WAIT_L(0); PG8_BAR; PG8_MMA(0, 0, At, B0); PG8_MMA(0, 1, At, B1); PG8_BAR; PG8_SCHED;
            PG8_LDA(At, 1, 1); PG8_STAGE(PG8_SB(1, 0), b3, voffB); PG8_STAGE(PG8_SB(1, 1), b3 + hstep, voffB); PG8_STAGE(PG8_SA(1, 0), a3, voffA);
            PG8_WAIT_V(8); PG8_WAIT_L(0); PG8_BAR; PG8_MMA(1, 0, At, B0); PG8_MMA(1, 1, At, B1); PG8_BAR; PG8_SCHED;
            } else {
            PG8_LDB(B0, 0, 0); PG8_SCHED; PG8_LDA(At, 0, 0); PG8_STAGE(PG8_SA(1, 1), a1 + hstep, voffA);
            PG8_WAIT_L(8); PG8_BAR; PG8_WAIT_L(0); PG8_MMA(0, 0, At, B0); PG8_BAR; PG8_SCHED;
            PG8_LDB(B1, 0, 1); PG8_STAGE(PG8_SB(0, 0), b2, voffB);
            PG8_BAR; PG8_WAIT_L(0); PG8_MMA(0, 1, At, B1); PG8_BAR;
            PG8_LDA(At, 0, 1); PG8_STAGE(PG8_SA(0, 0), a2, voffA);
            PG8_BAR; PG8_WAIT_L(0); PG8_MMA(1, 0, At, B0); PG8_BAR; PG8_SCHED;
            PG8_STAGE(PG8_SB(0, 1), b2 + hstep, voffB);
            PG8_WAIT_V(6); PG8_BAR; PG8_MMA(1, 1, At, B1); PG8_BAR;
            PG8_LDB(B0, 1, 0); PG8_SCHED; PG8_LDA(At, 1, 0); PG8_STAGE(PG8_SA(0, 1), a2 + hstep, voffA);
            PG8_WAIT_L(8); PG8_BAR; PG8_WAIT_L(0); PG8_MMA(0, 0, At, B0); PG8_BAR; PG8_SCHED;
            PG8_LDB(B1, 1, 1); PG8_STAGE(PG8_SB(1, 0), b3, voffB);
            PG8_BAR; PG8_WAIT_L(0); PG8_MMA(0, 1, At, B1); PG8_BAR;
            PG8_LDA(At, 1, 1); PG8_STAGE(PG8_SA(1, 0), a3, voffA);
            PG8_BAR; PG8_WAIT_L(0); PG8_MMA(1, 0, At, B0); PG8_BAR; PG8_SCHED;
            PG8_STAGE(PG8_SB(1, 1), b3 + hstep, voffB);
            PG8_WAIT_V(6); PG8_BAR; PG8_MMA(1, 1, At, B1); PG8_BAR;
            }
        }
        if constexpr (ALIGN_EPI) { if (wr == 0) PG8_BAR; }
        { E(acc, cur, wr, wc, fr, fq, esc, tid); S.done(cur); }
        if (!has_next) break;
#pragma unroll
        for (int a = 0; a < 2; ++a)
#pragma unroll
            for (int b = 0; b < 2; ++b)
#pragma unroll
                for (int m = 0; m < 4; ++m)
#pragma unroll
                    for (int n = 0; n < 2; ++n) acc[a][b][m][n] = (f32x4){0.f, 0.f, 0.f, 0.f};
        cur = nxt; cA = nA; cB = nB; ++ui;
        if constexpr (ALIGN_EPI) { if (wr == 1) PG8_BAR; }
    }
    PG8_WAIT_V(0);
    if constexpr (!ALIGN_EPI) { if (wr == 0) PG8_BAR; }
    PG8_BAR;
#undef PG8_SA
#undef PG8_SB
#undef PG8_STAGE
#undef PG8_LDA
#undef PG8_LDB
#undef PG8_MMA
#undef PG8_WAIT_V
#undef PG8_WAIT_L
#undef PG8_BAR
#undef PG8_SCHED
}
}

typedef float f32x4 __attribute__((ext_vector_type(4)));
typedef short bf16x8 __attribute__((ext_vector_type(8)));


__device__ __forceinline__ void build_rs(const float* ssq, int pm, LAS unsigned char* esc, int tid) {
    LAS float* rsT = (LAS float*)esc;
    WG_BAR();
    if (tid < 256) {
        float s = 0.f;
#pragma unroll
        for (int j = 0; j < 8; ++j) { const gu64* p = (const gu64*)(ssq + ((size_t)j * MP + pm * 256 + tid) * 4);
#pragma unroll
            for (int h = 0; h < 2; ++h) { const unsigned long long v = __hip_atomic_load(p + h, RLX_AGENT); s += __builtin_bit_cast(float, (unsigned)v) + __builtin_bit_cast(float, (unsigned)(v >> 32)); } }
        rsT[tid] = rsqrtf(s * (1.0f / DM) + EPS);
    }
    WG_BAR();
}

struct EpiProj {
    static constexpr bool PERM = false, AFTER_DRAIN = false;
    unsigned char* ws_; float* out_; const float* gq; const float* gk; int l;
    __device__ __forceinline__ void operator()(f32x4 (&acc)[2][2][4][2], const pg8::Unit& u, int wr, int wc, int fr, int fq, LAS unsigned char* esc, int tid) const {
        asm volatile("" : "+v"(fr), "+v"(fq), "+v"(tid));
        size_t z_ = 0; asm volatile("" : "+s"(z_)); unsigned char* ws = ws_ + z_;
        const float* ssq = (const float*)(ws + WS_SSQ); const float* ropec = (const float*)(ws + WS_ROPE); const float* ropes = ropec + ROPE_N;
        bf16* Q = (bf16*)(ws + WS_Q); bf16* K = (bf16*)(ws + WS_K); bf16* VT = (bf16*)(ws + WS_VT); float* U = (float*)(ws + WS_U); float* XP = (float*)(ws + WS_XP);
        float* ksn = (float*)(ws + WS_KSN); float* vsn = ksn + NSAMP * 256;
        float* out_pk = out_ + O_PK + (size_t)l * NBATCH * 128 * 256; float* out_pv = out_ + O_PV + (size_t)l * NBATCH * 128 * 256;
        const rsrc_t rs_ = ws_rsrc(ws);
        build_rs(ssq, u.pm, esc, tid);
        const LAS float* rsT = (const LAS float*)esc;
        LAS float* hss = (LAS float*)(esc + 1024);
        const int pn = u.pn;
#pragma unroll
        for (int ai = 0; ai < 2; ++ai)
#pragma unroll
            for (int m = 0; m < 4; ++m) { const float rsv = rsT[ai * 128 + wr * 64 + m * 16 + fr];
#pragma unroll
                for (int bj = 0; bj < 2; ++bj)
#pragma unroll
                    for (int n = 0; n < 2; ++n) acc[ai][bj][m][n] *= rsv; }
        if (pn <= 4) {
#pragma unroll
            for (int ai = 0; ai < 2; ++ai)
#pragma unroll
                for (int m = 0; m < 4; ++m)
#pragma unroll
                    for (int bj = 0; bj < 2; ++bj) { const f32x4 a = acc[ai][bj][m][0], b = acc[ai][bj][m][1];
                        float s = (a[0] * a[0] + a[1] * a[1]) + (a[2] * a[2] + a[3] * a[3]) + (b[0] * b[0] + b[1] * b[1]) + (b[2] * b[2] + b[3] * b[3]);
                        s += __shfl_xor(s, 16); s += __shfl_xor(s, 32);
                        if (fq == 0) hss[(bj * 256 + ai * 128 + wr * 64 + m * 16 + fr) * 4 + wc] = s; }
            WG_BAR();
            const float* g = (pn < 4) ? gq : gk; const float osc = (pn < 4) ? QSCALE : 1.0f;
            f32x4 gv[2];
#pragma unroll
            for (int n = 0; n < 2; ++n) gv[n] = *(const f32x4*)(g + wc * 32 + n * 16 + 4 * fq);
#pragma unroll
            for (int ai = 0; ai < 2; ++ai)
#pragma unroll
                for (int m = 0; m < 4; ++m) {
                    const int rl = ai * 128 + wr * 64 + m * 16 + fr, r = u.pm * 256 + rl;
                    const bool samp = r >= SROW0, pad = r >= MR;
                    const int b = (r >= TT && !samp) ? 1 : 0, t = r - b * TT;
                    const int pidx = samp ? ROPE_SAMPLE_IDX : t;
                    f32x4 cs = {1.f, 1.f, 1.f, 1.f}, sn = {0.f, 0.f, 0.f, 0.f};
                    if (wc == 0 && !pad) { cs = *(const f32x4*)(ropec + (size_t)pidx * 16 + 4 * fq); sn = *(const f32x4*)(ropes + (size_t)pidx * 16 + 4 * fq); }
#pragma unroll
                    for (int bj = 0; bj < 2; ++bj) {
                        const f32x4 hv = *(const LAS f32x4*)(hss + (bj * 256 + rl) * 4);
                        const float hn = rsqrtf(((hv[0] + hv[1]) + (hv[2] + hv[3])) * (1.0f / 128.0f) + EPS);
                        f32x4 x1 = acc[ai][bj][m][0] * hn * gv[0], x2 = acc[ai][bj][m][1] * hn * gv[1];
                        if (wc == 0) { const f32x4 o1 = x1 * cs - x2 * sn, o2 = x2 * cs + x1 * sn; x1 = o1; x2 = o2; }
                        x1 = x1 * osc; x2 = x2 * osc;
                        const int cl = bj * 128 + wc * 32 + 4 * fq;
                        { const int od = fq & 1; const unsigned a0 = pk2(x1[0], x1[1]), a1 = pk2(x1[2], x1[3]), b0 = pk2(x2[0], x2[1]), b1 = pk2(x2[2], x2[3]);
                          const unsigned s0 = od ? a0 : b0, s1 = od ? a1 : b1; const unsigned r0 = (unsigned)__shfl_xor((int)s0, 16), r1 = (unsigned)__shfl_xor((int)s1, 16);
                          const v4u w16 = od ? (v4u){r0, r1, b0, b1} : (v4u){a0, a1, r0, r1};
                          const int cl16 = bj * 128 + wc * 32 + 4 * (fq & ~1) + (od ? 16 : 0);
                          if (pn < 4) ST16(rs_, WS_Q + ((size_t)r * 1024 + pn * 256 + cl16) * 2, w16); else ST16(rs_, WS_K + ((size_t)r * 256 + cl16) * 2, w16); }
                        if (pn == 4) {
                            if (samp && !pad) { const size_t o = WS_KSN + ((size_t)(r - SROW0) * 256 + cl) * 4; ST16(rs_, o, x1); ST16(rs_, o + 64, x2); }
                            else if (!samp && t >= TT - 128) { float* o = out_pk + ((size_t)(b * 128 + (t - (TT - 128))) * 256) + cl; *(f32x4*)o = x1; *(f32x4*)(o + 16) = x2; } }
                    }
                }
        } else if (pn == 5) {
#pragma unroll
            for (int ai = 0; ai < 2; ++ai)
#pragma unroll
                for (int m = 0; m < 4; ++m) {
                    const int rl = ai * 128 + wr * 64 + m * 16 + fr, r = u.pm * 256 + rl;
                    const bool samp = r >= SROW0, pad = r >= MR;
                    const int b = (r >= TT && !samp) ? 1 : 0, t = r - b * TT;
                    const int tpos = (t & ~15) + perm16(t & 15);
#pragma unroll
                    for (int bj = 0; bj < 2; ++bj)
#pragma unroll
                        for (int n = 0; n < 2; ++n) { const f32x4 x = acc[ai][bj][m][n]; const int d = wc * 32 + n * 16 + 4 * fq;
                            if (!samp) { const size_t vo = WS_VT + (((size_t)((b * 2 + bj) * 128 + d)) * TPV + tpos) * 2;
#pragma unroll
                                for (int j = 0; j < 4; ++j) ST2(rs_, vo + (size_t)j * TPV * 2, pk2(x[j], 0.f) & 0xffffu);
                                if (t >= TT - 128) *(f32x4*)(out_pv + ((size_t)(b * 128 + (t - (TT - 128))) * 256) + bj * 128 + d) = x; }
                            else if (!pad) ST16(rs_, WS_KSN + ((size_t)NSAMP * 256 + (size_t)(r - SROW0) * 256 + bj * 128 + d) * 4, x); }
                }
        } else {
            const size_t dsto = (pn < 8) ? WS_U + (size_t)(pn - 6) * 256 * 4 : WS_XP + (size_t)(pn - 8) * 256 * 4;
#pragma unroll
            for (int ai = 0; ai < 2; ++ai)
#pragma unroll
                for (int m = 0; m < 4; ++m) { const size_t ro = dsto + ((size_t)(u.pm * 256 + ai * 128 + wr * 64 + m * 16 + fr) * 512 + wc * 32 + 4 * fq) * 4;
#pragma unroll
                    for (int bj = 0; bj < 2; ++bj)
#pragma unroll
                        for (int n = 0; n < 2; ++n) ST16(rs_, ro + (size_t)(bj * 128 + n * 16) * 4, acc[ai][bj][m][n]); }
        }
    }
};

struct EpiRes {
    static constexpr bool PERM = true, AFTER_DRAIN = false;
    unsigned char* ws_; float* out; int last; int yinit;
    __device__ __forceinline__ void operator()(f32x4 (&acc)[2][2][4][2], const pg8::Unit& u, int wr, int wc, int fr, int fq, LAS unsigned char* esc, int tid) const {
        asm volatile("" : "+v"(fr), "+v"(fq), "+v"(tid));
        size_t z_ = 0; asm volatile("" : "+s"(z_)); unsigned char* ws = ws_ + z_;
        const bf16* XB = (const bf16*)(ws + WS_XB); const rsrc_t rs_ = ws_rsrc(ws);
        v4u xb[2][4][2];
#pragma unroll
        for (int ai = 0; ai < 2; ++ai)
#pragma unroll
            for (int m = 0; m < 4; ++m) { const bf16* xp = XB + (size_t)(u.pm * 256 + ai * 128 + wr * 64 + m * 16 + fr) * DM + u.pn * 256 + wc * 32 + 8 * fq;
#pragma unroll
                for (int bj = 0; bj < 2; ++bj) xb[ai][m][bj] = *(const v4u*)(xp + bj * 128); }
#pragma unroll
        for (int ai = 0; ai < 2; ++ai)
#pragma unroll
            for (int m = 0; m < 4; ++m) {
                const int r = u.pm * 256 + ai * 128 + wr * 64 + m * 16 + fr; const int c0 = u.pn * 256 + wc * 32 + 8 * fq;
                const size_t eo = (size_t)r * DM + c0; float s = 0.f;
                f32x4 v[2][2];
#pragma unroll
                for (int bj = 0; bj < 2; ++bj) { const v4u w = xb[ai][m][bj];
                    const f32x4 x0 = {__builtin_bit_cast(float, w.x << 16), __builtin_bit_cast(float, w.x & 0xffff0000u), __builtin_bit_cast(float, w.y << 16), __builtin_bit_cast(float, w.y & 0xffff0000u)};
                    const f32x4 x1 = {__builtin_bit_cast(float, w.z << 16), __builtin_bit_cast(float, w.z & 0xffff0000u), __builtin_bit_cast(float, w.w << 16), __builtin_bit_cast(float, w.w & 0xffff0000u)};
                    v[bj][0] = x0 + acc[ai][bj][m][0]; v[bj][1] = x1 + acc[ai][bj][m][1];
#pragma unroll
                    for (int n = 0; n < 2; ++n) { const f32x4 q = v[bj][n] * v[bj][n]; s += (q[0] + q[1]) + (q[2] + q[3]); } }
                if (!last) {
#pragma unroll
                    for (int bj = 0; bj < 2; ++bj)
                        ST16(rs_, WS_XB + (eo + bj * 128) * 2, ((v4u){pk2(v[bj][0][0], v[bj][0][1]), pk2(v[bj][0][2], v[bj][0][3]), pk2(v[bj][1][0], v[bj][1][1]), pk2(v[bj][1][2], v[bj][1][3])}));
                    s += __shfl_xor(s, 16); s += __shfl_xor(s, 32);
                    if (fq == 0) ST4(rs_, WS_SSQ + (((size_t)u.pn * MP + r) * 4 + wc) * 4, s);
                    if (yinit && r < MR) { const bool samp = r >= SROW0; const size_t yo = samp ? O_YS + (size_t)(r - SROW0) * DM + c0 : O_YP + ((size_t)NSEQ + (r - TT - NMETA)) * DM + c0;
                        const rsrc_t ro_ = __builtin_amdgcn_make_buffer_rsrc(out, 0, (int)(O_END * 4), 0x00020000);
#pragma unroll
                        for (int bj = 0; bj < 2; ++bj)
#pragma unroll
                            for (int n = 0; n < 2; ++n) ST16(ro_, (yo + bj * 128 + n * 4) * 4, v[bj][n]); }
                } else {
                    const bool samp = r >= SROW0, pad = r >= MR; const int b = (r >= TT && !samp) ? 1 : 0, t = r - b * TT;
                    float* op = nullptr;
                    if (samp) { if (!pad) op = out + O_YS + (size_t)(r - SROW0) * DM + c0; } else if (t >= NMETA) op = out + O_YP + ((size_t)b * NSEQ + (t - NMETA)) * DM + c0;
                    if (op) {
#pragma unroll
                        for (int bj = 0; bj < 2; ++bj)
#pragma unroll
                            for (int n = 0; n < 2; ++n) *(f32x4*)(op + bj * 128 + n * 4) = v[bj][n]; }
                }
            }
    }
};

struct EpiAtom {
    static constexpr bool PERM = true, AFTER_DRAIN = false;
    float* out;
    __device__ __forceinline__ void operator()(f32x4 (&acc)[2][2][4][2], const pg8::Unit& u, int wr, int wc, int fr, int fq, LAS unsigned char* esc, int tid) const {
        asm volatile("" : "+v"(fr), "+v"(fq), "+v"(tid));
        if (wr != 0) return;
#pragma unroll
        for (int m = 0; m < 4; ++m) { const int r = u.pm * 256 + m * 16 + fr; const int c0 = u.pn * 256 + wc * 32 + 8 * fq;
            const bool samp = r >= SROW0; float* op = samp ? out + O_YS + (size_t)(r - SROW0) * DM + c0 : out + O_YP + ((size_t)NSEQ + (r - TT - NMETA)) * DM + c0;
            if (r < MR) {
#pragma unroll
                for (int bj = 0; bj < 2; ++bj)
#pragma unroll
                    for (int n = 0; n < 2; ++n)
#pragma unroll
                        for (int j = 0; j < 4; ++j) __hip_atomic_fetch_add(op + bj * 128 + n * 4 + j, acc[0][bj][m][n][j], RLX_AGENT); } }
    }
};

struct EpiFfn1 {
    static constexpr bool PERM = true, AFTER_DRAIN = false;
    unsigned char* ws_;
    __device__ __forceinline__ void operator()(f32x4 (&acc)[2][2][4][2], const pg8::Unit& u, int wr, int wc, int fr, int fq, LAS unsigned char* esc, int tid) const {
        asm volatile("" : "+v"(fr), "+v"(fq), "+v"(tid));
        size_t z_ = 0; asm volatile("" : "+s"(z_)); unsigned char* ws = ws_ + z_;
        const rsrc_t rs_ = ws_rsrc(ws);
        build_rs((const float*)(ws + WS_SSQ), u.pm, esc, tid);
        const LAS float* rsT = (const LAS float*)esc;
#pragma unroll
        for (int ai = 0; ai < 2; ++ai)
#pragma unroll
            for (int m = 0; m < 4; ++m) { const int rl = ai * 128 + wr * 64 + m * 16 + fr; const float rsv = rsT[rl];
                const size_t ho = WS_H + ((size_t)(u.pm * 256 + rl) * DFF + u.pn * 256 + wc * 32 + 8 * fq) * 2;
#pragma unroll
                for (int bj = 0; bj < 2; ++bj) { f32x4 v0 = acc[ai][bj][m][0] * rsv, v1 = acc[ai][bj][m][1] * rsv;
#pragma unroll
                    for (int j = 0; j < 4; ++j) { const float a = fmaxf(v0[j], 0.f), b = fmaxf(v1[j], 0.f); v0[j] = a * a; v1[j] = b * b; }
                    ST16(rs_, ho + bj * 256, ((v4u){pk2(v0[0], v0[1]), pk2(v0[2], v0[3]), pk2(v1[0], v1[1]), pk2(v1[2], v1[3])})); } }
    }
};

#define XB_TMO      128
#define XB_XCNT(j)  (256  + 64 * (j))
#define XB_XSUB(j)  (1280 + 64 * (j))
#define XB_XGEN(j)  (2304 + 64 * (j))
#define XB_TOP      3328
#define XB_TOPGEN   3392
#define XCD_BAR_WORDS 3456
#define XB_SPIN_CAP (1u << 18)
__device__ __forceinline__ unsigned xb_ld(unsigned* p)              { return __hip_atomic_load(p, __ATOMIC_RELAXED, __HIP_MEMORY_SCOPE_AGENT); }
__device__ __forceinline__ unsigned xb_add(unsigned* p, unsigned v) { return __hip_atomic_fetch_add(p, v, __ATOMIC_RELAXED, __HIP_MEMORY_SCOPE_AGENT); }
__device__ __forceinline__ unsigned xb_xcc_id() { return (unsigned)__builtin_amdgcn_s_getreg((3 << 11) | 20) & 0xFu; }
#define XB_SPIN(cond, bar) do { unsigned _sp = 0; while (cond) { __builtin_amdgcn_s_sleep(1); \
    if ((++_sp & 255u) == 0u) { if (xb_ld(&(bar)[XB_TMO])) break; if (_sp > XB_SPIN_CAP) { atomicAdd(&(bar)[XB_TMO], 1u); break; } } } } while (0)

struct XcdBarrier {
    unsigned* bar; unsigned x;
    volatile LAS unsigned* st;
};

__device__ __forceinline__ XcdBarrier xcd_barrier_post(unsigned* bar, volatile LAS unsigned* st) {
    XcdBarrier b; b.bar = bar; b.x = xb_xcc_id(); b.st = st;
    if (threadIdx.x == 0) (void)xb_add(&bar[XB_XCNT(b.x)], 1u);
    return b;
}
__device__ __forceinline__ void xcd_barrier_complete(unsigned* bar, unsigned x, unsigned& nloc, unsigned& nx) {
    const unsigned G = gridDim.x * gridDim.y * gridDim.z;
    unsigned sum, cnt, mine, sp = 0u;
    for (;;) {
        sum = 0u; cnt = 0u; mine = 0u;
#pragma unroll
        for (unsigned j = 0; j < 16; ++j) { const unsigned c = xb_ld(&bar[XB_XCNT(j)]); sum += c; cnt += (c > 0u) ? 1u : 0u; mine = (j == x) ? c : mine; }
        if (sum == G) break;
        __builtin_amdgcn_s_sleep(1);
        if ((++sp & 255u) == 0u) { if (xb_ld(&bar[XB_TMO])) break; if (sp > XB_SPIN_CAP) { atomicAdd(&bar[XB_TMO], 1u); break; } }
    }
    nloc = mine > 0u ? mine : 1u; nx = cnt > 0u ? cnt : 1u;
}

__device__ __forceinline__ void xcd_barrier(const XcdBarrier& b) {
    asm volatile("s_waitcnt vmcnt(0)" ::: "memory");
    __syncthreads();
    if (threadIdx.x == 0) {
        unsigned* bar = b.bar;
        __builtin_amdgcn_s_waitcnt(0);
        unsigned nloc = b.st[0], nx = b.st[1];
        if (nloc == 0u) { xcd_barrier_complete(bar, b.x, nloc, nx); b.st[0] = nloc; b.st[1] = nx; }
        const unsigned old = xb_add(&bar[XB_XSUB(b.x)], 1u);
        const unsigned gen = old / nloc;
        if (old + 1u == (gen + 1u) * nloc) {
            __builtin_amdgcn_fence(__ATOMIC_RELEASE, "agent");
            asm volatile("s_waitcnt vmcnt(0)" ::: "memory");
            const unsigned og = xb_add(&bar[XB_TOP], 1u);
            const unsigned tg = og / nx;
            if (og + 1u == (tg + 1u) * nx) xb_add(&bar[XB_TOPGEN], 1u);
            else XB_SPIN(xb_ld(&bar[XB_TOPGEN]) == tg, bar);
            __builtin_amdgcn_fence(__ATOMIC_ACQUIRE, "agent");
            xb_add(&bar[XB_XGEN(b.x)], 1u);
            asm volatile("s_waitcnt vmcnt(0)" ::: "memory");
        } else {
            XB_SPIN(xb_ld(&bar[XB_XGEN(b.x)]) == gen, bar);
            __builtin_amdgcn_fence(__ATOMIC_ACQUIRE, "agent");
            asm volatile("s_waitcnt vmcnt(0)" ::: "memory");
        }
    }
    __syncthreads();
}

struct Frame {
    LAS unsigned char* lds;
    volatile LAS unsigned* MISC;
    gu32* ctl;
    int wave, vcu, G;
    __device__ __forceinline__ int lane() const { int l; asm volatile("v_mbcnt_lo_u32_b32 %0, -1, 0\n\tv_mbcnt_hi_u32_b32 %0, -1, %0" : "=v"(l)); return l; }
    __device__ __forceinline__ int tid() const { return wave * 64 + lane(); }
    float* out; unsigned char* ws;
};
#define IN_XPROMPT 0
#define IN_XSAMPLE 1
#define IN_CACHEK 2
#define IN_CACHEV 3
#define IN_SSMRE 4
#define IN_SSMIM 5
#define IN_SPOOL 6
#define IN_META 7
#define IN_GMIX 8
#define IN_WIN 9
#define IN_GQ 10
#define IN_GK 11
#define IN_SINKS 12
#define IN_ARE 13
#define IN_AIM 14
#define IN_LOGDT 15
#define IN_BRE 16
#define IN_BIM 17
#define IN_CRE 18
#define IN_CIM 19
#define IN_DSKIP 20
#define IN_WGLU 21
#define IN_BGLU 22
#define IN_WPOOL 23
#define IN_PSCALE 24
#define IN_GOA 25
#define IN_GOS 26
#define IN_GOP 27
#define IN_WOUT 28
#define IN_GFFN 29
#define IN_WFF1 30
#define IN_WFF2 31
struct Args { const float* in[32]; float* out; unsigned char* ws; int ph_lo, ph_hi; };
static_assert(sizeof(Args) == 32 * 8 + 8 + 8 + 8, "Args has no padding");

__device__ __forceinline__ void p0_transpose_item(const float* W, int K, int N, bf16* WT, const float* gain, LAS float* scr, int item, int lane) {
    const int nblk = N / 32, kb = item / nblk, nb = item % nblk, k0 = 64 * kb, n0 = 32 * nb;
    float wv[32];
#pragma unroll
    for (int i = 0; i < 32; ++i) wv[i] = W[(size_t)(k0 + 2 * i + (lane >> 5)) * N + n0 + (lane & 31)];
    if (gain) {
#pragma unroll
        for (int i = 0; i < 32; ++i) wv[i] *= gain[k0 + 2 * i + (lane >> 5)];
    }
#pragma unroll
    for (int i = 0; i < 32; ++i) scr[(2 * i + (lane >> 5)) * 33 + (lane & 31)] = wv[i];
    LDS_WAIT(); asm volatile("" ::: "memory");
    const int c = lane & 7;
#pragma unroll
    for (int j = 0; j < 4; ++j) { const int n = (lane >> 3) + 8 * j; const LAS float* s = scr + (8 * c) * 33 + n;
        v4u o; o.x = pk2(s[0 * 33], s[1 * 33]); o.y = pk2(s[2 * 33], s[3 * 33]); o.z = pk2(s[4 * 33], s[5 * 33]); o.w = pk2(s[6 * 33], s[7 * 33]);
        *(GAS v4u*)(WT + (size_t)(n0 + n) * K + k0 + 8 * c) = o; }
    LDS_WAIT(); asm volatile("" ::: "memory");
}
__device__ __forceinline__ void sincos_d(double x, double& s, double& c) {
    const double TWO_PI = 6.283185307179586476925286766559;
    const double k = rint(x * (1.0 / TWO_PI)); const double r = fma(-k, TWO_PI, x), r2 = r * r;
    const double fs[14] = {0.16666666666666666, 0.05, 0.023809523809523808, 0.013888888888888888, 0.00909090909090909, 0.00641025641025641, 0.004761904761904762, 0.003676470588235294,
                           0.0029239766081871343, 0.002380952380952381, 0.001976284584980237, 0.0016666666666666668, 0.0014245014245014246, 0.0012315270935960591};
    const double fc[14] = {0.5, 0.08333333333333333, 0.03333333333333333, 0.017857142857142856, 0.011111111111111112, 0.007575757575757576, 0.005494505494505495, 0.004166666666666667,
                           0.0032679738562091504, 0.002631578947368421, 0.0021645021645021645, 0.0018115942028985507, 0.0015384615384615385, 0.0013227513227513227};
    double ts = r, tc = 1.0; s = r; c = 1.0;
#pragma unroll
    for (int i = 0; i < 14; ++i) { ts *= -r2 * fs[i]; s += ts; tc *= -r2 * fc[i]; c += tc; }
}
__device__ __forceinline__ double exp_small(double x) {
    double t = 1.0, e = 1.0;
#pragma unroll
    for (int i = 1; i <= 14; ++i) { t *= x * (1.0 / i); e += t; }
    return e;
}
__device__ __forceinline__ void p0_prologue(const Args& AR, Frame& F) {
    LAS float* scr = (LAS float*)(F.lds + F.wave * 16384);
    const int gw = F.vcu * 8 + F.wave, NGW = F.G * 8, lane = F.lane();
    unsigned char* ws = F.ws;
    constexpr int I_IN = (DM / 64) * (INW / 32), I_OUT = (DM / 64) * (DM / 32), I_1 = (DM / 64) * (DFF / 32), I_2 = (DFF / 64) * (DM / 32), I_GLU = (512 / 64) * (512 / 32), I_POOL = 4 * 2 * 4;
    constexpr int I_LAYER = I_IN + I_OUT + I_1 + I_2 + I_GLU + I_POOL;
    for (int it = gw; it < NLAYER * I_LAYER; it += NGW) {
        const int l = it / I_LAYER; int r = it % I_LAYER;
        if (r < I_IN) { p0_transpose_item(AR.in[IN_WIN] + (size_t)l * DM * INW, DM, INW, (bf16*)(ws + WS_WIN) + (size_t)l * INW * DM, AR.in[IN_GMIX] + l * DM, scr, r, lane); continue; } r -= I_IN;
        if (r < I_OUT) { const int k0 = 64 * (r / (DM / 32));
            const float* g = (k0 < 1024) ? AR.in[IN_GOA] + l * 1024 : (k0 < 1536) ? AR.in[IN_GOS] + l * 512 - 1024 : AR.in[IN_GOP] + l * 512 - 1536;
            p0_transpose_item(AR.in[IN_WOUT] + (size_t)l * DM * DM, DM, DM, (bf16*)(ws + WS_WOUT) + (size_t)l * DM * DM, g, scr, r, lane); continue; } r -= I_OUT;
        if (r < I_1) { p0_transpose_item(AR.in[IN_WFF1] + (size_t)l * DM * DFF, DM, DFF, (bf16*)(ws + WS_W1) + (size_t)l * DFF * DM, AR.in[IN_GFFN] + l * DM, scr, r, lane); continue; } r -= I_1;
        if (r < I_2) { p0_transpose_item(AR.in[IN_WFF2] + (size_t)l * DFF * DM, DFF, DM, (bf16*)(ws + WS_W2) + (size_t)l * DM * DFF, nullptr, scr, r, lane); continue; } r -= I_2;
        if (r < I_GLU) { p0_transpose_item(AR.in[IN_WGLU] + (size_t)l * 512 * 512, 512, 512, (bf16*)(ws + WS_WGLU) + (size_t)l * 512 * 512, nullptr, scr, r, lane); continue; } r -= I_GLU;
        { const int g = r / 8; p0_transpose_item(AR.in[IN_WPOOL] + ((size_t)l * 4 + g) * 128 * 128, 128, 128, (bf16*)(ws + WS_WPOOL) + ((size_t)l * 4 + g) * 128 * 128, nullptr, scr, r % 8, lane); }
    }
    bf16* XB = (bf16*)(ws + WS_XB); float* SSQ = (float*)(ws + WS_SSQ);
    for (int m = gw; m < MP; m += NGW) {
        const float* src = nullptr;
        if (m < SROW0) { const int b = m >= TT ? 1 : 0, t = m - b * TT; src = (t < NMETA) ? AR.in[IN_META] + (size_t)t * DM : AR.in[IN_XPROMPT] + ((size_t)b * NSEQ + (t - NMETA)) * DM; }
        else if (m < MR) src = AR.in[IN_XSAMPLE] + (size_t)(m - SROW0) * DM;
        float s = 0.f;
#pragma unroll
        for (int j = 0; j < 8; ++j) { f32x4 v = {0.f, 0.f, 0.f, 0.f}; if (src) v = *(const f32x4*)(src + j * 256 + lane * 4);
            s += (v[0] * v[0] + v[1] * v[1]) + (v[2] * v[2] + v[3] * v[3]);
            *(v2u*)(XB + (size_t)m * DM + j * 256 + lane * 4) = (v2u){pk2(v[0], v[1]), pk2(v[2], v[3])}; }
        s = wave_sum(s);
        if (lane < 32) SSQ[((size_t)(lane >> 2) * MP + m) * 4 + (lane & 3)] = (lane == 0) ? s : 0.f;
    }
    const int gt = gw * 64 + lane, NGT = NGW * 64;
    for (int id = gt; id < NLAYER * 32 * 64; id += NGT) {
        const int l = id >> 11, g = (id >> 6) & 31, n = id & 63;
        unsigned char* tb = ws + WS_TAB + (size_t)l * TB_LAYER;
        const double dt = (double)expf(AR.in[IN_LOGDT][l * 32 + g]);
        const double ar = (double)AR.in[IN_ARE][id], ai = (double)AR.in[IN_AIM][id];
        const double mag = exp_small(dt * ar); double sn, cs; sincos_d(dt * ai, sn, cs);
        const double abr = mag * cs, abi = mag * sn, den = ar * ar + ai * ai;
        const double fr = ((abr - 1.0) * ar + abi * ai) / den, fi = (abi * ar - (abr - 1.0) * ai) / den;
        ((float*)(tb + TB_ABR))[g * 64 + n] = (float)abr; ((float*)(tb + TB_ABI))[g * 64 + n] = (float)abi;
        const float* Br = AR.in[IN_BRE] + (size_t)id * 16; const float* Bi = AR.in[IN_BIM] + (size_t)id * 16;
        float* bbr = (float*)(tb + TB_BBR) + (size_t)(g * 64 + n) * 16; float* bbi = (float*)(tb + TB_BBI) + (size_t)(g * 64 + n) * 16;
        bf16* bbt = (bf16*)(tb + TB_PM) + (size_t)g * 128 * 16;
#pragma unroll
        for (int c = 0; c < 16; ++c) { const double br = Br[c], bi = Bi[c]; const float vr = (float)(fr * br - fi * bi), vi = (float)(fr * bi + fi * br); bbr[c] = vr; bbi[c] = vi;
            bbt[n * 16 + c] = (bf16)(pk2(vr, 0.f) & 0xffffu); bbt[(64 + n) * 16 + c] = (bf16)(pk2(vi, 0.f) & 0xffffu); }
        double pr = abr, pi = abi;
        for (int t = 0; t < 64; ++t) {
            if (t == 15) { ((float*)(tb + TB_A16R))[g * 64 + n] = (float)pr; ((float*)(tb + TB_A16I))[g * 64 + n] = (float)pi; }
            if (t == 31) { ((float*)(tb + TB_A32R))[g * 64 + n] = (float)pr; ((float*)(tb + TB_A32I))[g * 64 + n] = (float)pi; }
            if (t == 63) { ((float*)(tb + TB_ALR))[g * 64 + n] = (float)pr; ((float*)(tb + TB_ALI))[g * 64 + n] = (float)pi; }
            const double nr = pr * abr - pi * abi, ni = pr * abi + pi * abr; pr = nr; pi = ni;
        }
        bf16* CmT = (bf16*)(tb + TB_CMT) + (size_t)g * 16 * 128;
        const float* Cr = AR.in[IN_CRE] + ((size_t)(l * 32 + g) * 16) * 64 + n; const float* Ci = AR.in[IN_CIM] + ((size_t)(l * 32 + g) * 16) * 64 + n;
#pragma unroll
        for (int c = 0; c < 16; ++c) { CmT[c * 128 + n] = (bf16)(pk2(Cr[c * 64], 0.f) & 0xffffu); CmT[c * 128 + 64 + n] = (bf16)(pk2(-Ci[c * 64], 0.f) & 0xffffu); }
    }
    float* rc = (float*)(ws + WS_ROPE); float* rs_ = rc + ROPE_N;
    for (int id = gt; id < (int)ROPE_N; id += NGT) {
        const int p = id >> 4, i = id & 15; const double pos = (p == ROPE_SAMPLE_IDX) ? 16384.0 : (double)p;
        double inv = 1.0;
        for (int k = 0; k < i; ++k) inv *= 0.44036660267178046;
        double sn, cs; sincos_d(pos * inv, sn, cs);
        rc[id] = (float)cs; rs_[id] = (float)sn;
    }
}

__device__ __forceinline__ void attn_unit(const Args& AR, Frame& F, int l, int b, int i) {
    int lane_ = F.lane(); asm volatile("" : "+v"(lane_));
    size_t z_ = 0; asm volatile("" : "+s"(z_)); unsigned char* ws = F.ws + z_;
    const int lane = lane_, h = F.wave, c = lane & 31, hh = lane >> 5, kvh = h >> 2;
    const int t0 = 32 * i; const size_t rb = (size_t)b * TT;
#if PROBE && (PROBE_KIND == 11 || PROBE_KIND == 12)
    const unsigned long long ta0 = __builtin_amdgcn_s_memrealtime();
#endif
    const bf16* Q = (const bf16*)(ws + WS_Q); const bf16* K = (const bf16*)(ws + WS_K); const bf16* VT = (const bf16*)(ws + WS_VT);
    LAS float* ex = (LAS float*)(F.lds + ESC_OFF);
    bf16x8 qf[8];
    { const bf16* qp = Q + (rb + t0 + c) * 1024 + 128 * h + 8 * hh;
#pragma unroll
      for (int ks = 0; ks < 8; ++ks) qf[ks] = *(const bf16x8*)(qp + 16 * ks); }
    const int kt0 = (t0 >= 128) ? 0 : (4 - i);
    f32x16 S[5];
    bf16x8 kf[5][8];
#define ATT_LOADK(KT) do { if ((KT) >= kt0) { const bf16* kp_ = K + (rb + (t0 - 128 + 32 * (KT)) + c) * 256 + 128 * kvh + 8 * hh; \
        _Pragma("unroll") for (int ks_ = 0; ks_ < 8; ++ks_) kf[KT][ks_] = *(const bf16x8*)(kp_ + 16 * ks_); } } while (0)
    ATT_LOADK(0); ATT_LOADK(1); ATT_LOADK(2);
#pragma unroll
    for (int kt = 0; kt < 5; ++kt) {
#pragma unroll
        for (int r = 0; r < 16; ++r) S[kt][r] = -INFINITY;
        if (kt == 1) { ATT_LOADK(3); ATT_LOADK(4); }
        if (kt >= kt0) {
            f32x16 a = {0.f, 0.f, 0.f, 0.f, 0.f, 0.f, 0.f, 0.f, 0.f, 0.f, 0.f, 0.f, 0.f, 0.f, 0.f, 0.f};
#pragma unroll
            for (int ks = 0; ks < 8; ++ks) a = __builtin_amdgcn_mfma_f32_32x32x16_bf16(kf[kt][ks], qf[ks], a, 0, 0, 0);
#pragma unroll
            for (int r = 0; r < 16; ++r) { const int kr = (r & 3) + 8 * (r >> 2) + 4 * hh; bool ok = true;
                if (kt == 0) ok = kr >= c;
                if (kt == 4) ok = kr <= c;
                S[kt][r] = ok ? a[r] : -INFINITY; }
        }
    }
#if PROBE && PROBE_KIND == 11
    if (F.tid() == 0) F.MISC[6] += (unsigned)(__builtin_amdgcn_s_memrealtime() - ta0);
#endif
#undef ATT_LOADK
    const float sink2 = AR.in[IN_SINKS][l * 8 + h] * LOG2E;
    float mx = sink2;
#pragma unroll
    for (int kt = 0; kt < 5; ++kt)
#pragma unroll
        for (int r = 0; r < 16; ++r) mx = fmaxf(mx, S[kt][r]);
    mx = fmaxf(mx, __shfl_xor(mx, 32));
    float sum = 0.f;
#pragma unroll
    for (int kt = 0; kt < 5; ++kt)
#pragma unroll
        for (int r = 0; r < 16; ++r) { const float p = __builtin_amdgcn_exp2f(S[kt][r] - mx); S[kt][r] = p; sum += p; }
    sum += __shfl_xor(sum, 32);
    const float inv = 1.0f / (sum + __builtin_amdgcn_exp2f(sink2 - mx));
    f32x16 O[4];
#pragma unroll
    for (int db = 0; db < 4; ++db)
#pragma unroll
        for (int r = 0; r < 16; ++r) O[db][r] = 0.f;
    const bf16* vbase = VT + ((size_t)((b * 2 + kvh) * 128 + c)) * TPV + (t0 - 128) + 8 * hh;
    bf16x8 vf[2][2][4];
#define ATT_LOADV(KT) do { _Pragma("unroll") for (int s_ = 0; s_ < 2; ++s_) _Pragma("unroll") for (int db_ = 0; db_ < 4; ++db_) \
        vf[(KT) & 1][s_][db_] = *(const bf16x8*)(vbase + (size_t)(32 * db_) * TPV + 32 * (KT) + 16 * s_); } while (0)
#pragma unroll
    for (int kt = 0; kt < 5; ++kt) if (kt == kt0) ATT_LOADV(kt);
#pragma unroll
    for (int kt = 0; kt < 5; ++kt) {
        if (kt >= kt0) {
            if (kt < 4) ATT_LOADV(kt + 1);
#pragma unroll
            for (int s = 0; s < 2; ++s) {
                v4u pw; pw.x = pk2(S[kt][8 * s + 0], S[kt][8 * s + 1]); pw.y = pk2(S[kt][8 * s + 2], S[kt][8 * s + 3]); pw.z = pk2(S[kt][8 * s + 4], S[kt][8 * s + 5]); pw.w = pk2(S[kt][8 * s + 6], S[kt][8 * s + 7]);
                const bf16x8 pf = __builtin_bit_cast(bf16x8, pw);
#pragma unroll
                for (int db = 0; db < 4; ++db) O[db] = __builtin_amdgcn_mfma_f32_32x32x16_bf16(vf[kt & 1][s][db], pf, O[db], 0, 0, 0);
            }
        }
    }
#undef ATT_LOADV
    float ss = 0.f;
#pragma unroll
    for (int db = 0; db < 4; ++db)
#pragma unroll
        for (int r = 0; r < 16; ++r) { O[db][r] *= inv; ss += O[db][r] * O[db][r]; }
#if PROBE && PROBE_KIND == 12
    if (F.tid() == 0) F.MISC[6] += (unsigned)(__builtin_amdgcn_s_memrealtime() - ta0);
#endif
    ss += __shfl_xor(ss, 32);
    if (hh == 0) ex[h * 32 + c] = ss;
    WG_BAR();
    float tot = 0.f;
#pragma unroll
    for (int j = 0; j < 8; ++j) tot += ex[j * 32 + c];
    const float rsa = rsqrtf(tot * (1.0f / 1024.0f) + EPS);
    if (t0 + c < TT) {
        const rsrc_t rs_ = ws_rsrc(ws); const size_t mo16 = WS_MIX + ((rb + t0 + c) * DM + 128 * h) * 2 + 16 * hh;
#pragma unroll
        for (int db = 0; db < 4; ++db)
#pragma unroll
            for (int g4 = 0; g4 < 4; g4 += 2) {
                unsigned ax = pk2(O[db][4 * g4 + 0] * rsa, O[db][4 * g4 + 1] * rsa), ay = pk2(O[db][4 * g4 + 2] * rsa, O[db][4 * g4 + 3] * rsa);
                unsigned bx = pk2(O[db][4 * g4 + 4] * rsa, O[db][4 * g4 + 5] * rsa), by = pk2(O[db][4 * g4 + 6] * rsa, O[db][4 * g4 + 7] * rsa);
                { auto r = __builtin_amdgcn_permlane32_swap(ax, bx, false, false); ax = r[0]; bx = r[1]; }
                { auto r = __builtin_amdgcn_permlane32_swap(ay, by, false, false); ay = r[0]; by = r[1]; }
                ST16(rs_, mo16 + (32 * db + 8 * g4) * 2, ((v4u){ax, ay, bx, by}));
            }
    }
    WG_BAR();
}

__device__ __forceinline__ void sattn_unit(const Args& AR, Frame& F, int l, int s) {
    int tid_ = F.tid(); asm volatile("" : "+v"(tid_));
    const int tid = tid_, lane = tid & 63, wave = F.wave;
    LAS float* qs = (LAS float*)F.lds;
    LAS float* sc = qs + 1024;
    LAS float* part = sc + 8 * 132;
    LAS float* red = part + 4096;
    const size_t row = SROW0 + s;
    const bf16* Q = (const bf16*)(F.ws + WS_Q) + row * 1024;
    const float* ksn = (const float*)(F.ws + WS_KSN) + (size_t)s * 256; const float* vsn = ksn + NSAMP * 256;
    const float* ck = AR.in[IN_CACHEK] + ((size_t)(l * NSAMP + s)) * 128 * 256; const float* cv = AR.in[IN_CACHEV] + ((size_t)(l * NSAMP + s)) * 128 * 256;
    for (int j = tid; j < 1024; j += 512) qs[j] = bf2f(Q[j]);
    WG_BAR();
    { const int key = tid >> 2, pt = tid & 3;
#pragma unroll
      for (int kvh = 0; kvh < 2; ++kvh) {
          const float* kp = ck + (size_t)key * 256 + kvh * 128 + 32 * pt; float d[4] = {0.f, 0.f, 0.f, 0.f};
#pragma unroll
          for (int j = 0; j < 8; ++j) { const f32x4 kv = *(const f32x4*)(kp + 4 * j);
#pragma unroll
              for (int g = 0; g < 4; ++g) { const f32x4 qv = *(const LAS f32x4*)(qs + (4 * kvh + g) * 128 + 32 * pt + 4 * j); d[g] += (kv[0] * qv[0] + kv[1] * qv[1]) + (kv[2] * qv[2] + kv[3] * qv[3]); } }
#pragma unroll
          for (int g = 0; g < 4; ++g) { d[g] += __shfl_xor(d[g], 1); d[g] += __shfl_xor(d[g], 2); if (pt == 0) sc[(4 * kvh + g) * 132 + key] = d[g]; }
      } }
    {
      const int h = wave, kvh = h >> 2; float d = ksn[kvh * 128 + lane] * qs[h * 128 + lane] + ksn[kvh * 128 + 64 + lane] * qs[h * 128 + 64 + lane];
      d = wave_sum(d); if (lane == 0) sc[h * 132 + 128] = d; }
    WG_BAR();
    { const int h = wave; const float sink2 = AR.in[IN_SINKS][l * 8 + h] * LOG2E;
      const float v0 = sc[h * 132 + lane], v1 = sc[h * 132 + 64 + lane], v2 = (lane == 0) ? sc[h * 132 + 128] : -INFINITY;
      const float mx = fmaxf(wave_max(fmaxf(fmaxf(v0, v1), v2)), sink2);
      const float p0 = __builtin_amdgcn_exp2f(v0 - mx), p1 = __builtin_amdgcn_exp2f(v1 - mx), p2 = __builtin_amdgcn_exp2f(v2 - mx);
      const float inv = 1.0f / (wave_sum(p0 + p1 + p2) + __builtin_amdgcn_exp2f(sink2 - mx));
      sc[h * 132 + lane] = p0 * inv; sc[h * 132 + 64 + lane] = p1 * inv; if (lane == 0) sc[h * 132 + 128] = p2 * inv; }
    WG_BAR();
    { const int d = tid & 127, kq = tid >> 7;
#pragma unroll
      for (int kvh = 0; kvh < 2; ++kvh) { float a[4] = {0.f, 0.f, 0.f, 0.f};
#pragma unroll 8
          for (int k = 0; k < 32; ++k) { const int key = 32 * kq + k; const float v = cv[(size_t)key * 256 + kvh * 128 + d];
#pragma unroll
              for (int g = 0; g < 4; ++g) a[g] += sc[(4 * kvh + g) * 132 + key] * v; }
#pragma unroll
          for (int g = 0; g < 4; ++g) part[kq * 1024 + (4 * kvh + g) * 128 + d] = a[g]; } }
    WG_BAR();
    float o[2]; float ss = 0.f;
#pragma unroll
    for (int e = 0; e < 2; ++e) { const int j = tid + 512 * e, h = j >> 7, d = j & 127, kvh = h >> 2;
        o[e] = (part[j] + part[1024 + j]) + (part[2048 + j] + part[3072 + j]) + sc[h * 132 + 128] * vsn[kvh * 128 + d]; ss += o[e] * o[e]; }
    ss = wave_sum(ss); if (lane == 0) red[wave] = ss;
    WG_BAR();
    { float tot = 0.f;
#pragma unroll
      for (int j = 0; j < 8; ++j) tot += red[j];
      const float rsa = rsqrtf(tot * (1.0f / 1024.0f) + EPS);
      const rsrc_t rs_ = ws_rsrc(F.ws);
#pragma unroll
      for (int e = 0; e < 2; ++e) ST2(rs_, WS_MIX + (row * DM + tid + 512 * e) * 2, pk2(o[e] * rsa, 0.f) & 0xffffu); }
    { float* ok = F.out + O_SK + ((size_t)(l * NSAMP + s)) * 128 * 256; float* ov = F.out + O_SV + ((size_t)(l * NSAMP + s)) * 128 * 256;
      for (int j = tid; j < 127 * 64; j += 512) { *(f32x4*)(ok + 4 * j) = *(const f32x4*)(ck + 256 + 4 * j); *(f32x4*)(ov + 4 * j) = *(const f32x4*)(cv + 256 + 4 * j); }
      if (tid < 64) *(f32x4*)(ok + 127 * 256 + 4 * tid) = *(const f32x4*)(ksn + 4 * tid);
      else if (tid < 128) *(f32x4*)(ov + 127 * 256 + 4 * (tid - 64)) = *(const f32x4*)(vsn + 4 * (tid - 64)); }
    WG_BAR();
}

__device__ __forceinline__ float gelu_tanh(float y) {
    const float inner = 0.7978845608028654f * (y + 0.044715f * y * y * y);
    return y / (1.0f + __builtin_amdgcn_exp2f(-2.0f * LOG2E * inner));
}
__device__ __forceinline__ float sigmoidf_(float x) { return 1.0f / (1.0f + __builtin_amdgcn_exp2f(-LOG2E * x)); }
#define SWZ(r, ch, PITCH) ((r) * (PITCH) + ((((ch)) ^ ((r) & 15)) << 4))

#ifndef SSM_P1
#define SSM_P1 1
#endif
#ifndef SSM_M2
#define SSM_M2 1
#endif
__device__ __forceinline__ int rowtok(int r) { return 16 * ((r >> 2) & 1) + 4 * (r >> 3) + (r & 3); }
struct SsmG { f32x16 X[4]; };
struct SsmIn { f32x4 u0, u1; };
__device__ __forceinline__ SsmIn ssm_load_in(const float* U, int rowb, int g, int lane) { const float* up = U + (size_t)(rowb + rowtok(lane & 31)) * 512 + 16 * g + 8 * (lane >> 5); SsmIn r; r.u0 = *(const f32x4*)up; r.u1 = *(const f32x4*)(up + 4); return r; }
__device__ __forceinline__ void ssm_block(const Args& AR, SsmG& G, const SsmIn& in, int g, const bf16x8 (&bbf)[4], const float (&ab)[4], float (&hr)[2], float (&hi)[2], int mode, int l, int s0, int lane) {
    const int c = lane & 31, hh = lane >> 5;
    bf16x8 af;
    { const f32x4 u0 = in.u0, u1 = in.u1;
      v4u pw; pw.x = pk2(u0[0], u0[1]); pw.y = pk2(u0[2], u0[3]); pw.z = pk2(u1[0], u1[1]); pw.w = pk2(u1[2], u1[3]); af = __builtin_bit_cast(bf16x8, pw); }
    const f32x16 z16 = {0.f, 0.f, 0.f, 0.f, 0.f, 0.f, 0.f, 0.f, 0.f, 0.f, 0.f, 0.f, 0.f, 0.f, 0.f, 0.f};
#pragma unroll
    for (int nb = 0; nb < 4; ++nb) G.X[nb] = __builtin_amdgcn_mfma_f32_32x32x16_bf16(af, bbf[nb], z16, 0, 0, 0);
#pragma unroll
    for (int s = 0; s < 2; ++s) {
        const float ar = ab[2 * s], ai = ab[2 * s + 1];
        if (SSM_M2 && mode == 2) {
            { int cx = c; asm volatile("" : "+v"(cx)); const size_t o0 = ((size_t)(l * NSAMP + (s0 + 16 * hh)) * 32 + g) * 64 + cx + 32 * s; const float* qr = AR.in[IN_SSMRE] + o0; const float* qi = AR.in[IN_SSMIM] + o0;
              size_t jo = 0;
#pragma unroll
              for (int j = 0; j < 16; ++j) { const float pr = qr[jo], pi = qi[jo]; jo += 2048; asm volatile("" : "+v"(jo));
                const float nr = ar * pr - ai * pi + G.X[s][j], ni = ar * pi + ai * pr + G.X[2 + s][j]; G.X[s][j] = nr; G.X[2 + s][j] = ni; } }
            continue;
        }
        float r = (hh == 0) ? hr[s] : 0.f, i = (hh == 0) ? hi[s] : 0.f;
#pragma unroll
        for (int j = 0; j < 16; ++j) { const float nr = ar * r - ai * i + G.X[s][j], ni = ar * i + ai * r + G.X[2 + s][j]; r = nr; i = ni; G.X[s][j] = r; G.X[2 + s][j] = i; }
        float vr = __shfl_xor(r, 32), vi = __shfl_xor(i, 32);
        if (hh == 0 || mode == 1) { vr = 0.f; vi = 0.f; }
        float pr = ar, pi = ai; asm volatile("" : "+v"(pr), "+v"(pi));
#pragma unroll
        for (int j = 0; j < 16; ++j) { G.X[s][j] += pr * vr - pi * vi; G.X[2 + s][j] += pr * vi + pi * vr; const float nr = pr * ar - pi * ai, ni = pr * ai + pi * ar; pr = nr; pi = ni; }
        const float er = G.X[s][15], ei = G.X[2 + s][15];
        const float xr = __shfl_xor(er, 32), xi = __shfl_xor(ei, 32);
        hr[s] = (hh == 1) ? er : xr; hi[s] = (hh == 1) ? ei : xi;
    }
}
struct SsmTab { float ab[4]; bf16x8 bbf[4]; };
struct SsmTabC { bf16x8 cmf[4]; f32x4 dsk; };
__device__ __forceinline__ SsmTab ssm_load_tab(const unsigned char* tb, int w, int gi, int lg) {
    SsmTab T; const int g = 4 * w + gi, c32 = lg & 31, hh = lg >> 5;
    T.ab[0] = ((const float*)(tb + TB_ABR))[g * 64 + c32]; T.ab[1] = ((const float*)(tb + TB_ABI))[g * 64 + c32]; T.ab[2] = ((const float*)(tb + TB_ABR))[g * 64 + 32 + c32]; T.ab[3] = ((const float*)(tb + TB_ABI))[g * 64 + 32 + c32];
    const bf16* bt = (const bf16*)(tb + TB_PM) + (size_t)g * 128 * 16 + c32 * 16 + 8 * hh;
#pragma unroll
    for (int nb = 0; nb < 4; ++nb) T.bbf[nb] = *(const bf16x8*)(bt + nb * 32 * 16);
    return T;
}
__device__ __forceinline__ SsmTabC ssm_load_tabc(const unsigned char* tb, const float* dskip, int w, int gi, int lg) {
    SsmTabC T; const int g = 4 * w + gi, t16 = lg & 15, cq = lg >> 4;
    const bf16* cm = (const bf16*)(tb + TB_CMT) + (size_t)g * 16 * 128 + t16 * 128 + 8 * cq;
#pragma unroll
    for (int nb = 0; nb < 4; ++nb) T.cmf[nb] = *(const bf16x8*)(cm + 32 * nb);
    T.dsk = *(const f32x4*)(dskip + 64 * w + 16 * gi + 4 * cq); return T;
}
__device__ __forceinline__ void ssm_unit(const Args& AR, Frame& F, int l, int c_in) {
    const int c = c_in;
#if PROBE && PROBE_KIND == 13
    const unsigned long long tq0 = __builtin_amdgcn_s_memrealtime();
#define SSM_CP(n) do { if ((n) == PROBE_TYPE && F.tid() == 0) F.MISC[6] += (unsigned)(__builtin_amdgcn_s_memrealtime() - tq0); } while (0)
#else
#define SSM_CP(n) do { } while (0)
#endif
    int lane_ = F.lane(); asm volatile("" : "+v"(lane_));
    const int lane = lane_, w = F.wave, t16 = lane & 15, cq = lane >> 4, c32 = lane & 31, hh = lane >> 5;
    const int row0 = 64 * c;
    size_t z_ = 0; asm volatile("" : "+s"(z_)); unsigned char* ws = F.ws + z_;
    const unsigned char* tb = ws + WS_TAB + (size_t)l * TB_LAYER;
    const float* U = (const float*)(ws + WS_U);
    float* SST = (float*)(ws + WS_SST) + ((size_t)l * NCHUNK) * 32 * 128;
    gu32* flags = F.ctl + CW_SSMF + (size_t)(l * NCHUNK) * 8 * 16;
    LAS unsigned char* Zs = F.lds;
    LAS unsigned char* Hm = F.lds + 65536 + w * 8704;
    LAS float* red = (LAS float*)(F.lds + 137216);
    SsmG SG;
    float hcar[4] = {0.f, 0.f, 0.f, 0.f};
    if (SSM_P1 && c != NCHUNK - 1) {
#pragma unroll 1
        for (int gi = 0; gi < 4; ++gi) {
            const int g = 4 * w + gi;
            int lg_ = lane; asm volatile("" : "+v"(lg_));
            const int c32 = lg_ & 31, hh = lg_ >> 5;
            float ab[4]; ab[0] = ((const float*)(tb + TB_ABR))[g * 64 + c32]; ab[1] = ((const float*)(tb + TB_ABI))[g * 64 + c32]; ab[2] = ((const float*)(tb + TB_ABR))[g * 64 + 32 + c32]; ab[3] = ((const float*)(tb + TB_ABI))[g * 64 + 32 + c32];
            bf16x8 bbf[4];
            { const bf16* bt = (const bf16*)(tb + TB_PM) + (size_t)g * 128 * 16 + c32 * 16 + 8 * hh;
#pragma unroll
              for (int nb = 0; nb < 4; ++nb) bbf[nb] = *(const bf16x8*)(bt + nb * 32 * 16); }
            float hr[2] = {0.f, 0.f}, hi[2] = {0.f, 0.f};
            const SsmIn in0 = ssm_load_in(U, row0, g, lg_), in1 = ssm_load_in(U, row0 + 32, g, lg_);
            ssm_block(AR, SG, in0, g, bbf, ab, hr, hi, (c == 64) ? 1 : 0, l, 0, lg_);
            ssm_block(AR, SG, in1, g, bbf, ab, hr, hi, 0, l, 0, lg_);
            if (hh == 0) {
#pragma unroll
                for (int s = 0; s < 2; ++s) __hip_atomic_store((gu64*)(SST + ((size_t)c * 32 + g) * 128 + 2 * (c32 + 32 * s)), ((unsigned long long)__builtin_bit_cast(unsigned, hi[s]) << 32) | __builtin_bit_cast(unsigned, hr[s]), RLX_AGENT);
            }
        }
        VM_WAIT();
        if (lane == 0) __hip_atomic_store(flags + ((size_t)c * 8 + w) * 16, 1u, RLX_AGENT);
    }
    SSM_CP(1);
    const int cs0 = (c <= 64) ? 0 : 64, npred = c - cs0;
    if (npred > 0) {
        unsigned sp = 0; bool ok = false;
        for (;;) { ok = (lane >= npred) || (__hip_atomic_load(flags + ((size_t)(cs0 + lane) * 8 + w) * 16, RLX_AGENT) != 0u);
            if (__all(ok)) break;
            __builtin_amdgcn_s_sleep(2);
            if (++sp > (1u << 20)) { if (lane == 0) __hip_atomic_store(F.ctl + CW_TMO, 0x55u, RLX_AGENT); break; } }
        __builtin_amdgcn_fence(__ATOMIC_ACQUIRE, "agent");
        VM_WAIT();
    }
    SSM_CP(2);
    SSM_CP(2);
    SsmTab T = ssm_load_tab(tb, w, 0, lane);
    SsmTabC TC = ssm_load_tabc(tb, AR.in[IN_DSKIP] + l * 512, w, 0, lane);
    SsmIn inx = ssm_load_in(U, row0, 4 * w, lane);
#pragma unroll 1
    for (int step = 0; step < 8; ++step) {
        const int gi = step >> 1, half = step & 1, g = 4 * w + gi;
        int lg_ = lane; asm volatile("" : "+v"(lg_));
        const int t16 = lg_ & 15, cq = lg_ >> 4, c32 = lg_ & 31, hh = lg_ >> 5;
        int cc_ = c_in; asm volatile("" : "+s"(cc_)); const int c = cc_;
        const bool samp = (c == NCHUNK - 1) && (half == 1);
        const int col = 64 * w + 16 * gi + 4 * cq;
        const int ns = (step < 7) ? step + 1 : 7, ngi = ns >> 1, nhalf = ns & 1;
        const SsmIn in_n = ssm_load_in(U, row0 + 32 * nhalf, 4 * w + ngi, lg_);
        f32x4 uvp[2];
#pragma unroll
        for (int mt = 0; mt < 2; ++mt) uvp[mt] = *(const f32x4*)(U + (size_t)(row0 + 32 * half + 16 * mt + t16) * 512 + col);
        if (half == 0 && gi > 0) { T = ssm_load_tab(tb, w, gi, lg_); TC = ssm_load_tabc(tb, AR.in[IN_DSKIP] + l * 512, w, gi, lg_); }
        float hr[2], hi[2];
        if (half == 0) {
            hr[0] = 0.f; hr[1] = 0.f; hi[0] = 0.f; hi[1] = 0.f;
            if (npred > 0) {
                float aL[4]; aL[0] = ((const float*)(tb + TB_ALR))[g * 64 + c32]; aL[1] = ((const float*)(tb + TB_ALI))[g * 64 + c32]; aL[2] = ((const float*)(tb + TB_ALR))[g * 64 + 32 + c32]; aL[3] = ((const float*)(tb + TB_ALI))[g * 64 + 32 + c32];
                const float* sb = SST + ((size_t)g) * 128 + 2 * c32;
                for (int cp = cs0; cp < c; cp += 16) {
                    f32x2 sv[16][2];
#pragma unroll
                    for (int j = 0; j < 16; ++j) { const int cj = (cp + j < c) ? cp + j : c - 1; const float* sp_ = sb + (size_t)cj * 32 * 128; sv[j][0] = *(const f32x2*)sp_; sv[j][1] = *(const f32x2*)(sp_ + 64); }
#pragma unroll
                    for (int j = 0; j < 16; ++j) if (cp + j < c) {
#pragma unroll
                        for (int s = 0; s < 2; ++s) { const float nr = aL[2 * s] * hr[s] - aL[2 * s + 1] * hi[s] + sv[j][s][0], ni = aL[2 * s] * hi[s] + aL[2 * s + 1] * hr[s] + sv[j][s][1]; hr[s] = nr; hi[s] = ni; } }
                }
            }
        } else {
#pragma unroll
            for (int s = 0; s < 2; ++s) { hr[s] = hcar[2 * s]; hi[s] = hcar[2 * s + 1]; }
        }
        ssm_block(AR, SG, inx, g, T.bbf, T.ab, hr, hi, samp ? 2 : ((c == 64 && half == 0) ? 1 : 0), l, 0, lg_);
#pragma unroll
        for (int s = 0; s < 2; ++s) { hcar[2 * s] = hr[s]; hcar[2 * s + 1] = hi[s]; }
        { LAS unsigned char* hw = Hm + hh * (16 * 272) + c32 * 2;
#pragma unroll
          for (int j = 0; j < 16; ++j)
#pragma unroll
            for (int nb = 0; nb < 4; ++nb) *(LAS bf16*)(hw + j * 272 + nb * 64) = (bf16)(pk2(SG.X[nb][j], 0.f) & 0xffffu); }
        if ((c == 64 && half == 0) || (c == NCHUNK - 1 && half == 0)) {
            int cx = c32; asm volatile("" : "+v"(cx));
            if (hh == (c == 64 ? 0 : 1)) {
#pragma unroll
                for (int s = 0; s < 2; ++s) { const size_t o = ((size_t)(l * NBATCH + (c == 64 ? 0 : 1)) * 32 + g) * 64 + cx + 32 * s; F.out[O_PSR + o] = SG.X[s][15]; F.out[O_PSI + o] = SG.X[2 + s][15]; } } }
        if (samp) { int cx = c32; asm volatile("" : "+v"(cx)); const size_t o0 = ((size_t)(l * NSAMP + 16 * hh) * 32 + g) * 64 + cx; float* qr = F.out + O_SSR + o0; float* qi = F.out + O_SSI + o0;
#pragma unroll
            for (size_t j = 0, jo = 0; j < 16; ++j) { qr[jo] = SG.X[0][j]; qr[jo + 32] = SG.X[1][j]; qi[jo] = SG.X[2][j]; qi[jo + 32] = SG.X[3][j]; jo += 2048; asm volatile("" : "+v"(jo)); } }
        LDS_WAIT();
#pragma unroll
        for (int mt = 0; mt < 2; ++mt) {
            f32x4 y = {0.f, 0.f, 0.f, 0.f};
#pragma unroll
            for (int ks = 0; ks < 4; ++ks) { const bf16x8 hf = *(const LAS bf16x8*)(Hm + (16 * mt + t16) * 272 + (4 * ks + cq) * 16);
                y = __builtin_amdgcn_mfma_f32_16x16x32_bf16(TC.cmf[ks], hf, y, 0, 0, 0); }
            const int rl = 32 * half + 16 * mt + t16;
            const f32x4 uv = uvp[mt];
            f32x4 z;
#pragma unroll
            for (int e = 0; e < 4; ++e) z[e] = gelu_tanh(y[e] + TC.dsk[e] * uv[e]);
            *(LAS v2u*)(Zs + SWZ(rl, col >> 3, 1024) + (col & 7) * 2) = (v2u){pk2(z[0], z[1]), pk2(z[2], z[3])};
        }
        LDS_WAIT();
        inx = in_n;
    }
    WG_BAR();
    SSM_CP(3);
    f32x4 G[4][4];
#pragma unroll
    for (int mt = 0; mt < 4; ++mt)
#pragma unroll
        for (int nt = 0; nt < 4; ++nt) G[mt][nt] = (f32x4){0.f, 0.f, 0.f, 0.f};
    { const bf16* Wg = (const bf16*)(ws + WS_WGLU) + (size_t)l * 512 * 512 + (size_t)(64 * w + t16) * 512 + 8 * cq;
#pragma unroll 4
      for (int ks = 0; ks < 16; ++ks) {
          bf16x8 wf[4], zf[4];
#pragma unroll
          for (int nt = 0; nt < 4; ++nt) wf[nt] = *(const bf16x8*)(Wg + (size_t)nt * 16 * 512 + 32 * ks);
#pragma unroll
          for (int mt = 0; mt < 4; ++mt) zf[mt] = *(const LAS bf16x8*)(Zs + SWZ(16 * mt + t16, 4 * ks + cq, 1024));
#pragma unroll
          for (int mt = 0; mt < 4; ++mt)
#pragma unroll
              for (int nt = 0; nt < 4; ++nt) G[mt][nt] = __builtin_amdgcn_mfma_f32_16x16x32_bf16(wf[nt], zf[mt], G[mt][nt], 0, 0, 0);
      } }
#pragma unroll
    for (int mt = 0; mt < 4; ++mt) { float ss = 0.f; const int rl = 16 * mt + t16;
#pragma unroll
        for (int nt = 0; nt < 4; ++nt) { const int col = 64 * w + 16 * nt + 4 * cq; const f32x4 bg = *(const f32x4*)(AR.in[IN_BGLU] + l * 512 + col);
            const v2u zz = *(const LAS v2u*)(Zs + SWZ(rl, col >> 3, 1024) + (col & 7) * 2);
            const float zv[4] = {bf2f((unsigned short)(zz.x & 0xffffu)), bf2f((unsigned short)(zz.x >> 16)), bf2f((unsigned short)(zz.y & 0xffffu)), bf2f((unsigned short)(zz.y >> 16))};
#pragma unroll
            for (int e = 0; e < 4; ++e) { const float o = zv[e] * sigmoidf_(G[mt][nt][e] + bg[e]); G[mt][nt][e] = o; ss += o * o; } }
        ss += __shfl_xor(ss, 16); ss += __shfl_xor(ss, 32);
        if (cq == 0) red[rl * 8 + w] = ss; }
    SSM_CP(4);
    WG_BAR();
    { const rsrc_t rs_ = ws_rsrc(ws);
#pragma unroll
      for (int mt = 0; mt < 4; ++mt) { const int rl = 16 * mt + t16; const LAS f32x4* rp = (const LAS f32x4*)(red + rl * 8); const f32x4 a = rp[0], b2 = rp[1];
          const float rsn = rsqrtf(((a[0] + a[1]) + (a[2] + a[3]) + (b2[0] + b2[1]) + (b2[2] + b2[3])) * (1.0f / 512.0f) + EPS);
          const int od = cq & 1; const size_t mo = WS_MIX + ((size_t)(row0 + rl) * DM + 1024 + 64 * w + 4 * (cq & ~1)) * 2 + (od ? 32 : 0);
#pragma unroll
          for (int nt = 0; nt < 4; nt += 2) {
              const unsigned a0 = pk2(G[mt][nt][0] * rsn, G[mt][nt][1] * rsn), a1 = pk2(G[mt][nt][2] * rsn, G[mt][nt][3] * rsn);
              const unsigned b0 = pk2(G[mt][nt + 1][0] * rsn, G[mt][nt + 1][1] * rsn), b1 = pk2(G[mt][nt + 1][2] * rsn, G[mt][nt + 1][3] * rsn);
              const unsigned s0 = od ? a0 : b0, s1 = od ? a1 : b1;
              const unsigned r0 = (unsigned)__shfl_xor((int)s0, 16), r1 = (unsigned)__shfl_xor((int)s1, 16);
              ST16(rs_, mo + 32 * nt, (od ? (v4u){r0, r1, b0, b1} : (v4u){a0, a1, r0, r1})); } } }
    WG_BAR();
}
#undef SSM_ROWS4

template <int WLEN>
__device__ __forceinline__ void pool_half(const float* XP, float* out, int l, int ch, int rfirst, int rl0, LAS unsigned char* Ds) {
    float xv[48];
#pragma unroll
    for (int i = 0; i < 48; ++i) { const int ra = rfirst + i - 16; xv[i] = (ra >= 0) ? XP[(size_t)ra * 512 + ch] : 0.f; }
    int seg = (rfirst >= TT) ? TT : 0;
    float sum = 0.f;
#pragma unroll
    for (int j = 1; j <= WLEN; ++j) if (rfirst - j >= seg) sum += xv[16 - j];
#pragma unroll
    for (int i = 0; i < 32; ++i) {
        const int ra = rfirst + i; const float x = xv[16 + i];
        if (ra == TT) { seg = TT; sum = 0.f; }
        sum += x;
        if (ra - WLEN >= seg) sum -= xv[16 + i - WLEN];
        const int cnt = (ra - seg + 1 < WLEN) ? (ra - seg + 1) : WLEN;
        const float dm = sum * __builtin_amdgcn_rcpf((float)cnt) - x;
        if (ra >= TT - 15 && ra < TT) out[O_PP + ((size_t)(l * NBATCH + 0) * 15 + (ra - (TT - 15))) * 512 + ch] = x;
        if (ra >= SROW0 - 15) out[O_PP + ((size_t)(l * NBATCH + 1) * 15 + (ra - (SROW0 - 15))) * 512 + ch] = x;
        const int r = rl0 + i;
        *(LAS bf16*)(Ds + SWZ(r, ch >> 3, 1024) + (ch & 7) * 2) = (bf16)(pk2(dm, 0.f) & 0xffffu);
    }
}
template <int WLEN>
__device__ __forceinline__ void pool_sample_rows(const float* XP, const float* sp, float* out, int l, int ch, LAS unsigned char* Ds) {
#pragma unroll 2
    for (int s = 0; s < NSAMP; ++s) {
        const float* pp = sp + (size_t)s * 15 * 512; float pv[15];
#pragma unroll
        for (int j = 0; j < 15; ++j) pv[j] = pp[(size_t)j * 512];
        const float x = XP[(size_t)(SROW0 + s) * 512 + ch]; float a = x;
#pragma unroll
        for (int j = 16 - WLEN; j < 15; ++j) a += pv[j];
        const float dm = a * (1.0f / WLEN) - x;
        float* op = out + O_SP + ((size_t)(l * NSAMP + s) * 15) * 512 + ch;
#pragma unroll
        for (int j = 0; j < 14; ++j) op[(size_t)j * 512] = pv[j + 1];
        op[(size_t)14 * 512] = x;
        *(LAS bf16*)(Ds + SWZ(32 + s, ch >> 3, 1024) + (ch & 7) * 2) = (bf16)(pk2(dm, 0.f) & 0xffffu);
    }
}
__device__ __forceinline__ void pool_unit(const Args& AR, Frame& F, int l, int c) {
    int tid_ = F.tid(); asm volatile("" : "+v"(tid_));
    const int tid = tid_, lane = tid & 63, w = F.wave, t16 = lane & 15, cq = lane >> 4;
    const int row0 = 64 * c;
    size_t z_ = 0; asm volatile("" : "+s"(z_)); unsigned char* ws = F.ws + z_;
    const float* XP = (const float*)(ws + WS_XP);
    LAS unsigned char* Ds = F.lds;
    LAS float* red = (LAS float*)(F.lds + ESC_OFF);
    { const int ch = tid, wsel = w >> 1;
      const float* sp = AR.in[IN_SPOOL] + (size_t)l * NSAMP * 15 * 512 + ch;
#pragma unroll 1
      for (int half = 0; half < 2; ++half) {
          if (c == NCHUNK - 1 && half == 1) {
              if (wsel == 0) pool_sample_rows<2>(XP, sp, F.out, l, ch, Ds); else if (wsel == 1) pool_sample_rows<4>(XP, sp, F.out, l, ch, Ds);
              else if (wsel == 2) pool_sample_rows<8>(XP, sp, F.out, l, ch, Ds); else pool_sample_rows<16>(XP, sp, F.out, l, ch, Ds);
          } else {
              const int rfirst = row0 + 32 * half;
              if (wsel == 0) pool_half<2>(XP, F.out, l, ch, rfirst, 32 * half, Ds); else if (wsel == 1) pool_half<4>(XP, F.out, l, ch, rfirst, 32 * half, Ds);
              else if (wsel == 2) pool_half<8>(XP, F.out, l, ch, rfirst, 32 * half, Ds); else pool_half<16>(XP, F.out, l, ch, rfirst, 32 * half, Ds);
          }
      } }
    WG_BAR();
    const int gp = w & 3, rh = w >> 2;
    f32x4 A[2][8];
#pragma unroll
    for (int mt = 0; mt < 2; ++mt)
#pragma unroll
        for (int nt = 0; nt < 8; ++nt) A[mt][nt] = (f32x4){0.f, 0.f, 0.f, 0.f};
    { const bf16* Wp = (const bf16*)(ws + WS_WPOOL) + ((size_t)(l * 4 + gp) * 128 + t16) * 128 + 8 * cq;
#pragma unroll
      for (int ks = 0; ks < 4; ++ks) {
          bf16x8 df[2];
#pragma unroll
          for (int mt = 0; mt < 2; ++mt) df[mt] = *(const LAS bf16x8*)(Ds + SWZ(32 * rh + 16 * mt + t16, 16 * gp + 4 * ks + cq, 1024));
#pragma unroll
          for (int nt = 0; nt < 8; ++nt) { const bf16x8 wf = *(const bf16x8*)(Wp + (size_t)nt * 16 * 128 + 32 * ks);
#pragma unroll
              for (int mt = 0; mt < 2; ++mt) A[mt][nt] = __builtin_amdgcn_mfma_f32_16x16x32_bf16(wf, df[mt], A[mt][nt], 0, 0, 0); }
      } }
#pragma unroll
    for (int mt = 0; mt < 2; ++mt) { float ss = 0.f;
#pragma unroll
        for (int nt = 0; nt < 8; ++nt) { const f32x4 sc = *(const f32x4*)(AR.in[IN_PSCALE] + l * 512 + 128 * gp + 16 * nt + 4 * cq);
#pragma unroll
            for (int e = 0; e < 4; ++e) { const float o = A[mt][nt][e] * sc[e]; A[mt][nt][e] = o; ss += o * o; } }
        ss += __shfl_xor(ss, 16); ss += __shfl_xor(ss, 32);
        if (cq == 0) red[(32 * rh + 16 * mt + t16) * 4 + gp] = ss; }
    WG_BAR();
    { const rsrc_t rs_ = ws_rsrc(ws);
#pragma unroll
      for (int mt = 0; mt < 2; ++mt) { const int rl = 32 * rh + 16 * mt + t16; const f32x4 a = *(const LAS f32x4*)(red + rl * 4);
          const float rsn = rsqrtf(((a[0] + a[1]) + (a[2] + a[3])) * (1.0f / 512.0f) + EPS);
          const int od = cq & 1; const size_t mo = WS_MIX + ((size_t)(row0 + rl) * DM + 1536 + 128 * gp + 4 * (cq & ~1)) * 2 + (od ? 32 : 0);
#pragma unroll
          for (int nt = 0; nt < 8; nt += 2) {
              const unsigned a0 = pk2(A[mt][nt][0] * rsn, A[mt][nt][1] * rsn), a1 = pk2(A[mt][nt][2] * rsn, A[mt][nt][3] * rsn);
              const unsigned b0 = pk2(A[mt][nt + 1][0] * rsn, A[mt][nt + 1][1] * rsn), b1 = pk2(A[mt][nt + 1][2] * rsn, A[mt][nt + 1][3] * rsn);
              const unsigned s0 = od ? a0 : b0, s1 = od ? a1 : b1;
              const unsigned r0 = (unsigned)__shfl_xor((int)s0, 16), r1 = (unsigned)__shfl_xor((int)s1, 16);
              ST16(rs_, mo + 32 * nt, (od ? (v4u){r0, r1, b0, b1} : (v4u){a0, a1, r0, r1})); } } }
    WG_BAR();
}

#ifndef ACQ_SCOPE
#define ACQ_SCOPE "agent"
#endif
#ifndef PE_ROW_OWNED
#define PE_ROW_OWNED 0
#endif
#ifndef PUBLISH_FENCE
#define PUBLISH_FENCE 0
#endif
enum { U_END = 0, U_PA = 1, U_PC = 2, U_PD = 3, U_PE = 4, U_PEQ = 5  , U_SSM = 6, U_ATT = 7, U_SATT = 8, U_POOL = 9 };
constexpr int U_GEMM_LAST = U_PEQ;
constexpr int NPANEL = MP / 256;
constexpr int QCAP = 1024;
__host__ __device__ constexpr unsigned mkd(int type, int l, int a, int b) { return ((unsigned)type << 24) | ((unsigned)l << 20) | ((unsigned)a << 10) | (unsigned)b; }
__device__ __forceinline__ gu32* cnt_word(gu32* ctl, int l, int kind, int pm) { return ctl + CW_CNT + ((l * 5 + kind) * 40 + pm) * 16; }
__host__ __device__ constexpr unsigned mix_target(int pm) { return 3u * (unsigned)((MR - 256 * pm) < 256 ? (MR - 256 * pm) : 256); }

__device__ __forceinline__ void build_queue(unsigned* qt, int q, int lane) {
    const int nx = (q == 0) ? 5 : 4;
    const int nssm = (NCHUNK - 1 - q) / 8 + 1, natt = (NBATCH * NQB - 1 - q) / 8 + 1, nsat = NSAMP / 8;
    const int sz[8] = {NPANEL + 2 * nx, nssm, natt, nsat, nssm, NPANEL, 4 * NPANEL, 0};
    if (lane < 16) {
        const int l = lane >> 3, sec = lane & 7;
        int per0 = 0;
#pragma unroll
        for (int i = 0; i < 7; ++i) per0 += sz[i];
        const int pe0 = NPANEL, pe1 = NPANEL - 1 + 4;
        int n = 1 + l * (per0 + pe0);
#pragma unroll
        for (int i = 0; i < 7; ++i) if (i < sec) n += sz[i];
        if (sec == 0) { for (int pm = 0; pm < NPANEL; ++pm) { qt[n++] = mkd(U_PA, l, pm, q); if ((pm & 7) == q) { qt[n++] = mkd(U_PA, l, pm, 8); qt[n++] = mkd(U_PA, l, pm, 9); } } }
        else if (sec == 1) { for (int c = q; c < NCHUNK; c += 8) qt[n++] = mkd(U_SSM, l, c, 0); }
        else if (sec == 2) { for (int i = q; i < NBATCH * NQB; i += 8) qt[n++] = mkd(U_ATT, l, i, 0); }
        else if (sec == 3) { for (int s = q; s < NSAMP; s += 8) qt[n++] = mkd(U_SATT, l, s, 0); }
        else if (sec == 4) { for (int c = q; c < NCHUNK; c += 8) qt[n++] = mkd(U_POOL, l, c, 0); }
        else if (sec == 5) { for (int pm = 0; pm < NPANEL; ++pm) qt[n++] = mkd(U_PC, l, pm, q); }
        else if (sec == 6) { for (int pm = 0; pm < NPANEL; ++pm) for (int j = 0; j < 4; ++j) qt[n++] = mkd(U_PD, l, pm, 4 * q + j); }
        else {
            for (int pm = 0; pm < NPANEL - 1; ++pm) qt[n++] = mkd(U_PE, l, pm, q);
            if (l == NLAYER - 1) { for (int k = 0; k < 4; ++k) qt[n++] = mkd(U_PEQ, l, NPANEL - 1, 4 * q + k); } else qt[n++] = mkd(U_PE, l, NPANEL - 1, q);
        }
        if (lane == 15) qt[0] = (unsigned)(2 * per0 + pe0 + pe1);
    }
}

struct Sched {
    gu32* ctl; const unsigned* qglob; LAS unsigned* qlds; volatile LAS unsigned* slot; int myq; unsigned nclaim; int ptype;
    __device__ __forceinline__ unsigned claim_lane() {
        { unsigned ho = (unsigned)(CW_QHEAD + myq * 64); asm volatile("" : "+s"(ho));
          const unsigned idx = __hip_atomic_fetch_add(ctl + ho, 1u, RLX_AGENT); if (idx < qlds[0]) return qlds[1 + idx]; }
        for (int k = 1; k < 8; ++k) { const int q = (myq + k) & 7; const unsigned* qg = qglob + (size_t)q * QCAP;
            if (__hip_atomic_load((gu32*)(ctl + CW_QHEAD + q * 64), RLX_AGENT) >= qg[0]) continue;
            const unsigned idx = __hip_atomic_fetch_add(ctl + CW_QHEAD + q * 64, 1u, RLX_AGENT); if (idx < qg[0]) return qg[1 + idx]; }
        return 0u;
    }
    __device__ __forceinline__ unsigned claim_wg(int tid) {
        const unsigned k = nclaim++ & 1u;
        if (tid == 0) slot[k] = claim_lane();
        WG_BAR();
        return slot[k];
    }
    __device__ __forceinline__ void poll(gu32* w, unsigned want) {
        unsigned sp = 0;
#if PROBE && PROBE_KIND == 1
        if (__hip_atomic_load(w, RLX_AGENT) >= want) return;
        struct TAcc { unsigned long long t0; volatile LAS unsigned* acc; bool on; __device__ ~TAcc() { if (on) acc[6] += (unsigned)(__builtin_amdgcn_s_memrealtime() - t0); } } tacc_{__builtin_amdgcn_s_memrealtime(), slot, PROBE_TYPE == 0 || ptype == PROBE_TYPE};
#endif
        while (__hip_atomic_load(w, RLX_AGENT) < want) { __builtin_amdgcn_s_sleep(2);
            if ((++sp & 1023u) == 0u) { if (__hip_atomic_load(ctl + CW_TMO, RLX_AGENT) != 0u) break; if (sp > (1u << 17)) { __hip_atomic_store(ctl + CW_TMO, 0x66u, RLX_AGENT); break; } } }
    }
    __device__ __forceinline__ bool ready_now(gu32* w, unsigned want) { return __hip_atomic_load(w, RLX_AGENT) >= want; }
    __device__ __forceinline__ bool deps_ready_now(unsigned d) {
        const int type = d >> 24, l = (d >> 20) & 15, a = (d >> 10) & 1023; bool ok = true;
        if (type == U_PA) { if (l > 0) { const int p2 = (a + 1 < NPANEL) ? a + 1 : NPANEL - 1; ok = ready_now(cnt_word(ctl, l - 1, 4, a), 8u) && ready_now(cnt_word(ctl, l - 1, 1, p2), mix_target(p2)); } }
        else if (type == U_PC) ok = ready_now(cnt_word(ctl, l, 1, a), mix_target(a));
        else if (type == U_PD) ok = ready_now(cnt_word(ctl, l, 2, a), 8u);
        else ok = ready_now(cnt_word(ctl, l, 3, a), 32u);
        if (ok) { __builtin_amdgcn_fence(__ATOMIC_ACQUIRE, ACQ_SCOPE); asm volatile("s_waitcnt vmcnt(0)" ::: "memory"); }
        return ok;
    }
    __device__ __forceinline__ void wait_deps(unsigned d, int tid) {
        if (tid == 0) {
            const int type = d >> 24, l = (d >> 20) & 15, a = (d >> 10) & 1023; ptype = type;
            if (type == U_PA) { if (l > 0) { poll(cnt_word(ctl, l - 1, 4, a), 8u); const int p2 = (a + 1 < NPANEL) ? a + 1 : NPANEL - 1; poll(cnt_word(ctl, l - 1, 1, p2), mix_target(p2)); } }
            else if (type == U_PC) poll(cnt_word(ctl, l, 1, a), mix_target(a));
            else if (type == U_PD) poll(cnt_word(ctl, l, 2, a), 8u);
            else if (type == U_PE || type == U_PEQ) poll(cnt_word(ctl, l, 3, a), 32u);
            else if (type == U_SSM) poll(cnt_word(ctl, l, 0, a >> 2), 10u);
            else if (type == U_POOL) { poll(cnt_word(ctl, l, 0, a >> 2), 10u); const int r0 = 64 * a - 16; if (r0 >= 0) poll(cnt_word(ctl, l, 0, r0 >> 8), 10u); }
            else if (type == U_SATT) poll(cnt_word(ctl, l, 0, NPANEL - 1), 10u);
            else if (type == U_ATT) { const int b = a / NQB, i = a % NQB, t0 = 32 * i; const int rlo = b * TT + (t0 >= 128 ? t0 - 128 : 0), rhi = b * TT + ((t0 + 31 < TT) ? t0 + 31 : TT - 1);
                poll(cnt_word(ctl, l, 0, rlo >> 8), 10u); if ((rhi >> 8) != (rlo >> 8)) poll(cnt_word(ctl, l, 0, rhi >> 8), 10u); }
            __builtin_amdgcn_fence(__ATOMIC_ACQUIRE, ACQ_SCOPE);
            asm volatile("s_waitcnt vmcnt(0)" ::: "memory");
        }
        asm volatile("" ::: "memory"); __builtin_amdgcn_s_barrier(); asm volatile("" ::: "memory");
    }
    __device__ __forceinline__ void publish(unsigned d, int tid) {
        asm volatile("s_waitcnt vmcnt(0)" ::: "memory");
        WG_BAR();
        if (tid == 0) {
            const int type = d >> 24, l = (d >> 20) & 15, a = (d >> 10) & 1023;
#if PUBLISH_FENCE
            __builtin_amdgcn_fence(__ATOMIC_RELEASE, "agent");
            asm volatile("s_waitcnt vmcnt(0)" ::: "memory");
#endif
            if (type == U_PA) __hip_atomic_fetch_add(cnt_word(ctl, l, 0, a), 1u, RLX_AGENT);
            else if (type == U_PC) __hip_atomic_fetch_add(cnt_word(ctl, l, 2, a), 1u, RLX_AGENT);
            else if (type == U_PD) __hip_atomic_fetch_add(cnt_word(ctl, l, 3, a), 1u, RLX_AGENT);
            else if (type == U_PE) __hip_atomic_fetch_add(cnt_word(ctl, l, 4, a), 1u, RLX_AGENT);
            else if (type == U_SSM || type == U_POOL) __hip_atomic_fetch_add(cnt_word(ctl, l, 1, a >> 2), 64u, RLX_AGENT);
            else if (type == U_SATT) __hip_atomic_fetch_add(cnt_word(ctl, l, 1, NPANEL - 1), 1u, RLX_AGENT);
            else if (type == U_ATT) { const int b = a / NQB, i = a % NQB, t0 = 32 * i; const int r0 = b * TT + t0, r1 = b * TT + ((t0 + 31 < TT) ? t0 + 31 : TT - 1);
                const int p0 = r0 >> 8, p1 = r1 >> 8;
                if (p0 == p1) __hip_atomic_fetch_add(cnt_word(ctl, l, 1, p0), (unsigned)(r1 - r0 + 1), RLX_AGENT);
                else { __hip_atomic_fetch_add(cnt_word(ctl, l, 1, p0), (unsigned)(256 * p1 - r0), RLX_AGENT); __hip_atomic_fetch_add(cnt_word(ctl, l, 1, p1), (unsigned)(r1 - 256 * p1 + 1), RLX_AGENT); } }
        }
    }
};

#ifndef A_AUX
#define A_AUX 0
#endif
struct GU { const char* A; const char* B; unsigned voffA[2], voffB[2]; size_t hstep; int nt; unsigned d; pg8::Unit u; };

struct StreamCtx { unsigned char* ws; float* out; const float* gq; const float* gk; int R[2], C[2], Rp[2]; };
__device__ __forceinline__ void gu_fill(GU& g, unsigned d, const StreamCtx& X) {
    const int type = d >> 24, l = (d >> 20) & 15, pm = (d >> 10) & 1023; int pn = d & 1023;
    unsigned char* ws = X.ws;
    const bf16* A; const bf16* B; int K = DM; bool perm = false;
    if (type == U_PA) { A = (const bf16*)(ws + WS_XB); B = (const bf16*)(ws + WS_WIN) + (size_t)l * INW * DM; }
    else if (type == U_PC) { A = (const bf16*)(ws + WS_MIX); B = (const bf16*)(ws + WS_WOUT) + (size_t)l * DM * DM; perm = true; }
    else if (type == U_PD) { A = (const bf16*)(ws + WS_XB); B = (const bf16*)(ws + WS_W1) + (size_t)l * DFF * DM; perm = true; }
    else { A = (const bf16*)(ws + WS_H); B = (const bf16*)(ws + WS_W2) + (size_t)l * DM * DFF; K = DFF; perm = true; }
    int koff = 0, nt = K / 64;
    if (type == U_PEQ) { koff = (pn & 3) * (DFF / 4); nt = DFF / 4 / 64; pn >>= 2; }
    g.d = d; g.u.pm = pm; g.u.pn = pn; g.nt = nt; g.hstep = (size_t)128 * K * 2;
    g.A = (const char*)A + ((size_t)pm * 256 * K + koff) * 2; g.B = (const char*)B + ((size_t)pn * 256 * K + koff) * 2;
#pragma unroll
    for (int i = 0; i < 2; ++i) { g.voffA[i] = (unsigned)(X.R[i] * K + X.C[i]) * 2u; g.voffB[i] = (unsigned)((perm ? X.Rp[i] : X.R[i]) * K + X.C[i]) * 2u; }
}

__device__ __forceinline__ unsigned gemm_stream(const Args& AR, Frame& F, Sched& Q, unsigned d0) {
    int tid_ = F.tid(); asm volatile("" : "+v"(tid_));
    const int tid = tid_, wid = __builtin_amdgcn_readfirstlane(tid >> 6), lane = tid & 63, wr = wid >> 2, wc = wid & 3, fr = lane & 15, fq = lane >> 4;
    LAS unsigned char* lds = F.lds; LAS unsigned char* esc = F.lds + ESC_OFF;
    StreamCtx X; X.ws = F.ws; X.out = F.out;
#pragma unroll
    for (int i = 0; i < 2; ++i) { int R, C; pg8::stage_rc(tid * 16 + i * 8192, R, C); X.R[i] = R; X.C[i] = C; X.Rp[i] = (R & ~31) + pg8::perm32(R & 31); }
    const size_t kstep = (size_t)(pg8::BK * 2);
    const unsigned ldsw = (unsigned)wid * 1024u;
    const int aoff = pg8::lds_byte(wr * 64 + fr, fq * 8), boff = pg8::lds_byte(wc * 32 + fr, fq * 8);
#define PG8_SA(b, h) (((b) * 2 + (h)) * pg8::HTB)
#define PG8_SB(b, h) ((4 + (b) * 2 + (h)) * pg8::HTB)
#define PG8_STAGE(bufoff, gbase, voff) do { _Pragma("unroll") for (int _i = 0; _i < 2; ++_i) \
        __builtin_amdgcn_global_load_lds((const unsigned*)((const char*)(gbase) + (voff)[_i]), (LAS unsigned*)(lds + (bufoff) + ldsw + _i * 8192), 16, 0, 0); } while (0)
#define PG8_STAGE_A(bufoff, gbase, voff) do { _Pragma("unroll") for (int _i = 0; _i < 2; ++_i) \
        __builtin_amdgcn_global_load_lds((const unsigned*)((const char*)(gbase) + (voff)[_i]), (LAS unsigned*)(lds + (bufoff) + ldsw + _i * 8192), 16, 0, A_AUX); } while (0)
#define PG8_LDA(dst, b, h) do { _Pragma("unroll") for (int m = 0; m < 4; ++m) _Pragma("unroll") for (int k = 0; k < 2; ++k) dst[m][k] = *(const LAS bf16x8*)(lds + PG8_SA(b, h) + aoff + m * 2048 + k * 1024); } while (0)
#define PG8_LDB(dst, b, h) do { _Pragma("unroll") for (int n = 0; n < 2; ++n) _Pragma("unroll") for (int k = 0; k < 2; ++k) dst[n][k] = *(const LAS bf16x8*)(lds + PG8_SB(b, h) + boff + n * 2048 + k * 1024); } while (0)
#define PG8_MMA(ai, bj, At, Bt) do { if (mm[ai]) { __builtin_amdgcn_s_setprio(1); _Pragma("unroll") for (int m = 0; m < 4; ++m) _Pragma("unroll") for (int n = 0; n < 2; ++n) _Pragma("unroll") for (int k = 0; k < 2; ++k) \
        acc[ai][bj][m][n] = __builtin_amdgcn_mfma_f32_16x16x32_bf16(Bt[n][k], At[m][k], acc[ai][bj][m][n], 0, 0, 0); __builtin_amdgcn_s_setprio(0); } } while (0)
#define PG8_WAIT_V(n) asm volatile("s_waitcnt vmcnt(" #n ")" ::: "memory")
#define PG8_WAIT_L(n) asm volatile("s_waitcnt lgkmcnt(" #n ")" ::: "memory")
#define PG8_BAR __builtin_amdgcn_s_barrier()
#define PG8_SCHED __builtin_amdgcn_sched_barrier(0)
#if PROBE && PROBE_KIND == 10
    const unsigned long long tse0 = __builtin_amdgcn_s_memrealtime();
#endif
    GU cur;
    gu_fill(cur, d0, X);
    f32x4 acc[2][2][4][2];
#pragma unroll
    for (int a = 0; a < 2; ++a)
#pragma unroll
        for (int b = 0; b < 2; ++b)
#pragma unroll
            for (int m = 0; m < 4; ++m)
#pragma unroll
                for (int n = 0; n < 2; ++n) acc[a][b][m][n] = (f32x4){0.f, 0.f, 0.f, 0.f};
    bf16x8 At[4][2], B0[2][2], B1[2][2];
    PG8_STAGE(PG8_SB(0, 0), cur.B, cur.voffB); PG8_STAGE(PG8_SB(0, 1), cur.B + cur.hstep, cur.voffB);
    Q.wait_deps(cur.d, tid);
    PG8_STAGE_A(PG8_SA(0, 0), cur.A, cur.voffA); PG8_STAGE_A(PG8_SA(0, 1), cur.A + cur.hstep, cur.voffA);
    if (wr == 1) PG8_BAR;
    PG8_WAIT_V(2); PG8_BAR;
    PG8_STAGE(PG8_SB(1, 0), cur.B + kstep, cur.voffB); PG8_STAGE_A(PG8_SA(1, 0), cur.A + kstep, cur.voffA); PG8_STAGE(PG8_SB(1, 1), cur.B + cur.hstep + kstep, cur.voffB);
    PG8_WAIT_V(6); PG8_BAR;
#if PROBE && PROBE_KIND == 10
    if (tid == 0) { Q.slot[6] += (unsigned)(__builtin_amdgcn_s_memrealtime() - tse0); Q.slot[7] += 1u; }
#endif
    unsigned carry = 0u; unsigned ui = 0u;
    for (;;) {
        bool go = false;
        const char* cA = cur.A; const char* cB = cur.B; const size_t hstep = cur.hstep; const int nt = cur.nt;
#if PROBE && PROBE_KIND == 3
        const unsigned long long tu0 = __builtin_amdgcn_s_memrealtime();
#endif
        const bool fullp = cur.u.pm != NPANEL - 1; const bool mm[2] = {fullp || wr == 0, fullp};
        for (int t = 0; t < nt; t += 2) {
            const bool last = (t == nt - 2);
            const char* a1 = cA + (size_t)(t + 1) * kstep;
            const char* a2_ = cA + (size_t)(last ? 0 : t + 2) * kstep; const char* b2_ = cB + (size_t)(last ? 0 : t + 2) * kstep;
            const char* a2 = a2_; const char* b2 = b2_; size_t h2 = hstep;
            unsigned vA2[2], vB2[2];
#pragma unroll
            for (int i = 0; i < 2; ++i) { vA2[i] = cur.voffA[i]; vB2[i] = cur.voffB[i]; }
            if (last) {
                const unsigned k = 2u + (ui & 1u);
#if PROBE && PROBE_KIND == 8
                const unsigned long long tc0 = __builtin_amdgcn_s_memrealtime();
#endif
                if (tid == 0) { const unsigned dn = Q.claim_lane(); Q.slot[k] = dn;
                    Q.slot[2u + k] = ((dn >> 24) >= U_PA && (dn >> 24) <= U_GEMM_LAST && (!STREAM_SAME_SECTION || ((dn >> 20) == (cur.d >> 20))) && Q.deps_ready_now(dn)) ? 1u : 0u; }
                asm volatile("s_waitcnt lgkmcnt(0)" ::: "memory"); PG8_BAR; asm volatile("" ::: "memory");
                carry = Q.slot[k]; go = Q.slot[2u + k] != 0u;
#if PROBE && PROBE_KIND == 14
                if (tid == 0 && (int)(cur.d >> 24) == PROBE_TYPE) { Q.slot[6] += go ? 100u : 0u; Q.slot[7] += 1u; }
#endif
#if PROBE && PROBE_KIND == 8
                if (tid == 0 && (int)(cur.d >> 24) == PROBE_TYPE) { Q.slot[6] += (unsigned)(__builtin_amdgcn_s_memrealtime() - tc0); Q.slot[7] += 1u; }
#endif
                if (go) { GU n2; gu_fill(n2, carry, X); a2 = n2.A; b2 = n2.B; h2 = n2.hstep;
#pragma unroll
                    for (int i = 0; i < 2; ++i) { vA2[i] = n2.voffA[i]; vB2[i] = n2.voffB[i]; } }
            }
            const char* a3 = a2 + kstep; const char* b3 = b2 + kstep;
            PG8_LDB(B0, 0, 0); PG8_LDB(B1, 0, 1); PG8_SCHED; PG8_LDA(At, 0, 0); PG8_STAGE_A(PG8_SA(1, 1), a1 + hstep, cur.voffA);
            PG8_WAIT_V(8); PG8_WAIT_L(0); PG8_BAR; PG8_MMA(0, 0, At, B0); PG8_MMA(0, 1, At, B1); PG8_BAR; PG8_SCHED;
            PG8_LDA(At, 0, 1); PG8_STAGE(PG8_SB(0, 0), b2, vB2); PG8_STAGE(PG8_SB(0, 1), b2 + h2, vB2); PG8_STAGE_A(PG8_SA(0, 0), a2, vA2);
            PG8_WAIT_V(8); PG8_WAIT_L(0); PG8_BAR; PG8_MMA(1, 0, At, B0); PG8_MMA(1, 1, At, B1); PG8_BAR; PG8_SCHED;
            PG8_LDB(B0, 1, 0); PG8_LDB(B1, 1, 1); PG8_SCHED; PG8_LDA(At, 1, 0); PG8_STAGE_A(PG8_SA(0, 1), a2 + h2, vA2);
            PG8_WAIT_V(8); PG8_WAIT_L(0); PG8_BAR; PG8_MMA(0, 0, At, B0); PG8_MMA(0, 1, At, B1); PG8_BAR; PG8_SCHED;
            PG8_LDA(At, 1, 1); PG8_STAGE(PG8_SB(1, 0), b3, vB2); PG8_STAGE(PG8_SB(1, 1), b3 + h2, vB2); PG8_STAGE_A(PG8_SA(1, 0), a3, vA2);
            PG8_WAIT_V(8); PG8_WAIT_L(0); PG8_BAR; PG8_MMA(1, 0, At, B0); PG8_MMA(1, 1, At, B1); PG8_BAR; PG8_SCHED;
        }
#if PROBE && PROBE_KIND == 7
        const unsigned long long te0 = __builtin_amdgcn_s_memrealtime();
#endif
        if (wr == 0) PG8_BAR;
        { const int type = cur.d >> 24, l = (cur.d >> 20) & 15;
          if (type == U_PA) { EpiProj E{X.ws, X.out, AR.in[IN_GQ] + l * 128, AR.in[IN_GK] + l * 128, l}; E(acc, cur.u, wr, wc, fr, fq, esc, tid); }
          else if (type == U_PD) { EpiFfn1 E{X.ws}; E(acc, cur.u, wr, wc, fr, fq, esc, tid); }
          else if (type == U_PEQ) { EpiAtom E{X.out}; E(acc, cur.u, wr, wc, fr, fq, esc, tid); }
          else { EpiRes E{X.ws, X.out, (type == U_PE && l == NLAYER - 1) ? 1 : 0, (type == U_PC && l == NLAYER - 1 && cur.u.pm == NPANEL - 1) ? 1 : 0}; E(acc, cur.u, wr, wc, fr, fq, esc, tid); }
          Q.publish(cur.d, tid);
#if PROBE && PROBE_KIND == 7
          if (tid == 0 && (int)(cur.d >> 24) == PROBE_TYPE && cur.u.pm != NPANEL - 1) { Q.slot[6] += (unsigned)(__builtin_amdgcn_s_memrealtime() - te0); Q.slot[7] += 1u; }
#endif
#if PROBE && PROBE_KIND == 3
          if (tid == 0 && (int)(cur.d >> 24) == PROBE_TYPE && cur.u.pm != NPANEL - 1) { Q.slot[6] += (unsigned)(__builtin_amdgcn_s_memrealtime() - tu0); Q.slot[7] += 1u; }
#endif
          }
        if (!go) break;
#pragma unroll
        for (int a = 0; a < 2; ++a)
#pragma unroll
            for (int b = 0; b < 2; ++b)
#pragma unroll
                for (int m = 0; m < 4; ++m)
#pragma unroll
                    for (int n = 0; n < 2; ++n) acc[a][b][m][n] = (f32x4){0.f, 0.f, 0.f, 0.f};
        gu_fill(cur, carry, X); ++ui;
        if (wr == 1) PG8_BAR;
    }
    PG8_WAIT_V(0);
    PG8_BAR;
#undef PG8_SA
#undef PG8_SB
#undef PG8_STAGE
#undef PG8_STAGE_A
#undef PG8_LDA
#undef PG8_LDB
#undef PG8_MMA
#undef PG8_WAIT_V
#undef PG8_WAIT_L
#undef PG8_BAR
#undef PG8_SCHED
    return carry;
}

__global__ void __launch_bounds__(512, 2) hymba_fwd(Args args) {
    extern __shared__ __attribute__((aligned(16))) unsigned char lds[];
    Frame F;
    F.lds = (LAS unsigned char*)lds;
    F.MISC = (volatile LAS unsigned*)(F.lds + MISC_OFF);
    F.wave = __builtin_amdgcn_readfirstlane((int)(threadIdx.x >> 6));
    F.G = gridDim.x; { const int bx = blockIdx.x; F.vcu = (F.G % 8 == 0) ? (bx % 8) * (F.G / 8) + bx / 8 : bx; }
    F.ws = args.ws; F.out = args.out; F.ctl = (gu32*)(args.ws + WS_CTL);
    for (int u = F.tid(); u < (LDS_BYTES - LDSCTL_OFF) / 4; u += 512) ((LAS unsigned*)(F.lds + LDSCTL_OFF))[u] = 0u;
    __syncthreads();
    XcdBarrier bar = xcd_barrier_post((unsigned*)(F.ctl + CW_BAR), F.MISC + 8);
#if PROBE
    const unsigned long long tk0 = __builtin_amdgcn_s_memrealtime();
#endif
    for (int rep = 0; rep < DUP_P0; ++rep) p0_prologue(args, F);
#if PROBE && (PROBE_KIND == 5 || PROBE_KIND == 6)
    if (F.tid() == 0) { F.MISC[6] = (unsigned)(__builtin_amdgcn_s_memrealtime() - tk0); if (PROBE_KIND == 6) __hip_atomic_fetch_max(F.ctl + CW_STAT + 48, F.MISC[6], RLX_AGENT); }
#endif
    if (blockIdx.x < 8 && F.wave == 7) build_queue((unsigned*)(args.ws + WS_QUEUE) + (size_t)blockIdx.x * QCAP, (int)blockIdx.x, F.lane());
    xcd_barrier(bar);
    Sched Q; Q.ctl = F.ctl; Q.qglob = (const unsigned*)(args.ws + WS_QUEUE); Q.qlds = (LAS unsigned*)(F.lds + QTAB_OFF); Q.slot = F.MISC; Q.myq = __builtin_amdgcn_readfirstlane((int)(bar.x & 7u)); Q.nclaim = 0u; Q.ptype = 0;
    { const unsigned* qg = Q.qglob + (size_t)Q.myq * QCAP; for (int i = F.tid(); i < QCAP; i += 512) Q.qlds[i] = qg[i]; }
    WG_BAR();
    unsigned d = Q.claim_wg(F.tid());
#if SEC_BARRIER
    int cursec = 0;
#endif
    for (;;) {
        const int type = d >> 24;
#if SEC_BARRIER
        { const int sec = (type == U_END) ? 5 * NLAYER : ((d >> 20) & 15) * 5 + ((type >= U_SSM) ? 1 : (type == U_PA ? 0 : type));
          while (cursec < sec) { if ((SEC_MASK >> cursec) & 1) xcd_barrier(bar); ++cursec; } }
#endif
        if (type == U_END) break;
        if (type <= U_GEMM_LAST) {
#if PROBE && PROBE_KIND == 9
            const unsigned long long ts0 = __builtin_amdgcn_s_memrealtime();
#endif
            d = gemm_stream(args, F, Q, d);
#if PROBE && PROBE_KIND == 9
            if (F.tid() == 0) { F.MISC[6] += (unsigned)(__builtin_amdgcn_s_memrealtime() - ts0); }
#endif
            continue; }
        const int l = (d >> 20) & 15, a = (d >> 10) & 1023;
        Q.wait_deps(d, F.tid());
#if PROBE && PROBE_KIND == 2
        const unsigned long long tp0 = __builtin_amdgcn_s_memrealtime();
#endif
        if (type == U_SSM) ssm_unit(args, F, l, a);
        else if (type == U_ATT) attn_unit(args, F, l, a / NQB, a % NQB);
        else if (type == U_SATT) sattn_unit(args, F, l, a);
        else pool_unit(args, F, l, a);
        Q.publish(d, F.tid());
#if PROBE && PROBE_KIND == 2
        if (F.tid() == 0 && (PROBE_TYPE == 0 || type == PROBE_TYPE)) F.MISC[6] += (unsigned)(__builtin_amdgcn_s_memrealtime() - tp0);
#endif
        d = Q.claim_wg(F.tid());
    }
#if PROBE
    if (F.tid() == 0) {
        const unsigned tend = (unsigned)(__builtin_amdgcn_s_memrealtime() - tk0);
        if (PROBE_KIND == 4) { F.MISC[6] = tend; __hip_atomic_fetch_max(F.ctl + CW_STAT + 48, tend, RLX_AGENT); }
        __hip_atomic_fetch_add(F.ctl + CW_STAT, F.MISC[6], RLX_AGENT);
        __hip_atomic_fetch_add(F.ctl + CW_STAT + 32, F.MISC[7], RLX_AGENT);
        const unsigned n = __hip_atomic_fetch_add(F.ctl + CW_STAT + 16, 1u, RLX_AGENT);
        F.MISC[7] = (n == gridDim.x - 1) ? 1u : 0u;
        if (n == gridDim.x - 1) { F.MISC[5] = __hip_atomic_load(F.ctl + CW_STAT, RLX_AGENT); F.MISC[4] = __hip_atomic_load(F.ctl + CW_STAT + 32, RLX_AGENT); F.MISC[3] = __hip_atomic_load(F.ctl + CW_STAT + 48, RLX_AGENT); }
    }
    WG_BAR();
    if (F.MISC[7]) { float v = (float)F.MISC[5] / (float)gridDim.x * 0.01f;
        if (PROBE_KIND == 10 && PROBE_TYPE == 1) v = (float)F.MISC[4] / (float)gridDim.x;
        if (PROBE_KIND == 14) v = (float)F.MISC[5] / (float)(F.MISC[4] ? F.MISC[4] : 1u);
        if (PROBE_KIND == 3 || PROBE_KIND == 7 || PROBE_KIND == 8) v = (float)F.MISC[5] * 0.01f / (float)(F.MISC[4] ? F.MISC[4] : 1u);
        if (PROBE_KIND == 4) v = (float)F.MISC[3] * 0.01f - v;
        if (PROBE_KIND == 6) v = (float)F.MISC[3] * 0.01f;
        v = floorf((v + 0.5f * PROBE_Q) / PROBE_Q) * PROBE_Q;
        for (int i = F.tid(); i < NLAYER * NSAMP * 15 * 512; i += 512) F.out[O_SP + i] = v; }
#endif
}

extern "C" void kernel_launch(void* const* d_in, const int* in_sizes, int n_in, void* d_out, int out_size, void* d_ws, size_t ws_size, hipStream_t stream) {
    static int grid = 0;
    if (grid == 0) {
        if (n_in != 32 || (size_t)out_size != O_END || ws_size < WS_END) { fprintf(stderr, "kernel_launch: unexpected shapes: n_in %d out %d (want %zu) ws %zu (want >= %zu)\n", n_in, out_size, (size_t)O_END, ws_size, (size_t)WS_END); grid = -1; return; }
        int dev = 0, cus = 0, per_cu = 0;
        if (hipGetDevice(&dev) != hipSuccess || hipDeviceGetAttribute(&cus, hipDeviceAttributeMultiprocessorCount, dev) != hipSuccess) { fprintf(stderr, "kernel_launch: device query failed\n"); grid = -1; return; }
        if (hipFuncSetAttribute((const void*)hymba_fwd, hipFuncAttributeMaxDynamicSharedMemorySize, LDS_BYTES) != hipSuccess) { fprintf(stderr, "kernel_launch: hipFuncSetAttribute failed\n"); grid = -1; return; }
        if (hipOccupancyMaxActiveBlocksPerMultiprocessor(&per_cu, (const void*)hymba_fwd, 512, LDS_BYTES) != hipSuccess || per_cu < 1) { fprintf(stderr, "kernel_launch: occupancy query says %d blocks per CU\n", per_cu); per_cu = 1; }
        (void)hipGetLastError();
        grid = cus;
        if (grid % 8 != 0) grid -= grid % 8;
    }
    if (grid < 0) return;
    (void)hipMemsetAsync((char*)d_ws + WS_CTL, 0, CTL_ZERO_BYTES, stream);
    Args a{};
    for (int i = 0; i < 32; ++i) a.in[i] = (const float*)d_in[i];
    a.out = (float*)d_out; a.ws = (unsigned char*)d_ws; a.ph_lo = 0; a.ph_hi = 0;
    hipLaunchKernelGGL(hymba_fwd, dim3(grid), dim3(512), LDS_BYTES, stream, a);
    const hipError_t le = hipPeekAtLastError();
    if (le != hipSuccess) fprintf(stderr, "kernel_launch: launch failed: %s\n", hipGetErrorName(le));
}
```

```cpp
#include <hip/hip_runtime.h>
#include <cstdio>
#include <cstdint>

#ifndef MK_N_LAUNCHES
#define MK_N_LAUNCHES 1
#endif

#ifndef SEC_BARRIER
#define SEC_BARRIER 0
#endif
#ifndef STREAM_SAME_SECTION
#define STREAM_SAME_SECTION 0
#endif
#ifndef SEC_MASK
#define SEC_MASK 0x10
#endif
#ifndef PROBE
#define PROBE 0
#endif
#ifndef PROBE_KIND
#define PROBE_KIND 1
#endif
#ifndef PROBE_TYPE
#define PROBE_TYPE 0
#endif
#ifndef PROBE_Q
#define PROBE_Q 20.0f
#endif
#ifndef DUP_PB
#define DUP_PB 1
#endif
#ifndef DUP_P0
#define DUP_P0 1
#endif

constexpr int DM = 2048, TT = 4112  , NSEQ = 4096, NMETA = 16, NBATCH = 2, NSAMP = 32;
constexpr int MR = NBATCH * TT + NSAMP;
constexpr int MP = 8448;
constexpr int SROW0 = NBATCH * TT;
constexpr int INW = 2560, DFF = 8192, NLAYER = 2;
constexpr int TPV = 4128;
constexpr int ROPE_SAMPLE_IDX = TT;
constexpr float EPS = 1e-6f;
constexpr float LOG2E = 1.4426950408889634f;
constexpr float QSCALE = 0.08838834764831845f * LOG2E;
constexpr int NCHUNK = MR / 64;
constexpr int NQB = (TT + 31) / 32;

constexpr size_t O_YP = 0, O_YS = O_YP + (size_t)NBATCH * NSEQ * DM, O_PK = O_YS + (size_t)NSAMP * DM, O_PV = O_PK + (size_t)NLAYER * NBATCH * 128 * 256,
                 O_PSR = O_PV + (size_t)NLAYER * NBATCH * 128 * 256, O_PSI = O_PSR + (size_t)NLAYER * NBATCH * 2048, O_PP = O_PSI + (size_t)NLAYER * NBATCH * 2048,
                 O_SK = O_PP + (size_t)NLAYER * NBATCH * 15 * 512, O_SV = O_SK + (size_t)NLAYER * NSAMP * 128 * 256, O_SSR = O_SV + (size_t)NLAYER * NSAMP * 128 * 256,
                 O_SSI = O_SSR + (size_t)NLAYER * NSAMP * 2048, O_SP = O_SSI + (size_t)NLAYER * NSAMP * 2048, O_END = O_SP + (size_t)NLAYER * NSAMP * 15 * 512;

constexpr size_t MiB = 1u << 20;
constexpr size_t WS_CTL = 0, CTL_ZERO_BYTES = 256 * 1024;
constexpr size_t WS_WIN = 1 * MiB, WS_WOUT = 21 * MiB, WS_W1 = 37 * MiB, WS_W2 = 101 * MiB, WS_WGLU = 165 * MiB, WS_WPOOL = 166 * MiB, WS_TAB = 167 * MiB;
constexpr size_t WS_X = 170 * MiB, WS_XB = 236 * MiB, WS_Q = 269 * MiB, WS_K = 286 * MiB, WS_VT = 291 * MiB, WS_U = 296 * MiB, WS_XP = 313 * MiB, WS_MIX = 330 * MiB,
                 WS_H = 363 * MiB, WS_SSQ = 495 * MiB, WS_SST = 497 * MiB, WS_KSN = 502 * MiB, WS_QUEUE = 503 * MiB, WS_END = 504 * MiB;
static_assert(WS_WIN + (size_t)NLAYER * INW * DM * 2 <= WS_WOUT && WS_WOUT + (size_t)NLAYER * DM * DM * 2 <= WS_W1 && WS_W1 + (size_t)NLAYER * DFF * DM * 2 <= WS_W2 && WS_W2 + (size_t)NLAYER * DFF * DM * 2 <= WS_WGLU, "ws map 1");
static_assert(WS_X + (size_t)MP * DM * 4 <= WS_XB && WS_XB + (size_t)MP * DM * 2 <= WS_Q && WS_Q + (size_t)MP * 1024 * 2 <= WS_K && WS_K + (size_t)MP * 256 * 2 <= WS_VT && WS_VT + (size_t)4 * 128 * TPV * 2 <= WS_U, "ws map 2");
static_assert(WS_U + (size_t)MP * 512 * 4 <= WS_XP && WS_XP + (size_t)MP * 512 * 4 <= WS_MIX && WS_MIX + (size_t)MP * DM * 2 <= WS_H && WS_H + (size_t)MP * DFF * 2 <= WS_SSQ && WS_SSQ + (size_t)MP * 32 * 4 <= WS_SST, "ws map 3");
static_assert(WS_SST + (size_t)NLAYER * NCHUNK * 32 * 64 * 8 <= WS_KSN, "ws map 4");
constexpr size_t TB_ABR = 0, TB_ABI = 8192, TB_ALR = 16384, TB_ALI = 24576, TB_A16R = 32768, TB_A16I = 40960, TB_A32R = 49152, TB_A32I = 57344,
                 TB_BBR = 65536, TB_BBI = TB_BBR + 131072, TB_PM = TB_BBI + 131072, TB_CMT = TB_PM + 524288, TB_LAYER = 1 * MiB;
static_assert(TB_CMT + 131072 <= TB_LAYER, "table map");
constexpr size_t WS_ROPE = WS_TAB + 2 * MiB;
constexpr size_t ROPE_N = (size_t)(TT + 1) * 16;
constexpr int CW_TMO = 0, CW_CODE = 1, CW_BAR = 4096, CW_QHEAD = 8192  , CW_STAT = 8800, CW_CNT = 9216  , CW_SSMF = 16384  ;
static_assert(CW_CNT + NLAYER * 5 * 40 * 16 <= CW_SSMF, "ctl map: counters");
static_assert((CW_SSMF + NLAYER * NCHUNK * 8 * 16) * 4 <= (int)CTL_ZERO_BYTES, "ctl map");

constexpr int RING_BYTES = 131072, ESC_OFF = RING_BYTES  , QTAB_OFF = ESC_OFF + 12288  , LDSCTL_OFF = QTAB_OFF + 4096, MISC_OFF = LDSCTL_OFF + 320, LDS_BYTES = 148480;
static_assert(MISC_OFF + 128 <= LDS_BYTES, "LDS map");

#define GAS __attribute__((address_space(1)))
#define LAS __attribute__((address_space(3)))
typedef unsigned short bf16;
typedef unsigned v4u __attribute__((ext_vector_type(4)));
typedef unsigned v2u __attribute__((ext_vector_type(2)));
typedef float f32x2 __attribute__((ext_vector_type(2)));
typedef float f32x16 __attribute__((ext_vector_type(16)));
typedef __bf16 bf16x2_t __attribute__((ext_vector_type(2)));
typedef GAS unsigned gu32;
typedef GAS unsigned long long gu64;
#define RLX_AGENT __ATOMIC_RELAXED, __HIP_MEMORY_SCOPE_AGENT
#define LDS_WAIT() asm volatile("s_waitcnt lgkmcnt(0)" ::: "memory")
#define VM_WAIT() asm volatile("s_waitcnt vmcnt(0)" ::: "memory")
#define WG_BAR() do { asm volatile("s_waitcnt lgkmcnt(0)" ::: "memory"); __builtin_amdgcn_s_barrier(); asm volatile("" ::: "memory"); } while (0)
__device__ __forceinline__ unsigned pk2(float lo, float hi) { f32x2 v = {lo, hi}; bf16x2_t b = __builtin_convertvector(v, bf16x2_t); return __builtin_bit_cast(unsigned, b); }
__device__ __forceinline__ float bf2f(unsigned short h) { return __builtin_bit_cast(float, (unsigned)h << 16); }
__device__ __forceinline__ int lane_now() { int l; asm volatile("v_mbcnt_lo_u32_b32 %0, -1, 0\n\tv_mbcnt_hi_u32_b32 %0, -1, %0" : "=v"(l)); return l; }
__device__ __forceinline__ int shfl_xor_(int v, int m) { return __builtin_amdgcn_ds_bpermute((lane_now() ^ m) << 2, v); }
__device__ __forceinline__ float shfl_xor_(float v, int m) { return __builtin_bit_cast(float, __builtin_amdgcn_ds_bpermute((lane_now() ^ m) << 2, __builtin_bit_cast(int, v))); }
#define __shfl_xor(v, m) shfl_xor_((v), (m))
__device__ __forceinline__ float wave_sum(float v) {
#pragma unroll
    for (int o = 1; o < 64; o <<= 1) v += __shfl_xor(v, o);
    return v;
}
__device__ __forceinline__ float wave_max(float v) {
#pragma unroll
    for (int o = 1; o < 64; o <<= 1) v = fmaxf(v, __shfl_xor(v, o));
    return v;
}

typedef __amdgpu_buffer_rsrc_t rsrc_t;
__device__ __forceinline__ rsrc_t ws_rsrc(unsigned char* ws) { return __builtin_amdgcn_make_buffer_rsrc(ws, 0, (int)WS_END, 0x00020000); }
#define ST16(r, off, v) __builtin_amdgcn_raw_buffer_store_b128(__builtin_bit_cast(v4u, (v)), (r), (unsigned)(off), 0, 16)
#define ST8(r, off, v)  __builtin_amdgcn_raw_buffer_store_b64((v), (r), (unsigned)(off), 0, 16)
#define ST4(r, off, v)  __builtin_amdgcn_raw_buffer_store_b32(__builtin_bit_cast(unsigned, (v)), (r), (unsigned)(off), 0, 16)
#define ST2(r, off, v)  __builtin_amdgcn_raw_buffer_store_b16((unsigned short)(v), (r), (unsigned)(off), 0, 16)
__host__ __device__ __forceinline__ int perm16(int o) { return 8 * ((o >> 2) & 1) + 4 * (o >> 3) + (o & 3); }

namespace pg8 {
#define PG8_LAS __attribute__((address_space(3)))
typedef unsigned short bf16_t;
typedef short bf16x8 __attribute__((ext_vector_type(8)));
typedef float f32x4 __attribute__((ext_vector_type(4)));
typedef unsigned u32x4 __attribute__((ext_vector_type(4)));
constexpr int BM = 256, BK = 64, HALF = 128, HTB = HALF * BK * 2  , STAGE_BYTES = 8 * HTB, NXCD = 8, WGM = 8;

__host__ __device__ __forceinline__ int lds_byte(int r, int c) { const int st = (r >> 4) * 2 + (c >> 5), rr = r & 15, cc = c & 31, ob = rr * 64 + cc * 2; return st * 1024 + (ob ^ (((ob >> 9) & 1) << 5)); }
__host__ __device__ __forceinline__ void stage_rc(int b, int& R, int& C) { const int st = b / 1024, sb = b % 1024, swz = sb ^ (((sb >> 9) & 1) << 5); R = (st >> 1) * 16 + swz / 64; C = (st & 1) * 32 + (swz % 64) / 2; }
__host__ __device__ __forceinline__ int perm32(int rho) { const int n = rho >> 4, i = rho & 15; return 8 * (i >> 2) + 4 * n + (i & 3); }

struct Unit { int pm, pn; };
struct Gemm { const bf16_t* A; const bf16_t* Bt; int M, N, K; };

struct StaticOrder {
    int nM, nN, nwg, G, c;
    __host__ __device__ void init(int M, int N, int G_, int c_) { nM = M / BM; nN = N / BM; nwg = nM * nN; G = G_; c = c_; }
    __host__ __device__ bool next(int i, Unit& u) const {
        const long L = (long)i * G + c; if (L >= nwg) return false;
        int wgid = (int)L; { const int q = nwg / NXCD, r = nwg % NXCD, xcd = wgid % NXCD, off = wgid / NXCD; wgid = (xcd < r ? xcd * (q + 1) : r * (q + 1) + (xcd - r) * q) + off; }
        const int nig = WGM * nN, gid = wgid / nig, fm = gid * WGM, gsz = (nM - fm) < WGM ? (nM - fm) : WGM;
        u.pm = fm + ((wgid % nig) % gsz); u.pn = (wgid % nig) / gsz; return true;
    }
    __device__ __forceinline__ void a_ready(const Unit&) const {}
    __device__ __forceinline__ void done(const Unit&) const {}
};


template <class Epi, class Sched, bool ALIGN_EPI = false, bool SP2 = false>
__device__ __forceinline__ void gemm_phase(PG8_LAS unsigned char* lds, PG8_LAS unsigned char* esc, const Gemm g, const Sched& S, const Epi& E) {
    int tid_ = threadIdx.x; asm volatile("" : "+v"(tid_));
    const int tid = tid_, wid = __builtin_amdgcn_readfirstlane(tid >> 6), lane = tid & 63, wr = wid >> 2, wc = wid & 3, fr = lane & 15, fq = lane >> 4;
    const int K = g.K, nt = K / BK;
    unsigned voffA[2], voffB[2];
#pragma unroll
    for (int i = 0; i < 2; ++i) { int R, C; stage_rc(tid * 16 + i * 8192, R, C); const int Rb = Epi::PERM ? ((R & ~31) + perm32(R & 31)) : R;
        voffA[i] = (unsigned)(R * K + C) * 2u; voffB[i] = (unsigned)(Rb * K + C) * 2u; }
    const size_t kstep = (size_t)(BK * 2);
    const size_t hstep = (size_t)HALF * K * 2;
    const size_t tstep = 2 * hstep;
    const unsigned ldsw = (unsigned)wid * 1024u;
    const int aoff = lds_byte(wr * 64 + fr, fq * 8), boff = lds_byte(wc * 32 + fr, fq * 8);
#define PG8_SA(b, h) (((b) * 2 + (h)) * HTB)
#define PG8_SB(b, h) ((4 + (b) * 2 + (h)) * HTB)
#define PG8_STAGE(bufoff, gbase, voff) do { _Pragma("unroll") for (int _i = 0; _i < 2; ++_i) \
        __builtin_amdgcn_global_load_lds((const unsigned*)((const char*)(gbase) + (voff)[_i]), (PG8_LAS unsigned*)(lds + (bufoff) + ldsw + _i * 8192), 16, 0, 0); } while (0)
#define PG8_LDA(dst, b, h) do { _Pragma("unroll") for (int m = 0; m < 4; ++m) _Pragma("unroll") for (int k = 0; k < 2; ++k) dst[m][k] = *(const PG8_LAS bf16x8*)(lds + PG8_SA(b, h) + aoff + m * 2048 + k * 1024); } while (0)
#define PG8_LDB(dst, b, h) do { _Pragma("unroll") for (int n = 0; n < 2; ++n) _Pragma("unroll") for (int k = 0; k < 2; ++k) dst[n][k] = *(const PG8_LAS bf16x8*)(lds + PG8_SB(b, h) + boff + n * 2048 + k * 1024); } while (0)
#define PG8_MMA(ai, bj, At, Bt) do { __builtin_amdgcn_s_setprio(1); _Pragma("unroll") for (int m = 0; m < 4; ++m) _Pragma("unroll") for (int n = 0; n < 2; ++n) _Pragma("unroll") for (int k = 0; k < 2; ++k) \
        acc[ai][bj][m][n] = __builtin_amdgcn_mfma_f32_16x16x32_bf16(Bt[n][k], At[m][k], acc[ai][bj][m][n], 0, 0, 0); __builtin_amdgcn_s_setprio(0); } while (0)
#define PG8_WAIT_V(n) asm volatile("s_waitcnt vmcnt(" #n ")" ::: "memory")
#define PG8_WAIT_L(n) asm volatile("s_waitcnt lgkmcnt(" #n ")" ::: "memory")
#define PG8_BAR __builtin_amdgcn_s_barrier()
#define PG8_SCHED __builtin_amdgcn_sched_barrier(0)
    Unit cur, nxt; int ui = 0;
    if (!S.next(0, cur)) return;
    f32x4 acc[2][2][4][2];
#pragma unroll
    for (int a = 0; a < 2; ++a)
#pragma unroll
        for (int b = 0; b < 2; ++b)
#pragma unroll
            for (int m = 0; m < 4; ++m)
#pragma unroll
                for (int n = 0; n < 2; ++n) acc[a][b][m][n] = (f32x4){0.f, 0.f, 0.f, 0.f};
    bf16x8 At[4][2], B0[2][2], B1[2][2];
    const char* cA = (const char*)g.A + (size_t)cur.pm * tstep; const char* cB = (const char*)g.Bt + (size_t)cur.pn * tstep;
    S.a_ready(cur);
    if constexpr (SP2) {
        PG8_STAGE(PG8_SB(0, 0), cB, voffB); PG8_STAGE(PG8_SB(0, 1), cB + hstep, voffB); PG8_STAGE(PG8_SA(0, 0), cA, voffA); PG8_STAGE(PG8_SA(0, 1), cA + hstep, voffA);
        if (wr == 1) PG8_BAR;
        PG8_WAIT_V(2); PG8_BAR;
        PG8_STAGE(PG8_SB(1, 0), cB + kstep, voffB); PG8_STAGE(PG8_SA(1, 0), cA + kstep, voffA); PG8_STAGE(PG8_SB(1, 1), cB + hstep + kstep, voffB);
        PG8_WAIT_V(6); PG8_BAR;
    } else {
        PG8_STAGE(PG8_SB(0, 0), cB, voffB); PG8_STAGE(PG8_SA(0, 0), cA, voffA); PG8_STAGE(PG8_SB(0, 1), cB + hstep, voffB); PG8_STAGE(PG8_SA(0, 1), cA + hstep, voffA);
        if (wr == 1) PG8_BAR;
        PG8_WAIT_V(4); PG8_BAR;
        PG8_STAGE(PG8_SB(1, 0), cB + kstep, voffB); PG8_STAGE(PG8_SA(1, 0), cA + kstep, voffA); PG8_STAGE(PG8_SB(1, 1), cB + hstep + kstep, voffB);
        PG8_WAIT_V(6); PG8_BAR;
    }
    for (;;) {
        const bool has_next = S.next(ui + 1, nxt);
        const char* nA = has_next ? (const char*)g.A + (size_t)nxt.pm * tstep : cA; const char* nB = has_next ? (const char*)g.Bt + (size_t)nxt.pn * tstep : cB;
        for (int t = 0; t < nt; t += 2) {
            const bool last = (t == nt - 2);
            const char* a1 = cA + (size_t)(t + 1) * kstep;
            const char* a2 = last ? nA : cA + (size_t)(t + 2) * kstep; const char* b2 = last ? nB : cB + (size_t)(t + 2) * kstep;
            const char* a3 = a2 + kstep; const char* b3 = b2 + kstep;
            if (last && has_next) S.a_ready(nxt);
            if constexpr (SP2) {
            PG8_LDB(B0, 0, 0); PG8_LDB(B1, 0, 1); PG8_SCHED; PG8_LDA(At, 0, 0); PG8_STAGE(PG8_SA(1, 1), a1 + hstep, voffA);
            PG8_WAIT_V(8); PG8_WAIT_L(0); PG8_BAR; PG8_MMA(0, 0, At, B0); PG8_MMA(0, 1, At, B1); PG8_BAR; PG8_SCHED;
            PG8_LDA(At, 0, 1); PG8_STAGE(PG8_SB(0, 0), b2, voffB); PG8_STAGE(PG8_SB(0, 1), b2 + hstep, voffB); PG8_STAGE(PG8_SA(0, 0), a2, voffA);
            PG8_WAIT_V(8); PG8_WAIT_L(0); PG8_BAR; PG8_MMA(1, 0, At, B0); PG8_MMA(1, 1, At, B1); PG8_BAR; PG8_SCHED;
            PG8_LDB(B0, 1, 0); PG8_LDB(B1, 1, 1); PG8_SCHED; PG8_LDA(At, 1, 0); PG8_STAGE(PG8_SA(0, 1), a2 + hstep, voffA);
            PG8_WAIT_V(8); PG8_WAIT_L(0); PG8_BAR; PG8_MMA(0, 0, At, B0); PG8_MMA(0, 1, At, B1); PG8_BAR; PG8_SCHED;
            PG8_LDA(At, 1, 1); PG8_STAGE(PG8_SB(1, 0), b3, voffB); PG8_STAGE(PG8_SB(1, 1), b3 + hstep, voffB); PG8_STAGE(PG8_SA(1, 0), a3, voffA);
            PG8_WAIT_V(8); PG8_WAIT_L(0); PG8_BAR; PG8_MMA(1, 0, At, B0); PG8_MMA(1, 1, At, B1); PG8_BAR; PG8_SCHED;
            } else {
            PG8_LDB(B0, 0, 0); PG8_SCHED; PG8_LDA(At, 0, 0); PG8_STAGE(PG8_SA(1, 1), a1 + hstep, voffA);
            PG8_WAIT_L(8); PG8_BAR; PG8_WAIT_L(0); PG8_MMA(0, 0, At, B0); PG8_BAR; PG8_SCHED;
            PG8_LDB(B1, 0, 1); PG8_STAGE(PG8_SB(0, 0), b2, voffB);
            PG8_BAR; PG8_WAIT_L(0); PG8_MMA(0, 1, At, B1); PG8_BAR;
            PG8_LDA(At, 0, 1); PG8_STAGE(PG8_SA(0, 0), a2, voffA);
            PG8_BAR; PG8_WAIT_L(0); PG8_MMA(1, 0, At, B0); PG8_BAR; PG8_SCHED;
            PG8_STAGE(PG8_SB(0, 1), b2 + hstep, voffB);
            PG8_WAIT_V(6); PG8_BAR; PG8_MMA(1, 1, At, B1); PG8_BAR;
            PG8_LDB(B0, 1, 0); PG8_SCHED; PG8_LDA(At, 1, 0); PG8_STAGE(PG8_SA(0, 1), a2 + hstep, voffA);
            PG8_WAIT_L(8); PG8_BAR; PG8_WAIT_L(0); PG8_MMA(0, 0, At, B0); PG8_BAR; PG8_SCHED;
            PG8_LDB(B1, 1, 1); PG8_STAGE(PG8_SB(1, 0), b3, voffB);
            PG8_BAR; PG8_WAIT_L(0); PG8_MMA(0, 1, At, B1); PG8_BAR;
            PG8_LDA(At, 1, 1); PG8_STAGE(PG8_SA(1, 0), a3, voffA);
            PG8_BAR; PG8_WAIT_L(0); PG8_MMA(1, 0, At, B0); PG8_BAR; PG8_SCHED;
            PG8_STAGE(PG8_SB(1, 1), b3 + hstep, voffB);
            PG8_WAIT_V(6); PG8_BAR; PG8_MMA(1, 1, At, B1); PG8_BAR;
            }
        }
        if constexpr (ALIGN_EPI) { if (wr == 0) PG8_BAR; }
        { E(acc, cur, wr, wc, fr, fq, esc, tid); S.done(cur); }
        if (!has_next) break;
#pragma unroll
        for (int a = 0; a < 2; ++a)
#pragma unroll
            for (int b = 0; b < 2; ++b)
#pragma unroll
                for (int m = 0; m < 4; ++m)
#pragma unroll
                    for (int n = 0; n < 2; ++n) acc[a][b][m][n] = (f32x4){0.f, 0.f, 0.f, 0.f};
        cur = nxt; cA = nA; cB = nB; ++ui;
        if constexpr (ALIGN_EPI) { if (wr == 1) PG8_BAR; }
    }
    PG8_WAIT_V(0);
    if constexpr (!ALIGN_EPI) { if (wr == 0) PG8_BAR; }
    PG8_BAR;
#undef PG8_SA
#undef PG8_SB
#undef PG8_STAGE
#undef PG8_LDA
#undef PG8_LDB
#undef PG8_MMA
#undef PG8_WAIT_V
#undef PG8_WAIT_L
#undef PG8_BAR
#undef PG8_SCHED
}
}

typedef float f32x4 __attribute__((ext_vector_type(4)));
typedef short bf16x8 __attribute__((ext_vector_type(8)));


struct RsLoad { unsigned long long v[16]; };
__host__ __device__ constexpr int rs_off(unsigned buf) { return buf ? 9216 : 0; }
__device__ __forceinline__ void rs_issue(const float* ssq, int pm, int tid, RsLoad& r) {
    asm volatile("" : "+v"(tid));
#pragma unroll
    for (int j = 0; j < 8; ++j) { const gu64* p = (const gu64*)(ssq + ((size_t)j * MP + pm * 256 + tid) * 4);
#pragma unroll
        for (int h = 0; h < 2; ++h) r.v[2 * j + h] = __hip_atomic_load(p + h, RLX_AGENT); }
}
__device__ __forceinline__ void rs_finish(const RsLoad& r, LAS unsigned char* esc, unsigned buf, int tid) {
    float s = 0.f;
#pragma unroll
    for (int i = 0; i < 16; ++i) s += __builtin_bit_cast(float, (unsigned)r.v[i]) + __builtin_bit_cast(float, (unsigned)(r.v[i] >> 32));
    asm volatile("" : "+v"(tid));
    ((LAS float*)(esc + rs_off(buf)))[tid] = rsqrtf(s * (1.0f / DM) + EPS);
}

struct EpiProj {
    static constexpr bool PERM = false, AFTER_DRAIN = false;
    unsigned char* ws_; float* out_; const float* gq; const float* gk; int l; int rsoff;
    __device__ __forceinline__ void operator()(f32x4 (&acc)[2][2][4][2], const pg8::Unit& u, int wr, int wc, int fr, int fq, LAS unsigned char* esc, int tid) const {
        asm volatile("" : "+v"(fr), "+v"(fq), "+v"(tid));
        size_t z_ = 0; asm volatile("" : "+s"(z_)); unsigned char* ws = ws_ + z_;
        const float* ssq = (const float*)(ws + WS_SSQ); const float* ropec = (const float*)(ws + WS_ROPE); const float* ropes = ropec + ROPE_N;
        bf16* Q = (bf16*)(ws + WS_Q); bf16* K = (bf16*)(ws + WS_K); bf16* VT = (bf16*)(ws + WS_VT); float* U = (float*)(ws + WS_U); float* XP = (float*)(ws + WS_XP);
        float* ksn = (float*)(ws + WS_KSN); float* vsn = ksn + NSAMP * 256;
        float* out_pk = out_ + O_PK + (size_t)l * NBATCH * 128 * 256; float* out_pv = out_ + O_PV + (size_t)l * NBATCH * 128 * 256;
        const rsrc_t rs_ = ws_rsrc(ws);
        const LAS float* rsT = (const LAS float*)(esc + rsoff);
        LAS float* hss = (LAS float*)(esc + 1024);
        const int pn = u.pn;
#pragma unroll
        for (int ai = 0; ai < 2; ++ai)
#pragma unroll
            for (int m = 0; m < 4; ++m) { const float rsv = rsT[ai * 128 + wr * 64 + m * 16 + fr];
#pragma unroll
                for (int bj = 0; bj < 2; ++bj)
#pragma unroll
                    for (int n = 0; n < 2; ++n) acc[ai][bj][m][n] *= rsv; }
        if (pn <= 4) {
#pragma unroll
            for (int ai = 0; ai < 2; ++ai)
#pragma unroll
                for (int m = 0; m < 4; ++m)
#pragma unroll
                    for (int bj = 0; bj < 2; ++bj) { const f32x4 a = acc[ai][bj][m][0], b = acc[ai][bj][m][1];
                        float s = (a[0] * a[0] + a[1] * a[1]) + (a[2] * a[2] + a[3] * a[3]) + (b[0] * b[0] + b[1] * b[1]) + (b[2] * b[2] + b[3] * b[3]);
                        s += __shfl_xor(s, 16); s += __shfl_xor(s, 32);
                        if (fq == 0) hss[(bj * 256 + ai * 128 + wr * 64 + m * 16 + fr) * 4 + wc] = s; }
            WG_BAR();
            const float* g = (pn < 4) ? gq : gk; const float osc = (pn < 4) ? QSCALE : 1.0f;
            f32x4 gv[2];
#pragma unroll
            for (int n = 0; n < 2; ++n) gv[n] = *(const f32x4*)(g + wc * 32 + n * 16 + 4 * fq);
#pragma unroll
            for (int ai = 0; ai < 2; ++ai)
#pragma unroll
                for (int m = 0; m < 4; ++m) {
                    const int rl = ai * 128 + wr * 64 + m * 16 + fr, r = u.pm * 256 + rl;
                    const bool samp = r >= SROW0, pad = r >= MR;
                    const int b = (r >= TT && !samp) ? 1 : 0, t = r - b * TT;
                    const int pidx = samp ? ROPE_SAMPLE_IDX : t;
                    f32x4 cs = {1.f, 1.f, 1.f, 1.f}, sn = {0.f, 0.f, 0.f, 0.f};
                    if (wc == 0 && !pad) { cs = *(const f32x4*)(ropec + (size_t)pidx * 16 + 4 * fq); sn = *(const f32x4*)(ropes + (size_t)pidx * 16 + 4 * fq); }
#pragma unroll
                    for (int bj = 0; bj < 2; ++bj) {
                        const f32x4 hv = *(const LAS f32x4*)(hss + (bj * 256 + rl) * 4);
                        const float hn = rsqrtf(((hv[0] + hv[1]) + (hv[2] + hv[3])) * (1.0f / 128.0f) + EPS);
                        f32x4 x1 = acc[ai][bj][m][0] * hn * gv[0], x2 = acc[ai][bj][m][1] * hn * gv[1];
                        if (wc == 0) { const f32x4 o1 = x1 * cs - x2 * sn, o2 = x2 * cs + x1 * sn; x1 = o1; x2 = o2; }
                        x1 = x1 * osc; x2 = x2 * osc;
                        const int cl = bj * 128 + wc * 32 + 4 * fq;
                        { const int od = fq & 1; const unsigned a0 = pk2(x1[0], x1[1]), a1 = pk2(x1[2], x1[3]), b0 = pk2(x2[0], x2[1]), b1 = pk2(x2[2], x2[3]);
                          const unsigned s0 = od ? a0 : b0, s1 = od ? a1 : b1; const unsigned r0 = (unsigned)__shfl_xor((int)s0, 16), r1 = (unsigned)__shfl_xor((int)s1, 16);
                          const v4u w16 = od ? (v4u){r0, r1, b0, b1} : (v4u){a0, a1, r0, r1};
                          const int cl16 = bj * 128 + wc * 32 + 4 * (fq & ~1) + (od ? 16 : 0);
                          if (pn < 4) ST16(rs_, WS_Q + ((size_t)r * 1024 + pn * 256 + cl16) * 2, w16); else ST16(rs_, WS_K + ((size_t)r * 256 + cl16) * 2, w16); }
                        if (pn == 4) {
                            if (samp && !pad) { const size_t o = WS_KSN + ((size_t)(r - SROW0) * 256 + cl) * 4; ST16(rs_, o, x1); ST16(rs_, o + 64, x2); }
                            else if (!samp && t >= TT - 128) { float* o = out_pk + ((size_t)(b * 128 + (t - (TT - 128))) * 256) + cl; *(f32x4*)o = x1; *(f32x4*)(o + 16) = x2; } }
                    }
                }
        } else if (pn == 5) {
#pragma unroll
            for (int ai = 0; ai < 2; ++ai)
#pragma unroll
                for (int m = 0; m < 4; ++m) {
                    const int rl = ai * 128 + wr * 64 + m * 16 + fr, r = u.pm * 256 + rl;
                    const bool samp = r >= SROW0, pad = r >= MR;
                    const int b = (r >= TT && !samp) ? 1 : 0, t = r - b * TT;
                    const int tpos = (t & ~15) + perm16(t & 15);
#pragma unroll
                    for (int bj = 0; bj < 2; ++bj)
#pragma unroll
                        for (int n = 0; n < 2; ++n) { const f32x4 x = acc[ai][bj][m][n]; const int d = wc * 32 + n * 16 + 4 * fq;
                            if (!samp) { const size_t vo = WS_VT + (((size_t)((b * 2 + bj) * 128 + d)) * TPV + tpos) * 2;
#pragma unroll
                                for (int j = 0; j < 4; ++j) ST2(rs_, vo + (size_t)j * TPV * 2, pk2(x[j], 0.f) & 0xffffu);
                                if (t >= TT - 128) *(f32x4*)(out_pv + ((size_t)(b * 128 + (t - (TT - 128))) * 256) + bj * 128 + d) = x; }
                            else if (!pad) ST16(rs_, WS_KSN + ((size_t)NSAMP * 256 + (size_t)(r - SROW0) * 256 + bj * 128 + d) * 4, x); }
                }
        } else if (pn < 8) {
#pragma unroll
            for (int ai = 0; ai < 2; ++ai)
#pragma unroll
                for (int m = 0; m < 4; ++m) { const size_t ro = WS_U + ((size_t)(u.pm * 256 + ai * 128 + wr * 64 + m * 16 + fr) * 512 + (pn - 6) * 256 + wc * 32 + 4 * fq) * 2;
#pragma unroll
                    for (int bj = 0; bj < 2; ++bj)
#pragma unroll
                        for (int n = 0; n < 2; ++n) { const f32x4 x = acc[ai][bj][m][n]; ST8(rs_, ro + (size_t)(bj * 128 + n * 16) * 2, ((v2u){pk2(x[0], x[1]), pk2(x[2], x[3])})); } }
        } else {
            const size_t dsto = WS_XP + (size_t)(pn - 8) * 256 * 4;
#pragma unroll
            for (int ai = 0; ai < 2; ++ai)
#pragma unroll
                for (int m = 0; m < 4; ++m) { const size_t ro = dsto + ((size_t)(u.pm * 256 + ai * 128 + wr * 64 + m * 16 + fr) * 512 + wc * 32 + 4 * fq) * 4;
#pragma unroll
                    for (int bj = 0; bj < 2; ++bj)
#pragma unroll
                        for (int n = 0; n < 2; ++n) ST16(rs_, ro + (size_t)(bj * 128 + n * 16) * 4, acc[ai][bj][m][n]); }
        }
    }
};

struct EpiRes {
    static constexpr bool PERM = true, AFTER_DRAIN = false;
    unsigned char* ws_; float* out; int last; int yinit;
    __device__ __forceinline__ void operator()(f32x4 (&acc)[2][2][4][2], const pg8::Unit& u, int wr, int wc, int fr, int fq, LAS unsigned char* esc, int tid) const {
        asm volatile("" : "+v"(fr), "+v"(fq), "+v"(tid));
        size_t z_ = 0; asm volatile("" : "+s"(z_)); unsigned char* ws = ws_ + z_;
        const bf16* XB = (const bf16*)(ws + WS_XB); const rsrc_t rs_ = ws_rsrc(ws);
        v4u xb[2][4][2];
#pragma unroll
        for (int ai = 0; ai < 2; ++ai)
#pragma unroll
            for (int m = 0; m < 4; ++m) { const bf16* xp = XB + (size_t)(u.pm * 256 + ai * 128 + wr * 64 + m * 16 + fr) * DM + u.pn * 256 + wc * 32 + 8 * fq;
#pragma unroll
                for (int bj = 0; bj < 2; ++bj) xb[ai][m][bj] = *(const v4u*)(xp + bj * 128); }
#pragma unroll
        for (int ai = 0; ai < 2; ++ai)
#pragma unroll
            for (int m = 0; m < 4; ++m) {
                const int r = u.pm * 256 + ai * 128 + wr * 64 + m * 16 + fr; const int c0 = u.pn * 256 + wc * 32 + 8 * fq;
                const size_t eo = (size_t)r * DM + c0; float s = 0.f;
                f32x4 v[2][2];
#pragma unroll
                for (int bj = 0; bj < 2; ++bj) { const v4u w = xb[ai][m][bj];
                    const f32x4 x0 = {__builtin_bit_cast(float, w.x << 16), __builtin_bit_cast(float, w.x & 0xffff0000u), __builtin_bit_cast(float, w.y << 16), __builtin_bit_cast(float, w.y & 0xffff0000u)};
                    const f32x4 x1 = {__builtin_bit_cast(float, w.z << 16), __builtin_bit_cast(float, w.z & 0xffff0000u), __builtin_bit_cast(float, w.w << 16), __builtin_bit_cast(float, w.w & 0xffff0000u)};
                    v[bj][0] = x0 + acc[ai][bj][m][0]; v[bj][1] = x1 + acc[ai][bj][m][1];
#pragma unroll
                    for (int n = 0; n < 2; ++n) { const f32x4 q = v[bj][n] * v[bj][n]; s += (q[0] + q[1]) + (q[2] + q[3]); } }
                if (!last) {
#pragma unroll
                    for (int bj = 0; bj < 2; ++bj)
                        ST16(rs_, WS_XB + (eo + bj * 128) * 2, ((v4u){pk2(v[bj][0][0], v[bj][0][1]), pk2(v[bj][0][2], v[bj][0][3]), pk2(v[bj][1][0], v[bj][1][1]), pk2(v[bj][1][2], v[bj][1][3])}));
                    s += __shfl_xor(s, 16); s += __shfl_xor(s, 32);
                    if (fq == 0) ST4(rs_, WS_SSQ + (((size_t)u.pn * MP + r) * 4 + wc) * 4, s);
                    if (yinit && r < MR) { const bool samp = r >= SROW0; const size_t yo = samp ? O_YS + (size_t)(r - SROW0) * DM + c0 : O_YP + ((size_t)NSEQ + (r - TT - NMETA)) * DM + c0;
                        const rsrc_t ro_ = __builtin_amdgcn_make_buffer_rsrc(out, 0, (int)(O_END * 4), 0x00020000);
#pragma unroll
                        for (int bj = 0; bj < 2; ++bj)
#pragma unroll
                            for (int n = 0; n < 2; ++n) ST16(ro_, (yo + bj * 128 + n * 4) * 4, v[bj][n]); }
                } else {
                    const bool samp = r >= SROW0, pad = r >= MR; const int b = (r >= TT && !samp) ? 1 : 0, t = r - b * TT;
                    float* op = nullptr;
                    if (samp) { if (!pad) op = out + O_YS + (size_t)(r - SROW0) * DM + c0; } else if (t >= NMETA) op = out + O_YP + ((size_t)b * NSEQ + (t - NMETA)) * DM + c0;
                    if (op) {
#pragma unroll
                        for (int bj = 0; bj < 2; ++bj)
#pragma unroll
                            for (int n = 0; n < 2; ++n) *(f32x4*)(op + bj * 128 + n * 4) = v[bj][n]; }
                }
            }
    }
};

struct EpiAtom {
    static constexpr bool PERM = true, AFTER_DRAIN = false;
    float* out;
    __device__ __forceinline__ void operator()(f32x4 (&acc)[2][2][4][2], const pg8::Unit& u, int wr, int wc, int fr, int fq, LAS unsigned char* esc, int tid) const {
        asm volatile("" : "+v"(fr), "+v"(fq), "+v"(tid));
        if (wr != 0) return;
#pragma unroll
        for (int m = 0; m < 4; ++m) { const int r = u.pm * 256 + m * 16 + fr; const int c0 = u.pn * 256 + wc * 32 + 8 * fq;
            const bool samp = r >= SROW0; float* op = samp ? out + O_YS + (size_t)(r - SROW0) * DM + c0 : out + O_YP + ((size_t)NSEQ + (r - TT - NMETA)) * DM + c0;
            if (r < MR) {
#pragma unroll
                for (int bj = 0; bj < 2; ++bj)
#pragma unroll
                    for (int n = 0; n < 2; ++n)
#pragma unroll
                        for (int j = 0; j < 4; ++j) __hip_atomic_fetch_add(op + bj * 128 + n * 4 + j, acc[0][bj][m][n][j], RLX_AGENT); } }
    }
};

struct EpiFfn1 {
    static constexpr bool PERM = true, AFTER_DRAIN = false;
    unsigned char* ws_; int rsoff;
    __device__ __forceinline__ void operator()(f32x4 (&acc)[2][2][4][2], const pg8::Unit& u, int wr, int wc, int fr, int fq, LAS unsigned char* esc, int tid) const {
        asm volatile("" : "+v"(fr), "+v"(fq), "+v"(tid));
        size_t z_ = 0; asm volatile("" : "+s"(z_)); unsigned char* ws = ws_ + z_;
        const rsrc_t rs_ = ws_rsrc(ws);
        const LAS float* rsT = (const LAS float*)(esc + rsoff);
#pragma unroll
        for (int ai = 0; ai < 2; ++ai)
#pragma unroll
            for (int m = 0; m < 4; ++m) { const int rl = ai * 128 + wr * 64 + m * 16 + fr; const float rsv = rsT[rl];
                const size_t ho = WS_H + ((size_t)(u.pm * 256 + rl) * DFF + u.pn * 256 + wc * 32 + 8 * fq) * 2;
#pragma unroll
                for (int bj = 0; bj < 2; ++bj) { f32x4 v0 = acc[ai][bj][m][0] * rsv, v1 = acc[ai][bj][m][1] * rsv;
#pragma unroll
                    for (int j = 0; j < 4; ++j) { const float a = fmaxf(v0[j], 0.f), b = fmaxf(v1[j], 0.f); v0[j] = a * a; v1[j] = b * b; }
                    ST16(rs_, ho + bj * 256, ((v4u){pk2(v0[0], v0[1]), pk2(v0[2], v0[3]), pk2(v1[0], v1[1]), pk2(v1[2], v1[3])})); } }
    }
};

#define XB_TMO      128
#define XB_XCNT(j)  (256  + 64 * (j))
#define XB_XSUB(j)  (1280 + 64 * (j))
#define XB_XGEN(j)  (2304 + 64 * (j))
#define XB_TOP      3328
#define XB_TOPGEN   3392
#define XCD_BAR_WORDS 3456
#define XB_SPIN_CAP (1u << 18)
__device__ __forceinline__ unsigned xb_ld(unsigned* p)              { return __hip_atomic_load(p, __ATOMIC_RELAXED, __HIP_MEMORY_SCOPE_AGENT); }
__device__ __forceinline__ unsigned xb_add(unsigned* p, unsigned v) { return __hip_atomic_fetch_add(p, v, __ATOMIC_RELAXED, __HIP_MEMORY_SCOPE_AGENT); }
__device__ __forceinline__ unsigned xb_xcc_id() { return (unsigned)__builtin_amdgcn_s_getreg((3 << 11) | 20) & 0xFu; }
#define XB_SPIN(cond, bar) do { unsigned _sp = 0; while (cond) { __builtin_amdgcn_s_sleep(1); \
    if ((++_sp & 255u) == 0u) { if (xb_ld(&(bar)[XB_TMO])) break; if (_sp > XB_SPIN_CAP) { atomicAdd(&(bar)[XB_TMO], 1u); break; } } } } while (0)

struct XcdBarrier {
    unsigned* bar; unsigned x;
    volatile LAS unsigned* st;
};

__device__ __forceinline__ XcdBarrier xcd_barrier_post(unsigned* bar, volatile LAS unsigned* st) {
    XcdBarrier b; b.bar = bar; b.x = xb_xcc_id(); b.st = st;
    if (threadIdx.x == 0) (void)xb_add(&bar[XB_XCNT(b.x)], 1u);
    return b;
}
__device__ __forceinline__ void xcd_barrier_complete(unsigned* bar, unsigned x, unsigned& nloc, unsigned& nx) {
    const unsigned G = gridDim.x * gridDim.y * gridDim.z;
    unsigned sum, cnt, mine, sp = 0u;
    for (;;) {
        sum = 0u; cnt = 0u; mine = 0u;
#pragma unroll
        for (unsigned j = 0; j < 16; ++j) { const unsigned c = xb_ld(&bar[XB_XCNT(j)]); sum += c; cnt += (c > 0u) ? 1u : 0u; mine = (j == x) ? c : mine; }
        if (sum == G) break;
        __builtin_amdgcn_s_sleep(1);
        if ((++sp & 255u) == 0u) { if (xb_ld(&bar[XB_TMO])) break; if (sp > XB_SPIN_CAP) { atomicAdd(&bar[XB_TMO], 1u); break; } }
    }
    nloc = mine > 0u ? mine : 1u; nx = cnt > 0u ? cnt : 1u;
}

__device__ __forceinline__ void xcd_barrier(const XcdBarrier& b) {
    asm volatile("s_waitcnt vmcnt(0)" ::: "memory");
    __syncthreads();
    if (threadIdx.x == 0) {
        unsigned* bar = b.bar;
        __builtin_amdgcn_s_waitcnt(0);
        unsigned nloc = b.st[0], nx = b.st[1];
        if (nloc == 0u) { xcd_barrier_complete(bar, b.x, nloc, nx); b.st[0] = nloc; b.st[1] = nx; }
        const unsigned old = xb_add(&bar[XB_XSUB(b.x)], 1u);
        const unsigned gen = old / nloc;
        if (old + 1u == (gen + 1u) * nloc) {
            __builtin_amdgcn_fence(__ATOMIC_RELEASE, "agent");
            asm volatile("s_waitcnt vmcnt(0)" ::: "memory");
            const unsigned og = xb_add(&bar[XB_TOP], 1u);
            const unsigned tg = og / nx;
            if (og + 1u == (tg + 1u) * nx) xb_add(&bar[XB_TOPGEN], 1u);
            else XB_SPIN(xb_ld(&bar[XB_TOPGEN]) == tg, bar);
            __builtin_amdgcn_fence(__ATOMIC_ACQUIRE, "agent");
            xb_add(&bar[XB_XGEN(b.x)], 1u);
            asm volatile("s_waitcnt vmcnt(0)" ::: "memory");
        } else {
            XB_SPIN(xb_ld(&bar[XB_XGEN(b.x)]) == gen, bar);
            __builtin_amdgcn_fence(__ATOMIC_ACQUIRE, "agent");
            asm volatile("s_waitcnt vmcnt(0)" ::: "memory");
        }
    }
    __syncthreads();
}

struct Frame {
    LAS unsigned char* lds;
    volatile LAS unsigned* MISC;
    gu32* ctl;
    int wave, vcu, G;
    __device__ __forceinline__ int lane() const { int l; asm volatile("v_mbcnt_lo_u32_b32 %0, -1, 0\n\tv_mbcnt_hi_u32_b32 %0, -1, %0" : "=v"(l)); return l; }
    __device__ __forceinline__ int tid() const { return wave * 64 + lane(); }
    float* out; unsigned char* ws;
};
#define IN_XPROMPT 0
#define IN_XSAMPLE 1
#define IN_CACHEK 2
#define IN_CACHEV 3
#define IN_SSMRE 4
#define IN_SSMIM 5
#define IN_SPOOL 6
#define IN_META 7
#define IN_GMIX 8
#define IN_WIN 9
#define IN_GQ 10
#define IN_GK 11
#define IN_SINKS 12
#define IN_ARE 13
#define IN_AIM 14
#define IN_LOGDT 15
#define IN_BRE 16
#define IN_BIM 17
#define IN_CRE 18
#define IN_CIM 19
#define IN_DSKIP 20
#define IN_WGLU 21
#define IN_BGLU 22
#define IN_WPOOL 23
#define IN_PSCALE 24
#define IN_GOA 25
#define IN_GOS 26
#define IN_GOP 27
#define IN_WOUT 28
#define IN_GFFN 29
#define IN_WFF1 30
#define IN_WFF2 31
struct Args { const float* in[32]; float* out; unsigned char* ws; int ph_lo, ph_hi; };
static_assert(sizeof(Args) == 32 * 8 + 8 + 8 + 8, "Args has no padding");

template <int FRAG = 0>
__device__ __forceinline__ void p0_transpose_item(const float* W, int K, int N, bf16* WT, const float* gain, LAS float* scr, int item, int lane) {
    const int nblk = N / 32, kb = item / nblk, nb = item % nblk, k0 = 64 * kb, n0 = 32 * nb;
    float wv[32];
#pragma unroll
    for (int i = 0; i < 32; ++i) wv[i] = W[(size_t)(k0 + 2 * i + (lane >> 5)) * N + n0 + (lane & 31)];
    if (gain) {
        const float gv = gain[k0 + lane]; const bool hi = lane >= 32;
#pragma unroll
        for (int i = 0; i < 32; ++i) { const float g0 = __builtin_bit_cast(float, __builtin_amdgcn_readlane(__builtin_bit_cast(int, gv), 2 * i)), g1 = __builtin_bit_cast(float, __builtin_amdgcn_readlane(__builtin_bit_cast(int, gv), 2 * i + 1));
            wv[i] *= hi ? g1 : g0; }
    }
#pragma unroll
    for (int i = 0; i < 32; ++i) scr[(2 * i + (lane >> 5)) * 33 + (lane & 31)] = wv[i];
    LDS_WAIT(); asm volatile("" ::: "memory");
    const int c = lane & 7;
#pragma unroll
    for (int j = 0; j < 4; ++j) { const int n = (lane >> 3) + 8 * j; const LAS float* s = scr + (8 * c) * 33 + n;
        v4u o; o.x = pk2(s[0 * 33], s[1 * 33]); o.y = pk2(s[2 * 33], s[3 * 33]); o.z = pk2(s[4 * 33], s[5 * 33]); o.w = pk2(s[6 * 33], s[7 * 33]);
        const int nn = n0 + n, kk = k0 + 8 * c;
        if (FRAG == 1) *(GAS v4u*)(WT + ((size_t)((((nn >> 6) * 16 + (kk >> 5)) * 4 + ((nn >> 4) & 3)) * 64 + ((kk >> 3) & 3) * 16 + (nn & 15))) * 8) = o;
        else if (FRAG == 2) *(GAS v4u*)(WT + ((size_t)(((kk >> 5) * 8 + (nn >> 4)) * 64 + ((kk >> 3) & 3) * 16 + (nn & 15))) * 8) = o;
        else *(GAS v4u*)(WT + (size_t)nn * K + kk) = o; }
    LDS_WAIT(); asm volatile("" ::: "memory");
}
__device__ __forceinline__ void sincos_d(double x, double& s, double& c) {
    const double TWO_PI = 6.283185307179586476925286766559;
    const double k = rint(x * (1.0 / TWO_PI)); const double r = fma(-k, TWO_PI, x), r2 = r * r;
    const double fs[14] = {0.16666666666666666, 0.05, 0.023809523809523808, 0.013888888888888888, 0.00909090909090909, 0.00641025641025641, 0.004761904761904762, 0.003676470588235294,
                           0.0029239766081871343, 0.002380952380952381, 0.001976284584980237, 0.0016666666666666668, 0.0014245014245014246, 0.0012315270935960591};
    const double fc[14] = {0.5, 0.08333333333333333, 0.03333333333333333, 0.017857142857142856, 0.011111111111111112, 0.007575757575757576, 0.005494505494505495, 0.004166666666666667,
                           0.0032679738562091504, 0.002631578947368421, 0.0021645021645021645, 0.0018115942028985507, 0.0015384615384615385, 0.0013227513227513227};
    double ts = r, tc = 1.0; s = r; c = 1.0;
#pragma unroll
    for (int i = 0; i < 14; ++i) { ts *= -r2 * fs[i]; s += ts; tc *= -r2 * fc[i]; c += tc; }
}
__device__ __forceinline__ double exp_small(double x) {
    double t = 1.0, e = 1.0;
#pragma unroll
    for (int i = 1; i <= 14; ++i) { t *= x * (1.0 / i); e += t; }
    return e;
}
__device__ __forceinline__ void p0_prologue(const Args& AR, Frame& F) {
    LAS float* scr = (LAS float*)(F.lds + F.wave * 16384);
    const int gw = F.vcu * 8 + F.wave, NGW = F.G * 8, lane = F.lane();
    unsigned char* ws = F.ws;
    constexpr int I_IN = (DM / 64) * (INW / 32), I_OUT = (DM / 64) * (DM / 32), I_1 = (DM / 64) * (DFF / 32), I_2 = (DFF / 64) * (DM / 32), I_GLU = (512 / 64) * (512 / 32), I_POOL = 4 * 2 * 4;
    constexpr int I_LAYER = I_IN + I_OUT + I_1 + I_2 + I_GLU + I_POOL;
    for (int it = gw; it < NLAYER * I_LAYER; it += NGW) {
        const int l = it / I_LAYER; int r = it % I_LAYER;
        if (r < I_IN) { p0_transpose_item(AR.in[IN_WIN] + (size_t)l * DM * INW, DM, INW, (bf16*)(ws + WS_WIN) + (size_t)l * INW * DM, AR.in[IN_GMIX] + l * DM, scr, r, lane); continue; } r -= I_IN;
        if (r < I_OUT) { const int k0 = 64 * (r / (DM / 32));
            const float* g = (k0 < 1024) ? AR.in[IN_GOA] + l * 1024 : (k0 < 1536) ? AR.in[IN_GOS] + l * 512 - 1024 : AR.in[IN_GOP] + l * 512 - 1536;
            p0_transpose_item(AR.in[IN_WOUT] + (size_t)l * DM * DM, DM, DM, (bf16*)(ws + WS_WOUT) + (size_t)l * DM * DM, g, scr, r, lane); continue; } r -= I_OUT;
        if (r < I_1) { p0_transpose_item(AR.in[IN_WFF1] + (size_t)l * DM * DFF, DM, DFF, (bf16*)(ws + WS_W1) + (size_t)l * DFF * DM, AR.in[IN_GFFN] + l * DM, scr, r, lane); continue; } r -= I_1;
        if (r < I_2) { p0_transpose_item(AR.in[IN_WFF2] + (size_t)l * DFF * DM, DFF, DM, (bf16*)(ws + WS_W2) + (size_t)l * DM * DFF, nullptr, scr, r, lane); continue; } r -= I_2;
        if (r < I_GLU) { p0_transpose_item<1>(AR.in[IN_WGLU] + (size_t)l * 512 * 512, 512, 512, (bf16*)(ws + WS_WGLU) + (size_t)l * 512 * 512, nullptr, scr, r, lane); continue; } r -= I_GLU;
        { const int g = r / 8; p0_transpose_item<2>(AR.in[IN_WPOOL] + ((size_t)l * 4 + g) * 128 * 128, 128, 128, (bf16*)(ws + WS_WPOOL) + ((size_t)l * 4 + g) * 128 * 128, nullptr, scr, r % 8, lane); }
    }
    bf16* XB = (bf16*)(ws + WS_XB); float* SSQ = (float*)(ws + WS_SSQ);
    for (int m = gw; m < MP; m += NGW) {
        const float* src = nullptr;
        if (m < SROW0) { const int b = m >= TT ? 1 : 0, t = m - b * TT; src = (t < NMETA) ? AR.in[IN_META] + (size_t)t * DM : AR.in[IN_XPROMPT] + ((size_t)b * NSEQ + (t - NMETA)) * DM; }
        else if (m < MR) src = AR.in[IN_XSAMPLE] + (size_t)(m - SROW0) * DM;
        float s = 0.f;
        f32x4 xv[8];
#pragma unroll
        for (int j = 0; j < 8; ++j) { xv[j] = (f32x4){0.f, 0.f, 0.f, 0.f}; if (src) xv[j] = *(const f32x4*)(src + j * 256 + lane * 4); }
#pragma unroll
        for (int j = 0; j < 8; ++j) { const f32x4 v = xv[j];
            s += (v[0] * v[0] + v[1] * v[1]) + (v[2] * v[2] + v[3] * v[3]);
            *(v2u*)(XB + (size_t)m * DM + j * 256 + lane * 4) = (v2u){pk2(v[0], v[1]), pk2(v[2], v[3])}; }
        s = wave_sum(s);
        if (lane < 32) SSQ[((size_t)(lane >> 2) * MP + m) * 4 + (lane & 3)] = (lane == 0) ? s : 0.f;
    }
    const int gt = gw * 64 + lane, NGT = NGW * 64;
    for (int id = gt; id < NLAYER * 32 * 64; id += NGT) {
        const int l = id >> 11, g = (id >> 6) & 31, n = id & 63;
        unsigned char* tb = ws + WS_TAB + (size_t)l * TB_LAYER;
        const double dt = (double)expf(AR.in[IN_LOGDT][l * 32 + g]);
        const double ar = (double)AR.in[IN_ARE][id], ai = (double)AR.in[IN_AIM][id];
        const double mag = exp_small(dt * ar); double sn, cs; sincos_d(dt * ai, sn, cs);
        const double abr = mag * cs, abi = mag * sn, den = ar * ar + ai * ai;
        const double fr = ((abr - 1.0) * ar + abi * ai) / den, fi = (abi * ar - (abr - 1.0) * ai) / den;
        ((float*)(tb + TB_ABR))[g * 64 + n] = (float)abr; ((float*)(tb + TB_ABI))[g * 64 + n] = (float)abi;
        const float* Br = AR.in[IN_BRE] + (size_t)id * 16; const float* Bi = AR.in[IN_BIM] + (size_t)id * 16;
        const float* Cr = AR.in[IN_CRE] + ((size_t)(l * 32 + g) * 16) * 64 + n; const float* Ci = AR.in[IN_CIM] + ((size_t)(l * 32 + g) * 16) * 64 + n;
        float brv[16], biv[16], crv[16], civ[16];
#pragma unroll
        for (int c = 0; c < 16; ++c) { brv[c] = Br[c]; biv[c] = Bi[c]; crv[c] = Cr[c * 64]; civ[c] = Ci[c * 64]; }
        float* bbr = (float*)(tb + TB_BBR) + (size_t)(g * 64 + n) * 16; float* bbi = (float*)(tb + TB_BBI) + (size_t)(g * 64 + n) * 16;
        bf16* bbt = (bf16*)(tb + TB_PM) + (size_t)g * 128 * 16;
#pragma unroll
        for (int c = 0; c < 16; ++c) { const double br = brv[c], bi = biv[c]; const float vr = (float)(fr * br - fi * bi), vi = (float)(fr * bi + fi * br); bbr[c] = vr; bbi[c] = vi;
            bbt[n * 16 + c] = (bf16)(pk2(vr, 0.f) & 0xffffu); bbt[(64 + n) * 16 + c] = (bf16)(pk2(vi, 0.f) & 0xffffu); }
        double pr = abr, pi = abi;
        for (int t = 0; t < 64; ++t) {
            if (t == 15) { ((float*)(tb + TB_A16R))[g * 64 + n] = (float)pr; ((float*)(tb + TB_A16I))[g * 64 + n] = (float)pi; }
            if (t == 31) { ((float*)(tb + TB_A32R))[g * 64 + n] = (float)pr; ((float*)(tb + TB_A32I))[g * 64 + n] = (float)pi; }
            if (t == 63) { ((float*)(tb + TB_ALR))[g * 64 + n] = (float)pr; ((float*)(tb + TB_ALI))[g * 64 + n] = (float)pi; }
            const double nr = pr * abr - pi * abi, ni = pr * abi + pi * abr; pr = nr; pi = ni;
        }
        bf16* CmT = (bf16*)(tb + TB_CMT) + (size_t)g * 16 * 128;
#pragma unroll
        for (int c = 0; c < 16; ++c) { CmT[c * 128 + n] = (bf16)(pk2(crv[c], 0.f) & 0xffffu); CmT[c * 128 + 64 + n] = (bf16)(pk2(-civ[c], 0.f) & 0xffffu); }
    }
    float* rc = (float*)(ws + WS_ROPE); float* rs_ = rc + ROPE_N;
    for (int id = gt; id < (int)ROPE_N; id += NGT) {
        const int p = id >> 4, i = id & 15; const double pos = (p == ROPE_SAMPLE_IDX) ? 16384.0 : (double)p;
        double inv = 1.0;
        for (int k = 0; k < i; ++k) inv *= 0.44036660267178046;
        double sn, cs; sincos_d(pos * inv, sn, cs);
        rc[id] = (float)cs; rs_[id] = (float)sn;
    }
}

__device__ __forceinline__ void attn_unit(const Args& AR, Frame& F, int l, int b, int i) {
    int lane_ = F.lane(); asm volatile("" : "+v"(lane_));
    size_t z_ = 0; asm volatile("" : "+s"(z_)); unsigned char* ws = F.ws + z_;
    const int lane = lane_, h = F.wave, c = lane & 31, hh = lane >> 5, kvh = h >> 2;
    const int t0 = 32 * i; const size_t rb = (size_t)b * TT;
#if PROBE && (PROBE_KIND == 11 || PROBE_KIND == 12)
    const unsigned long long ta0 = __builtin_amdgcn_s_memrealtime();
#endif
    const bf16* Q = (const bf16*)(ws + WS_Q); const bf16* K = (const bf16*)(ws + WS_K); const bf16* VT = (const bf16*)(ws + WS_VT);
    LAS float* ex = (LAS float*)(F.lds + ESC_OFF);
    bf16x8 qf[8];
    { const bf16* qp = Q + (rb + t0 + c) * 1024 + 128 * h + 8 * hh;
#pragma unroll
      for (int ks = 0; ks < 8; ++ks) qf[ks] = *(const bf16x8*)(qp + 16 * ks); }
    const int kt0 = (t0 >= 128) ? 0 : (4 - i);
    f32x16 S[5];
    bf16x8 kf[5][8];
#define ATT_LOADK(KT) do { if ((KT) >= kt0) { const bf16* kp_ = K + (rb + (t0 - 128 + 32 * (KT)) + c) * 256 + 128 * kvh + 8 * hh; \
        _Pragma("unroll") for (int ks_ = 0; ks_ < 8; ++ks_) kf[KT][ks_] = *(const bf16x8*)(kp_ + 16 * ks_); } } while (0)
    ATT_LOADK(0); ATT_LOADK(1); ATT_LOADK(2);
#pragma unroll
    for (int kt = 0; kt < 5; ++kt) {
#pragma unroll
        for (int r = 0; r < 16; ++r) S[kt][r] = -INFINITY;
        if (kt == 1) { ATT_LOADK(3); ATT_LOADK(4); }
        if (kt >= kt0) {
            f32x16 a = {0.f, 0.f, 0.f, 0.f, 0.f, 0.f, 0.f, 0.f, 0.f, 0.f, 0.f, 0.f, 0.f, 0.f, 0.f, 0.f};
#pragma unroll
            for (int ks = 0; ks < 8; ++ks) a = __builtin_amdgcn_mfma_f32_32x32x16_bf16(kf[kt][ks], qf[ks], a, 0, 0, 0);
#pragma unroll
            for (int r = 0; r < 16; ++r) { const int kr = (r & 3) + 8 * (r >> 2) + 4 * hh; bool ok = true;
                if (kt == 0) ok = kr >= c;
                if (kt == 4) ok = kr <= c;
                S[kt][r] = ok ? a[r] : -INFINITY; }
        }
    }
#if PROBE && PROBE_KIND == 11
    if (F.tid() == 0) F.MISC[6] += (unsigned)(__builtin_amdgcn_s_memrealtime() - ta0);
#endif
#undef ATT_LOADK
    const float sink2 = AR.in[IN_SINKS][l * 8 + h] * LOG2E;
    float mx = sink2;
#pragma unroll
    for (int kt = 0; kt < 5; ++kt)
#pragma unroll
        for (int r = 0; r < 16; ++r) mx = fmaxf(mx, S[kt][r]);
    mx = fmaxf(mx, __shfl_xor(mx, 32));
    float sum = 0.f;
#pragma unroll
    for (int kt = 0; kt < 5; ++kt)
#pragma unroll
        for (int r = 0; r < 16; ++r) { const float p = __builtin_amdgcn_exp2f(S[kt][r] - mx); S[kt][r] = p; sum += p; }
    sum += __shfl_xor(sum, 32);
    const float inv = 1.0f / (sum + __builtin_amdgcn_exp2f(sink2 - mx));
    f32x16 O[4];
#pragma unroll
    for (int db = 0; db < 4; ++db)
#pragma unroll
        for (int r = 0; r < 16; ++r) O[db][r] = 0.f;
    const bf16* vbase = VT + ((size_t)((b * 2 + kvh) * 128 + c)) * TPV + (t0 - 128) + 8 * hh;
    bf16x8 vf[2][2][4];
#define ATT_LOADV(KT) do { _Pragma("unroll") for (int s_ = 0; s_ < 2; ++s_) _Pragma("unroll") for (int db_ = 0; db_ < 4; ++db_) \
        vf[(KT) & 1][s_][db_] = *(const bf16x8*)(vbase + (size_t)(32 * db_) * TPV + 32 * (KT) + 16 * s_); } while (0)
    ATT_LOADV(0);
#pragma unroll
    for (int kt = 0; kt < 5; ++kt) {
        if (kt < 4) ATT_LOADV(kt + 1);
        if (kt >= kt0) {
#pragma unroll
            for (int s = 0; s < 2; ++s) {
                v4u pw; pw.x = pk2(S[kt][8 * s + 0], S[kt][8 * s + 1]); pw.y = pk2(S[kt][8 * s + 2], S[kt][8 * s + 3]); pw.z = pk2(S[kt][8 * s + 4], S[kt][8 * s + 5]); pw.w = pk2(S[kt][8 * s + 6], S[kt][8 * s + 7]);
                const bf16x8 pf = __builtin_bit_cast(bf16x8, pw);
#pragma unroll
                for (int db = 0; db < 4; ++db) O[db] = __builtin_amdgcn_mfma_f32_32x32x16_bf16(vf[kt & 1][s][db], pf, O[db], 0, 0, 0);
            }
        }
    }
#undef ATT_LOADV
    float ss = 0.f;
#pragma unroll
    for (int db = 0; db < 4; ++db)
#pragma unroll
        for (int r = 0; r < 16; ++r) { O[db][r] *= inv; ss += O[db][r] * O[db][r]; }
#if PROBE && PROBE_KIND == 12
    if (F.tid() == 0) F.MISC[6] += (unsigned)(__builtin_amdgcn_s_memrealtime() - ta0);
#endif
    ss += __shfl_xor(ss, 32);
    if (hh == 0) ex[h * 32 + c] = ss;
    WG_BAR();
    float tot = 0.f;
#pragma unroll
    for (int j = 0; j < 8; ++j) tot += ex[j * 32 + c];
    const float rsa = rsqrtf(tot * (1.0f / 1024.0f) + EPS);
    if (t0 + c < TT) {
        const rsrc_t rs_ = ws_rsrc(ws); const size_t mo16 = WS_MIX + ((rb + t0 + c) * DM + 128 * h) * 2 + 16 * hh;
#pragma unroll
        for (int db = 0; db < 4; ++db)
#pragma unroll
            for (int g4 = 0; g4 < 4; g4 += 2) {
                unsigned ax = pk2(O[db][4 * g4 + 0] * rsa, O[db][4 * g4 + 1] * rsa), ay = pk2(O[db][4 * g4 + 2] * rsa, O[db][4 * g4 + 3] * rsa);
                unsigned bx = pk2(O[db][4 * g4 + 4] * rsa, O[db][4 * g4 + 5] * rsa), by = pk2(O[db][4 * g4 + 6] * rsa, O[db][4 * g4 + 7] * rsa);
                { auto r = __builtin_amdgcn_permlane32_swap(ax, bx, false, false); ax = r[0]; bx = r[1]; }
                { auto r = __builtin_amdgcn_permlane32_swap(ay, by, false, false); ay = r[0]; by = r[1]; }
                ST16(rs_, mo16 + (32 * db + 8 * g4) * 2, ((v4u){ax, ay, bx, by}));
            }
    }
    WG_BAR();
}

__device__ __forceinline__ void sattn_unit(const Args& AR, Frame& F, int l, int s) {
    int tid_ = F.tid(); asm volatile("" : "+v"(tid_));
    const int tid = tid_, lane = tid & 63, wave = F.wave;
    LAS float* qs = (LAS float*)F.lds;
    LAS float* sc = qs + 1024;
    LAS float* part = sc + 8 * 132;
    LAS float* red = part + 4096;
    const size_t row = SROW0 + s;
    const bf16* Q = (const bf16*)(F.ws + WS_Q) + row * 1024;
    const float* ksn = (const float*)(F.ws + WS_KSN) + (size_t)s * 256; const float* vsn = ksn + NSAMP * 256;
    const float* ck = AR.in[IN_CACHEK] + ((size_t)(l * NSAMP + s)) * 128 * 256; const float* cv = AR.in[IN_CACHEV] + ((size_t)(l * NSAMP + s)) * 128 * 256;
    for (int j = tid; j < 1024; j += 512) qs[j] = bf2f(Q[j]);
    WG_BAR();
    { const int key = tid >> 2, pt = tid & 3;
#pragma unroll
      for (int kvh = 0; kvh < 2; ++kvh) {
          const float* kp = ck + (size_t)key * 256 + kvh * 128 + 32 * pt; float d[4] = {0.f, 0.f, 0.f, 0.f};
#pragma unroll
          for (int j = 0; j < 8; ++j) { const f32x4 kv = *(const f32x4*)(kp + 4 * j);
#pragma unroll
              for (int g = 0; g < 4; ++g) { const f32x4 qv = *(const LAS f32x4*)(qs + (4 * kvh + g) * 128 + 32 * pt + 4 * j); d[g] += (kv[0] * qv[0] + kv[1] * qv[1]) + (kv[2] * qv[2] + kv[3] * qv[3]); } }
#pragma unroll
          for (int g = 0; g < 4; ++g) { d[g] += __shfl_xor(d[g], 1); d[g] += __shfl_xor(d[g], 2); if (pt == 0) sc[(4 * kvh + g) * 132 + key] = d[g]; }
      } }
    {
      const int h = wave, kvh = h >> 2; float d = ksn[kvh * 128 + lane] * qs[h * 128 + lane] + ksn[kvh * 128 + 64 + lane] * qs[h * 128 + 64 + lane];
      d = wave_sum(d); if (lane == 0) sc[h * 132 + 128] = d; }
    WG_BAR();
    { const int h = wave; const float sink2 = AR.in[IN_SINKS][l * 8 + h] * LOG2E;
      const float v0 = sc[h * 132 + lane], v1 = sc[h * 132 + 64 + lane], v2 = (lane == 0) ? sc[h * 132 + 128] : -INFINITY;
      const float mx = fmaxf(wave_max(fmaxf(fmaxf(v0, v1), v2)), sink2);
      const float p0 = __builtin_amdgcn_exp2f(v0 - mx), p1 = __builtin_amdgcn_exp2f(v1 - mx), p2 = __builtin_amdgcn_exp2f(v2 - mx);
      const float inv = 1.0f / (wave_sum(p0 + p1 + p2) + __builtin_amdgcn_exp2f(sink2 - mx));
      sc[h * 132 + lane] = p0 * inv; sc[h * 132 + 64 + lane] = p1 * inv; if (lane == 0) sc[h * 132 + 128] = p2 * inv; }
    WG_BAR();
    { const int d = tid & 127, kq = tid >> 7;
#pragma unroll
      for (int kvh = 0; kvh < 2; ++kvh) { float a[4] = {0.f, 0.f, 0.f, 0.f};
          float vv[32];
#pragma unroll
          for (int k = 0; k < 32; ++k) vv[k] = cv[(size_t)(32 * kq + k) * 256 + kvh * 128 + d];
#pragma unroll
          for (int k = 0; k < 32; ++k) { const int key = 32 * kq + k;
#pragma unroll
              for (int g = 0; g < 4; ++g) a[g] += sc[(4 * kvh + g) * 132 + key] * vv[k]; }
#pragma unroll
          for (int g = 0; g < 4; ++g) part[kq * 1024 + (4 * kvh + g) * 128 + d] = a[g]; } }
    WG_BAR();
    float o[2]; float ss = 0.f;
#pragma unroll
    for (int e = 0; e < 2; ++e) { const int j = tid + 512 * e, h = j >> 7, d = j & 127, kvh = h >> 2;
        o[e] = (part[j] + part[1024 + j]) + (part[2048 + j] + part[3072 + j]) + sc[h * 132 + 128] * vsn[kvh * 128 + d]; ss += o[e] * o[e]; }
    ss = wave_sum(ss); if (lane == 0) red[wave] = ss;
    WG_BAR();
    { float tot = 0.f;
#pragma unroll
      for (int j = 0; j < 8; ++j) tot += red[j];
      const float rsa = rsqrtf(tot * (1.0f / 1024.0f) + EPS);
      const rsrc_t rs_ = ws_rsrc(F.ws);
#pragma unroll
      for (int e = 0; e < 2; ++e) ST2(rs_, WS_MIX + (row * DM + tid + 512 * e) * 2, pk2(o[e] * rsa, 0.f) & 0xffffu); }
    { float* ok = F.out + O_SK + ((size_t)(l * NSAMP + s)) * 128 * 256; float* ov = F.out + O_SV + ((size_t)(l * NSAMP + s)) * 128 * 256;
#pragma unroll 1
      for (int jb = 0; jb < 16; jb += 4) { f32x4 ka[4], va[4];
#pragma unroll
          for (int e = 0; e < 4; ++e) { const int j = tid + 512 * (jb + e); if (j < 127 * 64) { ka[e] = *(const f32x4*)(ck + 256 + 4 * j); va[e] = *(const f32x4*)(cv + 256 + 4 * j); } }
#pragma unroll
          for (int e = 0; e < 4; ++e) { const int j = tid + 512 * (jb + e); if (j < 127 * 64) { *(f32x4*)(ok + 4 * j) = ka[e]; *(f32x4*)(ov + 4 * j) = va[e]; } } }
      if (tid < 64) *(f32x4*)(ok + 127 * 256 + 4 * tid) = *(const f32x4*)(ksn + 4 * tid);
      else if (tid < 128) *(f32x4*)(ov + 127 * 256 + 4 * (tid - 64)) = *(const f32x4*)(vsn + 4 * (tid - 64)); }
    WG_BAR();
}

__device__ __forceinline__ float gelu_tanh(float y) {
    const float inner = 0.7978845608028654f * (y + 0.044715f * y * y * y);
    return y / (1.0f + __builtin_amdgcn_exp2f(-2.0f * LOG2E * inner));
}
__device__ __forceinline__ float sigmoidf_(float x) { return 1.0f / (1.0f + __builtin_amdgcn_exp2f(-LOG2E * x)); }
#define SWZ(r, ch, PITCH) ((r) * (PITCH) + ((((ch)) ^ ((r) & 15)) << 4))

#ifndef SSM_P1
#define SSM_P1 1
#endif
#ifndef SSM_M2
#define SSM_M2 1
#endif
__device__ __forceinline__ int rowtok(int r) { return 16 * ((r >> 2) & 1) + 4 * (r >> 3) + (r & 3); }
struct SsmG { f32x16 X[4]; };
struct SsmIn { bf16x8 a; };
__device__ __forceinline__ SsmIn ssm_load_in(const bf16* U, int rowb, int g, int lane) { const bf16* up = U + (size_t)(rowb + rowtok(lane & 31)) * 512 + 16 * g + 8 * (lane >> 5); SsmIn r; r.a = *(const bf16x8*)up; return r; }
__device__ __forceinline__ void ssm_block(const Args& AR, SsmG& G, const SsmIn& in, int g, const bf16x8 (&bbf)[4], const float (&ab)[4], float (&hr)[2], float (&hi)[2], int mode, int l, int s0, int lane) {
    const int c = lane & 31, hh = lane >> 5;
    const bf16x8 af = in.a;
    const f32x16 z16 = {0.f, 0.f, 0.f, 0.f, 0.f, 0.f, 0.f, 0.f, 0.f, 0.f, 0.f, 0.f, 0.f, 0.f, 0.f, 0.f};
#pragma unroll
    for (int nb = 0; nb < 4; ++nb) G.X[nb] = __builtin_amdgcn_mfma_f32_32x32x16_bf16(af, bbf[nb], z16, 0, 0, 0);
#pragma unroll
    for (int s = 0; s < 2; ++s) {
        const float ar = ab[2 * s], ai = ab[2 * s + 1];
        if (SSM_M2 && mode == 2) {
            { int cx = c; asm volatile("" : "+v"(cx)); const size_t o0 = ((size_t)(l * NSAMP + (s0 + 16 * hh)) * 32 + g) * 64 + cx + 32 * s; const float* qr = AR.in[IN_SSMRE] + o0; const float* qi = AR.in[IN_SSMIM] + o0;
              size_t jo = 0;
#pragma unroll
              for (int j = 0; j < 16; ++j) { const float pr = qr[jo], pi = qi[jo]; jo += 2048; asm volatile("" : "+v"(jo));
                const float nr = ar * pr - ai * pi + G.X[s][j], ni = ar * pi + ai * pr + G.X[2 + s][j]; G.X[s][j] = nr; G.X[2 + s][j] = ni; } }
            continue;
        }
        float r = (hh == 0) ? hr[s] : 0.f, i = (hh == 0) ? hi[s] : 0.f;
#pragma unroll
        for (int j = 0; j < 16; ++j) { const float nr = ar * r - ai * i + G.X[s][j], ni = ar * i + ai * r + G.X[2 + s][j]; r = nr; i = ni; G.X[s][j] = r; G.X[2 + s][j] = i; }
        float vr = __shfl_xor(r, 32), vi = __shfl_xor(i, 32);
        if (hh == 0 || mode == 1) { vr = 0.f; vi = 0.f; }
        float pr = ar, pi = ai; asm volatile("" : "+v"(pr), "+v"(pi));
#pragma unroll
        for (int j = 0; j < 16; ++j) { G.X[s][j] += pr * vr - pi * vi; G.X[2 + s][j] += pr * vi + pi * vr; const float nr = pr * ar - pi * ai, ni = pr * ai + pi * ar; pr = nr; pi = ni; }
        const float er = G.X[s][15], ei = G.X[2 + s][15];
        const float xr = __shfl_xor(er, 32), xi = __shfl_xor(ei, 32);
        hr[s] = (hh == 1) ? er : xr; hi[s] = (hh == 1) ? ei : xi;
    }
}
struct SsmTab { float ab[4]; bf16x8 bbf[4]; };
struct SsmTabC { bf16x8 cmf[4]; f32x4 dsk; };
__device__ __forceinline__ SsmTab ssm_load_tab(const unsigned char* tb, int w, int gi, int lg) {
    SsmTab T; const int g = 4 * w + gi, c32 = lg & 31, hh = lg >> 5;
    T.ab[0] = ((const float*)(tb + TB_ABR))[g * 64 + c32]; T.ab[1] = ((const float*)(tb + TB_ABI))[g * 64 + c32]; T.ab[2] = ((const float*)(tb + TB_ABR))[g * 64 + 32 + c32]; T.ab[3] = ((const float*)(tb + TB_ABI))[g * 64 + 32 + c32];
    const bf16* bt = (const bf16*)(tb + TB_PM) + (size_t)g * 128 * 16 + c32 * 16 + 8 * hh;
#pragma unroll
    for (int nb = 0; nb < 4; ++nb) T.bbf[nb] = *(const bf16x8*)(bt + nb * 32 * 16);
    return T;
}
__device__ __forceinline__ SsmTabC ssm_load_tabc(const unsigned char* tb, const float* dskip, int w, int gi, int lg) {
    SsmTabC T; const int g = 4 * w + gi, t16 = lg & 15, cq = lg >> 4;
    const bf16* cm = (const bf16*)(tb + TB_CMT) + (size_t)g * 16 * 128 + t16 * 128 + 8 * cq;
#pragma unroll
    for (int nb = 0; nb < 4; ++nb) T.cmf[nb] = *(const bf16x8*)(cm + 32 * nb);
    T.dsk = *(const f32x4*)(dskip + 64 * w + 16 * gi + 4 * cq); return T;
}
__device__ __forceinline__ void ssm_unit(const Args& AR, Frame& F, int l, int c_in) {
    const int c = c_in;
#if PROBE && PROBE_KIND == 13
    const unsigned long long tq0 = __builtin_amdgcn_s_memrealtime();
#define SSM_CP(n) do { if ((n) == PROBE_TYPE && F.tid() == 0) F.MISC[6] += (unsigned)(__builtin_amdgcn_s_memrealtime() - tq0); } while (0)
#else
#define SSM_CP(n) do { } while (0)
#endif
    int lane_ = F.lane(); asm volatile("" : "+v"(lane_));
    const int lane = lane_, w = F.wave, t16 = lane & 15, cq = lane >> 4, c32 = lane & 31, hh = lane >> 5;
    const int row0 = 64 * c;
    size_t z_ = 0; asm volatile("" : "+s"(z_)); unsigned char* ws = F.ws + z_;
    const unsigned char* tb = ws + WS_TAB + (size_t)l * TB_LAYER;
    const bf16* U = (const bf16*)(ws + WS_U);
    float* SST = (float*)(ws + WS_SST) + ((size_t)l * NCHUNK) * 32 * 128;
    gu32* flags = F.ctl + CW_SSMF + (size_t)(l * NCHUNK) * 8 * 16;
    LAS unsigned char* Zs = F.lds;
    LAS unsigned char* Hm = F.lds + 65536 + w * 8704;
    LAS float* red = (LAS float*)(F.lds + 137216);
    SsmG SG;
    float hcar[4] = {0.f, 0.f, 0.f, 0.f};
    if (SSM_P1 && c != NCHUNK - 1) {
        int lg_ = lane; asm volatile("" : "+v"(lg_));
        const int c32 = lg_ & 31, hh = lg_ >> 5;
        float ab4[4][4]; bf16x8 bbf4[4][4]; SsmIn in04[4], in14[4];
#pragma unroll
        for (int gi = 0; gi < 4; ++gi) { const int g = 4 * w + gi;
            ab4[gi][0] = ((const float*)(tb + TB_ABR))[g * 64 + c32]; ab4[gi][1] = ((const float*)(tb + TB_ABI))[g * 64 + c32]; ab4[gi][2] = ((const float*)(tb + TB_ABR))[g * 64 + 32 + c32]; ab4[gi][3] = ((const float*)(tb + TB_ABI))[g * 64 + 32 + c32];
            const bf16* bt = (const bf16*)(tb + TB_PM) + (size_t)g * 128 * 16 + c32 * 16 + 8 * hh;
#pragma unroll
            for (int nb = 0; nb < 4; ++nb) bbf4[gi][nb] = *(const bf16x8*)(bt + nb * 32 * 16);
            in04[gi] = ssm_load_in(U, row0, g, lg_); in14[gi] = ssm_load_in(U, row0 + 32, g, lg_); }
#pragma unroll
        for (int gi = 0; gi < 4; ++gi) { const int g = 4 * w + gi;
            float hr[2] = {0.f, 0.f}, hi[2] = {0.f, 0.f};
            ssm_block(AR, SG, in04[gi], g, bbf4[gi], ab4[gi], hr, hi, (c == 64) ? 1 : 0, l, 0, lg_);
            ssm_block(AR, SG, in14[gi], g, bbf4[gi], ab4[gi], hr, hi, 0, l, 0, lg_);
            if (hh == 0) {
#pragma unroll
                for (int s = 0; s < 2; ++s) __hip_atomic_store((gu64*)(SST + ((size_t)c * 32 + g) * 128 + 2 * (c32 + 32 * s)), ((unsigned long long)__builtin_bit_cast(unsigned, hi[s]) << 32) | __builtin_bit_cast(unsigned, hr[s]), RLX_AGENT);
            }
        }
        VM_WAIT();
        if (lane == 0) __hip_atomic_store(flags + ((size_t)c * 8 + w) * 16, 1u, RLX_AGENT);
    }
    SSM_CP(1);
    const int cs0 = (c <= 64) ? 0 : 64, npred = c - cs0;
    if (npred > 0) {
        unsigned sp = 0; bool ok = false;
        for (;;) { ok = (lane >= npred) || (__hip_atomic_load(flags + ((size_t)(cs0 + lane) * 8 + w) * 16, RLX_AGENT) != 0u);
            if (__all(ok)) break;
            __builtin_amdgcn_s_sleep(2);
            if (++sp > (1u << 20)) { if (lane == 0) __hip_atomic_store(F.ctl + CW_TMO, 0x55u, RLX_AGENT); break; } }
        __builtin_amdgcn_fence(__ATOMIC_ACQUIRE, "agent");
        VM_WAIT();
    }
    SSM_CP(2);
    SSM_CP(2);
    SsmTab T = ssm_load_tab(tb, w, 0, lane);
    SsmTabC TC = ssm_load_tabc(tb, AR.in[IN_DSKIP] + l * 512, w, 0, lane);
    SsmIn inx = ssm_load_in(U, row0, 4 * w, lane);
#pragma unroll 1
    for (int step = 0; step < 8; ++step) {
        const int gi = step >> 1, half = step & 1, g = 4 * w + gi;
        int lg_ = lane; asm volatile("" : "+v"(lg_));
        const int t16 = lg_ & 15, cq = lg_ >> 4, c32 = lg_ & 31, hh = lg_ >> 5;
        int cc_ = c_in; asm volatile("" : "+s"(cc_)); const int c = cc_;
        const bool samp = (c == NCHUNK - 1) && (half == 1);
        const int col = 64 * w + 16 * gi + 4 * cq;
        const int ns = (step < 7) ? step + 1 : 7, ngi = ns >> 1, nhalf = ns & 1;
        const SsmIn in_n = ssm_load_in(U, row0 + 32 * nhalf, 4 * w + ngi, lg_);
        v2u uvp[2];
#pragma unroll
        for (int mt = 0; mt < 2; ++mt) uvp[mt] = *(const v2u*)(U + (size_t)(row0 + 32 * half + 16 * mt + t16) * 512 + col);
        if (half == 0 && gi > 0) { T = ssm_load_tab(tb, w, gi, lg_); TC = ssm_load_tabc(tb, AR.in[IN_DSKIP] + l * 512, w, gi, lg_); }
        float hr[2], hi[2];
        if (half == 0) {
            hr[0] = 0.f; hr[1] = 0.f; hi[0] = 0.f; hi[1] = 0.f;
            if (npred > 0) {
                float aL[4]; aL[0] = ((const float*)(tb + TB_ALR))[g * 64 + c32]; aL[1] = ((const float*)(tb + TB_ALI))[g * 64 + c32]; aL[2] = ((const float*)(tb + TB_ALR))[g * 64 + 32 + c32]; aL[3] = ((const float*)(tb + TB_ALI))[g * 64 + 32 + c32];
                const float* sb = SST + ((size_t)g) * 128 + 2 * c32;
                for (int cp = cs0; cp < c; cp += 16) {
                    f32x2 sv[16][2];
#pragma unroll
                    for (int j = 0; j < 16; ++j) { const int cj = (cp + j < c) ? cp + j : c - 1; const float* sp_ = sb + (size_t)cj * 32 * 128; sv[j][0] = *(const f32x2*)sp_; sv[j][1] = *(const f32x2*)(sp_ + 64); }
#pragma unroll
                    for (int j = 0; j < 16; ++j) if (cp + j < c) {
#pragma unroll
                        for (int s = 0; s < 2; ++s) { const float nr = aL[2 * s] * hr[s] - aL[2 * s + 1] * hi[s] + sv[j][s][0], ni = aL[2 * s] * hi[s] + aL[2 * s + 1] * hr[s] + sv[j][s][1]; hr[s] = nr; hi[s] = ni; } }
                }
            }
        } else {
#pragma unroll
            for (int s = 0; s < 2; ++s) { hr[s] = hcar[2 * s]; hi[s] = hcar[2 * s + 1]; }
        }
        ssm_block(AR, SG, inx, g, T.bbf, T.ab, hr, hi, samp ? 2 : ((c == 64 && half == 0) ? 1 : 0), l, 0, lg_);
#pragma unroll
        for (int s = 0; s < 2; ++s) { hcar[2 * s] = hr[s]; hcar[2 * s + 1] = hi[s]; }
        { LAS unsigned char* hw = Hm + hh * (16 * 272) + c32 * 2;
#pragma unroll
          for (int j = 0; j < 16; ++j)
#pragma unroll
            for (int nb = 0; nb < 4; ++nb) *(LAS bf16*)(hw + j * 272 + nb * 64) = (bf16)(pk2(SG.X[nb][j], 0.f) & 0xffffu); }
        if ((c == 64 && half == 0) || (c == NCHUNK - 1 && half == 0)) {
            int cx = c32; asm volatile("" : "+v"(cx));
            if (hh == (c == 64 ? 0 : 1)) {
#pragma unroll
                for (int s = 0; s < 2; ++s) { const size_t o = ((size_t)(l * NBATCH + (c == 64 ? 0 : 1)) * 32 + g) * 64 + cx + 32 * s; F.out[O_PSR + o] = SG.X[s][15]; F.out[O_PSI + o] = SG.X[2 + s][15]; } } }
        if (samp) { int cx = c32; asm volatile("" : "+v"(cx)); const size_t o0 = ((size_t)(l * NSAMP + 16 * hh) * 32 + g) * 64 + cx; float* qr = F.out + O_SSR + o0; float* qi = F.out + O_SSI + o0;
#pragma unroll
            for (size_t j = 0, jo = 0; j < 16; ++j) { qr[jo] = SG.X[0][j]; qr[jo + 32] = SG.X[1][j]; qi[jo] = SG.X[2][j]; qi[jo + 32] = SG.X[3][j]; jo += 2048; asm volatile("" : "+v"(jo)); } }
        LDS_WAIT();
#pragma unroll
        for (int mt = 0; mt < 2; ++mt) {
            f32x4 y = {0.f, 0.f, 0.f, 0.f};
#pragma unroll
            for (int ks = 0; ks < 4; ++ks) { const bf16x8 hf = *(const LAS bf16x8*)(Hm + (16 * mt + t16) * 272 + (4 * ks + cq) * 16);
                y = __builtin_amdgcn_mfma_f32_16x16x32_bf16(TC.cmf[ks], hf, y, 0, 0, 0); }
            const int rl = 32 * half + 16 * mt + t16;
            const f32x4 uv = {__builtin_bit_cast(float, uvp[mt].x << 16), __builtin_bit_cast(float, uvp[mt].x & 0xffff0000u), __builtin_bit_cast(float, uvp[mt].y << 16), __builtin_bit_cast(float, uvp[mt].y & 0xffff0000u)};
            f32x4 z;
#pragma unroll
            for (int e = 0; e < 4; ++e) z[e] = gelu_tanh(y[e] + TC.dsk[e] * uv[e]);
            *(LAS v2u*)(Zs + SWZ(rl, col >> 3, 1024) + (col & 7) * 2) = (v2u){pk2(z[0], z[1]), pk2(z[2], z[3])};
        }
        LDS_WAIT();
        inx = in_n;
    }
    WG_BAR();
    SSM_CP(3);
    f32x4 G[4][4];
    f32x4 bgv[4];
#pragma unroll
    for (int nt = 0; nt < 4; ++nt) bgv[nt] = *(const f32x4*)(AR.in[IN_BGLU] + l * 512 + 64 * w + 16 * nt + 4 * cq);
#pragma unroll
    for (int mt = 0; mt < 4; ++mt)
#pragma unroll
        for (int nt = 0; nt < 4; ++nt) G[mt][nt] = (f32x4){0.f, 0.f, 0.f, 0.f};
    { const bf16* Wg = (const bf16*)(ws + WS_WGLU) + (size_t)l * 512 * 512 + ((size_t)w * 16 * 4 * 64 + lane) * 8;
      bf16x8 wq[4][4];
#pragma unroll
      for (int pk = 0; pk < 3; ++pk)
#pragma unroll
          for (int nt = 0; nt < 4; ++nt) wq[pk][nt] = *(const bf16x8*)(Wg + (size_t)(pk * 4 + nt) * 64 * 8);
#pragma unroll
      for (int ks = 0; ks < 16; ++ks) {
          bf16x8 zf[4];
          if (ks + 3 < 16) {
#pragma unroll
              for (int nt = 0; nt < 4; ++nt) wq[(ks + 3) & 3][nt] = *(const bf16x8*)(Wg + (size_t)((ks + 3) * 4 + nt) * 64 * 8); }
#pragma unroll
          for (int mt = 0; mt < 4; ++mt) zf[mt] = *(const LAS bf16x8*)(Zs + SWZ(16 * mt + t16, 4 * ks + cq, 1024));
#pragma unroll
          for (int mt = 0; mt < 4; ++mt)
#pragma unroll
              for (int nt = 0; nt < 4; ++nt) G[mt][nt] = __builtin_amdgcn_mfma_f32_16x16x32_bf16(wq[ks & 3][nt], zf[mt], G[mt][nt], 0, 0, 0);
      } }
#pragma unroll
    for (int mt = 0; mt < 4; ++mt) { float ss = 0.f; const int rl = 16 * mt + t16;
#pragma unroll
        for (int nt = 0; nt < 4; ++nt) { const int col = 64 * w + 16 * nt + 4 * cq; const f32x4 bg = bgv[nt];
            const v2u zz = *(const LAS v2u*)(Zs + SWZ(rl, col >> 3, 1024) + (col & 7) * 2);
            const float zv[4] = {bf2f((unsigned short)(zz.x & 0xffffu)), bf2f((unsigned short)(zz.x >> 16)), bf2f((unsigned short)(zz.y & 0xffffu)), bf2f((unsigned short)(zz.y >> 16))};
#pragma unroll
            for (int e = 0; e < 4; ++e) { const float o = zv[e] * sigmoidf_(G[mt][nt][e] + bg[e]); G[mt][nt][e] = o; ss += o * o; } }
        ss += __shfl_xor(ss, 16); ss += __shfl_xor(ss, 32);
        if (cq == 0) red[rl * 8 + w] = ss; }
    SSM_CP(4);
    WG_BAR();
    { const rsrc_t rs_ = ws_rsrc(ws);
#pragma unroll
      for (int mt = 0; mt < 4; ++mt) { const int rl = 16 * mt + t16; const LAS f32x4* rp = (const LAS f32x4*)(red + rl * 8); const f32x4 a = rp[0], b2 = rp[1];
          const float rsn = rsqrtf(((a[0] + a[1]) + (a[2] + a[3]) + (b2[0] + b2[1]) + (b2[2] + b2[3])) * (1.0f / 512.0f) + EPS);
          const int od = cq & 1; const size_t mo = WS_MIX + ((size_t)(row0 + rl) * DM + 1024 + 64 * w + 4 * (cq & ~1)) * 2 + (od ? 32 : 0);
#pragma unroll
          for (int nt = 0; nt < 4; nt += 2) {
              const unsigned a0 = pk2(G[mt][nt][0] * rsn, G[mt][nt][1] * rsn), a1 = pk2(G[mt][nt][2] * rsn, G[mt][nt][3] * rsn);
              const unsigned b0 = pk2(G[mt][nt + 1][0] * rsn, G[mt][nt + 1][1] * rsn), b1 = pk2(G[mt][nt + 1][2] * rsn, G[mt][nt + 1][3] * rsn);
              const unsigned s0 = od ? a0 : b0, s1 = od ? a1 : b1;
              const unsigned r0 = (unsigned)__shfl_xor((int)s0, 16), r1 = (unsigned)__shfl_xor((int)s1, 16);
              ST16(rs_, mo + 32 * nt, (od ? (v4u){r0, r1, b0, b1} : (v4u){a0, a1, r0, r1})); } } }
    WG_BAR();
}
#undef SSM_ROWS4

template <int WLEN>
__device__ __forceinline__ void pool_half(const float* XP, float* out, int l, int ch, int rfirst, int rl0, LAS unsigned char* Ds) {
    float xv[48];
#pragma unroll
    for (int i = 0; i < 48; ++i) { const int ra = rfirst + i - 16; xv[i] = (ra >= 0) ? XP[(size_t)ra * 512 + ch] : 0.f; }
    int seg = (rfirst >= TT) ? TT : 0;
    float sum = 0.f;
#pragma unroll
    for (int j = 1; j <= WLEN; ++j) if (rfirst - j >= seg) sum += xv[16 - j];
#pragma unroll
    for (int i = 0; i < 32; ++i) {
        const int ra = rfirst + i; const float x = xv[16 + i];
        if (ra == TT) { seg = TT; sum = 0.f; }
        sum += x;
        if (ra - WLEN >= seg) sum -= xv[16 + i - WLEN];
        const int cnt = (ra - seg + 1 < WLEN) ? (ra - seg + 1) : WLEN;
        const float dm = sum * __builtin_amdgcn_rcpf((float)cnt) - x;
        if (ra >= TT - 15 && ra < TT) out[O_PP + ((size_t)(l * NBATCH + 0) * 15 + (ra - (TT - 15))) * 512 + ch] = x;
        if (ra >= SROW0 - 15) out[O_PP + ((size_t)(l * NBATCH + 1) * 15 + (ra - (SROW0 - 15))) * 512 + ch] = x;
        const int r = rl0 + i;
        *(LAS bf16*)(Ds + SWZ(r, ch >> 3, 1024) + (ch & 7) * 2) = (bf16)(pk2(dm, 0.f) & 0xffffu);
    }
}
template <int WLEN>
__device__ __forceinline__ void pool_sample_rows(const float* XP, const float* sp, float* out, int l, int ch, LAS unsigned char* Ds) {
#pragma unroll 2
    for (int s = 0; s < NSAMP; ++s) {
        const float* pp = sp + (size_t)s * 15 * 512; float pv[15];
#pragma unroll
        for (int j = 0; j < 15; ++j) pv[j] = pp[(size_t)j * 512];
        const float x = XP[(size_t)(SROW0 + s) * 512 + ch]; float a = x;
#pragma unroll
        for (int j = 16 - WLEN; j < 15; ++j) a += pv[j];
        const float dm = a * (1.0f / WLEN) - x;
        float* op = out + O_SP + ((size_t)(l * NSAMP + s) * 15) * 512 + ch;
#pragma unroll
        for (int j = 0; j < 14; ++j) op[(size_t)j * 512] = pv[j + 1];
        op[(size_t)14 * 512] = x;
        *(LAS bf16*)(Ds + SWZ(32 + s, ch >> 3, 1024) + (ch & 7) * 2) = (bf16)(pk2(dm, 0.f) & 0xffffu);
    }
}
__device__ __forceinline__ void pool_unit(const Args& AR, Frame& F, int l, int c) {
    int tid_ = F.tid(); asm volatile("" : "+v"(tid_));
    const int tid = tid_, lane = tid & 63, w = F.wave, t16 = lane & 15, cq = lane >> 4;
    const int row0 = 64 * c;
    size_t z_ = 0; asm volatile("" : "+s"(z_)); unsigned char* ws = F.ws + z_;
    const float* XP = (const float*)(ws + WS_XP);
    LAS unsigned char* Ds = F.lds;
    LAS float* red = (LAS float*)(F.lds + ESC_OFF);
    bf16x8 wfp[4][8];
    { const int gp_ = w & 3; const bf16* Wp = (const bf16*)(ws + WS_WPOOL) + (size_t)(l * 4 + gp_) * 128 * 128 + (size_t)lane * 8;
#pragma unroll
      for (int ks = 0; ks < 4; ++ks)
#pragma unroll
          for (int nt = 0; nt < 8; ++nt) wfp[ks][nt] = *(const bf16x8*)(Wp + (size_t)(ks * 8 + nt) * 64 * 8); }
    { const int ch = tid, wsel = w >> 1;
      const float* sp = AR.in[IN_SPOOL] + (size_t)l * NSAMP * 15 * 512 + ch;
#pragma unroll 1
      for (int half = 0; half < 2; ++half) {
          if (c == NCHUNK - 1 && half == 1) {
              if (wsel == 0) pool_sample_rows<2>(XP, sp, F.out, l, ch, Ds); else if (wsel == 1) pool_sample_rows<4>(XP, sp, F.out, l, ch, Ds);
              else if (wsel == 2) pool_sample_rows<8>(XP, sp, F.out, l, ch, Ds); else pool_sample_rows<16>(XP, sp, F.out, l, ch, Ds);
          } else {
              const int rfirst = row0 + 32 * half;
              if (wsel == 0) pool_half<2>(XP, F.out, l, ch, rfirst, 32 * half, Ds); else if (wsel == 1) pool_half<4>(XP, F.out, l, ch, rfirst, 32 * half, Ds);
              else if (wsel == 2) pool_half<8>(XP, F.out, l, ch, rfirst, 32 * half, Ds); else pool_half<16>(XP, F.out, l, ch, rfirst, 32 * half, Ds);
          }
      } }
    WG_BAR();
    const int gp = w & 3, rh = w >> 2;
    f32x4 A[2][8];
#pragma unroll
    for (int mt = 0; mt < 2; ++mt)
#pragma unroll
        for (int nt = 0; nt < 8; ++nt) A[mt][nt] = (f32x4){0.f, 0.f, 0.f, 0.f};
    {
#pragma unroll
      for (int ks = 0; ks < 4; ++ks) {
          bf16x8 df[2];
#pragma unroll
          for (int mt = 0; mt < 2; ++mt) df[mt] = *(const LAS bf16x8*)(Ds + SWZ(32 * rh + 16 * mt + t16, 16 * gp + 4 * ks + cq, 1024));
#pragma unroll
          for (int nt = 0; nt < 8; ++nt) {
#pragma unroll
              for (int mt = 0; mt < 2; ++mt) A[mt][nt] = __builtin_amdgcn_mfma_f32_16x16x32_bf16(wfp[ks][nt], df[mt], A[mt][nt], 0, 0, 0); }
      } }
    f32x4 scp[8];
#pragma unroll
    for (int nt = 0; nt < 8; ++nt) scp[nt] = *(const f32x4*)(AR.in[IN_PSCALE] + l * 512 + 128 * gp + 16 * nt + 4 * cq);
#pragma unroll
    for (int mt = 0; mt < 2; ++mt) { float ss = 0.f;
#pragma unroll
        for (int nt = 0; nt < 8; ++nt) { const f32x4 sc = scp[nt];
#pragma unroll
            for (int e = 0; e < 4; ++e) { const float o = A[mt][nt][e] * sc[e]; A[mt][nt][e] = o; ss += o * o; } }
        ss += __shfl_xor(ss, 16); ss += __shfl_xor(ss, 32);
        if (cq == 0) red[(32 * rh + 16 * mt + t16) * 4 + gp] = ss; }
    WG_BAR();
    { const rsrc_t rs_ = ws_rsrc(ws);
#pragma unroll
      for (int mt = 0; mt < 2; ++mt) { const int rl = 32 * rh + 16 * mt + t16; const f32x4 a = *(const LAS f32x4*)(red + rl * 4);
          const float rsn = rsqrtf(((a[0] + a[1]) + (a[2] + a[3])) * (1.0f / 512.0f) + EPS);
          const int od = cq & 1; const size_t mo = WS_MIX + ((size_t)(row0 + rl) * DM + 1536 + 128 * gp + 4 * (cq & ~1)) * 2 + (od ? 32 : 0);
#pragma unroll
          for (int nt = 0; nt < 8; nt += 2) {
              const unsigned a0 = pk2(A[mt][nt][0] * rsn, A[mt][nt][1] * rsn), a1 = pk2(A[mt][nt][2] * rsn, A[mt][nt][3] * rsn);
              const unsigned b0 = pk2(A[mt][nt + 1][0] * rsn, A[mt][nt + 1][1] * rsn), b1 = pk2(A[mt][nt + 1][2] * rsn, A[mt][nt + 1][3] * rsn);
              const unsigned s0 = od ? a0 : b0, s1 = od ? a1 : b1;
              const unsigned r0 = (unsigned)__shfl_xor((int)s0, 16), r1 = (unsigned)__shfl_xor((int)s1, 16);
              ST16(rs_, mo + 32 * nt, (od ? (v4u){r0, r1, b0, b1} : (v4u){a0, a1, r0, r1})); } } }
    WG_BAR();
}

#ifndef ACQ_SCOPE
#define ACQ_SCOPE "agent"
#endif
#ifndef PE_ROW_OWNED
#define PE_ROW_OWNED 0
#endif
#ifndef PUBLISH_FENCE
#define PUBLISH_FENCE 0
#endif
enum { U_END = 0, U_PA = 1, U_PC = 2, U_PD = 3, U_PE = 4, U_PEQ = 5  , U_SSM = 6, U_ATT = 7, U_SATT = 8, U_POOL = 9 };
constexpr int U_GEMM_LAST = U_PEQ;
constexpr int NPANEL = MP / 256;
constexpr int QCAP = 1024;
__host__ __device__ constexpr unsigned mkd(int type, int l, int a, int b) { return ((unsigned)type << 24) | ((unsigned)l << 20) | ((unsigned)a << 10) | (unsigned)b; }
__device__ __forceinline__ gu32* cnt_word(gu32* ctl, int l, int kind, int pm) { return ctl + CW_CNT + ((l * 5 + kind) * 40 + pm) * 16; }
__host__ __device__ constexpr unsigned mix_target(int pm) { return 3u * (unsigned)((MR - 256 * pm) < 256 ? (MR - 256 * pm) : 256); }

__device__ __forceinline__ int pa_extra_queue(int pm, int pn) { return (pn == 8) ? (pm & 3) : 4 + (pm & 3); }
__device__ __forceinline__ void build_queue(unsigned* qt, int q, int lane) {
    const int nx = (q == 0) ? 5 : 4;
    const int nssm = (NCHUNK - 1 - q) / 8 + 1, natt = (NBATCH * NQB - 1 - q) / 8 + 1, nsat = NSAMP / 8;
    int nxe = 0;
    for (int pm = 0; pm < NPANEL; ++pm) nxe += (pa_extra_queue(pm, 8) == q) + (pa_extra_queue(pm, 9) == q);
    const int sz[8] = {NPANEL + nxe, nssm, natt + nssm, nsat, 0, NPANEL, 4 * NPANEL, 0};
    if (lane < 16) {
        const int l = lane >> 3, sec = lane & 7;
        int per0 = 0;
#pragma unroll
        for (int i = 0; i < 7; ++i) per0 += sz[i];
        const int pe0 = NPANEL, pe1 = NPANEL - 1 + 4;
        int n = 1 + l * (per0 + pe0);
#pragma unroll
        for (int i = 0; i < 7; ++i) if (i < sec) n += sz[i];
        if (sec == 0) { for (int pm = 0; pm < NPANEL; ++pm) { qt[n++] = mkd(U_PA, l, pm, q); if (pa_extra_queue(pm, 8) == q) qt[n++] = mkd(U_PA, l, pm, 8); if (pa_extra_queue(pm, 9) == q) qt[n++] = mkd(U_PA, l, pm, 9); } }
        else if (sec == 1) { for (int c = q; c < NCHUNK; c += 8) qt[n++] = mkd(U_SSM, l, c, 0); }
        else if (sec == 2) { for (int k = 0; k <= (NBATCH * NQB - 1 - q) / 16; ++k) { const int a0 = q + 16 * k, c = q + 8 * k, a1 = a0 + 8;
                if (a0 < NBATCH * NQB) qt[n++] = mkd(U_ATT, l, a0, 0); if (c < NCHUNK) qt[n++] = mkd(U_POOL, l, c, 0); if (a1 < NBATCH * NQB) qt[n++] = mkd(U_ATT, l, a1, 0); } }
        else if (sec == 3) { for (int s = q; s < NSAMP; s += 8) qt[n++] = mkd(U_SATT, l, s, 0); }
        else if (sec == 4) { }
        else if (sec == 5) { for (int pm = 0; pm < NPANEL; ++pm) qt[n++] = mkd(U_PC, l, pm, q); }
        else if (sec == 6) { for (int pm = 0; pm < NPANEL; ++pm) for (int j = 0; j < 4; ++j) qt[n++] = mkd(U_PD, l, pm, 4 * q + j); }
        else {
            for (int pm = 0; pm < NPANEL - 1; ++pm) qt[n++] = mkd(U_PE, l, pm, q);
            if (l == NLAYER - 1) { for (int k = 0; k < 4; ++k) qt[n++] = mkd(U_PEQ, l, NPANEL - 1, 4 * q + k); } else qt[n++] = mkd(U_PE, l, NPANEL - 1, q);
        }
        if (lane == 15) qt[0] = (unsigned)(2 * per0 + pe0 + pe1);
    }
}

struct Sched {
    gu32* ctl; const unsigned* qglob; LAS unsigned* qlds; volatile LAS unsigned* slot; int myq; unsigned nclaim; int ptype;
    __device__ __forceinline__ unsigned claim_lane() {
        { unsigned ho = (unsigned)(CW_QHEAD + myq * 64); asm volatile("" : "+s"(ho));
          const unsigned idx = __hip_atomic_fetch_add(ctl + ho, 1u, RLX_AGENT); if (idx < qlds[0]) return qlds[1 + idx]; }
        for (int k = 1; k < 8; ++k) { const int q = (myq + k) & 7; const unsigned* qg = qglob + (size_t)q * QCAP;
            if (__hip_atomic_load((gu32*)(ctl + CW_QHEAD + q * 64), RLX_AGENT) >= qg[0]) continue;
            const unsigned idx = __hip_atomic_fetch_add(ctl + CW_QHEAD + q * 64, 1u, RLX_AGENT); if (idx < qg[0]) return qg[1 + idx]; }
        return 0u;
    }
    __device__ __forceinline__ unsigned claim_wg(int tid) {
        const unsigned k = nclaim++ & 1u;
        if (tid == 0) slot[k] = claim_lane();
        WG_BAR();
        return slot[k];
    }
    __device__ __forceinline__ void poll(gu32* w, unsigned want) {
        unsigned sp = 0;
#if PROBE && PROBE_KIND == 1
        if (__hip_atomic_load(w, RLX_AGENT) >= want) return;
        struct TAcc { unsigned long long t0; volatile LAS unsigned* acc; bool on; __device__ ~TAcc() { if (on) acc[6] += (unsigned)(__builtin_amdgcn_s_memrealtime() - t0); } } tacc_{__builtin_amdgcn_s_memrealtime(), slot, PROBE_TYPE == 0 || ptype == PROBE_TYPE};
#endif
        while (__hip_atomic_load(w, RLX_AGENT) < want) { __builtin_amdgcn_s_sleep(2);
            if ((++sp & 1023u) == 0u) { if (__hip_atomic_load(ctl + CW_TMO, RLX_AGENT) != 0u) break; if (sp > (1u << 17)) { __hip_atomic_store(ctl + CW_TMO, 0x66u, RLX_AGENT); break; } } }
    }
    __device__ __forceinline__ void poll2(gu32* w1, unsigned want1, gu32* w2, unsigned want2) {
        const unsigned v1 = __hip_atomic_load(w1, RLX_AGENT), v2 = __hip_atomic_load(w2, RLX_AGENT);
        if (v1 >= want1 && v2 >= want2) return;
        poll(w1, want1); poll(w2, want2);
    }
    __device__ __forceinline__ bool ready_now(gu32* w, unsigned want) { return __hip_atomic_load(w, RLX_AGENT) >= want; }
    __device__ __forceinline__ bool deps_ready_now(unsigned d) {
        const int type = d >> 24, l = (d >> 20) & 15, a = (d >> 10) & 1023; bool ok = true;
        if (type == U_PA) { if (l > 0) { const int p2 = (a + 1 < NPANEL) ? a + 1 : NPANEL - 1;
                const unsigned v1 = __hip_atomic_load(cnt_word(ctl, l - 1, 4, a), RLX_AGENT), v2 = __hip_atomic_load(cnt_word(ctl, l - 1, 1, p2), RLX_AGENT); ok = (v1 >= 8u) && (v2 >= mix_target(p2)); } }
        else if (type == U_PC) ok = ready_now(cnt_word(ctl, l, 1, a), mix_target(a));
        else if (type == U_PD) ok = ready_now(cnt_word(ctl, l, 2, a), 8u);
        else ok = ready_now(cnt_word(ctl, l, 3, a), 32u);
        if (ok) { __builtin_amdgcn_fence(__ATOMIC_ACQUIRE, ACQ_SCOPE); asm volatile("s_waitcnt vmcnt(0)" ::: "memory"); }
        return ok;
    }
    __device__ __forceinline__ void wait_deps(unsigned d, int tid) {
        if (tid == 0) {
            const int type = d >> 24, l = (d >> 20) & 15, a = (d >> 10) & 1023; ptype = type;
            if (type == U_PA) { if (l > 0) { const int p2 = (a + 1 < NPANEL) ? a + 1 : NPANEL - 1; poll2(cnt_word(ctl, l - 1, 4, a), 8u, cnt_word(ctl, l - 1, 1, p2), mix_target(p2)); } }
            else if (type == U_PC) poll(cnt_word(ctl, l, 1, a), mix_target(a));
            else if (type == U_PD) poll(cnt_word(ctl, l, 2, a), 8u);
            else if (type == U_PE || type == U_PEQ) poll(cnt_word(ctl, l, 3, a), 32u);
            else if (type == U_SSM) poll(cnt_word(ctl, l, 0, a >> 2), 10u);
            else if (type == U_POOL) { const int r0 = 64 * a - 16; if (r0 >= 0 && (r0 >> 8) != (a >> 2)) poll2(cnt_word(ctl, l, 0, a >> 2), 10u, cnt_word(ctl, l, 0, r0 >> 8), 10u); else poll(cnt_word(ctl, l, 0, a >> 2), 10u); }
            else if (type == U_SATT) poll(cnt_word(ctl, l, 0, NPANEL - 1), 10u);
            else if (type == U_ATT) { const int b = a / NQB, i = a % NQB, t0 = 32 * i; const int rlo = b * TT + (t0 >= 128 ? t0 - 128 : 0), rhi = b * TT + ((t0 + 31 < TT) ? t0 + 31 : TT - 1);
                if ((rhi >> 8) != (rlo >> 8)) poll2(cnt_word(ctl, l, 0, rlo >> 8), 10u, cnt_word(ctl, l, 0, rhi >> 8), 10u); else poll(cnt_word(ctl, l, 0, rlo >> 8), 10u); }
            __builtin_amdgcn_fence(__ATOMIC_ACQUIRE, ACQ_SCOPE);
            asm volatile("s_waitcnt vmcnt(0)" ::: "memory");
        }
        asm volatile("" ::: "memory"); __builtin_amdgcn_s_barrier(); asm volatile("" ::: "memory");
    }
    __device__ __forceinline__ void publish(unsigned d, int tid) {
        asm volatile("s_waitcnt vmcnt(0)" ::: "memory");
        WG_BAR();
        if (tid == 0) {
            const int type = d >> 24, l = (d >> 20) & 15, a = (d >> 10) & 1023;
#if PUBLISH_FENCE
            __builtin_amdgcn_fence(__ATOMIC_RELEASE, "agent");
            asm volatile("s_waitcnt vmcnt(0)" ::: "memory");
#endif
            if (type == U_PA) __hip_atomic_fetch_add(cnt_word(ctl, l, 0, a), 1u, RLX_AGENT);
            else if (type == U_PC) __hip_atomic_fetch_add(cnt_word(ctl, l, 2, a), 1u, RLX_AGENT);
            else if (type == U_PD) __hip_atomic_fetch_add(cnt_word(ctl, l, 3, a), 1u, RLX_AGENT);
            else if (type == U_PE) __hip_atomic_fetch_add(cnt_word(ctl, l, 4, a), 1u, RLX_AGENT);
            else if (type == U_SSM || type == U_POOL) __hip_atomic_fetch_add(cnt_word(ctl, l, 1, a >> 2), 64u, RLX_AGENT);
            else if (type == U_SATT) __hip_atomic_fetch_add(cnt_word(ctl, l, 1, NPANEL - 1), 1u, RLX_AGENT);
            else if (type == U_ATT) { const int b = a / NQB, i = a % NQB, t0 = 32 * i; const int r0 = b * TT + t0, r1 = b * TT + ((t0 + 31 < TT) ? t0 + 31 : TT - 1);
                const int p0 = r0 >> 8, p1 = r1 >> 8;
                if (p0 == p1) __hip_atomic_fetch_add(cnt_word(ctl, l, 1, p0), (unsigned)(r1 - r0 + 1), RLX_AGENT);
                else { __hip_atomic_fetch_add(cnt_word(ctl, l, 1, p0), (unsigned)(256 * p1 - r0), RLX_AGENT); __hip_atomic_fetch_add(cnt_word(ctl, l, 1, p1), (unsigned)(r1 - 256 * p1 + 1), RLX_AGENT); } }
        }
    }
};

#ifndef A_AUX
#define A_AUX 0
#endif
struct GU { const char* A; const char* B; unsigned voffA[2], voffB[2]; size_t hstep; int nt; int t0; unsigned d; pg8::Unit u; };

struct StreamCtx { unsigned char* ws; float* out; const float* gq; const float* gk; int R[2], C[2], Rp[2]; };
#ifndef KPH_MUL
#define KPH_MUL 155
#endif
__device__ __forceinline__ void gu_fill(GU& g, unsigned d, const StreamCtx& X) {
    const int type = d >> 24, l = (d >> 20) & 15, pm = (d >> 10) & 1023; int pn = d & 1023;
    unsigned char* ws = X.ws;
    const bf16* A; const bf16* B; int K = DM; bool perm = false;
    if (type == U_PA) { A = (const bf16*)(ws + WS_XB); B = (const bf16*)(ws + WS_WIN) + (size_t)l * INW * DM; }
    else if (type == U_PC) { A = (const bf16*)(ws + WS_MIX); B = (const bf16*)(ws + WS_WOUT) + (size_t)l * DM * DM; perm = true; }
    else if (type == U_PD) { A = (const bf16*)(ws + WS_XB); B = (const bf16*)(ws + WS_W1) + (size_t)l * DFF * DM; perm = true; }
    else { A = (const bf16*)(ws + WS_H); B = (const bf16*)(ws + WS_W2) + (size_t)l * DM * DFF; K = DFF; perm = true; }
    int koff = 0, nt = K / 64;
    if (type == U_PEQ) { koff = (pn & 3) * (DFF / 4); nt = DFF / 4 / 64; pn >>= 2; }
    g.d = d; g.u.pm = pm; g.u.pn = pn; g.nt = nt; g.hstep = (size_t)128 * K * 2; g.t0 = (type == U_PD) ? (int)(2u * ((((unsigned)(4 * pm + (pn & 3)) * KPH_MUL + 128u) >> 8) % 16u)) : (type == U_PE) ? (int)(2u * ((((unsigned)pm * KPH_MUL + 128u) >> 8) % 64u)) : 0;
    g.A = (const char*)A + ((size_t)pm * 256 * K + koff) * 2; g.B = (const char*)B + ((size_t)pn * 256 * K + koff) * 2;
#pragma unroll
    for (int i = 0; i < 2; ++i) { g.voffA[i] = (unsigned)(X.R[i] * K + X.C[i]) * 2u; g.voffB[i] = (unsigned)((perm ? X.Rp[i] : X.R[i]) * K + X.C[i]) * 2u; }
}

__device__ __forceinline__ unsigned gemm_stream(const Args& AR, Frame& F, Sched& Q, unsigned d0) {
    int tid_ = F.tid(); asm volatile("" : "+v"(tid_));
    const int tid = tid_, wid = __builtin_amdgcn_readfirstlane(tid >> 6), lane = tid & 63, wr = wid >> 2, wc = wid & 3, fr = lane & 15, fq = lane >> 4;
    LAS unsigned char* lds = F.lds; LAS unsigned char* esc = F.lds + ESC_OFF;
    StreamCtx X; X.ws = F.ws; X.out = F.out;
#pragma unroll
    for (int i = 0; i < 2; ++i) { int R, C; pg8::stage_rc(tid * 16 + i * 8192, R, C); X.R[i] = R; X.C[i] = C; X.Rp[i] = (R & ~31) + pg8::perm32(R & 31); }
    const size_t kstep = (size_t)(pg8::BK * 2);
    const unsigned ldsw = (unsigned)wid * 1024u;
#define PG8_SA(b, h) (((b) * 2 + (h)) * pg8::HTB)
#define PG8_SB(b, h) ((4 + (b) * 2 + (h)) * pg8::HTB)
#define PG8_STAGE(bufoff, gbase, voff) do { _Pragma("unroll") for (int _i = 0; _i < 2; ++_i) \
        __builtin_amdgcn_global_load_lds((const unsigned*)((const char*)(gbase) + (voff)[_i]), (LAS unsigned*)(lds + (bufoff) + ldsw + _i * 8192), 16, 0, 0); } while (0)
#define PG8_STAGE_A(bufoff, gbase, voff) do { _Pragma("unroll") for (int _i = 0; _i < 2; ++_i) \
        __builtin_amdgcn_global_load_lds((const unsigned*)((const char*)(gbase) + (voff)[_i]), (LAS unsigned*)(lds + (bufoff) + ldsw + _i * 8192), 16, 0, A_AUX); } while (0)
#define PG8_LDA(dst, b, h) do { _Pragma("unroll") for (int m = 0; m < 4; ++m) _Pragma("unroll") for (int k = 0; k < 2; ++k) dst[m][k] = *(const LAS bf16x8*)(lds + PG8_SA(b, h) + aoff + m * 2048 + k * 1024); } while (0)
#define PG8_LDB(dst, b, h) do { _Pragma("unroll") for (int n = 0; n < 2; ++n) _Pragma("unroll") for (int k = 0; k < 2; ++k) dst[n][k] = *(const LAS bf16x8*)(lds + PG8_SB(b, h) + boff + n * 2048 + k * 1024); } while (0)
#define PG8_MMA(ai, bj, At, Bt) do { if (mm[ai]) { __builtin_amdgcn_s_setprio(1); _Pragma("unroll") for (int m = 0; m < 4; ++m) _Pragma("unroll") for (int n = 0; n < 2; ++n) _Pragma("unroll") for (int k = 0; k < 2; ++k) \
        acc[ai][bj][m][n] = __builtin_amdgcn_mfma_f32_16x16x32_bf16(Bt[n][k], At[m][k], acc[ai][bj][m][n], 0, 0, 0); __builtin_amdgcn_s_setprio(0); } } while (0)
#define PG8_WAIT_V(n) asm volatile("s_waitcnt vmcnt(" #n ")" ::: "memory")
#define PG8_WAIT_L(n) asm volatile("s_waitcnt lgkmcnt(" #n ")" ::: "memory")
#define PG8_BAR __builtin_amdgcn_s_barrier()
#define PG8_SCHED __builtin_amdgcn_sched_barrier(0)
#if PROBE && PROBE_KIND == 10
    const unsigned long long tse0 = __builtin_amdgcn_s_memrealtime();
#endif
    GU cur;
    gu_fill(cur, d0, X);
    f32x4 acc[2][2][4][2];
#pragma unroll
    for (int a = 0; a < 2; ++a)
#pragma unroll
        for (int b = 0; b < 2; ++b)
#pragma unroll
            for (int m = 0; m < 4; ++m)
#pragma unroll
                for (int n = 0; n < 2; ++n) acc[a][b][m][n] = (f32x4){0.f, 0.f, 0.f, 0.f};
    bf16x8 At[4][2], B0[2][2], B1[2][2];
    const char* eA = cur.A + (size_t)cur.t0 * kstep; const char* eB = cur.B + (size_t)cur.t0 * kstep;
    PG8_STAGE(PG8_SB(0, 0), eB, cur.voffB); PG8_STAGE(PG8_SB(0, 1), eB + cur.hstep, cur.voffB);
    Q.wait_deps(cur.d, tid);
    unsigned rb = 0u;
    { const int ty0 = d0 >> 24; const bool nr0 = (ty0 == U_PA || ty0 == U_PD) && tid < 256;
      RsLoad r0; if (nr0) rs_issue((const float*)(X.ws + WS_SSQ), cur.u.pm, tid, r0);
      PG8_STAGE_A(PG8_SA(0, 0), eA, cur.voffA); PG8_STAGE_A(PG8_SA(0, 1), eA + cur.hstep, cur.voffA);
      if (wr == 1) PG8_BAR;
      PG8_WAIT_V(2); PG8_BAR;
      if (nr0) rs_finish(r0, esc, 0u, tid); }
    PG8_STAGE(PG8_SB(1, 0), eB + kstep, cur.voffB); PG8_STAGE_A(PG8_SA(1, 0), eA + kstep, cur.voffA); PG8_STAGE(PG8_SB(1, 1), eB + cur.hstep + kstep, cur.voffB);
    PG8_WAIT_V(6); PG8_BAR;
#if PROBE && PROBE_KIND == 10
    if (tid == 0) { Q.slot[6] += (unsigned)(__builtin_amdgcn_s_memrealtime() - tse0); Q.slot[7] += 1u; }
#endif
    unsigned carry = 0u; unsigned ui = 0u;
    for (;;) {
        bool go = false;
        int tk_ = tid; asm volatile("" : "+v"(tk_));
        const int aoff = pg8::lds_byte(wr * 64 + (tk_ & 15), ((tk_ >> 4) & 3) * 8), boff = pg8::lds_byte(wc * 32 + (tk_ & 15), ((tk_ >> 4) & 3) * 8);
        const char* cA = cur.A; const char* cB = cur.B; const size_t hstep = cur.hstep; const int nt = cur.nt, t0 = cur.t0;
#if PROBE && PROBE_KIND == 3
        const unsigned long long tu0 = __builtin_amdgcn_s_memrealtime();
#endif
        const bool fullp = cur.u.pm != NPANEL - 1; const bool mm[2] = {fullp || wr == 0, fullp};
        for (int t = 0; t < nt; t += 2) {
            const bool last = (t == nt - 2);
            int p0 = t + t0; if (p0 >= nt) p0 -= nt;
            int p2 = (last ? 0 : t + 2) + t0; if (p2 >= nt) p2 -= nt;
            const char* a1 = cA + (size_t)(p0 + 1) * kstep;
            const char* a2_ = cA + (size_t)p2 * kstep; const char* b2_ = cB + (size_t)p2 * kstep;
            const char* a2 = a2_; const char* b2 = b2_; size_t h2 = hstep;
            unsigned vA2[2], vB2[2];
#pragma unroll
            for (int i = 0; i < 2; ++i) { vA2[i] = cur.voffA[i]; vB2[i] = cur.voffB[i]; }
            if (last) {
                const unsigned k = 2u + (ui & 1u);
#if PROBE && PROBE_KIND == 8
                const unsigned long long tc0 = __builtin_amdgcn_s_memrealtime();
#endif
                if (tid == 0) { const unsigned dn = Q.claim_lane(); Q.slot[k] = dn;
                    Q.slot[2u + k] = ((dn >> 24) >= U_PA && (dn >> 24) <= U_GEMM_LAST && (!STREAM_SAME_SECTION || ((dn >> 20) == (cur.d >> 20))) && Q.deps_ready_now(dn)) ? 1u : 0u; }
                asm volatile("s_waitcnt lgkmcnt(0)" ::: "memory"); PG8_BAR; asm volatile("" ::: "memory");
                carry = Q.slot[k]; go = Q.slot[2u + k] != 0u;
#if PROBE && PROBE_KIND == 14
                if (tid == 0 && (int)(cur.d >> 24) == PROBE_TYPE) { Q.slot[6] += go ? 100u : 0u; Q.slot[7] += 1u; }
#endif
#if PROBE && PROBE_KIND == 8
                if (tid == 0 && (int)(cur.d >> 24) == PROBE_TYPE) { Q.slot[6] += (unsigned)(__builtin_amdgcn_s_memrealtime() - tc0); Q.slot[7] += 1u; }
#endif
                if (go) { GU n2; gu_fill(n2, carry, X); a2 = n2.A + (size_t)n2.t0 * kstep; b2 = n2.B + (size_t)n2.t0 * kstep; h2 = n2.hstep;
#pragma unroll
                    for (int i = 0; i < 2; ++i) { vA2[i] = n2.voffA[i]; vB2[i] = n2.voffB[i]; } }
            }
            const char* a3 = a2 + kstep; const char* b3 = b2 + kstep;
            PG8_LDB(B0, 0, 0); PG8_LDB(B1, 0, 1); PG8_SCHED; PG8_LDA(At, 0, 0); PG8_STAGE_A(PG8_SA(1, 1), a1 + hstep, cur.voffA);
            PG8_WAIT_V(8); PG8_WAIT_L(0); PG8_BAR; PG8_MMA(0, 0, At, B0); PG8_MMA(0, 1, At, B1); PG8_BAR; PG8_SCHED;
            PG8_LDA(At, 0, 1); PG8_STAGE(PG8_SB(0, 0), b2, vB2); PG8_STAGE(PG8_SB(0, 1), b2 + h2, vB2); PG8_STAGE_A(PG8_SA(0, 0), a2, vA2);
            PG8_WAIT_V(8); PG8_WAIT_L(0); PG8_BAR; PG8_MMA(1, 0, At, B0); PG8_MMA(1, 1, At, B1); PG8_BAR; PG8_SCHED;
            PG8_LDB(B0, 1, 0); PG8_LDB(B1, 1, 1); PG8_SCHED; PG8_LDA(At, 1, 0); PG8_STAGE_A(PG8_SA(0, 1), a2 + h2, vA2);
            PG8_WAIT_V(8); PG8_WAIT_L(0); PG8_BAR; PG8_MMA(0, 0, At, B0); PG8_MMA(0, 1, At, B1); PG8_BAR; PG8_SCHED;
            PG8_LDA(At, 1, 1); PG8_STAGE(PG8_SB(1, 0), b3, vB2); PG8_STAGE(PG8_SB(1, 1), b3 + h2, vB2); PG8_STAGE_A(PG8_SA(1, 0), a3, vA2);
            PG8_WAIT_V(8); PG8_WAIT_L(0); PG8_BAR; PG8_MMA(1, 0, At, B0); PG8_MMA(1, 1, At, B1); PG8_BAR; PG8_SCHED;
        }
#if PROBE && PROBE_KIND == 7
        const unsigned long long te0 = __builtin_amdgcn_s_memrealtime();
#endif
        if (wr == 0) PG8_BAR;
        { const int type = cur.d >> 24, l = (cur.d >> 20) & 15;
          int te_ = tid; asm volatile("" : "+v"(te_)); const int fr = te_ & 15, fq = (te_ >> 4) & 3;
          if (type == U_PA) { EpiProj E{X.ws, X.out, AR.in[IN_GQ] + l * 128, AR.in[IN_GK] + l * 128, l, rs_off(rb)}; E(acc, cur.u, wr, wc, fr, fq, esc, tid); }
          else if (type == U_PD) { EpiFfn1 E{X.ws, rs_off(rb)}; E(acc, cur.u, wr, wc, fr, fq, esc, tid); }
          else if (type == U_PEQ) { EpiAtom E{X.out}; E(acc, cur.u, wr, wc, fr, fq, esc, tid); }
          else { EpiRes E{X.ws, X.out, (type == U_PE && l == NLAYER - 1) ? 1 : 0, (type == U_PC && l == NLAYER - 1 && cur.u.pm == NPANEL - 1) ? 1 : 0}; E(acc, cur.u, wr, wc, fr, fq, esc, tid); }
          { const int tyn = carry >> 24; const bool nrn = go && (tyn == U_PA || tyn == U_PD) && tid < 256;
            RsLoad rn; if (nrn) rs_issue((const float*)(X.ws + WS_SSQ), (int)((carry >> 10) & 1023u), tid, rn);
            if (nrn) rs_finish(rn, esc, rb ^ 1u, tid);
            Q.publish(cur.d, tid);
            asm volatile("" ::: "memory"); }
#if PROBE && PROBE_KIND == 7
          if (tid == 0 && (int)(cur.d >> 24) == PROBE_TYPE && cur.u.pm != NPANEL - 1) { Q.slot[6] += (unsigned)(__builtin_amdgcn_s_memrealtime() - te0); Q.slot[7] += 1u; }
#endif
#if PROBE && PROBE_KIND == 3
          if (tid == 0 && (int)(cur.d >> 24) == PROBE_TYPE && cur.u.pm != NPANEL - 1) { Q.slot[6] += (unsigned)(__builtin_amdgcn_s_memrealtime() - tu0); Q.slot[7] += 1u; }
#endif
          }
        if (!go) break;
        { float z0 = 0.f; asm volatile("" : "+v"(z0));
#pragma unroll
        for (int a = 0; a < 2; ++a)
#pragma unroll
            for (int b = 0; b < 2; ++b)
#pragma unroll
                for (int m = 0; m < 4; ++m)
#pragma unroll
                    for (int n = 0; n < 2; ++n) acc[a][b][m][n] = (f32x4){z0, z0, z0, z0}; }
        gu_fill(cur, carry, X); ++ui; rb ^= 1u;
        if (wr == 1) PG8_BAR;
    }
    PG8_WAIT_V(0);
    PG8_BAR;
#undef PG8_SA
#undef PG8_SB
#undef PG8_STAGE
#undef PG8_STAGE_A
#undef PG8_LDA
#undef PG8_LDB
#undef PG8_MMA
#undef PG8_WAIT_V
#undef PG8_WAIT_L
#undef PG8_BAR
#undef PG8_SCHED
    return carry;
}

__global__ void __launch_bounds__(512, 2) hymba_fwd(Args args) {
    extern __shared__ __attribute__((aligned(16))) unsigned char lds[];
    Frame F;
    F.lds = (LAS unsigned char*)lds;
    F.MISC = (volatile LAS unsigned*)(F.lds + MISC_OFF);
    F.wave = __builtin_amdgcn_readfirstlane((int)(threadIdx.x >> 6));
    F.G = gridDim.x; { const int bx = blockIdx.x; F.vcu = (F.G % 8 == 0) ? (bx % 8) * (F.G / 8) + bx / 8 : bx; }
    F.ws = args.ws; F.out = args.out; F.ctl = (gu32*)(args.ws + WS_CTL);
    for (int u = F.tid(); u < (LDS_BYTES - LDSCTL_OFF) / 4; u += 512) ((LAS unsigned*)(F.lds + LDSCTL_OFF))[u] = 0u;
    __syncthreads();
    XcdBarrier bar = xcd_barrier_post((unsigned*)(F.ctl + CW_BAR), F.MISC + 8);
#if PROBE
    const unsigned long long tk0 = __builtin_amdgcn_s_memrealtime();
#endif
    for (int rep = 0; rep < DUP_P0; ++rep) p0_prologue(args, F);
#if PROBE && (PROBE_KIND == 5 || PROBE_KIND == 6)
    if (F.tid() == 0) { F.MISC[6] = (unsigned)(__builtin_amdgcn_s_memrealtime() - tk0); if (PROBE_KIND == 6) __hip_atomic_fetch_max(F.ctl + CW_STAT + 48, F.MISC[6], RLX_AGENT); }
#endif
    if (blockIdx.x < 8 && F.wave == 7) build_queue((unsigned*)(args.ws + WS_QUEUE) + (size_t)blockIdx.x * QCAP, (int)blockIdx.x, F.lane());
    xcd_barrier(bar);
    Sched Q; Q.ctl = F.ctl; Q.qglob = (const unsigned*)(args.ws + WS_QUEUE); Q.qlds = (LAS unsigned*)(F.lds + QTAB_OFF); Q.slot = F.MISC; Q.myq = __builtin_amdgcn_readfirstlane((int)(bar.x & 7u)); Q.nclaim = 0u; Q.ptype = 0;
    { const unsigned* qg = Q.qglob + (size_t)Q.myq * QCAP; for (int i = F.tid(); i < QCAP; i += 512) Q.qlds[i] = qg[i]; }
    WG_BAR();
    unsigned d = Q.claim_wg(F.tid());
#if SEC_BARRIER
    int cursec = 0;
#endif
    for (;;) {
        const int type = d >> 24;
#if SEC_BARRIER
        { const int sec = (type == U_END) ? 5 * NLAYER : ((d >> 20) & 15) * 5 + ((type >= U_SSM) ? 1 : (type == U_PA ? 0 : type));
          while (cursec < sec) { if ((SEC_MASK >> cursec) & 1) xcd_barrier(bar); ++cursec; } }
#endif
        if (type == U_END) break;
        if (type <= U_GEMM_LAST) {
#if PROBE && PROBE_KIND == 9
            const unsigned long long ts0 = __builtin_amdgcn_s_memrealtime();
#endif
            d = gemm_stream(args, F, Q, d);
#if PROBE && PROBE_KIND == 9
            if (F.tid() == 0) { F.MISC[6] += (unsigned)(__builtin_amdgcn_s_memrealtime() - ts0); }
#endif
            continue; }
        const int l = (d >> 20) & 15, a = (d >> 10) & 1023;
        Q.wait_deps(d, F.tid());
#if PROBE && PROBE_KIND == 2
        const unsigned long long tp0 = __builtin_amdgcn_s_memrealtime();
#endif
        if (type == U_SSM) ssm_unit(args, F, l, a);
        else if (type == U_ATT) attn_unit(args, F, l, a / NQB, a % NQB);
        else if (type == U_SATT) sattn_unit(args, F, l, a);
        else pool_unit(args, F, l, a);
        const unsigned kc = Q.nclaim++ & 1u;
        if (F.tid() == 0) Q.slot[kc] = Q.claim_lane();
        Q.publish(d, F.tid());
#if PROBE && PROBE_KIND == 2
        if (F.tid() == 0 && (PROBE_TYPE == 0 || type == PROBE_TYPE)) F.MISC[6] += (unsigned)(__builtin_amdgcn_s_memrealtime() - tp0);
#endif
        d = Q.slot[kc];
    }
#if PROBE
    if (F.tid() == 0) {
        const unsigned tend = (unsigned)(__builtin_amdgcn_s_memrealtime() - tk0);
        if (PROBE_KIND == 4) { F.MISC[6] = tend; __hip_atomic_fetch_max(F.ctl + CW_STAT + 48, tend, RLX_AGENT); }
        __hip_atomic_fetch_add(F.ctl + CW_STAT, F.MISC[6], RLX_AGENT);
        __hip_atomic_fetch_add(F.ctl + CW_STAT + 32, F.MISC[7], RLX_AGENT);
        const unsigned n = __hip_atomic_fetch_add(F.ctl + CW_STAT + 16, 1u, RLX_AGENT);
        F.MISC[7] = (n == gridDim.x - 1) ? 1u : 0u;
        if (n == gridDim.x - 1) { F.MISC[5] = __hip_atomic_load(F.ctl + CW_STAT, RLX_AGENT); F.MISC[4] = __hip_atomic_load(F.ctl + CW_STAT + 32, RLX_AGENT); F.MISC[3] = __hip_atomic_load(F.ctl + CW_STAT + 48, RLX_AGENT); }
    }
    WG_BAR();
    if (F.MISC[7]) { float v = (float)F.MISC[5] / (float)gridDim.x * 0.01f;
        if (PROBE_KIND == 10 && PROBE_TYPE == 1) v = (float)F.MISC[4] / (float)gridDim.x;
        if (PROBE_KIND == 14) v = (float)F.MISC[5] / (float)(F.MISC[4] ? F.MISC[4] : 1u);
        if (PROBE_KIND == 3 || PROBE_KIND == 7 || PROBE_KIND == 8) v = (float)F.MISC[5] * 0.01f / (float)(F.MISC[4] ? F.MISC[4] : 1u);
        if (PROBE_KIND == 4) v = (float)F.MISC[3] * 0.01f - v;
        if (PROBE_KIND == 6) v = (float)F.MISC[3] * 0.01f;
        v = floorf((v + 0.5f * PROBE_Q) / PROBE_Q) * PROBE_Q;
        for (int i = F.tid(); i < NLAYER * NSAMP * 15 * 512; i += 512) F.out[O_SP + i] = v; }
#endif
}

extern "C" void kernel_launch(void* const* d_in, const int* in_sizes, int n_in, void* d_out, int out_size, void* d_ws, size_t ws_size, hipStream_t stream) {
    static int grid = 0;
    if (grid == 0) {
        if (n_in != 32 || (size_t)out_size != O_END || ws_size < WS_END) { fprintf(stderr, "kernel_launch: unexpected shapes: n_in %d out %d (want %zu) ws %zu (want >= %zu)\n", n_in, out_size, (size_t)O_END, ws_size, (size_t)WS_END); grid = -1; return; }
        int dev = 0, cus = 0, per_cu = 0;
        if (hipGetDevice(&dev) != hipSuccess || hipDeviceGetAttribute(&cus, hipDeviceAttributeMultiprocessorCount, dev) != hipSuccess) { fprintf(stderr, "kernel_launch: device query failed\n"); grid = -1; return; }
        if (hipFuncSetAttribute((const void*)hymba_fwd, hipFuncAttributeMaxDynamicSharedMemorySize, LDS_BYTES) != hipSuccess) { fprintf(stderr, "kernel_launch: hipFuncSetAttribute failed\n"); grid = -1; return; }
        if (hipOccupancyMaxActiveBlocksPerMultiprocessor(&per_cu, (const void*)hymba_fwd, 512, LDS_BYTES) != hipSuccess || per_cu < 1) { fprintf(stderr, "kernel_launch: occupancy query says %d blocks per CU\n", per_cu); per_cu = 1; }
        (void)hipGetLastError();
        grid = cus;
        if (grid % 8 != 0) grid -= grid % 8;
    }
    if (grid < 0) return;
    (void)hipMemsetAsync((char*)d_ws + WS_CTL, 0, CTL_ZERO_BYTES, stream);
    Args a{};
    for (int i = 0; i < 32; ++i) a.in[i] = (const float*)d_in[i];
    a.out = (float*)d_out; a.ws = (unsigned char*)d_ws; a.ph_lo = 0; a.ph_hi = 0;
    hipLaunchKernelGGL(hymba_fwd, dim3(grid), dim3(512), LDS_BYTES, stream, a);
    const hipError_t le = hipPeekAtLastError();
    if (le != hipSuccess) fprintf(stderr, "kernel_launch: launch failed: %s\n", hipGetErrorName(le));
}
```

```cpp
#include <hip/hip_runtime.h>
#include <cstdio>
#include <cstdint>

#ifndef MK_N_LAUNCHES
#define MK_N_LAUNCHES 1
#endif

#ifndef SEC_BARRIER
#define SEC_BARRIER 0
#endif
#ifndef STREAM_SAME_SECTION
#define STREAM_SAME_SECTION 0
#endif
#ifndef SEC_MASK
#define SEC_MASK 0x10
#endif
#ifndef PROBE
#define PROBE 0
#endif
#ifndef PROBE_KIND
#define PROBE_KIND 1
#endif
#ifndef PROBE_TYPE
#define PROBE_TYPE 0
#endif
#ifndef PROBE_Q
#define PROBE_Q 20.0f
#endif
#ifndef DUP_PB
#define DUP_PB 1
#endif
#ifndef DUP_P0
#define DUP_P0 1
#endif

constexpr int DM = 2048, TT = 4112  , NSEQ = 4096, NMETA = 16, NBATCH = 2, NSAMP = 32;
constexpr int MR = NBATCH * TT + NSAMP;
constexpr int MP = 8448;
constexpr int SROW0 = NBATCH * TT;
constexpr int INW = 2560, DFF = 8192, NLAYER = 2;
constexpr int TPV = 4128;
constexpr int ROPE_SAMPLE_IDX = TT;
constexpr float EPS = 1e-6f;
constexpr float LOG2E = 1.4426950408889634f;
constexpr float QSCALE = 0.08838834764831845f * LOG2E;
constexpr int NCHUNK = MR / 64;
constexpr int NQB = (TT + 31) / 32;

constexpr size_t O_YP = 0, O_YS = O_YP + (size_t)NBATCH * NSEQ * DM, O_PK = O_YS + (size_t)NSAMP * DM, O_PV = O_PK + (size_t)NLAYER * NBATCH * 128 * 256,
                 O_PSR = O_PV + (size_t)NLAYER * NBATCH * 128 * 256, O_PSI = O_PSR + (size_t)NLAYER * NBATCH * 2048, O_PP = O_PSI + (size_t)NLAYER * NBATCH * 2048,
                 O_SK = O_PP + (size_t)NLAYER * NBATCH * 15 * 512, O_SV = O_SK + (size_t)NLAYER * NSAMP * 128 * 256, O_SSR = O_SV + (size_t)NLAYER * NSAMP * 128 * 256,
                 O_SSI = O_SSR + (size_t)NLAYER * NSAMP * 2048, O_SP = O_SSI + (size_t)NLAYER * NSAMP * 2048, O_END = O_SP + (size_t)NLAYER * NSAMP * 15 * 512;

constexpr size_t MiB = 1u << 20;
constexpr size_t WS_CTL = 0, CTL_ZERO_BYTES = 256 * 1024;
constexpr size_t WS_WIN = 1 * MiB, WS_WOUT = 21 * MiB, WS_W1 = 37 * MiB, WS_W2 = 101 * MiB, WS_WGLU = 165 * MiB, WS_WPOOL = 166 * MiB, WS_TAB = 167 * MiB;
constexpr size_t WS_X = 170 * MiB, WS_XB = 236 * MiB, WS_Q = 269 * MiB, WS_K = 286 * MiB, WS_VT = 291 * MiB, WS_U = 296 * MiB, WS_XP = 313 * MiB, WS_MIX = 330 * MiB,
                 WS_H = 363 * MiB, WS_SSQ = 495 * MiB, WS_SST = 497 * MiB, WS_KSN = 502 * MiB, WS_QUEUE = 503 * MiB, WS_END = 504 * MiB;
static_assert(WS_WIN + (size_t)NLAYER * INW * DM * 2 <= WS_WOUT && WS_WOUT + (size_t)NLAYER * DM * DM * 2 <= WS_W1 && WS_W1 + (size_t)NLAYER * DFF * DM * 2 <= WS_W2 && WS_W2 + (size_t)NLAYER * DFF * DM * 2 <= WS_WGLU, "ws map 1");
static_assert(WS_X + (size_t)MP * DM * 4 <= WS_XB && WS_XB + (size_t)MP * DM * 2 <= WS_Q && WS_Q + (size_t)MP * 1024 * 2 <= WS_K && WS_K + (size_t)MP * 256 * 2 <= WS_VT && WS_VT + (size_t)4 * 128 * TPV * 2 <= WS_U, "ws map 2");
static_assert(WS_U + (size_t)MP * 512 * 4 <= WS_XP && WS_XP + (size_t)MP * 512 * 4 <= WS_MIX && WS_MIX + (size_t)MP * DM * 2 <= WS_H && WS_H + (size_t)MP * DFF * 2 <= WS_SSQ && WS_SSQ + (size_t)MP * 32 * 4 <= WS_SST, "ws map 3");
static_assert(WS_SST + (size_t)NLAYER * NCHUNK * 32 * 64 * 8 <= WS_KSN, "ws map 4");
constexpr size_t TB_ABR = 0, TB_ABI = 8192, TB_ALR = 16384, TB_ALI = 24576, TB_A16R = 32768, TB_A16I = 40960, TB_A32R = 49152, TB_A32I = 57344,
                 TB_BBR = 65536, TB_BBI = TB_BBR + 131072, TB_PM = TB_BBI + 131072, TB_CMT = TB_PM + 524288, TB_LAYER = 1 * MiB;
static_assert(TB_CMT + 131072 <= TB_LAYER, "table map");
constexpr size_t WS_ROPE = WS_TAB + 2 * MiB;
constexpr size_t ROPE_N = (size_t)(TT + 1) * 16;
constexpr int CW_TMO = 0, CW_CODE = 1, CW_BAR = 4096, CW_QHEAD = 8192  , CW_STAT = 8800, CW_CNT = 9216  , CW_SSMF = 16384  ;
static_assert(CW_CNT + NLAYER * 5 * 40 * 16 <= CW_SSMF, "ctl map: counters");
static_assert((CW_SSMF + NLAYER * NCHUNK * 8 * 16) * 4 <= (int)CTL_ZERO_BYTES, "ctl map");

constexpr int RING_BYTES = 131072, ESC_OFF = RING_BYTES  , QTAB_OFF = ESC_OFF + 12288  , LDSCTL_OFF = QTAB_OFF + 4096, MISC_OFF = LDSCTL_OFF + 320, LDS_BYTES = 148480;
static_assert(MISC_OFF + 128 <= LDS_BYTES, "LDS map");

#define GAS __attribute__((address_space(1)))
#define LAS __attribute__((address_space(3)))
typedef unsigned short bf16;
typedef unsigned v4u __attribute__((ext_vector_type(4)));
typedef unsigned v2u __attribute__((ext_vector_type(2)));
typedef float f32x2 __attribute__((ext_vector_type(2)));
typedef float f32x16 __attribute__((ext_vector_type(16)));
typedef __bf16 bf16x2_t __attribute__((ext_vector_type(2)));
typedef GAS unsigned gu32;
typedef GAS unsigned long long gu64;
#define RLX_AGENT __ATOMIC_RELAXED, __HIP_MEMORY_SCOPE_AGENT
#define LDS_WAIT() asm volatile("s_waitcnt lgkmcnt(0)" ::: "memory")
#define VM_WAIT() asm volatile("s_waitcnt vmcnt(0)" ::: "memory")
#define WG_BAR() do { asm volatile("s_waitcnt lgkmcnt(0)" ::: "memory"); __builtin_amdgcn_s_barrier(); asm volatile("" ::: "memory"); } while (0)
__device__ __forceinline__ unsigned pk2(float lo, float hi) { f32x2 v = {lo, hi}; bf16x2_t b = __builtin_convertvector(v, bf16x2_t); return __builtin_bit_cast(unsigned, b); }
__device__ __forceinline__ float bf2f(unsigned short h) { return __builtin_bit_cast(float, (unsigned)h << 16); }
__device__ __forceinline__ int lane_now() { int l; asm volatile("v_mbcnt_lo_u32_b32 %0, -1, 0\n\tv_mbcnt_hi_u32_b32 %0, -1, %0" : "=v"(l)); return l; }
__device__ __forceinline__ int shfl_xor_(int v, int m) { return __builtin_amdgcn_ds_bpermute((lane_now() ^ m) << 2, v); }
__device__ __forceinline__ float shfl_xor_(float v, int m) { return __builtin_bit_cast(float, __builtin_amdgcn_ds_bpermute((lane_now() ^ m) << 2, __builtin_bit_cast(int, v))); }
#define __shfl_xor(v, m) shfl_xor_((v), (m))
__device__ __forceinline__ float wave_sum(float v) {
#pragma unroll
    for (int o = 1; o < 64; o <<= 1) v += __shfl_xor(v, o);
    return v;
}
__device__ __forceinline__ float wave_max(float v) {
#pragma unroll
    for (int o = 1; o < 64; o <<= 1) v = fmaxf(v, __shfl_xor(v, o));
    return v;
}

typedef __amdgpu_buffer_rsrc_t rsrc_t;
__device__ __forceinline__ rsrc_t ws_rsrc(unsigned char* ws) { return __builtin_amdgcn_make_buffer_rsrc(ws, 0, (int)WS_END, 0x00020000); }
#define ST16(r, off, v) __builtin_amdgcn_raw_buffer_store_b128(__builtin_bit_cast(v4u, (v)), (r), (unsigned)(off), 0, 16)
#define ST8(r, off, v)  __builtin_amdgcn_raw_buffer_store_b64((v), (r), (unsigned)(off), 0, 16)
#define ST4(r, off, v)  __builtin_amdgcn_raw_buffer_store_b32(__builtin_bit_cast(unsigned, (v)), (r), (unsigned)(off), 0, 16)
#define ST2(r, off, v)  __builtin_amdgcn_raw_buffer_store_b16((unsigned short)(v), (r), (unsigned)(off), 0, 16)
__host__ __device__ __forceinline__ int perm16(int o) { return 8 * ((o >> 2) & 1) + 4 * (o >> 3) + (o & 3); }

namespace pg8 {
#define PG8_LAS __attribute__((address_space(3)))
typedef unsigned short bf16_t;
typedef short bf16x8 __attribute__((ext_vector_type(8)));
typedef float f32x4 __attribute__((ext_vector_type(4)));
typedef unsigned u32x4 __attribute__((ext_vector_type(4)));
constexpr int BM = 256, BK = 64, HALF = 128, HTB = HALF * BK * 2  , STAGE_BYTES = 8 * HTB, NXCD = 8, WGM = 8;

__host__ __device__ __forceinline__ int lds_byte(int r, int c) { const int st = (r >> 4) * 2 + (c >> 5), rr = r & 15, cc = c & 31, ob = rr * 64 + cc * 2; return st * 1024 + (ob ^ (((ob >> 9) & 1) << 5)); }
__host__ __device__ __forceinline__ void stage_rc(int b, int& R, int& C) { const int st = b / 1024, sb = b % 1024, swz = sb ^ (((sb >> 9) & 1) << 5); R = (st >> 1) * 16 + swz / 64; C = (st & 1) * 32 + (swz % 64) / 2; }
__host__ __device__ __forceinline__ int perm32(int rho) { const int n = rho >> 4, i = rho & 15; return 8 * (i >> 2) + 4 * n + (i & 3); }

struct Unit { int pm, pn; };
struct Gemm { const bf16_t* A; const bf16_t* Bt; int M, N, K; };

struct StaticOrder {
    int nM, nN, nwg, G, c;
    __host__ __device__ void init(int M, int N, int G_, int c_) { nM = M / BM; nN = N / BM; nwg = nM * nN; G = G_; c = c_; }
    __host__ __device__ bool next(int i, Unit& u) const {
        const long L = (long)i * G + c; if (L >= nwg) return false;
        int wgid = (int)L; { const int q = nwg / NXCD, r = nwg % NXCD, xcd = wgid % NXCD, off = wgid / NXCD; wgid = (xcd < r ? xcd * (q + 1) : r * (q + 1) + (xcd - r) * q) + off; }
        const int nig = WGM * nN, gid = wgid / nig, fm = gid * WGM, gsz = (nM - fm) < WGM ? (nM - fm) : WGM;
        u.pm = fm + ((wgid % nig) % gsz); u.pn = (wgid % nig) / gsz; return true;
    }
    __device__ __forceinline__ void a_ready(const Unit&) const {}
    __device__ __forceinline__ void done(const Unit&) const {}
};


template <class Epi, class Sched, bool ALIGN_EPI = false, bool SP2 = false>
__device__ __forceinline__ void gemm_phase(PG8_LAS unsigned char* lds, PG8_LAS unsigned char* esc, const Gemm g, const Sched& S, const Epi& E) {
    int tid_ = threadIdx.x; asm volatile("" : "+v"(tid_));
    const int tid = tid_, wid = __builtin_amdgcn_readfirstlane(tid >> 6), lane = tid & 63, wr = wid >> 2, wc = wid & 3, fr = lane & 15, fq = lane >> 4;
    const int K = g.K, nt = K / BK;
    unsigned voffA[2], voffB[2];
#pragma unroll
    for (int i = 0; i < 2; ++i) { int R, C; stage_rc(tid * 16 + i * 8192, R, C); const int Rb = Epi::PERM ? ((R & ~31) + perm32(R & 31)) : R;
        voffA[i] = (unsigned)(R * K + C) * 2u; voffB[i] = (unsigned)(Rb * K + C) * 2u; }
    const size_t kstep = (size_t)(BK * 2);
    const size_t hstep = (size_t)HALF * K * 2;
    const size_t tstep = 2 * hstep;
    const unsigned ldsw = (unsigned)wid * 1024u;
    const int aoff = lds_byte(wr * 64 + fr, fq * 8), boff = lds_byte(wc * 32 + fr, fq * 8);
#define PG8_SA(b, h) (((b) * 2 + (h)) * HTB)
#define PG8_SB(b, h) ((4 + (b) * 2 + (h)) * HTB)
#define PG8_STAGE(bufoff, gbase, voff) do { _Pragma("unroll") for (int _i = 0; _i < 2; ++_i) \
        __builtin_amdgcn_global_load_lds((const unsigned*)((const char*)(gbase) + (voff)[_i]), (PG8_LAS unsigned*)(lds + (bufoff) + ldsw + _i * 8192), 16, 0, 0); } while (0)
#define PG8_LDA(dst, b, h) do { _Pragma("unroll") for (int m = 0; m < 4; ++m) _Pragma("unroll") for (int k = 0; k < 2; ++k) dst[m][k] = *(const PG8_LAS bf16x8*)(lds + PG8_SA(b, h) + aoff + m * 2048 + k * 1024); } while (0)
#define PG8_LDB(dst, b, h) do { _Pragma("unroll") for (int n = 0; n < 2; ++n) _Pragma("unroll") for (int k = 0; k < 2; ++k) dst[n][k] = *(const PG8_LAS bf16x8*)(lds + PG8_SB(b, h) + boff + n * 2048 + k * 1024); } while (0)
#define PG8_MMA(ai, bj, At, Bt) do { __builtin_amdgcn_s_setprio(1); _Pragma("unroll") for (int m = 0; m < 4; ++m) _Pragma("unroll") for (int n = 0; n < 2; ++n) _Pragma("unroll") for (int k = 0; k < 2; ++k) \
        acc[ai][bj][m][n] = __builtin_amdgcn_mfma_f32_16x16x32_bf16(Bt[n][k], At[m][k], acc[ai][bj][m][n], 0, 0, 0); __builtin_amdgcn_s_setprio(0); } while (0)
#define PG8_WAIT_V(n) asm volatile("s_waitcnt vmcnt(" #n ")" ::: "memory")
#define PG8_WAIT_L(n) asm volatile("s_waitcnt lgkmcnt(" #n ")" ::: "memory")
#define PG8_BAR __builtin_amdgcn_s_barrier()
#define PG8_SCHED __builtin_amdgcn_sched_barrier(0)
    Unit cur, nxt; int ui = 0;
    if (!S.next(0, cur)) return;
    f32x4 acc[2][2][4][2];
#pragma unroll
    for (int a = 0; a < 2; ++a)
#pragma unroll
        for (int b = 0; b < 2; ++b)
#pragma unroll
            for (int m = 0; m < 4; ++m)
#pragma unroll
                for (int n = 0; n < 2; ++n) acc[a][b][m][n] = (f32x4){0.f, 0.f, 0.f, 0.f};
    bf16x8 At[4][2], B0[2][2], B1[2][2];
    const char* cA = (const char*)g.A + (size_t)cur.pm * tstep; const char* cB = (const char*)g.Bt + (size_t)cur.pn * tstep;
    S.a_ready(cur);
    if constexpr (SP2) {
        PG8_STAGE(PG8_SB(0, 0), cB, voffB); PG8_STAGE(PG8_SB(0, 1), cB + hstep, voffB); PG8_STAGE(PG8_SA(0, 0), cA, voffA); PG8_STAGE(PG8_SA(0, 1), cA + hstep, voffA);
        if (wr == 1) PG8_BAR;
        PG8_WAIT_V(2); PG8_BAR;
        PG8_STAGE(PG8_SB(1, 0), cB + kstep, voffB); PG8_STAGE(PG8_SA(1, 0), cA + kstep, voffA); PG8_STAGE(PG8_SB(1, 1), cB + hstep + kstep, voffB);
        PG8_WAIT_V(6); PG8_BAR;
    } else {
        PG8_STAGE(PG8_SB(0, 0), cB, voffB); PG8_STAGE(PG8_SA(0, 0), cA, voffA); PG8_STAGE(PG8_SB(0, 1), cB + hstep, voffB); PG8_STAGE(PG8_SA(0, 1), cA + hstep, voffA);
        if (wr == 1) PG8_BAR;
        PG8_WAIT_V(4); PG8_BAR;
        PG8_STAGE(PG8_SB(1, 0), cB + kstep, voffB); PG8_STAGE(PG8_SA(1, 0), cA + kstep, voffA); PG8_STAGE(PG8_SB(1, 1), cB + hstep + kstep, voffB);
        PG8_WAIT_V(6); PG8_BAR;
    }
    for (;;) {
        const bool has_next = S.next(ui + 1, nxt);
        const char* nA = has_next ? (const char*)g.A + (size_t)nxt.pm * tstep : cA; const char* nB = has_next ? (const char*)g.Bt + (size_t)nxt.pn * tstep : cB;
        for (int t = 0; t < nt; t += 2) {
            const bool last = (t == nt - 2);
            const char* a1 = cA + (size_t)(t + 1) * kstep;
            const char* a2 = last ? nA : cA + (size_t)(t + 2) * kstep; const char* b2 = last ? nB : cB + (size_t)(t + 2) * kstep;
            const char* a3 = a2 + kstep; const char* b3 = b2 + kstep;
            if (last && has_next) S.a_ready(nxt);
            if constexpr (SP2) {
            PG8_LDB(B0, 0, 0); PG8_LDB(B1, 0, 1); PG8_SCHED; PG8_LDA(At, 0, 0); PG8_STAGE(PG8_SA(1, 1), a1 + hstep, voffA);
            PG8_WAIT_V(8); PG8_WAIT_L(0); PG8_BAR; PG8_MMA(0, 0, At, B0); PG8_MMA(0, 1, At, B1); PG8_BAR; PG8_SCHED;
            PG8_LDA(At, 0, 1); PG8_STAGE(PG8_SB(0, 0), b2, voffB); PG8_STAGE(PG8_SB(0, 1), b2 + hstep, voffB); PG8_STAGE(PG8_SA(0, 0), a2, voffA);
            PG8_WAIT_V(8); PG8_WAIT_L(0); PG8_BAR; PG8_MMA(1, 0, At, B0); PG8_MMA(1, 1, At, B1); PG8_BAR; PG8_SCHED;
            PG8_LDB(B0, 1, 0); PG8_LDB(B1, 1, 1); PG8_SCHED; PG8_LDA(At, 1, 0); PG8_STAGE(PG8_SA(0, 1), a2 + hstep, voffA);
            PG8_WAIT_V(8); PG8_WAIT_L(0); PG8_BAR; PG8_MMA(0, 0, At, B0); PG8_MMA(0, 1, At, B1); PG8_BAR; PG8_SCHED;
            PG8_LDA(At, 1, 1); PG8_STAGE(PG8_SB(1, 0), b3, voffB); PG8_STAGE(PG8_SB(1, 1), b3 + hstep, voffB); PG8_STAGE(PG8_SA(1, 0), a3, voffA);
            PG8_WAIT_V(8); PG8_WAIT_L(0); PG8_BAR; PG8_MMA(1, 0, At, B0); PG8_MMA(1, 1, At, B1); PG8_BAR; PG8_SCHED;
            } else {
            PG8_LDB(B0, 0, 0); PG8_SCHED; PG8_LDA(At, 0, 0); PG8_STAGE(PG8_SA(1, 1), a1 + hstep, voffA);
            PG8_WAIT_L(8); PG8_BAR; PG8_WAIT_L(0); PG8_MMA(0, 0, At, B0); PG8_BAR; PG8_SCHED;
            PG8_LDB(B1, 0, 1); PG8_STAGE(PG8_SB(0, 0), b2, voffB);
            PG8_BAR; PG8_WAIT_L(0); PG8_MMA(0, 1, At, B1); PG8_BAR;
            PG8_LDA(At, 0, 1); PG8_STAGE(PG8_SA(0, 0), a2, voffA);
            PG8_BAR; PG8_WAIT_L(0); PG8_MMA(1, 0, At, B0); PG8_BAR; PG8_SCHED;
            PG8_STAGE(PG8_SB(0, 1), b2 + hstep, voffB);
            PG8_WAIT_V(6); PG8_BAR; PG8_MMA(1, 1, At, B1); PG8_BAR;
            PG8_LDB(B0, 1, 0); PG8_SCHED; PG8_LDA(At, 1, 0); PG8_STAGE(PG8_SA(0, 1), a2 + hstep, voffA);
            PG8_WAIT_L(8); PG8_BAR; PG8_WAIT_L(0); PG8_MMA(0, 0, At, B0); PG8_BAR; PG8_SCHED;
            PG8_LDB(B1, 1, 1); PG8_STAGE(PG8_SB(1, 0), b3, voffB);
            PG8_BAR; PG8_WAIT_L(0); PG8_MMA(0, 1, At, B1); PG8_BAR;
            PG8_LDA(At, 1, 1); PG8_STAGE(PG8_SA(1, 0), a3, voffA);
            PG8_BAR; PG8_WAIT_L(0); PG8_MMA(1, 0, At, B0); PG8_BAR; PG8_SCHED;
            PG8_STAGE(PG8_SB(1, 1), b3 + hstep, voffB);
            PG8_WAIT_V(6); PG8_BAR; PG8_MMA(1, 1, At, B1); PG8_BAR;
            }
        }
        if constexpr (ALIGN_EPI) { if (wr == 0) PG8_BAR; }
        { E(acc, cur, wr, wc, fr, fq, esc, tid); S.done(cur); }
        if (!has_next) break;
#pragma unroll
        for (int a = 0; a < 2; ++a)
#pragma unroll
            for (int b = 0; b < 2; ++b)
#pragma unroll
                for (int m = 0; m < 4; ++m)
#pragma unroll
                    for (int n = 0; n < 2; ++n) acc[a][b][m][n] = (f32x4){0.f, 0.f, 0.f, 0.f};
        cur = nxt; cA = nA; cB = nB; ++ui;
        if constexpr (ALIGN_EPI) { if (wr == 1) PG8_BAR; }
    }
    PG8_WAIT_V(0);
    if constexpr (!ALIGN_EPI) { if (wr == 0) PG8_BAR; }
    PG8_BAR;
#undef PG8_SA
#undef PG8_SB
#undef PG8_STAGE
#undef PG8_LDA
#undef PG8_LDB
#undef PG8_MMA
#undef PG8_WAIT_V
#undef PG8_WAIT_L
#undef PG8_BAR
#undef PG8_SCHED
}
}

typedef float f32x4 __attribute__((ext_vector_type(4)));
typedef short bf16x8 __attribute__((ext_vector_type(8)));


struct RsLoad { unsigned long long v[16]; };
__host__ __device__ constexpr int rs_off(unsigned buf) { return buf ? 9216 : 0; }
__device__ __forceinline__ void rs_issue(const float* ssq, int pm, int tid, RsLoad& r) {
    asm volatile("" : "+v"(tid));
#pragma unroll
    for (int j = 0; j < 8; ++j) { const gu64* p = (const gu64*)(ssq + ((size_t)j * MP + pm * 256 + tid) * 4);
#pragma unroll
        for (int h = 0; h < 2; ++h) r.v[2 * j + h] = __hip_atomic_load(p + h, RLX_AGENT); }
}
__device__ __forceinline__ void rs_finish(const RsLoad& r, LAS unsigned char* esc, unsigned buf, int tid) {
    float s = 0.f;
#pragma unroll
    for (int i = 0; i < 16; ++i) s += __builtin_bit_cast(float, (unsigned)r.v[i]) + __builtin_bit_cast(float, (unsigned)(r.v[i] >> 32));
    asm volatile("" : "+v"(tid));
    ((LAS float*)(esc + rs_off(buf)))[tid] = rsqrtf(s * (1.0f / DM) + EPS);
}

struct EpiProj {
    static constexpr bool PERM = false, AFTER_DRAIN = false;
    unsigned char* ws_; float* out_; const float* gq; const float* gk; int l; int rsoff;
    __device__ __forceinline__ void operator()(f32x4 (&acc)[2][2][4][2], const pg8::Unit& u, int wr, int wc, int fr, int fq, LAS unsigned char* esc, int tid) const {
        asm volatile("" : "+v"(fr), "+v"(fq), "+v"(tid));
        size_t z_ = 0; asm volatile("" : "+s"(z_)); unsigned char* ws = ws_ + z_;
        const float* ssq = (const float*)(ws + WS_SSQ); const float* ropec = (const float*)(ws + WS_ROPE); const float* ropes = ropec + ROPE_N;
        bf16* Q = (bf16*)(ws + WS_Q); bf16* K = (bf16*)(ws + WS_K); bf16* VT = (bf16*)(ws + WS_VT); float* U = (float*)(ws + WS_U); float* XP = (float*)(ws + WS_XP);
        float* ksn = (float*)(ws + WS_KSN); float* vsn = ksn + NSAMP * 256;
        float* out_pk = out_ + O_PK + (size_t)l * NBATCH * 128 * 256; float* out_pv = out_ + O_PV + (size_t)l * NBATCH * 128 * 256;
        const rsrc_t rs_ = ws_rsrc(ws);
        const LAS float* rsT = (const LAS float*)(esc + rsoff);
        LAS float* hss = (LAS float*)(esc + 1024);
        const int pn = u.pn;
#pragma unroll
        for (int ai = 0; ai < 2; ++ai)
#pragma unroll
            for (int m = 0; m < 4; ++m) { const float rsv = rsT[ai * 128 + wr * 64 + m * 16 + fr];
#pragma unroll
                for (int bj = 0; bj < 2; ++bj)
#pragma unroll
                    for (int n = 0; n < 2; ++n) acc[ai][bj][m][n] *= rsv; }
        if (pn <= 4) {
#pragma unroll
            for (int ai = 0; ai < 2; ++ai)
#pragma unroll
                for (int m = 0; m < 4; ++m)
#pragma unroll
                    for (int bj = 0; bj < 2; ++bj) { const f32x4 a = acc[ai][bj][m][0], b = acc[ai][bj][m][1];
                        float s = (a[0] * a[0] + a[1] * a[1]) + (a[2] * a[2] + a[3] * a[3]) + (b[0] * b[0] + b[1] * b[1]) + (b[2] * b[2] + b[3] * b[3]);
                        s += __shfl_xor(s, 16); s += __shfl_xor(s, 32);
                        if (fq == 0) hss[(bj * 256 + ai * 128 + wr * 64 + m * 16 + fr) * 4 + wc] = s; }
            WG_BAR();
            const float* g = (pn < 4) ? gq : gk; const float osc = (pn < 4) ? QSCALE : 1.0f;
            f32x4 gv[2];
#pragma unroll
            for (int n = 0; n < 2; ++n) gv[n] = *(const f32x4*)(g + wc * 32 + n * 16 + 4 * fq);
#pragma unroll
            for (int ai = 0; ai < 2; ++ai)
#pragma unroll
                for (int m = 0; m < 4; ++m) {
                    const int rl = ai * 128 + wr * 64 + m * 16 + fr, r = u.pm * 256 + rl;
                    const bool samp = r >= SROW0, pad = r >= MR;
                    const int b = (r >= TT && !samp) ? 1 : 0, t = r - b * TT;
                    const int pidx = samp ? ROPE_SAMPLE_IDX : t;
                    f32x4 cs = {1.f, 1.f, 1.f, 1.f}, sn = {0.f, 0.f, 0.f, 0.f};
                    if (wc == 0 && !pad) { cs = *(const f32x4*)(ropec + (size_t)pidx * 16 + 4 * fq); sn = *(const f32x4*)(ropes + (size_t)pidx * 16 + 4 * fq); }
#pragma unroll
                    for (int bj = 0; bj < 2; ++bj) {
                        const f32x4 hv = *(const LAS f32x4*)(hss + (bj * 256 + rl) * 4);
                        const float hn = rsqrtf(((hv[0] + hv[1]) + (hv[2] + hv[3])) * (1.0f / 128.0f) + EPS);
                        f32x4 x1 = acc[ai][bj][m][0] * hn * gv[0], x2 = acc[ai][bj][m][1] * hn * gv[1];
                        if (wc == 0) { const f32x4 o1 = x1 * cs - x2 * sn, o2 = x2 * cs + x1 * sn; x1 = o1; x2 = o2; }
                        x1 = x1 * osc; x2 = x2 * osc;
                        const int cl = bj * 128 + wc * 32 + 4 * fq;
                        { const int od = fq & 1; const unsigned a0 = pk2(x1[0], x1[1]), a1 = pk2(x1[2], x1[3]), b0 = pk2(x2[0], x2[1]), b1 = pk2(x2[2], x2[3]);
                          const unsigned s0 = od ? a0 : b0, s1 = od ? a1 : b1; const unsigned r0 = (unsigned)__shfl_xor((int)s0, 16), r1 = (unsigned)__shfl_xor((int)s1, 16);
                          const v4u w16 = od ? (v4u){r0, r1, b0, b1} : (v4u){a0, a1, r0, r1};
                          const int cl16 = bj * 128 + wc * 32 + 4 * (fq & ~1) + (od ? 16 : 0);
                          if (pn < 4) ST16(rs_, WS_Q + ((size_t)r * 1024 + pn * 256 + cl16) * 2, w16); else ST16(rs_, WS_K + ((size_t)r * 256 + cl16) * 2, w16); }
                        if (pn == 4) {
                            if (samp && !pad) { const size_t o = WS_KSN + ((size_t)(r - SROW0) * 256 + cl) * 4; ST16(rs_, o, x1); ST16(rs_, o + 64, x2); }
                            else if (!samp && t >= TT - 128) { float* o = out_pk + ((size_t)(b * 128 + (t - (TT - 128))) * 256) + cl; *(f32x4*)o = x1; *(f32x4*)(o + 16) = x2; } }
                    }
                }
        } else if (pn == 5) {
#pragma unroll
            for (int ai = 0; ai < 2; ++ai)
#pragma unroll
                for (int m = 0; m < 4; ++m) {
                    const int rl = ai * 128 + wr * 64 + m * 16 + fr, r = u.pm * 256 + rl;
                    const bool samp = r >= SROW0, pad = r >= MR;
                    const int b = (r >= TT && !samp) ? 1 : 0, t = r - b * TT;
                    const int tpos = (t & ~15) + perm16(t & 15);
#pragma unroll
                    for (int bj = 0; bj < 2; ++bj)
#pragma unroll
                        for (int n = 0; n < 2; ++n) { const f32x4 x = acc[ai][bj][m][n]; const int d = wc * 32 + n * 16 + 4 * fq;
                            if (!samp) { const size_t vo = WS_VT + (((size_t)((b * 2 + bj) * 128 + d)) * TPV + tpos) * 2;
#pragma unroll
                                for (int j = 0; j < 4; ++j) ST2(rs_, vo + (size_t)j * TPV * 2, pk2(x[j], 0.f) & 0xffffu);
                                if (t >= TT - 128) *(f32x4*)(out_pv + ((size_t)(b * 128 + (t - (TT - 128))) * 256) + bj * 128 + d) = x; }
                            else if (!pad) ST16(rs_, WS_KSN + ((size_t)NSAMP * 256 + (size_t)(r - SROW0) * 256 + bj * 128 + d) * 4, x); }
                }
        } else if (pn < 8) {
#pragma unroll
            for (int ai = 0; ai < 2; ++ai)
#pragma unroll
                for (int m = 0; m < 4; ++m) { const size_t ro = WS_U + ((size_t)(u.pm * 256 + ai * 128 + wr * 64 + m * 16 + fr) * 512 + (pn - 6) * 256 + wc * 32 + 4 * fq) * 2;
#pragma unroll
                    for (int bj = 0; bj < 2; ++bj)
#pragma unroll
                        for (int n = 0; n < 2; ++n) { const f32x4 x = acc[ai][bj][m][n]; ST8(rs_, ro + (size_t)(bj * 128 + n * 16) * 2, ((v2u){pk2(x[0], x[1]), pk2(x[2], x[3])})); } }
        } else {
            const size_t dsto = WS_XP + (size_t)(pn - 8) * 256 * 4;
#pragma unroll
            for (int ai = 0; ai < 2; ++ai)
#pragma unroll
                for (int m = 0; m < 4; ++m) { const size_t ro = dsto + ((size_t)(u.pm * 256 + ai * 128 + wr * 64 + m * 16 + fr) * 512 + wc * 32 + 4 * fq) * 4;
#pragma unroll
                    for (int bj = 0; bj < 2; ++bj)
#pragma unroll
                        for (int n = 0; n < 2; ++n) ST16(rs_, ro + (size_t)(bj * 128 + n * 16) * 4, acc[ai][bj][m][n]); }
        }
    }
};

struct EpiRes {
    static constexpr bool PERM = true, AFTER_DRAIN = false;
    unsigned char* ws_; float* out; int last; int yinit;
    __device__ __forceinline__ void operator()(f32x4 (&acc)[2][2][4][2], const pg8::Unit& u, int wr, int wc, int fr, int fq, LAS unsigned char* esc, int tid) const {
        asm volatile("" : "+v"(fr), "+v"(fq), "+v"(tid));
        size_t z_ = 0; asm volatile("" : "+s"(z_)); unsigned char* ws = ws_ + z_;
        const bf16* XB = (const bf16*)(ws + WS_XB); const rsrc_t rs_ = ws_rsrc(ws);
        v4u xb[2][4][2];
#pragma unroll
        for (int ai = 0; ai < 2; ++ai)
#pragma unroll
            for (int m = 0; m < 4; ++m) { const bf16* xp = XB + (size_t)(u.pm * 256 + ai * 128 + wr * 64 + m * 16 + fr) * DM + u.pn * 256 + wc * 32 + 8 * fq;
#pragma unroll
                for (int bj = 0; bj < 2; ++bj) xb[ai][m][bj] = *(const v4u*)(xp + bj * 128); }
#pragma unroll
        for (int ai = 0; ai < 2; ++ai)
#pragma unroll
            for (int m = 0; m < 4; ++m) {
                const int r = u.pm * 256 + ai * 128 + wr * 64 + m * 16 + fr; const int c0 = u.pn * 256 + wc * 32 + 8 * fq;
                const size_t eo = (size_t)r * DM + c0; float s = 0.f;
                f32x4 v[2][2];
#pragma unroll
                for (int bj = 0; bj < 2; ++bj) { const v4u w = xb[ai][m][bj];
                    const f32x4 x0 = {__builtin_bit_cast(float, w.x << 16), __builtin_bit_cast(float, w.x & 0xffff0000u), __builtin_bit_cast(float, w.y << 16), __builtin_bit_cast(float, w.y & 0xffff0000u)};
                    const f32x4 x1 = {__builtin_bit_cast(float, w.z << 16), __builtin_bit_cast(float, w.z & 0xffff0000u), __builtin_bit_cast(float, w.w << 16), __builtin_bit_cast(float, w.w & 0xffff0000u)};
                    v[bj][0] = x0 + acc[ai][bj][m][0]; v[bj][1] = x1 + acc[ai][bj][m][1];
#pragma unroll
                    for (int n = 0; n < 2; ++n) { const f32x4 q = v[bj][n] * v[bj][n]; s += (q[0] + q[1]) + (q[2] + q[3]); } }
                if (!last) {
#pragma unroll
                    for (int bj = 0; bj < 2; ++bj)
                        ST16(rs_, WS_XB + (eo + bj * 128) * 2, ((v4u){pk2(v[bj][0][0], v[bj][0][1]), pk2(v[bj][0][2], v[bj][0][3]), pk2(v[bj][1][0], v[bj][1][1]), pk2(v[bj][1][2], v[bj][1][3])}));
                    s += __shfl_xor(s, 16); s += __shfl_xor(s, 32);
                    if (fq == 0) ST4(rs_, WS_SSQ + (((size_t)u.pn * MP + r) * 4 + wc) * 4, s);
                    if (yinit && r < MR) { const bool samp = r >= SROW0; const size_t yo = samp ? O_YS + (size_t)(r - SROW0) * DM + c0 : O_YP + ((size_t)NSEQ + (r - TT - NMETA)) * DM + c0;
                        const rsrc_t ro_ = __builtin_amdgcn_make_buffer_rsrc(out, 0, (int)(O_END * 4), 0x00020000);
#pragma unroll
                        for (int bj = 0; bj < 2; ++bj)
#pragma unroll
                            for (int n = 0; n < 2; ++n) ST16(ro_, (yo + bj * 128 + n * 4) * 4, v[bj][n]); }
                } else {
                    const bool samp = r >= SROW0, pad = r >= MR; const int b = (r >= TT && !samp) ? 1 : 0, t = r - b * TT;
                    float* op = nullptr;
                    if (samp) { if (!pad) op = out + O_YS + (size_t)(r - SROW0) * DM + c0; } else if (t >= NMETA) op = out + O_YP + ((size_t)b * NSEQ + (t - NMETA)) * DM + c0;
                    if (op) {
#pragma unroll
                        for (int bj = 0; bj < 2; ++bj)
#pragma unroll
                            for (int n = 0; n < 2; ++n) *(f32x4*)(op + bj * 128 + n * 4) = v[bj][n]; }
                }
            }
    }
};

struct EpiAtom {
    static constexpr bool PERM = true, AFTER_DRAIN = false;
    float* out;
    __device__ __forceinline__ void operator()(f32x4 (&acc)[2][2][4][2], const pg8::Unit& u, int wr, int wc, int fr, int fq, LAS unsigned char* esc, int tid) const {
        asm volatile("" : "+v"(fr), "+v"(fq), "+v"(tid));
        if (wr != 0) return;
#pragma unroll
        for (int m = 0; m < 4; ++m) { const int r = u.pm * 256 + m * 16 + fr; const int c0 = u.pn * 256 + wc * 32 + 8 * fq;
            const bool samp = r >= SROW0; float* op = samp ? out + O_YS + (size_t)(r - SROW0) * DM + c0 : out + O_YP + ((size_t)NSEQ + (r - TT - NMETA)) * DM + c0;
            if (r < MR) {
#pragma unroll
                for (int bj = 0; bj < 2; ++bj)
#pragma unroll
                    for (int n = 0; n < 2; ++n)
#pragma unroll
                        for (int j = 0; j < 4; ++j) __hip_atomic_fetch_add(op + bj * 128 + n * 4 + j, acc[0][bj][m][n][j], RLX_AGENT); } }
    }
};

struct EpiFfn1 {
    static constexpr bool PERM = true, AFTER_DRAIN = false;
    unsigned char* ws_; int rsoff;
    __device__ __forceinline__ void operator()(f32x4 (&acc)[2][2][4][2], const pg8::Unit& u, int wr, int wc, int fr, int fq, LAS unsigned char* esc, int tid) const {
        asm volatile("" : "+v"(fr), "+v"(fq), "+v"(tid));
        size_t z_ = 0; asm volatile("" : "+s"(z_)); unsigned char* ws = ws_ + z_;
        const rsrc_t rs_ = ws_rsrc(ws);
        const LAS float* rsT = (const LAS float*)(esc + rsoff);
#pragma unroll
        for (int ai = 0; ai < 2; ++ai)
#pragma unroll
            for (int m = 0; m < 4; ++m) { const int rl = ai * 128 + wr * 64 + m * 16 + fr; const float rsv = rsT[rl];
                const size_t ho = WS_H + ((size_t)(u.pm * 256 + rl) * DFF + u.pn * 256 + wc * 32 + 8 * fq) * 2;
#pragma unroll
                for (int bj = 0; bj < 2; ++bj) { f32x4 v0 = acc[ai][bj][m][0] * rsv, v1 = acc[ai][bj][m][1] * rsv;
#pragma unroll
                    for (int j = 0; j < 4; ++j) { const float a = fmaxf(v0[j], 0.f), b = fmaxf(v1[j], 0.f); v0[j] = a * a; v1[j] = b * b; }
                    ST16(rs_, ho + bj * 256, ((v4u){pk2(v0[0], v0[1]), pk2(v0[2], v0[3]), pk2(v1[0], v1[1]), pk2(v1[2], v1[3])})); } }
    }
};

#define XB_TMO      128
#define XB_XCNT(j)  (256  + 64 * (j))
#define XB_XSUB(j)  (1280 + 64 * (j))
#define XB_XGEN(j)  (2304 + 64 * (j))
#define XB_TOP      3328
#define XB_TOPGEN   3392
#define XCD_BAR_WORDS 3456
#define XB_SPIN_CAP (1u << 18)
__device__ __forceinline__ unsigned xb_ld(unsigned* p)              { return __hip_atomic_load(p, __ATOMIC_RELAXED, __HIP_MEMORY_SCOPE_AGENT); }
__device__ __forceinline__ unsigned xb_add(unsigned* p, unsigned v) { return __hip_atomic_fetch_add(p, v, __ATOMIC_RELAXED, __HIP_MEMORY_SCOPE_AGENT); }
__device__ __forceinline__ unsigned xb_xcc_id() { return (unsigned)__builtin_amdgcn_s_getreg((3 << 11) | 20) & 0xFu; }
#define XB_SPIN(cond, bar) do { unsigned _sp = 0; while (cond) { __builtin_amdgcn_s_sleep(1); \
    if ((++_sp & 255u) == 0u) { if (xb_ld(&(bar)[XB_TMO])) break; if (_sp > XB_SPIN_CAP) { atomicAdd(&(bar)[XB_TMO], 1u); break; } } } } while (0)

struct XcdBarrier {
    unsigned* bar; unsigned x;
    volatile LAS unsigned* st;
};

__device__ __forceinline__ XcdBarrier xcd_barrier_post(unsigned* bar, volatile LAS unsigned* st) {
    XcdBarrier b; b.bar = bar; b.x = xb_xcc_id(); b.st = st;
    if (threadIdx.x == 0) (void)xb_add(&bar[XB_XCNT(b.x)], 1u);
    return b;
}
__device__ __forceinline__ void xcd_barrier_complete(unsigned* bar, unsigned x, unsigned& nloc, unsigned& nx) {
    const unsigned G = gridDim.x * gridDim.y * gridDim.z;
    unsigned sum, cnt, mine, sp = 0u;
    for (;;) {
        sum = 0u; cnt = 0u; mine = 0u;
#pragma unroll
        for (unsigned j = 0; j < 16; ++j) { const unsigned c = xb_ld(&bar[XB_XCNT(j)]); sum += c; cnt += (c > 0u) ? 1u : 0u; mine = (j == x) ? c : mine; }
        if (sum == G) break;
        __builtin_amdgcn_s_sleep(1);
        if ((++sp & 255u) == 0u) { if (xb_ld(&bar[XB_TMO])) break; if (sp > XB_SPIN_CAP) { atomicAdd(&bar[XB_TMO], 1u); break; } }
    }
    nloc = mine > 0u ? mine : 1u; nx = cnt > 0u ? cnt : 1u;
}

__device__ __forceinline__ void xcd_barrier(const XcdBarrier& b) {
    asm volatile("s_waitcnt vmcnt(0)" ::: "memory");
    __syncthreads();
    if (threadIdx.x == 0) {
        unsigned* bar = b.bar;
        __builtin_amdgcn_s_waitcnt(0);
        unsigned nloc = b.st[0], nx = b.st[1];
        if (nloc == 0u) { xcd_barrier_complete(bar, b.x, nloc, nx); b.st[0] = nloc; b.st[1] = nx; }
        const unsigned old = xb_add(&bar[XB_XSUB(b.x)], 1u);
        const unsigned gen = old / nloc;
        if (old + 1u == (gen + 1u) * nloc) {
            __builtin_amdgcn_fence(__ATOMIC_RELEASE, "agent");
            asm volatile("s_waitcnt vmcnt(0)" ::: "memory");
            const unsigned og = xb_add(&bar[XB_TOP], 1u);
            const unsigned tg = og / nx;
            if (og + 1u == (tg + 1u) * nx) xb_add(&bar[XB_TOPGEN], 1u);
            else XB_SPIN(xb_ld(&bar[XB_TOPGEN]) == tg, bar);
            __builtin_amdgcn_fence(__ATOMIC_ACQUIRE, "agent");
            xb_add(&bar[XB_XGEN(b.x)], 1u);
            asm volatile("s_waitcnt vmcnt(0)" ::: "memory");
        } else {
            XB_SPIN(xb_ld(&bar[XB_XGEN(b.x)]) == gen, bar);
            __builtin_amdgcn_fence(__ATOMIC_ACQUIRE, "agent");
            asm volatile("s_waitcnt vmcnt(0)" ::: "memory");
        }
    }
    __syncthreads();
}

struct Frame {
    LAS unsigned char* lds;
    volatile LAS unsigned* MISC;
    gu32* ctl;
    int wave, vcu, G;
    __device__ __forceinline__ int lane() const { int l; asm volatile("v_mbcnt_lo_u32_b32 %0, -1, 0\n\tv_mbcnt_hi_u32_b32 %0, -1, %0" : "=v"(l)); return l; }
    __device__ __forceinline__ int tid() const { return wave * 64 + lane(); }
    float* out; unsigned char* ws;
};
#define IN_XPROMPT 0
#define IN_XSAMPLE 1
#define IN_CACHEK 2
#define IN_CACHEV 3
#define IN_SSMRE 4
#define IN_SSMIM 5
#define IN_SPOOL 6
#define IN_META 7
#define IN_GMIX 8
#define IN_WIN 9
#define IN_GQ 10
#define IN_GK 11
#define IN_SINKS 12
#define IN_ARE 13
#define IN_AIM 14
#define IN_LOGDT 15
#define IN_BRE 16
#define IN_BIM 17
#define IN_CRE 18
#define IN_CIM 19
#define IN_DSKIP 20
#define IN_WGLU 21
#define IN_BGLU 22
#define IN_WPOOL 23
#define IN_PSCALE 24
#define IN_GOA 25
#define IN_GOS 26
#define IN_GOP 27
#define IN_WOUT 28
#define IN_GFFN 29
#define IN_WFF1 30
#define IN_WFF2 31
struct Args { const float* in[32]; float* out; unsigned char* ws; int ph_lo, ph_hi; };
static_assert(sizeof(Args) == 32 * 8 + 8 + 8 + 8, "Args has no padding");

template <bool FRAG = false>
__device__ __forceinline__ void p0_transpose_item(const float* W, int K, int N, bf16* WT, const float* gain, LAS float* scr, int item, int lane) {
    const int nblk = N / 32, kb = item / nblk, nb = item % nblk, k0 = 64 * kb, n0 = 32 * nb;
    float wv[32];
#pragma unroll
    for (int i = 0; i < 32; ++i) wv[i] = W[(size_t)(k0 + 2 * i + (lane >> 5)) * N + n0 + (lane & 31)];
    if (gain) {
        const float gv = gain[k0 + lane]; const bool hi = lane >= 32;
#pragma unroll
        for (int i = 0; i < 32; ++i) { const float g0 = __builtin_bit_cast(float, __builtin_amdgcn_readlane(__builtin_bit_cast(int, gv), 2 * i)), g1 = __builtin_bit_cast(float, __builtin_amdgcn_readlane(__builtin_bit_cast(int, gv), 2 * i + 1));
            wv[i] *= hi ? g1 : g0; }
    }
#pragma unroll
    for (int i = 0; i < 32; ++i) scr[(2 * i + (lane >> 5)) * 33 + (lane & 31)] = wv[i];
    LDS_WAIT(); asm volatile("" ::: "memory");
    const int c = lane & 7;
#pragma unroll
    for (int j = 0; j < 4; ++j) { const int n = (lane >> 3) + 8 * j; const LAS float* s = scr + (8 * c) * 33 + n;
        v4u o; o.x = pk2(s[0 * 33], s[1 * 33]); o.y = pk2(s[2 * 33], s[3 * 33]); o.z = pk2(s[4 * 33], s[5 * 33]); o.w = pk2(s[6 * 33], s[7 * 33]);
        const int nn = n0 + n, kk = k0 + 8 * c;
        if (FRAG) *(GAS v4u*)(WT + ((size_t)((((nn >> 6) * 16 + (kk >> 5)) * 4 + ((nn >> 4) & 3)) * 64 + ((kk >> 3) & 3) * 16 + (nn & 15))) * 8) = o;
        else *(GAS v4u*)(WT + (size_t)nn * K + kk) = o; }
    LDS_WAIT(); asm volatile("" ::: "memory");
}
__device__ __forceinline__ void sincos_d(double x, double& s, double& c) {
    const double TWO_PI = 6.283185307179586476925286766559;
    const double k = rint(x * (1.0 / TWO_PI)); const double r = fma(-k, TWO_PI, x), r2 = r * r;
    const double fs[14] = {0.16666666666666666, 0.05, 0.023809523809523808, 0.013888888888888888, 0.00909090909090909, 0.00641025641025641, 0.004761904761904762, 0.003676470588235294,
                           0.0029239766081871343, 0.002380952380952381, 0.001976284584980237, 0.0016666666666666668, 0.0014245014245014246, 0.0012315270935960591};
    const double fc[14] = {0.5, 0.08333333333333333, 0.03333333333333333, 0.017857142857142856, 0.011111111111111112, 0.007575757575757576, 0.005494505494505495, 0.004166666666666667,
                           0.0032679738562091504, 0.002631578947368421, 0.0021645021645021645, 0.0018115942028985507, 0.0015384615384615385, 0.0013227513227513227};
    double ts = r, tc = 1.0; s = r; c = 1.0;
#pragma unroll
    for (int i = 0; i < 14; ++i) { ts *= -r2 * fs[i]; s += ts; tc *= -r2 * fc[i]; c += tc; }
}
__device__ __forceinline__ double exp_small(double x) {
    double t = 1.0, e = 1.0;
#pragma unroll
    for (int i = 1; i <= 14; ++i) { t *= x * (1.0 / i); e += t; }
    return e;
}
__device__ __forceinline__ void p0_prologue(const Args& AR, Frame& F) {
    LAS float* scr = (LAS float*)(F.lds + F.wave * 16384);
    const int gw = F.vcu * 8 + F.wave, NGW = F.G * 8, lane = F.lane();
    unsigned char* ws = F.ws;
    constexpr int I_IN = (DM / 64) * (INW / 32), I_OUT = (DM / 64) * (DM / 32), I_1 = (DM / 64) * (DFF / 32), I_2 = (DFF / 64) * (DM / 32), I_GLU = (512 / 64) * (512 / 32), I_POOL = 4 * 2 * 4;
    constexpr int I_LAYER = I_IN + I_OUT + I_1 + I_2 + I_GLU + I_POOL;
    for (int it = gw; it < NLAYER * I_LAYER; it += NGW) {
        const int l = it / I_LAYER; int r = it % I_LAYER;
        if (r < I_IN) { p0_transpose_item(AR.in[IN_WIN] + (size_t)l * DM * INW, DM, INW, (bf16*)(ws + WS_WIN) + (size_t)l * INW * DM, AR.in[IN_GMIX] + l * DM, scr, r, lane); continue; } r -= I_IN;
        if (r < I_OUT) { const int k0 = 64 * (r / (DM / 32));
            const float* g = (k0 < 1024) ? AR.in[IN_GOA] + l * 1024 : (k0 < 1536) ? AR.in[IN_GOS] + l * 512 - 1024 : AR.in[IN_GOP] + l * 512 - 1536;
            p0_transpose_item(AR.in[IN_WOUT] + (size_t)l * DM * DM, DM, DM, (bf16*)(ws + WS_WOUT) + (size_t)l * DM * DM, g, scr, r, lane); continue; } r -= I_OUT;
        if (r < I_1) { p0_transpose_item(AR.in[IN_WFF1] + (size_t)l * DM * DFF, DM, DFF, (bf16*)(ws + WS_W1) + (size_t)l * DFF * DM, AR.in[IN_GFFN] + l * DM, scr, r, lane); continue; } r -= I_1;
        if (r < I_2) { p0_transpose_item(AR.in[IN_WFF2] + (size_t)l * DFF * DM, DFF, DM, (bf16*)(ws + WS_W2) + (size_t)l * DM * DFF, nullptr, scr, r, lane); continue; } r -= I_2;
        if (r < I_GLU) { p0_transpose_item<true>(AR.in[IN_WGLU] + (size_t)l * 512 * 512, 512, 512, (bf16*)(ws + WS_WGLU) + (size_t)l * 512 * 512, nullptr, scr, r, lane); continue; } r -= I_GLU;
        { const int g = r / 8; p0_transpose_item(AR.in[IN_WPOOL] + ((size_t)l * 4 + g) * 128 * 128, 128, 128, (bf16*)(ws + WS_WPOOL) + ((size_t)l * 4 + g) * 128 * 128, nullptr, scr, r % 8, lane); }
    }
    bf16* XB = (bf16*)(ws + WS_XB); float* SSQ = (float*)(ws + WS_SSQ);
    for (int m = gw; m < MP; m += NGW) {
        const float* src = nullptr;
        if (m < SROW0) { const int b = m >= TT ? 1 : 0, t = m - b * TT; src = (t < NMETA) ? AR.in[IN_META] + (size_t)t * DM : AR.in[IN_XPROMPT] + ((size_t)b * NSEQ + (t - NMETA)) * DM; }
        else if (m < MR) src = AR.in[IN_XSAMPLE] + (size_t)(m - SROW0) * DM;
        float s = 0.f;
        f32x4 xv[8];
#pragma unroll
        for (int j = 0; j < 8; ++j) { xv[j] = (f32x4){0.f, 0.f, 0.f, 0.f}; if (src) xv[j] = *(const f32x4*)(src + j * 256 + lane * 4); }
#pragma unroll
        for (int j = 0; j < 8; ++j) { const f32x4 v = xv[j];
            s += (v[0] * v[0] + v[1] * v[1]) + (v[2] * v[2] + v[3] * v[3]);
            *(v2u*)(XB + (size_t)m * DM + j * 256 + lane * 4) = (v2u){pk2(v[0], v[1]), pk2(v[2], v[3])}; }
        s = wave_sum(s);
        if (lane < 32) SSQ[((size_t)(lane >> 2) * MP + m) * 4 + (lane & 3)] = (lane == 0) ? s : 0.f;
    }
    const int gt = gw * 64 + lane, NGT = NGW * 64;
    for (int id = gt; id < NLAYER * 32 * 64; id += NGT) {
        const int l = id >> 11, g = (id >> 6) & 31, n = id & 63;
        unsigned char* tb = ws + WS_TAB + (size_t)l * TB_LAYER;
        const double dt = (double)expf(AR.in[IN_LOGDT][l * 32 + g]);
        const double ar = (double)AR.in[IN_ARE][id], ai = (double)AR.in[IN_AIM][id];
        const double mag = exp_small(dt * ar); double sn, cs; sincos_d(dt * ai, sn, cs);
        const double abr = mag * cs, abi = mag * sn, den = ar * ar + ai * ai;
        const double fr = ((abr - 1.0) * ar + abi * ai) / den, fi = (abi * ar - (abr - 1.0) * ai) / den;
        ((float*)(tb + TB_ABR))[g * 64 + n] = (float)abr; ((float*)(tb + TB_ABI))[g * 64 + n] = (float)abi;
        const float* Br = AR.in[IN_BRE] + (size_t)id * 16; const float* Bi = AR.in[IN_BIM] + (size_t)id * 16;
        const float* Cr = AR.in[IN_CRE] + ((size_t)(l * 32 + g) * 16) * 64 + n; const float* Ci = AR.in[IN_CIM] + ((size_t)(l * 32 + g) * 16) * 64 + n;
        float brv[16], biv[16], crv[16], civ[16];
#pragma unroll
        for (int c = 0; c < 16; ++c) { brv[c] = Br[c]; biv[c] = Bi[c]; crv[c] = Cr[c * 64]; civ[c] = Ci[c * 64]; }
        float* bbr = (float*)(tb + TB_BBR) + (size_t)(g * 64 + n) * 16; float* bbi = (float*)(tb + TB_BBI) + (size_t)(g * 64 + n) * 16;
        bf16* bbt = (bf16*)(tb + TB_PM) + (size_t)g * 128 * 16;
#pragma unroll
        for (int c = 0; c < 16; ++c) { const double br = brv[c], bi = biv[c]; const float vr = (float)(fr * br - fi * bi), vi = (float)(fr * bi + fi * br); bbr[c] = vr; bbi[c] = vi;
            bbt[n * 16 + c] = (bf16)(pk2(vr, 0.f) & 0xffffu); bbt[(64 + n) * 16 + c] = (bf16)(pk2(vi, 0.f) & 0xffffu); }
        double pr = abr, pi = abi;
        for (int t = 0; t < 64; ++t) {
            if (t == 15) { ((float*)(tb + TB_A16R))[g * 64 + n] = (float)pr; ((float*)(tb + TB_A16I))[g * 64 + n] = (float)pi; }
            if (t == 31) { ((float*)(tb + TB_A32R))[g * 64 + n] = (float)pr; ((float*)(tb + TB_A32I))[g * 64 + n] = (float)pi; }
            if (t == 63) { ((float*)(tb + TB_ALR))[g * 64 + n] = (float)pr; ((float*)(tb + TB_ALI))[g * 64 + n] = (float)pi; }
            const double nr = pr * abr - pi * abi, ni = pr * abi + pi * abr; pr = nr; pi = ni;
        }
        bf16* CmT = (bf16*)(tb + TB_CMT) + (size_t)g * 16 * 128;
#pragma unroll
        for (int c = 0; c < 16; ++c) { CmT[c * 128 + n] = (bf16)(pk2(crv[c], 0.f) & 0xffffu); CmT[c * 128 + 64 + n] = (bf16)(pk2(-civ[c], 0.f) & 0xffffu); }
    }
    float* rc = (float*)(ws + WS_ROPE); float* rs_ = rc + ROPE_N;
    for (int id = gt; id < (int)ROPE_N; id += NGT) {
        const int p = id >> 4, i = id & 15; const double pos = (p == ROPE_SAMPLE_IDX) ? 16384.0 : (double)p;
        double inv = 1.0;
        for (int k = 0; k < i; ++k) inv *= 0.44036660267178046;
        double sn, cs; sincos_d(pos * inv, sn, cs);
        rc[id] = (float)cs; rs_[id] = (float)sn;
    }
}

__device__ __forceinline__ void attn_unit(const Args& AR, Frame& F, int l, int b, int i) {
    int lane_ = F.lane(); asm volatile("" : "+v"(lane_));
    size_t z_ = 0; asm volatile("" : "+s"(z_)); unsigned char* ws = F.ws + z_;
    const int lane = lane_, h = F.wave, c = lane & 31, hh = lane >> 5, kvh = h >> 2;
    const int t0 = 32 * i; const size_t rb = (size_t)b * TT;
#if PROBE && (PROBE_KIND == 11 || PROBE_KIND == 12)
    const unsigned long long ta0 = __builtin_amdgcn_s_memrealtime();
#endif
    const bf16* Q = (const bf16*)(ws + WS_Q); const bf16* K = (const bf16*)(ws + WS_K); const bf16* VT = (const bf16*)(ws + WS_VT);
    LAS float* ex = (LAS float*)(F.lds + ESC_OFF);
    bf16x8 qf[8];
    { const bf16* qp = Q + (rb + t0 + c) * 1024 + 128 * h + 8 * hh;
#pragma unroll
      for (int ks = 0; ks < 8; ++ks) qf[ks] = *(const bf16x8*)(qp + 16 * ks); }
    const int kt0 = (t0 >= 128) ? 0 : (4 - i);
    f32x16 S[5];
    bf16x8 kf[5][8];
#define ATT_LOADK(KT) do { if ((KT) >= kt0) { const bf16* kp_ = K + (rb + (t0 - 128 + 32 * (KT)) + c) * 256 + 128 * kvh + 8 * hh; \
        _Pragma("unroll") for (int ks_ = 0; ks_ < 8; ++ks_) kf[KT][ks_] = *(const bf16x8*)(kp_ + 16 * ks_); } } while (0)
    ATT_LOADK(0); ATT_LOADK(1); ATT_LOADK(2);
#pragma unroll
    for (int kt = 0; kt < 5; ++kt) {
#pragma unroll
        for (int r = 0; r < 16; ++r) S[kt][r] = -INFINITY;
        if (kt == 1) { ATT_LOADK(3); ATT_LOADK(4); }
        if (kt >= kt0) {
            f32x16 a = {0.f, 0.f, 0.f, 0.f, 0.f, 0.f, 0.f, 0.f, 0.f, 0.f, 0.f, 0.f, 0.f, 0.f, 0.f, 0.f};
#pragma unroll
            for (int ks = 0; ks < 8; ++ks) a = __builtin_amdgcn_mfma_f32_32x32x16_bf16(kf[kt][ks], qf[ks], a, 0, 0, 0);
#pragma unroll
            for (int r = 0; r < 16; ++r) { const int kr = (r & 3) + 8 * (r >> 2) + 4 * hh; bool ok = true;
                if (kt == 0) ok = kr >= c;
                if (kt == 4) ok = kr <= c;
                S[kt][r] = ok ? a[r] : -INFINITY; }
        }
    }
#if PROBE && PROBE_KIND == 11
    if (F.tid() == 0) F.MISC[6] += (unsigned)(__builtin_amdgcn_s_memrealtime() - ta0);
#endif
#undef ATT_LOADK
    const float sink2 = AR.in[IN_SINKS][l * 8 + h] * LOG2E;
    float mx = sink2;
#pragma unroll
    for (int kt = 0; kt < 5; ++kt)
#pragma unroll
        for (int r = 0; r < 16; ++r) mx = fmaxf(mx, S[kt][r]);
    mx = fmaxf(mx, __shfl_xor(mx, 32));
    float sum = 0.f;
#pragma unroll
    for (int kt = 0; kt < 5; ++kt)
#pragma unroll
        for (int r = 0; r < 16; ++r) { const float p = __builtin_amdgcn_exp2f(S[kt][r] - mx); S[kt][r] = p; sum += p; }
    sum += __shfl_xor(sum, 32);
    const float inv = 1.0f / (sum + __builtin_amdgcn_exp2f(sink2 - mx));
    f32x16 O[4];
#pragma unroll
    for (int db = 0; db < 4; ++db)
#pragma unroll
        for (int r = 0; r < 16; ++r) O[db][r] = 0.f;
    const bf16* vbase = VT + ((size_t)((b * 2 + kvh) * 128 + c)) * TPV + (t0 - 128) + 8 * hh;
    bf16x8 vf[2][2][4];
#define ATT_LOADV(KT) do { _Pragma("unroll") for (int s_ = 0; s_ < 2; ++s_) _Pragma("unroll") for (int db_ = 0; db_ < 4; ++db_) \
        vf[(KT) & 1][s_][db_] = *(const bf16x8*)(vbase + (size_t)(32 * db_) * TPV + 32 * (KT) + 16 * s_); } while (0)
    ATT_LOADV(0);
#pragma unroll
    for (int kt = 0; kt < 5; ++kt) {
        if (kt < 4) ATT_LOADV(kt + 1);
        if (kt >= kt0) {
#pragma unroll
            for (int s = 0; s < 2; ++s) {
                v4u pw; pw.x = pk2(S[kt][8 * s + 0], S[kt][8 * s + 1]); pw.y = pk2(S[kt][8 * s + 2], S[kt][8 * s + 3]); pw.z = pk2(S[kt][8 * s + 4], S[kt][8 * s + 5]); pw.w = pk2(S[kt][8 * s + 6], S[kt][8 * s + 7]);
                const bf16x8 pf = __builtin_bit_cast(bf16x8, pw);
#pragma unroll
                for (int db = 0; db < 4; ++db) O[db] = __builtin_amdgcn_mfma_f32_32x32x16_bf16(vf[kt & 1][s][db], pf, O[db], 0, 0, 0);
            }
        }
    }
#undef ATT_LOADV
    float ss = 0.f;
#pragma unroll
    for (int db = 0; db < 4; ++db)
#pragma unroll
        for (int r = 0; r < 16; ++r) { O[db][r] *= inv; ss += O[db][r] * O[db][r]; }
#if PROBE && PROBE_KIND == 12
    if (F.tid() == 0) F.MISC[6] += (unsigned)(__builtin_amdgcn_s_memrealtime() - ta0);
#endif
    ss += __shfl_xor(ss, 32);
    if (hh == 0) ex[h * 32 + c] = ss;
    WG_BAR();
    float tot = 0.f;
#pragma unroll
    for (int j = 0; j < 8; ++j) tot += ex[j * 32 + c];
    const float rsa = rsqrtf(tot * (1.0f / 1024.0f) + EPS);
    if (t0 + c < TT) {
        const rsrc_t rs_ = ws_rsrc(ws); const size_t mo16 = WS_MIX + ((rb + t0 + c) * DM + 128 * h) * 2 + 16 * hh;
#pragma unroll
        for (int db = 0; db < 4; ++db)
#pragma unroll
            for (int g4 = 0; g4 < 4; g4 += 2) {
                unsigned ax = pk2(O[db][4 * g4 + 0] * rsa, O[db][4 * g4 + 1] * rsa), ay = pk2(O[db][4 * g4 + 2] * rsa, O[db][4 * g4 + 3] * rsa);
                unsigned bx = pk2(O[db][4 * g4 + 4] * rsa, O[db][4 * g4 + 5] * rsa), by = pk2(O[db][4 * g4 + 6] * rsa, O[db][4 * g4 + 7] * rsa);
                { auto r = __builtin_amdgcn_permlane32_swap(ax, bx, false, false); ax = r[0]; bx = r[1]; }
                { auto r = __builtin_amdgcn_permlane32_swap(ay, by, false, false); ay = r[0]; by = r[1]; }
                ST16(rs_, mo16 + (32 * db + 8 * g4) * 2, ((v4u){ax, ay, bx, by}));
            }
    }
    WG_BAR();
}

__device__ __forceinline__ void sattn_unit(const Args& AR, Frame& F, int l, int s) {
    int tid_ = F.tid(); asm volatile("" : "+v"(tid_));
    const int tid = tid_, lane = tid & 63, wave = F.wave;
    LAS float* qs = (LAS float*)F.lds;
    LAS float* sc = qs + 1024;
    LAS float* part = sc + 8 * 132;
    LAS float* red = part + 4096;
    const size_t row = SROW0 + s;
    const bf16* Q = (const bf16*)(F.ws + WS_Q) + row * 1024;
    const float* ksn = (const float*)(F.ws + WS_KSN) + (size_t)s * 256; const float* vsn = ksn + NSAMP * 256;
    const float* ck = AR.in[IN_CACHEK] + ((size_t)(l * NSAMP + s)) * 128 * 256; const float* cv = AR.in[IN_CACHEV] + ((size_t)(l * NSAMP + s)) * 128 * 256;
    for (int j = tid; j < 1024; j += 512) qs[j] = bf2f(Q[j]);
    WG_BAR();
    { const int key = tid >> 2, pt = tid & 3;
#pragma unroll
      for (int kvh = 0; kvh < 2; ++kvh) {
          const float* kp = ck + (size_t)key * 256 + kvh * 128 + 32 * pt; float d[4] = {0.f, 0.f, 0.f, 0.f};
#pragma unroll
          for (int j = 0; j < 8; ++j) { const f32x4 kv = *(const f32x4*)(kp + 4 * j);
#pragma unroll
              for (int g = 0; g < 4; ++g) { const f32x4 qv = *(const LAS f32x4*)(qs + (4 * kvh + g) * 128 + 32 * pt + 4 * j); d[g] += (kv[0] * qv[0] + kv[1] * qv[1]) + (kv[2] * qv[2] + kv[3] * qv[3]); } }
#pragma unroll
          for (int g = 0; g < 4; ++g) { d[g] += __shfl_xor(d[g], 1); d[g] += __shfl_xor(d[g], 2); if (pt == 0) sc[(4 * kvh + g) * 132 + key] = d[g]; }
      } }
    {
      const int h = wave, kvh = h >> 2; float d = ksn[kvh * 128 + lane] * qs[h * 128 + lane] + ksn[kvh * 128 + 64 + lane] * qs[h * 128 + 64 + lane];
      d = wave_sum(d); if (lane == 0) sc[h * 132 + 128] = d; }
    WG_BAR();
    { const int h = wave; const float sink2 = AR.in[IN_SINKS][l * 8 + h] * LOG2E;
      const float v0 = sc[h * 132 + lane], v1 = sc[h * 132 + 64 + lane], v2 = (lane == 0) ? sc[h * 132 + 128] : -INFINITY;
      const float mx = fmaxf(wave_max(fmaxf(fmaxf(v0, v1), v2)), sink2);
      const float p0 = __builtin_amdgcn_exp2f(v0 - mx), p1 = __builtin_amdgcn_exp2f(v1 - mx), p2 = __builtin_amdgcn_exp2f(v2 - mx);
      const float inv = 1.0f / (wave_sum(p0 + p1 + p2) + __builtin_amdgcn_exp2f(sink2 - mx));
      sc[h * 132 + lane] = p0 * inv; sc[h * 132 + 64 + lane] = p1 * inv; if (lane == 0) sc[h * 132 + 128] = p2 * inv; }
    WG_BAR();
    { const int d = tid & 127, kq = tid >> 7;
#pragma unroll
      for (int kvh = 0; kvh < 2; ++kvh) { float a[4] = {0.f, 0.f, 0.f, 0.f};
          float vv[32];
#pragma unroll
          for (int k = 0; k < 32; ++k) vv[k] = cv[(size_t)(32 * kq + k) * 256 + kvh * 128 + d];
#pragma unroll
          for (int k = 0; k < 32; ++k) { const int key = 32 * kq + k;
#pragma unroll
              for (int g = 0; g < 4; ++g) a[g] += sc[(4 * kvh + g) * 132 + key] * vv[k]; }
#pragma unroll
          for (int g = 0; g < 4; ++g) part[kq * 1024 + (4 * kvh + g) * 128 + d] = a[g]; } }
    WG_BAR();
    float o[2]; float ss = 0.f;
#pragma unroll
    for (int e = 0; e < 2; ++e) { const int j = tid + 512 * e, h = j >> 7, d = j & 127, kvh = h >> 2;
        o[e] = (part[j] + part[1024 + j]) + (part[2048 + j] + part[3072 + j]) + sc[h * 132 + 128] * vsn[kvh * 128 + d]; ss += o[e] * o[e]; }
    ss = wave_sum(ss); if (lane == 0) red[wave] = ss;
    WG_BAR();
    { float tot = 0.f;
#pragma unroll
      for (int j = 0; j < 8; ++j) tot += red[j];
      const float rsa = rsqrtf(tot * (1.0f / 1024.0f) + EPS);
      const rsrc_t rs_ = ws_rsrc(F.ws);
#pragma unroll
      for (int e = 0; e < 2; ++e) ST2(rs_, WS_MIX + (row * DM + tid + 512 * e) * 2, pk2(o[e] * rsa, 0.f) & 0xffffu); }
    { float* ok = F.out + O_SK + ((size_t)(l * NSAMP + s)) * 128 * 256; float* ov = F.out + O_SV + ((size_t)(l * NSAMP + s)) * 128 * 256;
#pragma unroll 1
      for (int jb = 0; jb < 16; jb += 4) { f32x4 ka[4], va[4];
#pragma unroll
          for (int e = 0; e < 4; ++e) { const int j = tid + 512 * (jb + e); if (j < 127 * 64) { ka[e] = *(const f32x4*)(ck + 256 + 4 * j); va[e] = *(const f32x4*)(cv + 256 + 4 * j); } }
#pragma unroll
          for (int e = 0; e < 4; ++e) { const int j = tid + 512 * (jb + e); if (j < 127 * 64) { *(f32x4*)(ok + 4 * j) = ka[e]; *(f32x4*)(ov + 4 * j) = va[e]; } } }
      if (tid < 64) *(f32x4*)(ok + 127 * 256 + 4 * tid) = *(const f32x4*)(ksn + 4 * tid);
      else if (tid < 128) *(f32x4*)(ov + 127 * 256 + 4 * (tid - 64)) = *(const f32x4*)(vsn + 4 * (tid - 64)); }
    WG_BAR();
}

__device__ __forceinline__ float gelu_tanh(float y) {
    const float inner = 0.7978845608028654f * (y + 0.044715f * y * y * y);
    return y / (1.0f + __builtin_amdgcn_exp2f(-2.0f * LOG2E * inner));
}
__device__ __forceinline__ float sigmoidf_(float x) { return 1.0f / (1.0f + __builtin_amdgcn_exp2f(-LOG2E * x)); }
#define SWZ(r, ch, PITCH) ((r) * (PITCH) + ((((ch)) ^ ((r) & 15)) << 4))

#ifndef SSM_P1
#define SSM_P1 1
#endif
#ifndef SSM_M2
#define SSM_M2 1
#endif
__device__ __forceinline__ int rowtok(int r) { return 16 * ((r >> 2) & 1) + 4 * (r >> 3) + (r & 3); }
struct SsmG { f32x16 X[4]; };
struct SsmIn { bf16x8 a; };
__device__ __forceinline__ SsmIn ssm_load_in(const bf16* U, int rowb, int g, int lane) { const bf16* up = U + (size_t)(rowb + rowtok(lane & 31)) * 512 + 16 * g + 8 * (lane >> 5); SsmIn r; r.a = *(const bf16x8*)up; return r; }
__device__ __forceinline__ void ssm_block(const Args& AR, SsmG& G, const SsmIn& in, int g, const bf16x8 (&bbf)[4], const float (&ab)[4], float (&hr)[2], float (&hi)[2], int mode, int l, int s0, int lane) {
    const int c = lane & 31, hh = lane >> 5;
    const bf16x8 af = in.a;
    const f32x16 z16 = {0.f, 0.f, 0.f, 0.f, 0.f, 0.f, 0.f, 0.f, 0.f, 0.f, 0.f, 0.f, 0.f, 0.f, 0.f, 0.f};
#pragma unroll
    for (int nb = 0; nb < 4; ++nb) G.X[nb] = __builtin_amdgcn_mfma_f32_32x32x16_bf16(af, bbf[nb], z16, 0, 0, 0);
#pragma unroll
    for (int s = 0; s < 2; ++s) {
        const float ar = ab[2 * s], ai = ab[2 * s + 1];
        if (SSM_M2 && mode == 2) {
            { int cx = c; asm volatile("" : "+v"(cx)); const size_t o0 = ((size_t)(l * NSAMP + (s0 + 16 * hh)) * 32 + g) * 64 + cx + 32 * s; const float* qr = AR.in[IN_SSMRE] + o0; const float* qi = AR.in[IN_SSMIM] + o0;
              size_t jo = 0;
#pragma unroll
              for (int j = 0; j < 16; ++j) { const float pr = qr[jo], pi = qi[jo]; jo += 2048; asm volatile("" : "+v"(jo));
                const float nr = ar * pr - ai * pi + G.X[s][j], ni = ar * pi + ai * pr + G.X[2 + s][j]; G.X[s][j] = nr; G.X[2 + s][j] = ni; } }
            continue;
        }
        float r = (hh == 0) ? hr[s] : 0.f, i = (hh == 0) ? hi[s] : 0.f;
#pragma unroll
        for (int j = 0; j < 16; ++j) { const float nr = ar * r - ai * i + G.X[s][j], ni = ar * i + ai * r + G.X[2 + s][j]; r = nr; i = ni; G.X[s][j] = r; G.X[2 + s][j] = i; }
        float vr = __shfl_xor(r, 32), vi = __shfl_xor(i, 32);
        if (hh == 0 || mode == 1) { vr = 0.f; vi = 0.f; }
        float pr = ar, pi = ai; asm volatile("" : "+v"(pr), "+v"(pi));
#pragma unroll
        for (int j = 0; j < 16; ++j) { G.X[s][j] += pr * vr - pi * vi; G.X[2 + s][j] += pr * vi + pi * vr; const float nr = pr * ar - pi * ai, ni = pr * ai + pi * ar; pr = nr; pi = ni; }
        const float er = G.X[s][15], ei = G.X[2 + s][15];
        const float xr = __shfl_xor(er, 32), xi = __shfl_xor(ei, 32);
        hr[s] = (hh == 1) ? er : xr; hi[s] = (hh == 1) ? ei : xi;
    }
}
struct SsmTab { float ab[4]; bf16x8 bbf[4]; };
struct SsmTabC { bf16x8 cmf[4]; f32x4 dsk; };
__device__ __forceinline__ SsmTab ssm_load_tab(const unsigned char* tb, int w, int gi, int lg) {
    SsmTab T; const int g = 4 * w + gi, c32 = lg & 31, hh = lg >> 5;
    T.ab[0] = ((const float*)(tb + TB_ABR))[g * 64 + c32]; T.ab[1] = ((const float*)(tb + TB_ABI))[g * 64 + c32]; T.ab[2] = ((const float*)(tb + TB_ABR))[g * 64 + 32 + c32]; T.ab[3] = ((const float*)(tb + TB_ABI))[g * 64 + 32 + c32];
    const bf16* bt = (const bf16*)(tb + TB_PM) + (size_t)g * 128 * 16 + c32 * 16 + 8 * hh;
#pragma unroll
    for (int nb = 0; nb < 4; ++nb) T.bbf[nb] = *(const bf16x8*)(bt + nb * 32 * 16);
    return T;
}
__device__ __forceinline__ SsmTabC ssm_load_tabc(const unsigned char* tb, const float* dskip, int w, int gi, int lg) {
    SsmTabC T; const int g = 4 * w + gi, t16 = lg & 15, cq = lg >> 4;
    const bf16* cm = (const bf16*)(tb + TB_CMT) + (size_t)g * 16 * 128 + t16 * 128 + 8 * cq;
#pragma unroll
    for (int nb = 0; nb < 4; ++nb) T.cmf[nb] = *(const bf16x8*)(cm + 32 * nb);
    T.dsk = *(const f32x4*)(dskip + 64 * w + 16 * gi + 4 * cq); return T;
}
__device__ __forceinline__ void ssm_unit(const Args& AR, Frame& F, int l, int c_in) {
    const int c = c_in;
#if PROBE && PROBE_KIND == 13
    const unsigned long long tq0 = __builtin_amdgcn_s_memrealtime();
#define SSM_CP(n) do { if ((n) == PROBE_TYPE && F.tid() == 0) F.MISC[6] += (unsigned)(__builtin_amdgcn_s_memrealtime() - tq0); } while (0)
#else
#define SSM_CP(n) do { } while (0)
#endif
    int lane_ = F.lane(); asm volatile("" : "+v"(lane_));
    const int lane = lane_, w = F.wave, t16 = lane & 15, cq = lane >> 4, c32 = lane & 31, hh = lane >> 5;
    const int row0 = 64 * c;
    size_t z_ = 0; asm volatile("" : "+s"(z_)); unsigned char* ws = F.ws + z_;
    const unsigned char* tb = ws + WS_TAB + (size_t)l * TB_LAYER;
    const bf16* U = (const bf16*)(ws + WS_U);
    float* SST = (float*)(ws + WS_SST) + ((size_t)l * NCHUNK) * 32 * 128;
    gu32* flags = F.ctl + CW_SSMF + (size_t)(l * NCHUNK) * 8 * 16;
    LAS unsigned char* Zs = F.lds;
    LAS unsigned char* Hm = F.lds + 65536 + w * 8704;
    LAS float* red = (LAS float*)(F.lds + 137216);
    SsmG SG;
    float hcar[4] = {0.f, 0.f, 0.f, 0.f};
    if (SSM_P1 && c != NCHUNK - 1) {
        int lg_ = lane; asm volatile("" : "+v"(lg_));
        const int c32 = lg_ & 31, hh = lg_ >> 5;
        float ab4[4][4]; bf16x8 bbf4[4][4]; SsmIn in04[4], in14[4];
#pragma unroll
        for (int gi = 0; gi < 4; ++gi) { const int g = 4 * w + gi;
            ab4[gi][0] = ((const float*)(tb + TB_ABR))[g * 64 + c32]; ab4[gi][1] = ((const float*)(tb + TB_ABI))[g * 64 + c32]; ab4[gi][2] = ((const float*)(tb + TB_ABR))[g * 64 + 32 + c32]; ab4[gi][3] = ((const float*)(tb + TB_ABI))[g * 64 + 32 + c32];
            const bf16* bt = (const bf16*)(tb + TB_PM) + (size_t)g * 128 * 16 + c32 * 16 + 8 * hh;
#pragma unroll
            for (int nb = 0; nb < 4; ++nb) bbf4[gi][nb] = *(const bf16x8*)(bt + nb * 32 * 16);
            in04[gi] = ssm_load_in(U, row0, g, lg_); in14[gi] = ssm_load_in(U, row0 + 32, g, lg_); }
#pragma unroll
        for (int gi = 0; gi < 4; ++gi) { const int g = 4 * w + gi;
            float hr[2] = {0.f, 0.f}, hi[2] = {0.f, 0.f};
            ssm_block(AR, SG, in04[gi], g, bbf4[gi], ab4[gi], hr, hi, (c == 64) ? 1 : 0, l, 0, lg_);
            ssm_block(AR, SG, in14[gi], g, bbf4[gi], ab4[gi], hr, hi, 0, l, 0, lg_);
            if (hh == 0) {
#pragma unroll
                for (int s = 0; s < 2; ++s) __hip_atomic_store((gu64*)(SST + ((size_t)c * 32 + g) * 128 + 2 * (c32 + 32 * s)), ((unsigned long long)__builtin_bit_cast(unsigned, hi[s]) << 32) | __builtin_bit_cast(unsigned, hr[s]), RLX_AGENT);
            }
        }
        VM_WAIT();
        if (lane == 0) __hip_atomic_store(flags + ((size_t)c * 8 + w) * 16, 1u, RLX_AGENT);
    }
    SSM_CP(1);
    const int cs0 = (c <= 64) ? 0 : 64, npred = c - cs0;
    if (npred > 0) {
        unsigned sp = 0; bool ok = false;
        for (;;) { ok = (lane >= npred) || (__hip_atomic_load(flags + ((size_t)(cs0 + lane) * 8 + w) * 16, RLX_AGENT) != 0u);
            if (__all(ok)) break;
            __builtin_amdgcn_s_sleep(1);
            if (++sp > (1u << 20)) { if (lane == 0) __hip_atomic_store(F.ctl + CW_TMO, 0x55u, RLX_AGENT); break; } }
        __builtin_amdgcn_fence(__ATOMIC_ACQUIRE, "agent");
        VM_WAIT();
    }
    SSM_CP(2);
    SSM_CP(2);
    SsmTab T = ssm_load_tab(tb, w, 0, lane);
    SsmTabC TC = ssm_load_tabc(tb, AR.in[IN_DSKIP] + l * 512, w, 0, lane);
    SsmIn inx = ssm_load_in(U, row0, 4 * w, lane);
#pragma unroll 1
    for (int step = 0; step < 8; ++step) {
        const int gi = step >> 1, half = step & 1, g = 4 * w + gi;
        int lg_ = lane; asm volatile("" : "+v"(lg_));
        const int t16 = lg_ & 15, cq = lg_ >> 4, c32 = lg_ & 31, hh = lg_ >> 5;
        int cc_ = c_in; asm volatile("" : "+s"(cc_)); const int c = cc_;
        const bool samp = (c == NCHUNK - 1) && (half == 1);
        const int col = 64 * w + 16 * gi + 4 * cq;
        const int ns = (step < 7) ? step + 1 : 7, ngi = ns >> 1, nhalf = ns & 1;
        const SsmIn in_n = ssm_load_in(U, row0 + 32 * nhalf, 4 * w + ngi, lg_);
        v2u uvp[2];
#pragma unroll
        for (int mt = 0; mt < 2; ++mt) uvp[mt] = *(const v2u*)(U + (size_t)(row0 + 32 * half + 16 * mt + t16) * 512 + col);
        if (half == 0 && gi > 0) { T = ssm_load_tab(tb, w, gi, lg_); TC = ssm_load_tabc(tb, AR.in[IN_DSKIP] + l * 512, w, gi, lg_); }
        float hr[2], hi[2];
        if (half == 0) {
            hr[0] = 0.f; hr[1] = 0.f; hi[0] = 0.f; hi[1] = 0.f;
            if (npred > 0) {
                float aL[4]; aL[0] = ((const float*)(tb + TB_ALR))[g * 64 + c32]; aL[1] = ((const float*)(tb + TB_ALI))[g * 64 + c32]; aL[2] = ((const float*)(tb + TB_ALR))[g * 64 + 32 + c32]; aL[3] = ((const float*)(tb + TB_ALI))[g * 64 + 32 + c32];
                const float* sb = SST + ((size_t)g) * 128 + 2 * c32;
                for (int cp = cs0; cp < c; cp += 16) {
                    f32x2 sv[16][2];
#pragma unroll
                    for (int j = 0; j < 16; ++j) { const int cj = (cp + j < c) ? cp + j : c - 1; const float* sp_ = sb + (size_t)cj * 32 * 128; sv[j][0] = *(const f32x2*)sp_; sv[j][1] = *(const f32x2*)(sp_ + 64); }
#pragma unroll
                    for (int j = 0; j < 16; ++j) if (cp + j < c) {
#pragma unroll
                        for (int s = 0; s < 2; ++s) { const float nr = aL[2 * s] * hr[s] - aL[2 * s + 1] * hi[s] + sv[j][s][0], ni = aL[2 * s] * hi[s] + aL[2 * s + 1] * hr[s] + sv[j][s][1]; hr[s] = nr; hi[s] = ni; } }
                }
            }
        } else {
#pragma unroll
            for (int s = 0; s < 2; ++s) { hr[s] = hcar[2 * s]; hi[s] = hcar[2 * s + 1]; }
        }
        ssm_block(AR, SG, inx, g, T.bbf, T.ab, hr, hi, samp ? 2 : ((c == 64 && half == 0) ? 1 : 0), l, 0, lg_);
#pragma unroll
        for (int s = 0; s < 2; ++s) { hcar[2 * s] = hr[s]; hcar[2 * s + 1] = hi[s]; }
        { LAS unsigned char* hw = Hm + hh * (16 * 272) + c32 * 2;
#pragma unroll
          for (int j = 0; j < 16; ++j)
#pragma unroll
            for (int nb = 0; nb < 4; ++nb) *(LAS bf16*)(hw + j * 272 + nb * 64) = (bf16)(pk2(SG.X[nb][j], 0.f) & 0xffffu); }
        if ((c == 64 && half == 0) || (c == NCHUNK - 1 && half == 0)) {
            int cx = c32; asm volatile("" : "+v"(cx));
            if (hh == (c == 64 ? 0 : 1)) {
#pragma unroll
                for (int s = 0; s < 2; ++s) { const size_t o = ((size_t)(l * NBATCH + (c == 64 ? 0 : 1)) * 32 + g) * 64 + cx + 32 * s; F.out[O_PSR + o] = SG.X[s][15]; F.out[O_PSI + o] = SG.X[2 + s][15]; } } }
        if (samp) { int cx = c32; asm volatile("" : "+v"(cx)); const size_t o0 = ((size_t)(l * NSAMP + 16 * hh) * 32 + g) * 64 + cx; float* qr = F.out + O_SSR + o0; float* qi = F.out + O_SSI + o0;
#pragma unroll
            for (size_t j = 0, jo = 0; j < 16; ++j) { qr[jo] = SG.X[0][j]; qr[jo + 32] = SG.X[1][j]; qi[jo] = SG.X[2][j]; qi[jo + 32] = SG.X[3][j]; jo += 2048; asm volatile("" : "+v"(jo)); } }
        LDS_WAIT();
#pragma unroll
        for (int mt = 0; mt < 2; ++mt) {
            f32x4 y = {0.f, 0.f, 0.f, 0.f};
#pragma unroll
            for (int ks = 0; ks < 4; ++ks) { const bf16x8 hf = *(const LAS bf16x8*)(Hm + (16 * mt + t16) * 272 + (4 * ks + cq) * 16);
                y = __builtin_amdgcn_mfma_f32_16x16x32_bf16(TC.cmf[ks], hf, y, 0, 0, 0); }
            const int rl = 32 * half + 16 * mt + t16;
            const f32x4 uv = {__builtin_bit_cast(float, uvp[mt].x << 16), __builtin_bit_cast(float, uvp[mt].x & 0xffff0000u), __builtin_bit_cast(float, uvp[mt].y << 16), __builtin_bit_cast(float, uvp[mt].y & 0xffff0000u)};
            f32x4 z;
#pragma unroll
            for (int e = 0; e < 4; ++e) z[e] = gelu_tanh(y[e] + TC.dsk[e] * uv[e]);
            *(LAS v2u*)(Zs + SWZ(rl, col >> 3, 1024) + (col & 7) * 2) = (v2u){pk2(z[0], z[1]), pk2(z[2], z[3])};
        }
        LDS_WAIT();
        inx = in_n;
    }
    WG_BAR();
    SSM_CP(3);
    f32x4 G[4][4];
    f32x4 bgv[4];
#pragma unroll
    for (int nt = 0; nt < 4; ++nt) bgv[nt] = *(const f32x4*)(AR.in[IN_BGLU] + l * 512 + 64 * w + 16 * nt + 4 * cq);
#pragma unroll
    for (int mt = 0; mt < 4; ++mt)
#pragma unroll
        for (int nt = 0; nt < 4; ++nt) G[mt][nt] = (f32x4){0.f, 0.f, 0.f, 0.f};
    { const bf16* Wg = (const bf16*)(ws + WS_WGLU) + (size_t)l * 512 * 512 + ((size_t)w * 16 * 4 * 64 + lane) * 8;
      bf16x8 wq[4][4];
#pragma unroll
      for (int pk = 0; pk < 3; ++pk)
#pragma unroll
          for (int nt = 0; nt < 4; ++nt) wq[pk][nt] = *(const bf16x8*)(Wg + (size_t)(pk * 4 + nt) * 64 * 8);
#pragma unroll
      for (int ks = 0; ks < 16; ++ks) {
          bf16x8 zf[4];
          if (ks + 3 < 16) {
#pragma unroll
              for (int nt = 0; nt < 4; ++nt) wq[(ks + 3) & 3][nt] = *(const bf16x8*)(Wg + (size_t)((ks + 3) * 4 + nt) * 64 * 8); }
#pragma unroll
          for (int mt = 0; mt < 4; ++mt) zf[mt] = *(const LAS bf16x8*)(Zs + SWZ(16 * mt + t16, 4 * ks + cq, 1024));
#pragma unroll
          for (int mt = 0; mt < 4; ++mt)
#pragma unroll
              for (int nt = 0; nt < 4; ++nt) G[mt][nt] = __builtin_amdgcn_mfma_f32_16x16x32_bf16(wq[ks & 3][nt], zf[mt], G[mt][nt], 0, 0, 0);
      } }
#pragma unroll
    for (int mt = 0; mt < 4; ++mt) { float ss = 0.f; const int rl = 16 * mt + t16;
#pragma unroll
        for (int nt = 0; nt < 4; ++nt) { const int col = 64 * w + 16 * nt + 4 * cq; const f32x4 bg = bgv[nt];
            const v2u zz = *(const LAS v2u*)(Zs + SWZ(rl, col >> 3, 1024) + (col & 7) * 2);
            const float zv[4] = {bf2f((unsigned short)(zz.x & 0xffffu)), bf2f((unsigned short)(zz.x >> 16)), bf2f((unsigned short)(zz.y & 0xffffu)), bf2f((unsigned short)(zz.y >> 16))};
#pragma unroll
            for (int e = 0; e < 4; ++e) { const float o = zv[e] * sigmoidf_(G[mt][nt][e] + bg[e]); G[mt][nt][e] = o; ss += o * o; } }
        ss += __shfl_xor(ss, 16); ss += __shfl_xor(ss, 32);
        if (cq == 0) red[rl * 8 + w] = ss; }
    SSM_CP(4);
    WG_BAR();
    { const rsrc_t rs_ = ws_rsrc(ws);
#pragma unroll
      for (int mt = 0; mt < 4; ++mt) { const int rl = 16 * mt + t16; const LAS f32x4* rp = (const LAS f32x4*)(red + rl * 8); const f32x4 a = rp[0], b2 = rp[1];
          const float rsn = rsqrtf(((a[0] + a[1]) + (a[2] + a[3]) + (b2[0] + b2[1]) + (b2[2] + b2[3])) * (1.0f / 512.0f) + EPS);
          const int od = cq & 1; const size_t mo = WS_MIX + ((size_t)(row0 + rl) * DM + 1024 + 64 * w + 4 * (cq & ~1)) * 2 + (od ? 32 : 0);
#pragma unroll
          for (int nt = 0; nt < 4; nt += 2) {
              const unsigned a0 = pk2(G[mt][nt][0] * rsn, G[mt][nt][1] * rsn), a1 = pk2(G[mt][nt][2] * rsn, G[mt][nt][3] * rsn);
              const unsigned b0 = pk2(G[mt][nt + 1][0] * rsn, G[mt][nt + 1][1] * rsn), b1 = pk2(G[mt][nt + 1][2] * rsn, G[mt][nt + 1][3] * rsn);
              const unsigned s0 = od ? a0 : b0, s1 = od ? a1 : b1;
              const unsigned r0 = (unsigned)__shfl_xor((int)s0, 16), r1 = (unsigned)__shfl_xor((int)s1, 16);
              ST16(rs_, mo + 32 * nt, (od ? (v4u){r0, r1, b0, b1} : (v4u){a0, a1, r0, r1})); } } }
    WG_BAR();
}
#undef SSM_ROWS4

template <int WLEN>
__device__ __forceinline__ void pool_half(const float* XP, float* out, int l, int ch, int rfirst, int rl0, LAS unsigned char* Ds) {
    float xv[48];
#pragma unroll
    for (int i = 0; i < 48; ++i) { const int ra = rfirst + i - 16; xv[i] = (ra >= 0) ? XP[(size_t)ra * 512 + ch] : 0.f; }
    int seg = (rfirst >= TT) ? TT : 0;
    float sum = 0.f;
#pragma unroll
    for (int j = 1; j <= WLEN; ++j) if (rfirst - j >= seg) sum += xv[16 - j];
#pragma unroll
    for (int i = 0; i < 32; ++i) {
        const int ra = rfirst + i; const float x = xv[16 + i];
        if (ra == TT) { seg = TT; sum = 0.f; }
        sum += x;
        if (ra - WLEN >= seg) sum -= xv[16 + i - WLEN];
        const int cnt = (ra - seg + 1 < WLEN) ? (ra - seg + 1) : WLEN;
        const float dm = sum * __builtin_amdgcn_rcpf((float)cnt) - x;
        if (ra >= TT - 15 && ra < TT) out[O_PP + ((size_t)(l * NBATCH + 0) * 15 + (ra - (TT - 15))) * 512 + ch] = x;
        if (ra >= SROW0 - 15) out[O_PP + ((size_t)(l * NBATCH + 1) * 15 + (ra - (SROW0 - 15))) * 512 + ch] = x;
        const int r = rl0 + i;
        *(LAS bf16*)(Ds + SWZ(r, ch >> 3, 1024) + (ch & 7) * 2) = (bf16)(pk2(dm, 0.f) & 0xffffu);
    }
}
template <int WLEN>
__device__ __forceinline__ void pool_sample_rows(const float* XP, const float* sp, float* out, int l, int ch, LAS unsigned char* Ds) {
#pragma unroll 2
    for (int s = 0; s < NSAMP; ++s) {
        const float* pp = sp + (size_t)s * 15 * 512; float pv[15];
#pragma unroll
        for (int j = 0; j < 15; ++j) pv[j] = pp[(size_t)j * 512];
        const float x = XP[(size_t)(SROW0 + s) * 512 + ch]; float a = x;
#pragma unroll
        for (int j = 16 - WLEN; j < 15; ++j) a += pv[j];
        const float dm = a * (1.0f / WLEN) - x;
        float* op = out + O_SP + ((size_t)(l * NSAMP + s) * 15) * 512 + ch;
#pragma unroll
        for (int j = 0; j < 14; ++j) op[(size_t)j * 512] = pv[j + 1];
        op[(size_t)14 * 512] = x;
        *(LAS bf16*)(Ds + SWZ(32 + s, ch >> 3, 1024) + (ch & 7) * 2) = (bf16)(pk2(dm, 0.f) & 0xffffu);
    }
}
__device__ __forceinline__ void pool_unit(const Args& AR, Frame& F, int l, int c) {
    int tid_ = F.tid(); asm volatile("" : "+v"(tid_));
    const int tid = tid_, lane = tid & 63, w = F.wave, t16 = lane & 15, cq = lane >> 4;
    const int row0 = 64 * c;
    size_t z_ = 0; asm volatile("" : "+s"(z_)); unsigned char* ws = F.ws + z_;
    const float* XP = (const float*)(ws + WS_XP);
    LAS unsigned char* Ds = F.lds;
    LAS float* red = (LAS float*)(F.lds + ESC_OFF);
    bf16x8 wfp[4][8];
    { const int gp_ = w & 3; const bf16* Wp = (const bf16*)(ws + WS_WPOOL) + ((size_t)(l * 4 + gp_) * 128 + t16) * 128 + 8 * cq;
#pragma unroll
      for (int ks = 0; ks < 4; ++ks)
#pragma unroll
          for (int nt = 0; nt < 8; ++nt) wfp[ks][nt] = *(const bf16x8*)(Wp + (size_t)nt * 16 * 128 + 32 * ks); }
    { const int ch = tid, wsel = w >> 1;
      const float* sp = AR.in[IN_SPOOL] + (size_t)l * NSAMP * 15 * 512 + ch;
#pragma unroll 1
      for (int half = 0; half < 2; ++half) {
          if (c == NCHUNK - 1 && half == 1) {
              if (wsel == 0) pool_sample_rows<2>(XP, sp, F.out, l, ch, Ds); else if (wsel == 1) pool_sample_rows<4>(XP, sp, F.out, l, ch, Ds);
              else if (wsel == 2) pool_sample_rows<8>(XP, sp, F.out, l, ch, Ds); else pool_sample_rows<16>(XP, sp, F.out, l, ch, Ds);
          } else {
              const int rfirst = row0 + 32 * half;
              if (wsel == 0) pool_half<2>(XP, F.out, l, ch, rfirst, 32 * half, Ds); else if (wsel == 1) pool_half<4>(XP, F.out, l, ch, rfirst, 32 * half, Ds);
              else if (wsel == 2) pool_half<8>(XP, F.out, l, ch, rfirst, 32 * half, Ds); else pool_half<16>(XP, F.out, l, ch, rfirst, 32 * half, Ds);
          }
      } }
    WG_BAR();
    const int gp = w & 3, rh = w >> 2;
    f32x4 A[2][8];
#pragma unroll
    for (int mt = 0; mt < 2; ++mt)
#pragma unroll
        for (int nt = 0; nt < 8; ++nt) A[mt][nt] = (f32x4){0.f, 0.f, 0.f, 0.f};
    {
#pragma unroll
      for (int ks = 0; ks < 4; ++ks) {
          bf16x8 df[2];
#pragma unroll
          for (int mt = 0; mt < 2; ++mt) df[mt] = *(const LAS bf16x8*)(Ds + SWZ(32 * rh + 16 * mt + t16, 16 * gp + 4 * ks + cq, 1024));
#pragma unroll
          for (int nt = 0; nt < 8; ++nt) {
#pragma unroll
              for (int mt = 0; mt < 2; ++mt) A[mt][nt] = __builtin_amdgcn_mfma_f32_16x16x32_bf16(wfp[ks][nt], df[mt], A[mt][nt], 0, 0, 0); }
      } }
    f32x4 scp[8];
#pragma unroll
    for (int nt = 0; nt < 8; ++nt) scp[nt] = *(const f32x4*)(AR.in[IN_PSCALE] + l * 512 + 128 * gp + 16 * nt + 4 * cq);
#pragma unroll
    for (int mt = 0; mt < 2; ++mt) { float ss = 0.f;
#pragma unroll
        for (int nt = 0; nt < 8; ++nt) { const f32x4 sc = scp[nt];
#pragma unroll
            for (int e = 0; e < 4; ++e) { const float o = A[mt][nt][e] * sc[e]; A[mt][nt][e] = o; ss += o * o; } }
        ss += __shfl_xor(ss, 16); ss += __shfl_xor(ss, 32);
        if (cq == 0) red[(32 * rh + 16 * mt + t16) * 4 + gp] = ss; }
    WG_BAR();
    { const rsrc_t rs_ = ws_rsrc(ws);
#pragma unroll
      for (int mt = 0; mt < 2; ++mt) { const int rl = 32 * rh + 16 * mt + t16; const f32x4 a = *(const LAS f32x4*)(red + rl * 4);
          const float rsn = rsqrtf(((a[0] + a[1]) + (a[2] + a[3])) * (1.0f / 512.0f) + EPS);
          const int od = cq & 1; const size_t mo = WS_MIX + ((size_t)(row0 + rl) * DM + 1536 + 128 * gp + 4 * (cq & ~1)) * 2 + (od ? 32 : 0);
#pragma unroll
          for (int nt = 0; nt < 8; nt += 2) {
              const unsigned a0 = pk2(A[mt][nt][0] * rsn, A[mt][nt][1] * rsn), a1 = pk2(A[mt][nt][2] * rsn, A[mt][nt][3] * rsn);
              const unsigned b0 = pk2(A[mt][nt + 1][0] * rsn, A[mt][nt + 1][1] * rsn), b1 = pk2(A[mt][nt + 1][2] * rsn, A[mt][nt + 1][3] * rsn);
              const unsigned s0 = od ? a0 : b0, s1 = od ? a1 : b1;
              const unsigned r0 = (unsigned)__shfl_xor((int)s0, 16), r1 = (unsigned)__shfl_xor((int)s1, 16);
              ST16(rs_, mo + 32 * nt, (od ? (v4u){r0, r1, b0, b1} : (v4u){a0, a1, r0, r1})); } } }
    WG_BAR();
}

#ifndef ACQ_SCOPE
#define ACQ_SCOPE "agent"
#endif
#ifndef PE_ROW_OWNED
#define PE_ROW_OWNED 0
#endif
#ifndef PUBLISH_FENCE
#define PUBLISH_FENCE 0
#endif
enum { U_END = 0, U_PA = 1, U_PC = 2, U_PD = 3, U_PE = 4, U_PEQ = 5  , U_SSM = 6, U_ATT = 7, U_SATT = 8, U_POOL = 9 };
constexpr int U_GEMM_LAST = U_PEQ;
constexpr int NPANEL = MP / 256;
constexpr int QCAP = 1024;
__host__ __device__ constexpr unsigned mkd(int type, int l, int a, int b) { return ((unsigned)type << 24) | ((unsigned)l << 20) | ((unsigned)a << 10) | (unsigned)b; }
__device__ __forceinline__ gu32* cnt_word(gu32* ctl, int l, int kind, int pm) { return ctl + CW_CNT + ((l * 5 + kind) * 40 + pm) * 16; }
__host__ __device__ constexpr unsigned mix_target(int pm) { return 3u * (unsigned)((MR - 256 * pm) < 256 ? (MR - 256 * pm) : 256); }

__device__ __forceinline__ int pa_extra_queue(int pm, int pn) { return (pn == 8) ? (pm & 3) : 4 + (pm & 3); }
__device__ __forceinline__ void build_queue(unsigned* qt, int q, int lane) {
    const int nx = (q == 0) ? 5 : 4;
    const int nssm = (NCHUNK - 1 - q) / 8 + 1, natt = (NBATCH * NQB - 1 - q) / 8 + 1, nsat = NSAMP / 8;
    int nxe = 0;
    for (int pm = 0; pm < NPANEL; ++pm) nxe += (pa_extra_queue(pm, 8) == q) + (pa_extra_queue(pm, 9) == q);
    const int sz[8] = {NPANEL + nxe, nssm, natt + nssm, nsat, 0, NPANEL, 4 * NPANEL, 0};
    if (lane < 16) {
        const int l = lane >> 3, sec = lane & 7;
        int per0 = 0;
#pragma unroll
        for (int i = 0; i < 7; ++i) per0 += sz[i];
        const int pe0 = NPANEL, pe1 = NPANEL - 1 + 4;
        int n = 1 + l * (per0 + pe0);
#pragma unroll
        for (int i = 0; i < 7; ++i) if (i < sec) n += sz[i];
        if (sec == 0) { for (int pm = 0; pm < NPANEL; ++pm) { qt[n++] = mkd(U_PA, l, pm, q); if (pa_extra_queue(pm, 8) == q) qt[n++] = mkd(U_PA, l, pm, 8); if (pa_extra_queue(pm, 9) == q) qt[n++] = mkd(U_PA, l, pm, 9); } }
        else if (sec == 1) { for (int c = q; c < NCHUNK; c += 8) qt[n++] = mkd(U_SSM, l, c, 0); }
        else if (sec == 2) { for (int k = 0; k <= (NBATCH * NQB - 1 - q) / 16; ++k) { const int a0 = q + 16 * k, c = q + 8 * k, a1 = a0 + 8;
                if (a0 < NBATCH * NQB) qt[n++] = mkd(U_ATT, l, a0, 0); if (c < NCHUNK) qt[n++] = mkd(U_POOL, l, c, 0); if (a1 < NBATCH * NQB) qt[n++] = mkd(U_ATT, l, a1, 0); } }
        else if (sec == 3) { for (int s = q; s < NSAMP; s += 8) qt[n++] = mkd(U_SATT, l, s, 0); }
        else if (sec == 4) { }
        else if (sec == 5) { for (int pm = 0; pm < NPANEL; ++pm) qt[n++] = mkd(U_PC, l, pm, q); }
        else if (sec == 6) { for (int pm = 0; pm < NPANEL; ++pm) for (int j = 0; j < 4; ++j) qt[n++] = mkd(U_PD, l, pm, 4 * q + j); }
        else {
            for (int pm = 0; pm < NPANEL - 1; ++pm) qt[n++] = mkd(U_PE, l, pm, q);
            if (l == NLAYER - 1) { for (int k = 0; k < 4; ++k) qt[n++] = mkd(U_PEQ, l, NPANEL - 1, 4 * q + k); } else qt[n++] = mkd(U_PE, l, NPANEL - 1, q);
        }
        if (lane == 15) qt[0] = (unsigned)(2 * per0 + pe0 + pe1);
    }
}

struct Sched {
    gu32* ctl; const unsigned* qglob; LAS unsigned* qlds; volatile LAS unsigned* slot; int myq; unsigned nclaim; int ptype;
    __device__ __forceinline__ unsigned claim_lane() {
        { unsigned ho = (unsigned)(CW_QHEAD + myq * 64); asm volatile("" : "+s"(ho));
          const unsigned idx = __hip_atomic_fetch_add(ctl + ho, 1u, RLX_AGENT); if (idx < qlds[0]) return qlds[1 + idx]; }
        for (int k = 1; k < 8; ++k) { const int q = (myq + k) & 7; const unsigned* qg = qglob + (size_t)q * QCAP;
            if (__hip_atomic_load((gu32*)(ctl + CW_QHEAD + q * 64), RLX_AGENT) >= qg[0]) continue;
            const unsigned idx = __hip_atomic_fetch_add(ctl + CW_QHEAD + q * 64, 1u, RLX_AGENT); if (idx < qg[0]) return qg[1 + idx]; }
        return 0u;
    }
    __device__ __forceinline__ unsigned claim_wg(int tid) {
        const unsigned k = nclaim++ & 1u;
        if (tid == 0) slot[k] = claim_lane();
        WG_BAR();
        return slot[k];
    }
    __device__ __forceinline__ void poll(gu32* w, unsigned want) {
        unsigned sp = 0;
#if PROBE && PROBE_KIND == 1
        if (__hip_atomic_load(w, RLX_AGENT) >= want) return;
        struct TAcc { unsigned long long t0; volatile LAS unsigned* acc; bool on; __device__ ~TAcc() { if (on) acc[6] += (unsigned)(__builtin_amdgcn_s_memrealtime() - t0); } } tacc_{__builtin_amdgcn_s_memrealtime(), slot, PROBE_TYPE == 0 || ptype == PROBE_TYPE};
#endif
        while (__hip_atomic_load(w, RLX_AGENT) < want) { __builtin_amdgcn_s_sleep(1);
            if ((++sp & 1023u) == 0u) { if (__hip_atomic_load(ctl + CW_TMO, RLX_AGENT) != 0u) break; if (sp > (1u << 17)) { __hip_atomic_store(ctl + CW_TMO, 0x66u, RLX_AGENT); break; } } }
    }
    __device__ __forceinline__ void poll2(gu32* w1, unsigned want1, gu32* w2, unsigned want2) {
        const unsigned v1 = __hip_atomic_load(w1, RLX_AGENT), v2 = __hip_atomic_load(w2, RLX_AGENT);
        if (v1 >= want1 && v2 >= want2) return;
        poll(w1, want1); poll(w2, want2);
    }
    __device__ __forceinline__ bool ready_now(gu32* w, unsigned want) { return __hip_atomic_load(w, RLX_AGENT) >= want; }
    __device__ __forceinline__ bool deps_ready_now(unsigned d) {
        const int type = d >> 24, l = (d >> 20) & 15, a = (d >> 10) & 1023; bool ok = true;
        if (type == U_PA) { if (l > 0) { const int p2 = (a + 1 < NPANEL) ? a + 1 : NPANEL - 1;
                const unsigned v1 = __hip_atomic_load(cnt_word(ctl, l - 1, 4, a), RLX_AGENT), v2 = __hip_atomic_load(cnt_word(ctl, l - 1, 1, p2), RLX_AGENT); ok = (v1 >= 8u) && (v2 >= mix_target(p2)); } }
        else if (type == U_PC) ok = ready_now(cnt_word(ctl, l, 1, a), mix_target(a));
        else if (type == U_PD) ok = ready_now(cnt_word(ctl, l, 2, a), 8u);
        else ok = ready_now(cnt_word(ctl, l, 3, a), 32u);
        if (ok) { __builtin_amdgcn_fence(__ATOMIC_ACQUIRE, ACQ_SCOPE); asm volatile("s_waitcnt vmcnt(0)" ::: "memory"); }
        return ok;
    }
    __device__ __forceinline__ void wait_deps(unsigned d, int tid) {
        if (tid == 0) {
            const int type = d >> 24, l = (d >> 20) & 15, a = (d >> 10) & 1023; ptype = type;
            if (type == U_PA) { if (l > 0) { const int p2 = (a + 1 < NPANEL) ? a + 1 : NPANEL - 1; poll2(cnt_word(ctl, l - 1, 4, a), 8u, cnt_word(ctl, l - 1, 1, p2), mix_target(p2)); } }
            else if (type == U_PC) poll(cnt_word(ctl, l, 1, a), mix_target(a));
            else if (type == U_PD) poll(cnt_word(ctl, l, 2, a), 8u);
            else if (type == U_PE || type == U_PEQ) poll(cnt_word(ctl, l, 3, a), 32u);
            else if (type == U_SSM) poll(cnt_word(ctl, l, 0, a >> 2), 10u);
            else if (type == U_POOL) { const int r0 = 64 * a - 16; if (r0 >= 0 && (r0 >> 8) != (a >> 2)) poll2(cnt_word(ctl, l, 0, a >> 2), 10u, cnt_word(ctl, l, 0, r0 >> 8), 10u); else poll(cnt_word(ctl, l, 0, a >> 2), 10u); }
            else if (type == U_SATT) poll(cnt_word(ctl, l, 0, NPANEL - 1), 10u);
            else if (type == U_ATT) { const int b = a / NQB, i = a % NQB, t0 = 32 * i; const int rlo = b * TT + (t0 >= 128 ? t0 - 128 : 0), rhi = b * TT + ((t0 + 31 < TT) ? t0 + 31 : TT - 1);
                if ((rhi >> 8) != (rlo >> 8)) poll2(cnt_word(ctl, l, 0, rlo >> 8), 10u, cnt_word(ctl, l, 0, rhi >> 8), 10u); else poll(cnt_word(ctl, l, 0, rlo >> 8), 10u); }
            __builtin_amdgcn_fence(__ATOMIC_ACQUIRE, ACQ_SCOPE);
            asm volatile("s_waitcnt vmcnt(0)" ::: "memory");
        }
        asm volatile("" ::: "memory"); __builtin_amdgcn_s_barrier(); asm volatile("" ::: "memory");
    }
    __device__ __forceinline__ void publish(unsigned d, int tid) {
        asm volatile("s_waitcnt vmcnt(0)" ::: "memory");
        WG_BAR();
        if (tid == 0) {
            const int type = d >> 24, l = (d >> 20) & 15, a = (d >> 10) & 1023;
#if PUBLISH_FENCE
            __builtin_amdgcn_fence(__ATOMIC_RELEASE, "agent");
            asm volatile("s_waitcnt vmcnt(0)" ::: "memory");
#endif
            if (type == U_PA) __hip_atomic_fetch_add(cnt_word(ctl, l, 0, a), 1u, RLX_AGENT);
            else if (type == U_PC) __hip_atomic_fetch_add(cnt_word(ctl, l, 2, a), 1u, RLX_AGENT);
            else if (type == U_PD) __hip_atomic_fetch_add(cnt_word(ctl, l, 3, a), 1u, RLX_AGENT);
            else if (type == U_PE) __hip_atomic_fetch_add(cnt_word(ctl, l, 4, a), 1u, RLX_AGENT);
            else if (type == U_SSM || type == U_POOL) __hip_atomic_fetch_add(cnt_word(ctl, l, 1, a >> 2), 64u, RLX_AGENT);
            else if (type == U_SATT) __hip_atomic_fetch_add(cnt_word(ctl, l, 1, NPANEL - 1), 1u, RLX_AGENT);
            else if (type == U_ATT) { const int b = a / NQB, i = a % NQB, t0 = 32 * i; const int r0 = b * TT + t0, r1 = b * TT + ((t0 + 31 < TT) ? t0 + 31 : TT - 1);
                const int p0 = r0 >> 8, p1 = r1 >> 8;
                if (p0 == p1) __hip_atomic_fetch_add(cnt_word(ctl, l, 1, p0), (unsigned)(r1 - r0 + 1), RLX_AGENT);
                else { __hip_atomic_fetch_add(cnt_word(ctl, l, 1, p0), (unsigned)(256 * p1 - r0), RLX_AGENT); __hip_atomic_fetch_add(cnt_word(ctl, l, 1, p1), (unsigned)(r1 - 256 * p1 + 1), RLX_AGENT); } }
        }
    }
};

#ifndef A_AUX
#define A_AUX 0
#endif
struct GU { const char* A; const char* B; unsigned voffA[2], voffB[2]; size_t hstep; int nt; int t0; unsigned d; pg8::Unit u; };

struct StreamCtx { unsigned char* ws; float* out; const float* gq; const float* gk; int R[2], C[2], Rp[2]; };
#ifndef KPH_MUL
#define KPH_MUL 155
#endif
__device__ __forceinline__ void gu_fill(GU& g, unsigned d, const StreamCtx& X) {
    const int type = d >> 24, l = (d >> 20) & 15, pm = (d >> 10) & 1023; int pn = d & 1023;
    unsigned char* ws = X.ws;
    const bf16* A; const bf16* B; int K = DM; bool perm = false;
    if (type == U_PA) { A = (const bf16*)(ws + WS_XB); B = (const bf16*)(ws + WS_WIN) + (size_t)l * INW * DM; }
    else if (type == U_PC) { A = (const bf16*)(ws + WS_MIX); B = (const bf16*)(ws + WS_WOUT) + (size_t)l * DM * DM; perm = true; }
    else if (type == U_PD) { A = (const bf16*)(ws + WS_XB); B = (const bf16*)(ws + WS_W1) + (size_t)l * DFF * DM; perm = true; }
    else { A = (const bf16*)(ws + WS_H); B = (const bf16*)(ws + WS_W2) + (size_t)l * DM * DFF; K = DFF; perm = true; }
    int koff = 0, nt = K / 64;
    if (type == U_PEQ) { koff = (pn & 3) * (DFF / 4); nt = DFF / 4 / 64; pn >>= 2; }
    g.d = d; g.u.pm = pm; g.u.pn = pn; g.nt = nt; g.hstep = (size_t)128 * K * 2; g.t0 = (type == U_PD) ? (int)(2u * ((((unsigned)(4 * pm + (pn & 3)) * KPH_MUL + 128u) >> 8) % 16u)) : (type == U_PE) ? (int)(2u * ((((unsigned)pm * KPH_MUL + 128u) >> 8) % 64u)) : 0;
    g.A = (const char*)A + ((size_t)pm * 256 * K + koff) * 2; g.B = (const char*)B + ((size_t)pn * 256 * K + koff) * 2;
#pragma unroll
    for (int i = 0; i < 2; ++i) { g.voffA[i] = (unsigned)(X.R[i] * K + X.C[i]) * 2u; g.voffB[i] = (unsigned)((perm ? X.Rp[i] : X.R[i]) * K + X.C[i]) * 2u; }
}

__device__ __forceinline__ unsigned gemm_stream(const Args& AR, Frame& F, Sched& Q, unsigned d0) {
    int tid_ = F.tid(); asm volatile("" : "+v"(tid_));
    const int tid = tid_, wid = __builtin_amdgcn_readfirstlane(tid >> 6), lane = tid & 63, wr = wid >> 2, wc = wid & 3, fr = lane & 15, fq = lane >> 4;
    LAS unsigned char* lds = F.lds; LAS unsigned char* esc = F.lds + ESC_OFF;
    StreamCtx X; X.ws = F.ws; X.out = F.out;
#pragma unroll
    for (int i = 0; i < 2; ++i) { int R, C; pg8::stage_rc(tid * 16 + i * 8192, R, C); X.R[i] = R; X.C[i] = C; X.Rp[i] = (R & ~31) + pg8::perm32(R & 31); }
    const size_t kstep = (size_t)(pg8::BK * 2);
    const unsigned ldsw = (unsigned)wid * 1024u;
#define PG8_SA(b, h) (((b) * 2 + (h)) * pg8::HTB)
#define PG8_SB(b, h) ((4 + (b) * 2 + (h)) * pg8::HTB)
#define PG8_STAGE(bufoff, gbase, voff) do { _Pragma("unroll") for (int _i = 0; _i < 2; ++_i) \
        __builtin_amdgcn_global_load_lds((const unsigned*)((const char*)(gbase) + (voff)[_i]), (LAS unsigned*)(lds + (bufoff) + ldsw + _i * 8192), 16, 0, 0); } while (0)
#define PG8_STAGE_A(bufoff, gbase, voff) do { _Pragma("unroll") for (int _i = 0; _i < 2; ++_i) \
        __builtin_amdgcn_global_load_lds((const unsigned*)((const char*)(gbase) + (voff)[_i]), (LAS unsigned*)(lds + (bufoff) + ldsw + _i * 8192), 16, 0, A_AUX); } while (0)
#define PG8_LDA(dst, b, h) do { _Pragma("unroll") for (int m = 0; m < 4; ++m) _Pragma("unroll") for (int k = 0; k < 2; ++k) dst[m][k] = *(const LAS bf16x8*)(lds + PG8_SA(b, h) + aoff + m * 2048 + k * 1024); } while (0)
#define PG8_LDB(dst, b, h) do { _Pragma("unroll") for (int n = 0; n < 2; ++n) _Pragma("unroll") for (int k = 0; k < 2; ++k) dst[n][k] = *(const LAS bf16x8*)(lds + PG8_SB(b, h) + boff + n * 2048 + k * 1024); } while (0)
#define PG8_MMA(ai, bj, At, Bt) do { if (mm[ai]) { __builtin_amdgcn_s_setprio(1); _Pragma("unroll") for (int m = 0; m < 4; ++m) _Pragma("unroll") for (int n = 0; n < 2; ++n) _Pragma("unroll") for (int k = 0; k < 2; ++k) \
        acc[ai][bj][m][n] = __builtin_amdgcn_mfma_f32_16x16x32_bf16(Bt[n][k], At[m][k], acc[ai][bj][m][n], 0, 0, 0); __builtin_amdgcn_s_setprio(0); } } while (0)
#define PG8_WAIT_V(n) asm volatile("s_waitcnt vmcnt(" #n ")" ::: "memory")
#define PG8_WAIT_L(n) asm volatile("s_waitcnt lgkmcnt(" #n ")" ::: "memory")
#define PG8_BAR __builtin_amdgcn_s_barrier()
#define PG8_SCHED __builtin_amdgcn_sched_barrier(0)
#if PROBE && PROBE_KIND == 10
    const unsigned long long tse0 = __builtin_amdgcn_s_memrealtime();
#endif
    GU cur;
    gu_fill(cur, d0, X);
    f32x4 acc[2][2][4][2];
#pragma unroll
    for (int a = 0; a < 2; ++a)
#pragma unroll
        for (int b = 0; b < 2; ++b)
#pragma unroll
            for (int m = 0; m < 4; ++m)
#pragma unroll
                for (int n = 0; n < 2; ++n) acc[a][b][m][n] = (f32x4){0.f, 0.f, 0.f, 0.f};
    bf16x8 At[4][2], B0[2][2], B1[2][2];
    const char* eA = cur.A + (size_t)cur.t0 * kstep; const char* eB = cur.B + (size_t)cur.t0 * kstep;
    PG8_STAGE(PG8_SB(0, 0), eB, cur.voffB); PG8_STAGE(PG8_SB(0, 1), eB + cur.hstep, cur.voffB);
    Q.wait_deps(cur.d, tid);
    unsigned rb = 0u;
    { const int ty0 = d0 >> 24; const bool nr0 = (ty0 == U_PA || ty0 == U_PD) && tid < 256;
      RsLoad r0; if (nr0) rs_issue((const float*)(X.ws + WS_SSQ), cur.u.pm, tid, r0);
      PG8_STAGE_A(PG8_SA(0, 0), eA, cur.voffA); PG8_STAGE_A(PG8_SA(0, 1), eA + cur.hstep, cur.voffA);
      if (wr == 1) PG8_BAR;
      PG8_WAIT_V(2); PG8_BAR;
      if (nr0) rs_finish(r0, esc, 0u, tid); }
    PG8_STAGE(PG8_SB(1, 0), eB + kstep, cur.voffB); PG8_STAGE_A(PG8_SA(1, 0), eA + kstep, cur.voffA); PG8_STAGE(PG8_SB(1, 1), eB + cur.hstep + kstep, cur.voffB);
    PG8_WAIT_V(6); PG8_BAR;
#if PROBE && PROBE_KIND == 10
    if (tid == 0) { Q.slot[6] += (unsigned)(__builtin_amdgcn_s_memrealtime() - tse0); Q.slot[7] += 1u; }
#endif
    unsigned carry = 0u; unsigned ui = 0u;
    for (;;) {
        bool go = false;
        int tk_ = tid; asm volatile("" : "+v"(tk_));
        const int aoff = pg8::lds_byte(wr * 64 + (tk_ & 15), ((tk_ >> 4) & 3) * 8), boff = pg8::lds_byte(wc * 32 + (tk_ & 15), ((tk_ >> 4) & 3) * 8);
        const char* cA = cur.A; const char* cB = cur.B; const size_t hstep = cur.hstep; const int nt = cur.nt, t0 = cur.t0;
#if PROBE && PROBE_KIND == 3
        const unsigned long long tu0 = __builtin_amdgcn_s_memrealtime();
#endif
        const bool fullp = cur.u.pm != NPANEL - 1; const bool mm[2] = {fullp || wr == 0, fullp};
        for (int t = 0; t < nt; t += 2) {
            const bool last = (t == nt - 2);
            int p0 = t + t0; if (p0 >= nt) p0 -= nt;
            int p2 = (last ? 0 : t + 2) + t0; if (p2 >= nt) p2 -= nt;
            const char* a1 = cA + (size_t)(p0 + 1) * kstep;
            const char* a2_ = cA + (size_t)p2 * kstep; const char* b2_ = cB + (size_t)p2 * kstep;
            const char* a2 = a2_; const char* b2 = b2_; size_t h2 = hstep;
            unsigned vA2[2], vB2[2];
#pragma unroll
            for (int i = 0; i < 2; ++i) { vA2[i] = cur.voffA[i]; vB2[i] = cur.voffB[i]; }
            if (last) {
                const unsigned k = 2u + (ui & 1u);
#if PROBE && PROBE_KIND == 8
                const unsigned long long tc0 = __builtin_amdgcn_s_memrealtime();
#endif
                if (tid == 0) { const unsigned dn = Q.claim_lane(); Q.slot[k] = dn;
                    Q.slot[2u + k] = ((dn >> 24) >= U_PA && (dn >> 24) <= U_GEMM_LAST && (!STREAM_SAME_SECTION || ((dn >> 20) == (cur.d >> 20))) && Q.deps_ready_now(dn)) ? 1u : 0u; }
                asm volatile("s_waitcnt lgkmcnt(0)" ::: "memory"); PG8_BAR; asm volatile("" ::: "memory");
                carry = Q.slot[k]; go = Q.slot[2u + k] != 0u;
#if PROBE && PROBE_KIND == 14
                if (tid == 0 && (int)(cur.d >> 24) == PROBE_TYPE) { Q.slot[6] += go ? 100u : 0u; Q.slot[7] += 1u; }
#endif
#if PROBE && PROBE_KIND == 8
                if (tid == 0 && (int)(cur.d >> 24) == PROBE_TYPE) { Q.slot[6] += (unsigned)(__builtin_amdgcn_s_memrealtime() - tc0); Q.slot[7] += 1u; }
#endif
                if (go) { GU n2; gu_fill(n2, carry, X); a2 = n2.A + (size_t)n2.t0 * kstep; b2 = n2.B + (size_t)n2.t0 * kstep; h2 = n2.hstep;
#pragma unroll
                    for (int i = 0; i < 2; ++i) { vA2[i] = n2.voffA[i]; vB2[i] = n2.voffB[i]; } }
            }
            const char* a3 = a2 + kstep; const char* b3 = b2 + kstep;
            PG8_LDB(B0, 0, 0); PG8_LDB(B1, 0, 1); PG8_SCHED; PG8_LDA(At, 0, 0); PG8_STAGE_A(PG8_SA(1, 1), a1 + hstep, cur.voffA);
            PG8_WAIT_V(8); PG8_WAIT_L(0); PG8_BAR; PG8_MMA(0, 0, At, B0); PG8_MMA(0, 1, At, B1); PG8_BAR; PG8_SCHED;
            PG8_LDA(At, 0, 1); PG8_STAGE(PG8_SB(0, 0), b2, vB2); PG8_STAGE(PG8_SB(0, 1), b2 + h2, vB2); PG8_STAGE_A(PG8_SA(0, 0), a2, vA2);
            PG8_WAIT_V(8); PG8_WAIT_L(0); PG8_BAR; PG8_MMA(1, 0, At, B0); PG8_MMA(1, 1, At, B1); PG8_BAR; PG8_SCHED;
            PG8_LDB(B0, 1, 0); PG8_LDB(B1, 1, 1); PG8_SCHED; PG8_LDA(At, 1, 0); PG8_STAGE_A(PG8_SA(0, 1), a2 + h2, vA2);
            PG8_WAIT_V(8); PG8_WAIT_L(0); PG8_BAR; PG8_MMA(0, 0, At, B0); PG8_MMA(0, 1, At, B1); PG8_BAR; PG8_SCHED;
            PG8_LDA(At, 1, 1); PG8_STAGE(PG8_SB(1, 0), b3, vB2); PG8_STAGE(PG8_SB(1, 1), b3 + h2, vB2); PG8_STAGE_A(PG8_SA(1, 0), a3, vA2);
            PG8_WAIT_V(8); PG8_WAIT_L(0); PG8_BAR; PG8_MMA(1, 0, At, B0); PG8_MMA(1, 1, At, B1); PG8_BAR; PG8_SCHED;
        }
#if PROBE && PROBE_KIND == 7
        const unsigned long long te0 = __builtin_amdgcn_s_memrealtime();
#endif
        if (wr == 0) PG8_BAR;
        { const int type = cur.d >> 24, l = (cur.d >> 20) & 15;
          int te_ = tid; asm volatile("" : "+v"(te_)); const int fr = te_ & 15, fq = (te_ >> 4) & 3;
          if (type == U_PA) { EpiProj E{X.ws, X.out, AR.in[IN_GQ] + l * 128, AR.in[IN_GK] + l * 128, l, rs_off(rb)}; E(acc, cur.u, wr, wc, fr, fq, esc, tid); }
          else if (type == U_PD) { EpiFfn1 E{X.ws, rs_off(rb)}; E(acc, cur.u, wr, wc, fr, fq, esc, tid); }
          else if (type == U_PEQ) { EpiAtom E{X.out}; E(acc, cur.u, wr, wc, fr, fq, esc, tid); }
          else { EpiRes E{X.ws, X.out, (type == U_PE && l == NLAYER - 1) ? 1 : 0, (type == U_PC && l == NLAYER - 1 && cur.u.pm == NPANEL - 1) ? 1 : 0}; E(acc, cur.u, wr, wc, fr, fq, esc, tid); }
          { const int tyn = carry >> 24; const bool nrn = go && (tyn == U_PA || tyn == U_PD) && tid < 256;
            RsLoad rn; if (nrn) rs_issue((const float*)(X.ws + WS_SSQ), (int)((carry >> 10) & 1023u), tid, rn);
            if (nrn) rs_finish(rn, esc, rb ^ 1u, tid);
            Q.publish(cur.d, tid);
            asm volatile("" ::: "memory"); }
#if PROBE && PROBE_KIND == 7
          if (tid == 0 && (int)(cur.d >> 24) == PROBE_TYPE && cur.u.pm != NPANEL - 1) { Q.slot[6] += (unsigned)(__builtin_amdgcn_s_memrealtime() - te0); Q.slot[7] += 1u; }
#endif
#if PROBE && PROBE_KIND == 3
          if (tid == 0 && (int)(cur.d >> 24) == PROBE_TYPE && cur.u.pm != NPANEL - 1) { Q.slot[6] += (unsigned)(__builtin_amdgcn_s_memrealtime() - tu0); Q.slot[7] += 1u; }
#endif
          }
        if (!go) break;
        { float z0 = 0.f; asm volatile("" : "+v"(z0));
#pragma unroll
        for (int a = 0; a < 2; ++a)
#pragma unroll
            for (int b = 0; b < 2; ++b)
#pragma unroll
                for (int m = 0; m < 4; ++m)
#pragma unroll
                    for (int n = 0; n < 2; ++n) acc[a][b][m][n] = (f32x4){z0, z0, z0, z0}; }
        gu_fill(cur, carry, X); ++ui; rb ^= 1u;
        if (wr == 1) PG8_BAR;
    }
    PG8_WAIT_V(0);
    PG8_BAR;
#undef PG8_SA
#undef PG8_SB
#undef PG8_STAGE
#undef PG8_STAGE_A
#undef PG8_LDA
#undef PG8_LDB
#undef PG8_MMA
#undef PG8_WAIT_V
#undef PG8_WAIT_L
#undef PG8_BAR
#undef PG8_SCHED
    return carry;
}

__global__ void __launch_bounds__(512, 2) hymba_fwd(Args args) {
    extern __shared__ __attribute__((aligned(16))) unsigned char lds[];
    Frame F;
    F.lds = (LAS unsigned char*)lds;
    F.MISC = (volatile LAS unsigned*)(F.lds + MISC_OFF);
    F.wave = __builtin_amdgcn_readfirstlane((int)(threadIdx.x >> 6));
    F.G = gridDim.x; { const int bx = blockIdx.x; F.vcu = (F.G % 8 == 0) ? (bx % 8) * (F.G / 8) + bx / 8 : bx; }
    F.ws = args.ws; F.out = args.out; F.ctl = (gu32*)(args.ws + WS_CTL);
    for (int u = F.tid(); u < (LDS_BYTES - LDSCTL_OFF) / 4; u += 512) ((LAS unsigned*)(F.lds + LDSCTL_OFF))[u] = 0u;
    __syncthreads();
    XcdBarrier bar = xcd_barrier_post((unsigned*)(F.ctl + CW_BAR), F.MISC + 8);
#if PROBE
    const unsigned long long tk0 = __builtin_amdgcn_s_memrealtime();
#endif
    for (int rep = 0; rep < DUP_P0; ++rep) p0_prologue(args, F);
#if PROBE && (PROBE_KIND == 5 || PROBE_KIND == 6)
    if (F.tid() == 0) { F.MISC[6] = (unsigned)(__builtin_amdgcn_s_memrealtime() - tk0); if (PROBE_KIND == 6) __hip_atomic_fetch_max(F.ctl + CW_STAT + 48, F.MISC[6], RLX_AGENT); }
#endif
    if (blockIdx.x < 8 && F.wave == 7) build_queue((unsigned*)(args.ws + WS_QUEUE) + (size_t)blockIdx.x * QCAP, (int)blockIdx.x, F.lane());
    xcd_barrier(bar);
    Sched Q; Q.ctl = F.ctl; Q.qglob = (const unsigned*)(args.ws + WS_QUEUE); Q.qlds = (LAS unsigned*)(F.lds + QTAB_OFF); Q.slot = F.MISC; Q.myq = __builtin_amdgcn_readfirstlane((int)(bar.x & 7u)); Q.nclaim = 0u; Q.ptype = 0;
    { const unsigned* qg = Q.qglob + (size_t)Q.myq * QCAP; for (int i = F.tid(); i < QCAP; i += 512) Q.qlds[i] = qg[i]; }
    WG_BAR();
    unsigned d = Q.claim_wg(F.tid());
#if SEC_BARRIER
    int cursec = 0;
#endif
    for (;;) {
        const int type = d >> 24;
#if SEC_BARRIER
        { const int sec = (type == U_END) ? 5 * NLAYER : ((d >> 20) & 15) * 5 + ((type >= U_SSM) ? 1 : (type == U_PA ? 0 : type));
          while (cursec < sec) { if ((SEC_MASK >> cursec) & 1) xcd_barrier(bar); ++cursec; } }
#endif
        if (type == U_END) break;
        if (type <= U_GEMM_LAST) {
#if PROBE && PROBE_KIND == 9
            const unsigned long long ts0 = __builtin_amdgcn_s_memrealtime();
#endif
            d = gemm_stream(args, F, Q, d);
#if PROBE && PROBE_KIND == 9
            if (F.tid() == 0) { F.MISC[6] += (unsigned)(__builtin_amdgcn_s_memrealtime() - ts0); }
#endif
            continue; }
        const int l = (d >> 20) & 15, a = (d >> 10) & 1023;
        Q.wait_deps(d, F.tid());
#if PROBE && PROBE_KIND == 2
        const unsigned long long tp0 = __builtin_amdgcn_s_memrealtime();
#endif
        if (type == U_SSM) ssm_unit(args, F, l, a);
        else if (type == U_ATT) attn_unit(args, F, l, a / NQB, a % NQB);
        else if (type == U_SATT) sattn_unit(args, F, l, a);
        else pool_unit(args, F, l, a);
        const unsigned kc = Q.nclaim++ & 1u;
        if (F.tid() == 0) Q.slot[kc] = Q.claim_lane();
        Q.publish(d, F.tid());
#if PROBE && PROBE_KIND == 2
        if (F.tid() == 0 && (PROBE_TYPE == 0 || type == PROBE_TYPE)) F.MISC[6] += (unsigned)(__builtin_amdgcn_s_memrealtime() - tp0);
#endif
        d = Q.slot[kc];
    }
#if PROBE
    if (F.tid() == 0) {
        const unsigned tend = (unsigned)(__builtin_amdgcn_s_memrealtime() - tk0);
        if (PROBE_KIND == 4) { F.MISC[6] = tend; __hip_atomic_fetch_max(F.ctl + CW_STAT + 48, tend, RLX_AGENT); }
        __hip_atomic_fetch_add(F.ctl + CW_STAT, F.MISC[6], RLX_AGENT);
        __hip_atomic_fetch_add(F.ctl + CW_STAT + 32, F.MISC[7], RLX_AGENT);
        const unsigned n = __hip_atomic_fetch_add(F.ctl + CW_STAT + 16, 1u, RLX_AGENT);
        F.MISC[7] = (n == gridDim.x - 1) ? 1u : 0u;
        if (n == gridDim.x - 1) { F.MISC[5] = __hip_atomic_load(F.ctl + CW_STAT, RLX_AGENT); F.MISC[4] = __hip_atomic_load(F.ctl + CW_STAT + 32, RLX_AGENT); F.MISC[3] = __hip_atomic_load(F.ctl + CW_STAT + 48, RLX_AGENT); }
    }
    WG_BAR();
    if (F.MISC[7]) { float v = (float)F.MISC[5] / (float)gridDim.x * 0.01f;
        if (PROBE_KIND == 10 && PROBE_TYPE == 1) v = (float)F.MISC[4] / (float)gridDim.x;
        if (PROBE_KIND == 14) v = (float)F.MISC[5] / (float)(F.MISC[4] ? F.MISC[4] : 1u);
        if (PROBE_KIND == 3 || PROBE_KIND == 7 || PROBE_KIND == 8) v = (float)F.MISC[5] * 0.01f / (float)(F.MISC[4] ? F.MISC[4] : 1u);
        if (PROBE_KIND == 4) v = (float)F.MISC[3] * 0.01f - v;
        if (PROBE_KIND == 6) v = (float)F.MISC[3] * 0.01f;
        v = floorf((v + 0.5f * PROBE_Q) / PROBE_Q) * PROBE_Q;
        for (int i = F.tid(); i < NLAYER * NSAMP * 15 * 512; i += 512) F.out[O_SP + i] = v; }
#endif
}

extern "C" void kernel_launch(void* const* d_in, const int* in_sizes, int n_in, void* d_out, int out_size, void* d_ws, size_t ws_size, hipStream_t stream) {
    static int grid = 0;
    if (grid == 0) {
        if (n_in != 32 || (size_t)out_size != O_END || ws_size < WS_END) { fprintf(stderr, "kernel_launch: unexpected shapes: n_in %d out %d (want %zu) ws %zu (want >= %zu)\n", n_in, out_size, (size_t)O_END, ws_size, (size_t)WS_END); grid = -1; return; }
        int dev = 0, cus = 0, per_cu = 0;
        if (hipGetDevice(&dev) != hipSuccess || hipDeviceGetAttribute(&cus, hipDeviceAttributeMultiprocessorCount, dev) != hipSuccess) { fprintf(stderr, "kernel_launch: device query failed\n"); grid = -1; return; }
        if (hipFuncSetAttribute((const void*)hymba_fwd, hipFuncAttributeMaxDynamicSharedMemorySize, LDS_BYTES) != hipSuccess) { fprintf(stderr, "kernel_launch: hipFuncSetAttribute failed\n"); grid = -1; return; }
        if (hipOccupancyMaxActiveBlocksPerMultiprocessor(&per_cu, (const void*)hymba_fwd, 512, LDS_BYTES) != hipSuccess || per_cu < 1) { fprintf(stderr, "kernel_launch: occupancy query says %d blocks per CU\n", per_cu); per_cu = 1; }
        (void)hipGetLastError();
        grid = cus;
        if (grid % 8 != 0) grid -= grid % 8;
    }
    if (grid < 0) return;
    (void)hipMemsetAsync((char*)d_ws + WS_CTL, 0, CTL_ZERO_BYTES, stream);
    Args a{};
    for (int i = 0; i < 32; ++i) a.in[i] = (const float*)d_in[i];
    a.out = (float*)d_out; a.ws = (unsigned char*)d_ws; a.ph_lo = 0; a.ph_hi = 0;
    hipLaunchKernelGGL(hymba_fwd, dim3(grid), dim3(512), LDS_BYTES, stream, a);
    const hipError_t le = hipPeekAtLastError();
    if (le != hipSuccess) fprintf(stderr, "kernel_launch: launch failed: %s\n", hipGetErrorName(le));
}
```
